# Optimizing an MI355X kernel written in HIP

```python
import math
import jax, jax.numpy as jnp
from jax import lax
import numpy as np

D_MODEL = 1024
BATCH = 2
SEQ = 8192
DEPTH = 1

SSD_EXPAND = 2
D_INNER = SSD_EXPAND * D_MODEL
SSD_HEAD_DIM = 64
SSD_HEADS = D_INNER // SSD_HEAD_DIM
SSD_GROUPS = 4
D_STATE = 128
CONV_WIDTH = 4
SSD_CHUNK = 128
D_XBC = D_INNER + 2 * SSD_GROUPS * D_STATE
DIFF_HEADS = 8
DIFF_HEAD_DIM = 64
DIFF_V_DIM = 2 * DIFF_HEAD_DIM
DIFF_QK = DIFF_HEADS * 2 * DIFF_HEAD_DIM
DIFF_V = DIFF_HEADS * DIFF_V_DIM
Q_BLOCK = 128
MEM_LEN = 256
MEM_HEADS = 4
MEM_HEAD_DIM = D_MODEL // MEM_HEADS
PEER_HEADS = 8
PEER_N_KEYS = 128
PEER_N_EXPERTS = PEER_N_KEYS * PEER_N_KEYS
PEER_D_KEY = 256
PEER_HALF = PEER_D_KEY // 2
PEER_TOPK = 16
PEER_BLOCK = 128
ALPHA = (2 * DEPTH) ** 0.25
BETA = (8 * DEPTH) ** -0.25
LN_EPS = 1e-5
RMS_EPS = 1e-5
D_IN_PROJ = D_INNER + D_XBC + SSD_HEADS + 2 * DIFF_QK + DIFF_V + 2 * D_MODEL

kernel_name = "hybrid_ssd_diffattn_peer_block"


def _split_cols(h):
    sizes = (D_INNER, D_XBC, SSD_HEADS, DIFF_QK, DIFF_QK, DIFF_V, D_MODEL, D_MODEL)
    offs = np.cumsum(sizes)[:-1].tolist()
    return jnp.split(h, offs, axis=-1)


def layer_norm(x, g, b):
    xf = x.astype(jnp.float32)
    mu = jnp.mean(xf, axis=-1, keepdims=True)
    var = jnp.mean(jnp.square(xf - mu), axis=-1, keepdims=True)
    return ((xf - mu) * lax.rsqrt(var + LN_EPS) * g + b).astype(x.dtype)


def rms_norm(x, w):
    xf = x.astype(jnp.float32)
    xf = xf * lax.rsqrt(jnp.mean(jnp.square(xf), axis=-1, keepdims=True) + RMS_EPS)
    return (xf * w).astype(x.dtype)


def causal_dwconv(x, w, b):
    y = lax.conv_general_dilated(
        x, w[:, None, :], window_strides=(1,), padding=[(CONV_WIDTH - 1, 0)],
        dimension_numbers=("NWC", "WIO", "NWC"), feature_group_count=x.shape[-1])
    return y + b


def ssd_chunked(X, dtA, Bm, Cm):
    b, l, h, p = X.shape
    g, n = Bm.shape[2], Bm.shape[3]
    e = h // g
    c = l // SSD_CHUNK
    L = SSD_CHUNK
    X = X.reshape(b, c, L, g, e, p)
    A = dtA.astype(jnp.float32).reshape(b, c, L, g, e)
    Bm = Bm.reshape(b, c, L, g, n)
    Cm = Cm.reshape(b, c, L, g, n)
    Acs = jnp.cumsum(A, axis=2)
    AcsT = jnp.moveaxis(Acs, 2, -1)
    seg = AcsT[..., :, None] - AcsT[..., None, :]
    tril = jnp.tril(jnp.ones((L, L), dtype=bool))
    decay = jnp.exp(jnp.where(tril, seg, -jnp.inf))
    CB = jnp.einsum("bclgn,bcsgn->bcgls", Cm, Bm)
    M = CB[:, :, :, None] * decay
    y_diag = jnp.einsum("bcgels,bcsgep->bclgep", M, X)
    decay_states = jnp.exp(Acs[:, :, -1:] - Acs)
    states = jnp.einsum("bclgn,bclgep->bcgepn", Bm, X * decay_states[..., None])
    chunk_decay = jnp.exp(Acs[:, :, -1])

    def step(h_prev, inp):
        st, dec = inp
        return h_prev * dec[..., None, None] + st, h_prev

    h0 = jnp.zeros_like(states[:, 0])
    _, prev = lax.scan(step, h0, (jnp.moveaxis(states, 1, 0), jnp.moveaxis(chunk_decay, 1, 0)))
    prev = jnp.moveaxis(prev, 0, 1)
    y_off = jnp.einsum("bclgn,bcgepn->bclgep", Cm, prev) * jnp.exp(Acs)[..., None]
    return (y_diag + y_off).reshape(b, l, h, p)


def mamba2_branch(z, xbc, dt_raw, conv_w, conv_b, dt_bias, a_log, d_skip, norm_w):
    bsz, seq, _ = z.shape
    xbc = jax.nn.silu(causal_dwconv(xbc, conv_w, conv_b))
    xs, bm, cm = jnp.split(xbc, [D_INNER, D_INNER + SSD_GROUPS * D_STATE], axis=-1)
    dt = jax.nn.softplus(dt_raw.astype(jnp.float32) + dt_bias.astype(jnp.float32))
    a = -jnp.exp(a_log.astype(jnp.float32))
    xh = xs.reshape(bsz, seq, SSD_HEADS, SSD_HEAD_DIM)
    y = ssd_chunked(xh * dt[..., None], dt * a,
                    bm.reshape(bsz, seq, SSD_GROUPS, D_STATE),
                    cm.reshape(bsz, seq, SSD_GROUPS, D_STATE))
    y = y + d_skip[:, None] * xh
    y = y.reshape(bsz, seq, D_INNER) * jax.nn.silu(z)
    yg = y.astype(jnp.float32).reshape(bsz, seq, SSD_GROUPS, D_INNER // SSD_GROUPS)
    yg = yg * lax.rsqrt(jnp.mean(jnp.square(yg), axis=-1, keepdims=True) + RMS_EPS)
    return (yg.reshape(bsz, seq, D_INNER) * norm_w).astype(z.dtype)


def diff_attention(q, k, v, lam, lambda_init, subln_w):
    bsz, seq, _ = q.shape
    nb = seq // Q_BLOCK
    qb = q.reshape(bsz, nb, Q_BLOCK, DIFF_HEADS, 2, DIFF_HEAD_DIM).transpose(1, 0, 3, 4, 2, 5)
    qb = qb * (DIFF_HEAD_DIM ** -0.5)
    kt = k.reshape(bsz, seq, DIFF_HEADS, 2, DIFF_HEAD_DIM).transpose(0, 2, 3, 1, 4)
    vt = v.reshape(bsz, seq, DIFF_HEADS, DIFF_V_DIM).transpose(0, 2, 1, 3)
    key_pos = jnp.arange(seq)

    def one_block(args):
        qblk, blk = args
        s = jnp.einsum("bhmqd,bhmkd->bhmqk", qblk, kt).astype(jnp.float32)
        q_pos = blk * Q_BLOCK + jnp.arange(Q_BLOCK)
        s = jnp.where(key_pos[None, :] <= q_pos[:, None], s, -jnp.inf)
        p = jax.nn.softmax(s, axis=-1)
        att = p[:, :, 0] - lam * p[:, :, 1]
        return jnp.einsum("bhqk,bhkv->bhqv", att.astype(vt.dtype), vt)

    o = lax.map(one_block, (qb, jnp.arange(nb)))
    o = o.transpose(1, 0, 3, 2, 4).reshape(bsz, seq, DIFF_HEADS, DIFF_V_DIM)
    o = rms_norm(o, subln_w) * (1.0 - lambda_init)
    return o.reshape(bsz, seq, DIFF_V)


def memory_cross_attention(x, mem, wq, wk, wv, wo):
    bsz, seq, _ = x.shape
    m = mem.shape[1]
    q = (x @ wq).reshape(bsz, seq, MEM_HEADS, MEM_HEAD_DIM)
    k = (mem @ wk).reshape(bsz, m, MEM_HEADS, MEM_HEAD_DIM)
    v = (mem @ wv).reshape(bsz, m, MEM_HEADS, MEM_HEAD_DIM)
    s = jnp.einsum("bshd,bmhd->bhsm", q, k).astype(jnp.float32) * (MEM_HEAD_DIM ** -0.5)
    p = jax.nn.softmax(s, axis=-1).astype(x.dtype)
    o = jnp.einsum("bhsm,bmhd->bshd", p, v).reshape(bsz, seq, D_MODEL)
    return o @ wo


def peer_ffn(x, wq, sub_keys, peer_u, peer_v):
    bsz, seq, _ = x.shape
    q = (x @ wq).reshape(bsz, seq, PEER_HEADS, 2, PEER_HALF)
    s = jnp.einsum("bshtd,htkd->bshtk", q, sub_keys).astype(jnp.float32)
    top_s, top_i = lax.top_k(s, PEER_TOPK)
    cand_s = (top_s[..., 0, :, None] + top_s[..., 1, None, :]).reshape(bsz, seq, PEER_HEADS, PEER_TOPK * PEER_TOPK)
    cand_i = (top_i[..., 0, :, None] * PEER_N_KEYS + top_i[..., 1, None, :]).reshape(bsz, seq, PEER_HEADS, PEER_TOPK * PEER_TOPK)
    best_s, best_j = lax.top_k(cand_s, PEER_TOPK)
    idx = jnp.take_along_axis(cand_i, best_j, axis=-1)
    gate = jax.nn.softmax(best_s, axis=-1).astype(x.dtype)
    nb = seq // PEER_BLOCK

    def blockify(t):
        return t.reshape(bsz, nb, PEER_BLOCK, *t.shape[2:]).swapaxes(0, 1)

    def one_block(args):
        xb, ib, gb = args
        u = jnp.take(peer_u, ib, axis=0)
        hid = jnp.einsum("bqhkd,bqd->bqhk", u, xb)
        w = gb * jax.nn.gelu(hid, approximate=False)
        vv = jnp.take(peer_v, ib, axis=0)
        return jnp.einsum("bqhk,bqhkd->bqd", w, vv)

    y = lax.map(one_block, (blockify(x), blockify(idx), blockify(gate)))
    return y.swapaxes(0, 1).reshape(bsz, seq, D_MODEL)


def setup_inputs(seed: int = 0) -> dict:
    key = jax.random.key(seed)
    ks = iter(jax.random.split(key, 40))

    def nrm(shape, std):
        return jax.random.normal(next(ks), shape, jnp.float32) * std

    def near_one(shape):
        return 1.0 + 0.01 * jax.random.normal(next(ks), shape, jnp.float32)

    dt0 = jnp.exp(jax.random.uniform(next(ks), (DEPTH, SSD_HEADS), jnp.float32,
                                     math.log(1e-3), math.log(1e-1)))
    dt_bias = dt0 + jnp.log(-jnp.expm1(-dt0))
    a_log = jnp.log(jax.random.uniform(next(ks), (DEPTH, SSD_HEADS), jnp.float32, 1.0, 16.0))
    return {
        "x": nrm((BATCH, SEQ, D_MODEL), 1.0),
        "mem": nrm((BATCH, MEM_LEN, D_MODEL), 1.0),
        "w_in": nrm((DEPTH, D_MODEL, D_IN_PROJ), D_MODEL ** -0.5),
        "conv_w": nrm((DEPTH, CONV_WIDTH, D_XBC), CONV_WIDTH ** -0.5),
        "conv_b": nrm((DEPTH, D_XBC), 0.01),
        "dt_bias": dt_bias,
        "a_log": a_log,
        "d_skip": near_one((DEPTH, SSD_HEADS)),
        "ssd_norm_w": near_one((DEPTH, D_INNER)),
        "w_ssd_br": nrm((DEPTH, D_INNER, D_MODEL), D_INNER ** -0.5),
        "lam_q": nrm((DEPTH, 2, DIFF_HEAD_DIM), 0.1),
        "lam_k": nrm((DEPTH, 2, DIFF_HEAD_DIM), 0.1),
        "subln_w": near_one((DEPTH, DIFF_V_DIM)),
        "w_diff_br": nrm((DEPTH, DIFF_V, D_MODEL), DIFF_V ** -0.5),
        "gate_bias": nrm((DEPTH, 2, D_MODEL), 0.01),
        "w_o": nrm((DEPTH, D_MODEL, D_MODEL), BETA * D_MODEL ** -0.5),
        "ln1_g": near_one((DEPTH, D_MODEL)),
        "ln1_b": nrm((DEPTH, D_MODEL), 0.01),
        "w_cq": nrm((DEPTH, D_MODEL, D_MODEL), D_MODEL ** -0.5),
        "w_ck": nrm((DEPTH, D_MODEL, D_MODEL), D_MODEL ** -0.5),
        "w_cv": nrm((DEPTH, D_MODEL, D_MODEL), D_MODEL ** -0.5),
        "w_co": nrm((DEPTH, D_MODEL, D_MODEL), BETA * D_MODEL ** -0.5),
        "ln2_g": near_one((DEPTH, D_MODEL)),
        "ln2_b": nrm((DEPTH, D_MODEL), 0.01),
        "w_pq": nrm((DEPTH, D_MODEL, PEER_HEADS * PEER_D_KEY), D_MODEL ** -0.5),
        "sub_keys": nrm((DEPTH, PEER_HEADS, 2, PEER_N_KEYS, PEER_HALF), PEER_HALF ** -0.5),
        "peer_u": nrm((DEPTH, PEER_N_EXPERTS, D_MODEL), D_MODEL ** -0.5),
        "peer_v": nrm((DEPTH, PEER_N_EXPERTS, D_MODEL), BETA * PEER_HEADS ** -0.5),
        "ln3_g": near_one((DEPTH, D_MODEL)),
        "ln3_b": nrm((DEPTH, D_MODEL), 0.01),
    }


def reference(x, mem, w_in, conv_w, conv_b, dt_bias, a_log, d_skip, ssd_norm_w, w_ssd_br,
              lam_q, lam_k, subln_w, w_diff_br, gate_bias, w_o, ln1_g, ln1_b,
              w_cq, w_ck, w_cv, w_co, ln2_g, ln2_b, w_pq, sub_keys, peer_u, peer_v,
              ln3_g, ln3_b):
    for l in range(DEPTH):
        lambda_init = 0.8 - 0.6 * math.exp(-0.3 * l)
        h = x @ w_in[l]
        z, xbc, dt_raw, q, k, v, g_ssd, g_att = _split_cols(h)
        y_ssd = mamba2_branch(z, xbc, dt_raw, conv_w[l], conv_b[l], dt_bias[l], a_log[l],
                              d_skip[l], ssd_norm_w[l]) @ w_ssd_br[l]
        lq = lam_q[l].astype(jnp.float32)
        lk = lam_k[l].astype(jnp.float32)
        lam = jnp.exp(jnp.sum(lq[0] * lk[0])) - jnp.exp(jnp.sum(lq[1] * lk[1])) + lambda_init
        y_att = diff_attention(q, k, v, lam, lambda_init, subln_w[l]) @ w_diff_br[l]
        gate_a = jax.nn.sigmoid(g_ssd + gate_bias[l, 0])
        gate_b = jax.nn.sigmoid(g_att + gate_bias[l, 1])
        mix = (gate_a * y_ssd + gate_b * y_att) @ w_o[l]
        x = layer_norm(ALPHA * x + mix, ln1_g[l], ln1_b[l])
        x = layer_norm(ALPHA * x + memory_cross_attention(x, mem, w_cq[l], w_ck[l], w_cv[l], w_co[l]),
                       ln2_g[l], ln2_b[l])
        x = layer_norm(ALPHA * x + peer_ffn(x, w_pq[l], sub_keys[l], peer_u[l], peer_v[l]),
                       ln3_g[l], ln3_b[l])
    return x
```

```cpp
#include <hip/hip_runtime.h>
#include <cstdio>
#include <cstdint>
#include <cmath>

typedef unsigned short bf16_t;
typedef float f32x4 __attribute__((ext_vector_type(4)));
typedef unsigned u32x4 __attribute__((ext_vector_type(4)));

constexpr int D = 1024, BATCH = 2, SEQ = 8192, M = BATCH * SEQ;
constexpr int DI = 2048, NH = 32, HP = 64, NG = 4, DS = 128, DXBC = 3072;
constexpr int AH = 8, AD = 64, AV = 128;
constexpr int MEML = 256, MH = 4, MHD = 256;
constexpr int PH = 8, PK = 128, PDK = 256, PHALF = 128, PTOP = 16;
constexpr int NIN = 10272, NINP = 10240;
constexpr float ALPHA = 1.189207115002721f;
constexpr float LOG2E = 1.4426950408889634f;
constexpr float QSCALE = 0.125f * LOG2E;
constexpr float CQSCALE = 0.0625f * LOG2E;
constexpr float LAMBDA_INIT = 0.2f;
constexpr int HC_Z = 0, HC_XBC = 2048, HC_Q = 5120, HC_K = 6144, HC_V = 7168, HC_GS = 8192, HC_GA = 9216, HP_ = NINP;

constexpr size_t MiB = 1u << 20;
constexpr size_t WS_CTL = 0;
constexpr size_t WS_WIN = 1 * MiB;
constexpr size_t WS_WSSD = 21 * MiB;
constexpr size_t WS_WDIFF = 25 * MiB, WS_WO = 27 * MiB, WS_WCQ = 29 * MiB, WS_WCKV = 31 * MiB  , WS_WCO = 35 * MiB;
constexpr size_t WS_WPQ = 37 * MiB;
constexpr size_t WS_SUBK = 41 * MiB;
constexpr size_t WS_MEMB = 42 * MiB;
constexpr size_t WS_KCVC = 43 * MiB;
constexpr size_t WS_DT = 45 * MiB;
constexpr size_t WS_XB = 47 * MiB;
constexpr size_t WS_H = 79 * MiB;
constexpr size_t WS_T1 = 239 * MiB;
constexpr size_t WS_PU = 79 * MiB, WS_PV = 111 * MiB;
constexpr size_t WS_QC = 143 * MiB, WS_XO = 175 * MiB;
constexpr size_t WS_QP = 207 * MiB;
constexpr size_t WS_IDX = 143 * MiB, WS_GATE = 151 * MiB;
constexpr size_t WS_END = 271 * MiB;
constexpr int CW_LAM = 64;

__device__ __forceinline__ unsigned f2bf(float f) { unsigned u = __builtin_bit_cast(unsigned, f); return (u + 0x7fffu + ((u >> 16) & 1u)) >> 16; }
__device__ __forceinline__ float bf2f(unsigned h) { return __builtin_bit_cast(float, h << 16); }
__device__ __forceinline__ unsigned pk2(float lo, float hi) { return f2bf(lo) | (f2bf(hi) << 16); }
__device__ __forceinline__ float bflo(unsigned w) { return __builtin_bit_cast(float, w << 16); }
__device__ __forceinline__ float bfhi(unsigned w) { return __builtin_bit_cast(float, w & 0xffff0000u); }
__device__ __forceinline__ float sigmoidf_(float v) { return 1.f / (1.f + __expf(-v)); }
__device__ __forceinline__ float siluf_(float v) { return v / (1.f + __expf(-v)); }
__device__ __forceinline__ float wave_sum(float v) {
#pragma unroll
    for (int o = 1; o < 64; o <<= 1) v += __shfl_xor(v, o);
    return v;
}
__device__ __forceinline__ float wave_max(float v) {
#pragma unroll
    for (int o = 1; o < 64; o <<= 1) v = fmaxf(v, __shfl_xor(v, o));
    return v;
}

__global__ void __launch_bounds__(256) k_transpose(const float* __restrict__ W, int K, int Nsrc, bf16_t* __restrict__ Wt, int Nout, int skip_at, int skip, int pad_) {
    __shared__ float t[32][33];
    const int n0 = blockIdx.x * 32, k0 = blockIdx.y * 32, tx = threadIdx.x & 31, ty = threadIdx.x >> 5;
#pragma unroll
    for (int i = 0; i < 4; ++i) { const int n = n0 + tx, k = k0 + ty + 8 * i; const int c = n + (n >= skip_at ? skip : 0); t[ty + 8 * i][tx] = (n < Nout) ? W[(size_t)k * Nsrc + c] : 0.f; }
    __syncthreads();
#pragma unroll
    for (int i = 0; i < 4; ++i) { const int n = n0 + ty + 8 * i, k = k0 + tx; if (n < Nout) Wt[(size_t)n * K + k] = (bf16_t)f2bf(t[tx][ty + 8 * i]); }
}
__global__ void __launch_bounds__(256) k_cvt(const float* __restrict__ src, bf16_t* __restrict__ dst, size_t n4) {
    for (size_t i = (size_t)blockIdx.x * 256 + threadIdx.x; i < n4; i += (size_t)gridDim.x * 256) {
        const f32x4 v = ((const f32x4*)src)[i]; uint2 o; o.x = pk2(v.x, v.y); o.y = pk2(v.z, v.w); ((uint2*)dst)[i] = o; }
}
__global__ void __launch_bounds__(256) k_dt(const float* __restrict__ x, const float* __restrict__ w_in, const float* __restrict__ dt_bias, float* __restrict__ DT,
                                            const float* __restrict__ lam_q, const float* __restrict__ lam_k, float* __restrict__ lam_out) {
    __shared__ float xs[8][1024];
    const int m0 = blockIdx.x * 8, tid = threadIdx.x;
    for (int i = tid; i < 8 * 1024; i += 256) xs[i >> 10][i & 1023] = x[(size_t)(m0 + (i >> 10)) * D + (i & 1023)];
    __syncthreads();
    const int h = tid & 31, r = tid >> 5;
    float acc = 0.f;
    for (int k = 0; k < 1024; ++k) acc = fmaf(xs[r][k], w_in[(size_t)k * NIN + 5120 + h], acc);
    const float v = acc + dt_bias[h];
    DT[(size_t)(m0 + r) * 32 + h] = v > 20.f ? v : log1pf(expf(v));
    if (blockIdx.x == 0 && tid == 0) {
        float s0 = 0.f, s1 = 0.f;
        for (int i = 0; i < 64; ++i) { s0 += lam_q[i] * lam_k[i]; s1 += lam_q[64 + i] * lam_k[64 + i]; }
        *lam_out = expf(s0) - expf(s1) + LAMBDA_INIT;
    }
}

template <class Epi>
__global__ void __launch_bounds__(256) k_gemm_naive(const bf16_t* __restrict__ A, const bf16_t* __restrict__ Bt, int lda, int K, Epi E) {
    __shared__ float As[32][132];
    __shared__ float Bs[32][68];
    const int tid = threadIdx.x, row0 = blockIdx.y * 128, col0 = blockIdx.x * 64;
    const int tr = (tid >> 3) * 4, tc = (tid & 7) * 8;
    float acc[4][8];
#pragma unroll
    for (int i = 0; i < 4; ++i)
#pragma unroll
        for (int j = 0; j < 8; ++j) acc[i][j] = 0.f;
    for (int k0 = 0; k0 < K; k0 += 32) {
        {
            const int r = tid >> 1, kh = (tid & 1) * 16;
            const u32x4 a0 = *(const u32x4*)(A + (size_t)(row0 + r) * lda + k0 + kh), a1 = *(const u32x4*)(A + (size_t)(row0 + r) * lda + k0 + kh + 8);
            const unsigned w[8] = {a0.x, a0.y, a0.z, a0.w, a1.x, a1.y, a1.z, a1.w};
#pragma unroll
            for (int j = 0; j < 8; ++j) { As[kh + 2 * j][r] = bflo(w[j]); As[kh + 2 * j + 1][r] = bfhi(w[j]); }
            const int c = tid >> 2, kq = (tid & 3) * 8;
            const u32x4 b0 = *(const u32x4*)(Bt + (size_t)(col0 + c) * K + k0 + kq);
            const unsigned wb[4] = {b0.x, b0.y, b0.z, b0.w};
#pragma unroll
            for (int j = 0; j < 4; ++j) { Bs[kq + 2 * j][c] = bflo(wb[j]); Bs[kq + 2 * j + 1][c] = bfhi(wb[j]); }
        }
        __syncthreads();
#pragma unroll 8
        for (int k = 0; k < 32; ++k) {
            const f32x4 a = *(const f32x4*)&As[k][tr]; const f32x4 b0 = *(const f32x4*)&Bs[k][tc], b1 = *(const f32x4*)&Bs[k][tc + 4];
            const float av[4] = {a.x, a.y, a.z, a.w}; const float bv[8] = {b0.x, b0.y, b0.z, b0.w, b1.x, b1.y, b1.z, b1.w};
#pragma unroll
            for (int i = 0; i < 4; ++i)
#pragma unroll
                for (int j = 0; j < 8; ++j) acc[i][j] = fmaf(av[i], bv[j], acc[i][j]);
        }
        __syncthreads();
    }
#pragma unroll
    for (int i = 0; i < 4; ++i) E(row0 + tr + i, col0 + tc, acc[i]);
}

__device__ __forceinline__ void store_bf16x8(bf16_t* p, const float (&v)[8]) { u32x4 w; w.x = pk2(v[0], v[1]); w.y = pk2(v[2], v[3]); w.z = pk2(v[4], v[5]); w.w = pk2(v[6], v[7]); *(u32x4*)p = w; }
struct EpiPlain { bf16_t* O; int ldc; float scale;
    __device__ __forceinline__ void operator()(int row, int col0, const float (&v)[8]) const { float o[8];
#pragma unroll
        for (int j = 0; j < 8; ++j) o[j] = v[j] * scale; store_bf16x8(O + (size_t)row * ldc + col0, o); } };
struct EpiInProj { bf16_t* H; const float* gate_bias;
    __device__ __forceinline__ void operator()(int row, int col0, const float (&v)[8]) const { float o[8];
        if (col0 >= HC_GS) { const float* gb = gate_bias + (col0 - HC_GS);
#pragma unroll
            for (int j = 0; j < 8; ++j) o[j] = sigmoidf_(v[j] + gb[j]); }
        else { const float s = (col0 >= HC_Q && col0 < HC_K) ? QSCALE : 1.f;
#pragma unroll
            for (int j = 0; j < 8; ++j) o[j] = v[j] * s; }
        store_bf16x8(H + (size_t)row * HP_ + col0, o); } };
struct EpiGate1 { const bf16_t* H; float* T1;
    __device__ __forceinline__ void operator()(int row, int col0, const float (&v)[8]) const {
        const u32x4 g = *(const u32x4*)(H + (size_t)row * HP_ + HC_GS + col0); const unsigned gw[4] = {g.x, g.y, g.z, g.w};
        float* t = T1 + (size_t)row * D + col0;
#pragma unroll
        for (int j = 0; j < 4; ++j) { t[2 * j] = bflo(gw[j]) * v[2 * j]; t[2 * j + 1] = bfhi(gw[j]) * v[2 * j + 1]; } } };
struct EpiGate2 { bf16_t* H; const float* T1;
    __device__ __forceinline__ void operator()(int row, int col0, const float (&v)[8]) const {
        const u32x4 g = *(const u32x4*)(H + (size_t)row * HP_ + HC_GA + col0); const unsigned gw[4] = {g.x, g.y, g.z, g.w};
        const float* t = T1 + (size_t)row * D + col0; float o[8];
#pragma unroll
        for (int j = 0; j < 4; ++j) { o[2 * j] = t[2 * j] + bflo(gw[j]) * v[2 * j]; o[2 * j + 1] = t[2 * j + 1] + bfhi(gw[j]) * v[2 * j + 1]; }
        store_bf16x8(H + (size_t)row * HP_ + HC_K + col0, o); } };
struct EpiResid { const float* base; float* out; int row_off; int pad_;
    __device__ __forceinline__ void operator()(int row, int col0, const float (&v)[8]) const {
        const size_t o = (size_t)(row + row_off) * D + col0;
#pragma unroll
        for (int j = 0; j < 8; ++j) out[o + j] = ALPHA * base[o + j] + v[j]; } };

__global__ void __launch_bounds__(256) k_attn_naive(bf16_t* __restrict__ H, const float* __restrict__ subln_w, const float* __restrict__ lam_p) {
    extern __shared__ float o0s[];
    const int tid = threadIdx.x, h = blockIdx.y, row = blockIdx.x * 256 + tid;
    const int wave_last = blockIdx.x * 256 + (tid | 63);
    const float lam = *lam_p;
    float o[128];
    for (int m = 0; m < 2; ++m) {
        float q[64];
        { const bf16_t* qp = H + (size_t)row * HP_ + HC_Q + h * 128 + m * 64;
#pragma unroll
          for (int j = 0; j < 8; ++j) { const u32x4 w = *(const u32x4*)(qp + 8 * j); q[8 * j] = bflo(w.x); q[8 * j + 1] = bfhi(w.x); q[8 * j + 2] = bflo(w.y); q[8 * j + 3] = bfhi(w.y); q[8 * j + 4] = bflo(w.z); q[8 * j + 5] = bfhi(w.z); q[8 * j + 6] = bflo(w.w); q[8 * j + 7] = bfhi(w.w); } }
        float mx = -INFINITY, l = 0.f;
#pragma unroll
        for (int j = 0; j < 128; ++j) o[j] = 0.f;
        for (int t = 0; t <= wave_last; ++t) {
            const bf16_t* kp = H + (size_t)t * HP_ + HC_K + h * 128 + m * 64;
            float s = 0.f;
#pragma unroll
            for (int j = 0; j < 8; ++j) { const u32x4 w = *(const u32x4*)(kp + 8 * j);
                s = fmaf(q[8 * j], bflo(w.x), s); s = fmaf(q[8 * j + 1], bfhi(w.x), s); s = fmaf(q[8 * j + 2], bflo(w.y), s); s = fmaf(q[8 * j + 3], bfhi(w.y), s);
                s = fmaf(q[8 * j + 4], bflo(w.z), s); s = fmaf(q[8 * j + 5], bfhi(w.z), s); s = fmaf(q[8 * j + 6], bflo(w.w), s); s = fmaf(q[8 * j + 7], bfhi(w.w), s); }
            if (t > row) s = -INFINITY;
            const float mn = fmaxf(mx, s);
            const float f = (mn == -INFINITY) ? 1.f : exp2f(mx - mn), p = (s == -INFINITY) ? 0.f : exp2f(s - mn);
            mx = mn; l = l * f + p;
            const bf16_t* vp = H + (size_t)t * HP_ + HC_V + h * 128;
#pragma unroll
            for (int j = 0; j < 16; ++j) { const u32x4 w = *(const u32x4*)(vp + 8 * j);
                o[8 * j] = fmaf(p, bflo(w.x), o[8 * j] * f); o[8 * j + 1] = fmaf(p, bfhi(w.x), o[8 * j + 1] * f); o[8 * j + 2] = fmaf(p, bflo(w.y), o[8 * j + 2] * f); o[8 * j + 3] = fmaf(p, bfhi(w.y), o[8 * j + 3] * f);
                o[8 * j + 4] = fmaf(p, bflo(w.z), o[8 * j + 4] * f); o[8 * j + 5] = fmaf(p, bfhi(w.z), o[8 * j + 5] * f); o[8 * j + 6] = fmaf(p, bflo(w.w), o[8 * j + 6] * f); o[8 * j + 7] = fmaf(p, bfhi(w.w), o[8 * j + 7] * f); }
        }
        const float il = 1.f / l;
        if (m == 0) {
#pragma unroll
            for (int j = 0; j < 128; ++j) o0s[j * 256 + tid] = o[j] * il;
        } else {
            float ss = 0.f;
#pragma unroll
            for (int j = 0; j < 128; ++j) { o[j] = o0s[j * 256 + tid] - lam * (o[j] * il); ss += o[j] * o[j]; }
            const float r = rsqrtf(ss * (1.f / 128.f) + 1e-5f) * (1.f - LAMBDA_INIT);
            bf16_t* op = H + (size_t)row * HP_ + HC_Q + h * 128;
#pragma unroll
            for (int j = 0; j < 16; ++j) { float v8[8];
#pragma unroll
                for (int e = 0; e < 8; ++e) v8[e] = o[8 * j + e] * r * subln_w[8 * j + e];
                store_bf16x8(op + 8 * j, v8); }
        }
    }
}

__global__ void __launch_bounds__(256) k_conv_bc(const bf16_t* __restrict__ H, const float* __restrict__ conv_w, const float* __restrict__ conv_b, float* __restrict__ BC, int t0, int nt) {
    const size_t i = (size_t)blockIdx.x * 256 + threadIdx.x; if (i >= (size_t)nt * 1024) return;
    const int t = t0 + (int)(i >> 10), c = 2048 + (int)(i & 1023);
    float a = conv_b[c];
#pragma unroll
    for (int j = 0; j < 4; ++j) { const int tt = t - 3 + j; if (tt >= 0) a = fmaf(conv_w[j * DXBC + c], bf2f(H[(size_t)tt * HP_ + HC_XBC + c]), a); }
    BC[i] = siluf_(a);
}
__global__ void __launch_bounds__(256) k_ssd_seq(const bf16_t* __restrict__ H, const float* __restrict__ BC, const float* __restrict__ DT  ,
                                                 const float* __restrict__ conv_w, const float* __restrict__ conv_b, const float* __restrict__ a_log, const float* __restrict__ d_skip,
                                                 float* __restrict__ ST, float* __restrict__ YRAW  , int t0, int nt) {
    const int h = blockIdx.x, tid = threadIdx.x, p = tid >> 2, nq = tid & 3, g = h >> 3, ch = h * 64 + p;
    float st[32];
    float* stp = ST + ((size_t)(h * 64 + p) * 128 + nq * 32);
    if (t0 == 0) {
#pragma unroll
        for (int j = 0; j < 32; ++j) st[j] = 0.f;
    } else {
#pragma unroll
        for (int j = 0; j < 32; ++j) st[j] = stp[j];
    }
    const float a = -expf(a_log[h]), dsk = d_skip[h];
    const float cw0 = conv_w[ch], cw1 = conv_w[DXBC + ch], cw2 = conv_w[2 * DXBC + ch], cw3 = conv_w[3 * DXBC + ch], cb = conv_b[ch];
    float x0 = 0.f, x1 = 0.f, x2 = 0.f;
    if (t0 >= 3) { x0 = bf2f(H[(size_t)(t0 - 3) * HP_ + HC_XBC + ch]); x1 = bf2f(H[(size_t)(t0 - 2) * HP_ + HC_XBC + ch]); x2 = bf2f(H[(size_t)(t0 - 1) * HP_ + HC_XBC + ch]); }
    for (int i = 0; i < nt; ++i) {
        const int t = t0 + i;
        const float x3 = bf2f(H[(size_t)t * HP_ + HC_XBC + ch]);
        const float xs = siluf_(cb + cw0 * x0 + cw1 * x1 + cw2 * x2 + cw3 * x3);
        x0 = x1; x1 = x2; x2 = x3;
        const float dt = DT[(size_t)t * 32 + h], dA = expf(dt * a), dx = dt * xs;
        const float* bp = BC + (size_t)i * 1024 + g * 128 + nq * 32; const float* cp = bp + 512;
        float y = 0.f;
#pragma unroll
        for (int j = 0; j < 8; ++j) { const f32x4 b = *(const f32x4*)(bp + 4 * j), c = *(const f32x4*)(cp + 4 * j);
            st[4 * j] = fmaf(st[4 * j], dA, dx * b.x); y = fmaf(c.x, st[4 * j], y);
            st[4 * j + 1] = fmaf(st[4 * j + 1], dA, dx * b.y); y = fmaf(c.y, st[4 * j + 1], y);
            st[4 * j + 2] = fmaf(st[4 * j + 2], dA, dx * b.z); y = fmaf(c.z, st[4 * j + 2], y);
            st[4 * j + 3] = fmaf(st[4 * j + 3], dA, dx * b.w); y = fmaf(c.w, st[4 * j + 3], y); }
        y += __shfl_xor(y, 1); y += __shfl_xor(y, 2);
        if (nq == 0) { const float z = bf2f(H[(size_t)t * HP_ + HC_Z + ch]); YRAW[(size_t)i * DI + ch] = (y + dsk * xs) * siluf_(z); }
    }
#pragma unroll
    for (int j = 0; j < 32; ++j) stp[j] = st[j];
}
__global__ void __launch_bounds__(256) k_ssd_norm(const float* __restrict__ YRAW, const float* __restrict__ norm_w, bf16_t* __restrict__ H, int t0, int nt) {
    const int w = blockIdx.x * 4 + (threadIdx.x >> 6), lane = threadIdx.x & 63; if (w >= nt * 4) return;
    const int i = w >> 2, g = w & 3;
    const float* yp = YRAW + (size_t)i * DI + g * 512 + lane * 8;
    const f32x4 a = *(const f32x4*)yp, b = *(const f32x4*)(yp + 4);
    float ss = a.x * a.x + a.y * a.y + a.z * a.z + a.w * a.w + b.x * b.x + b.y * b.y + b.z * b.z + b.w * b.w;
    ss = wave_sum(ss);
    const float r = rsqrtf(ss * (1.f / 512.f) + 1e-5f);
    const float* nw = norm_w + g * 512 + lane * 8;
    float o[8] = {a.x * r * nw[0], a.y * r * nw[1], a.z * r * nw[2], a.w * r * nw[3], b.x * r * nw[4], b.y * r * nw[5], b.z * r * nw[6], b.w * r * nw[7]};
    store_bf16x8(H + (size_t)(t0 + i) * HP_ + HC_Z + g * 512 + lane * 8, o);
}

__global__ void __launch_bounds__(256) k_ln(float* __restrict__ X, const float* __restrict__ g, const float* __restrict__ b, bf16_t* __restrict__ XB, int row0, int nrows) {
    const int w = blockIdx.x * 4 + (threadIdx.x >> 6), lane = threadIdx.x & 63; if (w >= nrows) return;
    const int row = row0 + w;
    f32x4* xr = (f32x4*)(X + (size_t)row * D) + lane;
    f32x4 v[4]; float s = 0.f;
#pragma unroll
    for (int j = 0; j < 4; ++j) { v[j] = xr[64 * j]; s += (v[j].x + v[j].y) + (v[j].z + v[j].w); }
    const float mean = wave_sum(s) * (1.f / D); float s2 = 0.f;
#pragma unroll
    for (int j = 0; j < 4; ++j) { v[j] = v[j] - mean; s2 += (v[j].x * v[j].x + v[j].y * v[j].y) + (v[j].z * v[j].z + v[j].w * v[j].w); }
    const float rstd = rsqrtf(wave_sum(s2) * (1.f / D) + 1e-5f);
#pragma unroll
    for (int j = 0; j < 4; ++j) { const int c = 4 * lane + 256 * j; const f32x4 gg = *(const f32x4*)(g + c), bb = *(const f32x4*)(b + c);
        f32x4 o = v[j] * rstd * gg + bb; xr[64 * j] = o;
        uint2 pb; pb.x = pk2(o.x, o.y); pb.y = pk2(o.z, o.w); *(uint2*)(XB + (size_t)row * D + c) = pb; }
}

__global__ void __launch_bounds__(256) k_xattn_naive(const bf16_t* __restrict__ QC, const bf16_t* __restrict__ KCVC, bf16_t* __restrict__ XO) {
    __shared__ float qs[1024]; __shared__ float ps[256]; __shared__ float red[8];
    const int tok = blockIdx.x, b = tok / SEQ, tid = threadIdx.x, lane = tid & 63, wv = tid >> 6;
    for (int i = tid; i < 1024; i += 256) qs[i] = bf2f(QC[(size_t)tok * D + i]);
    __syncthreads();
    const bf16_t* KV = KCVC + (size_t)b * MEML * 2048;
    for (int h = 0; h < MH; ++h) {
        const bf16_t* kp = KV + (size_t)tid * 2048 + h * 256;
        float s = 0.f;
        for (int d = 0; d < 256; d += 8) { const u32x4 w = *(const u32x4*)(kp + d); const float* q = qs + h * 256 + d;
            s += q[0] * bflo(w.x) + q[1] * bfhi(w.x) + q[2] * bflo(w.y) + q[3] * bfhi(w.y) + q[4] * bflo(w.z) + q[5] * bfhi(w.z) + q[6] * bflo(w.w) + q[7] * bfhi(w.w); }
        float mx = wave_max(s); if (lane == 0) red[wv] = mx; __syncthreads();
        mx = fmaxf(fmaxf(red[0], red[1]), fmaxf(red[2], red[3]));
        const float p = exp2f(s - mx);
        float sm = wave_sum(p); if (lane == 0) red[4 + wv] = sm; ps[tid] = p; __syncthreads();
        sm = (red[4] + red[5]) + (red[6] + red[7]);
        float o = 0.f;
        for (int j = 0; j < 256; ++j) o = fmaf(ps[j], bf2f(KV[(size_t)j * 2048 + 1024 + h * 256 + tid]), o);
        XO[(size_t)tok * D + h * 256 + tid] = (bf16_t)f2bf(o / sm);
        __syncthreads();
    }
}

__global__ void __launch_bounds__(256) k_peer_select_naive(const bf16_t* __restrict__ QP, const bf16_t* __restrict__ SUBK, int* __restrict__ IDX, float* __restrict__ GATE) {
    __shared__ float qs[2048]; __shared__ float s[256]; __shared__ float tops[32]; __shared__ int topi[32]; __shared__ float cs[256]; __shared__ int ci[256]; __shared__ float bs[16]; __shared__ int bi[16];
    const int tok = blockIdx.x, tid = threadIdx.x;
    for (int i = tid; i < 2048; i += 256) qs[i] = bf2f(QP[(size_t)tok * 2048 + i]);
    __syncthreads();
    for (int h = 0; h < PH; ++h) {
        const int half = tid >> 7, key = tid & 127;
        { const bf16_t* kp = SUBK + ((size_t)(h * 2 + half) * 128 + key) * 128; const float* q = qs + h * 256 + half * 128; float a = 0.f;
          for (int d = 0; d < 128; d += 8) { const u32x4 w = *(const u32x4*)(kp + d);
              a += q[d] * bflo(w.x) + q[d + 1] * bfhi(w.x) + q[d + 2] * bflo(w.y) + q[d + 3] * bfhi(w.y) + q[d + 4] * bflo(w.z) + q[d + 5] * bfhi(w.z) + q[d + 6] * bflo(w.w) + q[d + 7] * bfhi(w.w); }
          s[tid] = a; }
        __syncthreads();
        { const float me = s[tid]; int rank = 0; const float* sp = s + half * 128;
          for (int j = 0; j < 128; ++j) { const float o = sp[j]; rank += (o > me || (o == me && j < key)) ? 1 : 0; }
          if (rank < 16) { tops[half * 16 + rank] = me; topi[half * 16 + rank] = key; } }
        __syncthreads();
        { const int i = tid >> 4, j = tid & 15; cs[tid] = tops[i] + tops[16 + j]; ci[tid] = topi[i] * 128 + topi[16 + j]; }
        __syncthreads();
        { const float me = cs[tid]; int rank = 0;
          for (int j = 0; j < 256; ++j) { const float o = cs[j]; rank += (o > me || (o == me && j < tid)) ? 1 : 0; }
          if (rank < 16) { bs[rank] = me; bi[rank] = ci[tid]; } }
        __syncthreads();
        if (tid < 16) { float mx = bs[0]; float sum = 0.f;
            for (int j = 0; j < 16; ++j) sum += expf(bs[j] - mx);
            GATE[(size_t)tok * 128 + h * 16 + tid] = expf(bs[tid] - mx) / sum; IDX[(size_t)tok * 128 + h * 16 + tid] = bi[tid]; }
        __syncthreads();
    }
}

__global__ void __launch_bounds__(256) k_peer_gather_naive(float* __restrict__ X  , const bf16_t* __restrict__ PU, const bf16_t* __restrict__ PV,
                                                           const int* __restrict__ IDX, const float* __restrict__ GATE, const float* __restrict__ g3, const float* __restrict__ b3) {
    __shared__ float ys[4][1024]; __shared__ float red[8];
    const int tok = blockIdx.x, tid = threadIdx.x, lane = tid & 63, wv = tid >> 6;
    float xr[16], y[16];
    { const float* xp = X + (size_t)tok * D + lane * 16;
#pragma unroll
      for (int j = 0; j < 16; ++j) { xr[j] = xp[j]; y[j] = 0.f; } }
    for (int e = 0; e < 32; ++e) {
        const int slot = wv * 32 + e; const int id = IDX[(size_t)tok * 128 + slot]; const float gt = GATE[(size_t)tok * 128 + slot];
        const bf16_t* up = PU + (size_t)id * D + lane * 16; const u32x4 u0 = *(const u32x4*)up, u1 = *(const u32x4*)(up + 8);
        const unsigned uw[8] = {u0.x, u0.y, u0.z, u0.w, u1.x, u1.y, u1.z, u1.w};
        float hsum = 0.f;
#pragma unroll
        for (int j = 0; j < 8; ++j) { hsum = fmaf(xr[2 * j], bflo(uw[j]), hsum); hsum = fmaf(xr[2 * j + 1], bfhi(uw[j]), hsum); }
        hsum = wave_sum(hsum);
        const float w = gt * 0.5f * hsum * (1.f + erff(hsum * 0.70710678118654752f));
        const bf16_t* vp = PV + (size_t)id * D + lane * 16; const u32x4 v0 = *(const u32x4*)vp, v1 = *(const u32x4*)(vp + 8);
        const unsigned vw[8] = {v0.x, v0.y, v0.z, v0.w, v1.x, v1.y, v1.z, v1.w};
#pragma unroll
        for (int j = 0; j < 8; ++j) { y[2 * j] = fmaf(w, bflo(vw[j]), y[2 * j]); y[2 * j + 1] = fmaf(w, bfhi(vw[j]), y[2 * j + 1]); }
    }
#pragma unroll
    for (int j = 0; j < 16; ++j) ys[wv][lane * 16 + j] = y[j];
    __syncthreads();
    float v[4]; float s = 0.f;
#pragma unroll
    for (int j = 0; j < 4; ++j) { const int c = tid * 4 + j; v[j] = ALPHA * X[(size_t)tok * D + c] + ((ys[0][c] + ys[1][c]) + (ys[2][c] + ys[3][c])); s += v[j]; }
    s = wave_sum(s); if (lane == 0) red[wv] = s; __syncthreads();
    const float mean = ((red[0] + red[1]) + (red[2] + red[3])) * (1.f / D);
    float s2 = 0.f;
#pragma unroll
    for (int j = 0; j < 4; ++j) { v[j] -= mean; s2 += v[j] * v[j]; }
    s2 = wave_sum(s2); if (lane == 0) red[4 + wv] = s2; __syncthreads();
    const float rstd = rsqrtf(((red[4] + red[5]) + (red[6] + red[7])) * (1.f / D) + 1e-5f);
#pragma unroll
    for (int j = 0; j < 4; ++j) { const int c = tid * 4 + j; X[(size_t)tok * D + c] = v[j] * rstd * g3[c] + b3[c]; }
}

template <class Epi> static void gemm_naive(hipStream_t s, const bf16_t* A, int lda, const bf16_t* Bt, int Mr, int N, int K, Epi E) {
    hipLaunchKernelGGL(k_gemm_naive<Epi>, dim3(N / 64, Mr / 128), dim3(256), 0, s, A, Bt, lda, K, E);
}
extern "C" void kernel_launch(void* const* d_in, const int* in_sizes, int n_in, void* d_out, int out_size, void* d_ws, size_t ws_size, hipStream_t stream) {
    if (n_in != 30 || out_size != M * D || ws_size < WS_END) { fprintf(stderr, "kernel_launch: unexpected sizes n_in %d out %d ws %zu (need %zu)\n", n_in, out_size, ws_size, (size_t)WS_END); return; }
    const float* x = (const float*)d_in[0]; const float* mem = (const float*)d_in[1]; const float* w_in = (const float*)d_in[2];
    const float* conv_w = (const float*)d_in[3]; const float* conv_b = (const float*)d_in[4]; const float* dt_bias = (const float*)d_in[5];
    const float* a_log = (const float*)d_in[6]; const float* d_skip = (const float*)d_in[7]; const float* ssd_norm_w = (const float*)d_in[8];
    const float* w_ssd_br = (const float*)d_in[9]; const float* lam_q = (const float*)d_in[10]; const float* lam_k = (const float*)d_in[11];
    const float* subln_w = (const float*)d_in[12]; const float* w_diff_br = (const float*)d_in[13]; const float* gate_bias = (const float*)d_in[14];
    const float* w_o = (const float*)d_in[15]; const float* ln1_g = (const float*)d_in[16]; const float* ln1_b = (const float*)d_in[17];
    const float* w_cq = (const float*)d_in[18]; const float* w_ck = (const float*)d_in[19]; const float* w_cv = (const float*)d_in[20]; const float* w_co = (const float*)d_in[21];
    const float* ln2_g = (const float*)d_in[22]; const float* ln2_b = (const float*)d_in[23]; const float* w_pq = (const float*)d_in[24];
    const float* sub_keys = (const float*)d_in[25]; const float* peer_u = (const float*)d_in[26]; const float* peer_v = (const float*)d_in[27];
    const float* ln3_g = (const float*)d_in[28]; const float* ln3_b = (const float*)d_in[29];
    unsigned char* ws = (unsigned char*)d_ws; float* out = (float*)d_out;
    static bool attr_set = false;
    if (!attr_set) { (void)hipFuncSetAttribute((const void*)k_attn_naive, hipFuncAttributeMaxDynamicSharedMemorySize, 128 * 256 * 4); attr_set = true; }
    float* lam = (float*)(ws + WS_CTL) + CW_LAM;
    bf16_t* WinT = (bf16_t*)(ws + WS_WIN); bf16_t* WssdT = (bf16_t*)(ws + WS_WSSD); bf16_t* WdiffT = (bf16_t*)(ws + WS_WDIFF); bf16_t* WoT = (bf16_t*)(ws + WS_WO);
    bf16_t* WcqT = (bf16_t*)(ws + WS_WCQ); bf16_t* WckvT = (bf16_t*)(ws + WS_WCKV); bf16_t* WcoT = (bf16_t*)(ws + WS_WCO); bf16_t* WpqT = (bf16_t*)(ws + WS_WPQ);
    bf16_t* SUBK = (bf16_t*)(ws + WS_SUBK); bf16_t* MEMB = (bf16_t*)(ws + WS_MEMB); bf16_t* KCVC = (bf16_t*)(ws + WS_KCVC); float* DT = (float*)(ws + WS_DT);
    bf16_t* XB = (bf16_t*)(ws + WS_XB); bf16_t* H = (bf16_t*)(ws + WS_H); float* T1 = (float*)(ws + WS_T1);
    bf16_t* PU = (bf16_t*)(ws + WS_PU); bf16_t* PV = (bf16_t*)(ws + WS_PV); bf16_t* QC = (bf16_t*)(ws + WS_QC); bf16_t* XO = (bf16_t*)(ws + WS_XO); bf16_t* QP = (bf16_t*)(ws + WS_QP);
    int* IDX = (int*)(ws + WS_IDX); float* GATE = (float*)(ws + WS_GATE);

    hipLaunchKernelGGL(k_transpose, dim3(NINP / 32, D / 32), dim3(256), 0, stream, w_in, D, NIN, WinT, NINP, 5120, 32, 0);
    hipLaunchKernelGGL(k_transpose, dim3(D / 32, DI / 32), dim3(256), 0, stream, w_ssd_br, DI, D, WssdT, D, 1 << 30, 0, 0);
    hipLaunchKernelGGL(k_transpose, dim3(D / 32, D / 32), dim3(256), 0, stream, w_diff_br, D, D, WdiffT, D, 1 << 30, 0, 0);
    hipLaunchKernelGGL(k_transpose, dim3(D / 32, D / 32), dim3(256), 0, stream, w_o, D, D, WoT, D, 1 << 30, 0, 0);
    hipLaunchKernelGGL(k_transpose, dim3(D / 32, D / 32), dim3(256), 0, stream, w_cq, D, D, WcqT, D, 1 << 30, 0, 0);
    hipLaunchKernelGGL(k_transpose, dim3(D / 32, D / 32), dim3(256), 0, stream, w_ck, D, D, WckvT, D, 1 << 30, 0, 0);
    hipLaunchKernelGGL(k_transpose, dim3(D / 32, D / 32), dim3(256), 0, stream, w_cv, D, D, WckvT + (size_t)D * D, D, 1 << 30, 0, 0);
    hipLaunchKernelGGL(k_transpose, dim3(D / 32, D / 32), dim3(256), 0, stream, w_co, D, D, WcoT, D, 1 << 30, 0, 0);
    hipLaunchKernelGGL(k_transpose, dim3(2048 / 32, D / 32), dim3(256), 0, stream, w_pq, D, 2048, WpqT, 2048, 1 << 30, 0, 0);
    hipLaunchKernelGGL(k_cvt, dim3(2048), dim3(256), 0, stream, x, XB, (size_t)M * D / 4);
    hipLaunchKernelGGL(k_cvt, dim3(512), dim3(256), 0, stream, mem, MEMB, (size_t)BATCH * MEML * D / 4);
    hipLaunchKernelGGL(k_cvt, dim3(256), dim3(256), 0, stream, sub_keys, SUBK, (size_t)PH * 2 * PK * PHALF / 4);
    hipLaunchKernelGGL(k_dt, dim3(M / 8), dim3(256), 0, stream, x, w_in, dt_bias, DT, lam_q, lam_k, lam);
    gemm_naive(stream, MEMB, D, WckvT, BATCH * MEML, 2048, D, EpiPlain{KCVC, 2048, 1.f});

    float* YRAW = out + (size_t)SEQ * D;
    float* BCf = T1;
    float* ST = T1 + (size_t)4096 * 1024;
    for (int b = 0; b < BATCH; ++b) {
        gemm_naive(stream, XB + (size_t)b * SEQ * D, D, WinT, SEQ, NINP, D, EpiInProj{H, gate_bias});
        for (int seg = 0; seg < 2; ++seg) {
            const int t0 = seg * 4096, nt = 4096;
            hipLaunchKernelGGL(k_conv_bc, dim3(nt * 1024 / 256), dim3(256), 0, stream, H, conv_w, conv_b, BCf, t0, nt);
            hipLaunchKernelGGL(k_ssd_seq, dim3(NH), dim3(256), 0, stream, H, BCf, DT + (size_t)b * SEQ * 32, conv_w, conv_b, a_log, d_skip, ST, YRAW, t0, nt);
            hipLaunchKernelGGL(k_ssd_norm, dim3(nt), dim3(256), 0, stream, YRAW, ssd_norm_w, H, t0, nt);
        }
        hipLaunchKernelGGL(k_attn_naive, dim3(SEQ / 256, AH), dim3(256), 128 * 256 * 4, stream, H, subln_w, lam);
        gemm_naive(stream, H + HC_Z, HP_, WssdT, SEQ, D, DI, EpiGate1{H, T1});
        gemm_naive(stream, H + HC_Q, HP_, WdiffT, SEQ, D, D, EpiGate2{H, T1});
        gemm_naive(stream, H + HC_K, HP_, WoT, SEQ, D, D, EpiResid{x, out, b * SEQ, 0});
    }
    hipLaunchKernelGGL(k_ln, dim3(M / 4), dim3(256), 0, stream, out, ln1_g, ln1_b, XB, 0, M);
    hipLaunchKernelGGL(k_cvt, dim3(4096), dim3(256), 0, stream, peer_u, PU, (size_t)PK * PK * D / 4);
    hipLaunchKernelGGL(k_cvt, dim3(4096), dim3(256), 0, stream, peer_v, PV, (size_t)PK * PK * D / 4);
    gemm_naive(stream, XB, D, WcqT, M, D, D, EpiPlain{QC, D, CQSCALE});
    hipLaunchKernelGGL(k_xattn_naive, dim3(M), dim3(256), 0, stream, QC, KCVC, XO);
    gemm_naive(stream, XO, D, WcoT, M, D, D, EpiResid{out, out, 0, 0});
    hipLaunchKernelGGL(k_ln, dim3(M / 4), dim3(256), 0, stream, out, ln2_g, ln2_b, XB, 0, M);
    gemm_naive(stream, XB, D, WpqT, M, 2048, D, EpiPlain{QP, 2048, 1.f});
    hipLaunchKernelGGL(k_peer_select_naive, dim3(M), dim3(256), 0, stream, QP, SUBK, IDX, GATE);
    hipLaunchKernelGGL(k_peer_gather_naive, dim3(M), dim3(256), 0, stream, out, PU, PV, IDX, GATE, ln3_g, ln3_b);
}
```

```cpp
#include <hip/hip_runtime.h>
#include <cstdio>
#include <cstdint>
#include <cmath>
#include <type_traits>

typedef unsigned short bf16_t;
typedef float f32x4 __attribute__((ext_vector_type(4)));
typedef unsigned u32x4 __attribute__((ext_vector_type(4)));
typedef unsigned u32x2 __attribute__((ext_vector_type(2)));

constexpr int D = 1024, BATCH = 2, SEQ = 8192, M = BATCH * SEQ;
constexpr int DI = 2048, NH = 32, HP = 64, NG = 4, DS = 128, DXBC = 3072;
constexpr int AH = 8, AD = 64, AV = 128;
constexpr int MEML = 256, MH = 4, MHD = 256;
constexpr int PH = 8, PK = 128, PDK = 256, PHALF = 128, PTOP = 16;
constexpr int NIN = 10272, NINP = 10240;
constexpr float ALPHA = 1.189207115002721f;
constexpr float LOG2E = 1.4426950408889634f;
constexpr float QSCALE = 0.125f * LOG2E;
constexpr float CQSCALE = 0.0625f * LOG2E;
constexpr float LAMBDA_INIT = 0.2f;
constexpr int HC_Z = 0, HC_XBC = 2048, HC_Q = 5120, HC_K = 6144, HC_V = 7168, HC_GS = 8192, HC_GA = 9216, HP_ = NINP;

constexpr size_t MiB = 1u << 20;
constexpr size_t WS_CTL = 0;
constexpr size_t WS_WIN = 1 * MiB;
constexpr size_t WS_WSSD = 21 * MiB;
constexpr size_t WS_WDIFF = 25 * MiB, WS_WO = 27 * MiB, WS_WCQ = 29 * MiB, WS_WCKV = 31 * MiB  , WS_WCO = 35 * MiB;
constexpr size_t WS_WPQ = 37 * MiB;
constexpr size_t WS_SUBK = 41 * MiB;
constexpr size_t WS_MEMB = 42 * MiB;
constexpr size_t WS_KCVC = 43 * MiB;
constexpr size_t WS_DT = 45 * MiB;
constexpr size_t WS_XB = 47 * MiB;
constexpr size_t WS_H = 79 * MiB;
constexpr size_t WS_T1 = 239 * MiB;
constexpr size_t WS_PU = 79 * MiB, WS_PV = 111 * MiB;
constexpr size_t WS_QC = 143 * MiB, WS_XO = 175 * MiB;
constexpr size_t WS_QP = 207 * MiB;
constexpr size_t WS_IDX = 143 * MiB, WS_GATE = 151 * MiB;
constexpr size_t WS_END = 271 * MiB;
constexpr int CW_LAM = 64;

__device__ __forceinline__ unsigned f2bf(float f) { unsigned u = __builtin_bit_cast(unsigned, f); return (u + 0x7fffu + ((u >> 16) & 1u)) >> 16; }
__device__ __forceinline__ float bf2f(unsigned h) { return __builtin_bit_cast(float, h << 16); }
__device__ __forceinline__ unsigned pk2(float lo, float hi) { return f2bf(lo) | (f2bf(hi) << 16); }
__device__ __forceinline__ float bflo(unsigned w) { return __builtin_bit_cast(float, w << 16); }
__device__ __forceinline__ float bfhi(unsigned w) { return __builtin_bit_cast(float, w & 0xffff0000u); }
__device__ __forceinline__ float sigmoidf_(float v) { return 1.f / (1.f + __expf(-v)); }
__device__ __forceinline__ float siluf_(float v) { return v / (1.f + __expf(-v)); }
__device__ __forceinline__ float wave_sum(float v) {
#pragma unroll
    for (int o = 1; o < 64; o <<= 1) v += __shfl_xor(v, o);
    return v;
}
__device__ __forceinline__ float wave_max(float v) {
#pragma unroll
    for (int o = 1; o < 64; o <<= 1) v = fmaxf(v, __shfl_xor(v, o));
    return v;
}

__global__ void __launch_bounds__(256) k_transpose(const float* __restrict__ W, int K, int Nsrc, bf16_t* __restrict__ Wt, int Nout, int skip_at, int skip, int pad_) {
    __shared__ float t[32][33];
    const int n0 = blockIdx.x * 32, k0 = blockIdx.y * 32, tx = threadIdx.x & 31, ty = threadIdx.x >> 5;
#pragma unroll
    for (int i = 0; i < 4; ++i) { const int n = n0 + tx, k = k0 + ty + 8 * i; const int c = n + (n >= skip_at ? skip : 0); t[ty + 8 * i][tx] = (n < Nout) ? W[(size_t)k * Nsrc + c] : 0.f; }
    __syncthreads();
#pragma unroll
    for (int i = 0; i < 4; ++i) { const int n = n0 + ty + 8 * i, k = k0 + tx; if (n < Nout) Wt[(size_t)n * K + k] = (bf16_t)f2bf(t[tx][ty + 8 * i]); }
}
__global__ void __launch_bounds__(256) k_cvt(const float* __restrict__ src, bf16_t* __restrict__ dst, size_t n4) {
    for (size_t i = (size_t)blockIdx.x * 256 + threadIdx.x; i < n4; i += (size_t)gridDim.x * 256) {
        const f32x4 v = ((const f32x4*)src)[i]; uint2 o; o.x = pk2(v.x, v.y); o.y = pk2(v.z, v.w); ((uint2*)dst)[i] = o; }
}
__global__ void __launch_bounds__(256) k_dt(const float* __restrict__ x, const float* __restrict__ w_in, const float* __restrict__ dt_bias, float* __restrict__ DT,
                                            const float* __restrict__ lam_q, const float* __restrict__ lam_k, float* __restrict__ lam_out) {
    __shared__ float xs[8][1024];
    const int m0 = blockIdx.x * 8, tid = threadIdx.x;
    for (int i = tid; i < 8 * 1024; i += 256) xs[i >> 10][i & 1023] = x[(size_t)(m0 + (i >> 10)) * D + (i & 1023)];
    __syncthreads();
    const int h = tid & 31, r = tid >> 5;
    float acc = 0.f;
    for (int k = 0; k < 1024; ++k) acc = fmaf(xs[r][k], w_in[(size_t)k * NIN + 5120 + h], acc);
    const float v = acc + dt_bias[h];
    DT[(size_t)(m0 + r) * 32 + h] = v > 20.f ? v : log1pf(expf(v));
    if (blockIdx.x == 0 && tid == 0) {
        float s0 = 0.f, s1 = 0.f;
        for (int i = 0; i < 64; ++i) { s0 += lam_q[i] * lam_k[i]; s1 += lam_q[64 + i] * lam_k[64 + i]; }
        *lam_out = expf(s0) - expf(s1) + LAMBDA_INIT;
    }
}

template <class Epi>
__global__ void __launch_bounds__(256) k_gemm_naive(const bf16_t* __restrict__ A, const bf16_t* __restrict__ Bt, int lda, int K, Epi E) {
    __shared__ float As[32][132];
    __shared__ float Bs[32][68];
    const int tid = threadIdx.x, row0 = blockIdx.y * 128, col0 = blockIdx.x * 64;
    const int tr = (tid >> 3) * 4, tc = (tid & 7) * 8;
    float acc[4][8];
#pragma unroll
    for (int i = 0; i < 4; ++i)
#pragma unroll
        for (int j = 0; j < 8; ++j) acc[i][j] = 0.f;
    for (int k0 = 0; k0 < K; k0 += 32) {
        {
            const int r = tid >> 1, kh = (tid & 1) * 16;
            const u32x4 a0 = *(const u32x4*)(A + (size_t)(row0 + r) * lda + k0 + kh), a1 = *(const u32x4*)(A + (size_t)(row0 + r) * lda + k0 + kh + 8);
            const unsigned w[8] = {a0.x, a0.y, a0.z, a0.w, a1.x, a1.y, a1.z, a1.w};
#pragma unroll
            for (int j = 0; j < 8; ++j) { As[kh + 2 * j][r] = bflo(w[j]); As[kh + 2 * j + 1][r] = bfhi(w[j]); }
            const int c = tid >> 2, kq = (tid & 3) * 8;
            const u32x4 b0 = *(const u32x4*)(Bt + (size_t)(col0 + c) * K + k0 + kq);
            const unsigned wb[4] = {b0.x, b0.y, b0.z, b0.w};
#pragma unroll
            for (int j = 0; j < 4; ++j) { Bs[kq + 2 * j][c] = bflo(wb[j]); Bs[kq + 2 * j + 1][c] = bfhi(wb[j]); }
        }
        __syncthreads();
#pragma unroll 8
        for (int k = 0; k < 32; ++k) {
            const f32x4 a = *(const f32x4*)&As[k][tr]; const f32x4 b0 = *(const f32x4*)&Bs[k][tc], b1 = *(const f32x4*)&Bs[k][tc + 4];
            const float av[4] = {a.x, a.y, a.z, a.w}; const float bv[8] = {b0.x, b0.y, b0.z, b0.w, b1.x, b1.y, b1.z, b1.w};
#pragma unroll
            for (int i = 0; i < 4; ++i)
#pragma unroll
                for (int j = 0; j < 8; ++j) acc[i][j] = fmaf(av[i], bv[j], acc[i][j]);
        }
        __syncthreads();
    }
#pragma unroll
    for (int i = 0; i < 4; ++i) E(row0 + tr + i, col0 + tc, acc[i]);
}

__device__ __forceinline__ void store_bf16x8(bf16_t* p, const float (&v)[8]) { u32x4 w; w.x = pk2(v[0], v[1]); w.y = pk2(v[2], v[3]); w.z = pk2(v[4], v[5]); w.w = pk2(v[6], v[7]); *(u32x4*)p = w; }
struct EpiPlain { bf16_t* O; int ldc; float scale;
    __device__ __forceinline__ void operator()(int row, int col0, const float (&v)[8]) const { float o[8];
#pragma unroll
        for (int j = 0; j < 8; ++j) o[j] = v[j] * scale; store_bf16x8(O + (size_t)row * ldc + col0, o); } };
struct EpiInProj { bf16_t* H; const float* gate_bias;
    __device__ __forceinline__ void operator()(int row, int col0, const float (&v)[8]) const { float o[8];
        if (col0 >= HC_GS) { const float* gb = gate_bias + (col0 - HC_GS);
#pragma unroll
            for (int j = 0; j < 8; ++j) o[j] = sigmoidf_(v[j] + gb[j]); }
        else { const float s = (col0 >= HC_Q && col0 < HC_K) ? QSCALE : 1.f;
#pragma unroll
            for (int j = 0; j < 8; ++j) o[j] = v[j] * s; }
        store_bf16x8(H + (size_t)row * HP_ + col0, o); } };
struct EpiGate1 { const bf16_t* H; float* T1;
    __device__ __forceinline__ void operator()(int row, int col0, const float (&v)[8]) const {
        const u32x4 g = *(const u32x4*)(H + (size_t)row * HP_ + HC_GS + col0); const unsigned gw[4] = {g.x, g.y, g.z, g.w};
        float* t = T1 + (size_t)row * D + col0;
#pragma unroll
        for (int j = 0; j < 4; ++j) { t[2 * j] = bflo(gw[j]) * v[2 * j]; t[2 * j + 1] = bfhi(gw[j]) * v[2 * j + 1]; } } };
struct EpiGate2 { bf16_t* H; const float* T1;
    __device__ __forceinline__ void operator()(int row, int col0, const float (&v)[8]) const {
        const u32x4 g = *(const u32x4*)(H + (size_t)row * HP_ + HC_GA + col0); const unsigned gw[4] = {g.x, g.y, g.z, g.w};
        const float* t = T1 + (size_t)row * D + col0; float o[8];
#pragma unroll
        for (int j = 0; j < 4; ++j) { o[2 * j] = t[2 * j] + bflo(gw[j]) * v[2 * j]; o[2 * j + 1] = t[2 * j + 1] + bfhi(gw[j]) * v[2 * j + 1]; }
        store_bf16x8(H + (size_t)row * HP_ + HC_K + col0, o); } };
struct EpiResid { const float* base; float* out; int row_off; int pad_;
    __device__ __forceinline__ void operator()(int row, int col0, const float (&v)[8]) const {
        const size_t o = (size_t)(row + row_off) * D + col0;
#pragma unroll
        for (int j = 0; j < 8; ++j) out[o + j] = ALPHA * base[o + j] + v[j]; } };


namespace pg8 {
#define PG8_LAS __attribute__((address_space(3)))
typedef short bf16x8 __attribute__((ext_vector_type(8)));
constexpr int BM = 256, BK = 64, HALF = 128, HTB = HALF * BK * 2, STAGE_BYTES = 8 * HTB, NXCD = 8, WGM = 8;
__host__ __device__ __forceinline__ int lds_byte(int r, int c) { const int st = (r >> 4) * 2 + (c >> 5), rr = r & 15, cc = c & 31, ob = rr * 64 + cc * 2; return st * 1024 + (ob ^ (((ob >> 9) & 1) << 5)); }
__host__ __device__ __forceinline__ void stage_rc(int b, int& R, int& C) { const int st = b / 1024, sb = b % 1024, swz = sb ^ (((sb >> 9) & 1) << 5); R = (st >> 1) * 16 + swz / 64; C = (st & 1) * 32 + (swz % 64) / 2; }
__host__ __device__ __forceinline__ int perm32(int rho) { const int n = rho >> 4, i = rho & 15; return 8 * (i >> 2) + 4 * n + (i & 3); }
struct Unit { int pm, pn; };
struct Gemm { const bf16_t* A; const bf16_t* Bt; int M, N, K, lda; };
struct StaticOrder {
    int nM, nN, nwg, G, c;
    __host__ __device__ void init(int M, int N, int G_, int c_) { nM = M / BM; nN = N / BM; nwg = nM * nN; G = G_; c = c_; }
    __host__ __device__ bool next(int i, Unit& u) const {
        const long L = (long)i * G + c; if (L >= nwg) return false;
        int wgid = (int)L; { const int q = nwg / NXCD, r = nwg % NXCD, xcd = wgid % NXCD, off = wgid / NXCD; wgid = (xcd < r ? xcd * (q + 1) : r * (q + 1) + (xcd - r) * q) + off; }
        const int nig = WGM * nN, gid = wgid / nig, fm = gid * WGM, gsz = (nM - fm) < WGM ? (nM - fm) : WGM;
        u.pm = fm + ((wgid % nig) % gsz); u.pn = (wgid % nig) / gsz; return true;
    }
};
template <class F> struct EpiAdapt {
    static constexpr bool PERM = true, AFTER_DRAIN = false; F f;
    __device__ __forceinline__ void operator()(const f32x4 (&acc)[2][2][4][2], const Unit& u, int wr, int wc, int fr, int fq) const {
#pragma unroll
        for (int ai = 0; ai < 2; ++ai)
#pragma unroll
            for (int m = 0; m < 4; ++m) { const int row = u.pm * BM + ai * HALF + wr * 64 + m * 16 + fr;
#pragma unroll
                for (int bj = 0; bj < 2; ++bj) { const int col0 = u.pn * BM + bj * HALF + wc * 32 + 8 * fq;
                    const f32x4 a = acc[ai][bj][m][0], b = acc[ai][bj][m][1]; const float v[8] = {a[0], a[1], a[2], a[3], b[0], b[1], b[2], b[3]};
                    f(row, col0, v); } }
    }
};
template <class Epi, class Sched, bool ALIGN_EPI>
__device__ __forceinline__ void gemm_phase(PG8_LAS unsigned char* lds, const Gemm g, const Sched& S, const Epi& E) {
    const int tid = threadIdx.x, wid = __builtin_amdgcn_readfirstlane(tid >> 6), lane = tid & 63, wr = wid >> 2, wc = wid & 3, fr = lane & 15, fq = lane >> 4;
    const int K = g.K, nt = K / BK, lda = g.lda;
    unsigned voffA[2], voffB[2];
#pragma unroll
    for (int i = 0; i < 2; ++i) { int R, C; stage_rc(tid * 16 + i * 8192, R, C); const int Rb = Epi::PERM ? ((R & ~31) + perm32(R & 31)) : R;
        voffA[i] = (unsigned)(R * lda + C) * 2u; voffB[i] = (unsigned)(Rb * K + C) * 2u; }
    const size_t kstep = (size_t)(BK * 2);
    const size_t hstepA = (size_t)HALF * lda * 2, hstepB = (size_t)HALF * K * 2;
    const size_t tstepA = 2 * hstepA, tstepB = 2 * hstepB;
    const unsigned ldsw = (unsigned)wid * 1024u;
    const int aoff = lds_byte(wr * 64 + fr, fq * 8), boff = lds_byte(wc * 32 + fr, fq * 8);
#define PG8_SA(b, h) (((b) * 2 + (h)) * HTB)
#define PG8_SB(b, h) ((4 + (b) * 2 + (h)) * HTB)
#define PG8_STAGE(bufoff, gbase, voff) do { _Pragma("unroll") for (int _i = 0; _i < 2; ++_i) \
        __builtin_amdgcn_global_load_lds((const unsigned*)((const char*)(gbase) + (voff)[_i]), (PG8_LAS unsigned*)(lds + (bufoff) + ldsw + _i * 8192), 16, 0, 0); } while (0)
#define PG8_LDA(dst, b, h) do { _Pragma("unroll") for (int m = 0; m < 4; ++m) _Pragma("unroll") for (int k = 0; k < 2; ++k) dst[m][k] = *(const PG8_LAS bf16x8*)(lds + PG8_SA(b, h) + aoff + m * 2048 + k * 1024); } while (0)
#define PG8_LDB(dst, b, h) do { _Pragma("unroll") for (int n = 0; n < 2; ++n) _Pragma("unroll") for (int k = 0; k < 2; ++k) dst[n][k] = *(const PG8_LAS bf16x8*)(lds + PG8_SB(b, h) + boff + n * 2048 + k * 1024); } while (0)
#define PG8_MMA(ai, bj, At, Bt) do { __builtin_amdgcn_s_setprio(1); _Pragma("unroll") for (int m = 0; m < 4; ++m) _Pragma("unroll") for (int n = 0; n < 2; ++n) _Pragma("unroll") for (int k = 0; k < 2; ++k) \
        acc[ai][bj][m][n] = __builtin_amdgcn_mfma_f32_16x16x32_bf16(Bt[n][k], At[m][k], acc[ai][bj][m][n], 0, 0, 0); __builtin_amdgcn_s_setprio(0); } while (0)
#define PG8_WAIT_V(n) asm volatile("s_waitcnt vmcnt(" #n ")" ::: "memory")
#define PG8_WAIT_L(n) asm volatile("s_waitcnt lgkmcnt(" #n ")" ::: "memory")
#define PG8_BAR __builtin_amdgcn_s_barrier()
#define PG8_SCHED __builtin_amdgcn_sched_barrier(0)
    Unit cur, nxt; int ui = 0;
    if (!S.next(0, cur)) return;
    f32x4 acc[2][2][4][2];
#pragma unroll
    for (int a = 0; a < 2; ++a)
#pragma unroll
        for (int b = 0; b < 2; ++b)
#pragma unroll
            for (int m = 0; m < 4; ++m)
#pragma unroll
                for (int n = 0; n < 2; ++n) acc[a][b][m][n] = (f32x4){0.f, 0.f, 0.f, 0.f};
    bf16x8 At[4][2], B0[2][2], B1[2][2];
    const char* cA = (const char*)g.A + (size_t)cur.pm * tstepA; const char* cB = (const char*)g.Bt + (size_t)cur.pn * tstepB;
    PG8_STAGE(PG8_SB(0, 0), cB, voffB); PG8_STAGE(PG8_SB(0, 1), cB + hstepB, voffB); PG8_STAGE(PG8_SA(0, 0), cA, voffA); PG8_STAGE(PG8_SA(0, 1), cA + hstepA, voffA);
    if (wr == 1) PG8_BAR;
    PG8_WAIT_V(2); PG8_BAR;
    PG8_STAGE(PG8_SB(1, 0), cB + kstep, voffB); PG8_STAGE(PG8_SA(1, 0), cA + kstep, voffA); PG8_STAGE(PG8_SB(1, 1), cB + hstepB + kstep, voffB);
    PG8_WAIT_V(6); PG8_BAR;
    for (;;) {
        const bool has_next = S.next(ui + 1, nxt);
        const char* nA = has_next ? (const char*)g.A + (size_t)nxt.pm * tstepA : cA; const char* nB = has_next ? (const char*)g.Bt + (size_t)nxt.pn * tstepB : cB;
        for (int t = 0; t < nt; t += 2) {
            const bool last = (t == nt - 2);
            const char* a1 = cA + (size_t)(t + 1) * kstep;
            const char* a2 = last ? nA : cA + (size_t)(t + 2) * kstep; const char* b2 = last ? nB : cB + (size_t)(t + 2) * kstep;
            const char* a3 = a2 + kstep; const char* b3 = b2 + kstep;
            PG8_LDB(B0, 0, 0); PG8_LDB(B1, 0, 1); PG8_SCHED; PG8_LDA(At, 0, 0); PG8_STAGE(PG8_SA(1, 1), a1 + hstepA, voffA);
            PG8_WAIT_V(8); PG8_WAIT_L(0); PG8_BAR; PG8_MMA(0, 0, At, B0); PG8_MMA(0, 1, At, B1); PG8_BAR; PG8_SCHED;
            PG8_LDA(At, 0, 1); PG8_STAGE(PG8_SB(0, 0), b2, voffB); PG8_STAGE(PG8_SB(0, 1), b2 + hstepB, voffB); PG8_STAGE(PG8_SA(0, 0), a2, voffA);
            PG8_WAIT_V(8); PG8_WAIT_L(0); PG8_BAR; PG8_MMA(1, 0, At, B0); PG8_MMA(1, 1, At, B1); PG8_BAR; PG8_SCHED;
            PG8_LDB(B0, 1, 0); PG8_LDB(B1, 1, 1); PG8_SCHED; PG8_LDA(At, 1, 0); PG8_STAGE(PG8_SA(0, 1), a2 + hstepA, voffA);
            PG8_WAIT_V(8); PG8_WAIT_L(0); PG8_BAR; PG8_MMA(0, 0, At, B0); PG8_MMA(0, 1, At, B1); PG8_BAR; PG8_SCHED;
            PG8_LDA(At, 1, 1); PG8_STAGE(PG8_SB(1, 0), b3, voffB); PG8_STAGE(PG8_SB(1, 1), b3 + hstepB, voffB); PG8_STAGE(PG8_SA(1, 0), a3, voffA);
            PG8_WAIT_V(8); PG8_WAIT_L(0); PG8_BAR; PG8_MMA(1, 0, At, B0); PG8_MMA(1, 1, At, B1); PG8_BAR; PG8_SCHED;
        }
        if constexpr (ALIGN_EPI) { if (wr == 0) PG8_BAR; }
        E(acc, cur, wr, wc, fr, fq);
        if (!has_next) break;
#pragma unroll
        for (int a = 0; a < 2; ++a)
#pragma unroll
            for (int b = 0; b < 2; ++b)
#pragma unroll
                for (int m = 0; m < 4; ++m)
#pragma unroll
                    for (int n = 0; n < 2; ++n) acc[a][b][m][n] = (f32x4){0.f, 0.f, 0.f, 0.f};
        cur = nxt; cA = nA; cB = nB; ++ui;
        if constexpr (ALIGN_EPI) { if (wr == 1) PG8_BAR; }
    }
    PG8_WAIT_V(0);
    if constexpr (!ALIGN_EPI) { if (wr == 0) PG8_BAR; }
    PG8_BAR;
#undef PG8_SA
#undef PG8_SB
#undef PG8_STAGE
#undef PG8_LDA
#undef PG8_LDB
#undef PG8_MMA
#undef PG8_WAIT_V
#undef PG8_WAIT_L
#undef PG8_BAR
#undef PG8_SCHED
}
}
constexpr int LDS_BYTES = 147456;
template <class F>
__global__ void __launch_bounds__(512, 2) k_gemm_pg8(pg8::Gemm g, F f) {
    extern __shared__ __attribute__((aligned(16))) unsigned char lds[];
    pg8::StaticOrder S; S.init(g.M, g.N, gridDim.x, blockIdx.x);
    pg8::EpiAdapt<F> E{f};
    pg8::gemm_phase<pg8::EpiAdapt<F>, pg8::StaticOrder, true>((PG8_LAS unsigned char*)lds, g, S, E);
}


namespace dattn {
#define DA_LAS __attribute__((address_space(3)))
typedef short bf16x8 __attribute__((ext_vector_type(8)));
typedef short s16x4 __attribute__((ext_vector_type(4)));
typedef float f32x16 __attribute__((ext_vector_type(16)));
constexpr int KP = 272, VP = 320, KBUF = 64 * KP, VBUF = 64 * VP, BUF = KBUF + VBUF, XOFF = 2 * BUF, LDS_NEED = XOFF + 65536;
static_assert(LDS_NEED <= 147456, "attention LDS");
__device__ __forceinline__ unsigned cvtpk(float lo, float hi) { typedef float f2 __attribute__((ext_vector_type(2))); typedef __bf16 b2 __attribute__((ext_vector_type(2))); f2 v = {lo, hi}; b2 b = __builtin_convertvector(v, b2); return __builtin_bit_cast(unsigned, b); }
__device__ __forceinline__ s16x4 vtr(const DA_LAS unsigned char* p) { typedef short v4i16_t __attribute__((ext_vector_type(4))); return __builtin_bit_cast(s16x4, __builtin_amdgcn_ds_read_tr16_b64_v4i16((DA_LAS v4i16_t*)p)); }
__device__ __forceinline__ void unit(DA_LAS unsigned char* lds, bf16_t* Hb, int h, int qb, const float* __restrict__ subln_w, float lam) {
    const int tid = threadIdx.x, lane = tid & 63, w = __builtin_amdgcn_readfirstlane(tid >> 6), mp = w >> 2, rb = w & 3, c32 = lane & 31, hh = lane >> 5;
    const int qrow = 128 * qb + 32 * rb + c32;
    bf16x8 qf[4];
    { const bf16_t* qp = Hb + (size_t)qrow * HP_ + HC_Q + h * 128 + 64 * mp + 8 * hh;
#pragma unroll
      for (int s = 0; s < 4; ++s) qf[s] = *(const bf16x8*)(qp + 16 * s); }
    const int srow = tid >> 4, sch = tid & 15;
    const bf16_t* kg = Hb + HC_K + h * 128 + sch * 8; const bf16_t* vg = Hb + HC_V + h * 128 + sch * 8;
    const int nt = 2 * qb + 2;
    u32x4 kr[2], vr[2];
#define DA_LOAD(t) do { _Pragma("unroll") for (int j = 0; j < 2; ++j) { const size_t ro = (size_t)(64 * (t) + srow + 32 * j) * HP_; kr[j] = *(const u32x4*)(kg + ro); vr[j] = *(const u32x4*)(vg + ro); } } while (0)
#define DA_WRITE(buf) do { _Pragma("unroll") for (int j = 0; j < 2; ++j) { *(DA_LAS u32x4*)(lds + (buf) * BUF + (srow + 32 * j) * KP + sch * 16) = kr[j]; *(DA_LAS u32x4*)(lds + (buf) * BUF + KBUF + (srow + 32 * j) * VP + sch * 16) = vr[j]; } } while (0)
    DA_LOAD(0); DA_WRITE(0);
    __syncthreads();
    f32x16 oT[4];
#pragma unroll
    for (int i = 0; i < 4; ++i) oT[i] = (f32x16){0.f, 0.f, 0.f, 0.f, 0.f, 0.f, 0.f, 0.f, 0.f, 0.f, 0.f, 0.f, 0.f, 0.f, 0.f, 0.f};
    float mrow = -INFINITY, lrow = 0.f;
    const int koff = c32 * KP + (64 * mp + 8 * hh) * 2;
    const int voff = KBUF + (4 * hh + ((lane & 15) >> 2)) * VP + (16 * ((lane >> 4) & 1) + 4 * (lane & 3)) * 2;
    for (int t = 0; t < nt; ++t) {
        const int cur = t & 1;
        if (t + 1 < nt) DA_LOAD(t + 1);
        if (!(t == nt - 1 && rb <= 1)) {
            const DA_LAS unsigned char* kb = lds + cur * BUF + koff;
            f32x16 s0 = (f32x16){0.f, 0.f, 0.f, 0.f, 0.f, 0.f, 0.f, 0.f, 0.f, 0.f, 0.f, 0.f, 0.f, 0.f, 0.f, 0.f}, s1 = s0;
#pragma unroll
            for (int s = 0; s < 4; ++s) {
                const bf16x8 a0 = *(const DA_LAS bf16x8*)(kb + s * 32), a1 = *(const DA_LAS bf16x8*)(kb + 32 * KP + s * 32);
                s0 = __builtin_amdgcn_mfma_f32_32x32x16_bf16(a0, qf[s], s0, 0, 0, 0);
                s1 = __builtin_amdgcn_mfma_f32_32x32x16_bf16(a1, qf[s], s1, 0, 0, 0);
            }
            if (t >= nt - 2) {
                const int k0 = 64 * t + 4 * hh;
#pragma unroll
                for (int r = 0; r < 16; ++r) { const int key = k0 + (r & 3) + 8 * (r >> 2); if (key > qrow) s0[r] = -INFINITY; if (key + 32 > qrow) s1[r] = -INFINITY; }
            }
            float mx = fmaxf(s0[0], s1[0]);
#pragma unroll
            for (int r = 1; r < 16; ++r) mx = fmaxf(mx, fmaxf(s0[r], s1[r]));
            mx = fmaxf(mx, __shfl_xor(mx, 32));
            const float mnew = fmaxf(mrow, mx), alpha = __builtin_amdgcn_exp2f(mrow - mnew);
            mrow = mnew;
            float ps = 0.f;
#pragma unroll
            for (int r = 0; r < 16; ++r) { s0[r] = __builtin_amdgcn_exp2f(s0[r] - mnew); s1[r] = __builtin_amdgcn_exp2f(s1[r] - mnew); ps += s0[r] + s1[r]; }
            lrow = lrow * alpha + ps;
#pragma unroll
            for (int i = 0; i < 4; ++i)
#pragma unroll
                for (int r = 0; r < 16; ++r) oT[i][r] *= alpha;
            bf16x8 pf[2][2];
#pragma unroll
            for (int s = 0; s < 2; ++s) {
                u32x4 a, b;
                a.x = cvtpk(s0[8 * s], s0[8 * s + 1]); a.y = cvtpk(s0[8 * s + 2], s0[8 * s + 3]); a.z = cvtpk(s0[8 * s + 4], s0[8 * s + 5]); a.w = cvtpk(s0[8 * s + 6], s0[8 * s + 7]);
                b.x = cvtpk(s1[8 * s], s1[8 * s + 1]); b.y = cvtpk(s1[8 * s + 2], s1[8 * s + 3]); b.z = cvtpk(s1[8 * s + 4], s1[8 * s + 5]); b.w = cvtpk(s1[8 * s + 6], s1[8 * s + 7]);
                pf[0][s] = __builtin_bit_cast(bf16x8, a); pf[1][s] = __builtin_bit_cast(bf16x8, b);
            }
            const DA_LAS unsigned char* vb = lds + cur * BUF + voff;
#pragma unroll
            for (int db = 0; db < 4; ++db)
#pragma unroll
                for (int t2 = 0; t2 < 2; ++t2)
#pragma unroll
                    for (int s = 0; s < 2; ++s) {
                        const s16x4 lo = vtr(vb + (32 * t2 + 16 * s) * VP + db * 64), hi = vtr(vb + (32 * t2 + 16 * s + 8) * VP + db * 64);
                        const bf16x8 vf = (bf16x8){lo[0], lo[1], lo[2], lo[3], hi[0], hi[1], hi[2], hi[3]};
                        oT[db] = __builtin_amdgcn_mfma_f32_32x32x16_bf16(vf, pf[t2][s], oT[db], 0, 0, 0);
                    }
        }
        if (t + 1 < nt) DA_WRITE(cur ^ 1);
        __syncthreads();
    }
#undef DA_LOAD
#undef DA_WRITE
    const float inv = 1.f / (lrow + __shfl_xor(lrow, 32));
    DA_LAS float* X = (DA_LAS float*)(lds + XOFF) + rb * 4096 + lane;
    if (mp == 1) {
#pragma unroll
        for (int i = 0; i < 4; ++i)
#pragma unroll
            for (int r = 0; r < 16; ++r) X[(i * 16 + r) * 64] = oT[i][r] * inv;
    }
    __syncthreads();
    if (mp == 0) {
        float ss = 0.f;
#pragma unroll
        for (int i = 0; i < 4; ++i)
#pragma unroll
            for (int r = 0; r < 16; ++r) { const float o = oT[i][r] * inv - lam * X[(i * 16 + r) * 64]; oT[i][r] = o; ss += o * o; }
        ss += __shfl_xor(ss, 32);
        const float rr = rsqrtf(ss * (1.f / 128.f) + 1e-5f) * (1.f - LAMBDA_INIT);
        bf16_t* op = Hb + (size_t)qrow * HP_ + HC_Q + h * 128 + 4 * hh;
#pragma unroll
        for (int i = 0; i < 4; ++i)
#pragma unroll
            for (int g = 0; g < 4; ++g) { const int d0 = 32 * i + 8 * g; const f32x4 sw = *(const f32x4*)(subln_w + d0 + 4 * hh);
                uint2 o; o.x = pk2(oT[i][4 * g] * rr * sw.x, oT[i][4 * g + 1] * rr * sw.y); o.y = pk2(oT[i][4 * g + 2] * rr * sw.z, oT[i][4 * g + 3] * rr * sw.w);
                *(uint2*)(op + d0) = o; }
    }
    __syncthreads();
}
}
__global__ void __launch_bounds__(512, 2) k_attn_mfma(bf16_t* Hb, const float* __restrict__ subln_w, const float* __restrict__ lam_p) {
    extern __shared__ __attribute__((aligned(16))) unsigned char lds[];
    const float lam = *lam_p; const int c = blockIdx.x, h = c >> 5, j = c & 31;
    dattn::unit((DA_LAS unsigned char*)lds, Hb, h, 63 - j, subln_w, lam);
    dattn::unit((DA_LAS unsigned char*)lds, Hb, h, j, subln_w, lam);
}


namespace ssd {
#define SS_LAS __attribute__((address_space(3)))
typedef short bf16x8 __attribute__((ext_vector_type(8)));
typedef short s16x4 __attribute__((ext_vector_type(4)));
typedef float f32x16 __attribute__((ext_vector_type(16)));
constexpr int XP = 192;
constexpr int BPT = 320;
constexpr int CP = 272;
__device__ __forceinline__ s16x4 vtr(const SS_LAS unsigned char* p) { typedef short v4i16_t __attribute__((ext_vector_type(4))); return __builtin_bit_cast(s16x4, __builtin_amdgcn_ds_read_tr16_b64_v4i16((SS_LAS v4i16_t*)p)); }
__device__ __forceinline__ unsigned cvtpk(float lo, float hi) { typedef float f2 __attribute__((ext_vector_type(2))); typedef __bf16 b2 __attribute__((ext_vector_type(2))); f2 v = {lo, hi}; b2 b = __builtin_convertvector(v, b2); return __builtin_bit_cast(unsigned, b); }
__device__ __forceinline__ void acs_tables(SS_LAS float* ACS, SS_LAS float* DTS, const float* __restrict__ DTb, const float* __restrict__ a_log, int c, int g) {
    const int lane = threadIdx.x & 63, e = __builtin_amdgcn_readfirstlane(threadIdx.x >> 6), h = 8 * g + e;
    const float a = -expf(a_log[h]);
    const float d0 = DTb[(size_t)(128 * c + 2 * lane) * 32 + h], d1 = DTb[(size_t)(128 * c + 2 * lane + 1) * 32 + h];
    const float a0 = d0 * a, a1 = d1 * a;
    float sc = a0 + a1;
#pragma unroll
    for (int o = 1; o < 64; o <<= 1) { const float v = __shfl_up(sc, o); if (lane >= o) sc += v; }
    const float ex = sc - (a0 + a1);
    ACS[(2 * lane) * 8 + e] = ex + a0; ACS[(2 * lane + 1) * 8 + e] = ex + a0 + a1;
    DTS[(2 * lane) * 8 + e] = d0; DTS[(2 * lane + 1) * 8 + e] = d1;
}
template <class F> __device__ __forceinline__ void conv_item(const bf16_t* __restrict__ Hb, int t0, int l0, int xch0, const float* __restrict__ conv_w, const float* __restrict__ conv_b, F sink) {
    float w[4][8], bias[8];
#pragma unroll
    for (int j = 0; j < 4; ++j) { const f32x4 a = *(const f32x4*)(conv_w + j * DXBC + xch0), b = *(const f32x4*)(conv_w + j * DXBC + xch0 + 4); w[j][0] = a.x; w[j][1] = a.y; w[j][2] = a.z; w[j][3] = a.w; w[j][4] = b.x; w[j][5] = b.y; w[j][6] = b.z; w[j][7] = b.w; }
    { const f32x4 a = *(const f32x4*)(conv_b + xch0), b = *(const f32x4*)(conv_b + xch0 + 4); bias[0] = a.x; bias[1] = a.y; bias[2] = a.z; bias[3] = a.w; bias[4] = b.x; bias[5] = b.y; bias[6] = b.z; bias[7] = b.w; }
    float x0[8], x1[8], x2[8];
    const bf16_t* src = Hb + HC_XBC + xch0;
#define SS_ROW(dst, tt) do { u32x4 q_ = (u32x4){0u, 0u, 0u, 0u}; if ((tt) >= 0) q_ = *(const u32x4*)(src + (size_t)(tt) * HP_); dst[0] = bflo(q_.x); dst[1] = bfhi(q_.x); dst[2] = bflo(q_.y); dst[3] = bfhi(q_.y); dst[4] = bflo(q_.z); dst[5] = bfhi(q_.z); dst[6] = bflo(q_.w); dst[7] = bfhi(q_.w); } while (0)
    SS_ROW(x0, t0 + l0 - 3); SS_ROW(x1, t0 + l0 - 2); SS_ROW(x2, t0 + l0 - 1);
#pragma unroll
    for (int i = 0; i < 16; ++i) {
        float x3[8]; SS_ROW(x3, t0 + l0 + i);
        float v[8];
#pragma unroll
        for (int k = 0; k < 8; ++k) { const float a = bias[k] + w[0][k] * x0[k] + w[1][k] * x1[k] + w[2][k] * x2[k] + w[3][k] * x3[k]; v[k] = a / (1.f + __expf(-a)); x0[k] = x1[k]; x1[k] = x2[k]; x2[k] = x3[k]; }
        sink(l0 + i, v);
    }
#undef SS_ROW
}
constexpr int A_BS = 0, A_XD = 128 * BPT  , A_ACS = A_XD + 2 * 128 * XP  , A_DTS = A_ACS + 4096, A_END = A_DTS + 4096;
__device__ __forceinline__ void phaseA_unit(SS_LAS unsigned char* lds, const bf16_t* __restrict__ Hb, const float* __restrict__ DTb, const float* __restrict__ conv_w, const float* __restrict__ conv_b,
                                            const float* __restrict__ a_log, bf16_t* __restrict__ ST, float* __restrict__ CD, int c, int g) {
    const int tid = threadIdx.x, lane = tid & 63, w = __builtin_amdgcn_readfirstlane(tid >> 6), c32 = lane & 31, hh = lane >> 5;
    SS_LAS float* ACS = (SS_LAS float*)(lds + A_ACS); SS_LAS float* DTS = (SS_LAS float*)(lds + A_DTS);
    acs_tables(ACS, DTS, DTb, a_log, c, g);
    __syncthreads();
    if (tid < 8) CD[c * 32 + 8 * g + tid] = __expf(ACS[127 * 8 + tid]);
    auto stageX = [&](int e, int item, int buf) {
        const int cg = item >> 3, seg = item & 7; const float aend = ACS[127 * 8 + e];
        conv_item(Hb, 128 * c, 16 * seg, g * 512 + e * 64 + cg * 8, conv_w, conv_b, [&](int l, const float (&v)[8]) {
            const float sc = DTS[l * 8 + e] * __expf(aend - ACS[l * 8 + e]);
            u32x4 o; o.x = cvtpk(v[0] * sc, v[1] * sc); o.y = cvtpk(v[2] * sc, v[3] * sc); o.z = cvtpk(v[4] * sc, v[5] * sc); o.w = cvtpk(v[6] * sc, v[7] * sc);
            *(SS_LAS u32x4*)(lds + A_XD + buf * 128 * XP + l * XP + cg * 16) = o; });
    };
    if (tid < 128) { const int cg = tid >> 3, seg = tid & 7;
        conv_item(Hb, 128 * c, 16 * seg, 2048 + g * 128 + cg * 8, conv_w, conv_b, [&](int l, const float (&v)[8]) {
            u32x4 o; o.x = cvtpk(v[0], v[1]); o.y = cvtpk(v[2], v[3]); o.z = cvtpk(v[4], v[5]); o.w = cvtpk(v[6], v[7]);
            *(SS_LAS u32x4*)(lds + A_BS + l * BPT + cg * 16) = o; });
    } else if (tid < 192) stageX(0, tid - 128, 0);
    __syncthreads();
    const int pb = w & 1, nb = w >> 1;
    const int rsel = ((lane & 15) >> 2), csel = 16 * ((lane >> 4) & 1) + 4 * (lane & 3);
    for (int e = 0; e < 8; ++e) {
        if (e + 1 < 8 && tid >= 448) stageX(e + 1, tid - 448, (e + 1) & 1);
        f32x16 acc = (f32x16){0.f, 0.f, 0.f, 0.f, 0.f, 0.f, 0.f, 0.f, 0.f, 0.f, 0.f, 0.f, 0.f, 0.f, 0.f, 0.f};
        const SS_LAS unsigned char* bp = lds + A_BS + (8 * hh + rsel) * BPT + (32 * nb + csel) * 2;
        const SS_LAS unsigned char* xp = lds + A_XD + (e & 1) * 128 * XP + (8 * hh + rsel) * XP + (32 * pb + csel) * 2;
#pragma unroll
        for (int ks = 0; ks < 8; ++ks) {
            const s16x4 b0 = vtr(bp + (16 * ks) * BPT), b1 = vtr(bp + (16 * ks + 4) * BPT), x0 = vtr(xp + (16 * ks) * XP), x1 = vtr(xp + (16 * ks + 4) * XP);
            const bf16x8 bf = (bf16x8){b0[0], b0[1], b0[2], b0[3], b1[0], b1[1], b1[2], b1[3]}, xf = (bf16x8){x0[0], x0[1], x0[2], x0[3], x1[0], x1[1], x1[2], x1[3]};
            acc = __builtin_amdgcn_mfma_f32_32x32x16_bf16(bf, xf, acc, 0, 0, 0);
        }
        bf16_t* sp = ST + ((size_t)(c * 32 + 8 * g + e) * 64 + 32 * pb + c32) * 128 + 32 * nb + 4 * hh;
#pragma unroll
        for (int q = 0; q < 4; ++q) { uint2 o; o.x = cvtpk(acc[4 * q], acc[4 * q + 1]); o.y = cvtpk(acc[4 * q + 2], acc[4 * q + 3]); *(uint2*)(sp + 8 * q) = o; }
        __syncthreads();
    }
}
__device__ __forceinline__ void scan_phase(bf16_t* __restrict__ ST, const float* __restrict__ CD, int gtid) {
    const int h = gtid >> 12;
    unsigned* p = (unsigned*)ST + gtid;
    float r0 = 0.f, r1 = 0.f;
    for (int c0 = 0; c0 < 64; c0 += 16) {
        unsigned v[16]; float d[16];
#pragma unroll
        for (int i = 0; i < 16; ++i) { v[i] = p[(size_t)(c0 + i) * 131072]; d[i] = CD[(c0 + i) * 32 + h]; }
#pragma unroll
        for (int i = 0; i < 16; ++i) { p[(size_t)(c0 + i) * 131072] = cvtpk(r0, r1); r0 = r0 * d[i] + bflo(v[i]); r1 = r1 * d[i] + bfhi(v[i]); }
    }
}
constexpr int C_CS = 0, C_BS = 128 * CP  , C_X1 = C_BS  , C_CBT = 2 * 128 * CP  , C_X0 = C_CBT + 32768  , C_ACS = C_X0 + 128 * XP  , C_DTS = C_ACS + 4096,
              C_SSQ = C_DTS + 4096, C_END = C_SSQ + 1024;
static_assert(C_END <= 147456 && 128 * XP <= 128 * CP, "ssd phase C LDS");
__device__ __forceinline__ void phaseC_unit(SS_LAS unsigned char* lds, bf16_t* __restrict__ Hb, const float* __restrict__ DTb, const float* __restrict__ conv_w, const float* __restrict__ conv_b,
                                            const float* __restrict__ a_log, const float* __restrict__ d_skip, const float* __restrict__ norm_w, const bf16_t* __restrict__ ST, int c, int g) {
    const int tid = threadIdx.x, lane = tid & 63, w = __builtin_amdgcn_readfirstlane(tid >> 6), c32 = lane & 31, hh = lane >> 5;
    SS_LAS float* ACS = (SS_LAS float*)(lds + C_ACS); SS_LAS float* DTS = (SS_LAS float*)(lds + C_DTS); SS_LAS float* SSQ = (SS_LAS float*)(lds + C_SSQ);
    acs_tables(ACS, DTS, DTb, a_log, c, g);
    auto stageX = [&](int e, int item, int buf) {
        const int cg = item >> 3, seg = item & 7;
        conv_item(Hb, 128 * c, 16 * seg, g * 512 + e * 64 + cg * 8, conv_w, conv_b, [&](int l, const float (&v)[8]) {
            u32x4 o; o.x = cvtpk(v[0], v[1]); o.y = cvtpk(v[2], v[3]); o.z = cvtpk(v[4], v[5]); o.w = cvtpk(v[6], v[7]);
            *(SS_LAS u32x4*)(lds + (buf ? C_X1 : C_X0) + l * XP + cg * 16) = o; });
    };
    if (tid < 256) { const int isC = tid >> 7, it = tid & 127, cg = it >> 3, seg = it & 7;
        conv_item(Hb, 128 * c, 16 * seg, 2048 + isC * 512 + g * 128 + cg * 8, conv_w, conv_b, [&](int l, const float (&v)[8]) {
            u32x4 o; o.x = cvtpk(v[0], v[1]); o.y = cvtpk(v[2], v[3]); o.z = cvtpk(v[4], v[5]); o.w = cvtpk(v[6], v[7]);
            *(SS_LAS u32x4*)(lds + (isC ? C_CS : C_BS) + l * CP + cg * 16) = o; });
    } else if (tid < 320) stageX(0, tid - 256, 0);
    __syncthreads();
    for (int i = w; i < 10; i += 8) {
        const int sb = (i < 4) ? 0 : (i < 7) ? 1 : (i < 9) ? 2 : 3, lb = (i < 4) ? i : (i < 7) ? i - 3 : (i < 9) ? i - 5 : 3;
        f32x16 acc = (f32x16){0.f, 0.f, 0.f, 0.f, 0.f, 0.f, 0.f, 0.f, 0.f, 0.f, 0.f, 0.f, 0.f, 0.f, 0.f, 0.f};
        const SS_LAS unsigned char* bp = lds + C_BS + (32 * sb + c32) * CP + 16 * hh, *cp = lds + C_CS + (32 * lb + c32) * CP + 16 * hh;
#pragma unroll
        for (int ks = 0; ks < 8; ++ks) acc = __builtin_amdgcn_mfma_f32_32x32x16_bf16(*(const SS_LAS bf16x8*)(bp + 32 * ks), *(const SS_LAS bf16x8*)(cp + 32 * ks), acc, 0, 0, 0);
        SS_LAS unsigned* o = (SS_LAS unsigned*)(lds + C_CBT) + (sb * 4 + lb) * 512 + lane;
#pragma unroll
        for (int q = 0; q < 8; ++q) o[q * 64] = cvtpk(acc[2 * q], acc[2 * q + 1]);
    }
    __syncthreads();
    const int pb = w & 1, lb = w >> 1, lrow = 32 * lb + c32;
    const int rsel = ((lane & 15) >> 2), csel = 16 * ((lane >> 4) & 1) + 4 * (lane & 3);
    unsigned ypk[8][8];
    float ssq = 0.f;
    for (int e = 0; e < 8; ++e) {
        const int h = 8 * g + e;
        if (e + 1 < 8 && tid >= 448) stageX(e + 1, tid - 448, (e + 1) & 1);
        const int xoff = (e & 1) ? C_X1 : C_X0;
        f32x16 acc = (f32x16){0.f, 0.f, 0.f, 0.f, 0.f, 0.f, 0.f, 0.f, 0.f, 0.f, 0.f, 0.f, 0.f, 0.f, 0.f, 0.f};
        {
            const bf16_t* pp = ST + ((size_t)(c * 32 + h) * 64 + 32 * pb + c32) * 128 + 8 * hh;
            const SS_LAS unsigned char* cp = lds + C_CS + lrow * CP + 16 * hh;
#pragma unroll
            for (int ks = 0; ks < 8; ++ks) acc = __builtin_amdgcn_mfma_f32_32x32x16_bf16(*(const bf16x8*)(pp + 16 * ks), *(const SS_LAS bf16x8*)(cp + 32 * ks), acc, 0, 0, 0);
        }
        const float al = ACS[lrow * 8 + e], eal = __expf(al);
#pragma unroll
        for (int r = 0; r < 16; ++r) acc[r] *= eal;
        for (int sb = 0; sb <= lb; ++sb) {
            const SS_LAS unsigned* cbp = (const SS_LAS unsigned*)(lds + C_CBT) + (sb * 4 + lb) * 512 + lane;
            float m[16];
#pragma unroll
            for (int q = 0; q < 8; ++q) { const unsigned u = cbp[q * 64]; m[2 * q] = bflo(u); m[2 * q + 1] = bfhi(u); }
#pragma unroll
            for (int r = 0; r < 16; ++r) { const int srow = 32 * sb + (r & 3) + 8 * (r >> 2) + 4 * hh;
                const float f = __expf(al - ACS[srow * 8 + e]) * DTS[srow * 8 + e];
                m[r] = (srow <= lrow) ? m[r] * f : 0.f; }
            const SS_LAS unsigned char* xp = lds + xoff + (32 * sb + 4 * hh + rsel) * XP + (32 * pb + csel) * 2;
#pragma unroll
            for (int ks = 0; ks < 2; ++ks) {
                const s16x4 x0 = vtr(xp + (16 * ks) * XP), x1 = vtr(xp + (16 * ks + 8) * XP);
                const bf16x8 xf = (bf16x8){x0[0], x0[1], x0[2], x0[3], x1[0], x1[1], x1[2], x1[3]};
                u32x4 mm; mm.x = cvtpk(m[8 * ks], m[8 * ks + 1]); mm.y = cvtpk(m[8 * ks + 2], m[8 * ks + 3]); mm.z = cvtpk(m[8 * ks + 4], m[8 * ks + 5]); mm.w = cvtpk(m[8 * ks + 6], m[8 * ks + 7]);
                acc = __builtin_amdgcn_mfma_f32_32x32x16_bf16(xf, __builtin_bit_cast(bf16x8, mm), acc, 0, 0, 0);
            }
        }
        const float dsk = d_skip[h];
        const bf16_t* zp = Hb + (size_t)(128 * c + lrow) * HP_ + HC_Z + g * 512 + e * 64 + 32 * pb + 4 * hh;
        const SS_LAS unsigned char* xr = lds + xoff + lrow * XP + (32 * pb + 4 * hh) * 2;
        unsigned yt[8];
#pragma unroll
        for (int q = 0; q < 4; ++q) {
            const u32x2 zz = *(const u32x2*)(zp + 8 * q); const u32x2 xx = *(const SS_LAS u32x2*)(xr + 16 * q);
            const float zv[4] = {bflo(zz.x), bfhi(zz.x), bflo(zz.y), bfhi(zz.y)}, xv[4] = {bflo(xx.x), bfhi(xx.x), bflo(xx.y), bfhi(xx.y)};
            float y[4];
#pragma unroll
            for (int k = 0; k < 4; ++k) { y[k] = (acc[4 * q + k] + dsk * xv[k]) * (zv[k] / (1.f + __expf(-zv[k]))); ssq += y[k] * y[k]; }
            yt[2 * q] = cvtpk(y[0], y[1]); yt[2 * q + 1] = cvtpk(y[2], y[3]);
        }
#define SS_YSET(E) case E: { _Pragma("unroll") for (int q_ = 0; q_ < 8; ++q_) ypk[E][q_] = yt[q_]; } break;
        switch (e) { SS_YSET(0) SS_YSET(1) SS_YSET(2) SS_YSET(3) SS_YSET(4) SS_YSET(5) SS_YSET(6) default: { _Pragma("unroll") for (int q_ = 0; q_ < 8; ++q_) ypk[7][q_] = yt[q_]; } break; }
#undef SS_YSET
        __syncthreads();
    }
    ssq += __shfl_xor(ssq, 32);
    if (hh == 0) SSQ[pb * 128 + lrow] = ssq;
    __syncthreads();
    const float rstd = rsqrtf((SSQ[lrow] + SSQ[128 + lrow]) * (1.f / 512.f) + 1e-5f);
    bf16_t* op = Hb + (size_t)(128 * c + lrow) * HP_ + HC_Z + g * 512 + 32 * pb + 4 * hh;
    const float* nw = norm_w + g * 512 + 32 * pb + 4 * hh;
#pragma unroll
    for (int e = 0; e < 8; ++e)
#pragma unroll
        for (int q = 0; q < 4; ++q) { const f32x4 n4 = *(const f32x4*)(nw + e * 64 + 8 * q);
            uint2 o; o.x = cvtpk(bflo(ypk[e][2 * q]) * rstd * n4.x, bfhi(ypk[e][2 * q]) * rstd * n4.y); o.y = cvtpk(bflo(ypk[e][2 * q + 1]) * rstd * n4.z, bfhi(ypk[e][2 * q + 1]) * rstd * n4.w);
            *(uint2*)(op + e * 64 + 8 * q) = o; }
    __syncthreads();
}
}
__global__ void __launch_bounds__(512, 2) k_ssdA(const bf16_t* Hb, const float* DTb, const float* conv_w, const float* conv_b, const float* a_log, bf16_t* ST, float* CD) {
    extern __shared__ __attribute__((aligned(16))) unsigned char lds[];
    ssd::phaseA_unit((SS_LAS unsigned char*)lds, Hb, DTb, conv_w, conv_b, a_log, ST, CD, blockIdx.x >> 2, blockIdx.x & 3);
}
__global__ void __launch_bounds__(512, 2) k_ssdScan(bf16_t* ST, const float* CD) { ssd::scan_phase(ST, CD, blockIdx.x * 512 + threadIdx.x); }
__global__ void __launch_bounds__(512, 2) k_ssdC(bf16_t* Hb, const float* DTb, const float* conv_w, const float* conv_b, const float* a_log, const float* d_skip, const float* norm_w, const bf16_t* ST) {
    extern __shared__ __attribute__((aligned(16))) unsigned char lds[];
    ssd::phaseC_unit((SS_LAS unsigned char*)lds, Hb, DTb, conv_w, conv_b, a_log, d_skip, norm_w, ST, blockIdx.x >> 2, blockIdx.x & 3);
}

__global__ void __launch_bounds__(256) k_attn_naive(bf16_t* __restrict__ H, const float* __restrict__ subln_w, const float* __restrict__ lam_p) {
    extern __shared__ float o0s[];
    const int tid = threadIdx.x, h = blockIdx.y, row = blockIdx.x * 256 + tid;
    const int wave_last = blockIdx.x * 256 + (tid | 63);
    const float lam = *lam_p;
    float o[128];
    for (int m = 0; m < 2; ++m) {
        float q[64];
        { const bf16_t* qp = H + (size_t)row * HP_ + HC_Q + h * 128 + m * 64;
#pragma unroll
          for (int j = 0; j < 8; ++j) { const u32x4 w = *(const u32x4*)(qp + 8 * j); q[8 * j] = bflo(w.x); q[8 * j + 1] = bfhi(w.x); q[8 * j + 2] = bflo(w.y); q[8 * j + 3] = bfhi(w.y); q[8 * j + 4] = bflo(w.z); q[8 * j + 5] = bfhi(w.z); q[8 * j + 6] = bflo(w.w); q[8 * j + 7] = bfhi(w.w); } }
        float mx = -INFINITY, l = 0.f;
#pragma unroll
        for (int j = 0; j < 128; ++j) o[j] = 0.f;
        for (int t = 0; t <= wave_last; ++t) {
            const bf16_t* kp = H + (size_t)t * HP_ + HC_K + h * 128 + m * 64;
            float s = 0.f;
#pragma unroll
            for (int j = 0; j < 8; ++j) { const u32x4 w = *(const u32x4*)(kp + 8 * j);
                s = fmaf(q[8 * j], bflo(w.x), s); s = fmaf(q[8 * j + 1], bfhi(w.x), s); s = fmaf(q[8 * j + 2], bflo(w.y), s); s = fmaf(q[8 * j + 3], bfhi(w.y), s);
                s = fmaf(q[8 * j + 4], bflo(w.z), s); s = fmaf(q[8 * j + 5], bfhi(w.z), s); s = fmaf(q[8 * j + 6], bflo(w.w), s); s = fmaf(q[8 * j + 7], bfhi(w.w), s); }
            if (t > row) s = -INFINITY;
            const float mn = fmaxf(mx, s);
            const float f = (mn == -INFINITY) ? 1.f : exp2f(mx - mn), p = (s == -INFINITY) ? 0.f : exp2f(s - mn);
            mx = mn; l = l * f + p;
            const bf16_t* vp = H + (size_t)t * HP_ + HC_V + h * 128;
#pragma unroll
            for (int j = 0; j < 16; ++j) { const u32x4 w = *(const u32x4*)(vp + 8 * j);
                o[8 * j] = fmaf(p, bflo(w.x), o[8 * j] * f); o[8 * j + 1] = fmaf(p, bfhi(w.x), o[8 * j + 1] * f); o[8 * j + 2] = fmaf(p, bflo(w.y), o[8 * j + 2] * f); o[8 * j + 3] = fmaf(p, bfhi(w.y), o[8 * j + 3] * f);
                o[8 * j + 4] = fmaf(p, bflo(w.z), o[8 * j + 4] * f); o[8 * j + 5] = fmaf(p, bfhi(w.z), o[8 * j + 5] * f); o[8 * j + 6] = fmaf(p, bflo(w.w), o[8 * j + 6] * f); o[8 * j + 7] = fmaf(p, bfhi(w.w), o[8 * j + 7] * f); }
        }
        const float il = 1.f / l;
        if (m == 0) {
#pragma unroll
            for (int j = 0; j < 128; ++j) o0s[j * 256 + tid] = o[j] * il;
        } else {
            float ss = 0.f;
#pragma unroll
            for (int j = 0; j < 128; ++j) { o[j] = o0s[j * 256 + tid] - lam * (o[j] * il); ss += o[j] * o[j]; }
            const float r = rsqrtf(ss * (1.f / 128.f) + 1e-5f) * (1.f - LAMBDA_INIT);
            bf16_t* op = H + (size_t)row * HP_ + HC_Q + h * 128;
#pragma unroll
            for (int j = 0; j < 16; ++j) { float v8[8];
#pragma unroll
                for (int e = 0; e < 8; ++e) v8[e] = o[8 * j + e] * r * subln_w[8 * j + e];
                store_bf16x8(op + 8 * j, v8); }
        }
    }
}

__global__ void __launch_bounds__(256) k_conv_bc(const bf16_t* __restrict__ H, const float* __restrict__ conv_w, const float* __restrict__ conv_b, float* __restrict__ BC, int t0, int nt) {
    const size_t i = (size_t)blockIdx.x * 256 + threadIdx.x; if (i >= (size_t)nt * 1024) return;
    const int t = t0 + (int)(i >> 10), c = 2048 + (int)(i & 1023);
    float a = conv_b[c];
#pragma unroll
    for (int j = 0; j < 4; ++j) { const int tt = t - 3 + j; if (tt >= 0) a = fmaf(conv_w[j * DXBC + c], bf2f(H[(size_t)tt * HP_ + HC_XBC + c]), a); }
    BC[i] = siluf_(a);
}
__global__ void __launch_bounds__(256) k_ssd_seq(const bf16_t* __restrict__ H, const float* __restrict__ BC, const float* __restrict__ DT  ,
                                                 const float* __restrict__ conv_w, const float* __restrict__ conv_b, const float* __restrict__ a_log, const float* __restrict__ d_skip,
                                                 float* __restrict__ ST, float* __restrict__ YRAW  , int t0, int nt) {
    const int h = blockIdx.x, tid = threadIdx.x, p = tid >> 2, nq = tid & 3, g = h >> 3, ch = h * 64 + p;
    float st[32];
    float* stp = ST + ((size_t)(h * 64 + p) * 128 + nq * 32);
    if (t0 == 0) {
#pragma unroll
        for (int j = 0; j < 32; ++j) st[j] = 0.f;
    } else {
#pragma unroll
        for (int j = 0; j < 32; ++j) st[j] = stp[j];
    }
    const float a = -expf(a_log[h]), dsk = d_skip[h];
    const float cw0 = conv_w[ch], cw1 = conv_w[DXBC + ch], cw2 = conv_w[2 * DXBC + ch], cw3 = conv_w[3 * DXBC + ch], cb = conv_b[ch];
    float x0 = 0.f, x1 = 0.f, x2 = 0.f;
    if (t0 >= 3) { x0 = bf2f(H[(size_t)(t0 - 3) * HP_ + HC_XBC + ch]); x1 = bf2f(H[(size_t)(t0 - 2) * HP_ + HC_XBC + ch]); x2 = bf2f(H[(size_t)(t0 - 1) * HP_ + HC_XBC + ch]); }
    for (int i = 0; i < nt; ++i) {
        const int t = t0 + i;
        const float x3 = bf2f(H[(size_t)t * HP_ + HC_XBC + ch]);
        const float xs = siluf_(cb + cw0 * x0 + cw1 * x1 + cw2 * x2 + cw3 * x3);
        x0 = x1; x1 = x2; x2 = x3;
        const float dt = DT[(size_t)t * 32 + h], dA = expf(dt * a), dx = dt * xs;
        const float* bp = BC + (size_t)i * 1024 + g * 128 + nq * 32; const float* cp = bp + 512;
        float y = 0.f;
#pragma unroll
        for (int j = 0; j < 8; ++j) { const f32x4 b = *(const f32x4*)(bp + 4 * j), c = *(const f32x4*)(cp + 4 * j);
            st[4 * j] = fmaf(st[4 * j], dA, dx * b.x); y = fmaf(c.x, st[4 * j], y);
            st[4 * j + 1] = fmaf(st[4 * j + 1], dA, dx * b.y); y = fmaf(c.y, st[4 * j + 1], y);
            st[4 * j + 2] = fmaf(st[4 * j + 2], dA, dx * b.z); y = fmaf(c.z, st[4 * j + 2], y);
            st[4 * j + 3] = fmaf(st[4 * j + 3], dA, dx * b.w); y = fmaf(c.w, st[4 * j + 3], y); }
        y += __shfl_xor(y, 1); y += __shfl_xor(y, 2);
        if (nq == 0) { const float z = bf2f(H[(size_t)t * HP_ + HC_Z + ch]); YRAW[(size_t)i * DI + ch] = (y + dsk * xs) * siluf_(z); }
    }
#pragma unroll
    for (int j = 0; j < 32; ++j) stp[j] = st[j];
}
__global__ void __launch_bounds__(256) k_ssd_norm(const float* __restrict__ YRAW, const float* __restrict__ norm_w, bf16_t* __restrict__ H, int t0, int nt) {
    const int w = blockIdx.x * 4 + (threadIdx.x >> 6), lane = threadIdx.x & 63; if (w >= nt * 4) return;
    const int i = w >> 2, g = w & 3;
    const float* yp = YRAW + (size_t)i * DI + g * 512 + lane * 8;
    const f32x4 a = *(const f32x4*)yp, b = *(const f32x4*)(yp + 4);
    float ss = a.x * a.x + a.y * a.y + a.z * a.z + a.w * a.w + b.x * b.x + b.y * b.y + b.z * b.z + b.w * b.w;
    ss = wave_sum(ss);
    const float r = rsqrtf(ss * (1.f / 512.f) + 1e-5f);
    const float* nw = norm_w + g * 512 + lane * 8;
    float o[8] = {a.x * r * nw[0], a.y * r * nw[1], a.z * r * nw[2], a.w * r * nw[3], b.x * r * nw[4], b.y * r * nw[5], b.z * r * nw[6], b.w * r * nw[7]};
    store_bf16x8(H + (size_t)(t0 + i) * HP_ + HC_Z + g * 512 + lane * 8, o);
}

__global__ void __launch_bounds__(256) k_ln(float* __restrict__ X, const float* __restrict__ g, const float* __restrict__ b, bf16_t* __restrict__ XB, int row0, int nrows) {
    const int w = blockIdx.x * 4 + (threadIdx.x >> 6), lane = threadIdx.x & 63; if (w >= nrows) return;
    const int row = row0 + w;
    f32x4* xr = (f32x4*)(X + (size_t)row * D) + lane;
    f32x4 v[4]; float s = 0.f;
#pragma unroll
    for (int j = 0; j < 4; ++j) { v[j] = xr[64 * j]; s += (v[j].x + v[j].y) + (v[j].z + v[j].w); }
    const float mean = wave_sum(s) * (1.f / D); float s2 = 0.f;
#pragma unroll
    for (int j = 0; j < 4; ++j) { v[j] = v[j] - mean; s2 += (v[j].x * v[j].x + v[j].y * v[j].y) + (v[j].z * v[j].z + v[j].w * v[j].w); }
    const float rstd = rsqrtf(wave_sum(s2) * (1.f / D) + 1e-5f);
#pragma unroll
    for (int j = 0; j < 4; ++j) { const int c = 4 * lane + 256 * j; const f32x4 gg = *(const f32x4*)(g + c), bb = *(const f32x4*)(b + c);
        f32x4 o = v[j] * rstd * gg + bb; xr[64 * j] = o;
        uint2 pb; pb.x = pk2(o.x, o.y); pb.y = pk2(o.z, o.w); *(uint2*)(XB + (size_t)row * D + c) = pb; }
}

__global__ void __launch_bounds__(256) k_xattn_naive(const bf16_t* __restrict__ QC, const bf16_t* __restrict__ KCVC, bf16_t* __restrict__ XO) {
    __shared__ float qs[1024]; __shared__ float ps[256]; __shared__ float red[8];
    const int tok = blockIdx.x, b = tok / SEQ, tid = threadIdx.x, lane = tid & 63, wv = tid >> 6;
    for (int i = tid; i < 1024; i += 256) qs[i] = bf2f(QC[(size_t)tok * D + i]);
    __syncthreads();
    const bf16_t* KV = KCVC + (size_t)b * MEML * 2048;
    for (int h = 0; h < MH; ++h) {
        const bf16_t* kp = KV + (size_t)tid * 2048 + h * 256;
        float s = 0.f;
        for (int d = 0; d < 256; d += 8) { const u32x4 w = *(const u32x4*)(kp + d); const float* q = qs + h * 256 + d;
            s += q[0] * bflo(w.x) + q[1] * bfhi(w.x) + q[2] * bflo(w.y) + q[3] * bfhi(w.y) + q[4] * bflo(w.z) + q[5] * bfhi(w.z) + q[6] * bflo(w.w) + q[7] * bfhi(w.w); }
        float mx = wave_max(s); if (lane == 0) red[wv] = mx; __syncthreads();
        mx = fmaxf(fmaxf(red[0], red[1]), fmaxf(red[2], red[3]));
        const float p = exp2f(s - mx);
        float sm = wave_sum(p); if (lane == 0) red[4 + wv] = sm; ps[tid] = p; __syncthreads();
        sm = (red[4] + red[5]) + (red[6] + red[7]);
        float o = 0.f;
        for (int j = 0; j < 256; ++j) o = fmaf(ps[j], bf2f(KV[(size_t)j * 2048 + 1024 + h * 256 + tid]), o);
        XO[(size_t)tok * D + h * 256 + tid] = (bf16_t)f2bf(o / sm);
        __syncthreads();
    }
}

__global__ void __launch_bounds__(256) k_peer_select_naive(const bf16_t* __restrict__ QP, const bf16_t* __restrict__ SUBK, int* __restrict__ IDX, float* __restrict__ GATE) {
    __shared__ float qs[2048]; __shared__ float s[256]; __shared__ float tops[32]; __shared__ int topi[32]; __shared__ float cs[256]; __shared__ int ci[256]; __shared__ float bs[16]; __shared__ int bi[16];
    const int tok = blockIdx.x, tid = threadIdx.x;
    for (int i = tid; i < 2048; i += 256) qs[i] = bf2f(QP[(size_t)tok * 2048 + i]);
    __syncthreads();
    for (int h = 0; h < PH; ++h) {
        const int half = tid >> 7, key = tid & 127;
        { const bf16_t* kp = SUBK + ((size_t)(h * 2 + half) * 128 + key) * 128; const float* q = qs + h * 256 + half * 128; float a = 0.f;
          for (int d = 0; d < 128; d += 8) { const u32x4 w = *(const u32x4*)(kp + d);
              a += q[d] * bflo(w.x) + q[d + 1] * bfhi(w.x) + q[d + 2] * bflo(w.y) + q[d + 3] * bfhi(w.y) + q[d + 4] * bflo(w.z) + q[d + 5] * bfhi(w.z) + q[d + 6] * bflo(w.w) + q[d + 7] * bfhi(w.w); }
          s[tid] = a; }
        __syncthreads();
        { const float me = s[tid]; int rank = 0; const float* sp = s + half * 128;
          for (int j = 0; j < 128; ++j) { const float o = sp[j]; rank += (o > me || (o == me && j < key)) ? 1 : 0; }
          if (rank < 16) { tops[half * 16 + rank] = me; topi[half * 16 + rank] = key; } }
        __syncthreads();
        { const int i = tid >> 4, j = tid & 15; cs[tid] = tops[i] + tops[16 + j]; ci[tid] = topi[i] * 128 + topi[16 + j]; }
        __syncthreads();
        { const float me = cs[tid]; int rank = 0;
          for (int j = 0; j < 256; ++j) { const float o = cs[j]; rank += (o > me || (o == me && j < tid)) ? 1 : 0; }
          if (rank < 16) { bs[rank] = me; bi[rank] = ci[tid]; } }
        __syncthreads();
        if (tid < 16) { float mx = bs[0]; float sum = 0.f;
            for (int j = 0; j < 16; ++j) sum += expf(bs[j] - mx);
            GATE[(size_t)tok * 128 + h * 16 + tid] = expf(bs[tid] - mx) / sum; IDX[(size_t)tok * 128 + h * 16 + tid] = bi[tid]; }
        __syncthreads();
    }
}

__global__ void __launch_bounds__(256) k_peer_gather_naive(float* __restrict__ X  , const bf16_t* __restrict__ PU, const bf16_t* __restrict__ PV,
                                                           const int* __restrict__ IDX, const float* __restrict__ GATE, const float* __restrict__ g3, const float* __restrict__ b3) {
    __shared__ float ys[4][1024]; __shared__ float red[8];
    const int tok = blockIdx.x, tid = threadIdx.x, lane = tid & 63, wv = tid >> 6;
    float xr[16], y[16];
    { const float* xp = X + (size_t)tok * D + lane * 16;
#pragma unroll
      for (int j = 0; j < 16; ++j) { xr[j] = xp[j]; y[j] = 0.f; } }
    for (int e = 0; e < 32; ++e) {
        const int slot = wv * 32 + e; const int id = IDX[(size_t)tok * 128 + slot]; const float gt = GATE[(size_t)tok * 128 + slot];
        const bf16_t* up = PU + (size_t)id * D + lane * 16; const u32x4 u0 = *(const u32x4*)up, u1 = *(const u32x4*)(up + 8);
        const unsigned uw[8] = {u0.x, u0.y, u0.z, u0.w, u1.x, u1.y, u1.z, u1.w};
        float hsum = 0.f;
#pragma unroll
        for (int j = 0; j < 8; ++j) { hsum = fmaf(xr[2 * j], bflo(uw[j]), hsum); hsum = fmaf(xr[2 * j + 1], bfhi(uw[j]), hsum); }
        hsum = wave_sum(hsum);
        const float w = gt * 0.5f * hsum * (1.f + erff(hsum * 0.70710678118654752f));
        const bf16_t* vp = PV + (size_t)id * D + lane * 16; const u32x4 v0 = *(const u32x4*)vp, v1 = *(const u32x4*)(vp + 8);
        const unsigned vw[8] = {v0.x, v0.y, v0.z, v0.w, v1.x, v1.y, v1.z, v1.w};
#pragma unroll
        for (int j = 0; j < 8; ++j) { y[2 * j] = fmaf(w, bflo(vw[j]), y[2 * j]); y[2 * j + 1] = fmaf(w, bfhi(vw[j]), y[2 * j + 1]); }
    }
#pragma unroll
    for (int j = 0; j < 16; ++j) ys[wv][lane * 16 + j] = y[j];
    __syncthreads();
    float v[4]; float s = 0.f;
#pragma unroll
    for (int j = 0; j < 4; ++j) { const int c = tid * 4 + j; v[j] = ALPHA * X[(size_t)tok * D + c] + ((ys[0][c] + ys[1][c]) + (ys[2][c] + ys[3][c])); s += v[j]; }
    s = wave_sum(s); if (lane == 0) red[wv] = s; __syncthreads();
    const float mean = ((red[0] + red[1]) + (red[2] + red[3])) * (1.f / D);
    float s2 = 0.f;
#pragma unroll
    for (int j = 0; j < 4; ++j) { v[j] -= mean; s2 += v[j] * v[j]; }
    s2 = wave_sum(s2); if (lane == 0) red[4 + wv] = s2; __syncthreads();
    const float rstd = rsqrtf(((red[4] + red[5]) + (red[6] + red[7])) * (1.f / D) + 1e-5f);
#pragma unroll
    for (int j = 0; j < 4; ++j) { const int c = tid * 4 + j; X[(size_t)tok * D + c] = v[j] * rstd * g3[c] + b3[c]; }
}

#ifndef USE_PG8
#define USE_PG8 1
#endif
#ifndef USE_SSD_MFMA
#define USE_SSD_MFMA 1
#endif
#ifndef USE_ATTN_MFMA
#define USE_ATTN_MFMA 1
#endif
template <class Epi> static void gemm_naive(hipStream_t s, const bf16_t* A, int lda, const bf16_t* Bt, int Mr, int N, int K, Epi E) {
#if USE_PG8
    static bool attr = false;
    if (!attr) { (void)hipFuncSetAttribute((const void*)k_gemm_pg8<Epi>, hipFuncAttributeMaxDynamicSharedMemorySize, LDS_BYTES); attr = true; }
    pg8::Gemm g{A, Bt, Mr, N, K, lda};
    hipLaunchKernelGGL(k_gemm_pg8<Epi>, dim3(256), dim3(512), LDS_BYTES, s, g, E);
#else
    hipLaunchKernelGGL(k_gemm_naive<Epi>, dim3(N / 64, Mr / 128), dim3(256), 0, s, A, Bt, lda, K, E);
#endif
}
extern "C" void kernel_launch(void* const* d_in, const int* in_sizes, int n_in, void* d_out, int out_size, void* d_ws, size_t ws_size, hipStream_t stream) {
    if (n_in != 30 || out_size != M * D || ws_size < WS_END) { fprintf(stderr, "kernel_launch: unexpected sizes n_in %d out %d ws %zu (need %zu)\n", n_in, out_size, ws_size, (size_t)WS_END); return; }
    const float* x = (const float*)d_in[0]; const float* mem = (const float*)d_in[1]; const float* w_in = (const float*)d_in[2];
    const float* conv_w = (const float*)d_in[3]; const float* conv_b = (const float*)d_in[4]; const float* dt_bias = (const float*)d_in[5];
    const float* a_log = (const float*)d_in[6]; const float* d_skip = (const float*)d_in[7]; const float* ssd_norm_w = (const float*)d_in[8];
    const float* w_ssd_br = (const float*)d_in[9]; const float* lam_q = (const float*)d_in[10]; const float* lam_k = (const float*)d_in[11];
    const float* subln_w = (const float*)d_in[12]; const float* w_diff_br = (const float*)d_in[13]; const float* gate_bias = (const float*)d_in[14];
    const float* w_o = (const float*)d_in[15]; const float* ln1_g = (const float*)d_in[16]; const float* ln1_b = (const float*)d_in[17];
    const float* w_cq = (const float*)d_in[18]; const float* w_ck = (const float*)d_in[19]; const float* w_cv = (const float*)d_in[20]; const float* w_co = (const float*)d_in[21];
    const float* ln2_g = (const float*)d_in[22]; const float* ln2_b = (const float*)d_in[23]; const float* w_pq = (const float*)d_in[24];
    const float* sub_keys = (const float*)d_in[25]; const float* peer_u = (const float*)d_in[26]; const float* peer_v = (const float*)d_in[27];
    const float* ln3_g = (const float*)d_in[28]; const float* ln3_b = (const float*)d_in[29];
    unsigned char* ws = (unsigned char*)d_ws; float* out = (float*)d_out;
    static bool attr_set = false;
    if (!attr_set) { (void)hipFuncSetAttribute((const void*)k_attn_naive, hipFuncAttributeMaxDynamicSharedMemorySize, 128 * 256 * 4);
        (void)hipFuncSetAttribute((const void*)k_attn_mfma, hipFuncAttributeMaxDynamicSharedMemorySize, LDS_BYTES);
        (void)hipFuncSetAttribute((const void*)k_ssdA, hipFuncAttributeMaxDynamicSharedMemorySize, LDS_BYTES);
        (void)hipFuncSetAttribute((const void*)k_ssdC, hipFuncAttributeMaxDynamicSharedMemorySize, LDS_BYTES); attr_set = true; }
    float* lam = (float*)(ws + WS_CTL) + CW_LAM;
    bf16_t* WinT = (bf16_t*)(ws + WS_WIN); bf16_t* WssdT = (bf16_t*)(ws + WS_WSSD); bf16_t* WdiffT = (bf16_t*)(ws + WS_WDIFF); bf16_t* WoT = (bf16_t*)(ws + WS_WO);
    bf16_t* WcqT = (bf16_t*)(ws + WS_WCQ); bf16_t* WckvT = (bf16_t*)(ws + WS_WCKV); bf16_t* WcoT = (bf16_t*)(ws + WS_WCO); bf16_t* WpqT = (bf16_t*)(ws + WS_WPQ);
    bf16_t* SUBK = (bf16_t*)(ws + WS_SUBK); bf16_t* MEMB = (bf16_t*)(ws + WS_MEMB); bf16_t* KCVC = (bf16_t*)(ws + WS_KCVC); float* DT = (float*)(ws + WS_DT);
    bf16_t* XB = (bf16_t*)(ws + WS_XB); bf16_t* H = (bf16_t*)(ws + WS_H); float* T1 = (float*)(ws + WS_T1);
    bf16_t* PU = (bf16_t*)(ws + WS_PU); bf16_t* PV = (bf16_t*)(ws + WS_PV); bf16_t* QC = (bf16_t*)(ws + WS_QC); bf16_t* XO = (bf16_t*)(ws + WS_XO); bf16_t* QP = (bf16_t*)(ws + WS_QP);
    int* IDX = (int*)(ws + WS_IDX); float* GATE = (float*)(ws + WS_GATE);

    hipLaunchKernelGGL(k_transpose, dim3(NINP / 32, D / 32), dim3(256), 0, stream, w_in, D, NIN, WinT, NINP, 5120, 32, 0);
    hipLaunchKernelGGL(k_transpose, dim3(D / 32, DI / 32), dim3(256), 0, stream, w_ssd_br, DI, D, WssdT, D, 1 << 30, 0, 0);
    hipLaunchKernelGGL(k_transpose, dim3(D / 32, D / 32), dim3(256), 0, stream, w_diff_br, D, D, WdiffT, D, 1 << 30, 0, 0);
    hipLaunchKernelGGL(k_transpose, dim3(D / 32, D / 32), dim3(256), 0, stream, w_o, D, D, WoT, D, 1 << 30, 0, 0);
    hipLaunchKernelGGL(k_transpose, dim3(D / 32, D / 32), dim3(256), 0, stream, w_cq, D, D, WcqT, D, 1 << 30, 0, 0);
    hipLaunchKernelGGL(k_transpose, dim3(D / 32, D / 32), dim3(256), 0, stream, w_ck, D, D, WckvT, D, 1 << 30, 0, 0);
    hipLaunchKernelGGL(k_transpose, dim3(D / 32, D / 32), dim3(256), 0, stream, w_cv, D, D, WckvT + (size_t)D * D, D, 1 << 30, 0, 0);
    hipLaunchKernelGGL(k_transpose, dim3(D / 32, D / 32), dim3(256), 0, stream, w_co, D, D, WcoT, D, 1 << 30, 0, 0);
    hipLaunchKernelGGL(k_transpose, dim3(2048 / 32, D / 32), dim3(256), 0, stream, w_pq, D, 2048, WpqT, 2048, 1 << 30, 0, 0);
    hipLaunchKernelGGL(k_cvt, dim3(2048), dim3(256), 0, stream, x, XB, (size_t)M * D / 4);
    hipLaunchKernelGGL(k_cvt, dim3(512), dim3(256), 0, stream, mem, MEMB, (size_t)BATCH * MEML * D / 4);
    hipLaunchKernelGGL(k_cvt, dim3(256), dim3(256), 0, stream, sub_keys, SUBK, (size_t)PH * 2 * PK * PHALF / 4);
    hipLaunchKernelGGL(k_dt, dim3(M / 8), dim3(256), 0, stream, x, w_in, dt_bias, DT, lam_q, lam_k, lam);
    gemm_naive(stream, MEMB, D, WckvT, BATCH * MEML, 2048, D, EpiPlain{KCVC, 2048, 1.f});

    float* YRAW = out + (size_t)SEQ * D;
    float* BCf = T1;
    float* ST = T1 + (size_t)4096 * 1024;
    for (int b = 0; b < BATCH; ++b) {
        gemm_naive(stream, XB + (size_t)b * SEQ * D, D, WinT, SEQ, NINP, D, EpiInProj{H, gate_bias});
#if USE_SSD_MFMA
        {   bf16_t* STb = (bf16_t*)T1; float* CDb = (float*)(ws + WS_CTL) + 1024;
            hipLaunchKernelGGL(k_ssdA, dim3(256), dim3(512), LDS_BYTES, stream, H, DT + (size_t)b * SEQ * 32, conv_w, conv_b, a_log, STb, CDb);
            hipLaunchKernelGGL(k_ssdScan, dim3(256), dim3(512), 0, stream, STb, CDb);
            hipLaunchKernelGGL(k_ssdC, dim3(256), dim3(512), LDS_BYTES, stream, H, DT + (size_t)b * SEQ * 32, conv_w, conv_b, a_log, d_skip, ssd_norm_w, STb); }
#else
        for (int seg = 0; seg < 2; ++seg) {
            const int t0 = seg * 4096, nt = 4096;
            hipLaunchKernelGGL(k_conv_bc, dim3(nt * 1024 / 256), dim3(256), 0, stream, H, conv_w, conv_b, BCf, t0, nt);
            hipLaunchKernelGGL(k_ssd_seq, dim3(NH), dim3(256), 0, stream, H, BCf, DT + (size_t)b * SEQ * 32, conv_w, conv_b, a_log, d_skip, ST, YRAW, t0, nt);
            hipLaunchKernelGGL(k_ssd_norm, dim3(nt), dim3(256), 0, stream, YRAW, ssd_norm_w, H, t0, nt);
        }
#endif
#if USE_ATTN_MFMA
        hipLaunchKernelGGL(k_attn_mfma, dim3(256), dim3(512), LDS_BYTES, stream, H, subln_w, lam);
#else
        hipLaunchKernelGGL(k_attn_naive, dim3(SEQ / 256, AH), dim3(256), 128 * 256 * 4, stream, H, subln_w, lam);
#endif
        gemm_naive(stream, H + HC_Z, HP_, WssdT, SEQ, D, DI, EpiGate1{H, T1});
        gemm_naive(stream, H + HC_Q, HP_, WdiffT, SEQ, D, D, EpiGate2{H, T1});
        gemm_naive(stream, H + HC_K, HP_, WoT, SEQ, D, D, EpiResid{x, out, b * SEQ, 0});
    }
    hipLaunchKernelGGL(k_ln, dim3(M / 4), dim3(256), 0, stream, out, ln1_g, ln1_b, XB, 0, M);
    hipLaunchKernelGGL(k_cvt, dim3(4096), dim3(256), 0, stream, peer_u, PU, (size_t)PK * PK * D / 4);
    hipLaunchKernelGGL(k_cvt, dim3(4096), dim3(256), 0, stream, peer_v, PV, (size_t)PK * PK * D / 4);
    gemm_naive(stream, XB, D, WcqT, M, D, D, EpiPlain{QC, D, CQSCALE});
    hipLaunchKernelGGL(k_xattn_naive, dim3(M), dim3(256), 0, stream, QC, KCVC, XO);
    gemm_naive(stream, XO, D, WcoT, M, D, D, EpiResid{out, out, 0, 0});
    hipLaunchKernelGGL(k_ln, dim3(M / 4), dim3(256), 0, stream, out, ln2_g, ln2_b, XB, 0, M);
    gemm_naive(stream, XB, D, WpqT, M, 2048, D, EpiPlain{QP, 2048, 1.f});
    hipLaunchKernelGGL(k_peer_select_naive, dim3(M), dim3(256), 0, stream, QP, SUBK, IDX, GATE);
    hipLaunchKernelGGL(k_peer_gather_naive, dim3(M), dim3(256), 0, stream, out, PU, PV, IDX, GATE, ln3_g, ln3_b);
}
```

```cpp
#include <hip/hip_runtime.h>
#include <hip/hip_cooperative_groups.h>
namespace cg = cooperative_groups;
#include <cstdio>
#include <cstdint>
#include <cmath>
#include <type_traits>

typedef unsigned short bf16_t;
typedef float f32x4 __attribute__((ext_vector_type(4)));
typedef unsigned u32x4 __attribute__((ext_vector_type(4)));
typedef unsigned u32x2 __attribute__((ext_vector_type(2)));

constexpr int D = 1024, BATCH = 2, SEQ = 8192, M = BATCH * SEQ;
constexpr int DI = 2048, NH = 32, HP = 64, NG = 4, DS = 128, DXBC = 3072;
constexpr int AH = 8, AD = 64, AV = 128;
constexpr int MEML = 256, MH = 4, MHD = 256;
constexpr int PH = 8, PK = 128, PDK = 256, PHALF = 128, PTOP = 16;
constexpr int NIN = 10272, NINP = 10240;
constexpr float ALPHA = 1.189207115002721f;
constexpr float LOG2E = 1.4426950408889634f;
constexpr float QSCALE = 0.125f * LOG2E;
constexpr float CQSCALE = 0.0625f * LOG2E;
constexpr float LAMBDA_INIT = 0.2f;
constexpr int HC_Z = 0, HC_XBC = 2048, HC_Q = 5120, HC_K = 6144, HC_V = 7168, HC_GS = 8192, HC_GA = 9216, HP_ = NINP;

constexpr size_t MiB = 1u << 20;
constexpr size_t WS_CTL = 0;
constexpr size_t WS_WIN = 1 * MiB;
constexpr size_t WS_WSSD = 21 * MiB;
constexpr size_t WS_WDIFF = 25 * MiB, WS_WO = 27 * MiB, WS_WCQ = 29 * MiB, WS_WCKV = 31 * MiB  , WS_WCO = 35 * MiB;
constexpr size_t WS_WPQ = 37 * MiB;
constexpr size_t WS_SUBK = 41 * MiB;
constexpr size_t WS_MEMB = 42 * MiB;
constexpr size_t WS_KCVC = 43 * MiB;
constexpr size_t WS_DT = 45 * MiB;
constexpr size_t WS_XB = 47 * MiB;
constexpr size_t WS_H = 79 * MiB;
constexpr size_t WS_T1 = 239 * MiB;
constexpr size_t WS_PU = 79 * MiB, WS_PV = 111 * MiB;
constexpr size_t WS_QC = 143 * MiB, WS_XO = 175 * MiB;
constexpr size_t WS_QP = 207 * MiB;
constexpr size_t WS_IDX = 143 * MiB, WS_GATE = 151 * MiB;
constexpr size_t WS_END = 271 * MiB;
constexpr int CW_LAM = 64;

__device__ __forceinline__ int opaque_tid() { int t = threadIdx.x; asm volatile("" : "+v"(t)); return t; }
__device__ __forceinline__ unsigned f2bf(float f) { unsigned u = __builtin_bit_cast(unsigned, f); return (u + 0x7fffu + ((u >> 16) & 1u)) >> 16; }
__device__ __forceinline__ float bf2f(unsigned h) { return __builtin_bit_cast(float, h << 16); }
__device__ __forceinline__ unsigned pk2(float lo, float hi) { return f2bf(lo) | (f2bf(hi) << 16); }
__device__ __forceinline__ float bflo(unsigned w) { return __builtin_bit_cast(float, w << 16); }
__device__ __forceinline__ float bfhi(unsigned w) { return __builtin_bit_cast(float, w & 0xffff0000u); }
__device__ __forceinline__ float sigmoidf_(float v) { return 1.f / (1.f + __expf(-v)); }
__device__ __forceinline__ float siluf_(float v) { return v / (1.f + __expf(-v)); }
__device__ __forceinline__ float wave_sum(float v) {
#pragma unroll
    for (int o = 1; o < 64; o <<= 1) v += __shfl_xor(v, o);
    return v;
}
__device__ __forceinline__ float wave_max(float v) {
#pragma unroll
    for (int o = 1; o < 64; o <<= 1) v = fmaxf(v, __shfl_xor(v, o));
    return v;
}

__device__ __forceinline__ void store_bf16x8(bf16_t* p, const float (&v)[8]) { u32x4 w; w.x = pk2(v[0], v[1]); w.y = pk2(v[2], v[3]); w.z = pk2(v[4], v[5]); w.w = pk2(v[6], v[7]); *(u32x4*)p = w; }
struct EpiPlain { bf16_t* O; int ldc; float scale;
    __device__ __forceinline__ void operator()(int row, int col0, const float (&v)[8]) const { float o[8];
#pragma unroll
        for (int j = 0; j < 8; ++j) o[j] = v[j] * scale; store_bf16x8(O + (size_t)row * ldc + col0, o); } };
struct EpiInProj { bf16_t* H; const float* gate_bias;
    __device__ __forceinline__ void operator()(int row, int col0, const float (&v)[8]) const { float o[8];
        if (col0 >= HC_GS) { const float* gb = gate_bias + (col0 - HC_GS);
#pragma unroll
            for (int j = 0; j < 8; ++j) o[j] = sigmoidf_(v[j] + gb[j]); }
        else { const float s = (col0 >= HC_Q && col0 < HC_K) ? QSCALE : 1.f;
#pragma unroll
            for (int j = 0; j < 8; ++j) o[j] = v[j] * s; }
        store_bf16x8(H + (size_t)row * HP_ + col0, o); } };
struct EpiGate1 { const bf16_t* H; float* T1;
    __device__ __forceinline__ void operator()(int row, int col0, const float (&v)[8]) const {
        const u32x4 g = *(const u32x4*)(H + (size_t)row * HP_ + HC_GS + col0); const unsigned gw[4] = {g.x, g.y, g.z, g.w};
        float* t = T1 + (size_t)row * D + col0;
#pragma unroll
        for (int j = 0; j < 4; ++j) { t[2 * j] = bflo(gw[j]) * v[2 * j]; t[2 * j + 1] = bfhi(gw[j]) * v[2 * j + 1]; } } };
struct EpiGate2 { bf16_t* H; const float* T1;
    __device__ __forceinline__ void operator()(int row, int col0, const float (&v)[8]) const {
        const u32x4 g = *(const u32x4*)(H + (size_t)row * HP_ + HC_GA + col0); const unsigned gw[4] = {g.x, g.y, g.z, g.w};
        const float* t = T1 + (size_t)row * D + col0; float o[8];
#pragma unroll
        for (int j = 0; j < 4; ++j) { o[2 * j] = t[2 * j] + bflo(gw[j]) * v[2 * j]; o[2 * j + 1] = t[2 * j + 1] + bfhi(gw[j]) * v[2 * j + 1]; }
        store_bf16x8(H + (size_t)row * HP_ + HC_K + col0, o); } };
struct EpiResid { const float* base; float* out; int row_off; int pad_;
    __device__ __forceinline__ void operator()(int row, int col0, const float (&v)[8]) const {
        const size_t o = (size_t)(row + row_off) * D + col0;
#pragma unroll
        for (int j = 0; j < 8; ++j) out[o + j] = ALPHA * base[o + j] + v[j]; } };


namespace pg8 {
#define PG8_LAS __attribute__((address_space(3)))
typedef short bf16x8 __attribute__((ext_vector_type(8)));
constexpr int BM = 256, BK = 64, HALF = 128, HTB = HALF * BK * 2, STAGE_BYTES = 8 * HTB, NXCD = 8, WGM = 8;
__host__ __device__ __forceinline__ int lds_byte(int r, int c) { const int st = (r >> 4) * 2 + (c >> 5), rr = r & 15, cc = c & 31, ob = rr * 64 + cc * 2; return st * 1024 + (ob ^ (((ob >> 9) & 1) << 5)); }
__host__ __device__ __forceinline__ void stage_rc(int b, int& R, int& C) { const int st = b / 1024, sb = b % 1024, swz = sb ^ (((sb >> 9) & 1) << 5); R = (st >> 1) * 16 + swz / 64; C = (st & 1) * 32 + (swz % 64) / 2; }
__host__ __device__ __forceinline__ int perm32(int rho) { const int n = rho >> 4, i = rho & 15; return 8 * (i >> 2) + 4 * n + (i & 3); }
struct Unit { int pm, pn; };
struct Gemm { const bf16_t* A; const bf16_t* Bt; int M, N, K, lda; };
struct StaticOrder {
    int nM, nN, nwg, G, c;
    __host__ __device__ void init(int M, int N, int G_, int c_) { nM = M / BM; nN = N / BM; nwg = nM * nN; G = G_; c = c_; }
    __host__ __device__ bool next(int i, Unit& u) const {
        const long L = (long)i * G + c; if (L >= nwg) return false;
        int wgid = (int)L; { const int q = nwg / NXCD, r = nwg % NXCD, xcd = wgid % NXCD, off = wgid / NXCD; wgid = (xcd < r ? xcd * (q + 1) : r * (q + 1) + (xcd - r) * q) + off; }
        const int nig = WGM * nN, gid = wgid / nig, fm = gid * WGM, gsz = (nM - fm) < WGM ? (nM - fm) : WGM;
        u.pm = fm + ((wgid % nig) % gsz); u.pn = (wgid % nig) / gsz; return true;
    }
};
template <class F> struct EpiAdapt {
    static constexpr bool PERM = true, AFTER_DRAIN = false; F f;
    __device__ __forceinline__ void operator()(const f32x4 (&acc)[2][2][4][2], const Unit& u, int wr, int wc, int fr, int fq) const {
#pragma unroll
        for (int ai = 0; ai < 2; ++ai)
#pragma unroll
            for (int m = 0; m < 4; ++m) { const int row = u.pm * BM + ai * HALF + wr * 64 + m * 16 + fr;
#pragma unroll
                for (int bj = 0; bj < 2; ++bj) { const int col0 = u.pn * BM + bj * HALF + wc * 32 + 8 * fq;
                    const f32x4 a = acc[ai][bj][m][0], b = acc[ai][bj][m][1]; const float v[8] = {a[0], a[1], a[2], a[3], b[0], b[1], b[2], b[3]};
                    f(row, col0, v); } }
    }
};
template <class Epi, class Sched, bool ALIGN_EPI>
__device__ __forceinline__ void gemm_phase(PG8_LAS unsigned char* lds, const Gemm g, const Sched& S, const Epi& E) {
    const int tid = opaque_tid(), wid = __builtin_amdgcn_readfirstlane(tid >> 6), lane = tid & 63, wr = wid >> 2, wc = wid & 3, fr = lane & 15, fq = lane >> 4;
    const int K = g.K, nt = K / BK, lda = g.lda;
    unsigned voffA[2], voffB[2];
#pragma unroll
    for (int i = 0; i < 2; ++i) { int R, C; stage_rc(tid * 16 + i * 8192, R, C); const int Rb = Epi::PERM ? ((R & ~31) + perm32(R & 31)) : R;
        voffA[i] = (unsigned)(R * lda + C) * 2u; voffB[i] = (unsigned)(Rb * K + C) * 2u; }
    const size_t kstep = (size_t)(BK * 2);
    const size_t hstepA = (size_t)HALF * lda * 2, hstepB = (size_t)HALF * K * 2;
    const size_t tstepA = 2 * hstepA, tstepB = 2 * hstepB;
    const unsigned ldsw = (unsigned)wid * 1024u;
    const int aoff = lds_byte(wr * 64 + fr, fq * 8), boff = lds_byte(wc * 32 + fr, fq * 8);
#define PG8_SA(b, h) (((b) * 2 + (h)) * HTB)
#define PG8_SB(b, h) ((4 + (b) * 2 + (h)) * HTB)
#define PG8_STAGE(bufoff, gbase, voff) do { _Pragma("unroll") for (int _i = 0; _i < 2; ++_i) \
        __builtin_amdgcn_global_load_lds((const unsigned*)((const char*)(gbase) + (voff)[_i]), (PG8_LAS unsigned*)(lds + (bufoff) + ldsw + _i * 8192), 16, 0, 0); } while (0)
#define PG8_LDA(dst, b, h) do { _Pragma("unroll") for (int m = 0; m < 4; ++m) _Pragma("unroll") for (int k = 0; k < 2; ++k) dst[m][k] = *(const PG8_LAS bf16x8*)(lds + PG8_SA(b, h) + aoff + m * 2048 + k * 1024); } while (0)
#define PG8_LDB(dst, b, h) do { _Pragma("unroll") for (int n = 0; n < 2; ++n) _Pragma("unroll") for (int k = 0; k < 2; ++k) dst[n][k] = *(const PG8_LAS bf16x8*)(lds + PG8_SB(b, h) + boff + n * 2048 + k * 1024); } while (0)
#define PG8_MMA(ai, bj, At, Bt) do { __builtin_amdgcn_s_setprio(1); _Pragma("unroll") for (int m = 0; m < 4; ++m) _Pragma("unroll") for (int n = 0; n < 2; ++n) _Pragma("unroll") for (int k = 0; k < 2; ++k) \
        acc[ai][bj][m][n] = __builtin_amdgcn_mfma_f32_16x16x32_bf16(Bt[n][k], At[m][k], acc[ai][bj][m][n], 0, 0, 0); __builtin_amdgcn_s_setprio(0); } while (0)
#define PG8_WAIT_V(n) asm volatile("s_waitcnt vmcnt(" #n ")" ::: "memory")
#define PG8_WAIT_L(n) asm volatile("s_waitcnt lgkmcnt(" #n ")" ::: "memory")
#define PG8_BAR __builtin_amdgcn_s_barrier()
#define PG8_SCHED __builtin_amdgcn_sched_barrier(0)
    Unit cur, nxt; int ui = 0;
    if (!S.next(0, cur)) return;
    f32x4 acc[2][2][4][2];
#pragma unroll
    for (int a = 0; a < 2; ++a)
#pragma unroll
        for (int b = 0; b < 2; ++b)
#pragma unroll
            for (int m = 0; m < 4; ++m)
#pragma unroll
                for (int n = 0; n < 2; ++n) acc[a][b][m][n] = (f32x4){0.f, 0.f, 0.f, 0.f};
    bf16x8 At[4][2], B0[2][2], B1[2][2];
    const char* cA = (const char*)g.A + (size_t)cur.pm * tstepA; const char* cB = (const char*)g.Bt + (size_t)cur.pn * tstepB;
    PG8_STAGE(PG8_SB(0, 0), cB, voffB); PG8_STAGE(PG8_SB(0, 1), cB + hstepB, voffB); PG8_STAGE(PG8_SA(0, 0), cA, voffA); PG8_STAGE(PG8_SA(0, 1), cA + hstepA, voffA);
    if (wr == 1) PG8_BAR;
    PG8_WAIT_V(2); PG8_BAR;
    PG8_STAGE(PG8_SB(1, 0), cB + kstep, voffB); PG8_STAGE(PG8_SA(1, 0), cA + kstep, voffA); PG8_STAGE(PG8_SB(1, 1), cB + hstepB + kstep, voffB);
    PG8_WAIT_V(6); PG8_BAR;
    for (;;) {
        const bool has_next = S.next(ui + 1, nxt);
        const char* nA = has_next ? (const char*)g.A + (size_t)nxt.pm * tstepA : cA; const char* nB = has_next ? (const char*)g.Bt + (size_t)nxt.pn * tstepB : cB;
        for (int t = 0; t < nt; t += 2) {
            const bool last = (t == nt - 2);
            const char* a1 = cA + (size_t)(t + 1) * kstep;
            const char* a2 = last ? nA : cA + (size_t)(t + 2) * kstep; const char* b2 = last ? nB : cB + (size_t)(t + 2) * kstep;
            const char* a3 = a2 + kstep; const char* b3 = b2 + kstep;
            PG8_LDB(B0, 0, 0); PG8_LDB(B1, 0, 1); PG8_SCHED; PG8_LDA(At, 0, 0); PG8_STAGE(PG8_SA(1, 1), a1 + hstepA, voffA);
            PG8_WAIT_V(8); PG8_WAIT_L(0); PG8_BAR; PG8_MMA(0, 0, At, B0); PG8_MMA(0, 1, At, B1); PG8_BAR; PG8_SCHED;
            PG8_LDA(At, 0, 1); PG8_STAGE(PG8_SB(0, 0), b2, voffB); PG8_STAGE(PG8_SB(0, 1), b2 + hstepB, voffB); PG8_STAGE(PG8_SA(0, 0), a2, voffA);
            PG8_WAIT_V(8); PG8_WAIT_L(0); PG8_BAR; PG8_MMA(1, 0, At, B0); PG8_MMA(1, 1, At, B1); PG8_BAR; PG8_SCHED;
            PG8_LDB(B0, 1, 0); PG8_LDB(B1, 1, 1); PG8_SCHED; PG8_LDA(At, 1, 0); PG8_STAGE(PG8_SA(0, 1), a2 + hstepA, voffA);
            PG8_WAIT_V(8); PG8_WAIT_L(0); PG8_BAR; PG8_MMA(0, 0, At, B0); PG8_MMA(0, 1, At, B1); PG8_BAR; PG8_SCHED;
            PG8_LDA(At, 1, 1); PG8_STAGE(PG8_SB(1, 0), b3, voffB); PG8_STAGE(PG8_SB(1, 1), b3 + hstepB, voffB); PG8_STAGE(PG8_SA(1, 0), a3, voffA);
            PG8_WAIT_V(8); PG8_WAIT_L(0); PG8_BAR; PG8_MMA(1, 0, At, B0); PG8_MMA(1, 1, At, B1); PG8_BAR; PG8_SCHED;
        }
        if constexpr (ALIGN_EPI) { if (wr == 0) PG8_BAR; }
        E(acc, cur, wr, wc, fr, fq);
        if (!has_next) break;
#pragma unroll
        for (int a = 0; a < 2; ++a)
#pragma unroll
            for (int b = 0; b < 2; ++b)
#pragma unroll
                for (int m = 0; m < 4; ++m)
#pragma unroll
                    for (int n = 0; n < 2; ++n) acc[a][b][m][n] = (f32x4){0.f, 0.f, 0.f, 0.f};
        cur = nxt; cA = nA; cB = nB; ++ui;
        if constexpr (ALIGN_EPI) { if (wr == 1) PG8_BAR; }
    }
    PG8_WAIT_V(0);
    if constexpr (!ALIGN_EPI) { if (wr == 0) PG8_BAR; }
    PG8_BAR;
#undef PG8_SA
#undef PG8_SB
#undef PG8_STAGE
#undef PG8_LDA
#undef PG8_LDB
#undef PG8_MMA
#undef PG8_WAIT_V
#undef PG8_WAIT_L
#undef PG8_BAR
#undef PG8_SCHED
}
}
constexpr int LDS_BYTES = 147456;
namespace dattn {
#define DA_LAS __attribute__((address_space(3)))
typedef short bf16x8 __attribute__((ext_vector_type(8)));
typedef short s16x4 __attribute__((ext_vector_type(4)));
typedef float f32x16 __attribute__((ext_vector_type(16)));
constexpr int KP = 272, VP = 320, KBUF = 64 * KP, VBUF = 64 * VP, BUF = KBUF + VBUF, XOFF = 2 * BUF, LDS_NEED = XOFF + 65536;
static_assert(LDS_NEED <= 147456, "attention LDS");
__device__ __forceinline__ unsigned cvtpk(float lo, float hi) { typedef float f2 __attribute__((ext_vector_type(2))); typedef __bf16 b2 __attribute__((ext_vector_type(2))); f2 v = {lo, hi}; b2 b = __builtin_convertvector(v, b2); return __builtin_bit_cast(unsigned, b); }
__device__ __forceinline__ s16x4 vtr(const DA_LAS unsigned char* p) { typedef short v4i16_t __attribute__((ext_vector_type(4))); return __builtin_bit_cast(s16x4, __builtin_amdgcn_ds_read_tr16_b64_v4i16((DA_LAS v4i16_t*)p)); }
__device__ __forceinline__ void unit(DA_LAS unsigned char* lds, bf16_t* Hb, int h, int qb, const float* __restrict__ subln_w, float lam) {
    const int tid = opaque_tid(), lane = tid & 63, w = __builtin_amdgcn_readfirstlane(tid >> 6), mp = w >> 2, rb = w & 3, c32 = lane & 31, hh = lane >> 5;
    const int qrow = 128 * qb + 32 * rb + c32;
    bf16x8 qf[4];
    { const bf16_t* qp = Hb + (size_t)qrow * HP_ + HC_Q + h * 128 + 64 * mp + 8 * hh;
#pragma unroll
      for (int s = 0; s < 4; ++s) qf[s] = *(const bf16x8*)(qp + 16 * s); }
    const int srow = tid >> 4, sch = tid & 15;
    const bf16_t* kg = Hb + HC_K + h * 128 + sch * 8; const bf16_t* vg = Hb + HC_V + h * 128 + sch * 8;
    const int nt = 2 * qb + 2;
    u32x4 kr[2], vr[2];
#define DA_LOAD(t) do { _Pragma("unroll") for (int j = 0; j < 2; ++j) { const size_t ro = (size_t)(64 * (t) + srow + 32 * j) * HP_; kr[j] = *(const u32x4*)(kg + ro); vr[j] = *(const u32x4*)(vg + ro); } } while (0)
#define DA_WRITE(buf) do { _Pragma("unroll") for (int j = 0; j < 2; ++j) { *(DA_LAS u32x4*)(lds + (buf) * BUF + (srow + 32 * j) * KP + sch * 16) = kr[j]; *(DA_LAS u32x4*)(lds + (buf) * BUF + KBUF + (srow + 32 * j) * VP + sch * 16) = vr[j]; } } while (0)
    DA_LOAD(0); DA_WRITE(0);
    __syncthreads();
    f32x16 oT[4];
#pragma unroll
    for (int i = 0; i < 4; ++i) oT[i] = (f32x16){0.f, 0.f, 0.f, 0.f, 0.f, 0.f, 0.f, 0.f, 0.f, 0.f, 0.f, 0.f, 0.f, 0.f, 0.f, 0.f};
    float mrow = -INFINITY, lrow = 0.f;
    const int koff = c32 * KP + (64 * mp + 8 * hh) * 2;
    const int voff = KBUF + (4 * hh + ((lane & 15) >> 2)) * VP + (16 * ((lane >> 4) & 1) + 4 * (lane & 3)) * 2;
    for (int t = 0; t < nt; ++t) {
        const int cur = t & 1;
        if (t + 1 < nt) DA_LOAD(t + 1);
        if (!(t == nt - 1 && rb <= 1)) {
            const DA_LAS unsigned char* kb = lds + cur * BUF + koff;
            f32x16 s0 = (f32x16){0.f, 0.f, 0.f, 0.f, 0.f, 0.f, 0.f, 0.f, 0.f, 0.f, 0.f, 0.f, 0.f, 0.f, 0.f, 0.f}, s1 = s0;
#pragma unroll
            for (int s = 0; s < 4; ++s) {
                const bf16x8 a0 = *(const DA_LAS bf16x8*)(kb + s * 32), a1 = *(const DA_LAS bf16x8*)(kb + 32 * KP + s * 32);
                s0 = __builtin_amdgcn_mfma_f32_32x32x16_bf16(a0, qf[s], s0, 0, 0, 0);
                s1 = __builtin_amdgcn_mfma_f32_32x32x16_bf16(a1, qf[s], s1, 0, 0, 0);
            }
            if (t >= nt - 2) {
                const int k0 = 64 * t + 4 * hh;
#pragma unroll
                for (int r = 0; r < 16; ++r) { const int key = k0 + (r & 3) + 8 * (r >> 2); if (key > qrow) s0[r] = -INFINITY; if (key + 32 > qrow) s1[r] = -INFINITY; }
            }
            float mx = fmaxf(s0[0], s1[0]);
#pragma unroll
            for (int r = 1; r < 16; ++r) mx = fmaxf(mx, fmaxf(s0[r], s1[r]));
            mx = fmaxf(mx, __shfl_xor(mx, 32));
            const float mnew = fmaxf(mrow, mx), alpha = __builtin_amdgcn_exp2f(mrow - mnew);
            mrow = mnew;
            float ps = 0.f;
#pragma unroll
            for (int r = 0; r < 16; ++r) { s0[r] = __builtin_amdgcn_exp2f(s0[r] - mnew); s1[r] = __builtin_amdgcn_exp2f(s1[r] - mnew); ps += s0[r] + s1[r]; }
            lrow = lrow * alpha + ps;
#pragma unroll
            for (int i = 0; i < 4; ++i)
#pragma unroll
                for (int r = 0; r < 16; ++r) oT[i][r] *= alpha;
            bf16x8 pf[2][2];
#pragma unroll
            for (int s = 0; s < 2; ++s) {
                u32x4 a, b;
                a.x = cvtpk(s0[8 * s], s0[8 * s + 1]); a.y = cvtpk(s0[8 * s + 2], s0[8 * s + 3]); a.z = cvtpk(s0[8 * s + 4], s0[8 * s + 5]); a.w = cvtpk(s0[8 * s + 6], s0[8 * s + 7]);
                b.x = cvtpk(s1[8 * s], s1[8 * s + 1]); b.y = cvtpk(s1[8 * s + 2], s1[8 * s + 3]); b.z = cvtpk(s1[8 * s + 4], s1[8 * s + 5]); b.w = cvtpk(s1[8 * s + 6], s1[8 * s + 7]);
                pf[0][s] = __builtin_bit_cast(bf16x8, a); pf[1][s] = __builtin_bit_cast(bf16x8, b);
            }
            const DA_LAS unsigned char* vb = lds + cur * BUF + voff;
#pragma unroll
            for (int db = 0; db < 4; ++db)
#pragma unroll
                for (int t2 = 0; t2 < 2; ++t2)
#pragma unroll
                    for (int s = 0; s < 2; ++s) {
                        const s16x4 lo = vtr(vb + (32 * t2 + 16 * s) * VP + db * 64), hi = vtr(vb + (32 * t2 + 16 * s + 8) * VP + db * 64);
                        const bf16x8 vf = (bf16x8){lo[0], lo[1], lo[2], lo[3], hi[0], hi[1], hi[2], hi[3]};
                        oT[db] = __builtin_amdgcn_mfma_f32_32x32x16_bf16(vf, pf[t2][s], oT[db], 0, 0, 0);
                    }
        }
        if (t + 1 < nt) DA_WRITE(cur ^ 1);
        __syncthreads();
    }
#undef DA_LOAD
#undef DA_WRITE
    const float inv = 1.f / (lrow + __shfl_xor(lrow, 32));
    DA_LAS float* X = (DA_LAS float*)(lds + XOFF) + rb * 4096 + lane;
    if (mp == 1) {
#pragma unroll
        for (int i = 0; i < 4; ++i)
#pragma unroll
            for (int r = 0; r < 16; ++r) X[(i * 16 + r) * 64] = oT[i][r] * inv;
    }
    __syncthreads();
    if (mp == 0) {
        float ss = 0.f;
#pragma unroll
        for (int i = 0; i < 4; ++i)
#pragma unroll
            for (int r = 0; r < 16; ++r) { const float o = oT[i][r] * inv - lam * X[(i * 16 + r) * 64]; oT[i][r] = o; ss += o * o; }
        ss += __shfl_xor(ss, 32);
        const float rr = rsqrtf(ss * (1.f / 128.f) + 1e-5f) * (1.f - LAMBDA_INIT);
        bf16_t* op = Hb + (size_t)qrow * HP_ + HC_Q + h * 128 + 4 * hh;
#pragma unroll
        for (int i = 0; i < 4; ++i)
#pragma unroll
            for (int g = 0; g < 4; ++g) { const int d0 = 32 * i + 8 * g; const f32x4 sw = *(const f32x4*)(subln_w + d0 + 4 * hh);
                uint2 o; o.x = pk2(oT[i][4 * g] * rr * sw.x, oT[i][4 * g + 1] * rr * sw.y); o.y = pk2(oT[i][4 * g + 2] * rr * sw.z, oT[i][4 * g + 3] * rr * sw.w);
                *(uint2*)(op + d0) = o; }
    }
    __syncthreads();
}
}
namespace ssd {
#define SS_LAS __attribute__((address_space(3)))
typedef short bf16x8 __attribute__((ext_vector_type(8)));
typedef short s16x4 __attribute__((ext_vector_type(4)));
typedef float f32x16 __attribute__((ext_vector_type(16)));
constexpr int XP = 192;
constexpr int BPT = 320;
constexpr int CP = 272;
__device__ __forceinline__ s16x4 vtr(const SS_LAS unsigned char* p) { typedef short v4i16_t __attribute__((ext_vector_type(4))); return __builtin_bit_cast(s16x4, __builtin_amdgcn_ds_read_tr16_b64_v4i16((SS_LAS v4i16_t*)p)); }
__device__ __forceinline__ unsigned cvtpk(float lo, float hi) { typedef float f2 __attribute__((ext_vector_type(2))); typedef __bf16 b2 __attribute__((ext_vector_type(2))); f2 v = {lo, hi}; b2 b = __builtin_convertvector(v, b2); return __builtin_bit_cast(unsigned, b); }
__device__ __forceinline__ void acs_tables(SS_LAS float* ACS, SS_LAS float* DTS, const float* __restrict__ DTb, const float* __restrict__ a_log, int c, int g) {
    const int tid_ = opaque_tid(); const int lane = tid_ & 63, e = __builtin_amdgcn_readfirstlane(tid_ >> 6), h = 8 * g + e;
    const float a = -expf(a_log[h]);
    const float d0 = DTb[(size_t)(128 * c + 2 * lane) * 32 + h], d1 = DTb[(size_t)(128 * c + 2 * lane + 1) * 32 + h];
    const float a0 = d0 * a, a1 = d1 * a;
    float sc = a0 + a1;
#pragma unroll
    for (int o = 1; o < 64; o <<= 1) { const float v = __shfl_up(sc, o); if (lane >= o) sc += v; }
    const float ex = sc - (a0 + a1);
    ACS[(2 * lane) * 8 + e] = ex + a0; ACS[(2 * lane + 1) * 8 + e] = ex + a0 + a1;
    DTS[(2 * lane) * 8 + e] = d0; DTS[(2 * lane + 1) * 8 + e] = d1;
}
template <class F> __device__ __forceinline__ void conv_item(const bf16_t* __restrict__ Hb, int t0, int l0, int xch0, const float* __restrict__ conv_w, const float* __restrict__ conv_b, F sink) {
    float w[4][8], bias[8];
#pragma unroll
    for (int j = 0; j < 4; ++j) { const f32x4 a = *(const f32x4*)(conv_w + j * DXBC + xch0), b = *(const f32x4*)(conv_w + j * DXBC + xch0 + 4); w[j][0] = a.x; w[j][1] = a.y; w[j][2] = a.z; w[j][3] = a.w; w[j][4] = b.x; w[j][5] = b.y; w[j][6] = b.z; w[j][7] = b.w; }
    { const f32x4 a = *(const f32x4*)(conv_b + xch0), b = *(const f32x4*)(conv_b + xch0 + 4); bias[0] = a.x; bias[1] = a.y; bias[2] = a.z; bias[3] = a.w; bias[4] = b.x; bias[5] = b.y; bias[6] = b.z; bias[7] = b.w; }
    float x0[8], x1[8], x2[8];
    const bf16_t* src = Hb + HC_XBC + xch0;
#define SS_ROW(dst, tt) do { u32x4 q_ = (u32x4){0u, 0u, 0u, 0u}; if ((tt) >= 0) q_ = *(const u32x4*)(src + (size_t)(tt) * HP_); dst[0] = bflo(q_.x); dst[1] = bfhi(q_.x); dst[2] = bflo(q_.y); dst[3] = bfhi(q_.y); dst[4] = bflo(q_.z); dst[5] = bfhi(q_.z); dst[6] = bflo(q_.w); dst[7] = bfhi(q_.w); } while (0)
    SS_ROW(x0, t0 + l0 - 3); SS_ROW(x1, t0 + l0 - 2); SS_ROW(x2, t0 + l0 - 1);
#pragma unroll
    for (int i = 0; i < 16; ++i) {
        float x3[8]; SS_ROW(x3, t0 + l0 + i);
        float v[8];
#pragma unroll
        for (int k = 0; k < 8; ++k) { const float a = bias[k] + w[0][k] * x0[k] + w[1][k] * x1[k] + w[2][k] * x2[k] + w[3][k] * x3[k]; v[k] = a / (1.f + __expf(-a)); x0[k] = x1[k]; x1[k] = x2[k]; x2[k] = x3[k]; }
        sink(l0 + i, v);
    }
#undef SS_ROW
}
constexpr int A_BS = 0, A_XD = 128 * BPT  , A_ACS = A_XD + 2 * 128 * XP  , A_DTS = A_ACS + 4096, A_END = A_DTS + 4096;
__device__ __forceinline__ void phaseA_unit(SS_LAS unsigned char* lds, const bf16_t* __restrict__ Hb, const float* __restrict__ DTb, const float* __restrict__ conv_w, const float* __restrict__ conv_b,
                                            const float* __restrict__ a_log, bf16_t* __restrict__ ST, float* __restrict__ CD, int c, int g) {
    const int tid = opaque_tid(), lane = tid & 63, w = __builtin_amdgcn_readfirstlane(tid >> 6), c32 = lane & 31, hh = lane >> 5;
    SS_LAS float* ACS = (SS_LAS float*)(lds + A_ACS); SS_LAS float* DTS = (SS_LAS float*)(lds + A_DTS);
    acs_tables(ACS, DTS, DTb, a_log, c, g);
    __syncthreads();
    if (tid < 8) CD[c * 32 + 8 * g + tid] = __expf(ACS[127 * 8 + tid]);
    auto stageX = [&](int e, int item, int buf) {
        const int cg = item >> 3, seg = item & 7; const float aend = ACS[127 * 8 + e];
        conv_item(Hb, 128 * c, 16 * seg, g * 512 + e * 64 + cg * 8, conv_w, conv_b, [&](int l, const float (&v)[8]) {
            const float sc = DTS[l * 8 + e] * __expf(aend - ACS[l * 8 + e]);
            u32x4 o; o.x = cvtpk(v[0] * sc, v[1] * sc); o.y = cvtpk(v[2] * sc, v[3] * sc); o.z = cvtpk(v[4] * sc, v[5] * sc); o.w = cvtpk(v[6] * sc, v[7] * sc);
            *(SS_LAS u32x4*)(lds + A_XD + buf * 128 * XP + l * XP + cg * 16) = o; });
    };
    if (tid < 128) { const int cg = tid >> 3, seg = tid & 7;
        conv_item(Hb, 128 * c, 16 * seg, 2048 + g * 128 + cg * 8, conv_w, conv_b, [&](int l, const float (&v)[8]) {
            u32x4 o; o.x = cvtpk(v[0], v[1]); o.y = cvtpk(v[2], v[3]); o.z = cvtpk(v[4], v[5]); o.w = cvtpk(v[6], v[7]);
            *(SS_LAS u32x4*)(lds + A_BS + l * BPT + cg * 16) = o; });
    } else if (tid < 192) stageX(0, tid - 128, 0);
    __syncthreads();
    const int pb = w & 1, nb = w >> 1;
    const int rsel = ((lane & 15) >> 2), csel = 16 * ((lane >> 4) & 1) + 4 * (lane & 3);
    for (int e = 0; e < 8; ++e) {
        if (e + 1 < 8 && tid >= 448) stageX(e + 1, tid - 448, (e + 1) & 1);
        f32x16 acc = (f32x16){0.f, 0.f, 0.f, 0.f, 0.f, 0.f, 0.f, 0.f, 0.f, 0.f, 0.f, 0.f, 0.f, 0.f, 0.f, 0.f};
        const SS_LAS unsigned char* bp = lds + A_BS + (8 * hh + rsel) * BPT + (32 * nb + csel) * 2;
        const SS_LAS unsigned char* xp = lds + A_XD + (e & 1) * 128 * XP + (8 * hh + rsel) * XP + (32 * pb + csel) * 2;
#pragma unroll
        for (int ks = 0; ks < 8; ++ks) {
            const s16x4 b0 = vtr(bp + (16 * ks) * BPT), b1 = vtr(bp + (16 * ks + 4) * BPT), x0 = vtr(xp + (16 * ks) * XP), x1 = vtr(xp + (16 * ks + 4) * XP);
            const bf16x8 bf = (bf16x8){b0[0], b0[1], b0[2], b0[3], b1[0], b1[1], b1[2], b1[3]}, xf = (bf16x8){x0[0], x0[1], x0[2], x0[3], x1[0], x1[1], x1[2], x1[3]};
            acc = __builtin_amdgcn_mfma_f32_32x32x16_bf16(bf, xf, acc, 0, 0, 0);
        }
        bf16_t* sp = ST + ((size_t)(c * 32 + 8 * g + e) * 64 + 32 * pb + c32) * 128 + 32 * nb + 4 * hh;
#pragma unroll
        for (int q = 0; q < 4; ++q) { uint2 o; o.x = cvtpk(acc[4 * q], acc[4 * q + 1]); o.y = cvtpk(acc[4 * q + 2], acc[4 * q + 3]); *(uint2*)(sp + 8 * q) = o; }
        __syncthreads();
    }
}
__device__ __forceinline__ void scan_phase(bf16_t* __restrict__ ST, const float* __restrict__ CD, int gtid) {
    const int h = gtid >> 12;
    unsigned* p = (unsigned*)ST + gtid;
    float r0 = 0.f, r1 = 0.f;
    for (int c0 = 0; c0 < 64; c0 += 16) {
        unsigned v[16]; float d[16];
#pragma unroll
        for (int i = 0; i < 16; ++i) { v[i] = p[(size_t)(c0 + i) * 131072]; d[i] = CD[(c0 + i) * 32 + h]; }
#pragma unroll
        for (int i = 0; i < 16; ++i) { p[(size_t)(c0 + i) * 131072] = cvtpk(r0, r1); r0 = r0 * d[i] + bflo(v[i]); r1 = r1 * d[i] + bfhi(v[i]); }
    }
}
constexpr int C_CS = 0, C_BS = 128 * CP  , C_X1 = C_BS  , C_CBT = 2 * 128 * CP  , C_X0 = C_CBT + 32768  , C_ACS = C_X0 + 128 * XP  , C_DTS = C_ACS + 4096,
              C_SSQ = C_DTS + 4096, C_END = C_SSQ + 1024;
static_assert(C_END <= 147456 && 128 * XP <= 128 * CP, "ssd phase C LDS");
__device__ __forceinline__ void phaseC_unit(SS_LAS unsigned char* lds, bf16_t* __restrict__ Hb, const float* __restrict__ DTb, const float* __restrict__ conv_w, const float* __restrict__ conv_b,
                                            const float* __restrict__ a_log, const float* __restrict__ d_skip, const float* __restrict__ norm_w, const bf16_t* __restrict__ ST, int c, int g) {
    const int tid = opaque_tid(), lane = tid & 63, w = __builtin_amdgcn_readfirstlane(tid >> 6), c32 = lane & 31, hh = lane >> 5;
    SS_LAS float* ACS = (SS_LAS float*)(lds + C_ACS); SS_LAS float* DTS = (SS_LAS float*)(lds + C_DTS); SS_LAS float* SSQ = (SS_LAS float*)(lds + C_SSQ);
    acs_tables(ACS, DTS, DTb, a_log, c, g);
    auto stageX = [&](int e, int item, int buf) {
        const int cg = item >> 3, seg = item & 7;
        conv_item(Hb, 128 * c, 16 * seg, g * 512 + e * 64 + cg * 8, conv_w, conv_b, [&](int l, const float (&v)[8]) {
            u32x4 o; o.x = cvtpk(v[0], v[1]); o.y = cvtpk(v[2], v[3]); o.z = cvtpk(v[4], v[5]); o.w = cvtpk(v[6], v[7]);
            *(SS_LAS u32x4*)(lds + (buf ? C_X1 : C_X0) + l * XP + cg * 16) = o; });
    };
    if (tid < 256) { const int isC = tid >> 7, it = tid & 127, cg = it >> 3, seg = it & 7;
        conv_item(Hb, 128 * c, 16 * seg, 2048 + isC * 512 + g * 128 + cg * 8, conv_w, conv_b, [&](int l, const float (&v)[8]) {
            u32x4 o; o.x = cvtpk(v[0], v[1]); o.y = cvtpk(v[2], v[3]); o.z = cvtpk(v[4], v[5]); o.w = cvtpk(v[6], v[7]);
            *(SS_LAS u32x4*)(lds + (isC ? C_CS : C_BS) + l * CP + cg * 16) = o; });
    } else if (tid < 320) stageX(0, tid - 256, 0);
    __syncthreads();
    for (int i = w; i < 10; i += 8) {
        const int sb = (i < 4) ? 0 : (i < 7) ? 1 : (i < 9) ? 2 : 3, lb = (i < 4) ? i : (i < 7) ? i - 3 : (i < 9) ? i - 5 : 3;
        f32x16 acc = (f32x16){0.f, 0.f, 0.f, 0.f, 0.f, 0.f, 0.f, 0.f, 0.f, 0.f, 0.f, 0.f, 0.f, 0.f, 0.f, 0.f};
        const SS_LAS unsigned char* bp = lds + C_BS + (32 * sb + c32) * CP + 16 * hh, *cp = lds + C_CS + (32 * lb + c32) * CP + 16 * hh;
#pragma unroll
        for (int ks = 0; ks < 8; ++ks) acc = __builtin_amdgcn_mfma_f32_32x32x16_bf16(*(const SS_LAS bf16x8*)(bp + 32 * ks), *(const SS_LAS bf16x8*)(cp + 32 * ks), acc, 0, 0, 0);
        SS_LAS unsigned* o = (SS_LAS unsigned*)(lds + C_CBT) + (sb * 4 + lb) * 512 + lane;
#pragma unroll
        for (int q = 0; q < 8; ++q) o[q * 64] = cvtpk(acc[2 * q], acc[2 * q + 1]);
    }
    __syncthreads();
    const int pb = w & 1, lb = w >> 1, lrow = 32 * lb + c32;
    const int rsel = ((lane & 15) >> 2), csel = 16 * ((lane >> 4) & 1) + 4 * (lane & 3);
    unsigned ypk[8][8];
    float ssq = 0.f;
    for (int e = 0; e < 8; ++e) {
        const int h = 8 * g + e;
        if (e + 1 < 8 && tid >= 448) stageX(e + 1, tid - 448, (e + 1) & 1);
        const int xoff = (e & 1) ? C_X1 : C_X0;
        f32x16 acc = (f32x16){0.f, 0.f, 0.f, 0.f, 0.f, 0.f, 0.f, 0.f, 0.f, 0.f, 0.f, 0.f, 0.f, 0.f, 0.f, 0.f};
        {
            const bf16_t* pp = ST + ((size_t)(c * 32 + h) * 64 + 32 * pb + c32) * 128 + 8 * hh;
            const SS_LAS unsigned char* cp = lds + C_CS + lrow * CP + 16 * hh;
#pragma unroll
            for (int ks = 0; ks < 8; ++ks) acc = __builtin_amdgcn_mfma_f32_32x32x16_bf16(*(const bf16x8*)(pp + 16 * ks), *(const SS_LAS bf16x8*)(cp + 32 * ks), acc, 0, 0, 0);
        }
        const float al = ACS[lrow * 8 + e], eal = __expf(al);
#pragma unroll
        for (int r = 0; r < 16; ++r) acc[r] *= eal;
        for (int sb = 0; sb <= lb; ++sb) {
            const SS_LAS unsigned* cbp = (const SS_LAS unsigned*)(lds + C_CBT) + (sb * 4 + lb) * 512 + lane;
            float m[16];
#pragma unroll
            for (int q = 0; q < 8; ++q) { const unsigned u = cbp[q * 64]; m[2 * q] = bflo(u); m[2 * q + 1] = bfhi(u); }
#pragma unroll
            for (int r = 0; r < 16; ++r) { const int srow = 32 * sb + (r & 3) + 8 * (r >> 2) + 4 * hh;
                const float f = __expf(al - ACS[srow * 8 + e]) * DTS[srow * 8 + e];
                m[r] = (srow <= lrow) ? m[r] * f : 0.f; }
            const SS_LAS unsigned char* xp = lds + xoff + (32 * sb + 4 * hh + rsel) * XP + (32 * pb + csel) * 2;
#pragma unroll
            for (int ks = 0; ks < 2; ++ks) {
                const s16x4 x0 = vtr(xp + (16 * ks) * XP), x1 = vtr(xp + (16 * ks + 8) * XP);
                const bf16x8 xf = (bf16x8){x0[0], x0[1], x0[2], x0[3], x1[0], x1[1], x1[2], x1[3]};
                u32x4 mm; mm.x = cvtpk(m[8 * ks], m[8 * ks + 1]); mm.y = cvtpk(m[8 * ks + 2], m[8 * ks + 3]); mm.z = cvtpk(m[8 * ks + 4], m[8 * ks + 5]); mm.w = cvtpk(m[8 * ks + 6], m[8 * ks + 7]);
                acc = __builtin_amdgcn_mfma_f32_32x32x16_bf16(xf, __builtin_bit_cast(bf16x8, mm), acc, 0, 0, 0);
            }
        }
        const float dsk = d_skip[h];
        const bf16_t* zp = Hb + (size_t)(128 * c + lrow) * HP_ + HC_Z + g * 512 + e * 64 + 32 * pb + 4 * hh;
        const SS_LAS unsigned char* xr = lds + xoff + lrow * XP + (32 * pb + 4 * hh) * 2;
        unsigned yt[8];
#pragma unroll
        for (int q = 0; q < 4; ++q) {
            const u32x2 zz = *(const u32x2*)(zp + 8 * q); const u32x2 xx = *(const SS_LAS u32x2*)(xr + 16 * q);
            const float zv[4] = {bflo(zz.x), bfhi(zz.x), bflo(zz.y), bfhi(zz.y)}, xv[4] = {bflo(xx.x), bfhi(xx.x), bflo(xx.y), bfhi(xx.y)};
            float y[4];
#pragma unroll
            for (int k = 0; k < 4; ++k) { y[k] = (acc[4 * q + k] + dsk * xv[k]) * (zv[k] / (1.f + __expf(-zv[k]))); ssq += y[k] * y[k]; }
            yt[2 * q] = cvtpk(y[0], y[1]); yt[2 * q + 1] = cvtpk(y[2], y[3]);
        }
#define SS_YSET(E) case E: { _Pragma("unroll") for (int q_ = 0; q_ < 8; ++q_) ypk[E][q_] = yt[q_]; } break;
        switch (e) { SS_YSET(0) SS_YSET(1) SS_YSET(2) SS_YSET(3) SS_YSET(4) SS_YSET(5) SS_YSET(6) default: { _Pragma("unroll") for (int q_ = 0; q_ < 8; ++q_) ypk[7][q_] = yt[q_]; } break; }
#undef SS_YSET
        __syncthreads();
    }
    ssq += __shfl_xor(ssq, 32);
    if (hh == 0) SSQ[pb * 128 + lrow] = ssq;
    __syncthreads();
    const float rstd = rsqrtf((SSQ[lrow] + SSQ[128 + lrow]) * (1.f / 512.f) + 1e-5f);
    bf16_t* op = Hb + (size_t)(128 * c + lrow) * HP_ + HC_Z + g * 512 + 32 * pb + 4 * hh;
    const float* nw = norm_w + g * 512 + 32 * pb + 4 * hh;
#pragma unroll
    for (int e = 0; e < 8; ++e)
#pragma unroll
        for (int q = 0; q < 4; ++q) { const f32x4 n4 = *(const f32x4*)(nw + e * 64 + 8 * q);
            uint2 o; o.x = cvtpk(bflo(ypk[e][2 * q]) * rstd * n4.x, bfhi(ypk[e][2 * q]) * rstd * n4.y); o.y = cvtpk(bflo(ypk[e][2 * q + 1]) * rstd * n4.z, bfhi(ypk[e][2 * q + 1]) * rstd * n4.w);
            *(uint2*)(op + e * 64 + 8 * q) = o; }
    __syncthreads();
}
}

namespace sp {
#define SP_LAS __attribute__((address_space(3)))
#define SP_LDSWAIT() do { asm volatile("s_waitcnt lgkmcnt(0)" ::: "memory"); } while (0)
__device__ __forceinline__ void transpose_item(const float* __restrict__ W, int ldw, int col0, int K, int nblk, bf16_t* __restrict__ WT, int row_off, SP_LAS float* scr, int item, int lane) {
    const int kb = item / nblk, nb = item % nblk, k0 = 64 * kb, n0 = 32 * nb;
#pragma unroll 8
    for (int i = 0; i < 32; ++i) { const int kk = 2 * i + (lane >> 5); scr[kk * 33 + (lane & 31)] = W[(size_t)(k0 + kk) * ldw + col0 + n0 + (lane & 31)]; }
    SP_LDSWAIT();
    const int cc = lane & 7;
#pragma unroll
    for (int j = 0; j < 4; ++j) { const int n = (lane >> 3) + 8 * j; const SP_LAS float* s = scr + (8 * cc) * 33 + n;
        u32x4 o; o.x = pk2(s[0 * 33], s[1 * 33]); o.y = pk2(s[2 * 33], s[3 * 33]); o.z = pk2(s[4 * 33], s[5 * 33]); o.w = pk2(s[6 * 33], s[7 * 33]);
        *(u32x4*)(WT + (size_t)(row_off + n0 + n) * K + k0 + 8 * cc) = o; }
    SP_LDSWAIT();
}
__device__ __forceinline__ void cvt_range(const float* __restrict__ src, bf16_t* __restrict__ dst, size_t n4, size_t gtid, size_t gthreads) {
    for (size_t i = gtid; i < n4; i += gthreads) { const f32x4 v = ((const f32x4*)src)[i]; u32x2 o; o.x = pk2(v.x, v.y); o.y = pk2(v.z, v.w); ((u32x2*)dst)[i] = o; }
}
__device__ __forceinline__ void dt_item(SP_LAS float* xs, const float* __restrict__ x, const float* __restrict__ w_in, const float* __restrict__ dt_bias, float* __restrict__ DT, int item) {
    const int tid = opaque_tid(), m0 = item * 16;
    for (int i = tid; i < 16 * 256; i += 512) { const f32x4 v = ((const f32x4*)(x + (size_t)m0 * D))[i]; *(SP_LAS f32x4*)(xs + 4 * i) = v; }
    __syncthreads();
    const int h = tid & 31, r = tid >> 5; float acc = 0.f;
    const float* wp = w_in + 5120 + h;
#pragma unroll 8
    for (int k = 0; k < 1024; ++k) acc = fmaf(xs[r * 1024 + k], wp[(size_t)k * NIN], acc);
    const float v = acc + dt_bias[h];
    DT[(size_t)(m0 + r) * 32 + h] = v > 20.f ? v : log1pf(expf(v));
    __syncthreads();
}
__device__ __forceinline__ void ln_row(float* __restrict__ X, const float* __restrict__ g, const float* __restrict__ b, bf16_t* __restrict__ XB, int row, int lane) {
    f32x4* xr = (f32x4*)(X + (size_t)row * D) + lane;
    f32x4 v[4]; float s = 0.f;
#pragma unroll
    for (int j = 0; j < 4; ++j) { v[j] = xr[64 * j]; s += (v[j].x + v[j].y) + (v[j].z + v[j].w); }
    const float mean = wave_sum(s) * (1.f / D); float s2 = 0.f;
#pragma unroll
    for (int j = 0; j < 4; ++j) { v[j] = v[j] - mean; s2 += (v[j].x * v[j].x + v[j].y * v[j].y) + (v[j].z * v[j].z + v[j].w * v[j].w); }
    const float rstd = rsqrtf(wave_sum(s2) * (1.f / D) + 1e-5f);
#pragma unroll
    for (int j = 0; j < 4; ++j) { const int c = 4 * lane + 256 * j; const f32x4 gg = *(const f32x4*)(g + c), bb = *(const f32x4*)(b + c);
        f32x4 o = v[j] * rstd * gg + bb; xr[64 * j] = o;
        u32x2 pb; pb.x = pk2(o.x, o.y); pb.y = pk2(o.z, o.w); *(u32x2*)(XB + (size_t)row * D + c) = pb; }
}
__device__ __forceinline__ void xattn_pair(SP_LAS float* L, const bf16_t* __restrict__ QC, const bf16_t* __restrict__ KCVC, bf16_t* __restrict__ XO, int tok0) {
    const int t512 = opaque_tid(); const int half = t512 >> 8, tid = t512 & 255, lane = tid & 63, wv = tid >> 6, tok = tok0 + half, b = tok / SEQ;
    SP_LAS float* qs = L + half * 1024; SP_LAS float* ps = L + 2048 + half * 256; SP_LAS float* red = L + 2560 + half * 8;
    for (int i = tid; i < 1024; i += 256) qs[i] = bf2f(QC[(size_t)tok * D + i]);
    __syncthreads();
    const bf16_t* KV = KCVC + (size_t)b * MEML * 2048;
    for (int h = 0; h < MH; ++h) {
        const bf16_t* kp = KV + (size_t)tid * 2048 + h * 256;
        float s = 0.f;
        for (int d = 0; d < 256; d += 8) { const u32x4 w = *(const u32x4*)(kp + d); const SP_LAS float* q = qs + h * 256 + d;
            s += q[0] * bflo(w.x) + q[1] * bfhi(w.x) + q[2] * bflo(w.y) + q[3] * bfhi(w.y) + q[4] * bflo(w.z) + q[5] * bfhi(w.z) + q[6] * bflo(w.w) + q[7] * bfhi(w.w); }
        float mx = wave_max(s); if (lane == 0) red[wv] = mx; __syncthreads();
        mx = fmaxf(fmaxf(red[0], red[1]), fmaxf(red[2], red[3]));
        const float p = exp2f(s - mx);
        float sm = wave_sum(p); if (lane == 0) red[4 + wv] = sm; ps[tid] = p; __syncthreads();
        sm = (red[4] + red[5]) + (red[6] + red[7]);
        float o = 0.f;
        for (int j = 0; j < 256; ++j) o = fmaf(ps[j], bf2f(KV[(size_t)j * 2048 + 1024 + h * 256 + tid]), o);
        XO[(size_t)tok * D + h * 256 + tid] = (bf16_t)f2bf(o / sm);
        __syncthreads();
    }
}
__device__ __forceinline__ void select_pair(SP_LAS float* L, const bf16_t* __restrict__ QP, const bf16_t* __restrict__ SUBK, int* __restrict__ IDX, float* __restrict__ GATE, int tok0) {
    const int t512 = opaque_tid(); const int hf = t512 >> 8, tid = t512 & 255, tok = tok0 + hf;
    SP_LAS float* base = L + hf * 3072;
    SP_LAS float* qs = base; SP_LAS float* s = base + 2048; SP_LAS float* tops = base + 2304; SP_LAS int* topi = (SP_LAS int*)(base + 2336); SP_LAS float* cs = base + 2368; SP_LAS int* ci = (SP_LAS int*)(base + 2624);
    SP_LAS float* bs = base + 2880; SP_LAS int* bi = (SP_LAS int*)(base + 2896);
    for (int i = tid; i < 2048; i += 256) qs[i] = bf2f(QP[(size_t)tok * 2048 + i]);
    __syncthreads();
    for (int h = 0; h < PH; ++h) {
        const int half = tid >> 7, key = tid & 127;
        { const bf16_t* kp = SUBK + ((size_t)(h * 2 + half) * 128 + key) * 128; const SP_LAS float* q = qs + h * 256 + half * 128; float a = 0.f;
          for (int d = 0; d < 128; d += 8) { const u32x4 w = *(const u32x4*)(kp + d);
              a += q[d] * bflo(w.x) + q[d + 1] * bfhi(w.x) + q[d + 2] * bflo(w.y) + q[d + 3] * bfhi(w.y) + q[d + 4] * bflo(w.z) + q[d + 5] * bfhi(w.z) + q[d + 6] * bflo(w.w) + q[d + 7] * bfhi(w.w); }
          s[tid] = a; }
        __syncthreads();
        { const float me = s[tid]; int rank = 0; const SP_LAS float* spp = s + half * 128;
          for (int j = 0; j < 128; ++j) { const float o = spp[j]; rank += (o > me || (o == me && j < key)) ? 1 : 0; }
          if (rank < 16) { tops[half * 16 + rank] = me; topi[half * 16 + rank] = key; } }
        __syncthreads();
        { const int i = tid >> 4, j = tid & 15; cs[tid] = tops[i] + tops[16 + j]; ci[tid] = topi[i] * 128 + topi[16 + j]; }
        __syncthreads();
        { const float me = cs[tid]; int rank = 0;
          for (int j = 0; j < 256; ++j) { const float o = cs[j]; rank += (o > me || (o == me && j < tid)) ? 1 : 0; }
          if (rank < 16) { bs[rank] = me; bi[rank] = ci[tid]; } }
        __syncthreads();
        if (tid < 16) { const float mx = bs[0]; float sum = 0.f;
            for (int j = 0; j < 16; ++j) sum += expf(bs[j] - mx);
            GATE[(size_t)tok * 128 + h * 16 + tid] = expf(bs[tid] - mx) / sum; IDX[(size_t)tok * 128 + h * 16 + tid] = bi[tid]; }
        __syncthreads();
    }
}
__device__ __forceinline__ void gather_token(SP_LAS float* L, float* __restrict__ X, const bf16_t* __restrict__ PU, const bf16_t* __restrict__ PV, const int* __restrict__ IDX, const float* __restrict__ GATE,
                                             const float* __restrict__ g3, const float* __restrict__ b3, int tok) {
    const int tid = opaque_tid(), lane = tid & 63, wv = tid >> 6;
    SP_LAS float* ys = L; SP_LAS float* red = L + 8192;
    float xr[16], y[16];
    { const float* xp = X + (size_t)tok * D + lane * 16;
#pragma unroll
      for (int j = 0; j < 4; ++j) { const f32x4 v = *(const f32x4*)(xp + 4 * j); xr[4 * j] = v.x; xr[4 * j + 1] = v.y; xr[4 * j + 2] = v.z; xr[4 * j + 3] = v.w; }
#pragma unroll
      for (int j = 0; j < 16; ++j) y[j] = 0.f; }
    for (int e = 0; e < 16; ++e) {
        const int slot = wv * 16 + e; const int id = IDX[(size_t)tok * 128 + slot]; const float gt = GATE[(size_t)tok * 128 + slot];
        const bf16_t* up = PU + (size_t)id * D + lane * 16; const u32x4 u0 = *(const u32x4*)up, u1 = *(const u32x4*)(up + 8);
        const unsigned uw[8] = {u0.x, u0.y, u0.z, u0.w, u1.x, u1.y, u1.z, u1.w};
        float hsum = 0.f;
#pragma unroll
        for (int j = 0; j < 8; ++j) { hsum = fmaf(xr[2 * j], bflo(uw[j]), hsum); hsum = fmaf(xr[2 * j + 1], bfhi(uw[j]), hsum); }
        hsum = wave_sum(hsum);
        const float w = gt * 0.5f * hsum * (1.f + erff(hsum * 0.70710678118654752f));
        const bf16_t* vp = PV + (size_t)id * D + lane * 16; const u32x4 v0 = *(const u32x4*)vp, v1 = *(const u32x4*)(vp + 8);
        const unsigned vw[8] = {v0.x, v0.y, v0.z, v0.w, v1.x, v1.y, v1.z, v1.w};
#pragma unroll
        for (int j = 0; j < 8; ++j) { y[2 * j] = fmaf(w, bflo(vw[j]), y[2 * j]); y[2 * j + 1] = fmaf(w, bfhi(vw[j]), y[2 * j + 1]); }
    }
#pragma unroll
    for (int j = 0; j < 16; ++j) ys[wv * 1024 + lane * 16 + j] = y[j];
    __syncthreads();
    float v[2]; float s = 0.f;
#pragma unroll
    for (int j = 0; j < 2; ++j) { const int c = tid * 2 + j; float a = 0.f;
#pragma unroll
        for (int k = 0; k < 8; ++k) a += ys[k * 1024 + c];
        v[j] = ALPHA * X[(size_t)tok * D + c] + a; s += v[j]; }
    s = wave_sum(s); if (lane == 0) red[wv] = s; __syncthreads();
    float tot = 0.f;
#pragma unroll
    for (int k = 0; k < 8; ++k) tot += red[k];
    const float mean = tot * (1.f / D);
    float s2 = 0.f;
#pragma unroll
    for (int j = 0; j < 2; ++j) { v[j] -= mean; s2 += v[j] * v[j]; }
    s2 = wave_sum(s2); if (lane == 0) red[8 + wv] = s2; __syncthreads();
    float tot2 = 0.f;
#pragma unroll
    for (int k = 0; k < 8; ++k) tot2 += red[8 + k];
    const float rstd = rsqrtf(tot2 * (1.f / D) + 1e-5f);
#pragma unroll
    for (int j = 0; j < 2; ++j) { const int c = tid * 2 + j; X[(size_t)tok * D + c] = v[j] * rstd * g3[c] + b3[c]; }
    __syncthreads();
}
}

struct Params { const float* in[30]; float* out; unsigned char* ws; };
template <class F> __device__ __forceinline__ void run_gemm(unsigned char* lds, const bf16_t* A, int lda, const bf16_t* Bt, int Mr, int N, int K, F f) {
    pg8::Gemm g{A, Bt, Mr, N, K, lda}; pg8::StaticOrder S; S.init(Mr, N, gridDim.x, blockIdx.x); pg8::EpiAdapt<F> E{f};
    pg8::gemm_phase<pg8::EpiAdapt<F>, pg8::StaticOrder, true>((PG8_LAS unsigned char*)lds, g, S, E);
}
#define KA_LAS __attribute__((address_space(4)))
#define PH_BEGIN const KA_LAS unsigned char* ka_ = (const KA_LAS unsigned char*)__builtin_amdgcn_kernarg_segment_ptr(); asm volatile("" : "+s"(ka_))
#define PIN(k) (*(const float* const KA_LAS*)(ka_ + 8 * (k)))
#define POUT (*(float* const KA_LAS*)(ka_ + 240))
#define PWS (*(unsigned char* const KA_LAS*)(ka_ + 248))
__global__ void __launch_bounds__(512, 2) hybrid_fwd(Params P) {
    extern __shared__ __attribute__((aligned(16))) unsigned char lds[];
    cg::grid_group grid = cg::this_grid();
    {
        PH_BEGIN; unsigned char* ws = PWS;
        const int tid = opaque_tid(), lane = tid & 63, wave = __builtin_amdgcn_readfirstlane(tid >> 6), c = blockIdx.x, G = gridDim.x;
        const size_t gtid = (size_t)c * 512 + tid, gthreads = (size_t)G * 512; const int gw = c * 8 + wave, NGW = G * 8;
        const float* w_in = PIN(2);
        bf16_t* WinT = (bf16_t*)(ws + WS_WIN); bf16_t* WckvT = (bf16_t*)(ws + WS_WCKV);
        SP_LAS float* scr = (SP_LAS float*)lds + wave * (64 * 33);
        constexpr int I0 = 2560, I1 = 5120, I2 = 6144, I3 = 6656, I4 = 7168, I5 = 7680, I6 = 8192, I7 = 8704, I8 = 9216, I9 = 10240;
        for (int it = gw; it < I9; it += NGW) {
            if (it < I0) sp::transpose_item(w_in, NIN, 0, D, 160, WinT, 0, scr, it, lane);
            else if (it < I1) sp::transpose_item(w_in, NIN, 5152, D, 160, WinT, 5120, scr, it - I0, lane);
            else if (it < I2) sp::transpose_item(PIN(9), D, 0, DI, 32, (bf16_t*)(ws + WS_WSSD), 0, scr, it - I1, lane);
            else if (it < I3) sp::transpose_item(PIN(13), D, 0, D, 32, (bf16_t*)(ws + WS_WDIFF), 0, scr, it - I2, lane);
            else if (it < I4) sp::transpose_item(PIN(15), D, 0, D, 32, (bf16_t*)(ws + WS_WO), 0, scr, it - I3, lane);
            else if (it < I5) sp::transpose_item(PIN(18), D, 0, D, 32, (bf16_t*)(ws + WS_WCQ), 0, scr, it - I4, lane);
            else if (it < I6) sp::transpose_item(PIN(19), D, 0, D, 32, WckvT, 0, scr, it - I5, lane);
            else if (it < I7) sp::transpose_item(PIN(20), D, 0, D, 32, WckvT, 1024, scr, it - I6, lane);
            else if (it < I8) sp::transpose_item(PIN(21), D, 0, D, 32, (bf16_t*)(ws + WS_WCO), 0, scr, it - I7, lane);
            else sp::transpose_item(PIN(24), 2048, 0, D, 64, (bf16_t*)(ws + WS_WPQ), 0, scr, it - I8, lane);
        }
        const float* x = PIN(0);
        sp::cvt_range(x, (bf16_t*)(ws + WS_XB), (size_t)M * D / 4, gtid, gthreads);
        sp::cvt_range(PIN(1), (bf16_t*)(ws + WS_MEMB), (size_t)BATCH * MEML * D / 4, gtid, gthreads);
        sp::cvt_range(PIN(25), (bf16_t*)(ws + WS_SUBK), (size_t)PH * 2 * PK * PHALF / 4, gtid, gthreads);
        __syncthreads();
        for (int it = c; it < M / 16; it += G) sp::dt_item((SP_LAS float*)lds, x, w_in, PIN(5), (float*)(ws + WS_DT), it);
        if (c == 0 && tid == 0) { const float* lam_q = PIN(10); const float* lam_k = PIN(11); float s0 = 0.f, s1 = 0.f;
            for (int i = 0; i < 64; ++i) { s0 += lam_q[i] * lam_k[i]; s1 += lam_q[64 + i] * lam_k[64 + i]; }
            ((float*)(ws + WS_CTL))[CW_LAM] = expf(s0) - expf(s1) + LAMBDA_INIT; }
    }
    grid.sync();
    { PH_BEGIN; unsigned char* ws = PWS;
      run_gemm(lds, (const bf16_t*)(ws + WS_MEMB), D, (const bf16_t*)(ws + WS_WCKV), BATCH * MEML, 2048, D, EpiPlain{(bf16_t*)(ws + WS_KCVC), 2048, 1.f});
      run_gemm(lds, (const bf16_t*)(ws + WS_XB), D, (const bf16_t*)(ws + WS_WIN), SEQ, NINP, D, EpiInProj{(bf16_t*)(ws + WS_H), PIN(14)}); }
    grid.sync();
#pragma unroll 1
    for (int b = 0; b < BATCH; ++b) {
        { PH_BEGIN; unsigned char* ws = PWS; const int c = blockIdx.x, G = gridDim.x;
          bf16_t* H = (bf16_t*)(ws + WS_H); const float* DTb = (const float*)(ws + WS_DT) + (size_t)b * SEQ * 32;
          for (int u = c; u < 256; u += G) ssd::phaseA_unit((SS_LAS unsigned char*)lds, H, DTb, PIN(3), PIN(4), PIN(6), (bf16_t*)(ws + WS_T1), (float*)(ws + WS_CTL) + 1024, u >> 2, u & 3);
          const float lam = ((const float*)(ws + WS_CTL))[CW_LAM]; const float* subln_w = PIN(12);
          for (int u = c; u < 256; u += G) { const int h = u >> 5, j = u & 31;
              dattn::unit((DA_LAS unsigned char*)lds, H, h, 63 - j, subln_w, lam);
              dattn::unit((DA_LAS unsigned char*)lds, H, h, j, subln_w, lam); } }
        grid.sync();
        { PH_BEGIN; unsigned char* ws = PWS; const int tid = opaque_tid();
          for (size_t i = (size_t)blockIdx.x * 512 + tid; i < 131072; i += (size_t)gridDim.x * 512) ssd::scan_phase((bf16_t*)(ws + WS_T1), (const float*)(ws + WS_CTL) + 1024, (int)i); }
        grid.sync();
        { PH_BEGIN; unsigned char* ws = PWS; const int c = blockIdx.x, G = gridDim.x;
          for (int u = c; u < 256; u += G) ssd::phaseC_unit((SS_LAS unsigned char*)lds, (bf16_t*)(ws + WS_H), (const float*)(ws + WS_DT) + (size_t)b * SEQ * 32, PIN(3), PIN(4), PIN(6), PIN(7), PIN(8), (const bf16_t*)(ws + WS_T1), u >> 2, u & 3); }
        grid.sync();
        { PH_BEGIN; unsigned char* ws = PWS; bf16_t* H = (bf16_t*)(ws + WS_H); float* T1 = (float*)(ws + WS_T1);
          run_gemm(lds, H + HC_Z, HP_, (const bf16_t*)(ws + WS_WSSD), SEQ, D, DI, EpiGate1{H, T1});
          run_gemm(lds, H + HC_Q, HP_, (const bf16_t*)(ws + WS_WDIFF), SEQ, D, D, EpiGate2{H, T1}); }
        grid.sync();
        { PH_BEGIN; unsigned char* ws = PWS;
          run_gemm(lds, (const bf16_t*)(ws + WS_H) + HC_K, HP_, (const bf16_t*)(ws + WS_WO), SEQ, D, D, EpiResid{PIN(0), POUT, b * SEQ, 0}); }
        grid.sync();
        if (b + 1 < BATCH) {
            { PH_BEGIN; unsigned char* ws = PWS;
              run_gemm(lds, (const bf16_t*)(ws + WS_XB) + (size_t)(b + 1) * SEQ * D, D, (const bf16_t*)(ws + WS_WIN), SEQ, NINP, D, EpiInProj{(bf16_t*)(ws + WS_H), PIN(14)}); }
            grid.sync();
        }
    }
    { PH_BEGIN; unsigned char* ws = PWS; const int tid = opaque_tid(), lane = tid & 63, wave = __builtin_amdgcn_readfirstlane(tid >> 6), c = blockIdx.x, G = gridDim.x;
      const size_t gtid = (size_t)c * 512 + tid, gthreads = (size_t)G * 512;
      float* out = POUT; const float* g = PIN(16); const float* bb = PIN(17); bf16_t* XB = (bf16_t*)(ws + WS_XB);
      for (int r = c * 8 + wave; r < M; r += G * 8) sp::ln_row(out, g, bb, XB, r, lane);
      sp::cvt_range(PIN(26), (bf16_t*)(ws + WS_PU), (size_t)PK * PK * D / 4, gtid, gthreads);
      sp::cvt_range(PIN(27), (bf16_t*)(ws + WS_PV), (size_t)PK * PK * D / 4, gtid, gthreads); }
    grid.sync();
    { PH_BEGIN; unsigned char* ws = PWS;
      run_gemm(lds, (const bf16_t*)(ws + WS_XB), D, (const bf16_t*)(ws + WS_WCQ), M, D, D, EpiPlain{(bf16_t*)(ws + WS_QC), D, CQSCALE}); }
    grid.sync();
    { PH_BEGIN; unsigned char* ws = PWS; const int c = blockIdx.x, G = gridDim.x;
      for (int t = 2 * c; t < M; t += 2 * G) sp::xattn_pair((SP_LAS float*)lds, (const bf16_t*)(ws + WS_QC), (const bf16_t*)(ws + WS_KCVC), (bf16_t*)(ws + WS_XO), t); }
    grid.sync();
    { PH_BEGIN; unsigned char* ws = PWS; float* out = POUT;
      run_gemm(lds, (const bf16_t*)(ws + WS_XO), D, (const bf16_t*)(ws + WS_WCO), M, D, D, EpiResid{out, out, 0, 0}); }
    grid.sync();
    { PH_BEGIN; unsigned char* ws = PWS; const int tid = opaque_tid(), lane = tid & 63, wave = __builtin_amdgcn_readfirstlane(tid >> 6), c = blockIdx.x, G = gridDim.x;
      float* out = POUT; const float* g = PIN(22); const float* bb = PIN(23); bf16_t* XB = (bf16_t*)(ws + WS_XB);
      for (int r = c * 8 + wave; r < M; r += G * 8) sp::ln_row(out, g, bb, XB, r, lane); }
    grid.sync();
    { PH_BEGIN; unsigned char* ws = PWS;
      run_gemm(lds, (const bf16_t*)(ws + WS_XB), D, (const bf16_t*)(ws + WS_WPQ), M, 2048, D, EpiPlain{(bf16_t*)(ws + WS_QP), 2048, 1.f}); }
    grid.sync();
    { PH_BEGIN; unsigned char* ws = PWS; const int c = blockIdx.x, G = gridDim.x;
      for (int t = 2 * c; t < M; t += 2 * G) sp::select_pair((SP_LAS float*)lds, (const bf16_t*)(ws + WS_QP), (const bf16_t*)(ws + WS_SUBK), (int*)(ws + WS_IDX), (float*)(ws + WS_GATE), t); }
    grid.sync();
    { PH_BEGIN; unsigned char* ws = PWS; const int c = blockIdx.x, G = gridDim.x;
      for (int t = c; t < M; t += G) sp::gather_token((SP_LAS float*)lds, POUT, (const bf16_t*)(ws + WS_PU), (const bf16_t*)(ws + WS_PV), (const int*)(ws + WS_IDX), (const float*)(ws + WS_GATE), PIN(28), PIN(29), t); }
}

extern "C" void kernel_launch(void* const* d_in, const int* in_sizes, int n_in, void* d_out, int out_size, void* d_ws, size_t ws_size, hipStream_t stream) {
    static int grid_blocks = 0;
    if (grid_blocks == 0) {
        if (n_in != 30 || out_size != M * D || ws_size < WS_END) { fprintf(stderr, "kernel_launch: unexpected sizes n_in %d out %d ws %zu (need %zu)\n", n_in, out_size, ws_size, (size_t)WS_END); grid_blocks = -1; return; }
        int dev = 0, cus = 0, per_cu = 0;
        (void)hipGetDevice(&dev); (void)hipDeviceGetAttribute(&cus, hipDeviceAttributeMultiprocessorCount, dev);
        (void)hipFuncSetAttribute((const void*)hybrid_fwd, hipFuncAttributeMaxDynamicSharedMemorySize, LDS_BYTES);
        if (hipOccupancyMaxActiveBlocksPerMultiprocessor(&per_cu, (const void*)hybrid_fwd, 512, LDS_BYTES) != hipSuccess || per_cu < 1) { fprintf(stderr, "kernel_launch: occupancy query failed (%d)\n", per_cu); per_cu = 1; }
        (void)hipGetLastError();
        grid_blocks = cus * 1;
    }
    if (grid_blocks < 0) return;
    Params p{};
    for (int i = 0; i < 30; ++i) p.in[i] = (const float*)d_in[i];
    p.out = (float*)d_out; p.ws = (unsigned char*)d_ws;
    void* args[] = {&p};
    hipError_t e = hipLaunchCooperativeKernel((const void*)hybrid_fwd, dim3(grid_blocks), dim3(512), args, LDS_BYTES, stream);
    if (e != hipSuccess) fprintf(stderr, "cooperative launch failed: %s (grid %d)\n", hipGetErrorString(e), grid_blocks);
}
```

```cpp
#include <hip/hip_runtime.h>
#include <hip/hip_cooperative_groups.h>
namespace cg = cooperative_groups;
#include <cstdio>
#include <cstdint>
#include <cmath>
#include <type_traits>

typedef unsigned short bf16_t;
typedef float f32x4 __attribute__((ext_vector_type(4)));
typedef unsigned u32x4 __attribute__((ext_vector_type(4)));
typedef unsigned u32x2 __attribute__((ext_vector_type(2)));

constexpr int D = 1024, BATCH = 2, SEQ = 8192, M = BATCH * SEQ;
constexpr int DI = 2048, NH = 32, HP = 64, NG = 4, DS = 128, DXBC = 3072;
constexpr int AH = 8, AD = 64, AV = 128;
constexpr int MEML = 256, MH = 4, MHD = 256;
constexpr int PH = 8, PK = 128, PDK = 256, PHALF = 128, PTOP = 16;
constexpr int NIN = 10272, NINP = 10240;
constexpr float ALPHA = 1.189207115002721f;
constexpr float LOG2E = 1.4426950408889634f;
constexpr float QSCALE = 0.125f * LOG2E;
constexpr float CQSCALE = 0.0625f * LOG2E;
constexpr float LAMBDA_INIT = 0.2f;
constexpr int HC_Z = 0, HC_XBC = 2048, HC_Q = 5120, HC_K = 6144, HC_V = 7168, HC_GS = 8192, HC_GA = 9216, HP_ = NINP;

constexpr size_t MiB = 1u << 20;
constexpr size_t WS_CTL = 0;
constexpr size_t WS_WIN = 1 * MiB;
constexpr size_t WS_WSSD = 21 * MiB;
constexpr size_t WS_WDIFF = 25 * MiB, WS_WO = 27 * MiB, WS_WCQ = 29 * MiB, WS_WCKV = 31 * MiB  , WS_WCO = 35 * MiB;
constexpr size_t WS_WPQ = 37 * MiB;
constexpr size_t WS_SUBK = 41 * MiB;
constexpr size_t WS_MEMB = 42 * MiB;
constexpr size_t WS_KCVC = 43 * MiB;
constexpr size_t WS_DT = 45 * MiB;
constexpr size_t WS_XB = 47 * MiB;
constexpr size_t WS_H = 79 * MiB;
constexpr size_t WS_T1 = 239 * MiB;
constexpr size_t WS_PU = 79 * MiB, WS_PV = 111 * MiB;
constexpr size_t WS_QC = 143 * MiB, WS_XO = 175 * MiB;
constexpr size_t WS_QP = 207 * MiB;
constexpr size_t WS_IDX = 143 * MiB, WS_GATE = 151 * MiB;
constexpr size_t WS_END = 271 * MiB;
constexpr int CW_LAM = 64;

__device__ __forceinline__ int opaque_tid() { int t = threadIdx.x; asm volatile("" : "+v"(t)); return t; }
__device__ __forceinline__ unsigned f2bf(float f) { unsigned u = __builtin_bit_cast(unsigned, f); return (u + 0x7fffu + ((u >> 16) & 1u)) >> 16; }
__device__ __forceinline__ float bf2f(unsigned h) { return __builtin_bit_cast(float, h << 16); }
__device__ __forceinline__ unsigned pk2(float lo, float hi) { return f2bf(lo) | (f2bf(hi) << 16); }
__device__ __forceinline__ float bflo(unsigned w) { return __builtin_bit_cast(float, w << 16); }
__device__ __forceinline__ float bfhi(unsigned w) { return __builtin_bit_cast(float, w & 0xffff0000u); }
__device__ __forceinline__ float sigmoidf_(float v) { return 1.f / (1.f + __expf(-v)); }
__device__ __forceinline__ float siluf_(float v) { return v / (1.f + __expf(-v)); }
__device__ __forceinline__ float wave_sum(float v) {
#pragma unroll
    for (int o = 1; o < 64; o <<= 1) v += __shfl_xor(v, o);
    return v;
}
__device__ __forceinline__ float wave_max(float v) {
#pragma unroll
    for (int o = 1; o < 64; o <<= 1) v = fmaxf(v, __shfl_xor(v, o));
    return v;
}

__device__ __forceinline__ void store_bf16x8(bf16_t* p, const float (&v)[8]) { u32x4 w; w.x = pk2(v[0], v[1]); w.y = pk2(v[2], v[3]); w.z = pk2(v[4], v[5]); w.w = pk2(v[6], v[7]); *(u32x4*)p = w; }
struct EpiPlain { bf16_t* O; int ldc; float scale;
    __device__ __forceinline__ void operator()(int row, int col0, const float (&v)[8]) const { float o[8];
#pragma unroll
        for (int j = 0; j < 8; ++j) o[j] = v[j] * scale; store_bf16x8(O + (size_t)row * ldc + col0, o); } };
struct EpiInProj { bf16_t* H; const float* gate_bias;
    __device__ __forceinline__ void operator()(int row, int col0, const float (&v)[8]) const { float o[8];
        if (col0 >= HC_GS) { const float* gb = gate_bias + (col0 - HC_GS);
#pragma unroll
            for (int j = 0; j < 8; ++j) o[j] = sigmoidf_(v[j] + gb[j]); }
        else { const float s = (col0 >= HC_Q && col0 < HC_K) ? QSCALE : 1.f;
#pragma unroll
            for (int j = 0; j < 8; ++j) o[j] = v[j] * s; }
        store_bf16x8(H + (size_t)row * HP_ + col0, o); } };
struct EpiGate1 { const bf16_t* H; float* T1;
    __device__ __forceinline__ void operator()(int row, int col0, const float (&v)[8]) const {
        const u32x4 g = *(const u32x4*)(H + (size_t)row * HP_ + HC_GS + col0); const unsigned gw[4] = {g.x, g.y, g.z, g.w};
        float* t = T1 + (size_t)row * D + col0;
#pragma unroll
        for (int j = 0; j < 4; ++j) { t[2 * j] = bflo(gw[j]) * v[2 * j]; t[2 * j + 1] = bfhi(gw[j]) * v[2 * j + 1]; } } };
struct EpiGate2 { bf16_t* H; const float* T1;
    __device__ __forceinline__ void operator()(int row, int col0, const float (&v)[8]) const {
        const u32x4 g = *(const u32x4*)(H + (size_t)row * HP_ + HC_GA + col0); const unsigned gw[4] = {g.x, g.y, g.z, g.w};
        const float* t = T1 + (size_t)row * D + col0; float o[8];
#pragma unroll
        for (int j = 0; j < 4; ++j) { o[2 * j] = t[2 * j] + bflo(gw[j]) * v[2 * j]; o[2 * j + 1] = t[2 * j + 1] + bfhi(gw[j]) * v[2 * j + 1]; }
        store_bf16x8(H + (size_t)row * HP_ + HC_K + col0, o); } };
struct EpiResid { const float* base; float* out; int row_off; int pad_;
    __device__ __forceinline__ void operator()(int row, int col0, const float (&v)[8]) const {
        const size_t o = (size_t)(row + row_off) * D + col0;
#pragma unroll
        for (int j = 0; j < 8; ++j) out[o + j] = ALPHA * base[o + j] + v[j]; } };


namespace pg8 {
#define PG8_LAS __attribute__((address_space(3)))
typedef short bf16x8 __attribute__((ext_vector_type(8)));
constexpr int BM = 256, BK = 64, HALF = 128, HTB = HALF * BK * 2, STAGE_BYTES = 8 * HTB, NXCD = 8, WGM = 8;
__host__ __device__ __forceinline__ int lds_byte(int r, int c) { const int st = (r >> 4) * 2 + (c >> 5), rr = r & 15, cc = c & 31, ob = rr * 64 + cc * 2; return st * 1024 + (ob ^ (((ob >> 9) & 1) << 5)); }
__host__ __device__ __forceinline__ void stage_rc(int b, int& R, int& C) { const int st = b / 1024, sb = b % 1024, swz = sb ^ (((sb >> 9) & 1) << 5); R = (st >> 1) * 16 + swz / 64; C = (st & 1) * 32 + (swz % 64) / 2; }
__host__ __device__ __forceinline__ int perm32(int rho) { const int n = rho >> 4, i = rho & 15; return 8 * (i >> 2) + 4 * n + (i & 3); }
struct Unit { int pm, pn; };
struct Gemm { const bf16_t* A; const bf16_t* Bt; int M, N, K, lda; };
struct StaticOrder {
    int nM, nN, nwg, G, c;
    __host__ __device__ void init(int M, int N, int G_, int c_) { nM = M / BM; nN = N / BM; nwg = nM * nN; G = G_; c = c_; }
    __host__ __device__ bool next(int i, Unit& u) const {
        const long L = (long)i * G + c; if (L >= nwg) return false;
        int wgid = (int)L; { const int q = nwg / NXCD, r = nwg % NXCD, xcd = wgid % NXCD, off = wgid / NXCD; wgid = (xcd < r ? xcd * (q + 1) : r * (q + 1) + (xcd - r) * q) + off; }
        const int nig = WGM * nN, gid = wgid / nig, fm = gid * WGM, gsz = (nM - fm) < WGM ? (nM - fm) : WGM;
        u.pm = fm + ((wgid % nig) % gsz); u.pn = (wgid % nig) / gsz; return true;
    }
};
template <class F> struct EpiAdapt {
    static constexpr bool PERM = true, AFTER_DRAIN = false; F f;
    __device__ __forceinline__ void operator()(const f32x4 (&acc)[2][2][4][2], const Unit& u, int wr, int wc, int fr, int fq) const {
#pragma unroll
        for (int ai = 0; ai < 2; ++ai)
#pragma unroll
            for (int m = 0; m < 4; ++m) { const int row = u.pm * BM + ai * HALF + wr * 64 + m * 16 + fr;
#pragma unroll
                for (int bj = 0; bj < 2; ++bj) { const int col0 = u.pn * BM + bj * HALF + wc * 32 + 8 * fq;
                    const f32x4 a = acc[ai][bj][m][0], b = acc[ai][bj][m][1]; const float v[8] = {a[0], a[1], a[2], a[3], b[0], b[1], b[2], b[3]};
                    f(row, col0, v); } }
    }
};
template <class Epi, class Sched, bool ALIGN_EPI>
__device__ __forceinline__ void gemm_phase(PG8_LAS unsigned char* lds, const Gemm g, const Sched& S, const Epi& E) {
    const int tid = opaque_tid(), wid = __builtin_amdgcn_readfirstlane(tid >> 6), lane = tid & 63, wr = wid >> 2, wc = wid & 3, fr = lane & 15, fq = lane >> 4;
    const int K = g.K, nt = K / BK, lda = g.lda;
    unsigned voffA[2], voffB[2];
#pragma unroll
    for (int i = 0; i < 2; ++i) { int R, C; stage_rc(tid * 16 + i * 8192, R, C); const int Rb = Epi::PERM ? ((R & ~31) + perm32(R & 31)) : R;
        voffA[i] = (unsigned)(R * lda + C) * 2u; voffB[i] = (unsigned)(Rb * K + C) * 2u; }
    const size_t kstep = (size_t)(BK * 2);
    const size_t hstepA = (size_t)HALF * lda * 2, hstepB = (size_t)HALF * K * 2;
    const size_t tstepA = 2 * hstepA, tstepB = 2 * hstepB;
    const unsigned ldsw = (unsigned)wid * 1024u;
    const int aoff = lds_byte(wr * 64 + fr, fq * 8), boff = lds_byte(wc * 32 + fr, fq * 8);
#define PG8_SA(b, h) (((b) * 2 + (h)) * HTB)
#define PG8_SB(b, h) ((4 + (b) * 2 + (h)) * HTB)
#define PG8_STAGE(bufoff, gbase, voff) do { _Pragma("unroll") for (int _i = 0; _i < 2; ++_i) \
        __builtin_amdgcn_global_load_lds((const unsigned*)((const char*)(gbase) + (voff)[_i]), (PG8_LAS unsigned*)(lds + (bufoff) + ldsw + _i * 8192), 16, 0, 0); } while (0)
#define PG8_LDA(dst, b, h) do { _Pragma("unroll") for (int m = 0; m < 4; ++m) _Pragma("unroll") for (int k = 0; k < 2; ++k) dst[m][k] = *(const PG8_LAS bf16x8*)(lds + PG8_SA(b, h) + aoff + m * 2048 + k * 1024); } while (0)
#define PG8_LDB(dst, b, h) do { _Pragma("unroll") for (int n = 0; n < 2; ++n) _Pragma("unroll") for (int k = 0; k < 2; ++k) dst[n][k] = *(const PG8_LAS bf16x8*)(lds + PG8_SB(b, h) + boff + n * 2048 + k * 1024); } while (0)
#define PG8_MMA(ai, bj, At, Bt) do { __builtin_amdgcn_s_setprio(1); _Pragma("unroll") for (int m = 0; m < 4; ++m) _Pragma("unroll") for (int n = 0; n < 2; ++n) _Pragma("unroll") for (int k = 0; k < 2; ++k) \
        acc[ai][bj][m][n] = __builtin_amdgcn_mfma_f32_16x16x32_bf16(Bt[n][k], At[m][k], acc[ai][bj][m][n], 0, 0, 0); __builtin_amdgcn_s_setprio(0); } while (0)
#define PG8_WAIT_V(n) asm volatile("s_waitcnt vmcnt(" #n ")" ::: "memory")
#define PG8_WAIT_L(n) asm volatile("s_waitcnt lgkmcnt(" #n ")" ::: "memory")
#define PG8_BAR __builtin_amdgcn_s_barrier()
#define PG8_SCHED __builtin_amdgcn_sched_barrier(0)
    Unit cur, nxt; int ui = 0;
    if (!S.next(0, cur)) return;
    f32x4 acc[2][2][4][2];
#pragma unroll
    for (int a = 0; a < 2; ++a)
#pragma unroll
        for (int b = 0; b < 2; ++b)
#pragma unroll
            for (int m = 0; m < 4; ++m)
#pragma unroll
                for (int n = 0; n < 2; ++n) acc[a][b][m][n] = (f32x4){0.f, 0.f, 0.f, 0.f};
    bf16x8 At[4][2], B0[2][2], B1[2][2];
    const char* cA = (const char*)g.A + (size_t)cur.pm * tstepA; const char* cB = (const char*)g.Bt + (size_t)cur.pn * tstepB;
    PG8_STAGE(PG8_SB(0, 0), cB, voffB); PG8_STAGE(PG8_SB(0, 1), cB + hstepB, voffB); PG8_STAGE(PG8_SA(0, 0), cA, voffA); PG8_STAGE(PG8_SA(0, 1), cA + hstepA, voffA);
    if (wr == 1) PG8_BAR;
    PG8_WAIT_V(2); PG8_BAR;
    PG8_STAGE(PG8_SB(1, 0), cB + kstep, voffB); PG8_STAGE(PG8_SA(1, 0), cA + kstep, voffA); PG8_STAGE(PG8_SB(1, 1), cB + hstepB + kstep, voffB);
    PG8_WAIT_V(6); PG8_BAR;
    for (;;) {
        const bool has_next = S.next(ui + 1, nxt);
        const char* nA = has_next ? (const char*)g.A + (size_t)nxt.pm * tstepA : cA; const char* nB = has_next ? (const char*)g.Bt + (size_t)nxt.pn * tstepB : cB;
        for (int t = 0; t < nt; t += 2) {
            const bool last = (t == nt - 2);
            const char* a1 = cA + (size_t)(t + 1) * kstep;
            const char* a2 = last ? nA : cA + (size_t)(t + 2) * kstep; const char* b2 = last ? nB : cB + (size_t)(t + 2) * kstep;
            const char* a3 = a2 + kstep; const char* b3 = b2 + kstep;
            PG8_LDB(B0, 0, 0); PG8_LDB(B1, 0, 1); PG8_SCHED; PG8_LDA(At, 0, 0); PG8_STAGE(PG8_SA(1, 1), a1 + hstepA, voffA);
            PG8_WAIT_V(8); PG8_WAIT_L(0); PG8_BAR; PG8_MMA(0, 0, At, B0); PG8_MMA(0, 1, At, B1); PG8_BAR; PG8_SCHED;
            PG8_LDA(At, 0, 1); PG8_STAGE(PG8_SB(0, 0), b2, voffB); PG8_STAGE(PG8_SB(0, 1), b2 + hstepB, voffB); PG8_STAGE(PG8_SA(0, 0), a2, voffA);
            PG8_WAIT_V(8); PG8_WAIT_L(0); PG8_BAR; PG8_MMA(1, 0, At, B0); PG8_MMA(1, 1, At, B1); PG8_BAR; PG8_SCHED;
            PG8_LDB(B0, 1, 0); PG8_LDB(B1, 1, 1); PG8_SCHED; PG8_LDA(At, 1, 0); PG8_STAGE(PG8_SA(0, 1), a2 + hstepA, voffA);
            PG8_WAIT_V(8); PG8_WAIT_L(0); PG8_BAR; PG8_MMA(0, 0, At, B0); PG8_MMA(0, 1, At, B1); PG8_BAR; PG8_SCHED;
            PG8_LDA(At, 1, 1); PG8_STAGE(PG8_SB(1, 0), b3, voffB); PG8_STAGE(PG8_SB(1, 1), b3 + hstepB, voffB); PG8_STAGE(PG8_SA(1, 0), a3, voffA);
            PG8_WAIT_V(8); PG8_WAIT_L(0); PG8_BAR; PG8_MMA(1, 0, At, B0); PG8_MMA(1, 1, At, B1); PG8_BAR; PG8_SCHED;
        }
        if constexpr (ALIGN_EPI) { if (wr == 0) PG8_BAR; }
        E(acc, cur, wr, wc, fr, fq);
        if (!has_next) break;
#pragma unroll
        for (int a = 0; a < 2; ++a)
#pragma unroll
            for (int b = 0; b < 2; ++b)
#pragma unroll
                for (int m = 0; m < 4; ++m)
#pragma unroll
                    for (int n = 0; n < 2; ++n) acc[a][b][m][n] = (f32x4){0.f, 0.f, 0.f, 0.f};
        cur = nxt; cA = nA; cB = nB; ++ui;
        if constexpr (ALIGN_EPI) { if (wr == 1) PG8_BAR; }
    }
    PG8_WAIT_V(0);
    if constexpr (!ALIGN_EPI) { if (wr == 0) PG8_BAR; }
    PG8_BAR;
#undef PG8_SA
#undef PG8_SB
#undef PG8_STAGE
#undef PG8_LDA
#undef PG8_LDB
#undef PG8_MMA
#undef PG8_WAIT_V
#undef PG8_WAIT_L
#undef PG8_BAR
#undef PG8_SCHED
}
}
constexpr int LDS_BYTES = 147456;
namespace dattn {
#define DA_LAS __attribute__((address_space(3)))
typedef short bf16x8 __attribute__((ext_vector_type(8)));
typedef short s16x4 __attribute__((ext_vector_type(4)));
typedef float f32x16 __attribute__((ext_vector_type(16)));
constexpr int KP = 272, VP = 320, KBUF = 64 * KP, VBUF = 64 * VP, BUF = KBUF + VBUF, XOFF = 2 * BUF, LDS_NEED = XOFF + 65536;
static_assert(LDS_NEED <= 147456, "attention LDS");
__device__ __forceinline__ unsigned cvtpk(float lo, float hi) { typedef float f2 __attribute__((ext_vector_type(2))); typedef __bf16 b2 __attribute__((ext_vector_type(2))); f2 v = {lo, hi}; b2 b = __builtin_convertvector(v, b2); return __builtin_bit_cast(unsigned, b); }
__device__ __forceinline__ s16x4 vtr(const DA_LAS unsigned char* p) { typedef short v4i16_t __attribute__((ext_vector_type(4))); return __builtin_bit_cast(s16x4, __builtin_amdgcn_ds_read_tr16_b64_v4i16((DA_LAS v4i16_t*)p)); }
template <bool STORE = true> __device__ __forceinline__ void unit(DA_LAS unsigned char* lds, bf16_t* Hb, int h, int qb, const float* __restrict__ subln_w, float lam) {
    const int tid = opaque_tid(), lane = tid & 63, w = __builtin_amdgcn_readfirstlane(tid >> 6), mp = w >> 2, rb = w & 3, c32 = lane & 31, hh = lane >> 5;
    const int qrow = 128 * qb + 32 * rb + c32;
    bf16x8 qf[4];
    { const bf16_t* qp = Hb + (size_t)qrow * HP_ + HC_Q + h * 128 + 64 * mp + 8 * hh;
#pragma unroll
      for (int s = 0; s < 4; ++s) qf[s] = *(const bf16x8*)(qp + 16 * s); }
    const int srow = tid >> 4, sch = tid & 15;
    const bf16_t* kg = Hb + HC_K + h * 128 + sch * 8; const bf16_t* vg = Hb + HC_V + h * 128 + sch * 8;
    const int nt = 2 * qb + 2;
    u32x4 kr[2], vr[2];
#define DA_LOAD(t) do { _Pragma("unroll") for (int j = 0; j < 2; ++j) { const size_t ro = (size_t)(64 * (t) + srow + 32 * j) * HP_; kr[j] = *(const u32x4*)(kg + ro); vr[j] = *(const u32x4*)(vg + ro); } } while (0)
#define DA_WRITE(buf) do { _Pragma("unroll") for (int j = 0; j < 2; ++j) { *(DA_LAS u32x4*)(lds + (buf) * BUF + (srow + 32 * j) * KP + sch * 16) = kr[j]; *(DA_LAS u32x4*)(lds + (buf) * BUF + KBUF + (srow + 32 * j) * VP + sch * 16) = vr[j]; } } while (0)
    DA_LOAD(0); DA_WRITE(0);
    __syncthreads();
    f32x16 oT[4];
#pragma unroll
    for (int i = 0; i < 4; ++i) oT[i] = (f32x16){0.f, 0.f, 0.f, 0.f, 0.f, 0.f, 0.f, 0.f, 0.f, 0.f, 0.f, 0.f, 0.f, 0.f, 0.f, 0.f};
    float mrow = -INFINITY, lrow = 0.f;
    const int koff = c32 * KP + (64 * mp + 8 * hh) * 2;
    const int voff = KBUF + (4 * hh + ((lane & 15) >> 2)) * VP + (16 * ((lane >> 4) & 1) + 4 * (lane & 3)) * 2;
    for (int t = 0; t < nt; ++t) {
        const int cur = t & 1;
        if (t + 1 < nt) DA_LOAD(t + 1);
        if (!(t == nt - 1 && rb <= 1)) {
            const DA_LAS unsigned char* kb = lds + cur * BUF + koff;
            f32x16 s0 = (f32x16){0.f, 0.f, 0.f, 0.f, 0.f, 0.f, 0.f, 0.f, 0.f, 0.f, 0.f, 0.f, 0.f, 0.f, 0.f, 0.f}, s1 = s0;
#pragma unroll
            for (int s = 0; s < 4; ++s) {
                const bf16x8 a0 = *(const DA_LAS bf16x8*)(kb + s * 32), a1 = *(const DA_LAS bf16x8*)(kb + 32 * KP + s * 32);
                s0 = __builtin_amdgcn_mfma_f32_32x32x16_bf16(a0, qf[s], s0, 0, 0, 0);
                s1 = __builtin_amdgcn_mfma_f32_32x32x16_bf16(a1, qf[s], s1, 0, 0, 0);
            }
            if (t >= nt - 2) {
                const int k0 = 64 * t + 4 * hh;
#pragma unroll
                for (int r = 0; r < 16; ++r) { const int key = k0 + (r & 3) + 8 * (r >> 2); if (key > qrow) s0[r] = -INFINITY; if (key + 32 > qrow) s1[r] = -INFINITY; }
            }
            float mx = fmaxf(s0[0], s1[0]);
#pragma unroll
            for (int r = 1; r < 16; ++r) mx = fmaxf(mx, fmaxf(s0[r], s1[r]));
            mx = fmaxf(mx, __shfl_xor(mx, 32));
            const float mnew = fmaxf(mrow, mx), alpha = __builtin_amdgcn_exp2f(mrow - mnew);
            mrow = mnew;
            float ps = 0.f;
#pragma unroll
            for (int r = 0; r < 16; ++r) { s0[r] = __builtin_amdgcn_exp2f(s0[r] - mnew); s1[r] = __builtin_amdgcn_exp2f(s1[r] - mnew); ps += s0[r] + s1[r]; }
            lrow = lrow * alpha + ps;
#pragma unroll
            for (int i = 0; i < 4; ++i)
#pragma unroll
                for (int r = 0; r < 16; ++r) oT[i][r] *= alpha;
            bf16x8 pf[2][2];
#pragma unroll
            for (int s = 0; s < 2; ++s) {
                u32x4 a, b;
                a.x = cvtpk(s0[8 * s], s0[8 * s + 1]); a.y = cvtpk(s0[8 * s + 2], s0[8 * s + 3]); a.z = cvtpk(s0[8 * s + 4], s0[8 * s + 5]); a.w = cvtpk(s0[8 * s + 6], s0[8 * s + 7]);
                b.x = cvtpk(s1[8 * s], s1[8 * s + 1]); b.y = cvtpk(s1[8 * s + 2], s1[8 * s + 3]); b.z = cvtpk(s1[8 * s + 4], s1[8 * s + 5]); b.w = cvtpk(s1[8 * s + 6], s1[8 * s + 7]);
                pf[0][s] = __builtin_bit_cast(bf16x8, a); pf[1][s] = __builtin_bit_cast(bf16x8, b);
            }
            const DA_LAS unsigned char* vb = lds + cur * BUF + voff;
#pragma unroll
            for (int db = 0; db < 4; ++db)
#pragma unroll
                for (int t2 = 0; t2 < 2; ++t2)
#pragma unroll
                    for (int s = 0; s < 2; ++s) {
                        const s16x4 lo = vtr(vb + (32 * t2 + 16 * s) * VP + db * 64), hi = vtr(vb + (32 * t2 + 16 * s + 8) * VP + db * 64);
                        const bf16x8 vf = (bf16x8){lo[0], lo[1], lo[2], lo[3], hi[0], hi[1], hi[2], hi[3]};
                        oT[db] = __builtin_amdgcn_mfma_f32_32x32x16_bf16(vf, pf[t2][s], oT[db], 0, 0, 0);
                    }
        }
        if (t + 1 < nt) DA_WRITE(cur ^ 1);
        __syncthreads();
    }
#undef DA_LOAD
#undef DA_WRITE
    const float inv = 1.f / (lrow + __shfl_xor(lrow, 32));
    DA_LAS float* X = (DA_LAS float*)(lds + XOFF) + rb * 4096 + lane;
    if (mp == 1) {
#pragma unroll
        for (int i = 0; i < 4; ++i)
#pragma unroll
            for (int r = 0; r < 16; ++r) X[(i * 16 + r) * 64] = oT[i][r] * inv;
    }
    __syncthreads();
    if (mp == 0) {
        float ss = 0.f;
#pragma unroll
        for (int i = 0; i < 4; ++i)
#pragma unroll
            for (int r = 0; r < 16; ++r) { const float o = oT[i][r] * inv - lam * X[(i * 16 + r) * 64]; oT[i][r] = o; ss += o * o; }
        ss += __shfl_xor(ss, 32);
        const float rr = rsqrtf(ss * (1.f / 128.f) + 1e-5f) * (1.f - LAMBDA_INIT);
        bf16_t* op = Hb + (size_t)qrow * HP_ + HC_Q + h * 128 + 4 * hh;
#pragma unroll
        for (int i = 0; i < 4; ++i)
#pragma unroll
            for (int g = 0; g < 4; ++g) { const int d0 = 32 * i + 8 * g; const f32x4 sw = *(const f32x4*)(subln_w + d0 + 4 * hh);
                uint2 o; o.x = pk2(oT[i][4 * g] * rr * sw.x, oT[i][4 * g + 1] * rr * sw.y); o.y = pk2(oT[i][4 * g + 2] * rr * sw.z, oT[i][4 * g + 3] * rr * sw.w);
                if (STORE || o.x == 0x12345u) *(uint2*)(op + d0) = o; }
    }
    __syncthreads();
}
}
namespace ssd {
#define SS_LAS __attribute__((address_space(3)))
typedef short bf16x8 __attribute__((ext_vector_type(8)));
typedef short s16x4 __attribute__((ext_vector_type(4)));
typedef float f32x16 __attribute__((ext_vector_type(16)));
constexpr int XP = 192;
constexpr int BPT = 320;
constexpr int CP = 272;
__device__ __forceinline__ s16x4 vtr(const SS_LAS unsigned char* p) { typedef short v4i16_t __attribute__((ext_vector_type(4))); return __builtin_bit_cast(s16x4, __builtin_amdgcn_ds_read_tr16_b64_v4i16((SS_LAS v4i16_t*)p)); }
__device__ __forceinline__ unsigned cvtpk(float lo, float hi) { typedef float f2 __attribute__((ext_vector_type(2))); typedef __bf16 b2 __attribute__((ext_vector_type(2))); f2 v = {lo, hi}; b2 b = __builtin_convertvector(v, b2); return __builtin_bit_cast(unsigned, b); }
__device__ __forceinline__ void acs_tables(SS_LAS float* ACS, SS_LAS float* DTS, const float* __restrict__ DTb, const float* __restrict__ a_log, int c, int g) {
    const int tid_ = opaque_tid(); const int lane = tid_ & 63, e = __builtin_amdgcn_readfirstlane(tid_ >> 6), h = 8 * g + e;
    const float a = -expf(a_log[h]);
    const float d0 = DTb[(size_t)(128 * c + 2 * lane) * 32 + h], d1 = DTb[(size_t)(128 * c + 2 * lane + 1) * 32 + h];
    const float a0 = d0 * a, a1 = d1 * a;
    float sc = a0 + a1;
#pragma unroll
    for (int o = 1; o < 64; o <<= 1) { const float v = __shfl_up(sc, o); if (lane >= o) sc += v; }
    const float ex = sc - (a0 + a1);
    ACS[(2 * lane) * 8 + e] = ex + a0; ACS[(2 * lane + 1) * 8 + e] = ex + a0 + a1;
    DTS[(2 * lane) * 8 + e] = d0; DTS[(2 * lane + 1) * 8 + e] = d1;
}
template <class F> __device__ __forceinline__ void conv_item(const bf16_t* __restrict__ Hb, int t0, int l0, int xch0, const float* __restrict__ conv_w, const float* __restrict__ conv_b, F sink) {
    float w[4][8], bias[8];
#pragma unroll
    for (int j = 0; j < 4; ++j) { const f32x4 a = *(const f32x4*)(conv_w + j * DXBC + xch0), b = *(const f32x4*)(conv_w + j * DXBC + xch0 + 4); w[j][0] = a.x; w[j][1] = a.y; w[j][2] = a.z; w[j][3] = a.w; w[j][4] = b.x; w[j][5] = b.y; w[j][6] = b.z; w[j][7] = b.w; }
    { const f32x4 a = *(const f32x4*)(conv_b + xch0), b = *(const f32x4*)(conv_b + xch0 + 4); bias[0] = a.x; bias[1] = a.y; bias[2] = a.z; bias[3] = a.w; bias[4] = b.x; bias[5] = b.y; bias[6] = b.z; bias[7] = b.w; }
    float x0[8], x1[8], x2[8];
    const bf16_t* src = Hb + HC_XBC + xch0;
#define SS_ROW(dst, tt) do { u32x4 q_ = (u32x4){0u, 0u, 0u, 0u}; if ((tt) >= 0) q_ = *(const u32x4*)(src + (size_t)(tt) * HP_); dst[0] = bflo(q_.x); dst[1] = bfhi(q_.x); dst[2] = bflo(q_.y); dst[3] = bfhi(q_.y); dst[4] = bflo(q_.z); dst[5] = bfhi(q_.z); dst[6] = bflo(q_.w); dst[7] = bfhi(q_.w); } while (0)
    SS_ROW(x0, t0 + l0 - 3); SS_ROW(x1, t0 + l0 - 2); SS_ROW(x2, t0 + l0 - 1);
#pragma unroll
    for (int i = 0; i < 16; ++i) {
        float x3[8]; SS_ROW(x3, t0 + l0 + i);
        float v[8];
#pragma unroll
        for (int k = 0; k < 8; ++k) { const float a = bias[k] + w[0][k] * x0[k] + w[1][k] * x1[k] + w[2][k] * x2[k] + w[3][k] * x3[k]; v[k] = a / (1.f + __expf(-a)); x0[k] = x1[k]; x1[k] = x2[k]; x2[k] = x3[k]; }
        sink(l0 + i, v);
    }
#undef SS_ROW
}
constexpr int A_BS = 0, A_XD = 128 * BPT  , A_ACS = A_XD + 2 * 128 * XP  , A_DTS = A_ACS + 4096, A_END = A_DTS + 4096;
__device__ __forceinline__ void phaseA_unit(SS_LAS unsigned char* lds, const bf16_t* __restrict__ Hb, const float* __restrict__ DTb, const float* __restrict__ conv_w, const float* __restrict__ conv_b,
                                            const float* __restrict__ a_log, bf16_t* __restrict__ ST, float* __restrict__ CD, int c, int g) {
    const int tid = opaque_tid(), lane = tid & 63, w = __builtin_amdgcn_readfirstlane(tid >> 6), c32 = lane & 31, hh = lane >> 5;
    SS_LAS float* ACS = (SS_LAS float*)(lds + A_ACS); SS_LAS float* DTS = (SS_LAS float*)(lds + A_DTS);
    acs_tables(ACS, DTS, DTb, a_log, c, g);
    __syncthreads();
    if (tid < 8) CD[c * 32 + 8 * g + tid] = __expf(ACS[127 * 8 + tid]);
    auto stageX = [&](int e, int item, int buf) {
        const int cg = item >> 3, seg = item & 7; const float aend = ACS[127 * 8 + e];
        conv_item(Hb, 128 * c, 16 * seg, g * 512 + e * 64 + cg * 8, conv_w, conv_b, [&](int l, const float (&v)[8]) {
            const float sc = DTS[l * 8 + e] * __expf(aend - ACS[l * 8 + e]);
            u32x4 o; o.x = cvtpk(v[0] * sc, v[1] * sc); o.y = cvtpk(v[2] * sc, v[3] * sc); o.z = cvtpk(v[4] * sc, v[5] * sc); o.w = cvtpk(v[6] * sc, v[7] * sc);
            *(SS_LAS u32x4*)(lds + A_XD + buf * 128 * XP + l * XP + cg * 16) = o; });
    };
    if (tid < 128) { const int cg = tid >> 3, seg = tid & 7;
        conv_item(Hb, 128 * c, 16 * seg, 2048 + g * 128 + cg * 8, conv_w, conv_b, [&](int l, const float (&v)[8]) {
            u32x4 o; o.x = cvtpk(v[0], v[1]); o.y = cvtpk(v[2], v[3]); o.z = cvtpk(v[4], v[5]); o.w = cvtpk(v[6], v[7]);
            *(SS_LAS u32x4*)(lds + A_BS + l * BPT + cg * 16) = o; });
    } else if (tid < 192) stageX(0, tid - 128, 0);
    __syncthreads();
    const int pb = w & 1, nb = w >> 1;
    const int rsel = ((lane & 15) >> 2), csel = 16 * ((lane >> 4) & 1) + 4 * (lane & 3);
    for (int e = 0; e < 8; ++e) {
        if (e + 1 < 8 && tid >= 448) stageX(e + 1, tid - 448, (e + 1) & 1);
        f32x16 acc = (f32x16){0.f, 0.f, 0.f, 0.f, 0.f, 0.f, 0.f, 0.f, 0.f, 0.f, 0.f, 0.f, 0.f, 0.f, 0.f, 0.f};
        const SS_LAS unsigned char* bp = lds + A_BS + (8 * hh + rsel) * BPT + (32 * nb + csel) * 2;
        const SS_LAS unsigned char* xp = lds + A_XD + (e & 1) * 128 * XP + (8 * hh + rsel) * XP + (32 * pb + csel) * 2;
#pragma unroll
        for (int ks = 0; ks < 8; ++ks) {
            const s16x4 b0 = vtr(bp + (16 * ks) * BPT), b1 = vtr(bp + (16 * ks + 4) * BPT), x0 = vtr(xp + (16 * ks) * XP), x1 = vtr(xp + (16 * ks + 4) * XP);
            const bf16x8 bf = (bf16x8){b0[0], b0[1], b0[2], b0[3], b1[0], b1[1], b1[2], b1[3]}, xf = (bf16x8){x0[0], x0[1], x0[2], x0[3], x1[0], x1[1], x1[2], x1[3]};
            acc = __builtin_amdgcn_mfma_f32_32x32x16_bf16(bf, xf, acc, 0, 0, 0);
        }
        bf16_t* sp = ST + ((size_t)(c * 32 + 8 * g + e) * 64 + 32 * pb + c32) * 128 + 32 * nb + 4 * hh;
#pragma unroll
        for (int q = 0; q < 4; ++q) { uint2 o; o.x = cvtpk(acc[4 * q], acc[4 * q + 1]); o.y = cvtpk(acc[4 * q + 2], acc[4 * q + 3]); *(uint2*)(sp + 8 * q) = o; }
        __syncthreads();
    }
}
__device__ __forceinline__ void scan_phase(bf16_t* __restrict__ ST, const float* __restrict__ CD, int gtid) {
    const int h = gtid >> 12;
    unsigned* p = (unsigned*)ST + gtid;
    float r0 = 0.f, r1 = 0.f;
    for (int c0 = 0; c0 < 64; c0 += 16) {
        unsigned v[16]; float d[16];
#pragma unroll
        for (int i = 0; i < 16; ++i) { v[i] = p[(size_t)(c0 + i) * 131072]; d[i] = CD[(c0 + i) * 32 + h]; }
#pragma unroll
        for (int i = 0; i < 16; ++i) { p[(size_t)(c0 + i) * 131072] = cvtpk(r0, r1); r0 = r0 * d[i] + bflo(v[i]); r1 = r1 * d[i] + bfhi(v[i]); }
    }
}
constexpr int C_CS = 0, C_BS = 128 * CP  , C_X1 = C_BS  , C_CBT = 2 * 128 * CP  , C_X0 = C_CBT + 32768  , C_ACS = C_X0 + 128 * XP  , C_DTS = C_ACS + 4096,
              C_SSQ = C_DTS + 4096, C_END = C_SSQ + 1024;
static_assert(C_END <= 147456 && 128 * XP <= 128 * CP, "ssd phase C LDS");
template <bool STORE = true> __device__ __forceinline__ void phaseC_unit(SS_LAS unsigned char* lds, bf16_t* __restrict__ Hb, const float* __restrict__ DTb, const float* __restrict__ conv_w, const float* __restrict__ conv_b,
                                            const float* __restrict__ a_log, const float* __restrict__ d_skip, const float* __restrict__ norm_w, const bf16_t* __restrict__ ST, int c, int g) {
    const int tid = opaque_tid(), lane = tid & 63, w = __builtin_amdgcn_readfirstlane(tid >> 6), c32 = lane & 31, hh = lane >> 5;
    SS_LAS float* ACS = (SS_LAS float*)(lds + C_ACS); SS_LAS float* DTS = (SS_LAS float*)(lds + C_DTS); SS_LAS float* SSQ = (SS_LAS float*)(lds + C_SSQ);
    acs_tables(ACS, DTS, DTb, a_log, c, g);
    auto stageX = [&](int e, int item, int buf) {
        const int cg = item >> 3, seg = item & 7;
        conv_item(Hb, 128 * c, 16 * seg, g * 512 + e * 64 + cg * 8, conv_w, conv_b, [&](int l, const float (&v)[8]) {
            u32x4 o; o.x = cvtpk(v[0], v[1]); o.y = cvtpk(v[2], v[3]); o.z = cvtpk(v[4], v[5]); o.w = cvtpk(v[6], v[7]);
            *(SS_LAS u32x4*)(lds + (buf ? C_X1 : C_X0) + l * XP + cg * 16) = o; });
    };
    if (tid < 256) { const int isC = tid >> 7, it = tid & 127, cg = it >> 3, seg = it & 7;
        conv_item(Hb, 128 * c, 16 * seg, 2048 + isC * 512 + g * 128 + cg * 8, conv_w, conv_b, [&](int l, const float (&v)[8]) {
            u32x4 o; o.x = cvtpk(v[0], v[1]); o.y = cvtpk(v[2], v[3]); o.z = cvtpk(v[4], v[5]); o.w = cvtpk(v[6], v[7]);
            *(SS_LAS u32x4*)(lds + (isC ? C_CS : C_BS) + l * CP + cg * 16) = o; });
    } else if (tid < 320) stageX(0, tid - 256, 0);
    __syncthreads();
    for (int i = w; i < 10; i += 8) {
        const int sb = (i < 4) ? 0 : (i < 7) ? 1 : (i < 9) ? 2 : 3, lb = (i < 4) ? i : (i < 7) ? i - 3 : (i < 9) ? i - 5 : 3;
        f32x16 acc = (f32x16){0.f, 0.f, 0.f, 0.f, 0.f, 0.f, 0.f, 0.f, 0.f, 0.f, 0.f, 0.f, 0.f, 0.f, 0.f, 0.f};
        const SS_LAS unsigned char* bp = lds + C_BS + (32 * sb + c32) * CP + 16 * hh, *cp = lds + C_CS + (32 * lb + c32) * CP + 16 * hh;
#pragma unroll
        for (int ks = 0; ks < 8; ++ks) acc = __builtin_amdgcn_mfma_f32_32x32x16_bf16(*(const SS_LAS bf16x8*)(bp + 32 * ks), *(const SS_LAS bf16x8*)(cp + 32 * ks), acc, 0, 0, 0);
        SS_LAS unsigned* o = (SS_LAS unsigned*)(lds + C_CBT) + (sb * 4 + lb) * 512 + lane;
#pragma unroll
        for (int q = 0; q < 8; ++q) o[q * 64] = cvtpk(acc[2 * q], acc[2 * q + 1]);
    }
    __syncthreads();
    const int pb = w & 1, lb = w >> 1, lrow = 32 * lb + c32;
    const int rsel = ((lane & 15) >> 2), csel = 16 * ((lane >> 4) & 1) + 4 * (lane & 3);
    unsigned ypk[8][8];
    float ssq = 0.f;
    for (int e = 0; e < 8; ++e) {
        const int h = 8 * g + e;
        if (e + 1 < 8 && tid >= 448) stageX(e + 1, tid - 448, (e + 1) & 1);
        const int xoff = (e & 1) ? C_X1 : C_X0;
        f32x16 acc = (f32x16){0.f, 0.f, 0.f, 0.f, 0.f, 0.f, 0.f, 0.f, 0.f, 0.f, 0.f, 0.f, 0.f, 0.f, 0.f, 0.f};
        {
            const bf16_t* pp = ST + ((size_t)(c * 32 + h) * 64 + 32 * pb + c32) * 128 + 8 * hh;
            const SS_LAS unsigned char* cp = lds + C_CS + lrow * CP + 16 * hh;
#pragma unroll
            for (int ks = 0; ks < 8; ++ks) acc = __builtin_amdgcn_mfma_f32_32x32x16_bf16(*(const bf16x8*)(pp + 16 * ks), *(const SS_LAS bf16x8*)(cp + 32 * ks), acc, 0, 0, 0);
        }
        const float al = ACS[lrow * 8 + e], eal = __expf(al);
#pragma unroll
        for (int r = 0; r < 16; ++r) acc[r] *= eal;
        for (int sb = 0; sb <= lb; ++sb) {
            const SS_LAS unsigned* cbp = (const SS_LAS unsigned*)(lds + C_CBT) + (sb * 4 + lb) * 512 + lane;
            float m[16];
#pragma unroll
            for (int q = 0; q < 8; ++q) { const unsigned u = cbp[q * 64]; m[2 * q] = bflo(u); m[2 * q + 1] = bfhi(u); }
#pragma unroll
            for (int r = 0; r < 16; ++r) { const int srow = 32 * sb + (r & 3) + 8 * (r >> 2) + 4 * hh;
                const float f = __expf(al - ACS[srow * 8 + e]) * DTS[srow * 8 + e];
                m[r] = (srow <= lrow) ? m[r] * f : 0.f; }
            const SS_LAS unsigned char* xp = lds + xoff + (32 * sb + 4 * hh + rsel) * XP + (32 * pb + csel) * 2;
#pragma unroll
            for (int ks = 0; ks < 2; ++ks) {
                const s16x4 x0 = vtr(xp + (16 * ks) * XP), x1 = vtr(xp + (16 * ks + 8) * XP);
                const bf16x8 xf = (bf16x8){x0[0], x0[1], x0[2], x0[3], x1[0], x1[1], x1[2], x1[3]};
                u32x4 mm; mm.x = cvtpk(m[8 * ks], m[8 * ks + 1]); mm.y = cvtpk(m[8 * ks + 2], m[8 * ks + 3]); mm.z = cvtpk(m[8 * ks + 4], m[8 * ks + 5]); mm.w = cvtpk(m[8 * ks + 6], m[8 * ks + 7]);
                acc = __builtin_amdgcn_mfma_f32_32x32x16_bf16(xf, __builtin_bit_cast(bf16x8, mm), acc, 0, 0, 0);
            }
        }
        const float dsk = d_skip[h];
        const bf16_t* zp = Hb + (size_t)(128 * c + lrow) * HP_ + HC_Z + g * 512 + e * 64 + 32 * pb + 4 * hh;
        const SS_LAS unsigned char* xr = lds + xoff + lrow * XP + (32 * pb + 4 * hh) * 2;
        unsigned yt[8];
#pragma unroll
        for (int q = 0; q < 4; ++q) {
            const u32x2 zz = *(const u32x2*)(zp + 8 * q); const u32x2 xx = *(const SS_LAS u32x2*)(xr + 16 * q);
            const float zv[4] = {bflo(zz.x), bfhi(zz.x), bflo(zz.y), bfhi(zz.y)}, xv[4] = {bflo(xx.x), bfhi(xx.x), bflo(xx.y), bfhi(xx.y)};
            float y[4];
#pragma unroll
            for (int k = 0; k < 4; ++k) { y[k] = (acc[4 * q + k] + dsk * xv[k]) * (zv[k] / (1.f + __expf(-zv[k]))); ssq += y[k] * y[k]; }
            yt[2 * q] = cvtpk(y[0], y[1]); yt[2 * q + 1] = cvtpk(y[2], y[3]);
        }
#define SS_YSET(E) case E: { _Pragma("unroll") for (int q_ = 0; q_ < 8; ++q_) ypk[E][q_] = yt[q_]; } break;
        switch (e) { SS_YSET(0) SS_YSET(1) SS_YSET(2) SS_YSET(3) SS_YSET(4) SS_YSET(5) SS_YSET(6) default: { _Pragma("unroll") for (int q_ = 0; q_ < 8; ++q_) ypk[7][q_] = yt[q_]; } break; }
#undef SS_YSET
        __syncthreads();
    }
    ssq += __shfl_xor(ssq, 32);
    if (hh == 0) SSQ[pb * 128 + lrow] = ssq;
    __syncthreads();
    const float rstd = rsqrtf((SSQ[lrow] + SSQ[128 + lrow]) * (1.f / 512.f) + 1e-5f);
    bf16_t* op = Hb + (size_t)(128 * c + lrow) * HP_ + HC_Z + g * 512 + 32 * pb + 4 * hh;
    const float* nw = norm_w + g * 512 + 32 * pb + 4 * hh;
#pragma unroll
    for (int e = 0; e < 8; ++e)
#pragma unroll
        for (int q = 0; q < 4; ++q) { const f32x4 n4 = *(const f32x4*)(nw + e * 64 + 8 * q);
            uint2 o; o.x = cvtpk(bflo(ypk[e][2 * q]) * rstd * n4.x, bfhi(ypk[e][2 * q]) * rstd * n4.y); o.y = cvtpk(bflo(ypk[e][2 * q + 1]) * rstd * n4.z, bfhi(ypk[e][2 * q + 1]) * rstd * n4.w);
            if (STORE || o.x == 0x12345u) *(uint2*)(op + e * 64 + 8 * q) = o; }
    __syncthreads();
}
}


namespace psel {
#define PS_LAS __attribute__((address_space(3)))
typedef short bf16x8 __attribute__((ext_vector_type(8)));
typedef float f32x16 __attribute__((ext_vector_type(16)));
__device__ __forceinline__ int ord(float f) { const int b = __builtin_bit_cast(int, f); return b ^ ((b >> 31) & 0x7fffffff); }
__device__ __forceinline__ float unord(int t) { return __builtin_bit_cast(float, t ^ ((t >> 31) & 0x7fffffff)); }
#define PS_INS(top, v) do { int v_ = (v); _Pragma("unroll") for (int i_ = 0; i_ < 16; ++i_) { const int hi_ = max(top[i_], v_); v_ = min(top[i_], v_); top[i_] = hi_; } } while (0)
__device__ __forceinline__ void step(PS_LAS int* EX, const bf16_t* __restrict__ QP, const bf16_t* __restrict__ SUBK, int* __restrict__ IDX, float* __restrict__ GATE, int tok0, int hp) {
    const int tid = opaque_tid(), lane = tid & 63, w1 = __builtin_amdgcn_readfirstlane(tid >> 6), c32 = lane & 31, hh = lane >> 5;
    {
        const int tile = w1 >> 2, hsel = (w1 >> 1) & 1, half = w1 & 1, h = 2 * hp + hsel;
        const bf16_t* qp = QP + (size_t)(tok0 + 32 * tile + c32) * 2048 + h * 256 + half * 128 + 8 * hh;
        const bf16_t* kp = SUBK + ((size_t)(h * 2 + half) * 128 + c32) * 128 + 8 * hh;
        bf16x8 qf[8];
#pragma unroll
        for (int ks = 0; ks < 8; ++ks) qf[ks] = *(const bf16x8*)(qp + 16 * ks);
        int top[16];
#pragma unroll
        for (int i = 0; i < 16; ++i) top[i] = (int)0x80000000;
#pragma unroll
        for (int mt = 0; mt < 4; ++mt) {
            f32x16 acc = (f32x16){0.f, 0.f, 0.f, 0.f, 0.f, 0.f, 0.f, 0.f, 0.f, 0.f, 0.f, 0.f, 0.f, 0.f, 0.f, 0.f};
#pragma unroll
            for (int ks = 0; ks < 8; ++ks) acc = __builtin_amdgcn_mfma_f32_32x32x16_bf16(*(const bf16x8*)(kp + (size_t)(32 * mt) * 128 + 16 * ks), qf[ks], acc, 0, 0, 0);
#pragma unroll
            for (int r = 0; r < 16; ++r) { const int key = 32 * mt + (r & 3) + 8 * (r >> 2) + 4 * hh; const int v = (ord(acc[r]) & ~127) | (127 - key); PS_INS(top, v); }
        }
        int oth[16];
#pragma unroll
        for (int i = 0; i < 16; ++i) oth[i] = __shfl_xor(top[i], 32);
#pragma unroll
        for (int i = 0; i < 16; ++i) PS_INS(top, oth[i]);
        if (hh == 0) {
#pragma unroll
            for (int i = 0; i < 16; ++i) EX[(w1 * 16 + i) * 32 + c32] = top[i];
        }
    }
    __syncthreads();
    if (lane < 16) {
        const int task = w1 * 16 + lane, th = task >> 5, tok32 = task & 31, tile = th >> 1, hsel = th & 1, h = 2 * hp + hsel;
        const PS_LAS int* ea = EX + ((th * 2 + 0) * 16) * 32 + tok32; const PS_LAS int* eb = EX + ((th * 2 + 1) * 16) * 32 + tok32;
        float as[16], bs[16];
#pragma unroll
        for (int i = 0; i < 16; ++i) { as[i] = unord(ea[i * 32] & ~127); bs[i] = unord(eb[i * 32] & ~127); }
        int top[16];
#pragma unroll
        for (int i = 0; i < 16; ++i) top[i] = (int)0x80000000;
#pragma unroll
        for (int i = 0; i < 16; ++i)
#pragma unroll
            for (int j = 0; j < 16; ++j) if ((i + 1) * (j + 1) <= 16) { const int v = (ord(as[i] + bs[j]) & ~255) | (255 - (i * 16 + j)); PS_INS(top, v); }
        float sc[16]; int id[16];
#pragma unroll
        for (int r = 0; r < 16; ++r) { const int cn = 255 - (top[r] & 255), i = cn >> 4, j = cn & 15; const int pa = ea[i * 32], pb = eb[j * 32];
            sc[r] = unord(pa & ~127) + unord(pb & ~127); id[r] = (127 - (pa & 127)) * 128 + (127 - (pb & 127)); }
        float sum = 0.f; const float mx = sc[0];
#pragma unroll
        for (int r = 0; r < 16; ++r) { sc[r] = __expf(sc[r] - mx); sum += sc[r]; }
        const size_t o = (size_t)(tok0 + 32 * tile + tok32) * 128 + h * 16;
        const float inv = 1.f / sum;
#pragma unroll
        for (int r = 0; r < 16; r += 4) { *(f32x4*)(GATE + o + r) = (f32x4){sc[r] * inv, sc[r + 1] * inv, sc[r + 2] * inv, sc[r + 3] * inv}; *(u32x4*)(IDX + o + r) = (u32x4){(unsigned)id[r], (unsigned)id[r + 1], (unsigned)id[r + 2], (unsigned)id[r + 3]}; }
    }
    __syncthreads();
}
}


namespace xattn {
#define XA_LAS __attribute__((address_space(3)))
typedef short bf16x8 __attribute__((ext_vector_type(8)));
typedef short s16x4 __attribute__((ext_vector_type(4)));
typedef float f32x16 __attribute__((ext_vector_type(16)));
constexpr int RP = 528;
__device__ __forceinline__ unsigned cvtpk(float lo, float hi) { typedef float f2 __attribute__((ext_vector_type(2))); typedef __bf16 b2 __attribute__((ext_vector_type(2))); f2 v = {lo, hi}; b2 b = __builtin_convertvector(v, b2); return __builtin_bit_cast(unsigned, b); }
__device__ __forceinline__ void stage(XA_LAS unsigned char* lds, const bf16_t* __restrict__ src, int pitch, int tid) {
#pragma unroll 4
    for (int i = 0; i < 16; ++i) { const int q = tid + 512 * i, row = q >> 5, ch = q & 31; *(XA_LAS u32x4*)(lds + row * RP + ch * 16) = *(const u32x4*)(src + (size_t)row * pitch + ch * 8); }
}
__device__ __forceinline__ void unit(XA_LAS unsigned char* lds, const bf16_t* __restrict__ QC, const bf16_t* __restrict__ KC, const bf16_t* __restrict__ VcT, bf16_t* __restrict__ XO, int tg, int h) {
    const int tid = opaque_tid(), lane = tid & 63, w = __builtin_amdgcn_readfirstlane(tid >> 6), c32 = lane & 31, hh = lane >> 5, b = tg >> 5;
    const int tok = 256 * tg + 32 * w + c32;
    stage(lds, KC + (size_t)b * MEML * D + h * 256, D, tid);
    bf16x8 pf[8][2]; float inv;
    {
        bf16x8 qf[16];
        const bf16_t* qp = QC + (size_t)tok * D + h * 256 + 8 * hh;
#pragma unroll
        for (int ks = 0; ks < 16; ++ks) qf[ks] = *(const bf16x8*)(qp + 16 * ks);
        __syncthreads();
        f32x16 acc[8];
        const XA_LAS unsigned char* kb = lds + c32 * RP + 16 * hh;
#pragma unroll
        for (int mt = 0; mt < 8; ++mt) {
            acc[mt] = (f32x16){0.f, 0.f, 0.f, 0.f, 0.f, 0.f, 0.f, 0.f, 0.f, 0.f, 0.f, 0.f, 0.f, 0.f, 0.f, 0.f};
#pragma unroll
            for (int ks = 0; ks < 16; ++ks) acc[mt] = __builtin_amdgcn_mfma_f32_32x32x16_bf16(*(const XA_LAS bf16x8*)(kb + (32 * mt) * RP + 32 * ks), qf[ks], acc[mt], 0, 0, 0);
        }
        float mx = acc[0][0];
#pragma unroll
        for (int mt = 0; mt < 8; ++mt)
#pragma unroll
            for (int r = 0; r < 16; ++r) mx = fmaxf(mx, acc[mt][r]);
        mx = fmaxf(mx, __shfl_xor(mx, 32));
        float sum = 0.f;
#pragma unroll
        for (int mt = 0; mt < 8; ++mt)
#pragma unroll
            for (int r = 0; r < 16; ++r) { acc[mt][r] = __builtin_amdgcn_exp2f(acc[mt][r] - mx); sum += acc[mt][r]; }
        sum += __shfl_xor(sum, 32); inv = 1.f / sum;
#pragma unroll
        for (int mt = 0; mt < 8; ++mt)
#pragma unroll
            for (int s2 = 0; s2 < 2; ++s2) { u32x4 a; a.x = cvtpk(acc[mt][8 * s2], acc[mt][8 * s2 + 1]); a.y = cvtpk(acc[mt][8 * s2 + 2], acc[mt][8 * s2 + 3]); a.z = cvtpk(acc[mt][8 * s2 + 4], acc[mt][8 * s2 + 5]); a.w = cvtpk(acc[mt][8 * s2 + 6], acc[mt][8 * s2 + 7]);
                pf[mt][s2] = __builtin_bit_cast(bf16x8, a); }
    }
    __syncthreads();
    stage(lds, VcT + ((size_t)b * D + h * 256) * MEML, MEML, tid);
    __syncthreads();
    const XA_LAS unsigned char* vb = lds + c32 * RP + 8 * hh;
    bf16_t* op = XO + (size_t)tok * D + h * 256 + 4 * hh;
#pragma unroll 1
    for (int dt = 0; dt < 8; ++dt) {
        f32x16 acc = (f32x16){0.f, 0.f, 0.f, 0.f, 0.f, 0.f, 0.f, 0.f, 0.f, 0.f, 0.f, 0.f, 0.f, 0.f, 0.f, 0.f};
#pragma unroll
        for (int mt = 0; mt < 8; ++mt)
#pragma unroll
            for (int s2 = 0; s2 < 2; ++s2) {
                const s16x4 lo = *(const XA_LAS s16x4*)(vb + (32 * dt) * RP + (32 * mt + 16 * s2) * 2), hi = *(const XA_LAS s16x4*)(vb + (32 * dt) * RP + (32 * mt + 16 * s2 + 8) * 2);
                const bf16x8 vf = (bf16x8){lo[0], lo[1], lo[2], lo[3], hi[0], hi[1], hi[2], hi[3]};
                acc = __builtin_amdgcn_mfma_f32_32x32x16_bf16(vf, pf[mt][s2], acc, 0, 0, 0);
            }
#pragma unroll
        for (int q = 0; q < 4; ++q) { u32x2 o; o.x = cvtpk(acc[4 * q] * inv, acc[4 * q + 1] * inv); o.y = cvtpk(acc[4 * q + 2] * inv, acc[4 * q + 3] * inv); *(u32x2*)(op + 32 * dt + 8 * q) = o; }
    }
    __syncthreads();
}
}

namespace sp {
#define SP_LAS __attribute__((address_space(3)))
#define SP_LDSWAIT() do { asm volatile("s_waitcnt lgkmcnt(0)" ::: "memory"); } while (0)
__device__ __forceinline__ void transpose_item(const float* __restrict__ W, int ldw, int col0, int K, int nblk, bf16_t* __restrict__ WT, int row_off, SP_LAS float* scr, int item, int lane) {
    const int kb = item / nblk, nb = item % nblk, k0 = 64 * kb, n0 = 32 * nb;
#pragma unroll 8
    for (int i = 0; i < 32; ++i) { const int kk = 2 * i + (lane >> 5); scr[kk * 33 + (lane & 31)] = W[(size_t)(k0 + kk) * ldw + col0 + n0 + (lane & 31)]; }
    SP_LDSWAIT();
    const int cc = lane & 7;
#pragma unroll
    for (int j = 0; j < 4; ++j) { const int n = (lane >> 3) + 8 * j; const SP_LAS float* s = scr + (8 * cc) * 33 + n;
        u32x4 o; o.x = pk2(s[0 * 33], s[1 * 33]); o.y = pk2(s[2 * 33], s[3 * 33]); o.z = pk2(s[4 * 33], s[5 * 33]); o.w = pk2(s[6 * 33], s[7 * 33]);
        *(u32x4*)(WT + (size_t)(row_off + n0 + n) * K + k0 + 8 * cc) = o; }
    SP_LDSWAIT();
}
__device__ __forceinline__ void cvt_range(const float* __restrict__ src, bf16_t* __restrict__ dst, size_t n4, size_t gtid, size_t gthreads) {
    for (size_t i = gtid; i < n4; i += gthreads) { const f32x4 v = ((const f32x4*)src)[i]; u32x2 o; o.x = pk2(v.x, v.y); o.y = pk2(v.z, v.w); ((u32x2*)dst)[i] = o; }
}
__device__ __forceinline__ void dt_item(SP_LAS float* xs, const float* __restrict__ x, const float* __restrict__ w_in, const float* __restrict__ dt_bias, float* __restrict__ DT, int item) {
    const int tid = opaque_tid(), m0 = item * 16;
    for (int i = tid; i < 16 * 256; i += 512) { const f32x4 v = ((const f32x4*)(x + (size_t)m0 * D))[i]; *(SP_LAS f32x4*)(xs + 4 * i) = v; }
    __syncthreads();
    const int h = tid & 31, r = tid >> 5; float acc = 0.f;
    const float* wp = w_in + 5120 + h;
#pragma unroll 8
    for (int k = 0; k < 1024; ++k) acc = fmaf(xs[r * 1024 + k], wp[(size_t)k * NIN], acc);
    const float v = acc + dt_bias[h];
    DT[(size_t)(m0 + r) * 32 + h] = v > 20.f ? v : log1pf(expf(v));
    __syncthreads();
}
__device__ __forceinline__ void ln_row(float* __restrict__ X, const float* __restrict__ g, const float* __restrict__ b, bf16_t* __restrict__ XB, int row, int lane) {
    f32x4* xr = (f32x4*)(X + (size_t)row * D) + lane;
    f32x4 v[4]; float s = 0.f;
#pragma unroll
    for (int j = 0; j < 4; ++j) { v[j] = xr[64 * j]; s += (v[j].x + v[j].y) + (v[j].z + v[j].w); }
    const float mean = wave_sum(s) * (1.f / D); float s2 = 0.f;
#pragma unroll
    for (int j = 0; j < 4; ++j) { v[j] = v[j] - mean; s2 += (v[j].x * v[j].x + v[j].y * v[j].y) + (v[j].z * v[j].z + v[j].w * v[j].w); }
    const float rstd = rsqrtf(wave_sum(s2) * (1.f / D) + 1e-5f);
#pragma unroll
    for (int j = 0; j < 4; ++j) { const int c = 4 * lane + 256 * j; const f32x4 gg = *(const f32x4*)(g + c), bb = *(const f32x4*)(b + c);
        f32x4 o = v[j] * rstd * gg + bb; xr[64 * j] = o;
        u32x2 pb; pb.x = pk2(o.x, o.y); pb.y = pk2(o.z, o.w); *(u32x2*)(XB + (size_t)row * D + c) = pb; }
}
__device__ __forceinline__ void xattn_pair(SP_LAS float* L, const bf16_t* __restrict__ QC, const bf16_t* __restrict__ KCVC, bf16_t* __restrict__ XO, int tok0) {
    const int t512 = opaque_tid(); const int half = t512 >> 8, tid = t512 & 255, lane = tid & 63, wv = tid >> 6, tok = tok0 + half, b = tok / SEQ;
    SP_LAS float* qs = L + half * 1024; SP_LAS float* ps = L + 2048 + half * 256; SP_LAS float* red = L + 2560 + half * 8;
    for (int i = tid; i < 1024; i += 256) qs[i] = bf2f(QC[(size_t)tok * D + i]);
    __syncthreads();
    const bf16_t* KV = KCVC + (size_t)b * MEML * 2048;
    for (int h = 0; h < MH; ++h) {
        const bf16_t* kp = KV + (size_t)tid * 2048 + h * 256;
        float s = 0.f;
        for (int d = 0; d < 256; d += 8) { const u32x4 w = *(const u32x4*)(kp + d); const SP_LAS float* q = qs + h * 256 + d;
            s += q[0] * bflo(w.x) + q[1] * bfhi(w.x) + q[2] * bflo(w.y) + q[3] * bfhi(w.y) + q[4] * bflo(w.z) + q[5] * bfhi(w.z) + q[6] * bflo(w.w) + q[7] * bfhi(w.w); }
        float mx = wave_max(s); if (lane == 0) red[wv] = mx; __syncthreads();
        mx = fmaxf(fmaxf(red[0], red[1]), fmaxf(red[2], red[3]));
        const float p = exp2f(s - mx);
        float sm = wave_sum(p); if (lane == 0) red[4 + wv] = sm; ps[tid] = p; __syncthreads();
        sm = (red[4] + red[5]) + (red[6] + red[7]);
        float o = 0.f;
        for (int j = 0; j < 256; ++j) o = fmaf(ps[j], bf2f(KV[(size_t)j * 2048 + 1024 + h * 256 + tid]), o);
        XO[(size_t)tok * D + h * 256 + tid] = (bf16_t)f2bf(o / sm);
        __syncthreads();
    }
}
__device__ __forceinline__ void select_pair(SP_LAS float* L, const bf16_t* __restrict__ QP, const bf16_t* __restrict__ SUBK, int* __restrict__ IDX, float* __restrict__ GATE, int tok0) {
    const int t512 = opaque_tid(); const int hf = t512 >> 8, tid = t512 & 255, tok = tok0 + hf;
    SP_LAS float* base = L + hf * 3072;
    SP_LAS float* qs = base; SP_LAS float* s = base + 2048; SP_LAS float* tops = base + 2304; SP_LAS int* topi = (SP_LAS int*)(base + 2336); SP_LAS float* cs = base + 2368; SP_LAS int* ci = (SP_LAS int*)(base + 2624);
    SP_LAS float* bs = base + 2880; SP_LAS int* bi = (SP_LAS int*)(base + 2896);
    for (int i = tid; i < 2048; i += 256) qs[i] = bf2f(QP[(size_t)tok * 2048 + i]);
    __syncthreads();
    for (int h = 0; h < PH; ++h) {
        const int half = tid >> 7, key = tid & 127;
        { const bf16_t* kp = SUBK + ((size_t)(h * 2 + half) * 128 + key) * 128; const SP_LAS float* q = qs + h * 256 + half * 128; float a = 0.f;
          for (int d = 0; d < 128; d += 8) { const u32x4 w = *(const u32x4*)(kp + d);
              a += q[d] * bflo(w.x) + q[d + 1] * bfhi(w.x) + q[d + 2] * bflo(w.y) + q[d + 3] * bfhi(w.y) + q[d + 4] * bflo(w.z) + q[d + 5] * bfhi(w.z) + q[d + 6] * bflo(w.w) + q[d + 7] * bfhi(w.w); }
          s[tid] = a; }
        __syncthreads();
        { const float me = s[tid]; int rank = 0; const SP_LAS float* spp = s + half * 128;
          for (int j = 0; j < 128; ++j) { const float o = spp[j]; rank += (o > me || (o == me && j < key)) ? 1 : 0; }
          if (rank < 16) { tops[half * 16 + rank] = me; topi[half * 16 + rank] = key; } }
        __syncthreads();
        { const int i = tid >> 4, j = tid & 15; cs[tid] = tops[i] + tops[16 + j]; ci[tid] = topi[i] * 128 + topi[16 + j]; }
        __syncthreads();
        { const float me = cs[tid]; int rank = 0;
          for (int j = 0; j < 256; ++j) { const float o = cs[j]; rank += (o > me || (o == me && j < tid)) ? 1 : 0; }
          if (rank < 16) { bs[rank] = me; bi[rank] = ci[tid]; } }
        __syncthreads();
        if (tid < 16) { const float mx = bs[0]; float sum = 0.f;
            for (int j = 0; j < 16; ++j) sum += expf(bs[j] - mx);
            GATE[(size_t)tok * 128 + h * 16 + tid] = expf(bs[tid] - mx) / sum; IDX[(size_t)tok * 128 + h * 16 + tid] = bi[tid]; }
        __syncthreads();
    }
}
__device__ __forceinline__ void gather_token(SP_LAS float* L, float* __restrict__ X, const bf16_t* __restrict__ PU, const bf16_t* __restrict__ PV, const int* __restrict__ IDX, const float* __restrict__ GATE,
                                             const float* __restrict__ g3, const float* __restrict__ b3, int tok) {
    const int tid = opaque_tid(), lane = tid & 63, wv = tid >> 6;
    SP_LAS float* ys = L; SP_LAS float* red = L + 8192;
    float xr[16], y[16];
    { const float* xp = X + (size_t)tok * D + lane * 16;
#pragma unroll
      for (int j = 0; j < 4; ++j) { const f32x4 v = *(const f32x4*)(xp + 4 * j); xr[4 * j] = v.x; xr[4 * j + 1] = v.y; xr[4 * j + 2] = v.z; xr[4 * j + 3] = v.w; }
#pragma unroll
      for (int j = 0; j < 16; ++j) y[j] = 0.f; }
    for (int e = 0; e < 16; ++e) {
        const int slot = wv * 16 + e; const int id = IDX[(size_t)tok * 128 + slot]; const float gt = GATE[(size_t)tok * 128 + slot];
        const bf16_t* up = PU + (size_t)id * D + lane * 16; const u32x4 u0 = *(const u32x4*)up, u1 = *(const u32x4*)(up + 8);
        const unsigned uw[8] = {u0.x, u0.y, u0.z, u0.w, u1.x, u1.y, u1.z, u1.w};
        float hsum = 0.f;
#pragma unroll
        for (int j = 0; j < 8; ++j) { hsum = fmaf(xr[2 * j], bflo(uw[j]), hsum); hsum = fmaf(xr[2 * j + 1], bfhi(uw[j]), hsum); }
        hsum = wave_sum(hsum);
        const float w = gt * 0.5f * hsum * (1.f + erff(hsum * 0.70710678118654752f));
        const bf16_t* vp = PV + (size_t)id * D + lane * 16; const u32x4 v0 = *(const u32x4*)vp, v1 = *(const u32x4*)(vp + 8);
        const unsigned vw[8] = {v0.x, v0.y, v0.z, v0.w, v1.x, v1.y, v1.z, v1.w};
#pragma unroll
        for (int j = 0; j < 8; ++j) { y[2 * j] = fmaf(w, bflo(vw[j]), y[2 * j]); y[2 * j + 1] = fmaf(w, bfhi(vw[j]), y[2 * j + 1]); }
    }
#pragma unroll
    for (int j = 0; j < 16; ++j) ys[wv * 1024 + lane * 16 + j] = y[j];
    __syncthreads();
    float v[2]; float s = 0.f;
#pragma unroll
    for (int j = 0; j < 2; ++j) { const int c = tid * 2 + j; float a = 0.f;
#pragma unroll
        for (int k = 0; k < 8; ++k) a += ys[k * 1024 + c];
        v[j] = ALPHA * X[(size_t)tok * D + c] + a; s += v[j]; }
    s = wave_sum(s); if (lane == 0) red[wv] = s; __syncthreads();
    float tot = 0.f;
#pragma unroll
    for (int k = 0; k < 8; ++k) tot += red[k];
    const float mean = tot * (1.f / D);
    float s2 = 0.f;
#pragma unroll
    for (int j = 0; j < 2; ++j) { v[j] -= mean; s2 += v[j] * v[j]; }
    s2 = wave_sum(s2); if (lane == 0) red[8 + wv] = s2; __syncthreads();
    float tot2 = 0.f;
#pragma unroll
    for (int k = 0; k < 8; ++k) tot2 += red[8 + k];
    const float rstd = rsqrtf(tot2 * (1.f / D) + 1e-5f);
#pragma unroll
    for (int j = 0; j < 2; ++j) { const int c = tid * 2 + j; X[(size_t)tok * D + c] = v[j] * rstd * g3[c] + b3[c]; }
    __syncthreads();
}

__device__ __forceinline__ void gather_wave(float* __restrict__ X, const bf16_t* __restrict__ PU, const bf16_t* __restrict__ PV, const int* __restrict__ IDX, const float* __restrict__ GATE,
                                            const float* __restrict__ g3, const float* __restrict__ b3, int tok, int lane) {
    float xr[16], y[16];
    { const float* xp = X + (size_t)tok * D + 8 * lane;
      const f32x4 a = *(const f32x4*)xp, b = *(const f32x4*)(xp + 4), c2 = *(const f32x4*)(xp + 512), d2 = *(const f32x4*)(xp + 516);
      xr[0] = a.x; xr[1] = a.y; xr[2] = a.z; xr[3] = a.w; xr[4] = b.x; xr[5] = b.y; xr[6] = b.z; xr[7] = b.w;
      xr[8] = c2.x; xr[9] = c2.y; xr[10] = c2.z; xr[11] = c2.w; xr[12] = d2.x; xr[13] = d2.y; xr[14] = d2.z; xr[15] = d2.w; }
#pragma unroll
    for (int j = 0; j < 16; ++j) y[j] = 0.f;
    const int id0 = IDX[(size_t)tok * 128 + lane], id1 = IDX[(size_t)tok * 128 + 64 + lane];
    const float gt0 = GATE[(size_t)tok * 128 + lane], gt1 = GATE[(size_t)tok * 128 + 64 + lane];
    u32x4 ub[8][2], vb[8][2];
#define GW_ISSUE(buf, TBL, i) do { const int idv_ = ((i) < 8) ? id0 : id1; _Pragma("unroll") for (int k_ = 0; k_ < 8; ++k_) { \
        const int id_ = __builtin_amdgcn_readlane(idv_, (8 * (i) + k_) & 63); const bf16_t* row_ = (TBL) + (size_t)id_ * D + 8 * lane; \
        buf[k_][0] = *(const u32x4*)row_; buf[k_][1] = *(const u32x4*)(row_ + 512); } } while (0)
    GW_ISSUE(ub, PU, 0); GW_ISSUE(vb, PV, 0);
    const bool h32 = (lane & 32) != 0, h16 = (lane & 16) != 0, h8 = (lane & 8) != 0;
#pragma unroll 1
    for (int i = 0; i < 16; ++i) {
        float p[8];
#pragma unroll
        for (int k = 0; k < 8; ++k) { const unsigned w[8] = {ub[k][0].x, ub[k][0].y, ub[k][0].z, ub[k][0].w, ub[k][1].x, ub[k][1].y, ub[k][1].z, ub[k][1].w}; float a = 0.f;
#pragma unroll
            for (int j = 0; j < 8; ++j) { a = fmaf(xr[2 * j], bflo(w[j]), a); a = fmaf(xr[2 * j + 1], bfhi(w[j]), a); }
            p[k] = a; __builtin_amdgcn_sched_barrier(0); }
        { const int in_ = (i + 1 < 16) ? i + 1 : 15; GW_ISSUE(ub, PU, in_); }
        float q4[4], q2[2], q1;
#pragma unroll
        for (int k = 0; k < 4; ++k) q4[k] = (h32 ? p[k + 4] : p[k]) + __shfl_xor(h32 ? p[k] : p[k + 4], 32);
#pragma unroll
        for (int k = 0; k < 2; ++k) q2[k] = (h16 ? q4[k + 2] : q4[k]) + __shfl_xor(h16 ? q4[k] : q4[k + 2], 16);
        q1 = (h8 ? q2[1] : q2[0]) + __shfl_xor(h8 ? q2[0] : q2[1], 8);
        q1 += __shfl_xor(q1, 4); q1 += __shfl_xor(q1, 2); q1 += __shfl_xor(q1, 1);
        const float gsel = __shfl((i < 8) ? gt0 : gt1, (8 * i + (lane >> 3)) & 63);
        const float wv = gsel * 0.5f * q1 * (1.f + erff(q1 * 0.70710678118654752f));
#pragma unroll
        for (int k = 0; k < 8; ++k) { const float wk = __builtin_bit_cast(float, __builtin_amdgcn_readlane(__builtin_bit_cast(int, wv), 8 * k));
            const unsigned w[8] = {vb[k][0].x, vb[k][0].y, vb[k][0].z, vb[k][0].w, vb[k][1].x, vb[k][1].y, vb[k][1].z, vb[k][1].w};
#pragma unroll
            for (int j = 0; j < 8; ++j) { y[2 * j] = fmaf(wk, bflo(w[j]), y[2 * j]); y[2 * j + 1] = fmaf(wk, bfhi(w[j]), y[2 * j + 1]); }
            __builtin_amdgcn_sched_barrier(0); }
        { const int in_ = (i + 1 < 16) ? i + 1 : 15; GW_ISSUE(vb, PV, in_); }
    }
#undef GW_ISSUE
    float s = 0.f;
#pragma unroll
    for (int j = 0; j < 16; ++j) { y[j] = ALPHA * xr[j] + y[j]; s += y[j]; }
    const float mean = wave_sum(s) * (1.f / D); float s2 = 0.f;
#pragma unroll
    for (int j = 0; j < 16; ++j) { y[j] -= mean; s2 += y[j] * y[j]; }
    const float rstd = rsqrtf(wave_sum(s2) * (1.f / D) + 1e-5f);
    float* op = X + (size_t)tok * D + 8 * lane;
#pragma unroll
    for (int hq = 0; hq < 4; ++hq) { const int off = (hq >> 1) * 512 + (hq & 1) * 4; const f32x4 gg = *(const f32x4*)(g3 + 8 * lane + off), bb = *(const f32x4*)(b3 + 8 * lane + off);
        f32x4 o; o.x = y[4 * hq] * rstd * gg.x + bb.x; o.y = y[4 * hq + 1] * rstd * gg.y + bb.y; o.z = y[4 * hq + 2] * rstd * gg.z + bb.z; o.w = y[4 * hq + 3] * rstd * gg.w + bb.w;
        *(f32x4*)(op + off) = o; }
}
}


#define LAS __attribute__((address_space(3)))
#define XB_TMO      128
#define XB_XCNT(j)  (256  + 64 * (j))
#define XB_XSUB(j)  (1280 + 64 * (j))
#define XB_XGEN(j)  (2304 + 64 * (j))
#define XB_TOP      3328
#define XB_TOPGEN   3392
#define XCD_BAR_WORDS 3456
#define XB_SPIN_CAP (1u << 18)
__device__ __forceinline__ unsigned xb_ld(unsigned* p)              { return __hip_atomic_load(p, __ATOMIC_RELAXED, __HIP_MEMORY_SCOPE_AGENT); }
__device__ __forceinline__ unsigned xb_add(unsigned* p, unsigned v) { return __hip_atomic_fetch_add(p, v, __ATOMIC_RELAXED, __HIP_MEMORY_SCOPE_AGENT); }
__device__ __forceinline__ unsigned xb_xcc_id() { return (unsigned)__builtin_amdgcn_s_getreg((3 << 11) | 20) & 0xFu; }
#define XB_SPIN(cond, bar) do { unsigned _sp = 0; while (cond) { __builtin_amdgcn_s_sleep(1); \
    if ((++_sp & 255u) == 0u) { if (xb_ld(&(bar)[XB_TMO])) break; if (_sp > XB_SPIN_CAP) { atomicAdd(&(bar)[XB_TMO], 1u); break; } } } } while (0)
struct XcdBarrier { unsigned* bar; unsigned x; volatile LAS unsigned* st; };
__device__ __forceinline__ XcdBarrier xcd_barrier_post(unsigned* bar, volatile LAS unsigned* st) {
    XcdBarrier b; b.bar = bar; b.x = xb_xcc_id(); b.st = st;
    if (threadIdx.x == 0) (void)xb_add(&bar[XB_XCNT(b.x)], 1u);
    return b;
}
__device__ __forceinline__ void xcd_barrier_complete(unsigned* bar, unsigned x, unsigned& nloc, unsigned& nx) {
    const unsigned G = gridDim.x * gridDim.y * gridDim.z;
    unsigned sum, cnt, mine, sp = 0u;
    for (;;) {
        sum = 0u; cnt = 0u; mine = 0u;
#pragma unroll
        for (unsigned j = 0; j < 16; ++j) { const unsigned c = xb_ld(&bar[XB_XCNT(j)]); sum += c; cnt += (c > 0u) ? 1u : 0u; mine = (j == x) ? c : mine; }
        if (sum == G) break;
        __builtin_amdgcn_s_sleep(1);
        if ((++sp & 255u) == 0u) { if (xb_ld(&bar[XB_TMO])) break; if (sp > XB_SPIN_CAP) { atomicAdd(&bar[XB_TMO], 1u); break; } }
    }
    nloc = mine > 0u ? mine : 1u; nx = cnt > 0u ? cnt : 1u;
}
__device__ __forceinline__ void xcd_barrier(const XcdBarrier& b) {
    asm volatile("s_waitcnt vmcnt(0)" ::: "memory");
    __syncthreads();
    if (threadIdx.x == 0) {
        unsigned* bar = b.bar;
        __builtin_amdgcn_s_waitcnt(0);
        unsigned nloc = b.st[0], nx = b.st[1];
        if (nloc == 0u) { xcd_barrier_complete(bar, b.x, nloc, nx); b.st[0] = nloc; b.st[1] = nx; }
        const unsigned old = xb_add(&bar[XB_XSUB(b.x)], 1u);
        const unsigned gen = old / nloc;
        if (old + 1u == (gen + 1u) * nloc) {
            __builtin_amdgcn_fence(__ATOMIC_RELEASE, "agent");
            asm volatile("s_waitcnt vmcnt(0)" ::: "memory");
            const unsigned og = xb_add(&bar[XB_TOP], 1u);
            const unsigned tg = og / nx;
            if (og + 1u == (tg + 1u) * nx) xb_add(&bar[XB_TOPGEN], 1u);
            else XB_SPIN(xb_ld(&bar[XB_TOPGEN]) == tg, bar);
            __builtin_amdgcn_fence(__ATOMIC_ACQUIRE, "agent");
            xb_add(&bar[XB_XGEN(b.x)], 1u);
            asm volatile("s_waitcnt vmcnt(0)" ::: "memory");
        } else {
            XB_SPIN(xb_ld(&bar[XB_XGEN(b.x)]) == gen, bar);
            __builtin_amdgcn_fence(__ATOMIC_ACQUIRE, "agent");
            asm volatile("s_waitcnt vmcnt(0)" ::: "memory");
        }
    }
    __syncthreads();
}
constexpr int CW_BAR = 4096;
constexpr int MISC_OFF = 147456 - 64;

struct Params { const float* in[30]; float* out; unsigned char* ws; };
template <class F> __device__ __forceinline__ void run_gemm(unsigned char* lds, const bf16_t* A, int lda, const bf16_t* Bt, int Mr, int N, int K, F f) {
    pg8::Gemm g{A, Bt, Mr, N, K, lda}; pg8::StaticOrder S; S.init(Mr, N, gridDim.x, blockIdx.x); pg8::EpiAdapt<F> E{f};
    pg8::gemm_phase<pg8::EpiAdapt<F>, pg8::StaticOrder, true>((PG8_LAS unsigned char*)lds, g, S, E);
}
#ifndef PROBE_ATTN
#define PROBE_ATTN 0
#endif
#ifndef PROBE_SSD
#define PROBE_SSD 0
#endif
#ifndef PROBE_SYNC
#define PROBE_SYNC 0
#endif
#define KA_LAS __attribute__((address_space(4)))
#define PH_BEGIN const KA_LAS unsigned char* ka_ = (const KA_LAS unsigned char*)__builtin_amdgcn_kernarg_segment_ptr(); asm volatile("" : "+s"(ka_))
#define PIN(k) (*(const float* const KA_LAS*)(ka_ + 8 * (k)))
#define POUT (*(float* const KA_LAS*)(ka_ + 240))
#define PWS (*(unsigned char* const KA_LAS*)(ka_ + 248))
__global__ void __launch_bounds__(512, 2) hybrid_fwd(Params P) {
    extern __shared__ __attribute__((aligned(16))) unsigned char lds[];
    cg::grid_group grid = cg::this_grid();
    { PH_BEGIN; volatile LAS unsigned* misc = (volatile LAS unsigned*)((LAS unsigned char*)lds + MISC_OFF);
      if (threadIdx.x < 16) misc[threadIdx.x] = 0u;
      __syncthreads();
      (void)xcd_barrier_post((unsigned*)(PWS + WS_CTL) + CW_BAR, misc); }
#define GSYNC() do { PH_BEGIN; XcdBarrier xb_; xb_.bar = (unsigned*)(PWS + WS_CTL) + CW_BAR; xb_.x = xb_xcc_id(); xb_.st = (volatile LAS unsigned*)((LAS unsigned char*)lds + MISC_OFF); xcd_barrier(xb_); } while (0)
    {
        PH_BEGIN; unsigned char* ws = PWS;
        const int tid = opaque_tid(), lane = tid & 63, wave = __builtin_amdgcn_readfirstlane(tid >> 6), c = blockIdx.x, G = gridDim.x;
        const size_t gtid = (size_t)c * 512 + tid, gthreads = (size_t)G * 512; const int gw = c * 8 + wave, NGW = G * 8;
        const float* w_in = PIN(2);
        bf16_t* WinT = (bf16_t*)(ws + WS_WIN); bf16_t* WckvT = (bf16_t*)(ws + WS_WCKV);
        SP_LAS float* scr = (SP_LAS float*)lds + wave * (64 * 33);
        constexpr int I0 = 2560, I1 = 5120, I2 = 6144, I3 = 6656, I4 = 7168, I5 = 7680, I6 = 8192, I7 = 8704, I8 = 9216, I9 = 10240;
        for (int it = gw; it < I9; it += NGW) {
            if (it < I0) sp::transpose_item(w_in, NIN, 0, D, 160, WinT, 0, scr, it, lane);
            else if (it < I1) sp::transpose_item(w_in, NIN, 5152, D, 160, WinT, 5120, scr, it - I0, lane);
            else if (it < I2) sp::transpose_item(PIN(9), D, 0, DI, 32, (bf16_t*)(ws + WS_WSSD), 0, scr, it - I1, lane);
            else if (it < I3) sp::transpose_item(PIN(13), D, 0, D, 32, (bf16_t*)(ws + WS_WDIFF), 0, scr, it - I2, lane);
            else if (it < I4) sp::transpose_item(PIN(15), D, 0, D, 32, (bf16_t*)(ws + WS_WO), 0, scr, it - I3, lane);
            else if (it < I5) sp::transpose_item(PIN(18), D, 0, D, 32, (bf16_t*)(ws + WS_WCQ), 0, scr, it - I4, lane);
            else if (it < I6) sp::transpose_item(PIN(19), D, 0, D, 32, WckvT, 0, scr, it - I5, lane);
            else if (it < I7) sp::transpose_item(PIN(20), D, 0, D, 32, WckvT, 1024, scr, it - I6, lane);
            else if (it < I8) sp::transpose_item(PIN(21), D, 0, D, 32, (bf16_t*)(ws + WS_WCO), 0, scr, it - I7, lane);
            else sp::transpose_item(PIN(24), 2048, 0, D, 64, (bf16_t*)(ws + WS_WPQ), 0, scr, it - I8, lane);
        }
        const float* x = PIN(0);
        sp::cvt_range(x, (bf16_t*)(ws + WS_XB), (size_t)M * D / 4, gtid, gthreads);
        sp::cvt_range(PIN(1), (bf16_t*)(ws + WS_MEMB), (size_t)BATCH * MEML * D / 4, gtid, gthreads);
        sp::cvt_range(PIN(25), (bf16_t*)(ws + WS_SUBK), (size_t)PH * 2 * PK * PHALF / 4, gtid, gthreads);
        __syncthreads();
        for (int it = c; it < M / 16; it += G) sp::dt_item((SP_LAS float*)lds, x, w_in, PIN(5), (float*)(ws + WS_DT), it);
        if (c == 0 && tid == 0) { const float* lam_q = PIN(10); const float* lam_k = PIN(11); float s0 = 0.f, s1 = 0.f;
            for (int i = 0; i < 64; ++i) { s0 += lam_q[i] * lam_k[i]; s1 += lam_q[64 + i] * lam_k[64 + i]; }
            ((float*)(ws + WS_CTL))[CW_LAM] = expf(s0) - expf(s1) + LAMBDA_INIT; }
    }
    grid.sync();
    { PH_BEGIN; unsigned char* ws = PWS;
      run_gemm(lds, (const bf16_t*)(ws + WS_MEMB), D, (const bf16_t*)(ws + WS_WCKV), BATCH * MEML, D, D, EpiPlain{(bf16_t*)(ws + WS_KCVC), D, 1.f});
      for (int bb = 0; bb < BATCH; ++bb)
          run_gemm(lds, (const bf16_t*)(ws + WS_WCKV) + (size_t)D * D, D, (const bf16_t*)(ws + WS_MEMB) + (size_t)bb * MEML * D, D, MEML, D, EpiPlain{(bf16_t*)(ws + WS_KCVC) + (size_t)BATCH * MEML * D + (size_t)bb * D * MEML, MEML, 1.f});
      run_gemm(lds, (const bf16_t*)(ws + WS_XB), D, (const bf16_t*)(ws + WS_WIN), SEQ, NINP, D, EpiInProj{(bf16_t*)(ws + WS_H), PIN(14)}); }
    GSYNC();
#pragma unroll 1
    for (int b = 0; b < BATCH; ++b) {
        { PH_BEGIN; unsigned char* ws = PWS; const int c = blockIdx.x, G = gridDim.x;
          bf16_t* H = (bf16_t*)(ws + WS_H); const float* DTb = (const float*)(ws + WS_DT) + (size_t)b * SEQ * 32;
          for (int u = c; u < 256; u += G) ssd::phaseA_unit((SS_LAS unsigned char*)lds, H, DTb, PIN(3), PIN(4), PIN(6), (bf16_t*)(ws + WS_T1), (float*)(ws + WS_CTL) + 1024, u >> 2, u & 3);
          const float lam = ((const float*)(ws + WS_CTL))[CW_LAM]; const float* subln_w = PIN(12);
#if PROBE_ATTN
          for (int u = c; u < 256; u += G) { const int h = u >> 5, j = u & 31;
              dattn::unit<false>((DA_LAS unsigned char*)lds, H, h, 63 - j, subln_w, lam);
              dattn::unit<false>((DA_LAS unsigned char*)lds, H, h, j, subln_w, lam); }
#endif
          for (int u = c; u < 256; u += G) { const int h = u >> 5, j = u & 31;
              dattn::unit((DA_LAS unsigned char*)lds, H, h, 63 - j, subln_w, lam);
              dattn::unit((DA_LAS unsigned char*)lds, H, h, j, subln_w, lam); } }
        GSYNC();
        { PH_BEGIN; unsigned char* ws = PWS; const int tid = opaque_tid();
          for (size_t i = (size_t)blockIdx.x * 512 + tid; i < 131072; i += (size_t)gridDim.x * 512) ssd::scan_phase((bf16_t*)(ws + WS_T1), (const float*)(ws + WS_CTL) + 1024, (int)i); }
        GSYNC();
        { PH_BEGIN; unsigned char* ws = PWS; const int c = blockIdx.x, G = gridDim.x;
#if PROBE_SSD
          for (int u = c; u < 256; u += G) ssd::phaseA_unit((SS_LAS unsigned char*)lds, (bf16_t*)(ws + WS_H), (const float*)(ws + WS_DT) + (size_t)b * SEQ * 32, PIN(3), PIN(4), PIN(6), (bf16_t*)(POUT + (size_t)SEQ * D), (float*)(ws + WS_CTL) + 8192, u >> 2, u & 3);
          for (int u = c; u < 256; u += G) ssd::phaseC_unit<false>((SS_LAS unsigned char*)lds, (bf16_t*)(ws + WS_H), (const float*)(ws + WS_DT) + (size_t)b * SEQ * 32, PIN(3), PIN(4), PIN(6), PIN(7), PIN(8), (const bf16_t*)(ws + WS_T1), u >> 2, u & 3);
#endif
          for (int u = c; u < 256; u += G) ssd::phaseC_unit((SS_LAS unsigned char*)lds, (bf16_t*)(ws + WS_H), (const float*)(ws + WS_DT) + (size_t)b * SEQ * 32, PIN(3), PIN(4), PIN(6), PIN(7), PIN(8), (const bf16_t*)(ws + WS_T1), u >> 2, u & 3); }
        GSYNC();
        { PH_BEGIN; unsigned char* ws = PWS; bf16_t* H = (bf16_t*)(ws + WS_H); float* T1 = (float*)(ws + WS_T1);
          run_gemm(lds, H + HC_Z, HP_, (const bf16_t*)(ws + WS_WSSD), SEQ, D, DI, EpiGate1{H, T1});
          run_gemm(lds, H + HC_Q, HP_, (const bf16_t*)(ws + WS_WDIFF), SEQ, D, D, EpiGate2{H, T1}); }
        GSYNC();
        { PH_BEGIN; unsigned char* ws = PWS;
          run_gemm(lds, (const bf16_t*)(ws + WS_H) + HC_K, HP_, (const bf16_t*)(ws + WS_WO), SEQ, D, D, EpiResid{PIN(0), POUT, b * SEQ, 0}); }
        GSYNC();
        if (b + 1 < BATCH) {
            { PH_BEGIN; unsigned char* ws = PWS;
              run_gemm(lds, (const bf16_t*)(ws + WS_XB) + (size_t)(b + 1) * SEQ * D, D, (const bf16_t*)(ws + WS_WIN), SEQ, NINP, D, EpiInProj{(bf16_t*)(ws + WS_H), PIN(14)}); }
            GSYNC();
        }
    }
    { PH_BEGIN; unsigned char* ws = PWS; const int tid = opaque_tid(), lane = tid & 63, wave = __builtin_amdgcn_readfirstlane(tid >> 6), c = blockIdx.x, G = gridDim.x;
      const size_t gtid = (size_t)c * 512 + tid, gthreads = (size_t)G * 512;
      float* out = POUT; const float* g = PIN(16); const float* bb = PIN(17); bf16_t* XB = (bf16_t*)(ws + WS_XB);
      for (int r = c * 8 + wave; r < M; r += G * 8) sp::ln_row(out, g, bb, XB, r, lane);
      sp::cvt_range(PIN(26), (bf16_t*)(ws + WS_PU), (size_t)PK * PK * D / 4, gtid, gthreads);
      sp::cvt_range(PIN(27), (bf16_t*)(ws + WS_PV), (size_t)PK * PK * D / 4, gtid, gthreads); }
    GSYNC();
    { PH_BEGIN; unsigned char* ws = PWS;
      run_gemm(lds, (const bf16_t*)(ws + WS_XB), D, (const bf16_t*)(ws + WS_WCQ), M, D, D, EpiPlain{(bf16_t*)(ws + WS_QC), D, CQSCALE}); }
    GSYNC();
    { PH_BEGIN; unsigned char* ws = PWS; const int c = blockIdx.x, G = gridDim.x;
      for (int u = c; u < 256; u += G) xattn::unit((XA_LAS unsigned char*)lds, (const bf16_t*)(ws + WS_QC), (const bf16_t*)(ws + WS_KCVC), (const bf16_t*)(ws + WS_KCVC) + (size_t)BATCH * MEML * D, (bf16_t*)(ws + WS_XO), u >> 2, u & 3); }
    GSYNC();
    { PH_BEGIN; unsigned char* ws = PWS; float* out = POUT;
      run_gemm(lds, (const bf16_t*)(ws + WS_XO), D, (const bf16_t*)(ws + WS_WCO), M, D, D, EpiResid{out, out, 0, 0}); }
    GSYNC();
    { PH_BEGIN; unsigned char* ws = PWS; const int tid = opaque_tid(), lane = tid & 63, wave = __builtin_amdgcn_readfirstlane(tid >> 6), c = blockIdx.x, G = gridDim.x;
      float* out = POUT; const float* g = PIN(22); const float* bb = PIN(23); bf16_t* XB = (bf16_t*)(ws + WS_XB);
      for (int r = c * 8 + wave; r < M; r += G * 8) sp::ln_row(out, g, bb, XB, r, lane); }
    GSYNC();
    { PH_BEGIN; unsigned char* ws = PWS;
      run_gemm(lds, (const bf16_t*)(ws + WS_XB), D, (const bf16_t*)(ws + WS_WPQ), M, 2048, D, EpiPlain{(bf16_t*)(ws + WS_QP), 2048, 1.f}); }
    GSYNC();
    { PH_BEGIN; unsigned char* ws = PWS; const int c = blockIdx.x, G = gridDim.x;
      for (int t = 64 * c; t < M; t += 64 * G)
          for (int hp = 0; hp < 4; ++hp) psel::step((PS_LAS int*)lds, (const bf16_t*)(ws + WS_QP), (const bf16_t*)(ws + WS_SUBK), (int*)(ws + WS_IDX), (float*)(ws + WS_GATE), t, hp); }
    GSYNC();
    { PH_BEGIN; unsigned char* ws = PWS; const int tid = opaque_tid(), lane = tid & 63, wave = __builtin_amdgcn_readfirstlane(tid >> 6);
      float* out = POUT; const float* g3 = PIN(28); const float* b3 = PIN(29);
      for (int t = blockIdx.x * 8 + wave; t < M; t += gridDim.x * 8) sp::gather_wave(out, (const bf16_t*)(ws + WS_PU), (const bf16_t*)(ws + WS_PV), (const int*)(ws + WS_IDX), (const float*)(ws + WS_GATE), g3, b3, t, lane); }
}

extern "C" void kernel_launch(void* const* d_in, const int* in_sizes, int n_in, void* d_out, int out_size, void* d_ws, size_t ws_size, hipStream_t stream) {
    static int grid_blocks = 0;
    if (grid_blocks == 0) {
        if (n_in != 30 || out_size != M * D || ws_size < WS_END) { fprintf(stderr, "kernel_launch: unexpected sizes n_in %d out %d ws %zu (need %zu)\n", n_in, out_size, ws_size, (size_t)WS_END); grid_blocks = -1; return; }
        int dev = 0, cus = 0, per_cu = 0;
        (void)hipGetDevice(&dev); (void)hipDeviceGetAttribute(&cus, hipDeviceAttributeMultiprocessorCount, dev);
        (void)hipFuncSetAttribute((const void*)hybrid_fwd, hipFuncAttributeMaxDynamicSharedMemorySize, LDS_BYTES);
        if (hipOccupancyMaxActiveBlocksPerMultiprocessor(&per_cu, (const void*)hybrid_fwd, 512, LDS_BYTES) != hipSuccess || per_cu < 1) { fprintf(stderr, "kernel_launch: occupancy query failed (%d)\n", per_cu); per_cu = 1; }
        (void)hipGetLastError();
        grid_blocks = cus * 1;
    }
    if (grid_blocks < 0) return;
    if (hipMemsetAsync(d_ws, 0, 65536, stream) != hipSuccess) { fprintf(stderr, "kernel_launch: memset of control words failed\n"); return; }
    Params p{};
    for (int i = 0; i < 30; ++i) p.in[i] = (const float*)d_in[i];
    p.out = (float*)d_out; p.ws = (unsigned char*)d_ws;
    void* args[] = {&p};
    hipError_t e = hipLaunchCooperativeKernel((const void*)hybrid_fwd, dim3(grid_blocks), dim3(512), args, LDS_BYTES, stream);
    if (e != hipSuccess) fprintf(stderr, "cooperative launch failed: %s (grid %d)\n", hipGetErrorString(e), grid_blocks);
}
```

```cpp
#include <hip/hip_runtime.h>
#include <hip/hip_cooperative_groups.h>
namespace cg = cooperative_groups;
#include <cstdio>
#include <cstdint>
#include <cmath>
#include <type_traits>

typedef unsigned short bf16_t;
typedef float f32x4 __attribute__((ext_vector_type(4)));
typedef unsigned u32x4 __attribute__((ext_vector_type(4)));
typedef unsigned u32x2 __attribute__((ext_vector_type(2)));

constexpr int D = 1024, BATCH = 2, SEQ = 8192, M = BATCH * SEQ;
constexpr int DI = 2048, NH = 32, HP = 64, NG = 4, DS = 128, DXBC = 3072;
constexpr int AH = 8, AD = 64, AV = 128;
constexpr int MEML = 256, MH = 4, MHD = 256;
constexpr int PH = 8, PK = 128, PDK = 256, PHALF = 128, PTOP = 16;
constexpr int NIN = 10272, NINP = 10240;
constexpr float ALPHA = 1.189207115002721f;
constexpr float LOG2E = 1.4426950408889634f;
constexpr float QSCALE = 0.125f * LOG2E;
constexpr float CQSCALE = 0.0625f * LOG2E;
constexpr float LAMBDA_INIT = 0.2f;
constexpr int HC_Z = 0, HC_XBC = 2048, HC_Q = 5120, HC_K = 6144, HC_V = 7168, HC_GS = 8192, HC_GA = 9216, HP_ = NINP;

constexpr size_t MiB = 1u << 20;
constexpr size_t WS_CTL = 0;
constexpr size_t WS_WIN = 1 * MiB;
constexpr size_t WS_WSSD = 21 * MiB;
constexpr size_t WS_WDIFF = 25 * MiB, WS_WO = 27 * MiB, WS_WCQ = 29 * MiB, WS_WCKV = 31 * MiB  , WS_WCO = 35 * MiB;
constexpr size_t WS_WPQ = 37 * MiB;
constexpr size_t WS_SUBK = 41 * MiB;
constexpr size_t WS_MEMB = 42 * MiB;
constexpr size_t WS_KCVC = 43 * MiB;
constexpr size_t WS_DT = 45 * MiB;
constexpr size_t WS_XB = 47 * MiB;
constexpr size_t WS_H = 79 * MiB;
constexpr size_t WS_T1 = 239 * MiB;
constexpr size_t WS_PU = 79 * MiB, WS_PV = 111 * MiB;
constexpr size_t WS_QC = 143 * MiB, WS_XO = 175 * MiB;
constexpr size_t WS_QP = 207 * MiB;
constexpr size_t WS_IDX = 143 * MiB, WS_GATE = 151 * MiB;
constexpr size_t WS_END = 271 * MiB;
constexpr int CW_LAM = 64;

__device__ __forceinline__ int opaque_tid() { int t = threadIdx.x; asm volatile("" : "+v"(t)); return t; }
__device__ __forceinline__ unsigned f2bf(float f) { unsigned u = __builtin_bit_cast(unsigned, f); return (u + 0x7fffu + ((u >> 16) & 1u)) >> 16; }
__device__ __forceinline__ float bf2f(unsigned h) { return __builtin_bit_cast(float, h << 16); }
__device__ __forceinline__ unsigned pk2(float lo, float hi) { return f2bf(lo) | (f2bf(hi) << 16); }
__device__ __forceinline__ float bflo(unsigned w) { return __builtin_bit_cast(float, w << 16); }
__device__ __forceinline__ float bfhi(unsigned w) { return __builtin_bit_cast(float, w & 0xffff0000u); }
__device__ __forceinline__ float sigmoidf_(float v) { return 1.f / (1.f + __expf(-v)); }
__device__ __forceinline__ float siluf_(float v) { return v / (1.f + __expf(-v)); }
__device__ __forceinline__ float wave_sum(float v) {
#pragma unroll
    for (int o = 1; o < 64; o <<= 1) v += __shfl_xor(v, o);
    return v;
}
__device__ __forceinline__ float wave_max(float v) {
#pragma unroll
    for (int o = 1; o < 64; o <<= 1) v = fmaxf(v, __shfl_xor(v, o));
    return v;
}

__device__ __forceinline__ void store_bf16x8(bf16_t* p, const float (&v)[8]) { u32x4 w; w.x = pk2(v[0], v[1]); w.y = pk2(v[2], v[3]); w.z = pk2(v[4], v[5]); w.w = pk2(v[6], v[7]); *(u32x4*)p = w; }
struct EpiPlain { bf16_t* O; int ldc; float scale;
    __device__ __forceinline__ void operator()(int row, int col0, const float (&v)[8]) const { float o[8];
#pragma unroll
        for (int j = 0; j < 8; ++j) o[j] = v[j] * scale; store_bf16x8(O + (size_t)row * ldc + col0, o); } };
struct EpiInProj { bf16_t* H; const float* gate_bias;
    __device__ __forceinline__ void operator()(int row, int col0, const float (&v)[8]) const { float o[8];
        if (col0 >= HC_GS) { const float* gb = gate_bias + (col0 - HC_GS);
#pragma unroll
            for (int j = 0; j < 8; ++j) o[j] = sigmoidf_(v[j] + gb[j]); }
        else { const float s = (col0 >= HC_Q && col0 < HC_K) ? QSCALE : 1.f;
#pragma unroll
            for (int j = 0; j < 8; ++j) o[j] = v[j] * s; }
        store_bf16x8(H + (size_t)row * HP_ + col0, o); } };
struct EpiGate1 { const bf16_t* H; float* T1;
    __device__ __forceinline__ void operator()(int row, int col0, const float (&v)[8]) const {
        const u32x4 g = *(const u32x4*)(H + (size_t)row * HP_ + HC_GS + col0); const unsigned gw[4] = {g.x, g.y, g.z, g.w};
        float* t = T1 + (size_t)row * D + col0;
#pragma unroll
        for (int j = 0; j < 4; ++j) { t[2 * j] = bflo(gw[j]) * v[2 * j]; t[2 * j + 1] = bfhi(gw[j]) * v[2 * j + 1]; } } };
struct EpiGate2 { bf16_t* H; const float* T1;
    __device__ __forceinline__ void operator()(int row, int col0, const float (&v)[8]) const {
        const u32x4 g = *(const u32x4*)(H + (size_t)row * HP_ + HC_GA + col0); const unsigned gw[4] = {g.x, g.y, g.z, g.w};
        const float* t = T1 + (size_t)row * D + col0; float o[8];
#pragma unroll
        for (int j = 0; j < 4; ++j) { o[2 * j] = t[2 * j] + bflo(gw[j]) * v[2 * j]; o[2 * j + 1] = t[2 * j + 1] + bfhi(gw[j]) * v[2 * j + 1]; }
        store_bf16x8(H + (size_t)row * HP_ + HC_K + col0, o); } };
struct EpiResid { const float* base; float* out; int row_off; int pad_;
    __device__ __forceinline__ void operator()(int row, int col0, const float (&v)[8]) const {
        const size_t o = (size_t)(row + row_off) * D + col0;
#pragma unroll
        for (int j = 0; j < 8; ++j) out[o + j] = ALPHA * base[o + j] + v[j]; } };


namespace pg8 {
#define PG8_LAS __attribute__((address_space(3)))
typedef short bf16x8 __attribute__((ext_vector_type(8)));
constexpr int BM = 256, BK = 64, HALF = 128, HTB = HALF * BK * 2, STAGE_BYTES = 8 * HTB, NXCD = 8, WGM = 8;
__host__ __device__ __forceinline__ int lds_byte(int r, int c) { const int st = (r >> 4) * 2 + (c >> 5), rr = r & 15, cc = c & 31, ob = rr * 64 + cc * 2; return st * 1024 + (ob ^ (((ob >> 9) & 1) << 5)); }
__host__ __device__ __forceinline__ void stage_rc(int b, int& R, int& C) { const int st = b / 1024, sb = b % 1024, swz = sb ^ (((sb >> 9) & 1) << 5); R = (st >> 1) * 16 + swz / 64; C = (st & 1) * 32 + (swz % 64) / 2; }
__host__ __device__ __forceinline__ int perm32(int rho) { const int n = rho >> 4, i = rho & 15; return 8 * (i >> 2) + 4 * n + (i & 3); }
struct Unit { int pm, pn; };
struct Gemm { const bf16_t* A; const bf16_t* Bt; int M, N, K, lda; };
struct StaticOrder {
    int nM, nN, nwg, G, c;
    __host__ __device__ void init(int M, int N, int G_, int c_) { nM = M / BM; nN = N / BM; nwg = nM * nN; G = G_; c = c_; }
    __host__ __device__ bool next(int i, Unit& u) const {
        const long L = (long)i * G + c; if (L >= nwg) return false;
        int wgid = (int)L; { const int q = nwg / NXCD, r = nwg % NXCD, xcd = wgid % NXCD, off = wgid / NXCD; wgid = (xcd < r ? xcd * (q + 1) : r * (q + 1) + (xcd - r) * q) + off; }
        const int nig = WGM * nN, gid = wgid / nig, fm = gid * WGM, gsz = (nM - fm) < WGM ? (nM - fm) : WGM;
        u.pm = fm + ((wgid % nig) % gsz); u.pn = (wgid % nig) / gsz; return true;
    }
};
template <class F> struct EpiAdapt {
    static constexpr bool PERM = true, AFTER_DRAIN = false; F f;
    __device__ __forceinline__ void operator()(const f32x4 (&acc)[2][2][4][2], const Unit& u, int wr, int wc, int fr, int fq) const {
#pragma unroll
        for (int ai = 0; ai < 2; ++ai)
#pragma unroll
            for (int m = 0; m < 4; ++m) { const int row = u.pm * BM + ai * HALF + wr * 64 + m * 16 + fr;
#pragma unroll
                for (int bj = 0; bj < 2; ++bj) { const int col0 = u.pn * BM + bj * HALF + wc * 32 + 8 * fq;
                    const f32x4 a = acc[ai][bj][m][0], b = acc[ai][bj][m][1]; const float v[8] = {a[0], a[1], a[2], a[3], b[0], b[1], b[2], b[3]};
                    f(row, col0, v); } }
    }
};
template <class Epi, class Sched, bool ALIGN_EPI>
__device__ __forceinline__ void gemm_phase(PG8_LAS unsigned char* lds, const Gemm g, const Sched& S, const Epi& E) {
    const int tid = opaque_tid(), wid = __builtin_amdgcn_readfirstlane(tid >> 6), lane = tid & 63, wr = wid >> 2, wc = wid & 3, fr = lane & 15, fq = lane >> 4;
    const int K = g.K, nt = K / BK, lda = g.lda;
    unsigned voffA[2], voffB[2];
#pragma unroll
    for (int i = 0; i < 2; ++i) { int R, C; stage_rc(tid * 16 + i * 8192, R, C); const int Rb = Epi::PERM ? ((R & ~31) + perm32(R & 31)) : R;
        voffA[i] = (unsigned)(R * lda + C) * 2u; voffB[i] = (unsigned)(Rb * K + C) * 2u; }
    const size_t kstep = (size_t)(BK * 2);
    const size_t hstepA = (size_t)HALF * lda * 2, hstepB = (size_t)HALF * K * 2;
    const size_t tstepA = 2 * hstepA, tstepB = 2 * hstepB;
    const unsigned ldsw = (unsigned)wid * 1024u;
    const int aoff = lds_byte(wr * 64 + fr, fq * 8), boff = lds_byte(wc * 32 + fr, fq * 8);
#define PG8_SA(b, h) (((b) * 2 + (h)) * HTB)
#define PG8_SB(b, h) ((4 + (b) * 2 + (h)) * HTB)
#define PG8_STAGE(bufoff, gbase, voff) do { _Pragma("unroll") for (int _i = 0; _i < 2; ++_i) \
        __builtin_amdgcn_global_load_lds((const unsigned*)((const char*)(gbase) + (voff)[_i]), (PG8_LAS unsigned*)(lds + (bufoff) + ldsw + _i * 8192), 16, 0, 0); } while (0)
#define PG8_LDA(dst, b, h) do { _Pragma("unroll") for (int m = 0; m < 4; ++m) _Pragma("unroll") for (int k = 0; k < 2; ++k) dst[m][k] = *(const PG8_LAS bf16x8*)(lds + PG8_SA(b, h) + aoff + m * 2048 + k * 1024); } while (0)
#define PG8_LDB(dst, b, h) do { _Pragma("unroll") for (int n = 0; n < 2; ++n) _Pragma("unroll") for (int k = 0; k < 2; ++k) dst[n][k] = *(const PG8_LAS bf16x8*)(lds + PG8_SB(b, h) + boff + n * 2048 + k * 1024); } while (0)
#define PG8_MMA(ai, bj, At, Bt) do { __builtin_amdgcn_s_setprio(1); _Pragma("unroll") for (int m = 0; m < 4; ++m) _Pragma("unroll") for (int n = 0; n < 2; ++n) _Pragma("unroll") for (int k = 0; k < 2; ++k) \
        acc[ai][bj][m][n] = __builtin_amdgcn_mfma_f32_16x16x32_bf16(Bt[n][k], At[m][k], acc[ai][bj][m][n], 0, 0, 0); __builtin_amdgcn_s_setprio(0); } while (0)
#define PG8_WAIT_V(n) asm volatile("s_waitcnt vmcnt(" #n ")" ::: "memory")
#define PG8_WAIT_L(n) asm volatile("s_waitcnt lgkmcnt(" #n ")" ::: "memory")
#define PG8_BAR __builtin_amdgcn_s_barrier()
#define PG8_SCHED __builtin_amdgcn_sched_barrier(0)
    Unit cur, nxt; int ui = 0;
    if (!S.next(0, cur)) return;
    f32x4 acc[2][2][4][2];
#pragma unroll
    for (int a = 0; a < 2; ++a)
#pragma unroll
        for (int b = 0; b < 2; ++b)
#pragma unroll
            for (int m = 0; m < 4; ++m)
#pragma unroll
                for (int n = 0; n < 2; ++n) acc[a][b][m][n] = (f32x4){0.f, 0.f, 0.f, 0.f};
    bf16x8 At[4][2], B0[2][2], B1[2][2];
    const char* cA = (const char*)g.A + (size_t)cur.pm * tstepA; const char* cB = (const char*)g.Bt + (size_t)cur.pn * tstepB;
    PG8_STAGE(PG8_SB(0, 0), cB, voffB); PG8_STAGE(PG8_SB(0, 1), cB + hstepB, voffB); PG8_STAGE(PG8_SA(0, 0), cA, voffA); PG8_STAGE(PG8_SA(0, 1), cA + hstepA, voffA);
    if (wr == 1) PG8_BAR;
    PG8_WAIT_V(2); PG8_BAR;
    PG8_STAGE(PG8_SB(1, 0), cB + kstep, voffB); PG8_STAGE(PG8_SA(1, 0), cA + kstep, voffA); PG8_STAGE(PG8_SB(1, 1), cB + hstepB + kstep, voffB);
    PG8_WAIT_V(6); PG8_BAR;
    for (;;) {
        const bool has_next = S.next(ui + 1, nxt);
        const char* nA = has_next ? (const char*)g.A + (size_t)nxt.pm * tstepA : cA; const char* nB = has_next ? (const char*)g.Bt + (size_t)nxt.pn * tstepB : cB;
        for (int t = 0; t < nt; t += 2) {
            const bool last = (t == nt - 2);
            const char* a1 = cA + (size_t)(t + 1) * kstep;
            const char* a2 = last ? nA : cA + (size_t)(t + 2) * kstep; const char* b2 = last ? nB : cB + (size_t)(t + 2) * kstep;
            const char* a3 = a2 + kstep; const char* b3 = b2 + kstep;
            PG8_LDB(B0, 0, 0); PG8_LDB(B1, 0, 1); PG8_SCHED; PG8_LDA(At, 0, 0); PG8_STAGE(PG8_SA(1, 1), a1 + hstepA, voffA);
            PG8_WAIT_V(8); PG8_WAIT_L(0); PG8_BAR; PG8_MMA(0, 0, At, B0); PG8_MMA(0, 1, At, B1); PG8_BAR; PG8_SCHED;
            PG8_LDA(At, 0, 1); PG8_STAGE(PG8_SB(0, 0), b2, voffB); PG8_STAGE(PG8_SB(0, 1), b2 + hstepB, voffB); PG8_STAGE(PG8_SA(0, 0), a2, voffA);
            PG8_WAIT_V(8); PG8_WAIT_L(0); PG8_BAR; PG8_MMA(1, 0, At, B0); PG8_MMA(1, 1, At, B1); PG8_BAR; PG8_SCHED;
            PG8_LDB(B0, 1, 0); PG8_LDB(B1, 1, 1); PG8_SCHED; PG8_LDA(At, 1, 0); PG8_STAGE(PG8_SA(0, 1), a2 + hstepA, voffA);
            PG8_WAIT_V(8); PG8_WAIT_L(0); PG8_BAR; PG8_MMA(0, 0, At, B0); PG8_MMA(0, 1, At, B1); PG8_BAR; PG8_SCHED;
            PG8_LDA(At, 1, 1); PG8_STAGE(PG8_SB(1, 0), b3, voffB); PG8_STAGE(PG8_SB(1, 1), b3 + hstepB, voffB); PG8_STAGE(PG8_SA(1, 0), a3, voffA);
            PG8_WAIT_V(8); PG8_WAIT_L(0); PG8_BAR; PG8_MMA(1, 0, At, B0); PG8_MMA(1, 1, At, B1); PG8_BAR; PG8_SCHED;
        }
        if constexpr (ALIGN_EPI) { if (wr == 0) PG8_BAR; }
        E(acc, cur, wr, wc, fr, fq);
        if (!has_next) break;
#pragma unroll
        for (int a = 0; a < 2; ++a)
#pragma unroll
            for (int b = 0; b < 2; ++b)
#pragma unroll
                for (int m = 0; m < 4; ++m)
#pragma unroll
                    for (int n = 0; n < 2; ++n) acc[a][b][m][n] = (f32x4){0.f, 0.f, 0.f, 0.f};
        cur = nxt; cA = nA; cB = nB; ++ui;
        if constexpr (ALIGN_EPI) { if (wr == 1) PG8_BAR; }
    }
    PG8_WAIT_V(0);
    if constexpr (!ALIGN_EPI) { if (wr == 0) PG8_BAR; }
    PG8_BAR;
#undef PG8_SA
#undef PG8_SB
#undef PG8_STAGE
#undef PG8_LDA
#undef PG8_LDB
#undef PG8_MMA
#undef PG8_WAIT_V
#undef PG8_WAIT_L
#undef PG8_BAR
#undef PG8_SCHED
}
}
constexpr int LDS_BYTES = 147456;
namespace dattn {
#define DA_LAS __attribute__((address_space(3)))
typedef short bf16x8 __attribute__((ext_vector_type(8)));
typedef short s16x4 __attribute__((ext_vector_type(4)));
typedef float f32x16 __attribute__((ext_vector_type(16)));
constexpr int KP = 272, VP = 320, KBUF = 64 * KP, VBUF = 64 * VP, BUF = KBUF + VBUF, XOFF = 2 * BUF, LDS_NEED = XOFF + 65536;
static_assert(LDS_NEED <= 147456, "attention LDS");
__device__ __forceinline__ unsigned cvtpk(float lo, float hi) { typedef float f2 __attribute__((ext_vector_type(2))); typedef __bf16 b2 __attribute__((ext_vector_type(2))); f2 v = {lo, hi}; b2 b = __builtin_convertvector(v, b2); return __builtin_bit_cast(unsigned, b); }
__device__ __forceinline__ s16x4 vtr(const DA_LAS unsigned char* p) { typedef short v4i16_t __attribute__((ext_vector_type(4))); return __builtin_bit_cast(s16x4, __builtin_amdgcn_ds_read_tr16_b64_v4i16((DA_LAS v4i16_t*)p)); }
template <bool STORE = true> __device__ __forceinline__ void unit(DA_LAS unsigned char* lds, bf16_t* Hb, int h, int qb, const float* __restrict__ subln_w, float lam) {
    const int tid = opaque_tid(), lane = tid & 63, w = __builtin_amdgcn_readfirstlane(tid >> 6), mp = w >> 2, rb = w & 3, c32 = lane & 31, hh = lane >> 5;
    const int qrow = 128 * qb + 32 * rb + c32;
    bf16x8 qf[4];
    { const bf16_t* qp = Hb + (size_t)qrow * HP_ + HC_Q + h * 128 + 64 * mp + 8 * hh;
#pragma unroll
      for (int s = 0; s < 4; ++s) qf[s] = *(const bf16x8*)(qp + 16 * s); }
    const int srow = tid >> 4, sch = tid & 15;
    const bf16_t* kg = Hb + HC_K + h * 128 + sch * 8; const bf16_t* vg = Hb + HC_V + h * 128 + sch * 8;
    const int nt = 2 * qb + 2;
    u32x4 kr[2], vr[2];
#define DA_LOAD(t) do { _Pragma("unroll") for (int j = 0; j < 2; ++j) { const size_t ro = (size_t)(64 * (t) + srow + 32 * j) * HP_; kr[j] = *(const u32x4*)(kg + ro); vr[j] = *(const u32x4*)(vg + ro); } } while (0)
#define DA_WRITE(buf) do { _Pragma("unroll") for (int j = 0; j < 2; ++j) { *(DA_LAS u32x4*)(lds + (buf) * BUF + (srow + 32 * j) * KP + sch * 16) = kr[j]; *(DA_LAS u32x4*)(lds + (buf) * BUF + KBUF + (srow + 32 * j) * VP + sch * 16) = vr[j]; } } while (0)
    DA_LOAD(0); DA_WRITE(0);
    __syncthreads();
    f32x16 oT[4];
#pragma unroll
    for (int i = 0; i < 4; ++i) oT[i] = (f32x16){0.f, 0.f, 0.f, 0.f, 0.f, 0.f, 0.f, 0.f, 0.f, 0.f, 0.f, 0.f, 0.f, 0.f, 0.f, 0.f};
    float mrow = -INFINITY, lrow = 0.f;
    const int koff = c32 * KP + (64 * mp + 8 * hh) * 2;
    const int voff = KBUF + (4 * hh + ((lane & 15) >> 2)) * VP + (16 * ((lane >> 4) & 1) + 4 * (lane & 3)) * 2;
    for (int t = 0; t < nt; ++t) {
        const int cur = t & 1;
        if (t + 1 < nt) DA_LOAD(t + 1);
        if (!(t == nt - 1 && rb <= 1)) {
            const DA_LAS unsigned char* kb = lds + cur * BUF + koff;
            f32x16 s0 = (f32x16){0.f, 0.f, 0.f, 0.f, 0.f, 0.f, 0.f, 0.f, 0.f, 0.f, 0.f, 0.f, 0.f, 0.f, 0.f, 0.f}, s1 = s0;
#pragma unroll
            for (int s = 0; s < 4; ++s) {
                const bf16x8 a0 = *(const DA_LAS bf16x8*)(kb + s * 32), a1 = *(const DA_LAS bf16x8*)(kb + 32 * KP + s * 32);
                s0 = __builtin_amdgcn_mfma_f32_32x32x16_bf16(a0, qf[s], s0, 0, 0, 0);
                s1 = __builtin_amdgcn_mfma_f32_32x32x16_bf16(a1, qf[s], s1, 0, 0, 0);
            }
            if (t >= nt - 2) {
                const int k0 = 64 * t + 4 * hh;
#pragma unroll
                for (int r = 0; r < 16; ++r) { const int key = k0 + (r & 3) + 8 * (r >> 2); if (key > qrow) s0[r] = -INFINITY; if (key + 32 > qrow) s1[r] = -INFINITY; }
            }
            float mx = fmaxf(s0[0], s1[0]);
#pragma unroll
            for (int r = 1; r < 16; ++r) mx = fmaxf(mx, fmaxf(s0[r], s1[r]));
            mx = fmaxf(mx, __shfl_xor(mx, 32));
            const float mnew = fmaxf(mrow, mx), alpha = __builtin_amdgcn_exp2f(mrow - mnew);
            mrow = mnew;
            float ps = 0.f;
#pragma unroll
            for (int r = 0; r < 16; ++r) { s0[r] = __builtin_amdgcn_exp2f(s0[r] - mnew); s1[r] = __builtin_amdgcn_exp2f(s1[r] - mnew); ps += s0[r] + s1[r]; }
            lrow = lrow * alpha + ps;
#pragma unroll
            for (int i = 0; i < 4; ++i)
#pragma unroll
                for (int r = 0; r < 16; ++r) oT[i][r] *= alpha;
            bf16x8 pf[2][2];
#pragma unroll
            for (int s = 0; s < 2; ++s) {
                u32x4 a, b;
                a.x = cvtpk(s0[8 * s], s0[8 * s + 1]); a.y = cvtpk(s0[8 * s + 2], s0[8 * s + 3]); a.z = cvtpk(s0[8 * s + 4], s0[8 * s + 5]); a.w = cvtpk(s0[8 * s + 6], s0[8 * s + 7]);
                b.x = cvtpk(s1[8 * s], s1[8 * s + 1]); b.y = cvtpk(s1[8 * s + 2], s1[8 * s + 3]); b.z = cvtpk(s1[8 * s + 4], s1[8 * s + 5]); b.w = cvtpk(s1[8 * s + 6], s1[8 * s + 7]);
                pf[0][s] = __builtin_bit_cast(bf16x8, a); pf[1][s] = __builtin_bit_cast(bf16x8, b);
            }
            const DA_LAS unsigned char* vb = lds + cur * BUF + voff;
#pragma unroll
            for (int db = 0; db < 4; ++db)
#pragma unroll
                for (int t2 = 0; t2 < 2; ++t2)
#pragma unroll
                    for (int s = 0; s < 2; ++s) {
                        const s16x4 lo = vtr(vb + (32 * t2 + 16 * s) * VP + db * 64), hi = vtr(vb + (32 * t2 + 16 * s + 8) * VP + db * 64);
                        const bf16x8 vf = (bf16x8){lo[0], lo[1], lo[2], lo[3], hi[0], hi[1], hi[2], hi[3]};
                        oT[db] = __builtin_amdgcn_mfma_f32_32x32x16_bf16(vf, pf[t2][s], oT[db], 0, 0, 0);
                    }
        }
        if (t + 1 < nt) DA_WRITE(cur ^ 1);
        __syncthreads();
    }
#undef DA_LOAD
#undef DA_WRITE
    const float inv = 1.f / (lrow + __shfl_xor(lrow, 32));
    DA_LAS float* X = (DA_LAS float*)(lds + XOFF) + rb * 4096 + lane;
    if (mp == 1) {
#pragma unroll
        for (int i = 0; i < 4; ++i)
#pragma unroll
            for (int r = 0; r < 16; ++r) X[(i * 16 + r) * 64] = oT[i][r] * inv;
    }
    __syncthreads();
    if (mp == 0) {
        float ss = 0.f;
#pragma unroll
        for (int i = 0; i < 4; ++i)
#pragma unroll
            for (int r = 0; r < 16; ++r) { const float o = oT[i][r] * inv - lam * X[(i * 16 + r) * 64]; oT[i][r] = o; ss += o * o; }
        ss += __shfl_xor(ss, 32);
        const float rr = rsqrtf(ss * (1.f / 128.f) + 1e-5f) * (1.f - LAMBDA_INIT);
        bf16_t* op = Hb + (size_t)qrow * HP_ + HC_Q + h * 128 + 4 * hh;
#pragma unroll
        for (int i = 0; i < 4; ++i)
#pragma unroll
            for (int g = 0; g < 4; ++g) { const int d0 = 32 * i + 8 * g; const f32x4 sw = *(const f32x4*)(subln_w + d0 + 4 * hh);
                uint2 o; o.x = pk2(oT[i][4 * g] * rr * sw.x, oT[i][4 * g + 1] * rr * sw.y); o.y = pk2(oT[i][4 * g + 2] * rr * sw.z, oT[i][4 * g + 3] * rr * sw.w);
                if (STORE || o.x == 0x12345u) *(uint2*)(op + d0) = o; }
    }
    __syncthreads();
}
}
namespace ssd {
#define SS_LAS __attribute__((address_space(3)))
typedef short bf16x8 __attribute__((ext_vector_type(8)));
typedef short s16x4 __attribute__((ext_vector_type(4)));
typedef float f32x16 __attribute__((ext_vector_type(16)));
constexpr int XP = 192;
constexpr int BPT = 320;
constexpr int CP = 272;
__device__ __forceinline__ s16x4 vtr(const SS_LAS unsigned char* p) { typedef short v4i16_t __attribute__((ext_vector_type(4))); return __builtin_bit_cast(s16x4, __builtin_amdgcn_ds_read_tr16_b64_v4i16((SS_LAS v4i16_t*)p)); }
__device__ __forceinline__ unsigned cvtpk(float lo, float hi) { typedef float f2 __attribute__((ext_vector_type(2))); typedef __bf16 b2 __attribute__((ext_vector_type(2))); f2 v = {lo, hi}; b2 b = __builtin_convertvector(v, b2); return __builtin_bit_cast(unsigned, b); }
__device__ __forceinline__ void acs_tables(SS_LAS float* ACS, SS_LAS float* DTS, const float* __restrict__ DTb, const float* __restrict__ a_log, int c, int g) {
    const int tid_ = opaque_tid(); const int lane = tid_ & 63, e = __builtin_amdgcn_readfirstlane(tid_ >> 6), h = 8 * g + e;
    const float a = -expf(a_log[h]);
    const float d0 = DTb[(size_t)(128 * c + 2 * lane) * 32 + h], d1 = DTb[(size_t)(128 * c + 2 * lane + 1) * 32 + h];
    const float a0 = d0 * a, a1 = d1 * a;
    float sc = a0 + a1;
#pragma unroll
    for (int o = 1; o < 64; o <<= 1) { const float v = __shfl_up(sc, o); if (lane >= o) sc += v; }
    const float ex = sc - (a0 + a1);
    ACS[(2 * lane) * 8 + e] = ex + a0; ACS[(2 * lane + 1) * 8 + e] = ex + a0 + a1;
    DTS[(2 * lane) * 8 + e] = d0; DTS[(2 * lane + 1) * 8 + e] = d1;
}
template <class F> __device__ __forceinline__ void conv_item(const bf16_t* __restrict__ Hb, int t0, int l0, int xch0, const float* __restrict__ conv_w, const float* __restrict__ conv_b, F sink) {
    float w[4][8], bias[8];
#pragma unroll
    for (int j = 0; j < 4; ++j) { const f32x4 a = *(const f32x4*)(conv_w + j * DXBC + xch0), b = *(const f32x4*)(conv_w + j * DXBC + xch0 + 4); w[j][0] = a.x; w[j][1] = a.y; w[j][2] = a.z; w[j][3] = a.w; w[j][4] = b.x; w[j][5] = b.y; w[j][6] = b.z; w[j][7] = b.w; }
    { const f32x4 a = *(const f32x4*)(conv_b + xch0), b = *(const f32x4*)(conv_b + xch0 + 4); bias[0] = a.x; bias[1] = a.y; bias[2] = a.z; bias[3] = a.w; bias[4] = b.x; bias[5] = b.y; bias[6] = b.z; bias[7] = b.w; }
    const bf16_t* src = Hb + HC_XBC + xch0;
    u32x4 rw[11];
#pragma unroll
    for (int i = 0; i < 11; ++i) { const int tt = t0 + l0 - 3 + i; rw[i] = *(const u32x4*)(src + (size_t)(tt < 0 ? 0 : tt) * HP_); }
    if (t0 + l0 < 3) {
#pragma unroll
        for (int i = 0; i < 3; ++i) if (t0 + l0 - 3 + i < 0) rw[i] = (u32x4){0u, 0u, 0u, 0u};
    }
#define SS_UNP(dst, q_) do { dst[0] = bflo(q_.x); dst[1] = bfhi(q_.x); dst[2] = bflo(q_.y); dst[3] = bfhi(q_.y); dst[4] = bflo(q_.z); dst[5] = bfhi(q_.z); dst[6] = bflo(q_.w); dst[7] = bfhi(q_.w); } while (0)
    float x0[8], x1[8], x2[8];
    SS_UNP(x0, rw[0]); SS_UNP(x1, rw[1]); SS_UNP(x2, rw[2]);
#pragma unroll
    for (int i = 0; i < 8; ++i) {
        float x3[8]; SS_UNP(x3, rw[3 + i]);
        float v[8];
#pragma unroll
        for (int k = 0; k < 8; ++k) { const float a = bias[k] + w[0][k] * x0[k] + w[1][k] * x1[k] + w[2][k] * x2[k] + w[3][k] * x3[k]; v[k] = a / (1.f + __expf(-a)); x0[k] = x1[k]; x1[k] = x2[k]; x2[k] = x3[k]; }
        sink(l0 + i, v);
    }
#undef SS_UNP
}
constexpr int A_BS = 0, A_XD = 128 * BPT  , A_ACS = A_XD + 2 * 128 * XP  , A_DTS = A_ACS + 4096, A_END = A_DTS + 4096;
__device__ __forceinline__ void phaseA_unit(SS_LAS unsigned char* lds, const bf16_t* __restrict__ Hb, const float* __restrict__ DTb, const float* __restrict__ conv_w, const float* __restrict__ conv_b,
                                            const float* __restrict__ a_log, bf16_t* __restrict__ ST, float* __restrict__ CD, int c, int g) {
    const int tid = opaque_tid(), lane = tid & 63, w = __builtin_amdgcn_readfirstlane(tid >> 6), c32 = lane & 31, hh = lane >> 5;
    SS_LAS float* ACS = (SS_LAS float*)(lds + A_ACS); SS_LAS float* DTS = (SS_LAS float*)(lds + A_DTS);
    acs_tables(ACS, DTS, DTb, a_log, c, g);
    __syncthreads();
    if (tid < 8) CD[c * 32 + 8 * g + tid] = __expf(ACS[127 * 8 + tid]);
    auto stageX = [&](int e, int item, int buf) {
        const int cg = item >> 4, seg = item & 15; const float aend = ACS[127 * 8 + e];
        conv_item(Hb, 128 * c, 8 * seg, g * 512 + e * 64 + cg * 8, conv_w, conv_b, [&](int l, const float (&v)[8]) {
            const float sc = DTS[l * 8 + e] * __expf(aend - ACS[l * 8 + e]);
            u32x4 o; o.x = cvtpk(v[0] * sc, v[1] * sc); o.y = cvtpk(v[2] * sc, v[3] * sc); o.z = cvtpk(v[4] * sc, v[5] * sc); o.w = cvtpk(v[6] * sc, v[7] * sc);
            *(SS_LAS u32x4*)(lds + A_XD + buf * 128 * XP + l * XP + cg * 16) = o; });
    };
    if (tid < 256) { const int cg = tid >> 4, seg = tid & 15;
        conv_item(Hb, 128 * c, 8 * seg, 2048 + g * 128 + cg * 8, conv_w, conv_b, [&](int l, const float (&v)[8]) {
            u32x4 o; o.x = cvtpk(v[0], v[1]); o.y = cvtpk(v[2], v[3]); o.z = cvtpk(v[4], v[5]); o.w = cvtpk(v[6], v[7]);
            *(SS_LAS u32x4*)(lds + A_BS + l * BPT + cg * 16) = o; });
    } else if (tid < 384) stageX(0, tid - 256, 0);
    __syncthreads();
    const int pb = w & 1, nb = w >> 1;
    const int rsel = ((lane & 15) >> 2), csel = 16 * ((lane >> 4) & 1) + 4 * (lane & 3);
    for (int e = 0; e < 8; ++e) {
        if (e + 1 < 8 && tid >= 384) stageX(e + 1, tid - 384, (e + 1) & 1);
        f32x16 acc = (f32x16){0.f, 0.f, 0.f, 0.f, 0.f, 0.f, 0.f, 0.f, 0.f, 0.f, 0.f, 0.f, 0.f, 0.f, 0.f, 0.f};
        const SS_LAS unsigned char* bp = lds + A_BS + (8 * hh + rsel) * BPT + (32 * nb + csel) * 2;
        const SS_LAS unsigned char* xp = lds + A_XD + (e & 1) * 128 * XP + (8 * hh + rsel) * XP + (32 * pb + csel) * 2;
#pragma unroll
        for (int ks = 0; ks < 8; ++ks) {
            const s16x4 b0 = vtr(bp + (16 * ks) * BPT), b1 = vtr(bp + (16 * ks + 4) * BPT), x0 = vtr(xp + (16 * ks) * XP), x1 = vtr(xp + (16 * ks + 4) * XP);
            const bf16x8 bf = (bf16x8){b0[0], b0[1], b0[2], b0[3], b1[0], b1[1], b1[2], b1[3]}, xf = (bf16x8){x0[0], x0[1], x0[2], x0[3], x1[0], x1[1], x1[2], x1[3]};
            acc = __builtin_amdgcn_mfma_f32_32x32x16_bf16(bf, xf, acc, 0, 0, 0);
        }
        bf16_t* sp = ST + ((size_t)(c * 32 + 8 * g + e) * 64 + 32 * pb + c32) * 128 + 32 * nb + 4 * hh;
#pragma unroll
        for (int q = 0; q < 4; ++q) { uint2 o; o.x = cvtpk(acc[4 * q], acc[4 * q + 1]); o.y = cvtpk(acc[4 * q + 2], acc[4 * q + 3]); *(uint2*)(sp + 8 * q) = o; }
        __syncthreads();
    }
}
__device__ __forceinline__ void scan_phase(bf16_t* __restrict__ ST, const float* __restrict__ CD, int gtid) {
    const int h = gtid >> 12;
    unsigned* p = (unsigned*)ST + gtid;
    float r0 = 0.f, r1 = 0.f;
    for (int c0 = 0; c0 < 64; c0 += 16) {
        unsigned v[16]; float d[16];
#pragma unroll
        for (int i = 0; i < 16; ++i) { v[i] = p[(size_t)(c0 + i) * 131072]; d[i] = CD[(c0 + i) * 32 + h]; }
#pragma unroll
        for (int i = 0; i < 16; ++i) { p[(size_t)(c0 + i) * 131072] = cvtpk(r0, r1); r0 = r0 * d[i] + bflo(v[i]); r1 = r1 * d[i] + bfhi(v[i]); }
    }
}
constexpr int C_CS = 0, C_BS = 128 * CP  , C_X1 = C_BS  , C_CBT = 2 * 128 * CP  , C_X0 = C_CBT + 32768  , C_ACS = C_X0 + 128 * XP  , C_DTS = C_ACS + 4096,
              C_SSQ = C_DTS + 4096, C_END = C_SSQ + 1024;
static_assert(C_END <= 147456 && 128 * XP <= 128 * CP, "ssd phase C LDS");
template <bool STORE = true> __device__ __forceinline__ void phaseC_unit(SS_LAS unsigned char* lds, bf16_t* __restrict__ Hb, const float* __restrict__ DTb, const float* __restrict__ conv_w, const float* __restrict__ conv_b,
                                            const float* __restrict__ a_log, const float* __restrict__ d_skip, const float* __restrict__ norm_w, const bf16_t* __restrict__ ST, int c, int g) {
    const int tid = opaque_tid(), lane = tid & 63, w = __builtin_amdgcn_readfirstlane(tid >> 6), c32 = lane & 31, hh = lane >> 5;
    SS_LAS float* ACS = (SS_LAS float*)(lds + C_ACS); SS_LAS float* DTS = (SS_LAS float*)(lds + C_DTS); SS_LAS float* SSQ = (SS_LAS float*)(lds + C_SSQ);
    acs_tables(ACS, DTS, DTb, a_log, c, g);
    auto stageX = [&](int e, int item, int buf) {
        const int cg = item >> 4, seg = item & 15;
        conv_item(Hb, 128 * c, 8 * seg, g * 512 + e * 64 + cg * 8, conv_w, conv_b, [&](int l, const float (&v)[8]) {
            u32x4 o; o.x = cvtpk(v[0], v[1]); o.y = cvtpk(v[2], v[3]); o.z = cvtpk(v[4], v[5]); o.w = cvtpk(v[6], v[7]);
            *(SS_LAS u32x4*)(lds + (buf ? C_X1 : C_X0) + l * XP + cg * 16) = o; });
    };
    { const int isC = tid >> 8, it = tid & 255, cg = it >> 4, seg = it & 15;
        conv_item(Hb, 128 * c, 8 * seg, 2048 + isC * 512 + g * 128 + cg * 8, conv_w, conv_b, [&](int l, const float (&v)[8]) {
            u32x4 o; o.x = cvtpk(v[0], v[1]); o.y = cvtpk(v[2], v[3]); o.z = cvtpk(v[4], v[5]); o.w = cvtpk(v[6], v[7]);
            *(SS_LAS u32x4*)(lds + (isC ? C_CS : C_BS) + l * CP + cg * 16) = o; }); }
    if (tid < 128) stageX(0, tid, 0);
    __syncthreads();
    for (int i = w; i < 10; i += 8) {
        const int sb = (i < 4) ? 0 : (i < 7) ? 1 : (i < 9) ? 2 : 3, lb = (i < 4) ? i : (i < 7) ? i - 3 : (i < 9) ? i - 5 : 3;
        f32x16 acc = (f32x16){0.f, 0.f, 0.f, 0.f, 0.f, 0.f, 0.f, 0.f, 0.f, 0.f, 0.f, 0.f, 0.f, 0.f, 0.f, 0.f};
        const SS_LAS unsigned char* bp = lds + C_BS + (32 * sb + c32) * CP + 16 * hh, *cp = lds + C_CS + (32 * lb + c32) * CP + 16 * hh;
#pragma unroll
        for (int ks = 0; ks < 8; ++ks) acc = __builtin_amdgcn_mfma_f32_32x32x16_bf16(*(const SS_LAS bf16x8*)(bp + 32 * ks), *(const SS_LAS bf16x8*)(cp + 32 * ks), acc, 0, 0, 0);
        SS_LAS unsigned* o = (SS_LAS unsigned*)(lds + C_CBT) + (sb * 4 + lb) * 512 + lane;
#pragma unroll
        for (int q = 0; q < 8; ++q) o[q * 64] = cvtpk(acc[2 * q], acc[2 * q + 1]);
    }
    __syncthreads();
    const int pb = w & 1, lb = w >> 1, lrow = 32 * lb + c32;
    const int rsel = ((lane & 15) >> 2), csel = 16 * ((lane >> 4) & 1) + 4 * (lane & 3);
    unsigned ypk[8][8];
    float ssq = 0.f;
    for (int e = 0; e < 8; ++e) {
        const int h = 8 * g + e;
        if (e + 1 < 8 && tid >= 384) stageX(e + 1, tid - 384, (e + 1) & 1);
        const int xoff = (e & 1) ? C_X1 : C_X0;
        f32x16 acc = (f32x16){0.f, 0.f, 0.f, 0.f, 0.f, 0.f, 0.f, 0.f, 0.f, 0.f, 0.f, 0.f, 0.f, 0.f, 0.f, 0.f};
        {
            const bf16_t* pp = ST + ((size_t)(c * 32 + h) * 64 + 32 * pb + c32) * 128 + 8 * hh;
            const SS_LAS unsigned char* cp = lds + C_CS + lrow * CP + 16 * hh;
#pragma unroll
            for (int ks = 0; ks < 8; ++ks) acc = __builtin_amdgcn_mfma_f32_32x32x16_bf16(*(const bf16x8*)(pp + 16 * ks), *(const SS_LAS bf16x8*)(cp + 32 * ks), acc, 0, 0, 0);
        }
        const float al = ACS[lrow * 8 + e], eal = __expf(al);
#pragma unroll
        for (int r = 0; r < 16; ++r) acc[r] *= eal;
        for (int sb = 0; sb <= lb; ++sb) {
            const SS_LAS unsigned* cbp = (const SS_LAS unsigned*)(lds + C_CBT) + (sb * 4 + lb) * 512 + lane;
            float m[16];
#pragma unroll
            for (int q = 0; q < 8; ++q) { const unsigned u = cbp[q * 64]; m[2 * q] = bflo(u); m[2 * q + 1] = bfhi(u); }
#pragma unroll
            for (int r = 0; r < 16; ++r) { const int srow = 32 * sb + (r & 3) + 8 * (r >> 2) + 4 * hh;
                const float f = __expf(al - ACS[srow * 8 + e]) * DTS[srow * 8 + e];
                m[r] = (srow <= lrow) ? m[r] * f : 0.f; }
            const SS_LAS unsigned char* xp = lds + xoff + (32 * sb + 4 * hh + rsel) * XP + (32 * pb + csel) * 2;
#pragma unroll
            for (int ks = 0; ks < 2; ++ks) {
                const s16x4 x0 = vtr(xp + (16 * ks) * XP), x1 = vtr(xp + (16 * ks + 8) * XP);
                const bf16x8 xf = (bf16x8){x0[0], x0[1], x0[2], x0[3], x1[0], x1[1], x1[2], x1[3]};
                u32x4 mm; mm.x = cvtpk(m[8 * ks], m[8 * ks + 1]); mm.y = cvtpk(m[8 * ks + 2], m[8 * ks + 3]); mm.z = cvtpk(m[8 * ks + 4], m[8 * ks + 5]); mm.w = cvtpk(m[8 * ks + 6], m[8 * ks + 7]);
                acc = __builtin_amdgcn_mfma_f32_32x32x16_bf16(xf, __builtin_bit_cast(bf16x8, mm), acc, 0, 0, 0);
            }
        }
        const float dsk = d_skip[h];
        const bf16_t* zp = Hb + (size_t)(128 * c + lrow) * HP_ + HC_Z + g * 512 + e * 64 + 32 * pb + 4 * hh;
        const SS_LAS unsigned char* xr = lds + xoff + lrow * XP + (32 * pb + 4 * hh) * 2;
        unsigned yt[8];
#pragma unroll
        for (int q = 0; q < 4; ++q) {
            const u32x2 zz = *(const u32x2*)(zp + 8 * q); const u32x2 xx = *(const SS_LAS u32x2*)(xr + 16 * q);
            const float zv[4] = {bflo(zz.x), bfhi(zz.x), bflo(zz.y), bfhi(zz.y)}, xv[4] = {bflo(xx.x), bfhi(xx.x), bflo(xx.y), bfhi(xx.y)};
            float y[4];
#pragma unroll
            for (int k = 0; k < 4; ++k) { y[k] = (acc[4 * q + k] + dsk * xv[k]) * (zv[k] / (1.f + __expf(-zv[k]))); ssq += y[k] * y[k]; }
            yt[2 * q] = cvtpk(y[0], y[1]); yt[2 * q + 1] = cvtpk(y[2], y[3]);
        }
#define SS_YSET(E) case E: { _Pragma("unroll") for (int q_ = 0; q_ < 8; ++q_) ypk[E][q_] = yt[q_]; } break;
        switch (e) { SS_YSET(0) SS_YSET(1) SS_YSET(2) SS_YSET(3) SS_YSET(4) SS_YSET(5) SS_YSET(6) default: { _Pragma("unroll") for (int q_ = 0; q_ < 8; ++q_) ypk[7][q_] = yt[q_]; } break; }
#undef SS_YSET
        __syncthreads();
    }
    ssq += __shfl_xor(ssq, 32);
    if (hh == 0) SSQ[pb * 128 + lrow] = ssq;
    __syncthreads();
    const float rstd = rsqrtf((SSQ[lrow] + SSQ[128 + lrow]) * (1.f / 512.f) + 1e-5f);
    bf16_t* op = Hb + (size_t)(128 * c + lrow) * HP_ + HC_Z + g * 512 + 32 * pb + 4 * hh;
    const float* nw = norm_w + g * 512 + 32 * pb + 4 * hh;
#pragma unroll
    for (int e = 0; e < 8; ++e)
#pragma unroll
        for (int q = 0; q < 4; ++q) { const f32x4 n4 = *(const f32x4*)(nw + e * 64 + 8 * q);
            uint2 o; o.x = cvtpk(bflo(ypk[e][2 * q]) * rstd * n4.x, bfhi(ypk[e][2 * q]) * rstd * n4.y); o.y = cvtpk(bflo(ypk[e][2 * q + 1]) * rstd * n4.z, bfhi(ypk[e][2 * q + 1]) * rstd * n4.w);
            if (STORE || o.x == 0x12345u) *(uint2*)(op + e * 64 + 8 * q) = o; }
    __syncthreads();
}
}


namespace psel {
#define PS_LAS __attribute__((address_space(3)))
typedef short bf16x8 __attribute__((ext_vector_type(8)));
typedef float f32x16 __attribute__((ext_vector_type(16)));
__device__ __forceinline__ int ord(float f) { const int b = __builtin_bit_cast(int, f); return b ^ ((b >> 31) & 0x7fffffff); }
__device__ __forceinline__ float unord(int t) { return __builtin_bit_cast(float, t ^ ((t >> 31) & 0x7fffffff)); }
#define PS_INS(top, v) do { int v_ = (v); _Pragma("unroll") for (int i_ = 0; i_ < 16; ++i_) { const int hi_ = max(top[i_], v_); v_ = min(top[i_], v_); top[i_] = hi_; } } while (0)
__device__ __forceinline__ void step(PS_LAS int* EX, const bf16_t* __restrict__ QP, const bf16_t* __restrict__ SUBK, int* __restrict__ IDX, float* __restrict__ GATE, int tok0, int hp) {
    const int tid = opaque_tid(), lane = tid & 63, w1 = __builtin_amdgcn_readfirstlane(tid >> 6), c32 = lane & 31, hh = lane >> 5;
    {
        const int tile = w1 >> 2, hsel = (w1 >> 1) & 1, half = w1 & 1, h = 2 * hp + hsel;
        const bf16_t* qp = QP + (size_t)(tok0 + 32 * tile + c32) * 2048 + h * 256 + half * 128 + 8 * hh;
        const bf16_t* kp = SUBK + ((size_t)(h * 2 + half) * 128 + c32) * 128 + 8 * hh;
        bf16x8 qf[8];
#pragma unroll
        for (int ks = 0; ks < 8; ++ks) qf[ks] = *(const bf16x8*)(qp + 16 * ks);
        int top[16];
#pragma unroll
        for (int i = 0; i < 16; ++i) top[i] = (int)0x80000000;
#pragma unroll
        for (int mt = 0; mt < 4; ++mt) {
            f32x16 acc = (f32x16){0.f, 0.f, 0.f, 0.f, 0.f, 0.f, 0.f, 0.f, 0.f, 0.f, 0.f, 0.f, 0.f, 0.f, 0.f, 0.f};
#pragma unroll
            for (int ks = 0; ks < 8; ++ks) acc = __builtin_amdgcn_mfma_f32_32x32x16_bf16(*(const bf16x8*)(kp + (size_t)(32 * mt) * 128 + 16 * ks), qf[ks], acc, 0, 0, 0);
#pragma unroll
            for (int r = 0; r < 16; ++r) { const int key = 32 * mt + (r & 3) + 8 * (r >> 2) + 4 * hh; const int v = (ord(acc[r]) & ~127) | (127 - key); PS_INS(top, v); }
        }
        int oth[16];
#pragma unroll
        for (int i = 0; i < 16; ++i) oth[i] = __shfl_xor(top[i], 32);
#pragma unroll
        for (int i = 0; i < 16; ++i) PS_INS(top, oth[i]);
        if (hh == 0) {
#pragma unroll
            for (int i = 0; i < 16; ++i) EX[(w1 * 16 + i) * 32 + c32] = top[i];
        }
    }
    __syncthreads();
    if (lane < 16) {
        const int task = w1 * 16 + lane, th = task >> 5, tok32 = task & 31, tile = th >> 1, hsel = th & 1, h = 2 * hp + hsel;
        const PS_LAS int* ea = EX + ((th * 2 + 0) * 16) * 32 + tok32; const PS_LAS int* eb = EX + ((th * 2 + 1) * 16) * 32 + tok32;
        float as[16], bs[16];
#pragma unroll
        for (int i = 0; i < 16; ++i) { as[i] = unord(ea[i * 32] & ~127); bs[i] = unord(eb[i * 32] & ~127); }
        int top[16];
#pragma unroll
        for (int i = 0; i < 16; ++i) top[i] = (int)0x80000000;
#pragma unroll
        for (int i = 0; i < 16; ++i)
#pragma unroll
            for (int j = 0; j < 16; ++j) if ((i + 1) * (j + 1) <= 16) { const int v = (ord(as[i] + bs[j]) & ~255) | (255 - (i * 16 + j)); PS_INS(top, v); }
        float sc[16]; int id[16];
#pragma unroll
        for (int r = 0; r < 16; ++r) { const int cn = 255 - (top[r] & 255), i = cn >> 4, j = cn & 15; const int pa = ea[i * 32], pb = eb[j * 32];
            sc[r] = unord(pa & ~127) + unord(pb & ~127); id[r] = (127 - (pa & 127)) * 128 + (127 - (pb & 127)); }
        float sum = 0.f; const float mx = sc[0];
#pragma unroll
        for (int r = 0; r < 16; ++r) { sc[r] = __expf(sc[r] - mx); sum += sc[r]; }
        const size_t o = (size_t)(tok0 + 32 * tile + tok32) * 128 + h * 16;
        const float inv = 1.f / sum;
#pragma unroll
        for (int r = 0; r < 16; r += 4) { *(f32x4*)(GATE + o + r) = (f32x4){sc[r] * inv, sc[r + 1] * inv, sc[r + 2] * inv, sc[r + 3] * inv}; *(u32x4*)(IDX + o + r) = (u32x4){(unsigned)id[r], (unsigned)id[r + 1], (unsigned)id[r + 2], (unsigned)id[r + 3]}; }
    }
    __syncthreads();
}
}


namespace xattn {
#define XA_LAS __attribute__((address_space(3)))
typedef short bf16x8 __attribute__((ext_vector_type(8)));
typedef short s16x4 __attribute__((ext_vector_type(4)));
typedef float f32x16 __attribute__((ext_vector_type(16)));
constexpr int RP = 528;
__device__ __forceinline__ unsigned cvtpk(float lo, float hi) { typedef float f2 __attribute__((ext_vector_type(2))); typedef __bf16 b2 __attribute__((ext_vector_type(2))); f2 v = {lo, hi}; b2 b = __builtin_convertvector(v, b2); return __builtin_bit_cast(unsigned, b); }
__device__ __forceinline__ void stage(XA_LAS unsigned char* lds, const bf16_t* __restrict__ src, int pitch, int tid) {
#pragma unroll 4
    for (int i = 0; i < 16; ++i) { const int q = tid + 512 * i, row = q >> 5, ch = q & 31; *(XA_LAS u32x4*)(lds + row * RP + ch * 16) = *(const u32x4*)(src + (size_t)row * pitch + ch * 8); }
}
__device__ __forceinline__ void unit(XA_LAS unsigned char* lds, const bf16_t* __restrict__ QC, const bf16_t* __restrict__ KC, const bf16_t* __restrict__ VcT, bf16_t* __restrict__ XO, int tg, int h) {
    const int tid = opaque_tid(), lane = tid & 63, w = __builtin_amdgcn_readfirstlane(tid >> 6), c32 = lane & 31, hh = lane >> 5, b = tg >> 5;
    const int tok = 256 * tg + 32 * w + c32;
    stage(lds, KC + (size_t)b * MEML * D + h * 256, D, tid);
    bf16x8 pf[8][2]; float inv;
    {
        bf16x8 qf[16];
        const bf16_t* qp = QC + (size_t)tok * D + h * 256 + 8 * hh;
#pragma unroll
        for (int ks = 0; ks < 16; ++ks) qf[ks] = *(const bf16x8*)(qp + 16 * ks);
        __syncthreads();
        f32x16 acc[8];
        const XA_LAS unsigned char* kb = lds + c32 * RP + 16 * hh;
#pragma unroll
        for (int mt = 0; mt < 8; ++mt) {
            acc[mt] = (f32x16){0.f, 0.f, 0.f, 0.f, 0.f, 0.f, 0.f, 0.f, 0.f, 0.f, 0.f, 0.f, 0.f, 0.f, 0.f, 0.f};
#pragma unroll
            for (int ks = 0; ks < 16; ++ks) acc[mt] = __builtin_amdgcn_mfma_f32_32x32x16_bf16(*(const XA_LAS bf16x8*)(kb + (32 * mt) * RP + 32 * ks), qf[ks], acc[mt], 0, 0, 0);
        }
        float mx = acc[0][0];
#pragma unroll
        for (int mt = 0; mt < 8; ++mt)
#pragma unroll
            for (int r = 0; r < 16; ++r) mx = fmaxf(mx, acc[mt][r]);
        mx = fmaxf(mx, __shfl_xor(mx, 32));
        float sum = 0.f;
#pragma unroll
        for (int mt = 0; mt < 8; ++mt)
#pragma unroll
            for (int r = 0; r < 16; ++r) { acc[mt][r] = __builtin_amdgcn_exp2f(acc[mt][r] - mx); sum += acc[mt][r]; }
        sum += __shfl_xor(sum, 32); inv = 1.f / sum;
#pragma unroll
        for (int mt = 0; mt < 8; ++mt)
#pragma unroll
            for (int s2 = 0; s2 < 2; ++s2) { u32x4 a; a.x = cvtpk(acc[mt][8 * s2], acc[mt][8 * s2 + 1]); a.y = cvtpk(acc[mt][8 * s2 + 2], acc[mt][8 * s2 + 3]); a.z = cvtpk(acc[mt][8 * s2 + 4], acc[mt][8 * s2 + 5]); a.w = cvtpk(acc[mt][8 * s2 + 6], acc[mt][8 * s2 + 7]);
                pf[mt][s2] = __builtin_bit_cast(bf16x8, a); }
    }
    __syncthreads();
    stage(lds, VcT + ((size_t)b * D + h * 256) * MEML, MEML, tid);
    __syncthreads();
    const XA_LAS unsigned char* vb = lds + c32 * RP + 8 * hh;
    bf16_t* op = XO + (size_t)tok * D + h * 256 + 4 * hh;
#pragma unroll 1
    for (int dt = 0; dt < 8; ++dt) {
        f32x16 acc = (f32x16){0.f, 0.f, 0.f, 0.f, 0.f, 0.f, 0.f, 0.f, 0.f, 0.f, 0.f, 0.f, 0.f, 0.f, 0.f, 0.f};
#pragma unroll
        for (int mt = 0; mt < 8; ++mt)
#pragma unroll
            for (int s2 = 0; s2 < 2; ++s2) {
                const s16x4 lo = *(const XA_LAS s16x4*)(vb + (32 * dt) * RP + (32 * mt + 16 * s2) * 2), hi = *(const XA_LAS s16x4*)(vb + (32 * dt) * RP + (32 * mt + 16 * s2 + 8) * 2);
                const bf16x8 vf = (bf16x8){lo[0], lo[1], lo[2], lo[3], hi[0], hi[1], hi[2], hi[3]};
                acc = __builtin_amdgcn_mfma_f32_32x32x16_bf16(vf, pf[mt][s2], acc, 0, 0, 0);
            }
#pragma unroll
        for (int q = 0; q < 4; ++q) { u32x2 o; o.x = cvtpk(acc[4 * q] * inv, acc[4 * q + 1] * inv); o.y = cvtpk(acc[4 * q + 2] * inv, acc[4 * q + 3] * inv); *(u32x2*)(op + 32 * dt + 8 * q) = o; }
    }
    __syncthreads();
}
}

namespace sp {
#define SP_LAS __attribute__((address_space(3)))
#define SP_LDSWAIT() do { asm volatile("s_waitcnt lgkmcnt(0)" ::: "memory"); } while (0)
__device__ __forceinline__ void transpose_item(const float* __restrict__ W, int ldw, int col0, int K, int nblk, bf16_t* __restrict__ WT, int row_off, SP_LAS float* scr, int item, int lane) {
    const int kb = item / nblk, nb = item % nblk, k0 = 64 * kb, n0 = 32 * nb;
#pragma unroll 8
    for (int i = 0; i < 32; ++i) { const int kk = 2 * i + (lane >> 5); scr[kk * 33 + (lane & 31)] = W[(size_t)(k0 + kk) * ldw + col0 + n0 + (lane & 31)]; }
    SP_LDSWAIT();
    const int cc = lane & 7;
#pragma unroll
    for (int j = 0; j < 4; ++j) { const int n = (lane >> 3) + 8 * j; const SP_LAS float* s = scr + (8 * cc) * 33 + n;
        u32x4 o; o.x = pk2(s[0 * 33], s[1 * 33]); o.y = pk2(s[2 * 33], s[3 * 33]); o.z = pk2(s[4 * 33], s[5 * 33]); o.w = pk2(s[6 * 33], s[7 * 33]);
        *(u32x4*)(WT + (size_t)(row_off + n0 + n) * K + k0 + 8 * cc) = o; }
    SP_LDSWAIT();
}
__device__ __forceinline__ void cvt_range(const float* __restrict__ src, bf16_t* __restrict__ dst, size_t n4, size_t gtid, size_t gthreads) {
    for (size_t i = gtid; i < n4; i += gthreads) { const f32x4 v = ((const f32x4*)src)[i]; u32x2 o; o.x = pk2(v.x, v.y); o.y = pk2(v.z, v.w); ((u32x2*)dst)[i] = o; }
}

__device__ __forceinline__ void cvt_fp8_range(const float* __restrict__ src, unsigned char* __restrict__ dst, size_t n16, float scale, size_t gtid, size_t gthreads) {
    for (size_t i = gtid; i < n16; i += gthreads) {
        const f32x4* sp4 = (const f32x4*)src + 4 * i; u32x4 o; unsigned ow[4];
#pragma unroll
        for (int q = 0; q < 4; ++q) { const f32x4 v = sp4[q];
            const float a = fminf(fmaxf(v.x * scale, -448.f), 448.f), b = fminf(fmaxf(v.y * scale, -448.f), 448.f), c2 = fminf(fmaxf(v.z * scale, -448.f), 448.f), d2 = fminf(fmaxf(v.w * scale, -448.f), 448.f);
            int p = 0; p = __builtin_amdgcn_cvt_pk_fp8_f32(a, b, p, false); p = __builtin_amdgcn_cvt_pk_fp8_f32(c2, d2, p, true); ow[q] = (unsigned)p; }
        o.x = ow[0]; o.y = ow[1]; o.z = ow[2]; o.w = ow[3];
        ((u32x4*)dst)[i] = o;
    }
}
__device__ __forceinline__ void dt_item(SP_LAS float* xs, const float* __restrict__ x, const float* __restrict__ w_in, const float* __restrict__ dt_bias, float* __restrict__ DT, int item) {
    const int tid = opaque_tid(), m0 = item * 16;
    for (int i = tid; i < 16 * 256; i += 512) { const f32x4 v = ((const f32x4*)(x + (size_t)m0 * D))[i]; *(SP_LAS f32x4*)(xs + 4 * i) = v; }
    __syncthreads();
    const int h = tid & 31, r = tid >> 5; float acc = 0.f;
    const float* wp = w_in + 5120 + h;
#pragma unroll 8
    for (int k = 0; k < 1024; ++k) acc = fmaf(xs[r * 1024 + k], wp[(size_t)k * NIN], acc);
    const float v = acc + dt_bias[h];
    DT[(size_t)(m0 + r) * 32 + h] = v > 20.f ? v : log1pf(expf(v));
    __syncthreads();
}
__device__ __forceinline__ void ln_row(float* __restrict__ X, const float* __restrict__ g, const float* __restrict__ b, bf16_t* __restrict__ XB, int row, int lane) {
    f32x4* xr = (f32x4*)(X + (size_t)row * D) + lane;
    f32x4 v[4]; float s = 0.f;
#pragma unroll
    for (int j = 0; j < 4; ++j) { v[j] = xr[64 * j]; s += (v[j].x + v[j].y) + (v[j].z + v[j].w); }
    const float mean = wave_sum(s) * (1.f / D); float s2 = 0.f;
#pragma unroll
    for (int j = 0; j < 4; ++j) { v[j] = v[j] - mean; s2 += (v[j].x * v[j].x + v[j].y * v[j].y) + (v[j].z * v[j].z + v[j].w * v[j].w); }
    const float rstd = rsqrtf(wave_sum(s2) * (1.f / D) + 1e-5f);
#pragma unroll
    for (int j = 0; j < 4; ++j) { const int c = 4 * lane + 256 * j; const f32x4 gg = *(const f32x4*)(g + c), bb = *(const f32x4*)(b + c);
        f32x4 o = v[j] * rstd * gg + bb; xr[64 * j] = o;
        u32x2 pb; pb.x = pk2(o.x, o.y); pb.y = pk2(o.z, o.w); *(u32x2*)(XB + (size_t)row * D + c) = pb; }
}
__device__ __forceinline__ void xattn_pair(SP_LAS float* L, const bf16_t* __restrict__ QC, const bf16_t* __restrict__ KCVC, bf16_t* __restrict__ XO, int tok0) {
    const int t512 = opaque_tid(); const int half = t512 >> 8, tid = t512 & 255, lane = tid & 63, wv = tid >> 6, tok = tok0 + half, b = tok / SEQ;
    SP_LAS float* qs = L + half * 1024; SP_LAS float* ps = L + 2048 + half * 256; SP_LAS float* red = L + 2560 + half * 8;
    for (int i = tid; i < 1024; i += 256) qs[i] = bf2f(QC[(size_t)tok * D + i]);
    __syncthreads();
    const bf16_t* KV = KCVC + (size_t)b * MEML * 2048;
    for (int h = 0; h < MH; ++h) {
        const bf16_t* kp = KV + (size_t)tid * 2048 + h * 256;
        float s = 0.f;
        for (int d = 0; d < 256; d += 8) { const u32x4 w = *(const u32x4*)(kp + d); const SP_LAS float* q = qs + h * 256 + d;
            s += q[0] * bflo(w.x) + q[1] * bfhi(w.x) + q[2] * bflo(w.y) + q[3] * bfhi(w.y) + q[4] * bflo(w.z) + q[5] * bfhi(w.z) + q[6] * bflo(w.w) + q[7] * bfhi(w.w); }
        float mx = wave_max(s); if (lane == 0) red[wv] = mx; __syncthreads();
        mx = fmaxf(fmaxf(red[0], red[1]), fmaxf(red[2], red[3]));
        const float p = exp2f(s - mx);
        float sm = wave_sum(p); if (lane == 0) red[4 + wv] = sm; ps[tid] = p; __syncthreads();
        sm = (red[4] + red[5]) + (red[6] + red[7]);
        float o = 0.f;
        for (int j = 0; j < 256; ++j) o = fmaf(ps[j], bf2f(KV[(size_t)j * 2048 + 1024 + h * 256 + tid]), o);
        XO[(size_t)tok * D + h * 256 + tid] = (bf16_t)f2bf(o / sm);
        __syncthreads();
    }
}
__device__ __forceinline__ void select_pair(SP_LAS float* L, const bf16_t* __restrict__ QP, const bf16_t* __restrict__ SUBK, int* __restrict__ IDX, float* __restrict__ GATE, int tok0) {
    const int t512 = opaque_tid(); const int hf = t512 >> 8, tid = t512 & 255, tok = tok0 + hf;
    SP_LAS float* base = L + hf * 3072;
    SP_LAS float* qs = base; SP_LAS float* s = base + 2048; SP_LAS float* tops = base + 2304; SP_LAS int* topi = (SP_LAS int*)(base + 2336); SP_LAS float* cs = base + 2368; SP_LAS int* ci = (SP_LAS int*)(base + 2624);
    SP_LAS float* bs = base + 2880; SP_LAS int* bi = (SP_LAS int*)(base + 2896);
    for (int i = tid; i < 2048; i += 256) qs[i] = bf2f(QP[(size_t)tok * 2048 + i]);
    __syncthreads();
    for (int h = 0; h < PH; ++h) {
        const int half = tid >> 7, key = tid & 127;
        { const bf16_t* kp = SUBK + ((size_t)(h * 2 + half) * 128 + key) * 128; const SP_LAS float* q = qs + h * 256 + half * 128; float a = 0.f;
          for (int d = 0; d < 128; d += 8) { const u32x4 w = *(const u32x4*)(kp + d);
              a += q[d] * bflo(w.x) + q[d + 1] * bfhi(w.x) + q[d + 2] * bflo(w.y) + q[d + 3] * bfhi(w.y) + q[d + 4] * bflo(w.z) + q[d + 5] * bfhi(w.z) + q[d + 6] * bflo(w.w) + q[d + 7] * bfhi(w.w); }
          s[tid] = a; }
        __syncthreads();
        { const float me = s[tid]; int rank = 0; const SP_LAS float* spp = s + half * 128;
          for (int j = 0; j < 128; ++j) { const float o = spp[j]; rank += (o > me || (o == me && j < key)) ? 1 : 0; }
          if (rank < 16) { tops[half * 16 + rank] = me; topi[half * 16 + rank] = key; } }
        __syncthreads();
        { const int i = tid >> 4, j = tid & 15; cs[tid] = tops[i] + tops[16 + j]; ci[tid] = topi[i] * 128 + topi[16 + j]; }
        __syncthreads();
        { const float me = cs[tid]; int rank = 0;
          for (int j = 0; j < 256; ++j) { const float o = cs[j]; rank += (o > me || (o == me && j < tid)) ? 1 : 0; }
          if (rank < 16) { bs[rank] = me; bi[rank] = ci[tid]; } }
        __syncthreads();
        if (tid < 16) { const float mx = bs[0]; float sum = 0.f;
            for (int j = 0; j < 16; ++j) sum += expf(bs[j] - mx);
            GATE[(size_t)tok * 128 + h * 16 + tid] = expf(bs[tid] - mx) / sum; IDX[(size_t)tok * 128 + h * 16 + tid] = bi[tid]; }
        __syncthreads();
    }
}
__device__ __forceinline__ void gather_token(SP_LAS float* L, float* __restrict__ X, const bf16_t* __restrict__ PU, const bf16_t* __restrict__ PV, const int* __restrict__ IDX, const float* __restrict__ GATE,
                                             const float* __restrict__ g3, const float* __restrict__ b3, int tok) {
    const int tid = opaque_tid(), lane = tid & 63, wv = tid >> 6;
    SP_LAS float* ys = L; SP_LAS float* red = L + 8192;
    float xr[16], y[16];
    { const float* xp = X + (size_t)tok * D + lane * 16;
#pragma unroll
      for (int j = 0; j < 4; ++j) { const f32x4 v = *(const f32x4*)(xp + 4 * j); xr[4 * j] = v.x; xr[4 * j + 1] = v.y; xr[4 * j + 2] = v.z; xr[4 * j + 3] = v.w; }
#pragma unroll
      for (int j = 0; j < 16; ++j) y[j] = 0.f; }
    for (int e = 0; e < 16; ++e) {
        const int slot = wv * 16 + e; const int id = IDX[(size_t)tok * 128 + slot]; const float gt = GATE[(size_t)tok * 128 + slot];
        const bf16_t* up = PU + (size_t)id * D + lane * 16; const u32x4 u0 = *(const u32x4*)up, u1 = *(const u32x4*)(up + 8);
        const unsigned uw[8] = {u0.x, u0.y, u0.z, u0.w, u1.x, u1.y, u1.z, u1.w};
        float hsum = 0.f;
#pragma unroll
        for (int j = 0; j < 8; ++j) { hsum = fmaf(xr[2 * j], bflo(uw[j]), hsum); hsum = fmaf(xr[2 * j + 1], bfhi(uw[j]), hsum); }
        hsum = wave_sum(hsum);
        const float w = gt * 0.5f * hsum * (1.f + erff(hsum * 0.70710678118654752f));
        const bf16_t* vp = PV + (size_t)id * D + lane * 16; const u32x4 v0 = *(const u32x4*)vp, v1 = *(const u32x4*)(vp + 8);
        const unsigned vw[8] = {v0.x, v0.y, v0.z, v0.w, v1.x, v1.y, v1.z, v1.w};
#pragma unroll
        for (int j = 0; j < 8; ++j) { y[2 * j] = fmaf(w, bflo(vw[j]), y[2 * j]); y[2 * j + 1] = fmaf(w, bfhi(vw[j]), y[2 * j + 1]); }
    }
#pragma unroll
    for (int j = 0; j < 16; ++j) ys[wv * 1024 + lane * 16 + j] = y[j];
    __syncthreads();
    float v[2]; float s = 0.f;
#pragma unroll
    for (int j = 0; j < 2; ++j) { const int c = tid * 2 + j; float a = 0.f;
#pragma unroll
        for (int k = 0; k < 8; ++k) a += ys[k * 1024 + c];
        v[j] = ALPHA * X[(size_t)tok * D + c] + a; s += v[j]; }
    s = wave_sum(s); if (lane == 0) red[wv] = s; __syncthreads();
    float tot = 0.f;
#pragma unroll
    for (int k = 0; k < 8; ++k) tot += red[k];
    const float mean = tot * (1.f / D);
    float s2 = 0.f;
#pragma unroll
    for (int j = 0; j < 2; ++j) { v[j] -= mean; s2 += v[j] * v[j]; }
    s2 = wave_sum(s2); if (lane == 0) red[8 + wv] = s2; __syncthreads();
    float tot2 = 0.f;
#pragma unroll
    for (int k = 0; k < 8; ++k) tot2 += red[8 + k];
    const float rstd = rsqrtf(tot2 * (1.f / D) + 1e-5f);
#pragma unroll
    for (int j = 0; j < 2; ++j) { const int c = tid * 2 + j; X[(size_t)tok * D + c] = v[j] * rstd * g3[c] + b3[c]; }
    __syncthreads();
}

constexpr float PEER_SU = 2048.f, PEER_SV = 256.f;
typedef float f32x2v __attribute__((ext_vector_type(2)));
__device__ __forceinline__ void gather_wave(float* __restrict__ X, const unsigned char* __restrict__ PU, const unsigned char* __restrict__ PV, const int* __restrict__ IDX, const float* __restrict__ GATE,
                                            const float* __restrict__ g3, const float* __restrict__ b3, int tok, int lane) {
    float xr[16], y[16];
    { const f32x4* xp = (const f32x4*)(X + (size_t)tok * D + 16 * lane);
#pragma unroll
      for (int q = 0; q < 4; ++q) { const f32x4 v = xp[q]; xr[4 * q] = v.x; xr[4 * q + 1] = v.y; xr[4 * q + 2] = v.z; xr[4 * q + 3] = v.w; } }
#pragma unroll
    for (int j = 0; j < 16; ++j) y[j] = 0.f;
    const int id0 = IDX[(size_t)tok * 128 + lane], id1 = IDX[(size_t)tok * 128 + 64 + lane];
    const float gt0 = GATE[(size_t)tok * 128 + lane], gt1 = GATE[(size_t)tok * 128 + 64 + lane];
    u32x4 ub[8], vb[8];
#define GW_ISSUE(buf, TBL, i) do { const int idv_ = ((i) < 8) ? id0 : id1; _Pragma("unroll") for (int k_ = 0; k_ < 8; ++k_) { \
        const int id_ = __builtin_amdgcn_readlane(idv_, (8 * (i) + k_) & 63); buf[k_] = *(const u32x4*)((TBL) + (size_t)id_ * D + 16 * lane); } } while (0)
    GW_ISSUE(ub, PU, 0); GW_ISSUE(vb, PV, 0);
    const bool h32 = (lane & 32) != 0, h16 = (lane & 16) != 0, h8 = (lane & 8) != 0;
#pragma unroll 1
    for (int i = 0; i < 16; ++i) {
        float p[8];
#pragma unroll
        for (int k = 0; k < 8; ++k) { const unsigned w[4] = {ub[k].x, ub[k].y, ub[k].z, ub[k].w}; float a = 0.f;
#pragma unroll
            for (int q = 0; q < 4; ++q) { const f32x2v lo = __builtin_amdgcn_cvt_pk_f32_fp8((int)w[q], false), hi = __builtin_amdgcn_cvt_pk_f32_fp8((int)w[q], true);
                a = fmaf(xr[4 * q], lo.x, a); a = fmaf(xr[4 * q + 1], lo.y, a); a = fmaf(xr[4 * q + 2], hi.x, a); a = fmaf(xr[4 * q + 3], hi.y, a); }
            p[k] = a; }
        { const int in_ = (i + 1 < 16) ? i + 1 : 15; GW_ISSUE(ub, PU, in_); }
        float q4[4], q2[2], q1;
#pragma unroll
        for (int k = 0; k < 4; ++k) q4[k] = (h32 ? p[k + 4] : p[k]) + __shfl_xor(h32 ? p[k] : p[k + 4], 32);
#pragma unroll
        for (int k = 0; k < 2; ++k) q2[k] = (h16 ? q4[k + 2] : q4[k]) + __shfl_xor(h16 ? q4[k] : q4[k + 2], 16);
        q1 = (h8 ? q2[1] : q2[0]) + __shfl_xor(h8 ? q2[0] : q2[1], 8);
        q1 += __shfl_xor(q1, 4); q1 += __shfl_xor(q1, 2); q1 += __shfl_xor(q1, 1);
        q1 *= (1.f / PEER_SU);
        const float gsel = __shfl((i < 8) ? gt0 : gt1, (8 * i + (lane >> 3)) & 63);
        const float wv = gsel * 0.5f * q1 * (1.f + erff(q1 * 0.70710678118654752f));
#pragma unroll
        for (int k = 0; k < 8; ++k) { const float wk = __builtin_bit_cast(float, __builtin_amdgcn_readlane(__builtin_bit_cast(int, wv), 8 * k));
            const unsigned w[4] = {vb[k].x, vb[k].y, vb[k].z, vb[k].w};
#pragma unroll
            for (int q = 0; q < 4; ++q) { const f32x2v lo = __builtin_amdgcn_cvt_pk_f32_fp8((int)w[q], false), hi = __builtin_amdgcn_cvt_pk_f32_fp8((int)w[q], true);
                y[4 * q] = fmaf(wk, lo.x, y[4 * q]); y[4 * q + 1] = fmaf(wk, lo.y, y[4 * q + 1]); y[4 * q + 2] = fmaf(wk, hi.x, y[4 * q + 2]); y[4 * q + 3] = fmaf(wk, hi.y, y[4 * q + 3]); } }
        { const int in_ = (i + 1 < 16) ? i + 1 : 15; GW_ISSUE(vb, PV, in_); }
    }
#undef GW_ISSUE
    float s = 0.f;
#pragma unroll
    for (int j = 0; j < 16; ++j) { y[j] = ALPHA * xr[j] + y[j] * (1.f / PEER_SV); s += y[j]; }
    const float mean = wave_sum(s) * (1.f / D); float s2 = 0.f;
#pragma unroll
    for (int j = 0; j < 16; ++j) { y[j] -= mean; s2 += y[j] * y[j]; }
    const float rstd = rsqrtf(wave_sum(s2) * (1.f / D) + 1e-5f);
    float* op = X + (size_t)tok * D + 16 * lane;
#pragma unroll
    for (int q = 0; q < 4; ++q) { const f32x4 gg = *(const f32x4*)(g3 + 16 * lane + 4 * q), bb = *(const f32x4*)(b3 + 16 * lane + 4 * q);
        f32x4 o; o.x = y[4 * q] * rstd * gg.x + bb.x; o.y = y[4 * q + 1] * rstd * gg.y + bb.y; o.z = y[4 * q + 2] * rstd * gg.z + bb.z; o.w = y[4 * q + 3] * rstd * gg.w + bb.w;
        *(f32x4*)(op + 4 * q) = o; }
}
}


#define LAS __attribute__((address_space(3)))
#define XB_TMO      128
#define XB_XCNT(j)  (256  + 64 * (j))
#define XB_XSUB(j)  (1280 + 64 * (j))
#define XB_XGEN(j)  (2304 + 64 * (j))
#define XB_TOP      3328
#define XB_TOPGEN   3392
#define XCD_BAR_WORDS 3456
#define XB_SPIN_CAP (1u << 18)
__device__ __forceinline__ unsigned xb_ld(unsigned* p)              { return __hip_atomic_load(p, __ATOMIC_RELAXED, __HIP_MEMORY_SCOPE_AGENT); }
__device__ __forceinline__ unsigned xb_add(unsigned* p, unsigned v) { return __hip_atomic_fetch_add(p, v, __ATOMIC_RELAXED, __HIP_MEMORY_SCOPE_AGENT); }
__device__ __forceinline__ unsigned xb_xcc_id() { return (unsigned)__builtin_amdgcn_s_getreg((3 << 11) | 20) & 0xFu; }
#define XB_SPIN(cond, bar) do { unsigned _sp = 0; while (cond) { __builtin_amdgcn_s_sleep(1); \
    if ((++_sp & 255u) == 0u) { if (xb_ld(&(bar)[XB_TMO])) break; if (_sp > XB_SPIN_CAP) { atomicAdd(&(bar)[XB_TMO], 1u); break; } } } } while (0)
struct XcdBarrier { unsigned* bar; unsigned x; volatile LAS unsigned* st; };
__device__ __forceinline__ XcdBarrier xcd_barrier_post(unsigned* bar, volatile LAS unsigned* st) {
    XcdBarrier b; b.bar = bar; b.x = xb_xcc_id(); b.st = st;
    if (threadIdx.x == 0) (void)xb_add(&bar[XB_XCNT(b.x)], 1u);
    return b;
}
__device__ __forceinline__ void xcd_barrier_complete(unsigned* bar, unsigned x, unsigned& nloc, unsigned& nx) {
    const unsigned G = gridDim.x * gridDim.y * gridDim.z;
    unsigned sum, cnt, mine, sp = 0u;
    for (;;) {
        sum = 0u; cnt = 0u; mine = 0u;
#pragma unroll
        for (unsigned j = 0; j < 16; ++j) { const unsigned c = xb_ld(&bar[XB_XCNT(j)]); sum += c; cnt += (c > 0u) ? 1u : 0u; mine = (j == x) ? c : mine; }
        if (sum == G) break;
        __builtin_amdgcn_s_sleep(1);
        if ((++sp & 255u) == 0u) { if (xb_ld(&bar[XB_TMO])) break; if (sp > XB_SPIN_CAP) { atomicAdd(&bar[XB_TMO], 1u); break; } }
    }
    nloc = mine > 0u ? mine : 1u; nx = cnt > 0u ? cnt : 1u;
}
__device__ __forceinline__ void xcd_barrier(const XcdBarrier& b) {
    asm volatile("s_waitcnt vmcnt(0)" ::: "memory");
    __syncthreads();
    if (threadIdx.x == 0) {
        unsigned* bar = b.bar;
        __builtin_amdgcn_s_waitcnt(0);
        unsigned nloc = b.st[0], nx = b.st[1];
        if (nloc == 0u) { xcd_barrier_complete(bar, b.x, nloc, nx); b.st[0] = nloc; b.st[1] = nx; }
        const unsigned old = xb_add(&bar[XB_XSUB(b.x)], 1u);
        const unsigned gen = old / nloc;
        if (old + 1u == (gen + 1u) * nloc) {
            __builtin_amdgcn_fence(__ATOMIC_RELEASE, "agent");
            asm volatile("s_waitcnt vmcnt(0)" ::: "memory");
            const unsigned og = xb_add(&bar[XB_TOP], 1u);
            const unsigned tg = og / nx;
            if (og + 1u == (tg + 1u) * nx) xb_add(&bar[XB_TOPGEN], 1u);
            else XB_SPIN(xb_ld(&bar[XB_TOPGEN]) == tg, bar);
            __builtin_amdgcn_fence(__ATOMIC_ACQUIRE, "agent");
            xb_add(&bar[XB_XGEN(b.x)], 1u);
            asm volatile("s_waitcnt vmcnt(0)" ::: "memory");
        } else {
            XB_SPIN(xb_ld(&bar[XB_XGEN(b.x)]) == gen, bar);
            __builtin_amdgcn_fence(__ATOMIC_ACQUIRE, "agent");
            asm volatile("s_waitcnt vmcnt(0)" ::: "memory");
        }
    }
    __syncthreads();
}
constexpr int CW_BAR = 4096;
constexpr int MISC_OFF = 147456 - 64;

struct Params { const float* in[30]; float* out; unsigned char* ws; };
template <class F> __device__ __forceinline__ void run_gemm(unsigned char* lds, const bf16_t* A, int lda, const bf16_t* Bt, int Mr, int N, int K, F f) {
    pg8::Gemm g{A, Bt, Mr, N, K, lda}; pg8::StaticOrder S; S.init(Mr, N, gridDim.x, blockIdx.x); pg8::EpiAdapt<F> E{f};
    pg8::gemm_phase<pg8::EpiAdapt<F>, pg8::StaticOrder, true>((PG8_LAS unsigned char*)lds, g, S, E);
}
#ifndef PROBE_ATTN
#define PROBE_ATTN 0
#endif
#ifndef PROBE_SSD
#define PROBE_SSD 0
#endif
#ifndef PROBE_SYNC
#define PROBE_SYNC 0
#endif
#define KA_LAS __attribute__((address_space(4)))
#define PH_BEGIN const KA_LAS unsigned char* ka_ = (const KA_LAS unsigned char*)__builtin_amdgcn_kernarg_segment_ptr(); asm volatile("" : "+s"(ka_))
#define PIN(k) (*(const float* const KA_LAS*)(ka_ + 8 * (k)))
#define POUT (*(float* const KA_LAS*)(ka_ + 240))
#define PWS (*(unsigned char* const KA_LAS*)(ka_ + 248))
__global__ void __launch_bounds__(512, 2) hybrid_fwd(Params P) {
    extern __shared__ __attribute__((aligned(16))) unsigned char lds[];
    cg::grid_group grid = cg::this_grid();
    { PH_BEGIN; volatile LAS unsigned* misc = (volatile LAS unsigned*)((LAS unsigned char*)lds + MISC_OFF);
      if (threadIdx.x < 16) misc[threadIdx.x] = 0u;
      __syncthreads();
      (void)xcd_barrier_post((unsigned*)(PWS + WS_CTL) + CW_BAR, misc); }
#define GSYNC() do { PH_BEGIN; XcdBarrier xb_; xb_.bar = (unsigned*)(PWS + WS_CTL) + CW_BAR; xb_.x = xb_xcc_id(); xb_.st = (volatile LAS unsigned*)((LAS unsigned char*)lds + MISC_OFF); xcd_barrier(xb_); } while (0)
    {
        PH_BEGIN; unsigned char* ws = PWS;
        const int tid = opaque_tid(), lane = tid & 63, wave = __builtin_amdgcn_readfirstlane(tid >> 6), c = blockIdx.x, G = gridDim.x;
        const size_t gtid = (size_t)c * 512 + tid, gthreads = (size_t)G * 512; const int gw = c * 8 + wave, NGW = G * 8;
        const float* w_in = PIN(2);
        bf16_t* WinT = (bf16_t*)(ws + WS_WIN); bf16_t* WckvT = (bf16_t*)(ws + WS_WCKV);
        SP_LAS float* scr = (SP_LAS float*)lds + wave * (64 * 33);
        constexpr int I0 = 2560, I1 = 5120, I2 = 6144, I3 = 6656, I4 = 7168, I5 = 7680, I6 = 8192, I7 = 8704, I8 = 9216, I9 = 10240;
        for (int it = gw; it < I9; it += NGW) {
            if (it < I0) sp::transpose_item(w_in, NIN, 0, D, 160, WinT, 0, scr, it, lane);
            else if (it < I1) sp::transpose_item(w_in, NIN, 5152, D, 160, WinT, 5120, scr, it - I0, lane);
            else if (it < I2) sp::transpose_item(PIN(9), D, 0, DI, 32, (bf16_t*)(ws + WS_WSSD), 0, scr, it - I1, lane);
            else if (it < I3) sp::transpose_item(PIN(13), D, 0, D, 32, (bf16_t*)(ws + WS_WDIFF), 0, scr, it - I2, lane);
            else if (it < I4) sp::transpose_item(PIN(15), D, 0, D, 32, (bf16_t*)(ws + WS_WO), 0, scr, it - I3, lane);
            else if (it < I5) sp::transpose_item(PIN(18), D, 0, D, 32, (bf16_t*)(ws + WS_WCQ), 0, scr, it - I4, lane);
            else if (it < I6) sp::transpose_item(PIN(19), D, 0, D, 32, WckvT, 0, scr, it - I5, lane);
            else if (it < I7) sp::transpose_item(PIN(20), D, 0, D, 32, WckvT, 1024, scr, it - I6, lane);
            else if (it < I8) sp::transpose_item(PIN(21), D, 0, D, 32, (bf16_t*)(ws + WS_WCO), 0, scr, it - I7, lane);
            else sp::transpose_item(PIN(24), 2048, 0, D, 64, (bf16_t*)(ws + WS_WPQ), 0, scr, it - I8, lane);
        }
        const float* x = PIN(0);
        sp::cvt_range(x, (bf16_t*)(ws + WS_XB), (size_t)M * D / 4, gtid, gthreads);
        sp::cvt_range(PIN(1), (bf16_t*)(ws + WS_MEMB), (size_t)BATCH * MEML * D / 4, gtid, gthreads);
        sp::cvt_range(PIN(25), (bf16_t*)(ws + WS_SUBK), (size_t)PH * 2 * PK * PHALF / 4, gtid, gthreads);
        __syncthreads();
        for (int it = c; it < M / 16; it += G) sp::dt_item((SP_LAS float*)lds, x, w_in, PIN(5), (float*)(ws + WS_DT), it);
        if (c == 0 && tid == 0) { const float* lam_q = PIN(10); const float* lam_k = PIN(11); float s0 = 0.f, s1 = 0.f;
            for (int i = 0; i < 64; ++i) { s0 += lam_q[i] * lam_k[i]; s1 += lam_q[64 + i] * lam_k[64 + i]; }
            ((float*)(ws + WS_CTL))[CW_LAM] = expf(s0) - expf(s1) + LAMBDA_INIT; }
    }
    grid.sync();
    { PH_BEGIN; unsigned char* ws = PWS;
      run_gemm(lds, (const bf16_t*)(ws + WS_MEMB), D, (const bf16_t*)(ws + WS_WCKV), BATCH * MEML, D, D, EpiPlain{(bf16_t*)(ws + WS_KCVC), D, 1.f});
      for (int bb = 0; bb < BATCH; ++bb)
          run_gemm(lds, (const bf16_t*)(ws + WS_WCKV) + (size_t)D * D, D, (const bf16_t*)(ws + WS_MEMB) + (size_t)bb * MEML * D, D, MEML, D, EpiPlain{(bf16_t*)(ws + WS_KCVC) + (size_t)BATCH * MEML * D + (size_t)bb * D * MEML, MEML, 1.f});
      run_gemm(lds, (const bf16_t*)(ws + WS_XB), D, (const bf16_t*)(ws + WS_WIN), SEQ, NINP, D, EpiInProj{(bf16_t*)(ws + WS_H), PIN(14)}); }
    GSYNC();
#pragma unroll 1
    for (int b = 0; b < BATCH; ++b) {
        { PH_BEGIN; unsigned char* ws = PWS; const int c = blockIdx.x, G = gridDim.x;
          bf16_t* H = (bf16_t*)(ws + WS_H); const float* DTb = (const float*)(ws + WS_DT) + (size_t)b * SEQ * 32;
          for (int u = c; u < 256; u += G) ssd::phaseA_unit((SS_LAS unsigned char*)lds, H, DTb, PIN(3), PIN(4), PIN(6), (bf16_t*)(ws + WS_T1), (float*)(ws + WS_CTL) + 1024, u >> 2, u & 3);
          const float lam = ((const float*)(ws + WS_CTL))[CW_LAM]; const float* subln_w = PIN(12);
#if PROBE_ATTN
          for (int u = c; u < 256; u += G) { const int h = u >> 5, j = u & 31;
              dattn::unit<false>((DA_LAS unsigned char*)lds, H, h, 63 - j, subln_w, lam);
              dattn::unit<false>((DA_LAS unsigned char*)lds, H, h, j, subln_w, lam); }
#endif
          for (int u = c; u < 256; u += G) { const int h = u >> 5, j = u & 31;
              dattn::unit((DA_LAS unsigned char*)lds, H, h, 63 - j, subln_w, lam);
              dattn::unit((DA_LAS unsigned char*)lds, H, h, j, subln_w, lam); } }
        GSYNC();
        { PH_BEGIN; unsigned char* ws = PWS; const int tid = opaque_tid();
          for (size_t i = (size_t)blockIdx.x * 512 + tid; i < 131072; i += (size_t)gridDim.x * 512) ssd::scan_phase((bf16_t*)(ws + WS_T1), (const float*)(ws + WS_CTL) + 1024, (int)i); }
        GSYNC();
        { PH_BEGIN; unsigned char* ws = PWS; const int c = blockIdx.x, G = gridDim.x;
#if PROBE_SSD
          for (int u = c; u < 256; u += G) ssd::phaseA_unit((SS_LAS unsigned char*)lds, (bf16_t*)(ws + WS_H), (const float*)(ws + WS_DT) + (size_t)b * SEQ * 32, PIN(3), PIN(4), PIN(6), (bf16_t*)(POUT + (size_t)SEQ * D), (float*)(ws + WS_CTL) + 8192, u >> 2, u & 3);
          for (int u = c; u < 256; u += G) ssd::phaseC_unit<false>((SS_LAS unsigned char*)lds, (bf16_t*)(ws + WS_H), (const float*)(ws + WS_DT) + (size_t)b * SEQ * 32, PIN(3), PIN(4), PIN(6), PIN(7), PIN(8), (const bf16_t*)(ws + WS_T1), u >> 2, u & 3);
#endif
          for (int u = c; u < 256; u += G) ssd::phaseC_unit((SS_LAS unsigned char*)lds, (bf16_t*)(ws + WS_H), (const float*)(ws + WS_DT) + (size_t)b * SEQ * 32, PIN(3), PIN(4), PIN(6), PIN(7), PIN(8), (const bf16_t*)(ws + WS_T1), u >> 2, u & 3); }
        GSYNC();
        { PH_BEGIN; unsigned char* ws = PWS; bf16_t* H = (bf16_t*)(ws + WS_H); float* T1 = (float*)(ws + WS_T1);
          run_gemm(lds, H + HC_Z, HP_, (const bf16_t*)(ws + WS_WSSD), SEQ, D, DI, EpiGate1{H, T1});
          run_gemm(lds, H + HC_Q, HP_, (const bf16_t*)(ws + WS_WDIFF), SEQ, D, D, EpiGate2{H, T1}); }
        GSYNC();
        { PH_BEGIN; unsigned char* ws = PWS;
          run_gemm(lds, (const bf16_t*)(ws + WS_H) + HC_K, HP_, (const bf16_t*)(ws + WS_WO), SEQ, D, D, EpiResid{PIN(0), POUT, b * SEQ, 0}); }
        GSYNC();
        if (b + 1 < BATCH) {
            { PH_BEGIN; unsigned char* ws = PWS;
              run_gemm(lds, (const bf16_t*)(ws + WS_XB) + (size_t)(b + 1) * SEQ * D, D, (const bf16_t*)(ws + WS_WIN), SEQ, NINP, D, EpiInProj{(bf16_t*)(ws + WS_H), PIN(14)}); }
            GSYNC();
        }
    }
    { PH_BEGIN; unsigned char* ws = PWS; const int tid = opaque_tid(), lane = tid & 63, wave = __builtin_amdgcn_readfirstlane(tid >> 6), c = blockIdx.x, G = gridDim.x;
      const size_t gtid = (size_t)c * 512 + tid, gthreads = (size_t)G * 512;
      float* out = POUT; const float* g = PIN(16); const float* bb = PIN(17); bf16_t* XB = (bf16_t*)(ws + WS_XB);
      for (int r = c * 8 + wave; r < M; r += G * 8) sp::ln_row(out, g, bb, XB, r, lane);
      sp::cvt_fp8_range(PIN(26), ws + WS_PU, (size_t)PK * PK * D / 16, sp::PEER_SU, gtid, gthreads);
      sp::cvt_fp8_range(PIN(27), ws + WS_PV, (size_t)PK * PK * D / 16, sp::PEER_SV, gtid, gthreads); }
    GSYNC();
    { PH_BEGIN; unsigned char* ws = PWS;
      run_gemm(lds, (const bf16_t*)(ws + WS_XB), D, (const bf16_t*)(ws + WS_WCQ), M, D, D, EpiPlain{(bf16_t*)(ws + WS_QC), D, CQSCALE}); }
    GSYNC();
    { PH_BEGIN; unsigned char* ws = PWS; const int c = blockIdx.x, G = gridDim.x;
      for (int u = c; u < 256; u += G) xattn::unit((XA_LAS unsigned char*)lds, (const bf16_t*)(ws + WS_QC), (const bf16_t*)(ws + WS_KCVC), (const bf16_t*)(ws + WS_KCVC) + (size_t)BATCH * MEML * D, (bf16_t*)(ws + WS_XO), u >> 2, u & 3); }
    GSYNC();
    { PH_BEGIN; unsigned char* ws = PWS; float* out = POUT;
      run_gemm(lds, (const bf16_t*)(ws + WS_XO), D, (const bf16_t*)(ws + WS_WCO), M, D, D, EpiResid{out, out, 0, 0}); }
    GSYNC();
    { PH_BEGIN; unsigned char* ws = PWS; const int tid = opaque_tid(), lane = tid & 63, wave = __builtin_amdgcn_readfirstlane(tid >> 6), c = blockIdx.x, G = gridDim.x;
      float* out = POUT; const float* g = PIN(22); const float* bb = PIN(23); bf16_t* XB = (bf16_t*)(ws + WS_XB);
      for (int r = c * 8 + wave; r < M; r += G * 8) sp::ln_row(out, g, bb, XB, r, lane); }
    GSYNC();
    { PH_BEGIN; unsigned char* ws = PWS;
      run_gemm(lds, (const bf16_t*)(ws + WS_XB), D, (const bf16_t*)(ws + WS_WPQ), M, 2048, D, EpiPlain{(bf16_t*)(ws + WS_QP), 2048, 1.f}); }
    GSYNC();
    { PH_BEGIN; unsigned char* ws = PWS; const int c = blockIdx.x, G = gridDim.x;
      for (int t = 64 * c; t < M; t += 64 * G)
          for (int hp = 0; hp < 4; ++hp) psel::step((PS_LAS int*)lds, (const bf16_t*)(ws + WS_QP), (const bf16_t*)(ws + WS_SUBK), (int*)(ws + WS_IDX), (float*)(ws + WS_GATE), t, hp); }
    GSYNC();
    { PH_BEGIN; unsigned char* ws = PWS; const int tid = opaque_tid(), lane = tid & 63, wave = __builtin_amdgcn_readfirstlane(tid >> 6);
      float* out = POUT; const float* g3 = PIN(28); const float* b3 = PIN(29);
      for (int t = blockIdx.x * 8 + wave; t < M; t += gridDim.x * 8) sp::gather_wave(out, ws + WS_PU, ws + WS_PV, (const int*)(ws + WS_IDX), (const float*)(ws + WS_GATE), g3, b3, t, lane); }
}

extern "C" void kernel_launch(void* const* d_in, const int* in_sizes, int n_in, void* d_out, int out_size, void* d_ws, size_t ws_size, hipStream_t stream) {
    static int grid_blocks = 0;
    if (grid_blocks == 0) {
        if (n_in != 30 || out_size != M * D || ws_size < WS_END) { fprintf(stderr, "kernel_launch: unexpected sizes n_in %d out %d ws %zu (need %zu)\n", n_in, out_size, ws_size, (size_t)WS_END); grid_blocks = -1; return; }
        int dev = 0, cus = 0, per_cu = 0;
        (void)hipGetDevice(&dev); (void)hipDeviceGetAttribute(&cus, hipDeviceAttributeMultiprocessorCount, dev);
        (void)hipFuncSetAttribute((const void*)hybrid_fwd, hipFuncAttributeMaxDynamicSharedMemorySize, LDS_BYTES);
        if (hipOccupancyMaxActiveBlocksPerMultiprocessor(&per_cu, (const void*)hybrid_fwd, 512, LDS_BYTES) != hipSuccess || per_cu < 1) { fprintf(stderr, "kernel_launch: occupancy query failed (%d)\n", per_cu); per_cu = 1; }
        (void)hipGetLastError();
        grid_blocks = cus * 1;
    }
    if (grid_blocks < 0) return;
    if (hipMemsetAsync(d_ws, 0, 65536, stream) != hipSuccess) { fprintf(stderr, "kernel_launch: memset of control words failed\n"); return; }
    Params p{};
    for (int i = 0; i < 30; ++i) p.in[i] = (const float*)d_in[i];
    p.out = (float*)d_out; p.ws = (unsigned char*)d_ws;
    void* args[] = {&p};
    hipError_t e = hipLaunchCooperativeKernel((const void*)hybrid_fwd, dim3(grid_blocks), dim3(512), args, LDS_BYTES, stream);
    if (e != hipSuccess) fprintf(stderr, "cooperative launch failed: %s (grid %d)\n", hipGetErrorString(e), grid_blocks);
}
```

```cpp
#include <hip/hip_runtime.h>
#include <hip/hip_cooperative_groups.h>
namespace cg = cooperative_groups;
#include <cstdio>
#include <cstdint>
#include <cmath>
#include <type_traits>

typedef unsigned short bf16_t;
typedef float f32x4 __attribute__((ext_vector_type(4)));
typedef unsigned u32x4 __attribute__((ext_vector_type(4)));
typedef unsigned u32x2 __attribute__((ext_vector_type(2)));

constexpr int D = 1024, BATCH = 2, SEQ = 8192, M = BATCH * SEQ;
constexpr int DI = 2048, NH = 32, HP = 64, NG = 4, DS = 128, DXBC = 3072;
constexpr int AH = 8, AD = 64, AV = 128;
constexpr int MEML = 256, MH = 4, MHD = 256;
constexpr int PH = 8, PK = 128, PDK = 256, PHALF = 128, PTOP = 16;
constexpr int NIN = 10272, NINP = 10240;
constexpr float ALPHA = 1.189207115002721f;
constexpr float LOG2E = 1.4426950408889634f;
constexpr float QSCALE = 0.125f * LOG2E;
constexpr float CQSCALE = 0.0625f * LOG2E;
constexpr float LAMBDA_INIT = 0.2f;
constexpr int HC_Z = 0, HC_XBC = 2048, HC_Q = 5120, HC_K = 6144, HC_V = 7168, HC_GS = 8192, HC_GA = 9216, HP_ = NINP;

constexpr size_t MiB = 1u << 20;
constexpr size_t WS_CTL = 0;
constexpr size_t WS_WIN = 1 * MiB;
constexpr size_t WS_WSSD = 21 * MiB;
constexpr size_t WS_WDIFF = 25 * MiB, WS_WO = 27 * MiB, WS_WCQ = 29 * MiB, WS_WCKV = 31 * MiB  , WS_WCO = 35 * MiB;
constexpr size_t WS_WPQ = 37 * MiB;
constexpr size_t WS_SUBK = 41 * MiB;
constexpr size_t WS_MEMB = 42 * MiB;
constexpr size_t WS_KCVC = 43 * MiB;
constexpr size_t WS_DT = 45 * MiB;
constexpr size_t WS_XB = 47 * MiB;
constexpr size_t WS_H = 79 * MiB;
constexpr size_t WS_T1 = 239 * MiB;
constexpr size_t WS_PU = 79 * MiB, WS_PV = 111 * MiB;
constexpr size_t WS_QC = 143 * MiB, WS_XO = 175 * MiB;
constexpr size_t WS_QP = 207 * MiB;
constexpr size_t WS_IDX = 143 * MiB, WS_GATE = 151 * MiB;
constexpr size_t WS_END = 271 * MiB;
constexpr int CW_LAM = 64;

__device__ __forceinline__ int opaque_tid() { int t = threadIdx.x; asm volatile("" : "+v"(t)); return t; }
__device__ __forceinline__ unsigned f2bf(float f) { unsigned u = __builtin_bit_cast(unsigned, f); return (u + 0x7fffu + ((u >> 16) & 1u)) >> 16; }
__device__ __forceinline__ float bf2f(unsigned h) { return __builtin_bit_cast(float, h << 16); }
__device__ __forceinline__ unsigned pk2(float lo, float hi) { return f2bf(lo) | (f2bf(hi) << 16); }
__device__ __forceinline__ float bflo(unsigned w) { return __builtin_bit_cast(float, w << 16); }
__device__ __forceinline__ float bfhi(unsigned w) { return __builtin_bit_cast(float, w & 0xffff0000u); }
__device__ __forceinline__ float sigmoidf_(float v) { return __builtin_amdgcn_rcpf(1.f + __expf(-v)); }
__device__ __forceinline__ float siluf_(float v) { return v * __builtin_amdgcn_rcpf(1.f + __expf(-v)); }
__device__ __forceinline__ float wave_sum(float v) {
#pragma unroll
    for (int o = 1; o < 64; o <<= 1) v += __shfl_xor(v, o);
    return v;
}
__device__ __forceinline__ float wave_max(float v) {
#pragma unroll
    for (int o = 1; o < 64; o <<= 1) v = fmaxf(v, __shfl_xor(v, o));
    return v;
}

__device__ __forceinline__ void store_bf16x8(bf16_t* p, const float (&v)[8]) { u32x4 w; w.x = pk2(v[0], v[1]); w.y = pk2(v[2], v[3]); w.z = pk2(v[4], v[5]); w.w = pk2(v[6], v[7]); *(u32x4*)p = w; }
struct EpiPlain { bf16_t* O; int ldc; float scale;
    __device__ __forceinline__ void operator()(int row, int col0, const float (&v)[8]) const { float o[8];
#pragma unroll
        for (int j = 0; j < 8; ++j) o[j] = v[j] * scale; store_bf16x8(O + (size_t)row * ldc + col0, o); } };
struct EpiInProj { bf16_t* H; const float* gate_bias;
    __device__ __forceinline__ void operator()(int row, int col0, const float (&v)[8]) const { float o[8];
        if (col0 >= HC_GS) { const float* gb = gate_bias + (col0 - HC_GS);
#pragma unroll
            for (int j = 0; j < 8; ++j) o[j] = sigmoidf_(v[j] + gb[j]); }
        else { const float s = (col0 >= HC_Q && col0 < HC_K) ? QSCALE : 1.f;
#pragma unroll
            for (int j = 0; j < 8; ++j) o[j] = v[j] * s; }
        store_bf16x8(H + (size_t)row * HP_ + col0, o); } };
struct EpiGate1 { const bf16_t* H; float* T1;
    __device__ __forceinline__ void operator()(int row, int col0, const float (&v)[8]) const {
        const u32x4 g = *(const u32x4*)(H + (size_t)row * HP_ + HC_GS + col0); const unsigned gw[4] = {g.x, g.y, g.z, g.w};
        float* t = T1 + (size_t)row * D + col0;
#pragma unroll
        for (int j = 0; j < 4; ++j) { t[2 * j] = bflo(gw[j]) * v[2 * j]; t[2 * j + 1] = bfhi(gw[j]) * v[2 * j + 1]; } } };
struct EpiGate2 { bf16_t* H; const float* T1;
    __device__ __forceinline__ void operator()(int row, int col0, const float (&v)[8]) const {
        const u32x4 g = *(const u32x4*)(H + (size_t)row * HP_ + HC_GA + col0); const unsigned gw[4] = {g.x, g.y, g.z, g.w};
        const float* t = T1 + (size_t)row * D + col0; float o[8];
#pragma unroll
        for (int j = 0; j < 4; ++j) { o[2 * j] = t[2 * j] + bflo(gw[j]) * v[2 * j]; o[2 * j + 1] = t[2 * j + 1] + bfhi(gw[j]) * v[2 * j + 1]; }
        store_bf16x8(H + (size_t)row * HP_ + HC_K + col0, o); } };
struct EpiResid { const float* base; float* out; int row_off; int pad_;
    __device__ __forceinline__ void operator()(int row, int col0, const float (&v)[8]) const {
        const size_t o = (size_t)(row + row_off) * D + col0;
#pragma unroll
        for (int j = 0; j < 8; ++j) out[o + j] = ALPHA * base[o + j] + v[j]; } };


namespace pg8 {
#define PG8_LAS __attribute__((address_space(3)))
typedef short bf16x8 __attribute__((ext_vector_type(8)));
constexpr int BM = 256, BK = 64, HALF = 128, HTB = HALF * BK * 2, STAGE_BYTES = 8 * HTB, NXCD = 8, WGM = 8;
__host__ __device__ __forceinline__ int lds_byte(int r, int c) { const int st = (r >> 4) * 2 + (c >> 5), rr = r & 15, cc = c & 31, ob = rr * 64 + cc * 2; return st * 1024 + (ob ^ (((ob >> 9) & 1) << 5)); }
__host__ __device__ __forceinline__ void stage_rc(int b, int& R, int& C) { const int st = b / 1024, sb = b % 1024, swz = sb ^ (((sb >> 9) & 1) << 5); R = (st >> 1) * 16 + swz / 64; C = (st & 1) * 32 + (swz % 64) / 2; }
__host__ __device__ __forceinline__ int perm32(int rho) { const int n = rho >> 4, i = rho & 15; return 8 * (i >> 2) + 4 * n + (i & 3); }
struct Unit { int pm, pn; };
struct Gemm { const bf16_t* A; const bf16_t* Bt; int M, N, K, lda; };
struct StaticOrder {
    int nM, nN, nwg, G, c;
    __host__ __device__ void init(int M, int N, int G_, int c_) { nM = M / BM; nN = N / BM; nwg = nM * nN; G = G_; c = c_; }
    __host__ __device__ bool next(int i, Unit& u) const {
        const long L = (long)i * G + c; if (L >= nwg) return false;
        int wgid = (int)L; { const int q = nwg / NXCD, r = nwg % NXCD, xcd = wgid % NXCD, off = wgid / NXCD; wgid = (xcd < r ? xcd * (q + 1) : r * (q + 1) + (xcd - r) * q) + off; }
        const int nig = WGM * nN, gid = wgid / nig, fm = gid * WGM, gsz = (nM - fm) < WGM ? (nM - fm) : WGM;
        u.pm = fm + ((wgid % nig) % gsz); u.pn = (wgid % nig) / gsz; return true;
    }
};
template <class F> struct EpiAdapt {
    static constexpr bool PERM = true, AFTER_DRAIN = false; F f;
    __device__ __forceinline__ void operator()(const f32x4 (&acc)[2][2][4][2], const Unit& u, int wr, int wc, int fr, int fq) const {
#pragma unroll
        for (int ai = 0; ai < 2; ++ai)
#pragma unroll
            for (int m = 0; m < 4; ++m) { const int row = u.pm * BM + ai * HALF + wr * 64 + m * 16 + fr;
#pragma unroll
                for (int bj = 0; bj < 2; ++bj) { const int col0 = u.pn * BM + bj * HALF + wc * 32 + 8 * fq;
                    const f32x4 a = acc[ai][bj][m][0], b = acc[ai][bj][m][1]; const float v[8] = {a[0], a[1], a[2], a[3], b[0], b[1], b[2], b[3]};
                    f(row, col0, v); } }
    }
};
template <class Epi, class Sched, bool ALIGN_EPI>
__device__ __forceinline__ void gemm_phase(PG8_LAS unsigned char* lds, const Gemm g, const Sched& S, const Epi& E) {
    const int tid = opaque_tid(), wid = __builtin_amdgcn_readfirstlane(tid >> 6), lane = tid & 63, wr = wid >> 2, wc = wid & 3, fr = lane & 15, fq = lane >> 4;
    const int K = g.K, nt = K / BK, lda = g.lda;
    unsigned voffA[2], voffB[2];
#pragma unroll
    for (int i = 0; i < 2; ++i) { int R, C; stage_rc(tid * 16 + i * 8192, R, C); const int Rb = Epi::PERM ? ((R & ~31) + perm32(R & 31)) : R;
        voffA[i] = (unsigned)(R * lda + C) * 2u; voffB[i] = (unsigned)(Rb * K + C) * 2u; }
    const size_t kstep = (size_t)(BK * 2);
    const size_t hstepA = (size_t)HALF * lda * 2, hstepB = (size_t)HALF * K * 2;
    const size_t tstepA = 2 * hstepA, tstepB = 2 * hstepB;
    const unsigned ldsw = (unsigned)wid * 1024u;
    const int aoff = lds_byte(wr * 64 + fr, fq * 8), boff = lds_byte(wc * 32 + fr, fq * 8);
#define PG8_SA(b, h) (((b) * 2 + (h)) * HTB)
#define PG8_SB(b, h) ((4 + (b) * 2 + (h)) * HTB)
#define PG8_STAGE(bufoff, gbase, voff) do { _Pragma("unroll") for (int _i = 0; _i < 2; ++_i) \
        __builtin_amdgcn_global_load_lds((const unsigned*)((const char*)(gbase) + (voff)[_i]), (PG8_LAS unsigned*)(lds + (bufoff) + ldsw + _i * 8192), 16, 0, 0); } while (0)
#define PG8_LDA(dst, b, h) do { _Pragma("unroll") for (int m = 0; m < 4; ++m) _Pragma("unroll") for (int k = 0; k < 2; ++k) dst[m][k] = *(const PG8_LAS bf16x8*)(lds + PG8_SA(b, h) + aoff + m * 2048 + k * 1024); } while (0)
#define PG8_LDB(dst, b, h) do { _Pragma("unroll") for (int n = 0; n < 2; ++n) _Pragma("unroll") for (int k = 0; k < 2; ++k) dst[n][k] = *(const PG8_LAS bf16x8*)(lds + PG8_SB(b, h) + boff + n * 2048 + k * 1024); } while (0)
#define PG8_MMA(ai, bj, At, Bt) do { __builtin_amdgcn_s_setprio(1); _Pragma("unroll") for (int m = 0; m < 4; ++m) _Pragma("unroll") for (int n = 0; n < 2; ++n) _Pragma("unroll") for (int k = 0; k < 2; ++k) \
        acc[ai][bj][m][n] = __builtin_amdgcn_mfma_f32_16x16x32_bf16(Bt[n][k], At[m][k], acc[ai][bj][m][n], 0, 0, 0); __builtin_amdgcn_s_setprio(0); } while (0)
#define PG8_WAIT_V(n) asm volatile("s_waitcnt vmcnt(" #n ")" ::: "memory")
#define PG8_WAIT_L(n) asm volatile("s_waitcnt lgkmcnt(" #n ")" ::: "memory")
#define PG8_BAR __builtin_amdgcn_s_barrier()
#define PG8_SCHED __builtin_amdgcn_sched_barrier(0)
    Unit cur, nxt; int ui = 0;
    if (!S.next(0, cur)) return;
    f32x4 acc[2][2][4][2];
#pragma unroll
    for (int a = 0; a < 2; ++a)
#pragma unroll
        for (int b = 0; b < 2; ++b)
#pragma unroll
            for (int m = 0; m < 4; ++m)
#pragma unroll
                for (int n = 0; n < 2; ++n) acc[a][b][m][n] = (f32x4){0.f, 0.f, 0.f, 0.f};
    bf16x8 At[4][2], B0[2][2], B1[2][2];
    const char* cA = (const char*)g.A + (size_t)cur.pm * tstepA; const char* cB = (const char*)g.Bt + (size_t)cur.pn * tstepB;
    PG8_STAGE(PG8_SB(0, 0), cB, voffB); PG8_STAGE(PG8_SB(0, 1), cB + hstepB, voffB); PG8_STAGE(PG8_SA(0, 0), cA, voffA); PG8_STAGE(PG8_SA(0, 1), cA + hstepA, voffA);
    if (wr == 1) PG8_BAR;
    PG8_WAIT_V(2); PG8_BAR;
    PG8_STAGE(PG8_SB(1, 0), cB + kstep, voffB); PG8_STAGE(PG8_SA(1, 0), cA + kstep, voffA); PG8_STAGE(PG8_SB(1, 1), cB + hstepB + kstep, voffB);
    PG8_WAIT_V(6); PG8_BAR;
    for (;;) {
        const bool has_next = S.next(ui + 1, nxt);
        const char* nA = has_next ? (const char*)g.A + (size_t)nxt.pm * tstepA : cA; const char* nB = has_next ? (const char*)g.Bt + (size_t)nxt.pn * tstepB : cB;
        for (int t = 0; t < nt; t += 2) {
            const bool last = (t == nt - 2);
            const char* a1 = cA + (size_t)(t + 1) * kstep;
            const char* a2 = last ? nA : cA + (size_t)(t + 2) * kstep; const char* b2 = last ? nB : cB + (size_t)(t + 2) * kstep;
            const char* a3 = a2 + kstep; const char* b3 = b2 + kstep;
            PG8_LDB(B0, 0, 0); PG8_LDB(B1, 0, 1); PG8_SCHED; PG8_LDA(At, 0, 0); PG8_STAGE(PG8_SA(1, 1), a1 + hstepA, voffA);
            PG8_WAIT_V(8); PG8_WAIT_L(0); PG8_BAR; PG8_MMA(0, 0, At, B0); PG8_MMA(0, 1, At, B1); PG8_BAR; PG8_SCHED;
            PG8_LDA(At, 0, 1); PG8_STAGE(PG8_SB(0, 0), b2, voffB); PG8_STAGE(PG8_SB(0, 1), b2 + hstepB, voffB); PG8_STAGE(PG8_SA(0, 0), a2, voffA);
            PG8_WAIT_V(8); PG8_WAIT_L(0); PG8_BAR; PG8_MMA(1, 0, At, B0); PG8_MMA(1, 1, At, B1); PG8_BAR; PG8_SCHED;
            PG8_LDB(B0, 1, 0); PG8_LDB(B1, 1, 1); PG8_SCHED; PG8_LDA(At, 1, 0); PG8_STAGE(PG8_SA(0, 1), a2 + hstepA, voffA);
            PG8_WAIT_V(8); PG8_WAIT_L(0); PG8_BAR; PG8_MMA(0, 0, At, B0); PG8_MMA(0, 1, At, B1); PG8_BAR; PG8_SCHED;
            PG8_LDA(At, 1, 1); PG8_STAGE(PG8_SB(1, 0), b3, voffB); PG8_STAGE(PG8_SB(1, 1), b3 + hstepB, voffB); PG8_STAGE(PG8_SA(1, 0), a3, voffA);
            PG8_WAIT_V(8); PG8_WAIT_L(0); PG8_BAR; PG8_MMA(1, 0, At, B0); PG8_MMA(1, 1, At, B1); PG8_BAR; PG8_SCHED;
        }
        if constexpr (ALIGN_EPI) { if (wr == 0) PG8_BAR; }
        E(acc, cur, wr, wc, fr, fq);
        if (!has_next) break;
#pragma unroll
        for (int a = 0; a < 2; ++a)
#pragma unroll
            for (int b = 0; b < 2; ++b)
#pragma unroll
                for (int m = 0; m < 4; ++m)
#pragma unroll
                    for (int n = 0; n < 2; ++n) acc[a][b][m][n] = (f32x4){0.f, 0.f, 0.f, 0.f};
        cur = nxt; cA = nA; cB = nB; ++ui;
        if constexpr (ALIGN_EPI) { if (wr == 1) PG8_BAR; }
    }
    PG8_WAIT_V(0);
    if constexpr (!ALIGN_EPI) { if (wr == 0) PG8_BAR; }
    PG8_BAR;
#undef PG8_SA
#undef PG8_SB
#undef PG8_STAGE
#undef PG8_LDA
#undef PG8_LDB
#undef PG8_MMA
#undef PG8_WAIT_V
#undef PG8_WAIT_L
#undef PG8_BAR
#undef PG8_SCHED
}
}
constexpr int LDS_BYTES = 148480;
namespace dattn {
#define DA_LAS __attribute__((address_space(3)))
typedef short bf16x8 __attribute__((ext_vector_type(8)));
typedef short s16x4 __attribute__((ext_vector_type(4)));
typedef float f32x16 __attribute__((ext_vector_type(16)));
constexpr int KP = 272, VP = 320, KBUF = 64 * KP, VBUF = 64 * VP, BUF = KBUF + VBUF, XOFF = 2 * BUF, LDS_NEED = XOFF + 65536;
static_assert(LDS_NEED <= 147456, "attention LDS");
__device__ __forceinline__ unsigned cvtpk(float lo, float hi) { typedef float f2 __attribute__((ext_vector_type(2))); typedef __bf16 b2 __attribute__((ext_vector_type(2))); f2 v = {lo, hi}; b2 b = __builtin_convertvector(v, b2); return __builtin_bit_cast(unsigned, b); }
__device__ __forceinline__ s16x4 vtr(const DA_LAS unsigned char* p) { typedef short v4i16_t __attribute__((ext_vector_type(4))); return __builtin_bit_cast(s16x4, __builtin_amdgcn_ds_read_tr16_b64_v4i16((DA_LAS v4i16_t*)p)); }
template <bool STORE = true> __device__ __forceinline__ void unit(DA_LAS unsigned char* lds, bf16_t* Hb, int h, int qb, const float* __restrict__ subln_w, float lam) {
    const int tid = opaque_tid(), lane = tid & 63, w = __builtin_amdgcn_readfirstlane(tid >> 6), mp = w >> 2, rb = w & 3, c32 = lane & 31, hh = lane >> 5;
    const int qrow = 128 * qb + 32 * rb + c32;
    bf16x8 qf[4];
    { const bf16_t* qp = Hb + (size_t)qrow * HP_ + HC_Q + h * 128 + 64 * mp + 8 * hh;
#pragma unroll
      for (int s = 0; s < 4; ++s) qf[s] = *(const bf16x8*)(qp + 16 * s); }
    const int srow = tid >> 4, sch = tid & 15;
    const bf16_t* kg = Hb + HC_K + h * 128 + sch * 8; const bf16_t* vg = Hb + HC_V + h * 128 + sch * 8;
    const int nt = 2 * qb + 2;
    u32x4 kr[2], vr[2];
#define DA_LOAD(t) do { _Pragma("unroll") for (int j = 0; j < 2; ++j) { const size_t ro = (size_t)(64 * (t) + srow + 32 * j) * HP_; kr[j] = *(const u32x4*)(kg + ro); vr[j] = *(const u32x4*)(vg + ro); } } while (0)
#define DA_WRITE(buf) do { _Pragma("unroll") for (int j = 0; j < 2; ++j) { *(DA_LAS u32x4*)(lds + (buf) * BUF + (srow + 32 * j) * KP + sch * 16) = kr[j]; *(DA_LAS u32x4*)(lds + (buf) * BUF + KBUF + (srow + 32 * j) * VP + sch * 16) = vr[j]; } } while (0)
    DA_LOAD(0); DA_WRITE(0);
    __syncthreads();
    f32x16 oT[4];
#pragma unroll
    for (int i = 0; i < 4; ++i) oT[i] = (f32x16){0.f, 0.f, 0.f, 0.f, 0.f, 0.f, 0.f, 0.f, 0.f, 0.f, 0.f, 0.f, 0.f, 0.f, 0.f, 0.f};
    float mrow = -INFINITY, lrow = 0.f;
    const int koff = c32 * KP + (64 * mp + 8 * hh) * 2;
    const int voff = KBUF + (4 * hh + ((lane & 15) >> 2)) * VP + (16 * ((lane >> 4) & 1) + 4 * (lane & 3)) * 2;
    for (int t = 0; t < nt; ++t) {
        const int cur = t & 1;
        if (t + 1 < nt) DA_LOAD(t + 1);
        if (!(t == nt - 1 && rb <= 1)) {
            const DA_LAS unsigned char* kb = lds + cur * BUF + koff;
            f32x16 s0 = (f32x16){0.f, 0.f, 0.f, 0.f, 0.f, 0.f, 0.f, 0.f, 0.f, 0.f, 0.f, 0.f, 0.f, 0.f, 0.f, 0.f}, s1 = s0;
            bf16x8 kf0[4], kf1[4];
#pragma unroll
            for (int s = 0; s < 4; ++s) { kf0[s] = *(const DA_LAS bf16x8*)(kb + s * 32); kf1[s] = *(const DA_LAS bf16x8*)(kb + 32 * KP + s * 32); }
            __builtin_amdgcn_s_setprio(1);
#pragma unroll
            for (int s = 0; s < 4; ++s) {
                s0 = __builtin_amdgcn_mfma_f32_32x32x16_bf16(kf0[s], qf[s], s0, 0, 0, 0);
                s1 = __builtin_amdgcn_mfma_f32_32x32x16_bf16(kf1[s], qf[s], s1, 0, 0, 0);
            }
            __builtin_amdgcn_s_setprio(0);
            if (t >= nt - 2) {
                const int k0 = 64 * t + 4 * hh;
#pragma unroll
                for (int r = 0; r < 16; ++r) { const int key = k0 + (r & 3) + 8 * (r >> 2); if (key > qrow) s0[r] = -INFINITY; if (key + 32 > qrow) s1[r] = -INFINITY; }
            }
            float mx = fmaxf(s0[0], s1[0]);
#pragma unroll
            for (int r = 1; r < 16; ++r) mx = fmaxf(mx, fmaxf(s0[r], s1[r]));
            mx = fmaxf(mx, __shfl_xor(mx, 32));
            if (__any(mx > mrow + 8.f)) {
                const float mnew = fmaxf(mrow, mx), alpha = __builtin_amdgcn_exp2f(mrow - mnew);
                mrow = mnew; lrow *= alpha;
#pragma unroll
                for (int i = 0; i < 4; ++i)
#pragma unroll
                    for (int r = 0; r < 16; ++r) oT[i][r] *= alpha;
            }
            float ps = 0.f;
#pragma unroll
            for (int r = 0; r < 16; ++r) { s0[r] = __builtin_amdgcn_exp2f(s0[r] - mrow); s1[r] = __builtin_amdgcn_exp2f(s1[r] - mrow); ps += s0[r] + s1[r]; }
            lrow += ps;
            bf16x8 pf[2][2];
#pragma unroll
            for (int s = 0; s < 2; ++s) {
                u32x4 a, b;
                a.x = cvtpk(s0[8 * s], s0[8 * s + 1]); a.y = cvtpk(s0[8 * s + 2], s0[8 * s + 3]); a.z = cvtpk(s0[8 * s + 4], s0[8 * s + 5]); a.w = cvtpk(s0[8 * s + 6], s0[8 * s + 7]);
                b.x = cvtpk(s1[8 * s], s1[8 * s + 1]); b.y = cvtpk(s1[8 * s + 2], s1[8 * s + 3]); b.z = cvtpk(s1[8 * s + 4], s1[8 * s + 5]); b.w = cvtpk(s1[8 * s + 6], s1[8 * s + 7]);
                pf[0][s] = __builtin_bit_cast(bf16x8, a); pf[1][s] = __builtin_bit_cast(bf16x8, b);
            }
            const DA_LAS unsigned char* vb = lds + cur * BUF + voff;
#define DA_LDV(dst, db) do { _Pragma("unroll") for (int i_ = 0; i_ < 4; ++i_) { const s16x4 lo_ = vtr(vb + (16 * i_) * VP + (db) * 64), hi_ = vtr(vb + (16 * i_ + 8) * VP + (db) * 64); \
                dst[i_] = (bf16x8){lo_[0], lo_[1], lo_[2], lo_[3], hi_[0], hi_[1], hi_[2], hi_[3]}; } } while (0)
#define DA_MM(src, db) do { _Pragma("unroll") for (int i_ = 0; i_ < 4; ++i_) oT[db] = __builtin_amdgcn_mfma_f32_32x32x16_bf16(src[i_], pf[i_ >> 1][i_ & 1], oT[db], 0, 0, 0); } while (0)
            bf16x8 va[4], vq[4];
            DA_LDV(va, 0);
            DA_LDV(vq, 1); __builtin_amdgcn_s_setprio(1); DA_MM(va, 0); __builtin_amdgcn_s_setprio(0);
            DA_LDV(va, 2); __builtin_amdgcn_s_setprio(1); DA_MM(vq, 1); __builtin_amdgcn_s_setprio(0);
            DA_LDV(vq, 3); __builtin_amdgcn_s_setprio(1); DA_MM(va, 2); __builtin_amdgcn_s_setprio(0);
            __builtin_amdgcn_s_setprio(1); DA_MM(vq, 3);
#undef DA_LDV
#undef DA_MM
            __builtin_amdgcn_s_setprio(0);
        }
        if (t + 1 < nt) DA_WRITE(cur ^ 1);
        __syncthreads();
    }
#undef DA_LOAD
#undef DA_WRITE
    const float inv = 1.f / (lrow + __shfl_xor(lrow, 32));
    DA_LAS float* X = (DA_LAS float*)(lds + XOFF) + rb * 4096 + lane;
    if (mp == 1) {
#pragma unroll
        for (int i = 0; i < 4; ++i)
#pragma unroll
            for (int r = 0; r < 16; ++r) X[(i * 16 + r) * 64] = oT[i][r] * inv;
    }
    __syncthreads();
    if (mp == 0) {
        float ss = 0.f;
#pragma unroll
        for (int i = 0; i < 4; ++i)
#pragma unroll
            for (int r = 0; r < 16; ++r) { const float o = oT[i][r] * inv - lam * X[(i * 16 + r) * 64]; oT[i][r] = o; ss += o * o; }
        ss += __shfl_xor(ss, 32);
        const float rr = rsqrtf(ss * (1.f / 128.f) + 1e-5f) * (1.f - LAMBDA_INIT);
        bf16_t* op = Hb + (size_t)qrow * HP_ + HC_Q + h * 128 + 4 * hh;
#pragma unroll
        for (int i = 0; i < 4; ++i)
#pragma unroll
            for (int g = 0; g < 4; ++g) { const int d0 = 32 * i + 8 * g; const f32x4 sw = *(const f32x4*)(subln_w + d0 + 4 * hh);
                uint2 o; o.x = pk2(oT[i][4 * g] * rr * sw.x, oT[i][4 * g + 1] * rr * sw.y); o.y = pk2(oT[i][4 * g + 2] * rr * sw.z, oT[i][4 * g + 3] * rr * sw.w);
                if (STORE || o.x == 0x12345u) *(uint2*)(op + d0) = o; }
    }
    __syncthreads();
}
}
namespace ssd {
#define SS_LAS __attribute__((address_space(3)))
typedef short bf16x8 __attribute__((ext_vector_type(8)));
typedef short s16x4 __attribute__((ext_vector_type(4)));
typedef float f32x16 __attribute__((ext_vector_type(16)));
constexpr int XP = 192;
constexpr int BPT = 320;
constexpr int CP = 272;
__device__ __forceinline__ s16x4 vtr(const SS_LAS unsigned char* p) { typedef short v4i16_t __attribute__((ext_vector_type(4))); return __builtin_bit_cast(s16x4, __builtin_amdgcn_ds_read_tr16_b64_v4i16((SS_LAS v4i16_t*)p)); }
__device__ __forceinline__ unsigned cvtpk(float lo, float hi) { typedef float f2 __attribute__((ext_vector_type(2))); typedef __bf16 b2 __attribute__((ext_vector_type(2))); f2 v = {lo, hi}; b2 b = __builtin_convertvector(v, b2); return __builtin_bit_cast(unsigned, b); }
__device__ __forceinline__ void acs_tables(SS_LAS float* ACS, SS_LAS float* DTS, const float* __restrict__ DTb, const float* __restrict__ a_log, int c, int g) {
    const int tid_ = opaque_tid(); const int lane = tid_ & 63, e = __builtin_amdgcn_readfirstlane(tid_ >> 6), h = 8 * g + e;
    const float a = -expf(a_log[h]);
    const float d0 = DTb[(size_t)(128 * c + 2 * lane) * 32 + h], d1 = DTb[(size_t)(128 * c + 2 * lane + 1) * 32 + h];
    const float a0 = d0 * a, a1 = d1 * a;
    float sc = a0 + a1;
#pragma unroll
    for (int o = 1; o < 64; o <<= 1) { const float v = __shfl_up(sc, o); if (lane >= o) sc += v; }
    const float ex = sc - (a0 + a1);
    ACS[(2 * lane) * 8 + e] = ex + a0; ACS[(2 * lane + 1) * 8 + e] = ex + a0 + a1;
    DTS[(2 * lane) * 8 + e] = d0; DTS[(2 * lane + 1) * 8 + e] = d1;
}
template <class F> __device__ __forceinline__ void conv_item(const bf16_t* __restrict__ Hb, int t0, int l0, int xch0, const float* __restrict__ conv_w, const float* __restrict__ conv_b, F sink) {
    float w[4][8], bias[8];
#pragma unroll
    for (int j = 0; j < 4; ++j) { const f32x4 a = *(const f32x4*)(conv_w + j * DXBC + xch0), b = *(const f32x4*)(conv_w + j * DXBC + xch0 + 4); w[j][0] = a.x; w[j][1] = a.y; w[j][2] = a.z; w[j][3] = a.w; w[j][4] = b.x; w[j][5] = b.y; w[j][6] = b.z; w[j][7] = b.w; }
    { const f32x4 a = *(const f32x4*)(conv_b + xch0), b = *(const f32x4*)(conv_b + xch0 + 4); bias[0] = a.x; bias[1] = a.y; bias[2] = a.z; bias[3] = a.w; bias[4] = b.x; bias[5] = b.y; bias[6] = b.z; bias[7] = b.w; }
    const bf16_t* src = Hb + HC_XBC + xch0;
    u32x4 rw[11];
#pragma unroll
    for (int i = 0; i < 11; ++i) { const int tt = t0 + l0 - 3 + i; rw[i] = *(const u32x4*)(src + (size_t)(tt < 0 ? 0 : tt) * HP_); }
    if (t0 + l0 < 3) {
#pragma unroll
        for (int i = 0; i < 3; ++i) if (t0 + l0 - 3 + i < 0) rw[i] = (u32x4){0u, 0u, 0u, 0u};
    }
#define SS_UNP(dst, q_) do { dst[0] = bflo(q_.x); dst[1] = bfhi(q_.x); dst[2] = bflo(q_.y); dst[3] = bfhi(q_.y); dst[4] = bflo(q_.z); dst[5] = bfhi(q_.z); dst[6] = bflo(q_.w); dst[7] = bfhi(q_.w); } while (0)
    float x0[8], x1[8], x2[8];
    SS_UNP(x0, rw[0]); SS_UNP(x1, rw[1]); SS_UNP(x2, rw[2]);
#pragma unroll
    for (int i = 0; i < 8; ++i) {
        float x3[8]; SS_UNP(x3, rw[3 + i]);
        float v[8];
#pragma unroll
        for (int k = 0; k < 8; ++k) { const float a = bias[k] + w[0][k] * x0[k] + w[1][k] * x1[k] + w[2][k] * x2[k] + w[3][k] * x3[k]; v[k] = a * __builtin_amdgcn_rcpf(1.f + __expf(-a)); x0[k] = x1[k]; x1[k] = x2[k]; x2[k] = x3[k]; }
        sink(l0 + i, v);
    }
#undef SS_UNP
}
constexpr int A_BS = 0, A_XD = 128 * BPT  , A_ACS = A_XD + 2 * 128 * XP  , A_DTS = A_ACS + 4096, A_END = A_DTS + 4096;
__device__ __forceinline__ void phaseA_unit(SS_LAS unsigned char* lds, const bf16_t* __restrict__ Hb, const float* __restrict__ DTb, const float* __restrict__ conv_w, const float* __restrict__ conv_b,
                                            const float* __restrict__ a_log, bf16_t* __restrict__ ST, float* __restrict__ CD, int c, int g) {
    const int tid = opaque_tid(), lane = tid & 63, w = __builtin_amdgcn_readfirstlane(tid >> 6), c32 = lane & 31, hh = lane >> 5;
    SS_LAS float* ACS = (SS_LAS float*)(lds + A_ACS); SS_LAS float* DTS = (SS_LAS float*)(lds + A_DTS);
    acs_tables(ACS, DTS, DTb, a_log, c, g);
    __syncthreads();
    if (tid < 8) CD[c * 32 + 8 * g + tid] = __expf(ACS[127 * 8 + tid]);
    auto stageX = [&](int e, int item, int buf) {
        const int cg = item >> 4, seg = item & 15; const float aend = ACS[127 * 8 + e];
        conv_item(Hb, 128 * c, 8 * seg, g * 512 + e * 64 + cg * 8, conv_w, conv_b, [&](int l, const float (&v)[8]) {
            const float sc = DTS[l * 8 + e] * __expf(aend - ACS[l * 8 + e]);
            u32x4 o; o.x = cvtpk(v[0] * sc, v[1] * sc); o.y = cvtpk(v[2] * sc, v[3] * sc); o.z = cvtpk(v[4] * sc, v[5] * sc); o.w = cvtpk(v[6] * sc, v[7] * sc);
            *(SS_LAS u32x4*)(lds + A_XD + buf * 128 * XP + l * XP + cg * 16) = o; });
    };
    if (tid < 256) { const int cg = tid >> 4, seg = tid & 15;
        conv_item(Hb, 128 * c, 8 * seg, 2048 + g * 128 + cg * 8, conv_w, conv_b, [&](int l, const float (&v)[8]) {
            u32x4 o; o.x = cvtpk(v[0], v[1]); o.y = cvtpk(v[2], v[3]); o.z = cvtpk(v[4], v[5]); o.w = cvtpk(v[6], v[7]);
            *(SS_LAS u32x4*)(lds + A_BS + l * BPT + cg * 16) = o; });
    } else if (tid < 384) stageX(0, tid - 256, 0);
    __syncthreads();
    const int pb = w & 1, nb = w >> 1;
    const int rsel = ((lane & 15) >> 2), csel = 16 * ((lane >> 4) & 1) + 4 * (lane & 3);
    for (int e = 0; e < 8; ++e) {
        if (e + 1 < 8 && tid >= 384) stageX(e + 1, tid - 384, (e + 1) & 1);
        f32x16 acc = (f32x16){0.f, 0.f, 0.f, 0.f, 0.f, 0.f, 0.f, 0.f, 0.f, 0.f, 0.f, 0.f, 0.f, 0.f, 0.f, 0.f};
        const SS_LAS unsigned char* bp = lds + A_BS + (8 * hh + rsel) * BPT + (32 * nb + csel) * 2;
        const SS_LAS unsigned char* xp = lds + A_XD + (e & 1) * 128 * XP + (8 * hh + rsel) * XP + (32 * pb + csel) * 2;
#pragma unroll
        for (int ks = 0; ks < 8; ++ks) {
            const s16x4 b0 = vtr(bp + (16 * ks) * BPT), b1 = vtr(bp + (16 * ks + 4) * BPT), x0 = vtr(xp + (16 * ks) * XP), x1 = vtr(xp + (16 * ks + 4) * XP);
            const bf16x8 bf = (bf16x8){b0[0], b0[1], b0[2], b0[3], b1[0], b1[1], b1[2], b1[3]}, xf = (bf16x8){x0[0], x0[1], x0[2], x0[3], x1[0], x1[1], x1[2], x1[3]};
            acc = __builtin_amdgcn_mfma_f32_32x32x16_bf16(bf, xf, acc, 0, 0, 0);
        }
        bf16_t* sp = ST + ((size_t)(c * 32 + 8 * g + e) * 64 + 32 * pb + c32) * 128 + 32 * nb + 4 * hh;
#pragma unroll
        for (int q = 0; q < 4; ++q) { uint2 o; o.x = cvtpk(acc[4 * q], acc[4 * q + 1]); o.y = cvtpk(acc[4 * q + 2], acc[4 * q + 3]); *(uint2*)(sp + 8 * q) = o; }
        __syncthreads();
    }
}
__device__ __forceinline__ void scan_phase(bf16_t* __restrict__ ST, const float* __restrict__ CD, int gtid) {
    const int h = gtid >> 12;
    unsigned* p = (unsigned*)ST + gtid;
    float r0 = 0.f, r1 = 0.f;
    for (int c0 = 0; c0 < 64; c0 += 16) {
        unsigned v[16]; float d[16];
#pragma unroll
        for (int i = 0; i < 16; ++i) { v[i] = p[(size_t)(c0 + i) * 131072]; d[i] = CD[(c0 + i) * 32 + h]; }
#pragma unroll
        for (int i = 0; i < 16; ++i) { p[(size_t)(c0 + i) * 131072] = cvtpk(r0, r1); r0 = r0 * d[i] + bflo(v[i]); r1 = r1 * d[i] + bfhi(v[i]); }
    }
}
constexpr int C_CS = 0, C_BS = 128 * CP  , C_X1 = C_BS  , C_CBT = 2 * 128 * CP  , C_X0 = C_CBT + 32768  , C_ACS = C_X0 + 128 * XP  , C_DTS = C_ACS + 4096,
              C_SSQ = C_DTS + 4096, C_END = C_SSQ + 1024;
static_assert(C_END <= 147456 && 128 * XP <= 128 * CP, "ssd phase C LDS");
template <bool STORE = true> __device__ __forceinline__ void phaseC_unit(SS_LAS unsigned char* lds, bf16_t* __restrict__ Hb, const float* __restrict__ DTb, const float* __restrict__ conv_w, const float* __restrict__ conv_b,
                                            const float* __restrict__ a_log, const float* __restrict__ d_skip, const float* __restrict__ norm_w, const bf16_t* __restrict__ ST, int c, int g) {
    const int tid = opaque_tid(), lane = tid & 63, w = __builtin_amdgcn_readfirstlane(tid >> 6), c32 = lane & 31, hh = lane >> 5;
    SS_LAS float* ACS = (SS_LAS float*)(lds + C_ACS); SS_LAS float* DTS = (SS_LAS float*)(lds + C_DTS); SS_LAS float* SSQ = (SS_LAS float*)(lds + C_SSQ);
    acs_tables(ACS, DTS, DTb, a_log, c, g);
    auto stageX = [&](int e, int item, int buf) {
        const int cg = item >> 4, seg = item & 15;
        conv_item(Hb, 128 * c, 8 * seg, g * 512 + e * 64 + cg * 8, conv_w, conv_b, [&](int l, const float (&v)[8]) {
            u32x4 o; o.x = cvtpk(v[0], v[1]); o.y = cvtpk(v[2], v[3]); o.z = cvtpk(v[4], v[5]); o.w = cvtpk(v[6], v[7]);
            *(SS_LAS u32x4*)(lds + (buf ? C_X1 : C_X0) + l * XP + cg * 16) = o; });
    };
    { const int isC = tid >> 8, it = tid & 255, cg = it >> 4, seg = it & 15;
        conv_item(Hb, 128 * c, 8 * seg, 2048 + isC * 512 + g * 128 + cg * 8, conv_w, conv_b, [&](int l, const float (&v)[8]) {
            u32x4 o; o.x = cvtpk(v[0], v[1]); o.y = cvtpk(v[2], v[3]); o.z = cvtpk(v[4], v[5]); o.w = cvtpk(v[6], v[7]);
            *(SS_LAS u32x4*)(lds + (isC ? C_CS : C_BS) + l * CP + cg * 16) = o; }); }
    if (tid < 128) stageX(0, tid, 0);
    __syncthreads();
    for (int i = w; i < 10; i += 8) {
        const int sb = (i < 4) ? 0 : (i < 7) ? 1 : (i < 9) ? 2 : 3, lb = (i < 4) ? i : (i < 7) ? i - 3 : (i < 9) ? i - 5 : 3;
        f32x16 acc = (f32x16){0.f, 0.f, 0.f, 0.f, 0.f, 0.f, 0.f, 0.f, 0.f, 0.f, 0.f, 0.f, 0.f, 0.f, 0.f, 0.f};
        const SS_LAS unsigned char* bp = lds + C_BS + (32 * sb + c32) * CP + 16 * hh, *cp = lds + C_CS + (32 * lb + c32) * CP + 16 * hh;
#pragma unroll
        for (int ks = 0; ks < 8; ++ks) acc = __builtin_amdgcn_mfma_f32_32x32x16_bf16(*(const SS_LAS bf16x8*)(bp + 32 * ks), *(const SS_LAS bf16x8*)(cp + 32 * ks), acc, 0, 0, 0);
        SS_LAS unsigned* o = (SS_LAS unsigned*)(lds + C_CBT) + (sb * 4 + lb) * 512 + lane;
#pragma unroll
        for (int q = 0; q < 8; ++q) o[q * 64] = cvtpk(acc[2 * q], acc[2 * q + 1]);
    }
    __syncthreads();
    const int pb = w & 1, lb = w >> 1, lrow = 32 * lb + c32;
    const int rsel = ((lane & 15) >> 2), csel = 16 * ((lane >> 4) & 1) + 4 * (lane & 3);
    unsigned ypk[8][8];
    float ssq = 0.f;
    for (int e = 0; e < 8; ++e) {
        const int h = 8 * g + e;
        if (e + 1 < 8 && tid >= 384) stageX(e + 1, tid - 384, (e + 1) & 1);
        const int xoff = (e & 1) ? C_X1 : C_X0;
        f32x16 acc = (f32x16){0.f, 0.f, 0.f, 0.f, 0.f, 0.f, 0.f, 0.f, 0.f, 0.f, 0.f, 0.f, 0.f, 0.f, 0.f, 0.f};
        {
            const bf16_t* pp = ST + ((size_t)(c * 32 + h) * 64 + 32 * pb + c32) * 128 + 8 * hh;
            const SS_LAS unsigned char* cp = lds + C_CS + lrow * CP + 16 * hh;
#pragma unroll
            for (int ks = 0; ks < 8; ++ks) acc = __builtin_amdgcn_mfma_f32_32x32x16_bf16(*(const bf16x8*)(pp + 16 * ks), *(const SS_LAS bf16x8*)(cp + 32 * ks), acc, 0, 0, 0);
        }
        const float al = ACS[lrow * 8 + e], eal = __expf(al);
#pragma unroll
        for (int r = 0; r < 16; ++r) acc[r] *= eal;
        for (int sb = 0; sb <= lb; ++sb) {
            const SS_LAS unsigned* cbp = (const SS_LAS unsigned*)(lds + C_CBT) + (sb * 4 + lb) * 512 + lane;
            float m[16];
#pragma unroll
            for (int q = 0; q < 8; ++q) { const unsigned u = cbp[q * 64]; m[2 * q] = bflo(u); m[2 * q + 1] = bfhi(u); }
#pragma unroll
            for (int r = 0; r < 16; ++r) { const int srow = 32 * sb + (r & 3) + 8 * (r >> 2) + 4 * hh;
                const float f = __expf(al - ACS[srow * 8 + e]) * DTS[srow * 8 + e];
                m[r] = (srow <= lrow) ? m[r] * f : 0.f; }
            const SS_LAS unsigned char* xp = lds + xoff + (32 * sb + 4 * hh + rsel) * XP + (32 * pb + csel) * 2;
#pragma unroll
            for (int ks = 0; ks < 2; ++ks) {
                const s16x4 x0 = vtr(xp + (16 * ks) * XP), x1 = vtr(xp + (16 * ks + 8) * XP);
                const bf16x8 xf = (bf16x8){x0[0], x0[1], x0[2], x0[3], x1[0], x1[1], x1[2], x1[3]};
                u32x4 mm; mm.x = cvtpk(m[8 * ks], m[8 * ks + 1]); mm.y = cvtpk(m[8 * ks + 2], m[8 * ks + 3]); mm.z = cvtpk(m[8 * ks + 4], m[8 * ks + 5]); mm.w = cvtpk(m[8 * ks + 6], m[8 * ks + 7]);
                acc = __builtin_amdgcn_mfma_f32_32x32x16_bf16(xf, __builtin_bit_cast(bf16x8, mm), acc, 0, 0, 0);
            }
        }
        const float dsk = d_skip[h];
        const bf16_t* zp = Hb + (size_t)(128 * c + lrow) * HP_ + HC_Z + g * 512 + e * 64 + 32 * pb + 4 * hh;
        const SS_LAS unsigned char* xr = lds + xoff + lrow * XP + (32 * pb + 4 * hh) * 2;
        unsigned yt[8];
#pragma unroll
        for (int q = 0; q < 4; ++q) {
            const u32x2 zz = *(const u32x2*)(zp + 8 * q); const u32x2 xx = *(const SS_LAS u32x2*)(xr + 16 * q);
            const float zv[4] = {bflo(zz.x), bfhi(zz.x), bflo(zz.y), bfhi(zz.y)}, xv[4] = {bflo(xx.x), bfhi(xx.x), bflo(xx.y), bfhi(xx.y)};
            float y[4];
#pragma unroll
            for (int k = 0; k < 4; ++k) { y[k] = (acc[4 * q + k] + dsk * xv[k]) * (zv[k] * __builtin_amdgcn_rcpf(1.f + __expf(-zv[k]))); ssq += y[k] * y[k]; }
            yt[2 * q] = cvtpk(y[0], y[1]); yt[2 * q + 1] = cvtpk(y[2], y[3]);
        }
#define SS_YSET(E) case E: { _Pragma("unroll") for (int q_ = 0; q_ < 8; ++q_) ypk[E][q_] = yt[q_]; } break;
        switch (e) { SS_YSET(0) SS_YSET(1) SS_YSET(2) SS_YSET(3) SS_YSET(4) SS_YSET(5) SS_YSET(6) default: { _Pragma("unroll") for (int q_ = 0; q_ < 8; ++q_) ypk[7][q_] = yt[q_]; } break; }
#undef SS_YSET
        __syncthreads();
    }
    ssq += __shfl_xor(ssq, 32);
    if (hh == 0) SSQ[pb * 128 + lrow] = ssq;
    __syncthreads();
    const float rstd = rsqrtf((SSQ[lrow] + SSQ[128 + lrow]) * (1.f / 512.f) + 1e-5f);
    bf16_t* op = Hb + (size_t)(128 * c + lrow) * HP_ + HC_Z + g * 512 + 32 * pb + 4 * hh;
    const float* nw = norm_w + g * 512 + 32 * pb + 4 * hh;
#pragma unroll
    for (int e = 0; e < 8; ++e)
#pragma unroll
        for (int q = 0; q < 4; ++q) { const f32x4 n4 = *(const f32x4*)(nw + e * 64 + 8 * q);
            uint2 o; o.x = cvtpk(bflo(ypk[e][2 * q]) * rstd * n4.x, bfhi(ypk[e][2 * q]) * rstd * n4.y); o.y = cvtpk(bflo(ypk[e][2 * q + 1]) * rstd * n4.z, bfhi(ypk[e][2 * q + 1]) * rstd * n4.w);
            if (STORE || o.x == 0x12345u) *(uint2*)(op + e * 64 + 8 * q) = o; }
    __syncthreads();
}
}


namespace psel {
#define PS_LAS __attribute__((address_space(3)))
typedef short bf16x8 __attribute__((ext_vector_type(8)));
typedef float f32x16 __attribute__((ext_vector_type(16)));
__device__ __forceinline__ int ord(float f) { const int b = __builtin_bit_cast(int, f); return b ^ ((b >> 31) & 0x7fffffff); }
__device__ __forceinline__ float unord(int t) { return __builtin_bit_cast(float, t ^ ((t >> 31) & 0x7fffffff)); }
#define PS_INS(top, v) do { int v_ = (v); _Pragma("unroll") for (int i_ = 0; i_ < 16; ++i_) { const int hi_ = max(top[i_], v_); v_ = min(top[i_], v_); top[i_] = hi_; } } while (0)
__device__ __forceinline__ void step(PS_LAS int* EX, const bf16_t* __restrict__ QP, const bf16_t* __restrict__ SUBK, int* __restrict__ IDX, float* __restrict__ GATE, int tok0, int hp) {
    const int tid = opaque_tid(), lane = tid & 63, w1 = __builtin_amdgcn_readfirstlane(tid >> 6), c32 = lane & 31, hh = lane >> 5;
    {
        const int tile = w1 >> 2, hsel = (w1 >> 1) & 1, half = w1 & 1, h = 2 * hp + hsel;
        const bf16_t* qp = QP + (size_t)(tok0 + 32 * tile + c32) * 2048 + h * 256 + half * 128 + 8 * hh;
        const bf16_t* kp = SUBK + ((size_t)(h * 2 + half) * 128 + c32) * 128 + 8 * hh;
        bf16x8 qf[8];
#pragma unroll
        for (int ks = 0; ks < 8; ++ks) qf[ks] = *(const bf16x8*)(qp + 16 * ks);
        int top[16];
#pragma unroll
        for (int i = 0; i < 16; ++i) top[i] = (int)0x80000000;
        bf16x8 kfa[8], kfb[8];
#define PS_LDK(dst, mt_) do { _Pragma("unroll") for (int ks_ = 0; ks_ < 8; ++ks_) dst[ks_] = *(const bf16x8*)(kp + (size_t)(32 * (mt_)) * 128 + 16 * ks_); } while (0)
#define PS_TILE(src, mt_) do { f32x16 acc_ = (f32x16){0.f, 0.f, 0.f, 0.f, 0.f, 0.f, 0.f, 0.f, 0.f, 0.f, 0.f, 0.f, 0.f, 0.f, 0.f, 0.f}; \
            _Pragma("unroll") for (int ks_ = 0; ks_ < 8; ++ks_) acc_ = __builtin_amdgcn_mfma_f32_32x32x16_bf16(src[ks_], qf[ks_], acc_, 0, 0, 0); \
            _Pragma("unroll") for (int r_ = 0; r_ < 16; ++r_) { const int key_ = 32 * (mt_) + (r_ & 3) + 8 * (r_ >> 2) + 4 * hh; const int v__ = (ord(acc_[r_]) & ~127) | (127 - key_); PS_INS(top, v__); } } while (0)
        PS_LDK(kfa, 0);
        PS_LDK(kfb, 1); PS_TILE(kfa, 0);
        PS_LDK(kfa, 2); PS_TILE(kfb, 1);
        PS_LDK(kfb, 3); PS_TILE(kfa, 2);
        PS_TILE(kfb, 3);
#undef PS_LDK
#undef PS_TILE
        int oth[16];
#pragma unroll
        for (int i = 0; i < 16; ++i) oth[i] = __shfl_xor(top[i], 32);
#pragma unroll
        for (int i = 0; i < 16; ++i) PS_INS(top, oth[i]);
        if (hh == 0) {
#pragma unroll
            for (int i = 0; i < 16; ++i) EX[(w1 * 16 + i) * 32 + c32] = top[i];
        }
    }
    __syncthreads();
    if (lane < 16) {
        const int task = w1 * 16 + lane, th = task >> 5, tok32 = task & 31, tile = th >> 1, hsel = th & 1, h = 2 * hp + hsel;
        const PS_LAS int* ea = EX + ((th * 2 + 0) * 16) * 32 + tok32; const PS_LAS int* eb = EX + ((th * 2 + 1) * 16) * 32 + tok32;
        float as[16], bs[16];
#pragma unroll
        for (int i = 0; i < 16; ++i) { as[i] = unord(ea[i * 32] & ~127); bs[i] = unord(eb[i * 32] & ~127); }
        int top[16];
#pragma unroll
        for (int i = 0; i < 16; ++i) top[i] = (int)0x80000000;
#pragma unroll
        for (int i = 0; i < 16; ++i)
#pragma unroll
            for (int j = 0; j < 16; ++j) if ((i + 1) * (j + 1) <= 16) { const int v = (ord(as[i] + bs[j]) & ~255) | (255 - (i * 16 + j)); PS_INS(top, v); }
        float sc[16]; int id[16];
#pragma unroll
        for (int r = 0; r < 16; ++r) { const int cn = 255 - (top[r] & 255), i = cn >> 4, j = cn & 15; const int pa = ea[i * 32], pb = eb[j * 32];
            sc[r] = unord(pa & ~127) + unord(pb & ~127); id[r] = (127 - (pa & 127)) * 128 + (127 - (pb & 127)); }
        float sum = 0.f; const float mx = sc[0];
#pragma unroll
        for (int r = 0; r < 16; ++r) { sc[r] = __expf(sc[r] - mx); sum += sc[r]; }
        const size_t o = (size_t)(tok0 + 32 * tile + tok32) * 128 + h * 16;
        const float inv = 1.f / sum;
#pragma unroll
        for (int r = 0; r < 16; r += 4) { *(f32x4*)(GATE + o + r) = (f32x4){sc[r] * inv, sc[r + 1] * inv, sc[r + 2] * inv, sc[r + 3] * inv}; *(u32x4*)(IDX + o + r) = (u32x4){(unsigned)id[r], (unsigned)id[r + 1], (unsigned)id[r + 2], (unsigned)id[r + 3]}; }
    }
    __syncthreads();
}
}


namespace xattn {
#define XA_LAS __attribute__((address_space(3)))
typedef short bf16x8 __attribute__((ext_vector_type(8)));
typedef short s16x4 __attribute__((ext_vector_type(4)));
typedef float f32x16 __attribute__((ext_vector_type(16)));
constexpr int RP = 528;
__device__ __forceinline__ unsigned cvtpk(float lo, float hi) { typedef float f2 __attribute__((ext_vector_type(2))); typedef __bf16 b2 __attribute__((ext_vector_type(2))); f2 v = {lo, hi}; b2 b = __builtin_convertvector(v, b2); return __builtin_bit_cast(unsigned, b); }
__device__ __forceinline__ void stage(XA_LAS unsigned char* lds, const bf16_t* __restrict__ src, int pitch, int tid) {
#pragma unroll 4
    for (int i = 0; i < 16; ++i) { const int q = tid + 512 * i, row = q >> 5, ch = q & 31; *(XA_LAS u32x4*)(lds + row * RP + ch * 16) = *(const u32x4*)(src + (size_t)row * pitch + ch * 8); }
}
__device__ __forceinline__ void unit(XA_LAS unsigned char* lds, const bf16_t* __restrict__ QC, const bf16_t* __restrict__ KC, const bf16_t* __restrict__ VcT, bf16_t* __restrict__ XO, int tg, int h) {
    const int tid = opaque_tid(), lane = tid & 63, w = __builtin_amdgcn_readfirstlane(tid >> 6), c32 = lane & 31, hh = lane >> 5, b = tg >> 5;
    const int tok = 256 * tg + 32 * w + c32;
    stage(lds, KC + (size_t)b * MEML * D + h * 256, D, tid);
    bf16x8 pf[8][2]; float inv;
    {
        bf16x8 qf[16];
        const bf16_t* qp = QC + (size_t)tok * D + h * 256 + 8 * hh;
#pragma unroll
        for (int ks = 0; ks < 16; ++ks) qf[ks] = *(const bf16x8*)(qp + 16 * ks);
        __syncthreads();
        f32x16 acc[8];
        const XA_LAS unsigned char* kb = lds + c32 * RP + 16 * hh;
#pragma unroll
        for (int mt = 0; mt < 8; ++mt) {
            acc[mt] = (f32x16){0.f, 0.f, 0.f, 0.f, 0.f, 0.f, 0.f, 0.f, 0.f, 0.f, 0.f, 0.f, 0.f, 0.f, 0.f, 0.f};
#pragma unroll
            for (int ks = 0; ks < 16; ++ks) acc[mt] = __builtin_amdgcn_mfma_f32_32x32x16_bf16(*(const XA_LAS bf16x8*)(kb + (32 * mt) * RP + 32 * ks), qf[ks], acc[mt], 0, 0, 0);
        }
        float mx = acc[0][0];
#pragma unroll
        for (int mt = 0; mt < 8; ++mt)
#pragma unroll
            for (int r = 0; r < 16; ++r) mx = fmaxf(mx, acc[mt][r]);
        mx = fmaxf(mx, __shfl_xor(mx, 32));
        float sum = 0.f;
#pragma unroll
        for (int mt = 0; mt < 8; ++mt)
#pragma unroll
            for (int r = 0; r < 16; ++r) { acc[mt][r] = __builtin_amdgcn_exp2f(acc[mt][r] - mx); sum += acc[mt][r]; }
        sum += __shfl_xor(sum, 32); inv = 1.f / sum;
#pragma unroll
        for (int mt = 0; mt < 8; ++mt)
#pragma unroll
            for (int s2 = 0; s2 < 2; ++s2) { u32x4 a; a.x = cvtpk(acc[mt][8 * s2], acc[mt][8 * s2 + 1]); a.y = cvtpk(acc[mt][8 * s2 + 2], acc[mt][8 * s2 + 3]); a.z = cvtpk(acc[mt][8 * s2 + 4], acc[mt][8 * s2 + 5]); a.w = cvtpk(acc[mt][8 * s2 + 6], acc[mt][8 * s2 + 7]);
                pf[mt][s2] = __builtin_bit_cast(bf16x8, a); }
    }
    __syncthreads();
    stage(lds, VcT + ((size_t)b * D + h * 256) * MEML, MEML, tid);
    __syncthreads();
    const XA_LAS unsigned char* vb = lds + c32 * RP + 8 * hh;
    bf16_t* op = XO + (size_t)tok * D + h * 256 + 4 * hh;
#pragma unroll 1
    for (int dt = 0; dt < 8; ++dt) {
        f32x16 acc = (f32x16){0.f, 0.f, 0.f, 0.f, 0.f, 0.f, 0.f, 0.f, 0.f, 0.f, 0.f, 0.f, 0.f, 0.f, 0.f, 0.f};
#pragma unroll
        for (int mt = 0; mt < 8; ++mt)
#pragma unroll
            for (int s2 = 0; s2 < 2; ++s2) {
                const s16x4 lo = *(const XA_LAS s16x4*)(vb + (32 * dt) * RP + (32 * mt + 16 * s2) * 2), hi = *(const XA_LAS s16x4*)(vb + (32 * dt) * RP + (32 * mt + 16 * s2 + 8) * 2);
                const bf16x8 vf = (bf16x8){lo[0], lo[1], lo[2], lo[3], hi[0], hi[1], hi[2], hi[3]};
                acc = __builtin_amdgcn_mfma_f32_32x32x16_bf16(vf, pf[mt][s2], acc, 0, 0, 0);
            }
#pragma unroll
        for (int q = 0; q < 4; ++q) { u32x2 o; o.x = cvtpk(acc[4 * q] * inv, acc[4 * q + 1] * inv); o.y = cvtpk(acc[4 * q + 2] * inv, acc[4 * q + 3] * inv); *(u32x2*)(op + 32 * dt + 8 * q) = o; }
    }
    __syncthreads();
}
}

namespace sp {
#define SP_LAS __attribute__((address_space(3)))
#define SP_LDSWAIT() do { asm volatile("s_waitcnt lgkmcnt(0)" ::: "memory"); } while (0)
__device__ __forceinline__ void transpose_item(const float* __restrict__ W, int ldw, int col0, int K, int nblk, bf16_t* __restrict__ WT, int row_off, SP_LAS float* scr, int item, int lane) {
    const int kb = item / nblk, nb = item % nblk, k0 = 64 * kb, n0 = 32 * nb;
#pragma unroll 8
    for (int i = 0; i < 32; ++i) { const int kk = 2 * i + (lane >> 5); scr[kk * 33 + (lane & 31)] = W[(size_t)(k0 + kk) * ldw + col0 + n0 + (lane & 31)]; }
    SP_LDSWAIT();
    const int cc = lane & 7;
#pragma unroll
    for (int j = 0; j < 4; ++j) { const int n = (lane >> 3) + 8 * j; const SP_LAS float* s = scr + (8 * cc) * 33 + n;
        u32x4 o; o.x = pk2(s[0 * 33], s[1 * 33]); o.y = pk2(s[2 * 33], s[3 * 33]); o.z = pk2(s[4 * 33], s[5 * 33]); o.w = pk2(s[6 * 33], s[7 * 33]);
        *(u32x4*)(WT + (size_t)(row_off + n0 + n) * K + k0 + 8 * cc) = o; }
    SP_LDSWAIT();
}
__device__ __forceinline__ void cvt_range(const float* __restrict__ src, bf16_t* __restrict__ dst, size_t n4, size_t gtid, size_t gthreads) {
    for (size_t i = gtid; i < n4; i += gthreads) { const f32x4 v = ((const f32x4*)src)[i]; u32x2 o; o.x = pk2(v.x, v.y); o.y = pk2(v.z, v.w); ((u32x2*)dst)[i] = o; }
}

__device__ __forceinline__ void cvt_fp8_range(const float* __restrict__ src, unsigned char* __restrict__ dst, size_t n16, float scale, size_t gtid, size_t gthreads) {
    for (size_t i = gtid; i < n16; i += gthreads) {
        const f32x4* sp4 = (const f32x4*)src + 4 * i; u32x4 o; unsigned ow[4];
#pragma unroll
        for (int q = 0; q < 4; ++q) { const f32x4 v = sp4[q];
            const float a = fminf(fmaxf(v.x * scale, -448.f), 448.f), b = fminf(fmaxf(v.y * scale, -448.f), 448.f), c2 = fminf(fmaxf(v.z * scale, -448.f), 448.f), d2 = fminf(fmaxf(v.w * scale, -448.f), 448.f);
            int p = 0; p = __builtin_amdgcn_cvt_pk_fp8_f32(a, b, p, false); p = __builtin_amdgcn_cvt_pk_fp8_f32(c2, d2, p, true); ow[q] = (unsigned)p; }
        o.x = ow[0]; o.y = ow[1]; o.z = ow[2]; o.w = ow[3];
        ((u32x4*)dst)[i] = o;
    }
}
__device__ __forceinline__ void dt_stage_w(SP_LAS float* Wl, const float* __restrict__ w_in) {
    const int tid = opaque_tid();
#pragma unroll 8
    for (int i = 0; i < 64; ++i) { const int idx = tid + 512 * i; Wl[idx] = w_in[(size_t)(idx >> 5) * NIN + 5120 + (idx & 31)]; }
}
__device__ __forceinline__ void dt_item(SP_LAS float* Wl, SP_LAS float* xs, SP_LAS float* part, const float* __restrict__ x, const float* __restrict__ dt_bias, float* __restrict__ DT, int item) {
    const int tid = opaque_tid(), lane = tid & 63, w = tid >> 6, m0 = item * 4;
#pragma unroll
    for (int i = 0; i < 2; ++i) { const int q = tid + 512 * i; *(SP_LAS f32x4*)(xs + 4 * q) = ((const f32x4*)(x + (size_t)m0 * D))[q]; }
    __syncthreads();
    const int h = lane & 31, r = w >> 1, kq = (w & 1) * 2 + (lane >> 5);
    const SP_LAS float* xp = xs + r * 1024 + kq * 256; const SP_LAS float* wp = Wl + (kq * 256) * 32 + h;
    float a0 = 0.f, a1 = 0.f;
#pragma unroll 8
    for (int k = 0; k < 256; k += 2) { a0 = fmaf(xp[k], wp[k * 32], a0); a1 = fmaf(xp[k + 1], wp[(k + 1) * 32], a1); }
    float acc = a0 + a1;
    acc += __shfl_xor(acc, 32);
    if ((w & 1) && lane < 32) part[r * 32 + h] = acc;
    __syncthreads();
    if (!(w & 1) && lane < 32) { const float v = acc + part[r * 32 + h] + dt_bias[h]; DT[(size_t)(m0 + r) * 32 + h] = v > 20.f ? v : log1pf(expf(v)); }
}
__device__ __forceinline__ void ln_row(float* __restrict__ X, const float* __restrict__ g, const float* __restrict__ b, bf16_t* __restrict__ XB, int row, int lane) {
    f32x4* xr = (f32x4*)(X + (size_t)row * D) + lane;
    f32x4 v[4]; float s = 0.f;
#pragma unroll
    for (int j = 0; j < 4; ++j) { v[j] = xr[64 * j]; s += (v[j].x + v[j].y) + (v[j].z + v[j].w); }
    const float mean = wave_sum(s) * (1.f / D); float s2 = 0.f;
#pragma unroll
    for (int j = 0; j < 4; ++j) { v[j] = v[j] - mean; s2 += (v[j].x * v[j].x + v[j].y * v[j].y) + (v[j].z * v[j].z + v[j].w * v[j].w); }
    const float rstd = rsqrtf(wave_sum(s2) * (1.f / D) + 1e-5f);
#pragma unroll
    for (int j = 0; j < 4; ++j) { const int c = 4 * lane + 256 * j; const f32x4 gg = *(const f32x4*)(g + c), bb = *(const f32x4*)(b + c);
        f32x4 o = v[j] * rstd * gg + bb; xr[64 * j] = o;
        u32x2 pb; pb.x = pk2(o.x, o.y); pb.y = pk2(o.z, o.w); *(u32x2*)(XB + (size_t)row * D + c) = pb; }
}
__device__ __forceinline__ void xattn_pair(SP_LAS float* L, const bf16_t* __restrict__ QC, const bf16_t* __restrict__ KCVC, bf16_t* __restrict__ XO, int tok0) {
    const int t512 = opaque_tid(); const int half = t512 >> 8, tid = t512 & 255, lane = tid & 63, wv = tid >> 6, tok = tok0 + half, b = tok / SEQ;
    SP_LAS float* qs = L + half * 1024; SP_LAS float* ps = L + 2048 + half * 256; SP_LAS float* red = L + 2560 + half * 8;
    for (int i = tid; i < 1024; i += 256) qs[i] = bf2f(QC[(size_t)tok * D + i]);
    __syncthreads();
    const bf16_t* KV = KCVC + (size_t)b * MEML * 2048;
    for (int h = 0; h < MH; ++h) {
        const bf16_t* kp = KV + (size_t)tid * 2048 + h * 256;
        float s = 0.f;
        for (int d = 0; d < 256; d += 8) { const u32x4 w = *(const u32x4*)(kp + d); const SP_LAS float* q = qs + h * 256 + d;
            s += q[0] * bflo(w.x) + q[1] * bfhi(w.x) + q[2] * bflo(w.y) + q[3] * bfhi(w.y) + q[4] * bflo(w.z) + q[5] * bfhi(w.z) + q[6] * bflo(w.w) + q[7] * bfhi(w.w); }
        float mx = wave_max(s); if (lane == 0) red[wv] = mx; __syncthreads();
        mx = fmaxf(fmaxf(red[0], red[1]), fmaxf(red[2], red[3]));
        const float p = exp2f(s - mx);
        float sm = wave_sum(p); if (lane == 0) red[4 + wv] = sm; ps[tid] = p; __syncthreads();
        sm = (red[4] + red[5]) + (red[6] + red[7]);
        float o = 0.f;
        for (int j = 0; j < 256; ++j) o = fmaf(ps[j], bf2f(KV[(size_t)j * 2048 + 1024 + h * 256 + tid]), o);
        XO[(size_t)tok * D + h * 256 + tid] = (bf16_t)f2bf(o / sm);
        __syncthreads();
    }
}
__device__ __forceinline__ void select_pair(SP_LAS float* L, const bf16_t* __restrict__ QP, const bf16_t* __restrict__ SUBK, int* __restrict__ IDX, float* __restrict__ GATE, int tok0) {
    const int t512 = opaque_tid(); const int hf = t512 >> 8, tid = t512 & 255, tok = tok0 + hf;
    SP_LAS float* base = L + hf * 3072;
    SP_LAS float* qs = base; SP_LAS float* s = base + 2048; SP_LAS float* tops = base + 2304; SP_LAS int* topi = (SP_LAS int*)(base + 2336); SP_LAS float* cs = base + 2368; SP_LAS int* ci = (SP_LAS int*)(base + 2624);
    SP_LAS float* bs = base + 2880; SP_LAS int* bi = (SP_LAS int*)(base + 2896);
    for (int i = tid; i < 2048; i += 256) qs[i] = bf2f(QP[(size_t)tok * 2048 + i]);
    __syncthreads();
    for (int h = 0; h < PH; ++h) {
        const int half = tid >> 7, key = tid & 127;
        { const bf16_t* kp = SUBK + ((size_t)(h * 2 + half) * 128 + key) * 128; const SP_LAS float* q = qs + h * 256 + half * 128; float a = 0.f;
          for (int d = 0; d < 128; d += 8) { const u32x4 w = *(const u32x4*)(kp + d);
              a += q[d] * bflo(w.x) + q[d + 1] * bfhi(w.x) + q[d + 2] * bflo(w.y) + q[d + 3] * bfhi(w.y) + q[d + 4] * bflo(w.z) + q[d + 5] * bfhi(w.z) + q[d + 6] * bflo(w.w) + q[d + 7] * bfhi(w.w); }
          s[tid] = a; }
        __syncthreads();
        { const float me = s[tid]; int rank = 0; const SP_LAS float* spp = s + half * 128;
          for (int j = 0; j < 128; ++j) { const float o = spp[j]; rank += (o > me || (o == me && j < key)) ? 1 : 0; }
          if (rank < 16) { tops[half * 16 + rank] = me; topi[half * 16 + rank] = key; } }
        __syncthreads();
        { const int i = tid >> 4, j = tid & 15; cs[tid] = tops[i] + tops[16 + j]; ci[tid] = topi[i] * 128 + topi[16 + j]; }
        __syncthreads();
        { const float me = cs[tid]; int rank = 0;
          for (int j = 0; j < 256; ++j) { const float o = cs[j]; rank += (o > me || (o == me && j < tid)) ? 1 : 0; }
          if (rank < 16) { bs[rank] = me; bi[rank] = ci[tid]; } }
        __syncthreads();
        if (tid < 16) { const float mx = bs[0]; float sum = 0.f;
            for (int j = 0; j < 16; ++j) sum += expf(bs[j] - mx);
            GATE[(size_t)tok * 128 + h * 16 + tid] = expf(bs[tid] - mx) / sum; IDX[(size_t)tok * 128 + h * 16 + tid] = bi[tid]; }
        __syncthreads();
    }
}
__device__ __forceinline__ void gather_token(SP_LAS float* L, float* __restrict__ X, const bf16_t* __restrict__ PU, const bf16_t* __restrict__ PV, const int* __restrict__ IDX, const float* __restrict__ GATE,
                                             const float* __restrict__ g3, const float* __restrict__ b3, int tok) {
    const int tid = opaque_tid(), lane = tid & 63, wv = tid >> 6;
    SP_LAS float* ys = L; SP_LAS float* red = L + 8192;
    float xr[16], y[16];
    { const float* xp = X + (size_t)tok * D + lane * 16;
#pragma unroll
      for (int j = 0; j < 4; ++j) { const f32x4 v = *(const f32x4*)(xp + 4 * j); xr[4 * j] = v.x; xr[4 * j + 1] = v.y; xr[4 * j + 2] = v.z; xr[4 * j + 3] = v.w; }
#pragma unroll
      for (int j = 0; j < 16; ++j) y[j] = 0.f; }
    for (int e = 0; e < 16; ++e) {
        const int slot = wv * 16 + e; const int id = IDX[(size_t)tok * 128 + slot]; const float gt = GATE[(size_t)tok * 128 + slot];
        const bf16_t* up = PU + (size_t)id * D + lane * 16; const u32x4 u0 = *(const u32x4*)up, u1 = *(const u32x4*)(up + 8);
        const unsigned uw[8] = {u0.x, u0.y, u0.z, u0.w, u1.x, u1.y, u1.z, u1.w};
        float hsum = 0.f;
#pragma unroll
        for (int j = 0; j < 8; ++j) { hsum = fmaf(xr[2 * j], bflo(uw[j]), hsum); hsum = fmaf(xr[2 * j + 1], bfhi(uw[j]), hsum); }
        hsum = wave_sum(hsum);
        const float w = gt * 0.5f * hsum * (1.f + erff(hsum * 0.70710678118654752f));
        const bf16_t* vp = PV + (size_t)id * D + lane * 16; const u32x4 v0 = *(const u32x4*)vp, v1 = *(const u32x4*)(vp + 8);
        const unsigned vw[8] = {v0.x, v0.y, v0.z, v0.w, v1.x, v1.y, v1.z, v1.w};
#pragma unroll
        for (int j = 0; j < 8; ++j) { y[2 * j] = fmaf(w, bflo(vw[j]), y[2 * j]); y[2 * j + 1] = fmaf(w, bfhi(vw[j]), y[2 * j + 1]); }
    }
#pragma unroll
    for (int j = 0; j < 16; ++j) ys[wv * 1024 + lane * 16 + j] = y[j];
    __syncthreads();
    float v[2]; float s = 0.f;
#pragma unroll
    for (int j = 0; j < 2; ++j) { const int c = tid * 2 + j; float a = 0.f;
#pragma unroll
        for (int k = 0; k < 8; ++k) a += ys[k * 1024 + c];
        v[j] = ALPHA * X[(size_t)tok * D + c] + a; s += v[j]; }
    s = wave_sum(s); if (lane == 0) red[wv] = s; __syncthreads();
    float tot = 0.f;
#pragma unroll
    for (int k = 0; k < 8; ++k) tot += red[k];
    const float mean = tot * (1.f / D);
    float s2 = 0.f;
#pragma unroll
    for (int j = 0; j < 2; ++j) { v[j] -= mean; s2 += v[j] * v[j]; }
    s2 = wave_sum(s2); if (lane == 0) red[8 + wv] = s2; __syncthreads();
    float tot2 = 0.f;
#pragma unroll
    for (int k = 0; k < 8; ++k) tot2 += red[8 + k];
    const float rstd = rsqrtf(tot2 * (1.f / D) + 1e-5f);
#pragma unroll
    for (int j = 0; j < 2; ++j) { const int c = tid * 2 + j; X[(size_t)tok * D + c] = v[j] * rstd * g3[c] + b3[c]; }
    __syncthreads();
}

constexpr float PEER_SU = 2048.f, PEER_SV = 256.f;
typedef float f32x2v __attribute__((ext_vector_type(2)));
__device__ __forceinline__ void gather_wave(float* __restrict__ Xo, const float* X, const unsigned char* __restrict__ PU, const unsigned char* __restrict__ PV, const int* __restrict__ IDX, const float* __restrict__ GATE,
                                            const float* __restrict__ g3, const float* __restrict__ b3, int tok, int lane) {
    float xr[16], y[16];
    { const f32x4* xp = (const f32x4*)(X + (size_t)tok * D + 16 * lane);
#pragma unroll
      for (int q = 0; q < 4; ++q) { const f32x4 v = xp[q]; xr[4 * q] = v.x; xr[4 * q + 1] = v.y; xr[4 * q + 2] = v.z; xr[4 * q + 3] = v.w; } }
#pragma unroll
    for (int j = 0; j < 16; ++j) y[j] = 0.f;
    const int id0 = IDX[(size_t)tok * 128 + lane], id1 = IDX[(size_t)tok * 128 + 64 + lane];
    const float gt0 = GATE[(size_t)tok * 128 + lane], gt1 = GATE[(size_t)tok * 128 + 64 + lane];
    u32x4 ub[8], vb[8];
#define GW_ISSUE(buf, TBL, i) do { const int idv_ = ((i) < 8) ? id0 : id1; _Pragma("unroll") for (int k_ = 0; k_ < 8; ++k_) { \
        const int id_ = __builtin_amdgcn_readlane(idv_, (8 * (i) + k_) & 63); buf[k_] = *(const u32x4*)((TBL) + (size_t)id_ * D + 16 * lane); } } while (0)
    GW_ISSUE(ub, PU, 0); GW_ISSUE(vb, PV, 0);
    const bool h32 = (lane & 32) != 0, h16 = (lane & 16) != 0, h8 = (lane & 8) != 0;
#pragma unroll 1
    for (int i = 0; i < 16; ++i) {
        float p[8];
#pragma unroll
        for (int k = 0; k < 8; ++k) { const unsigned w[4] = {ub[k].x, ub[k].y, ub[k].z, ub[k].w}; float a = 0.f;
#pragma unroll
            for (int q = 0; q < 4; ++q) { const f32x2v lo = __builtin_amdgcn_cvt_pk_f32_fp8((int)w[q], false), hi = __builtin_amdgcn_cvt_pk_f32_fp8((int)w[q], true);
                a = fmaf(xr[4 * q], lo.x, a); a = fmaf(xr[4 * q + 1], lo.y, a); a = fmaf(xr[4 * q + 2], hi.x, a); a = fmaf(xr[4 * q + 3], hi.y, a); }
            p[k] = a; }
        { const int in_ = (i + 1 < 16) ? i + 1 : 15; GW_ISSUE(ub, PU, in_); }
        float q4[4], q2[2], q1;
#pragma unroll
        for (int k = 0; k < 4; ++k) q4[k] = (h32 ? p[k + 4] : p[k]) + __shfl_xor(h32 ? p[k] : p[k + 4], 32);
#pragma unroll
        for (int k = 0; k < 2; ++k) q2[k] = (h16 ? q4[k + 2] : q4[k]) + __shfl_xor(h16 ? q4[k] : q4[k + 2], 16);
        q1 = (h8 ? q2[1] : q2[0]) + __shfl_xor(h8 ? q2[0] : q2[1], 8);
        q1 += __shfl_xor(q1, 4); q1 += __shfl_xor(q1, 2); q1 += __shfl_xor(q1, 1);
        q1 *= (1.f / PEER_SU);
        const float gsel = __shfl((i < 8) ? gt0 : gt1, (8 * i + (lane >> 3)) & 63);
        const float wv = gsel * 0.5f * q1 * (1.f + erff(q1 * 0.70710678118654752f));
#pragma unroll
        for (int k = 0; k < 8; ++k) { const float wk = __builtin_bit_cast(float, __builtin_amdgcn_readlane(__builtin_bit_cast(int, wv), 8 * k));
            const unsigned w[4] = {vb[k].x, vb[k].y, vb[k].z, vb[k].w};
#pragma unroll
            for (int q = 0; q < 4; ++q) { const f32x2v lo = __builtin_amdgcn_cvt_pk_f32_fp8((int)w[q], false), hi = __builtin_amdgcn_cvt_pk_f32_fp8((int)w[q], true);
                y[4 * q] = fmaf(wk, lo.x, y[4 * q]); y[4 * q + 1] = fmaf(wk, lo.y, y[4 * q + 1]); y[4 * q + 2] = fmaf(wk, hi.x, y[4 * q + 2]); y[4 * q + 3] = fmaf(wk, hi.y, y[4 * q + 3]); } }
        { const int in_ = (i + 1 < 16) ? i + 1 : 15; GW_ISSUE(vb, PV, in_); }
    }
#undef GW_ISSUE
    float s = 0.f;
#pragma unroll
    for (int j = 0; j < 16; ++j) { y[j] = ALPHA * xr[j] + y[j] * (1.f / PEER_SV); s += y[j]; }
    const float mean = wave_sum(s) * (1.f / D); float s2 = 0.f;
#pragma unroll
    for (int j = 0; j < 16; ++j) { y[j] -= mean; s2 += y[j] * y[j]; }
    const float rstd = rsqrtf(wave_sum(s2) * (1.f / D) + 1e-5f);
    float* op = Xo + (size_t)tok * D + 16 * lane;
#pragma unroll
    for (int q = 0; q < 4; ++q) { const f32x4 gg = *(const f32x4*)(g3 + 16 * lane + 4 * q), bb = *(const f32x4*)(b3 + 16 * lane + 4 * q);
        f32x4 o; o.x = y[4 * q] * rstd * gg.x + bb.x; o.y = y[4 * q + 1] * rstd * gg.y + bb.y; o.z = y[4 * q + 2] * rstd * gg.z + bb.z; o.w = y[4 * q + 3] * rstd * gg.w + bb.w;
        *(f32x4*)(op + 4 * q) = o; }
}
}


#define LAS __attribute__((address_space(3)))
#define XB_TMO      128
#define XB_XCNT(j)  (256  + 64 * (j))
#define XB_XSUB(j)  (1280 + 64 * (j))
#define XB_XGEN(j)  (2304 + 64 * (j))
#define XB_TOP      3328
#define XB_TOPGEN   3392
#define XCD_BAR_WORDS 3456
#define XB_SPIN_CAP (1u << 18)
__device__ __forceinline__ unsigned xb_ld(unsigned* p)              { return __hip_atomic_load(p, __ATOMIC_RELAXED, __HIP_MEMORY_SCOPE_AGENT); }
__device__ __forceinline__ unsigned xb_add(unsigned* p, unsigned v) { return __hip_atomic_fetch_add(p, v, __ATOMIC_RELAXED, __HIP_MEMORY_SCOPE_AGENT); }
__device__ __forceinline__ unsigned xb_xcc_id() { return (unsigned)__builtin_amdgcn_s_getreg((3 << 11) | 20) & 0xFu; }
#define XB_SPIN(cond, bar) do { unsigned _sp = 0; while (cond) { __builtin_amdgcn_s_sleep(1); \
    if ((++_sp & 255u) == 0u) { if (xb_ld(&(bar)[XB_TMO])) break; if (_sp > XB_SPIN_CAP) { atomicAdd(&(bar)[XB_TMO], 1u); break; } } } } while (0)
struct XcdBarrier { unsigned* bar; unsigned x; volatile LAS unsigned* st; };
__device__ __forceinline__ XcdBarrier xcd_barrier_post(unsigned* bar, volatile LAS unsigned* st) {
    XcdBarrier b; b.bar = bar; b.x = xb_xcc_id(); b.st = st;
    if (threadIdx.x == 0) (void)xb_add(&bar[XB_XCNT(b.x)], 1u);
    return b;
}
__device__ __forceinline__ void xcd_barrier_complete(unsigned* bar, unsigned x, unsigned& nloc, unsigned& nx) {
    const unsigned G = gridDim.x * gridDim.y * gridDim.z;
    unsigned sum, cnt, mine, sp = 0u;
    for (;;) {
        sum = 0u; cnt = 0u; mine = 0u;
#pragma unroll
        for (unsigned j = 0; j < 16; ++j) { const unsigned c = xb_ld(&bar[XB_XCNT(j)]); sum += c; cnt += (c > 0u) ? 1u : 0u; mine = (j == x) ? c : mine; }
        if (sum == G) break;
        __builtin_amdgcn_s_sleep(1);
        if ((++sp & 255u) == 0u) { if (xb_ld(&bar[XB_TMO])) break; if (sp > XB_SPIN_CAP) { atomicAdd(&bar[XB_TMO], 1u); break; } }
    }
    nloc = mine > 0u ? mine : 1u; nx = cnt > 0u ? cnt : 1u;
}
__device__ __forceinline__ void xcd_barrier(const XcdBarrier& b) {
    asm volatile("s_waitcnt vmcnt(0)" ::: "memory");
    __syncthreads();
    if (threadIdx.x == 0) {
        unsigned* bar = b.bar;
        __builtin_amdgcn_s_waitcnt(0);
        unsigned nloc = b.st[0], nx = b.st[1];
        if (nloc == 0u) { xcd_barrier_complete(bar, b.x, nloc, nx); b.st[0] = nloc; b.st[1] = nx; }
        const unsigned old = xb_add(&bar[XB_XSUB(b.x)], 1u);
        const unsigned gen = old / nloc;
        if (old + 1u == (gen + 1u) * nloc) {
            __builtin_amdgcn_fence(__ATOMIC_RELEASE, "agent");
            asm volatile("s_waitcnt vmcnt(0)" ::: "memory");
            const unsigned og = xb_add(&bar[XB_TOP], 1u);
            const unsigned tg = og / nx;
            if (og + 1u == (tg + 1u) * nx) xb_add(&bar[XB_TOPGEN], 1u);
            else XB_SPIN(xb_ld(&bar[XB_TOPGEN]) == tg, bar);
            __builtin_amdgcn_fence(__ATOMIC_ACQUIRE, "agent");
            xb_add(&bar[XB_XGEN(b.x)], 1u);
            asm volatile("s_waitcnt vmcnt(0)" ::: "memory");
        } else {
            XB_SPIN(xb_ld(&bar[XB_XGEN(b.x)]) == gen, bar);
            __builtin_amdgcn_fence(__ATOMIC_ACQUIRE, "agent");
            asm volatile("s_waitcnt vmcnt(0)" ::: "memory");
        }
    }
    __syncthreads();
}
constexpr int CW_BAR = 4096;
constexpr int MISC_OFF = 147456;

struct Params { const float* in[30]; float* out; unsigned char* ws; };
template <class F> __device__ __forceinline__ void run_gemm(unsigned char* lds, const bf16_t* A, int lda, const bf16_t* Bt, int Mr, int N, int K, F f) {
    pg8::Gemm g{A, Bt, Mr, N, K, lda}; pg8::StaticOrder S; S.init(Mr, N, gridDim.x, blockIdx.x); pg8::EpiAdapt<F> E{f};
    pg8::gemm_phase<pg8::EpiAdapt<F>, pg8::StaticOrder, true>((PG8_LAS unsigned char*)lds, g, S, E);
}
#ifndef PROBE_ATTN
#define PROBE_ATTN 0
#endif
#ifndef PROBE_SSD
#define PROBE_SSD 0
#endif
#ifndef PROBE_SYNC
#define PROBE_SYNC 0
#endif
#define KA_LAS __attribute__((address_space(4)))
#define PH_BEGIN const KA_LAS unsigned char* ka_ = (const KA_LAS unsigned char*)__builtin_amdgcn_kernarg_segment_ptr(); asm volatile("" : "+s"(ka_))
#define PIN(k) (*(const float* const KA_LAS*)(ka_ + 8 * (k)))
#define POUT (*(float* const KA_LAS*)(ka_ + 240))
#define PWS (*(unsigned char* const KA_LAS*)(ka_ + 248))
__global__ void __launch_bounds__(512, 2) hybrid_fwd(Params P) {
    extern __shared__ __attribute__((aligned(16))) unsigned char lds[];
    cg::grid_group grid = cg::this_grid();
    { PH_BEGIN; volatile LAS unsigned* misc = (volatile LAS unsigned*)((LAS unsigned char*)lds + MISC_OFF);
      if (threadIdx.x < 16) misc[threadIdx.x] = 0u;
      __syncthreads();
      (void)xcd_barrier_post((unsigned*)(PWS + WS_CTL) + CW_BAR, misc);
      if (PWS == nullptr) grid.sync(); }
#define GSYNC() do { PH_BEGIN; XcdBarrier xb_; xb_.bar = (unsigned*)(PWS + WS_CTL) + CW_BAR; xb_.x = xb_xcc_id(); xb_.st = (volatile LAS unsigned*)((LAS unsigned char*)lds + MISC_OFF); xcd_barrier(xb_); } while (0)
    {
        PH_BEGIN; unsigned char* ws = PWS;
        const int tid = opaque_tid(), lane = tid & 63, wave = __builtin_amdgcn_readfirstlane(tid >> 6), c = blockIdx.x, G = gridDim.x;
        const size_t gtid = (size_t)c * 512 + tid, gthreads = (size_t)G * 512; const int gw = c * 8 + wave, NGW = G * 8;
        const float* w_in = PIN(2);
        bf16_t* WinT = (bf16_t*)(ws + WS_WIN); bf16_t* WckvT = (bf16_t*)(ws + WS_WCKV);
        SP_LAS float* scr = (SP_LAS float*)lds + wave * (64 * 33);
        constexpr int I0 = 2560, I1 = 5120, I2 = 6144, I3 = 6656, I4 = 7168, I5 = 7680, I6 = 8192, I7 = 8704, I8 = 9216, I9 = 10240;
        for (int it = gw; it < I9; it += NGW) {
            if (it < I0) sp::transpose_item(w_in, NIN, 0, D, 160, WinT, 0, scr, it, lane);
            else if (it < I1) sp::transpose_item(w_in, NIN, 5152, D, 160, WinT, 5120, scr, it - I0, lane);
            else if (it < I2) sp::transpose_item(PIN(9), D, 0, DI, 32, (bf16_t*)(ws + WS_WSSD), 0, scr, it - I1, lane);
            else if (it < I3) sp::transpose_item(PIN(13), D, 0, D, 32, (bf16_t*)(ws + WS_WDIFF), 0, scr, it - I2, lane);
            else if (it < I4) sp::transpose_item(PIN(15), D, 0, D, 32, (bf16_t*)(ws + WS_WO), 0, scr, it - I3, lane);
            else if (it < I5) sp::transpose_item(PIN(18), D, 0, D, 32, (bf16_t*)(ws + WS_WCQ), 0, scr, it - I4, lane);
            else if (it < I6) sp::transpose_item(PIN(19), D, 0, D, 32, WckvT, 0, scr, it - I5, lane);
            else if (it < I7) sp::transpose_item(PIN(20), D, 0, D, 32, WckvT, 1024, scr, it - I6, lane);
            else if (it < I8) sp::transpose_item(PIN(21), D, 0, D, 32, (bf16_t*)(ws + WS_WCO), 0, scr, it - I7, lane);
            else sp::transpose_item(PIN(24), 2048, 0, D, 64, (bf16_t*)(ws + WS_WPQ), 0, scr, it - I8, lane);
        }
        const float* x = PIN(0);
        sp::cvt_range(x, (bf16_t*)(ws + WS_XB), (size_t)M * D / 4, gtid, gthreads);
        sp::cvt_range(PIN(1), (bf16_t*)(ws + WS_MEMB), (size_t)BATCH * MEML * D / 4, gtid, gthreads);
        sp::cvt_range(PIN(25), (bf16_t*)(ws + WS_SUBK), (size_t)PH * 2 * PK * PHALF / 4, gtid, gthreads);
        __syncthreads();
        sp::dt_stage_w((SP_LAS float*)lds, w_in);
        for (int it = c; it < M / 4; it += G) sp::dt_item((SP_LAS float*)lds, (SP_LAS float*)lds + 32768, (SP_LAS float*)lds + 36896  , x, PIN(5), (float*)(ws + WS_DT), it);
        __syncthreads();
        if (c == 0 && tid == 0) { const float* lam_q = PIN(10); const float* lam_k = PIN(11); float s0 = 0.f, s1 = 0.f;
            for (int i = 0; i < 64; ++i) { s0 += lam_q[i] * lam_k[i]; s1 += lam_q[64 + i] * lam_k[64 + i]; }
            ((float*)(ws + WS_CTL))[CW_LAM] = expf(s0) - expf(s1) + LAMBDA_INIT; }
    }
    GSYNC();
    { PH_BEGIN; unsigned char* ws = PWS;
      run_gemm(lds, (const bf16_t*)(ws + WS_MEMB), D, (const bf16_t*)(ws + WS_WCKV), BATCH * MEML, D, D, EpiPlain{(bf16_t*)(ws + WS_KCVC), D, 1.f});
      for (int bb = 0; bb < BATCH; ++bb)
          run_gemm(lds, (const bf16_t*)(ws + WS_WCKV) + (size_t)D * D, D, (const bf16_t*)(ws + WS_MEMB) + (size_t)bb * MEML * D, D, MEML, D, EpiPlain{(bf16_t*)(ws + WS_KCVC) + (size_t)BATCH * MEML * D + (size_t)bb * D * MEML, MEML, 1.f});
      run_gemm(lds, (const bf16_t*)(ws + WS_XB), D, (const bf16_t*)(ws + WS_WIN), SEQ, NINP, D, EpiInProj{(bf16_t*)(ws + WS_H), PIN(14)}); }
    GSYNC();
#pragma unroll 1
    for (int b = 0; b < BATCH; ++b) {
        { PH_BEGIN; unsigned char* ws = PWS; const int c = blockIdx.x, G = gridDim.x;
          bf16_t* H = (bf16_t*)(ws + WS_H); const float* DTb = (const float*)(ws + WS_DT) + (size_t)b * SEQ * 32;
          for (int u = c; u < 256; u += G) ssd::phaseA_unit((SS_LAS unsigned char*)lds, H, DTb, PIN(3), PIN(4), PIN(6), (bf16_t*)(ws + WS_T1), (float*)(ws + WS_CTL) + 1024, u >> 2, u & 3);
          const float lam = ((const float*)(ws + WS_CTL))[CW_LAM]; const float* subln_w = PIN(12);
#if PROBE_ATTN
          for (int u = c; u < 256; u += G) { const int h = u >> 5, j = u & 31;
              dattn::unit<false>((DA_LAS unsigned char*)lds, H, h, 63 - j, subln_w, lam);
              dattn::unit<false>((DA_LAS unsigned char*)lds, H, h, j, subln_w, lam); }
#endif
          for (int u = c; u < 256; u += G) { const int h = u >> 5, j = u & 31;
              dattn::unit((DA_LAS unsigned char*)lds, H, h, 63 - j, subln_w, lam);
              dattn::unit((DA_LAS unsigned char*)lds, H, h, j, subln_w, lam); } }
        GSYNC();
        { PH_BEGIN; unsigned char* ws = PWS; const int tid = opaque_tid();
          for (size_t i = (size_t)blockIdx.x * 512 + tid; i < 131072; i += (size_t)gridDim.x * 512) ssd::scan_phase((bf16_t*)(ws + WS_T1), (const float*)(ws + WS_CTL) + 1024, (int)i); }
        GSYNC();
        { PH_BEGIN; unsigned char* ws = PWS; const int c = blockIdx.x, G = gridDim.x;
#if PROBE_SSD
          for (int u = c; u < 256; u += G) ssd::phaseA_unit((SS_LAS unsigned char*)lds, (bf16_t*)(ws + WS_H), (const float*)(ws + WS_DT) + (size_t)b * SEQ * 32, PIN(3), PIN(4), PIN(6), (bf16_t*)(POUT + (size_t)SEQ * D), (float*)(ws + WS_CTL) + 8192, u >> 2, u & 3);
          for (int u = c; u < 256; u += G) ssd::phaseC_unit<false>((SS_LAS unsigned char*)lds, (bf16_t*)(ws + WS_H), (const float*)(ws + WS_DT) + (size_t)b * SEQ * 32, PIN(3), PIN(4), PIN(6), PIN(7), PIN(8), (const bf16_t*)(ws + WS_T1), u >> 2, u & 3);
#endif
          for (int u = c; u < 256; u += G) ssd::phaseC_unit((SS_LAS unsigned char*)lds, (bf16_t*)(ws + WS_H), (const float*)(ws + WS_DT) + (size_t)b * SEQ * 32, PIN(3), PIN(4), PIN(6), PIN(7), PIN(8), (const bf16_t*)(ws + WS_T1), u >> 2, u & 3); }
        GSYNC();
        { PH_BEGIN; unsigned char* ws = PWS; bf16_t* H = (bf16_t*)(ws + WS_H); float* T1 = (float*)(ws + WS_T1);
          run_gemm(lds, H + HC_Z, HP_, (const bf16_t*)(ws + WS_WSSD), SEQ, D, DI, EpiGate1{H, T1});
          run_gemm(lds, H + HC_Q, HP_, (const bf16_t*)(ws + WS_WDIFF), SEQ, D, D, EpiGate2{H, T1}); }
        GSYNC();
        { PH_BEGIN; unsigned char* ws = PWS;
          run_gemm(lds, (const bf16_t*)(ws + WS_H) + HC_K, HP_, (const bf16_t*)(ws + WS_WO), SEQ, D, D, EpiResid{PIN(0), POUT, b * SEQ, 0}); }
        GSYNC();
        if (b + 1 < BATCH) {
            { PH_BEGIN; unsigned char* ws = PWS;
              run_gemm(lds, (const bf16_t*)(ws + WS_XB) + (size_t)(b + 1) * SEQ * D, D, (const bf16_t*)(ws + WS_WIN), SEQ, NINP, D, EpiInProj{(bf16_t*)(ws + WS_H), PIN(14)}); }
            GSYNC();
        }
    }
    { PH_BEGIN; unsigned char* ws = PWS; const int tid = opaque_tid(), lane = tid & 63, wave = __builtin_amdgcn_readfirstlane(tid >> 6), c = blockIdx.x, G = gridDim.x;
      const size_t gtid = (size_t)c * 512 + tid, gthreads = (size_t)G * 512;
      float* out = POUT; const float* g = PIN(16); const float* bb = PIN(17); bf16_t* XB = (bf16_t*)(ws + WS_XB);
      for (int r = c * 8 + wave; r < M; r += G * 8) sp::ln_row(out, g, bb, XB, r, lane);
      sp::cvt_fp8_range(PIN(26), ws + WS_PU, (size_t)PK * PK * D / 16, sp::PEER_SU, gtid, gthreads);
      sp::cvt_fp8_range(PIN(27), ws + WS_PV, (size_t)PK * PK * D / 16, sp::PEER_SV, gtid, gthreads); }
    GSYNC();
    { PH_BEGIN; unsigned char* ws = PWS;
      run_gemm(lds, (const bf16_t*)(ws + WS_XB), D, (const bf16_t*)(ws + WS_WCQ), M, D, D, EpiPlain{(bf16_t*)(ws + WS_QC), D, CQSCALE}); }
    GSYNC();
    { PH_BEGIN; unsigned char* ws = PWS; const int c = blockIdx.x, G = gridDim.x;
      for (int u = c; u < 256; u += G) xattn::unit((XA_LAS unsigned char*)lds, (const bf16_t*)(ws + WS_QC), (const bf16_t*)(ws + WS_KCVC), (const bf16_t*)(ws + WS_KCVC) + (size_t)BATCH * MEML * D, (bf16_t*)(ws + WS_XO), u >> 2, u & 3); }
    GSYNC();
    { PH_BEGIN; unsigned char* ws = PWS; float* out = POUT;
      run_gemm(lds, (const bf16_t*)(ws + WS_XO), D, (const bf16_t*)(ws + WS_WCO), M, D, D, EpiResid{out, out, 0, 0}); }
    GSYNC();
    { PH_BEGIN; unsigned char* ws = PWS; const int tid = opaque_tid(), lane = tid & 63, wave = __builtin_amdgcn_readfirstlane(tid >> 6), c = blockIdx.x, G = gridDim.x;
      float* out = POUT; const float* g = PIN(22); const float* bb = PIN(23); bf16_t* XB = (bf16_t*)(ws + WS_XB);
      for (int r = c * 8 + wave; r < M; r += G * 8) sp::ln_row(out, g, bb, XB, r, lane); }
    GSYNC();
    { PH_BEGIN; unsigned char* ws = PWS;
      run_gemm(lds, (const bf16_t*)(ws + WS_XB), D, (const bf16_t*)(ws + WS_WPQ), M, 2048, D, EpiPlain{(bf16_t*)(ws + WS_QP), 2048, 1.f}); }
    GSYNC();
    { PH_BEGIN; unsigned char* ws = PWS; const int c = blockIdx.x, G = gridDim.x;
      for (int t = 64 * c; t < M; t += 64 * G)
          for (int hp = 0; hp < 4; ++hp) psel::step((PS_LAS int*)lds, (const bf16_t*)(ws + WS_QP), (const bf16_t*)(ws + WS_SUBK), (int*)(ws + WS_IDX), (float*)(ws + WS_GATE), t, hp); }
    GSYNC();
    { PH_BEGIN; unsigned char* ws = PWS; const int tid = opaque_tid(), lane = tid & 63, wave = __builtin_amdgcn_readfirstlane(tid >> 6);
      float* out = POUT; const float* g3 = PIN(28); const float* b3 = PIN(29);
      for (int t = blockIdx.x * 8 + wave; t < M; t += gridDim.x * 8) sp::gather_wave(out, out, ws + WS_PU, ws + WS_PV, (const int*)(ws + WS_IDX), (const float*)(ws + WS_GATE), g3, b3, t, lane); }
}

extern "C" void kernel_launch(void* const* d_in, const int* in_sizes, int n_in, void* d_out, int out_size, void* d_ws, size_t ws_size, hipStream_t stream) {
    static int grid_blocks = 0;
    if (grid_blocks == 0) {
        if (n_in != 30 || out_size != M * D || ws_size < WS_END) { fprintf(stderr, "kernel_launch: unexpected sizes n_in %d out %d ws %zu (need %zu)\n", n_in, out_size, ws_size, (size_t)WS_END); grid_blocks = -1; return; }
        int dev = 0, cus = 0, per_cu = 0;
        (void)hipGetDevice(&dev); (void)hipDeviceGetAttribute(&cus, hipDeviceAttributeMultiprocessorCount, dev);
        (void)hipFuncSetAttribute((const void*)hybrid_fwd, hipFuncAttributeMaxDynamicSharedMemorySize, LDS_BYTES);
        if (hipOccupancyMaxActiveBlocksPerMultiprocessor(&per_cu, (const void*)hybrid_fwd, 512, LDS_BYTES) != hipSuccess || per_cu < 1) { fprintf(stderr, "kernel_launch: occupancy query failed (%d)\n", per_cu); per_cu = 1; }
        (void)hipGetLastError();
        grid_blocks = cus * 1;
    }
    if (grid_blocks < 0) return;
    if (hipMemsetAsync(d_ws, 0, 65536, stream) != hipSuccess) { fprintf(stderr, "kernel_launch: memset of control words failed\n"); return; }
    Params p{};
    for (int i = 0; i < 30; ++i) p.in[i] = (const float*)d_in[i];
    p.out = (float*)d_out; p.ws = (unsigned char*)d_ws;
    void* args[] = {&p};
    hipError_t e = hipLaunchCooperativeKernel((const void*)hybrid_fwd, dim3(grid_blocks), dim3(512), args, LDS_BYTES, stream);
    if (e != hipSuccess) fprintf(stderr, "cooperative launch failed: %s (grid %d)\n", hipGetErrorString(e), grid_blocks);
}
```

```cpp
#include <hip/hip_runtime.h>
#include <hip/hip_cooperative_groups.h>
namespace cg = cooperative_groups;
#include <cstdio>
#include <cstdint>
#include <cmath>
#include <type_traits>

typedef unsigned short bf16_t;
typedef float f32x4 __attribute__((ext_vector_type(4)));
typedef unsigned u32x4 __attribute__((ext_vector_type(4)));
typedef unsigned u32x2 __attribute__((ext_vector_type(2)));

constexpr int D = 1024, BATCH = 2, SEQ = 8192, M = BATCH * SEQ;
constexpr int DI = 2048, NH = 32, HP = 64, NG = 4, DS = 128, DXBC = 3072;
constexpr int AH = 8, AD = 64, AV = 128;
constexpr int MEML = 256, MH = 4, MHD = 256;
constexpr int PH = 8, PK = 128, PDK = 256, PHALF = 128, PTOP = 16;
constexpr int NIN = 10272, NINP = 10240;
constexpr float ALPHA = 1.189207115002721f;
constexpr float LOG2E = 1.4426950408889634f;
constexpr float QSCALE = 0.125f * LOG2E;
constexpr float CQSCALE = 0.0625f * LOG2E;
constexpr float LAMBDA_INIT = 0.2f;
constexpr int HC_Z = 0, HC_XBC = 2048, HC_Q = 5120, HC_K = 6144, HC_V = 7168, HC_GS = 8192, HC_GA = 9216, HP_ = NINP;

constexpr size_t MiB = 1u << 20;
constexpr size_t WS_CTL = 0;
constexpr size_t WS_WIN = 1 * MiB;
constexpr size_t WS_WSSD = 21 * MiB;
constexpr size_t WS_WDIFF = 25 * MiB, WS_WO = 27 * MiB, WS_WCQ = 29 * MiB, WS_WCKV = 31 * MiB  , WS_WCO = 35 * MiB;
constexpr size_t WS_WPQ = 37 * MiB;
constexpr size_t WS_SUBK = 41 * MiB;
constexpr size_t WS_MEMB = 42 * MiB;
constexpr size_t WS_KCVC = 43 * MiB;
constexpr size_t WS_DT = 45 * MiB;
constexpr size_t WS_XB = 47 * MiB;
constexpr size_t WS_H = 79 * MiB;
constexpr size_t WS_T1 = 239 * MiB;
constexpr size_t WS_PU = 47 * MiB, WS_PV = 63 * MiB;
constexpr size_t WS_X1B = 79 * MiB;
constexpr size_t WS_QC = 143 * MiB, WS_XO = 175 * MiB;
constexpr size_t WS_QP = 207 * MiB;
constexpr size_t WS_IDX = 143 * MiB, WS_GATE = 151 * MiB;
constexpr size_t WS_END = 271 * MiB;
constexpr int CW_LAM = 64;

__device__ __forceinline__ int opaque_tid() { int t = threadIdx.x; asm volatile("" : "+v"(t)); return t; }
__device__ __forceinline__ unsigned f2bf(float f) { unsigned u = __builtin_bit_cast(unsigned, f); return (u + 0x7fffu + ((u >> 16) & 1u)) >> 16; }
__device__ __forceinline__ float bf2f(unsigned h) { return __builtin_bit_cast(float, h << 16); }
__device__ __forceinline__ unsigned pk2(float lo, float hi) { return f2bf(lo) | (f2bf(hi) << 16); }
__device__ __forceinline__ float bflo(unsigned w) { return __builtin_bit_cast(float, w << 16); }
__device__ __forceinline__ float bfhi(unsigned w) { return __builtin_bit_cast(float, w & 0xffff0000u); }
__device__ __forceinline__ float sigmoidf_(float v) { return __builtin_amdgcn_rcpf(1.f + __expf(-v)); }
__device__ __forceinline__ float siluf_(float v) { return v * __builtin_amdgcn_rcpf(1.f + __expf(-v)); }
__device__ __forceinline__ float wave_sum(float v) {
#pragma unroll
    for (int o = 1; o < 64; o <<= 1) v += __shfl_xor(v, o);
    return v;
}
__device__ __forceinline__ float wave_max(float v) {
#pragma unroll
    for (int o = 1; o < 64; o <<= 1) v = fmaxf(v, __shfl_xor(v, o));
    return v;
}

__device__ __forceinline__ void store_bf16x8(bf16_t* p, const float (&v)[8]) { u32x4 w; w.x = pk2(v[0], v[1]); w.y = pk2(v[2], v[3]); w.z = pk2(v[4], v[5]); w.w = pk2(v[6], v[7]); *(u32x4*)p = w; }
struct EpiPlain { bf16_t* O; int ldc; float scale;
    __device__ __forceinline__ void operator()(int row, int col0, const float (&v)[8]) const { float o[8];
#pragma unroll
        for (int j = 0; j < 8; ++j) o[j] = v[j] * scale; store_bf16x8(O + (size_t)row * ldc + col0, o); } };
struct EpiInProj { bf16_t* H; const float* gate_bias;
    __device__ __forceinline__ void operator()(int row, int col0, const float (&v)[8]) const { float o[8];
        if (col0 >= HC_GS) { const float* gb = gate_bias + (col0 - HC_GS);
#pragma unroll
            for (int j = 0; j < 8; ++j) o[j] = sigmoidf_(v[j] + gb[j]); }
        else { const float s = (col0 >= HC_Q && col0 < HC_K) ? QSCALE : 1.f;
#pragma unroll
            for (int j = 0; j < 8; ++j) o[j] = v[j] * s; }
        store_bf16x8(H + (size_t)row * HP_ + col0, o); } };
struct EpiGate1 { const bf16_t* H; float* T1;
    __device__ __forceinline__ void operator()(int row, int col0, const float (&v)[8]) const {
        const u32x4 g = *(const u32x4*)(H + (size_t)row * HP_ + HC_GS + col0); const unsigned gw[4] = {g.x, g.y, g.z, g.w};
        float* t = T1 + (size_t)row * D + col0;
#pragma unroll
        for (int j = 0; j < 4; ++j) { t[2 * j] = bflo(gw[j]) * v[2 * j]; t[2 * j + 1] = bfhi(gw[j]) * v[2 * j + 1]; } } };
struct EpiGate2 { bf16_t* H; const float* T1;
    __device__ __forceinline__ void operator()(int row, int col0, const float (&v)[8]) const {
        const u32x4 g = *(const u32x4*)(H + (size_t)row * HP_ + HC_GA + col0); const unsigned gw[4] = {g.x, g.y, g.z, g.w};
        const float* t = T1 + (size_t)row * D + col0; float o[8];
#pragma unroll
        for (int j = 0; j < 4; ++j) { o[2 * j] = t[2 * j] + bflo(gw[j]) * v[2 * j]; o[2 * j + 1] = t[2 * j + 1] + bfhi(gw[j]) * v[2 * j + 1]; }
        store_bf16x8(H + (size_t)row * HP_ + HC_K + col0, o); } };
struct EpiResid { const float* base; float* out; int row_off; int pad_;
    __device__ __forceinline__ void operator()(int row, int col0, const float (&v)[8]) const {
        const size_t o = (size_t)(row + row_off) * D + col0;
#pragma unroll
        for (int j = 0; j < 8; ++j) out[o + j] = ALPHA * base[o + j] + v[j]; } };


namespace pg8 {
#define PG8_LAS __attribute__((address_space(3)))
typedef short bf16x8 __attribute__((ext_vector_type(8)));
constexpr int BM = 256, BK = 64, HALF = 128, HTB = HALF * BK * 2, STAGE_BYTES = 8 * HTB, NXCD = 8, WGM = 8;
__host__ __device__ __forceinline__ int lds_byte(int r, int c) { const int st = (r >> 4) * 2 + (c >> 5), rr = r & 15, cc = c & 31, ob = rr * 64 + cc * 2; return st * 1024 + (ob ^ (((ob >> 9) & 1) << 5)); }
__host__ __device__ __forceinline__ void stage_rc(int b, int& R, int& C) { const int st = b / 1024, sb = b % 1024, swz = sb ^ (((sb >> 9) & 1) << 5); R = (st >> 1) * 16 + swz / 64; C = (st & 1) * 32 + (swz % 64) / 2; }
__host__ __device__ __forceinline__ int perm32(int rho) { const int n = rho >> 4, i = rho & 15; return 8 * (i >> 2) + 4 * n + (i & 3); }
struct Unit { int pm, pn; };
struct Gemm { const bf16_t* A; const bf16_t* Bt; int M, N, K, lda; };
struct StaticOrder {
    int nM, nN, nwg, G, c;
    __host__ __device__ void init(int M, int N, int G_, int c_) { nM = M / BM; nN = N / BM; nwg = nM * nN; G = G_; c = c_; }
    __host__ __device__ bool next(int i, Unit& u) const {
        const long L = (long)i * G + c; if (L >= nwg) return false;
        int wgid = (int)L; { const int q = nwg / NXCD, r = nwg % NXCD, xcd = wgid % NXCD, off = wgid / NXCD; wgid = (xcd < r ? xcd * (q + 1) : r * (q + 1) + (xcd - r) * q) + off; }
        const int nig = WGM * nN, gid = wgid / nig, fm = gid * WGM, gsz = (nM - fm) < WGM ? (nM - fm) : WGM;
        u.pm = fm + ((wgid % nig) % gsz); u.pn = (wgid % nig) / gsz; return true;
    }
};
template <class F> struct EpiAdapt {
    static constexpr bool PERM = true, AFTER_DRAIN = false; F f;
    __device__ __forceinline__ void operator()(const f32x4 (&acc)[2][2][4][2], const Unit& u, int wr, int wc, int fr, int fq) const {
#pragma unroll
        for (int ai = 0; ai < 2; ++ai)
#pragma unroll
            for (int m = 0; m < 4; ++m) { const int row = u.pm * BM + ai * HALF + wr * 64 + m * 16 + fr;
#pragma unroll
                for (int bj = 0; bj < 2; ++bj) { const int col0 = u.pn * BM + bj * HALF + wc * 32 + 8 * fq;
                    const f32x4 a = acc[ai][bj][m][0], b = acc[ai][bj][m][1]; const float v[8] = {a[0], a[1], a[2], a[3], b[0], b[1], b[2], b[3]};
                    f(row, col0, v); } }
    }
};
template <class Epi, class Sched, bool ALIGN_EPI>
__device__ __forceinline__ void gemm_phase(PG8_LAS unsigned char* lds, const Gemm g, const Sched& S, const Epi& E) {
    const int tid = opaque_tid(), wid = __builtin_amdgcn_readfirstlane(tid >> 6), lane = tid & 63, wr = wid >> 2, wc = wid & 3, fr = lane & 15, fq = lane >> 4;
    const int K = g.K, nt = K / BK, lda = g.lda;
    unsigned voffA[2], voffB[2];
#pragma unroll
    for (int i = 0; i < 2; ++i) { int R, C; stage_rc(tid * 16 + i * 8192, R, C); const int Rb = Epi::PERM ? ((R & ~31) + perm32(R & 31)) : R;
        voffA[i] = (unsigned)(R * lda + C) * 2u; voffB[i] = (unsigned)(Rb * K + C) * 2u; }
    const size_t kstep = (size_t)(BK * 2);
    const size_t hstepA = (size_t)HALF * lda * 2, hstepB = (size_t)HALF * K * 2;
    const size_t tstepA = 2 * hstepA, tstepB = 2 * hstepB;
    const unsigned ldsw = (unsigned)wid * 1024u;
    const int aoff = lds_byte(wr * 64 + fr, fq * 8), boff = lds_byte(wc * 32 + fr, fq * 8);
#define PG8_SA(b, h) (((b) * 2 + (h)) * HTB)
#define PG8_SB(b, h) ((4 + (b) * 2 + (h)) * HTB)
#define PG8_STAGE(bufoff, gbase, voff) do { _Pragma("unroll") for (int _i = 0; _i < 2; ++_i) \
        __builtin_amdgcn_global_load_lds((const unsigned*)((const char*)(gbase) + (voff)[_i]), (PG8_LAS unsigned*)(lds + (bufoff) + ldsw + _i * 8192), 16, 0, 0); } while (0)
#define PG8_LDA(dst, b, h) do { _Pragma("unroll") for (int m = 0; m < 4; ++m) _Pragma("unroll") for (int k = 0; k < 2; ++k) dst[m][k] = *(const PG8_LAS bf16x8*)(lds + PG8_SA(b, h) + aoff + m * 2048 + k * 1024); } while (0)
#define PG8_LDB(dst, b, h) do { _Pragma("unroll") for (int n = 0; n < 2; ++n) _Pragma("unroll") for (int k = 0; k < 2; ++k) dst[n][k] = *(const PG8_LAS bf16x8*)(lds + PG8_SB(b, h) + boff + n * 2048 + k * 1024); } while (0)
#define PG8_MMA(ai, bj, At, Bt) do { __builtin_amdgcn_s_setprio(1); _Pragma("unroll") for (int m = 0; m < 4; ++m) _Pragma("unroll") for (int n = 0; n < 2; ++n) _Pragma("unroll") for (int k = 0; k < 2; ++k) \
        acc[ai][bj][m][n] = __builtin_amdgcn_mfma_f32_16x16x32_bf16(Bt[n][k], At[m][k], acc[ai][bj][m][n], 0, 0, 0); __builtin_amdgcn_s_setprio(0); } while (0)
#define PG8_WAIT_V(n) asm volatile("s_waitcnt vmcnt(" #n ")" ::: "memory")
#define PG8_WAIT_L(n) asm volatile("s_waitcnt lgkmcnt(" #n ")" ::: "memory")
#define PG8_BAR __builtin_amdgcn_s_barrier()
#define PG8_SCHED __builtin_amdgcn_sched_barrier(0)
    Unit cur, nxt; int ui = 0;
    if (!S.next(0, cur)) return;
    f32x4 acc[2][2][4][2];
#pragma unroll
    for (int a = 0; a < 2; ++a)
#pragma unroll
        for (int b = 0; b < 2; ++b)
#pragma unroll
            for (int m = 0; m < 4; ++m)
#pragma unroll
                for (int n = 0; n < 2; ++n) acc[a][b][m][n] = (f32x4){0.f, 0.f, 0.f, 0.f};
    bf16x8 At[4][2], B0[2][2], B1[2][2];
    const char* cA = (const char*)g.A + (size_t)cur.pm * tstepA; const char* cB = (const char*)g.Bt + (size_t)cur.pn * tstepB;
    PG8_STAGE(PG8_SB(0, 0), cB, voffB); PG8_STAGE(PG8_SB(0, 1), cB + hstepB, voffB); PG8_STAGE(PG8_SA(0, 0), cA, voffA); PG8_STAGE(PG8_SA(0, 1), cA + hstepA, voffA);
    if (wr == 1) PG8_BAR;
    PG8_WAIT_V(2); PG8_BAR;
    PG8_STAGE(PG8_SB(1, 0), cB + kstep, voffB); PG8_STAGE(PG8_SA(1, 0), cA + kstep, voffA); PG8_STAGE(PG8_SB(1, 1), cB + hstepB + kstep, voffB);
    PG8_WAIT_V(6); PG8_BAR;
    for (;;) {
        const bool has_next = S.next(ui + 1, nxt);
        const char* nA = has_next ? (const char*)g.A + (size_t)nxt.pm * tstepA : cA; const char* nB = has_next ? (const char*)g.Bt + (size_t)nxt.pn * tstepB : cB;
        for (int t = 0; t < nt; t += 2) {
            const bool last = (t == nt - 2);
            const char* a1 = cA + (size_t)(t + 1) * kstep;
            const char* a2 = last ? nA : cA + (size_t)(t + 2) * kstep; const char* b2 = last ? nB : cB + (size_t)(t + 2) * kstep;
            const char* a3 = a2 + kstep; const char* b3 = b2 + kstep;
            PG8_LDB(B0, 0, 0); PG8_LDB(B1, 0, 1); PG8_SCHED; PG8_LDA(At, 0, 0); PG8_STAGE(PG8_SA(1, 1), a1 + hstepA, voffA);
            PG8_WAIT_V(8); PG8_WAIT_L(0); PG8_BAR; PG8_MMA(0, 0, At, B0); PG8_MMA(0, 1, At, B1); PG8_BAR; PG8_SCHED;
            PG8_LDA(At, 0, 1); PG8_STAGE(PG8_SB(0, 0), b2, voffB); PG8_STAGE(PG8_SB(0, 1), b2 + hstepB, voffB); PG8_STAGE(PG8_SA(0, 0), a2, voffA);
            PG8_WAIT_V(8); PG8_WAIT_L(0); PG8_BAR; PG8_MMA(1, 0, At, B0); PG8_MMA(1, 1, At, B1); PG8_BAR; PG8_SCHED;
            PG8_LDB(B0, 1, 0); PG8_LDB(B1, 1, 1); PG8_SCHED; PG8_LDA(At, 1, 0); PG8_STAGE(PG8_SA(0, 1), a2 + hstepA, voffA);
            PG8_WAIT_V(8); PG8_WAIT_L(0); PG8_BAR; PG8_MMA(0, 0, At, B0); PG8_MMA(0, 1, At, B1); PG8_BAR; PG8_SCHED;
            PG8_LDA(At, 1, 1); PG8_STAGE(PG8_SB(1, 0), b3, voffB); PG8_STAGE(PG8_SB(1, 1), b3 + hstepB, voffB); PG8_STAGE(PG8_SA(1, 0), a3, voffA);
            PG8_WAIT_V(8); PG8_WAIT_L(0); PG8_BAR; PG8_MMA(1, 0, At, B0); PG8_MMA(1, 1, At, B1); PG8_BAR; PG8_SCHED;
        }
        if constexpr (ALIGN_EPI) { if (wr == 0) PG8_BAR; }
        E(acc, cur, wr, wc, fr, fq);
        if (!has_next) break;
#pragma unroll
        for (int a = 0; a < 2; ++a)
#pragma unroll
            for (int b = 0; b < 2; ++b)
#pragma unroll
                for (int m = 0; m < 4; ++m)
#pragma unroll
                    for (int n = 0; n < 2; ++n) acc[a][b][m][n] = (f32x4){0.f, 0.f, 0.f, 0.f};
        cur = nxt; cA = nA; cB = nB; ++ui;
        if constexpr (ALIGN_EPI) { if (wr == 1) PG8_BAR; }
    }
    PG8_WAIT_V(0);
    if constexpr (!ALIGN_EPI) { if (wr == 0) PG8_BAR; }
    PG8_BAR;
#undef PG8_SA
#undef PG8_SB
#undef PG8_STAGE
#undef PG8_LDA
#undef PG8_LDB
#undef PG8_MMA
#undef PG8_WAIT_V
#undef PG8_WAIT_L
#undef PG8_BAR
#undef PG8_SCHED
}
}
constexpr int LDS_BYTES = 148480;
namespace dattn {
#define DA_LAS __attribute__((address_space(3)))
typedef short bf16x8 __attribute__((ext_vector_type(8)));
typedef short s16x4 __attribute__((ext_vector_type(4)));
typedef float f32x16 __attribute__((ext_vector_type(16)));
constexpr int KP = 272, VP = 320, KBUF = 64 * KP, VBUF = 64 * VP, BUF = KBUF + VBUF, XOFF = 2 * BUF, LDS_NEED = XOFF + 65536;
static_assert(LDS_NEED <= 147456, "attention LDS");
__device__ __forceinline__ unsigned cvtpk(float lo, float hi) { typedef float f2 __attribute__((ext_vector_type(2))); typedef __bf16 b2 __attribute__((ext_vector_type(2))); f2 v = {lo, hi}; b2 b = __builtin_convertvector(v, b2); return __builtin_bit_cast(unsigned, b); }
__device__ __forceinline__ s16x4 vtr(const DA_LAS unsigned char* p) { typedef short v4i16_t __attribute__((ext_vector_type(4))); return __builtin_bit_cast(s16x4, __builtin_amdgcn_ds_read_tr16_b64_v4i16((DA_LAS v4i16_t*)p)); }
template <bool STORE = true> __device__ __forceinline__ void unit(DA_LAS unsigned char* lds, bf16_t* Hb, int h, int qb, const float* __restrict__ subln_w, float lam) {
    const int tid = opaque_tid(), lane = tid & 63, w = __builtin_amdgcn_readfirstlane(tid >> 6), mp = w >> 2, rb = w & 3, c32 = lane & 31, hh = lane >> 5;
    const int qrow = 128 * qb + 32 * rb + c32;
    bf16x8 qf[4];
    { const bf16_t* qp = Hb + (size_t)qrow * HP_ + HC_Q + h * 128 + 64 * mp + 8 * hh;
#pragma unroll
      for (int s = 0; s < 4; ++s) qf[s] = *(const bf16x8*)(qp + 16 * s); }
    const int srow = tid >> 4, sch = tid & 15;
    const bf16_t* kg = Hb + HC_K + h * 128 + sch * 8; const bf16_t* vg = Hb + HC_V + h * 128 + sch * 8;
    const int nt = 2 * qb + 2;
    u32x4 kr[2], vr[2];
#define DA_LOAD(t) do { _Pragma("unroll") for (int j = 0; j < 2; ++j) { const size_t ro = (size_t)(64 * (t) + srow + 32 * j) * HP_; kr[j] = *(const u32x4*)(kg + ro); vr[j] = *(const u32x4*)(vg + ro); } } while (0)
#define DA_WRITE(buf) do { _Pragma("unroll") for (int j = 0; j < 2; ++j) { *(DA_LAS u32x4*)(lds + (buf) * BUF + (srow + 32 * j) * KP + sch * 16) = kr[j]; *(DA_LAS u32x4*)(lds + (buf) * BUF + KBUF + (srow + 32 * j) * VP + sch * 16) = vr[j]; } } while (0)
    DA_LOAD(0); DA_WRITE(0);
    __syncthreads();
    f32x16 oT[4];
#pragma unroll
    for (int i = 0; i < 4; ++i) oT[i] = (f32x16){0.f, 0.f, 0.f, 0.f, 0.f, 0.f, 0.f, 0.f, 0.f, 0.f, 0.f, 0.f, 0.f, 0.f, 0.f, 0.f};
    float mrow = -INFINITY, lrow = 0.f;
    const int koff = c32 * KP + (64 * mp + 8 * hh) * 2;
    const int voff = KBUF + (4 * hh + ((lane & 15) >> 2)) * VP + (16 * ((lane >> 4) & 1) + 4 * (lane & 3)) * 2;
    for (int t = 0; t < nt; ++t) {
        const int cur = t & 1;
        if (t + 1 < nt) DA_LOAD(t + 1);
        if (!(t == nt - 1 && rb <= 1)) {
            const DA_LAS unsigned char* kb = lds + cur * BUF + koff;
            f32x16 s0 = (f32x16){0.f, 0.f, 0.f, 0.f, 0.f, 0.f, 0.f, 0.f, 0.f, 0.f, 0.f, 0.f, 0.f, 0.f, 0.f, 0.f}, s1 = s0;
            bf16x8 kf0[4], kf1[4];
#pragma unroll
            for (int s = 0; s < 4; ++s) { kf0[s] = *(const DA_LAS bf16x8*)(kb + s * 32); kf1[s] = *(const DA_LAS bf16x8*)(kb + 32 * KP + s * 32); }
            __builtin_amdgcn_s_setprio(1);
#pragma unroll
            for (int s = 0; s < 4; ++s) {
                s0 = __builtin_amdgcn_mfma_f32_32x32x16_bf16(kf0[s], qf[s], s0, 0, 0, 0);
                s1 = __builtin_amdgcn_mfma_f32_32x32x16_bf16(kf1[s], qf[s], s1, 0, 0, 0);
            }
            __builtin_amdgcn_s_setprio(0);
            if (t >= nt - 2) {
                const int k0 = 64 * t + 4 * hh;
#pragma unroll
                for (int r = 0; r < 16; ++r) { const int key = k0 + (r & 3) + 8 * (r >> 2); if (key > qrow) s0[r] = -INFINITY; if (key + 32 > qrow) s1[r] = -INFINITY; }
            }
            float mx = fmaxf(s0[0], s1[0]);
#pragma unroll
            for (int r = 1; r < 16; ++r) mx = fmaxf(mx, fmaxf(s0[r], s1[r]));
            mx = fmaxf(mx, __shfl_xor(mx, 32));
            if (__any(mx > mrow + 8.f)) {
                const float mnew = fmaxf(mrow, mx), alpha = __builtin_amdgcn_exp2f(mrow - mnew);
                mrow = mnew; lrow *= alpha;
#pragma unroll
                for (int i = 0; i < 4; ++i)
#pragma unroll
                    for (int r = 0; r < 16; ++r) oT[i][r] *= alpha;
            }
            float ps = 0.f;
#pragma unroll
            for (int r = 0; r < 16; ++r) { s0[r] = __builtin_amdgcn_exp2f(s0[r] - mrow); s1[r] = __builtin_amdgcn_exp2f(s1[r] - mrow); ps += s0[r] + s1[r]; }
            lrow += ps;
            bf16x8 pf[2][2];
#pragma unroll
            for (int s = 0; s < 2; ++s) {
                u32x4 a, b;
                a.x = cvtpk(s0[8 * s], s0[8 * s + 1]); a.y = cvtpk(s0[8 * s + 2], s0[8 * s + 3]); a.z = cvtpk(s0[8 * s + 4], s0[8 * s + 5]); a.w = cvtpk(s0[8 * s + 6], s0[8 * s + 7]);
                b.x = cvtpk(s1[8 * s], s1[8 * s + 1]); b.y = cvtpk(s1[8 * s + 2], s1[8 * s + 3]); b.z = cvtpk(s1[8 * s + 4], s1[8 * s + 5]); b.w = cvtpk(s1[8 * s + 6], s1[8 * s + 7]);
                pf[0][s] = __builtin_bit_cast(bf16x8, a); pf[1][s] = __builtin_bit_cast(bf16x8, b);
            }
            const DA_LAS unsigned char* vb = lds + cur * BUF + voff;
#define DA_LDV(dst, db) do { _Pragma("unroll") for (int i_ = 0; i_ < 4; ++i_) { const s16x4 lo_ = vtr(vb + (16 * i_) * VP + (db) * 64), hi_ = vtr(vb + (16 * i_ + 8) * VP + (db) * 64); \
                dst[i_] = (bf16x8){lo_[0], lo_[1], lo_[2], lo_[3], hi_[0], hi_[1], hi_[2], hi_[3]}; } } while (0)
#define DA_MM(src, db) do { _Pragma("unroll") for (int i_ = 0; i_ < 4; ++i_) oT[db] = __builtin_amdgcn_mfma_f32_32x32x16_bf16(src[i_], pf[i_ >> 1][i_ & 1], oT[db], 0, 0, 0); } while (0)
            bf16x8 va[4], vq[4];
            DA_LDV(va, 0);
            DA_LDV(vq, 1); __builtin_amdgcn_s_setprio(1); DA_MM(va, 0); __builtin_amdgcn_s_setprio(0);
            DA_LDV(va, 2); __builtin_amdgcn_s_setprio(1); DA_MM(vq, 1); __builtin_amdgcn_s_setprio(0);
            DA_LDV(vq, 3); __builtin_amdgcn_s_setprio(1); DA_MM(va, 2); __builtin_amdgcn_s_setprio(0);
            __builtin_amdgcn_s_setprio(1); DA_MM(vq, 3);
#undef DA_LDV
#undef DA_MM
            __builtin_amdgcn_s_setprio(0);
        }
        if (t + 1 < nt) DA_WRITE(cur ^ 1);
        __syncthreads();
    }
#undef DA_LOAD
#undef DA_WRITE
    const float inv = 1.f / (lrow + __shfl_xor(lrow, 32));
    DA_LAS float* X = (DA_LAS float*)(lds + XOFF) + rb * 4096 + lane;
    if (mp == 1) {
#pragma unroll
        for (int i = 0; i < 4; ++i)
#pragma unroll
            for (int r = 0; r < 16; ++r) X[(i * 16 + r) * 64] = oT[i][r] * inv;
    }
    __syncthreads();
    if (mp == 0) {
        float ss = 0.f;
#pragma unroll
        for (int i = 0; i < 4; ++i)
#pragma unroll
            for (int r = 0; r < 16; ++r) { const float o = oT[i][r] * inv - lam * X[(i * 16 + r) * 64]; oT[i][r] = o; ss += o * o; }
        ss += __shfl_xor(ss, 32);
        const float rr = rsqrtf(ss * (1.f / 128.f) + 1e-5f) * (1.f - LAMBDA_INIT);
        bf16_t* op = Hb + (size_t)qrow * HP_ + HC_Q + h * 128 + 4 * hh;
#pragma unroll
        for (int i = 0; i < 4; ++i)
#pragma unroll
            for (int g = 0; g < 4; ++g) { const int d0 = 32 * i + 8 * g; const f32x4 sw = *(const f32x4*)(subln_w + d0 + 4 * hh);
                uint2 o; o.x = pk2(oT[i][4 * g] * rr * sw.x, oT[i][4 * g + 1] * rr * sw.y); o.y = pk2(oT[i][4 * g + 2] * rr * sw.z, oT[i][4 * g + 3] * rr * sw.w);
                if (STORE || o.x == 0x12345u) *(uint2*)(op + d0) = o; }
    }
    __syncthreads();
}
}
namespace ssd {
#define SS_LAS __attribute__((address_space(3)))
typedef short bf16x8 __attribute__((ext_vector_type(8)));
typedef short s16x4 __attribute__((ext_vector_type(4)));
typedef float f32x16 __attribute__((ext_vector_type(16)));
constexpr int XP = 192;
constexpr int BPT = 320;
constexpr int CP = 272;
__device__ __forceinline__ s16x4 vtr(const SS_LAS unsigned char* p) { typedef short v4i16_t __attribute__((ext_vector_type(4))); return __builtin_bit_cast(s16x4, __builtin_amdgcn_ds_read_tr16_b64_v4i16((SS_LAS v4i16_t*)p)); }
__device__ __forceinline__ unsigned cvtpk(float lo, float hi) { typedef float f2 __attribute__((ext_vector_type(2))); typedef __bf16 b2 __attribute__((ext_vector_type(2))); f2 v = {lo, hi}; b2 b = __builtin_convertvector(v, b2); return __builtin_bit_cast(unsigned, b); }
__device__ __forceinline__ void acs_tables(SS_LAS float* ACS, SS_LAS float* DTS, const float* __restrict__ DTb, const float* __restrict__ a_log, int c, int g) {
    const int tid_ = opaque_tid(); const int lane = tid_ & 63, e = __builtin_amdgcn_readfirstlane(tid_ >> 6), h = 8 * g + e;
    const float a = -expf(a_log[h]);
    const float d0 = DTb[(size_t)(128 * c + 2 * lane) * 32 + h], d1 = DTb[(size_t)(128 * c + 2 * lane + 1) * 32 + h];
    const float a0 = d0 * a, a1 = d1 * a;
    float sc = a0 + a1;
#pragma unroll
    for (int o = 1; o < 64; o <<= 1) { const float v = __shfl_up(sc, o); if (lane >= o) sc += v; }
    const float ex = sc - (a0 + a1);
    ACS[(2 * lane) * 8 + e] = ex + a0; ACS[(2 * lane + 1) * 8 + e] = ex + a0 + a1;
    DTS[(2 * lane) * 8 + e] = d0; DTS[(2 * lane + 1) * 8 + e] = d1;
}
template <int NT, class F> __device__ __forceinline__ void conv_item(const bf16_t* __restrict__ Hb, int t0, int l0, int xch0, const float* __restrict__ conv_w, const float* __restrict__ conv_b, F sink) {
    float w[4][8], bias[8];
#pragma unroll
    for (int j = 0; j < 4; ++j) { const f32x4 a = *(const f32x4*)(conv_w + j * DXBC + xch0), b = *(const f32x4*)(conv_w + j * DXBC + xch0 + 4); w[j][0] = a.x; w[j][1] = a.y; w[j][2] = a.z; w[j][3] = a.w; w[j][4] = b.x; w[j][5] = b.y; w[j][6] = b.z; w[j][7] = b.w; }
    { const f32x4 a = *(const f32x4*)(conv_b + xch0), b = *(const f32x4*)(conv_b + xch0 + 4); bias[0] = a.x; bias[1] = a.y; bias[2] = a.z; bias[3] = a.w; bias[4] = b.x; bias[5] = b.y; bias[6] = b.z; bias[7] = b.w; }
    const bf16_t* src = Hb + HC_XBC + xch0;
    u32x4 rw[NT + 3];
#pragma unroll
    for (int i = 0; i < NT + 3; ++i) { const int tt = t0 + l0 - 3 + i; rw[i] = *(const u32x4*)(src + (size_t)(tt < 0 ? 0 : tt) * HP_); }
    if (t0 + l0 < 3) {
#pragma unroll
        for (int i = 0; i < 3; ++i) if (t0 + l0 - 3 + i < 0) rw[i] = (u32x4){0u, 0u, 0u, 0u};
    }
#define SS_UNP(dst, q_) do { dst[0] = bflo(q_.x); dst[1] = bfhi(q_.x); dst[2] = bflo(q_.y); dst[3] = bfhi(q_.y); dst[4] = bflo(q_.z); dst[5] = bfhi(q_.z); dst[6] = bflo(q_.w); dst[7] = bfhi(q_.w); } while (0)
    float x0[8], x1[8], x2[8];
    SS_UNP(x0, rw[0]); SS_UNP(x1, rw[1]); SS_UNP(x2, rw[2]);
#pragma unroll
    for (int i = 0; i < NT; ++i) {
        float x3[8]; SS_UNP(x3, rw[3 + i]);
        float v[8];
#pragma unroll
        for (int k = 0; k < 8; ++k) { const float a = bias[k] + w[0][k] * x0[k] + w[1][k] * x1[k] + w[2][k] * x2[k] + w[3][k] * x3[k]; v[k] = a * __builtin_amdgcn_rcpf(1.f + __expf(-a)); x0[k] = x1[k]; x1[k] = x2[k]; x2[k] = x3[k]; }
        sink(l0 + i, v);
    }
#undef SS_UNP
}
constexpr int A_BS = 0, A_XD = 128 * BPT  , A_ACS = A_XD + 2 * 128 * XP  , A_DTS = A_ACS + 4096, A_END = A_DTS + 4096;
__device__ __forceinline__ void phaseA_unit(SS_LAS unsigned char* lds, const bf16_t* __restrict__ Hb, const float* __restrict__ DTb, const float* __restrict__ conv_w, const float* __restrict__ conv_b,
                                            const float* __restrict__ a_log, bf16_t* __restrict__ ST, float* __restrict__ CD, int c, int g) {
    const int tid = opaque_tid(), lane = tid & 63, w = __builtin_amdgcn_readfirstlane(tid >> 6), c32 = lane & 31, hh = lane >> 5;
    SS_LAS float* ACS = (SS_LAS float*)(lds + A_ACS); SS_LAS float* DTS = (SS_LAS float*)(lds + A_DTS);
    acs_tables(ACS, DTS, DTb, a_log, c, g);
    __syncthreads();
    if (tid < 8) CD[c * 32 + 8 * g + tid] = __expf(ACS[127 * 8 + tid]);
    auto stageX = [&](int e, int item, int buf) {
        const int cg = item >> 5, seg = item & 31; const float aend = ACS[127 * 8 + e];
        conv_item<4>(Hb, 128 * c, 4 * seg, g * 512 + e * 64 + cg * 8, conv_w, conv_b, [&](int l, const float (&v)[8]) {
            const float sc = DTS[l * 8 + e] * __expf(aend - ACS[l * 8 + e]);
            u32x4 o; o.x = cvtpk(v[0] * sc, v[1] * sc); o.y = cvtpk(v[2] * sc, v[3] * sc); o.z = cvtpk(v[4] * sc, v[5] * sc); o.w = cvtpk(v[6] * sc, v[7] * sc);
            *(SS_LAS u32x4*)(lds + A_XD + buf * 128 * XP + l * XP + cg * 16) = o; });
    };
    { const int cg = tid >> 5, seg = tid & 31;
        conv_item<4>(Hb, 128 * c, 4 * seg, 2048 + g * 128 + cg * 8, conv_w, conv_b, [&](int l, const float (&v)[8]) {
            u32x4 o; o.x = cvtpk(v[0], v[1]); o.y = cvtpk(v[2], v[3]); o.z = cvtpk(v[4], v[5]); o.w = cvtpk(v[6], v[7]);
            *(SS_LAS u32x4*)(lds + A_BS + l * BPT + cg * 16) = o; }); }
    if (tid < 256) stageX(0, tid, 0);
    __syncthreads();
    const int pb = w & 1, nb = w >> 1;
    const int rsel = ((lane & 15) >> 2), csel = 16 * ((lane >> 4) & 1) + 4 * (lane & 3);
    for (int e = 0; e < 8; ++e) {
        if (e + 1 < 8 && tid >= 256) stageX(e + 1, tid - 256, (e + 1) & 1);
        f32x16 acc = (f32x16){0.f, 0.f, 0.f, 0.f, 0.f, 0.f, 0.f, 0.f, 0.f, 0.f, 0.f, 0.f, 0.f, 0.f, 0.f, 0.f};
        const SS_LAS unsigned char* bp = lds + A_BS + (8 * hh + rsel) * BPT + (32 * nb + csel) * 2;
        const SS_LAS unsigned char* xp = lds + A_XD + (e & 1) * 128 * XP + (8 * hh + rsel) * XP + (32 * pb + csel) * 2;
#pragma unroll
        for (int ks = 0; ks < 8; ++ks) {
            const s16x4 b0 = vtr(bp + (16 * ks) * BPT), b1 = vtr(bp + (16 * ks + 4) * BPT), x0 = vtr(xp + (16 * ks) * XP), x1 = vtr(xp + (16 * ks + 4) * XP);
            const bf16x8 bf = (bf16x8){b0[0], b0[1], b0[2], b0[3], b1[0], b1[1], b1[2], b1[3]}, xf = (bf16x8){x0[0], x0[1], x0[2], x0[3], x1[0], x1[1], x1[2], x1[3]};
            acc = __builtin_amdgcn_mfma_f32_32x32x16_bf16(bf, xf, acc, 0, 0, 0);
        }
        bf16_t* sp = ST + ((size_t)(c * 32 + 8 * g + e) * 64 + 32 * pb + c32) * 128 + 32 * nb + 4 * hh;
#pragma unroll
        for (int q = 0; q < 4; ++q) { uint2 o; o.x = cvtpk(acc[4 * q], acc[4 * q + 1]); o.y = cvtpk(acc[4 * q + 2], acc[4 * q + 3]); *(uint2*)(sp + 8 * q) = o; }
        __syncthreads();
    }
}
__device__ __forceinline__ void scan_phase(bf16_t* __restrict__ ST, const float* __restrict__ CD, int gtid) {
    const int h = gtid >> 12;
    unsigned* p = (unsigned*)ST + gtid;
    float r0 = 0.f, r1 = 0.f;
    for (int c0 = 0; c0 < 64; c0 += 16) {
        unsigned v[16]; float d[16];
#pragma unroll
        for (int i = 0; i < 16; ++i) { v[i] = p[(size_t)(c0 + i) * 131072]; d[i] = CD[(c0 + i) * 32 + h]; }
#pragma unroll
        for (int i = 0; i < 16; ++i) { p[(size_t)(c0 + i) * 131072] = cvtpk(r0, r1); r0 = r0 * d[i] + bflo(v[i]); r1 = r1 * d[i] + bfhi(v[i]); }
    }
}
constexpr int C_CS = 0, C_BS = 128 * CP  , C_X1 = C_BS  , C_CBT = 2 * 128 * CP  , C_X0 = C_CBT + 32768  , C_ACS = C_X0 + 128 * XP  , C_DTS = C_ACS + 4096,
              C_SSQ = C_DTS + 4096, C_END = C_SSQ + 1024;
static_assert(C_END <= 147456 && 128 * XP <= 128 * CP, "ssd phase C LDS");
template <bool STORE = true> __device__ __forceinline__ void phaseC_unit(SS_LAS unsigned char* lds, bf16_t* __restrict__ Hb, const float* __restrict__ DTb, const float* __restrict__ conv_w, const float* __restrict__ conv_b,
                                            const float* __restrict__ a_log, const float* __restrict__ d_skip, const float* __restrict__ norm_w, const bf16_t* __restrict__ ST, int c, int g) {
    const int tid = opaque_tid(), lane = tid & 63, w = __builtin_amdgcn_readfirstlane(tid >> 6), c32 = lane & 31, hh = lane >> 5;
    SS_LAS float* ACS = (SS_LAS float*)(lds + C_ACS); SS_LAS float* DTS = (SS_LAS float*)(lds + C_DTS); SS_LAS float* SSQ = (SS_LAS float*)(lds + C_SSQ);
    acs_tables(ACS, DTS, DTb, a_log, c, g);
    auto stageX = [&](int e, int item, int buf) {
        const int cg = item >> 5, seg = item & 31;
        conv_item<4>(Hb, 128 * c, 4 * seg, g * 512 + e * 64 + cg * 8, conv_w, conv_b, [&](int l, const float (&v)[8]) {
            u32x4 o; o.x = cvtpk(v[0], v[1]); o.y = cvtpk(v[2], v[3]); o.z = cvtpk(v[4], v[5]); o.w = cvtpk(v[6], v[7]);
            *(SS_LAS u32x4*)(lds + (buf ? C_X1 : C_X0) + l * XP + cg * 16) = o; });
    };
    { const int isC = tid >> 8, it = tid & 255, cg = it >> 4, seg = it & 15;
        conv_item<8>(Hb, 128 * c, 8 * seg, 2048 + isC * 512 + g * 128 + cg * 8, conv_w, conv_b, [&](int l, const float (&v)[8]) {
            u32x4 o; o.x = cvtpk(v[0], v[1]); o.y = cvtpk(v[2], v[3]); o.z = cvtpk(v[4], v[5]); o.w = cvtpk(v[6], v[7]);
            *(SS_LAS u32x4*)(lds + (isC ? C_CS : C_BS) + l * CP + cg * 16) = o; }); }
    if (tid < 256) stageX(0, tid, 0);
    __syncthreads();
    for (int i = w; i < 10; i += 8) {
        const int sb = (i < 4) ? 0 : (i < 7) ? 1 : (i < 9) ? 2 : 3, lb = (i < 4) ? i : (i < 7) ? i - 3 : (i < 9) ? i - 5 : 3;
        f32x16 acc = (f32x16){0.f, 0.f, 0.f, 0.f, 0.f, 0.f, 0.f, 0.f, 0.f, 0.f, 0.f, 0.f, 0.f, 0.f, 0.f, 0.f};
        const SS_LAS unsigned char* bp = lds + C_BS + (32 * sb + c32) * CP + 16 * hh, *cp = lds + C_CS + (32 * lb + c32) * CP + 16 * hh;
#pragma unroll
        for (int ks = 0; ks < 8; ++ks) acc = __builtin_amdgcn_mfma_f32_32x32x16_bf16(*(const SS_LAS bf16x8*)(bp + 32 * ks), *(const SS_LAS bf16x8*)(cp + 32 * ks), acc, 0, 0, 0);
        SS_LAS unsigned* o = (SS_LAS unsigned*)(lds + C_CBT) + (sb * 4 + lb) * 512 + lane;
#pragma unroll
        for (int q = 0; q < 8; ++q) o[q * 64] = cvtpk(acc[2 * q], acc[2 * q + 1]);
    }
    __syncthreads();
    const int pb = w & 1, lb = w >> 1, lrow = 32 * lb + c32;
    const int rsel = ((lane & 15) >> 2), csel = 16 * ((lane >> 4) & 1) + 4 * (lane & 3);
    unsigned ypk[8][8];
    float ssq = 0.f;
    for (int e = 0; e < 8; ++e) {
        const int h = 8 * g + e;
        if (e + 1 < 8 && tid >= 256) stageX(e + 1, tid - 256, (e + 1) & 1);
        const int xoff = (e & 1) ? C_X1 : C_X0;
        f32x16 acc = (f32x16){0.f, 0.f, 0.f, 0.f, 0.f, 0.f, 0.f, 0.f, 0.f, 0.f, 0.f, 0.f, 0.f, 0.f, 0.f, 0.f};
        {
            const bf16_t* pp = ST + ((size_t)(c * 32 + h) * 64 + 32 * pb + c32) * 128 + 8 * hh;
            const SS_LAS unsigned char* cp = lds + C_CS + lrow * CP + 16 * hh;
#pragma unroll
            for (int ks = 0; ks < 8; ++ks) acc = __builtin_amdgcn_mfma_f32_32x32x16_bf16(*(const bf16x8*)(pp + 16 * ks), *(const SS_LAS bf16x8*)(cp + 32 * ks), acc, 0, 0, 0);
        }
        const float al = ACS[lrow * 8 + e], eal = __expf(al);
#pragma unroll
        for (int r = 0; r < 16; ++r) acc[r] *= eal;
        for (int sb = 0; sb <= lb; ++sb) {
            const SS_LAS unsigned* cbp = (const SS_LAS unsigned*)(lds + C_CBT) + (sb * 4 + lb) * 512 + lane;
            float m[16];
#pragma unroll
            for (int q = 0; q < 8; ++q) { const unsigned u = cbp[q * 64]; m[2 * q] = bflo(u); m[2 * q + 1] = bfhi(u); }
#pragma unroll
            for (int r = 0; r < 16; ++r) { const int srow = 32 * sb + (r & 3) + 8 * (r >> 2) + 4 * hh;
                const float f = __expf(al - ACS[srow * 8 + e]) * DTS[srow * 8 + e];
                m[r] = (srow <= lrow) ? m[r] * f : 0.f; }
            const SS_LAS unsigned char* xp = lds + xoff + (32 * sb + 4 * hh + rsel) * XP + (32 * pb + csel) * 2;
#pragma unroll
            for (int ks = 0; ks < 2; ++ks) {
                const s16x4 x0 = vtr(xp + (16 * ks) * XP), x1 = vtr(xp + (16 * ks + 8) * XP);
                const bf16x8 xf = (bf16x8){x0[0], x0[1], x0[2], x0[3], x1[0], x1[1], x1[2], x1[3]};
                u32x4 mm; mm.x = cvtpk(m[8 * ks], m[8 * ks + 1]); mm.y = cvtpk(m[8 * ks + 2], m[8 * ks + 3]); mm.z = cvtpk(m[8 * ks + 4], m[8 * ks + 5]); mm.w = cvtpk(m[8 * ks + 6], m[8 * ks + 7]);
                acc = __builtin_amdgcn_mfma_f32_32x32x16_bf16(xf, __builtin_bit_cast(bf16x8, mm), acc, 0, 0, 0);
            }
        }
        const float dsk = d_skip[h];
        const bf16_t* zp = Hb + (size_t)(128 * c + lrow) * HP_ + HC_Z + g * 512 + e * 64 + 32 * pb + 4 * hh;
        const SS_LAS unsigned char* xr = lds + xoff + lrow * XP + (32 * pb + 4 * hh) * 2;
        unsigned yt[8];
#pragma unroll
        for (int q = 0; q < 4; ++q) {
            const u32x2 zz = *(const u32x2*)(zp + 8 * q); const u32x2 xx = *(const SS_LAS u32x2*)(xr + 16 * q);
            const float zv[4] = {bflo(zz.x), bfhi(zz.x), bflo(zz.y), bfhi(zz.y)}, xv[4] = {bflo(xx.x), bfhi(xx.x), bflo(xx.y), bfhi(xx.y)};
            float y[4];
#pragma unroll
            for (int k = 0; k < 4; ++k) { y[k] = (acc[4 * q + k] + dsk * xv[k]) * (zv[k] * __builtin_amdgcn_rcpf(1.f + __expf(-zv[k]))); ssq += y[k] * y[k]; }
            yt[2 * q] = cvtpk(y[0], y[1]); yt[2 * q + 1] = cvtpk(y[2], y[3]);
        }
#define SS_YSET(E) case E: { _Pragma("unroll") for (int q_ = 0; q_ < 8; ++q_) ypk[E][q_] = yt[q_]; } break;
        switch (e) { SS_YSET(0) SS_YSET(1) SS_YSET(2) SS_YSET(3) SS_YSET(4) SS_YSET(5) SS_YSET(6) default: { _Pragma("unroll") for (int q_ = 0; q_ < 8; ++q_) ypk[7][q_] = yt[q_]; } break; }
#undef SS_YSET
        __syncthreads();
    }
    ssq += __shfl_xor(ssq, 32);
    if (hh == 0) SSQ[pb * 128 + lrow] = ssq;
    __syncthreads();
    const float rstd = rsqrtf((SSQ[lrow] + SSQ[128 + lrow]) * (1.f / 512.f) + 1e-5f);
    bf16_t* op = Hb + (size_t)(128 * c + lrow) * HP_ + HC_Z + g * 512 + 32 * pb + 4 * hh;
    const float* nw = norm_w + g * 512 + 32 * pb + 4 * hh;
#pragma unroll
    for (int e = 0; e < 8; ++e)
#pragma unroll
        for (int q = 0; q < 4; ++q) { const f32x4 n4 = *(const f32x4*)(nw + e * 64 + 8 * q);
            uint2 o; o.x = cvtpk(bflo(ypk[e][2 * q]) * rstd * n4.x, bfhi(ypk[e][2 * q]) * rstd * n4.y); o.y = cvtpk(bflo(ypk[e][2 * q + 1]) * rstd * n4.z, bfhi(ypk[e][2 * q + 1]) * rstd * n4.w);
            if (STORE || o.x == 0x12345u) *(uint2*)(op + e * 64 + 8 * q) = o; }
    __syncthreads();
}
}


namespace psel {
#define PS_LAS __attribute__((address_space(3)))
typedef short bf16x8 __attribute__((ext_vector_type(8)));
typedef float f32x16 __attribute__((ext_vector_type(16)));
__device__ __forceinline__ int ord(float f) { const int b = __builtin_bit_cast(int, f); return b ^ ((b >> 31) & 0x7fffffff); }
__device__ __forceinline__ float unord(int t) { return __builtin_bit_cast(float, t ^ ((t >> 31) & 0x7fffffff)); }
#define PS_INS(top, v) do { int v_ = (v); _Pragma("unroll") for (int i_ = 0; i_ < 16; ++i_) { const int hi_ = max(top[i_], v_); v_ = min(top[i_], v_); top[i_] = hi_; } } while (0)
__device__ __forceinline__ void step(PS_LAS int* EX, const bf16_t* __restrict__ QP, const bf16_t* __restrict__ SUBK, int* __restrict__ IDX, float* __restrict__ GATE, int tok0, int hp) {
    const int tid = opaque_tid(), lane = tid & 63, w1 = __builtin_amdgcn_readfirstlane(tid >> 6), c32 = lane & 31, hh = lane >> 5;
    {
        const int tile = w1 >> 2, hsel = (w1 >> 1) & 1, half = w1 & 1, h = 2 * hp + hsel;
        const bf16_t* qp = QP + (size_t)(tok0 + 32 * tile + c32) * 2048 + h * 256 + half * 128 + 8 * hh;
        const bf16_t* kp = SUBK + ((size_t)(h * 2 + half) * 128 + c32) * 128 + 8 * hh;
        bf16x8 qf[8];
#pragma unroll
        for (int ks = 0; ks < 8; ++ks) qf[ks] = *(const bf16x8*)(qp + 16 * ks);
        int top[16];
#pragma unroll
        for (int i = 0; i < 16; ++i) top[i] = (int)0x80000000;
        bf16x8 kfa[8], kfb[8];
#define PS_LDK(dst, mt_) do { _Pragma("unroll") for (int ks_ = 0; ks_ < 8; ++ks_) dst[ks_] = *(const bf16x8*)(kp + (size_t)(32 * (mt_)) * 128 + 16 * ks_); } while (0)
#define PS_TILE(src, mt_) do { f32x16 acc_ = (f32x16){0.f, 0.f, 0.f, 0.f, 0.f, 0.f, 0.f, 0.f, 0.f, 0.f, 0.f, 0.f, 0.f, 0.f, 0.f, 0.f}; \
            _Pragma("unroll") for (int ks_ = 0; ks_ < 8; ++ks_) acc_ = __builtin_amdgcn_mfma_f32_32x32x16_bf16(src[ks_], qf[ks_], acc_, 0, 0, 0); \
            _Pragma("unroll") for (int r_ = 0; r_ < 16; ++r_) { const int key_ = 32 * (mt_) + (r_ & 3) + 8 * (r_ >> 2) + 4 * hh; const int v__ = (ord(acc_[r_]) & ~127) | (127 - key_); PS_INS(top, v__); } } while (0)
        PS_LDK(kfa, 0);
        PS_LDK(kfb, 1); PS_TILE(kfa, 0);
        PS_LDK(kfa, 2); PS_TILE(kfb, 1);
        PS_LDK(kfb, 3); PS_TILE(kfa, 2);
        PS_TILE(kfb, 3);
#undef PS_LDK
#undef PS_TILE
        int oth[16];
#pragma unroll
        for (int i = 0; i < 16; ++i) oth[i] = __shfl_xor(top[i], 32);
#pragma unroll
        for (int i = 0; i < 16; ++i) PS_INS(top, oth[i]);
        if (hh == 0) {
#pragma unroll
            for (int i = 0; i < 16; ++i) EX[(w1 * 16 + i) * 32 + c32] = top[i];
        }
    }
    __syncthreads();
    if (lane < 16) {
        const int task = w1 * 16 + lane, th = task >> 5, tok32 = task & 31, tile = th >> 1, hsel = th & 1, h = 2 * hp + hsel;
        const PS_LAS int* ea = EX + ((th * 2 + 0) * 16) * 32 + tok32; const PS_LAS int* eb = EX + ((th * 2 + 1) * 16) * 32 + tok32;
        float as[16], bs[16];
#pragma unroll
        for (int i = 0; i < 16; ++i) { as[i] = unord(ea[i * 32] & ~127); bs[i] = unord(eb[i * 32] & ~127); }
        int top[16];
#pragma unroll
        for (int i = 0; i < 16; ++i) top[i] = (int)0x80000000;
#pragma unroll
        for (int i = 0; i < 16; ++i)
#pragma unroll
            for (int j = 0; j < 16; ++j) if ((i + 1) * (j + 1) <= 16) { const int v = (ord(as[i] + bs[j]) & ~255) | (255 - (i * 16 + j)); PS_INS(top, v); }
        float sc[16]; int id[16];
#pragma unroll
        for (int r = 0; r < 16; ++r) { const int cn = 255 - (top[r] & 255), i = cn >> 4, j = cn & 15; const int pa = ea[i * 32], pb = eb[j * 32];
            sc[r] = unord(pa & ~127) + unord(pb & ~127); id[r] = (127 - (pa & 127)) * 128 + (127 - (pb & 127)); }
        float sum = 0.f; const float mx = sc[0];
#pragma unroll
        for (int r = 0; r < 16; ++r) { sc[r] = __expf(sc[r] - mx); sum += sc[r]; }
        const size_t o = (size_t)(tok0 + 32 * tile + tok32) * 128 + h * 16;
        const float inv = 1.f / sum;
#pragma unroll
        for (int r = 0; r < 16; r += 4) { *(f32x4*)(GATE + o + r) = (f32x4){sc[r] * inv, sc[r + 1] * inv, sc[r + 2] * inv, sc[r + 3] * inv}; *(u32x4*)(IDX + o + r) = (u32x4){(unsigned)id[r], (unsigned)id[r + 1], (unsigned)id[r + 2], (unsigned)id[r + 3]}; }
    }
    __syncthreads();
}
}


namespace xattn {
#define XA_LAS __attribute__((address_space(3)))
typedef short bf16x8 __attribute__((ext_vector_type(8)));
typedef short s16x4 __attribute__((ext_vector_type(4)));
typedef float f32x16 __attribute__((ext_vector_type(16)));
constexpr int RP = 528;
__device__ __forceinline__ unsigned cvtpk(float lo, float hi) { typedef float f2 __attribute__((ext_vector_type(2))); typedef __bf16 b2 __attribute__((ext_vector_type(2))); f2 v = {lo, hi}; b2 b = __builtin_convertvector(v, b2); return __builtin_bit_cast(unsigned, b); }
__device__ __forceinline__ void stage(XA_LAS unsigned char* lds, const bf16_t* __restrict__ src, int pitch, int tid) {
#pragma unroll 4
    for (int i = 0; i < 16; ++i) { const int q = tid + 512 * i, row = q >> 5, ch = q & 31; *(XA_LAS u32x4*)(lds + row * RP + ch * 16) = *(const u32x4*)(src + (size_t)row * pitch + ch * 8); }
}
__device__ __forceinline__ void unit(XA_LAS unsigned char* lds, const bf16_t* __restrict__ QC, const bf16_t* __restrict__ KC, const bf16_t* __restrict__ VcT, bf16_t* __restrict__ XO, int tg, int h) {
    const int tid = opaque_tid(), lane = tid & 63, w = __builtin_amdgcn_readfirstlane(tid >> 6), c32 = lane & 31, hh = lane >> 5, b = tg >> 5;
    const int tok = 256 * tg + 32 * w + c32;
    stage(lds, KC + (size_t)b * MEML * D + h * 256, D, tid);
    bf16x8 pf[8][2]; float inv;
    {
        bf16x8 qf[16];
        const bf16_t* qp = QC + (size_t)tok * D + h * 256 + 8 * hh;
#pragma unroll
        for (int ks = 0; ks < 16; ++ks) qf[ks] = *(const bf16x8*)(qp + 16 * ks);
        __syncthreads();
        f32x16 acc[8];
        const XA_LAS unsigned char* kb = lds + c32 * RP + 16 * hh;
#pragma unroll
        for (int mt = 0; mt < 8; ++mt) {
            acc[mt] = (f32x16){0.f, 0.f, 0.f, 0.f, 0.f, 0.f, 0.f, 0.f, 0.f, 0.f, 0.f, 0.f, 0.f, 0.f, 0.f, 0.f};
#pragma unroll
            for (int ks = 0; ks < 16; ++ks) acc[mt] = __builtin_amdgcn_mfma_f32_32x32x16_bf16(*(const XA_LAS bf16x8*)(kb + (32 * mt) * RP + 32 * ks), qf[ks], acc[mt], 0, 0, 0);
        }
        float mx = acc[0][0];
#pragma unroll
        for (int mt = 0; mt < 8; ++mt)
#pragma unroll
            for (int r = 0; r < 16; ++r) mx = fmaxf(mx, acc[mt][r]);
        mx = fmaxf(mx, __shfl_xor(mx, 32));
        float sum = 0.f;
#pragma unroll
        for (int mt = 0; mt < 8; ++mt)
#pragma unroll
            for (int r = 0; r < 16; ++r) { acc[mt][r] = __builtin_amdgcn_exp2f(acc[mt][r] - mx); sum += acc[mt][r]; }
        sum += __shfl_xor(sum, 32); inv = 1.f / sum;
#pragma unroll
        for (int mt = 0; mt < 8; ++mt)
#pragma unroll
            for (int s2 = 0; s2 < 2; ++s2) { u32x4 a; a.x = cvtpk(acc[mt][8 * s2], acc[mt][8 * s2 + 1]); a.y = cvtpk(acc[mt][8 * s2 + 2], acc[mt][8 * s2 + 3]); a.z = cvtpk(acc[mt][8 * s2 + 4], acc[mt][8 * s2 + 5]); a.w = cvtpk(acc[mt][8 * s2 + 6], acc[mt][8 * s2 + 7]);
                pf[mt][s2] = __builtin_bit_cast(bf16x8, a); }
    }
    __syncthreads();
    stage(lds, VcT + ((size_t)b * D + h * 256) * MEML, MEML, tid);
    __syncthreads();
    const XA_LAS unsigned char* vb = lds + c32 * RP + 8 * hh;
    bf16_t* op = XO + (size_t)tok * D + h * 256 + 4 * hh;
#pragma unroll 1
    for (int dt = 0; dt < 8; ++dt) {
        f32x16 acc = (f32x16){0.f, 0.f, 0.f, 0.f, 0.f, 0.f, 0.f, 0.f, 0.f, 0.f, 0.f, 0.f, 0.f, 0.f, 0.f, 0.f};
#pragma unroll
        for (int mt = 0; mt < 8; ++mt)
#pragma unroll
            for (int s2 = 0; s2 < 2; ++s2) {
                const s16x4 lo = *(const XA_LAS s16x4*)(vb + (32 * dt) * RP + (32 * mt + 16 * s2) * 2), hi = *(const XA_LAS s16x4*)(vb + (32 * dt) * RP + (32 * mt + 16 * s2 + 8) * 2);
                const bf16x8 vf = (bf16x8){lo[0], lo[1], lo[2], lo[3], hi[0], hi[1], hi[2], hi[3]};
                acc = __builtin_amdgcn_mfma_f32_32x32x16_bf16(vf, pf[mt][s2], acc, 0, 0, 0);
            }
#pragma unroll
        for (int q = 0; q < 4; ++q) { u32x2 o; o.x = cvtpk(acc[4 * q] * inv, acc[4 * q + 1] * inv); o.y = cvtpk(acc[4 * q + 2] * inv, acc[4 * q + 3] * inv); *(u32x2*)(op + 32 * dt + 8 * q) = o; }
    }
    __syncthreads();
}
}

namespace sp {
#define SP_LAS __attribute__((address_space(3)))
#define SP_LDSWAIT() do { asm volatile("s_waitcnt lgkmcnt(0)" ::: "memory"); } while (0)
__device__ __forceinline__ void transpose_item(const float* __restrict__ W, int ldw, int col0, int K, int nblk, bf16_t* __restrict__ WT, int row_off, SP_LAS float* scr, int item, int lane) {
    const int kb = item / nblk, nb = item % nblk, k0 = 64 * kb, n0 = 32 * nb;
#pragma unroll 8
    for (int i = 0; i < 32; ++i) { const int kk = 2 * i + (lane >> 5); scr[kk * 33 + (lane & 31)] = W[(size_t)(k0 + kk) * ldw + col0 + n0 + (lane & 31)]; }
    SP_LDSWAIT();
    const int cc = lane & 7;
#pragma unroll
    for (int j = 0; j < 4; ++j) { const int n = (lane >> 3) + 8 * j; const SP_LAS float* s = scr + (8 * cc) * 33 + n;
        u32x4 o; o.x = pk2(s[0 * 33], s[1 * 33]); o.y = pk2(s[2 * 33], s[3 * 33]); o.z = pk2(s[4 * 33], s[5 * 33]); o.w = pk2(s[6 * 33], s[7 * 33]);
        *(u32x4*)(WT + (size_t)(row_off + n0 + n) * K + k0 + 8 * cc) = o; }
    SP_LDSWAIT();
}
__device__ __forceinline__ void cvt_range(const float* __restrict__ src, bf16_t* __restrict__ dst, size_t n4, size_t gtid, size_t gthreads) {
    for (size_t i = gtid; i < n4; i += gthreads) { const f32x4 v = ((const f32x4*)src)[i]; u32x2 o; o.x = pk2(v.x, v.y); o.y = pk2(v.z, v.w); ((u32x2*)dst)[i] = o; }
}

__device__ __forceinline__ void cvt_fp8_range(const float* __restrict__ src, unsigned char* __restrict__ dst, size_t n16, float scale, size_t gtid, size_t gthreads) {
    for (size_t i = gtid; i < n16; i += gthreads) {
        const f32x4* sp4 = (const f32x4*)src + 4 * i; u32x4 o; unsigned ow[4];
#pragma unroll
        for (int q = 0; q < 4; ++q) { const f32x4 v = sp4[q];
            const float a = fminf(fmaxf(v.x * scale, -448.f), 448.f), b = fminf(fmaxf(v.y * scale, -448.f), 448.f), c2 = fminf(fmaxf(v.z * scale, -448.f), 448.f), d2 = fminf(fmaxf(v.w * scale, -448.f), 448.f);
            int p = 0; p = __builtin_amdgcn_cvt_pk_fp8_f32(a, b, p, false); p = __builtin_amdgcn_cvt_pk_fp8_f32(c2, d2, p, true); ow[q] = (unsigned)p; }
        o.x = ow[0]; o.y = ow[1]; o.z = ow[2]; o.w = ow[3];
        ((u32x4*)dst)[i] = o;
    }
}
__device__ __forceinline__ void dt_stage_w(SP_LAS float* Wl, const float* __restrict__ w_in) {
    const int tid = opaque_tid();
#pragma unroll 8
    for (int i = 0; i < 64; ++i) { const int idx = tid + 512 * i; Wl[idx] = w_in[(size_t)(idx >> 5) * NIN + 5120 + (idx & 31)]; }
}
__device__ __forceinline__ void dt_item(SP_LAS float* Wl, SP_LAS float* xs, SP_LAS float* part, const float* __restrict__ x, const float* __restrict__ dt_bias, float* __restrict__ DT, int item) {
    const int tid = opaque_tid(), lane = tid & 63, w = tid >> 6, m0 = item * 4;
#pragma unroll
    for (int i = 0; i < 2; ++i) { const int q = tid + 512 * i; *(SP_LAS f32x4*)(xs + 4 * q) = ((const f32x4*)(x + (size_t)m0 * D))[q]; }
    __syncthreads();
    const int h = lane & 31, r = w >> 1, kq = (w & 1) * 2 + (lane >> 5);
    const SP_LAS float* xp = xs + r * 1024 + kq * 256; const SP_LAS float* wp = Wl + (kq * 256) * 32 + h;
    float a0 = 0.f, a1 = 0.f;
#pragma unroll 8
    for (int k = 0; k < 256; k += 2) { a0 = fmaf(xp[k], wp[k * 32], a0); a1 = fmaf(xp[k + 1], wp[(k + 1) * 32], a1); }
    float acc = a0 + a1;
    acc += __shfl_xor(acc, 32);
    if ((w & 1) && lane < 32) part[r * 32 + h] = acc;
    __syncthreads();
    if (!(w & 1) && lane < 32) { const float v = acc + part[r * 32 + h] + dt_bias[h]; DT[(size_t)(m0 + r) * 32 + h] = v > 20.f ? v : log1pf(expf(v)); }
}
__device__ __forceinline__ void ln_row(float* __restrict__ X, const float* __restrict__ g, const float* __restrict__ b, bf16_t* __restrict__ XB, int row, int lane) {
    f32x4* xr = (f32x4*)(X + (size_t)row * D) + lane;
    f32x4 v[4]; float s = 0.f;
#pragma unroll
    for (int j = 0; j < 4; ++j) { v[j] = xr[64 * j]; s += (v[j].x + v[j].y) + (v[j].z + v[j].w); }
    const float mean = wave_sum(s) * (1.f / D); float s2 = 0.f;
#pragma unroll
    for (int j = 0; j < 4; ++j) { v[j] = v[j] - mean; s2 += (v[j].x * v[j].x + v[j].y * v[j].y) + (v[j].z * v[j].z + v[j].w * v[j].w); }
    const float rstd = rsqrtf(wave_sum(s2) * (1.f / D) + 1e-5f);
#pragma unroll
    for (int j = 0; j < 4; ++j) { const int c = 4 * lane + 256 * j; const f32x4 gg = *(const f32x4*)(g + c), bb = *(const f32x4*)(b + c);
        f32x4 o = v[j] * rstd * gg + bb; xr[64 * j] = o;
        u32x2 pb; pb.x = pk2(o.x, o.y); pb.y = pk2(o.z, o.w); *(u32x2*)(XB + (size_t)row * D + c) = pb; }
}
__device__ __forceinline__ void xattn_pair(SP_LAS float* L, const bf16_t* __restrict__ QC, const bf16_t* __restrict__ KCVC, bf16_t* __restrict__ XO, int tok0) {
    const int t512 = opaque_tid(); const int half = t512 >> 8, tid = t512 & 255, lane = tid & 63, wv = tid >> 6, tok = tok0 + half, b = tok / SEQ;
    SP_LAS float* qs = L + half * 1024; SP_LAS float* ps = L + 2048 + half * 256; SP_LAS float* red = L + 2560 + half * 8;
    for (int i = tid; i < 1024; i += 256) qs[i] = bf2f(QC[(size_t)tok * D + i]);
    __syncthreads();
    const bf16_t* KV = KCVC + (size_t)b * MEML * 2048;
    for (int h = 0; h < MH; ++h) {
        const bf16_t* kp = KV + (size_t)tid * 2048 + h * 256;
        float s = 0.f;
        for (int d = 0; d < 256; d += 8) { const u32x4 w = *(const u32x4*)(kp + d); const SP_LAS float* q = qs + h * 256 + d;
            s += q[0] * bflo(w.x) + q[1] * bfhi(w.x) + q[2] * bflo(w.y) + q[3] * bfhi(w.y) + q[4] * bflo(w.z) + q[5] * bfhi(w.z) + q[6] * bflo(w.w) + q[7] * bfhi(w.w); }
        float mx = wave_max(s); if (lane == 0) red[wv] = mx; __syncthreads();
        mx = fmaxf(fmaxf(red[0], red[1]), fmaxf(red[2], red[3]));
        const float p = exp2f(s - mx);
        float sm = wave_sum(p); if (lane == 0) red[4 + wv] = sm; ps[tid] = p; __syncthreads();
        sm = (red[4] + red[5]) + (red[6] + red[7]);
        float o = 0.f;
        for (int j = 0; j < 256; ++j) o = fmaf(ps[j], bf2f(KV[(size_t)j * 2048 + 1024 + h * 256 + tid]), o);
        XO[(size_t)tok * D + h * 256 + tid] = (bf16_t)f2bf(o / sm);
        __syncthreads();
    }
}
__device__ __forceinline__ void select_pair(SP_LAS float* L, const bf16_t* __restrict__ QP, const bf16_t* __restrict__ SUBK, int* __restrict__ IDX, float* __restrict__ GATE, int tok0) {
    const int t512 = opaque_tid(); const int hf = t512 >> 8, tid = t512 & 255, tok = tok0 + hf;
    SP_LAS float* base = L + hf * 3072;
    SP_LAS float* qs = base; SP_LAS float* s = base + 2048; SP_LAS float* tops = base + 2304; SP_LAS int* topi = (SP_LAS int*)(base + 2336); SP_LAS float* cs = base + 2368; SP_LAS int* ci = (SP_LAS int*)(base + 2624);
    SP_LAS float* bs = base + 2880; SP_LAS int* bi = (SP_LAS int*)(base + 2896);
    for (int i = tid; i < 2048; i += 256) qs[i] = bf2f(QP[(size_t)tok * 2048 + i]);
    __syncthreads();
    for (int h = 0; h < PH; ++h) {
        const int half = tid >> 7, key = tid & 127;
        { const bf16_t* kp = SUBK + ((size_t)(h * 2 + half) * 128 + key) * 128; const SP_LAS float* q = qs + h * 256 + half * 128; float a = 0.f;
          for (int d = 0; d < 128; d += 8) { const u32x4 w = *(const u32x4*)(kp + d);
              a += q[d] * bflo(w.x) + q[d + 1] * bfhi(w.x) + q[d + 2] * bflo(w.y) + q[d + 3] * bfhi(w.y) + q[d + 4] * bflo(w.z) + q[d + 5] * bfhi(w.z) + q[d + 6] * bflo(w.w) + q[d + 7] * bfhi(w.w); }
          s[tid] = a; }
        __syncthreads();
        { const float me = s[tid]; int rank = 0; const SP_LAS float* spp = s + half * 128;
          for (int j = 0; j < 128; ++j) { const float o = spp[j]; rank += (o > me || (o == me && j < key)) ? 1 : 0; }
          if (rank < 16) { tops[half * 16 + rank] = me; topi[half * 16 + rank] = key; } }
        __syncthreads();
        { const int i = tid >> 4, j = tid & 15; cs[tid] = tops[i] + tops[16 + j]; ci[tid] = topi[i] * 128 + topi[16 + j]; }
        __syncthreads();
        { const float me = cs[tid]; int rank = 0;
          for (int j = 0; j < 256; ++j) { const float o = cs[j]; rank += (o > me || (o == me && j < tid)) ? 1 : 0; }
          if (rank < 16) { bs[rank] = me; bi[rank] = ci[tid]; } }
        __syncthreads();
        if (tid < 16) { const float mx = bs[0]; float sum = 0.f;
            for (int j = 0; j < 16; ++j) sum += expf(bs[j] - mx);
            GATE[(size_t)tok * 128 + h * 16 + tid] = expf(bs[tid] - mx) / sum; IDX[(size_t)tok * 128 + h * 16 + tid] = bi[tid]; }
        __syncthreads();
    }
}
__device__ __forceinline__ void gather_token(SP_LAS float* L, float* __restrict__ X, const bf16_t* __restrict__ PU, const bf16_t* __restrict__ PV, const int* __restrict__ IDX, const float* __restrict__ GATE,
                                             const float* __restrict__ g3, const float* __restrict__ b3, int tok) {
    const int tid = opaque_tid(), lane = tid & 63, wv = tid >> 6;
    SP_LAS float* ys = L; SP_LAS float* red = L + 8192;
    float xr[16], y[16];
    { const float* xp = X + (size_t)tok * D + lane * 16;
#pragma unroll
      for (int j = 0; j < 4; ++j) { const f32x4 v = *(const f32x4*)(xp + 4 * j); xr[4 * j] = v.x; xr[4 * j + 1] = v.y; xr[4 * j + 2] = v.z; xr[4 * j + 3] = v.w; }
#pragma unroll
      for (int j = 0; j < 16; ++j) y[j] = 0.f; }
    for (int e = 0; e < 16; ++e) {
        const int slot = wv * 16 + e; const int id = IDX[(size_t)tok * 128 + slot]; const float gt = GATE[(size_t)tok * 128 + slot];
        const bf16_t* up = PU + (size_t)id * D + lane * 16; const u32x4 u0 = *(const u32x4*)up, u1 = *(const u32x4*)(up + 8);
        const unsigned uw[8] = {u0.x, u0.y, u0.z, u0.w, u1.x, u1.y, u1.z, u1.w};
        float hsum = 0.f;
#pragma unroll
        for (int j = 0; j < 8; ++j) { hsum = fmaf(xr[2 * j], bflo(uw[j]), hsum); hsum = fmaf(xr[2 * j + 1], bfhi(uw[j]), hsum); }
        hsum = wave_sum(hsum);
        const float w = gt * 0.5f * hsum * (1.f + erff(hsum * 0.70710678118654752f));
        const bf16_t* vp = PV + (size_t)id * D + lane * 16; const u32x4 v0 = *(const u32x4*)vp, v1 = *(const u32x4*)(vp + 8);
        const unsigned vw[8] = {v0.x, v0.y, v0.z, v0.w, v1.x, v1.y, v1.z, v1.w};
#pragma unroll
        for (int j = 0; j < 8; ++j) { y[2 * j] = fmaf(w, bflo(vw[j]), y[2 * j]); y[2 * j + 1] = fmaf(w, bfhi(vw[j]), y[2 * j + 1]); }
    }
#pragma unroll
    for (int j = 0; j < 16; ++j) ys[wv * 1024 + lane * 16 + j] = y[j];
    __syncthreads();
    float v[2]; float s = 0.f;
#pragma unroll
    for (int j = 0; j < 2; ++j) { const int c = tid * 2 + j; float a = 0.f;
#pragma unroll
        for (int k = 0; k < 8; ++k) a += ys[k * 1024 + c];
        v[j] = ALPHA * X[(size_t)tok * D + c] + a; s += v[j]; }
    s = wave_sum(s); if (lane == 0) red[wv] = s; __syncthreads();
    float tot = 0.f;
#pragma unroll
    for (int k = 0; k < 8; ++k) tot += red[k];
    const float mean = tot * (1.f / D);
    float s2 = 0.f;
#pragma unroll
    for (int j = 0; j < 2; ++j) { v[j] -= mean; s2 += v[j] * v[j]; }
    s2 = wave_sum(s2); if (lane == 0) red[8 + wv] = s2; __syncthreads();
    float tot2 = 0.f;
#pragma unroll
    for (int k = 0; k < 8; ++k) tot2 += red[8 + k];
    const float rstd = rsqrtf(tot2 * (1.f / D) + 1e-5f);
#pragma unroll
    for (int j = 0; j < 2; ++j) { const int c = tid * 2 + j; X[(size_t)tok * D + c] = v[j] * rstd * g3[c] + b3[c]; }
    __syncthreads();
}

constexpr float PEER_SU = 2048.f, PEER_SV = 256.f;
typedef float f32x2v __attribute__((ext_vector_type(2)));
__device__ __forceinline__ void gather_wave(float* __restrict__ Xo, const float* X, const unsigned char* __restrict__ PU, const unsigned char* __restrict__ PV, const int* __restrict__ IDX, const float* __restrict__ GATE,
                                            const float* __restrict__ g3, const float* __restrict__ b3, int tok, int lane) {
    float xr[16], y[16];
    { const f32x4* xp = (const f32x4*)(X + (size_t)tok * D + 16 * lane);
#pragma unroll
      for (int q = 0; q < 4; ++q) { const f32x4 v = xp[q]; xr[4 * q] = v.x; xr[4 * q + 1] = v.y; xr[4 * q + 2] = v.z; xr[4 * q + 3] = v.w; } }
#pragma unroll
    for (int j = 0; j < 16; ++j) y[j] = 0.f;
    const int id0 = IDX[(size_t)tok * 128 + lane], id1 = IDX[(size_t)tok * 128 + 64 + lane];
    const float gt0 = GATE[(size_t)tok * 128 + lane], gt1 = GATE[(size_t)tok * 128 + 64 + lane];
    u32x4 ub[8], vb[8];
#define GW_ISSUE(buf, TBL, i) do { const int idv_ = ((i) < 8) ? id0 : id1; _Pragma("unroll") for (int k_ = 0; k_ < 8; ++k_) { \
        const int id_ = __builtin_amdgcn_readlane(idv_, (8 * (i) + k_) & 63); buf[k_] = *(const u32x4*)((TBL) + (size_t)id_ * D + 16 * lane); } } while (0)
    GW_ISSUE(ub, PU, 0); GW_ISSUE(vb, PV, 0);
    const bool h32 = (lane & 32) != 0, h16 = (lane & 16) != 0, h8 = (lane & 8) != 0;
#pragma unroll 1
    for (int i = 0; i < 16; ++i) {
        float p[8];
#pragma unroll
        for (int k = 0; k < 8; ++k) { const unsigned w[4] = {ub[k].x, ub[k].y, ub[k].z, ub[k].w}; float a = 0.f;
#pragma unroll
            for (int q = 0; q < 4; ++q) { const f32x2v lo = __builtin_amdgcn_cvt_pk_f32_fp8((int)w[q], false), hi = __builtin_amdgcn_cvt_pk_f32_fp8((int)w[q], true);
                a = fmaf(xr[4 * q], lo.x, a); a = fmaf(xr[4 * q + 1], lo.y, a); a = fmaf(xr[4 * q + 2], hi.x, a); a = fmaf(xr[4 * q + 3], hi.y, a); }
            p[k] = a; }
        { const int in_ = (i + 1 < 16) ? i + 1 : 15; GW_ISSUE(ub, PU, in_); }
        float q4[4], q2[2], q1;
#pragma unroll
        for (int k = 0; k < 4; ++k) q4[k] = (h32 ? p[k + 4] : p[k]) + __shfl_xor(h32 ? p[k] : p[k + 4], 32);
#pragma unroll
        for (int k = 0; k < 2; ++k) q2[k] = (h16 ? q4[k + 2] : q4[k]) + __shfl_xor(h16 ? q4[k] : q4[k + 2], 16);
        q1 = (h8 ? q2[1] : q2[0]) + __shfl_xor(h8 ? q2[0] : q2[1], 8);
        q1 += __shfl_xor(q1, 4); q1 += __shfl_xor(q1, 2); q1 += __shfl_xor(q1, 1);
        q1 *= (1.f / PEER_SU);
        const float gsel = __shfl((i < 8) ? gt0 : gt1, (8 * i + (lane >> 3)) & 63);
        const float wv = gsel * 0.5f * q1 * (1.f + erff(q1 * 0.70710678118654752f));
#pragma unroll
        for (int k = 0; k < 8; ++k) { const float wk = __builtin_bit_cast(float, __builtin_amdgcn_readlane(__builtin_bit_cast(int, wv), 8 * k));
            const unsigned w[4] = {vb[k].x, vb[k].y, vb[k].z, vb[k].w};
#pragma unroll
            for (int q = 0; q < 4; ++q) { const f32x2v lo = __builtin_amdgcn_cvt_pk_f32_fp8((int)w[q], false), hi = __builtin_amdgcn_cvt_pk_f32_fp8((int)w[q], true);
                y[4 * q] = fmaf(wk, lo.x, y[4 * q]); y[4 * q + 1] = fmaf(wk, lo.y, y[4 * q + 1]); y[4 * q + 2] = fmaf(wk, hi.x, y[4 * q + 2]); y[4 * q + 3] = fmaf(wk, hi.y, y[4 * q + 3]); } }
        { const int in_ = (i + 1 < 16) ? i + 1 : 15; GW_ISSUE(vb, PV, in_); }
    }
#undef GW_ISSUE
    float s = 0.f;
#pragma unroll
    for (int j = 0; j < 16; ++j) { y[j] = ALPHA * xr[j] + y[j] * (1.f / PEER_SV); s += y[j]; }
    const float mean = wave_sum(s) * (1.f / D); float s2 = 0.f;
#pragma unroll
    for (int j = 0; j < 16; ++j) { y[j] -= mean; s2 += y[j] * y[j]; }
    const float rstd = rsqrtf(wave_sum(s2) * (1.f / D) + 1e-5f);
    float* op = Xo + (size_t)tok * D + 16 * lane;
#pragma unroll
    for (int q = 0; q < 4; ++q) { const f32x4 gg = *(const f32x4*)(g3 + 16 * lane + 4 * q), bb = *(const f32x4*)(b3 + 16 * lane + 4 * q);
        f32x4 o; o.x = y[4 * q] * rstd * gg.x + bb.x; o.y = y[4 * q + 1] * rstd * gg.y + bb.y; o.z = y[4 * q + 2] * rstd * gg.z + bb.z; o.w = y[4 * q + 3] * rstd * gg.w + bb.w;
        *(f32x4*)(op + 4 * q) = o; }
}
}


#define LAS __attribute__((address_space(3)))
#define XB_TMO      128
#define XB_XCNT(j)  (256  + 64 * (j))
#define XB_XSUB(j)  (1280 + 64 * (j))
#define XB_XGEN(j)  (2304 + 64 * (j))
#define XB_TOP      3328
#define XB_TOPGEN   3392
#define XCD_BAR_WORDS 3456
#define XB_SPIN_CAP (1u << 18)
__device__ __forceinline__ unsigned xb_ld(unsigned* p)              { return __hip_atomic_load(p, __ATOMIC_RELAXED, __HIP_MEMORY_SCOPE_AGENT); }
__device__ __forceinline__ unsigned xb_add(unsigned* p, unsigned v) { return __hip_atomic_fetch_add(p, v, __ATOMIC_RELAXED, __HIP_MEMORY_SCOPE_AGENT); }
__device__ __forceinline__ unsigned xb_xcc_id() { return (unsigned)__builtin_amdgcn_s_getreg((3 << 11) | 20) & 0xFu; }
#define XB_SPIN(cond, bar) do { unsigned _sp = 0; while (cond) { __builtin_amdgcn_s_sleep(1); \
    if ((++_sp & 255u) == 0u) { if (xb_ld(&(bar)[XB_TMO])) break; if (_sp > XB_SPIN_CAP) { atomicAdd(&(bar)[XB_TMO], 1u); break; } } } } while (0)
struct XcdBarrier { unsigned* bar; unsigned x; volatile LAS unsigned* st; };
__device__ __forceinline__ XcdBarrier xcd_barrier_post(unsigned* bar, volatile LAS unsigned* st) {
    XcdBarrier b; b.bar = bar; b.x = xb_xcc_id(); b.st = st;
    if (threadIdx.x == 0) (void)xb_add(&bar[XB_XCNT(b.x)], 1u);
    return b;
}
__device__ __forceinline__ void xcd_barrier_complete(unsigned* bar, unsigned x, unsigned& nloc, unsigned& nx) {
    const unsigned G = gridDim.x * gridDim.y * gridDim.z;
    unsigned sum, cnt, mine, sp = 0u;
    for (;;) {
        sum = 0u; cnt = 0u; mine = 0u;
#pragma unroll
        for (unsigned j = 0; j < 16; ++j) { const unsigned c = xb_ld(&bar[XB_XCNT(j)]); sum += c; cnt += (c > 0u) ? 1u : 0u; mine = (j == x) ? c : mine; }
        if (sum == G) break;
        __builtin_amdgcn_s_sleep(1);
        if ((++sp & 255u) == 0u) { if (xb_ld(&bar[XB_TMO])) break; if (sp > XB_SPIN_CAP) { atomicAdd(&bar[XB_TMO], 1u); break; } }
    }
    nloc = mine > 0u ? mine : 1u; nx = cnt > 0u ? cnt : 1u;
}
__device__ __forceinline__ void xcd_barrier(const XcdBarrier& b) {
    asm volatile("s_waitcnt vmcnt(0)" ::: "memory");
    __syncthreads();
    if (threadIdx.x == 0) {
        unsigned* bar = b.bar;
        __builtin_amdgcn_s_waitcnt(0);
        unsigned nloc = b.st[0], nx = b.st[1];
        if (nloc == 0u) { xcd_barrier_complete(bar, b.x, nloc, nx); b.st[0] = nloc; b.st[1] = nx; }
        const unsigned old = xb_add(&bar[XB_XSUB(b.x)], 1u);
        const unsigned gen = old / nloc;
        if (old + 1u == (gen + 1u) * nloc) {
            __builtin_amdgcn_fence(__ATOMIC_RELEASE, "agent");
            asm volatile("s_waitcnt vmcnt(0)" ::: "memory");
            const unsigned og = xb_add(&bar[XB_TOP], 1u);
            const unsigned tg = og / nx;
            if (og + 1u == (tg + 1u) * nx) xb_add(&bar[XB_TOPGEN], 1u);
            else XB_SPIN(xb_ld(&bar[XB_TOPGEN]) == tg, bar);
            __builtin_amdgcn_fence(__ATOMIC_ACQUIRE, "agent");
            xb_add(&bar[XB_XGEN(b.x)], 1u);
            asm volatile("s_waitcnt vmcnt(0)" ::: "memory");
        } else {
            XB_SPIN(xb_ld(&bar[XB_XGEN(b.x)]) == gen, bar);
            __builtin_amdgcn_fence(__ATOMIC_ACQUIRE, "agent");
            asm volatile("s_waitcnt vmcnt(0)" ::: "memory");
        }
    }
    __syncthreads();
}
constexpr int CW_BAR = 4096;
constexpr int MISC_OFF = 147456;

struct Params { const float* in[30]; float* out; unsigned char* ws; };
template <class F> __device__ __forceinline__ void run_gemm(unsigned char* lds, const bf16_t* A, int lda, const bf16_t* Bt, int Mr, int N, int K, F f) {
    pg8::Gemm g{A, Bt, Mr, N, K, lda}; pg8::StaticOrder S; S.init(Mr, N, gridDim.x, blockIdx.x); pg8::EpiAdapt<F> E{f};
    pg8::gemm_phase<pg8::EpiAdapt<F>, pg8::StaticOrder, true>((PG8_LAS unsigned char*)lds, g, S, E);
}
#ifndef PROBE_ATTN
#define PROBE_ATTN 0
#endif
#ifndef PROBE_SSD
#define PROBE_SSD 0
#endif
#ifndef PROBE_SYNC
#define PROBE_SYNC 0
#endif
#define KA_LAS __attribute__((address_space(4)))
#define PH_BEGIN const KA_LAS unsigned char* ka_ = (const KA_LAS unsigned char*)__builtin_amdgcn_kernarg_segment_ptr(); asm volatile("" : "+s"(ka_))
#define PIN(k) (*(const float* const KA_LAS*)(ka_ + 8 * (k)))
#define POUT (*(float* const KA_LAS*)(ka_ + 240))
#define PWS (*(unsigned char* const KA_LAS*)(ka_ + 248))
__global__ void __launch_bounds__(512, 2) hybrid_fwd(Params P) {
    extern __shared__ __attribute__((aligned(16))) unsigned char lds[];
    cg::grid_group grid = cg::this_grid();
    { PH_BEGIN; volatile LAS unsigned* misc = (volatile LAS unsigned*)((LAS unsigned char*)lds + MISC_OFF);
      if (threadIdx.x < 16) misc[threadIdx.x] = 0u;
      __syncthreads();
      (void)xcd_barrier_post((unsigned*)(PWS + WS_CTL) + CW_BAR, misc);
      if (PWS == nullptr) grid.sync(); }
#define GSYNC() do { PH_BEGIN; XcdBarrier xb_; xb_.bar = (unsigned*)(PWS + WS_CTL) + CW_BAR; xb_.x = xb_xcc_id(); xb_.st = (volatile LAS unsigned*)((LAS unsigned char*)lds + MISC_OFF); xcd_barrier(xb_); } while (0)
    {
        PH_BEGIN; unsigned char* ws = PWS;
        const int tid = opaque_tid(), lane = tid & 63, wave = __builtin_amdgcn_readfirstlane(tid >> 6), c = blockIdx.x, G = gridDim.x;
        const size_t gtid = (size_t)c * 512 + tid, gthreads = (size_t)G * 512; const int gw = c * 8 + wave, NGW = G * 8;
        const float* w_in = PIN(2);
        bf16_t* WinT = (bf16_t*)(ws + WS_WIN); bf16_t* WckvT = (bf16_t*)(ws + WS_WCKV);
        SP_LAS float* scr = (SP_LAS float*)lds + wave * (64 * 33);
        constexpr int I0 = 2560, I1 = 5120, I2 = 6144, I3 = 6656, I4 = 7168, I5 = 7680, I6 = 8192, I7 = 8704, I8 = 9216, I9 = 10240;
        for (int it = gw; it < I9; it += NGW) {
            if (it < I0) sp::transpose_item(w_in, NIN, 0, D, 160, WinT, 0, scr, it, lane);
            else if (it < I1) sp::transpose_item(w_in, NIN, 5152, D, 160, WinT, 5120, scr, it - I0, lane);
            else if (it < I2) sp::transpose_item(PIN(9), D, 0, DI, 32, (bf16_t*)(ws + WS_WSSD), 0, scr, it - I1, lane);
            else if (it < I3) sp::transpose_item(PIN(13), D, 0, D, 32, (bf16_t*)(ws + WS_WDIFF), 0, scr, it - I2, lane);
            else if (it < I4) sp::transpose_item(PIN(15), D, 0, D, 32, (bf16_t*)(ws + WS_WO), 0, scr, it - I3, lane);
            else if (it < I5) sp::transpose_item(PIN(18), D, 0, D, 32, (bf16_t*)(ws + WS_WCQ), 0, scr, it - I4, lane);
            else if (it < I6) sp::transpose_item(PIN(19), D, 0, D, 32, WckvT, 0, scr, it - I5, lane);
            else if (it < I7) sp::transpose_item(PIN(20), D, 0, D, 32, WckvT, 1024, scr, it - I6, lane);
            else if (it < I8) sp::transpose_item(PIN(21), D, 0, D, 32, (bf16_t*)(ws + WS_WCO), 0, scr, it - I7, lane);
            else sp::transpose_item(PIN(24), 2048, 0, D, 64, (bf16_t*)(ws + WS_WPQ), 0, scr, it - I8, lane);
        }
        const float* x = PIN(0);
        sp::cvt_range(x, (bf16_t*)(ws + WS_XB), (size_t)M * D / 4, gtid, gthreads);
        sp::cvt_range(PIN(1), (bf16_t*)(ws + WS_MEMB), (size_t)BATCH * MEML * D / 4, gtid, gthreads);
        sp::cvt_range(PIN(25), (bf16_t*)(ws + WS_SUBK), (size_t)PH * 2 * PK * PHALF / 4, gtid, gthreads);
        __syncthreads();
        sp::dt_stage_w((SP_LAS float*)lds, w_in);
        for (int it = c; it < M / 4; it += G) sp::dt_item((SP_LAS float*)lds, (SP_LAS float*)lds + 32768, (SP_LAS float*)lds + 36896  , x, PIN(5), (float*)(ws + WS_DT), it);
        __syncthreads();
        if (c == 0 && tid == 0) { const float* lam_q = PIN(10); const float* lam_k = PIN(11); float s0 = 0.f, s1 = 0.f;
            for (int i = 0; i < 64; ++i) { s0 += lam_q[i] * lam_k[i]; s1 += lam_q[64 + i] * lam_k[64 + i]; }
            ((float*)(ws + WS_CTL))[CW_LAM] = expf(s0) - expf(s1) + LAMBDA_INIT; }
    }
    GSYNC();
    { PH_BEGIN; unsigned char* ws = PWS;
      run_gemm(lds, (const bf16_t*)(ws + WS_MEMB), D, (const bf16_t*)(ws + WS_WCKV), BATCH * MEML, D, D, EpiPlain{(bf16_t*)(ws + WS_KCVC), D, 1.f});
      for (int bb = 0; bb < BATCH; ++bb)
          run_gemm(lds, (const bf16_t*)(ws + WS_WCKV) + (size_t)D * D, D, (const bf16_t*)(ws + WS_MEMB) + (size_t)bb * MEML * D, D, MEML, D, EpiPlain{(bf16_t*)(ws + WS_KCVC) + (size_t)BATCH * MEML * D + (size_t)bb * D * MEML, MEML, 1.f});
      run_gemm(lds, (const bf16_t*)(ws + WS_XB), D, (const bf16_t*)(ws + WS_WIN), SEQ, NINP, D, EpiInProj{(bf16_t*)(ws + WS_H), PIN(14)}); }
    GSYNC();
#pragma unroll 1
    for (int b = 0; b < BATCH; ++b) {
        { PH_BEGIN; unsigned char* ws = PWS; const int c = blockIdx.x, G = gridDim.x;
          bf16_t* H = (bf16_t*)(ws + WS_H); const float* DTb = (const float*)(ws + WS_DT) + (size_t)b * SEQ * 32;
          for (int u = c; u < 256; u += G) ssd::phaseA_unit((SS_LAS unsigned char*)lds, H, DTb, PIN(3), PIN(4), PIN(6), (bf16_t*)(ws + WS_T1), (float*)(ws + WS_CTL) + 1024, u >> 2, u & 3);
          const float lam = ((const float*)(ws + WS_CTL))[CW_LAM]; const float* subln_w = PIN(12);
#if PROBE_ATTN
          for (int u = c; u < 256; u += G) { const int h = u >> 5, j = u & 31;
              dattn::unit<false>((DA_LAS unsigned char*)lds, H, h, 63 - j, subln_w, lam);
              dattn::unit<false>((DA_LAS unsigned char*)lds, H, h, j, subln_w, lam); }
#endif
          for (int u = c; u < 256; u += G) { const int h = u >> 5, j = u & 31;
              dattn::unit((DA_LAS unsigned char*)lds, H, h, 63 - j, subln_w, lam);
              dattn::unit((DA_LAS unsigned char*)lds, H, h, j, subln_w, lam); } }
        GSYNC();
        { PH_BEGIN; unsigned char* ws = PWS; const int tid = opaque_tid();
          for (size_t i = (size_t)blockIdx.x * 512 + tid; i < 131072; i += (size_t)gridDim.x * 512) ssd::scan_phase((bf16_t*)(ws + WS_T1), (const float*)(ws + WS_CTL) + 1024, (int)i); }
        GSYNC();
        { PH_BEGIN; unsigned char* ws = PWS; const int c = blockIdx.x, G = gridDim.x;
#if PROBE_SSD
          for (int u = c; u < 256; u += G) ssd::phaseA_unit((SS_LAS unsigned char*)lds, (bf16_t*)(ws + WS_H), (const float*)(ws + WS_DT) + (size_t)b * SEQ * 32, PIN(3), PIN(4), PIN(6), (bf16_t*)(POUT + (size_t)SEQ * D), (float*)(ws + WS_CTL) + 8192, u >> 2, u & 3);
          for (int u = c; u < 256; u += G) ssd::phaseC_unit<false>((SS_LAS unsigned char*)lds, (bf16_t*)(ws + WS_H), (const float*)(ws + WS_DT) + (size_t)b * SEQ * 32, PIN(3), PIN(4), PIN(6), PIN(7), PIN(8), (const bf16_t*)(ws + WS_T1), u >> 2, u & 3);
#endif
          for (int u = c; u < 256; u += G) ssd::phaseC_unit((SS_LAS unsigned char*)lds, (bf16_t*)(ws + WS_H), (const float*)(ws + WS_DT) + (size_t)b * SEQ * 32, PIN(3), PIN(4), PIN(6), PIN(7), PIN(8), (const bf16_t*)(ws + WS_T1), u >> 2, u & 3); }
        GSYNC();
        { PH_BEGIN; unsigned char* ws = PWS; bf16_t* H = (bf16_t*)(ws + WS_H); float* T1 = (float*)(ws + WS_T1);
          run_gemm(lds, H + HC_Z, HP_, (const bf16_t*)(ws + WS_WSSD), SEQ, D, DI, EpiGate1{H, T1});
          run_gemm(lds, H + HC_Q, HP_, (const bf16_t*)(ws + WS_WDIFF), SEQ, D, D, EpiGate2{H, T1});
          if (b == BATCH - 1 && 2 * (int)blockIdx.x >= (int)gridDim.x) { const int tid = opaque_tid(); const int half = (gridDim.x + 1) / 2;
              const size_t gt = (size_t)(blockIdx.x - half) * 512 + tid, gn = (size_t)(gridDim.x - half) * 512;
              sp::cvt_fp8_range(PIN(26), ws + WS_PU, (size_t)PK * PK * D / 16, sp::PEER_SU, gt, gn);
              sp::cvt_fp8_range(PIN(27), ws + WS_PV, (size_t)PK * PK * D / 16, sp::PEER_SV, gt, gn); } }
        GSYNC();
        { PH_BEGIN; unsigned char* ws = PWS;
          run_gemm(lds, (const bf16_t*)(ws + WS_H) + HC_K, HP_, (const bf16_t*)(ws + WS_WO), SEQ, D, D, EpiResid{PIN(0), POUT, b * SEQ, 0}); }
        GSYNC();
        if (b + 1 < BATCH) {
            { PH_BEGIN; unsigned char* ws = PWS;
              run_gemm(lds, (const bf16_t*)(ws + WS_XB) + (size_t)(b + 1) * SEQ * D, D, (const bf16_t*)(ws + WS_WIN), SEQ, NINP, D, EpiInProj{(bf16_t*)(ws + WS_H), PIN(14)}); }
            GSYNC();
        }
    }
    { PH_BEGIN; unsigned char* ws = PWS; const int tid = opaque_tid(), lane = tid & 63, wave = __builtin_amdgcn_readfirstlane(tid >> 6), c = blockIdx.x, G = gridDim.x;
      float* out = POUT; const float* g = PIN(16); const float* bb = PIN(17); bf16_t* XB = (bf16_t*)(ws + WS_X1B);
      for (int r = c * 8 + wave; r < M; r += G * 8) sp::ln_row(out, g, bb, XB, r, lane); }
    GSYNC();
    { PH_BEGIN; unsigned char* ws = PWS;
      run_gemm(lds, (const bf16_t*)(ws + WS_X1B), D, (const bf16_t*)(ws + WS_WCQ), M, D, D, EpiPlain{(bf16_t*)(ws + WS_QC), D, CQSCALE}); }
    GSYNC();
    { PH_BEGIN; unsigned char* ws = PWS; const int c = blockIdx.x, G = gridDim.x;
      for (int u = c; u < 256; u += G) xattn::unit((XA_LAS unsigned char*)lds, (const bf16_t*)(ws + WS_QC), (const bf16_t*)(ws + WS_KCVC), (const bf16_t*)(ws + WS_KCVC) + (size_t)BATCH * MEML * D, (bf16_t*)(ws + WS_XO), u >> 2, u & 3); }
    GSYNC();
    { PH_BEGIN; unsigned char* ws = PWS; float* out = POUT;
      run_gemm(lds, (const bf16_t*)(ws + WS_XO), D, (const bf16_t*)(ws + WS_WCO), M, D, D, EpiResid{out, out, 0, 0}); }
    GSYNC();
    { PH_BEGIN; unsigned char* ws = PWS; const int tid = opaque_tid(), lane = tid & 63, wave = __builtin_amdgcn_readfirstlane(tid >> 6), c = blockIdx.x, G = gridDim.x;
      float* out = POUT; const float* g = PIN(22); const float* bb = PIN(23); bf16_t* XB = (bf16_t*)(ws + WS_X1B);
      for (int r = c * 8 + wave; r < M; r += G * 8) sp::ln_row(out, g, bb, XB, r, lane); }
    GSYNC();
    { PH_BEGIN; unsigned char* ws = PWS;
      run_gemm(lds, (const bf16_t*)(ws + WS_X1B), D, (const bf16_t*)(ws + WS_WPQ), M, 2048, D, EpiPlain{(bf16_t*)(ws + WS_QP), 2048, 1.f}); }
    GSYNC();
    { PH_BEGIN; unsigned char* ws = PWS; const int c = blockIdx.x, G = gridDim.x;
      for (int t = 64 * c; t < M; t += 64 * G)
          for (int hp = 0; hp < 4; ++hp) psel::step((PS_LAS int*)lds, (const bf16_t*)(ws + WS_QP), (const bf16_t*)(ws + WS_SUBK), (int*)(ws + WS_IDX), (float*)(ws + WS_GATE), t, hp); }
    GSYNC();
    { PH_BEGIN; unsigned char* ws = PWS; const int tid = opaque_tid(), lane = tid & 63, wave = __builtin_amdgcn_readfirstlane(tid >> 6);
      float* out = POUT; const float* g3 = PIN(28); const float* b3 = PIN(29);
      for (int t = blockIdx.x * 8 + wave; t < M; t += gridDim.x * 8) sp::gather_wave(out, out, ws + WS_PU, ws + WS_PV, (const int*)(ws + WS_IDX), (const float*)(ws + WS_GATE), g3, b3, t, lane); }
}

extern "C" void kernel_launch(void* const* d_in, const int* in_sizes, int n_in, void* d_out, int out_size, void* d_ws, size_t ws_size, hipStream_t stream) {
    static int grid_blocks = 0;
    if (grid_blocks == 0) {
        if (n_in != 30 || out_size != M * D || ws_size < WS_END) { fprintf(stderr, "kernel_launch: unexpected sizes n_in %d out %d ws %zu (need %zu)\n", n_in, out_size, ws_size, (size_t)WS_END); grid_blocks = -1; return; }
        int dev = 0, cus = 0, per_cu = 0;
        (void)hipGetDevice(&dev); (void)hipDeviceGetAttribute(&cus, hipDeviceAttributeMultiprocessorCount, dev);
        (void)hipFuncSetAttribute((const void*)hybrid_fwd, hipFuncAttributeMaxDynamicSharedMemorySize, LDS_BYTES);
        if (hipOccupancyMaxActiveBlocksPerMultiprocessor(&per_cu, (const void*)hybrid_fwd, 512, LDS_BYTES) != hipSuccess || per_cu < 1) { fprintf(stderr, "kernel_launch: occupancy query failed (%d)\n", per_cu); per_cu = 1; }
        (void)hipGetLastError();
        grid_blocks = cus * 1;
    }
    if (grid_blocks < 0) return;
    if (hipMemsetAsync(d_ws, 0, 65536, stream) != hipSuccess) { fprintf(stderr, "kernel_launch: memset of control words failed\n"); return; }
    Params p{};
    for (int i = 0; i < 30; ++i) p.in[i] = (const float*)d_in[i];
    p.out = (float*)d_out; p.ws = (unsigned char*)d_ws;
    void* args[] = {&p};
    hipError_t e = hipLaunchCooperativeKernel((const void*)hybrid_fwd, dim3(grid_blocks), dim3(512), args, LDS_BYTES, stream);
    if (e != hipSuccess) fprintf(stderr, "cooperative launch failed: %s (grid %d)\n", hipGetErrorString(e), grid_blocks);
}
```

```cpp
#include <hip/hip_runtime.h>
#include <hip/hip_cooperative_groups.h>
namespace cg = cooperative_groups;
#include <cstdio>
#include <cstdint>
#include <cmath>
#include <type_traits>

typedef unsigned short bf16_t;
typedef float f32x4 __attribute__((ext_vector_type(4)));
typedef unsigned u32x4 __attribute__((ext_vector_type(4)));
typedef unsigned u32x2 __attribute__((ext_vector_type(2)));

constexpr int D = 1024, BATCH = 2, SEQ = 8192, M = BATCH * SEQ;
constexpr int DI = 2048, NH = 32, HP = 64, NG = 4, DS = 128, DXBC = 3072;
constexpr int AH = 8, AD = 64, AV = 128;
constexpr int MEML = 256, MH = 4, MHD = 256;
constexpr int PH = 8, PK = 128, PDK = 256, PHALF = 128, PTOP = 16;
constexpr int NIN = 10272, NINP = 10240;
constexpr float ALPHA = 1.189207115002721f;
constexpr float LOG2E = 1.4426950408889634f;
constexpr float QSCALE = 0.125f * LOG2E;
constexpr float CQSCALE = 0.0625f * LOG2E;
constexpr float LAMBDA_INIT = 0.2f;
constexpr int HC_Z = 0, HC_XBC = 2048, HC_Q = 5120, HC_K = 6144, HC_V = 7168, HC_GS = 8192, HC_GA = 9216, HP_ = NINP;

constexpr size_t MiB = 1u << 20;
constexpr size_t WS_CTL = 0;
constexpr size_t WS_WIN = 1 * MiB;
constexpr size_t WS_WSSD = 21 * MiB;
constexpr size_t WS_WDIFF = 25 * MiB, WS_WO = 27 * MiB, WS_WCQ = 29 * MiB, WS_WCKV = 31 * MiB  , WS_WCO = 35 * MiB;
constexpr size_t WS_WPQ = 37 * MiB;
constexpr size_t WS_SUBK = 41 * MiB;
constexpr size_t WS_MEMB = 42 * MiB;
constexpr size_t WS_KCVC = 43 * MiB;
constexpr size_t WS_DT = 45 * MiB;
constexpr size_t WS_XB = 47 * MiB;
constexpr size_t WS_H = 79 * MiB;
constexpr size_t WS_T1 = 239 * MiB;
constexpr size_t WS_PU = 47 * MiB, WS_PV = 63 * MiB;
constexpr size_t WS_X1B = 79 * MiB;
constexpr size_t WS_QC = 143 * MiB, WS_XO = 175 * MiB;
constexpr size_t WS_QP = 207 * MiB;
constexpr size_t WS_IDX = 143 * MiB, WS_GATE = 151 * MiB;
constexpr size_t WS_PART = 207 * MiB;
constexpr size_t WS_END = 271 * MiB;
constexpr int CW_LAM = 64;

__device__ __forceinline__ int opaque_tid() { int t = threadIdx.x; asm volatile("" : "+v"(t)); return t; }
__device__ __forceinline__ unsigned f2bf(float f) { unsigned u = __builtin_bit_cast(unsigned, f); return (u + 0x7fffu + ((u >> 16) & 1u)) >> 16; }
__device__ __forceinline__ float bf2f(unsigned h) { return __builtin_bit_cast(float, h << 16); }
__device__ __forceinline__ unsigned pk2(float lo, float hi) { return f2bf(lo) | (f2bf(hi) << 16); }
__device__ __forceinline__ float bflo(unsigned w) { return __builtin_bit_cast(float, w << 16); }
__device__ __forceinline__ float bfhi(unsigned w) { return __builtin_bit_cast(float, w & 0xffff0000u); }
__device__ __forceinline__ float sigmoidf_(float v) { return __builtin_amdgcn_rcpf(1.f + __expf(-v)); }
__device__ __forceinline__ float siluf_(float v) { return v * __builtin_amdgcn_rcpf(1.f + __expf(-v)); }
__device__ __forceinline__ float wave_sum(float v) {
#pragma unroll
    for (int o = 1; o < 64; o <<= 1) v += __shfl_xor(v, o);
    return v;
}
__device__ __forceinline__ float wave_max(float v) {
#pragma unroll
    for (int o = 1; o < 64; o <<= 1) v = fmaxf(v, __shfl_xor(v, o));
    return v;
}

__device__ __forceinline__ void store_bf16x8(bf16_t* p, const float (&v)[8]) { u32x4 w; w.x = pk2(v[0], v[1]); w.y = pk2(v[2], v[3]); w.z = pk2(v[4], v[5]); w.w = pk2(v[6], v[7]); *(u32x4*)p = w; }
struct EpiPlain { bf16_t* O; int ldc; float scale;
    __device__ __forceinline__ void operator()(int row, int col0, const float (&v)[8]) const { float o[8];
#pragma unroll
        for (int j = 0; j < 8; ++j) o[j] = v[j] * scale; store_bf16x8(O + (size_t)row * ldc + col0, o); } };
struct EpiInProj { bf16_t* H; const float* gate_bias;
    __device__ __forceinline__ void operator()(int row, int col0, const float (&v)[8]) const { float o[8];
        if (col0 >= HC_GS) { const float* gb = gate_bias + (col0 - HC_GS);
#pragma unroll
            for (int j = 0; j < 8; ++j) o[j] = sigmoidf_(v[j] + gb[j]); }
        else { const float s = (col0 >= HC_Q && col0 < HC_K) ? QSCALE : 1.f;
#pragma unroll
            for (int j = 0; j < 8; ++j) o[j] = v[j] * s; }
        store_bf16x8(H + (size_t)row * HP_ + col0, o); } };
struct EpiGate1 { const bf16_t* H; float* T1;
    __device__ __forceinline__ void operator()(int row, int col0, const float (&v)[8]) const {
        const u32x4 g = *(const u32x4*)(H + (size_t)row * HP_ + HC_GS + col0); const unsigned gw[4] = {g.x, g.y, g.z, g.w};
        float* t = T1 + (size_t)row * D + col0;
#pragma unroll
        for (int j = 0; j < 4; ++j) { t[2 * j] = bflo(gw[j]) * v[2 * j]; t[2 * j + 1] = bfhi(gw[j]) * v[2 * j + 1]; } } };
struct EpiGate2 { bf16_t* H; const float* T1;
    __device__ __forceinline__ void operator()(int row, int col0, const float (&v)[8]) const {
        const u32x4 g = *(const u32x4*)(H + (size_t)row * HP_ + HC_GA + col0); const unsigned gw[4] = {g.x, g.y, g.z, g.w};
        const float* t = T1 + (size_t)row * D + col0; float o[8];
#pragma unroll
        for (int j = 0; j < 4; ++j) { o[2 * j] = t[2 * j] + bflo(gw[j]) * v[2 * j]; o[2 * j + 1] = t[2 * j + 1] + bfhi(gw[j]) * v[2 * j + 1]; }
        store_bf16x8(H + (size_t)row * HP_ + HC_K + col0, o); } };
struct EpiResid { const float* base; float* out; int row_off; int pad_;
    __device__ __forceinline__ void operator()(int row, int col0, const float (&v)[8]) const {
        const size_t o = (size_t)(row + row_off) * D + col0;
#pragma unroll
        for (int j = 0; j < 8; ++j) out[o + j] = ALPHA * base[o + j] + v[j]; } };


namespace pg8 {
#define PG8_LAS __attribute__((address_space(3)))
typedef short bf16x8 __attribute__((ext_vector_type(8)));
constexpr int BM = 256, BK = 64, HALF = 128, HTB = HALF * BK * 2, STAGE_BYTES = 8 * HTB, NXCD = 8, WGM = 8;
__host__ __device__ __forceinline__ int lds_byte(int r, int c) { const int st = (r >> 4) * 2 + (c >> 5), rr = r & 15, cc = c & 31, ob = rr * 64 + cc * 2; return st * 1024 + (ob ^ (((ob >> 9) & 1) << 5)); }
__host__ __device__ __forceinline__ void stage_rc(int b, int& R, int& C) { const int st = b / 1024, sb = b % 1024, swz = sb ^ (((sb >> 9) & 1) << 5); R = (st >> 1) * 16 + swz / 64; C = (st & 1) * 32 + (swz % 64) / 2; }
__host__ __device__ __forceinline__ int perm32(int rho) { const int n = rho >> 4, i = rho & 15; return 8 * (i >> 2) + 4 * n + (i & 3); }
struct Unit { int pm, pn; };
struct Gemm { const bf16_t* A; const bf16_t* Bt; int M, N, K, lda; };
struct StaticOrder {
    int nM, nN, nwg, G, c;
    __host__ __device__ void init(int M, int N, int G_, int c_) { nM = M / BM; nN = N / BM; nwg = nM * nN; G = G_; c = c_; }
    __host__ __device__ bool next(int i, Unit& u) const {
        const long L = (long)i * G + c; if (L >= nwg) return false;
        int wgid = (int)L; { const int q = nwg / NXCD, r = nwg % NXCD, xcd = wgid % NXCD, off = wgid / NXCD; wgid = (xcd < r ? xcd * (q + 1) : r * (q + 1) + (xcd - r) * q) + off; }
        const int nig = WGM * nN, gid = wgid / nig, fm = gid * WGM, gsz = (nM - fm) < WGM ? (nM - fm) : WGM;
        u.pm = fm + ((wgid % nig) % gsz); u.pn = (wgid % nig) / gsz; return true;
    }
};
template <class F> struct EpiAdapt {
    static constexpr bool PERM = true, AFTER_DRAIN = false; F f;
    __device__ __forceinline__ void operator()(const f32x4 (&acc)[2][2][4][2], const Unit& u, int wr, int wc, int fr, int fq) const {
#pragma unroll
        for (int ai = 0; ai < 2; ++ai)
#pragma unroll
            for (int m = 0; m < 4; ++m) { const int row = u.pm * BM + ai * HALF + wr * 64 + m * 16 + fr;
#pragma unroll
                for (int bj = 0; bj < 2; ++bj) { const int col0 = u.pn * BM + bj * HALF + wc * 32 + 8 * fq;
                    const f32x4 a = acc[ai][bj][m][0], b = acc[ai][bj][m][1]; const float v[8] = {a[0], a[1], a[2], a[3], b[0], b[1], b[2], b[3]};
                    f(row, col0, v); } }
    }
};
template <class Epi, class Sched, bool ALIGN_EPI>
__device__ __forceinline__ void gemm_phase(PG8_LAS unsigned char* lds, const Gemm g, const Sched& S, const Epi& E) {
    const int tid = opaque_tid(), wid = __builtin_amdgcn_readfirstlane(tid >> 6), lane = tid & 63, wr = wid >> 2, wc = wid & 3, fr = lane & 15, fq = lane >> 4;
    const int K = g.K, nt = K / BK, lda = g.lda;
    unsigned voffA[2], voffB[2];
#pragma unroll
    for (int i = 0; i < 2; ++i) { int R, C; stage_rc(tid * 16 + i * 8192, R, C); const int Rb = Epi::PERM ? ((R & ~31) + perm32(R & 31)) : R;
        voffA[i] = (unsigned)(R * lda + C) * 2u; voffB[i] = (unsigned)(Rb * K + C) * 2u; }
    const size_t kstep = (size_t)(BK * 2);
    const size_t hstepA = (size_t)HALF * lda * 2, hstepB = (size_t)HALF * K * 2;
    const size_t tstepA = 2 * hstepA, tstepB = 2 * hstepB;
    const unsigned ldsw = (unsigned)wid * 1024u;
    const int aoff = lds_byte(wr * 64 + fr, fq * 8), boff = lds_byte(wc * 32 + fr, fq * 8);
#define PG8_SA(b, h) (((b) * 2 + (h)) * HTB)
#define PG8_SB(b, h) ((4 + (b) * 2 + (h)) * HTB)
#define PG8_STAGE(bufoff, gbase, voff) do { _Pragma("unroll") for (int _i = 0; _i < 2; ++_i) \
        __builtin_amdgcn_global_load_lds((const unsigned*)((const char*)(gbase) + (voff)[_i]), (PG8_LAS unsigned*)(lds + (bufoff) + ldsw + _i * 8192), 16, 0, 0); } while (0)
#define PG8_LDA(dst, b, h) do { _Pragma("unroll") for (int m = 0; m < 4; ++m) _Pragma("unroll") for (int k = 0; k < 2; ++k) dst[m][k] = *(const PG8_LAS bf16x8*)(lds + PG8_SA(b, h) + aoff + m * 2048 + k * 1024); } while (0)
#define PG8_LDB(dst, b, h) do { _Pragma("unroll") for (int n = 0; n < 2; ++n) _Pragma("unroll") for (int k = 0; k < 2; ++k) dst[n][k] = *(const PG8_LAS bf16x8*)(lds + PG8_SB(b, h) + boff + n * 2048 + k * 1024); } while (0)
#define PG8_MMA(ai, bj, At, Bt) do { __builtin_amdgcn_s_setprio(1); _Pragma("unroll") for (int m = 0; m < 4; ++m) _Pragma("unroll") for (int n = 0; n < 2; ++n) _Pragma("unroll") for (int k = 0; k < 2; ++k) \
        acc[ai][bj][m][n] = __builtin_amdgcn_mfma_f32_16x16x32_bf16(Bt[n][k], At[m][k], acc[ai][bj][m][n], 0, 0, 0); __builtin_amdgcn_s_setprio(0); } while (0)
#define PG8_WAIT_V(n) asm volatile("s_waitcnt vmcnt(" #n ")" ::: "memory")
#define PG8_WAIT_L(n) asm volatile("s_waitcnt lgkmcnt(" #n ")" ::: "memory")
#define PG8_BAR __builtin_amdgcn_s_barrier()
#define PG8_SCHED __builtin_amdgcn_sched_barrier(0)
    Unit cur, nxt; int ui = 0;
    if (!S.next(0, cur)) return;
    f32x4 acc[2][2][4][2];
#pragma unroll
    for (int a = 0; a < 2; ++a)
#pragma unroll
        for (int b = 0; b < 2; ++b)
#pragma unroll
            for (int m = 0; m < 4; ++m)
#pragma unroll
                for (int n = 0; n < 2; ++n) acc[a][b][m][n] = (f32x4){0.f, 0.f, 0.f, 0.f};
    bf16x8 At[4][2], B0[2][2], B1[2][2];
    const char* cA = (const char*)g.A + (size_t)cur.pm * tstepA; const char* cB = (const char*)g.Bt + (size_t)cur.pn * tstepB;
    PG8_STAGE(PG8_SB(0, 0), cB, voffB); PG8_STAGE(PG8_SB(0, 1), cB + hstepB, voffB); PG8_STAGE(PG8_SA(0, 0), cA, voffA); PG8_STAGE(PG8_SA(0, 1), cA + hstepA, voffA);
    if (wr == 1) PG8_BAR;
    PG8_WAIT_V(2); PG8_BAR;
    PG8_STAGE(PG8_SB(1, 0), cB + kstep, voffB); PG8_STAGE(PG8_SA(1, 0), cA + kstep, voffA); PG8_STAGE(PG8_SB(1, 1), cB + hstepB + kstep, voffB);
    PG8_WAIT_V(6); PG8_BAR;
    for (;;) {
        const bool has_next = S.next(ui + 1, nxt);
        const char* nA = has_next ? (const char*)g.A + (size_t)nxt.pm * tstepA : cA; const char* nB = has_next ? (const char*)g.Bt + (size_t)nxt.pn * tstepB : cB;
        for (int t = 0; t < nt; t += 2) {
            const bool last = (t == nt - 2);
            const char* a1 = cA + (size_t)(t + 1) * kstep;
            const char* a2 = last ? nA : cA + (size_t)(t + 2) * kstep; const char* b2 = last ? nB : cB + (size_t)(t + 2) * kstep;
            const char* a3 = a2 + kstep; const char* b3 = b2 + kstep;
            PG8_LDB(B0, 0, 0); PG8_LDB(B1, 0, 1); PG8_SCHED; PG8_LDA(At, 0, 0); PG8_STAGE(PG8_SA(1, 1), a1 + hstepA, voffA);
            PG8_WAIT_V(8); PG8_WAIT_L(0); PG8_BAR; PG8_MMA(0, 0, At, B0); PG8_MMA(0, 1, At, B1); PG8_BAR; PG8_SCHED;
            PG8_LDA(At, 0, 1); PG8_STAGE(PG8_SB(0, 0), b2, voffB); PG8_STAGE(PG8_SB(0, 1), b2 + hstepB, voffB); PG8_STAGE(PG8_SA(0, 0), a2, voffA);
            PG8_WAIT_V(8); PG8_WAIT_L(0); PG8_BAR; PG8_MMA(1, 0, At, B0); PG8_MMA(1, 1, At, B1); PG8_BAR; PG8_SCHED;
            PG8_LDB(B0, 1, 0); PG8_LDB(B1, 1, 1); PG8_SCHED; PG8_LDA(At, 1, 0); PG8_STAGE(PG8_SA(0, 1), a2 + hstepA, voffA);
            PG8_WAIT_V(8); PG8_WAIT_L(0); PG8_BAR; PG8_MMA(0, 0, At, B0); PG8_MMA(0, 1, At, B1); PG8_BAR; PG8_SCHED;
            PG8_LDA(At, 1, 1); PG8_STAGE(PG8_SB(1, 0), b3, voffB); PG8_STAGE(PG8_SB(1, 1), b3 + hstepB, voffB); PG8_STAGE(PG8_SA(1, 0), a3, voffA);
            PG8_WAIT_V(8); PG8_WAIT_L(0); PG8_BAR; PG8_MMA(1, 0, At, B0); PG8_MMA(1, 1, At, B1); PG8_BAR; PG8_SCHED;
        }
        if constexpr (ALIGN_EPI) { if (wr == 0) PG8_BAR; }
        E(acc, cur, wr, wc, fr, fq);
        if (!has_next) break;
#pragma unroll
        for (int a = 0; a < 2; ++a)
#pragma unroll
            for (int b = 0; b < 2; ++b)
#pragma unroll
                for (int m = 0; m < 4; ++m)
#pragma unroll
                    for (int n = 0; n < 2; ++n) acc[a][b][m][n] = (f32x4){0.f, 0.f, 0.f, 0.f};
        cur = nxt; cA = nA; cB = nB; ++ui;
        if constexpr (ALIGN_EPI) { if (wr == 1) PG8_BAR; }
    }
    PG8_WAIT_V(0);
    if constexpr (!ALIGN_EPI) { if (wr == 0) PG8_BAR; }
    PG8_BAR;
#undef PG8_SA
#undef PG8_SB
#undef PG8_STAGE
#undef PG8_LDA
#undef PG8_LDB
#undef PG8_MMA
#undef PG8_WAIT_V
#undef PG8_WAIT_L
#undef PG8_BAR
#undef PG8_SCHED
}
}
constexpr int LDS_BYTES = 148480;
namespace dattn {
#define DA_LAS __attribute__((address_space(3)))
typedef short bf16x8 __attribute__((ext_vector_type(8)));
typedef short s16x4 __attribute__((ext_vector_type(4)));
typedef float f32x16 __attribute__((ext_vector_type(16)));
constexpr int KP = 272, VP = 320, KBUF = 64 * KP, VBUF = 64 * VP, BUF = KBUF + VBUF, XOFF = 2 * BUF, LDS_NEED = XOFF + 65536;
static_assert(LDS_NEED <= 147456, "attention LDS");
__device__ __forceinline__ unsigned cvtpk(float lo, float hi) { typedef float f2 __attribute__((ext_vector_type(2))); typedef __bf16 b2 __attribute__((ext_vector_type(2))); f2 v = {lo, hi}; b2 b = __builtin_convertvector(v, b2); return __builtin_bit_cast(unsigned, b); }
__device__ __forceinline__ s16x4 vtr(const DA_LAS unsigned char* p) { typedef short v4i16_t __attribute__((ext_vector_type(4))); return __builtin_bit_cast(s16x4, __builtin_amdgcn_ds_read_tr16_b64_v4i16((DA_LAS v4i16_t*)p)); }
template <bool STORE = true> __device__ __forceinline__ void unit(DA_LAS unsigned char* lds, bf16_t* Hb, int h, int qb, const float* __restrict__ subln_w, float lam) {
    const int tid = opaque_tid(), lane = tid & 63, w = __builtin_amdgcn_readfirstlane(tid >> 6), mp = w >> 2, rb = w & 3, c32 = lane & 31, hh = lane >> 5;
    const int qrow = 128 * qb + 32 * rb + c32;
    bf16x8 qf[4];
    { const bf16_t* qp = Hb + (size_t)qrow * HP_ + HC_Q + h * 128 + 64 * mp + 8 * hh;
#pragma unroll
      for (int s = 0; s < 4; ++s) qf[s] = *(const bf16x8*)(qp + 16 * s); }
    const int srow = tid >> 4, sch = tid & 15;
    const bf16_t* kg = Hb + HC_K + h * 128 + sch * 8; const bf16_t* vg = Hb + HC_V + h * 128 + sch * 8;
    const int nt = 2 * qb + 2;
    u32x4 kr[2], vr[2];
#define DA_LOAD(t) do { _Pragma("unroll") for (int j = 0; j < 2; ++j) { const size_t ro = (size_t)(64 * (t) + srow + 32 * j) * HP_; kr[j] = *(const u32x4*)(kg + ro); vr[j] = *(const u32x4*)(vg + ro); } } while (0)
#define DA_WRITE(buf) do { _Pragma("unroll") for (int j = 0; j < 2; ++j) { *(DA_LAS u32x4*)(lds + (buf) * BUF + (srow + 32 * j) * KP + sch * 16) = kr[j]; *(DA_LAS u32x4*)(lds + (buf) * BUF + KBUF + (srow + 32 * j) * VP + sch * 16) = vr[j]; } } while (0)
    DA_LOAD(0); DA_WRITE(0);
    __syncthreads();
    f32x16 oT[4];
#pragma unroll
    for (int i = 0; i < 4; ++i) oT[i] = (f32x16){0.f, 0.f, 0.f, 0.f, 0.f, 0.f, 0.f, 0.f, 0.f, 0.f, 0.f, 0.f, 0.f, 0.f, 0.f, 0.f};
    float mrow = -INFINITY, lrow = 0.f;
    const int koff = c32 * KP + (64 * mp + 8 * hh) * 2;
    const int voff = KBUF + (4 * hh + ((lane & 15) >> 2)) * VP + (16 * ((lane >> 4) & 1) + 4 * (lane & 3)) * 2;
    for (int t = 0; t < nt; ++t) {
        const int cur = t & 1;
        if (t + 1 < nt) DA_LOAD(t + 1);
        if (!(t == nt - 1 && rb <= 1)) {
            const DA_LAS unsigned char* kb = lds + cur * BUF + koff;
            f32x16 s0 = (f32x16){0.f, 0.f, 0.f, 0.f, 0.f, 0.f, 0.f, 0.f, 0.f, 0.f, 0.f, 0.f, 0.f, 0.f, 0.f, 0.f}, s1 = s0;
            bf16x8 kf0[4], kf1[4];
#pragma unroll
            for (int s = 0; s < 4; ++s) { kf0[s] = *(const DA_LAS bf16x8*)(kb + s * 32); kf1[s] = *(const DA_LAS bf16x8*)(kb + 32 * KP + s * 32); }
            __builtin_amdgcn_s_setprio(1);
#pragma unroll
            for (int s = 0; s < 4; ++s) {
                s0 = __builtin_amdgcn_mfma_f32_32x32x16_bf16(kf0[s], qf[s], s0, 0, 0, 0);
                s1 = __builtin_amdgcn_mfma_f32_32x32x16_bf16(kf1[s], qf[s], s1, 0, 0, 0);
            }
            __builtin_amdgcn_s_setprio(0);
            if (t >= nt - 2) {
                const int k0 = 64 * t + 4 * hh;
#pragma unroll
                for (int r = 0; r < 16; ++r) { const int key = k0 + (r & 3) + 8 * (r >> 2); if (key > qrow) s0[r] = -INFINITY; if (key + 32 > qrow) s1[r] = -INFINITY; }
            }
            float mx = fmaxf(s0[0], s1[0]);
#pragma unroll
            for (int r = 1; r < 16; ++r) mx = fmaxf(mx, fmaxf(s0[r], s1[r]));
            mx = fmaxf(mx, __shfl_xor(mx, 32));
            if (__any(mx > mrow + 8.f)) {
                const float mnew = fmaxf(mrow, mx), alpha = __builtin_amdgcn_exp2f(mrow - mnew);
                mrow = mnew; lrow *= alpha;
#pragma unroll
                for (int i = 0; i < 4; ++i)
#pragma unroll
                    for (int r = 0; r < 16; ++r) oT[i][r] *= alpha;
            }
            float ps = 0.f;
#pragma unroll
            for (int r = 0; r < 16; ++r) { s0[r] = __builtin_amdgcn_exp2f(s0[r] - mrow); s1[r] = __builtin_amdgcn_exp2f(s1[r] - mrow); ps += s0[r] + s1[r]; }
            lrow += ps;
            bf16x8 pf[2][2];
#pragma unroll
            for (int s = 0; s < 2; ++s) {
                u32x4 a, b;
                a.x = cvtpk(s0[8 * s], s0[8 * s + 1]); a.y = cvtpk(s0[8 * s + 2], s0[8 * s + 3]); a.z = cvtpk(s0[8 * s + 4], s0[8 * s + 5]); a.w = cvtpk(s0[8 * s + 6], s0[8 * s + 7]);
                b.x = cvtpk(s1[8 * s], s1[8 * s + 1]); b.y = cvtpk(s1[8 * s + 2], s1[8 * s + 3]); b.z = cvtpk(s1[8 * s + 4], s1[8 * s + 5]); b.w = cvtpk(s1[8 * s + 6], s1[8 * s + 7]);
                pf[0][s] = __builtin_bit_cast(bf16x8, a); pf[1][s] = __builtin_bit_cast(bf16x8, b);
            }
            const DA_LAS unsigned char* vb = lds + cur * BUF + voff;
#define DA_LDV(dst, db) do { _Pragma("unroll") for (int i_ = 0; i_ < 4; ++i_) { const s16x4 lo_ = vtr(vb + (16 * i_) * VP + (db) * 64), hi_ = vtr(vb + (16 * i_ + 8) * VP + (db) * 64); \
                dst[i_] = (bf16x8){lo_[0], lo_[1], lo_[2], lo_[3], hi_[0], hi_[1], hi_[2], hi_[3]}; } } while (0)
#define DA_MM(src, db) do { _Pragma("unroll") for (int i_ = 0; i_ < 4; ++i_) oT[db] = __builtin_amdgcn_mfma_f32_32x32x16_bf16(src[i_], pf[i_ >> 1][i_ & 1], oT[db], 0, 0, 0); } while (0)
            bf16x8 va[4], vq[4];
            DA_LDV(va, 0);
            DA_LDV(vq, 1); __builtin_amdgcn_s_setprio(1); DA_MM(va, 0); __builtin_amdgcn_s_setprio(0);
            DA_LDV(va, 2); __builtin_amdgcn_s_setprio(1); DA_MM(vq, 1); __builtin_amdgcn_s_setprio(0);
            DA_LDV(vq, 3); __builtin_amdgcn_s_setprio(1); DA_MM(va, 2); __builtin_amdgcn_s_setprio(0);
            __builtin_amdgcn_s_setprio(1); DA_MM(vq, 3);
#undef DA_LDV
#undef DA_MM
            __builtin_amdgcn_s_setprio(0);
        }
        if (t + 1 < nt) DA_WRITE(cur ^ 1);
        __syncthreads();
    }
#undef DA_LOAD
#undef DA_WRITE
    const float inv = 1.f / (lrow + __shfl_xor(lrow, 32));
    DA_LAS float* X = (DA_LAS float*)(lds + XOFF) + rb * 4096 + lane;
    if (mp == 1) {
#pragma unroll
        for (int i = 0; i < 4; ++i)
#pragma unroll
            for (int r = 0; r < 16; ++r) X[(i * 16 + r) * 64] = oT[i][r] * inv;
    }
    __syncthreads();
    if (mp == 0) {
        float ss = 0.f;
#pragma unroll
        for (int i = 0; i < 4; ++i)
#pragma unroll
            for (int r = 0; r < 16; ++r) { const float o = oT[i][r] * inv - lam * X[(i * 16 + r) * 64]; oT[i][r] = o; ss += o * o; }
        ss += __shfl_xor(ss, 32);
        const float rr = rsqrtf(ss * (1.f / 128.f) + 1e-5f) * (1.f - LAMBDA_INIT);
        bf16_t* op = Hb + (size_t)qrow * HP_ + HC_Q + h * 128 + 4 * hh;
#pragma unroll
        for (int i = 0; i < 4; ++i)
#pragma unroll
            for (int g = 0; g < 4; ++g) { const int d0 = 32 * i + 8 * g; const f32x4 sw = *(const f32x4*)(subln_w + d0 + 4 * hh);
                uint2 o; o.x = pk2(oT[i][4 * g] * rr * sw.x, oT[i][4 * g + 1] * rr * sw.y); o.y = pk2(oT[i][4 * g + 2] * rr * sw.z, oT[i][4 * g + 3] * rr * sw.w);
                if (STORE || o.x == 0x12345u) *(uint2*)(op + d0) = o; }
    }
    __syncthreads();
}
}
namespace ssd {
#define SS_LAS __attribute__((address_space(3)))
typedef short bf16x8 __attribute__((ext_vector_type(8)));
typedef short s16x4 __attribute__((ext_vector_type(4)));
typedef float f32x16 __attribute__((ext_vector_type(16)));
constexpr int XP = 192;
constexpr int BPT = 320;
constexpr int CP = 272;
__device__ __forceinline__ s16x4 vtr(const SS_LAS unsigned char* p) { typedef short v4i16_t __attribute__((ext_vector_type(4))); return __builtin_bit_cast(s16x4, __builtin_amdgcn_ds_read_tr16_b64_v4i16((SS_LAS v4i16_t*)p)); }
__device__ __forceinline__ unsigned cvtpk(float lo, float hi) { typedef float f2 __attribute__((ext_vector_type(2))); typedef __bf16 b2 __attribute__((ext_vector_type(2))); f2 v = {lo, hi}; b2 b = __builtin_convertvector(v, b2); return __builtin_bit_cast(unsigned, b); }
__device__ __forceinline__ void acs_tables(SS_LAS float* ACS, SS_LAS float* DTS, const float* __restrict__ DTb, const float* __restrict__ a_log, int c, int g) {
    const int tid_ = opaque_tid(); const int lane = tid_ & 63, e = __builtin_amdgcn_readfirstlane(tid_ >> 6), h = 8 * g + e;
    const float a = -expf(a_log[h]);
    const float d0 = DTb[(size_t)(128 * c + 2 * lane) * 32 + h], d1 = DTb[(size_t)(128 * c + 2 * lane + 1) * 32 + h];
    const float a0 = d0 * a, a1 = d1 * a;
    float sc = a0 + a1;
#pragma unroll
    for (int o = 1; o < 64; o <<= 1) { const float v = __shfl_up(sc, o); if (lane >= o) sc += v; }
    const float ex = sc - (a0 + a1);
    ACS[(2 * lane) * 8 + e] = ex + a0; ACS[(2 * lane + 1) * 8 + e] = ex + a0 + a1;
    DTS[(2 * lane) * 8 + e] = d0; DTS[(2 * lane + 1) * 8 + e] = d1;
}
template <int NT, class F> __device__ __forceinline__ void conv_item(const bf16_t* __restrict__ Hb, int t0, int l0, int xch0, const float* __restrict__ conv_w, const float* __restrict__ conv_b, F sink) {
    float w[4][8], bias[8];
#pragma unroll
    for (int j = 0; j < 4; ++j) { const f32x4 a = *(const f32x4*)(conv_w + j * DXBC + xch0), b = *(const f32x4*)(conv_w + j * DXBC + xch0 + 4); w[j][0] = a.x; w[j][1] = a.y; w[j][2] = a.z; w[j][3] = a.w; w[j][4] = b.x; w[j][5] = b.y; w[j][6] = b.z; w[j][7] = b.w; }
    { const f32x4 a = *(const f32x4*)(conv_b + xch0), b = *(const f32x4*)(conv_b + xch0 + 4); bias[0] = a.x; bias[1] = a.y; bias[2] = a.z; bias[3] = a.w; bias[4] = b.x; bias[5] = b.y; bias[6] = b.z; bias[7] = b.w; }
    const bf16_t* src = Hb + HC_XBC + xch0;
    u32x4 rw[NT + 3];
#pragma unroll
    for (int i = 0; i < NT + 3; ++i) { const int tt = t0 + l0 - 3 + i; rw[i] = *(const u32x4*)(src + (size_t)(tt < 0 ? 0 : tt) * HP_); }
    if (t0 + l0 < 3) {
#pragma unroll
        for (int i = 0; i < 3; ++i) if (t0 + l0 - 3 + i < 0) rw[i] = (u32x4){0u, 0u, 0u, 0u};
    }
#define SS_UNP(dst, q_) do { dst[0] = bflo(q_.x); dst[1] = bfhi(q_.x); dst[2] = bflo(q_.y); dst[3] = bfhi(q_.y); dst[4] = bflo(q_.z); dst[5] = bfhi(q_.z); dst[6] = bflo(q_.w); dst[7] = bfhi(q_.w); } while (0)
    float x0[8], x1[8], x2[8];
    SS_UNP(x0, rw[0]); SS_UNP(x1, rw[1]); SS_UNP(x2, rw[2]);
#pragma unroll
    for (int i = 0; i < NT; ++i) {
        float x3[8]; SS_UNP(x3, rw[3 + i]);
        float v[8];
#pragma unroll
        for (int k = 0; k < 8; ++k) { const float a = bias[k] + w[0][k] * x0[k] + w[1][k] * x1[k] + w[2][k] * x2[k] + w[3][k] * x3[k]; v[k] = a * __builtin_amdgcn_rcpf(1.f + __expf(-a)); x0[k] = x1[k]; x1[k] = x2[k]; x2[k] = x3[k]; }
        sink(l0 + i, v);
    }
#undef SS_UNP
}
constexpr int A_BS = 0, A_XD = 128 * BPT  , A_ACS = A_XD + 2 * 128 * XP  , A_DTS = A_ACS + 4096, A_END = A_DTS + 4096;
__device__ __forceinline__ void phaseA_unit(SS_LAS unsigned char* lds, const bf16_t* __restrict__ Hb, const float* __restrict__ DTb, const float* __restrict__ conv_w, const float* __restrict__ conv_b,
                                            const float* __restrict__ a_log, bf16_t* __restrict__ ST, float* __restrict__ CD, int c, int g) {
    const int tid = opaque_tid(), lane = tid & 63, w = __builtin_amdgcn_readfirstlane(tid >> 6), c32 = lane & 31, hh = lane >> 5;
    SS_LAS float* ACS = (SS_LAS float*)(lds + A_ACS); SS_LAS float* DTS = (SS_LAS float*)(lds + A_DTS);
    acs_tables(ACS, DTS, DTb, a_log, c, g);
    __syncthreads();
    if (tid < 8) CD[c * 32 + 8 * g + tid] = __expf(ACS[127 * 8 + tid]);
    auto stageX = [&](int e, int item, int buf) {
        const int cg = item >> 5, seg = item & 31; const float aend = ACS[127 * 8 + e];
        conv_item<4>(Hb, 128 * c, 4 * seg, g * 512 + e * 64 + cg * 8, conv_w, conv_b, [&](int l, const float (&v)[8]) {
            const float sc = DTS[l * 8 + e] * __expf(aend - ACS[l * 8 + e]);
            u32x4 o; o.x = cvtpk(v[0] * sc, v[1] * sc); o.y = cvtpk(v[2] * sc, v[3] * sc); o.z = cvtpk(v[4] * sc, v[5] * sc); o.w = cvtpk(v[6] * sc, v[7] * sc);
            *(SS_LAS u32x4*)(lds + A_XD + buf * 128 * XP + l * XP + cg * 16) = o; });
    };
    { const int cg = tid >> 5, seg = tid & 31;
        conv_item<4>(Hb, 128 * c, 4 * seg, 2048 + g * 128 + cg * 8, conv_w, conv_b, [&](int l, const float (&v)[8]) {
            u32x4 o; o.x = cvtpk(v[0], v[1]); o.y = cvtpk(v[2], v[3]); o.z = cvtpk(v[4], v[5]); o.w = cvtpk(v[6], v[7]);
            *(SS_LAS u32x4*)(lds + A_BS + l * BPT + cg * 16) = o; }); }
    if (tid < 256) stageX(0, tid, 0);
    __syncthreads();
    const int pb = w & 1, nb = w >> 1;
    const int rsel = ((lane & 15) >> 2), csel = 16 * ((lane >> 4) & 1) + 4 * (lane & 3);
    for (int e = 0; e < 8; ++e) {
        if (e + 1 < 8 && tid >= 256) stageX(e + 1, tid - 256, (e + 1) & 1);
        f32x16 acc = (f32x16){0.f, 0.f, 0.f, 0.f, 0.f, 0.f, 0.f, 0.f, 0.f, 0.f, 0.f, 0.f, 0.f, 0.f, 0.f, 0.f};
        const SS_LAS unsigned char* bp = lds + A_BS + (8 * hh + rsel) * BPT + (32 * nb + csel) * 2;
        const SS_LAS unsigned char* xp = lds + A_XD + (e & 1) * 128 * XP + (8 * hh + rsel) * XP + (32 * pb + csel) * 2;
#pragma unroll
        for (int ks = 0; ks < 8; ++ks) {
            const s16x4 b0 = vtr(bp + (16 * ks) * BPT), b1 = vtr(bp + (16 * ks + 4) * BPT), x0 = vtr(xp + (16 * ks) * XP), x1 = vtr(xp + (16 * ks + 4) * XP);
            const bf16x8 bf = (bf16x8){b0[0], b0[1], b0[2], b0[3], b1[0], b1[1], b1[2], b1[3]}, xf = (bf16x8){x0[0], x0[1], x0[2], x0[3], x1[0], x1[1], x1[2], x1[3]};
            acc = __builtin_amdgcn_mfma_f32_32x32x16_bf16(bf, xf, acc, 0, 0, 0);
        }
        bf16_t* sp = ST + ((size_t)(c * 32 + 8 * g + e) * 64 + 32 * pb + c32) * 128 + 32 * nb + 4 * hh;
#pragma unroll
        for (int q = 0; q < 4; ++q) { uint2 o; o.x = cvtpk(acc[4 * q], acc[4 * q + 1]); o.y = cvtpk(acc[4 * q + 2], acc[4 * q + 3]); *(uint2*)(sp + 8 * q) = o; }
        __syncthreads();
    }
}
__device__ __forceinline__ void scan_phase(bf16_t* __restrict__ ST, const float* __restrict__ CD, int gtid) {
    const int h = gtid >> 12;
    unsigned* p = (unsigned*)ST + gtid;
    float r0 = 0.f, r1 = 0.f;
    for (int c0 = 0; c0 < 64; c0 += 16) {
        unsigned v[16]; float d[16];
#pragma unroll
        for (int i = 0; i < 16; ++i) { v[i] = p[(size_t)(c0 + i) * 131072]; d[i] = CD[(c0 + i) * 32 + h]; }
#pragma unroll
        for (int i = 0; i < 16; ++i) { p[(size_t)(c0 + i) * 131072] = cvtpk(r0, r1); r0 = r0 * d[i] + bflo(v[i]); r1 = r1 * d[i] + bfhi(v[i]); }
    }
}
constexpr int C_CS = 0, C_BS = 128 * CP  , C_X1 = C_BS  , C_CBT = 2 * 128 * CP  , C_X0 = C_CBT + 32768  , C_ACS = C_X0 + 128 * XP  , C_DTS = C_ACS + 4096,
              C_SSQ = C_DTS + 4096, C_END = C_SSQ + 1024;
static_assert(C_END <= 147456 && 128 * XP <= 128 * CP, "ssd phase C LDS");
template <bool STORE = true> __device__ __forceinline__ void phaseC_unit(SS_LAS unsigned char* lds, bf16_t* __restrict__ Hb, const float* __restrict__ DTb, const float* __restrict__ conv_w, const float* __restrict__ conv_b,
                                            const float* __restrict__ a_log, const float* __restrict__ d_skip, const float* __restrict__ norm_w, const bf16_t* __restrict__ ST, int c, int g) {
    const int tid = opaque_tid(), lane = tid & 63, w = __builtin_amdgcn_readfirstlane(tid >> 6), c32 = lane & 31, hh = lane >> 5;
    SS_LAS float* ACS = (SS_LAS float*)(lds + C_ACS); SS_LAS float* DTS = (SS_LAS float*)(lds + C_DTS); SS_LAS float* SSQ = (SS_LAS float*)(lds + C_SSQ);
    acs_tables(ACS, DTS, DTb, a_log, c, g);
    auto stageX = [&](int e, int item, int buf) {
        const int cg = item >> 5, seg = item & 31;
        conv_item<4>(Hb, 128 * c, 4 * seg, g * 512 + e * 64 + cg * 8, conv_w, conv_b, [&](int l, const float (&v)[8]) {
            u32x4 o; o.x = cvtpk(v[0], v[1]); o.y = cvtpk(v[2], v[3]); o.z = cvtpk(v[4], v[5]); o.w = cvtpk(v[6], v[7]);
            *(SS_LAS u32x4*)(lds + (buf ? C_X1 : C_X0) + l * XP + cg * 16) = o; });
    };
    { const int isC = tid >> 8, it = tid & 255, cg = it >> 4, seg = it & 15;
        conv_item<8>(Hb, 128 * c, 8 * seg, 2048 + isC * 512 + g * 128 + cg * 8, conv_w, conv_b, [&](int l, const float (&v)[8]) {
            u32x4 o; o.x = cvtpk(v[0], v[1]); o.y = cvtpk(v[2], v[3]); o.z = cvtpk(v[4], v[5]); o.w = cvtpk(v[6], v[7]);
            *(SS_LAS u32x4*)(lds + (isC ? C_CS : C_BS) + l * CP + cg * 16) = o; }); }
    if (tid < 256) stageX(0, tid, 0);
    __syncthreads();
    for (int i = w; i < 10; i += 8) {
        const int sb = (i < 4) ? 0 : (i < 7) ? 1 : (i < 9) ? 2 : 3, lb = (i < 4) ? i : (i < 7) ? i - 3 : (i < 9) ? i - 5 : 3;
        f32x16 acc = (f32x16){0.f, 0.f, 0.f, 0.f, 0.f, 0.f, 0.f, 0.f, 0.f, 0.f, 0.f, 0.f, 0.f, 0.f, 0.f, 0.f};
        const SS_LAS unsigned char* bp = lds + C_BS + (32 * sb + c32) * CP + 16 * hh, *cp = lds + C_CS + (32 * lb + c32) * CP + 16 * hh;
#pragma unroll
        for (int ks = 0; ks < 8; ++ks) acc = __builtin_amdgcn_mfma_f32_32x32x16_bf16(*(const SS_LAS bf16x8*)(bp + 32 * ks), *(const SS_LAS bf16x8*)(cp + 32 * ks), acc, 0, 0, 0);
        SS_LAS unsigned* o = (SS_LAS unsigned*)(lds + C_CBT) + (sb * 4 + lb) * 512 + lane;
#pragma unroll
        for (int q = 0; q < 8; ++q) o[q * 64] = cvtpk(acc[2 * q], acc[2 * q + 1]);
    }
    __syncthreads();
    const int pb = w & 1, lb = w >> 1, lrow = 32 * lb + c32;
    const int rsel = ((lane & 15) >> 2), csel = 16 * ((lane >> 4) & 1) + 4 * (lane & 3);
    unsigned ypk[8][8];
    float ssq = 0.f;
    for (int e = 0; e < 8; ++e) {
        const int h = 8 * g + e;
        if (e + 1 < 8 && tid >= 256) stageX(e + 1, tid - 256, (e + 1) & 1);
        const int xoff = (e & 1) ? C_X1 : C_X0;
        f32x16 acc = (f32x16){0.f, 0.f, 0.f, 0.f, 0.f, 0.f, 0.f, 0.f, 0.f, 0.f, 0.f, 0.f, 0.f, 0.f, 0.f, 0.f};
        {
            const bf16_t* pp = ST + ((size_t)(c * 32 + h) * 64 + 32 * pb + c32) * 128 + 8 * hh;
            const SS_LAS unsigned char* cp = lds + C_CS + lrow * CP + 16 * hh;
#pragma unroll
            for (int ks = 0; ks < 8; ++ks) acc = __builtin_amdgcn_mfma_f32_32x32x16_bf16(*(const bf16x8*)(pp + 16 * ks), *(const SS_LAS bf16x8*)(cp + 32 * ks), acc, 0, 0, 0);
        }
        const float al = ACS[lrow * 8 + e], eal = __expf(al);
#pragma unroll
        for (int r = 0; r < 16; ++r) acc[r] *= eal;
        for (int sb = 0; sb <= lb; ++sb) {
            const SS_LAS unsigned* cbp = (const SS_LAS unsigned*)(lds + C_CBT) + (sb * 4 + lb) * 512 + lane;
            float m[16];
#pragma unroll
            for (int q = 0; q < 8; ++q) { const unsigned u = cbp[q * 64]; m[2 * q] = bflo(u); m[2 * q + 1] = bfhi(u); }
#pragma unroll
            for (int r = 0; r < 16; ++r) { const int srow = 32 * sb + (r & 3) + 8 * (r >> 2) + 4 * hh;
                const float f = __expf(al - ACS[srow * 8 + e]) * DTS[srow * 8 + e];
                m[r] = (srow <= lrow) ? m[r] * f : 0.f; }
            const SS_LAS unsigned char* xp = lds + xoff + (32 * sb + 4 * hh + rsel) * XP + (32 * pb + csel) * 2;
#pragma unroll
            for (int ks = 0; ks < 2; ++ks) {
                const s16x4 x0 = vtr(xp + (16 * ks) * XP), x1 = vtr(xp + (16 * ks + 8) * XP);
                const bf16x8 xf = (bf16x8){x0[0], x0[1], x0[2], x0[3], x1[0], x1[1], x1[2], x1[3]};
                u32x4 mm; mm.x = cvtpk(m[8 * ks], m[8 * ks + 1]); mm.y = cvtpk(m[8 * ks + 2], m[8 * ks + 3]); mm.z = cvtpk(m[8 * ks + 4], m[8 * ks + 5]); mm.w = cvtpk(m[8 * ks + 6], m[8 * ks + 7]);
                acc = __builtin_amdgcn_mfma_f32_32x32x16_bf16(xf, __builtin_bit_cast(bf16x8, mm), acc, 0, 0, 0);
            }
        }
        const float dsk = d_skip[h];
        const bf16_t* zp = Hb + (size_t)(128 * c + lrow) * HP_ + HC_Z + g * 512 + e * 64 + 32 * pb + 4 * hh;
        const SS_LAS unsigned char* xr = lds + xoff + lrow * XP + (32 * pb + 4 * hh) * 2;
        unsigned yt[8];
#pragma unroll
        for (int q = 0; q < 4; ++q) {
            const u32x2 zz = *(const u32x2*)(zp + 8 * q); const u32x2 xx = *(const SS_LAS u32x2*)(xr + 16 * q);
            const float zv[4] = {bflo(zz.x), bfhi(zz.x), bflo(zz.y), bfhi(zz.y)}, xv[4] = {bflo(xx.x), bfhi(xx.x), bflo(xx.y), bfhi(xx.y)};
            float y[4];
#pragma unroll
            for (int k = 0; k < 4; ++k) { y[k] = (acc[4 * q + k] + dsk * xv[k]) * (zv[k] * __builtin_amdgcn_rcpf(1.f + __expf(-zv[k]))); ssq += y[k] * y[k]; }
            yt[2 * q] = cvtpk(y[0], y[1]); yt[2 * q + 1] = cvtpk(y[2], y[3]);
        }
#define SS_YSET(E) case E: { _Pragma("unroll") for (int q_ = 0; q_ < 8; ++q_) ypk[E][q_] = yt[q_]; } break;
        switch (e) { SS_YSET(0) SS_YSET(1) SS_YSET(2) SS_YSET(3) SS_YSET(4) SS_YSET(5) SS_YSET(6) default: { _Pragma("unroll") for (int q_ = 0; q_ < 8; ++q_) ypk[7][q_] = yt[q_]; } break; }
#undef SS_YSET
        __syncthreads();
    }
    ssq += __shfl_xor(ssq, 32);
    if (hh == 0) SSQ[pb * 128 + lrow] = ssq;
    __syncthreads();
    const float rstd = rsqrtf((SSQ[lrow] + SSQ[128 + lrow]) * (1.f / 512.f) + 1e-5f);
    bf16_t* op = Hb + (size_t)(128 * c + lrow) * HP_ + HC_Z + g * 512 + 32 * pb + 4 * hh;
    const float* nw = norm_w + g * 512 + 32 * pb + 4 * hh;
#pragma unroll
    for (int e = 0; e < 8; ++e)
#pragma unroll
        for (int q = 0; q < 4; ++q) { const f32x4 n4 = *(const f32x4*)(nw + e * 64 + 8 * q);
            uint2 o; o.x = cvtpk(bflo(ypk[e][2 * q]) * rstd * n4.x, bfhi(ypk[e][2 * q]) * rstd * n4.y); o.y = cvtpk(bflo(ypk[e][2 * q + 1]) * rstd * n4.z, bfhi(ypk[e][2 * q + 1]) * rstd * n4.w);
            if (STORE || o.x == 0x12345u) *(uint2*)(op + e * 64 + 8 * q) = o; }
    __syncthreads();
}
}


namespace psel {
#define PS_LAS __attribute__((address_space(3)))
typedef short bf16x8 __attribute__((ext_vector_type(8)));
typedef float f32x16 __attribute__((ext_vector_type(16)));
__device__ __forceinline__ int ord(float f) { const int b = __builtin_bit_cast(int, f); return b ^ ((b >> 31) & 0x7fffffff); }
__device__ __forceinline__ float unord(int t) { return __builtin_bit_cast(float, t ^ ((t >> 31) & 0x7fffffff)); }
#define PS_INS(top, v) do { int v_ = (v); _Pragma("unroll") for (int i_ = 0; i_ < 16; ++i_) { const int hi_ = max(top[i_], v_); v_ = min(top[i_], v_); top[i_] = hi_; } } while (0)
__device__ __forceinline__ void step(PS_LAS int* EX, const bf16_t* __restrict__ QP, const bf16_t* __restrict__ SUBK, int* __restrict__ IDX, float* __restrict__ GATE, int tok0, int hp) {
    const int tid = opaque_tid(), lane = tid & 63, w1 = __builtin_amdgcn_readfirstlane(tid >> 6), c32 = lane & 31, hh = lane >> 5;
    {
        const int tile = w1 >> 2, hsel = (w1 >> 1) & 1, half = w1 & 1, h = 2 * hp + hsel;
        const bf16_t* qp = QP + (size_t)(tok0 + 32 * tile + c32) * 2048 + h * 256 + half * 128 + 8 * hh;
        const bf16_t* kp = SUBK + ((size_t)(h * 2 + half) * 128 + c32) * 128 + 8 * hh;
        bf16x8 qf[8];
#pragma unroll
        for (int ks = 0; ks < 8; ++ks) qf[ks] = *(const bf16x8*)(qp + 16 * ks);
        int top[16];
#pragma unroll
        for (int i = 0; i < 16; ++i) top[i] = (int)0x80000000;
        bf16x8 kfa[8], kfb[8];
#define PS_LDK(dst, mt_) do { _Pragma("unroll") for (int ks_ = 0; ks_ < 8; ++ks_) dst[ks_] = *(const bf16x8*)(kp + (size_t)(32 * (mt_)) * 128 + 16 * ks_); } while (0)
#define PS_TILE(src, mt_) do { f32x16 acc_ = (f32x16){0.f, 0.f, 0.f, 0.f, 0.f, 0.f, 0.f, 0.f, 0.f, 0.f, 0.f, 0.f, 0.f, 0.f, 0.f, 0.f}; \
            _Pragma("unroll") for (int ks_ = 0; ks_ < 8; ++ks_) acc_ = __builtin_amdgcn_mfma_f32_32x32x16_bf16(src[ks_], qf[ks_], acc_, 0, 0, 0); \
            _Pragma("unroll") for (int r_ = 0; r_ < 16; ++r_) { const int key_ = 32 * (mt_) + (r_ & 3) + 8 * (r_ >> 2) + 4 * hh; const int v__ = (ord(acc_[r_]) & ~127) | (127 - key_); PS_INS(top, v__); } } while (0)
        PS_LDK(kfa, 0);
        PS_LDK(kfb, 1); PS_TILE(kfa, 0);
        PS_LDK(kfa, 2); PS_TILE(kfb, 1);
        PS_LDK(kfb, 3); PS_TILE(kfa, 2);
        PS_TILE(kfb, 3);
#undef PS_LDK
#undef PS_TILE
        int oth[16];
#pragma unroll
        for (int i = 0; i < 16; ++i) oth[i] = __shfl_xor(top[i], 32);
#pragma unroll
        for (int i = 0; i < 16; ++i) PS_INS(top, oth[i]);
        if (hh == 0) {
#pragma unroll
            for (int i = 0; i < 16; ++i) EX[(w1 * 16 + i) * 32 + c32] = top[i];
        }
    }
    __syncthreads();
    if (lane < 16) {
        const int task = w1 * 16 + lane, th = task >> 5, tok32 = task & 31, tile = th >> 1, hsel = th & 1, h = 2 * hp + hsel;
        const PS_LAS int* ea = EX + ((th * 2 + 0) * 16) * 32 + tok32; const PS_LAS int* eb = EX + ((th * 2 + 1) * 16) * 32 + tok32;
        float as[16], bs[16];
#pragma unroll
        for (int i = 0; i < 16; ++i) { as[i] = unord(ea[i * 32] & ~127); bs[i] = unord(eb[i * 32] & ~127); }
        int top[16];
#pragma unroll
        for (int i = 0; i < 16; ++i) top[i] = (int)0x80000000;
#pragma unroll
        for (int i = 0; i < 16; ++i)
#pragma unroll
            for (int j = 0; j < 16; ++j) if ((i + 1) * (j + 1) <= 16) { const int v = (ord(as[i] + bs[j]) & ~255) | (255 - (i * 16 + j)); PS_INS(top, v); }
        float sc[16]; int id[16];
#pragma unroll
        for (int r = 0; r < 16; ++r) { const int cn = 255 - (top[r] & 255), i = cn >> 4, j = cn & 15; const int pa = ea[i * 32], pb = eb[j * 32];
            sc[r] = unord(pa & ~127) + unord(pb & ~127); id[r] = (127 - (pa & 127)) * 128 + (127 - (pb & 127)); }
        float sum = 0.f; const float mx = sc[0];
#pragma unroll
        for (int r = 0; r < 16; ++r) { sc[r] = __expf(sc[r] - mx); sum += sc[r]; }
        const size_t o = (size_t)(tok0 + 32 * tile + tok32) * 128 + h * 16;
        const float inv = 1.f / sum;
#pragma unroll
        for (int r = 0; r < 16; r += 4) { *(f32x4*)(GATE + o + r) = (f32x4){sc[r] * inv, sc[r + 1] * inv, sc[r + 2] * inv, sc[r + 3] * inv}; *(u32x4*)(IDX + o + r) = (u32x4){(unsigned)id[r], (unsigned)id[r + 1], (unsigned)id[r + 2], (unsigned)id[r + 3]}; }
    }
    __syncthreads();
}
}


namespace xattn {
#define XA_LAS __attribute__((address_space(3)))
typedef short bf16x8 __attribute__((ext_vector_type(8)));
typedef short s16x4 __attribute__((ext_vector_type(4)));
typedef float f32x16 __attribute__((ext_vector_type(16)));
constexpr int RP = 528;
__device__ __forceinline__ unsigned cvtpk(float lo, float hi) { typedef float f2 __attribute__((ext_vector_type(2))); typedef __bf16 b2 __attribute__((ext_vector_type(2))); f2 v = {lo, hi}; b2 b = __builtin_convertvector(v, b2); return __builtin_bit_cast(unsigned, b); }
__device__ __forceinline__ void stage(XA_LAS unsigned char* lds, const bf16_t* __restrict__ src, int pitch, int tid) {
#pragma unroll 4
    for (int i = 0; i < 16; ++i) { const int q = tid + 512 * i, row = q >> 5, ch = q & 31; *(XA_LAS u32x4*)(lds + row * RP + ch * 16) = *(const u32x4*)(src + (size_t)row * pitch + ch * 8); }
}
__device__ __forceinline__ void unit(XA_LAS unsigned char* lds, const bf16_t* __restrict__ QC, const bf16_t* __restrict__ KC, const bf16_t* __restrict__ VcT, bf16_t* __restrict__ XO, int tg, int h) {
    const int tid = opaque_tid(), lane = tid & 63, w = __builtin_amdgcn_readfirstlane(tid >> 6), c32 = lane & 31, hh = lane >> 5, b = tg >> 5;
    const int tok = 256 * tg + 32 * w + c32;
    stage(lds, KC + (size_t)b * MEML * D + h * 256, D, tid);
    bf16x8 pf[8][2]; float inv;
    {
        bf16x8 qf[16];
        const bf16_t* qp = QC + (size_t)tok * D + h * 256 + 8 * hh;
#pragma unroll
        for (int ks = 0; ks < 16; ++ks) qf[ks] = *(const bf16x8*)(qp + 16 * ks);
        __syncthreads();
        f32x16 acc[8];
        const XA_LAS unsigned char* kb = lds + c32 * RP + 16 * hh;
#pragma unroll
        for (int mt = 0; mt < 8; ++mt) {
            acc[mt] = (f32x16){0.f, 0.f, 0.f, 0.f, 0.f, 0.f, 0.f, 0.f, 0.f, 0.f, 0.f, 0.f, 0.f, 0.f, 0.f, 0.f};
#pragma unroll
            for (int ks = 0; ks < 16; ++ks) acc[mt] = __builtin_amdgcn_mfma_f32_32x32x16_bf16(*(const XA_LAS bf16x8*)(kb + (32 * mt) * RP + 32 * ks), qf[ks], acc[mt], 0, 0, 0);
        }
        float mx = acc[0][0];
#pragma unroll
        for (int mt = 0; mt < 8; ++mt)
#pragma unroll
            for (int r = 0; r < 16; ++r) mx = fmaxf(mx, acc[mt][r]);
        mx = fmaxf(mx, __shfl_xor(mx, 32));
        float sum = 0.f;
#pragma unroll
        for (int mt = 0; mt < 8; ++mt)
#pragma unroll
            for (int r = 0; r < 16; ++r) { acc[mt][r] = __builtin_amdgcn_exp2f(acc[mt][r] - mx); sum += acc[mt][r]; }
        sum += __shfl_xor(sum, 32); inv = 1.f / sum;
#pragma unroll
        for (int mt = 0; mt < 8; ++mt)
#pragma unroll
            for (int s2 = 0; s2 < 2; ++s2) { u32x4 a; a.x = cvtpk(acc[mt][8 * s2], acc[mt][8 * s2 + 1]); a.y = cvtpk(acc[mt][8 * s2 + 2], acc[mt][8 * s2 + 3]); a.z = cvtpk(acc[mt][8 * s2 + 4], acc[mt][8 * s2 + 5]); a.w = cvtpk(acc[mt][8 * s2 + 6], acc[mt][8 * s2 + 7]);
                pf[mt][s2] = __builtin_bit_cast(bf16x8, a); }
    }
    __syncthreads();
    stage(lds, VcT + ((size_t)b * D + h * 256) * MEML, MEML, tid);
    __syncthreads();
    const XA_LAS unsigned char* vb = lds + c32 * RP + 8 * hh;
    bf16_t* op = XO + (size_t)tok * D + h * 256 + 4 * hh;
#pragma unroll 1
    for (int dt = 0; dt < 8; ++dt) {
        f32x16 acc = (f32x16){0.f, 0.f, 0.f, 0.f, 0.f, 0.f, 0.f, 0.f, 0.f, 0.f, 0.f, 0.f, 0.f, 0.f, 0.f, 0.f};
#pragma unroll
        for (int mt = 0; mt < 8; ++mt)
#pragma unroll
            for (int s2 = 0; s2 < 2; ++s2) {
                const s16x4 lo = *(const XA_LAS s16x4*)(vb + (32 * dt) * RP + (32 * mt + 16 * s2) * 2), hi = *(const XA_LAS s16x4*)(vb + (32 * dt) * RP + (32 * mt + 16 * s2 + 8) * 2);
                const bf16x8 vf = (bf16x8){lo[0], lo[1], lo[2], lo[3], hi[0], hi[1], hi[2], hi[3]};
                acc = __builtin_amdgcn_mfma_f32_32x32x16_bf16(vf, pf[mt][s2], acc, 0, 0, 0);
            }
#pragma unroll
        for (int q = 0; q < 4; ++q) { u32x2 o; o.x = cvtpk(acc[4 * q] * inv, acc[4 * q + 1] * inv); o.y = cvtpk(acc[4 * q + 2] * inv, acc[4 * q + 3] * inv); *(u32x2*)(op + 32 * dt + 8 * q) = o; }
    }
    __syncthreads();
}
}

namespace sp {
#define SP_LAS __attribute__((address_space(3)))
#define SP_LDSWAIT() do { asm volatile("s_waitcnt lgkmcnt(0)" ::: "memory"); } while (0)
__device__ __forceinline__ void transpose_item(const float* __restrict__ W, int ldw, int col0, int K, int nblk, bf16_t* __restrict__ WT, int row_off, SP_LAS float* scr, int item, int lane) {
    const int kb = item / nblk, nb = item % nblk, k0 = 64 * kb, n0 = 32 * nb;
#pragma unroll 8
    for (int i = 0; i < 32; ++i) { const int kk = 2 * i + (lane >> 5); scr[kk * 33 + (lane & 31)] = W[(size_t)(k0 + kk) * ldw + col0 + n0 + (lane & 31)]; }
    SP_LDSWAIT();
    const int cc = lane & 7;
#pragma unroll
    for (int j = 0; j < 4; ++j) { const int n = (lane >> 3) + 8 * j; const SP_LAS float* s = scr + (8 * cc) * 33 + n;
        u32x4 o; o.x = pk2(s[0 * 33], s[1 * 33]); o.y = pk2(s[2 * 33], s[3 * 33]); o.z = pk2(s[4 * 33], s[5 * 33]); o.w = pk2(s[6 * 33], s[7 * 33]);
        *(u32x4*)(WT + (size_t)(row_off + n0 + n) * K + k0 + 8 * cc) = o; }
    SP_LDSWAIT();
}
__device__ __forceinline__ void cvt_range(const float* __restrict__ src, bf16_t* __restrict__ dst, size_t n4, size_t gtid, size_t gthreads) {
    for (size_t i = gtid; i < n4; i += gthreads) { const f32x4 v = ((const f32x4*)src)[i]; u32x2 o; o.x = pk2(v.x, v.y); o.y = pk2(v.z, v.w); ((u32x2*)dst)[i] = o; }
}

__device__ __forceinline__ void cvt_fp8_range(const float* __restrict__ src, unsigned char* __restrict__ dst, size_t n16, float scale, size_t gtid, size_t gthreads) {
    for (size_t i = gtid; i < n16; i += gthreads) {
        const f32x4* sp4 = (const f32x4*)src + 4 * i; u32x4 o; unsigned ow[4];
#pragma unroll
        for (int q = 0; q < 4; ++q) { const f32x4 v = sp4[q];
            const float a = fminf(fmaxf(v.x * scale, -448.f), 448.f), b = fminf(fmaxf(v.y * scale, -448.f), 448.f), c2 = fminf(fmaxf(v.z * scale, -448.f), 448.f), d2 = fminf(fmaxf(v.w * scale, -448.f), 448.f);
            int p = 0; p = __builtin_amdgcn_cvt_pk_fp8_f32(a, b, p, false); p = __builtin_amdgcn_cvt_pk_fp8_f32(c2, d2, p, true); ow[q] = (unsigned)p; }
        o.x = ow[0]; o.y = ow[1]; o.z = ow[2]; o.w = ow[3];
        const size_t e_ = i >> 6, cg_ = i & 63; ((u32x4*)dst)[(cg_ >> 3) * ((size_t)PK * PK * 8) + e_ * 8 + (cg_ & 7)] = o;
    }
}
__device__ __forceinline__ void dt_stage_w(SP_LAS float* Wl, const float* __restrict__ w_in) {
    const int tid = opaque_tid();
#pragma unroll 8
    for (int i = 0; i < 64; ++i) { const int idx = tid + 512 * i; Wl[idx] = w_in[(size_t)(idx >> 5) * NIN + 5120 + (idx & 31)]; }
}
__device__ __forceinline__ void dt_item(SP_LAS float* Wl, SP_LAS float* xs, SP_LAS float* part, const float* __restrict__ x, const float* __restrict__ dt_bias, float* __restrict__ DT, int item) {
    const int tid = opaque_tid(), lane = tid & 63, w = tid >> 6, m0 = item * 4;
#pragma unroll
    for (int i = 0; i < 2; ++i) { const int q = tid + 512 * i; *(SP_LAS f32x4*)(xs + 4 * q) = ((const f32x4*)(x + (size_t)m0 * D))[q]; }
    __syncthreads();
    const int h = lane & 31, r = w >> 1, kq = (w & 1) * 2 + (lane >> 5);
    const SP_LAS float* xp = xs + r * 1024 + kq * 256; const SP_LAS float* wp = Wl + (kq * 256) * 32 + h;
    float a0 = 0.f, a1 = 0.f;
#pragma unroll 8
    for (int k = 0; k < 256; k += 2) { a0 = fmaf(xp[k], wp[k * 32], a0); a1 = fmaf(xp[k + 1], wp[(k + 1) * 32], a1); }
    float acc = a0 + a1;
    acc += __shfl_xor(acc, 32);
    if ((w & 1) && lane < 32) part[r * 32 + h] = acc;
    __syncthreads();
    if (!(w & 1) && lane < 32) { const float v = acc + part[r * 32 + h] + dt_bias[h]; DT[(size_t)(m0 + r) * 32 + h] = v > 20.f ? v : log1pf(expf(v)); }
}
__device__ __forceinline__ void ln_row(float* __restrict__ X, const float* __restrict__ g, const float* __restrict__ b, bf16_t* __restrict__ XB, int row, int lane) {
    f32x4* xr = (f32x4*)(X + (size_t)row * D) + lane;
    f32x4 v[4]; float s = 0.f;
#pragma unroll
    for (int j = 0; j < 4; ++j) { v[j] = xr[64 * j]; s += (v[j].x + v[j].y) + (v[j].z + v[j].w); }
    const float mean = wave_sum(s) * (1.f / D); float s2 = 0.f;
#pragma unroll
    for (int j = 0; j < 4; ++j) { v[j] = v[j] - mean; s2 += (v[j].x * v[j].x + v[j].y * v[j].y) + (v[j].z * v[j].z + v[j].w * v[j].w); }
    const float rstd = rsqrtf(wave_sum(s2) * (1.f / D) + 1e-5f);
#pragma unroll
    for (int j = 0; j < 4; ++j) { const int c = 4 * lane + 256 * j; const f32x4 gg = *(const f32x4*)(g + c), bb = *(const f32x4*)(b + c);
        f32x4 o = v[j] * rstd * gg + bb; xr[64 * j] = o;
        u32x2 pb; pb.x = pk2(o.x, o.y); pb.y = pk2(o.z, o.w); *(u32x2*)(XB + (size_t)row * D + c) = pb; }
}
__device__ __forceinline__ void xattn_pair(SP_LAS float* L, const bf16_t* __restrict__ QC, const bf16_t* __restrict__ KCVC, bf16_t* __restrict__ XO, int tok0) {
    const int t512 = opaque_tid(); const int half = t512 >> 8, tid = t512 & 255, lane = tid & 63, wv = tid >> 6, tok = tok0 + half, b = tok / SEQ;
    SP_LAS float* qs = L + half * 1024; SP_LAS float* ps = L + 2048 + half * 256; SP_LAS float* red = L + 2560 + half * 8;
    for (int i = tid; i < 1024; i += 256) qs[i] = bf2f(QC[(size_t)tok * D + i]);
    __syncthreads();
    const bf16_t* KV = KCVC + (size_t)b * MEML * 2048;
    for (int h = 0; h < MH; ++h) {
        const bf16_t* kp = KV + (size_t)tid * 2048 + h * 256;
        float s = 0.f;
        for (int d = 0; d < 256; d += 8) { const u32x4 w = *(const u32x4*)(kp + d); const SP_LAS float* q = qs + h * 256 + d;
            s += q[0] * bflo(w.x) + q[1] * bfhi(w.x) + q[2] * bflo(w.y) + q[3] * bfhi(w.y) + q[4] * bflo(w.z) + q[5] * bfhi(w.z) + q[6] * bflo(w.w) + q[7] * bfhi(w.w); }
        float mx = wave_max(s); if (lane == 0) red[wv] = mx; __syncthreads();
        mx = fmaxf(fmaxf(red[0], red[1]), fmaxf(red[2], red[3]));
        const float p = exp2f(s - mx);
        float sm = wave_sum(p); if (lane == 0) red[4 + wv] = sm; ps[tid] = p; __syncthreads();
        sm = (red[4] + red[5]) + (red[6] + red[7]);
        float o = 0.f;
        for (int j = 0; j < 256; ++j) o = fmaf(ps[j], bf2f(KV[(size_t)j * 2048 + 1024 + h * 256 + tid]), o);
        XO[(size_t)tok * D + h * 256 + tid] = (bf16_t)f2bf(o / sm);
        __syncthreads();
    }
}
__device__ __forceinline__ void select_pair(SP_LAS float* L, const bf16_t* __restrict__ QP, const bf16_t* __restrict__ SUBK, int* __restrict__ IDX, float* __restrict__ GATE, int tok0) {
    const int t512 = opaque_tid(); const int hf = t512 >> 8, tid = t512 & 255, tok = tok0 + hf;
    SP_LAS float* base = L + hf * 3072;
    SP_LAS float* qs = base; SP_LAS float* s = base + 2048; SP_LAS float* tops = base + 2304; SP_LAS int* topi = (SP_LAS int*)(base + 2336); SP_LAS float* cs = base + 2368; SP_LAS int* ci = (SP_LAS int*)(base + 2624);
    SP_LAS float* bs = base + 2880; SP_LAS int* bi = (SP_LAS int*)(base + 2896);
    for (int i = tid; i < 2048; i += 256) qs[i] = bf2f(QP[(size_t)tok * 2048 + i]);
    __syncthreads();
    for (int h = 0; h < PH; ++h) {
        const int half = tid >> 7, key = tid & 127;
        { const bf16_t* kp = SUBK + ((size_t)(h * 2 + half) * 128 + key) * 128; const SP_LAS float* q = qs + h * 256 + half * 128; float a = 0.f;
          for (int d = 0; d < 128; d += 8) { const u32x4 w = *(const u32x4*)(kp + d);
              a += q[d] * bflo(w.x) + q[d + 1] * bfhi(w.x) + q[d + 2] * bflo(w.y) + q[d + 3] * bfhi(w.y) + q[d + 4] * bflo(w.z) + q[d + 5] * bfhi(w.z) + q[d + 6] * bflo(w.w) + q[d + 7] * bfhi(w.w); }
          s[tid] = a; }
        __syncthreads();
        { const float me = s[tid]; int rank = 0; const SP_LAS float* spp = s + half * 128;
          for (int j = 0; j < 128; ++j) { const float o = spp[j]; rank += (o > me || (o == me && j < key)) ? 1 : 0; }
          if (rank < 16) { tops[half * 16 + rank] = me; topi[half * 16 + rank] = key; } }
        __syncthreads();
        { const int i = tid >> 4, j = tid & 15; cs[tid] = tops[i] + tops[16 + j]; ci[tid] = topi[i] * 128 + topi[16 + j]; }
        __syncthreads();
        { const float me = cs[tid]; int rank = 0;
          for (int j = 0; j < 256; ++j) { const float o = cs[j]; rank += (o > me || (o == me && j < tid)) ? 1 : 0; }
          if (rank < 16) { bs[rank] = me; bi[rank] = ci[tid]; } }
        __syncthreads();
        if (tid < 16) { const float mx = bs[0]; float sum = 0.f;
            for (int j = 0; j < 16; ++j) sum += expf(bs[j] - mx);
            GATE[(size_t)tok * 128 + h * 16 + tid] = expf(bs[tid] - mx) / sum; IDX[(size_t)tok * 128 + h * 16 + tid] = bi[tid]; }
        __syncthreads();
    }
}
__device__ __forceinline__ void gather_token(SP_LAS float* L, float* __restrict__ X, const bf16_t* __restrict__ PU, const bf16_t* __restrict__ PV, const int* __restrict__ IDX, const float* __restrict__ GATE,
                                             const float* __restrict__ g3, const float* __restrict__ b3, int tok) {
    const int tid = opaque_tid(), lane = tid & 63, wv = tid >> 6;
    SP_LAS float* ys = L; SP_LAS float* red = L + 8192;
    float xr[16], y[16];
    { const float* xp = X + (size_t)tok * D + lane * 16;
#pragma unroll
      for (int j = 0; j < 4; ++j) { const f32x4 v = *(const f32x4*)(xp + 4 * j); xr[4 * j] = v.x; xr[4 * j + 1] = v.y; xr[4 * j + 2] = v.z; xr[4 * j + 3] = v.w; }
#pragma unroll
      for (int j = 0; j < 16; ++j) y[j] = 0.f; }
    for (int e = 0; e < 16; ++e) {
        const int slot = wv * 16 + e; const int id = IDX[(size_t)tok * 128 + slot]; const float gt = GATE[(size_t)tok * 128 + slot];
        const bf16_t* up = PU + (size_t)id * D + lane * 16; const u32x4 u0 = *(const u32x4*)up, u1 = *(const u32x4*)(up + 8);
        const unsigned uw[8] = {u0.x, u0.y, u0.z, u0.w, u1.x, u1.y, u1.z, u1.w};
        float hsum = 0.f;
#pragma unroll
        for (int j = 0; j < 8; ++j) { hsum = fmaf(xr[2 * j], bflo(uw[j]), hsum); hsum = fmaf(xr[2 * j + 1], bfhi(uw[j]), hsum); }
        hsum = wave_sum(hsum);
        const float w = gt * 0.5f * hsum * (1.f + erff(hsum * 0.70710678118654752f));
        const bf16_t* vp = PV + (size_t)id * D + lane * 16; const u32x4 v0 = *(const u32x4*)vp, v1 = *(const u32x4*)(vp + 8);
        const unsigned vw[8] = {v0.x, v0.y, v0.z, v0.w, v1.x, v1.y, v1.z, v1.w};
#pragma unroll
        for (int j = 0; j < 8; ++j) { y[2 * j] = fmaf(w, bflo(vw[j]), y[2 * j]); y[2 * j + 1] = fmaf(w, bfhi(vw[j]), y[2 * j + 1]); }
    }
#pragma unroll
    for (int j = 0; j < 16; ++j) ys[wv * 1024 + lane * 16 + j] = y[j];
    __syncthreads();
    float v[2]; float s = 0.f;
#pragma unroll
    for (int j = 0; j < 2; ++j) { const int c = tid * 2 + j; float a = 0.f;
#pragma unroll
        for (int k = 0; k < 8; ++k) a += ys[k * 1024 + c];
        v[j] = ALPHA * X[(size_t)tok * D + c] + a; s += v[j]; }
    s = wave_sum(s); if (lane == 0) red[wv] = s; __syncthreads();
    float tot = 0.f;
#pragma unroll
    for (int k = 0; k < 8; ++k) tot += red[k];
    const float mean = tot * (1.f / D);
    float s2 = 0.f;
#pragma unroll
    for (int j = 0; j < 2; ++j) { v[j] -= mean; s2 += v[j] * v[j]; }
    s2 = wave_sum(s2); if (lane == 0) red[8 + wv] = s2; __syncthreads();
    float tot2 = 0.f;
#pragma unroll
    for (int k = 0; k < 8; ++k) tot2 += red[8 + k];
    const float rstd = rsqrtf(tot2 * (1.f / D) + 1e-5f);
#pragma unroll
    for (int j = 0; j < 2; ++j) { const int c = tid * 2 + j; X[(size_t)tok * D + c] = v[j] * rstd * g3[c] + b3[c]; }
    __syncthreads();
}

constexpr float PEER_SU = 2048.f, PEER_SV = 256.f;
typedef float f32x2v __attribute__((ext_vector_type(2)));
__device__ __forceinline__ void gather_wave(float* __restrict__ Xo, const float* X, const unsigned char* __restrict__ PU, const unsigned char* __restrict__ PV, const int* __restrict__ IDX, const float* __restrict__ GATE,
                                            const float* __restrict__ g3, const float* __restrict__ b3, int tok, int lane) {
    float xr[16], y[16];
    { const f32x4* xp = (const f32x4*)(X + (size_t)tok * D + 16 * lane);
#pragma unroll
      for (int q = 0; q < 4; ++q) { const f32x4 v = xp[q]; xr[4 * q] = v.x; xr[4 * q + 1] = v.y; xr[4 * q + 2] = v.z; xr[4 * q + 3] = v.w; } }
#pragma unroll
    for (int j = 0; j < 16; ++j) y[j] = 0.f;
    const int id0 = IDX[(size_t)tok * 128 + lane], id1 = IDX[(size_t)tok * 128 + 64 + lane];
    const float gt0 = GATE[(size_t)tok * 128 + lane], gt1 = GATE[(size_t)tok * 128 + 64 + lane];
    u32x4 ub[8], vb[8];
#define GW_ISSUE(buf, TBL, i) do { const int idv_ = ((i) < 8) ? id0 : id1; _Pragma("unroll") for (int k_ = 0; k_ < 8; ++k_) { \
        const int id_ = __builtin_amdgcn_readlane(idv_, (8 * (i) + k_) & 63); buf[k_] = *(const u32x4*)((TBL) + (size_t)id_ * D + 16 * lane); } } while (0)
    GW_ISSUE(ub, PU, 0); GW_ISSUE(vb, PV, 0);
    const bool h32 = (lane & 32) != 0, h16 = (lane & 16) != 0, h8 = (lane & 8) != 0;
#pragma unroll 1
    for (int i = 0; i < 16; ++i) {
        float p[8];
#pragma unroll
        for (int k = 0; k < 8; ++k) { const unsigned w[4] = {ub[k].x, ub[k].y, ub[k].z, ub[k].w}; float a = 0.f;
#pragma unroll
            for (int q = 0; q < 4; ++q) { const f32x2v lo = __builtin_amdgcn_cvt_pk_f32_fp8((int)w[q], false), hi = __builtin_amdgcn_cvt_pk_f32_fp8((int)w[q], true);
                a = fmaf(xr[4 * q], lo.x, a); a = fmaf(xr[4 * q + 1], lo.y, a); a = fmaf(xr[4 * q + 2], hi.x, a); a = fmaf(xr[4 * q + 3], hi.y, a); }
            p[k] = a; }
        { const int in_ = (i + 1 < 16) ? i + 1 : 15; GW_ISSUE(ub, PU, in_); }
        float q4[4], q2[2], q1;
#pragma unroll
        for (int k = 0; k < 4; ++k) q4[k] = (h32 ? p[k + 4] : p[k]) + __shfl_xor(h32 ? p[k] : p[k + 4], 32);
#pragma unroll
        for (int k = 0; k < 2; ++k) q2[k] = (h16 ? q4[k + 2] : q4[k]) + __shfl_xor(h16 ? q4[k] : q4[k + 2], 16);
        q1 = (h8 ? q2[1] : q2[0]) + __shfl_xor(h8 ? q2[0] : q2[1], 8);
        q1 += __shfl_xor(q1, 4); q1 += __shfl_xor(q1, 2); q1 += __shfl_xor(q1, 1);
        q1 *= (1.f / PEER_SU);
        const float gsel = __shfl((i < 8) ? gt0 : gt1, (8 * i + (lane >> 3)) & 63);
        const float wv = gsel * 0.5f * q1 * (1.f + erff(q1 * 0.70710678118654752f));
#pragma unroll
        for (int k = 0; k < 8; ++k) { const float wk = __builtin_bit_cast(float, __builtin_amdgcn_readlane(__builtin_bit_cast(int, wv), 8 * k));
            const unsigned w[4] = {vb[k].x, vb[k].y, vb[k].z, vb[k].w};
#pragma unroll
            for (int q = 0; q < 4; ++q) { const f32x2v lo = __builtin_amdgcn_cvt_pk_f32_fp8((int)w[q], false), hi = __builtin_amdgcn_cvt_pk_f32_fp8((int)w[q], true);
                y[4 * q] = fmaf(wk, lo.x, y[4 * q]); y[4 * q + 1] = fmaf(wk, lo.y, y[4 * q + 1]); y[4 * q + 2] = fmaf(wk, hi.x, y[4 * q + 2]); y[4 * q + 3] = fmaf(wk, hi.y, y[4 * q + 3]); } }
        { const int in_ = (i + 1 < 16) ? i + 1 : 15; GW_ISSUE(vb, PV, in_); }
    }
#undef GW_ISSUE
    float s = 0.f;
#pragma unroll
    for (int j = 0; j < 16; ++j) { y[j] = ALPHA * xr[j] + y[j] * (1.f / PEER_SV); s += y[j]; }
    const float mean = wave_sum(s) * (1.f / D); float s2 = 0.f;
#pragma unroll
    for (int j = 0; j < 16; ++j) { y[j] -= mean; s2 += y[j] * y[j]; }
    const float rstd = rsqrtf(wave_sum(s2) * (1.f / D) + 1e-5f);
    float* op = Xo + (size_t)tok * D + 16 * lane;
#pragma unroll
    for (int q = 0; q < 4; ++q) { const f32x4 gg = *(const f32x4*)(g3 + 16 * lane + 4 * q), bb = *(const f32x4*)(b3 + 16 * lane + 4 * q);
        f32x4 o; o.x = y[4 * q] * rstd * gg.x + bb.x; o.y = y[4 * q + 1] * rstd * gg.y + bb.y; o.z = y[4 * q + 2] * rstd * gg.z + bb.z; o.w = y[4 * q + 3] * rstd * gg.w + bb.w;
        *(f32x4*)(op + 4 * q) = o; }
}
}


#define LAS __attribute__((address_space(3)))
#define XB_TMO      128
#define XB_XCNT(j)  (256  + 64 * (j))
#define XB_XSUB(j)  (1280 + 64 * (j))
#define XB_XGEN(j)  (2304 + 64 * (j))
#define XB_TOP      3328
#define XB_TOPGEN   3392
#define XCD_BAR_WORDS 3456
#define XB_SPIN_CAP (1u << 18)
__device__ __forceinline__ unsigned xb_ld(unsigned* p)              { return __hip_atomic_load(p, __ATOMIC_RELAXED, __HIP_MEMORY_SCOPE_AGENT); }
__device__ __forceinline__ unsigned xb_add(unsigned* p, unsigned v) { return __hip_atomic_fetch_add(p, v, __ATOMIC_RELAXED, __HIP_MEMORY_SCOPE_AGENT); }
__device__ __forceinline__ unsigned xb_xcc_id() { return (unsigned)__builtin_amdgcn_s_getreg((3 << 11) | 20) & 0xFu; }
#define XB_SPIN(cond, bar) do { unsigned _sp = 0; while (cond) { __builtin_amdgcn_s_sleep(1); \
    if ((++_sp & 255u) == 0u) { if (xb_ld(&(bar)[XB_TMO])) break; if (_sp > XB_SPIN_CAP) { atomicAdd(&(bar)[XB_TMO], 1u); break; } } } } while (0)
struct XcdBarrier { unsigned* bar; unsigned x; volatile LAS unsigned* st; };
__device__ __forceinline__ XcdBarrier xcd_barrier_post(unsigned* bar, volatile LAS unsigned* st) {
    XcdBarrier b; b.bar = bar; b.x = xb_xcc_id(); b.st = st;
    if (threadIdx.x == 0) (void)xb_add(&bar[XB_XCNT(b.x)], 1u);
    return b;
}
__device__ __forceinline__ void xcd_barrier_complete(unsigned* bar, unsigned x, unsigned& nloc, unsigned& nx) {
    const unsigned G = gridDim.x * gridDim.y * gridDim.z;
    unsigned sum, cnt, mine, sp = 0u;
    for (;;) {
        sum = 0u; cnt = 0u; mine = 0u;
#pragma unroll
        for (unsigned j = 0; j < 16; ++j) { const unsigned c = xb_ld(&bar[XB_XCNT(j)]); sum += c; cnt += (c > 0u) ? 1u : 0u; mine = (j == x) ? c : mine; }
        if (sum == G) break;
        __builtin_amdgcn_s_sleep(1);
        if ((++sp & 255u) == 0u) { if (xb_ld(&bar[XB_TMO])) break; if (sp > XB_SPIN_CAP) { atomicAdd(&bar[XB_TMO], 1u); break; } }
    }
    nloc = mine > 0u ? mine : 1u; nx = cnt > 0u ? cnt : 1u;
}
__device__ __forceinline__ void xcd_barrier(const XcdBarrier& b) {
    asm volatile("s_waitcnt vmcnt(0)" ::: "memory");
    __syncthreads();
    if (threadIdx.x == 0) {
        unsigned* bar = b.bar;
        __builtin_amdgcn_s_waitcnt(0);
        unsigned nloc = b.st[0], nx = b.st[1];
        if (nloc == 0u) { xcd_barrier_complete(bar, b.x, nloc, nx); b.st[0] = nloc; b.st[1] = nx; }
        const unsigned old = xb_add(&bar[XB_XSUB(b.x)], 1u);
        const unsigned gen = old / nloc;
        if (old + 1u == (gen + 1u) * nloc) {
            __builtin_amdgcn_fence(__ATOMIC_RELEASE, "agent");
            asm volatile("s_waitcnt vmcnt(0)" ::: "memory");
            const unsigned og = xb_add(&bar[XB_TOP], 1u);
            const unsigned tg = og / nx;
            if (og + 1u == (tg + 1u) * nx) xb_add(&bar[XB_TOPGEN], 1u);
            else XB_SPIN(xb_ld(&bar[XB_TOPGEN]) == tg, bar);
            __builtin_amdgcn_fence(__ATOMIC_ACQUIRE, "agent");
            xb_add(&bar[XB_XGEN(b.x)], 1u);
            asm volatile("s_waitcnt vmcnt(0)" ::: "memory");
        } else {
            XB_SPIN(xb_ld(&bar[XB_XGEN(b.x)]) == gen, bar);
            __builtin_amdgcn_fence(__ATOMIC_ACQUIRE, "agent");
            asm volatile("s_waitcnt vmcnt(0)" ::: "memory");
        }
    }
    __syncthreads();
}
constexpr int CW_BAR = 4096;
constexpr int MISC_OFF = 147456;


namespace peer2 {
#define P2_LAS __attribute__((address_space(3)))
typedef float f32x2v __attribute__((ext_vector_type(2)));
constexpr int CW_TICK = 8192;
__device__ __forceinline__ float dpp_add_xor1(float v) { return v + __builtin_bit_cast(float, __builtin_amdgcn_update_dpp(0, __builtin_bit_cast(int, v), 0xB1, 0xf, 0xf, true)); }
__device__ __forceinline__ float dpp_add_xor2(float v) { return v + __builtin_bit_cast(float, __builtin_amdgcn_update_dpp(0, __builtin_bit_cast(int, v), 0x4E, 0xf, 0xf, true)); }
__device__ __forceinline__ float dpp_add_hmir(float v) { return v + __builtin_bit_cast(float, __builtin_amdgcn_update_dpp(0, __builtin_bit_cast(int, v), 0x141, 0xf, 0xf, true)); }
__device__ __forceinline__ float dpp_ror8(float v) { return __builtin_bit_cast(float, __builtin_amdgcn_update_dpp(0, __builtin_bit_cast(int, v), 0x128, 0xf, 0xf, true)); }
__device__ __forceinline__ float swap32_sum(float a, float b) { auto r = __builtin_amdgcn_permlane32_swap(__builtin_bit_cast(unsigned, a), __builtin_bit_cast(unsigned, b), false, false); return __builtin_bit_cast(float, r[0]) + __builtin_bit_cast(float, r[1]); }
struct Own { int j, rank, nrank, nsl; };
__device__ __forceinline__ Own ownership(unsigned* ctl, P2_LAS unsigned* scr, int phase, int wave) {
    const int G = gridDim.x;
    if (threadIdx.x == 0) {
        unsigned* bar = ctl + CW_BAR; bool uni = (G % 8) == 0;
        for (int j = 0; j < 8; ++j) uni = uni && (xb_ld(&bar[XB_XCNT(j)]) == (unsigned)(G / 8));
        const unsigned xcc = xb_xcc_id();
        if (uni && xcc < 8u) { scr[0] = xcc; scr[1] = xb_add(&ctl[CW_TICK + 64 * (8 * phase + (int)xcc)], 1u); }
        else { scr[0] = blockIdx.x & 7; scr[1] = blockIdx.x >> 3; }
    }
    __syncthreads();
    Own o;
    if (G % 8 == 0) { o.j = (int)scr[0]; o.rank = (int)scr[1] * 8 + wave; o.nrank = G; o.nsl = 8; }
    else { o.j = 0; o.rank = blockIdx.x * 8 + wave; o.nrank = G * 8; o.nsl = 1; }
    return o;
}
__device__ __forceinline__ float dot16_fp8(const float (&x)[16], const u32x4 u) {
    const unsigned w[4] = {u.x, u.y, u.z, u.w}; f32x2v a = {0.f, 0.f};
#pragma unroll
    for (int q = 0; q < 4; ++q) { const f32x2v lo = __builtin_amdgcn_cvt_pk_f32_fp8((int)w[q], false), hi = __builtin_amdgcn_cvt_pk_f32_fp8((int)w[q], true);
        a = __builtin_elementwise_fma((f32x2v){x[4 * q], x[4 * q + 1]}, lo, a); a = __builtin_elementwise_fma((f32x2v){x[4 * q + 2], x[4 * q + 3]}, hi, a); }
    return a.x + a.y;
}
__device__ __forceinline__ void u_wave(const float* __restrict__ X, const unsigned char* __restrict__ PU, const int* __restrict__ IDX, float* __restrict__ PART, int j, int rank, int nrank, int lane) {
    const int sub = lane & 7, grp = lane >> 3, col0 = 128 * j + 16 * sub;
    float* part = PART + (size_t)j * M * 128 + 16 * grp;
#define PU_LOADIDX(idv, xv, t_) do { const int tt_ = ((t_) < M) ? (t_) : (M - 1); const u32x4* ip_ = (const u32x4*)(IDX + (size_t)tt_ * 128 + 16 * grp); \
        _Pragma("unroll") for (int q_ = 0; q_ < 4; ++q_) { const u32x4 v_ = ip_[q_]; idv[4 * q_] = (int)v_.x; idv[4 * q_ + 1] = (int)v_.y; idv[4 * q_ + 2] = (int)v_.z; idv[4 * q_ + 3] = (int)v_.w; } \
        const f32x4* xp_ = (const f32x4*)(X + (size_t)tt_ * D + col0); \
        _Pragma("unroll") for (int q_ = 0; q_ < 4; ++q_) { const f32x4 v_ = xp_[q_]; xv[4 * q_] = v_.x; xv[4 * q_ + 1] = v_.y; xv[4 * q_ + 2] = v_.z; xv[4 * q_ + 3] = v_.w; } } while (0)
#define PU_GATHER(ubv, idv) do { _Pragma("unroll") for (int it_ = 0; it_ < 16; ++it_) ubv[it_] = *(const u32x4*)(PU + (size_t)j * (PK * PK * 128) + (size_t)idv[it_] * 128 + 16 * sub); } while (0)
#define PU_COMPUTE(ubv, xv, t_) do { float k0_ = 0.f, k1_ = 0.f; _Pragma("unroll") for (int it_ = 0; it_ < 16; ++it_) { float a_ = dot16_fp8(xv, ubv[it_]); a_ = dpp_add_xor1(a_); a_ = dpp_add_xor2(a_); a_ = dpp_add_hmir(a_); \
            if (it_ < 8) k0_ = ((it_ & 7) == sub) ? a_ : k0_; else k1_ = ((it_ & 7) == sub) ? a_ : k1_; } \
        if ((t_) < M) { part[(size_t)(t_) * 128 + sub] = k0_; part[(size_t)(t_) * 128 + sub + 8] = k1_; } } while (0)
    int idA[16], idB[16]; float xA[16], xB[16], xc[16]; u32x4 ubA[16], ubB[16];
    int t = rank;
    PU_LOADIDX(idA, xA, t); PU_GATHER(ubA, idA);
    PU_LOADIDX(idB, xB, t + nrank);
    for (; t < M; t += 2 * nrank) {
        PU_GATHER(ubB, idB);
#pragma unroll
        for (int q = 0; q < 16; ++q) xc[q] = xA[q];
        PU_LOADIDX(idA, xA, t + 2 * nrank);
        PU_COMPUTE(ubA, xc, t);
        PU_GATHER(ubA, idA);
#pragma unroll
        for (int q = 0; q < 16; ++q) xc[q] = xB[q];
        PU_LOADIDX(idB, xB, t + 3 * nrank);
        PU_COMPUTE(ubB, xc, t + nrank);
    }
#undef PU_LOADIDX
#undef PU_GATHER
#undef PU_COMPUTE
}
__device__ __forceinline__ void v_wave(float* __restrict__ X, const unsigned char* __restrict__ PV, const int* __restrict__ IDX, const float* __restrict__ GATE, const float* __restrict__ PART, P2_LAS float* wbuf, int j, int rank, int nrank, int lane) {
    const int sub = lane & 7, grp = lane >> 3, col0 = 128 * j + 16 * sub;
    const bool h32 = (lane & 32) != 0, h16 = (lane & 16) != 0, h8 = (lane & 8) != 0; const int cq = ((lane >> 5) & 1) * 8 + ((lane >> 4) & 1) * 4 + ((lane >> 3) & 1) * 2;
#define PV_ISSUE(vbv, hv, gv, t_) do { const int tt_ = ((t_) < M) ? (t_) : (M - 1); int id_[16]; const u32x4* ip_ = (const u32x4*)(IDX + (size_t)tt_ * 128 + 16 * grp); \
        _Pragma("unroll") for (int q_ = 0; q_ < 4; ++q_) { const u32x4 v_ = ip_[q_]; id_[4 * q_] = (int)v_.x; id_[4 * q_ + 1] = (int)v_.y; id_[4 * q_ + 2] = (int)v_.z; id_[4 * q_ + 3] = (int)v_.w; } \
        _Pragma("unroll") for (int it_ = 0; it_ < 16; ++it_) vbv[it_] = *(const u32x4*)(PV + (size_t)j * (PK * PK * 128) + (size_t)id_[it_] * 128 + 16 * sub); \
        _Pragma("unroll") for (int jj_ = 0; jj_ < 8; ++jj_) { const float* pp_ = PART + ((size_t)jj_ * M + tt_) * 128; hv[2 * jj_] = pp_[lane]; hv[2 * jj_ + 1] = pp_[64 + lane]; } \
        gv[0] = GATE[(size_t)tt_ * 128 + lane]; gv[1] = GATE[(size_t)tt_ * 128 + 64 + lane]; } while (0)
#define PV_COMPUTE(vbv, hv, gv, t_) do { float h0_ = 0.f, h1_ = 0.f; _Pragma("unroll") for (int jj_ = 0; jj_ < 8; ++jj_) { h0_ += hv[2 * jj_]; h1_ += hv[2 * jj_ + 1]; } \
        h0_ *= (1.f / sp::PEER_SU); h1_ *= (1.f / sp::PEER_SU); \
        const float w0_ = gv[0] * 0.5f * h0_ * (1.f + erff(h0_ * 0.70710678118654752f)), w1_ = gv[1] * 0.5f * h1_ * (1.f + erff(h1_ * 0.70710678118654752f)); \
        f32x2v y_[8]; _Pragma("unroll") for (int q_ = 0; q_ < 8; ++q_) y_[q_] = (f32x2v){0.f, 0.f}; \
        wbuf[lane] = w0_; wbuf[64 + lane] = w1_; asm volatile("s_waitcnt lgkmcnt(0)" ::: "memory");        \
        float wl_[16]; _Pragma("unroll") for (int q_ = 0; q_ < 4; ++q_) { const f32x4 v_ = *(const P2_LAS f32x4*)(wbuf + 16 * grp + 4 * q_); wl_[4 * q_] = v_.x; wl_[4 * q_ + 1] = v_.y; wl_[4 * q_ + 2] = v_.z; wl_[4 * q_ + 3] = v_.w; } \
        asm volatile("s_waitcnt lgkmcnt(0)" ::: "memory"); \
        _Pragma("unroll") for (int it_ = 0; it_ < 16; ++it_) { const float wq_ = wl_[it_]; \
            const unsigned ww_[4] = {vbv[it_].x, vbv[it_].y, vbv[it_].z, vbv[it_].w}; const f32x2v wv_ = {wq_, wq_}; \
            _Pragma("unroll") for (int q_ = 0; q_ < 4; ++q_) { y_[2 * q_] = __builtin_elementwise_fma(wv_, __builtin_amdgcn_cvt_pk_f32_fp8((int)ww_[q_], false), y_[2 * q_]); y_[2 * q_ + 1] = __builtin_elementwise_fma(wv_, __builtin_amdgcn_cvt_pk_f32_fp8((int)ww_[q_], true), y_[2 * q_ + 1]); } } \
        float yy_[16]; _Pragma("unroll") for (int k_ = 0; k_ < 8; ++k_) { yy_[2 * k_] = y_[k_].x; yy_[2 * k_ + 1] = y_[k_].y; } \
          \
        float y8_[8], y4_[4], y2_[2]; \
        _Pragma("unroll") for (int k_ = 0; k_ < 8; ++k_) y8_[k_] = (h32 ? yy_[k_ + 8] : yy_[k_]) + __shfl_xor(h32 ? yy_[k_] : yy_[k_ + 8], 32); \
        _Pragma("unroll") for (int k_ = 0; k_ < 4; ++k_) y4_[k_] = (h16 ? y8_[k_ + 4] : y8_[k_]) + __shfl_xor(h16 ? y8_[k_] : y8_[k_ + 4], 16); \
        _Pragma("unroll") for (int k_ = 0; k_ < 2; ++k_) y2_[k_] = (h8 ? y4_[k_ + 2] : y4_[k_]) + dpp_ror8(h8 ? y4_[k_] : y4_[k_ + 2]); \
        if ((t_) < M) { f32x2v* xp_ = (f32x2v*)(X + (size_t)(t_) * D + col0 + cq); f32x2v xv_ = *xp_; \
            xv_.x = ALPHA * xv_.x + y2_[0] * (1.f / sp::PEER_SV); xv_.y = ALPHA * xv_.y + y2_[1] * (1.f / sp::PEER_SV); *xp_ = xv_; } } while (0)
    u32x4 vbA[16], vbB[16]; float hA[16], hB[16], gA[2], gB[2];
    int t = rank;
    PV_ISSUE(vbA, hA, gA, t);
    for (; t < M; t += 2 * nrank) {
        PV_ISSUE(vbB, hB, gB, t + nrank);
        PV_COMPUTE(vbA, hA, gA, t);
        PV_ISSUE(vbA, hA, gA, t + 2 * nrank);
        PV_COMPUTE(vbB, hB, gB, t + nrank);
    }
#undef PV_ISSUE
#undef PV_COMPUTE
}
__device__ __forceinline__ void ln_row_plain(float* __restrict__ X, const float* __restrict__ g, const float* __restrict__ b, int row, int lane) {
    f32x4* xr = (f32x4*)(X + (size_t)row * D) + lane;
    f32x4 v[4]; float s = 0.f;
#pragma unroll
    for (int jq = 0; jq < 4; ++jq) { v[jq] = xr[64 * jq]; s += (v[jq].x + v[jq].y) + (v[jq].z + v[jq].w); }
    const float mean = wave_sum(s) * (1.f / D); float s2 = 0.f;
#pragma unroll
    for (int jq = 0; jq < 4; ++jq) { v[jq] = v[jq] - mean; s2 += (v[jq].x * v[jq].x + v[jq].y * v[jq].y) + (v[jq].z * v[jq].z + v[jq].w * v[jq].w); }
    const float rstd = rsqrtf(wave_sum(s2) * (1.f / D) + 1e-5f);
#pragma unroll
    for (int jq = 0; jq < 4; ++jq) { const int c = 4 * lane + 256 * jq; const f32x4 gg = *(const f32x4*)(g + c), bb = *(const f32x4*)(b + c); xr[64 * jq] = v[jq] * rstd * gg + bb; }
}
}

struct Params { const float* in[30]; float* out; unsigned char* ws; };
template <class F> __device__ __forceinline__ void run_gemm(unsigned char* lds, const bf16_t* A, int lda, const bf16_t* Bt, int Mr, int N, int K, F f) {
    pg8::Gemm g{A, Bt, Mr, N, K, lda}; pg8::StaticOrder S; S.init(Mr, N, gridDim.x, blockIdx.x); pg8::EpiAdapt<F> E{f};
    pg8::gemm_phase<pg8::EpiAdapt<F>, pg8::StaticOrder, true>((PG8_LAS unsigned char*)lds, g, S, E);
}
#ifndef PROBE_ATTN
#define PROBE_ATTN 0
#endif
#ifndef PROBE_SSD
#define PROBE_SSD 0
#endif
#ifndef PROBE_SYNC
#define PROBE_SYNC 0
#endif
#define KA_LAS __attribute__((address_space(4)))
#define PH_BEGIN const KA_LAS unsigned char* ka_ = (const KA_LAS unsigned char*)__builtin_amdgcn_kernarg_segment_ptr(); asm volatile("" : "+s"(ka_))
#define PIN(k) (*(const float* const KA_LAS*)(ka_ + 8 * (k)))
#define POUT (*(float* const KA_LAS*)(ka_ + 240))
#define PWS (*(unsigned char* const KA_LAS*)(ka_ + 248))
__global__ void __launch_bounds__(512, 2) hybrid_fwd(Params P) {
    extern __shared__ __attribute__((aligned(16))) unsigned char lds[];
    cg::grid_group grid = cg::this_grid();
    { PH_BEGIN; volatile LAS unsigned* misc = (volatile LAS unsigned*)((LAS unsigned char*)lds + MISC_OFF);
      if (threadIdx.x < 16) misc[threadIdx.x] = 0u;
      __syncthreads();
      (void)xcd_barrier_post((unsigned*)(PWS + WS_CTL) + CW_BAR, misc);
      if (PWS == nullptr) grid.sync(); }
#define GSYNC() do { PH_BEGIN; XcdBarrier xb_; xb_.bar = (unsigned*)(PWS + WS_CTL) + CW_BAR; xb_.x = xb_xcc_id(); xb_.st = (volatile LAS unsigned*)((LAS unsigned char*)lds + MISC_OFF); xcd_barrier(xb_); } while (0)
    {
        PH_BEGIN; unsigned char* ws = PWS;
        const int tid = opaque_tid(), lane = tid & 63, wave = __builtin_amdgcn_readfirstlane(tid >> 6), c = blockIdx.x, G = gridDim.x;
        const size_t gtid = (size_t)c * 512 + tid, gthreads = (size_t)G * 512; const int gw = c * 8 + wave, NGW = G * 8;
        const float* w_in = PIN(2);
        bf16_t* WinT = (bf16_t*)(ws + WS_WIN); bf16_t* WckvT = (bf16_t*)(ws + WS_WCKV);
        SP_LAS float* scr = (SP_LAS float*)lds + wave * (64 * 33);
        constexpr int I0 = 2560, I1 = 5120, I2 = 6144, I3 = 6656, I4 = 7168, I5 = 7680, I6 = 8192, I7 = 8704, I8 = 9216, I9 = 10240;
        for (int it = gw; it < I9; it += NGW) {
            if (it < I0) sp::transpose_item(w_in, NIN, 0, D, 160, WinT, 0, scr, it, lane);
            else if (it < I1) sp::transpose_item(w_in, NIN, 5152, D, 160, WinT, 5120, scr, it - I0, lane);
            else if (it < I2) sp::transpose_item(PIN(9), D, 0, DI, 32, (bf16_t*)(ws + WS_WSSD), 0, scr, it - I1, lane);
            else if (it < I3) sp::transpose_item(PIN(13), D, 0, D, 32, (bf16_t*)(ws + WS_WDIFF), 0, scr, it - I2, lane);
            else if (it < I4) sp::transpose_item(PIN(15), D, 0, D, 32, (bf16_t*)(ws + WS_WO), 0, scr, it - I3, lane);
            else if (it < I5) sp::transpose_item(PIN(18), D, 0, D, 32, (bf16_t*)(ws + WS_WCQ), 0, scr, it - I4, lane);
            else if (it < I6) sp::transpose_item(PIN(19), D, 0, D, 32, WckvT, 0, scr, it - I5, lane);
            else if (it < I7) sp::transpose_item(PIN(20), D, 0, D, 32, WckvT, 1024, scr, it - I6, lane);
            else if (it < I8) sp::transpose_item(PIN(21), D, 0, D, 32, (bf16_t*)(ws + WS_WCO), 0, scr, it - I7, lane);
            else sp::transpose_item(PIN(24), 2048, 0, D, 64, (bf16_t*)(ws + WS_WPQ), 0, scr, it - I8, lane);
        }
        const float* x = PIN(0);
        sp::cvt_range(x, (bf16_t*)(ws + WS_XB), (size_t)M * D / 4, gtid, gthreads);
        sp::cvt_range(PIN(1), (bf16_t*)(ws + WS_MEMB), (size_t)BATCH * MEML * D / 4, gtid, gthreads);
        sp::cvt_range(PIN(25), (bf16_t*)(ws + WS_SUBK), (size_t)PH * 2 * PK * PHALF / 4, gtid, gthreads);
        __syncthreads();
        sp::dt_stage_w((SP_LAS float*)lds, w_in);
        for (int it = c; it < M / 4; it += G) sp::dt_item((SP_LAS float*)lds, (SP_LAS float*)lds + 32768, (SP_LAS float*)lds + 36896  , x, PIN(5), (float*)(ws + WS_DT), it);
        __syncthreads();
        if (c == 0 && tid == 0) { const float* lam_q = PIN(10); const float* lam_k = PIN(11); float s0 = 0.f, s1 = 0.f;
            for (int i = 0; i < 64; ++i) { s0 += lam_q[i] * lam_k[i]; s1 += lam_q[64 + i] * lam_k[64 + i]; }
            ((float*)(ws + WS_CTL))[CW_LAM] = expf(s0) - expf(s1) + LAMBDA_INIT; }
    }
    GSYNC();
    { PH_BEGIN; unsigned char* ws = PWS;
      run_gemm(lds, (const bf16_t*)(ws + WS_MEMB), D, (const bf16_t*)(ws + WS_WCKV), BATCH * MEML, D, D, EpiPlain{(bf16_t*)(ws + WS_KCVC), D, 1.f});
      for (int bb = 0; bb < BATCH; ++bb)
          run_gemm(lds, (const bf16_t*)(ws + WS_WCKV) + (size_t)D * D, D, (const bf16_t*)(ws + WS_MEMB) + (size_t)bb * MEML * D, D, MEML, D, EpiPlain{(bf16_t*)(ws + WS_KCVC) + (size_t)BATCH * MEML * D + (size_t)bb * D * MEML, MEML, 1.f});
      run_gemm(lds, (const bf16_t*)(ws + WS_XB), D, (const bf16_t*)(ws + WS_WIN), SEQ, NINP, D, EpiInProj{(bf16_t*)(ws + WS_H), PIN(14)}); }
    GSYNC();
#pragma unroll 1
    for (int b = 0; b < BATCH; ++b) {
        { PH_BEGIN; unsigned char* ws = PWS; const int c = blockIdx.x, G = gridDim.x;
          bf16_t* H = (bf16_t*)(ws + WS_H); const float* DTb = (const float*)(ws + WS_DT) + (size_t)b * SEQ * 32;
          for (int u = c; u < 256; u += G) ssd::phaseA_unit((SS_LAS unsigned char*)lds, H, DTb, PIN(3), PIN(4), PIN(6), (bf16_t*)(ws + WS_T1), (float*)(ws + WS_CTL) + 1024, u >> 2, u & 3);
          const float lam = ((const float*)(ws + WS_CTL))[CW_LAM]; const float* subln_w = PIN(12);
#if PROBE_ATTN
          for (int u = c; u < 256; u += G) { const int h = u >> 5, j = u & 31;
              dattn::unit<false>((DA_LAS unsigned char*)lds, H, h, 63 - j, subln_w, lam);
              dattn::unit<false>((DA_LAS unsigned char*)lds, H, h, j, subln_w, lam); }
#endif
          for (int u = c; u < 256; u += G) { const int h = u >> 5, j = u & 31;
              dattn::unit((DA_LAS unsigned char*)lds, H, h, 63 - j, subln_w, lam);
              dattn::unit((DA_LAS unsigned char*)lds, H, h, j, subln_w, lam); } }
        GSYNC();
        { PH_BEGIN; unsigned char* ws = PWS; const int tid = opaque_tid();
          for (size_t i = (size_t)blockIdx.x * 512 + tid; i < 131072; i += (size_t)gridDim.x * 512) ssd::scan_phase((bf16_t*)(ws + WS_T1), (const float*)(ws + WS_CTL) + 1024, (int)i); }
        GSYNC();
        { PH_BEGIN; unsigned char* ws = PWS; const int c = blockIdx.x, G = gridDim.x;
#if PROBE_SSD
          for (int u = c; u < 256; u += G) ssd::phaseA_unit((SS_LAS unsigned char*)lds, (bf16_t*)(ws + WS_H), (const float*)(ws + WS_DT) + (size_t)b * SEQ * 32, PIN(3), PIN(4), PIN(6), (bf16_t*)(POUT + (size_t)SEQ * D), (float*)(ws + WS_CTL) + 8192, u >> 2, u & 3);
          for (int u = c; u < 256; u += G) ssd::phaseC_unit<false>((SS_LAS unsigned char*)lds, (bf16_t*)(ws + WS_H), (const float*)(ws + WS_DT) + (size_t)b * SEQ * 32, PIN(3), PIN(4), PIN(6), PIN(7), PIN(8), (const bf16_t*)(ws + WS_T1), u >> 2, u & 3);
#endif
          for (int u = c; u < 256; u += G) ssd::phaseC_unit((SS_LAS unsigned char*)lds, (bf16_t*)(ws + WS_H), (const float*)(ws + WS_DT) + (size_t)b * SEQ * 32, PIN(3), PIN(4), PIN(6), PIN(7), PIN(8), (const bf16_t*)(ws + WS_T1), u >> 2, u & 3); }
        GSYNC();
        { PH_BEGIN; unsigned char* ws = PWS; bf16_t* H = (bf16_t*)(ws + WS_H); float* T1 = (float*)(ws + WS_T1);
          run_gemm(lds, H + HC_Z, HP_, (const bf16_t*)(ws + WS_WSSD), SEQ, D, DI, EpiGate1{H, T1});
          run_gemm(lds, H + HC_Q, HP_, (const bf16_t*)(ws + WS_WDIFF), SEQ, D, D, EpiGate2{H, T1});
          if (b == BATCH - 1 && 2 * (int)blockIdx.x >= (int)gridDim.x) { const int tid = opaque_tid(); const int half = (gridDim.x + 1) / 2;
              const size_t gt = (size_t)(blockIdx.x - half) * 512 + tid, gn = (size_t)(gridDim.x - half) * 512;
              sp::cvt_fp8_range(PIN(26), ws + WS_PU, (size_t)PK * PK * D / 16, sp::PEER_SU, gt, gn);
              sp::cvt_fp8_range(PIN(27), ws + WS_PV, (size_t)PK * PK * D / 16, sp::PEER_SV, gt, gn); } }
        GSYNC();
        { PH_BEGIN; unsigned char* ws = PWS;
          run_gemm(lds, (const bf16_t*)(ws + WS_H) + HC_K, HP_, (const bf16_t*)(ws + WS_WO), SEQ, D, D, EpiResid{PIN(0), POUT, b * SEQ, 0}); }
        GSYNC();
        if (b + 1 < BATCH) {
            { PH_BEGIN; unsigned char* ws = PWS;
              run_gemm(lds, (const bf16_t*)(ws + WS_XB) + (size_t)(b + 1) * SEQ * D, D, (const bf16_t*)(ws + WS_WIN), SEQ, NINP, D, EpiInProj{(bf16_t*)(ws + WS_H), PIN(14)}); }
            GSYNC();
        }
    }
    { PH_BEGIN; unsigned char* ws = PWS; const int tid = opaque_tid(), lane = tid & 63, wave = __builtin_amdgcn_readfirstlane(tid >> 6), c = blockIdx.x, G = gridDim.x;
      float* out = POUT; const float* g = PIN(16); const float* bb = PIN(17); bf16_t* XB = (bf16_t*)(ws + WS_X1B);
      for (int r = c * 8 + wave; r < M; r += G * 8) sp::ln_row(out, g, bb, XB, r, lane); }
    GSYNC();
    { PH_BEGIN; unsigned char* ws = PWS;
      run_gemm(lds, (const bf16_t*)(ws + WS_X1B), D, (const bf16_t*)(ws + WS_WCQ), M, D, D, EpiPlain{(bf16_t*)(ws + WS_QC), D, CQSCALE}); }
    GSYNC();
    { PH_BEGIN; unsigned char* ws = PWS; const int c = blockIdx.x, G = gridDim.x;
      for (int u = c; u < 256; u += G) xattn::unit((XA_LAS unsigned char*)lds, (const bf16_t*)(ws + WS_QC), (const bf16_t*)(ws + WS_KCVC), (const bf16_t*)(ws + WS_KCVC) + (size_t)BATCH * MEML * D, (bf16_t*)(ws + WS_XO), u >> 2, u & 3); }
    GSYNC();
    { PH_BEGIN; unsigned char* ws = PWS; float* out = POUT;
      run_gemm(lds, (const bf16_t*)(ws + WS_XO), D, (const bf16_t*)(ws + WS_WCO), M, D, D, EpiResid{out, out, 0, 0}); }
    GSYNC();
    { PH_BEGIN; unsigned char* ws = PWS; const int tid = opaque_tid(), lane = tid & 63, wave = __builtin_amdgcn_readfirstlane(tid >> 6), c = blockIdx.x, G = gridDim.x;
      float* out = POUT; const float* g = PIN(22); const float* bb = PIN(23); bf16_t* XB = (bf16_t*)(ws + WS_X1B);
      for (int r = c * 8 + wave; r < M; r += G * 8) sp::ln_row(out, g, bb, XB, r, lane); }
    GSYNC();
    { PH_BEGIN; unsigned char* ws = PWS;
      run_gemm(lds, (const bf16_t*)(ws + WS_X1B), D, (const bf16_t*)(ws + WS_WPQ), M, 2048, D, EpiPlain{(bf16_t*)(ws + WS_QP), 2048, 1.f}); }
    GSYNC();
    { PH_BEGIN; unsigned char* ws = PWS; const int c = blockIdx.x, G = gridDim.x;
      for (int t = 64 * c; t < M; t += 64 * G)
          for (int hp = 0; hp < 4; ++hp) psel::step((PS_LAS int*)lds, (const bf16_t*)(ws + WS_QP), (const bf16_t*)(ws + WS_SUBK), (int*)(ws + WS_IDX), (float*)(ws + WS_GATE), t, hp); }
    GSYNC();
    { PH_BEGIN; unsigned char* ws = PWS; const int tid = opaque_tid(), lane = tid & 63, wave = __builtin_amdgcn_readfirstlane(tid >> 6);
      const peer2::Own o = peer2::ownership((unsigned*)(ws + WS_CTL), (P2_LAS unsigned*)lds, 0, wave);
      for (int jj = o.j; jj < 8; jj += o.nsl) peer2::u_wave(POUT, ws + WS_PU, (const int*)(ws + WS_IDX), (float*)(ws + WS_PART), jj, o.rank, o.nrank, lane); }
    GSYNC();
    { PH_BEGIN; unsigned char* ws = PWS; const int tid = opaque_tid(), lane = tid & 63, wave = __builtin_amdgcn_readfirstlane(tid >> 6);
      const peer2::Own o = peer2::ownership((unsigned*)(ws + WS_CTL), (P2_LAS unsigned*)lds, 1, wave);
      for (int jj = o.j; jj < 8; jj += o.nsl) peer2::v_wave(POUT, ws + WS_PV, (const int*)(ws + WS_IDX), (const float*)(ws + WS_GATE), (const float*)(ws + WS_PART), (P2_LAS float*)lds + 64 + wave * 128, jj, o.rank, o.nrank, lane); }
    GSYNC();
    { PH_BEGIN; const int tid = opaque_tid(), lane = tid & 63, wave = __builtin_amdgcn_readfirstlane(tid >> 6);
      float* out = POUT; const float* g3 = PIN(28); const float* b3 = PIN(29);
      for (int r = blockIdx.x * 8 + wave; r < M; r += gridDim.x * 8) peer2::ln_row_plain(out, g3, b3, r, lane); }
}

extern "C" void kernel_launch(void* const* d_in, const int* in_sizes, int n_in, void* d_out, int out_size, void* d_ws, size_t ws_size, hipStream_t stream) {
    static int grid_blocks = 0;
    if (grid_blocks == 0) {
        if (n_in != 30 || out_size != M * D || ws_size < WS_END) { fprintf(stderr, "kernel_launch: unexpected sizes n_in %d out %d ws %zu (need %zu)\n", n_in, out_size, ws_size, (size_t)WS_END); grid_blocks = -1; return; }
        int dev = 0, cus = 0, per_cu = 0;
        (void)hipGetDevice(&dev); (void)hipDeviceGetAttribute(&cus, hipDeviceAttributeMultiprocessorCount, dev);
        (void)hipFuncSetAttribute((const void*)hybrid_fwd, hipFuncAttributeMaxDynamicSharedMemorySize, LDS_BYTES);
        if (hipOccupancyMaxActiveBlocksPerMultiprocessor(&per_cu, (const void*)hybrid_fwd, 512, LDS_BYTES) != hipSuccess || per_cu < 1) { fprintf(stderr, "kernel_launch: occupancy query failed (%d)\n", per_cu); per_cu = 1; }
        (void)hipGetLastError();
        grid_blocks = cus * 1;
    }
    if (grid_blocks < 0) return;
    if (hipMemsetAsync(d_ws, 0, 65536, stream) != hipSuccess) { fprintf(stderr, "kernel_launch: memset of control words failed\n"); return; }
    Params p{};
    for (int i = 0; i < 30; ++i) p.in[i] = (const float*)d_in[i];
    p.out = (float*)d_out; p.ws = (unsigned char*)d_ws;
    void* args[] = {&p};
    hipError_t e = hipLaunchCooperativeKernel((const void*)hybrid_fwd, dim3(grid_blocks), dim3(512), args, LDS_BYTES, stream);
    if (e != hipSuccess) fprintf(stderr, "cooperative launch failed: %s (grid %d)\n", hipGetErrorString(e), grid_blocks);
}
```

```cpp
#include <hip/hip_runtime.h>
#include <hip/hip_cooperative_groups.h>
namespace cg = cooperative_groups;
#include <cstdio>
#include <cstdint>
#include <cmath>
#include <type_traits>

typedef unsigned short bf16_t;
typedef float f32x4 __attribute__((ext_vector_type(4)));
typedef unsigned u32x4 __attribute__((ext_vector_type(4)));
typedef unsigned u32x2 __attribute__((ext_vector_type(2)));

constexpr int D = 1024, BATCH = 2, SEQ = 8192, M = BATCH * SEQ;
constexpr int DI = 2048, NH = 32, HP = 64, NG = 4, DS = 128, DXBC = 3072;
constexpr int AH = 8, AD = 64, AV = 128;
constexpr int MEML = 256, MH = 4, MHD = 256;
constexpr int PH = 8, PK = 128, PDK = 256, PHALF = 128, PTOP = 16;
constexpr int NIN = 10272, NINP = 10240;
constexpr float ALPHA = 1.189207115002721f;
constexpr float LOG2E = 1.4426950408889634f;
constexpr float QSCALE = 0.125f * LOG2E;
constexpr float CQSCALE = 0.0625f * LOG2E;
constexpr float LAMBDA_INIT = 0.2f;
constexpr int HC_Z = 0, HC_XBC = 2048, HC_Q = 5120, HC_K = 6144, HC_V = 7168, HC_GS = 8192, HC_GA = 9216, HP_ = NINP;

constexpr size_t MiB = 1u << 20;
constexpr size_t WS_CTL = 0;
constexpr size_t WS_WIN = 1 * MiB;
constexpr size_t WS_WSSD = 21 * MiB;
constexpr size_t WS_WDIFF = 25 * MiB, WS_WO = 27 * MiB, WS_WCQ = 29 * MiB, WS_WCKV = 31 * MiB  , WS_WCO = 35 * MiB;
constexpr size_t WS_WPQ = 37 * MiB;
constexpr size_t WS_SUBK = 41 * MiB;
constexpr size_t WS_MEMB = 42 * MiB;
constexpr size_t WS_KCVC = 43 * MiB;
constexpr size_t WS_DT = 45 * MiB;
constexpr size_t WS_XB = 47 * MiB;
constexpr size_t WS_H = 79 * MiB;
constexpr size_t WS_T1 = 239 * MiB;
constexpr size_t WS_PU = 47 * MiB, WS_PV = 63 * MiB;
constexpr size_t WS_X1B = 79 * MiB;
constexpr size_t WS_QC = 143 * MiB, WS_XO = 175 * MiB;
constexpr size_t WS_QP = 207 * MiB;
constexpr size_t WS_IDX = 143 * MiB, WS_GATE = 151 * MiB;
constexpr size_t WS_PART = 207 * MiB;
constexpr size_t WS_END = 271 * MiB;
constexpr int CW_LAM = 64;

__device__ __forceinline__ int opaque_tid() { int t = threadIdx.x; asm volatile("" : "+v"(t)); return t; }
__device__ __forceinline__ unsigned f2bf(float f) { unsigned u = __builtin_bit_cast(unsigned, f); return (u + 0x7fffu + ((u >> 16) & 1u)) >> 16; }
__device__ __forceinline__ float bf2f(unsigned h) { return __builtin_bit_cast(float, h << 16); }
__device__ __forceinline__ unsigned pk2(float lo, float hi) { return f2bf(lo) | (f2bf(hi) << 16); }
__device__ __forceinline__ float bflo(unsigned w) { return __builtin_bit_cast(float, w << 16); }
__device__ __forceinline__ float bfhi(unsigned w) { return __builtin_bit_cast(float, w & 0xffff0000u); }
__device__ __forceinline__ float sigmoidf_(float v) { return __builtin_amdgcn_rcpf(1.f + __expf(-v)); }
__device__ __forceinline__ float siluf_(float v) { return v * __builtin_amdgcn_rcpf(1.f + __expf(-v)); }
__device__ __forceinline__ float wave_sum(float v) {
#pragma unroll
    for (int o = 1; o < 64; o <<= 1) v += __shfl_xor(v, o);
    return v;
}
__device__ __forceinline__ float wave_max(float v) {
#pragma unroll
    for (int o = 1; o < 64; o <<= 1) v = fmaxf(v, __shfl_xor(v, o));
    return v;
}

__device__ __forceinline__ void store_bf16x8(bf16_t* p, const float (&v)[8]) { u32x4 w; w.x = pk2(v[0], v[1]); w.y = pk2(v[2], v[3]); w.z = pk2(v[4], v[5]); w.w = pk2(v[6], v[7]); *(u32x4*)p = w; }
struct EpiPlain { bf16_t* O; int ldc; float scale;
    __device__ __forceinline__ void operator()(int row, int col0, const float (&v)[8]) const { float o[8];
#pragma unroll
        for (int j = 0; j < 8; ++j) o[j] = v[j] * scale; store_bf16x8(O + (size_t)row * ldc + col0, o); } };
struct EpiInProj { bf16_t* H; const float* gate_bias;
    __device__ __forceinline__ void operator()(int row, int col0, const float (&v)[8]) const { float o[8];
        if (col0 >= HC_GS) { const float* gb = gate_bias + (col0 - HC_GS);
#pragma unroll
            for (int j = 0; j < 8; ++j) o[j] = sigmoidf_(v[j] + gb[j]); }
        else { const float s = (col0 >= HC_Q && col0 < HC_K) ? QSCALE : 1.f;
#pragma unroll
            for (int j = 0; j < 8; ++j) o[j] = v[j] * s; }
        store_bf16x8(H + (size_t)row * HP_ + col0, o); } };
struct EpiGate1 { const bf16_t* H; float* T1;
    __device__ __forceinline__ void operator()(int row, int col0, const float (&v)[8]) const {
        const u32x4 g = *(const u32x4*)(H + (size_t)row * HP_ + HC_GS + col0); const unsigned gw[4] = {g.x, g.y, g.z, g.w};
        float* t = T1 + (size_t)row * D + col0;
#pragma unroll
        for (int j = 0; j < 4; ++j) { t[2 * j] = bflo(gw[j]) * v[2 * j]; t[2 * j + 1] = bfhi(gw[j]) * v[2 * j + 1]; } } };
struct EpiGate2 { bf16_t* H; const float* T1;
    __device__ __forceinline__ void operator()(int row, int col0, const float (&v)[8]) const {
        const u32x4 g = *(const u32x4*)(H + (size_t)row * HP_ + HC_GA + col0); const unsigned gw[4] = {g.x, g.y, g.z, g.w};
        const float* t = T1 + (size_t)row * D + col0; float o[8];
#pragma unroll
        for (int j = 0; j < 4; ++j) { o[2 * j] = t[2 * j] + bflo(gw[j]) * v[2 * j]; o[2 * j + 1] = t[2 * j + 1] + bfhi(gw[j]) * v[2 * j + 1]; }
        store_bf16x8(H + (size_t)row * HP_ + HC_K + col0, o); } };
struct EpiResid { const float* base; float* out; int row_off; int pad_;
    __device__ __forceinline__ void operator()(int row, int col0, const float (&v)[8]) const {
        const size_t o = (size_t)(row + row_off) * D + col0;
#pragma unroll
        for (int j = 0; j < 8; ++j) out[o + j] = ALPHA * base[o + j] + v[j]; } };


namespace pg8 {
#define PG8_LAS __attribute__((address_space(3)))
typedef short bf16x8 __attribute__((ext_vector_type(8)));
constexpr int BM = 256, BK = 64, HALF = 128, HTB = HALF * BK * 2, STAGE_BYTES = 8 * HTB, NXCD = 8, WGM = 8;
__host__ __device__ __forceinline__ int lds_byte(int r, int c) { const int st = (r >> 4) * 2 + (c >> 5), rr = r & 15, cc = c & 31, ob = rr * 64 + cc * 2; return st * 1024 + (ob ^ (((ob >> 9) & 1) << 5)); }
__host__ __device__ __forceinline__ void stage_rc(int b, int& R, int& C) { const int st = b / 1024, sb = b % 1024, swz = sb ^ (((sb >> 9) & 1) << 5); R = (st >> 1) * 16 + swz / 64; C = (st & 1) * 32 + (swz % 64) / 2; }
__host__ __device__ __forceinline__ int perm32(int rho) { const int n = rho >> 4, i = rho & 15; return 8 * (i >> 2) + 4 * n + (i & 3); }
struct Unit { int pm, pn; };
struct Gemm { const bf16_t* A; const bf16_t* Bt; int M, N, K, lda; };
struct StaticOrder {
    int nM, nN, nwg, G, c;
    __host__ __device__ void init(int M, int N, int G_, int c_) { nM = M / BM; nN = N / BM; nwg = nM * nN; G = G_; c = c_; }
    __host__ __device__ bool next(int i, Unit& u) const {
        const long L = (long)i * G + c; if (L >= nwg) return false;
        int wgid = (int)L; { const int q = nwg / NXCD, r = nwg % NXCD, xcd = wgid % NXCD, off = wgid / NXCD; wgid = (xcd < r ? xcd * (q + 1) : r * (q + 1) + (xcd - r) * q) + off; }
        const int nig = WGM * nN, gid = wgid / nig, fm = gid * WGM, gsz = (nM - fm) < WGM ? (nM - fm) : WGM;
        u.pm = fm + ((wgid % nig) % gsz); u.pn = (wgid % nig) / gsz; return true;
    }
};
template <class F> struct EpiAdapt {
    static constexpr bool PERM = true, AFTER_DRAIN = false; F f;
    __device__ __forceinline__ void operator()(const f32x4 (&acc)[2][2][4][2], const Unit& u, int wr, int wc, int fr, int fq) const {
#pragma unroll
        for (int ai = 0; ai < 2; ++ai)
#pragma unroll
            for (int m = 0; m < 4; ++m) { const int row = u.pm * BM + ai * HALF + wr * 64 + m * 16 + fr;
#pragma unroll
                for (int bj = 0; bj < 2; ++bj) { const int col0 = u.pn * BM + bj * HALF + wc * 32 + 8 * fq;
                    const f32x4 a = acc[ai][bj][m][0], b = acc[ai][bj][m][1]; const float v[8] = {a[0], a[1], a[2], a[3], b[0], b[1], b[2], b[3]};
                    f(row, col0, v); } }
    }
};
template <class Epi, class Sched, bool ALIGN_EPI>
__device__ __forceinline__ void gemm_phase(PG8_LAS unsigned char* lds, const Gemm g, const Sched& S, const Epi& E) {
    const int tid = opaque_tid(), wid = __builtin_amdgcn_readfirstlane(tid >> 6), lane = tid & 63, wr = wid >> 2, wc = wid & 3, fr = lane & 15, fq = lane >> 4;
    const int K = g.K, nt = K / BK, lda = g.lda;
    unsigned voffA[2], voffB[2];
#pragma unroll
    for (int i = 0; i < 2; ++i) { int R, C; stage_rc(tid * 16 + i * 8192, R, C); const int Rb = Epi::PERM ? ((R & ~31) + perm32(R & 31)) : R;
        voffA[i] = (unsigned)(R * lda + C) * 2u; voffB[i] = (unsigned)(Rb * K + C) * 2u; }
    const size_t kstep = (size_t)(BK * 2);
    const size_t hstepA = (size_t)HALF * lda * 2, hstepB = (size_t)HALF * K * 2;
    const size_t tstepA = 2 * hstepA, tstepB = 2 * hstepB;
    const unsigned ldsw = (unsigned)wid * 1024u;
    const int aoff = lds_byte(wr * 64 + fr, fq * 8), boff = lds_byte(wc * 32 + fr, fq * 8);
#define PG8_SA(b, h) (((b) * 2 + (h)) * HTB)
#define PG8_SB(b, h) ((4 + (b) * 2 + (h)) * HTB)
#define PG8_STAGE(bufoff, gbase, voff) do { _Pragma("unroll") for (int _i = 0; _i < 2; ++_i) \
        __builtin_amdgcn_global_load_lds((const unsigned*)((const char*)(gbase) + (voff)[_i]), (PG8_LAS unsigned*)(lds + (bufoff) + ldsw + _i * 8192), 16, 0, 0); } while (0)
#define PG8_LDA(dst, b, h) do { _Pragma("unroll") for (int m = 0; m < 4; ++m) _Pragma("unroll") for (int k = 0; k < 2; ++k) dst[m][k] = *(const PG8_LAS bf16x8*)(lds + PG8_SA(b, h) + aoff + m * 2048 + k * 1024); } while (0)
#define PG8_LDB(dst, b, h) do { _Pragma("unroll") for (int n = 0; n < 2; ++n) _Pragma("unroll") for (int k = 0; k < 2; ++k) dst[n][k] = *(const PG8_LAS bf16x8*)(lds + PG8_SB(b, h) + boff + n * 2048 + k * 1024); } while (0)
#define PG8_MMA(ai, bj, At, Bt) do { __builtin_amdgcn_s_setprio(1); _Pragma("unroll") for (int m = 0; m < 4; ++m) _Pragma("unroll") for (int n = 0; n < 2; ++n) _Pragma("unroll") for (int k = 0; k < 2; ++k) \
        acc[ai][bj][m][n] = __builtin_amdgcn_mfma_f32_16x16x32_bf16(Bt[n][k], At[m][k], acc[ai][bj][m][n], 0, 0, 0); __builtin_amdgcn_s_setprio(0); } while (0)
#define PG8_WAIT_V(n) asm volatile("s_waitcnt vmcnt(" #n ")" ::: "memory")
#define PG8_WAIT_L(n) asm volatile("s_waitcnt lgkmcnt(" #n ")" ::: "memory")
#define PG8_BAR __builtin_amdgcn_s_barrier()
#define PG8_SCHED __builtin_amdgcn_sched_barrier(0)
    Unit cur, nxt; int ui = 0;
    if (!S.next(0, cur)) return;
    f32x4 acc[2][2][4][2];
#pragma unroll
    for (int a = 0; a < 2; ++a)
#pragma unroll
        for (int b = 0; b < 2; ++b)
#pragma unroll
            for (int m = 0; m < 4; ++m)
#pragma unroll
                for (int n = 0; n < 2; ++n) acc[a][b][m][n] = (f32x4){0.f, 0.f, 0.f, 0.f};
    bf16x8 At[4][2], B0[2][2], B1[2][2];
    const char* cA = (const char*)g.A + (size_t)cur.pm * tstepA; const char* cB = (const char*)g.Bt + (size_t)cur.pn * tstepB;
    PG8_STAGE(PG8_SB(0, 0), cB, voffB); PG8_STAGE(PG8_SB(0, 1), cB + hstepB, voffB); PG8_STAGE(PG8_SA(0, 0), cA, voffA); PG8_STAGE(PG8_SA(0, 1), cA + hstepA, voffA);
    if (wr == 1) PG8_BAR;
    PG8_WAIT_V(2); PG8_BAR;
    PG8_STAGE(PG8_SB(1, 0), cB + kstep, voffB); PG8_STAGE(PG8_SA(1, 0), cA + kstep, voffA); PG8_STAGE(PG8_SB(1, 1), cB + hstepB + kstep, voffB);
    PG8_WAIT_V(6); PG8_BAR;
    for (;;) {
        const bool has_next = S.next(ui + 1, nxt);
        const char* nA = has_next ? (const char*)g.A + (size_t)nxt.pm * tstepA : cA; const char* nB = has_next ? (const char*)g.Bt + (size_t)nxt.pn * tstepB : cB;
        for (int t = 0; t < nt; t += 2) {
            const bool last = (t == nt - 2);
            const char* a1 = cA + (size_t)(t + 1) * kstep;
            const char* a2 = last ? nA : cA + (size_t)(t + 2) * kstep; const char* b2 = last ? nB : cB + (size_t)(t + 2) * kstep;
            const char* a3 = a2 + kstep; const char* b3 = b2 + kstep;
            PG8_LDB(B0, 0, 0); PG8_LDB(B1, 0, 1); PG8_SCHED; PG8_LDA(At, 0, 0); PG8_STAGE(PG8_SA(1, 1), a1 + hstepA, voffA);
            PG8_WAIT_V(8); PG8_WAIT_L(0); PG8_BAR; PG8_MMA(0, 0, At, B0); PG8_MMA(0, 1, At, B1); PG8_BAR; PG8_SCHED;
            PG8_LDA(At, 0, 1); PG8_STAGE(PG8_SB(0, 0), b2, voffB); PG8_STAGE(PG8_SB(0, 1), b2 + hstepB, voffB); PG8_STAGE(PG8_SA(0, 0), a2, voffA);
            PG8_WAIT_V(8); PG8_WAIT_L(0); PG8_BAR; PG8_MMA(1, 0, At, B0); PG8_MMA(1, 1, At, B1); PG8_BAR; PG8_SCHED;
            PG8_LDB(B0, 1, 0); PG8_LDB(B1, 1, 1); PG8_SCHED; PG8_LDA(At, 1, 0); PG8_STAGE(PG8_SA(0, 1), a2 + hstepA, voffA);
            PG8_WAIT_V(8); PG8_WAIT_L(0); PG8_BAR; PG8_MMA(0, 0, At, B0); PG8_MMA(0, 1, At, B1); PG8_BAR; PG8_SCHED;
            PG8_LDA(At, 1, 1); PG8_STAGE(PG8_SB(1, 0), b3, voffB); PG8_STAGE(PG8_SB(1, 1), b3 + hstepB, voffB); PG8_STAGE(PG8_SA(1, 0), a3, voffA);
            PG8_WAIT_V(8); PG8_WAIT_L(0); PG8_BAR; PG8_MMA(1, 0, At, B0); PG8_MMA(1, 1, At, B1); PG8_BAR; PG8_SCHED;
        }
        if constexpr (ALIGN_EPI) { if (wr == 0) PG8_BAR; }
        E(acc, cur, wr, wc, fr, fq);
        if (!has_next) break;
#pragma unroll
        for (int a = 0; a < 2; ++a)
#pragma unroll
            for (int b = 0; b < 2; ++b)
#pragma unroll
                for (int m = 0; m < 4; ++m)
#pragma unroll
                    for (int n = 0; n < 2; ++n) acc[a][b][m][n] = (f32x4){0.f, 0.f, 0.f, 0.f};
        cur = nxt; cA = nA; cB = nB; ++ui;
        if constexpr (ALIGN_EPI) { if (wr == 1) PG8_BAR; }
    }
    PG8_WAIT_V(0);
    if constexpr (!ALIGN_EPI) { if (wr == 0) PG8_BAR; }
    PG8_BAR;
#undef PG8_SA
#undef PG8_SB
#undef PG8_STAGE
#undef PG8_LDA
#undef PG8_LDB
#undef PG8_MMA
#undef PG8_WAIT_V
#undef PG8_WAIT_L
#undef PG8_BAR
#undef PG8_SCHED
}
}
constexpr int LDS_BYTES = 148480;
namespace dattn {
#define DA_LAS __attribute__((address_space(3)))
typedef short bf16x8 __attribute__((ext_vector_type(8)));
typedef short s16x4 __attribute__((ext_vector_type(4)));
typedef float f32x16 __attribute__((ext_vector_type(16)));
constexpr int KP = 272, VP = 320, KBUF = 64 * KP, VBUF = 64 * VP, BUF = KBUF + VBUF, XOFF = 2 * BUF, LDS_NEED = XOFF + 65536;
static_assert(LDS_NEED <= 147456, "attention LDS");
__device__ __forceinline__ unsigned cvtpk(float lo, float hi) { typedef float f2 __attribute__((ext_vector_type(2))); typedef __bf16 b2 __attribute__((ext_vector_type(2))); f2 v = {lo, hi}; b2 b = __builtin_convertvector(v, b2); return __builtin_bit_cast(unsigned, b); }
__device__ __forceinline__ s16x4 vtr(const DA_LAS unsigned char* p) { typedef short v4i16_t __attribute__((ext_vector_type(4))); return __builtin_bit_cast(s16x4, __builtin_amdgcn_ds_read_tr16_b64_v4i16((DA_LAS v4i16_t*)p)); }
template <bool STORE = true> __device__ __forceinline__ void unit(DA_LAS unsigned char* lds, bf16_t* Hb, int h, int qb, const float* __restrict__ subln_w, float lam) {
    const int tid = opaque_tid(), lane = tid & 63, w = __builtin_amdgcn_readfirstlane(tid >> 6), mp = w >> 2, rb = w & 3, c32 = lane & 31, hh = lane >> 5;
    const int qrow = 128 * qb + 32 * rb + c32;
    bf16x8 qf[4];
    { const bf16_t* qp = Hb + (size_t)qrow * HP_ + HC_Q + h * 128 + 64 * mp + 8 * hh;
#pragma unroll
      for (int s = 0; s < 4; ++s) qf[s] = *(const bf16x8*)(qp + 16 * s); }
    const int srow = tid >> 4, sch = tid & 15;
    const bf16_t* kg = Hb + HC_K + h * 128 + sch * 8; const bf16_t* vg = Hb + HC_V + h * 128 + sch * 8;
    const int nt = 2 * qb + 2;
    u32x4 kr[2], vr[2];
#define DA_LOAD(t) do { _Pragma("unroll") for (int j = 0; j < 2; ++j) { const size_t ro = (size_t)(64 * (t) + srow + 32 * j) * HP_; kr[j] = *(const u32x4*)(kg + ro); vr[j] = *(const u32x4*)(vg + ro); } } while (0)
#define DA_WRITE(buf) do { _Pragma("unroll") for (int j = 0; j < 2; ++j) { *(DA_LAS u32x4*)(lds + (buf) * BUF + (srow + 32 * j) * KP + sch * 16) = kr[j]; *(DA_LAS u32x4*)(lds + (buf) * BUF + KBUF + (srow + 32 * j) * VP + sch * 16) = vr[j]; } } while (0)
    DA_LOAD(0); DA_WRITE(0);
    __syncthreads();
    f32x16 oT[4];
#pragma unroll
    for (int i = 0; i < 4; ++i) oT[i] = (f32x16){0.f, 0.f, 0.f, 0.f, 0.f, 0.f, 0.f, 0.f, 0.f, 0.f, 0.f, 0.f, 0.f, 0.f, 0.f, 0.f};
    float mrow = -INFINITY, lrow = 0.f;
    const int koff = c32 * KP + (64 * mp + 8 * hh) * 2;
    const int voff = KBUF + (4 * hh + ((lane & 15) >> 2)) * VP + (16 * ((lane >> 4) & 1) + 4 * (lane & 3)) * 2;
    for (int t = 0; t < nt; ++t) {
        const int cur = t & 1;
        if (t + 1 < nt) DA_LOAD(t + 1);
        if (!(t == nt - 1 && rb <= 1)) {
            const DA_LAS unsigned char* kb = lds + cur * BUF + koff;
            f32x16 s0 = (f32x16){0.f, 0.f, 0.f, 0.f, 0.f, 0.f, 0.f, 0.f, 0.f, 0.f, 0.f, 0.f, 0.f, 0.f, 0.f, 0.f}, s1 = s0;
            bf16x8 kf0[4], kf1[4];
#pragma unroll
            for (int s = 0; s < 4; ++s) { kf0[s] = *(const DA_LAS bf16x8*)(kb + s * 32); kf1[s] = *(const DA_LAS bf16x8*)(kb + 32 * KP + s * 32); }
            __builtin_amdgcn_s_setprio(1);
#pragma unroll
            for (int s = 0; s < 4; ++s) {
                s0 = __builtin_amdgcn_mfma_f32_32x32x16_bf16(kf0[s], qf[s], s0, 0, 0, 0);
                s1 = __builtin_amdgcn_mfma_f32_32x32x16_bf16(kf1[s], qf[s], s1, 0, 0, 0);
            }
            __builtin_amdgcn_s_setprio(0);
            if (t >= nt - 2) {
                const int k0 = 64 * t + 4 * hh;
#pragma unroll
                for (int r = 0; r < 16; ++r) { const int key = k0 + (r & 3) + 8 * (r >> 2); if (key > qrow) s0[r] = -INFINITY; if (key + 32 > qrow) s1[r] = -INFINITY; }
            }
            float mx = fmaxf(s0[0], s1[0]);
#pragma unroll
            for (int r = 1; r < 16; ++r) mx = fmaxf(mx, fmaxf(s0[r], s1[r]));
            mx = fmaxf(mx, __shfl_xor(mx, 32));
            if (__any(mx > mrow + 8.f)) {
                const float mnew = fmaxf(mrow, mx), alpha = __builtin_amdgcn_exp2f(mrow - mnew);
                mrow = mnew; lrow *= alpha;
#pragma unroll
                for (int i = 0; i < 4; ++i)
#pragma unroll
                    for (int r = 0; r < 16; ++r) oT[i][r] *= alpha;
            }
            float ps = 0.f;
#pragma unroll
            for (int r = 0; r < 16; ++r) { s0[r] = __builtin_amdgcn_exp2f(s0[r] - mrow); s1[r] = __builtin_amdgcn_exp2f(s1[r] - mrow); ps += s0[r] + s1[r]; }
            lrow += ps;
            bf16x8 pf[2][2];
#pragma unroll
            for (int s = 0; s < 2; ++s) {
                u32x4 a, b;
                a.x = cvtpk(s0[8 * s], s0[8 * s + 1]); a.y = cvtpk(s0[8 * s + 2], s0[8 * s + 3]); a.z = cvtpk(s0[8 * s + 4], s0[8 * s + 5]); a.w = cvtpk(s0[8 * s + 6], s0[8 * s + 7]);
                b.x = cvtpk(s1[8 * s], s1[8 * s + 1]); b.y = cvtpk(s1[8 * s + 2], s1[8 * s + 3]); b.z = cvtpk(s1[8 * s + 4], s1[8 * s + 5]); b.w = cvtpk(s1[8 * s + 6], s1[8 * s + 7]);
                pf[0][s] = __builtin_bit_cast(bf16x8, a); pf[1][s] = __builtin_bit_cast(bf16x8, b);
            }
            const DA_LAS unsigned char* vb = lds + cur * BUF + voff;
#define DA_LDV(dst, db) do { _Pragma("unroll") for (int i_ = 0; i_ < 4; ++i_) { const s16x4 lo_ = vtr(vb + (16 * i_) * VP + (db) * 64), hi_ = vtr(vb + (16 * i_ + 8) * VP + (db) * 64); \
                dst[i_] = (bf16x8){lo_[0], lo_[1], lo_[2], lo_[3], hi_[0], hi_[1], hi_[2], hi_[3]}; } } while (0)
#define DA_MM(src, db) do { _Pragma("unroll") for (int i_ = 0; i_ < 4; ++i_) oT[db] = __builtin_amdgcn_mfma_f32_32x32x16_bf16(src[i_], pf[i_ >> 1][i_ & 1], oT[db], 0, 0, 0); } while (0)
            bf16x8 va[4], vq[4];
            DA_LDV(va, 0);
            DA_LDV(vq, 1); __builtin_amdgcn_s_setprio(1); DA_MM(va, 0); __builtin_amdgcn_s_setprio(0);
            DA_LDV(va, 2); __builtin_amdgcn_s_setprio(1); DA_MM(vq, 1); __builtin_amdgcn_s_setprio(0);
            DA_LDV(vq, 3); __builtin_amdgcn_s_setprio(1); DA_MM(va, 2); __builtin_amdgcn_s_setprio(0);
            __builtin_amdgcn_s_setprio(1); DA_MM(vq, 3);
#undef DA_LDV
#undef DA_MM
            __builtin_amdgcn_s_setprio(0);
        }
        if (t + 1 < nt) DA_WRITE(cur ^ 1);
        __syncthreads();
    }
#undef DA_LOAD
#undef DA_WRITE
    const float inv = 1.f / (lrow + __shfl_xor(lrow, 32));
    DA_LAS float* X = (DA_LAS float*)(lds + XOFF) + rb * 4096 + lane;
    if (mp == 1) {
#pragma unroll
        for (int i = 0; i < 4; ++i)
#pragma unroll
            for (int r = 0; r < 16; ++r) X[(i * 16 + r) * 64] = oT[i][r] * inv;
    }
    __syncthreads();
    if (mp == 0) {
        float ss = 0.f;
#pragma unroll
        for (int i = 0; i < 4; ++i)
#pragma unroll
            for (int r = 0; r < 16; ++r) { const float o = oT[i][r] * inv - lam * X[(i * 16 + r) * 64]; oT[i][r] = o; ss += o * o; }
        ss += __shfl_xor(ss, 32);
        const float rr = rsqrtf(ss * (1.f / 128.f) + 1e-5f) * (1.f - LAMBDA_INIT);
        bf16_t* op = Hb + (size_t)qrow * HP_ + HC_Q + h * 128 + 4 * hh;
#pragma unroll
        for (int i = 0; i < 4; ++i)
#pragma unroll
            for (int g = 0; g < 4; ++g) { const int d0 = 32 * i + 8 * g; const f32x4 sw = *(const f32x4*)(subln_w + d0 + 4 * hh);
                uint2 o; o.x = pk2(oT[i][4 * g] * rr * sw.x, oT[i][4 * g + 1] * rr * sw.y); o.y = pk2(oT[i][4 * g + 2] * rr * sw.z, oT[i][4 * g + 3] * rr * sw.w);
                if (STORE || o.x == 0x12345u) *(uint2*)(op + d0) = o; }
    }
    __syncthreads();
}
}
namespace ssd {
#define SS_LAS __attribute__((address_space(3)))
typedef short bf16x8 __attribute__((ext_vector_type(8)));
typedef short s16x4 __attribute__((ext_vector_type(4)));
typedef float f32x16 __attribute__((ext_vector_type(16)));
constexpr int XP = 192;
constexpr int BPT = 320;
constexpr int CP = 272;
__device__ __forceinline__ s16x4 vtr(const SS_LAS unsigned char* p) { typedef short v4i16_t __attribute__((ext_vector_type(4))); return __builtin_bit_cast(s16x4, __builtin_amdgcn_ds_read_tr16_b64_v4i16((SS_LAS v4i16_t*)p)); }
__device__ __forceinline__ unsigned cvtpk(float lo, float hi) { typedef float f2 __attribute__((ext_vector_type(2))); typedef __bf16 b2 __attribute__((ext_vector_type(2))); f2 v = {lo, hi}; b2 b = __builtin_convertvector(v, b2); return __builtin_bit_cast(unsigned, b); }
__device__ __forceinline__ void acs_tables(SS_LAS float* ACS, SS_LAS float* DTS, const float* __restrict__ DTb, const float* __restrict__ a_log, int c, int g) {
    const int tid_ = opaque_tid(); const int lane = tid_ & 63, e = __builtin_amdgcn_readfirstlane(tid_ >> 6), h = 8 * g + e;
    const float a = -expf(a_log[h]);
    const float d0 = DTb[(size_t)(128 * c + 2 * lane) * 32 + h], d1 = DTb[(size_t)(128 * c + 2 * lane + 1) * 32 + h];
    const float a0 = d0 * a, a1 = d1 * a;
    float sc = a0 + a1;
#pragma unroll
    for (int o = 1; o < 64; o <<= 1) { const float v = __shfl_up(sc, o); if (lane >= o) sc += v; }
    const float ex = sc - (a0 + a1);
    ACS[(2 * lane) * 8 + e] = ex + a0; ACS[(2 * lane + 1) * 8 + e] = ex + a0 + a1;
    DTS[(2 * lane) * 8 + e] = d0; DTS[(2 * lane + 1) * 8 + e] = d1;
}
template <int NT, class F> __device__ __forceinline__ void conv_item(const bf16_t* __restrict__ Hb, int t0, int l0, int xch0, const float* __restrict__ conv_w, const float* __restrict__ conv_b, F sink) {
    float w[4][8], bias[8];
#pragma unroll
    for (int j = 0; j < 4; ++j) { const f32x4 a = *(const f32x4*)(conv_w + j * DXBC + xch0), b = *(const f32x4*)(conv_w + j * DXBC + xch0 + 4); w[j][0] = a.x; w[j][1] = a.y; w[j][2] = a.z; w[j][3] = a.w; w[j][4] = b.x; w[j][5] = b.y; w[j][6] = b.z; w[j][7] = b.w; }
    { const f32x4 a = *(const f32x4*)(conv_b + xch0), b = *(const f32x4*)(conv_b + xch0 + 4); bias[0] = a.x; bias[1] = a.y; bias[2] = a.z; bias[3] = a.w; bias[4] = b.x; bias[5] = b.y; bias[6] = b.z; bias[7] = b.w; }
    const bf16_t* src = Hb + HC_XBC + xch0;
    u32x4 rw[NT + 3];
#pragma unroll
    for (int i = 0; i < NT + 3; ++i) { const int tt = t0 + l0 - 3 + i; rw[i] = *(const u32x4*)(src + (size_t)(tt < 0 ? 0 : tt) * HP_); }
    if (t0 + l0 < 3) {
#pragma unroll
        for (int i = 0; i < 3; ++i) if (t0 + l0 - 3 + i < 0) rw[i] = (u32x4){0u, 0u, 0u, 0u};
    }
#define SS_UNP(dst, q_) do { dst[0] = bflo(q_.x); dst[1] = bfhi(q_.x); dst[2] = bflo(q_.y); dst[3] = bfhi(q_.y); dst[4] = bflo(q_.z); dst[5] = bfhi(q_.z); dst[6] = bflo(q_.w); dst[7] = bfhi(q_.w); } while (0)
    float x0[8], x1[8], x2[8];
    SS_UNP(x0, rw[0]); SS_UNP(x1, rw[1]); SS_UNP(x2, rw[2]);
#pragma unroll
    for (int i = 0; i < NT; ++i) {
        float x3[8]; SS_UNP(x3, rw[3 + i]);
        float v[8];
#pragma unroll
        for (int k = 0; k < 8; ++k) { const float a = bias[k] + w[0][k] * x0[k] + w[1][k] * x1[k] + w[2][k] * x2[k] + w[3][k] * x3[k]; v[k] = a * __builtin_amdgcn_rcpf(1.f + __expf(-a)); x0[k] = x1[k]; x1[k] = x2[k]; x2[k] = x3[k]; }
        sink(l0 + i, v);
    }
#undef SS_UNP
}
constexpr int A_BS = 0, A_XD = 128 * BPT  , A_ACS = A_XD + 2 * 128 * XP  , A_DTS = A_ACS + 4096, A_END = A_DTS + 4096;
__device__ __forceinline__ void phaseA_unit(SS_LAS unsigned char* lds, const bf16_t* __restrict__ Hb, const float* __restrict__ DTb, const float* __restrict__ conv_w, const float* __restrict__ conv_b,
                                            const float* __restrict__ a_log, bf16_t* __restrict__ ST, float* __restrict__ CD, int c, int g) {
    const int tid = opaque_tid(), lane = tid & 63, w = __builtin_amdgcn_readfirstlane(tid >> 6), c32 = lane & 31, hh = lane >> 5;
    SS_LAS float* ACS = (SS_LAS float*)(lds + A_ACS); SS_LAS float* DTS = (SS_LAS float*)(lds + A_DTS);
    acs_tables(ACS, DTS, DTb, a_log, c, g);
    __syncthreads();
    if (tid < 8) CD[c * 32 + 8 * g + tid] = __expf(ACS[127 * 8 + tid]);
    auto stageX = [&](int e, int item, int buf) {
        const int cg = item >> 5, seg = item & 31; const float aend = ACS[127 * 8 + e];
        conv_item<4>(Hb, 128 * c, 4 * seg, g * 512 + e * 64 + cg * 8, conv_w, conv_b, [&](int l, const float (&v)[8]) {
            const float sc = DTS[l * 8 + e] * __expf(aend - ACS[l * 8 + e]);
            u32x4 o; o.x = cvtpk(v[0] * sc, v[1] * sc); o.y = cvtpk(v[2] * sc, v[3] * sc); o.z = cvtpk(v[4] * sc, v[5] * sc); o.w = cvtpk(v[6] * sc, v[7] * sc);
            *(SS_LAS u32x4*)(lds + A_XD + buf * 128 * XP + l * XP + cg * 16) = o; });
    };
    { const int cg = tid >> 5, seg = tid & 31;
        conv_item<4>(Hb, 128 * c, 4 * seg, 2048 + g * 128 + cg * 8, conv_w, conv_b, [&](int l, const float (&v)[8]) {
            u32x4 o; o.x = cvtpk(v[0], v[1]); o.y = cvtpk(v[2], v[3]); o.z = cvtpk(v[4], v[5]); o.w = cvtpk(v[6], v[7]);
            *(SS_LAS u32x4*)(lds + A_BS + l * BPT + cg * 16) = o; }); }
    if (tid < 256) stageX(0, tid, 0);
    __syncthreads();
    const int pb = w & 1, nb = w >> 1;
    const int rsel = ((lane & 15) >> 2), csel = 16 * ((lane >> 4) & 1) + 4 * (lane & 3);
    for (int e = 0; e < 8; ++e) {
        if (e + 1 < 8 && tid >= 256) stageX(e + 1, tid - 256, (e + 1) & 1);
        f32x16 acc = (f32x16){0.f, 0.f, 0.f, 0.f, 0.f, 0.f, 0.f, 0.f, 0.f, 0.f, 0.f, 0.f, 0.f, 0.f, 0.f, 0.f};
        const SS_LAS unsigned char* bp = lds + A_BS + (8 * hh + rsel) * BPT + (32 * nb + csel) * 2;
        const SS_LAS unsigned char* xp = lds + A_XD + (e & 1) * 128 * XP + (8 * hh + rsel) * XP + (32 * pb + csel) * 2;
#pragma unroll
        for (int ks = 0; ks < 8; ++ks) {
            const s16x4 b0 = vtr(bp + (16 * ks) * BPT), b1 = vtr(bp + (16 * ks + 4) * BPT), x0 = vtr(xp + (16 * ks) * XP), x1 = vtr(xp + (16 * ks + 4) * XP);
            const bf16x8 bf = (bf16x8){b0[0], b0[1], b0[2], b0[3], b1[0], b1[1], b1[2], b1[3]}, xf = (bf16x8){x0[0], x0[1], x0[2], x0[3], x1[0], x1[1], x1[2], x1[3]};
            acc = __builtin_amdgcn_mfma_f32_32x32x16_bf16(bf, xf, acc, 0, 0, 0);
        }
        bf16_t* sp = ST + ((size_t)(c * 32 + 8 * g + e) * 64 + 32 * pb + c32) * 128 + 32 * nb + 4 * hh;
#pragma unroll
        for (int q = 0; q < 4; ++q) { uint2 o; o.x = cvtpk(acc[4 * q], acc[4 * q + 1]); o.y = cvtpk(acc[4 * q + 2], acc[4 * q + 3]); *(uint2*)(sp + 8 * q) = o; }
        __syncthreads();
    }
}
__device__ __forceinline__ void scan_phase(bf16_t* __restrict__ ST, const float* __restrict__ CD, int gtid) {
    const int h = gtid >> 12;
    unsigned* p = (unsigned*)ST + gtid;
    float r0 = 0.f, r1 = 0.f;
    for (int c0 = 0; c0 < 64; c0 += 16) {
        unsigned v[16]; float d[16];
#pragma unroll
        for (int i = 0; i < 16; ++i) { v[i] = p[(size_t)(c0 + i) * 131072]; d[i] = CD[(c0 + i) * 32 + h]; }
#pragma unroll
        for (int i = 0; i < 16; ++i) { p[(size_t)(c0 + i) * 131072] = cvtpk(r0, r1); r0 = r0 * d[i] + bflo(v[i]); r1 = r1 * d[i] + bfhi(v[i]); }
    }
}
constexpr int C_CS = 0, C_BS = 128 * CP  , C_X1 = C_BS  , C_CBT = 2 * 128 * CP  , C_X0 = C_CBT + 32768  , C_ACS = C_X0 + 128 * XP  , C_DTS = C_ACS + 4096,
              C_SSQ = C_DTS + 4096, C_END = C_SSQ + 1024;
static_assert(C_END <= 147456 && 128 * XP <= 128 * CP, "ssd phase C LDS");
template <bool STORE = true> __device__ __forceinline__ void phaseC_unit(SS_LAS unsigned char* lds, bf16_t* __restrict__ Hb, const float* __restrict__ DTb, const float* __restrict__ conv_w, const float* __restrict__ conv_b,
                                            const float* __restrict__ a_log, const float* __restrict__ d_skip, const float* __restrict__ norm_w, const bf16_t* __restrict__ ST, int c, int g) {
    const int tid = opaque_tid(), lane = tid & 63, w = __builtin_amdgcn_readfirstlane(tid >> 6), c32 = lane & 31, hh = lane >> 5;
    SS_LAS float* ACS = (SS_LAS float*)(lds + C_ACS); SS_LAS float* DTS = (SS_LAS float*)(lds + C_DTS); SS_LAS float* SSQ = (SS_LAS float*)(lds + C_SSQ);
    acs_tables(ACS, DTS, DTb, a_log, c, g);
    auto stageX = [&](int e, int item, int buf) {
        const int cg = item >> 5, seg = item & 31;
        conv_item<4>(Hb, 128 * c, 4 * seg, g * 512 + e * 64 + cg * 8, conv_w, conv_b, [&](int l, const float (&v)[8]) {
            u32x4 o; o.x = cvtpk(v[0], v[1]); o.y = cvtpk(v[2], v[3]); o.z = cvtpk(v[4], v[5]); o.w = cvtpk(v[6], v[7]);
            *(SS_LAS u32x4*)(lds + (buf ? C_X1 : C_X0) + l * XP + cg * 16) = o; });
    };
    { const int isC = tid >> 8, it = tid & 255, cg = it >> 4, seg = it & 15;
        conv_item<8>(Hb, 128 * c, 8 * seg, 2048 + isC * 512 + g * 128 + cg * 8, conv_w, conv_b, [&](int l, const float (&v)[8]) {
            u32x4 o; o.x = cvtpk(v[0], v[1]); o.y = cvtpk(v[2], v[3]); o.z = cvtpk(v[4], v[5]); o.w = cvtpk(v[6], v[7]);
            *(SS_LAS u32x4*)(lds + (isC ? C_CS : C_BS) + l * CP + cg * 16) = o; }); }
    if (tid < 256) stageX(0, tid, 0);
    __syncthreads();
    for (int i = w; i < 10; i += 8) {
        const int sb = (i < 4) ? 0 : (i < 7) ? 1 : (i < 9) ? 2 : 3, lb = (i < 4) ? i : (i < 7) ? i - 3 : (i < 9) ? i - 5 : 3;
        f32x16 acc = (f32x16){0.f, 0.f, 0.f, 0.f, 0.f, 0.f, 0.f, 0.f, 0.f, 0.f, 0.f, 0.f, 0.f, 0.f, 0.f, 0.f};
        const SS_LAS unsigned char* bp = lds + C_BS + (32 * sb + c32) * CP + 16 * hh, *cp = lds + C_CS + (32 * lb + c32) * CP + 16 * hh;
#pragma unroll
        for (int ks = 0; ks < 8; ++ks) acc = __builtin_amdgcn_mfma_f32_32x32x16_bf16(*(const SS_LAS bf16x8*)(bp + 32 * ks), *(const SS_LAS bf16x8*)(cp + 32 * ks), acc, 0, 0, 0);
        SS_LAS unsigned* o = (SS_LAS unsigned*)(lds + C_CBT) + (sb * 4 + lb) * 512 + lane;
#pragma unroll
        for (int q = 0; q < 8; ++q) o[q * 64] = cvtpk(acc[2 * q], acc[2 * q + 1]);
    }
    __syncthreads();
    const int pb = w & 1, lb = w >> 1, lrow = 32 * lb + c32;
    const int rsel = ((lane & 15) >> 2), csel = 16 * ((lane >> 4) & 1) + 4 * (lane & 3);
    unsigned ypk[8][8];
    float ssq = 0.f;
    bf16x8 pcur[8]; u32x2 zcur[4];
#define SS_PREF(pdst, zdst, e_) do { const int h_ = 8 * g + (e_); const bf16_t* pp_ = ST + ((size_t)(c * 32 + h_) * 64 + 32 * pb + c32) * 128 + 8 * hh; \
        _Pragma("unroll") for (int ks_ = 0; ks_ < 8; ++ks_) pdst[ks_] = *(const bf16x8*)(pp_ + 16 * ks_); \
        const bf16_t* zp_ = Hb + (size_t)(128 * c + lrow) * HP_ + HC_Z + g * 512 + (e_) * 64 + 32 * pb + 4 * hh; \
        _Pragma("unroll") for (int q_ = 0; q_ < 4; ++q_) zdst[q_] = *(const u32x2*)(zp_ + 8 * q_); } while (0)
    SS_PREF(pcur, zcur, 0);
    for (int e = 0; e < 8; ++e) {
        const int h = 8 * g + e;
        if (e + 1 < 8 && tid >= 256) stageX(e + 1, tid - 256, (e + 1) & 1);
        bf16x8 pnext[8]; u32x2 znext[4];
        { const int en = (e + 1 < 8) ? e + 1 : 7; SS_PREF(pnext, znext, en); }
        const int xoff = (e & 1) ? C_X1 : C_X0;
        f32x16 acc = (f32x16){0.f, 0.f, 0.f, 0.f, 0.f, 0.f, 0.f, 0.f, 0.f, 0.f, 0.f, 0.f, 0.f, 0.f, 0.f, 0.f};
        {
            const SS_LAS unsigned char* cp = lds + C_CS + lrow * CP + 16 * hh;
#pragma unroll
            for (int ks = 0; ks < 8; ++ks) acc = __builtin_amdgcn_mfma_f32_32x32x16_bf16(pcur[ks], *(const SS_LAS bf16x8*)(cp + 32 * ks), acc, 0, 0, 0);
        }
        const float al = ACS[lrow * 8 + e], eal = __expf(al);
#pragma unroll
        for (int r = 0; r < 16; ++r) acc[r] *= eal;
        for (int sb = 0; sb <= lb; ++sb) {
            const SS_LAS unsigned* cbp = (const SS_LAS unsigned*)(lds + C_CBT) + (sb * 4 + lb) * 512 + lane;
            float m[16];
#pragma unroll
            for (int q = 0; q < 8; ++q) { const unsigned u = cbp[q * 64]; m[2 * q] = bflo(u); m[2 * q + 1] = bfhi(u); }
#pragma unroll
            for (int r = 0; r < 16; ++r) { const int srow = 32 * sb + (r & 3) + 8 * (r >> 2) + 4 * hh;
                const float f = __expf(al - ACS[srow * 8 + e]) * DTS[srow * 8 + e];
                m[r] = (srow <= lrow) ? m[r] * f : 0.f; }
            const SS_LAS unsigned char* xp = lds + xoff + (32 * sb + 4 * hh + rsel) * XP + (32 * pb + csel) * 2;
#pragma unroll
            for (int ks = 0; ks < 2; ++ks) {
                const s16x4 x0 = vtr(xp + (16 * ks) * XP), x1 = vtr(xp + (16 * ks + 8) * XP);
                const bf16x8 xf = (bf16x8){x0[0], x0[1], x0[2], x0[3], x1[0], x1[1], x1[2], x1[3]};
                u32x4 mm; mm.x = cvtpk(m[8 * ks], m[8 * ks + 1]); mm.y = cvtpk(m[8 * ks + 2], m[8 * ks + 3]); mm.z = cvtpk(m[8 * ks + 4], m[8 * ks + 5]); mm.w = cvtpk(m[8 * ks + 6], m[8 * ks + 7]);
                acc = __builtin_amdgcn_mfma_f32_32x32x16_bf16(xf, __builtin_bit_cast(bf16x8, mm), acc, 0, 0, 0);
            }
        }
        const float dsk = d_skip[h];
        const SS_LAS unsigned char* xr = lds + xoff + lrow * XP + (32 * pb + 4 * hh) * 2;
        unsigned yt[8];
#pragma unroll
        for (int q = 0; q < 4; ++q) {
            const u32x2 zz = zcur[q]; const u32x2 xx = *(const SS_LAS u32x2*)(xr + 16 * q);
            const float zv[4] = {bflo(zz.x), bfhi(zz.x), bflo(zz.y), bfhi(zz.y)}, xv[4] = {bflo(xx.x), bfhi(xx.x), bflo(xx.y), bfhi(xx.y)};
            float y[4];
#pragma unroll
            for (int k = 0; k < 4; ++k) { y[k] = (acc[4 * q + k] + dsk * xv[k]) * (zv[k] * __builtin_amdgcn_rcpf(1.f + __expf(-zv[k]))); ssq += y[k] * y[k]; }
            yt[2 * q] = cvtpk(y[0], y[1]); yt[2 * q + 1] = cvtpk(y[2], y[3]);
        }
#define SS_YSET(E) case E: { _Pragma("unroll") for (int q_ = 0; q_ < 8; ++q_) ypk[E][q_] = yt[q_]; } break;
        switch (e) { SS_YSET(0) SS_YSET(1) SS_YSET(2) SS_YSET(3) SS_YSET(4) SS_YSET(5) SS_YSET(6) default: { _Pragma("unroll") for (int q_ = 0; q_ < 8; ++q_) ypk[7][q_] = yt[q_]; } break; }
#undef SS_YSET
#pragma unroll
        for (int ks = 0; ks < 8; ++ks) pcur[ks] = pnext[ks];
#pragma unroll
        for (int q = 0; q < 4; ++q) zcur[q] = znext[q];
        __syncthreads();
    }
#undef SS_PREF
    ssq += __shfl_xor(ssq, 32);
    if (hh == 0) SSQ[pb * 128 + lrow] = ssq;
    __syncthreads();
    const float rstd = rsqrtf((SSQ[lrow] + SSQ[128 + lrow]) * (1.f / 512.f) + 1e-5f);
    bf16_t* op = Hb + (size_t)(128 * c + lrow) * HP_ + HC_Z + g * 512 + 32 * pb + 4 * hh;
    const float* nw = norm_w + g * 512 + 32 * pb + 4 * hh;
#pragma unroll
    for (int e = 0; e < 8; ++e)
#pragma unroll
        for (int q = 0; q < 4; ++q) { const f32x4 n4 = *(const f32x4*)(nw + e * 64 + 8 * q);
            uint2 o; o.x = cvtpk(bflo(ypk[e][2 * q]) * rstd * n4.x, bfhi(ypk[e][2 * q]) * rstd * n4.y); o.y = cvtpk(bflo(ypk[e][2 * q + 1]) * rstd * n4.z, bfhi(ypk[e][2 * q + 1]) * rstd * n4.w);
            if (STORE || o.x == 0x12345u) *(uint2*)(op + e * 64 + 8 * q) = o; }
    __syncthreads();
}
}


namespace psel {
#define PS_LAS __attribute__((address_space(3)))
typedef short bf16x8 __attribute__((ext_vector_type(8)));
typedef float f32x16 __attribute__((ext_vector_type(16)));
__device__ __forceinline__ int ord(float f) { const int b = __builtin_bit_cast(int, f); return b ^ ((b >> 31) & 0x7fffffff); }
__device__ __forceinline__ float unord(int t) { return __builtin_bit_cast(float, t ^ ((t >> 31) & 0x7fffffff)); }
#define PS_INS(top, v) do { int v_ = (v); _Pragma("unroll") for (int i_ = 0; i_ < 16; ++i_) { const int hi_ = max(top[i_], v_); v_ = min(top[i_], v_); top[i_] = hi_; } } while (0)
__device__ __forceinline__ void step(PS_LAS int* EX, const bf16_t* __restrict__ QP, const bf16_t* __restrict__ SUBK, int* __restrict__ IDX, float* __restrict__ GATE, int tok0, int hp) {
    const int tid = opaque_tid(), lane = tid & 63, w1 = __builtin_amdgcn_readfirstlane(tid >> 6), c32 = lane & 31, hh = lane >> 5;
    {
        const int tile = w1 >> 2, hsel = (w1 >> 1) & 1, half = w1 & 1, h = 2 * hp + hsel;
        const bf16_t* qp = QP + (size_t)(tok0 + 32 * tile + c32) * 2048 + h * 256 + half * 128 + 8 * hh;
        const bf16_t* kp = SUBK + ((size_t)(h * 2 + half) * 128 + c32) * 128 + 8 * hh;
        bf16x8 qf[8];
#pragma unroll
        for (int ks = 0; ks < 8; ++ks) qf[ks] = *(const bf16x8*)(qp + 16 * ks);
        int top[16];
#pragma unroll
        for (int i = 0; i < 16; ++i) top[i] = (int)0x80000000;
        bf16x8 kfa[8], kfb[8];
#define PS_LDK(dst, mt_) do { _Pragma("unroll") for (int ks_ = 0; ks_ < 8; ++ks_) dst[ks_] = *(const bf16x8*)(kp + (size_t)(32 * (mt_)) * 128 + 16 * ks_); } while (0)
#define PS_TILE(src, mt_) do { f32x16 acc_ = (f32x16){0.f, 0.f, 0.f, 0.f, 0.f, 0.f, 0.f, 0.f, 0.f, 0.f, 0.f, 0.f, 0.f, 0.f, 0.f, 0.f}; \
            _Pragma("unroll") for (int ks_ = 0; ks_ < 8; ++ks_) acc_ = __builtin_amdgcn_mfma_f32_32x32x16_bf16(src[ks_], qf[ks_], acc_, 0, 0, 0); \
            _Pragma("unroll") for (int r_ = 0; r_ < 16; ++r_) { const int key_ = 32 * (mt_) + (r_ & 3) + 8 * (r_ >> 2) + 4 * hh; const int v__ = (ord(acc_[r_]) & ~127) | (127 - key_); PS_INS(top, v__); } } while (0)
        PS_LDK(kfa, 0);
        PS_LDK(kfb, 1); PS_TILE(kfa, 0);
        PS_LDK(kfa, 2); PS_TILE(kfb, 1);
        PS_LDK(kfb, 3); PS_TILE(kfa, 2);
        PS_TILE(kfb, 3);
#undef PS_LDK
#undef PS_TILE
        int oth[16];
#pragma unroll
        for (int i = 0; i < 16; ++i) oth[i] = __shfl_xor(top[i], 32);
#pragma unroll
        for (int i = 0; i < 16; ++i) PS_INS(top, oth[i]);
        if (hh == 0) {
#pragma unroll
            for (int i = 0; i < 16; ++i) EX[(w1 * 16 + i) * 32 + c32] = top[i];
        }
    }
    __syncthreads();
    if (lane < 16) {
        const int task = w1 * 16 + lane, th = task >> 5, tok32 = task & 31, tile = th >> 1, hsel = th & 1, h = 2 * hp + hsel;
        const PS_LAS int* ea = EX + ((th * 2 + 0) * 16) * 32 + tok32; const PS_LAS int* eb = EX + ((th * 2 + 1) * 16) * 32 + tok32;
        float as[16], bs[16];
#pragma unroll
        for (int i = 0; i < 16; ++i) { as[i] = unord(ea[i * 32] & ~127); bs[i] = unord(eb[i * 32] & ~127); }
        int top[16];
#pragma unroll
        for (int i = 0; i < 16; ++i) top[i] = (int)0x80000000;
#pragma unroll
        for (int i = 0; i < 16; ++i)
#pragma unroll
            for (int j = 0; j < 16; ++j) if ((i + 1) * (j + 1) <= 16) { const int v = (ord(as[i] + bs[j]) & ~255) | (255 - (i * 16 + j)); PS_INS(top, v); }
        float sc[16]; int id[16];
#pragma unroll
        for (int r = 0; r < 16; ++r) { const int cn = 255 - (top[r] & 255), i = cn >> 4, j = cn & 15; const int pa = ea[i * 32], pb = eb[j * 32];
            sc[r] = unord(pa & ~127) + unord(pb & ~127); id[r] = (127 - (pa & 127)) * 128 + (127 - (pb & 127)); }
        float sum = 0.f; const float mx = sc[0];
#pragma unroll
        for (int r = 0; r < 16; ++r) { sc[r] = __expf(sc[r] - mx); sum += sc[r]; }
        const size_t o = (size_t)(tok0 + 32 * tile + tok32) * 128 + h * 16;
        const float inv = 1.f / sum;
#pragma unroll
        for (int r = 0; r < 16; r += 4) { *(f32x4*)(GATE + o + r) = (f32x4){sc[r] * inv, sc[r + 1] * inv, sc[r + 2] * inv, sc[r + 3] * inv}; *(u32x4*)(IDX + o + r) = (u32x4){(unsigned)id[r], (unsigned)id[r + 1], (unsigned)id[r + 2], (unsigned)id[r + 3]}; }
    }
    __syncthreads();
}
}


namespace xattn {
#define XA_LAS __attribute__((address_space(3)))
typedef short bf16x8 __attribute__((ext_vector_type(8)));
typedef short s16x4 __attribute__((ext_vector_type(4)));
typedef float f32x16 __attribute__((ext_vector_type(16)));
constexpr int RP = 528;
__device__ __forceinline__ unsigned cvtpk(float lo, float hi) { typedef float f2 __attribute__((ext_vector_type(2))); typedef __bf16 b2 __attribute__((ext_vector_type(2))); f2 v = {lo, hi}; b2 b = __builtin_convertvector(v, b2); return __builtin_bit_cast(unsigned, b); }
__device__ __forceinline__ void stage(XA_LAS unsigned char* lds, const bf16_t* __restrict__ src, int pitch, int tid) {
#pragma unroll 4
    for (int i = 0; i < 16; ++i) { const int q = tid + 512 * i, row = q >> 5, ch = q & 31; *(XA_LAS u32x4*)(lds + row * RP + ch * 16) = *(const u32x4*)(src + (size_t)row * pitch + ch * 8); }
}
__device__ __forceinline__ void unit(XA_LAS unsigned char* lds, const bf16_t* __restrict__ QC, const bf16_t* __restrict__ KC, const bf16_t* __restrict__ VcT, bf16_t* __restrict__ XO, int tg, int h) {
    const int tid = opaque_tid(), lane = tid & 63, w = __builtin_amdgcn_readfirstlane(tid >> 6), c32 = lane & 31, hh = lane >> 5, b = tg >> 5;
    const int tok = 256 * tg + 32 * w + c32;
    stage(lds, KC + (size_t)b * MEML * D + h * 256, D, tid);
    bf16x8 pf[8][2]; float inv;
    {
        bf16x8 qf[16];
        const bf16_t* qp = QC + (size_t)tok * D + h * 256 + 8 * hh;
#pragma unroll
        for (int ks = 0; ks < 16; ++ks) qf[ks] = *(const bf16x8*)(qp + 16 * ks);
        __syncthreads();
        f32x16 acc[8];
        const XA_LAS unsigned char* kb = lds + c32 * RP + 16 * hh;
#pragma unroll
        for (int mt = 0; mt < 8; ++mt) {
            acc[mt] = (f32x16){0.f, 0.f, 0.f, 0.f, 0.f, 0.f, 0.f, 0.f, 0.f, 0.f, 0.f, 0.f, 0.f, 0.f, 0.f, 0.f};
#pragma unroll
            for (int ks = 0; ks < 16; ++ks) acc[mt] = __builtin_amdgcn_mfma_f32_32x32x16_bf16(*(const XA_LAS bf16x8*)(kb + (32 * mt) * RP + 32 * ks), qf[ks], acc[mt], 0, 0, 0);
        }
        float mx = acc[0][0];
#pragma unroll
        for (int mt = 0; mt < 8; ++mt)
#pragma unroll
            for (int r = 0; r < 16; ++r) mx = fmaxf(mx, acc[mt][r]);
        mx = fmaxf(mx, __shfl_xor(mx, 32));
        float sum = 0.f;
#pragma unroll
        for (int mt = 0; mt < 8; ++mt)
#pragma unroll
            for (int r = 0; r < 16; ++r) { acc[mt][r] = __builtin_amdgcn_exp2f(acc[mt][r] - mx); sum += acc[mt][r]; }
        sum += __shfl_xor(sum, 32); inv = 1.f / sum;
#pragma unroll
        for (int mt = 0; mt < 8; ++mt)
#pragma unroll
            for (int s2 = 0; s2 < 2; ++s2) { u32x4 a; a.x = cvtpk(acc[mt][8 * s2], acc[mt][8 * s2 + 1]); a.y = cvtpk(acc[mt][8 * s2 + 2], acc[mt][8 * s2 + 3]); a.z = cvtpk(acc[mt][8 * s2 + 4], acc[mt][8 * s2 + 5]); a.w = cvtpk(acc[mt][8 * s2 + 6], acc[mt][8 * s2 + 7]);
                pf[mt][s2] = __builtin_bit_cast(bf16x8, a); }
    }
    __syncthreads();
    stage(lds, VcT + ((size_t)b * D + h * 256) * MEML, MEML, tid);
    __syncthreads();
    const XA_LAS unsigned char* vb = lds + c32 * RP + 8 * hh;
    bf16_t* op = XO + (size_t)tok * D + h * 256 + 4 * hh;
#pragma unroll 1
    for (int dt = 0; dt < 8; ++dt) {
        f32x16 acc = (f32x16){0.f, 0.f, 0.f, 0.f, 0.f, 0.f, 0.f, 0.f, 0.f, 0.f, 0.f, 0.f, 0.f, 0.f, 0.f, 0.f};
#pragma unroll
        for (int mt = 0; mt < 8; ++mt)
#pragma unroll
            for (int s2 = 0; s2 < 2; ++s2) {
                const s16x4 lo = *(const XA_LAS s16x4*)(vb + (32 * dt) * RP + (32 * mt + 16 * s2) * 2), hi = *(const XA_LAS s16x4*)(vb + (32 * dt) * RP + (32 * mt + 16 * s2 + 8) * 2);
                const bf16x8 vf = (bf16x8){lo[0], lo[1], lo[2], lo[3], hi[0], hi[1], hi[2], hi[3]};
                acc = __builtin_amdgcn_mfma_f32_32x32x16_bf16(vf, pf[mt][s2], acc, 0, 0, 0);
            }
#pragma unroll
        for (int q = 0; q < 4; ++q) { u32x2 o; o.x = cvtpk(acc[4 * q] * inv, acc[4 * q + 1] * inv); o.y = cvtpk(acc[4 * q + 2] * inv, acc[4 * q + 3] * inv); *(u32x2*)(op + 32 * dt + 8 * q) = o; }
    }
    __syncthreads();
}
}

namespace sp {
#define SP_LAS __attribute__((address_space(3)))
#define SP_LDSWAIT() do { asm volatile("s_waitcnt lgkmcnt(0)" ::: "memory"); } while (0)
__device__ __forceinline__ void transpose_item(const float* __restrict__ W, int ldw, int col0, int K, int nblk, bf16_t* __restrict__ WT, int row_off, SP_LAS float* scr, int item, int lane) {
    const int kb = item / nblk, nb = item % nblk, k0 = 64 * kb, n0 = 32 * nb;
#pragma unroll 8
    for (int i = 0; i < 32; ++i) { const int kk = 2 * i + (lane >> 5); scr[kk * 33 + (lane & 31)] = W[(size_t)(k0 + kk) * ldw + col0 + n0 + (lane & 31)]; }
    SP_LDSWAIT();
    const int cc = lane & 7;
#pragma unroll
    for (int j = 0; j < 4; ++j) { const int n = (lane >> 3) + 8 * j; const SP_LAS float* s = scr + (8 * cc) * 33 + n;
        u32x4 o; o.x = pk2(s[0 * 33], s[1 * 33]); o.y = pk2(s[2 * 33], s[3 * 33]); o.z = pk2(s[4 * 33], s[5 * 33]); o.w = pk2(s[6 * 33], s[7 * 33]);
        *(u32x4*)(WT + (size_t)(row_off + n0 + n) * K + k0 + 8 * cc) = o; }
    SP_LDSWAIT();
}
__device__ __forceinline__ void cvt_range(const float* __restrict__ src, bf16_t* __restrict__ dst, size_t n4, size_t gtid, size_t gthreads) {
    for (size_t i = gtid; i < n4; i += gthreads) { const f32x4 v = ((const f32x4*)src)[i]; u32x2 o; o.x = pk2(v.x, v.y); o.y = pk2(v.z, v.w); ((u32x2*)dst)[i] = o; }
}

__device__ __forceinline__ void cvt_fp8_range(const float* __restrict__ src, unsigned char* __restrict__ dst, size_t n16, float scale, size_t gtid, size_t gthreads) {
    for (size_t i = gtid; i < n16; i += gthreads) {
        const f32x4* sp4 = (const f32x4*)src + 4 * i; u32x4 o; unsigned ow[4];
#pragma unroll
        for (int q = 0; q < 4; ++q) { const f32x4 v = sp4[q];
            const float a = fminf(fmaxf(v.x * scale, -448.f), 448.f), b = fminf(fmaxf(v.y * scale, -448.f), 448.f), c2 = fminf(fmaxf(v.z * scale, -448.f), 448.f), d2 = fminf(fmaxf(v.w * scale, -448.f), 448.f);
            int p = 0; p = __builtin_amdgcn_cvt_pk_fp8_f32(a, b, p, false); p = __builtin_amdgcn_cvt_pk_fp8_f32(c2, d2, p, true); ow[q] = (unsigned)p; }
        o.x = ow[0]; o.y = ow[1]; o.z = ow[2]; o.w = ow[3];
        const size_t e_ = i >> 6, cg_ = i & 63; ((u32x4*)dst)[(cg_ >> 3) * ((size_t)PK * PK * 8) + e_ * 8 + (cg_ & 7)] = o;
    }
}
__device__ __forceinline__ void dt_stage_w(SP_LAS float* Wl, const float* __restrict__ w_in) {
    const int tid = opaque_tid();
#pragma unroll 8
    for (int i = 0; i < 64; ++i) { const int idx = tid + 512 * i; Wl[idx] = w_in[(size_t)(idx >> 5) * NIN + 5120 + (idx & 31)]; }
}
__device__ __forceinline__ void dt_item(SP_LAS float* Wl, SP_LAS float* xs, SP_LAS float* part, const float* __restrict__ x, const float* __restrict__ dt_bias, float* __restrict__ DT, int item) {
    const int tid = opaque_tid(), lane = tid & 63, w = tid >> 6, m0 = item * 4;
#pragma unroll
    for (int i = 0; i < 2; ++i) { const int q = tid + 512 * i; *(SP_LAS f32x4*)(xs + 4 * q) = ((const f32x4*)(x + (size_t)m0 * D))[q]; }
    __syncthreads();
    const int h = lane & 31, r = w >> 1, kq = (w & 1) * 2 + (lane >> 5);
    const SP_LAS float* xp = xs + r * 1024 + kq * 256; const SP_LAS float* wp = Wl + (kq * 256) * 32 + h;
    float a0 = 0.f, a1 = 0.f;
#pragma unroll 8
    for (int k = 0; k < 256; k += 2) { a0 = fmaf(xp[k], wp[k * 32], a0); a1 = fmaf(xp[k + 1], wp[(k + 1) * 32], a1); }
    float acc = a0 + a1;
    acc += __shfl_xor(acc, 32);
    if ((w & 1) && lane < 32) part[r * 32 + h] = acc;
    __syncthreads();
    if (!(w & 1) && lane < 32) { const float v = acc + part[r * 32 + h] + dt_bias[h]; DT[(size_t)(m0 + r) * 32 + h] = v > 20.f ? v : log1pf(expf(v)); }
}
__device__ __forceinline__ void ln_row(float* __restrict__ X, const float* __restrict__ g, const float* __restrict__ b, bf16_t* __restrict__ XB, int row, int lane) {
    f32x4* xr = (f32x4*)(X + (size_t)row * D) + lane;
    f32x4 v[4]; float s = 0.f;
#pragma unroll
    for (int j = 0; j < 4; ++j) { v[j] = xr[64 * j]; s += (v[j].x + v[j].y) + (v[j].z + v[j].w); }
    const float mean = wave_sum(s) * (1.f / D); float s2 = 0.f;
#pragma unroll
    for (int j = 0; j < 4; ++j) { v[j] = v[j] - mean; s2 += (v[j].x * v[j].x + v[j].y * v[j].y) + (v[j].z * v[j].z + v[j].w * v[j].w); }
    const float rstd = rsqrtf(wave_sum(s2) * (1.f / D) + 1e-5f);
#pragma unroll
    for (int j = 0; j < 4; ++j) { const int c = 4 * lane + 256 * j; const f32x4 gg = *(const f32x4*)(g + c), bb = *(const f32x4*)(b + c);
        f32x4 o = v[j] * rstd * gg + bb; xr[64 * j] = o;
        u32x2 pb; pb.x = pk2(o.x, o.y); pb.y = pk2(o.z, o.w); *(u32x2*)(XB + (size_t)row * D + c) = pb; }
}
__device__ __forceinline__ void xattn_pair(SP_LAS float* L, const bf16_t* __restrict__ QC, const bf16_t* __restrict__ KCVC, bf16_t* __restrict__ XO, int tok0) {
    const int t512 = opaque_tid(); const int half = t512 >> 8, tid = t512 & 255, lane = tid & 63, wv = tid >> 6, tok = tok0 + half, b = tok / SEQ;
    SP_LAS float* qs = L + half * 1024; SP_LAS float* ps = L + 2048 + half * 256; SP_LAS float* red = L + 2560 + half * 8;
    for (int i = tid; i < 1024; i += 256) qs[i] = bf2f(QC[(size_t)tok * D + i]);
    __syncthreads();
    const bf16_t* KV = KCVC + (size_t)b * MEML * 2048;
    for (int h = 0; h < MH; ++h) {
        const bf16_t* kp = KV + (size_t)tid * 2048 + h * 256;
        float s = 0.f;
        for (int d = 0; d < 256; d += 8) { const u32x4 w = *(const u32x4*)(kp + d); const SP_LAS float* q = qs + h * 256 + d;
            s += q[0] * bflo(w.x) + q[1] * bfhi(w.x) + q[2] * bflo(w.y) + q[3] * bfhi(w.y) + q[4] * bflo(w.z) + q[5] * bfhi(w.z) + q[6] * bflo(w.w) + q[7] * bfhi(w.w); }
        float mx = wave_max(s); if (lane == 0) red[wv] = mx; __syncthreads();
        mx = fmaxf(fmaxf(red[0], red[1]), fmaxf(red[2], red[3]));
        const float p = exp2f(s - mx);
        float sm = wave_sum(p); if (lane == 0) red[4 + wv] = sm; ps[tid] = p; __syncthreads();
        sm = (red[4] + red[5]) + (red[6] + red[7]);
        float o = 0.f;
        for (int j = 0; j < 256; ++j) o = fmaf(ps[j], bf2f(KV[(size_t)j * 2048 + 1024 + h * 256 + tid]), o);
        XO[(size_t)tok * D + h * 256 + tid] = (bf16_t)f2bf(o / sm);
        __syncthreads();
    }
}
__device__ __forceinline__ void select_pair(SP_LAS float* L, const bf16_t* __restrict__ QP, const bf16_t* __restrict__ SUBK, int* __restrict__ IDX, float* __restrict__ GATE, int tok0) {
    const int t512 = opaque_tid(); const int hf = t512 >> 8, tid = t512 & 255, tok = tok0 + hf;
    SP_LAS float* base = L + hf * 3072;
    SP_LAS float* qs = base; SP_LAS float* s = base + 2048; SP_LAS float* tops = base + 2304; SP_LAS int* topi = (SP_LAS int*)(base + 2336); SP_LAS float* cs = base + 2368; SP_LAS int* ci = (SP_LAS int*)(base + 2624);
    SP_LAS float* bs = base + 2880; SP_LAS int* bi = (SP_LAS int*)(base + 2896);
    for (int i = tid; i < 2048; i += 256) qs[i] = bf2f(QP[(size_t)tok * 2048 + i]);
    __syncthreads();
    for (int h = 0; h < PH; ++h) {
        const int half = tid >> 7, key = tid & 127;
        { const bf16_t* kp = SUBK + ((size_t)(h * 2 + half) * 128 + key) * 128; const SP_LAS float* q = qs + h * 256 + half * 128; float a = 0.f;
          for (int d = 0; d < 128; d += 8) { const u32x4 w = *(const u32x4*)(kp + d);
              a += q[d] * bflo(w.x) + q[d + 1] * bfhi(w.x) + q[d + 2] * bflo(w.y) + q[d + 3] * bfhi(w.y) + q[d + 4] * bflo(w.z) + q[d + 5] * bfhi(w.z) + q[d + 6] * bflo(w.w) + q[d + 7] * bfhi(w.w); }
          s[tid] = a; }
        __syncthreads();
        { const float me = s[tid]; int rank = 0; const SP_LAS float* spp = s + half * 128;
          for (int j = 0; j < 128; ++j) { const float o = spp[j]; rank += (o > me || (o == me && j < key)) ? 1 : 0; }
          if (rank < 16) { tops[half * 16 + rank] = me; topi[half * 16 + rank] = key; } }
        __syncthreads();
        { const int i = tid >> 4, j = tid & 15; cs[tid] = tops[i] + tops[16 + j]; ci[tid] = topi[i] * 128 + topi[16 + j]; }
        __syncthreads();
        { const float me = cs[tid]; int rank = 0;
          for (int j = 0; j < 256; ++j) { const float o = cs[j]; rank += (o > me || (o == me && j < tid)) ? 1 : 0; }
          if (rank < 16) { bs[rank] = me; bi[rank] = ci[tid]; } }
        __syncthreads();
        if (tid < 16) { const float mx = bs[0]; float sum = 0.f;
            for (int j = 0; j < 16; ++j) sum += expf(bs[j] - mx);
            GATE[(size_t)tok * 128 + h * 16 + tid] = expf(bs[tid] - mx) / sum; IDX[(size_t)tok * 128 + h * 16 + tid] = bi[tid]; }
        __syncthreads();
    }
}
__device__ __forceinline__ void gather_token(SP_LAS float* L, float* __restrict__ X, const bf16_t* __restrict__ PU, const bf16_t* __restrict__ PV, const int* __restrict__ IDX, const float* __restrict__ GATE,
                                             const float* __restrict__ g3, const float* __restrict__ b3, int tok) {
    const int tid = opaque_tid(), lane = tid & 63, wv = tid >> 6;
    SP_LAS float* ys = L; SP_LAS float* red = L + 8192;
    float xr[16], y[16];
    { const float* xp = X + (size_t)tok * D + lane * 16;
#pragma unroll
      for (int j = 0; j < 4; ++j) { const f32x4 v = *(const f32x4*)(xp + 4 * j); xr[4 * j] = v.x; xr[4 * j + 1] = v.y; xr[4 * j + 2] = v.z; xr[4 * j + 3] = v.w; }
#pragma unroll
      for (int j = 0; j < 16; ++j) y[j] = 0.f; }
    for (int e = 0; e < 16; ++e) {
        const int slot = wv * 16 + e; const int id = IDX[(size_t)tok * 128 + slot]; const float gt = GATE[(size_t)tok * 128 + slot];
        const bf16_t* up = PU + (size_t)id * D + lane * 16; const u32x4 u0 = *(const u32x4*)up, u1 = *(const u32x4*)(up + 8);
        const unsigned uw[8] = {u0.x, u0.y, u0.z, u0.w, u1.x, u1.y, u1.z, u1.w};
        float hsum = 0.f;
#pragma unroll
        for (int j = 0; j < 8; ++j) { hsum = fmaf(xr[2 * j], bflo(uw[j]), hsum); hsum = fmaf(xr[2 * j + 1], bfhi(uw[j]), hsum); }
        hsum = wave_sum(hsum);
        const float w = gt * 0.5f * hsum * (1.f + erff(hsum * 0.70710678118654752f));
        const bf16_t* vp = PV + (size_t)id * D + lane * 16; const u32x4 v0 = *(const u32x4*)vp, v1 = *(const u32x4*)(vp + 8);
        const unsigned vw[8] = {v0.x, v0.y, v0.z, v0.w, v1.x, v1.y, v1.z, v1.w};
#pragma unroll
        for (int j = 0; j < 8; ++j) { y[2 * j] = fmaf(w, bflo(vw[j]), y[2 * j]); y[2 * j + 1] = fmaf(w, bfhi(vw[j]), y[2 * j + 1]); }
    }
#pragma unroll
    for (int j = 0; j < 16; ++j) ys[wv * 1024 + lane * 16 + j] = y[j];
    __syncthreads();
    float v[2]; float s = 0.f;
#pragma unroll
    for (int j = 0; j < 2; ++j) { const int c = tid * 2 + j; float a = 0.f;
#pragma unroll
        for (int k = 0; k < 8; ++k) a += ys[k * 1024 + c];
        v[j] = ALPHA * X[(size_t)tok * D + c] + a; s += v[j]; }
    s = wave_sum(s); if (lane == 0) red[wv] = s; __syncthreads();
    float tot = 0.f;
#pragma unroll
    for (int k = 0; k < 8; ++k) tot += red[k];
    const float mean = tot * (1.f / D);
    float s2 = 0.f;
#pragma unroll
    for (int j = 0; j < 2; ++j) { v[j] -= mean; s2 += v[j] * v[j]; }
    s2 = wave_sum(s2); if (lane == 0) red[8 + wv] = s2; __syncthreads();
    float tot2 = 0.f;
#pragma unroll
    for (int k = 0; k < 8; ++k) tot2 += red[8 + k];
    const float rstd = rsqrtf(tot2 * (1.f / D) + 1e-5f);
#pragma unroll
    for (int j = 0; j < 2; ++j) { const int c = tid * 2 + j; X[(size_t)tok * D + c] = v[j] * rstd * g3[c] + b3[c]; }
    __syncthreads();
}

constexpr float PEER_SU = 2048.f, PEER_SV = 256.f;
typedef float f32x2v __attribute__((ext_vector_type(2)));
__device__ __forceinline__ void gather_wave(float* __restrict__ Xo, const float* X, const unsigned char* __restrict__ PU, const unsigned char* __restrict__ PV, const int* __restrict__ IDX, const float* __restrict__ GATE,
                                            const float* __restrict__ g3, const float* __restrict__ b3, int tok, int lane) {
    float xr[16], y[16];
    { const f32x4* xp = (const f32x4*)(X + (size_t)tok * D + 16 * lane);
#pragma unroll
      for (int q = 0; q < 4; ++q) { const f32x4 v = xp[q]; xr[4 * q] = v.x; xr[4 * q + 1] = v.y; xr[4 * q + 2] = v.z; xr[4 * q + 3] = v.w; } }
#pragma unroll
    for (int j = 0; j < 16; ++j) y[j] = 0.f;
    const int id0 = IDX[(size_t)tok * 128 + lane], id1 = IDX[(size_t)tok * 128 + 64 + lane];
    const float gt0 = GATE[(size_t)tok * 128 + lane], gt1 = GATE[(size_t)tok * 128 + 64 + lane];
    u32x4 ub[8], vb[8];
#define GW_ISSUE(buf, TBL, i) do { const int idv_ = ((i) < 8) ? id0 : id1; _Pragma("unroll") for (int k_ = 0; k_ < 8; ++k_) { \
        const int id_ = __builtin_amdgcn_readlane(idv_, (8 * (i) + k_) & 63); buf[k_] = *(const u32x4*)((TBL) + (size_t)id_ * D + 16 * lane); } } while (0)
    GW_ISSUE(ub, PU, 0); GW_ISSUE(vb, PV, 0);
    const bool h32 = (lane & 32) != 0, h16 = (lane & 16) != 0, h8 = (lane & 8) != 0;
#pragma unroll 1
    for (int i = 0; i < 16; ++i) {
        float p[8];
#pragma unroll
        for (int k = 0; k < 8; ++k) { const unsigned w[4] = {ub[k].x, ub[k].y, ub[k].z, ub[k].w}; float a = 0.f;
#pragma unroll
            for (int q = 0; q < 4; ++q) { const f32x2v lo = __builtin_amdgcn_cvt_pk_f32_fp8((int)w[q], false), hi = __builtin_amdgcn_cvt_pk_f32_fp8((int)w[q], true);
                a = fmaf(xr[4 * q], lo.x, a); a = fmaf(xr[4 * q + 1], lo.y, a); a = fmaf(xr[4 * q + 2], hi.x, a); a = fmaf(xr[4 * q + 3], hi.y, a); }
            p[k] = a; }
        { const int in_ = (i + 1 < 16) ? i + 1 : 15; GW_ISSUE(ub, PU, in_); }
        float q4[4], q2[2], q1;
#pragma unroll
        for (int k = 0; k < 4; ++k) q4[k] = (h32 ? p[k + 4] : p[k]) + __shfl_xor(h32 ? p[k] : p[k + 4], 32);
#pragma unroll
        for (int k = 0; k < 2; ++k) q2[k] = (h16 ? q4[k + 2] : q4[k]) + __shfl_xor(h16 ? q4[k] : q4[k + 2], 16);
        q1 = (h8 ? q2[1] : q2[0]) + __shfl_xor(h8 ? q2[0] : q2[1], 8);
        q1 += __shfl_xor(q1, 4); q1 += __shfl_xor(q1, 2); q1 += __shfl_xor(q1, 1);
        q1 *= (1.f / PEER_SU);
        const float gsel = __shfl((i < 8) ? gt0 : gt1, (8 * i + (lane >> 3)) & 63);
        const float wv = gsel * 0.5f * q1 * (1.f + erff(q1 * 0.70710678118654752f));
#pragma unroll
        for (int k = 0; k < 8; ++k) { const float wk = __builtin_bit_cast(float, __builtin_amdgcn_readlane(__builtin_bit_cast(int, wv), 8 * k));
            const unsigned w[4] = {vb[k].x, vb[k].y, vb[k].z, vb[k].w};
#pragma unroll
            for (int q = 0; q < 4; ++q) { const f32x2v lo = __builtin_amdgcn_cvt_pk_f32_fp8((int)w[q], false), hi = __builtin_amdgcn_cvt_pk_f32_fp8((int)w[q], true);
                y[4 * q] = fmaf(wk, lo.x, y[4 * q]); y[4 * q + 1] = fmaf(wk, lo.y, y[4 * q + 1]); y[4 * q + 2] = fmaf(wk, hi.x, y[4 * q + 2]); y[4 * q + 3] = fmaf(wk, hi.y, y[4 * q + 3]); } }
        { const int in_ = (i + 1 < 16) ? i + 1 : 15; GW_ISSUE(vb, PV, in_); }
    }
#undef GW_ISSUE
    float s = 0.f;
#pragma unroll
    for (int j = 0; j < 16; ++j) { y[j] = ALPHA * xr[j] + y[j] * (1.f / PEER_SV); s += y[j]; }
    const float mean = wave_sum(s) * (1.f / D); float s2 = 0.f;
#pragma unroll
    for (int j = 0; j < 16; ++j) { y[j] -= mean; s2 += y[j] * y[j]; }
    const float rstd = rsqrtf(wave_sum(s2) * (1.f / D) + 1e-5f);
    float* op = Xo + (size_t)tok * D + 16 * lane;
#pragma unroll
    for (int q = 0; q < 4; ++q) { const f32x4 gg = *(const f32x4*)(g3 + 16 * lane + 4 * q), bb = *(const f32x4*)(b3 + 16 * lane + 4 * q);
        f32x4 o; o.x = y[4 * q] * rstd * gg.x + bb.x; o.y = y[4 * q + 1] * rstd * gg.y + bb.y; o.z = y[4 * q + 2] * rstd * gg.z + bb.z; o.w = y[4 * q + 3] * rstd * gg.w + bb.w;
        *(f32x4*)(op + 4 * q) = o; }
}
}


#define LAS __attribute__((address_space(3)))
#define XB_TMO      128
#define XB_XCNT(j)  (256  + 64 * (j))
#define XB_XSUB(j)  (1280 + 64 * (j))
#define XB_XGEN(j)  (2304 + 64 * (j))
#define XB_TOP      3328
#define XB_TOPGEN   3392
#define XCD_BAR_WORDS 3456
#define XB_SPIN_CAP (1u << 18)
__device__ __forceinline__ unsigned xb_ld(unsigned* p)              { return __hip_atomic_load(p, __ATOMIC_RELAXED, __HIP_MEMORY_SCOPE_AGENT); }
__device__ __forceinline__ unsigned xb_add(unsigned* p, unsigned v) { return __hip_atomic_fetch_add(p, v, __ATOMIC_RELAXED, __HIP_MEMORY_SCOPE_AGENT); }
__device__ __forceinline__ unsigned xb_xcc_id() { return (unsigned)__builtin_amdgcn_s_getreg((3 << 11) | 20) & 0xFu; }
#define XB_SPIN(cond, bar) do { unsigned _sp = 0; while (cond) { __builtin_amdgcn_s_sleep(1); \
    if ((++_sp & 255u) == 0u) { if (xb_ld(&(bar)[XB_TMO])) break; if (_sp > XB_SPIN_CAP) { atomicAdd(&(bar)[XB_TMO], 1u); break; } } } } while (0)
struct XcdBarrier { unsigned* bar; unsigned x; volatile LAS unsigned* st; };
__device__ __forceinline__ XcdBarrier xcd_barrier_post(unsigned* bar, volatile LAS unsigned* st) {
    XcdBarrier b; b.bar = bar; b.x = xb_xcc_id(); b.st = st;
    if (threadIdx.x == 0) (void)xb_add(&bar[XB_XCNT(b.x)], 1u);
    return b;
}
__device__ __forceinline__ void xcd_barrier_complete(unsigned* bar, unsigned x, unsigned& nloc, unsigned& nx) {
    const unsigned G = gridDim.x * gridDim.y * gridDim.z;
    unsigned sum, cnt, mine, sp = 0u;
    for (;;) {
        sum = 0u; cnt = 0u; mine = 0u;
#pragma unroll
        for (unsigned j = 0; j < 16; ++j) { const unsigned c = xb_ld(&bar[XB_XCNT(j)]); sum += c; cnt += (c > 0u) ? 1u : 0u; mine = (j == x) ? c : mine; }
        if (sum == G) break;
        __builtin_amdgcn_s_sleep(1);
        if ((++sp & 255u) == 0u) { if (xb_ld(&bar[XB_TMO])) break; if (sp > XB_SPIN_CAP) { atomicAdd(&bar[XB_TMO], 1u); break; } }
    }
    nloc = mine > 0u ? mine : 1u; nx = cnt > 0u ? cnt : 1u;
}
__device__ __forceinline__ void xcd_barrier(const XcdBarrier& b) {
    asm volatile("s_waitcnt vmcnt(0)" ::: "memory");
    __syncthreads();
    if (threadIdx.x == 0) {
        unsigned* bar = b.bar;
        __builtin_amdgcn_s_waitcnt(0);
        unsigned nloc = b.st[0], nx = b.st[1];
        if (nloc == 0u) { xcd_barrier_complete(bar, b.x, nloc, nx); b.st[0] = nloc; b.st[1] = nx; }
        const unsigned old = xb_add(&bar[XB_XSUB(b.x)], 1u);
        const unsigned gen = old / nloc;
        if (old + 1u == (gen + 1u) * nloc) {
            __builtin_amdgcn_fence(__ATOMIC_RELEASE, "agent");
            asm volatile("s_waitcnt vmcnt(0)" ::: "memory");
            const unsigned og = xb_add(&bar[XB_TOP], 1u);
            const unsigned tg = og / nx;
            if (og + 1u == (tg + 1u) * nx) xb_add(&bar[XB_TOPGEN], 1u);
            else XB_SPIN(xb_ld(&bar[XB_TOPGEN]) == tg, bar);
            __builtin_amdgcn_fence(__ATOMIC_ACQUIRE, "agent");
            xb_add(&bar[XB_XGEN(b.x)], 1u);
            asm volatile("s_waitcnt vmcnt(0)" ::: "memory");
        } else {
            XB_SPIN(xb_ld(&bar[XB_XGEN(b.x)]) == gen, bar);
            __builtin_amdgcn_fence(__ATOMIC_ACQUIRE, "agent");
            asm volatile("s_waitcnt vmcnt(0)" ::: "memory");
        }
    }
    __syncthreads();
}
constexpr int CW_BAR = 4096;
constexpr int MISC_OFF = 147456;


namespace peer2 {
#define P2_LAS __attribute__((address_space(3)))
typedef float f32x2v __attribute__((ext_vector_type(2)));
constexpr int CW_TICK = 8192;
__device__ __forceinline__ float dpp_add_xor1(float v) { return v + __builtin_bit_cast(float, __builtin_amdgcn_update_dpp(0, __builtin_bit_cast(int, v), 0xB1, 0xf, 0xf, true)); }
__device__ __forceinline__ float dpp_add_xor2(float v) { return v + __builtin_bit_cast(float, __builtin_amdgcn_update_dpp(0, __builtin_bit_cast(int, v), 0x4E, 0xf, 0xf, true)); }
__device__ __forceinline__ float dpp_add_hmir(float v) { return v + __builtin_bit_cast(float, __builtin_amdgcn_update_dpp(0, __builtin_bit_cast(int, v), 0x141, 0xf, 0xf, true)); }
__device__ __forceinline__ float dpp_ror8(float v) { return __builtin_bit_cast(float, __builtin_amdgcn_update_dpp(0, __builtin_bit_cast(int, v), 0x128, 0xf, 0xf, true)); }
__device__ __forceinline__ float swap32_sum(float a, float b) { auto r = __builtin_amdgcn_permlane32_swap(__builtin_bit_cast(unsigned, a), __builtin_bit_cast(unsigned, b), false, false); return __builtin_bit_cast(float, r[0]) + __builtin_bit_cast(float, r[1]); }
struct Own { int j, rank, nrank, nsl; };
__device__ __forceinline__ Own ownership(unsigned* ctl, P2_LAS unsigned* scr, int phase, int wave) {
    const int G = gridDim.x;
    if (threadIdx.x == 0) {
        unsigned* bar = ctl + CW_BAR; bool uni = (G % 8) == 0;
        for (int j = 0; j < 8; ++j) uni = uni && (xb_ld(&bar[XB_XCNT(j)]) == (unsigned)(G / 8));
        const unsigned xcc = xb_xcc_id();
        if (uni && xcc < 8u) { scr[0] = xcc; scr[1] = xb_add(&ctl[CW_TICK + 64 * (8 * phase + (int)xcc)], 1u); }
        else { scr[0] = blockIdx.x & 7; scr[1] = blockIdx.x >> 3; }
    }
    __syncthreads();
    Own o;
    if (G % 8 == 0) { o.j = (int)scr[0]; o.rank = (int)scr[1] * 8 + wave; o.nrank = G; o.nsl = 8; }
    else { o.j = 0; o.rank = blockIdx.x * 8 + wave; o.nrank = G * 8; o.nsl = 1; }
    return o;
}
__device__ __forceinline__ float dot16_fp8(const float (&x)[16], const u32x4 u) {
    const unsigned w[4] = {u.x, u.y, u.z, u.w}; f32x2v a = {0.f, 0.f};
#pragma unroll
    for (int q = 0; q < 4; ++q) { const f32x2v lo = __builtin_amdgcn_cvt_pk_f32_fp8((int)w[q], false), hi = __builtin_amdgcn_cvt_pk_f32_fp8((int)w[q], true);
        a = __builtin_elementwise_fma((f32x2v){x[4 * q], x[4 * q + 1]}, lo, a); a = __builtin_elementwise_fma((f32x2v){x[4 * q + 2], x[4 * q + 3]}, hi, a); }
    return a.x + a.y;
}
__device__ __forceinline__ void u_wave(const float* __restrict__ X, const unsigned char* __restrict__ PU, const int* __restrict__ IDX, float* __restrict__ PART, int j, int rank, int nrank, int lane) {
    const int sub = lane & 7, grp = lane >> 3, col0 = 128 * j + 16 * sub;
    float* part = PART + (size_t)j * M * 128 + 16 * grp;
#define PU_LOADIDX(idv, xv, t_) do { const int tt_ = ((t_) < M) ? (t_) : (M - 1); const u32x4* ip_ = (const u32x4*)(IDX + (size_t)tt_ * 128 + 16 * grp); \
        _Pragma("unroll") for (int q_ = 0; q_ < 4; ++q_) { const u32x4 v_ = ip_[q_]; idv[4 * q_] = (int)v_.x; idv[4 * q_ + 1] = (int)v_.y; idv[4 * q_ + 2] = (int)v_.z; idv[4 * q_ + 3] = (int)v_.w; } \
        const f32x4* xp_ = (const f32x4*)(X + (size_t)tt_ * D + col0); \
        _Pragma("unroll") for (int q_ = 0; q_ < 4; ++q_) { const f32x4 v_ = xp_[q_]; xv[4 * q_] = v_.x; xv[4 * q_ + 1] = v_.y; xv[4 * q_ + 2] = v_.z; xv[4 * q_ + 3] = v_.w; } } while (0)
#define PU_GATHER(ubv, idv) do { _Pragma("unroll") for (int it_ = 0; it_ < 16; ++it_) ubv[it_] = *(const u32x4*)(PU + (size_t)j * (PK * PK * 128) + (size_t)idv[it_] * 128 + 16 * sub); } while (0)
#define PU_COMPUTE(ubv, xv, t_) do { float k0_ = 0.f, k1_ = 0.f; _Pragma("unroll") for (int it_ = 0; it_ < 16; ++it_) { float a_ = dot16_fp8(xv, ubv[it_]); a_ = dpp_add_xor1(a_); a_ = dpp_add_xor2(a_); a_ = dpp_add_hmir(a_); \
            if (it_ < 8) k0_ = ((it_ & 7) == sub) ? a_ : k0_; else k1_ = ((it_ & 7) == sub) ? a_ : k1_; } \
        if ((t_) < M) { part[(size_t)(t_) * 128 + sub] = k0_; part[(size_t)(t_) * 128 + sub + 8] = k1_; } } while (0)
    int idA[16], idB[16]; float xA[16], xB[16], xc[16]; u32x4 ubA[16], ubB[16];
    int t = rank;
    PU_LOADIDX(idA, xA, t); PU_GATHER(ubA, idA);
    PU_LOADIDX(idB, xB, t + nrank);
    for (; t < M; t += 2 * nrank) {
        PU_GATHER(ubB, idB);
#pragma unroll
        for (int q = 0; q < 16; ++q) xc[q] = xA[q];
        PU_LOADIDX(idA, xA, t + 2 * nrank);
        PU_COMPUTE(ubA, xc, t);
        PU_GATHER(ubA, idA);
#pragma unroll
        for (int q = 0; q < 16; ++q) xc[q] = xB[q];
        PU_LOADIDX(idB, xB, t + 3 * nrank);
        PU_COMPUTE(ubB, xc, t + nrank);
    }
#undef PU_LOADIDX
#undef PU_GATHER
#undef PU_COMPUTE
}
__device__ __forceinline__ void v_wave(float* __restrict__ X, const unsigned char* __restrict__ PV, const int* __restrict__ IDX, const float* __restrict__ GATE, const float* __restrict__ PART, P2_LAS float* wbuf, int j, int rank, int nrank, int lane) {
    const int sub = lane & 7, grp = lane >> 3, col0 = 128 * j + 16 * sub;
    const bool h32 = (lane & 32) != 0, h16 = (lane & 16) != 0, h8 = (lane & 8) != 0; const int cq = ((lane >> 5) & 1) * 8 + ((lane >> 4) & 1) * 4 + ((lane >> 3) & 1) * 2;
#define PV_ISSUE(vbv, hv, gv, t_) do { const int tt_ = ((t_) < M) ? (t_) : (M - 1); int id_[16]; const u32x4* ip_ = (const u32x4*)(IDX + (size_t)tt_ * 128 + 16 * grp); \
        _Pragma("unroll") for (int q_ = 0; q_ < 4; ++q_) { const u32x4 v_ = ip_[q_]; id_[4 * q_] = (int)v_.x; id_[4 * q_ + 1] = (int)v_.y; id_[4 * q_ + 2] = (int)v_.z; id_[4 * q_ + 3] = (int)v_.w; } \
        _Pragma("unroll") for (int it_ = 0; it_ < 16; ++it_) vbv[it_] = *(const u32x4*)(PV + (size_t)j * (PK * PK * 128) + (size_t)id_[it_] * 128 + 16 * sub); \
        _Pragma("unroll") for (int jj_ = 0; jj_ < 8; ++jj_) { const float* pp_ = PART + ((size_t)jj_ * M + tt_) * 128; hv[2 * jj_] = pp_[lane]; hv[2 * jj_ + 1] = pp_[64 + lane]; } \
        gv[0] = GATE[(size_t)tt_ * 128 + lane]; gv[1] = GATE[(size_t)tt_ * 128 + 64 + lane]; } while (0)
#define PV_COMPUTE(vbv, hv, gv, t_) do { float h0_ = 0.f, h1_ = 0.f; _Pragma("unroll") for (int jj_ = 0; jj_ < 8; ++jj_) { h0_ += hv[2 * jj_]; h1_ += hv[2 * jj_ + 1]; } \
        h0_ *= (1.f / sp::PEER_SU); h1_ *= (1.f / sp::PEER_SU); \
        const float w0_ = gv[0] * 0.5f * h0_ * (1.f + erff(h0_ * 0.70710678118654752f)), w1_ = gv[1] * 0.5f * h1_ * (1.f + erff(h1_ * 0.70710678118654752f)); \
        f32x2v y_[8]; _Pragma("unroll") for (int q_ = 0; q_ < 8; ++q_) y_[q_] = (f32x2v){0.f, 0.f}; \
        wbuf[lane] = w0_; wbuf[64 + lane] = w1_; asm volatile("s_waitcnt lgkmcnt(0)" ::: "memory");        \
        float wl_[16]; _Pragma("unroll") for (int q_ = 0; q_ < 4; ++q_) { const f32x4 v_ = *(const P2_LAS f32x4*)(wbuf + 16 * grp + 4 * q_); wl_[4 * q_] = v_.x; wl_[4 * q_ + 1] = v_.y; wl_[4 * q_ + 2] = v_.z; wl_[4 * q_ + 3] = v_.w; } \
        asm volatile("s_waitcnt lgkmcnt(0)" ::: "memory"); \
        _Pragma("unroll") for (int it_ = 0; it_ < 16; ++it_) { const float wq_ = wl_[it_]; \
            const unsigned ww_[4] = {vbv[it_].x, vbv[it_].y, vbv[it_].z, vbv[it_].w}; const f32x2v wv_ = {wq_, wq_}; \
            _Pragma("unroll") for (int q_ = 0; q_ < 4; ++q_) { y_[2 * q_] = __builtin_elementwise_fma(wv_, __builtin_amdgcn_cvt_pk_f32_fp8((int)ww_[q_], false), y_[2 * q_]); y_[2 * q_ + 1] = __builtin_elementwise_fma(wv_, __builtin_amdgcn_cvt_pk_f32_fp8((int)ww_[q_], true), y_[2 * q_ + 1]); } } \
        float yy_[16]; _Pragma("unroll") for (int k_ = 0; k_ < 8; ++k_) { yy_[2 * k_] = y_[k_].x; yy_[2 * k_ + 1] = y_[k_].y; } \
          \
        float y8_[8], y4_[4], y2_[2]; \
        _Pragma("unroll") for (int k_ = 0; k_ < 8; ++k_) y8_[k_] = (h32 ? yy_[k_ + 8] : yy_[k_]) + __shfl_xor(h32 ? yy_[k_] : yy_[k_ + 8], 32); \
        _Pragma("unroll") for (int k_ = 0; k_ < 4; ++k_) y4_[k_] = (h16 ? y8_[k_ + 4] : y8_[k_]) + __shfl_xor(h16 ? y8_[k_] : y8_[k_ + 4], 16); \
        _Pragma("unroll") for (int k_ = 0; k_ < 2; ++k_) y2_[k_] = (h8 ? y4_[k_ + 2] : y4_[k_]) + dpp_ror8(h8 ? y4_[k_] : y4_[k_ + 2]); \
        if ((t_) < M) { f32x2v* xp_ = (f32x2v*)(X + (size_t)(t_) * D + col0 + cq); f32x2v xv_ = *xp_; \
            xv_.x = ALPHA * xv_.x + y2_[0] * (1.f / sp::PEER_SV); xv_.y = ALPHA * xv_.y + y2_[1] * (1.f / sp::PEER_SV); *xp_ = xv_; } } while (0)
    u32x4 vbA[16], vbB[16]; float hA[16], hB[16], gA[2], gB[2];
    int t = rank;
    PV_ISSUE(vbA, hA, gA, t);
    for (; t < M; t += 2 * nrank) {
        PV_ISSUE(vbB, hB, gB, t + nrank);
        PV_COMPUTE(vbA, hA, gA, t);
        PV_ISSUE(vbA, hA, gA, t + 2 * nrank);
        PV_COMPUTE(vbB, hB, gB, t + nrank);
    }
#undef PV_ISSUE
#undef PV_COMPUTE
}
__device__ __forceinline__ void ln_row_plain(float* __restrict__ X, const float* __restrict__ g, const float* __restrict__ b, int row, int lane) {
    f32x4* xr = (f32x4*)(X + (size_t)row * D) + lane;
    f32x4 v[4]; float s = 0.f;
#pragma unroll
    for (int jq = 0; jq < 4; ++jq) { v[jq] = xr[64 * jq]; s += (v[jq].x + v[jq].y) + (v[jq].z + v[jq].w); }
    const float mean = wave_sum(s) * (1.f / D); float s2 = 0.f;
#pragma unroll
    for (int jq = 0; jq < 4; ++jq) { v[jq] = v[jq] - mean; s2 += (v[jq].x * v[jq].x + v[jq].y * v[jq].y) + (v[jq].z * v[jq].z + v[jq].w * v[jq].w); }
    const float rstd = rsqrtf(wave_sum(s2) * (1.f / D) + 1e-5f);
#pragma unroll
    for (int jq = 0; jq < 4; ++jq) { const int c = 4 * lane + 256 * jq; const f32x4 gg = *(const f32x4*)(g + c), bb = *(const f32x4*)(b + c); xr[64 * jq] = v[jq] * rstd * gg + bb; }
}
}

struct Params { const float* in[30]; float* out; unsigned char* ws; };
template <class F> __device__ __forceinline__ void run_gemm(unsigned char* lds, const bf16_t* A, int lda, const bf16_t* Bt, int Mr, int N, int K, F f) {
    pg8::Gemm g{A, Bt, Mr, N, K, lda}; pg8::StaticOrder S; S.init(Mr, N, gridDim.x, blockIdx.x); pg8::EpiAdapt<F> E{f};
    pg8::gemm_phase<pg8::EpiAdapt<F>, pg8::StaticOrder, true>((PG8_LAS unsigned char*)lds, g, S, E);
}
#ifndef PROBE_ATTN
#define PROBE_ATTN 0
#endif
#ifndef PROBE_SSD
#define PROBE_SSD 0
#endif
#ifndef PROBE_SYNC
#define PROBE_SYNC 0
#endif
#define KA_LAS __attribute__((address_space(4)))
#define PH_BEGIN const KA_LAS unsigned char* ka_ = (const KA_LAS unsigned char*)__builtin_amdgcn_kernarg_segment_ptr(); asm volatile("" : "+s"(ka_))
#define PIN(k) (*(const float* const KA_LAS*)(ka_ + 8 * (k)))
#define POUT (*(float* const KA_LAS*)(ka_ + 240))
#define PWS (*(unsigned char* const KA_LAS*)(ka_ + 248))
__global__ void __launch_bounds__(512, 2) hybrid_fwd(Params P) {
    extern __shared__ __attribute__((aligned(16))) unsigned char lds[];
    cg::grid_group grid = cg::this_grid();
    { PH_BEGIN; volatile LAS unsigned* misc = (volatile LAS unsigned*)((LAS unsigned char*)lds + MISC_OFF);
      if (threadIdx.x < 16) misc[threadIdx.x] = 0u;
      __syncthreads();
      (void)xcd_barrier_post((unsigned*)(PWS + WS_CTL) + CW_BAR, misc);
      if (PWS == nullptr) grid.sync(); }
#define GSYNC() do { PH_BEGIN; XcdBarrier xb_; xb_.bar = (unsigned*)(PWS + WS_CTL) + CW_BAR; xb_.x = xb_xcc_id(); xb_.st = (volatile LAS unsigned*)((LAS unsigned char*)lds + MISC_OFF); xcd_barrier(xb_); } while (0)
    {
        PH_BEGIN; unsigned char* ws = PWS;
        const int tid = opaque_tid(), lane = tid & 63, wave = __builtin_amdgcn_readfirstlane(tid >> 6), c = blockIdx.x, G = gridDim.x;
        const size_t gtid = (size_t)c * 512 + tid, gthreads = (size_t)G * 512; const int gw = c * 8 + wave, NGW = G * 8;
        const float* w_in = PIN(2);
        bf16_t* WinT = (bf16_t*)(ws + WS_WIN); bf16_t* WckvT = (bf16_t*)(ws + WS_WCKV);
        SP_LAS float* scr = (SP_LAS float*)lds + wave * (64 * 33);
        constexpr int I0 = 2560, I1 = 5120, I2 = 6144, I3 = 6656, I4 = 7168, I5 = 7680, I6 = 8192, I7 = 8704, I8 = 9216, I9 = 10240;
        for (int it = gw; it < I9; it += NGW) {
            if (it < I0) sp::transpose_item(w_in, NIN, 0, D, 160, WinT, 0, scr, it, lane);
            else if (it < I1) sp::transpose_item(w_in, NIN, 5152, D, 160, WinT, 5120, scr, it - I0, lane);
            else if (it < I2) sp::transpose_item(PIN(9), D, 0, DI, 32, (bf16_t*)(ws + WS_WSSD), 0, scr, it - I1, lane);
            else if (it < I3) sp::transpose_item(PIN(13), D, 0, D, 32, (bf16_t*)(ws + WS_WDIFF), 0, scr, it - I2, lane);
            else if (it < I4) sp::transpose_item(PIN(15), D, 0, D, 32, (bf16_t*)(ws + WS_WO), 0, scr, it - I3, lane);
            else if (it < I5) sp::transpose_item(PIN(18), D, 0, D, 32, (bf16_t*)(ws + WS_WCQ), 0, scr, it - I4, lane);
            else if (it < I6) sp::transpose_item(PIN(19), D, 0, D, 32, WckvT, 0, scr, it - I5, lane);
            else if (it < I7) sp::transpose_item(PIN(20), D, 0, D, 32, WckvT, 1024, scr, it - I6, lane);
            else if (it < I8) sp::transpose_item(PIN(21), D, 0, D, 32, (bf16_t*)(ws + WS_WCO), 0, scr, it - I7, lane);
            else sp::transpose_item(PIN(24), 2048, 0, D, 64, (bf16_t*)(ws + WS_WPQ), 0, scr, it - I8, lane);
        }
        const float* x = PIN(0);
        sp::cvt_range(x, (bf16_t*)(ws + WS_XB), (size_t)M * D / 4, gtid, gthreads);
        sp::cvt_range(PIN(1), (bf16_t*)(ws + WS_MEMB), (size_t)BATCH * MEML * D / 4, gtid, gthreads);
        sp::cvt_range(PIN(25), (bf16_t*)(ws + WS_SUBK), (size_t)PH * 2 * PK * PHALF / 4, gtid, gthreads);
        __syncthreads();
        sp::dt_stage_w((SP_LAS float*)lds, w_in);
        for (int it = c; it < M / 4; it += G) sp::dt_item((SP_LAS float*)lds, (SP_LAS float*)lds + 32768, (SP_LAS float*)lds + 36896  , x, PIN(5), (float*)(ws + WS_DT), it);
        __syncthreads();
        if (c == 0 && tid == 0) { const float* lam_q = PIN(10); const float* lam_k = PIN(11); float s0 = 0.f, s1 = 0.f;
            for (int i = 0; i < 64; ++i) { s0 += lam_q[i] * lam_k[i]; s1 += lam_q[64 + i] * lam_k[64 + i]; }
            ((float*)(ws + WS_CTL))[CW_LAM] = expf(s0) - expf(s1) + LAMBDA_INIT; }
    }
    GSYNC();
    { PH_BEGIN; unsigned char* ws = PWS;
      run_gemm(lds, (const bf16_t*)(ws + WS_MEMB), D, (const bf16_t*)(ws + WS_WCKV), BATCH * MEML, D, D, EpiPlain{(bf16_t*)(ws + WS_KCVC), D, 1.f});
      for (int bb = 0; bb < BATCH; ++bb)
          run_gemm(lds, (const bf16_t*)(ws + WS_WCKV) + (size_t)D * D, D, (const bf16_t*)(ws + WS_MEMB) + (size_t)bb * MEML * D, D, MEML, D, EpiPlain{(bf16_t*)(ws + WS_KCVC) + (size_t)BATCH * MEML * D + (size_t)bb * D * MEML, MEML, 1.f});
      run_gemm(lds, (const bf16_t*)(ws + WS_XB), D, (const bf16_t*)(ws + WS_WIN), SEQ, NINP, D, EpiInProj{(bf16_t*)(ws + WS_H), PIN(14)}); }
    GSYNC();
#pragma unroll 1
    for (int b = 0; b < BATCH; ++b) {
        { PH_BEGIN; unsigned char* ws = PWS; const int c = blockIdx.x, G = gridDim.x;
          bf16_t* H = (bf16_t*)(ws + WS_H); const float* DTb = (const float*)(ws + WS_DT) + (size_t)b * SEQ * 32;
          for (int u = c; u < 256; u += G) ssd::phaseA_unit((SS_LAS unsigned char*)lds, H, DTb, PIN(3), PIN(4), PIN(6), (bf16_t*)(ws + WS_T1), (float*)(ws + WS_CTL) + 1024, u >> 2, u & 3);
          const float lam = ((const float*)(ws + WS_CTL))[CW_LAM]; const float* subln_w = PIN(12);
#if PROBE_ATTN
          for (int u = c; u < 256; u += G) { const int h = u >> 5, j = u & 31;
              dattn::unit<false>((DA_LAS unsigned char*)lds, H, h, 63 - j, subln_w, lam);
              dattn::unit<false>((DA_LAS unsigned char*)lds, H, h, j, subln_w, lam); }
#endif
          for (int u = c; u < 256; u += G) { const int h = u >> 5, j = u & 31;
              dattn::unit((DA_LAS unsigned char*)lds, H, h, 63 - j, subln_w, lam);
              dattn::unit((DA_LAS unsigned char*)lds, H, h, j, subln_w, lam); } }
        GSYNC();
        { PH_BEGIN; unsigned char* ws = PWS; const int tid = opaque_tid();
          for (size_t i = (size_t)blockIdx.x * 512 + tid; i < 131072; i += (size_t)gridDim.x * 512) ssd::scan_phase((bf16_t*)(ws + WS_T1), (const float*)(ws + WS_CTL) + 1024, (int)i); }
        GSYNC();
        { PH_BEGIN; unsigned char* ws = PWS; const int c = blockIdx.x, G = gridDim.x;
#if PROBE_SSD
          for (int u = c; u < 256; u += G) ssd::phaseA_unit((SS_LAS unsigned char*)lds, (bf16_t*)(ws + WS_H), (const float*)(ws + WS_DT) + (size_t)b * SEQ * 32, PIN(3), PIN(4), PIN(6), (bf16_t*)(POUT + (size_t)SEQ * D), (float*)(ws + WS_CTL) + 8192, u >> 2, u & 3);
          for (int u = c; u < 256; u += G) ssd::phaseC_unit<false>((SS_LAS unsigned char*)lds, (bf16_t*)(ws + WS_H), (const float*)(ws + WS_DT) + (size_t)b * SEQ * 32, PIN(3), PIN(4), PIN(6), PIN(7), PIN(8), (const bf16_t*)(ws + WS_T1), u >> 2, u & 3);
#endif
          for (int u = c; u < 256; u += G) ssd::phaseC_unit((SS_LAS unsigned char*)lds, (bf16_t*)(ws + WS_H), (const float*)(ws + WS_DT) + (size_t)b * SEQ * 32, PIN(3), PIN(4), PIN(6), PIN(7), PIN(8), (const bf16_t*)(ws + WS_T1), u >> 2, u & 3); }
        GSYNC();
        { PH_BEGIN; unsigned char* ws = PWS; bf16_t* H = (bf16_t*)(ws + WS_H); float* T1 = (float*)(ws + WS_T1);
          run_gemm(lds, H + HC_Z, HP_, (const bf16_t*)(ws + WS_WSSD), SEQ, D, DI, EpiGate1{H, T1});
          run_gemm(lds, H + HC_Q, HP_, (const bf16_t*)(ws + WS_WDIFF), SEQ, D, D, EpiGate2{H, T1});
          if (b == BATCH - 1 && 2 * (int)blockIdx.x >= (int)gridDim.x) { const int tid = opaque_tid(); const int half = (gridDim.x + 1) / 2;
              const size_t gt = (size_t)(blockIdx.x - half) * 512 + tid, gn = (size_t)(gridDim.x - half) * 512;
              sp::cvt_fp8_range(PIN(26), ws + WS_PU, (size_t)PK * PK * D / 16, sp::PEER_SU, gt, gn);
              sp::cvt_fp8_range(PIN(27), ws + WS_PV, (size_t)PK * PK * D / 16, sp::PEER_SV, gt, gn); } }
        GSYNC();
        { PH_BEGIN; unsigned char* ws = PWS;
          run_gemm(lds, (const bf16_t*)(ws + WS_H) + HC_K, HP_, (const bf16_t*)(ws + WS_WO), SEQ, D, D, EpiResid{PIN(0), POUT, b * SEQ, 0}); }
        GSYNC();
        if (b + 1 < BATCH) {
            { PH_BEGIN; unsigned char* ws = PWS;
              run_gemm(lds, (const bf16_t*)(ws + WS_XB) + (size_t)(b + 1) * SEQ * D, D, (const bf16_t*)(ws + WS_WIN), SEQ, NINP, D, EpiInProj{(bf16_t*)(ws + WS_H), PIN(14)}); }
            GSYNC();
        }
    }
    { PH_BEGIN; unsigned char* ws = PWS; const int tid = opaque_tid(), lane = tid & 63, wave = __builtin_amdgcn_readfirstlane(tid >> 6), c = blockIdx.x, G = gridDim.x;
      float* out = POUT; const float* g = PIN(16); const float* bb = PIN(17); bf16_t* XB = (bf16_t*)(ws + WS_X1B);
      for (int r = c * 8 + wave; r < M; r += G * 8) sp::ln_row(out, g, bb, XB, r, lane); }
    GSYNC();
    { PH_BEGIN; unsigned char* ws = PWS;
      run_gemm(lds, (const bf16_t*)(ws + WS_X1B), D, (const bf16_t*)(ws + WS_WCQ), M, D, D, EpiPlain{(bf16_t*)(ws + WS_QC), D, CQSCALE}); }
    GSYNC();
    { PH_BEGIN; unsigned char* ws = PWS; const int c = blockIdx.x, G = gridDim.x;
      for (int u = c; u < 256; u += G) xattn::unit((XA_LAS unsigned char*)lds, (const bf16_t*)(ws + WS_QC), (const bf16_t*)(ws + WS_KCVC), (const bf16_t*)(ws + WS_KCVC) + (size_t)BATCH * MEML * D, (bf16_t*)(ws + WS_XO), u >> 2, u & 3); }
    GSYNC();
    { PH_BEGIN; unsigned char* ws = PWS; float* out = POUT;
      run_gemm(lds, (const bf16_t*)(ws + WS_XO), D, (const bf16_t*)(ws + WS_WCO), M, D, D, EpiResid{out, out, 0, 0}); }
    GSYNC();
    { PH_BEGIN; unsigned char* ws = PWS; const int tid = opaque_tid(), lane = tid & 63, wave = __builtin_amdgcn_readfirstlane(tid >> 6), c = blockIdx.x, G = gridDim.x;
      float* out = POUT; const float* g = PIN(22); const float* bb = PIN(23); bf16_t* XB = (bf16_t*)(ws + WS_X1B);
      for (int r = c * 8 + wave; r < M; r += G * 8) sp::ln_row(out, g, bb, XB, r, lane); }
    GSYNC();
    { PH_BEGIN; unsigned char* ws = PWS;
      run_gemm(lds, (const bf16_t*)(ws + WS_X1B), D, (const bf16_t*)(ws + WS_WPQ), M, 2048, D, EpiPlain{(bf16_t*)(ws + WS_QP), 2048, 1.f}); }
    GSYNC();
    { PH_BEGIN; unsigned char* ws = PWS; const int c = blockIdx.x, G = gridDim.x;
      for (int t = 64 * c; t < M; t += 64 * G)
          for (int hp = 0; hp < 4; ++hp) psel::step((PS_LAS int*)lds, (const bf16_t*)(ws + WS_QP), (const bf16_t*)(ws + WS_SUBK), (int*)(ws + WS_IDX), (float*)(ws + WS_GATE), t, hp); }
    GSYNC();
    { PH_BEGIN; unsigned char* ws = PWS; const int tid = opaque_tid(), lane = tid & 63, wave = __builtin_amdgcn_readfirstlane(tid >> 6);
      const peer2::Own o = peer2::ownership((unsigned*)(ws + WS_CTL), (P2_LAS unsigned*)lds, 0, wave);
      for (int jj = o.j; jj < 8; jj += o.nsl) peer2::u_wave(POUT, ws + WS_PU, (const int*)(ws + WS_IDX), (float*)(ws + WS_PART), jj, o.rank, o.nrank, lane); }
    GSYNC();
    { PH_BEGIN; unsigned char* ws = PWS; const int tid = opaque_tid(), lane = tid & 63, wave = __builtin_amdgcn_readfirstlane(tid >> 6);
      const peer2::Own o = peer2::ownership((unsigned*)(ws + WS_CTL), (P2_LAS unsigned*)lds, 1, wave);
      for (int jj = o.j; jj < 8; jj += o.nsl) peer2::v_wave(POUT, ws + WS_PV, (const int*)(ws + WS_IDX), (const float*)(ws + WS_GATE), (const float*)(ws + WS_PART), (P2_LAS float*)lds + 64 + wave * 128, jj, o.rank, o.nrank, lane); }
    GSYNC();
    { PH_BEGIN; const int tid = opaque_tid(), lane = tid & 63, wave = __builtin_amdgcn_readfirstlane(tid >> 6);
      float* out = POUT; const float* g3 = PIN(28); const float* b3 = PIN(29);
      for (int r = blockIdx.x * 8 + wave; r < M; r += gridDim.x * 8) peer2::ln_row_plain(out, g3, b3, r, lane); }
}

extern "C" void kernel_launch(void* const* d_in, const int* in_sizes, int n_in, void* d_out, int out_size, void* d_ws, size_t ws_size, hipStream_t stream) {
    static int grid_blocks = 0;
    if (grid_blocks == 0) {
        if (n_in != 30 || out_size != M * D || ws_size < WS_END) { fprintf(stderr, "kernel_launch: unexpected sizes n_in %d out %d ws %zu (need %zu)\n", n_in, out_size, ws_size, (size_t)WS_END); grid_blocks = -1; return; }
        int dev = 0, cus = 0, per_cu = 0;
        (void)hipGetDevice(&dev); (void)hipDeviceGetAttribute(&cus, hipDeviceAttributeMultiprocessorCount, dev);
        (void)hipFuncSetAttribute((const void*)hybrid_fwd, hipFuncAttributeMaxDynamicSharedMemorySize, LDS_BYTES);
        if (hipOccupancyMaxActiveBlocksPerMultiprocessor(&per_cu, (const void*)hybrid_fwd, 512, LDS_BYTES) != hipSuccess || per_cu < 1) { fprintf(stderr, "kernel_launch: occupancy query failed (%d)\n", per_cu); per_cu = 1; }
        (void)hipGetLastError();
        grid_blocks = cus * 1;
    }
    if (grid_blocks < 0) return;
    if (hipMemsetAsync(d_ws, 0, 65536, stream) != hipSuccess) { fprintf(stderr, "kernel_launch: memset of control words failed\n"); return; }
    Params p{};
    for (int i = 0; i < 30; ++i) p.in[i] = (const float*)d_in[i];
    p.out = (float*)d_out; p.ws = (unsigned char*)d_ws;
    void* args[] = {&p};
    hipError_t e = hipLaunchCooperativeKernel((const void*)hybrid_fwd, dim3(grid_blocks), dim3(512), args, LDS_BYTES, stream);
    if (e != hipSuccess) fprintf(stderr, "cooperative launch failed: %s (grid %d)\n", hipGetErrorString(e), grid_blocks);
}
```

```cpp
#include <hip/hip_runtime.h>
#include <hip/hip_cooperative_groups.h>
namespace cg = cooperative_groups;
#include <cstdio>
#include <cstdint>
#include <cmath>
#include <type_traits>

typedef unsigned short bf16_t;
typedef float f32x4 __attribute__((ext_vector_type(4)));
typedef unsigned u32x4 __attribute__((ext_vector_type(4)));
typedef unsigned u32x2 __attribute__((ext_vector_type(2)));

constexpr int D = 1024, BATCH = 2, SEQ = 8192, M = BATCH * SEQ;
constexpr int DI = 2048, NH = 32, HP = 64, NG = 4, DS = 128, DXBC = 3072;
constexpr int AH = 8, AD = 64, AV = 128;
constexpr int MEML = 256, MH = 4, MHD = 256;
constexpr int PH = 8, PK = 128, PDK = 256, PHALF = 128, PTOP = 16;
constexpr int NIN = 10272, NINP = 10240;
constexpr float ALPHA = 1.189207115002721f;
constexpr float LOG2E = 1.4426950408889634f;
constexpr float QSCALE = 0.125f * LOG2E;
constexpr float CQSCALE = 0.0625f * LOG2E;
constexpr float LAMBDA_INIT = 0.2f;
constexpr int HC_Z = 0, HC_XBC = 2048, HC_Q = 5120, HC_K = 6144, HC_V = 7168, HC_GS = 8192, HC_GA = 9216, HP_ = NINP;

constexpr size_t MiB = 1u << 20;
constexpr size_t WS_CTL = 0;
constexpr size_t WS_WIN = 1 * MiB;
constexpr size_t WS_WSSD = 21 * MiB;
constexpr size_t WS_WDIFF = 25 * MiB, WS_WO = 27 * MiB, WS_WCQ = 29 * MiB, WS_WCKV = 31 * MiB  , WS_WCO = 35 * MiB;
constexpr size_t WS_WPQ = 37 * MiB;
constexpr size_t WS_SUBK = 41 * MiB;
constexpr size_t WS_MEMB = 42 * MiB;
constexpr size_t WS_KCVC = 43 * MiB;
constexpr size_t WS_DT = 45 * MiB;
constexpr size_t WS_XB = 47 * MiB;
constexpr size_t WS_H = 79 * MiB;
constexpr size_t WS_T1 = 239 * MiB;
constexpr size_t WS_PU = 47 * MiB, WS_PV = 63 * MiB;
constexpr size_t WS_X1B = 79 * MiB;
constexpr size_t WS_QC = 143 * MiB, WS_XO = 175 * MiB;
constexpr size_t WS_QP = 207 * MiB;
constexpr size_t WS_IDX = 143 * MiB, WS_GATE = 151 * MiB;
constexpr size_t WS_PART = 207 * MiB;
constexpr size_t WS_END = 271 * MiB;
constexpr int CW_LAM = 64;

__device__ __forceinline__ int opaque_tid() { int t = threadIdx.x; asm volatile("" : "+v"(t)); return t; }
__device__ __forceinline__ unsigned f2bf(float f) { unsigned u = __builtin_bit_cast(unsigned, f); return (u + 0x7fffu + ((u >> 16) & 1u)) >> 16; }
__device__ __forceinline__ float bf2f(unsigned h) { return __builtin_bit_cast(float, h << 16); }
__device__ __forceinline__ unsigned pk2(float lo, float hi) { return f2bf(lo) | (f2bf(hi) << 16); }
__device__ __forceinline__ float bflo(unsigned w) { return __builtin_bit_cast(float, w << 16); }
__device__ __forceinline__ float bfhi(unsigned w) { return __builtin_bit_cast(float, w & 0xffff0000u); }
__device__ __forceinline__ float sigmoidf_(float v) { return __builtin_amdgcn_rcpf(1.f + __expf(-v)); }
__device__ __forceinline__ float siluf_(float v) { return v * __builtin_amdgcn_rcpf(1.f + __expf(-v)); }
__device__ __forceinline__ float wave_sum(float v) {
#pragma unroll
    for (int o = 1; o < 64; o <<= 1) v += __shfl_xor(v, o);
    return v;
}
__device__ __forceinline__ float wave_max(float v) {
#pragma unroll
    for (int o = 1; o < 64; o <<= 1) v = fmaxf(v, __shfl_xor(v, o));
    return v;
}

__device__ __forceinline__ void store_bf16x8(bf16_t* p, const float (&v)[8]) { u32x4 w; w.x = pk2(v[0], v[1]); w.y = pk2(v[2], v[3]); w.z = pk2(v[4], v[5]); w.w = pk2(v[6], v[7]); *(u32x4*)p = w; }
struct EpiPlain { bf16_t* O; int ldc; float scale;
    __device__ __forceinline__ void operator()(int row, int col0, const float (&v)[8]) const { float o[8];
#pragma unroll
        for (int j = 0; j < 8; ++j) o[j] = v[j] * scale; store_bf16x8(O + (size_t)row * ldc + col0, o); } };
struct EpiInProj { bf16_t* H; const float* gate_bias;
    __device__ __forceinline__ void operator()(int row, int col0, const float (&v)[8]) const { float o[8];
        if (col0 >= HC_GS) { const float* gb = gate_bias + (col0 - HC_GS);
#pragma unroll
            for (int j = 0; j < 8; ++j) o[j] = sigmoidf_(v[j] + gb[j]); }
        else { const float s = (col0 >= HC_Q && col0 < HC_K) ? QSCALE : 1.f;
#pragma unroll
            for (int j = 0; j < 8; ++j) o[j] = v[j] * s; }
        store_bf16x8(H + (size_t)row * HP_ + col0, o); } };
struct EpiGate1 { const bf16_t* H; float* T1;
    __device__ __forceinline__ void operator()(int row, int col0, const float (&v)[8]) const {
        const u32x4 g = *(const u32x4*)(H + (size_t)row * HP_ + HC_GS + col0); const unsigned gw[4] = {g.x, g.y, g.z, g.w};
        float* t = T1 + (size_t)row * D + col0;
#pragma unroll
        for (int j = 0; j < 4; ++j) { t[2 * j] = bflo(gw[j]) * v[2 * j]; t[2 * j + 1] = bfhi(gw[j]) * v[2 * j + 1]; } } };
struct EpiGate2 { bf16_t* H; const float* T1;
    __device__ __forceinline__ void operator()(int row, int col0, const float (&v)[8]) const {
        const u32x4 g = *(const u32x4*)(H + (size_t)row * HP_ + HC_GA + col0); const unsigned gw[4] = {g.x, g.y, g.z, g.w};
        const float* t = T1 + (size_t)row * D + col0; float o[8];
#pragma unroll
        for (int j = 0; j < 4; ++j) { o[2 * j] = t[2 * j] + bflo(gw[j]) * v[2 * j]; o[2 * j + 1] = t[2 * j + 1] + bfhi(gw[j]) * v[2 * j + 1]; }
        store_bf16x8(H + (size_t)row * HP_ + HC_K + col0, o); } };
struct EpiResid { const float* base; float* out; int row_off; int pad_;
    __device__ __forceinline__ void operator()(int row, int col0, const float (&v)[8]) const {
        const size_t o = (size_t)(row + row_off) * D + col0;
#pragma unroll
        for (int j = 0; j < 8; ++j) out[o + j] = ALPHA * base[o + j] + v[j]; } };


namespace pg8 {
#define PG8_LAS __attribute__((address_space(3)))
typedef short bf16x8 __attribute__((ext_vector_type(8)));
constexpr int BM = 256, BK = 64, HALF = 128, HTB = HALF * BK * 2, STAGE_BYTES = 8 * HTB, NXCD = 8, WGM = 8;
__host__ __device__ __forceinline__ int lds_byte(int r, int c) { const int st = (r >> 4) * 2 + (c >> 5), rr = r & 15, cc = c & 31, ob = rr * 64 + cc * 2; return st * 1024 + (ob ^ (((ob >> 9) & 1) << 5)); }
__host__ __device__ __forceinline__ void stage_rc(int b, int& R, int& C) { const int st = b / 1024, sb = b % 1024, swz = sb ^ (((sb >> 9) & 1) << 5); R = (st >> 1) * 16 + swz / 64; C = (st & 1) * 32 + (swz % 64) / 2; }
__host__ __device__ __forceinline__ int perm32(int rho) { const int n = rho >> 4, i = rho & 15; return 8 * (i >> 2) + 4 * n + (i & 3); }
struct Unit { int pm, pn; };
struct Gemm { const bf16_t* A; const bf16_t* Bt; int M, N, K, lda; };
struct StaticOrder {
    int nM, nN, nwg, G, c;
    __host__ __device__ void init(int M, int N, int G_, int c_) { nM = M / BM; nN = N / BM; nwg = nM * nN; G = G_; c = c_; }
    __host__ __device__ bool next(int i, Unit& u) const {
        const long L = (long)i * G + c; if (L >= nwg) return false;
        int wgid = (int)L; { const int q = nwg / NXCD, r = nwg % NXCD, xcd = wgid % NXCD, off = wgid / NXCD; wgid = (xcd < r ? xcd * (q + 1) : r * (q + 1) + (xcd - r) * q) + off; }
        const int nig = WGM * nN, gid = wgid / nig, fm = gid * WGM, gsz = (nM - fm) < WGM ? (nM - fm) : WGM;
        u.pm = fm + ((wgid % nig) % gsz); u.pn = (wgid % nig) / gsz; return true;
    }
};
template <class F> struct EpiAdapt {
    static constexpr bool PERM = true, AFTER_DRAIN = false; F f;
    __device__ __forceinline__ void operator()(const f32x4 (&acc)[2][2][4][2], const Unit& u, int wr, int wc, int fr, int fq) const {
#pragma unroll
        for (int ai = 0; ai < 2; ++ai)
#pragma unroll
            for (int m = 0; m < 4; ++m) { const int row = u.pm * BM + ai * HALF + wr * 64 + m * 16 + fr;
#pragma unroll
                for (int bj = 0; bj < 2; ++bj) { const int col0 = u.pn * BM + bj * HALF + wc * 32 + 8 * fq;
                    const f32x4 a = acc[ai][bj][m][0], b = acc[ai][bj][m][1]; const float v[8] = {a[0], a[1], a[2], a[3], b[0], b[1], b[2], b[3]};
                    f(row, col0, v); } }
    }
};
template <class Epi, class Sched, bool ALIGN_EPI>
__device__ __forceinline__ void gemm_phase(PG8_LAS unsigned char* lds, const Gemm g, const Sched& S, const Epi& E) {
    const int tid = opaque_tid(), wid = __builtin_amdgcn_readfirstlane(tid >> 6), lane = tid & 63, wr = wid >> 2, wc = wid & 3, fr = lane & 15, fq = lane >> 4;
    const int K = g.K, nt = K / BK, lda = g.lda;
    unsigned voffA[2], voffB[2];
#pragma unroll
    for (int i = 0; i < 2; ++i) { int R, C; stage_rc(tid * 16 + i * 8192, R, C); const int Rb = Epi::PERM ? ((R & ~31) + perm32(R & 31)) : R;
        voffA[i] = (unsigned)(R * lda + C) * 2u; voffB[i] = (unsigned)(Rb * K + C) * 2u; }
    const size_t kstep = (size_t)(BK * 2);
    const size_t hstepA = (size_t)HALF * lda * 2, hstepB = (size_t)HALF * K * 2;
    const size_t tstepA = 2 * hstepA, tstepB = 2 * hstepB;
    const unsigned ldsw = (unsigned)wid * 1024u;
    const int aoff = lds_byte(wr * 64 + fr, fq * 8), boff = lds_byte(wc * 32 + fr, fq * 8);
#define PG8_SA(b, h) (((b) * 2 + (h)) * HTB)
#define PG8_SB(b, h) ((4 + (b) * 2 + (h)) * HTB)
#define PG8_STAGE(bufoff, gbase, voff) do { _Pragma("unroll") for (int _i = 0; _i < 2; ++_i) \
        __builtin_amdgcn_global_load_lds((const unsigned*)((const char*)(gbase) + (voff)[_i]), (PG8_LAS unsigned*)(lds + (bufoff) + ldsw + _i * 8192), 16, 0, 0); } while (0)
#define PG8_LDA(dst, b, h) do { _Pragma("unroll") for (int m = 0; m < 4; ++m) _Pragma("unroll") for (int k = 0; k < 2; ++k) dst[m][k] = *(const PG8_LAS bf16x8*)(lds + PG8_SA(b, h) + aoff + m * 2048 + k * 1024); } while (0)
#define PG8_LDB(dst, b, h) do { _Pragma("unroll") for (int n = 0; n < 2; ++n) _Pragma("unroll") for (int k = 0; k < 2; ++k) dst[n][k] = *(const PG8_LAS bf16x8*)(lds + PG8_SB(b, h) + boff + n * 2048 + k * 1024); } while (0)
#define PG8_MMA(ai, bj, At, Bt) do { __builtin_amdgcn_s_setprio(1); _Pragma("unroll") for (int m = 0; m < 4; ++m) _Pragma("unroll") for (int n = 0; n < 2; ++n) _Pragma("unroll") for (int k = 0; k < 2; ++k) \
        acc[ai][bj][m][n] = __builtin_amdgcn_mfma_f32_16x16x32_bf16(Bt[n][k], At[m][k], acc[ai][bj][m][n], 0, 0, 0); __builtin_amdgcn_s_setprio(0); } while (0)
#define PG8_WAIT_V(n) asm volatile("s_waitcnt vmcnt(" #n ")" ::: "memory")
#define PG8_WAIT_L(n) asm volatile("s_waitcnt lgkmcnt(" #n ")" ::: "memory")
#define PG8_BAR __builtin_amdgcn_s_barrier()
#define PG8_SCHED __builtin_amdgcn_sched_barrier(0)
    Unit cur, nxt; int ui = 0;
    if (!S.next(0, cur)) return;
    f32x4 acc[2][2][4][2];
#pragma unroll
    for (int a = 0; a < 2; ++a)
#pragma unroll
        for (int b = 0; b < 2; ++b)
#pragma unroll
            for (int m = 0; m < 4; ++m)
#pragma unroll
                for (int n = 0; n < 2; ++n) acc[a][b][m][n] = (f32x4){0.f, 0.f, 0.f, 0.f};
    bf16x8 At[4][2], B0[2][2], B1[2][2];
    const char* cA = (const char*)g.A + (size_t)cur.pm * tstepA; const char* cB = (const char*)g.Bt + (size_t)cur.pn * tstepB;
    PG8_STAGE(PG8_SB(0, 0), cB, voffB); PG8_STAGE(PG8_SB(0, 1), cB + hstepB, voffB); PG8_STAGE(PG8_SA(0, 0), cA, voffA); PG8_STAGE(PG8_SA(0, 1), cA + hstepA, voffA);
    if (wr == 1) PG8_BAR;
    PG8_WAIT_V(2); PG8_BAR;
    PG8_STAGE(PG8_SB(1, 0), cB + kstep, voffB); PG8_STAGE(PG8_SA(1, 0), cA + kstep, voffA); PG8_STAGE(PG8_SB(1, 1), cB + hstepB + kstep, voffB);
    PG8_WAIT_V(6); PG8_BAR;
    for (;;) {
        const bool has_next = S.next(ui + 1, nxt);
        const char* nA = has_next ? (const char*)g.A + (size_t)nxt.pm * tstepA : cA; const char* nB = has_next ? (const char*)g.Bt + (size_t)nxt.pn * tstepB : cB;
        for (int t = 0; t < nt; t += 2) {
            const bool last = (t == nt - 2);
            const char* a1 = cA + (size_t)(t + 1) * kstep;
            const char* a2 = last ? nA : cA + (size_t)(t + 2) * kstep; const char* b2 = last ? nB : cB + (size_t)(t + 2) * kstep;
            const char* a3 = a2 + kstep; const char* b3 = b2 + kstep;
            PG8_LDB(B0, 0, 0); PG8_LDB(B1, 0, 1); PG8_SCHED; PG8_LDA(At, 0, 0); PG8_STAGE(PG8_SA(1, 1), a1 + hstepA, voffA);
            PG8_WAIT_V(8); PG8_WAIT_L(0); PG8_BAR; PG8_MMA(0, 0, At, B0); PG8_MMA(0, 1, At, B1); PG8_BAR; PG8_SCHED;
            PG8_LDA(At, 0, 1); PG8_STAGE(PG8_SB(0, 0), b2, voffB); PG8_STAGE(PG8_SB(0, 1), b2 + hstepB, voffB); PG8_STAGE(PG8_SA(0, 0), a2, voffA);
            PG8_WAIT_V(8); PG8_WAIT_L(0); PG8_BAR; PG8_MMA(1, 0, At, B0); PG8_MMA(1, 1, At, B1); PG8_BAR; PG8_SCHED;
            PG8_LDB(B0, 1, 0); PG8_LDB(B1, 1, 1); PG8_SCHED; PG8_LDA(At, 1, 0); PG8_STAGE(PG8_SA(0, 1), a2 + hstepA, voffA);
            PG8_WAIT_V(8); PG8_WAIT_L(0); PG8_BAR; PG8_MMA(0, 0, At, B0); PG8_MMA(0, 1, At, B1); PG8_BAR; PG8_SCHED;
            PG8_LDA(At, 1, 1); PG8_STAGE(PG8_SB(1, 0), b3, voffB); PG8_STAGE(PG8_SB(1, 1), b3 + hstepB, voffB); PG8_STAGE(PG8_SA(1, 0), a3, voffA);
            PG8_WAIT_V(8); PG8_WAIT_L(0); PG8_BAR; PG8_MMA(1, 0, At, B0); PG8_MMA(1, 1, At, B1); PG8_BAR; PG8_SCHED;
        }
        if constexpr (ALIGN_EPI) { if (wr == 0) PG8_BAR; }
        E(acc, cur, wr, wc, fr, fq);
        if (!has_next) break;
#pragma unroll
        for (int a = 0; a < 2; ++a)
#pragma unroll
            for (int b = 0; b < 2; ++b)
#pragma unroll
                for (int m = 0; m < 4; ++m)
#pragma unroll
                    for (int n = 0; n < 2; ++n) acc[a][b][m][n] = (f32x4){0.f, 0.f, 0.f, 0.f};
        cur = nxt; cA = nA; cB = nB; ++ui;
        if constexpr (ALIGN_EPI) { if (wr == 1) PG8_BAR; }
    }
    PG8_WAIT_V(0);
    if constexpr (!ALIGN_EPI) { if (wr == 0) PG8_BAR; }
    PG8_BAR;
#undef PG8_SA
#undef PG8_SB
#undef PG8_STAGE
#undef PG8_LDA
#undef PG8_LDB
#undef PG8_MMA
#undef PG8_WAIT_V
#undef PG8_WAIT_L
#undef PG8_BAR
#undef PG8_SCHED
}
}
constexpr int LDS_BYTES = 148480;
namespace dattn {
#define DA_LAS __attribute__((address_space(3)))
typedef short bf16x8 __attribute__((ext_vector_type(8)));
typedef short s16x4 __attribute__((ext_vector_type(4)));
typedef float f32x16 __attribute__((ext_vector_type(16)));
constexpr int KP = 272, VP = 320, KBUF = 64 * KP, VBUF = 64 * VP, BUF = KBUF + VBUF, XOFF = 2 * BUF, LDS_NEED = XOFF + 65536;
static_assert(LDS_NEED <= 147456, "attention LDS");
__device__ __forceinline__ unsigned cvtpk(float lo, float hi) { typedef float f2 __attribute__((ext_vector_type(2))); typedef __bf16 b2 __attribute__((ext_vector_type(2))); f2 v = {lo, hi}; b2 b = __builtin_convertvector(v, b2); return __builtin_bit_cast(unsigned, b); }
__device__ __forceinline__ s16x4 vtr(const DA_LAS unsigned char* p) { typedef short v4i16_t __attribute__((ext_vector_type(4))); return __builtin_bit_cast(s16x4, __builtin_amdgcn_ds_read_tr16_b64_v4i16((DA_LAS v4i16_t*)p)); }
template <bool STORE = true> __device__ __forceinline__ void unit(DA_LAS unsigned char* lds, bf16_t* Hb, int h, int qb, const float* __restrict__ subln_w, float lam) {
    const int tid = opaque_tid(), lane = tid & 63, w = __builtin_amdgcn_readfirstlane(tid >> 6), mp = w >> 2, rb = w & 3, c32 = lane & 31, hh = lane >> 5;
    const int qrow = 128 * qb + 32 * rb + c32;
    bf16x8 qf[4];
    { const bf16_t* qp = Hb + (size_t)qrow * HP_ + HC_Q + h * 128 + 64 * mp + 8 * hh;
#pragma unroll
      for (int s = 0; s < 4; ++s) qf[s] = *(const bf16x8*)(qp + 16 * s); }
    const int srow = tid >> 4, sch = tid & 15;
    const bf16_t* kg = Hb + HC_K + h * 128 + sch * 8; const bf16_t* vg = Hb + HC_V + h * 128 + sch * 8;
    const int nt = 2 * qb + 2;
    u32x4 kr[2], vr[2];
#define DA_LOAD(t) do { _Pragma("unroll") for (int j = 0; j < 2; ++j) { const size_t ro = (size_t)(64 * (t) + srow + 32 * j) * HP_; kr[j] = *(const u32x4*)(kg + ro); vr[j] = *(const u32x4*)(vg + ro); } } while (0)
#define DA_WRITE(buf) do { _Pragma("unroll") for (int j = 0; j < 2; ++j) { *(DA_LAS u32x4*)(lds + (buf) * BUF + (srow + 32 * j) * KP + sch * 16) = kr[j]; *(DA_LAS u32x4*)(lds + (buf) * BUF + KBUF + (srow + 32 * j) * VP + sch * 16) = vr[j]; } } while (0)
    DA_LOAD(0); DA_WRITE(0);
    __syncthreads();
    f32x16 oT[4];
#pragma unroll
    for (int i = 0; i < 4; ++i) oT[i] = (f32x16){0.f, 0.f, 0.f, 0.f, 0.f, 0.f, 0.f, 0.f, 0.f, 0.f, 0.f, 0.f, 0.f, 0.f, 0.f, 0.f};
    float lrow = 0.f;
    f32x16 negm = (f32x16){0.f, 0.f, 0.f, 0.f, 0.f, 0.f, 0.f, 0.f, 0.f, 0.f, 0.f, 0.f, 0.f, 0.f, 0.f, 0.f};
    const int koff = c32 * KP + (64 * mp + 8 * hh) * 2;
    const int voff = KBUF + (4 * hh + ((lane & 15) >> 2)) * VP + (16 * ((lane >> 4) & 1) + 4 * (lane & 3)) * 2;
    for (int t = 0; t < nt; ++t) {
        const int cur = t & 1;
        if (t + 1 < nt) DA_LOAD(t + 1);
        if (!(t == nt - 1 && rb <= 1)) {
            const DA_LAS unsigned char* kb = lds + cur * BUF + koff;
            f32x16 s0 = negm, s1 = negm;
            bf16x8 kf0[4], kf1[4];
#pragma unroll
            for (int s = 0; s < 4; ++s) { kf0[s] = *(const DA_LAS bf16x8*)(kb + s * 32); kf1[s] = *(const DA_LAS bf16x8*)(kb + 32 * KP + s * 32); }
            __builtin_amdgcn_s_setprio(1);
#pragma unroll
            for (int s = 0; s < 4; ++s) {
                s0 = __builtin_amdgcn_mfma_f32_32x32x16_bf16(kf0[s], qf[s], s0, 0, 0, 0);
                s1 = __builtin_amdgcn_mfma_f32_32x32x16_bf16(kf1[s], qf[s], s1, 0, 0, 0);
            }
            __builtin_amdgcn_s_setprio(0);
            if (t >= nt - 2) {
                const int k0 = 64 * t + 4 * hh;
#pragma unroll
                for (int r = 0; r < 16; ++r) { const int key = k0 + (r & 3) + 8 * (r >> 2); if (key > qrow) s0[r] = -INFINITY; if (key + 32 > qrow) s1[r] = -INFINITY; }
            }
            float mxa = fmaxf(fmaxf(s0[0], s0[1]), s1[0]), mxb = fmaxf(fmaxf(s0[2], s0[3]), s1[1]);
            mxa = fmaxf(fmaxf(mxa, s1[2]), s1[3]);
#pragma unroll
            for (int r = 4; r < 16; r += 4) { mxa = fmaxf(fmaxf(mxa, s0[r]), s0[r + 1]); mxb = fmaxf(fmaxf(mxb, s0[r + 2]), s0[r + 3]); mxa = fmaxf(fmaxf(mxa, s1[r]), s1[r + 1]); mxb = fmaxf(fmaxf(mxb, s1[r + 2]), s1[r + 3]); }
            float mx = fmaxf(mxa, mxb);
            mx = fmaxf(mx, __shfl_xor(mx, 32));
            if (__any(mx > 8.f)) {
                const float dl = fmaxf(mx, 0.f), alpha = __builtin_amdgcn_exp2f(-dl);
#pragma unroll
                for (int r = 0; r < 16; ++r) { s0[r] -= dl; s1[r] -= dl; negm[r] -= dl; }
                lrow *= alpha;
#pragma unroll
                for (int i = 0; i < 4; ++i)
#pragma unroll
                    for (int r = 0; r < 16; ++r) oT[i][r] *= alpha;
            }
            float ps = 0.f;
#pragma unroll
            for (int r = 0; r < 16; ++r) { s0[r] = __builtin_amdgcn_exp2f(s0[r]); s1[r] = __builtin_amdgcn_exp2f(s1[r]); ps += s0[r] + s1[r]; }
            lrow += ps;
            bf16x8 pf[2][2];
#pragma unroll
            for (int s = 0; s < 2; ++s) {
                u32x4 a, b;
                a.x = cvtpk(s0[8 * s], s0[8 * s + 1]); a.y = cvtpk(s0[8 * s + 2], s0[8 * s + 3]); a.z = cvtpk(s0[8 * s + 4], s0[8 * s + 5]); a.w = cvtpk(s0[8 * s + 6], s0[8 * s + 7]);
                b.x = cvtpk(s1[8 * s], s1[8 * s + 1]); b.y = cvtpk(s1[8 * s + 2], s1[8 * s + 3]); b.z = cvtpk(s1[8 * s + 4], s1[8 * s + 5]); b.w = cvtpk(s1[8 * s + 6], s1[8 * s + 7]);
                pf[0][s] = __builtin_bit_cast(bf16x8, a); pf[1][s] = __builtin_bit_cast(bf16x8, b);
            }
            const DA_LAS unsigned char* vb = lds + cur * BUF + voff;
#define DA_LDV(dst, db) do { _Pragma("unroll") for (int i_ = 0; i_ < 4; ++i_) { const s16x4 lo_ = vtr(vb + (16 * i_) * VP + (db) * 64), hi_ = vtr(vb + (16 * i_ + 8) * VP + (db) * 64); \
                dst[i_] = (bf16x8){lo_[0], lo_[1], lo_[2], lo_[3], hi_[0], hi_[1], hi_[2], hi_[3]}; } } while (0)
#define DA_MM(src, db) do { _Pragma("unroll") for (int i_ = 0; i_ < 4; ++i_) oT[db] = __builtin_amdgcn_mfma_f32_32x32x16_bf16(src[i_], pf[i_ >> 1][i_ & 1], oT[db], 0, 0, 0); } while (0)
            bf16x8 va[4], vq[4];
            DA_LDV(va, 0);
            DA_LDV(vq, 1); __builtin_amdgcn_s_setprio(1); DA_MM(va, 0); __builtin_amdgcn_s_setprio(0);
            DA_LDV(va, 2); __builtin_amdgcn_s_setprio(1); DA_MM(vq, 1); __builtin_amdgcn_s_setprio(0);
            DA_LDV(vq, 3); __builtin_amdgcn_s_setprio(1); DA_MM(va, 2); __builtin_amdgcn_s_setprio(0);
            __builtin_amdgcn_s_setprio(1); DA_MM(vq, 3);
#undef DA_LDV
#undef DA_MM
            __builtin_amdgcn_s_setprio(0);
        }
        if (t + 1 < nt) DA_WRITE(cur ^ 1);
        __syncthreads();
    }
#undef DA_LOAD
#undef DA_WRITE
    const float inv = 1.f / (lrow + __shfl_xor(lrow, 32));
    DA_LAS float* X = (DA_LAS float*)(lds + XOFF) + rb * 4096 + lane;
    if (mp == 1) {
#pragma unroll
        for (int i = 0; i < 4; ++i)
#pragma unroll
            for (int r = 0; r < 16; ++r) X[(i * 16 + r) * 64] = oT[i][r] * inv;
    }
    __syncthreads();
    if (mp == 0) {
        float ss = 0.f;
#pragma unroll
        for (int i = 0; i < 4; ++i)
#pragma unroll
            for (int r = 0; r < 16; ++r) { const float o = oT[i][r] * inv - lam * X[(i * 16 + r) * 64]; oT[i][r] = o; ss += o * o; }
        ss += __shfl_xor(ss, 32);
        const float rr = rsqrtf(ss * (1.f / 128.f) + 1e-5f) * (1.f - LAMBDA_INIT);
        bf16_t* op = Hb + (size_t)qrow * HP_ + HC_Q + h * 128 + 4 * hh;
#pragma unroll
        for (int i = 0; i < 4; ++i)
#pragma unroll
            for (int g = 0; g < 4; ++g) { const int d0 = 32 * i + 8 * g; const f32x4 sw = *(const f32x4*)(subln_w + d0 + 4 * hh);
                uint2 o; o.x = pk2(oT[i][4 * g] * rr * sw.x, oT[i][4 * g + 1] * rr * sw.y); o.y = pk2(oT[i][4 * g + 2] * rr * sw.z, oT[i][4 * g + 3] * rr * sw.w);
                if (STORE || o.x == 0x12345u) *(uint2*)(op + d0) = o; }
    }
    __syncthreads();
}
}
namespace ssd {
#define SS_LAS __attribute__((address_space(3)))
typedef short bf16x8 __attribute__((ext_vector_type(8)));
typedef short s16x4 __attribute__((ext_vector_type(4)));
typedef float f32x16 __attribute__((ext_vector_type(16)));
constexpr int XP = 192;
constexpr int BPT = 320;
constexpr int CP = 272;
__device__ __forceinline__ s16x4 vtr(const SS_LAS unsigned char* p) { typedef short v4i16_t __attribute__((ext_vector_type(4))); return __builtin_bit_cast(s16x4, __builtin_amdgcn_ds_read_tr16_b64_v4i16((SS_LAS v4i16_t*)p)); }
__device__ __forceinline__ unsigned cvtpk(float lo, float hi) { typedef float f2 __attribute__((ext_vector_type(2))); typedef __bf16 b2 __attribute__((ext_vector_type(2))); f2 v = {lo, hi}; b2 b = __builtin_convertvector(v, b2); return __builtin_bit_cast(unsigned, b); }
__device__ __forceinline__ void acs_tables(SS_LAS float* ACS, SS_LAS float* DTS, const float* __restrict__ DTb, const float* __restrict__ a_log, int c, int g) {
    const int tid_ = opaque_tid(); const int lane = tid_ & 63, e = __builtin_amdgcn_readfirstlane(tid_ >> 6), h = 8 * g + e;
    const float a = -expf(a_log[h]);
    const float d0 = DTb[(size_t)(128 * c + 2 * lane) * 32 + h], d1 = DTb[(size_t)(128 * c + 2 * lane + 1) * 32 + h];
    const float a0 = d0 * a, a1 = d1 * a;
    float sc = a0 + a1;
#pragma unroll
    for (int o = 1; o < 64; o <<= 1) { const float v = __shfl_up(sc, o); if (lane >= o) sc += v; }
    const float ex = sc - (a0 + a1);
    ACS[(2 * lane) * 8 + e] = ex + a0; ACS[(2 * lane + 1) * 8 + e] = ex + a0 + a1;
    DTS[(2 * lane) * 8 + e] = d0; DTS[(2 * lane + 1) * 8 + e] = d1;
}
template <int NT, class F> __device__ __forceinline__ void conv_item(const bf16_t* __restrict__ Hb, int t0, int l0, int xch0, const float* __restrict__ conv_w, const float* __restrict__ conv_b, F sink) {
    float w[4][8], bias[8];
#pragma unroll
    for (int j = 0; j < 4; ++j) { const f32x4 a = *(const f32x4*)(conv_w + j * DXBC + xch0), b = *(const f32x4*)(conv_w + j * DXBC + xch0 + 4); w[j][0] = a.x; w[j][1] = a.y; w[j][2] = a.z; w[j][3] = a.w; w[j][4] = b.x; w[j][5] = b.y; w[j][6] = b.z; w[j][7] = b.w; }
    { const f32x4 a = *(const f32x4*)(conv_b + xch0), b = *(const f32x4*)(conv_b + xch0 + 4); bias[0] = a.x; bias[1] = a.y; bias[2] = a.z; bias[3] = a.w; bias[4] = b.x; bias[5] = b.y; bias[6] = b.z; bias[7] = b.w; }
    const bf16_t* src = Hb + HC_XBC + xch0;
    u32x4 rw[NT + 3];
#pragma unroll
    for (int i = 0; i < NT + 3; ++i) { const int tt = t0 + l0 - 3 + i; rw[i] = *(const u32x4*)(src + (size_t)(tt < 0 ? 0 : tt) * HP_); }
    if (t0 + l0 < 3) {
#pragma unroll
        for (int i = 0; i < 3; ++i) if (t0 + l0 - 3 + i < 0) rw[i] = (u32x4){0u, 0u, 0u, 0u};
    }
#define SS_UNP(dst, q_) do { dst[0] = bflo(q_.x); dst[1] = bfhi(q_.x); dst[2] = bflo(q_.y); dst[3] = bfhi(q_.y); dst[4] = bflo(q_.z); dst[5] = bfhi(q_.z); dst[6] = bflo(q_.w); dst[7] = bfhi(q_.w); } while (0)
    float x0[8], x1[8], x2[8];
    SS_UNP(x0, rw[0]); SS_UNP(x1, rw[1]); SS_UNP(x2, rw[2]);
#pragma unroll
    for (int i = 0; i < NT; ++i) {
        float x3[8]; SS_UNP(x3, rw[3 + i]);
        float v[8];
#pragma unroll
        for (int k = 0; k < 8; ++k) { const float a = bias[k] + w[0][k] * x0[k] + w[1][k] * x1[k] + w[2][k] * x2[k] + w[3][k] * x3[k]; v[k] = a * __builtin_amdgcn_rcpf(1.f + __expf(-a)); x0[k] = x1[k]; x1[k] = x2[k]; x2[k] = x3[k]; }
        sink(l0 + i, v);
    }
#undef SS_UNP
}
constexpr int A_BS = 0, A_XD = 128 * BPT  , A_ACS = A_XD + 2 * 128 * XP  , A_DTS = A_ACS + 4096, A_END = A_DTS + 4096;
__device__ __forceinline__ void phaseA_unit(SS_LAS unsigned char* lds, const bf16_t* __restrict__ Hb, const float* __restrict__ DTb, const float* __restrict__ conv_w, const float* __restrict__ conv_b,
                                            const float* __restrict__ a_log, bf16_t* __restrict__ ST, float* __restrict__ CD, int c, int g) {
    const int tid = opaque_tid(), lane = tid & 63, w = __builtin_amdgcn_readfirstlane(tid >> 6), c32 = lane & 31, hh = lane >> 5;
    SS_LAS float* ACS = (SS_LAS float*)(lds + A_ACS); SS_LAS float* DTS = (SS_LAS float*)(lds + A_DTS);
    acs_tables(ACS, DTS, DTb, a_log, c, g);
    __syncthreads();
    if (tid < 8) CD[c * 32 + 8 * g + tid] = __expf(ACS[127 * 8 + tid]);
    auto stageX = [&](int e, int item, int buf) {
        const int cg = item >> 5, seg = item & 31; const float aend = ACS[127 * 8 + e];
        conv_item<4>(Hb, 128 * c, 4 * seg, g * 512 + e * 64 + cg * 8, conv_w, conv_b, [&](int l, const float (&v)[8]) {
            const float sc = DTS[l * 8 + e] * __expf(aend - ACS[l * 8 + e]);
            u32x4 o; o.x = cvtpk(v[0] * sc, v[1] * sc); o.y = cvtpk(v[2] * sc, v[3] * sc); o.z = cvtpk(v[4] * sc, v[5] * sc); o.w = cvtpk(v[6] * sc, v[7] * sc);
            *(SS_LAS u32x4*)(lds + A_XD + buf * 128 * XP + l * XP + cg * 16) = o; });
    };
    { const int cg = tid >> 5, seg = tid & 31;
        conv_item<4>(Hb, 128 * c, 4 * seg, 2048 + g * 128 + cg * 8, conv_w, conv_b, [&](int l, const float (&v)[8]) {
            u32x4 o; o.x = cvtpk(v[0], v[1]); o.y = cvtpk(v[2], v[3]); o.z = cvtpk(v[4], v[5]); o.w = cvtpk(v[6], v[7]);
            *(SS_LAS u32x4*)(lds + A_BS + l * BPT + cg * 16) = o; }); }
    if (tid < 256) stageX(0, tid, 0);
    __syncthreads();
    const int pb = w & 1, nb = w >> 1;
    const int rsel = ((lane & 15) >> 2), csel = 16 * ((lane >> 4) & 1) + 4 * (lane & 3);
    for (int e = 0; e < 8; ++e) {
        if (e + 1 < 8 && tid >= 256) stageX(e + 1, tid - 256, (e + 1) & 1);
        f32x16 acc = (f32x16){0.f, 0.f, 0.f, 0.f, 0.f, 0.f, 0.f, 0.f, 0.f, 0.f, 0.f, 0.f, 0.f, 0.f, 0.f, 0.f};
        const SS_LAS unsigned char* bp = lds + A_BS + (8 * hh + rsel) * BPT + (32 * nb + csel) * 2;
        const SS_LAS unsigned char* xp = lds + A_XD + (e & 1) * 128 * XP + (8 * hh + rsel) * XP + (32 * pb + csel) * 2;
#pragma unroll
        for (int ks = 0; ks < 8; ++ks) {
            const s16x4 b0 = vtr(bp + (16 * ks) * BPT), b1 = vtr(bp + (16 * ks + 4) * BPT), x0 = vtr(xp + (16 * ks) * XP), x1 = vtr(xp + (16 * ks + 4) * XP);
            const bf16x8 bf = (bf16x8){b0[0], b0[1], b0[2], b0[3], b1[0], b1[1], b1[2], b1[3]}, xf = (bf16x8){x0[0], x0[1], x0[2], x0[3], x1[0], x1[1], x1[2], x1[3]};
            acc = __builtin_amdgcn_mfma_f32_32x32x16_bf16(bf, xf, acc, 0, 0, 0);
        }
        bf16_t* sp = ST + ((size_t)(c * 32 + 8 * g + e) * 64 + 32 * pb + c32) * 128 + 32 * nb + 4 * hh;
#pragma unroll
        for (int q = 0; q < 4; ++q) { uint2 o; o.x = cvtpk(acc[4 * q], acc[4 * q + 1]); o.y = cvtpk(acc[4 * q + 2], acc[4 * q + 3]); *(uint2*)(sp + 8 * q) = o; }
        __syncthreads();
    }
}
__device__ __forceinline__ void scan_phase(bf16_t* __restrict__ ST, const float* __restrict__ CD, int gtid) {
    const int h = gtid >> 12;
    unsigned* p = (unsigned*)ST + gtid;
    float r0 = 0.f, r1 = 0.f;
    for (int c0 = 0; c0 < 64; c0 += 16) {
        unsigned v[16]; float d[16];
#pragma unroll
        for (int i = 0; i < 16; ++i) { v[i] = p[(size_t)(c0 + i) * 131072]; d[i] = CD[(c0 + i) * 32 + h]; }
#pragma unroll
        for (int i = 0; i < 16; ++i) { p[(size_t)(c0 + i) * 131072] = cvtpk(r0, r1); r0 = r0 * d[i] + bflo(v[i]); r1 = r1 * d[i] + bfhi(v[i]); }
    }
}
constexpr int C_CS = 0, C_BS = 128 * CP  , C_X1 = C_BS  , C_CBT = 2 * 128 * CP  , C_X0 = C_CBT + 32768  , C_ACS = C_X0 + 128 * XP  , C_DTS = C_ACS + 4096,
              C_SSQ = C_DTS + 4096, C_END = C_SSQ + 1024;
static_assert(C_END <= 147456 && 128 * XP <= 128 * CP, "ssd phase C LDS");
template <bool STORE = true> __device__ __forceinline__ void phaseC_unit(SS_LAS unsigned char* lds, bf16_t* __restrict__ Hb, const float* __restrict__ DTb, const float* __restrict__ conv_w, const float* __restrict__ conv_b,
                                            const float* __restrict__ a_log, const float* __restrict__ d_skip, const float* __restrict__ norm_w, const bf16_t* __restrict__ ST, int c, int g) {
    const int tid = opaque_tid(), lane = tid & 63, w = __builtin_amdgcn_readfirstlane(tid >> 6), c32 = lane & 31, hh = lane >> 5;
    SS_LAS float* ACS = (SS_LAS float*)(lds + C_ACS); SS_LAS float* DTS = (SS_LAS float*)(lds + C_DTS); SS_LAS float* SSQ = (SS_LAS float*)(lds + C_SSQ);
    acs_tables(ACS, DTS, DTb, a_log, c, g);
    auto stageX = [&](int e, int item, int buf) {
        const int cg = item >> 5, seg = item & 31;
        conv_item<4>(Hb, 128 * c, 4 * seg, g * 512 + e * 64 + cg * 8, conv_w, conv_b, [&](int l, const float (&v)[8]) {
            u32x4 o; o.x = cvtpk(v[0], v[1]); o.y = cvtpk(v[2], v[3]); o.z = cvtpk(v[4], v[5]); o.w = cvtpk(v[6], v[7]);
            *(SS_LAS u32x4*)(lds + (buf ? C_X1 : C_X0) + l * XP + cg * 16) = o; });
    };
    { const int isC = tid >> 8, it = tid & 255, cg = it >> 4, seg = it & 15;
        conv_item<8>(Hb, 128 * c, 8 * seg, 2048 + isC * 512 + g * 128 + cg * 8, conv_w, conv_b, [&](int l, const float (&v)[8]) {
            u32x4 o; o.x = cvtpk(v[0], v[1]); o.y = cvtpk(v[2], v[3]); o.z = cvtpk(v[4], v[5]); o.w = cvtpk(v[6], v[7]);
            *(SS_LAS u32x4*)(lds + (isC ? C_CS : C_BS) + l * CP + cg * 16) = o; }); }
    if (tid < 256) stageX(0, tid, 0);
    __syncthreads();
    for (int i = w; i < 10; i += 8) {
        const int sb = (i < 4) ? 0 : (i < 7) ? 1 : (i < 9) ? 2 : 3, lb = (i < 4) ? i : (i < 7) ? i - 3 : (i < 9) ? i - 5 : 3;
        f32x16 acc = (f32x16){0.f, 0.f, 0.f, 0.f, 0.f, 0.f, 0.f, 0.f, 0.f, 0.f, 0.f, 0.f, 0.f, 0.f, 0.f, 0.f};
        const SS_LAS unsigned char* bp = lds + C_BS + (32 * sb + c32) * CP + 16 * hh, *cp = lds + C_CS + (32 * lb + c32) * CP + 16 * hh;
#pragma unroll
        for (int ks = 0; ks < 8; ++ks) acc = __builtin_amdgcn_mfma_f32_32x32x16_bf16(*(const SS_LAS bf16x8*)(bp + 32 * ks), *(const SS_LAS bf16x8*)(cp + 32 * ks), acc, 0, 0, 0);
        SS_LAS unsigned* o = (SS_LAS unsigned*)(lds + C_CBT) + (sb * 4 + lb) * 512 + lane;
#pragma unroll
        for (int q = 0; q < 8; ++q) o[q * 64] = cvtpk(acc[2 * q], acc[2 * q + 1]);
    }
    __syncthreads();
    const int pb = w & 1, lb = w >> 1, lrow = 32 * lb + c32;
    const int rsel = ((lane & 15) >> 2), csel = 16 * ((lane >> 4) & 1) + 4 * (lane & 3);
    unsigned ypk[8][8];
    float ssq = 0.f;
    bf16x8 pcur[8]; u32x2 zcur[4];
#define SS_PREF(pdst, zdst, e_) do { const int h_ = 8 * g + (e_); const bf16_t* pp_ = ST + ((size_t)(c * 32 + h_) * 64 + 32 * pb + c32) * 128 + 8 * hh; \
        _Pragma("unroll") for (int ks_ = 0; ks_ < 8; ++ks_) pdst[ks_] = *(const bf16x8*)(pp_ + 16 * ks_); \
        const bf16_t* zp_ = Hb + (size_t)(128 * c + lrow) * HP_ + HC_Z + g * 512 + (e_) * 64 + 32 * pb + 4 * hh; \
        _Pragma("unroll") for (int q_ = 0; q_ < 4; ++q_) zdst[q_] = *(const u32x2*)(zp_ + 8 * q_); } while (0)
    SS_PREF(pcur, zcur, 0);
    for (int e = 0; e < 8; ++e) {
        const int h = 8 * g + e;
        if (e + 1 < 8 && tid >= 256) stageX(e + 1, tid - 256, (e + 1) & 1);
        bf16x8 pnext[8]; u32x2 znext[4];
        { const int en = (e + 1 < 8) ? e + 1 : 7; SS_PREF(pnext, znext, en); }
        const int xoff = (e & 1) ? C_X1 : C_X0;
        f32x16 acc = (f32x16){0.f, 0.f, 0.f, 0.f, 0.f, 0.f, 0.f, 0.f, 0.f, 0.f, 0.f, 0.f, 0.f, 0.f, 0.f, 0.f};
        {
            const SS_LAS unsigned char* cp = lds + C_CS + lrow * CP + 16 * hh;
#pragma unroll
            for (int ks = 0; ks < 8; ++ks) acc = __builtin_amdgcn_mfma_f32_32x32x16_bf16(pcur[ks], *(const SS_LAS bf16x8*)(cp + 32 * ks), acc, 0, 0, 0);
        }
        const float al = ACS[lrow * 8 + e], eal = __expf(al);
#pragma unroll
        for (int r = 0; r < 16; ++r) acc[r] *= eal;
        for (int sb = 0; sb <= lb; ++sb) {
            const SS_LAS unsigned* cbp = (const SS_LAS unsigned*)(lds + C_CBT) + (sb * 4 + lb) * 512 + lane;
            float m[16];
#pragma unroll
            for (int q = 0; q < 8; ++q) { const unsigned u = cbp[q * 64]; m[2 * q] = bflo(u); m[2 * q + 1] = bfhi(u); }
#pragma unroll
            for (int r = 0; r < 16; ++r) { const int srow = 32 * sb + (r & 3) + 8 * (r >> 2) + 4 * hh;
                const float f = __expf(al - ACS[srow * 8 + e]) * DTS[srow * 8 + e];
                m[r] = (srow <= lrow) ? m[r] * f : 0.f; }
            const SS_LAS unsigned char* xp = lds + xoff + (32 * sb + 4 * hh + rsel) * XP + (32 * pb + csel) * 2;
#pragma unroll
            for (int ks = 0; ks < 2; ++ks) {
                const s16x4 x0 = vtr(xp + (16 * ks) * XP), x1 = vtr(xp + (16 * ks + 8) * XP);
                const bf16x8 xf = (bf16x8){x0[0], x0[1], x0[2], x0[3], x1[0], x1[1], x1[2], x1[3]};
                u32x4 mm; mm.x = cvtpk(m[8 * ks], m[8 * ks + 1]); mm.y = cvtpk(m[8 * ks + 2], m[8 * ks + 3]); mm.z = cvtpk(m[8 * ks + 4], m[8 * ks + 5]); mm.w = cvtpk(m[8 * ks + 6], m[8 * ks + 7]);
                acc = __builtin_amdgcn_mfma_f32_32x32x16_bf16(xf, __builtin_bit_cast(bf16x8, mm), acc, 0, 0, 0);
            }
        }
        const float dsk = d_skip[h];
        const SS_LAS unsigned char* xr = lds + xoff + lrow * XP + (32 * pb + 4 * hh) * 2;
        unsigned yt[8];
#pragma unroll
        for (int q = 0; q < 4; ++q) {
            const u32x2 zz = zcur[q]; const u32x2 xx = *(const SS_LAS u32x2*)(xr + 16 * q);
            const float zv[4] = {bflo(zz.x), bfhi(zz.x), bflo(zz.y), bfhi(zz.y)}, xv[4] = {bflo(xx.x), bfhi(xx.x), bflo(xx.y), bfhi(xx.y)};
            float y[4];
#pragma unroll
            for (int k = 0; k < 4; ++k) { y[k] = (acc[4 * q + k] + dsk * xv[k]) * (zv[k] * __builtin_amdgcn_rcpf(1.f + __expf(-zv[k]))); ssq += y[k] * y[k]; }
            yt[2 * q] = cvtpk(y[0], y[1]); yt[2 * q + 1] = cvtpk(y[2], y[3]);
        }
#define SS_YSET(E) case E: { _Pragma("unroll") for (int q_ = 0; q_ < 8; ++q_) ypk[E][q_] = yt[q_]; } break;
        switch (e) { SS_YSET(0) SS_YSET(1) SS_YSET(2) SS_YSET(3) SS_YSET(4) SS_YSET(5) SS_YSET(6) default: { _Pragma("unroll") for (int q_ = 0; q_ < 8; ++q_) ypk[7][q_] = yt[q_]; } break; }
#undef SS_YSET
#pragma unroll
        for (int ks = 0; ks < 8; ++ks) pcur[ks] = pnext[ks];
#pragma unroll
        for (int q = 0; q < 4; ++q) zcur[q] = znext[q];
        __syncthreads();
    }
#undef SS_PREF
    ssq += __shfl_xor(ssq, 32);
    if (hh == 0) SSQ[pb * 128 + lrow] = ssq;
    __syncthreads();
    const float rstd = rsqrtf((SSQ[lrow] + SSQ[128 + lrow]) * (1.f / 512.f) + 1e-5f);
    bf16_t* op = Hb + (size_t)(128 * c + lrow) * HP_ + HC_Z + g * 512 + 32 * pb + 4 * hh;
    const float* nw = norm_w + g * 512 + 32 * pb + 4 * hh;
#pragma unroll
    for (int e = 0; e < 8; ++e)
#pragma unroll
        for (int q = 0; q < 4; ++q) { const f32x4 n4 = *(const f32x4*)(nw + e * 64 + 8 * q);
            uint2 o; o.x = cvtpk(bflo(ypk[e][2 * q]) * rstd * n4.x, bfhi(ypk[e][2 * q]) * rstd * n4.y); o.y = cvtpk(bflo(ypk[e][2 * q + 1]) * rstd * n4.z, bfhi(ypk[e][2 * q + 1]) * rstd * n4.w);
            if (STORE || o.x == 0x12345u) *(uint2*)(op + e * 64 + 8 * q) = o; }
    __syncthreads();
}
}


namespace psel {
#define PS_LAS __attribute__((address_space(3)))
typedef short bf16x8 __attribute__((ext_vector_type(8)));
typedef float f32x16 __attribute__((ext_vector_type(16)));
__device__ __forceinline__ int ord(float f) { const int b = __builtin_bit_cast(int, f); return b ^ ((b >> 31) & 0x7fffffff); }
__device__ __forceinline__ float unord(int t) { return __builtin_bit_cast(float, t ^ ((t >> 31) & 0x7fffffff)); }
#define PS_INS(top, v) do { int v_ = (v); _Pragma("unroll") for (int i_ = 0; i_ < 16; ++i_) { const int hi_ = max(top[i_], v_); v_ = min(top[i_], v_); top[i_] = hi_; } } while (0)
__device__ __forceinline__ void stage1(PS_LAS int* EXall, const bf16_t* __restrict__ QP, const bf16_t* __restrict__ SUBK, int tok0, int hp) {
    const int tid = opaque_tid(), lane = tid & 63, w1 = __builtin_amdgcn_readfirstlane(tid >> 6), c32 = lane & 31, hh = lane >> 5;
    PS_LAS int* EX = EXall + hp * 4096;
    {
        const int tile = w1 >> 2, hsel = (w1 >> 1) & 1, half = w1 & 1, h = 2 * hp + hsel;
        const bf16_t* qp = QP + (size_t)(tok0 + 32 * tile + c32) * 2048 + h * 256 + half * 128 + 8 * hh;
        const bf16_t* kp = SUBK + ((size_t)(h * 2 + half) * 128 + c32) * 128 + 8 * hh;
        bf16x8 qf[8];
#pragma unroll
        for (int ks = 0; ks < 8; ++ks) qf[ks] = *(const bf16x8*)(qp + 16 * ks);
        int top[16];
#pragma unroll
        for (int i = 0; i < 16; ++i) top[i] = (int)0x80000000;
        bf16x8 kfa[8], kfb[8];
#define PS_LDK(dst, mt_) do { _Pragma("unroll") for (int ks_ = 0; ks_ < 8; ++ks_) dst[ks_] = *(const bf16x8*)(kp + (size_t)(32 * (mt_)) * 128 + 16 * ks_); } while (0)
#define PS_TILE(src, mt_) do { f32x16 acc_ = (f32x16){0.f, 0.f, 0.f, 0.f, 0.f, 0.f, 0.f, 0.f, 0.f, 0.f, 0.f, 0.f, 0.f, 0.f, 0.f, 0.f}; \
            _Pragma("unroll") for (int ks_ = 0; ks_ < 8; ++ks_) acc_ = __builtin_amdgcn_mfma_f32_32x32x16_bf16(src[ks_], qf[ks_], acc_, 0, 0, 0); \
            _Pragma("unroll") for (int r_ = 0; r_ < 16; ++r_) { const int key_ = 32 * (mt_) + (r_ & 3) + 8 * (r_ >> 2) + 4 * hh; const int v__ = (ord(acc_[r_]) & ~127) | (127 - key_); PS_INS(top, v__); } } while (0)
        PS_LDK(kfa, 0);
        PS_LDK(kfb, 1); PS_TILE(kfa, 0);
        PS_LDK(kfa, 2); PS_TILE(kfb, 1);
        PS_LDK(kfb, 3); PS_TILE(kfa, 2);
        PS_TILE(kfb, 3);
#undef PS_LDK
#undef PS_TILE
        int oth[16];
#pragma unroll
        for (int i = 0; i < 16; ++i) oth[i] = __shfl_xor(top[i], 32);
#pragma unroll
        for (int i = 0; i < 16; ++i) PS_INS(top, oth[i]);
        if (hh == 0) {
#pragma unroll
            for (int i = 0; i < 16; ++i) EX[(w1 * 16 + i) * 32 + c32] = top[i];
        }
    }
}
__device__ __forceinline__ void stage2(PS_LAS int* EXall, int* __restrict__ IDX, float* __restrict__ GATE, int tok0) {
    const int tid = opaque_tid();
    {
        const int hp = tid >> 7, task = tid & 127, th = task >> 5, tok32 = task & 31, tile = th >> 1, hsel = th & 1, h = 2 * hp + hsel;
        PS_LAS int* EX = EXall + hp * 4096;
        const PS_LAS int* ea = EX + ((th * 2 + 0) * 16) * 32 + tok32; const PS_LAS int* eb = EX + ((th * 2 + 1) * 16) * 32 + tok32;
        float as[16], bs[16];
#pragma unroll
        for (int i = 0; i < 16; ++i) { as[i] = unord(ea[i * 32] & ~127); bs[i] = unord(eb[i * 32] & ~127); }
        int top[16];
#pragma unroll
        for (int i = 0; i < 16; ++i) top[i] = (int)0x80000000;
#pragma unroll
        for (int i = 0; i < 16; ++i)
#pragma unroll
            for (int j = 0; j < 16; ++j) if ((i + 1) * (j + 1) <= 16) { const int v = (ord(as[i] + bs[j]) & ~255) | (255 - (i * 16 + j)); PS_INS(top, v); }
        float sc[16]; int id[16];
#pragma unroll
        for (int r = 0; r < 16; ++r) { const int cn = 255 - (top[r] & 255), i = cn >> 4, j = cn & 15; const int pa = ea[i * 32], pb = eb[j * 32];
            sc[r] = unord(pa & ~127) + unord(pb & ~127); id[r] = (127 - (pa & 127)) * 128 + (127 - (pb & 127)); }
        float sum = 0.f; const float mx = sc[0];
#pragma unroll
        for (int r = 0; r < 16; ++r) { sc[r] = __expf(sc[r] - mx); sum += sc[r]; }
        const size_t o = (size_t)(tok0 + 32 * tile + tok32) * 128 + h * 16;
        const float inv = 1.f / sum;
#pragma unroll
        for (int r = 0; r < 16; r += 4) { *(f32x4*)(GATE + o + r) = (f32x4){sc[r] * inv, sc[r + 1] * inv, sc[r + 2] * inv, sc[r + 3] * inv}; *(u32x4*)(IDX + o + r) = (u32x4){(unsigned)id[r], (unsigned)id[r + 1], (unsigned)id[r + 2], (unsigned)id[r + 3]}; }
    }
}
}


namespace xattn {
#define XA_LAS __attribute__((address_space(3)))
typedef short bf16x8 __attribute__((ext_vector_type(8)));
typedef short s16x4 __attribute__((ext_vector_type(4)));
typedef float f32x16 __attribute__((ext_vector_type(16)));
constexpr int RP = 528;
__device__ __forceinline__ unsigned cvtpk(float lo, float hi) { typedef float f2 __attribute__((ext_vector_type(2))); typedef __bf16 b2 __attribute__((ext_vector_type(2))); f2 v = {lo, hi}; b2 b = __builtin_convertvector(v, b2); return __builtin_bit_cast(unsigned, b); }
__device__ __forceinline__ void stage(XA_LAS unsigned char* lds, const bf16_t* __restrict__ src, int pitch, int tid) {
#pragma unroll 4
    for (int i = 0; i < 16; ++i) { const int q = tid + 512 * i, row = q >> 5, ch = q & 31; *(XA_LAS u32x4*)(lds + row * RP + ch * 16) = *(const u32x4*)(src + (size_t)row * pitch + ch * 8); }
}
__device__ __forceinline__ void unit(XA_LAS unsigned char* lds, const bf16_t* __restrict__ QC, const bf16_t* __restrict__ KC, const bf16_t* __restrict__ VcT, bf16_t* __restrict__ XO, int tg, int h) {
    const int tid = opaque_tid(), lane = tid & 63, w = __builtin_amdgcn_readfirstlane(tid >> 6), c32 = lane & 31, hh = lane >> 5, b = tg >> 5;
    const int tok = 256 * tg + 32 * w + c32;
    stage(lds, KC + (size_t)b * MEML * D + h * 256, D, tid);
    bf16x8 pf[8][2]; float inv;
    {
        bf16x8 qf[16];
        const bf16_t* qp = QC + (size_t)tok * D + h * 256 + 8 * hh;
#pragma unroll
        for (int ks = 0; ks < 16; ++ks) qf[ks] = *(const bf16x8*)(qp + 16 * ks);
        __syncthreads();
        f32x16 acc[8];
        const XA_LAS unsigned char* kb = lds + c32 * RP + 16 * hh;
#pragma unroll
        for (int mt = 0; mt < 8; ++mt) {
            acc[mt] = (f32x16){0.f, 0.f, 0.f, 0.f, 0.f, 0.f, 0.f, 0.f, 0.f, 0.f, 0.f, 0.f, 0.f, 0.f, 0.f, 0.f};
#pragma unroll
            for (int ks = 0; ks < 16; ++ks) acc[mt] = __builtin_amdgcn_mfma_f32_32x32x16_bf16(*(const XA_LAS bf16x8*)(kb + (32 * mt) * RP + 32 * ks), qf[ks], acc[mt], 0, 0, 0);
        }
        float mx = acc[0][0];
#pragma unroll
        for (int mt = 0; mt < 8; ++mt)
#pragma unroll
            for (int r = 0; r < 16; ++r) mx = fmaxf(mx, acc[mt][r]);
        mx = fmaxf(mx, __shfl_xor(mx, 32));
        float sum = 0.f;
#pragma unroll
        for (int mt = 0; mt < 8; ++mt)
#pragma unroll
            for (int r = 0; r < 16; ++r) { acc[mt][r] = __builtin_amdgcn_exp2f(acc[mt][r] - mx); sum += acc[mt][r]; }
        sum += __shfl_xor(sum, 32); inv = 1.f / sum;
#pragma unroll
        for (int mt = 0; mt < 8; ++mt)
#pragma unroll
            for (int s2 = 0; s2 < 2; ++s2) { u32x4 a; a.x = cvtpk(acc[mt][8 * s2], acc[mt][8 * s2 + 1]); a.y = cvtpk(acc[mt][8 * s2 + 2], acc[mt][8 * s2 + 3]); a.z = cvtpk(acc[mt][8 * s2 + 4], acc[mt][8 * s2 + 5]); a.w = cvtpk(acc[mt][8 * s2 + 6], acc[mt][8 * s2 + 7]);
                pf[mt][s2] = __builtin_bit_cast(bf16x8, a); }
    }
    __syncthreads();
    stage(lds, VcT + ((size_t)b * D + h * 256) * MEML, MEML, tid);
    __syncthreads();
    const XA_LAS unsigned char* vb = lds + c32 * RP + 8 * hh;
    bf16_t* op = XO + (size_t)tok * D + h * 256 + 4 * hh;
#pragma unroll 1
    for (int dt = 0; dt < 8; ++dt) {
        f32x16 acc = (f32x16){0.f, 0.f, 0.f, 0.f, 0.f, 0.f, 0.f, 0.f, 0.f, 0.f, 0.f, 0.f, 0.f, 0.f, 0.f, 0.f};
#pragma unroll
        for (int mt = 0; mt < 8; ++mt)
#pragma unroll
            for (int s2 = 0; s2 < 2; ++s2) {
                const s16x4 lo = *(const XA_LAS s16x4*)(vb + (32 * dt) * RP + (32 * mt + 16 * s2) * 2), hi = *(const XA_LAS s16x4*)(vb + (32 * dt) * RP + (32 * mt + 16 * s2 + 8) * 2);
                const bf16x8 vf = (bf16x8){lo[0], lo[1], lo[2], lo[3], hi[0], hi[1], hi[2], hi[3]};
                acc = __builtin_amdgcn_mfma_f32_32x32x16_bf16(vf, pf[mt][s2], acc, 0, 0, 0);
            }
#pragma unroll
        for (int q = 0; q < 4; ++q) { u32x2 o; o.x = cvtpk(acc[4 * q] * inv, acc[4 * q + 1] * inv); o.y = cvtpk(acc[4 * q + 2] * inv, acc[4 * q + 3] * inv); *(u32x2*)(op + 32 * dt + 8 * q) = o; }
    }
    __syncthreads();
}
}

namespace sp {
#define SP_LAS __attribute__((address_space(3)))
#define SP_LDSWAIT() do { asm volatile("s_waitcnt lgkmcnt(0)" ::: "memory"); } while (0)
__device__ __forceinline__ void transpose_item(const float* __restrict__ W, int ldw, int col0, int K, int nblk, bf16_t* __restrict__ WT, int row_off, SP_LAS float* scr, int item, int lane) {
    const int kb = item / nblk, nb = item % nblk, k0 = 64 * kb, n0 = 32 * nb;
#pragma unroll 8
    for (int i = 0; i < 32; ++i) { const int kk = 2 * i + (lane >> 5); scr[kk * 33 + (lane & 31)] = W[(size_t)(k0 + kk) * ldw + col0 + n0 + (lane & 31)]; }
    SP_LDSWAIT();
    const int cc = lane & 7;
#pragma unroll
    for (int j = 0; j < 4; ++j) { const int n = (lane >> 3) + 8 * j; const SP_LAS float* s = scr + (8 * cc) * 33 + n;
        u32x4 o; o.x = pk2(s[0 * 33], s[1 * 33]); o.y = pk2(s[2 * 33], s[3 * 33]); o.z = pk2(s[4 * 33], s[5 * 33]); o.w = pk2(s[6 * 33], s[7 * 33]);
        *(u32x4*)(WT + (size_t)(row_off + n0 + n) * K + k0 + 8 * cc) = o; }
    SP_LDSWAIT();
}
__device__ __forceinline__ void cvt_range(const float* __restrict__ src, bf16_t* __restrict__ dst, size_t n4, size_t gtid, size_t gthreads) {
    for (size_t i = gtid; i < n4; i += gthreads) { const f32x4 v = ((const f32x4*)src)[i]; u32x2 o; o.x = pk2(v.x, v.y); o.y = pk2(v.z, v.w); ((u32x2*)dst)[i] = o; }
}

__device__ __forceinline__ void cvt_fp8_range(const float* __restrict__ src, unsigned char* __restrict__ dst, size_t n16, float scale, size_t gtid, size_t gthreads) {
    for (size_t i = gtid; i < n16; i += gthreads) {
        const f32x4* sp4 = (const f32x4*)src + 4 * i; u32x4 o; unsigned ow[4];
#pragma unroll
        for (int q = 0; q < 4; ++q) { const f32x4 v = sp4[q];
            const float a = fminf(fmaxf(v.x * scale, -448.f), 448.f), b = fminf(fmaxf(v.y * scale, -448.f), 448.f), c2 = fminf(fmaxf(v.z * scale, -448.f), 448.f), d2 = fminf(fmaxf(v.w * scale, -448.f), 448.f);
            int p = 0; p = __builtin_amdgcn_cvt_pk_fp8_f32(a, b, p, false); p = __builtin_amdgcn_cvt_pk_fp8_f32(c2, d2, p, true); ow[q] = (unsigned)p; }
        o.x = ow[0]; o.y = ow[1]; o.z = ow[2]; o.w = ow[3];
        const size_t e_ = i >> 6, cg_ = i & 63; ((u32x4*)dst)[(cg_ >> 3) * ((size_t)PK * PK * 8) + e_ * 8 + (cg_ & 7)] = o;
    }
}
__device__ __forceinline__ void dt_stage_w(SP_LAS float* Wl, const float* __restrict__ w_in) {
    const int tid = opaque_tid();
#pragma unroll 8
    for (int i = 0; i < 64; ++i) { const int idx = tid + 512 * i; Wl[idx] = w_in[(size_t)(idx >> 5) * NIN + 5120 + (idx & 31)]; }
}
__device__ __forceinline__ void dt_item(SP_LAS float* Wl, SP_LAS float* xs, SP_LAS float* part, const float* __restrict__ x, const float* __restrict__ dt_bias, float* __restrict__ DT, int item) {
    const int tid = opaque_tid(), lane = tid & 63, w = tid >> 6, m0 = item * 4;
#pragma unroll
    for (int i = 0; i < 2; ++i) { const int q = tid + 512 * i; *(SP_LAS f32x4*)(xs + 4 * q) = ((const f32x4*)(x + (size_t)m0 * D))[q]; }
    __syncthreads();
    const int h = lane & 31, r = w >> 1, kq = (w & 1) * 2 + (lane >> 5);
    const SP_LAS float* xp = xs + r * 1024 + kq * 256; const SP_LAS float* wp = Wl + (kq * 256) * 32 + h;
    float a0 = 0.f, a1 = 0.f;
#pragma unroll 8
    for (int k = 0; k < 256; k += 2) { a0 = fmaf(xp[k], wp[k * 32], a0); a1 = fmaf(xp[k + 1], wp[(k + 1) * 32], a1); }
    float acc = a0 + a1;
    acc += __shfl_xor(acc, 32);
    if ((w & 1) && lane < 32) part[r * 32 + h] = acc;
    __syncthreads();
    if (!(w & 1) && lane < 32) { const float v = acc + part[r * 32 + h] + dt_bias[h]; DT[(size_t)(m0 + r) * 32 + h] = v > 20.f ? v : log1pf(expf(v)); }
}
__device__ __forceinline__ void ln_row(float* __restrict__ X, const float* __restrict__ g, const float* __restrict__ b, bf16_t* __restrict__ XB, int row, int lane) {
    f32x4* xr = (f32x4*)(X + (size_t)row * D) + lane;
    f32x4 v[4]; float s = 0.f;
#pragma unroll
    for (int j = 0; j < 4; ++j) { v[j] = xr[64 * j]; s += (v[j].x + v[j].y) + (v[j].z + v[j].w); }
    const float mean = wave_sum(s) * (1.f / D); float s2 = 0.f;
#pragma unroll
    for (int j = 0; j < 4; ++j) { v[j] = v[j] - mean; s2 += (v[j].x * v[j].x + v[j].y * v[j].y) + (v[j].z * v[j].z + v[j].w * v[j].w); }
    const float rstd = rsqrtf(wave_sum(s2) * (1.f / D) + 1e-5f);
#pragma unroll
    for (int j = 0; j < 4; ++j) { const int c = 4 * lane + 256 * j; const f32x4 gg = *(const f32x4*)(g + c), bb = *(const f32x4*)(b + c);
        f32x4 o = v[j] * rstd * gg + bb; xr[64 * j] = o;
        u32x2 pb; pb.x = pk2(o.x, o.y); pb.y = pk2(o.z, o.w); *(u32x2*)(XB + (size_t)row * D + c) = pb; }
}
__device__ __forceinline__ void xattn_pair(SP_LAS float* L, const bf16_t* __restrict__ QC, const bf16_t* __restrict__ KCVC, bf16_t* __restrict__ XO, int tok0) {
    const int t512 = opaque_tid(); const int half = t512 >> 8, tid = t512 & 255, lane = tid & 63, wv = tid >> 6, tok = tok0 + half, b = tok / SEQ;
    SP_LAS float* qs = L + half * 1024; SP_LAS float* ps = L + 2048 + half * 256; SP_LAS float* red = L + 2560 + half * 8;
    for (int i = tid; i < 1024; i += 256) qs[i] = bf2f(QC[(size_t)tok * D + i]);
    __syncthreads();
    const bf16_t* KV = KCVC + (size_t)b * MEML * 2048;
    for (int h = 0; h < MH; ++h) {
        const bf16_t* kp = KV + (size_t)tid * 2048 + h * 256;
        float s = 0.f;
        for (int d = 0; d < 256; d += 8) { const u32x4 w = *(const u32x4*)(kp + d); const SP_LAS float* q = qs + h * 256 + d;
            s += q[0] * bflo(w.x) + q[1] * bfhi(w.x) + q[2] * bflo(w.y) + q[3] * bfhi(w.y) + q[4] * bflo(w.z) + q[5] * bfhi(w.z) + q[6] * bflo(w.w) + q[7] * bfhi(w.w); }
        float mx = wave_max(s); if (lane == 0) red[wv] = mx; __syncthreads();
        mx = fmaxf(fmaxf(red[0], red[1]), fmaxf(red[2], red[3]));
        const float p = exp2f(s - mx);
        float sm = wave_sum(p); if (lane == 0) red[4 + wv] = sm; ps[tid] = p; __syncthreads();
        sm = (red[4] + red[5]) + (red[6] + red[7]);
        float o = 0.f;
        for (int j = 0; j < 256; ++j) o = fmaf(ps[j], bf2f(KV[(size_t)j * 2048 + 1024 + h * 256 + tid]), o);
        XO[(size_t)tok * D + h * 256 + tid] = (bf16_t)f2bf(o / sm);
        __syncthreads();
    }
}
__device__ __forceinline__ void select_pair(SP_LAS float* L, const bf16_t* __restrict__ QP, const bf16_t* __restrict__ SUBK, int* __restrict__ IDX, float* __restrict__ GATE, int tok0) {
    const int t512 = opaque_tid(); const int hf = t512 >> 8, tid = t512 & 255, tok = tok0 + hf;
    SP_LAS float* base = L + hf * 3072;
    SP_LAS float* qs = base; SP_LAS float* s = base + 2048; SP_LAS float* tops = base + 2304; SP_LAS int* topi = (SP_LAS int*)(base + 2336); SP_LAS float* cs = base + 2368; SP_LAS int* ci = (SP_LAS int*)(base + 2624);
    SP_LAS float* bs = base + 2880; SP_LAS int* bi = (SP_LAS int*)(base + 2896);
    for (int i = tid; i < 2048; i += 256) qs[i] = bf2f(QP[(size_t)tok * 2048 + i]);
    __syncthreads();
    for (int h = 0; h < PH; ++h) {
        const int half = tid >> 7, key = tid & 127;
        { const bf16_t* kp = SUBK + ((size_t)(h * 2 + half) * 128 + key) * 128; const SP_LAS float* q = qs + h * 256 + half * 128; float a = 0.f;
          for (int d = 0; d < 128; d += 8) { const u32x4 w = *(const u32x4*)(kp + d);
              a += q[d] * bflo(w.x) + q[d + 1] * bfhi(w.x) + q[d + 2] * bflo(w.y) + q[d + 3] * bfhi(w.y) + q[d + 4] * bflo(w.z) + q[d + 5] * bfhi(w.z) + q[d + 6] * bflo(w.w) + q[d + 7] * bfhi(w.w); }
          s[tid] = a; }
        __syncthreads();
        { const float me = s[tid]; int rank = 0; const SP_LAS float* spp = s + half * 128;
          for (int j = 0; j < 128; ++j) { const float o = spp[j]; rank += (o > me || (o == me && j < key)) ? 1 : 0; }
          if (rank < 16) { tops[half * 16 + rank] = me; topi[half * 16 + rank] = key; } }
        __syncthreads();
        { const int i = tid >> 4, j = tid & 15; cs[tid] = tops[i] + tops[16 + j]; ci[tid] = topi[i] * 128 + topi[16 + j]; }
        __syncthreads();
        { const float me = cs[tid]; int rank = 0;
          for (int j = 0; j < 256; ++j) { const float o = cs[j]; rank += (o > me || (o == me && j < tid)) ? 1 : 0; }
          if (rank < 16) { bs[rank] = me; bi[rank] = ci[tid]; } }
        __syncthreads();
        if (tid < 16) { const float mx = bs[0]; float sum = 0.f;
            for (int j = 0; j < 16; ++j) sum += expf(bs[j] - mx);
            GATE[(size_t)tok * 128 + h * 16 + tid] = expf(bs[tid] - mx) / sum; IDX[(size_t)tok * 128 + h * 16 + tid] = bi[tid]; }
        __syncthreads();
    }
}
__device__ __forceinline__ void gather_token(SP_LAS float* L, float* __restrict__ X, const bf16_t* __restrict__ PU, const bf16_t* __restrict__ PV, const int* __restrict__ IDX, const float* __restrict__ GATE,
                                             const float* __restrict__ g3, const float* __restrict__ b3, int tok) {
    const int tid = opaque_tid(), lane = tid & 63, wv = tid >> 6;
    SP_LAS float* ys = L; SP_LAS float* red = L + 8192;
    float xr[16], y[16];
    { const float* xp = X + (size_t)tok * D + lane * 16;
#pragma unroll
      for (int j = 0; j < 4; ++j) { const f32x4 v = *(const f32x4*)(xp + 4 * j); xr[4 * j] = v.x; xr[4 * j + 1] = v.y; xr[4 * j + 2] = v.z; xr[4 * j + 3] = v.w; }
#pragma unroll
      for (int j = 0; j < 16; ++j) y[j] = 0.f; }
    for (int e = 0; e < 16; ++e) {
        const int slot = wv * 16 + e; const int id = IDX[(size_t)tok * 128 + slot]; const float gt = GATE[(size_t)tok * 128 + slot];
        const bf16_t* up = PU + (size_t)id * D + lane * 16; const u32x4 u0 = *(const u32x4*)up, u1 = *(const u32x4*)(up + 8);
        const unsigned uw[8] = {u0.x, u0.y, u0.z, u0.w, u1.x, u1.y, u1.z, u1.w};
        float hsum = 0.f;
#pragma unroll
        for (int j = 0; j < 8; ++j) { hsum = fmaf(xr[2 * j], bflo(uw[j]), hsum); hsum = fmaf(xr[2 * j + 1], bfhi(uw[j]), hsum); }
        hsum = wave_sum(hsum);
        const float w = gt * 0.5f * hsum * (1.f + erff(hsum * 0.70710678118654752f));
        const bf16_t* vp = PV + (size_t)id * D + lane * 16; const u32x4 v0 = *(const u32x4*)vp, v1 = *(const u32x4*)(vp + 8);
        const unsigned vw[8] = {v0.x, v0.y, v0.z, v0.w, v1.x, v1.y, v1.z, v1.w};
#pragma unroll
        for (int j = 0; j < 8; ++j) { y[2 * j] = fmaf(w, bflo(vw[j]), y[2 * j]); y[2 * j + 1] = fmaf(w, bfhi(vw[j]), y[2 * j + 1]); }
    }
#pragma unroll
    for (int j = 0; j < 16; ++j) ys[wv * 1024 + lane * 16 + j] = y[j];
    __syncthreads();
    float v[2]; float s = 0.f;
#pragma unroll
    for (int j = 0; j < 2; ++j) { const int c = tid * 2 + j; float a = 0.f;
#pragma unroll
        for (int k = 0; k < 8; ++k) a += ys[k * 1024 + c];
        v[j] = ALPHA * X[(size_t)tok * D + c] + a; s += v[j]; }
    s = wave_sum(s); if (lane == 0) red[wv] = s; __syncthreads();
    float tot = 0.f;
#pragma unroll
    for (int k = 0; k < 8; ++k) tot += red[k];
    const float mean = tot * (1.f / D);
    float s2 = 0.f;
#pragma unroll
    for (int j = 0; j < 2; ++j) { v[j] -= mean; s2 += v[j] * v[j]; }
    s2 = wave_sum(s2); if (lane == 0) red[8 + wv] = s2; __syncthreads();
    float tot2 = 0.f;
#pragma unroll
    for (int k = 0; k < 8; ++k) tot2 += red[8 + k];
    const float rstd = rsqrtf(tot2 * (1.f / D) + 1e-5f);
#pragma unroll
    for (int j = 0; j < 2; ++j) { const int c = tid * 2 + j; X[(size_t)tok * D + c] = v[j] * rstd * g3[c] + b3[c]; }
    __syncthreads();
}

constexpr float PEER_SU = 2048.f, PEER_SV = 256.f;
typedef float f32x2v __attribute__((ext_vector_type(2)));
__device__ __forceinline__ void gather_wave(float* __restrict__ Xo, const float* X, const unsigned char* __restrict__ PU, const unsigned char* __restrict__ PV, const int* __restrict__ IDX, const float* __restrict__ GATE,
                                            const float* __restrict__ g3, const float* __restrict__ b3, int tok, int lane) {
    float xr[16], y[16];
    { const f32x4* xp = (const f32x4*)(X + (size_t)tok * D + 16 * lane);
#pragma unroll
      for (int q = 0; q < 4; ++q) { const f32x4 v = xp[q]; xr[4 * q] = v.x; xr[4 * q + 1] = v.y; xr[4 * q + 2] = v.z; xr[4 * q + 3] = v.w; } }
#pragma unroll
    for (int j = 0; j < 16; ++j) y[j] = 0.f;
    const int id0 = IDX[(size_t)tok * 128 + lane], id1 = IDX[(size_t)tok * 128 + 64 + lane];
    const float gt0 = GATE[(size_t)tok * 128 + lane], gt1 = GATE[(size_t)tok * 128 + 64 + lane];
    u32x4 ub[8], vb[8];
#define GW_ISSUE(buf, TBL, i) do { const int idv_ = ((i) < 8) ? id0 : id1; _Pragma("unroll") for (int k_ = 0; k_ < 8; ++k_) { \
        const int id_ = __builtin_amdgcn_readlane(idv_, (8 * (i) + k_) & 63); buf[k_] = *(const u32x4*)((TBL) + (size_t)id_ * D + 16 * lane); } } while (0)
    GW_ISSUE(ub, PU, 0); GW_ISSUE(vb, PV, 0);
    const bool h32 = (lane & 32) != 0, h16 = (lane & 16) != 0, h8 = (lane & 8) != 0;
#pragma unroll 1
    for (int i = 0; i < 16; ++i) {
        float p[8];
#pragma unroll
        for (int k = 0; k < 8; ++k) { const unsigned w[4] = {ub[k].x, ub[k].y, ub[k].z, ub[k].w}; float a = 0.f;
#pragma unroll
            for (int q = 0; q < 4; ++q) { const f32x2v lo = __builtin_amdgcn_cvt_pk_f32_fp8((int)w[q], false), hi = __builtin_amdgcn_cvt_pk_f32_fp8((int)w[q], true);
                a = fmaf(xr[4 * q], lo.x, a); a = fmaf(xr[4 * q + 1], lo.y, a); a = fmaf(xr[4 * q + 2], hi.x, a); a = fmaf(xr[4 * q + 3], hi.y, a); }
            p[k] = a; }
        { const int in_ = (i + 1 < 16) ? i + 1 : 15; GW_ISSUE(ub, PU, in_); }
        float q4[4], q2[2], q1;
#pragma unroll
        for (int k = 0; k < 4; ++k) q4[k] = (h32 ? p[k + 4] : p[k]) + __shfl_xor(h32 ? p[k] : p[k + 4], 32);
#pragma unroll
        for (int k = 0; k < 2; ++k) q2[k] = (h16 ? q4[k + 2] : q4[k]) + __shfl_xor(h16 ? q4[k] : q4[k + 2], 16);
        q1 = (h8 ? q2[1] : q2[0]) + __shfl_xor(h8 ? q2[0] : q2[1], 8);
        q1 += __shfl_xor(q1, 4); q1 += __shfl_xor(q1, 2); q1 += __shfl_xor(q1, 1);
        q1 *= (1.f / PEER_SU);
        const float gsel = __shfl((i < 8) ? gt0 : gt1, (8 * i + (lane >> 3)) & 63);
        const float wv = gsel * 0.5f * q1 * (1.f + erff(q1 * 0.70710678118654752f));
#pragma unroll
        for (int k = 0; k < 8; ++k) { const float wk = __builtin_bit_cast(float, __builtin_amdgcn_readlane(__builtin_bit_cast(int, wv), 8 * k));
            const unsigned w[4] = {vb[k].x, vb[k].y, vb[k].z, vb[k].w};
#pragma unroll
            for (int q = 0; q < 4; ++q) { const f32x2v lo = __builtin_amdgcn_cvt_pk_f32_fp8((int)w[q], false), hi = __builtin_amdgcn_cvt_pk_f32_fp8((int)w[q], true);
                y[4 * q] = fmaf(wk, lo.x, y[4 * q]); y[4 * q + 1] = fmaf(wk, lo.y, y[4 * q + 1]); y[4 * q + 2] = fmaf(wk, hi.x, y[4 * q + 2]); y[4 * q + 3] = fmaf(wk, hi.y, y[4 * q + 3]); } }
        { const int in_ = (i + 1 < 16) ? i + 1 : 15; GW_ISSUE(vb, PV, in_); }
    }
#undef GW_ISSUE
    float s = 0.f;
#pragma unroll
    for (int j = 0; j < 16; ++j) { y[j] = ALPHA * xr[j] + y[j] * (1.f / PEER_SV); s += y[j]; }
    const float mean = wave_sum(s) * (1.f / D); float s2 = 0.f;
#pragma unroll
    for (int j = 0; j < 16; ++j) { y[j] -= mean; s2 += y[j] * y[j]; }
    const float rstd = rsqrtf(wave_sum(s2) * (1.f / D) + 1e-5f);
    float* op = Xo + (size_t)tok * D + 16 * lane;
#pragma unroll
    for (int q = 0; q < 4; ++q) { const f32x4 gg = *(const f32x4*)(g3 + 16 * lane + 4 * q), bb = *(const f32x4*)(b3 + 16 * lane + 4 * q);
        f32x4 o; o.x = y[4 * q] * rstd * gg.x + bb.x; o.y = y[4 * q + 1] * rstd * gg.y + bb.y; o.z = y[4 * q + 2] * rstd * gg.z + bb.z; o.w = y[4 * q + 3] * rstd * gg.w + bb.w;
        *(f32x4*)(op + 4 * q) = o; }
}
}


#define LAS __attribute__((address_space(3)))
#define XB_TMO      128
#define XB_XCNT(j)  (256  + 64 * (j))
#define XB_XSUB(j)  (1280 + 64 * (j))
#define XB_XGEN(j)  (2304 + 64 * (j))
#define XB_TOP      3328
#define XB_TOPGEN   3392
#define XCD_BAR_WORDS 3456
#define XB_SPIN_CAP (1u << 18)
__device__ __forceinline__ unsigned xb_ld(unsigned* p)              { return __hip_atomic_load(p, __ATOMIC_RELAXED, __HIP_MEMORY_SCOPE_AGENT); }
__device__ __forceinline__ unsigned xb_add(unsigned* p, unsigned v) { return __hip_atomic_fetch_add(p, v, __ATOMIC_RELAXED, __HIP_MEMORY_SCOPE_AGENT); }
__device__ __forceinline__ unsigned xb_xcc_id() { return (unsigned)__builtin_amdgcn_s_getreg((3 << 11) | 20) & 0xFu; }
#define XB_SPIN(cond, bar) do { unsigned _sp = 0; while (cond) { __builtin_amdgcn_s_sleep(1); \
    if ((++_sp & 255u) == 0u) { if (xb_ld(&(bar)[XB_TMO])) break; if (_sp > XB_SPIN_CAP) { atomicAdd(&(bar)[XB_TMO], 1u); break; } } } } while (0)
struct XcdBarrier { unsigned* bar; unsigned x; volatile LAS unsigned* st; };
__device__ __forceinline__ XcdBarrier xcd_barrier_post(unsigned* bar, volatile LAS unsigned* st) {
    XcdBarrier b; b.bar = bar; b.x = xb_xcc_id(); b.st = st;
    if (threadIdx.x == 0) (void)xb_add(&bar[XB_XCNT(b.x)], 1u);
    return b;
}
__device__ __forceinline__ void xcd_barrier_complete(unsigned* bar, unsigned x, unsigned& nloc, unsigned& nx) {
    const unsigned G = gridDim.x * gridDim.y * gridDim.z;
    unsigned sum, cnt, mine, sp = 0u;
    for (;;) {
        sum = 0u; cnt = 0u; mine = 0u;
#pragma unroll
        for (unsigned j = 0; j < 16; ++j) { const unsigned c = xb_ld(&bar[XB_XCNT(j)]); sum += c; cnt += (c > 0u) ? 1u : 0u; mine = (j == x) ? c : mine; }
        if (sum == G) break;
        __builtin_amdgcn_s_sleep(1);
        if ((++sp & 255u) == 0u) { if (xb_ld(&bar[XB_TMO])) break; if (sp > XB_SPIN_CAP) { atomicAdd(&bar[XB_TMO], 1u); break; } }
    }
    nloc = mine > 0u ? mine : 1u; nx = cnt > 0u ? cnt : 1u;
}
__device__ __forceinline__ void xcd_barrier(const XcdBarrier& b) {
    asm volatile("s_waitcnt vmcnt(0)" ::: "memory");
    __syncthreads();
    if (threadIdx.x == 0) {
        unsigned* bar = b.bar;
        __builtin_amdgcn_s_waitcnt(0);
        unsigned nloc = b.st[0], nx = b.st[1];
        if (nloc == 0u) { xcd_barrier_complete(bar, b.x, nloc, nx); b.st[0] = nloc; b.st[1] = nx; }
        const unsigned old = xb_add(&bar[XB_XSUB(b.x)], 1u);
        const unsigned gen = old / nloc;
        if (old + 1u == (gen + 1u) * nloc) {
            __builtin_amdgcn_fence(__ATOMIC_RELEASE, "agent");
            asm volatile("s_waitcnt vmcnt(0)" ::: "memory");
            const unsigned og = xb_add(&bar[XB_TOP], 1u);
            const unsigned tg = og / nx;
            if (og + 1u == (tg + 1u) * nx) xb_add(&bar[XB_TOPGEN], 1u);
            else XB_SPIN(xb_ld(&bar[XB_TOPGEN]) == tg, bar);
            __builtin_amdgcn_fence(__ATOMIC_ACQUIRE, "agent");
            xb_add(&bar[XB_XGEN(b.x)], 1u);
            asm volatile("s_waitcnt vmcnt(0)" ::: "memory");
        } else {
            XB_SPIN(xb_ld(&bar[XB_XGEN(b.x)]) == gen, bar);
            __builtin_amdgcn_fence(__ATOMIC_ACQUIRE, "agent");
            asm volatile("s_waitcnt vmcnt(0)" ::: "memory");
        }
    }
    __syncthreads();
}
constexpr int CW_BAR = 4096;
constexpr int MISC_OFF = 147456;


namespace peer2 {
#define P2_LAS __attribute__((address_space(3)))
typedef float f32x2v __attribute__((ext_vector_type(2)));
constexpr int CW_TICK = 8192;
__device__ __forceinline__ float dpp_add_xor1(float v) { return v + __builtin_bit_cast(float, __builtin_amdgcn_update_dpp(0, __builtin_bit_cast(int, v), 0xB1, 0xf, 0xf, true)); }
__device__ __forceinline__ float dpp_add_xor2(float v) { return v + __builtin_bit_cast(float, __builtin_amdgcn_update_dpp(0, __builtin_bit_cast(int, v), 0x4E, 0xf, 0xf, true)); }
__device__ __forceinline__ float dpp_add_hmir(float v) { return v + __builtin_bit_cast(float, __builtin_amdgcn_update_dpp(0, __builtin_bit_cast(int, v), 0x141, 0xf, 0xf, true)); }
__device__ __forceinline__ float dpp_ror8(float v) { return __builtin_bit_cast(float, __builtin_amdgcn_update_dpp(0, __builtin_bit_cast(int, v), 0x128, 0xf, 0xf, true)); }
__device__ __forceinline__ float swap32_sum(float a, float b) { auto r = __builtin_amdgcn_permlane32_swap(__builtin_bit_cast(unsigned, a), __builtin_bit_cast(unsigned, b), false, false); return __builtin_bit_cast(float, r[0]) + __builtin_bit_cast(float, r[1]); }
struct Own { int j, rank, nrank, nsl; };
__device__ __forceinline__ Own ownership(unsigned* ctl, P2_LAS unsigned* scr, int phase, int wave) {
    const int G = gridDim.x;
    if (threadIdx.x == 0) {
        unsigned* bar = ctl + CW_BAR; bool uni = (G % 8) == 0;
        for (int j = 0; j < 8; ++j) uni = uni && (xb_ld(&bar[XB_XCNT(j)]) == (unsigned)(G / 8));
        const unsigned xcc = xb_xcc_id();
        if (uni && xcc < 8u) { scr[0] = xcc; scr[1] = xb_add(&ctl[CW_TICK + 64 * (8 * phase + (int)xcc)], 1u); }
        else { scr[0] = blockIdx.x & 7; scr[1] = blockIdx.x >> 3; }
    }
    __syncthreads();
    Own o;
    if (G % 8 == 0) { o.j = (int)scr[0]; o.rank = (int)scr[1] * 8 + wave; o.nrank = G; o.nsl = 8; }
    else { o.j = 0; o.rank = blockIdx.x * 8 + wave; o.nrank = G * 8; o.nsl = 1; }
    return o;
}
__device__ __forceinline__ float dot16_fp8(const float (&x)[16], const u32x4 u) {
    const unsigned w[4] = {u.x, u.y, u.z, u.w}; f32x2v a = {0.f, 0.f};
#pragma unroll
    for (int q = 0; q < 4; ++q) { const f32x2v lo = __builtin_amdgcn_cvt_pk_f32_fp8((int)w[q], false), hi = __builtin_amdgcn_cvt_pk_f32_fp8((int)w[q], true);
        a = __builtin_elementwise_fma((f32x2v){x[4 * q], x[4 * q + 1]}, lo, a); a = __builtin_elementwise_fma((f32x2v){x[4 * q + 2], x[4 * q + 3]}, hi, a); }
    return a.x + a.y;
}
__device__ __forceinline__ void u_wave(const float* __restrict__ X, const unsigned char* __restrict__ PU, const int* __restrict__ IDX, float* __restrict__ PART, int j, int rank, int nrank, int lane) {
    const int sub = lane & 7, grp = lane >> 3, col0 = 128 * j + 16 * sub;
    float* part = PART + (size_t)j * M * 128 + 16 * grp;
#define PU_LOADIDX(idv, xv, t_) do { const int tt_ = ((t_) < M) ? (t_) : (M - 1); const u32x4* ip_ = (const u32x4*)(IDX + (size_t)tt_ * 128 + 16 * grp); \
        _Pragma("unroll") for (int q_ = 0; q_ < 4; ++q_) { const u32x4 v_ = ip_[q_]; idv[4 * q_] = (int)v_.x; idv[4 * q_ + 1] = (int)v_.y; idv[4 * q_ + 2] = (int)v_.z; idv[4 * q_ + 3] = (int)v_.w; } \
        const f32x4* xp_ = (const f32x4*)(X + (size_t)tt_ * D + col0); \
        _Pragma("unroll") for (int q_ = 0; q_ < 4; ++q_) { const f32x4 v_ = xp_[q_]; xv[4 * q_] = v_.x; xv[4 * q_ + 1] = v_.y; xv[4 * q_ + 2] = v_.z; xv[4 * q_ + 3] = v_.w; } } while (0)
#define PU_GATHER(ubv, idv) do { _Pragma("unroll") for (int it_ = 0; it_ < 16; ++it_) ubv[it_] = *(const u32x4*)(PU + (size_t)j * (PK * PK * 128) + (size_t)idv[it_] * 128 + 16 * sub); } while (0)
#define PU_COMPUTE(ubv, xv, t_) do { float k0_ = 0.f, k1_ = 0.f; _Pragma("unroll") for (int it_ = 0; it_ < 16; ++it_) { float a_ = dot16_fp8(xv, ubv[it_]); a_ = dpp_add_xor1(a_); a_ = dpp_add_xor2(a_); a_ = dpp_add_hmir(a_); \
            if (it_ < 8) k0_ = ((it_ & 7) == sub) ? a_ : k0_; else k1_ = ((it_ & 7) == sub) ? a_ : k1_; } \
        if ((t_) < M) { part[(size_t)(t_) * 128 + sub] = k0_; part[(size_t)(t_) * 128 + sub + 8] = k1_; } } while (0)
    int idA[16], idB[16]; float xA[16], xB[16], xc[16]; u32x4 ubA[16], ubB[16];
    int t = rank;
    PU_LOADIDX(idA, xA, t); PU_GATHER(ubA, idA);
    PU_LOADIDX(idB, xB, t + nrank);
    for (; t < M; t += 2 * nrank) {
        PU_GATHER(ubB, idB);
#pragma unroll
        for (int q = 0; q < 16; ++q) xc[q] = xA[q];
        PU_LOADIDX(idA, xA, t + 2 * nrank);
        PU_COMPUTE(ubA, xc, t);
        PU_GATHER(ubA, idA);
#pragma unroll
        for (int q = 0; q < 16; ++q) xc[q] = xB[q];
        PU_LOADIDX(idB, xB, t + 3 * nrank);
        PU_COMPUTE(ubB, xc, t + nrank);
    }
#undef PU_LOADIDX
#undef PU_GATHER
#undef PU_COMPUTE
}
__device__ __forceinline__ void v_wave(float* __restrict__ X, const unsigned char* __restrict__ PV, const int* __restrict__ IDX, const float* __restrict__ GATE, const float* __restrict__ PART, P2_LAS float* wbuf, int j, int rank, int nrank, int lane) {
    const int sub = lane & 7, grp = lane >> 3, col0 = 128 * j + 16 * sub;
    const bool h32 = (lane & 32) != 0, h16 = (lane & 16) != 0, h8 = (lane & 8) != 0; const int cq = ((lane >> 5) & 1) * 8 + ((lane >> 4) & 1) * 4 + ((lane >> 3) & 1) * 2;
#define PV_ISSUE(vbv, hv, gv, t_) do { const int tt_ = ((t_) < M) ? (t_) : (M - 1); int id_[16]; const u32x4* ip_ = (const u32x4*)(IDX + (size_t)tt_ * 128 + 16 * grp); \
        _Pragma("unroll") for (int q_ = 0; q_ < 4; ++q_) { const u32x4 v_ = ip_[q_]; id_[4 * q_] = (int)v_.x; id_[4 * q_ + 1] = (int)v_.y; id_[4 * q_ + 2] = (int)v_.z; id_[4 * q_ + 3] = (int)v_.w; } \
        _Pragma("unroll") for (int it_ = 0; it_ < 16; ++it_) vbv[it_] = *(const u32x4*)(PV + (size_t)j * (PK * PK * 128) + (size_t)id_[it_] * 128 + 16 * sub); \
        _Pragma("unroll") for (int jj_ = 0; jj_ < 8; ++jj_) { const float* pp_ = PART + ((size_t)jj_ * M + tt_) * 128; hv[2 * jj_] = pp_[lane]; hv[2 * jj_ + 1] = pp_[64 + lane]; } \
        gv[0] = GATE[(size_t)tt_ * 128 + lane]; gv[1] = GATE[(size_t)tt_ * 128 + 64 + lane]; } while (0)
#define PV_COMPUTE(vbv, hv, gv, t_) do { float h0_ = 0.f, h1_ = 0.f; _Pragma("unroll") for (int jj_ = 0; jj_ < 8; ++jj_) { h0_ += hv[2 * jj_]; h1_ += hv[2 * jj_ + 1]; } \
        h0_ *= (1.f / sp::PEER_SU); h1_ *= (1.f / sp::PEER_SU); \
        const float w0_ = gv[0] * 0.5f * h0_ * (1.f + erff(h0_ * 0.70710678118654752f)), w1_ = gv[1] * 0.5f * h1_ * (1.f + erff(h1_ * 0.70710678118654752f)); \
        f32x2v y_[8]; _Pragma("unroll") for (int q_ = 0; q_ < 8; ++q_) y_[q_] = (f32x2v){0.f, 0.f}; \
        wbuf[lane] = w0_; wbuf[64 + lane] = w1_; asm volatile("s_waitcnt lgkmcnt(0)" ::: "memory");        \
        float wl_[16]; _Pragma("unroll") for (int q_ = 0; q_ < 4; ++q_) { const f32x4 v_ = *(const P2_LAS f32x4*)(wbuf + 16 * grp + 4 * q_); wl_[4 * q_] = v_.x; wl_[4 * q_ + 1] = v_.y; wl_[4 * q_ + 2] = v_.z; wl_[4 * q_ + 3] = v_.w; } \
        asm volatile("s_waitcnt lgkmcnt(0)" ::: "memory"); \
        _Pragma("unroll") for (int it_ = 0; it_ < 16; ++it_) { const float wq_ = wl_[it_]; \
            const unsigned ww_[4] = {vbv[it_].x, vbv[it_].y, vbv[it_].z, vbv[it_].w}; const f32x2v wv_ = {wq_, wq_}; \
            _Pragma("unroll") for (int q_ = 0; q_ < 4; ++q_) { y_[2 * q_] = __builtin_elementwise_fma(wv_, __builtin_amdgcn_cvt_pk_f32_fp8((int)ww_[q_], false), y_[2 * q_]); y_[2 * q_ + 1] = __builtin_elementwise_fma(wv_, __builtin_amdgcn_cvt_pk_f32_fp8((int)ww_[q_], true), y_[2 * q_ + 1]); } } \
        float yy_[16]; _Pragma("unroll") for (int k_ = 0; k_ < 8; ++k_) { yy_[2 * k_] = y_[k_].x; yy_[2 * k_ + 1] = y_[k_].y; } \
          \
        float y8_[8], y4_[4], y2_[2]; \
        _Pragma("unroll") for (int k_ = 0; k_ < 8; ++k_) y8_[k_] = (h32 ? yy_[k_ + 8] : yy_[k_]) + __shfl_xor(h32 ? yy_[k_] : yy_[k_ + 8], 32); \
        _Pragma("unroll") for (int k_ = 0; k_ < 4; ++k_) y4_[k_] = (h16 ? y8_[k_ + 4] : y8_[k_]) + __shfl_xor(h16 ? y8_[k_] : y8_[k_ + 4], 16); \
        _Pragma("unroll") for (int k_ = 0; k_ < 2; ++k_) y2_[k_] = (h8 ? y4_[k_ + 2] : y4_[k_]) + dpp_ror8(h8 ? y4_[k_] : y4_[k_ + 2]); \
        if ((t_) < M) { f32x2v* xp_ = (f32x2v*)(X + (size_t)(t_) * D + col0 + cq); f32x2v xv_ = *xp_; \
            xv_.x = ALPHA * xv_.x + y2_[0] * (1.f / sp::PEER_SV); xv_.y = ALPHA * xv_.y + y2_[1] * (1.f / sp::PEER_SV); *xp_ = xv_; } } while (0)
    u32x4 vbA[16], vbB[16]; float hA[16], hB[16], gA[2], gB[2];
    int t = rank;
    PV_ISSUE(vbA, hA, gA, t);
    for (; t < M; t += 2 * nrank) {
        PV_ISSUE(vbB, hB, gB, t + nrank);
        PV_COMPUTE(vbA, hA, gA, t);
        PV_ISSUE(vbA, hA, gA, t + 2 * nrank);
        PV_COMPUTE(vbB, hB, gB, t + nrank);
    }
#undef PV_ISSUE
#undef PV_COMPUTE
}
__device__ __forceinline__ void ln_row_plain(float* __restrict__ X, const float* __restrict__ g, const float* __restrict__ b, int row, int lane) {
    f32x4* xr = (f32x4*)(X + (size_t)row * D) + lane;
    f32x4 v[4]; float s = 0.f;
#pragma unroll
    for (int jq = 0; jq < 4; ++jq) { v[jq] = xr[64 * jq]; s += (v[jq].x + v[jq].y) + (v[jq].z + v[jq].w); }
    const float mean = wave_sum(s) * (1.f / D); float s2 = 0.f;
#pragma unroll
    for (int jq = 0; jq < 4; ++jq) { v[jq] = v[jq] - mean; s2 += (v[jq].x * v[jq].x + v[jq].y * v[jq].y) + (v[jq].z * v[jq].z + v[jq].w * v[jq].w); }
    const float rstd = rsqrtf(wave_sum(s2) * (1.f / D) + 1e-5f);
#pragma unroll
    for (int jq = 0; jq < 4; ++jq) { const int c = 4 * lane + 256 * jq; const f32x4 gg = *(const f32x4*)(g + c), bb = *(const f32x4*)(b + c); xr[64 * jq] = v[jq] * rstd * gg + bb; }
}
}

struct Params { const float* in[30]; float* out; unsigned char* ws; };
template <class F> __device__ __forceinline__ void run_gemm(unsigned char* lds, const bf16_t* A, int lda, const bf16_t* Bt, int Mr, int N, int K, F f) {
    pg8::Gemm g{A, Bt, Mr, N, K, lda}; pg8::StaticOrder S; S.init(Mr, N, gridDim.x, blockIdx.x); pg8::EpiAdapt<F> E{f};
    pg8::gemm_phase<pg8::EpiAdapt<F>, pg8::StaticOrder, true>((PG8_LAS unsigned char*)lds, g, S, E);
}
#ifndef PROBE_ATTN
#define PROBE_ATTN 0
#endif
#ifndef PROBE_SSD
#define PROBE_SSD 0
#endif
#ifndef PROBE_SYNC
#define PROBE_SYNC 0
#endif
#define KA_LAS __attribute__((address_space(4)))
#define PH_BEGIN const KA_LAS unsigned char* ka_ = (const KA_LAS unsigned char*)__builtin_amdgcn_kernarg_segment_ptr(); asm volatile("" : "+s"(ka_))
#define PIN(k) (*(const float* const KA_LAS*)(ka_ + 8 * (k)))
#define POUT (*(float* const KA_LAS*)(ka_ + 240))
#define PWS (*(unsigned char* const KA_LAS*)(ka_ + 248))
__global__ void __launch_bounds__(512, 2) hybrid_fwd(Params P) {
    extern __shared__ __attribute__((aligned(16))) unsigned char lds[];
    cg::grid_group grid = cg::this_grid();
    { PH_BEGIN; volatile LAS unsigned* misc = (volatile LAS unsigned*)((LAS unsigned char*)lds + MISC_OFF);
      if (threadIdx.x < 16) misc[threadIdx.x] = 0u;
      __syncthreads();
      (void)xcd_barrier_post((unsigned*)(PWS + WS_CTL) + CW_BAR, misc);
      if (PWS == nullptr) grid.sync(); }
#define GSYNC() do { PH_BEGIN; XcdBarrier xb_; xb_.bar = (unsigned*)(PWS + WS_CTL) + CW_BAR; xb_.x = xb_xcc_id(); xb_.st = (volatile LAS unsigned*)((LAS unsigned char*)lds + MISC_OFF); xcd_barrier(xb_); } while (0)
    {
        PH_BEGIN; unsigned char* ws = PWS;
        const int tid = opaque_tid(), lane = tid & 63, wave = __builtin_amdgcn_readfirstlane(tid >> 6), c = blockIdx.x, G = gridDim.x;
        const size_t gtid = (size_t)c * 512 + tid, gthreads = (size_t)G * 512; const int gw = c * 8 + wave, NGW = G * 8;
        const float* w_in = PIN(2);
        bf16_t* WinT = (bf16_t*)(ws + WS_WIN); bf16_t* WckvT = (bf16_t*)(ws + WS_WCKV);
        SP_LAS float* scr = (SP_LAS float*)lds + wave * (64 * 33);
        constexpr int I0 = 2560, I1 = 5120, I2 = 6144, I3 = 6656, I4 = 7168, I5 = 7680, I6 = 8192, I7 = 8704, I8 = 9216, I9 = 10240;
        for (int it = gw; it < I9; it += NGW) {
            if (it < I0) sp::transpose_item(w_in, NIN, 0, D, 160, WinT, 0, scr, it, lane);
            else if (it < I1) sp::transpose_item(w_in, NIN, 5152, D, 160, WinT, 5120, scr, it - I0, lane);
            else if (it < I2) sp::transpose_item(PIN(9), D, 0, DI, 32, (bf16_t*)(ws + WS_WSSD), 0, scr, it - I1, lane);
            else if (it < I3) sp::transpose_item(PIN(13), D, 0, D, 32, (bf16_t*)(ws + WS_WDIFF), 0, scr, it - I2, lane);
            else if (it < I4) sp::transpose_item(PIN(15), D, 0, D, 32, (bf16_t*)(ws + WS_WO), 0, scr, it - I3, lane);
            else if (it < I5) sp::transpose_item(PIN(18), D, 0, D, 32, (bf16_t*)(ws + WS_WCQ), 0, scr, it - I4, lane);
            else if (it < I6) sp::transpose_item(PIN(19), D, 0, D, 32, WckvT, 0, scr, it - I5, lane);
            else if (it < I7) sp::transpose_item(PIN(20), D, 0, D, 32, WckvT, 1024, scr, it - I6, lane);
            else if (it < I8) sp::transpose_item(PIN(21), D, 0, D, 32, (bf16_t*)(ws + WS_WCO), 0, scr, it - I7, lane);
            else sp::transpose_item(PIN(24), 2048, 0, D, 64, (bf16_t*)(ws + WS_WPQ), 0, scr, it - I8, lane);
        }
        const float* x = PIN(0);
        sp::cvt_range(x, (bf16_t*)(ws + WS_XB), (size_t)M * D / 4, gtid, gthreads);
        sp::cvt_range(PIN(1), (bf16_t*)(ws + WS_MEMB), (size_t)BATCH * MEML * D / 4, gtid, gthreads);
        sp::cvt_range(PIN(25), (bf16_t*)(ws + WS_SUBK), (size_t)PH * 2 * PK * PHALF / 4, gtid, gthreads);
        __syncthreads();
        sp::dt_stage_w((SP_LAS float*)lds, w_in);
        for (int it = c; it < M / 4; it += G) sp::dt_item((SP_LAS float*)lds, (SP_LAS float*)lds + 32768, (SP_LAS float*)lds + 36896  , x, PIN(5), (float*)(ws + WS_DT), it);
        __syncthreads();
        if (c == 0 && tid == 0) { const float* lam_q = PIN(10); const float* lam_k = PIN(11); float s0 = 0.f, s1 = 0.f;
            for (int i = 0; i < 64; ++i) { s0 += lam_q[i] * lam_k[i]; s1 += lam_q[64 + i] * lam_k[64 + i]; }
            ((float*)(ws + WS_CTL))[CW_LAM] = expf(s0) - expf(s1) + LAMBDA_INIT; }
    }
    GSYNC();
    { PH_BEGIN; unsigned char* ws = PWS;
      run_gemm(lds, (const bf16_t*)(ws + WS_MEMB), D, (const bf16_t*)(ws + WS_WCKV), BATCH * MEML, D, D, EpiPlain{(bf16_t*)(ws + WS_KCVC), D, 1.f});
      for (int bb = 0; bb < BATCH; ++bb)
          run_gemm(lds, (const bf16_t*)(ws + WS_WCKV) + (size_t)D * D, D, (const bf16_t*)(ws + WS_MEMB) + (size_t)bb * MEML * D, D, MEML, D, EpiPlain{(bf16_t*)(ws + WS_KCVC) + (size_t)BATCH * MEML * D + (size_t)bb * D * MEML, MEML, 1.f});
      run_gemm(lds, (const bf16_t*)(ws + WS_XB), D, (const bf16_t*)(ws + WS_WIN), SEQ, NINP, D, EpiInProj{(bf16_t*)(ws + WS_H), PIN(14)}); }
    GSYNC();
#pragma unroll 1
    for (int b = 0; b < BATCH; ++b) {
        { PH_BEGIN; unsigned char* ws = PWS; const int c = blockIdx.x, G = gridDim.x;
          bf16_t* H = (bf16_t*)(ws + WS_H); const float* DTb = (const float*)(ws + WS_DT) + (size_t)b * SEQ * 32;
          for (int u = c; u < 256; u += G) ssd::phaseA_unit((SS_LAS unsigned char*)lds, H, DTb, PIN(3), PIN(4), PIN(6), (bf16_t*)(ws + WS_T1), (float*)(ws + WS_CTL) + 1024, u >> 2, u & 3);
          const float lam = ((const float*)(ws + WS_CTL))[CW_LAM]; const float* subln_w = PIN(12);
#if PROBE_ATTN
          for (int u = c; u < 256; u += G) { const int h = u >> 5, j = u & 31;
              dattn::unit<false>((DA_LAS unsigned char*)lds, H, h, 63 - j, subln_w, lam);
              dattn::unit<false>((DA_LAS unsigned char*)lds, H, h, j, subln_w, lam); }
#endif
          for (int u = c; u < 256; u += G) { const int h = u >> 5, j = u & 31;
              dattn::unit((DA_LAS unsigned char*)lds, H, h, 63 - j, subln_w, lam);
              dattn::unit((DA_LAS unsigned char*)lds, H, h, j, subln_w, lam); } }
        GSYNC();
        { PH_BEGIN; unsigned char* ws = PWS; const int tid = opaque_tid();
          for (size_t i = (size_t)blockIdx.x * 512 + tid; i < 131072; i += (size_t)gridDim.x * 512) ssd::scan_phase((bf16_t*)(ws + WS_T1), (const float*)(ws + WS_CTL) + 1024, (int)i); }
        GSYNC();
        { PH_BEGIN; unsigned char* ws = PWS; const int c = blockIdx.x, G = gridDim.x;
#if PROBE_SSD
          for (int u = c; u < 256; u += G) ssd::phaseA_unit((SS_LAS unsigned char*)lds, (bf16_t*)(ws + WS_H), (const float*)(ws + WS_DT) + (size_t)b * SEQ * 32, PIN(3), PIN(4), PIN(6), (bf16_t*)(POUT + (size_t)SEQ * D), (float*)(ws + WS_CTL) + 8192, u >> 2, u & 3);
          for (int u = c; u < 256; u += G) ssd::phaseC_unit<false>((SS_LAS unsigned char*)lds, (bf16_t*)(ws + WS_H), (const float*)(ws + WS_DT) + (size_t)b * SEQ * 32, PIN(3), PIN(4), PIN(6), PIN(7), PIN(8), (const bf16_t*)(ws + WS_T1), u >> 2, u & 3);
#endif
          for (int u = c; u < 256; u += G) ssd::phaseC_unit((SS_LAS unsigned char*)lds, (bf16_t*)(ws + WS_H), (const float*)(ws + WS_DT) + (size_t)b * SEQ * 32, PIN(3), PIN(4), PIN(6), PIN(7), PIN(8), (const bf16_t*)(ws + WS_T1), u >> 2, u & 3); }
        GSYNC();
        { PH_BEGIN; unsigned char* ws = PWS; bf16_t* H = (bf16_t*)(ws + WS_H); float* T1 = (float*)(ws + WS_T1);
          run_gemm(lds, H + HC_Z, HP_, (const bf16_t*)(ws + WS_WSSD), SEQ, D, DI, EpiGate1{H, T1});
          run_gemm(lds, H + HC_Q, HP_, (const bf16_t*)(ws + WS_WDIFF), SEQ, D, D, EpiGate2{H, T1});
          if (b == BATCH - 1 && 2 * (int)blockIdx.x >= (int)gridDim.x) { const int tid = opaque_tid(); const int half = (gridDim.x + 1) / 2;
              const size_t gt = (size_t)(blockIdx.x - half) * 512 + tid, gn = (size_t)(gridDim.x - half) * 512;
              sp::cvt_fp8_range(PIN(26), ws + WS_PU, (size_t)PK * PK * D / 16, sp::PEER_SU, gt, gn);
              sp::cvt_fp8_range(PIN(27), ws + WS_PV, (size_t)PK * PK * D / 16, sp::PEER_SV, gt, gn); } }
        GSYNC();
        { PH_BEGIN; unsigned char* ws = PWS;
          run_gemm(lds, (const bf16_t*)(ws + WS_H) + HC_K, HP_, (const bf16_t*)(ws + WS_WO), SEQ, D, D, EpiResid{PIN(0), POUT, b * SEQ, 0}); }
        GSYNC();
        if (b + 1 < BATCH) {
            { PH_BEGIN; unsigned char* ws = PWS;
              run_gemm(lds, (const bf16_t*)(ws + WS_XB) + (size_t)(b + 1) * SEQ * D, D, (const bf16_t*)(ws + WS_WIN), SEQ, NINP, D, EpiInProj{(bf16_t*)(ws + WS_H), PIN(14)}); }
            GSYNC();
        }
    }
    { PH_BEGIN; unsigned char* ws = PWS; const int tid = opaque_tid(), lane = tid & 63, wave = __builtin_amdgcn_readfirstlane(tid >> 6), c = blockIdx.x, G = gridDim.x;
      float* out = POUT; const float* g = PIN(16); const float* bb = PIN(17); bf16_t* XB = (bf16_t*)(ws + WS_X1B);
      for (int r = c * 8 + wave; r < M; r += G * 8) sp::ln_row(out, g, bb, XB, r, lane); }
    GSYNC();
    { PH_BEGIN; unsigned char* ws = PWS;
      run_gemm(lds, (const bf16_t*)(ws + WS_X1B), D, (const bf16_t*)(ws + WS_WCQ), M, D, D, EpiPlain{(bf16_t*)(ws + WS_QC), D, CQSCALE}); }
    GSYNC();
    { PH_BEGIN; unsigned char* ws = PWS; const int c = blockIdx.x, G = gridDim.x;
      for (int u = c; u < 256; u += G) xattn::unit((XA_LAS unsigned char*)lds, (const bf16_t*)(ws + WS_QC), (const bf16_t*)(ws + WS_KCVC), (const bf16_t*)(ws + WS_KCVC) + (size_t)BATCH * MEML * D, (bf16_t*)(ws + WS_XO), u >> 2, u & 3); }
    GSYNC();
    { PH_BEGIN; unsigned char* ws = PWS; float* out = POUT;
      run_gemm(lds, (const bf16_t*)(ws + WS_XO), D, (const bf16_t*)(ws + WS_WCO), M, D, D, EpiResid{out, out, 0, 0}); }
    GSYNC();
    { PH_BEGIN; unsigned char* ws = PWS; const int tid = opaque_tid(), lane = tid & 63, wave = __builtin_amdgcn_readfirstlane(tid >> 6), c = blockIdx.x, G = gridDim.x;
      float* out = POUT; const float* g = PIN(22); const float* bb = PIN(23); bf16_t* XB = (bf16_t*)(ws + WS_X1B);
      for (int r = c * 8 + wave; r < M; r += G * 8) sp::ln_row(out, g, bb, XB, r, lane); }
    GSYNC();
    { PH_BEGIN; unsigned char* ws = PWS;
      run_gemm(lds, (const bf16_t*)(ws + WS_X1B), D, (const bf16_t*)(ws + WS_WPQ), M, 2048, D, EpiPlain{(bf16_t*)(ws + WS_QP), 2048, 1.f}); }
    GSYNC();
    { PH_BEGIN; unsigned char* ws = PWS; const int c = blockIdx.x, G = gridDim.x;
      for (int t = 64 * c; t < M; t += 64 * G) {
          for (int hp = 0; hp < 4; ++hp) psel::stage1((PS_LAS int*)lds, (const bf16_t*)(ws + WS_QP), (const bf16_t*)(ws + WS_SUBK), t, hp);
          __syncthreads();
          psel::stage2((PS_LAS int*)lds, (int*)(ws + WS_IDX), (float*)(ws + WS_GATE), t);
          __syncthreads(); } }
    GSYNC();
    { PH_BEGIN; unsigned char* ws = PWS; const int tid = opaque_tid(), lane = tid & 63, wave = __builtin_amdgcn_readfirstlane(tid >> 6);
      const peer2::Own o = peer2::ownership((unsigned*)(ws + WS_CTL), (P2_LAS unsigned*)lds, 0, wave);
      for (int jj = o.j; jj < 8; jj += o.nsl) peer2::u_wave(POUT, ws + WS_PU, (const int*)(ws + WS_IDX), (float*)(ws + WS_PART), jj, o.rank, o.nrank, lane); }
    GSYNC();
    { PH_BEGIN; unsigned char* ws = PWS; const int tid = opaque_tid(), lane = tid & 63, wave = __builtin_amdgcn_readfirstlane(tid >> 6);
      const peer2::Own o = peer2::ownership((unsigned*)(ws + WS_CTL), (P2_LAS unsigned*)lds, 1, wave);
      for (int jj = o.j; jj < 8; jj += o.nsl) peer2::v_wave(POUT, ws + WS_PV, (const int*)(ws + WS_IDX), (const float*)(ws + WS_GATE), (const float*)(ws + WS_PART), (P2_LAS float*)lds + 64 + wave * 128, jj, o.rank, o.nrank, lane); }
    GSYNC();
    { PH_BEGIN; const int tid = opaque_tid(), lane = tid & 63, wave = __builtin_amdgcn_readfirstlane(tid >> 6);
      float* out = POUT; const float* g3 = PIN(28); const float* b3 = PIN(29);
      for (int r = blockIdx.x * 8 + wave; r < M; r += gridDim.x * 8) peer2::ln_row_plain(out, g3, b3, r, lane); }
}

extern "C" void kernel_launch(void* const* d_in, const int* in_sizes, int n_in, void* d_out, int out_size, void* d_ws, size_t ws_size, hipStream_t stream) {
    static int grid_blocks = 0;
    if (grid_blocks == 0) {
        if (n_in != 30 || out_size != M * D || ws_size < WS_END) { fprintf(stderr, "kernel_launch: unexpected sizes n_in %d out %d ws %zu (need %zu)\n", n_in, out_size, ws_size, (size_t)WS_END); grid_blocks = -1; return; }
        int dev = 0, cus = 0, per_cu = 0;
        (void)hipGetDevice(&dev); (void)hipDeviceGetAttribute(&cus, hipDeviceAttributeMultiprocessorCount, dev);
        (void)hipFuncSetAttribute((const void*)hybrid_fwd, hipFuncAttributeMaxDynamicSharedMemorySize, LDS_BYTES);
        if (hipOccupancyMaxActiveBlocksPerMultiprocessor(&per_cu, (const void*)hybrid_fwd, 512, LDS_BYTES) != hipSuccess || per_cu < 1) { fprintf(stderr, "kernel_launch: occupancy query failed (%d)\n", per_cu); per_cu = 1; }
        (void)hipGetLastError();
        grid_blocks = cus * 1;
    }
    if (grid_blocks < 0) return;
    if (hipMemsetAsync(d_ws, 0, 65536, stream) != hipSuccess) { fprintf(stderr, "kernel_launch: memset of control words failed\n"); return; }
    Params p{};
    for (int i = 0; i < 30; ++i) p.in[i] = (const float*)d_in[i];
    p.out = (float*)d_out; p.ws = (unsigned char*)d_ws;
    void* args[] = {&p};
    hipError_t e = hipLaunchCooperativeKernel((const void*)hybrid_fwd, dim3(grid_blocks), dim3(512), args, LDS_BYTES, stream);
    if (e != hipSuccess) fprintf(stderr, "cooperative launch failed: %s (grid %d)\n", hipGetErrorString(e), grid_blocks);
}
```

```cpp
#include <hip/hip_runtime.h>
#include <hip/hip_cooperative_groups.h>
namespace cg = cooperative_groups;
#include <cstdio>
#include <cstdint>
#include <cmath>
#include <type_traits>

typedef unsigned short bf16_t;
typedef float f32x4 __attribute__((ext_vector_type(4)));
typedef unsigned u32x4 __attribute__((ext_vector_type(4)));
typedef unsigned u32x2 __attribute__((ext_vector_type(2)));

constexpr int D = 1024, BATCH = 2, SEQ = 8192, M = BATCH * SEQ;
constexpr int DI = 2048, NH = 32, HP = 64, NG = 4, DS = 128, DXBC = 3072;
constexpr int AH = 8, AD = 64, AV = 128;
constexpr int MEML = 256, MH = 4, MHD = 256;
constexpr int PH = 8, PK = 128, PDK = 256, PHALF = 128, PTOP = 16;
constexpr int NIN = 10272, NINP = 10240;
constexpr float ALPHA = 1.189207115002721f;
constexpr float LOG2E = 1.4426950408889634f;
constexpr float QSCALE = 0.125f * LOG2E;
constexpr float CQSCALE = 0.0625f * LOG2E;
constexpr float LAMBDA_INIT = 0.2f;
constexpr int HC_Z = 0, HC_XBC = 2048, HC_Q = 5120, HC_K = 6144, HC_V = 7168, HC_GS = 8192, HC_GA = 9216, HP_ = NINP;

constexpr size_t MiB = 1u << 20;
constexpr size_t WS_CTL = 0;
constexpr size_t WS_WIN = 1 * MiB;
constexpr size_t WS_WSSD = 21 * MiB;
constexpr size_t WS_WDIFF = 25 * MiB, WS_WO = 27 * MiB, WS_WCQ = 29 * MiB, WS_WCKV = 31 * MiB  , WS_WCO = 35 * MiB;
constexpr size_t WS_WPQ = 37 * MiB;
constexpr size_t WS_SUBK = 41 * MiB;
constexpr size_t WS_MEMB = 42 * MiB;
constexpr size_t WS_KCVC = 43 * MiB;
constexpr size_t WS_DT = 45 * MiB;
constexpr size_t WS_XB = 47 * MiB;
constexpr size_t WS_H = 79 * MiB;
constexpr size_t WS_T1 = 239 * MiB;
constexpr size_t WS_PU = 47 * MiB, WS_PV = 63 * MiB;
constexpr size_t WS_X1B = 79 * MiB;
constexpr size_t WS_QC = 143 * MiB, WS_XO = 175 * MiB;
constexpr size_t WS_QP = 207 * MiB;
constexpr size_t WS_IDX = 143 * MiB, WS_GATE = 151 * MiB;
constexpr size_t WS_PART = 207 * MiB;
constexpr size_t WS_END = 271 * MiB;
constexpr int CW_LAM = 64;

__device__ __forceinline__ int opaque_tid() { int t = threadIdx.x; asm volatile("" : "+v"(t)); return t; }
__device__ __forceinline__ unsigned f2bf(float f) { unsigned u = __builtin_bit_cast(unsigned, f); return (u + 0x7fffu + ((u >> 16) & 1u)) >> 16; }
__device__ __forceinline__ float bf2f(unsigned h) { return __builtin_bit_cast(float, h << 16); }
__device__ __forceinline__ unsigned pk2(float lo, float hi) { return f2bf(lo) | (f2bf(hi) << 16); }
__device__ __forceinline__ float bflo(unsigned w) { return __builtin_bit_cast(float, w << 16); }
__device__ __forceinline__ float bfhi(unsigned w) { return __builtin_bit_cast(float, w & 0xffff0000u); }
__device__ __forceinline__ float sigmoidf_(float v) { return __builtin_amdgcn_rcpf(1.f + __expf(-v)); }
__device__ __forceinline__ float siluf_(float v) { return v * __builtin_amdgcn_rcpf(1.f + __expf(-v)); }
__device__ __forceinline__ float wave_sum(float v) {
#pragma unroll
    for (int o = 1; o < 64; o <<= 1) v += __shfl_xor(v, o);
    return v;
}
__device__ __forceinline__ float wave_max(float v) {
#pragma unroll
    for (int o = 1; o < 64; o <<= 1) v = fmaxf(v, __shfl_xor(v, o));
    return v;
}

__device__ __forceinline__ void store_bf16x8(bf16_t* p, const float (&v)[8]) { u32x4 w; w.x = pk2(v[0], v[1]); w.y = pk2(v[2], v[3]); w.z = pk2(v[4], v[5]); w.w = pk2(v[6], v[7]); *(u32x4*)p = w; }
struct EpiPlain { bf16_t* O; int ldc; float scale;
    __device__ __forceinline__ void operator()(int row, int col0, const float (&v)[8]) const { float o[8];
#pragma unroll
        for (int j = 0; j < 8; ++j) o[j] = v[j] * scale; store_bf16x8(O + (size_t)row * ldc + col0, o); } };
struct EpiInProj { bf16_t* H; const float* gate_bias;
    __device__ __forceinline__ void operator()(int row, int col0, const float (&v)[8]) const { float o[8];
        if (col0 >= HC_GS) { const float* gb = gate_bias + (col0 - HC_GS);
#pragma unroll
            for (int j = 0; j < 8; ++j) o[j] = sigmoidf_(v[j] + gb[j]); }
        else { const float s = (col0 >= HC_Q && col0 < HC_K) ? QSCALE : 1.f;
#pragma unroll
            for (int j = 0; j < 8; ++j) o[j] = v[j] * s; }
        store_bf16x8(H + (size_t)row * HP_ + col0, o); } };
struct EpiGate1 { const bf16_t* H; float* T1;
    __device__ __forceinline__ void operator()(int row, int col0, const float (&v)[8]) const {
        const u32x4 g = *(const u32x4*)(H + (size_t)row * HP_ + HC_GS + col0); const unsigned gw[4] = {g.x, g.y, g.z, g.w};
        float* t = T1 + (size_t)row * D + col0;
#pragma unroll
        for (int j = 0; j < 4; ++j) { t[2 * j] = bflo(gw[j]) * v[2 * j]; t[2 * j + 1] = bfhi(gw[j]) * v[2 * j + 1]; } } };
struct EpiGate2 { bf16_t* H; const float* T1;
    __device__ __forceinline__ void operator()(int row, int col0, const float (&v)[8]) const {
        const u32x4 g = *(const u32x4*)(H + (size_t)row * HP_ + HC_GA + col0); const unsigned gw[4] = {g.x, g.y, g.z, g.w};
        const float* t = T1 + (size_t)row * D + col0; float o[8];
#pragma unroll
        for (int j = 0; j < 4; ++j) { o[2 * j] = t[2 * j] + bflo(gw[j]) * v[2 * j]; o[2 * j + 1] = t[2 * j + 1] + bfhi(gw[j]) * v[2 * j + 1]; }
        store_bf16x8(H + (size_t)row * HP_ + HC_K + col0, o); } };
struct EpiResid { const float* base; float* out; int row_off; int pad_;
    __device__ __forceinline__ void operator()(int row, int col0, const float (&v)[8]) const {
        const size_t o = (size_t)(row + row_off) * D + col0;
#pragma unroll
        for (int j = 0; j < 8; ++j) out[o + j] = ALPHA * base[o + j] + v[j]; } };


namespace pg8 {
#define PG8_LAS __attribute__((address_space(3)))
typedef short bf16x8 __attribute__((ext_vector_type(8)));
constexpr int BM = 256, BK = 64, HALF = 128, HTB = HALF * BK * 2, STAGE_BYTES = 8 * HTB, NXCD = 8, WGM = 8;
__host__ __device__ __forceinline__ int lds_byte(int r, int c) { const int st = (r >> 4) * 2 + (c >> 5), rr = r & 15, cc = c & 31, ob = rr * 64 + cc * 2; return st * 1024 + (ob ^ (((ob >> 9) & 1) << 5)); }
__host__ __device__ __forceinline__ void stage_rc(int b, int& R, int& C) { const int st = b / 1024, sb = b % 1024, swz = sb ^ (((sb >> 9) & 1) << 5); R = (st >> 1) * 16 + swz / 64; C = (st & 1) * 32 + (swz % 64) / 2; }
__host__ __device__ __forceinline__ int perm32(int rho) { const int n = rho >> 4, i = rho & 15; return 8 * (i >> 2) + 4 * n + (i & 3); }
struct Unit { int pm, pn; };
struct Gemm { const bf16_t* A; const bf16_t* Bt; int M, N, K, lda; };
struct StaticOrder {
    int nM, nN, nwg, G, c;
    __host__ __device__ void init(int M, int N, int G_, int c_) { nM = M / BM; nN = N / BM; nwg = nM * nN; G = G_; c = c_; }
    __host__ __device__ bool next(int i, Unit& u) const {
        const long L = (long)i * G + c; if (L >= nwg) return false;
        int wgid = (int)L; { const int q = nwg / NXCD, r = nwg % NXCD, xcd = wgid % NXCD, off = wgid / NXCD; wgid = (xcd < r ? xcd * (q + 1) : r * (q + 1) + (xcd - r) * q) + off; }
        const int nig = WGM * nN, gid = wgid / nig, fm = gid * WGM, gsz = (nM - fm) < WGM ? (nM - fm) : WGM;
        u.pm = fm + ((wgid % nig) % gsz); u.pn = (wgid % nig) / gsz; return true;
    }
};
template <class F> struct EpiAdapt {
    static constexpr bool PERM = true, AFTER_DRAIN = false; F f;
    __device__ __forceinline__ void operator()(const f32x4 (&acc)[2][2][4][2], const Unit& u, int wr, int wc, int fr, int fq) const {
#pragma unroll
        for (int ai = 0; ai < 2; ++ai)
#pragma unroll
            for (int m = 0; m < 4; ++m) { const int row = u.pm * BM + ai * HALF + wr * 64 + m * 16 + fr;
#pragma unroll
                for (int bj = 0; bj < 2; ++bj) { const int col0 = u.pn * BM + bj * HALF + wc * 32 + 8 * fq;
                    const f32x4 a = acc[ai][bj][m][0], b = acc[ai][bj][m][1]; const float v[8] = {a[0], a[1], a[2], a[3], b[0], b[1], b[2], b[3]};
                    f(row, col0, v); } }
    }
};
template <class Epi, class Sched, bool ALIGN_EPI>
__device__ __forceinline__ void gemm_phase(PG8_LAS unsigned char* lds, const Gemm g, const Sched& S, const Epi& E) {
    const int tid = opaque_tid(), wid = __builtin_amdgcn_readfirstlane(tid >> 6), lane = tid & 63, wr = wid >> 2, wc = wid & 3, fr = lane & 15, fq = lane >> 4;
    const int K = g.K, nt = K / BK, lda = g.lda;
    unsigned voffA[2], voffB[2];
#pragma unroll
    for (int i = 0; i < 2; ++i) { int R, C; stage_rc(tid * 16 + i * 8192, R, C); const int Rb = Epi::PERM ? ((R & ~31) + perm32(R & 31)) : R;
        voffA[i] = (unsigned)(R * lda + C) * 2u; voffB[i] = (unsigned)(Rb * K + C) * 2u; }
    const size_t kstep = (size_t)(BK * 2);
    const size_t hstepA = (size_t)HALF * lda * 2, hstepB = (size_t)HALF * K * 2;
    const size_t tstepA = 2 * hstepA, tstepB = 2 * hstepB;
    const unsigned ldsw = (unsigned)wid * 1024u;
    const int aoff = lds_byte(wr * 64 + fr, fq * 8), boff = lds_byte(wc * 32 + fr, fq * 8);
#define PG8_SA(b, h) (((b) * 2 + (h)) * HTB)
#define PG8_SB(b, h) ((4 + (b) * 2 + (h)) * HTB)
#define PG8_STAGE(bufoff, gbase, voff) do { _Pragma("unroll") for (int _i = 0; _i < 2; ++_i) \
        __builtin_amdgcn_global_load_lds((const unsigned*)((const char*)(gbase) + (voff)[_i]), (PG8_LAS unsigned*)(lds + (bufoff) + ldsw + _i * 8192), 16, 0, 0); } while (0)
#define PG8_LDA(dst, b, h) do { _Pragma("unroll") for (int m = 0; m < 4; ++m) _Pragma("unroll") for (int k = 0; k < 2; ++k) dst[m][k] = *(const PG8_LAS bf16x8*)(lds + PG8_SA(b, h) + aoff + m * 2048 + k * 1024); } while (0)
#define PG8_LDB(dst, b, h) do { _Pragma("unroll") for (int n = 0; n < 2; ++n) _Pragma("unroll") for (int k = 0; k < 2; ++k) dst[n][k] = *(const PG8_LAS bf16x8*)(lds + PG8_SB(b, h) + boff + n * 2048 + k * 1024); } while (0)
#define PG8_MMA(ai, bj, At, Bt) do { __builtin_amdgcn_s_setprio(1); _Pragma("unroll") for (int m = 0; m < 4; ++m) _Pragma("unroll") for (int n = 0; n < 2; ++n) _Pragma("unroll") for (int k = 0; k < 2; ++k) \
        acc[ai][bj][m][n] = __builtin_amdgcn_mfma_f32_16x16x32_bf16(Bt[n][k], At[m][k], acc[ai][bj][m][n], 0, 0, 0); __builtin_amdgcn_s_setprio(0); } while (0)
#define PG8_WAIT_V(n) asm volatile("s_waitcnt vmcnt(" #n ")" ::: "memory")
#define PG8_WAIT_L(n) asm volatile("s_waitcnt lgkmcnt(" #n ")" ::: "memory")
#define PG8_BAR __builtin_amdgcn_s_barrier()
#define PG8_SCHED __builtin_amdgcn_sched_barrier(0)
    Unit cur, nxt; int ui = 0;
    if (!S.next(0, cur)) return;
    f32x4 acc[2][2][4][2];
#pragma unroll
    for (int a = 0; a < 2; ++a)
#pragma unroll
        for (int b = 0; b < 2; ++b)
#pragma unroll
            for (int m = 0; m < 4; ++m)
#pragma unroll
                for (int n = 0; n < 2; ++n) acc[a][b][m][n] = (f32x4){0.f, 0.f, 0.f, 0.f};
    bf16x8 At[4][2], B0[2][2], B1[2][2];
    const char* cA = (const char*)g.A + (size_t)cur.pm * tstepA; const char* cB = (const char*)g.Bt + (size_t)cur.pn * tstepB;
    PG8_STAGE(PG8_SB(0, 0), cB, voffB); PG8_STAGE(PG8_SB(0, 1), cB + hstepB, voffB); PG8_STAGE(PG8_SA(0, 0), cA, voffA); PG8_STAGE(PG8_SA(0, 1), cA + hstepA, voffA);
    if (wr == 1) PG8_BAR;
    PG8_WAIT_V(2); PG8_BAR;
    PG8_STAGE(PG8_SB(1, 0), cB + kstep, voffB); PG8_STAGE(PG8_SA(1, 0), cA + kstep, voffA); PG8_STAGE(PG8_SB(1, 1), cB + hstepB + kstep, voffB);
    PG8_WAIT_V(6); PG8_BAR;
    for (;;) {
        const bool has_next = S.next(ui + 1, nxt);
        const char* nA = has_next ? (const char*)g.A + (size_t)nxt.pm * tstepA : cA; const char* nB = has_next ? (const char*)g.Bt + (size_t)nxt.pn * tstepB : cB;
        for (int t = 0; t < nt; t += 2) {
            const bool last = (t == nt - 2);
            const char* a1 = cA + (size_t)(t + 1) * kstep;
            const char* a2 = last ? nA : cA + (size_t)(t + 2) * kstep; const char* b2 = last ? nB : cB + (size_t)(t + 2) * kstep;
            const char* a3 = a2 + kstep; const char* b3 = b2 + kstep;
            PG8_LDB(B0, 0, 0); PG8_LDB(B1, 0, 1); PG8_SCHED; PG8_LDA(At, 0, 0); PG8_STAGE(PG8_SA(1, 1), a1 + hstepA, voffA);
            PG8_WAIT_V(8); PG8_WAIT_L(0); PG8_BAR; PG8_MMA(0, 0, At, B0); PG8_MMA(0, 1, At, B1); PG8_BAR; PG8_SCHED;
            PG8_LDA(At, 0, 1); PG8_STAGE(PG8_SB(0, 0), b2, voffB); PG8_STAGE(PG8_SB(0, 1), b2 + hstepB, voffB); PG8_STAGE(PG8_SA(0, 0), a2, voffA);
            PG8_WAIT_V(8); PG8_WAIT_L(0); PG8_BAR; PG8_MMA(1, 0, At, B0); PG8_MMA(1, 1, At, B1); PG8_BAR; PG8_SCHED;
            PG8_LDB(B0, 1, 0); PG8_LDB(B1, 1, 1); PG8_SCHED; PG8_LDA(At, 1, 0); PG8_STAGE(PG8_SA(0, 1), a2 + hstepA, voffA);
            PG8_WAIT_V(8); PG8_WAIT_L(0); PG8_BAR; PG8_MMA(0, 0, At, B0); PG8_MMA(0, 1, At, B1); PG8_BAR; PG8_SCHED;
            PG8_LDA(At, 1, 1); PG8_STAGE(PG8_SB(1, 0), b3, voffB); PG8_STAGE(PG8_SB(1, 1), b3 + hstepB, voffB); PG8_STAGE(PG8_SA(1, 0), a3, voffA);
            PG8_WAIT_V(8); PG8_WAIT_L(0); PG8_BAR; PG8_MMA(1, 0, At, B0); PG8_MMA(1, 1, At, B1); PG8_BAR; PG8_SCHED;
        }
        if constexpr (ALIGN_EPI) { if (wr == 0) PG8_BAR; }
        E(acc, cur, wr, wc, fr, fq);
        if (!has_next) break;
#pragma unroll
        for (int a = 0; a < 2; ++a)
#pragma unroll
            for (int b = 0; b < 2; ++b)
#pragma unroll
                for (int m = 0; m < 4; ++m)
#pragma unroll
                    for (int n = 0; n < 2; ++n) acc[a][b][m][n] = (f32x4){0.f, 0.f, 0.f, 0.f};
        cur = nxt; cA = nA; cB = nB; ++ui;
        if constexpr (ALIGN_EPI) { if (wr == 1) PG8_BAR; }
    }
    PG8_WAIT_V(0);
    if constexpr (!ALIGN_EPI) { if (wr == 0) PG8_BAR; }
    PG8_BAR;
#undef PG8_SA
#undef PG8_SB
#undef PG8_STAGE
#undef PG8_LDA
#undef PG8_LDB
#undef PG8_MMA
#undef PG8_WAIT_V
#undef PG8_WAIT_L
#undef PG8_BAR
#undef PG8_SCHED
}
}
constexpr int LDS_BYTES = 148480;
namespace dattn {
#define DA_LAS __attribute__((address_space(3)))
typedef short bf16x8 __attribute__((ext_vector_type(8)));
typedef short s16x4 __attribute__((ext_vector_type(4)));
typedef float f32x16 __attribute__((ext_vector_type(16)));
constexpr int KP = 272, VP = 320, KBUF = 64 * KP, VBUF = 64 * VP, BUF = KBUF + VBUF, XOFF = 2 * BUF, LDS_NEED = XOFF + 65536;
static_assert(LDS_NEED <= 147456, "attention LDS");
__device__ __forceinline__ unsigned cvtpk(float lo, float hi) { typedef float f2 __attribute__((ext_vector_type(2))); typedef __bf16 b2 __attribute__((ext_vector_type(2))); f2 v = {lo, hi}; b2 b = __builtin_convertvector(v, b2); return __builtin_bit_cast(unsigned, b); }
__device__ __forceinline__ s16x4 vtr(const DA_LAS unsigned char* p) { typedef short v4i16_t __attribute__((ext_vector_type(4))); return __builtin_bit_cast(s16x4, __builtin_amdgcn_ds_read_tr16_b64_v4i16((DA_LAS v4i16_t*)p)); }
template <bool STORE = true> __device__ __forceinline__ void unit(DA_LAS unsigned char* lds, bf16_t* Hb, int h, int qb, const float* __restrict__ subln_w, float lam) {
    const int tid = opaque_tid(), lane = tid & 63, w = __builtin_amdgcn_readfirstlane(tid >> 6), mp = w >> 2, rb = w & 3, c32 = lane & 31, hh = lane >> 5;
    const int qrow = 128 * qb + 32 * rb + c32;
    bf16x8 qf[4];
    { const bf16_t* qp = Hb + (size_t)qrow * HP_ + HC_Q + h * 128 + 64 * mp + 8 * hh;
#pragma unroll
      for (int s = 0; s < 4; ++s) qf[s] = *(const bf16x8*)(qp + 16 * s); }
    const int srow = tid >> 4, sch = tid & 15;
    const bf16_t* kg = Hb + HC_K + h * 128 + sch * 8; const bf16_t* vg = Hb + HC_V + h * 128 + sch * 8;
    const int nt = 2 * qb + 2;
    u32x4 kr[2], vr[2];
#define DA_LOAD(t) do { _Pragma("unroll") for (int j = 0; j < 2; ++j) { const size_t ro = (size_t)(64 * (t) + srow + 32 * j) * HP_; kr[j] = *(const u32x4*)(kg + ro); vr[j] = *(const u32x4*)(vg + ro); } } while (0)
#define DA_WRITE(buf) do { _Pragma("unroll") for (int j = 0; j < 2; ++j) { *(DA_LAS u32x4*)(lds + (buf) * BUF + (srow + 32 * j) * KP + sch * 16) = kr[j]; *(DA_LAS u32x4*)(lds + (buf) * BUF + KBUF + (srow + 32 * j) * VP + sch * 16) = vr[j]; } } while (0)
    DA_LOAD(0); DA_WRITE(0);
    __syncthreads();
    f32x16 oT[4];
#pragma unroll
    for (int i = 0; i < 4; ++i) oT[i] = (f32x16){0.f, 0.f, 0.f, 0.f, 0.f, 0.f, 0.f, 0.f, 0.f, 0.f, 0.f, 0.f, 0.f, 0.f, 0.f, 0.f};
    float lrow = 0.f;
    f32x16 negm = (f32x16){0.f, 0.f, 0.f, 0.f, 0.f, 0.f, 0.f, 0.f, 0.f, 0.f, 0.f, 0.f, 0.f, 0.f, 0.f, 0.f};
    const int koff = c32 * KP + (64 * mp + 8 * hh) * 2;
    const int voff = KBUF + (4 * hh + ((lane & 15) >> 2)) * VP + (16 * ((lane >> 4) & 1) + 4 * (lane & 3)) * 2;
    for (int t = 0; t < nt; ++t) {
        const int cur = t & 1;
        if (t + 1 < nt) DA_LOAD(t + 1);
        if (!(t == nt - 1 && rb <= 1)) {
            const DA_LAS unsigned char* kb = lds + cur * BUF + koff;
            f32x16 s0 = negm, s1 = negm;
            bf16x8 kf0[4], kf1[4];
#pragma unroll
            for (int s = 0; s < 4; ++s) { kf0[s] = *(const DA_LAS bf16x8*)(kb + s * 32); kf1[s] = *(const DA_LAS bf16x8*)(kb + 32 * KP + s * 32); }
            __builtin_amdgcn_s_setprio(1);
#pragma unroll
            for (int s = 0; s < 4; ++s) {
                s0 = __builtin_amdgcn_mfma_f32_32x32x16_bf16(kf0[s], qf[s], s0, 0, 0, 0);
                s1 = __builtin_amdgcn_mfma_f32_32x32x16_bf16(kf1[s], qf[s], s1, 0, 0, 0);
            }
            __builtin_amdgcn_s_setprio(0);
            if (t >= nt - 2) {
                const int k0 = 64 * t + 4 * hh;
#pragma unroll
                for (int r = 0; r < 16; ++r) { const int key = k0 + (r & 3) + 8 * (r >> 2); if (key > qrow) s0[r] = -INFINITY; if (key + 32 > qrow) s1[r] = -INFINITY; }
            }
            float mxa = fmaxf(fmaxf(s0[0], s0[1]), s1[0]), mxb = fmaxf(fmaxf(s0[2], s0[3]), s1[1]);
            mxa = fmaxf(fmaxf(mxa, s1[2]), s1[3]);
#pragma unroll
            for (int r = 4; r < 16; r += 4) { mxa = fmaxf(fmaxf(mxa, s0[r]), s0[r + 1]); mxb = fmaxf(fmaxf(mxb, s0[r + 2]), s0[r + 3]); mxa = fmaxf(fmaxf(mxa, s1[r]), s1[r + 1]); mxb = fmaxf(fmaxf(mxb, s1[r + 2]), s1[r + 3]); }
            float mx = fmaxf(mxa, mxb);
            mx = fmaxf(mx, __shfl_xor(mx, 32));
            if (__any(mx > 8.f)) {
                const float dl = fmaxf(mx, 0.f), alpha = __builtin_amdgcn_exp2f(-dl);
#pragma unroll
                for (int r = 0; r < 16; ++r) { s0[r] -= dl; s1[r] -= dl; negm[r] -= dl; }
                lrow *= alpha;
#pragma unroll
                for (int i = 0; i < 4; ++i)
#pragma unroll
                    for (int r = 0; r < 16; ++r) oT[i][r] *= alpha;
            }
            float ps = 0.f;
#pragma unroll
            for (int r = 0; r < 16; ++r) { s0[r] = __builtin_amdgcn_exp2f(s0[r]); s1[r] = __builtin_amdgcn_exp2f(s1[r]); ps += s0[r] + s1[r]; }
            lrow += ps;
            bf16x8 pf[2][2];
#pragma unroll
            for (int s = 0; s < 2; ++s) {
                u32x4 a, b;
                a.x = cvtpk(s0[8 * s], s0[8 * s + 1]); a.y = cvtpk(s0[8 * s + 2], s0[8 * s + 3]); a.z = cvtpk(s0[8 * s + 4], s0[8 * s + 5]); a.w = cvtpk(s0[8 * s + 6], s0[8 * s + 7]);
                b.x = cvtpk(s1[8 * s], s1[8 * s + 1]); b.y = cvtpk(s1[8 * s + 2], s1[8 * s + 3]); b.z = cvtpk(s1[8 * s + 4], s1[8 * s + 5]); b.w = cvtpk(s1[8 * s + 6], s1[8 * s + 7]);
                pf[0][s] = __builtin_bit_cast(bf16x8, a); pf[1][s] = __builtin_bit_cast(bf16x8, b);
            }
            const DA_LAS unsigned char* vb = lds + cur * BUF + voff;
#define DA_LDV(dst, db) do { _Pragma("unroll") for (int i_ = 0; i_ < 4; ++i_) { const s16x4 lo_ = vtr(vb + (16 * i_) * VP + (db) * 64), hi_ = vtr(vb + (16 * i_ + 8) * VP + (db) * 64); \
                dst[i_] = (bf16x8){lo_[0], lo_[1], lo_[2], lo_[3], hi_[0], hi_[1], hi_[2], hi_[3]}; } } while (0)
#define DA_MM(src, db) do { _Pragma("unroll") for (int i_ = 0; i_ < 4; ++i_) oT[db] = __builtin_amdgcn_mfma_f32_32x32x16_bf16(src[i_], pf[i_ >> 1][i_ & 1], oT[db], 0, 0, 0); } while (0)
            bf16x8 va[4], vq[4];
            DA_LDV(va, 0);
            DA_LDV(vq, 1); __builtin_amdgcn_s_setprio(1); DA_MM(va, 0); __builtin_amdgcn_s_setprio(0);
            DA_LDV(va, 2); __builtin_amdgcn_s_setprio(1); DA_MM(vq, 1); __builtin_amdgcn_s_setprio(0);
            DA_LDV(vq, 3); __builtin_amdgcn_s_setprio(1); DA_MM(va, 2); __builtin_amdgcn_s_setprio(0);
            __builtin_amdgcn_s_setprio(1); DA_MM(vq, 3);
#undef DA_LDV
#undef DA_MM
            __builtin_amdgcn_s_setprio(0);
        }
        if (t + 1 < nt) DA_WRITE(cur ^ 1);
        __syncthreads();
    }
#undef DA_LOAD
#undef DA_WRITE
    const float inv = 1.f / (lrow + __shfl_xor(lrow, 32));
    DA_LAS float* X = (DA_LAS float*)(lds + XOFF) + rb * 4096 + lane;
    if (mp == 1) {
#pragma unroll
        for (int i = 0; i < 4; ++i)
#pragma unroll
            for (int r = 0; r < 16; ++r) X[(i * 16 + r) * 64] = oT[i][r] * inv;
    }
    __syncthreads();
    if (mp == 0) {
        float ss = 0.f;
#pragma unroll
        for (int i = 0; i < 4; ++i)
#pragma unroll
            for (int r = 0; r < 16; ++r) { const float o = oT[i][r] * inv - lam * X[(i * 16 + r) * 64]; oT[i][r] = o; ss += o * o; }
        ss += __shfl_xor(ss, 32);
        const float rr = rsqrtf(ss * (1.f / 128.f) + 1e-5f) * (1.f - LAMBDA_INIT);
        bf16_t* op = Hb + (size_t)qrow * HP_ + HC_Q + h * 128 + 4 * hh;
#pragma unroll
        for (int i = 0; i < 4; ++i)
#pragma unroll
            for (int g = 0; g < 4; ++g) { const int d0 = 32 * i + 8 * g; const f32x4 sw = *(const f32x4*)(subln_w + d0 + 4 * hh);
                uint2 o; o.x = pk2(oT[i][4 * g] * rr * sw.x, oT[i][4 * g + 1] * rr * sw.y); o.y = pk2(oT[i][4 * g + 2] * rr * sw.z, oT[i][4 * g + 3] * rr * sw.w);
                if (STORE || o.x == 0x12345u) *(uint2*)(op + d0) = o; }
    }
    __syncthreads();
}
}
namespace ssd {
#define SS_LAS __attribute__((address_space(3)))
typedef short bf16x8 __attribute__((ext_vector_type(8)));
typedef short s16x4 __attribute__((ext_vector_type(4)));
typedef float f32x16 __attribute__((ext_vector_type(16)));
constexpr int XP = 192;
constexpr int BPT = 320;
constexpr int CP = 272;
__device__ __forceinline__ s16x4 vtr(const SS_LAS unsigned char* p) { typedef short v4i16_t __attribute__((ext_vector_type(4))); return __builtin_bit_cast(s16x4, __builtin_amdgcn_ds_read_tr16_b64_v4i16((SS_LAS v4i16_t*)p)); }
__device__ __forceinline__ unsigned cvtpk(float lo, float hi) { typedef float f2 __attribute__((ext_vector_type(2))); typedef __bf16 b2 __attribute__((ext_vector_type(2))); f2 v = {lo, hi}; b2 b = __builtin_convertvector(v, b2); return __builtin_bit_cast(unsigned, b); }
__device__ __forceinline__ void acs_tables(SS_LAS float* ACS, SS_LAS float* DTS, const float* __restrict__ DTb, const float* __restrict__ a_log, int c, int g) {
    const int tid_ = opaque_tid(); const int lane = tid_ & 63, e = __builtin_amdgcn_readfirstlane(tid_ >> 6), h = 8 * g + e;
    const float a = -expf(a_log[h]);
    const float d0 = DTb[(size_t)(128 * c + 2 * lane) * 32 + h], d1 = DTb[(size_t)(128 * c + 2 * lane + 1) * 32 + h];
    const float a0 = d0 * a, a1 = d1 * a;
    float sc = a0 + a1;
#pragma unroll
    for (int o = 1; o < 64; o <<= 1) { const float v = __shfl_up(sc, o); if (lane >= o) sc += v; }
    const float ex = sc - (a0 + a1);
    ACS[(2 * lane) * 8 + e] = ex + a0; ACS[(2 * lane + 1) * 8 + e] = ex + a0 + a1;
    DTS[(2 * lane) * 8 + e] = d0; DTS[(2 * lane + 1) * 8 + e] = d1;
}
template <int NT, class F> __device__ __forceinline__ void conv_item(const bf16_t* __restrict__ Hb, int t0, int l0, int xch0, const float* __restrict__ conv_w, const float* __restrict__ conv_b, F sink) {
    float w[4][8], bias[8];
#pragma unroll
    for (int j = 0; j < 4; ++j) { const f32x4 a = *(const f32x4*)(conv_w + j * DXBC + xch0), b = *(const f32x4*)(conv_w + j * DXBC + xch0 + 4); w[j][0] = a.x; w[j][1] = a.y; w[j][2] = a.z; w[j][3] = a.w; w[j][4] = b.x; w[j][5] = b.y; w[j][6] = b.z; w[j][7] = b.w; }
    { const f32x4 a = *(const f32x4*)(conv_b + xch0), b = *(const f32x4*)(conv_b + xch0 + 4); bias[0] = a.x; bias[1] = a.y; bias[2] = a.z; bias[3] = a.w; bias[4] = b.x; bias[5] = b.y; bias[6] = b.z; bias[7] = b.w; }
    const bf16_t* src = Hb + HC_XBC + xch0;
    u32x4 rw[NT + 3];
#pragma unroll
    for (int i = 0; i < NT + 3; ++i) { const int tt = t0 + l0 - 3 + i; rw[i] = *(const u32x4*)(src + (size_t)(tt < 0 ? 0 : tt) * HP_); }
    if (t0 + l0 < 3) {
#pragma unroll
        for (int i = 0; i < 3; ++i) if (t0 + l0 - 3 + i < 0) rw[i] = (u32x4){0u, 0u, 0u, 0u};
    }
#define SS_UNP(dst, q_) do { dst[0] = bflo(q_.x); dst[1] = bfhi(q_.x); dst[2] = bflo(q_.y); dst[3] = bfhi(q_.y); dst[4] = bflo(q_.z); dst[5] = bfhi(q_.z); dst[6] = bflo(q_.w); dst[7] = bfhi(q_.w); } while (0)
    float x0[8], x1[8], x2[8];
    SS_UNP(x0, rw[0]); SS_UNP(x1, rw[1]); SS_UNP(x2, rw[2]);
#pragma unroll
    for (int i = 0; i < NT; ++i) {
        float x3[8]; SS_UNP(x3, rw[3 + i]);
        float v[8];
#pragma unroll
        for (int k = 0; k < 8; ++k) { const float a = bias[k] + w[0][k] * x0[k] + w[1][k] * x1[k] + w[2][k] * x2[k] + w[3][k] * x3[k]; v[k] = a * __builtin_amdgcn_rcpf(1.f + __expf(-a)); x0[k] = x1[k]; x1[k] = x2[k]; x2[k] = x3[k]; }
        sink(l0 + i, v);
    }
#undef SS_UNP
}
constexpr int A_BS = 0, A_XD = 128 * BPT  , A_ACS = A_XD + 2 * 128 * XP  , A_DTS = A_ACS + 4096, A_END = A_DTS + 4096;
__device__ __forceinline__ void phaseA_unit(SS_LAS unsigned char* lds, const bf16_t* __restrict__ Hb, const float* __restrict__ DTb, const float* __restrict__ conv_w, const float* __restrict__ conv_b,
                                            const float* __restrict__ a_log, bf16_t* __restrict__ ST, float* __restrict__ CD, int c, int g) {
    const int tid = opaque_tid(), lane = tid & 63, w = __builtin_amdgcn_readfirstlane(tid >> 6), c32 = lane & 31, hh = lane >> 5;
    SS_LAS float* ACS = (SS_LAS float*)(lds + A_ACS); SS_LAS float* DTS = (SS_LAS float*)(lds + A_DTS);
    acs_tables(ACS, DTS, DTb, a_log, c, g);
    __syncthreads();
    if (tid < 8) CD[c * 32 + 8 * g + tid] = __expf(ACS[127 * 8 + tid]);
    auto stageX = [&](int e, int item, int buf) {
        const int cg = item >> 5, seg = item & 31; const float aend = ACS[127 * 8 + e];
        conv_item<4>(Hb, 128 * c, 4 * seg, g * 512 + e * 64 + cg * 8, conv_w, conv_b, [&](int l, const float (&v)[8]) {
            const float sc = DTS[l * 8 + e] * __expf(aend - ACS[l * 8 + e]);
            u32x4 o; o.x = cvtpk(v[0] * sc, v[1] * sc); o.y = cvtpk(v[2] * sc, v[3] * sc); o.z = cvtpk(v[4] * sc, v[5] * sc); o.w = cvtpk(v[6] * sc, v[7] * sc);
            *(SS_LAS u32x4*)(lds + A_XD + buf * 128 * XP + l * XP + cg * 16) = o; });
    };
    { const int cg = tid >> 5, seg = tid & 31;
        conv_item<4>(Hb, 128 * c, 4 * seg, 2048 + g * 128 + cg * 8, conv_w, conv_b, [&](int l, const float (&v)[8]) {
            u32x4 o; o.x = cvtpk(v[0], v[1]); o.y = cvtpk(v[2], v[3]); o.z = cvtpk(v[4], v[5]); o.w = cvtpk(v[6], v[7]);
            *(SS_LAS u32x4*)(lds + A_BS + l * BPT + cg * 16) = o; }); }
    if (tid < 256) stageX(0, tid, 0);
    __syncthreads();
    const int pb = w & 1, nb = w >> 1;
    const int rsel = ((lane & 15) >> 2), csel = 16 * ((lane >> 4) & 1) + 4 * (lane & 3);
    for (int e = 0; e < 8; ++e) {
        if (e + 1 < 8 && tid >= 256) stageX(e + 1, tid - 256, (e + 1) & 1);
        f32x16 acc = (f32x16){0.f, 0.f, 0.f, 0.f, 0.f, 0.f, 0.f, 0.f, 0.f, 0.f, 0.f, 0.f, 0.f, 0.f, 0.f, 0.f};
        const SS_LAS unsigned char* bp = lds + A_BS + (8 * hh + rsel) * BPT + (32 * nb + csel) * 2;
        const SS_LAS unsigned char* xp = lds + A_XD + (e & 1) * 128 * XP + (8 * hh + rsel) * XP + (32 * pb + csel) * 2;
#pragma unroll
        for (int ks = 0; ks < 8; ++ks) {
            const s16x4 b0 = vtr(bp + (16 * ks) * BPT), b1 = vtr(bp + (16 * ks + 4) * BPT), x0 = vtr(xp + (16 * ks) * XP), x1 = vtr(xp + (16 * ks + 4) * XP);
            const bf16x8 bf = (bf16x8){b0[0], b0[1], b0[2], b0[3], b1[0], b1[1], b1[2], b1[3]}, xf = (bf16x8){x0[0], x0[1], x0[2], x0[3], x1[0], x1[1], x1[2], x1[3]};
            acc = __builtin_amdgcn_mfma_f32_32x32x16_bf16(bf, xf, acc, 0, 0, 0);
        }
        bf16_t* sp = ST + ((size_t)(c * 32 + 8 * g + e) * 64 + 32 * pb + c32) * 128 + 32 * nb + 4 * hh;
#pragma unroll
        for (int q = 0; q < 4; ++q) { uint2 o; o.x = cvtpk(acc[4 * q], acc[4 * q + 1]); o.y = cvtpk(acc[4 * q + 2], acc[4 * q + 3]); *(uint2*)(sp + 8 * q) = o; }
        __syncthreads();
    }
}
__device__ __forceinline__ void scan_phase(bf16_t* __restrict__ ST, const float* __restrict__ CD, int gtid) {
    const int h = gtid >> 12;
    unsigned* p = (unsigned*)ST + gtid;
    float r0 = 0.f, r1 = 0.f;
    for (int c0 = 0; c0 < 64; c0 += 16) {
        unsigned v[16]; float d[16];
#pragma unroll
        for (int i = 0; i < 16; ++i) { v[i] = p[(size_t)(c0 + i) * 131072]; d[i] = CD[(c0 + i) * 32 + h]; }
#pragma unroll
        for (int i = 0; i < 16; ++i) { p[(size_t)(c0 + i) * 131072] = cvtpk(r0, r1); r0 = r0 * d[i] + bflo(v[i]); r1 = r1 * d[i] + bfhi(v[i]); }
    }
}
constexpr int C_CS = 0, C_BS = 128 * CP  , C_X1 = C_BS  , C_CBT = 2 * 128 * CP  , C_X0 = C_CBT + 32768  , C_ACS = C_X0 + 128 * XP  , C_DTS = C_ACS + 4096,
              C_SSQ = C_DTS + 4096, C_END = C_SSQ + 1024;
static_assert(C_END <= 147456 && 128 * XP <= 128 * CP, "ssd phase C LDS");
template <bool STORE = true> __device__ __forceinline__ void phaseC_unit(SS_LAS unsigned char* lds, bf16_t* __restrict__ Hb, const float* __restrict__ DTb, const float* __restrict__ conv_w, const float* __restrict__ conv_b,
                                            const float* __restrict__ a_log, const float* __restrict__ d_skip, const float* __restrict__ norm_w, const bf16_t* __restrict__ ST, int c, int g) {
    const int tid = opaque_tid(), lane = tid & 63, w = __builtin_amdgcn_readfirstlane(tid >> 6), c32 = lane & 31, hh = lane >> 5;
    SS_LAS float* ACS = (SS_LAS float*)(lds + C_ACS); SS_LAS float* DTS = (SS_LAS float*)(lds + C_DTS); SS_LAS float* SSQ = (SS_LAS float*)(lds + C_SSQ);
    acs_tables(ACS, DTS, DTb, a_log, c, g);
    auto stageX = [&](int e, int item, int buf) {
        const int cg = item >> 5, seg = item & 31;
        conv_item<4>(Hb, 128 * c, 4 * seg, g * 512 + e * 64 + cg * 8, conv_w, conv_b, [&](int l, const float (&v)[8]) {
            u32x4 o; o.x = cvtpk(v[0], v[1]); o.y = cvtpk(v[2], v[3]); o.z = cvtpk(v[4], v[5]); o.w = cvtpk(v[6], v[7]);
            *(SS_LAS u32x4*)(lds + (buf ? C_X1 : C_X0) + l * XP + cg * 16) = o; });
    };
    { const int isC = tid >> 8, it = tid & 255, cg = it >> 4, seg = it & 15;
        conv_item<8>(Hb, 128 * c, 8 * seg, 2048 + isC * 512 + g * 128 + cg * 8, conv_w, conv_b, [&](int l, const float (&v)[8]) {
            u32x4 o; o.x = cvtpk(v[0], v[1]); o.y = cvtpk(v[2], v[3]); o.z = cvtpk(v[4], v[5]); o.w = cvtpk(v[6], v[7]);
            *(SS_LAS u32x4*)(lds + (isC ? C_CS : C_BS) + l * CP + cg * 16) = o; }); }
    if (tid < 256) stageX(0, tid, 0);
    __syncthreads();
    for (int i = w; i < 10; i += 8) {
        const int sb = (i < 4) ? 0 : (i < 7) ? 1 : (i < 9) ? 2 : 3, lb = (i < 4) ? i : (i < 7) ? i - 3 : (i < 9) ? i - 5 : 3;
        f32x16 acc = (f32x16){0.f, 0.f, 0.f, 0.f, 0.f, 0.f, 0.f, 0.f, 0.f, 0.f, 0.f, 0.f, 0.f, 0.f, 0.f, 0.f};
        const SS_LAS unsigned char* bp = lds + C_BS + (32 * sb + c32) * CP + 16 * hh, *cp = lds + C_CS + (32 * lb + c32) * CP + 16 * hh;
#pragma unroll
        for (int ks = 0; ks < 8; ++ks) acc = __builtin_amdgcn_mfma_f32_32x32x16_bf16(*(const SS_LAS bf16x8*)(bp + 32 * ks), *(const SS_LAS bf16x8*)(cp + 32 * ks), acc, 0, 0, 0);
        SS_LAS unsigned* o = (SS_LAS unsigned*)(lds + C_CBT) + (sb * 4 + lb) * 512 + lane;
#pragma unroll
        for (int q = 0; q < 8; ++q) o[q * 64] = cvtpk(acc[2 * q], acc[2 * q + 1]);
    }
    __syncthreads();
    const int pb = w & 1, lb = w >> 1, lrow = 32 * lb + c32;
    const int rsel = ((lane & 15) >> 2), csel = 16 * ((lane >> 4) & 1) + 4 * (lane & 3);
    unsigned ypk[8][8];
    float ssq = 0.f;
    bf16x8 pcur[8]; u32x2 zcur[4];
#define SS_PREF(pdst, zdst, e_) do { const int h_ = 8 * g + (e_); const bf16_t* pp_ = ST + ((size_t)(c * 32 + h_) * 64 + 32 * pb + c32) * 128 + 8 * hh; \
        _Pragma("unroll") for (int ks_ = 0; ks_ < 8; ++ks_) pdst[ks_] = *(const bf16x8*)(pp_ + 16 * ks_); \
        const bf16_t* zp_ = Hb + (size_t)(128 * c + lrow) * HP_ + HC_Z + g * 512 + (e_) * 64 + 32 * pb + 4 * hh; \
        _Pragma("unroll") for (int q_ = 0; q_ < 4; ++q_) zdst[q_] = *(const u32x2*)(zp_ + 8 * q_); } while (0)
    SS_PREF(pcur, zcur, 0);
    for (int e = 0; e < 8; ++e) {
        const int h = 8 * g + e;
        if (e + 1 < 8 && tid < 256) stageX(e + 1, tid, (e + 1) & 1);
        bf16x8 pnext[8]; u32x2 znext[4];
        { const int en = (e + 1 < 8) ? e + 1 : 7; SS_PREF(pnext, znext, en); }
        const int xoff = (e & 1) ? C_X1 : C_X0;
        f32x16 acc = (f32x16){0.f, 0.f, 0.f, 0.f, 0.f, 0.f, 0.f, 0.f, 0.f, 0.f, 0.f, 0.f, 0.f, 0.f, 0.f, 0.f};
        {
            const SS_LAS unsigned char* cp = lds + C_CS + lrow * CP + 16 * hh;
#pragma unroll
            for (int ks = 0; ks < 8; ++ks) acc = __builtin_amdgcn_mfma_f32_32x32x16_bf16(pcur[ks], *(const SS_LAS bf16x8*)(cp + 32 * ks), acc, 0, 0, 0);
        }
        const float al = ACS[lrow * 8 + e], eal = __expf(al);
#pragma unroll
        for (int r = 0; r < 16; ++r) acc[r] *= eal;
        for (int sb = 0; sb <= lb; ++sb) {
            const SS_LAS unsigned* cbp = (const SS_LAS unsigned*)(lds + C_CBT) + (sb * 4 + lb) * 512 + lane;
            float m[16];
#pragma unroll
            for (int q = 0; q < 8; ++q) { const unsigned u = cbp[q * 64]; m[2 * q] = bflo(u); m[2 * q + 1] = bfhi(u); }
#pragma unroll
            for (int r = 0; r < 16; ++r) { const int srow = 32 * sb + (r & 3) + 8 * (r >> 2) + 4 * hh;
                const float f = __expf(al - ACS[srow * 8 + e]) * DTS[srow * 8 + e];
                m[r] = (srow <= lrow) ? m[r] * f : 0.f; }
            const SS_LAS unsigned char* xp = lds + xoff + (32 * sb + 4 * hh + rsel) * XP + (32 * pb + csel) * 2;
#pragma unroll
            for (int ks = 0; ks < 2; ++ks) {
                const s16x4 x0 = vtr(xp + (16 * ks) * XP), x1 = vtr(xp + (16 * ks + 8) * XP);
                const bf16x8 xf = (bf16x8){x0[0], x0[1], x0[2], x0[3], x1[0], x1[1], x1[2], x1[3]};
                u32x4 mm; mm.x = cvtpk(m[8 * ks], m[8 * ks + 1]); mm.y = cvtpk(m[8 * ks + 2], m[8 * ks + 3]); mm.z = cvtpk(m[8 * ks + 4], m[8 * ks + 5]); mm.w = cvtpk(m[8 * ks + 6], m[8 * ks + 7]);
                acc = __builtin_amdgcn_mfma_f32_32x32x16_bf16(xf, __builtin_bit_cast(bf16x8, mm), acc, 0, 0, 0);
            }
        }
        const float dsk = d_skip[h];
        const SS_LAS unsigned char* xr = lds + xoff + lrow * XP + (32 * pb + 4 * hh) * 2;
        unsigned yt[8];
#pragma unroll
        for (int q = 0; q < 4; ++q) {
            const u32x2 zz = zcur[q]; const u32x2 xx = *(const SS_LAS u32x2*)(xr + 16 * q);
            const float zv[4] = {bflo(zz.x), bfhi(zz.x), bflo(zz.y), bfhi(zz.y)}, xv[4] = {bflo(xx.x), bfhi(xx.x), bflo(xx.y), bfhi(xx.y)};
            float y[4];
#pragma unroll
            for (int k = 0; k < 4; ++k) { y[k] = (acc[4 * q + k] + dsk * xv[k]) * (zv[k] * __builtin_amdgcn_rcpf(1.f + __expf(-zv[k]))); ssq += y[k] * y[k]; }
            yt[2 * q] = cvtpk(y[0], y[1]); yt[2 * q + 1] = cvtpk(y[2], y[3]);
        }
#define SS_YSET(E) case E: { _Pragma("unroll") for (int q_ = 0; q_ < 8; ++q_) ypk[E][q_] = yt[q_]; } break;
        switch (e) { SS_YSET(0) SS_YSET(1) SS_YSET(2) SS_YSET(3) SS_YSET(4) SS_YSET(5) SS_YSET(6) default: { _Pragma("unroll") for (int q_ = 0; q_ < 8; ++q_) ypk[7][q_] = yt[q_]; } break; }
#undef SS_YSET
#pragma unroll
        for (int ks = 0; ks < 8; ++ks) pcur[ks] = pnext[ks];
#pragma unroll
        for (int q = 0; q < 4; ++q) zcur[q] = znext[q];
        __syncthreads();
    }
#undef SS_PREF
    ssq += __shfl_xor(ssq, 32);
    if (hh == 0) SSQ[pb * 128 + lrow] = ssq;
    __syncthreads();
    const float rstd = rsqrtf((SSQ[lrow] + SSQ[128 + lrow]) * (1.f / 512.f) + 1e-5f);
    bf16_t* op = Hb + (size_t)(128 * c + lrow) * HP_ + HC_Z + g * 512 + 32 * pb + 4 * hh;
    const float* nw = norm_w + g * 512 + 32 * pb + 4 * hh;
#pragma unroll
    for (int e = 0; e < 8; ++e)
#pragma unroll
        for (int q = 0; q < 4; ++q) { const f32x4 n4 = *(const f32x4*)(nw + e * 64 + 8 * q);
            uint2 o; o.x = cvtpk(bflo(ypk[e][2 * q]) * rstd * n4.x, bfhi(ypk[e][2 * q]) * rstd * n4.y); o.y = cvtpk(bflo(ypk[e][2 * q + 1]) * rstd * n4.z, bfhi(ypk[e][2 * q + 1]) * rstd * n4.w);
            if (STORE || o.x == 0x12345u) *(uint2*)(op + e * 64 + 8 * q) = o; }
    __syncthreads();
}
}


namespace psel {
#define PS_LAS __attribute__((address_space(3)))
typedef short bf16x8 __attribute__((ext_vector_type(8)));
typedef float f32x16 __attribute__((ext_vector_type(16)));
__device__ __forceinline__ int ord(float f) { const int b = __builtin_bit_cast(int, f); return b ^ ((b >> 31) & 0x7fffffff); }
__device__ __forceinline__ float unord(int t) { return __builtin_bit_cast(float, t ^ ((t >> 31) & 0x7fffffff)); }
#define PS_INS(top, v) do { int v_ = (v); _Pragma("unroll") for (int i_ = 0; i_ < 16; ++i_) { const int hi_ = max(top[i_], v_); v_ = min(top[i_], v_); top[i_] = hi_; } } while (0)
__device__ __forceinline__ void stage1(PS_LAS int* EXall, const bf16_t* __restrict__ QP, const bf16_t* __restrict__ SUBK, int tok0, int hp) {
    const int tid = opaque_tid(), lane = tid & 63, w1 = __builtin_amdgcn_readfirstlane(tid >> 6), c32 = lane & 31, hh = lane >> 5;
    PS_LAS int* EX = EXall + hp * 4096;
    {
        const int tile = w1 >> 2, hsel = (w1 >> 1) & 1, half = w1 & 1, h = 2 * hp + hsel;
        const bf16_t* qp = QP + (size_t)(tok0 + 32 * tile + c32) * 2048 + h * 256 + half * 128 + 8 * hh;
        const bf16_t* kp = SUBK + ((size_t)(h * 2 + half) * 128 + c32) * 128 + 8 * hh;
        bf16x8 qf[8];
#pragma unroll
        for (int ks = 0; ks < 8; ++ks) qf[ks] = *(const bf16x8*)(qp + 16 * ks);
        int top[16];
#pragma unroll
        for (int i = 0; i < 16; ++i) top[i] = (int)0x80000000;
        bf16x8 kfa[8], kfb[8];
#define PS_LDK(dst, mt_) do { _Pragma("unroll") for (int ks_ = 0; ks_ < 8; ++ks_) dst[ks_] = *(const bf16x8*)(kp + (size_t)(32 * (mt_)) * 128 + 16 * ks_); } while (0)
#define PS_TILE(src, mt_) do { f32x16 acc_ = (f32x16){0.f, 0.f, 0.f, 0.f, 0.f, 0.f, 0.f, 0.f, 0.f, 0.f, 0.f, 0.f, 0.f, 0.f, 0.f, 0.f}; \
            _Pragma("unroll") for (int ks_ = 0; ks_ < 8; ++ks_) acc_ = __builtin_amdgcn_mfma_f32_32x32x16_bf16(src[ks_], qf[ks_], acc_, 0, 0, 0); \
            _Pragma("unroll") for (int r_ = 0; r_ < 16; ++r_) { const int key_ = 32 * (mt_) + (r_ & 3) + 8 * (r_ >> 2) + 4 * hh; const int v__ = (ord(acc_[r_]) & ~127) | (127 - key_); PS_INS(top, v__); } } while (0)
        PS_LDK(kfa, 0);
        PS_LDK(kfb, 1); PS_TILE(kfa, 0);
        PS_LDK(kfa, 2); PS_TILE(kfb, 1);
        PS_LDK(kfb, 3); PS_TILE(kfa, 2);
        PS_TILE(kfb, 3);
#undef PS_LDK
#undef PS_TILE
        int oth[16];
#pragma unroll
        for (int i = 0; i < 16; ++i) oth[i] = __shfl_xor(top[i], 32);
#pragma unroll
        for (int i = 0; i < 16; ++i) PS_INS(top, oth[i]);
        if (hh == 0) {
#pragma unroll
            for (int i = 0; i < 16; ++i) EX[(w1 * 16 + i) * 32 + c32] = top[i];
        }
    }
}
__device__ __forceinline__ void stage2(PS_LAS int* EXall, int* __restrict__ IDX, float* __restrict__ GATE, int tok0) {
    const int tid = opaque_tid();
    {
        const int hp = tid >> 7, task = tid & 127, th = task >> 5, tok32 = task & 31, tile = th >> 1, hsel = th & 1, h = 2 * hp + hsel;
        PS_LAS int* EX = EXall + hp * 4096;
        const PS_LAS int* ea = EX + ((th * 2 + 0) * 16) * 32 + tok32; const PS_LAS int* eb = EX + ((th * 2 + 1) * 16) * 32 + tok32;
        float as[16], bs[16];
#pragma unroll
        for (int i = 0; i < 16; ++i) { as[i] = unord(ea[i * 32] & ~127); bs[i] = unord(eb[i * 32] & ~127); }
        int top[16];
#pragma unroll
        for (int i = 0; i < 16; ++i) top[i] = (int)0x80000000;
#pragma unroll
        for (int i = 0; i < 16; ++i)
#pragma unroll
            for (int j = 0; j < 16; ++j) if ((i + 1) * (j + 1) <= 16) { const int v = (ord(as[i] + bs[j]) & ~255) | (255 - (i * 16 + j)); PS_INS(top, v); }
        float sc[16]; int id[16];
#pragma unroll
        for (int r = 0; r < 16; ++r) { const int cn = 255 - (top[r] & 255), i = cn >> 4, j = cn & 15; const int pa = ea[i * 32], pb = eb[j * 32];
            sc[r] = unord(pa & ~127) + unord(pb & ~127); id[r] = (127 - (pa & 127)) * 128 + (127 - (pb & 127)); }
        float sum = 0.f; const float mx = sc[0];
#pragma unroll
        for (int r = 0; r < 16; ++r) { sc[r] = __expf(sc[r] - mx); sum += sc[r]; }
        const size_t o = (size_t)(tok0 + 32 * tile + tok32) * 128 + h * 16;
        const float inv = 1.f / sum;
#pragma unroll
        for (int r = 0; r < 16; r += 4) { *(f32x4*)(GATE + o + r) = (f32x4){sc[r] * inv, sc[r + 1] * inv, sc[r + 2] * inv, sc[r + 3] * inv}; *(u32x4*)(IDX + o + r) = (u32x4){(unsigned)id[r], (unsigned)id[r + 1], (unsigned)id[r + 2], (unsigned)id[r + 3]}; }
    }
}
}


namespace xattn {
#define XA_LAS __attribute__((address_space(3)))
typedef short bf16x8 __attribute__((ext_vector_type(8)));
typedef short s16x4 __attribute__((ext_vector_type(4)));
typedef float f32x16 __attribute__((ext_vector_type(16)));
constexpr int RP = 528;
__device__ __forceinline__ unsigned cvtpk(float lo, float hi) { typedef float f2 __attribute__((ext_vector_type(2))); typedef __bf16 b2 __attribute__((ext_vector_type(2))); f2 v = {lo, hi}; b2 b = __builtin_convertvector(v, b2); return __builtin_bit_cast(unsigned, b); }
__device__ __forceinline__ void stage(XA_LAS unsigned char* lds, const bf16_t* __restrict__ src, int pitch, int tid) {
#pragma unroll 4
    for (int i = 0; i < 16; ++i) { const int q = tid + 512 * i, row = q >> 5, ch = q & 31; *(XA_LAS u32x4*)(lds + row * RP + ch * 16) = *(const u32x4*)(src + (size_t)row * pitch + ch * 8); }
}
__device__ __forceinline__ void unit(XA_LAS unsigned char* lds, const bf16_t* __restrict__ QC, const bf16_t* __restrict__ KC, const bf16_t* __restrict__ VcT, bf16_t* __restrict__ XO, int tg, int h) {
    const int tid = opaque_tid(), lane = tid & 63, w = __builtin_amdgcn_readfirstlane(tid >> 6), c32 = lane & 31, hh = lane >> 5, b = tg >> 5;
    const int tok = 256 * tg + 32 * w + c32;
    stage(lds, KC + (size_t)b * MEML * D + h * 256, D, tid);
    bf16x8 pf[8][2]; float inv;
    {
        bf16x8 qf[16];
        const bf16_t* qp = QC + (size_t)tok * D + h * 256 + 8 * hh;
#pragma unroll
        for (int ks = 0; ks < 16; ++ks) qf[ks] = *(const bf16x8*)(qp + 16 * ks);
        __syncthreads();
        f32x16 acc[8];
        const XA_LAS unsigned char* kb = lds + c32 * RP + 16 * hh;
#pragma unroll
        for (int mt = 0; mt < 8; ++mt) {
            acc[mt] = (f32x16){0.f, 0.f, 0.f, 0.f, 0.f, 0.f, 0.f, 0.f, 0.f, 0.f, 0.f, 0.f, 0.f, 0.f, 0.f, 0.f};
#pragma unroll
            for (int ks = 0; ks < 16; ++ks) acc[mt] = __builtin_amdgcn_mfma_f32_32x32x16_bf16(*(const XA_LAS bf16x8*)(kb + (32 * mt) * RP + 32 * ks), qf[ks], acc[mt], 0, 0, 0);
        }
        float mx = acc[0][0];
#pragma unroll
        for (int mt = 0; mt < 8; ++mt)
#pragma unroll
            for (int r = 0; r < 16; ++r) mx = fmaxf(mx, acc[mt][r]);
        mx = fmaxf(mx, __shfl_xor(mx, 32));
        float sum = 0.f;
#pragma unroll
        for (int mt = 0; mt < 8; ++mt)
#pragma unroll
            for (int r = 0; r < 16; ++r) { acc[mt][r] = __builtin_amdgcn_exp2f(acc[mt][r] - mx); sum += acc[mt][r]; }
        sum += __shfl_xor(sum, 32); inv = 1.f / sum;
#pragma unroll
        for (int mt = 0; mt < 8; ++mt)
#pragma unroll
            for (int s2 = 0; s2 < 2; ++s2) { u32x4 a; a.x = cvtpk(acc[mt][8 * s2], acc[mt][8 * s2 + 1]); a.y = cvtpk(acc[mt][8 * s2 + 2], acc[mt][8 * s2 + 3]); a.z = cvtpk(acc[mt][8 * s2 + 4], acc[mt][8 * s2 + 5]); a.w = cvtpk(acc[mt][8 * s2 + 6], acc[mt][8 * s2 + 7]);
                pf[mt][s2] = __builtin_bit_cast(bf16x8, a); }
    }
    __syncthreads();
    stage(lds, VcT + ((size_t)b * D + h * 256) * MEML, MEML, tid);
    __syncthreads();
    const XA_LAS unsigned char* vb = lds + c32 * RP + 8 * hh;
    bf16_t* op = XO + (size_t)tok * D + h * 256 + 4 * hh;
#pragma unroll 1
    for (int dt = 0; dt < 8; ++dt) {
        f32x16 acc = (f32x16){0.f, 0.f, 0.f, 0.f, 0.f, 0.f, 0.f, 0.f, 0.f, 0.f, 0.f, 0.f, 0.f, 0.f, 0.f, 0.f};
#pragma unroll
        for (int mt = 0; mt < 8; ++mt)
#pragma unroll
            for (int s2 = 0; s2 < 2; ++s2) {
                const s16x4 lo = *(const XA_LAS s16x4*)(vb + (32 * dt) * RP + (32 * mt + 16 * s2) * 2), hi = *(const XA_LAS s16x4*)(vb + (32 * dt) * RP + (32 * mt + 16 * s2 + 8) * 2);
                const bf16x8 vf = (bf16x8){lo[0], lo[1], lo[2], lo[3], hi[0], hi[1], hi[2], hi[3]};
                acc = __builtin_amdgcn_mfma_f32_32x32x16_bf16(vf, pf[mt][s2], acc, 0, 0, 0);
            }
#pragma unroll
        for (int q = 0; q < 4; ++q) { u32x2 o; o.x = cvtpk(acc[4 * q] * inv, acc[4 * q + 1] * inv); o.y = cvtpk(acc[4 * q + 2] * inv, acc[4 * q + 3] * inv); *(u32x2*)(op + 32 * dt + 8 * q) = o; }
    }
    __syncthreads();
}
}

namespace sp {
#define SP_LAS __attribute__((address_space(3)))
#define SP_LDSWAIT() do { asm volatile("s_waitcnt lgkmcnt(0)" ::: "memory"); } while (0)
__device__ __forceinline__ void transpose_item(const float* __restrict__ W, int ldw, int col0, int K, int nblk, bf16_t* __restrict__ WT, int row_off, SP_LAS float* scr, int item, int lane) {
    const int kb = item / nblk, nb = item % nblk, k0 = 64 * kb, n0 = 32 * nb;
#pragma unroll 8
    for (int i = 0; i < 32; ++i) { const int kk = 2 * i + (lane >> 5); scr[kk * 33 + (lane & 31)] = W[(size_t)(k0 + kk) * ldw + col0 + n0 + (lane & 31)]; }
    SP_LDSWAIT();
    const int cc = lane & 7;
#pragma unroll
    for (int j = 0; j < 4; ++j) { const int n = (lane >> 3) + 8 * j; const SP_LAS float* s = scr + (8 * cc) * 33 + n;
        u32x4 o; o.x = pk2(s[0 * 33], s[1 * 33]); o.y = pk2(s[2 * 33], s[3 * 33]); o.z = pk2(s[4 * 33], s[5 * 33]); o.w = pk2(s[6 * 33], s[7 * 33]);
        *(u32x4*)(WT + (size_t)(row_off + n0 + n) * K + k0 + 8 * cc) = o; }
    SP_LDSWAIT();
}
__device__ __forceinline__ void cvt_range(const float* __restrict__ src, bf16_t* __restrict__ dst, size_t n4, size_t gtid, size_t gthreads) {
    for (size_t i = gtid; i < n4; i += gthreads) { const f32x4 v = ((const f32x4*)src)[i]; u32x2 o; o.x = pk2(v.x, v.y); o.y = pk2(v.z, v.w); ((u32x2*)dst)[i] = o; }
}

__device__ __forceinline__ void cvt_fp8_range(const float* __restrict__ src, unsigned char* __restrict__ dst, size_t n16, float scale, size_t gtid, size_t gthreads) {
    for (size_t i = gtid; i < n16; i += gthreads) {
        const f32x4* sp4 = (const f32x4*)src + 4 * i; u32x4 o; unsigned ow[4];
#pragma unroll
        for (int q = 0; q < 4; ++q) { const f32x4 v = sp4[q];
            const float a = fminf(fmaxf(v.x * scale, -448.f), 448.f), b = fminf(fmaxf(v.y * scale, -448.f), 448.f), c2 = fminf(fmaxf(v.z * scale, -448.f), 448.f), d2 = fminf(fmaxf(v.w * scale, -448.f), 448.f);
            int p = 0; p = __builtin_amdgcn_cvt_pk_fp8_f32(a, b, p, false); p = __builtin_amdgcn_cvt_pk_fp8_f32(c2, d2, p, true); ow[q] = (unsigned)p; }
        o.x = ow[0]; o.y = ow[1]; o.z = ow[2]; o.w = ow[3];
        const size_t e_ = i >> 6, cg_ = i & 63; ((u32x4*)dst)[(cg_ >> 3) * ((size_t)PK * PK * 8) + e_ * 8 + (cg_ & 7)] = o;
    }
}
__device__ __forceinline__ void dt_stage_w(SP_LAS float* Wl, const float* __restrict__ w_in) {
    const int tid = opaque_tid();
#pragma unroll 8
    for (int i = 0; i < 64; ++i) { const int idx = tid + 512 * i; Wl[idx] = w_in[(size_t)(idx >> 5) * NIN + 5120 + (idx & 31)]; }
}
__device__ __forceinline__ void dt_item(SP_LAS float* Wl, SP_LAS float* xs, SP_LAS float* part, const float* __restrict__ x, const float* __restrict__ dt_bias, float* __restrict__ DT, int item) {
    const int tid = opaque_tid(), lane = tid & 63, w = tid >> 6, m0 = item * 4;
#pragma unroll
    for (int i = 0; i < 2; ++i) { const int q = tid + 512 * i; *(SP_LAS f32x4*)(xs + 4 * q) = ((const f32x4*)(x + (size_t)m0 * D))[q]; }
    __syncthreads();
    const int h = lane & 31, r = w >> 1, kq = (w & 1) * 2 + (lane >> 5);
    const SP_LAS float* xp = xs + r * 1024 + kq * 256; const SP_LAS float* wp = Wl + (kq * 256) * 32 + h;
    float a0 = 0.f, a1 = 0.f;
#pragma unroll 8
    for (int k = 0; k < 256; k += 2) { a0 = fmaf(xp[k], wp[k * 32], a0); a1 = fmaf(xp[k + 1], wp[(k + 1) * 32], a1); }
    float acc = a0 + a1;
    acc += __shfl_xor(acc, 32);
    if ((w & 1) && lane < 32) part[r * 32 + h] = acc;
    __syncthreads();
    if (!(w & 1) && lane < 32) { const float v = acc + part[r * 32 + h] + dt_bias[h]; DT[(size_t)(m0 + r) * 32 + h] = v > 20.f ? v : log1pf(expf(v)); }
}
__device__ __forceinline__ void ln_row(float* __restrict__ X, const float* __restrict__ g, const float* __restrict__ b, bf16_t* __restrict__ XB, int row, int lane) {
    f32x4* xr = (f32x4*)(X + (size_t)row * D) + lane;
    f32x4 v[4]; float s = 0.f;
#pragma unroll
    for (int j = 0; j < 4; ++j) { v[j] = xr[64 * j]; s += (v[j].x + v[j].y) + (v[j].z + v[j].w); }
    const float mean = wave_sum(s) * (1.f / D); float s2 = 0.f;
#pragma unroll
    for (int j = 0; j < 4; ++j) { v[j] = v[j] - mean; s2 += (v[j].x * v[j].x + v[j].y * v[j].y) + (v[j].z * v[j].z + v[j].w * v[j].w); }
    const float rstd = rsqrtf(wave_sum(s2) * (1.f / D) + 1e-5f);
#pragma unroll
    for (int j = 0; j < 4; ++j) { const int c = 4 * lane + 256 * j; const f32x4 gg = *(const f32x4*)(g + c), bb = *(const f32x4*)(b + c);
        f32x4 o = v[j] * rstd * gg + bb; xr[64 * j] = o;
        u32x2 pb; pb.x = pk2(o.x, o.y); pb.y = pk2(o.z, o.w); *(u32x2*)(XB + (size_t)row * D + c) = pb; }
}
__device__ __forceinline__ void xattn_pair(SP_LAS float* L, const bf16_t* __restrict__ QC, const bf16_t* __restrict__ KCVC, bf16_t* __restrict__ XO, int tok0) {
    const int t512 = opaque_tid(); const int half = t512 >> 8, tid = t512 & 255, lane = tid & 63, wv = tid >> 6, tok = tok0 + half, b = tok / SEQ;
    SP_LAS float* qs = L + half * 1024; SP_LAS float* ps = L + 2048 + half * 256; SP_LAS float* red = L + 2560 + half * 8;
    for (int i = tid; i < 1024; i += 256) qs[i] = bf2f(QC[(size_t)tok * D + i]);
    __syncthreads();
    const bf16_t* KV = KCVC + (size_t)b * MEML * 2048;
    for (int h = 0; h < MH; ++h) {
        const bf16_t* kp = KV + (size_t)tid * 2048 + h * 256;
        float s = 0.f;
        for (int d = 0; d < 256; d += 8) { const u32x4 w = *(const u32x4*)(kp + d); const SP_LAS float* q = qs + h * 256 + d;
            s += q[0] * bflo(w.x) + q[1] * bfhi(w.x) + q[2] * bflo(w.y) + q[3] * bfhi(w.y) + q[4] * bflo(w.z) + q[5] * bfhi(w.z) + q[6] * bflo(w.w) + q[7] * bfhi(w.w); }
        float mx = wave_max(s); if (lane == 0) red[wv] = mx; __syncthreads();
        mx = fmaxf(fmaxf(red[0], red[1]), fmaxf(red[2], red[3]));
        const float p = exp2f(s - mx);
        float sm = wave_sum(p); if (lane == 0) red[4 + wv] = sm; ps[tid] = p; __syncthreads();
        sm = (red[4] + red[5]) + (red[6] + red[7]);
        float o = 0.f;
        for (int j = 0; j < 256; ++j) o = fmaf(ps[j], bf2f(KV[(size_t)j * 2048 + 1024 + h * 256 + tid]), o);
        XO[(size_t)tok * D + h * 256 + tid] = (bf16_t)f2bf(o / sm);
        __syncthreads();
    }
}
__device__ __forceinline__ void select_pair(SP_LAS float* L, const bf16_t* __restrict__ QP, const bf16_t* __restrict__ SUBK, int* __restrict__ IDX, float* __restrict__ GATE, int tok0) {
    const int t512 = opaque_tid(); const int hf = t512 >> 8, tid = t512 & 255, tok = tok0 + hf;
    SP_LAS float* base = L + hf * 3072;
    SP_LAS float* qs = base; SP_LAS float* s = base + 2048; SP_LAS float* tops = base + 2304; SP_LAS int* topi = (SP_LAS int*)(base + 2336); SP_LAS float* cs = base + 2368; SP_LAS int* ci = (SP_LAS int*)(base + 2624);
    SP_LAS float* bs = base + 2880; SP_LAS int* bi = (SP_LAS int*)(base + 2896);
    for (int i = tid; i < 2048; i += 256) qs[i] = bf2f(QP[(size_t)tok * 2048 + i]);
    __syncthreads();
    for (int h = 0; h < PH; ++h) {
        const int half = tid >> 7, key = tid & 127;
        { const bf16_t* kp = SUBK + ((size_t)(h * 2 + half) * 128 + key) * 128; const SP_LAS float* q = qs + h * 256 + half * 128; float a = 0.f;
          for (int d = 0; d < 128; d += 8) { const u32x4 w = *(const u32x4*)(kp + d);
              a += q[d] * bflo(w.x) + q[d + 1] * bfhi(w.x) + q[d + 2] * bflo(w.y) + q[d + 3] * bfhi(w.y) + q[d + 4] * bflo(w.z) + q[d + 5] * bfhi(w.z) + q[d + 6] * bflo(w.w) + q[d + 7] * bfhi(w.w); }
          s[tid] = a; }
        __syncthreads();
        { const float me = s[tid]; int rank = 0; const SP_LAS float* spp = s + half * 128;
          for (int j = 0; j < 128; ++j) { const float o = spp[j]; rank += (o > me || (o == me && j < key)) ? 1 : 0; }
          if (rank < 16) { tops[half * 16 + rank] = me; topi[half * 16 + rank] = key; } }
        __syncthreads();
        { const int i = tid >> 4, j = tid & 15; cs[tid] = tops[i] + tops[16 + j]; ci[tid] = topi[i] * 128 + topi[16 + j]; }
        __syncthreads();
        { const float me = cs[tid]; int rank = 0;
          for (int j = 0; j < 256; ++j) { const float o = cs[j]; rank += (o > me || (o == me && j < tid)) ? 1 : 0; }
          if (rank < 16) { bs[rank] = me; bi[rank] = ci[tid]; } }
        __syncthreads();
        if (tid < 16) { const float mx = bs[0]; float sum = 0.f;
            for (int j = 0; j < 16; ++j) sum += expf(bs[j] - mx);
            GATE[(size_t)tok * 128 + h * 16 + tid] = expf(bs[tid] - mx) / sum; IDX[(size_t)tok * 128 + h * 16 + tid] = bi[tid]; }
        __syncthreads();
    }
}
__device__ __forceinline__ void gather_token(SP_LAS float* L, float* __restrict__ X, const bf16_t* __restrict__ PU, const bf16_t* __restrict__ PV, const int* __restrict__ IDX, const float* __restrict__ GATE,
                                             const float* __restrict__ g3, const float* __restrict__ b3, int tok) {
    const int tid = opaque_tid(), lane = tid & 63, wv = tid >> 6;
    SP_LAS float* ys = L; SP_LAS float* red = L + 8192;
    float xr[16], y[16];
    { const float* xp = X + (size_t)tok * D + lane * 16;
#pragma unroll
      for (int j = 0; j < 4; ++j) { const f32x4 v = *(const f32x4*)(xp + 4 * j); xr[4 * j] = v.x; xr[4 * j + 1] = v.y; xr[4 * j + 2] = v.z; xr[4 * j + 3] = v.w; }
#pragma unroll
      for (int j = 0; j < 16; ++j) y[j] = 0.f; }
    for (int e = 0; e < 16; ++e) {
        const int slot = wv * 16 + e; const int id = IDX[(size_t)tok * 128 + slot]; const float gt = GATE[(size_t)tok * 128 + slot];
        const bf16_t* up = PU + (size_t)id * D + lane * 16; const u32x4 u0 = *(const u32x4*)up, u1 = *(const u32x4*)(up + 8);
        const unsigned uw[8] = {u0.x, u0.y, u0.z, u0.w, u1.x, u1.y, u1.z, u1.w};
        float hsum = 0.f;
#pragma unroll
        for (int j = 0; j < 8; ++j) { hsum = fmaf(xr[2 * j], bflo(uw[j]), hsum); hsum = fmaf(xr[2 * j + 1], bfhi(uw[j]), hsum); }
        hsum = wave_sum(hsum);
        const float w = gt * 0.5f * hsum * (1.f + erff(hsum * 0.70710678118654752f));
        const bf16_t* vp = PV + (size_t)id * D + lane * 16; const u32x4 v0 = *(const u32x4*)vp, v1 = *(const u32x4*)(vp + 8);
        const unsigned vw[8] = {v0.x, v0.y, v0.z, v0.w, v1.x, v1.y, v1.z, v1.w};
#pragma unroll
        for (int j = 0; j < 8; ++j) { y[2 * j] = fmaf(w, bflo(vw[j]), y[2 * j]); y[2 * j + 1] = fmaf(w, bfhi(vw[j]), y[2 * j + 1]); }
    }
#pragma unroll
    for (int j = 0; j < 16; ++j) ys[wv * 1024 + lane * 16 + j] = y[j];
    __syncthreads();
    float v[2]; float s = 0.f;
#pragma unroll
    for (int j = 0; j < 2; ++j) { const int c = tid * 2 + j; float a = 0.f;
#pragma unroll
        for (int k = 0; k < 8; ++k) a += ys[k * 1024 + c];
        v[j] = ALPHA * X[(size_t)tok * D + c] + a; s += v[j]; }
    s = wave_sum(s); if (lane == 0) red[wv] = s; __syncthreads();
    float tot = 0.f;
#pragma unroll
    for (int k = 0; k < 8; ++k) tot += red[k];
    const float mean = tot * (1.f / D);
    float s2 = 0.f;
#pragma unroll
    for (int j = 0; j < 2; ++j) { v[j] -= mean; s2 += v[j] * v[j]; }
    s2 = wave_sum(s2); if (lane == 0) red[8 + wv] = s2; __syncthreads();
    float tot2 = 0.f;
#pragma unroll
    for (int k = 0; k < 8; ++k) tot2 += red[8 + k];
    const float rstd = rsqrtf(tot2 * (1.f / D) + 1e-5f);
#pragma unroll
    for (int j = 0; j < 2; ++j) { const int c = tid * 2 + j; X[(size_t)tok * D + c] = v[j] * rstd * g3[c] + b3[c]; }
    __syncthreads();
}

constexpr float PEER_SU = 2048.f, PEER_SV = 256.f;
typedef float f32x2v __attribute__((ext_vector_type(2)));
__device__ __forceinline__ void gather_wave(float* __restrict__ Xo, const float* X, const unsigned char* __restrict__ PU, const unsigned char* __restrict__ PV, const int* __restrict__ IDX, const float* __restrict__ GATE,
                                            const float* __restrict__ g3, const float* __restrict__ b3, int tok, int lane) {
    float xr[16], y[16];
    { const f32x4* xp = (const f32x4*)(X + (size_t)tok * D + 16 * lane);
#pragma unroll
      for (int q = 0; q < 4; ++q) { const f32x4 v = xp[q]; xr[4 * q] = v.x; xr[4 * q + 1] = v.y; xr[4 * q + 2] = v.z; xr[4 * q + 3] = v.w; } }
#pragma unroll
    for (int j = 0; j < 16; ++j) y[j] = 0.f;
    const int id0 = IDX[(size_t)tok * 128 + lane], id1 = IDX[(size_t)tok * 128 + 64 + lane];
    const float gt0 = GATE[(size_t)tok * 128 + lane], gt1 = GATE[(size_t)tok * 128 + 64 + lane];
    u32x4 ub[8], vb[8];
#define GW_ISSUE(buf, TBL, i) do { const int idv_ = ((i) < 8) ? id0 : id1; _Pragma("unroll") for (int k_ = 0; k_ < 8; ++k_) { \
        const int id_ = __builtin_amdgcn_readlane(idv_, (8 * (i) + k_) & 63); buf[k_] = *(const u32x4*)((TBL) + (size_t)id_ * D + 16 * lane); } } while (0)
    GW_ISSUE(ub, PU, 0); GW_ISSUE(vb, PV, 0);
    const bool h32 = (lane & 32) != 0, h16 = (lane & 16) != 0, h8 = (lane & 8) != 0;
#pragma unroll 1
    for (int i = 0; i < 16; ++i) {
        float p[8];
#pragma unroll
        for (int k = 0; k < 8; ++k) { const unsigned w[4] = {ub[k].x, ub[k].y, ub[k].z, ub[k].w}; float a = 0.f;
#pragma unroll
            for (int q = 0; q < 4; ++q) { const f32x2v lo = __builtin_amdgcn_cvt_pk_f32_fp8((int)w[q], false), hi = __builtin_amdgcn_cvt_pk_f32_fp8((int)w[q], true);
                a = fmaf(xr[4 * q], lo.x, a); a = fmaf(xr[4 * q + 1], lo.y, a); a = fmaf(xr[4 * q + 2], hi.x, a); a = fmaf(xr[4 * q + 3], hi.y, a); }
            p[k] = a; }
        { const int in_ = (i + 1 < 16) ? i + 1 : 15; GW_ISSUE(ub, PU, in_); }
        float q4[4], q2[2], q1;
#pragma unroll
        for (int k = 0; k < 4; ++k) q4[k] = (h32 ? p[k + 4] : p[k]) + __shfl_xor(h32 ? p[k] : p[k + 4], 32);
#pragma unroll
        for (int k = 0; k < 2; ++k) q2[k] = (h16 ? q4[k + 2] : q4[k]) + __shfl_xor(h16 ? q4[k] : q4[k + 2], 16);
        q1 = (h8 ? q2[1] : q2[0]) + __shfl_xor(h8 ? q2[0] : q2[1], 8);
        q1 += __shfl_xor(q1, 4); q1 += __shfl_xor(q1, 2); q1 += __shfl_xor(q1, 1);
        q1 *= (1.f / PEER_SU);
        const float gsel = __shfl((i < 8) ? gt0 : gt1, (8 * i + (lane >> 3)) & 63);
        const float wv = gsel * 0.5f * q1 * (1.f + erff(q1 * 0.70710678118654752f));
#pragma unroll
        for (int k = 0; k < 8; ++k) { const float wk = __builtin_bit_cast(float, __builtin_amdgcn_readlane(__builtin_bit_cast(int, wv), 8 * k));
            const unsigned w[4] = {vb[k].x, vb[k].y, vb[k].z, vb[k].w};
#pragma unroll
            for (int q = 0; q < 4; ++q) { const f32x2v lo = __builtin_amdgcn_cvt_pk_f32_fp8((int)w[q], false), hi = __builtin_amdgcn_cvt_pk_f32_fp8((int)w[q], true);
                y[4 * q] = fmaf(wk, lo.x, y[4 * q]); y[4 * q + 1] = fmaf(wk, lo.y, y[4 * q + 1]); y[4 * q + 2] = fmaf(wk, hi.x, y[4 * q + 2]); y[4 * q + 3] = fmaf(wk, hi.y, y[4 * q + 3]); } }
        { const int in_ = (i + 1 < 16) ? i + 1 : 15; GW_ISSUE(vb, PV, in_); }
    }
#undef GW_ISSUE
    float s = 0.f;
#pragma unroll
    for (int j = 0; j < 16; ++j) { y[j] = ALPHA * xr[j] + y[j] * (1.f / PEER_SV); s += y[j]; }
    const float mean = wave_sum(s) * (1.f / D); float s2 = 0.f;
#pragma unroll
    for (int j = 0; j < 16; ++j) { y[j] -= mean; s2 += y[j] * y[j]; }
    const float rstd = rsqrtf(wave_sum(s2) * (1.f / D) + 1e-5f);
    float* op = Xo + (size_t)tok * D + 16 * lane;
#pragma unroll
    for (int q = 0; q < 4; ++q) { const f32x4 gg = *(const f32x4*)(g3 + 16 * lane + 4 * q), bb = *(const f32x4*)(b3 + 16 * lane + 4 * q);
        f32x4 o; o.x = y[4 * q] * rstd * gg.x + bb.x; o.y = y[4 * q + 1] * rstd * gg.y + bb.y; o.z = y[4 * q + 2] * rstd * gg.z + bb.z; o.w = y[4 * q + 3] * rstd * gg.w + bb.w;
        *(f32x4*)(op + 4 * q) = o; }
}
}


#define LAS __attribute__((address_space(3)))
#define XB_TMO      128
#define XB_XCNT(j)  (256  + 64 * (j))
#define XB_XSUB(j)  (1280 + 64 * (j))
#define XB_XGEN(j)  (2304 + 64 * (j))
#define XB_TOP      3328
#define XB_TOPGEN   3392
#define XCD_BAR_WORDS 3456
#define XB_SPIN_CAP (1u << 18)
__device__ __forceinline__ unsigned xb_ld(unsigned* p)              { return __hip_atomic_load(p, __ATOMIC_RELAXED, __HIP_MEMORY_SCOPE_AGENT); }
__device__ __forceinline__ unsigned xb_add(unsigned* p, unsigned v) { return __hip_atomic_fetch_add(p, v, __ATOMIC_RELAXED, __HIP_MEMORY_SCOPE_AGENT); }
__device__ __forceinline__ unsigned xb_xcc_id() { return (unsigned)__builtin_amdgcn_s_getreg((3 << 11) | 20) & 0xFu; }
#define XB_SPIN(cond, bar) do { unsigned _sp = 0; while (cond) { __builtin_amdgcn_s_sleep(1); \
    if ((++_sp & 255u) == 0u) { if (xb_ld(&(bar)[XB_TMO])) break; if (_sp > XB_SPIN_CAP) { atomicAdd(&(bar)[XB_TMO], 1u); break; } } } } while (0)
struct XcdBarrier { unsigned* bar; unsigned x; volatile LAS unsigned* st; };
__device__ __forceinline__ XcdBarrier xcd_barrier_post(unsigned* bar, volatile LAS unsigned* st) {
    XcdBarrier b; b.bar = bar; b.x = xb_xcc_id(); b.st = st;
    if (threadIdx.x == 0) (void)xb_add(&bar[XB_XCNT(b.x)], 1u);
    return b;
}
__device__ __forceinline__ void xcd_barrier_complete(unsigned* bar, unsigned x, unsigned& nloc, unsigned& nx) {
    const unsigned G = gridDim.x * gridDim.y * gridDim.z;
    unsigned sum, cnt, mine, sp = 0u;
    for (;;) {
        sum = 0u; cnt = 0u; mine = 0u;
#pragma unroll
        for (unsigned j = 0; j < 16; ++j) { const unsigned c = xb_ld(&bar[XB_XCNT(j)]); sum += c; cnt += (c > 0u) ? 1u : 0u; mine = (j == x) ? c : mine; }
        if (sum == G) break;
        __builtin_amdgcn_s_sleep(1);
        if ((++sp & 255u) == 0u) { if (xb_ld(&bar[XB_TMO])) break; if (sp > XB_SPIN_CAP) { atomicAdd(&bar[XB_TMO], 1u); break; } }
    }
    nloc = mine > 0u ? mine : 1u; nx = cnt > 0u ? cnt : 1u;
}
__device__ __forceinline__ void xcd_barrier(const XcdBarrier& b) {
    asm volatile("s_waitcnt vmcnt(0)" ::: "memory");
    __syncthreads();
    if (threadIdx.x == 0) {
        unsigned* bar = b.bar;
        __builtin_amdgcn_s_waitcnt(0);
        unsigned nloc = b.st[0], nx = b.st[1];
        if (nloc == 0u) { xcd_barrier_complete(bar, b.x, nloc, nx); b.st[0] = nloc; b.st[1] = nx; }
        const unsigned old = xb_add(&bar[XB_XSUB(b.x)], 1u);
        const unsigned gen = old / nloc;
        if (old + 1u == (gen + 1u) * nloc) {
            __builtin_amdgcn_fence(__ATOMIC_RELEASE, "agent");
            asm volatile("s_waitcnt vmcnt(0)" ::: "memory");
            const unsigned og = xb_add(&bar[XB_TOP], 1u);
            const unsigned tg = og / nx;
            if (og + 1u == (tg + 1u) * nx) xb_add(&bar[XB_TOPGEN], 1u);
            else XB_SPIN(xb_ld(&bar[XB_TOPGEN]) == tg, bar);
            __builtin_amdgcn_fence(__ATOMIC_ACQUIRE, "agent");
            xb_add(&bar[XB_XGEN(b.x)], 1u);
            asm volatile("s_waitcnt vmcnt(0)" ::: "memory");
        } else {
            XB_SPIN(xb_ld(&bar[XB_XGEN(b.x)]) == gen, bar);
            __builtin_amdgcn_fence(__ATOMIC_ACQUIRE, "agent");
            asm volatile("s_waitcnt vmcnt(0)" ::: "memory");
        }
    }
    __syncthreads();
}
constexpr int CW_BAR = 4096;
constexpr int MISC_OFF = 147456;


namespace peer2 {
#define P2_LAS __attribute__((address_space(3)))
typedef float f32x2v __attribute__((ext_vector_type(2)));
constexpr int CW_TICK = 8192;
__device__ __forceinline__ float dpp_add_xor1(float v) { return v + __builtin_bit_cast(float, __builtin_amdgcn_update_dpp(0, __builtin_bit_cast(int, v), 0xB1, 0xf, 0xf, true)); }
__device__ __forceinline__ float dpp_add_xor2(float v) { return v + __builtin_bit_cast(float, __builtin_amdgcn_update_dpp(0, __builtin_bit_cast(int, v), 0x4E, 0xf, 0xf, true)); }
__device__ __forceinline__ float dpp_add_hmir(float v) { return v + __builtin_bit_cast(float, __builtin_amdgcn_update_dpp(0, __builtin_bit_cast(int, v), 0x141, 0xf, 0xf, true)); }
__device__ __forceinline__ float dpp_ror8(float v) { return __builtin_bit_cast(float, __builtin_amdgcn_update_dpp(0, __builtin_bit_cast(int, v), 0x128, 0xf, 0xf, true)); }
__device__ __forceinline__ float swap32_sum(float a, float b) { auto r = __builtin_amdgcn_permlane32_swap(__builtin_bit_cast(unsigned, a), __builtin_bit_cast(unsigned, b), false, false); return __builtin_bit_cast(float, r[0]) + __builtin_bit_cast(float, r[1]); }
struct Own { int j, rank, nrank, nsl; };
__device__ __forceinline__ Own ownership(unsigned* ctl, P2_LAS unsigned* scr, int phase, int wave) {
    const int G = gridDim.x;
    if (threadIdx.x == 0) {
        unsigned* bar = ctl + CW_BAR; bool uni = (G % 8) == 0;
        for (int j = 0; j < 8; ++j) uni = uni && (xb_ld(&bar[XB_XCNT(j)]) == (unsigned)(G / 8));
        const unsigned xcc = xb_xcc_id();
        if (uni && xcc < 8u) { scr[0] = xcc; scr[1] = xb_add(&ctl[CW_TICK + 64 * (8 * phase + (int)xcc)], 1u); }
        else { scr[0] = blockIdx.x & 7; scr[1] = blockIdx.x >> 3; }
    }
    __syncthreads();
    Own o;
    if (G % 8 == 0) { o.j = (int)scr[0]; o.rank = (int)scr[1] * 8 + wave; o.nrank = G; o.nsl = 8; }
    else { o.j = 0; o.rank = blockIdx.x * 8 + wave; o.nrank = G * 8; o.nsl = 1; }
    return o;
}
__device__ __forceinline__ float dot16_fp8(const float (&x)[16], const u32x4 u) {
    const unsigned w[4] = {u.x, u.y, u.z, u.w}; f32x2v a = {0.f, 0.f};
#pragma unroll
    for (int q = 0; q < 4; ++q) { const f32x2v lo = __builtin_amdgcn_cvt_pk_f32_fp8((int)w[q], false), hi = __builtin_amdgcn_cvt_pk_f32_fp8((int)w[q], true);
        a = __builtin_elementwise_fma((f32x2v){x[4 * q], x[4 * q + 1]}, lo, a); a = __builtin_elementwise_fma((f32x2v){x[4 * q + 2], x[4 * q + 3]}, hi, a); }
    return a.x + a.y;
}
__device__ __forceinline__ void u_wave(const float* __restrict__ X, const unsigned char* __restrict__ PU, const int* __restrict__ IDX, float* __restrict__ PART, int j, int rank, int nrank, int lane) {
    const int sub = lane & 7, grp = lane >> 3, col0 = 128 * j + 16 * sub;
    float* part = PART + (size_t)j * M * 128 + 16 * grp;
#define PU_LOADIDX(idv, xv, t_) do { const int tt_ = ((t_) < M) ? (t_) : (M - 1); const u32x4* ip_ = (const u32x4*)(IDX + (size_t)tt_ * 128 + 16 * grp); \
        _Pragma("unroll") for (int q_ = 0; q_ < 4; ++q_) { const u32x4 v_ = ip_[q_]; idv[4 * q_] = (int)v_.x; idv[4 * q_ + 1] = (int)v_.y; idv[4 * q_ + 2] = (int)v_.z; idv[4 * q_ + 3] = (int)v_.w; } \
        const f32x4* xp_ = (const f32x4*)(X + (size_t)tt_ * D + col0); \
        _Pragma("unroll") for (int q_ = 0; q_ < 4; ++q_) { const f32x4 v_ = xp_[q_]; xv[4 * q_] = v_.x; xv[4 * q_ + 1] = v_.y; xv[4 * q_ + 2] = v_.z; xv[4 * q_ + 3] = v_.w; } } while (0)
#define PU_GATHER(ubv, idv) do { _Pragma("unroll") for (int it_ = 0; it_ < 16; ++it_) ubv[it_] = *(const u32x4*)(PU + (size_t)j * (PK * PK * 128) + (size_t)idv[it_] * 128 + 16 * sub); } while (0)
#define PU_COMPUTE(ubv, xv, t_) do { float k0_ = 0.f, k1_ = 0.f; _Pragma("unroll") for (int it_ = 0; it_ < 16; ++it_) { float a_ = dot16_fp8(xv, ubv[it_]); a_ = dpp_add_xor1(a_); a_ = dpp_add_xor2(a_); a_ = dpp_add_hmir(a_); \
            if (it_ < 8) k0_ = ((it_ & 7) == sub) ? a_ : k0_; else k1_ = ((it_ & 7) == sub) ? a_ : k1_; } \
        if ((t_) < M) { part[(size_t)(t_) * 128 + sub] = k0_; part[(size_t)(t_) * 128 + sub + 8] = k1_; } } while (0)
    int idA[16], idB[16]; float xA[16], xB[16], xc[16]; u32x4 ubA[16], ubB[16];
    int t = rank;
    PU_LOADIDX(idA, xA, t); PU_GATHER(ubA, idA);
    PU_LOADIDX(idB, xB, t + nrank);
    for (; t < M; t += 2 * nrank) {
        PU_GATHER(ubB, idB);
#pragma unroll
        for (int q = 0; q < 16; ++q) xc[q] = xA[q];
        PU_LOADIDX(idA, xA, t + 2 * nrank);
        PU_COMPUTE(ubA, xc, t);
        PU_GATHER(ubA, idA);
#pragma unroll
        for (int q = 0; q < 16; ++q) xc[q] = xB[q];
        PU_LOADIDX(idB, xB, t + 3 * nrank);
        PU_COMPUTE(ubB, xc, t + nrank);
    }
#undef PU_LOADIDX
#undef PU_GATHER
#undef PU_COMPUTE
}
__device__ __forceinline__ void v_wave(float* __restrict__ X, const unsigned char* __restrict__ PV, const int* __restrict__ IDX, const float* __restrict__ GATE, const float* __restrict__ PART, P2_LAS float* wbuf, int j, int rank, int nrank, int lane) {
    const int sub = lane & 7, grp = lane >> 3, col0 = 128 * j + 16 * sub;
    const bool h32 = (lane & 32) != 0, h16 = (lane & 16) != 0, h8 = (lane & 8) != 0; const int cq = ((lane >> 5) & 1) * 8 + ((lane >> 4) & 1) * 4 + ((lane >> 3) & 1) * 2;
#define PV_ISSUE(vbv, hv, gv, t_) do { const int tt_ = ((t_) < M) ? (t_) : (M - 1); int id_[16]; const u32x4* ip_ = (const u32x4*)(IDX + (size_t)tt_ * 128 + 16 * grp); \
        _Pragma("unroll") for (int q_ = 0; q_ < 4; ++q_) { const u32x4 v_ = ip_[q_]; id_[4 * q_] = (int)v_.x; id_[4 * q_ + 1] = (int)v_.y; id_[4 * q_ + 2] = (int)v_.z; id_[4 * q_ + 3] = (int)v_.w; } \
        _Pragma("unroll") for (int it_ = 0; it_ < 16; ++it_) vbv[it_] = *(const u32x4*)(PV + (size_t)j * (PK * PK * 128) + (size_t)id_[it_] * 128 + 16 * sub); \
        _Pragma("unroll") for (int jj_ = 0; jj_ < 8; ++jj_) { const float* pp_ = PART + ((size_t)jj_ * M + tt_) * 128; hv[2 * jj_] = pp_[lane]; hv[2 * jj_ + 1] = pp_[64 + lane]; } \
        gv[0] = GATE[(size_t)tt_ * 128 + lane]; gv[1] = GATE[(size_t)tt_ * 128 + 64 + lane]; } while (0)
#define PV_COMPUTE(vbv, hv, gv, t_) do { float h0_ = 0.f, h1_ = 0.f; _Pragma("unroll") for (int jj_ = 0; jj_ < 8; ++jj_) { h0_ += hv[2 * jj_]; h1_ += hv[2 * jj_ + 1]; } \
        h0_ *= (1.f / sp::PEER_SU); h1_ *= (1.f / sp::PEER_SU); \
        const float w0_ = gv[0] * 0.5f * h0_ * (1.f + erff(h0_ * 0.70710678118654752f)), w1_ = gv[1] * 0.5f * h1_ * (1.f + erff(h1_ * 0.70710678118654752f)); \
        f32x2v y_[8]; _Pragma("unroll") for (int q_ = 0; q_ < 8; ++q_) y_[q_] = (f32x2v){0.f, 0.f}; \
        wbuf[lane] = w0_; wbuf[64 + lane] = w1_; asm volatile("s_waitcnt lgkmcnt(0)" ::: "memory");        \
        float wl_[16]; _Pragma("unroll") for (int q_ = 0; q_ < 4; ++q_) { const f32x4 v_ = *(const P2_LAS f32x4*)(wbuf + 16 * grp + 4 * q_); wl_[4 * q_] = v_.x; wl_[4 * q_ + 1] = v_.y; wl_[4 * q_ + 2] = v_.z; wl_[4 * q_ + 3] = v_.w; } \
        asm volatile("s_waitcnt lgkmcnt(0)" ::: "memory"); \
        _Pragma("unroll") for (int it_ = 0; it_ < 16; ++it_) { const float wq_ = wl_[it_]; \
            const unsigned ww_[4] = {vbv[it_].x, vbv[it_].y, vbv[it_].z, vbv[it_].w}; const f32x2v wv_ = {wq_, wq_}; \
            _Pragma("unroll") for (int q_ = 0; q_ < 4; ++q_) { y_[2 * q_] = __builtin_elementwise_fma(wv_, __builtin_amdgcn_cvt_pk_f32_fp8((int)ww_[q_], false), y_[2 * q_]); y_[2 * q_ + 1] = __builtin_elementwise_fma(wv_, __builtin_amdgcn_cvt_pk_f32_fp8((int)ww_[q_], true), y_[2 * q_ + 1]); } } \
        float yy_[16]; _Pragma("unroll") for (int k_ = 0; k_ < 8; ++k_) { yy_[2 * k_] = y_[k_].x; yy_[2 * k_ + 1] = y_[k_].y; } \
          \
        float y8_[8], y4_[4], y2_[2]; \
        _Pragma("unroll") for (int k_ = 0; k_ < 8; ++k_) y8_[k_] = (h32 ? yy_[k_ + 8] : yy_[k_]) + __shfl_xor(h32 ? yy_[k_] : yy_[k_ + 8], 32); \
        _Pragma("unroll") for (int k_ = 0; k_ < 4; ++k_) y4_[k_] = (h16 ? y8_[k_ + 4] : y8_[k_]) + __shfl_xor(h16 ? y8_[k_] : y8_[k_ + 4], 16); \
        _Pragma("unroll") for (int k_ = 0; k_ < 2; ++k_) y2_[k_] = (h8 ? y4_[k_ + 2] : y4_[k_]) + dpp_ror8(h8 ? y4_[k_] : y4_[k_ + 2]); \
        if ((t_) < M) { f32x2v* xp_ = (f32x2v*)(X + (size_t)(t_) * D + col0 + cq); f32x2v xv_ = *xp_; \
            xv_.x = ALPHA * xv_.x + y2_[0] * (1.f / sp::PEER_SV); xv_.y = ALPHA * xv_.y + y2_[1] * (1.f / sp::PEER_SV); *xp_ = xv_; } } while (0)
    u32x4 vbA[16], vbB[16]; float hA[16], hB[16], gA[2], gB[2];
    int t = rank;
    PV_ISSUE(vbA, hA, gA, t);
    for (; t < M; t += 2 * nrank) {
        PV_ISSUE(vbB, hB, gB, t + nrank);
        PV_COMPUTE(vbA, hA, gA, t);
        PV_ISSUE(vbA, hA, gA, t + 2 * nrank);
        PV_COMPUTE(vbB, hB, gB, t + nrank);
    }
#undef PV_ISSUE
#undef PV_COMPUTE
}
__device__ __forceinline__ void ln_row_plain(float* __restrict__ X, const float* __restrict__ g, const float* __restrict__ b, int row, int lane) {
    f32x4* xr = (f32x4*)(X + (size_t)row * D) + lane;
    f32x4 v[4]; float s = 0.f;
#pragma unroll
    for (int jq = 0; jq < 4; ++jq) { v[jq] = xr[64 * jq]; s += (v[jq].x + v[jq].y) + (v[jq].z + v[jq].w); }
    const float mean = wave_sum(s) * (1.f / D); float s2 = 0.f;
#pragma unroll
    for (int jq = 0; jq < 4; ++jq) { v[jq] = v[jq] - mean; s2 += (v[jq].x * v[jq].x + v[jq].y * v[jq].y) + (v[jq].z * v[jq].z + v[jq].w * v[jq].w); }
    const float rstd = rsqrtf(wave_sum(s2) * (1.f / D) + 1e-5f);
#pragma unroll
    for (int jq = 0; jq < 4; ++jq) { const int c = 4 * lane + 256 * jq; const f32x4 gg = *(const f32x4*)(g + c), bb = *(const f32x4*)(b + c); xr[64 * jq] = v[jq] * rstd * gg + bb; }
}
}

struct Params { const float* in[30]; float* out; unsigned char* ws; };
template <class F> __device__ __forceinline__ void run_gemm(unsigned char* lds, const bf16_t* A, int lda, const bf16_t* Bt, int Mr, int N, int K, F f) {
    pg8::Gemm g{A, Bt, Mr, N, K, lda}; pg8::StaticOrder S; S.init(Mr, N, gridDim.x, blockIdx.x); pg8::EpiAdapt<F> E{f};
    pg8::gemm_phase<pg8::EpiAdapt<F>, pg8::StaticOrder, true>((PG8_LAS unsigned char*)lds, g, S, E);
}
#ifndef PROBE_ATTN
#define PROBE_ATTN 0
#endif
#ifndef PROBE_SSD
#define PROBE_SSD 0
#endif
#ifndef PROBE_SYNC
#define PROBE_SYNC 0
#endif
#define KA_LAS __attribute__((address_space(4)))
#define PH_BEGIN const KA_LAS unsigned char* ka_ = (const KA_LAS unsigned char*)__builtin_amdgcn_kernarg_segment_ptr(); asm volatile("" : "+s"(ka_))
#define PIN(k) (*(const float* const KA_LAS*)(ka_ + 8 * (k)))
#define POUT (*(float* const KA_LAS*)(ka_ + 240))
#define PWS (*(unsigned char* const KA_LAS*)(ka_ + 248))
__global__ void __launch_bounds__(512, 2) hybrid_fwd(Params P) {
    extern __shared__ __attribute__((aligned(16))) unsigned char lds[];
    cg::grid_group grid = cg::this_grid();
    { PH_BEGIN; volatile LAS unsigned* misc = (volatile LAS unsigned*)((LAS unsigned char*)lds + MISC_OFF);
      if (threadIdx.x < 16) misc[threadIdx.x] = 0u;
      __syncthreads();
      (void)xcd_barrier_post((unsigned*)(PWS + WS_CTL) + CW_BAR, misc);
      if (PWS == nullptr) grid.sync(); }
#define GSYNC() do { PH_BEGIN; XcdBarrier xb_; xb_.bar = (unsigned*)(PWS + WS_CTL) + CW_BAR; xb_.x = xb_xcc_id(); xb_.st = (volatile LAS unsigned*)((LAS unsigned char*)lds + MISC_OFF); xcd_barrier(xb_); } while (0)
    {
        PH_BEGIN; unsigned char* ws = PWS;
        const int tid = opaque_tid(), lane = tid & 63, wave = __builtin_amdgcn_readfirstlane(tid >> 6), c = blockIdx.x, G = gridDim.x;
        const size_t gtid = (size_t)c * 512 + tid, gthreads = (size_t)G * 512; const int gw = c * 8 + wave, NGW = G * 8;
        const float* w_in = PIN(2);
        bf16_t* WinT = (bf16_t*)(ws + WS_WIN); bf16_t* WckvT = (bf16_t*)(ws + WS_WCKV);
        SP_LAS float* scr = (SP_LAS float*)lds + wave * (64 * 33);
        constexpr int I0 = 2560, I1 = 5120, I2 = 6144, I3 = 6656, I4 = 7168, I5 = 7680, I6 = 8192, I7 = 8704, I8 = 9216, I9 = 10240;
        for (int it = gw; it < I9; it += NGW) {
            if (it < I0) sp::transpose_item(w_in, NIN, 0, D, 160, WinT, 0, scr, it, lane);
            else if (it < I1) sp::transpose_item(w_in, NIN, 5152, D, 160, WinT, 5120, scr, it - I0, lane);
            else if (it < I2) sp::transpose_item(PIN(9), D, 0, DI, 32, (bf16_t*)(ws + WS_WSSD), 0, scr, it - I1, lane);
            else if (it < I3) sp::transpose_item(PIN(13), D, 0, D, 32, (bf16_t*)(ws + WS_WDIFF), 0, scr, it - I2, lane);
            else if (it < I4) sp::transpose_item(PIN(15), D, 0, D, 32, (bf16_t*)(ws + WS_WO), 0, scr, it - I3, lane);
            else if (it < I5) sp::transpose_item(PIN(18), D, 0, D, 32, (bf16_t*)(ws + WS_WCQ), 0, scr, it - I4, lane);
            else if (it < I6) sp::transpose_item(PIN(19), D, 0, D, 32, WckvT, 0, scr, it - I5, lane);
            else if (it < I7) sp::transpose_item(PIN(20), D, 0, D, 32, WckvT, 1024, scr, it - I6, lane);
            else if (it < I8) sp::transpose_item(PIN(21), D, 0, D, 32, (bf16_t*)(ws + WS_WCO), 0, scr, it - I7, lane);
            else sp::transpose_item(PIN(24), 2048, 0, D, 64, (bf16_t*)(ws + WS_WPQ), 0, scr, it - I8, lane);
        }
        const float* x = PIN(0);
        sp::cvt_range(x, (bf16_t*)(ws + WS_XB), (size_t)M * D / 4, gtid, gthreads);
        sp::cvt_range(PIN(1), (bf16_t*)(ws + WS_MEMB), (size_t)BATCH * MEML * D / 4, gtid, gthreads);
        sp::cvt_range(PIN(25), (bf16_t*)(ws + WS_SUBK), (size_t)PH * 2 * PK * PHALF / 4, gtid, gthreads);
        __syncthreads();
        sp::dt_stage_w((SP_LAS float*)lds, w_in);
        for (int it = c; it < M / 4; it += G) sp::dt_item((SP_LAS float*)lds, (SP_LAS float*)lds + 32768, (SP_LAS float*)lds + 36896  , x, PIN(5), (float*)(ws + WS_DT), it);
        __syncthreads();
        if (c == 0 && tid == 0) { const float* lam_q = PIN(10); const float* lam_k = PIN(11); float s0 = 0.f, s1 = 0.f;
            for (int i = 0; i < 64; ++i) { s0 += lam_q[i] * lam_k[i]; s1 += lam_q[64 + i] * lam_k[64 + i]; }
            ((float*)(ws + WS_CTL))[CW_LAM] = expf(s0) - expf(s1) + LAMBDA_INIT; }
    }
    GSYNC();
    { PH_BEGIN; unsigned char* ws = PWS;
      run_gemm(lds, (const bf16_t*)(ws + WS_MEMB), D, (const bf16_t*)(ws + WS_WCKV), BATCH * MEML, D, D, EpiPlain{(bf16_t*)(ws + WS_KCVC), D, 1.f});
      for (int bb = 0; bb < BATCH; ++bb)
          run_gemm(lds, (const bf16_t*)(ws + WS_WCKV) + (size_t)D * D, D, (const bf16_t*)(ws + WS_MEMB) + (size_t)bb * MEML * D, D, MEML, D, EpiPlain{(bf16_t*)(ws + WS_KCVC) + (size_t)BATCH * MEML * D + (size_t)bb * D * MEML, MEML, 1.f});
      run_gemm(lds, (const bf16_t*)(ws + WS_XB), D, (const bf16_t*)(ws + WS_WIN), SEQ, NINP, D, EpiInProj{(bf16_t*)(ws + WS_H), PIN(14)}); }
    GSYNC();
#pragma unroll 1
    for (int b = 0; b < BATCH; ++b) {
        { PH_BEGIN; unsigned char* ws = PWS; const int c = blockIdx.x, G = gridDim.x;
          bf16_t* H = (bf16_t*)(ws + WS_H); const float* DTb = (const float*)(ws + WS_DT) + (size_t)b * SEQ * 32;
          for (int u = c; u < 256; u += G) ssd::phaseA_unit((SS_LAS unsigned char*)lds, H, DTb, PIN(3), PIN(4), PIN(6), (bf16_t*)(ws + WS_T1), (float*)(ws + WS_CTL) + 1024, u >> 2, u & 3);
          const float lam = ((const float*)(ws + WS_CTL))[CW_LAM]; const float* subln_w = PIN(12);
#if PROBE_ATTN
          for (int u = c; u < 256; u += G) { const int h = u >> 5, j = u & 31;
              dattn::unit<false>((DA_LAS unsigned char*)lds, H, h, 63 - j, subln_w, lam);
              dattn::unit<false>((DA_LAS unsigned char*)lds, H, h, j, subln_w, lam); }
#endif
          for (int u = c; u < 256; u += G) { const int h = u >> 5, j = u & 31;
              dattn::unit((DA_LAS unsigned char*)lds, H, h, 63 - j, subln_w, lam);
              dattn::unit((DA_LAS unsigned char*)lds, H, h, j, subln_w, lam); } }
        GSYNC();
        { PH_BEGIN; unsigned char* ws = PWS; const int tid = opaque_tid();
          for (size_t i = (size_t)blockIdx.x * 512 + tid; i < 131072; i += (size_t)gridDim.x * 512) ssd::scan_phase((bf16_t*)(ws + WS_T1), (const float*)(ws + WS_CTL) + 1024, (int)i); }
        GSYNC();
        { PH_BEGIN; unsigned char* ws = PWS; const int c = blockIdx.x, G = gridDim.x;
#if PROBE_SSD
          for (int u = c; u < 256; u += G) ssd::phaseA_unit((SS_LAS unsigned char*)lds, (bf16_t*)(ws + WS_H), (const float*)(ws + WS_DT) + (size_t)b * SEQ * 32, PIN(3), PIN(4), PIN(6), (bf16_t*)(POUT + (size_t)SEQ * D), (float*)(ws + WS_CTL) + 8192, u >> 2, u & 3);
          for (int u = c; u < 256; u += G) ssd::phaseC_unit<false>((SS_LAS unsigned char*)lds, (bf16_t*)(ws + WS_H), (const float*)(ws + WS_DT) + (size_t)b * SEQ * 32, PIN(3), PIN(4), PIN(6), PIN(7), PIN(8), (const bf16_t*)(ws + WS_T1), u >> 2, u & 3);
#endif
          for (int u = c; u < 256; u += G) ssd::phaseC_unit((SS_LAS unsigned char*)lds, (bf16_t*)(ws + WS_H), (const float*)(ws + WS_DT) + (size_t)b * SEQ * 32, PIN(3), PIN(4), PIN(6), PIN(7), PIN(8), (const bf16_t*)(ws + WS_T1), u >> 2, u & 3); }
        GSYNC();
        { PH_BEGIN; unsigned char* ws = PWS; bf16_t* H = (bf16_t*)(ws + WS_H); float* T1 = (float*)(ws + WS_T1);
          run_gemm(lds, H + HC_Z, HP_, (const bf16_t*)(ws + WS_WSSD), SEQ, D, DI, EpiGate1{H, T1});
          run_gemm(lds, H + HC_Q, HP_, (const bf16_t*)(ws + WS_WDIFF), SEQ, D, D, EpiGate2{H, T1});
          if (b == BATCH - 1 && 2 * (int)blockIdx.x >= (int)gridDim.x) { const int tid = opaque_tid(); const int half = (gridDim.x + 1) / 2;
              const size_t gt = (size_t)(blockIdx.x - half) * 512 + tid, gn = (size_t)(gridDim.x - half) * 512;
              sp::cvt_fp8_range(PIN(26), ws + WS_PU, (size_t)PK * PK * D / 16, sp::PEER_SU, gt, gn);
              sp::cvt_fp8_range(PIN(27), ws + WS_PV, (size_t)PK * PK * D / 16, sp::PEER_SV, gt, gn); } }
        GSYNC();
        { PH_BEGIN; unsigned char* ws = PWS;
          run_gemm(lds, (const bf16_t*)(ws + WS_H) + HC_K, HP_, (const bf16_t*)(ws + WS_WO), SEQ, D, D, EpiResid{PIN(0), POUT, b * SEQ, 0}); }
        GSYNC();
        if (b + 1 < BATCH) {
            { PH_BEGIN; unsigned char* ws = PWS;
              run_gemm(lds, (const bf16_t*)(ws + WS_XB) + (size_t)(b + 1) * SEQ * D, D, (const bf16_t*)(ws + WS_WIN), SEQ, NINP, D, EpiInProj{(bf16_t*)(ws + WS_H), PIN(14)}); }
            GSYNC();
        }
    }
    { PH_BEGIN; unsigned char* ws = PWS; const int tid = opaque_tid(), lane = tid & 63, wave = __builtin_amdgcn_readfirstlane(tid >> 6), c = blockIdx.x, G = gridDim.x;
      float* out = POUT; const float* g = PIN(16); const float* bb = PIN(17); bf16_t* XB = (bf16_t*)(ws + WS_X1B);
      for (int r = c * 8 + wave; r < M; r += G * 8) sp::ln_row(out, g, bb, XB, r, lane); }
    GSYNC();
    { PH_BEGIN; unsigned char* ws = PWS;
      run_gemm(lds, (const bf16_t*)(ws + WS_X1B), D, (const bf16_t*)(ws + WS_WCQ), M, D, D, EpiPlain{(bf16_t*)(ws + WS_QC), D, CQSCALE}); }
    GSYNC();
    { PH_BEGIN; unsigned char* ws = PWS; const int c = blockIdx.x, G = gridDim.x;
      for (int u = c; u < 256; u += G) xattn::unit((XA_LAS unsigned char*)lds, (const bf16_t*)(ws + WS_QC), (const bf16_t*)(ws + WS_KCVC), (const bf16_t*)(ws + WS_KCVC) + (size_t)BATCH * MEML * D, (bf16_t*)(ws + WS_XO), u >> 2, u & 3); }
    GSYNC();
    { PH_BEGIN; unsigned char* ws = PWS; float* out = POUT;
      run_gemm(lds, (const bf16_t*)(ws + WS_XO), D, (const bf16_t*)(ws + WS_WCO), M, D, D, EpiResid{out, out, 0, 0}); }
    GSYNC();
    { PH_BEGIN; unsigned char* ws = PWS; const int tid = opaque_tid(), lane = tid & 63, wave = __builtin_amdgcn_readfirstlane(tid >> 6), c = blockIdx.x, G = gridDim.x;
      float* out = POUT; const float* g = PIN(22); const float* bb = PIN(23); bf16_t* XB = (bf16_t*)(ws + WS_X1B);
      for (int r = c * 8 + wave; r < M; r += G * 8) sp::ln_row(out, g, bb, XB, r, lane); }
    GSYNC();
    { PH_BEGIN; unsigned char* ws = PWS;
      run_gemm(lds, (const bf16_t*)(ws + WS_X1B), D, (const bf16_t*)(ws + WS_WPQ), M, 2048, D, EpiPlain{(bf16_t*)(ws + WS_QP), 2048, 1.f}); }
    GSYNC();
    { PH_BEGIN; unsigned char* ws = PWS; const int c = blockIdx.x, G = gridDim.x;
      for (int t = 64 * c; t < M; t += 64 * G) {
          for (int hp = 0; hp < 4; ++hp) psel::stage1((PS_LAS int*)lds, (const bf16_t*)(ws + WS_QP), (const bf16_t*)(ws + WS_SUBK), t, hp);
          __syncthreads();
          psel::stage2((PS_LAS int*)lds, (int*)(ws + WS_IDX), (float*)(ws + WS_GATE), t);
          __syncthreads(); } }
    GSYNC();
    { PH_BEGIN; unsigned char* ws = PWS; const int tid = opaque_tid(), lane = tid & 63, wave = __builtin_amdgcn_readfirstlane(tid >> 6);
      const peer2::Own o = peer2::ownership((unsigned*)(ws + WS_CTL), (P2_LAS unsigned*)lds, 0, wave);
      for (int jj = o.j; jj < 8; jj += o.nsl) peer2::u_wave(POUT, ws + WS_PU, (const int*)(ws + WS_IDX), (float*)(ws + WS_PART), jj, o.rank, o.nrank, lane); }
    GSYNC();
    { PH_BEGIN; unsigned char* ws = PWS; const int tid = opaque_tid(), lane = tid & 63, wave = __builtin_amdgcn_readfirstlane(tid >> 6);
      const peer2::Own o = peer2::ownership((unsigned*)(ws + WS_CTL), (P2_LAS unsigned*)lds, 1, wave);
      for (int jj = o.j; jj < 8; jj += o.nsl) peer2::v_wave(POUT, ws + WS_PV, (const int*)(ws + WS_IDX), (const float*)(ws + WS_GATE), (const float*)(ws + WS_PART), (P2_LAS float*)lds + 64 + wave * 128, jj, o.rank, o.nrank, lane); }
    GSYNC();
    { PH_BEGIN; const int tid = opaque_tid(), lane = tid & 63, wave = __builtin_amdgcn_readfirstlane(tid >> 6);
      float* out = POUT; const float* g3 = PIN(28); const float* b3 = PIN(29);
      for (int r = blockIdx.x * 8 + wave; r < M; r += gridDim.x * 8) peer2::ln_row_plain(out, g3, b3, r, lane); }
}

extern "C" void kernel_launch(void* const* d_in, const int* in_sizes, int n_in, void* d_out, int out_size, void* d_ws, size_t ws_size, hipStream_t stream) {
    static int grid_blocks = 0;
    if (grid_blocks == 0) {
        if (n_in != 30 || out_size != M * D || ws_size < WS_END) { fprintf(stderr, "kernel_launch: unexpected sizes n_in %d out %d ws %zu (need %zu)\n", n_in, out_size, ws_size, (size_t)WS_END); grid_blocks = -1; return; }
        int dev = 0, cus = 0, per_cu = 0;
        (void)hipGetDevice(&dev); (void)hipDeviceGetAttribute(&cus, hipDeviceAttributeMultiprocessorCount, dev);
        (void)hipFuncSetAttribute((const void*)hybrid_fwd, hipFuncAttributeMaxDynamicSharedMemorySize, LDS_BYTES);
        if (hipOccupancyMaxActiveBlocksPerMultiprocessor(&per_cu, (const void*)hybrid_fwd, 512, LDS_BYTES) != hipSuccess || per_cu < 1) { fprintf(stderr, "kernel_launch: occupancy query failed (%d)\n", per_cu); per_cu = 1; }
        (void)hipGetLastError();
        grid_blocks = cus * 1;
    }
    if (grid_blocks < 0) return;
    if (hipMemsetAsync(d_ws, 0, 65536, stream) != hipSuccess) { fprintf(stderr, "kernel_launch: memset of control words failed\n"); return; }
    Params p{};
    for (int i = 0; i < 30; ++i) p.in[i] = (const float*)d_in[i];
    p.out = (float*)d_out; p.ws = (unsigned char*)d_ws;
    void* args[] = {&p};
    hipError_t e = hipLaunchCooperativeKernel((const void*)hybrid_fwd, dim3(grid_blocks), dim3(512), args, LDS_BYTES, stream);
    if (e != hipSuccess) fprintf(stderr, "cooperative launch failed: %s (grid %d)\n", hipGetErrorString(e), grid_blocks);
}
```

```cpp
#include <hip/hip_runtime.h>
#include <hip/hip_cooperative_groups.h>
namespace cg = cooperative_groups;
#include <cstdio>
#include <cstdint>
#include <cmath>
#include <type_traits>

typedef unsigned short bf16_t;
typedef float f32x4 __attribute__((ext_vector_type(4)));
typedef unsigned u32x4 __attribute__((ext_vector_type(4)));
typedef unsigned u32x2 __attribute__((ext_vector_type(2)));

constexpr int D = 1024, BATCH = 2, SEQ = 8192, M = BATCH * SEQ;
constexpr int DI = 2048, NH = 32, HP = 64, NG = 4, DS = 128, DXBC = 3072;
constexpr int AH = 8, AD = 64, AV = 128;
constexpr int MEML = 256, MH = 4, MHD = 256;
constexpr int PH = 8, PK = 128, PDK = 256, PHALF = 128, PTOP = 16;
constexpr int NIN = 10272, NINP = 10240;
constexpr float ALPHA = 1.189207115002721f;
constexpr float LOG2E = 1.4426950408889634f;
constexpr float QSCALE = 0.125f * LOG2E;
constexpr float CQSCALE = 0.0625f * LOG2E;
constexpr float LAMBDA_INIT = 0.2f;
constexpr int HC_Z = 0, HC_XBC = 2048, HC_Q = 5120, HC_K = 6144, HC_V = 7168, HC_GS = 8192, HC_GA = 9216, HP_ = NINP;

constexpr size_t MiB = 1u << 20;
constexpr size_t WS_CTL = 0;
constexpr size_t WS_WIN = 1 * MiB;
constexpr size_t WS_WSSD = 21 * MiB;
constexpr size_t WS_WDIFF = 25 * MiB, WS_WO = 27 * MiB, WS_WCQ = 29 * MiB, WS_WCKV = 31 * MiB  , WS_WCO = 35 * MiB;
constexpr size_t WS_WPQ = 37 * MiB;
constexpr size_t WS_SUBK = 41 * MiB;
constexpr size_t WS_MEMB = 42 * MiB;
constexpr size_t WS_KCVC = 43 * MiB;
constexpr size_t WS_DT = 45 * MiB;
constexpr size_t WS_XB = 47 * MiB;
constexpr size_t WS_H = 79 * MiB;
constexpr size_t WS_T1 = 239 * MiB;
constexpr size_t WS_PU = 47 * MiB, WS_PV = 63 * MiB;
constexpr size_t WS_X1B = 79 * MiB;
constexpr size_t WS_QC = 143 * MiB, WS_XO = 175 * MiB;
constexpr size_t WS_QP = 207 * MiB;
constexpr size_t WS_IDX = 143 * MiB, WS_GATE = 151 * MiB;
constexpr size_t WS_PART = 207 * MiB;
constexpr size_t WS_END = 271 * MiB;
constexpr int CW_LAM = 64;

__device__ __forceinline__ int opaque_tid() { int t = threadIdx.x; asm volatile("" : "+v"(t)); return t; }
__device__ __forceinline__ unsigned f2bf(float f) { unsigned u = __builtin_bit_cast(unsigned, f); return (u + 0x7fffu + ((u >> 16) & 1u)) >> 16; }
__device__ __forceinline__ float bf2f(unsigned h) { return __builtin_bit_cast(float, h << 16); }
__device__ __forceinline__ unsigned pk2(float lo, float hi) { return f2bf(lo) | (f2bf(hi) << 16); }
__device__ __forceinline__ float bflo(unsigned w) { return __builtin_bit_cast(float, w << 16); }
__device__ __forceinline__ float bfhi(unsigned w) { return __builtin_bit_cast(float, w & 0xffff0000u); }
__device__ __forceinline__ float sigmoidf_(float v) { return __builtin_amdgcn_rcpf(1.f + __expf(-v)); }
__device__ __forceinline__ float siluf_(float v) { return v * __builtin_amdgcn_rcpf(1.f + __expf(-v)); }
__device__ __forceinline__ float wave_sum(float v) {
#pragma unroll
    for (int o = 1; o < 64; o <<= 1) v += __shfl_xor(v, o);
    return v;
}
__device__ __forceinline__ float wave_max(float v) {
#pragma unroll
    for (int o = 1; o < 64; o <<= 1) v = fmaxf(v, __shfl_xor(v, o));
    return v;
}

__device__ __forceinline__ void store_bf16x8(bf16_t* p, const float (&v)[8]) { u32x4 w; w.x = pk2(v[0], v[1]); w.y = pk2(v[2], v[3]); w.z = pk2(v[4], v[5]); w.w = pk2(v[6], v[7]); *(u32x4*)p = w; }
struct EpiPlain { bf16_t* O; int ldc; float scale;
    __device__ __forceinline__ void operator()(int row, int col0, const float (&v)[8]) const { float o[8];
#pragma unroll
        for (int j = 0; j < 8; ++j) o[j] = v[j] * scale; store_bf16x8(O + (size_t)row * ldc + col0, o); } };
struct EpiInProj { bf16_t* H; const float* gate_bias;
    __device__ __forceinline__ void operator()(int row, int col0, const float (&v)[8]) const { float o[8];
        if (col0 >= HC_GS) { const float* gb = gate_bias + (col0 - HC_GS);
#pragma unroll
            for (int j = 0; j < 8; ++j) o[j] = sigmoidf_(v[j] + gb[j]); }
        else { const float s = (col0 >= HC_Q && col0 < HC_K) ? QSCALE : 1.f;
#pragma unroll
            for (int j = 0; j < 8; ++j) o[j] = v[j] * s; }
        store_bf16x8(H + (size_t)row * HP_ + col0, o); } };
struct EpiGate1 { const bf16_t* H; float* T1;
    __device__ __forceinline__ void operator()(int row, int col0, const float (&v)[8]) const {
        const u32x4 g = *(const u32x4*)(H + (size_t)row * HP_ + HC_GS + col0); const unsigned gw[4] = {g.x, g.y, g.z, g.w};
        float* t = T1 + (size_t)row * D + col0;
#pragma unroll
        for (int j = 0; j < 4; ++j) { t[2 * j] = bflo(gw[j]) * v[2 * j]; t[2 * j + 1] = bfhi(gw[j]) * v[2 * j + 1]; } } };
struct EpiGate2 { bf16_t* H; const float* T1;
    __device__ __forceinline__ void operator()(int row, int col0, const float (&v)[8]) const {
        const u32x4 g = *(const u32x4*)(H + (size_t)row * HP_ + HC_GA + col0); const unsigned gw[4] = {g.x, g.y, g.z, g.w};
        const float* t = T1 + (size_t)row * D + col0; float o[8];
#pragma unroll
        for (int j = 0; j < 4; ++j) { o[2 * j] = t[2 * j] + bflo(gw[j]) * v[2 * j]; o[2 * j + 1] = t[2 * j + 1] + bfhi(gw[j]) * v[2 * j + 1]; }
        store_bf16x8(H + (size_t)row * HP_ + HC_K + col0, o); } };
struct EpiResid { const float* base; float* out; int row_off; int pad_;
    __device__ __forceinline__ void operator()(int row, int col0, const float (&v)[8]) const {
        const size_t o = (size_t)(row + row_off) * D + col0;
#pragma unroll
        for (int j = 0; j < 8; ++j) out[o + j] = ALPHA * base[o + j] + v[j]; } };


namespace pg8 {
#define PG8_LAS __attribute__((address_space(3)))
typedef short bf16x8 __attribute__((ext_vector_type(8)));
constexpr int BM = 256, BK = 64, HALF = 128, HTB = HALF * BK * 2, STAGE_BYTES = 8 * HTB, NXCD = 8, WGM = 8;
__host__ __device__ __forceinline__ int lds_byte(int r, int c) { const int st = (r >> 4) * 2 + (c >> 5), rr = r & 15, cc = c & 31, ob = rr * 64 + cc * 2; return st * 1024 + (ob ^ (((ob >> 9) & 1) << 5)); }
__host__ __device__ __forceinline__ void stage_rc(int b, int& R, int& C) { const int st = b / 1024, sb = b % 1024, swz = sb ^ (((sb >> 9) & 1) << 5); R = (st >> 1) * 16 + swz / 64; C = (st & 1) * 32 + (swz % 64) / 2; }
__host__ __device__ __forceinline__ int perm32(int rho) { const int n = rho >> 4, i = rho & 15; return 8 * (i >> 2) + 4 * n + (i & 3); }
struct Unit { int pm, pn; };
struct Gemm { const bf16_t* A; const bf16_t* Bt; int M, N, K, lda; };
struct StaticOrder {
    int nM, nN, nwg, G, c;
    __host__ __device__ void init(int M, int N, int G_, int c_) { nM = M / BM; nN = N / BM; nwg = nM * nN; G = G_; c = c_; }
    __host__ __device__ bool next(int i, Unit& u) const {
        const long L = (long)i * G + c; if (L >= nwg) return false;
        int wgid = (int)L; { const int q = nwg / NXCD, r = nwg % NXCD, xcd = wgid % NXCD, off = wgid / NXCD; wgid = (xcd < r ? xcd * (q + 1) : r * (q + 1) + (xcd - r) * q) + off; }
        const int nig = WGM * nN, gid = wgid / nig, fm = gid * WGM, gsz = (nM - fm) < WGM ? (nM - fm) : WGM;
        u.pm = fm + ((wgid % nig) % gsz); u.pn = (wgid % nig) / gsz; return true;
    }
};
template <class F> struct EpiAdapt {
    static constexpr bool PERM = true, AFTER_DRAIN = false; F f;
    __device__ __forceinline__ void operator()(const f32x4 (&acc)[2][2][4][2], const Unit& u, int wr, int wc, int fr, int fq) const {
#pragma unroll
        for (int ai = 0; ai < 2; ++ai)
#pragma unroll
            for (int m = 0; m < 4; ++m) { const int row = u.pm * BM + ai * HALF + wr * 64 + m * 16 + fr;
#pragma unroll
                for (int bj = 0; bj < 2; ++bj) { const int col0 = u.pn * BM + bj * HALF + wc * 32 + 8 * fq;
                    const f32x4 a = acc[ai][bj][m][0], b = acc[ai][bj][m][1]; const float v[8] = {a[0], a[1], a[2], a[3], b[0], b[1], b[2], b[3]};
                    f(row, col0, v); } }
    }
};
template <class Epi, class Sched, bool ALIGN_EPI>
__device__ __forceinline__ void gemm_phase(PG8_LAS unsigned char* lds, const Gemm g, const Sched& S, const Epi& E) {
    const int tid = opaque_tid(), wid = __builtin_amdgcn_readfirstlane(tid >> 6), lane = tid & 63, wr = wid >> 2, wc = wid & 3, fr = lane & 15, fq = lane >> 4;
    const int K = g.K, nt = K / BK, lda = g.lda;
    unsigned voffA[2], voffB[2];
#pragma unroll
    for (int i = 0; i < 2; ++i) { int R, C; stage_rc(tid * 16 + i * 8192, R, C); const int Rb = Epi::PERM ? ((R & ~31) + perm32(R & 31)) : R;
        voffA[i] = (unsigned)(R * lda + C) * 2u; voffB[i] = (unsigned)(Rb * K + C) * 2u; }
    const size_t kstep = (size_t)(BK * 2);
    const size_t hstepA = (size_t)HALF * lda * 2, hstepB = (size_t)HALF * K * 2;
    const size_t tstepA = 2 * hstepA, tstepB = 2 * hstepB;
    const unsigned ldsw = (unsigned)wid * 1024u;
    const int aoff = lds_byte(wr * 64 + fr, fq * 8), boff = lds_byte(wc * 32 + fr, fq * 8);
#define PG8_SA(b, h) (((b) * 2 + (h)) * HTB)
#define PG8_SB(b, h) ((4 + (b) * 2 + (h)) * HTB)
#define PG8_STAGE(bufoff, gbase, voff) do { _Pragma("unroll") for (int _i = 0; _i < 2; ++_i) \
        __builtin_amdgcn_global_load_lds((const unsigned*)((const char*)(gbase) + (voff)[_i]), (PG8_LAS unsigned*)(lds + (bufoff) + ldsw + _i * 8192), 16, 0, 0); } while (0)
#define PG8_LDA(dst, b, h) do { _Pragma("unroll") for (int m = 0; m < 4; ++m) _Pragma("unroll") for (int k = 0; k < 2; ++k) dst[m][k] = *(const PG8_LAS bf16x8*)(lds + PG8_SA(b, h) + aoff + m * 2048 + k * 1024); } while (0)
#define PG8_LDB(dst, b, h) do { _Pragma("unroll") for (int n = 0; n < 2; ++n) _Pragma("unroll") for (int k = 0; k < 2; ++k) dst[n][k] = *(const PG8_LAS bf16x8*)(lds + PG8_SB(b, h) + boff + n * 2048 + k * 1024); } while (0)
#define PG8_MMA(ai, bj, At, Bt) do { __builtin_amdgcn_s_setprio(1); _Pragma("unroll") for (int m = 0; m < 4; ++m) _Pragma("unroll") for (int n = 0; n < 2; ++n) _Pragma("unroll") for (int k = 0; k < 2; ++k) \
        acc[ai][bj][m][n] = __builtin_amdgcn_mfma_f32_16x16x32_bf16(Bt[n][k], At[m][k], acc[ai][bj][m][n], 0, 0, 0); __builtin_amdgcn_s_setprio(0); } while (0)
#define PG8_WAIT_V(n) asm volatile("s_waitcnt vmcnt(" #n ")" ::: "memory")
#define PG8_WAIT_L(n) asm volatile("s_waitcnt lgkmcnt(" #n ")" ::: "memory")
#define PG8_BAR __builtin_amdgcn_s_barrier()
#define PG8_SCHED __builtin_amdgcn_sched_barrier(0)
    Unit cur, nxt; int ui = 0;
    if (!S.next(0, cur)) return;
    f32x4 acc[2][2][4][2];
#pragma unroll
    for (int a = 0; a < 2; ++a)
#pragma unroll
        for (int b = 0; b < 2; ++b)
#pragma unroll
            for (int m = 0; m < 4; ++m)
#pragma unroll
                for (int n = 0; n < 2; ++n) acc[a][b][m][n] = (f32x4){0.f, 0.f, 0.f, 0.f};
    bf16x8 At[4][2], B0[2][2], B1[2][2];
    const char* cA = (const char*)g.A + (size_t)cur.pm * tstepA; const char* cB = (const char*)g.Bt + (size_t)cur.pn * tstepB;
    PG8_STAGE(PG8_SB(0, 0), cB, voffB); PG8_STAGE(PG8_SB(0, 1), cB + hstepB, voffB); PG8_STAGE(PG8_SA(0, 0), cA, voffA); PG8_STAGE(PG8_SA(0, 1), cA + hstepA, voffA);
    if (wr == 1) PG8_BAR;
    PG8_WAIT_V(2); PG8_BAR;
    PG8_STAGE(PG8_SB(1, 0), cB + kstep, voffB); PG8_STAGE(PG8_SA(1, 0), cA + kstep, voffA); PG8_STAGE(PG8_SB(1, 1), cB + hstepB + kstep, voffB);
    PG8_WAIT_V(6); PG8_BAR;
    for (;;) {
        const bool has_next = S.next(ui + 1, nxt);
        const char* nA = has_next ? (const char*)g.A + (size_t)nxt.pm * tstepA : cA; const char* nB = has_next ? (const char*)g.Bt + (size_t)nxt.pn * tstepB : cB;
        for (int t = 0; t < nt; t += 2) {
            const bool last = (t == nt - 2);
            const char* a1 = cA + (size_t)(t + 1) * kstep;
            const char* a2 = last ? nA : cA + (size_t)(t + 2) * kstep; const char* b2 = last ? nB : cB + (size_t)(t + 2) * kstep;
            const char* a3 = a2 + kstep; const char* b3 = b2 + kstep;
            PG8_LDB(B0, 0, 0); PG8_LDB(B1, 0, 1); PG8_SCHED; PG8_LDA(At, 0, 0); PG8_STAGE(PG8_SA(1, 1), a1 + hstepA, voffA);
            PG8_WAIT_V(8); PG8_WAIT_L(0); PG8_BAR; PG8_MMA(0, 0, At, B0); PG8_MMA(0, 1, At, B1); PG8_BAR; PG8_SCHED;
            PG8_LDA(At, 0, 1); PG8_STAGE(PG8_SB(0, 0), b2, voffB); PG8_STAGE(PG8_SB(0, 1), b2 + hstepB, voffB); PG8_STAGE(PG8_SA(0, 0), a2, voffA);
            PG8_WAIT_V(8); PG8_WAIT_L(0); PG8_BAR; PG8_MMA(1, 0, At, B0); PG8_MMA(1, 1, At, B1); PG8_BAR; PG8_SCHED;
            PG8_LDB(B0, 1, 0); PG8_LDB(B1, 1, 1); PG8_SCHED; PG8_LDA(At, 1, 0); PG8_STAGE(PG8_SA(0, 1), a2 + hstepA, voffA);
            PG8_WAIT_V(8); PG8_WAIT_L(0); PG8_BAR; PG8_MMA(0, 0, At, B0); PG8_MMA(0, 1, At, B1); PG8_BAR; PG8_SCHED;
            PG8_LDA(At, 1, 1); PG8_STAGE(PG8_SB(1, 0), b3, voffB); PG8_STAGE(PG8_SB(1, 1), b3 + hstepB, voffB); PG8_STAGE(PG8_SA(1, 0), a3, voffA);
            PG8_WAIT_V(8); PG8_WAIT_L(0); PG8_BAR; PG8_MMA(1, 0, At, B0); PG8_MMA(1, 1, At, B1); PG8_BAR; PG8_SCHED;
        }
        if constexpr (ALIGN_EPI) { if (wr == 0) PG8_BAR; }
        E(acc, cur, wr, wc, fr, fq);
        if (!has_next) break;
#pragma unroll
        for (int a = 0; a < 2; ++a)
#pragma unroll
            for (int b = 0; b < 2; ++b)
#pragma unroll
                for (int m = 0; m < 4; ++m)
#pragma unroll
                    for (int n = 0; n < 2; ++n) acc[a][b][m][n] = (f32x4){0.f, 0.f, 0.f, 0.f};
        cur = nxt; cA = nA; cB = nB; ++ui;
        if constexpr (ALIGN_EPI) { if (wr == 1) PG8_BAR; }
    }
    PG8_WAIT_V(0);
    if constexpr (!ALIGN_EPI) { if (wr == 0) PG8_BAR; }
    PG8_BAR;
#undef PG8_SA
#undef PG8_SB
#undef PG8_STAGE
#undef PG8_LDA
#undef PG8_LDB
#undef PG8_MMA
#undef PG8_WAIT_V
#undef PG8_WAIT_L
#undef PG8_BAR
#undef PG8_SCHED
}
}
constexpr int LDS_BYTES = 148480;
namespace dattn {
#define DA_LAS __attribute__((address_space(3)))
typedef short bf16x8 __attribute__((ext_vector_type(8)));
typedef short s16x4 __attribute__((ext_vector_type(4)));
typedef float f32x16 __attribute__((ext_vector_type(16)));
constexpr int KP = 272, VP = 320, KBUF = 64 * KP, VBUF = 64 * VP, BUF = KBUF + VBUF, XOFF = 2 * BUF, LDS_NEED = XOFF + 65536;
static_assert(LDS_NEED <= 147456, "attention LDS");
__device__ __forceinline__ unsigned cvtpk(float lo, float hi) { typedef float f2 __attribute__((ext_vector_type(2))); typedef __bf16 b2 __attribute__((ext_vector_type(2))); f2 v = {lo, hi}; b2 b = __builtin_convertvector(v, b2); return __builtin_bit_cast(unsigned, b); }
__device__ __forceinline__ s16x4 vtr(const DA_LAS unsigned char* p) { typedef short v4i16_t __attribute__((ext_vector_type(4))); return __builtin_bit_cast(s16x4, __builtin_amdgcn_ds_read_tr16_b64_v4i16((DA_LAS v4i16_t*)p)); }
template <bool STORE = true> __device__ __forceinline__ void unit(DA_LAS unsigned char* lds, bf16_t* Hb, int h, int qb, const float* __restrict__ subln_w, float lam) {
    const int tid = opaque_tid(), lane = tid & 63, w = __builtin_amdgcn_readfirstlane(tid >> 6), mp = w >> 2, rb = w & 3, c32 = lane & 31, hh = lane >> 5;
    const int qrow = 128 * qb + 32 * rb + c32;
    bf16x8 qf[4];
    { const bf16_t* qp = Hb + (size_t)qrow * HP_ + HC_Q + h * 128 + 64 * mp + 8 * hh;
#pragma unroll
      for (int s = 0; s < 4; ++s) qf[s] = *(const bf16x8*)(qp + 16 * s); }
    const int srow = tid >> 4, sch = tid & 15;
    const bf16_t* kg = Hb + HC_K + h * 128 + sch * 8; const bf16_t* vg = Hb + HC_V + h * 128 + sch * 8;
    const int nt = 2 * qb + 2;
    u32x4 kr[2], vr[2];
#define DA_LOAD(t) do { _Pragma("unroll") for (int j = 0; j < 2; ++j) { const size_t ro = (size_t)(64 * (t) + srow + 32 * j) * HP_; kr[j] = *(const u32x4*)(kg + ro); vr[j] = *(const u32x4*)(vg + ro); } } while (0)
#define DA_WRITE(buf) do { _Pragma("unroll") for (int j = 0; j < 2; ++j) { *(DA_LAS u32x4*)(lds + (buf) * BUF + (srow + 32 * j) * KP + sch * 16) = kr[j]; *(DA_LAS u32x4*)(lds + (buf) * BUF + KBUF + (srow + 32 * j) * VP + sch * 16) = vr[j]; } } while (0)
    DA_LOAD(0); DA_WRITE(0);
    __syncthreads();
    f32x16 oT[4];
#pragma unroll
    for (int i = 0; i < 4; ++i) oT[i] = (f32x16){0.f, 0.f, 0.f, 0.f, 0.f, 0.f, 0.f, 0.f, 0.f, 0.f, 0.f, 0.f, 0.f, 0.f, 0.f, 0.f};
    float lrow = 0.f;
    f32x16 negm = (f32x16){0.f, 0.f, 0.f, 0.f, 0.f, 0.f, 0.f, 0.f, 0.f, 0.f, 0.f, 0.f, 0.f, 0.f, 0.f, 0.f};
    const int koff = c32 * KP + (64 * mp + 8 * hh) * 2;
    const int voff = KBUF + (4 * hh + ((lane & 15) >> 2)) * VP + (16 * ((lane >> 4) & 1) + 4 * (lane & 3)) * 2;
    for (int t = 0; t < nt; ++t) {
        const int cur = t & 1;
        if (t + 1 < nt) DA_LOAD(t + 1);
        if (!(t == nt - 1 && rb <= 1)) {
            const DA_LAS unsigned char* kb = lds + cur * BUF + koff;
            f32x16 s0 = negm, s1 = negm;
            bf16x8 kf0[4], kf1[4];
#pragma unroll
            for (int s = 0; s < 4; ++s) { kf0[s] = *(const DA_LAS bf16x8*)(kb + s * 32); kf1[s] = *(const DA_LAS bf16x8*)(kb + 32 * KP + s * 32); }
            __builtin_amdgcn_s_setprio(1);
#pragma unroll
            for (int s = 0; s < 4; ++s) {
                s0 = __builtin_amdgcn_mfma_f32_32x32x16_bf16(kf0[s], qf[s], s0, 0, 0, 0);
                s1 = __builtin_amdgcn_mfma_f32_32x32x16_bf16(kf1[s], qf[s], s1, 0, 0, 0);
            }
            __builtin_amdgcn_s_setprio(0);
            if (t >= nt - 2) {
                const int k0 = 64 * t + 4 * hh;
#pragma unroll
                for (int r = 0; r < 16; ++r) { const int key = k0 + (r & 3) + 8 * (r >> 2); if (key > qrow) s0[r] = -INFINITY; if (key + 32 > qrow) s1[r] = -INFINITY; }
            }
            float mxa = fmaxf(fmaxf(s0[0], s0[1]), s1[0]), mxb = fmaxf(fmaxf(s0[2], s0[3]), s1[1]);
            mxa = fmaxf(fmaxf(mxa, s1[2]), s1[3]);
#pragma unroll
            for (int r = 4; r < 16; r += 4) { mxa = fmaxf(fmaxf(mxa, s0[r]), s0[r + 1]); mxb = fmaxf(fmaxf(mxb, s0[r + 2]), s0[r + 3]); mxa = fmaxf(fmaxf(mxa, s1[r]), s1[r + 1]); mxb = fmaxf(fmaxf(mxb, s1[r + 2]), s1[r + 3]); }
            float mx = fmaxf(mxa, mxb);
            mx = fmaxf(mx, __shfl_xor(mx, 32));
            if (__any(mx > 8.f)) {
                const float dl = fmaxf(mx, 0.f), alpha = __builtin_amdgcn_exp2f(-dl);
#pragma unroll
                for (int r = 0; r < 16; ++r) { s0[r] -= dl; s1[r] -= dl; negm[r] -= dl; }
                lrow *= alpha;
#pragma unroll
                for (int i = 0; i < 4; ++i)
#pragma unroll
                    for (int r = 0; r < 16; ++r) oT[i][r] *= alpha;
            }
            float ps = 0.f;
#pragma unroll
            for (int r = 0; r < 16; ++r) { s0[r] = __builtin_amdgcn_exp2f(s0[r]); s1[r] = __builtin_amdgcn_exp2f(s1[r]); ps += s0[r] + s1[r]; }
            lrow += ps;
            bf16x8 pf[2][2];
#pragma unroll
            for (int s = 0; s < 2; ++s) {
                u32x4 a, b;
                a.x = cvtpk(s0[8 * s], s0[8 * s + 1]); a.y = cvtpk(s0[8 * s + 2], s0[8 * s + 3]); a.z = cvtpk(s0[8 * s + 4], s0[8 * s + 5]); a.w = cvtpk(s0[8 * s + 6], s0[8 * s + 7]);
                b.x = cvtpk(s1[8 * s], s1[8 * s + 1]); b.y = cvtpk(s1[8 * s + 2], s1[8 * s + 3]); b.z = cvtpk(s1[8 * s + 4], s1[8 * s + 5]); b.w = cvtpk(s1[8 * s + 6], s1[8 * s + 7]);
                pf[0][s] = __builtin_bit_cast(bf16x8, a); pf[1][s] = __builtin_bit_cast(bf16x8, b);
            }
            const DA_LAS unsigned char* vb = lds + cur * BUF + voff;
#define DA_LDV(dst, db) do { _Pragma("unroll") for (int i_ = 0; i_ < 4; ++i_) { const s16x4 lo_ = vtr(vb + (16 * i_) * VP + (db) * 64), hi_ = vtr(vb + (16 * i_ + 8) * VP + (db) * 64); \
                dst[i_] = (bf16x8){lo_[0], lo_[1], lo_[2], lo_[3], hi_[0], hi_[1], hi_[2], hi_[3]}; } } while (0)
#define DA_MM(src, db) do { _Pragma("unroll") for (int i_ = 0; i_ < 4; ++i_) oT[db] = __builtin_amdgcn_mfma_f32_32x32x16_bf16(src[i_], pf[i_ >> 1][i_ & 1], oT[db], 0, 0, 0); } while (0)
            bf16x8 va[4], vq[4];
            DA_LDV(va, 0);
            DA_LDV(vq, 1); __builtin_amdgcn_s_setprio(1); DA_MM(va, 0); __builtin_amdgcn_s_setprio(0);
            DA_LDV(va, 2); __builtin_amdgcn_s_setprio(1); DA_MM(vq, 1); __builtin_amdgcn_s_setprio(0);
            DA_LDV(vq, 3); __builtin_amdgcn_s_setprio(1); DA_MM(va, 2); __builtin_amdgcn_s_setprio(0);
            __builtin_amdgcn_s_setprio(1); DA_MM(vq, 3);
#undef DA_LDV
#undef DA_MM
            __builtin_amdgcn_s_setprio(0);
        }
        if (t + 1 < nt) DA_WRITE(cur ^ 1);
        __syncthreads();
    }
#undef DA_LOAD
#undef DA_WRITE
    const float inv = 1.f / (lrow + __shfl_xor(lrow, 32));
    DA_LAS float* X = (DA_LAS float*)(lds + XOFF) + rb * 4096 + lane;
    if (mp == 1) {
#pragma unroll
        for (int i = 0; i < 4; ++i)
#pragma unroll
            for (int r = 0; r < 16; ++r) X[(i * 16 + r) * 64] = oT[i][r] * inv;
    }
    __syncthreads();
    if (mp == 0) {
        float ss = 0.f;
#pragma unroll
        for (int i = 0; i < 4; ++i)
#pragma unroll
            for (int r = 0; r < 16; ++r) { const float o = oT[i][r] * inv - lam * X[(i * 16 + r) * 64]; oT[i][r] = o; ss += o * o; }
        ss += __shfl_xor(ss, 32);
        const float rr = rsqrtf(ss * (1.f / 128.f) + 1e-5f) * (1.f - LAMBDA_INIT);
        bf16_t* op = Hb + (size_t)qrow * HP_ + HC_Q + h * 128 + 4 * hh;
#pragma unroll
        for (int i = 0; i < 4; ++i)
#pragma unroll
            for (int g = 0; g < 4; ++g) { const int d0 = 32 * i + 8 * g; const f32x4 sw = *(const f32x4*)(subln_w + d0 + 4 * hh);
                uint2 o; o.x = pk2(oT[i][4 * g] * rr * sw.x, oT[i][4 * g + 1] * rr * sw.y); o.y = pk2(oT[i][4 * g + 2] * rr * sw.z, oT[i][4 * g + 3] * rr * sw.w);
                if (STORE || o.x == 0x12345u) *(uint2*)(op + d0) = o; }
    }
    __syncthreads();
}
}
namespace ssd {
#define SS_LAS __attribute__((address_space(3)))
typedef short bf16x8 __attribute__((ext_vector_type(8)));
typedef short s16x4 __attribute__((ext_vector_type(4)));
typedef float f32x16 __attribute__((ext_vector_type(16)));
constexpr int XP = 192;
constexpr int BPT = 320;
constexpr int CP = 272;
__device__ __forceinline__ s16x4 vtr(const SS_LAS unsigned char* p) { typedef short v4i16_t __attribute__((ext_vector_type(4))); return __builtin_bit_cast(s16x4, __builtin_amdgcn_ds_read_tr16_b64_v4i16((SS_LAS v4i16_t*)p)); }
__device__ __forceinline__ unsigned cvtpk(float lo, float hi) { typedef float f2 __attribute__((ext_vector_type(2))); typedef __bf16 b2 __attribute__((ext_vector_type(2))); f2 v = {lo, hi}; b2 b = __builtin_convertvector(v, b2); return __builtin_bit_cast(unsigned, b); }
__device__ __forceinline__ void acs_tables(SS_LAS float* ACS, SS_LAS float* DTS, const float* __restrict__ DTb, const float* __restrict__ a_log, int c, int g) {
    const int tid_ = opaque_tid(); const int lane = tid_ & 63, e = __builtin_amdgcn_readfirstlane(tid_ >> 6), h = 8 * g + e;
    const float a = -expf(a_log[h]);
    const float d0 = DTb[(size_t)(128 * c + 2 * lane) * 32 + h], d1 = DTb[(size_t)(128 * c + 2 * lane + 1) * 32 + h];
    const float a0 = d0 * a, a1 = d1 * a;
    float sc = a0 + a1;
#pragma unroll
    for (int o = 1; o < 64; o <<= 1) { const float v = __shfl_up(sc, o); if (lane >= o) sc += v; }
    const float ex = sc - (a0 + a1);
    ACS[(2 * lane) * 8 + e] = ex + a0; ACS[(2 * lane + 1) * 8 + e] = ex + a0 + a1;
    DTS[(2 * lane) * 8 + e] = d0; DTS[(2 * lane + 1) * 8 + e] = d1;
}
template <int NT, class F> __device__ __forceinline__ void conv_item(const bf16_t* __restrict__ Hb, int t0, int l0, int xch0, const float* __restrict__ conv_w, const float* __restrict__ conv_b, F sink) {
    float w[4][8], bias[8];
#pragma unroll
    for (int j = 0; j < 4; ++j) { const f32x4 a = *(const f32x4*)(conv_w + j * DXBC + xch0), b = *(const f32x4*)(conv_w + j * DXBC + xch0 + 4); w[j][0] = a.x; w[j][1] = a.y; w[j][2] = a.z; w[j][3] = a.w; w[j][4] = b.x; w[j][5] = b.y; w[j][6] = b.z; w[j][7] = b.w; }
    { const f32x4 a = *(const f32x4*)(conv_b + xch0), b = *(const f32x4*)(conv_b + xch0 + 4); bias[0] = a.x; bias[1] = a.y; bias[2] = a.z; bias[3] = a.w; bias[4] = b.x; bias[5] = b.y; bias[6] = b.z; bias[7] = b.w; }
    const bf16_t* src = Hb + HC_XBC + xch0;
    u32x4 rw[NT + 3];
#pragma unroll
    for (int i = 0; i < NT + 3; ++i) { const int tt = t0 + l0 - 3 + i; rw[i] = *(const u32x4*)(src + (size_t)(tt < 0 ? 0 : tt) * HP_); }
    if (t0 + l0 < 3) {
#pragma unroll
        for (int i = 0; i < 3; ++i) if (t0 + l0 - 3 + i < 0) rw[i] = (u32x4){0u, 0u, 0u, 0u};
    }
#define SS_UNP(dst, q_) do { dst[0] = bflo(q_.x); dst[1] = bfhi(q_.x); dst[2] = bflo(q_.y); dst[3] = bfhi(q_.y); dst[4] = bflo(q_.z); dst[5] = bfhi(q_.z); dst[6] = bflo(q_.w); dst[7] = bfhi(q_.w); } while (0)
    float x0[8], x1[8], x2[8];
    SS_UNP(x0, rw[0]); SS_UNP(x1, rw[1]); SS_UNP(x2, rw[2]);
#pragma unroll
    for (int i = 0; i < NT; ++i) {
        float x3[8]; SS_UNP(x3, rw[3 + i]);
        float v[8];
#pragma unroll
        for (int k = 0; k < 8; ++k) { const float a = bias[k] + w[0][k] * x0[k] + w[1][k] * x1[k] + w[2][k] * x2[k] + w[3][k] * x3[k]; v[k] = a * __builtin_amdgcn_rcpf(1.f + __expf(-a)); x0[k] = x1[k]; x1[k] = x2[k]; x2[k] = x3[k]; }
        sink(l0 + i, v);
    }
#undef SS_UNP
}
constexpr int A_BS = 0, A_XD = 128 * BPT  , A_ACS = A_XD + 2 * 128 * XP  , A_DTS = A_ACS + 4096, A_END = A_DTS + 4096;
__device__ __forceinline__ void phaseA_unit(SS_LAS unsigned char* lds, const bf16_t* __restrict__ Hb, const float* __restrict__ DTb, const float* __restrict__ conv_w, const float* __restrict__ conv_b,
                                            const float* __restrict__ a_log, bf16_t* __restrict__ ST, float* __restrict__ CD, int c, int g) {
    const int tid = opaque_tid(), lane = tid & 63, w = __builtin_amdgcn_readfirstlane(tid >> 6), c32 = lane & 31, hh = lane >> 5;
    SS_LAS float* ACS = (SS_LAS float*)(lds + A_ACS); SS_LAS float* DTS = (SS_LAS float*)(lds + A_DTS);
    acs_tables(ACS, DTS, DTb, a_log, c, g);
    __syncthreads();
    if (tid < 8) CD[c * 32 + 8 * g + tid] = __expf(ACS[127 * 8 + tid]);
    auto stageX = [&](int e, int item, int buf) {
        const int cg = item >> 5, seg = item & 31; const float aend = ACS[127 * 8 + e];
        conv_item<4>(Hb, 128 * c, 4 * seg, g * 512 + e * 64 + cg * 8, conv_w, conv_b, [&](int l, const float (&v)[8]) {
            const float sc = DTS[l * 8 + e] * __expf(aend - ACS[l * 8 + e]);
            u32x4 o; o.x = cvtpk(v[0] * sc, v[1] * sc); o.y = cvtpk(v[2] * sc, v[3] * sc); o.z = cvtpk(v[4] * sc, v[5] * sc); o.w = cvtpk(v[6] * sc, v[7] * sc);
            *(SS_LAS u32x4*)(lds + A_XD + buf * 128 * XP + l * XP + cg * 16) = o; });
    };
    { const int cg = tid >> 5, seg = tid & 31;
        conv_item<4>(Hb, 128 * c, 4 * seg, 2048 + g * 128 + cg * 8, conv_w, conv_b, [&](int l, const float (&v)[8]) {
            u32x4 o; o.x = cvtpk(v[0], v[1]); o.y = cvtpk(v[2], v[3]); o.z = cvtpk(v[4], v[5]); o.w = cvtpk(v[6], v[7]);
            *(SS_LAS u32x4*)(lds + A_BS + l * BPT + cg * 16) = o; }); }
    if (tid < 256) stageX(0, tid, 0);
    __syncthreads();
    const int pb = w & 1, nb = w >> 1;
    const int rsel = ((lane & 15) >> 2), csel = 16 * ((lane >> 4) & 1) + 4 * (lane & 3);
    for (int e = 0; e < 8; ++e) {
        if (e + 1 < 8 && tid >= 256) stageX(e + 1, tid - 256, (e + 1) & 1);
        f32x16 acc = (f32x16){0.f, 0.f, 0.f, 0.f, 0.f, 0.f, 0.f, 0.f, 0.f, 0.f, 0.f, 0.f, 0.f, 0.f, 0.f, 0.f};
        const SS_LAS unsigned char* bp = lds + A_BS + (8 * hh + rsel) * BPT + (32 * nb + csel) * 2;
        const SS_LAS unsigned char* xp = lds + A_XD + (e & 1) * 128 * XP + (8 * hh + rsel) * XP + (32 * pb + csel) * 2;
#pragma unroll
        for (int ks = 0; ks < 8; ++ks) {
            const s16x4 b0 = vtr(bp + (16 * ks) * BPT), b1 = vtr(bp + (16 * ks + 4) * BPT), x0 = vtr(xp + (16 * ks) * XP), x1 = vtr(xp + (16 * ks + 4) * XP);
            const bf16x8 bf = (bf16x8){b0[0], b0[1], b0[2], b0[3], b1[0], b1[1], b1[2], b1[3]}, xf = (bf16x8){x0[0], x0[1], x0[2], x0[3], x1[0], x1[1], x1[2], x1[3]};
            acc = __builtin_amdgcn_mfma_f32_32x32x16_bf16(bf, xf, acc, 0, 0, 0);
        }
        bf16_t* sp = ST + ((size_t)(c * 32 + 8 * g + e) * 64 + 32 * pb + c32) * 128 + 32 * nb + 4 * hh;
#pragma unroll
        for (int q = 0; q < 4; ++q) { uint2 o; o.x = cvtpk(acc[4 * q], acc[4 * q + 1]); o.y = cvtpk(acc[4 * q + 2], acc[4 * q + 3]); *(uint2*)(sp + 8 * q) = o; }
        __syncthreads();
    }
}
__device__ __forceinline__ void scan_phase(bf16_t* __restrict__ ST, const float* __restrict__ CD, int gtid) {
    const int h = gtid >> 12;
    unsigned* p = (unsigned*)ST + gtid;
    float r0 = 0.f, r1 = 0.f;
    for (int c0 = 0; c0 < 64; c0 += 16) {
        unsigned v[16]; float d[16];
#pragma unroll
        for (int i = 0; i < 16; ++i) { v[i] = p[(size_t)(c0 + i) * 131072]; d[i] = CD[(c0 + i) * 32 + h]; }
#pragma unroll
        for (int i = 0; i < 16; ++i) { p[(size_t)(c0 + i) * 131072] = cvtpk(r0, r1); r0 = r0 * d[i] + bflo(v[i]); r1 = r1 * d[i] + bfhi(v[i]); }
    }
}
constexpr int C_CS = 0, C_BS = 128 * CP  , C_X1 = C_BS  , C_CBT = 2 * 128 * CP  , C_X0 = C_CBT + 32768  , C_ACS = C_X0 + 128 * XP  , C_DTS = C_ACS + 4096,
              C_SSQ = C_DTS + 4096, C_END = C_SSQ + 1024;
static_assert(C_END <= 147456 && 128 * XP <= 128 * CP, "ssd phase C LDS");
template <bool STORE = true> __device__ __forceinline__ void phaseC_unit(SS_LAS unsigned char* lds, bf16_t* __restrict__ Hb, const float* __restrict__ DTb, const float* __restrict__ conv_w, const float* __restrict__ conv_b,
                                            const float* __restrict__ a_log, const float* __restrict__ d_skip, const float* __restrict__ norm_w, const bf16_t* __restrict__ ST, int c, int g) {
    const int tid = opaque_tid(), lane = tid & 63, w = __builtin_amdgcn_readfirstlane(tid >> 6), c32 = lane & 31, hh = lane >> 5;
    SS_LAS float* ACS = (SS_LAS float*)(lds + C_ACS); SS_LAS float* DTS = (SS_LAS float*)(lds + C_DTS); SS_LAS float* SSQ = (SS_LAS float*)(lds + C_SSQ);
    acs_tables(ACS, DTS, DTb, a_log, c, g);
    auto stageX = [&](int e, int item, int buf) {
        const int cg = item >> 5, seg = item & 31;
        conv_item<4>(Hb, 128 * c, 4 * seg, g * 512 + e * 64 + cg * 8, conv_w, conv_b, [&](int l, const float (&v)[8]) {
            u32x4 o; o.x = cvtpk(v[0], v[1]); o.y = cvtpk(v[2], v[3]); o.z = cvtpk(v[4], v[5]); o.w = cvtpk(v[6], v[7]);
            *(SS_LAS u32x4*)(lds + (buf ? C_X1 : C_X0) + l * XP + cg * 16) = o; });
    };
    { const int isC = tid >> 8, it = tid & 255, cg = it >> 4, seg = it & 15;
        conv_item<8>(Hb, 128 * c, 8 * seg, 2048 + isC * 512 + g * 128 + cg * 8, conv_w, conv_b, [&](int l, const float (&v)[8]) {
            u32x4 o; o.x = cvtpk(v[0], v[1]); o.y = cvtpk(v[2], v[3]); o.z = cvtpk(v[4], v[5]); o.w = cvtpk(v[6], v[7]);
            *(SS_LAS u32x4*)(lds + (isC ? C_CS : C_BS) + l * CP + cg * 16) = o; }); }
    if (tid < 256) stageX(0, tid, 0);
    __syncthreads();
    for (int i = w; i < 10; i += 8) {
        const int sb = (i < 4) ? 0 : (i < 7) ? 1 : (i < 9) ? 2 : 3, lb = (i < 4) ? i : (i < 7) ? i - 3 : (i < 9) ? i - 5 : 3;
        f32x16 acc = (f32x16){0.f, 0.f, 0.f, 0.f, 0.f, 0.f, 0.f, 0.f, 0.f, 0.f, 0.f, 0.f, 0.f, 0.f, 0.f, 0.f};
        const SS_LAS unsigned char* bp = lds + C_BS + (32 * sb + c32) * CP + 16 * hh, *cp = lds + C_CS + (32 * lb + c32) * CP + 16 * hh;
#pragma unroll
        for (int ks = 0; ks < 8; ++ks) acc = __builtin_amdgcn_mfma_f32_32x32x16_bf16(*(const SS_LAS bf16x8*)(bp + 32 * ks), *(const SS_LAS bf16x8*)(cp + 32 * ks), acc, 0, 0, 0);
        SS_LAS unsigned* o = (SS_LAS unsigned*)(lds + C_CBT) + (sb * 4 + lb) * 512 + lane;
#pragma unroll
        for (int q = 0; q < 8; ++q) o[q * 64] = cvtpk(acc[2 * q], acc[2 * q + 1]);
    }
    __syncthreads();
    const int pb = w & 1, lb = w >> 1, lrow = 32 * lb + c32;
    const int rsel = ((lane & 15) >> 2), csel = 16 * ((lane >> 4) & 1) + 4 * (lane & 3);
    unsigned ypk[8][8];
    float ssq = 0.f;
    bf16x8 pcur[8]; u32x2 zcur[4];
#define SS_PREF(pdst, zdst, e_) do { const int h_ = 8 * g + (e_); const bf16_t* pp_ = ST + ((size_t)(c * 32 + h_) * 64 + 32 * pb + c32) * 128 + 8 * hh; \
        _Pragma("unroll") for (int ks_ = 0; ks_ < 8; ++ks_) pdst[ks_] = *(const bf16x8*)(pp_ + 16 * ks_); \
        const bf16_t* zp_ = Hb + (size_t)(128 * c + lrow) * HP_ + HC_Z + g * 512 + (e_) * 64 + 32 * pb + 4 * hh; \
        _Pragma("unroll") for (int q_ = 0; q_ < 4; ++q_) zdst[q_] = *(const u32x2*)(zp_ + 8 * q_); } while (0)
    SS_PREF(pcur, zcur, 0);
    for (int e = 0; e < 8; ++e) {
        const int h = 8 * g + e;
        if (e + 1 < 8 && tid < 256) stageX(e + 1, tid, (e + 1) & 1);
        bf16x8 pnext[8]; u32x2 znext[4];
        { const int en = (e + 1 < 8) ? e + 1 : 7; SS_PREF(pnext, znext, en); }
        const int xoff = (e & 1) ? C_X1 : C_X0;
        f32x16 acc = (f32x16){0.f, 0.f, 0.f, 0.f, 0.f, 0.f, 0.f, 0.f, 0.f, 0.f, 0.f, 0.f, 0.f, 0.f, 0.f, 0.f};
        {
            const SS_LAS unsigned char* cp = lds + C_CS + lrow * CP + 16 * hh;
#pragma unroll
            for (int ks = 0; ks < 8; ++ks) acc = __builtin_amdgcn_mfma_f32_32x32x16_bf16(pcur[ks], *(const SS_LAS bf16x8*)(cp + 32 * ks), acc, 0, 0, 0);
        }
        const float al = ACS[lrow * 8 + e], eal = __expf(al);
#pragma unroll
        for (int r = 0; r < 16; ++r) acc[r] *= eal;
        for (int sb = 0; sb <= lb; ++sb) {
            const SS_LAS unsigned* cbp = (const SS_LAS unsigned*)(lds + C_CBT) + (sb * 4 + lb) * 512 + lane;
            float m[16];
#pragma unroll
            for (int q = 0; q < 8; ++q) { const unsigned u = cbp[q * 64]; m[2 * q] = bflo(u); m[2 * q + 1] = bfhi(u); }
#pragma unroll
            for (int r = 0; r < 16; ++r) { const int srow = 32 * sb + (r & 3) + 8 * (r >> 2) + 4 * hh;
                const float f = __expf(al - ACS[srow * 8 + e]) * DTS[srow * 8 + e];
                m[r] = (srow <= lrow) ? m[r] * f : 0.f; }
            const SS_LAS unsigned char* xp = lds + xoff + (32 * sb + 4 * hh + rsel) * XP + (32 * pb + csel) * 2;
#pragma unroll
            for (int ks = 0; ks < 2; ++ks) {
                const s16x4 x0 = vtr(xp + (16 * ks) * XP), x1 = vtr(xp + (16 * ks + 8) * XP);
                const bf16x8 xf = (bf16x8){x0[0], x0[1], x0[2], x0[3], x1[0], x1[1], x1[2], x1[3]};
                u32x4 mm; mm.x = cvtpk(m[8 * ks], m[8 * ks + 1]); mm.y = cvtpk(m[8 * ks + 2], m[8 * ks + 3]); mm.z = cvtpk(m[8 * ks + 4], m[8 * ks + 5]); mm.w = cvtpk(m[8 * ks + 6], m[8 * ks + 7]);
                acc = __builtin_amdgcn_mfma_f32_32x32x16_bf16(xf, __builtin_bit_cast(bf16x8, mm), acc, 0, 0, 0);
            }
        }
        const float dsk = d_skip[h];
        const SS_LAS unsigned char* xr = lds + xoff + lrow * XP + (32 * pb + 4 * hh) * 2;
        unsigned yt[8];
#pragma unroll
        for (int q = 0; q < 4; ++q) {
            const u32x2 zz = zcur[q]; const u32x2 xx = *(const SS_LAS u32x2*)(xr + 16 * q);
            const float zv[4] = {bflo(zz.x), bfhi(zz.x), bflo(zz.y), bfhi(zz.y)}, xv[4] = {bflo(xx.x), bfhi(xx.x), bflo(xx.y), bfhi(xx.y)};
            float y[4];
#pragma unroll
            for (int k = 0; k < 4; ++k) { y[k] = (acc[4 * q + k] + dsk * xv[k]) * (zv[k] * __builtin_amdgcn_rcpf(1.f + __expf(-zv[k]))); ssq += y[k] * y[k]; }
            yt[2 * q] = cvtpk(y[0], y[1]); yt[2 * q + 1] = cvtpk(y[2], y[3]);
        }
#define SS_YSET(E) case E: { _Pragma("unroll") for (int q_ = 0; q_ < 8; ++q_) ypk[E][q_] = yt[q_]; } break;
        switch (e) { SS_YSET(0) SS_YSET(1) SS_YSET(2) SS_YSET(3) SS_YSET(4) SS_YSET(5) SS_YSET(6) default: { _Pragma("unroll") for (int q_ = 0; q_ < 8; ++q_) ypk[7][q_] = yt[q_]; } break; }
#undef SS_YSET
#pragma unroll
        for (int ks = 0; ks < 8; ++ks) pcur[ks] = pnext[ks];
#pragma unroll
        for (int q = 0; q < 4; ++q) zcur[q] = znext[q];
        __syncthreads();
    }
#undef SS_PREF
    ssq += __shfl_xor(ssq, 32);
    if (hh == 0) SSQ[pb * 128 + lrow] = ssq;
    __syncthreads();
    const float rstd = rsqrtf((SSQ[lrow] + SSQ[128 + lrow]) * (1.f / 512.f) + 1e-5f);
    bf16_t* op = Hb + (size_t)(128 * c + lrow) * HP_ + HC_Z + g * 512 + 32 * pb + 4 * hh;
    const float* nw = norm_w + g * 512 + 32 * pb + 4 * hh;
#pragma unroll
    for (int e = 0; e < 8; ++e)
#pragma unroll
        for (int q = 0; q < 4; ++q) { const f32x4 n4 = *(const f32x4*)(nw + e * 64 + 8 * q);
            uint2 o; o.x = cvtpk(bflo(ypk[e][2 * q]) * rstd * n4.x, bfhi(ypk[e][2 * q]) * rstd * n4.y); o.y = cvtpk(bflo(ypk[e][2 * q + 1]) * rstd * n4.z, bfhi(ypk[e][2 * q + 1]) * rstd * n4.w);
            if (STORE || o.x == 0x12345u) *(uint2*)(op + e * 64 + 8 * q) = o; }
    __syncthreads();
}
}


namespace psel {
#define PS_LAS __attribute__((address_space(3)))
typedef short bf16x8 __attribute__((ext_vector_type(8)));
typedef float f32x16 __attribute__((ext_vector_type(16)));
__device__ __forceinline__ int ord(float f) { const int b = __builtin_bit_cast(int, f); return b ^ ((b >> 31) & 0x7fffffff); }
__device__ __forceinline__ float unord(int t) { return __builtin_bit_cast(float, t ^ ((t >> 31) & 0x7fffffff)); }
#define PS_INS(top, v) do { int v_ = (v); _Pragma("unroll") for (int i_ = 0; i_ < 16; ++i_) { const int hi_ = max(top[i_], v_); v_ = min(top[i_], v_); top[i_] = hi_; } } while (0)
__device__ __forceinline__ void stage1(PS_LAS int* EXall, const bf16_t* __restrict__ QP, const bf16_t* __restrict__ SUBK, int tok0, int hp) {
    const int tid = opaque_tid(), lane = tid & 63, w1 = __builtin_amdgcn_readfirstlane(tid >> 6), c32 = lane & 31, hh = lane >> 5;
    PS_LAS int* EX = EXall + hp * 4096;
    {
        const int tile = w1 >> 2, hsel = (w1 >> 1) & 1, half = w1 & 1, h = 2 * hp + hsel;
        const bf16_t* qp = QP + (size_t)(tok0 + 32 * tile + c32) * 2048 + h * 256 + half * 128 + 8 * hh;
        const bf16_t* kp = SUBK + ((size_t)(h * 2 + half) * 128 + c32) * 128 + 8 * hh;
        bf16x8 qf[8];
#pragma unroll
        for (int ks = 0; ks < 8; ++ks) qf[ks] = *(const bf16x8*)(qp + 16 * ks);
        int top[16];
#pragma unroll
        for (int i = 0; i < 16; ++i) top[i] = (int)0x80000000;
        bf16x8 kfa[8], kfb[8];
#define PS_LDK(dst, mt_) do { _Pragma("unroll") for (int ks_ = 0; ks_ < 8; ++ks_) dst[ks_] = *(const bf16x8*)(kp + (size_t)(32 * (mt_)) * 128 + 16 * ks_); } while (0)
#define PS_TILE(src, mt_) do { f32x16 acc_ = (f32x16){0.f, 0.f, 0.f, 0.f, 0.f, 0.f, 0.f, 0.f, 0.f, 0.f, 0.f, 0.f, 0.f, 0.f, 0.f, 0.f}; \
            _Pragma("unroll") for (int ks_ = 0; ks_ < 8; ++ks_) acc_ = __builtin_amdgcn_mfma_f32_32x32x16_bf16(src[ks_], qf[ks_], acc_, 0, 0, 0); \
            _Pragma("unroll") for (int r_ = 0; r_ < 16; ++r_) { const int key_ = 32 * (mt_) + (r_ & 3) + 8 * (r_ >> 2) + 4 * hh; const int v__ = (ord(acc_[r_]) & ~127) | (127 - key_); PS_INS(top, v__); } } while (0)
        PS_LDK(kfa, 0);
        PS_LDK(kfb, 1); PS_TILE(kfa, 0);
        PS_LDK(kfa, 2); PS_TILE(kfb, 1);
        PS_LDK(kfb, 3); PS_TILE(kfa, 2);
        PS_TILE(kfb, 3);
#undef PS_LDK
#undef PS_TILE
        int oth[16];
#pragma unroll
        for (int i = 0; i < 16; ++i) oth[i] = __shfl_xor(top[i], 32);
#pragma unroll
        for (int i = 0; i < 16; ++i) PS_INS(top, oth[i]);
        if (hh == 0) {
#pragma unroll
            for (int i = 0; i < 16; ++i) EX[(w1 * 16 + i) * 32 + c32] = top[i];
        }
    }
}
__device__ __forceinline__ void stage2(PS_LAS int* EXall, int* __restrict__ IDX, float* __restrict__ GATE, int tok0) {
    const int tid = opaque_tid();
    {
        const int hp = tid >> 7, task = tid & 127, th = task >> 5, tok32 = task & 31, tile = th >> 1, hsel = th & 1, h = 2 * hp + hsel;
        PS_LAS int* EX = EXall + hp * 4096;
        const PS_LAS int* ea = EX + ((th * 2 + 0) * 16) * 32 + tok32; const PS_LAS int* eb = EX + ((th * 2 + 1) * 16) * 32 + tok32;
        float as[16], bs[16];
#pragma unroll
        for (int i = 0; i < 16; ++i) { as[i] = unord(ea[i * 32] & ~127); bs[i] = unord(eb[i * 32] & ~127); }
        int top[16];
#pragma unroll
        for (int i = 0; i < 16; ++i) top[i] = (int)0x80000000;
#pragma unroll
        for (int i = 0; i < 16; ++i)
#pragma unroll
            for (int j = 0; j < 16; ++j) if ((i + 1) * (j + 1) <= 16) { const int v = (ord(as[i] + bs[j]) & ~255) | (255 - (i * 16 + j)); PS_INS(top, v); }
        float sc[16]; int id[16];
#pragma unroll
        for (int r = 0; r < 16; ++r) { const int cn = 255 - (top[r] & 255), i = cn >> 4, j = cn & 15; const int pa = ea[i * 32], pb = eb[j * 32];
            sc[r] = unord(pa & ~127) + unord(pb & ~127); id[r] = (127 - (pa & 127)) * 128 + (127 - (pb & 127)); }
        float sum = 0.f; const float mx = sc[0];
#pragma unroll
        for (int r = 0; r < 16; ++r) { sc[r] = __expf(sc[r] - mx); sum += sc[r]; }
        const size_t o = (size_t)(tok0 + 32 * tile + tok32) * 128 + h * 16;
        const float inv = 1.f / sum;
#pragma unroll
        for (int r = 0; r < 16; r += 4) { *(f32x4*)(GATE + o + r) = (f32x4){sc[r] * inv, sc[r + 1] * inv, sc[r + 2] * inv, sc[r + 3] * inv}; *(u32x4*)(IDX + o + r) = (u32x4){(unsigned)id[r], (unsigned)id[r + 1], (unsigned)id[r + 2], (unsigned)id[r + 3]}; }
    }
}
}


namespace xattn {
#define XA_LAS __attribute__((address_space(3)))
typedef short bf16x8 __attribute__((ext_vector_type(8)));
typedef short s16x4 __attribute__((ext_vector_type(4)));
typedef float f32x16 __attribute__((ext_vector_type(16)));
constexpr int RP = 528;
__device__ __forceinline__ unsigned cvtpk(float lo, float hi) { typedef float f2 __attribute__((ext_vector_type(2))); typedef __bf16 b2 __attribute__((ext_vector_type(2))); f2 v = {lo, hi}; b2 b = __builtin_convertvector(v, b2); return __builtin_bit_cast(unsigned, b); }
__device__ __forceinline__ void stage(XA_LAS unsigned char* lds, const bf16_t* __restrict__ src, int pitch, int tid) {
#pragma unroll 4
    for (int i = 0; i < 16; ++i) { const int q = tid + 512 * i, row = q >> 5, ch = q & 31; *(XA_LAS u32x4*)(lds + row * RP + ch * 16) = *(const u32x4*)(src + (size_t)row * pitch + ch * 8); }
}
__device__ __forceinline__ void unit(XA_LAS unsigned char* lds, const bf16_t* __restrict__ QC, const bf16_t* __restrict__ KC, const bf16_t* __restrict__ VcT, bf16_t* __restrict__ XO, int tg, int h) {
    const int tid = opaque_tid(), lane = tid & 63, w = __builtin_amdgcn_readfirstlane(tid >> 6), c32 = lane & 31, hh = lane >> 5, b = tg >> 5;
    const int tok = 256 * tg + 32 * w + c32;
    stage(lds, KC + (size_t)b * MEML * D + h * 256, D, tid);
    bf16x8 pf[8][2]; float inv;
    {
        bf16x8 qf[16];
        const bf16_t* qp = QC + (size_t)tok * D + h * 256 + 8 * hh;
#pragma unroll
        for (int ks = 0; ks < 16; ++ks) qf[ks] = *(const bf16x8*)(qp + 16 * ks);
        __syncthreads();
        f32x16 acc[8];
        const XA_LAS unsigned char* kb = lds + c32 * RP + 16 * hh;
#pragma unroll
        for (int mt = 0; mt < 8; ++mt) {
            acc[mt] = (f32x16){0.f, 0.f, 0.f, 0.f, 0.f, 0.f, 0.f, 0.f, 0.f, 0.f, 0.f, 0.f, 0.f, 0.f, 0.f, 0.f};
#pragma unroll
            for (int ks = 0; ks < 16; ++ks) acc[mt] = __builtin_amdgcn_mfma_f32_32x32x16_bf16(*(const XA_LAS bf16x8*)(kb + (32 * mt) * RP + 32 * ks), qf[ks], acc[mt], 0, 0, 0);
        }
        float mx = acc[0][0];
#pragma unroll
        for (int mt = 0; mt < 8; ++mt)
#pragma unroll
            for (int r = 0; r < 16; ++r) mx = fmaxf(mx, acc[mt][r]);
        mx = fmaxf(mx, __shfl_xor(mx, 32));
        float sum = 0.f;
#pragma unroll
        for (int mt = 0; mt < 8; ++mt)
#pragma unroll
            for (int r = 0; r < 16; ++r) { acc[mt][r] = __builtin_amdgcn_exp2f(acc[mt][r] - mx); sum += acc[mt][r]; }
        sum += __shfl_xor(sum, 32); inv = 1.f / sum;
#pragma unroll
        for (int mt = 0; mt < 8; ++mt)
#pragma unroll
            for (int s2 = 0; s2 < 2; ++s2) { u32x4 a; a.x = cvtpk(acc[mt][8 * s2], acc[mt][8 * s2 + 1]); a.y = cvtpk(acc[mt][8 * s2 + 2], acc[mt][8 * s2 + 3]); a.z = cvtpk(acc[mt][8 * s2 + 4], acc[mt][8 * s2 + 5]); a.w = cvtpk(acc[mt][8 * s2 + 6], acc[mt][8 * s2 + 7]);
                pf[mt][s2] = __builtin_bit_cast(bf16x8, a); }
    }
    __syncthreads();
    stage(lds, VcT + ((size_t)b * D + h * 256) * MEML, MEML, tid);
    __syncthreads();
    const XA_LAS unsigned char* vb = lds + c32 * RP + 8 * hh;
    bf16_t* op = XO + (size_t)tok * D + h * 256 + 4 * hh;
#pragma unroll 1
    for (int dt = 0; dt < 8; ++dt) {
        f32x16 acc = (f32x16){0.f, 0.f, 0.f, 0.f, 0.f, 0.f, 0.f, 0.f, 0.f, 0.f, 0.f, 0.f, 0.f, 0.f, 0.f, 0.f};
#pragma unroll
        for (int mt = 0; mt < 8; ++mt)
#pragma unroll
            for (int s2 = 0; s2 < 2; ++s2) {
                const s16x4 lo = *(const XA_LAS s16x4*)(vb + (32 * dt) * RP + (32 * mt + 16 * s2) * 2), hi = *(const XA_LAS s16x4*)(vb + (32 * dt) * RP + (32 * mt + 16 * s2 + 8) * 2);
                const bf16x8 vf = (bf16x8){lo[0], lo[1], lo[2], lo[3], hi[0], hi[1], hi[2], hi[3]};
                acc = __builtin_amdgcn_mfma_f32_32x32x16_bf16(vf, pf[mt][s2], acc, 0, 0, 0);
            }
#pragma unroll
        for (int q = 0; q < 4; ++q) { u32x2 o; o.x = cvtpk(acc[4 * q] * inv, acc[4 * q + 1] * inv); o.y = cvtpk(acc[4 * q + 2] * inv, acc[4 * q + 3] * inv); *(u32x2*)(op + 32 * dt + 8 * q) = o; }
    }
    __syncthreads();
}
}

namespace sp {
#define SP_LAS __attribute__((address_space(3)))
#define SP_LDSWAIT() do { asm volatile("s_waitcnt lgkmcnt(0)" ::: "memory"); } while (0)
__device__ __forceinline__ void transpose_item(const float* __restrict__ W, int ldw, int col0, int K, int nblk, bf16_t* __restrict__ WT, int row_off, SP_LAS float* scr, int item, int lane) {
    const int kb = item / nblk, nb = item % nblk, k0 = 64 * kb, n0 = 32 * nb;
#pragma unroll 8
    for (int i = 0; i < 32; ++i) { const int kk = 2 * i + (lane >> 5); scr[kk * 33 + (lane & 31)] = W[(size_t)(k0 + kk) * ldw + col0 + n0 + (lane & 31)]; }
    SP_LDSWAIT();
    const int cc = lane & 7;
#pragma unroll
    for (int j = 0; j < 4; ++j) { const int n = (lane >> 3) + 8 * j; const SP_LAS float* s = scr + (8 * cc) * 33 + n;
        u32x4 o; o.x = pk2(s[0 * 33], s[1 * 33]); o.y = pk2(s[2 * 33], s[3 * 33]); o.z = pk2(s[4 * 33], s[5 * 33]); o.w = pk2(s[6 * 33], s[7 * 33]);
        *(u32x4*)(WT + (size_t)(row_off + n0 + n) * K + k0 + 8 * cc) = o; }
    SP_LDSWAIT();
}
__device__ __forceinline__ void cvt_range(const float* __restrict__ src, bf16_t* __restrict__ dst, size_t n4, size_t gtid, size_t gthreads) {
    for (size_t i = gtid; i < n4; i += gthreads) { const f32x4 v = ((const f32x4*)src)[i]; u32x2 o; o.x = pk2(v.x, v.y); o.y = pk2(v.z, v.w); ((u32x2*)dst)[i] = o; }
}

__device__ __forceinline__ void cvt_fp8_range(const float* __restrict__ src, unsigned char* __restrict__ dst, size_t n16, float scale, size_t gtid, size_t gthreads) {
    for (size_t i = gtid; i < n16; i += gthreads) {
        const f32x4* sp4 = (const f32x4*)src + 4 * i; u32x4 o; unsigned ow[4];
#pragma unroll
        for (int q = 0; q < 4; ++q) { const f32x4 v = sp4[q];
            const float a = fminf(fmaxf(v.x * scale, -448.f), 448.f), b = fminf(fmaxf(v.y * scale, -448.f), 448.f), c2 = fminf(fmaxf(v.z * scale, -448.f), 448.f), d2 = fminf(fmaxf(v.w * scale, -448.f), 448.f);
            int p = 0; p = __builtin_amdgcn_cvt_pk_fp8_f32(a, b, p, false); p = __builtin_amdgcn_cvt_pk_fp8_f32(c2, d2, p, true); ow[q] = (unsigned)p; }
        o.x = ow[0]; o.y = ow[1]; o.z = ow[2]; o.w = ow[3];
        const size_t e_ = i >> 6, cg_ = i & 63; ((u32x4*)dst)[(cg_ >> 3) * ((size_t)PK * PK * 8) + e_ * 8 + (cg_ & 7)] = o;
    }
}
__device__ __forceinline__ void dt_stage_w(SP_LAS float* Wl, const float* __restrict__ w_in) {
    const int tid = opaque_tid();
#pragma unroll 8
    for (int i = 0; i < 64; ++i) { const int idx = tid + 512 * i; Wl[idx] = w_in[(size_t)(idx >> 5) * NIN + 5120 + (idx & 31)]; }
}
__device__ __forceinline__ void dt_item(SP_LAS float* Wl, SP_LAS float* xs, SP_LAS float* part, const float* __restrict__ x, const float* __restrict__ dt_bias, float* __restrict__ DT, int item) {
    const int tid = opaque_tid(), lane = tid & 63, w = tid >> 6, m0 = item * 4;
#pragma unroll
    for (int i = 0; i < 2; ++i) { const int q = tid + 512 * i; *(SP_LAS f32x4*)(xs + 4 * q) = ((const f32x4*)(x + (size_t)m0 * D))[q]; }
    __syncthreads();
    const int h = lane & 31, r = w >> 1, kq = (w & 1) * 2 + (lane >> 5);
    const SP_LAS float* xp = xs + r * 1024 + kq * 256; const SP_LAS float* wp = Wl + (kq * 256) * 32 + h;
    float a0 = 0.f, a1 = 0.f;
#pragma unroll 8
    for (int k = 0; k < 256; k += 2) { a0 = fmaf(xp[k], wp[k * 32], a0); a1 = fmaf(xp[k + 1], wp[(k + 1) * 32], a1); }
    float acc = a0 + a1;
    acc += __shfl_xor(acc, 32);
    if ((w & 1) && lane < 32) part[r * 32 + h] = acc;
    __syncthreads();
    if (!(w & 1) && lane < 32) { const float v = acc + part[r * 32 + h] + dt_bias[h]; DT[(size_t)(m0 + r) * 32 + h] = v > 20.f ? v : log1pf(expf(v)); }
}
__device__ __forceinline__ void ln_row(float* __restrict__ X, const float* __restrict__ g, const float* __restrict__ b, bf16_t* __restrict__ XB, int row, int lane) {
    f32x4* xr = (f32x4*)(X + (size_t)row * D) + lane;
    f32x4 v[4]; float s = 0.f;
#pragma unroll
    for (int j = 0; j < 4; ++j) { v[j] = xr[64 * j]; s += (v[j].x + v[j].y) + (v[j].z + v[j].w); }
    const float mean = wave_sum(s) * (1.f / D); float s2 = 0.f;
#pragma unroll
    for (int j = 0; j < 4; ++j) { v[j] = v[j] - mean; s2 += (v[j].x * v[j].x + v[j].y * v[j].y) + (v[j].z * v[j].z + v[j].w * v[j].w); }
    const float rstd = rsqrtf(wave_sum(s2) * (1.f / D) + 1e-5f);
#pragma unroll
    for (int j = 0; j < 4; ++j) { const int c = 4 * lane + 256 * j; const f32x4 gg = *(const f32x4*)(g + c), bb = *(const f32x4*)(b + c);
        f32x4 o = v[j] * rstd * gg + bb; xr[64 * j] = o;
        u32x2 pb; pb.x = pk2(o.x, o.y); pb.y = pk2(o.z, o.w); *(u32x2*)(XB + (size_t)row * D + c) = pb; }
}
__device__ __forceinline__ void xattn_pair(SP_LAS float* L, const bf16_t* __restrict__ QC, const bf16_t* __restrict__ KCVC, bf16_t* __restrict__ XO, int tok0) {
    const int t512 = opaque_tid(); const int half = t512 >> 8, tid = t512 & 255, lane = tid & 63, wv = tid >> 6, tok = tok0 + half, b = tok / SEQ;
    SP_LAS float* qs = L + half * 1024; SP_LAS float* ps = L + 2048 + half * 256; SP_LAS float* red = L + 2560 + half * 8;
    for (int i = tid; i < 1024; i += 256) qs[i] = bf2f(QC[(size_t)tok * D + i]);
    __syncthreads();
    const bf16_t* KV = KCVC + (size_t)b * MEML * 2048;
    for (int h = 0; h < MH; ++h) {
        const bf16_t* kp = KV + (size_t)tid * 2048 + h * 256;
        float s = 0.f;
        for (int d = 0; d < 256; d += 8) { const u32x4 w = *(const u32x4*)(kp + d); const SP_LAS float* q = qs + h * 256 + d;
            s += q[0] * bflo(w.x) + q[1] * bfhi(w.x) + q[2] * bflo(w.y) + q[3] * bfhi(w.y) + q[4] * bflo(w.z) + q[5] * bfhi(w.z) + q[6] * bflo(w.w) + q[7] * bfhi(w.w); }
        float mx = wave_max(s); if (lane == 0) red[wv] = mx; __syncthreads();
        mx = fmaxf(fmaxf(red[0], red[1]), fmaxf(red[2], red[3]));
        const float p = exp2f(s - mx);
        float sm = wave_sum(p); if (lane == 0) red[4 + wv] = sm; ps[tid] = p; __syncthreads();
        sm = (red[4] + red[5]) + (red[6] + red[7]);
        float o = 0.f;
        for (int j = 0; j < 256; ++j) o = fmaf(ps[j], bf2f(KV[(size_t)j * 2048 + 1024 + h * 256 + tid]), o);
        XO[(size_t)tok * D + h * 256 + tid] = (bf16_t)f2bf(o / sm);
        __syncthreads();
    }
}
__device__ __forceinline__ void select_pair(SP_LAS float* L, const bf16_t* __restrict__ QP, const bf16_t* __restrict__ SUBK, int* __restrict__ IDX, float* __restrict__ GATE, int tok0) {
    const int t512 = opaque_tid(); const int hf = t512 >> 8, tid = t512 & 255, tok = tok0 + hf;
    SP_LAS float* base = L + hf * 3072;
    SP_LAS float* qs = base; SP_LAS float* s = base + 2048; SP_LAS float* tops = base + 2304; SP_LAS int* topi = (SP_LAS int*)(base + 2336); SP_LAS float* cs = base + 2368; SP_LAS int* ci = (SP_LAS int*)(base + 2624);
    SP_LAS float* bs = base + 2880; SP_LAS int* bi = (SP_LAS int*)(base + 2896);
    for (int i = tid; i < 2048; i += 256) qs[i] = bf2f(QP[(size_t)tok * 2048 + i]);
    __syncthreads();
    for (int h = 0; h < PH; ++h) {
        const int half = tid >> 7, key = tid & 127;
        { const bf16_t* kp = SUBK + ((size_t)(h * 2 + half) * 128 + key) * 128; const SP_LAS float* q = qs + h * 256 + half * 128; float a = 0.f;
          for (int d = 0; d < 128; d += 8) { const u32x4 w = *(const u32x4*)(kp + d);
              a += q[d] * bflo(w.x) + q[d + 1] * bfhi(w.x) + q[d + 2] * bflo(w.y) + q[d + 3] * bfhi(w.y) + q[d + 4] * bflo(w.z) + q[d + 5] * bfhi(w.z) + q[d + 6] * bflo(w.w) + q[d + 7] * bfhi(w.w); }
          s[tid] = a; }
        __syncthreads();
        { const float me = s[tid]; int rank = 0; const SP_LAS float* spp = s + half * 128;
          for (int j = 0; j < 128; ++j) { const float o = spp[j]; rank += (o > me || (o == me && j < key)) ? 1 : 0; }
          if (rank < 16) { tops[half * 16 + rank] = me; topi[half * 16 + rank] = key; } }
        __syncthreads();
        { const int i = tid >> 4, j = tid & 15; cs[tid] = tops[i] + tops[16 + j]; ci[tid] = topi[i] * 128 + topi[16 + j]; }
        __syncthreads();
        { const float me = cs[tid]; int rank = 0;
          for (int j = 0; j < 256; ++j) { const float o = cs[j]; rank += (o > me || (o == me && j < tid)) ? 1 : 0; }
          if (rank < 16) { bs[rank] = me; bi[rank] = ci[tid]; } }
        __syncthreads();
        if (tid < 16) { const float mx = bs[0]; float sum = 0.f;
            for (int j = 0; j < 16; ++j) sum += expf(bs[j] - mx);
            GATE[(size_t)tok * 128 + h * 16 + tid] = expf(bs[tid] - mx) / sum; IDX[(size_t)tok * 128 + h * 16 + tid] = bi[tid]; }
        __syncthreads();
    }
}
__device__ __forceinline__ void gather_token(SP_LAS float* L, float* __restrict__ X, const bf16_t* __restrict__ PU, const bf16_t* __restrict__ PV, const int* __restrict__ IDX, const float* __restrict__ GATE,
                                             const float* __restrict__ g3, const float* __restrict__ b3, int tok) {
    const int tid = opaque_tid(), lane = tid & 63, wv = tid >> 6;
    SP_LAS float* ys = L; SP_LAS float* red = L + 8192;
    float xr[16], y[16];
    { const float* xp = X + (size_t)tok * D + lane * 16;
#pragma unroll
      for (int j = 0; j < 4; ++j) { const f32x4 v = *(const f32x4*)(xp + 4 * j); xr[4 * j] = v.x; xr[4 * j + 1] = v.y; xr[4 * j + 2] = v.z; xr[4 * j + 3] = v.w; }
#pragma unroll
      for (int j = 0; j < 16; ++j) y[j] = 0.f; }
    for (int e = 0; e < 16; ++e) {
        const int slot = wv * 16 + e; const int id = IDX[(size_t)tok * 128 + slot]; const float gt = GATE[(size_t)tok * 128 + slot];
        const bf16_t* up = PU + (size_t)id * D + lane * 16; const u32x4 u0 = *(const u32x4*)up, u1 = *(const u32x4*)(up + 8);
        const unsigned uw[8] = {u0.x, u0.y, u0.z, u0.w, u1.x, u1.y, u1.z, u1.w};
        float hsum = 0.f;
#pragma unroll
        for (int j = 0; j < 8; ++j) { hsum = fmaf(xr[2 * j], bflo(uw[j]), hsum); hsum = fmaf(xr[2 * j + 1], bfhi(uw[j]), hsum); }
        hsum = wave_sum(hsum);
        const float w = gt * 0.5f * hsum * (1.f + erff(hsum * 0.70710678118654752f));
        const bf16_t* vp = PV + (size_t)id * D + lane * 16; const u32x4 v0 = *(const u32x4*)vp, v1 = *(const u32x4*)(vp + 8);
        const unsigned vw[8] = {v0.x, v0.y, v0.z, v0.w, v1.x, v1.y, v1.z, v1.w};
#pragma unroll
        for (int j = 0; j < 8; ++j) { y[2 * j] = fmaf(w, bflo(vw[j]), y[2 * j]); y[2 * j + 1] = fmaf(w, bfhi(vw[j]), y[2 * j + 1]); }
    }
#pragma unroll
    for (int j = 0; j < 16; ++j) ys[wv * 1024 + lane * 16 + j] = y[j];
    __syncthreads();
    float v[2]; float s = 0.f;
#pragma unroll
    for (int j = 0; j < 2; ++j) { const int c = tid * 2 + j; float a = 0.f;
#pragma unroll
        for (int k = 0; k < 8; ++k) a += ys[k * 1024 + c];
        v[j] = ALPHA * X[(size_t)tok * D + c] + a; s += v[j]; }
    s = wave_sum(s); if (lane == 0) red[wv] = s; __syncthreads();
    float tot = 0.f;
#pragma unroll
    for (int k = 0; k < 8; ++k) tot += red[k];
    const float mean = tot * (1.f / D);
    float s2 = 0.f;
#pragma unroll
    for (int j = 0; j < 2; ++j) { v[j] -= mean; s2 += v[j] * v[j]; }
    s2 = wave_sum(s2); if (lane == 0) red[8 + wv] = s2; __syncthreads();
    float tot2 = 0.f;
#pragma unroll
    for (int k = 0; k < 8; ++k) tot2 += red[8 + k];
    const float rstd = rsqrtf(tot2 * (1.f / D) + 1e-5f);
#pragma unroll
    for (int j = 0; j < 2; ++j) { const int c = tid * 2 + j; X[(size_t)tok * D + c] = v[j] * rstd * g3[c] + b3[c]; }
    __syncthreads();
}

constexpr float PEER_SU = 2048.f, PEER_SV = 256.f;
typedef float f32x2v __attribute__((ext_vector_type(2)));
__device__ __forceinline__ void gather_wave(float* __restrict__ Xo, const float* X, const unsigned char* __restrict__ PU, const unsigned char* __restrict__ PV, const int* __restrict__ IDX, const float* __restrict__ GATE,
                                            const float* __restrict__ g3, const float* __restrict__ b3, int tok, int lane) {
    float xr[16], y[16];
    { const f32x4* xp = (const f32x4*)(X + (size_t)tok * D + 16 * lane);
#pragma unroll
      for (int q = 0; q < 4; ++q) { const f32x4 v = xp[q]; xr[4 * q] = v.x; xr[4 * q + 1] = v.y; xr[4 * q + 2] = v.z; xr[4 * q + 3] = v.w; } }
#pragma unroll
    for (int j = 0; j < 16; ++j) y[j] = 0.f;
    const int id0 = IDX[(size_t)tok * 128 + lane], id1 = IDX[(size_t)tok * 128 + 64 + lane];
    const float gt0 = GATE[(size_t)tok * 128 + lane], gt1 = GATE[(size_t)tok * 128 + 64 + lane];
    u32x4 ub[8], vb[8];
#define GW_ISSUE(buf, TBL, i) do { const int idv_ = ((i) < 8) ? id0 : id1; _Pragma("unroll") for (int k_ = 0; k_ < 8; ++k_) { \
        const int id_ = __builtin_amdgcn_readlane(idv_, (8 * (i) + k_) & 63); buf[k_] = *(const u32x4*)((TBL) + (size_t)id_ * D + 16 * lane); } } while (0)
    GW_ISSUE(ub, PU, 0); GW_ISSUE(vb, PV, 0);
    const bool h32 = (lane & 32) != 0, h16 = (lane & 16) != 0, h8 = (lane & 8) != 0;
#pragma unroll 1
    for (int i = 0; i < 16; ++i) {
        float p[8];
#pragma unroll
        for (int k = 0; k < 8; ++k) { const unsigned w[4] = {ub[k].x, ub[k].y, ub[k].z, ub[k].w}; float a = 0.f;
#pragma unroll
            for (int q = 0; q < 4; ++q) { const f32x2v lo = __builtin_amdgcn_cvt_pk_f32_fp8((int)w[q], false), hi = __builtin_amdgcn_cvt_pk_f32_fp8((int)w[q], true);
                a = fmaf(xr[4 * q], lo.x, a); a = fmaf(xr[4 * q + 1], lo.y, a); a = fmaf(xr[4 * q + 2], hi.x, a); a = fmaf(xr[4 * q + 3], hi.y, a); }
            p[k] = a; }
        { const int in_ = (i + 1 < 16) ? i + 1 : 15; GW_ISSUE(ub, PU, in_); }
        float q4[4], q2[2], q1;
#pragma unroll
        for (int k = 0; k < 4; ++k) q4[k] = (h32 ? p[k + 4] : p[k]) + __shfl_xor(h32 ? p[k] : p[k + 4], 32);
#pragma unroll
        for (int k = 0; k < 2; ++k) q2[k] = (h16 ? q4[k + 2] : q4[k]) + __shfl_xor(h16 ? q4[k] : q4[k + 2], 16);
        q1 = (h8 ? q2[1] : q2[0]) + __shfl_xor(h8 ? q2[0] : q2[1], 8);
        q1 += __shfl_xor(q1, 4); q1 += __shfl_xor(q1, 2); q1 += __shfl_xor(q1, 1);
        q1 *= (1.f / PEER_SU);
        const float gsel = __shfl((i < 8) ? gt0 : gt1, (8 * i + (lane >> 3)) & 63);
        const float wv = gsel * 0.5f * q1 * (1.f + erff(q1 * 0.70710678118654752f));
#pragma unroll
        for (int k = 0; k < 8; ++k) { const float wk = __builtin_bit_cast(float, __builtin_amdgcn_readlane(__builtin_bit_cast(int, wv), 8 * k));
            const unsigned w[4] = {vb[k].x, vb[k].y, vb[k].z, vb[k].w};
#pragma unroll
            for (int q = 0; q < 4; ++q) { const f32x2v lo = __builtin_amdgcn_cvt_pk_f32_fp8((int)w[q], false), hi = __builtin_amdgcn_cvt_pk_f32_fp8((int)w[q], true);
                y[4 * q] = fmaf(wk, lo.x, y[4 * q]); y[4 * q + 1] = fmaf(wk, lo.y, y[4 * q + 1]); y[4 * q + 2] = fmaf(wk, hi.x, y[4 * q + 2]); y[4 * q + 3] = fmaf(wk, hi.y, y[4 * q + 3]); } }
        { const int in_ = (i + 1 < 16) ? i + 1 : 15; GW_ISSUE(vb, PV, in_); }
    }
#undef GW_ISSUE
    float s = 0.f;
#pragma unroll
    for (int j = 0; j < 16; ++j) { y[j] = ALPHA * xr[j] + y[j] * (1.f / PEER_SV); s += y[j]; }
    const float mean = wave_sum(s) * (1.f / D); float s2 = 0.f;
#pragma unroll
    for (int j = 0; j < 16; ++j) { y[j] -= mean; s2 += y[j] * y[j]; }
    const float rstd = rsqrtf(wave_sum(s2) * (1.f / D) + 1e-5f);
    float* op = Xo + (size_t)tok * D + 16 * lane;
#pragma unroll
    for (int q = 0; q < 4; ++q) { const f32x4 gg = *(const f32x4*)(g3 + 16 * lane + 4 * q), bb = *(const f32x4*)(b3 + 16 * lane + 4 * q);
        f32x4 o; o.x = y[4 * q] * rstd * gg.x + bb.x; o.y = y[4 * q + 1] * rstd * gg.y + bb.y; o.z = y[4 * q + 2] * rstd * gg.z + bb.z; o.w = y[4 * q + 3] * rstd * gg.w + bb.w;
        *(f32x4*)(op + 4 * q) = o; }
}
}


#define LAS __attribute__((address_space(3)))
#define XB_TMO      128
#define XB_XCNT(j)  (256  + 64 * (j))
#define XB_XSUB(j)  (1280 + 64 * (j))
#define XB_XGEN(j)  (2304 + 64 * (j))
#define XB_TOP      3328
#define XB_TOPGEN   3392
#define XCD_BAR_WORDS 3456
#define XB_SPIN_CAP (1u << 18)
__device__ __forceinline__ unsigned xb_ld(unsigned* p)              { return __hip_atomic_load(p, __ATOMIC_RELAXED, __HIP_MEMORY_SCOPE_AGENT); }
__device__ __forceinline__ unsigned xb_add(unsigned* p, unsigned v) { return __hip_atomic_fetch_add(p, v, __ATOMIC_RELAXED, __HIP_MEMORY_SCOPE_AGENT); }
__device__ __forceinline__ unsigned xb_xcc_id() { return (unsigned)__builtin_amdgcn_s_getreg((3 << 11) | 20) & 0xFu; }
#define XB_SPIN(cond, bar) do { unsigned _sp = 0; while (cond) { __builtin_amdgcn_s_sleep(1); \
    if ((++_sp & 255u) == 0u) { if (xb_ld(&(bar)[XB_TMO])) break; if (_sp > XB_SPIN_CAP) { atomicAdd(&(bar)[XB_TMO], 1u); break; } } } } while (0)
struct XcdBarrier { unsigned* bar; unsigned x; volatile LAS unsigned* st; };
__device__ __forceinline__ XcdBarrier xcd_barrier_post(unsigned* bar, volatile LAS unsigned* st) {
    XcdBarrier b; b.bar = bar; b.x = xb_xcc_id(); b.st = st;
    if (threadIdx.x == 0) (void)xb_add(&bar[XB_XCNT(b.x)], 1u);
    return b;
}
__device__ __forceinline__ void xcd_barrier_complete(unsigned* bar, unsigned x, unsigned& nloc, unsigned& nx) {
    const unsigned G = gridDim.x * gridDim.y * gridDim.z;
    unsigned sum, cnt, mine, sp = 0u;
    for (;;) {
        sum = 0u; cnt = 0u; mine = 0u;
#pragma unroll
        for (unsigned j = 0; j < 16; ++j) { const unsigned c = xb_ld(&bar[XB_XCNT(j)]); sum += c; cnt += (c > 0u) ? 1u : 0u; mine = (j == x) ? c : mine; }
        if (sum == G) break;
        __builtin_amdgcn_s_sleep(1);
        if ((++sp & 255u) == 0u) { if (xb_ld(&bar[XB_TMO])) break; if (sp > XB_SPIN_CAP) { atomicAdd(&bar[XB_TMO], 1u); break; } }
    }
    nloc = mine > 0u ? mine : 1u; nx = cnt > 0u ? cnt : 1u;
}
__device__ __forceinline__ void xcd_barrier(const XcdBarrier& b) {
    asm volatile("s_waitcnt vmcnt(0)" ::: "memory");
    __syncthreads();
    if (threadIdx.x == 0) {
        unsigned* bar = b.bar;
        __builtin_amdgcn_s_waitcnt(0);
        unsigned nloc = b.st[0], nx = b.st[1];
        if (nloc == 0u) { xcd_barrier_complete(bar, b.x, nloc, nx); b.st[0] = nloc; b.st[1] = nx; }
        const unsigned old = xb_add(&bar[XB_XSUB(b.x)], 1u);
        const unsigned gen = old / nloc;
        if (old + 1u == (gen + 1u) * nloc) {
            __builtin_amdgcn_fence(__ATOMIC_RELEASE, "agent");
            asm volatile("s_waitcnt vmcnt(0)" ::: "memory");
            const unsigned og = xb_add(&bar[XB_TOP], 1u);
            const unsigned tg = og / nx;
            if (og + 1u == (tg + 1u) * nx) xb_add(&bar[XB_TOPGEN], 1u);
            else XB_SPIN(xb_ld(&bar[XB_TOPGEN]) == tg, bar);
            __builtin_amdgcn_fence(__ATOMIC_ACQUIRE, "agent");
            xb_add(&bar[XB_XGEN(b.x)], 1u);
            asm volatile("s_waitcnt vmcnt(0)" ::: "memory");
        } else {
            XB_SPIN(xb_ld(&bar[XB_XGEN(b.x)]) == gen, bar);
            __builtin_amdgcn_fence(__ATOMIC_ACQUIRE, "agent");
            asm volatile("s_waitcnt vmcnt(0)" ::: "memory");
        }
    }
    __syncthreads();
}
constexpr int CW_BAR = 4096;
constexpr int MISC_OFF = 147456;


namespace peer2 {
#define P2_LAS __attribute__((address_space(3)))
typedef float f32x2v __attribute__((ext_vector_type(2)));
constexpr int CW_TICK = 8192;
__device__ __forceinline__ float dpp_add_xor1(float v) { return v + __builtin_bit_cast(float, __builtin_amdgcn_update_dpp(0, __builtin_bit_cast(int, v), 0xB1, 0xf, 0xf, true)); }
__device__ __forceinline__ float dpp_add_xor2(float v) { return v + __builtin_bit_cast(float, __builtin_amdgcn_update_dpp(0, __builtin_bit_cast(int, v), 0x4E, 0xf, 0xf, true)); }
__device__ __forceinline__ float dpp_add_hmir(float v) { return v + __builtin_bit_cast(float, __builtin_amdgcn_update_dpp(0, __builtin_bit_cast(int, v), 0x141, 0xf, 0xf, true)); }
__device__ __forceinline__ float dpp_ror8(float v) { return __builtin_bit_cast(float, __builtin_amdgcn_update_dpp(0, __builtin_bit_cast(int, v), 0x128, 0xf, 0xf, true)); }
__device__ __forceinline__ float swap32_sum(float a, float b) { auto r = __builtin_amdgcn_permlane32_swap(__builtin_bit_cast(unsigned, a), __builtin_bit_cast(unsigned, b), false, false); return __builtin_bit_cast(float, r[0]) + __builtin_bit_cast(float, r[1]); }
struct Own { int j, rank, nrank, nsl; };
__device__ __forceinline__ Own ownership(unsigned* ctl, P2_LAS unsigned* scr, int phase, int wave) {
    const int G = gridDim.x;
    if (threadIdx.x == 0) {
        unsigned* bar = ctl + CW_BAR; bool uni = (G % 8) == 0;
        for (int j = 0; j < 8; ++j) uni = uni && (xb_ld(&bar[XB_XCNT(j)]) == (unsigned)(G / 8));
        const unsigned xcc = xb_xcc_id();
        if (uni && xcc < 8u) { scr[0] = xcc; scr[1] = xb_add(&ctl[CW_TICK + 64 * (8 * phase + (int)xcc)], 1u); }
        else { scr[0] = blockIdx.x & 7; scr[1] = blockIdx.x >> 3; }
    }
    __syncthreads();
    Own o;
    if (G % 8 == 0) { o.j = (int)scr[0]; o.rank = (int)scr[1] * 8 + wave; o.nrank = G; o.nsl = 8; }
    else { o.j = 0; o.rank = blockIdx.x * 8 + wave; o.nrank = G * 8; o.nsl = 1; }
    return o;
}
__device__ __forceinline__ float dot16_fp8(const float (&x)[16], const u32x4 u) {
    const unsigned w[4] = {u.x, u.y, u.z, u.w}; f32x2v a = {0.f, 0.f};
#pragma unroll
    for (int q = 0; q < 4; ++q) { const f32x2v lo = __builtin_amdgcn_cvt_pk_f32_fp8((int)w[q], false), hi = __builtin_amdgcn_cvt_pk_f32_fp8((int)w[q], true);
        a = __builtin_elementwise_fma((f32x2v){x[4 * q], x[4 * q + 1]}, lo, a); a = __builtin_elementwise_fma((f32x2v){x[4 * q + 2], x[4 * q + 3]}, hi, a); }
    return a.x + a.y;
}
__device__ __forceinline__ void u_wave(const float* __restrict__ X, const unsigned char* __restrict__ PU, const int* __restrict__ IDX, float* __restrict__ PART, int j, int rank, int nrank, int lane) {
    const int sub = lane & 7, grp = lane >> 3, col0 = 128 * j + 16 * sub;
    float* part = PART + (size_t)j * M * 128 + 16 * grp;
#define PU_LOADIDX(idv, xv, t_) do { const int tt_ = ((t_) < M) ? (t_) : (M - 1); const u32x4* ip_ = (const u32x4*)(IDX + (size_t)tt_ * 128 + 16 * grp); \
        _Pragma("unroll") for (int q_ = 0; q_ < 4; ++q_) { const u32x4 v_ = ip_[q_]; idv[4 * q_] = (int)v_.x; idv[4 * q_ + 1] = (int)v_.y; idv[4 * q_ + 2] = (int)v_.z; idv[4 * q_ + 3] = (int)v_.w; } \
        const f32x4* xp_ = (const f32x4*)(X + (size_t)tt_ * D + col0); \
        _Pragma("unroll") for (int q_ = 0; q_ < 4; ++q_) { const f32x4 v_ = xp_[q_]; xv[4 * q_] = v_.x; xv[4 * q_ + 1] = v_.y; xv[4 * q_ + 2] = v_.z; xv[4 * q_ + 3] = v_.w; } } while (0)
#define PU_GATHER(ubv, idv) do { _Pragma("unroll") for (int it_ = 0; it_ < 16; ++it_) ubv[it_] = *(const u32x4*)(PU + (size_t)j * (PK * PK * 128) + (size_t)idv[it_] * 128 + 16 * sub); } while (0)
#define PU_COMPUTE(ubv, xv, t_) do { float k0_ = 0.f, k1_ = 0.f; _Pragma("unroll") for (int it_ = 0; it_ < 16; ++it_) { float a_ = dot16_fp8(xv, ubv[it_]); a_ = dpp_add_xor1(a_); a_ = dpp_add_xor2(a_); a_ = dpp_add_hmir(a_); \
            if (it_ < 8) k0_ = ((it_ & 7) == sub) ? a_ : k0_; else k1_ = ((it_ & 7) == sub) ? a_ : k1_; } \
        if ((t_) < M) { part[(size_t)(t_) * 128 + sub] = k0_; part[(size_t)(t_) * 128 + sub + 8] = k1_; } } while (0)
    int idA[16], idB[16]; float xA[16], xB[16], xc[16]; u32x4 ubA[16], ubB[16];
    int t = rank;
    PU_LOADIDX(idA, xA, t); PU_GATHER(ubA, idA);
    PU_LOADIDX(idB, xB, t + nrank);
    for (; t < M; t += 2 * nrank) {
        PU_GATHER(ubB, idB);
#pragma unroll
        for (int q = 0; q < 16; ++q) xc[q] = xA[q];
        PU_LOADIDX(idA, xA, t + 2 * nrank);
        PU_COMPUTE(ubA, xc, t);
        PU_GATHER(ubA, idA);
#pragma unroll
        for (int q = 0; q < 16; ++q) xc[q] = xB[q];
        PU_LOADIDX(idB, xB, t + 3 * nrank);
        PU_COMPUTE(ubB, xc, t + nrank);
    }
#undef PU_LOADIDX
#undef PU_GATHER
#undef PU_COMPUTE
}
__device__ __forceinline__ void v_wave(float* __restrict__ X, const unsigned char* __restrict__ PV, const int* __restrict__ IDX, const float* __restrict__ GATE, const float* __restrict__ PART, P2_LAS float* wbuf, int j, int rank, int nrank, int lane) {
    const int sub = lane & 7, grp = lane >> 3, col0 = 128 * j + 16 * sub;
    const bool h32 = (lane & 32) != 0, h16 = (lane & 16) != 0, h8 = (lane & 8) != 0; const int cq = ((lane >> 5) & 1) * 8 + ((lane >> 4) & 1) * 4 + ((lane >> 3) & 1) * 2;
#define PV_ISSUE(vbv, hv, gv, t_) do { const int tt_ = ((t_) < M) ? (t_) : (M - 1); int id_[16]; const u32x4* ip_ = (const u32x4*)(IDX + (size_t)tt_ * 128 + 16 * grp); \
        _Pragma("unroll") for (int q_ = 0; q_ < 4; ++q_) { const u32x4 v_ = ip_[q_]; id_[4 * q_] = (int)v_.x; id_[4 * q_ + 1] = (int)v_.y; id_[4 * q_ + 2] = (int)v_.z; id_[4 * q_ + 3] = (int)v_.w; } \
        _Pragma("unroll") for (int it_ = 0; it_ < 16; ++it_) vbv[it_] = *(const u32x4*)(PV + (size_t)j * (PK * PK * 128) + (size_t)id_[it_] * 128 + 16 * sub); \
        _Pragma("unroll") for (int jj_ = 0; jj_ < 8; ++jj_) { const float* pp_ = PART + ((size_t)jj_ * M + tt_) * 128; hv[2 * jj_] = pp_[lane]; hv[2 * jj_ + 1] = pp_[64 + lane]; } \
        gv[0] = GATE[(size_t)tt_ * 128 + lane]; gv[1] = GATE[(size_t)tt_ * 128 + 64 + lane]; } while (0)
#define PV_COMPUTE(vbv, hv, gv, t_) do { float h0_ = 0.f, h1_ = 0.f; _Pragma("unroll") for (int jj_ = 0; jj_ < 8; ++jj_) { h0_ += hv[2 * jj_]; h1_ += hv[2 * jj_ + 1]; } \
        h0_ *= (1.f / sp::PEER_SU); h1_ *= (1.f / sp::PEER_SU); \
        const float w0_ = gv[0] * 0.5f * h0_ * (1.f + erff(h0_ * 0.70710678118654752f)), w1_ = gv[1] * 0.5f * h1_ * (1.f + erff(h1_ * 0.70710678118654752f)); \
        f32x2v y_[8]; _Pragma("unroll") for (int q_ = 0; q_ < 8; ++q_) y_[q_] = (f32x2v){0.f, 0.f}; \
        wbuf[lane] = w0_; wbuf[64 + lane] = w1_; asm volatile("s_waitcnt lgkmcnt(0)" ::: "memory");        \
        float wl_[16]; _Pragma("unroll") for (int q_ = 0; q_ < 4; ++q_) { const f32x4 v_ = *(const P2_LAS f32x4*)(wbuf + 16 * grp + 4 * q_); wl_[4 * q_] = v_.x; wl_[4 * q_ + 1] = v_.y; wl_[4 * q_ + 2] = v_.z; wl_[4 * q_ + 3] = v_.w; } \
        asm volatile("s_waitcnt lgkmcnt(0)" ::: "memory"); \
        _Pragma("unroll") for (int it_ = 0; it_ < 16; ++it_) { const float wq_ = wl_[it_]; \
            const unsigned ww_[4] = {vbv[it_].x, vbv[it_].y, vbv[it_].z, vbv[it_].w}; const f32x2v wv_ = {wq_, wq_}; \
            _Pragma("unroll") for (int q_ = 0; q_ < 4; ++q_) { y_[2 * q_] = __builtin_elementwise_fma(wv_, __builtin_amdgcn_cvt_pk_f32_fp8((int)ww_[q_], false), y_[2 * q_]); y_[2 * q_ + 1] = __builtin_elementwise_fma(wv_, __builtin_amdgcn_cvt_pk_f32_fp8((int)ww_[q_], true), y_[2 * q_ + 1]); } } \
        float yy_[16]; _Pragma("unroll") for (int k_ = 0; k_ < 8; ++k_) { yy_[2 * k_] = y_[k_].x; yy_[2 * k_ + 1] = y_[k_].y; } \
          \
        float y8_[8], y4_[4], y2_[2]; \
        _Pragma("unroll") for (int k_ = 0; k_ < 8; ++k_) y8_[k_] = (h32 ? yy_[k_ + 8] : yy_[k_]) + __shfl_xor(h32 ? yy_[k_] : yy_[k_ + 8], 32); \
        _Pragma("unroll") for (int k_ = 0; k_ < 4; ++k_) y4_[k_] = (h16 ? y8_[k_ + 4] : y8_[k_]) + __shfl_xor(h16 ? y8_[k_] : y8_[k_ + 4], 16); \
        _Pragma("unroll") for (int k_ = 0; k_ < 2; ++k_) y2_[k_] = (h8 ? y4_[k_ + 2] : y4_[k_]) + dpp_ror8(h8 ? y4_[k_] : y4_[k_ + 2]); \
        if ((t_) < M) { f32x2v* xp_ = (f32x2v*)(X + (size_t)(t_) * D + col0 + cq); f32x2v xv_ = *xp_; \
            xv_.x = ALPHA * xv_.x + y2_[0] * (1.f / sp::PEER_SV); xv_.y = ALPHA * xv_.y + y2_[1] * (1.f / sp::PEER_SV); *xp_ = xv_; } } while (0)
    u32x4 vbA[16], vbB[16]; float hA[16], hB[16], gA[2], gB[2];
    int t = rank;
    PV_ISSUE(vbA, hA, gA, t);
    for (; t < M; t += 2 * nrank) {
        PV_ISSUE(vbB, hB, gB, t + nrank);
        PV_COMPUTE(vbA, hA, gA, t);
        PV_ISSUE(vbA, hA, gA, t + 2 * nrank);
        PV_COMPUTE(vbB, hB, gB, t + nrank);
    }
#undef PV_ISSUE
#undef PV_COMPUTE
}
__device__ __forceinline__ void ln_row_plain(float* __restrict__ X, const float* __restrict__ g, const float* __restrict__ b, int row, int lane) {
    f32x4* xr = (f32x4*)(X + (size_t)row * D) + lane;
    f32x4 v[4]; float s = 0.f;
#pragma unroll
    for (int jq = 0; jq < 4; ++jq) { v[jq] = xr[64 * jq]; s += (v[jq].x + v[jq].y) + (v[jq].z + v[jq].w); }
    const float mean = wave_sum(s) * (1.f / D); float s2 = 0.f;
#pragma unroll
    for (int jq = 0; jq < 4; ++jq) { v[jq] = v[jq] - mean; s2 += (v[jq].x * v[jq].x + v[jq].y * v[jq].y) + (v[jq].z * v[jq].z + v[jq].w * v[jq].w); }
    const float rstd = rsqrtf(wave_sum(s2) * (1.f / D) + 1e-5f);
#pragma unroll
    for (int jq = 0; jq < 4; ++jq) { const int c = 4 * lane + 256 * jq; const f32x4 gg = *(const f32x4*)(g + c), bb = *(const f32x4*)(b + c); xr[64 * jq] = v[jq] * rstd * gg + bb; }
}
}

struct Params { const float* in[30]; float* out; unsigned char* ws; };
template <class F> __device__ __forceinline__ void run_gemm(unsigned char* lds, const bf16_t* A, int lda, const bf16_t* Bt, int Mr, int N, int K, F f, int cshift = 0) {
    pg8::Gemm g{A, Bt, Mr, N, K, lda}; pg8::StaticOrder S; S.init(Mr, N, gridDim.x, (int)((blockIdx.x + gridDim.x - (unsigned)cshift) % gridDim.x)); pg8::EpiAdapt<F> E{f};
    pg8::gemm_phase<pg8::EpiAdapt<F>, pg8::StaticOrder, true>((PG8_LAS unsigned char*)lds, g, S, E);
}
#ifndef PROBE_ATTN
#define PROBE_ATTN 0
#endif
#ifndef PROBE_SSD
#define PROBE_SSD 0
#endif
#ifndef PROBE_SYNC
#define PROBE_SYNC 0
#endif
#define KA_LAS __attribute__((address_space(4)))
#define PH_BEGIN const KA_LAS unsigned char* ka_ = (const KA_LAS unsigned char*)__builtin_amdgcn_kernarg_segment_ptr(); asm volatile("" : "+s"(ka_))
#define PIN(k) (*(const float* const KA_LAS*)(ka_ + 8 * (k)))
#define POUT (*(float* const KA_LAS*)(ka_ + 240))
#define PWS (*(unsigned char* const KA_LAS*)(ka_ + 248))
__global__ void __launch_bounds__(512, 2) hybrid_fwd(Params P) {
    extern __shared__ __attribute__((aligned(16))) unsigned char lds[];
    cg::grid_group grid = cg::this_grid();
    { PH_BEGIN; volatile LAS unsigned* misc = (volatile LAS unsigned*)((LAS unsigned char*)lds + MISC_OFF);
      if (threadIdx.x < 16) misc[threadIdx.x] = 0u;
      __syncthreads();
      (void)xcd_barrier_post((unsigned*)(PWS + WS_CTL) + CW_BAR, misc);
      if (PWS == nullptr) grid.sync(); }
#define GSYNC() do { PH_BEGIN; XcdBarrier xb_; xb_.bar = (unsigned*)(PWS + WS_CTL) + CW_BAR; xb_.x = xb_xcc_id(); xb_.st = (volatile LAS unsigned*)((LAS unsigned char*)lds + MISC_OFF); xcd_barrier(xb_); } while (0)
    {
        PH_BEGIN; unsigned char* ws = PWS;
        const int tid = opaque_tid(), lane = tid & 63, wave = __builtin_amdgcn_readfirstlane(tid >> 6), c = blockIdx.x, G = gridDim.x;
        const size_t gtid = (size_t)c * 512 + tid, gthreads = (size_t)G * 512; const int gw = c * 8 + wave, NGW = G * 8;
        const float* w_in = PIN(2);
        bf16_t* WinT = (bf16_t*)(ws + WS_WIN); bf16_t* WckvT = (bf16_t*)(ws + WS_WCKV);
        SP_LAS float* scr = (SP_LAS float*)lds + wave * (64 * 33);
        constexpr int I0 = 2560, I1 = 5120, I2 = 6144, I3 = 6656, I4 = 7168, I5 = 7680, I6 = 8192, I7 = 8704, I8 = 9216, I9 = 10240;
        for (int it = gw; it < I9; it += NGW) {
            if (it < I0) sp::transpose_item(w_in, NIN, 0, D, 160, WinT, 0, scr, it, lane);
            else if (it < I1) sp::transpose_item(w_in, NIN, 5152, D, 160, WinT, 5120, scr, it - I0, lane);
            else if (it < I2) sp::transpose_item(PIN(9), D, 0, DI, 32, (bf16_t*)(ws + WS_WSSD), 0, scr, it - I1, lane);
            else if (it < I3) sp::transpose_item(PIN(13), D, 0, D, 32, (bf16_t*)(ws + WS_WDIFF), 0, scr, it - I2, lane);
            else if (it < I4) sp::transpose_item(PIN(15), D, 0, D, 32, (bf16_t*)(ws + WS_WO), 0, scr, it - I3, lane);
            else if (it < I5) sp::transpose_item(PIN(18), D, 0, D, 32, (bf16_t*)(ws + WS_WCQ), 0, scr, it - I4, lane);
            else if (it < I6) sp::transpose_item(PIN(19), D, 0, D, 32, WckvT, 0, scr, it - I5, lane);
            else if (it < I7) sp::transpose_item(PIN(20), D, 0, D, 32, WckvT, 1024, scr, it - I6, lane);
            else if (it < I8) sp::transpose_item(PIN(21), D, 0, D, 32, (bf16_t*)(ws + WS_WCO), 0, scr, it - I7, lane);
            else sp::transpose_item(PIN(24), 2048, 0, D, 64, (bf16_t*)(ws + WS_WPQ), 0, scr, it - I8, lane);
        }
        const float* x = PIN(0);
        sp::cvt_range(x, (bf16_t*)(ws + WS_XB), (size_t)M * D / 4, gtid, gthreads);
        sp::cvt_range(PIN(1), (bf16_t*)(ws + WS_MEMB), (size_t)BATCH * MEML * D / 4, gtid, gthreads);
        sp::cvt_range(PIN(25), (bf16_t*)(ws + WS_SUBK), (size_t)PH * 2 * PK * PHALF / 4, gtid, gthreads);
        __syncthreads();
        sp::dt_stage_w((SP_LAS float*)lds, w_in);
        for (int it = c; it < M / 4; it += G) sp::dt_item((SP_LAS float*)lds, (SP_LAS float*)lds + 32768, (SP_LAS float*)lds + 36896  , x, PIN(5), (float*)(ws + WS_DT), it);
        __syncthreads();
        if (c == 0 && tid == 0) { const float* lam_q = PIN(10); const float* lam_k = PIN(11); float s0 = 0.f, s1 = 0.f;
            for (int i = 0; i < 64; ++i) { s0 += lam_q[i] * lam_k[i]; s1 += lam_q[64 + i] * lam_k[64 + i]; }
            ((float*)(ws + WS_CTL))[CW_LAM] = expf(s0) - expf(s1) + LAMBDA_INIT; }
    }
    GSYNC();
    { PH_BEGIN; unsigned char* ws = PWS;
      run_gemm(lds, (const bf16_t*)(ws + WS_XB), D, (const bf16_t*)(ws + WS_WIN), SEQ, NINP, D, EpiInProj{(bf16_t*)(ws + WS_H), PIN(14)}); }
    GSYNC();
#pragma unroll 1
    for (int b = 0; b < BATCH; ++b) {
        { PH_BEGIN; unsigned char* ws = PWS; const int c = blockIdx.x, G = gridDim.x;
          bf16_t* H = (bf16_t*)(ws + WS_H); const float* DTb = (const float*)(ws + WS_DT) + (size_t)b * SEQ * 32;
          for (int u = c; u < 256; u += G) ssd::phaseA_unit((SS_LAS unsigned char*)lds, H, DTb, PIN(3), PIN(4), PIN(6), (bf16_t*)(ws + WS_T1), (float*)(ws + WS_CTL) + 1024, u >> 2, u & 3);
          const float lam = ((const float*)(ws + WS_CTL))[CW_LAM]; const float* subln_w = PIN(12);
#if PROBE_ATTN
          for (int u = c; u < 256; u += G) { const int h = u >> 5, j = u & 31;
              dattn::unit<false>((DA_LAS unsigned char*)lds, H, h, 63 - j, subln_w, lam);
              dattn::unit<false>((DA_LAS unsigned char*)lds, H, h, j, subln_w, lam); }
#endif
          for (int u = c; u < 256; u += G) { const int h = u >> 5, j = u & 31;
              dattn::unit((DA_LAS unsigned char*)lds, H, h, 63 - j, subln_w, lam);
              dattn::unit((DA_LAS unsigned char*)lds, H, h, j, subln_w, lam); } }
        GSYNC();
        { PH_BEGIN; unsigned char* ws = PWS; const int tid = opaque_tid();
          for (size_t i = (size_t)blockIdx.x * 512 + tid; i < 131072; i += (size_t)gridDim.x * 512) ssd::scan_phase((bf16_t*)(ws + WS_T1), (const float*)(ws + WS_CTL) + 1024, (int)i); }
        GSYNC();
        { PH_BEGIN; unsigned char* ws = PWS; const int c = blockIdx.x, G = gridDim.x;
#if PROBE_SSD
          for (int u = c; u < 256; u += G) ssd::phaseA_unit((SS_LAS unsigned char*)lds, (bf16_t*)(ws + WS_H), (const float*)(ws + WS_DT) + (size_t)b * SEQ * 32, PIN(3), PIN(4), PIN(6), (bf16_t*)(POUT + (size_t)SEQ * D), (float*)(ws + WS_CTL) + 8192, u >> 2, u & 3);
          for (int u = c; u < 256; u += G) ssd::phaseC_unit<false>((SS_LAS unsigned char*)lds, (bf16_t*)(ws + WS_H), (const float*)(ws + WS_DT) + (size_t)b * SEQ * 32, PIN(3), PIN(4), PIN(6), PIN(7), PIN(8), (const bf16_t*)(ws + WS_T1), u >> 2, u & 3);
#endif
          for (int u = c; u < 256; u += G) ssd::phaseC_unit((SS_LAS unsigned char*)lds, (bf16_t*)(ws + WS_H), (const float*)(ws + WS_DT) + (size_t)b * SEQ * 32, PIN(3), PIN(4), PIN(6), PIN(7), PIN(8), (const bf16_t*)(ws + WS_T1), u >> 2, u & 3); }
        GSYNC();
        { PH_BEGIN; unsigned char* ws = PWS; bf16_t* H = (bf16_t*)(ws + WS_H); float* T1 = (float*)(ws + WS_T1);
          run_gemm(lds, H + HC_Z, HP_, (const bf16_t*)(ws + WS_WSSD), SEQ, D, DI, EpiGate1{H, T1});
          run_gemm(lds, H + HC_Q, HP_, (const bf16_t*)(ws + WS_WDIFF), SEQ, D, D, EpiGate2{H, T1});
          if (b == 0) {
              const int hs = (int)gridDim.x / 2;
              run_gemm(lds, (const bf16_t*)(ws + WS_MEMB), D, (const bf16_t*)(ws + WS_WCKV), BATCH * MEML, D, D, EpiPlain{(bf16_t*)(ws + WS_KCVC), D, 1.f}, hs);
              for (int bb = 0; bb < BATCH; ++bb)
                  run_gemm(lds, (const bf16_t*)(ws + WS_WCKV) + (size_t)D * D, D, (const bf16_t*)(ws + WS_MEMB) + (size_t)bb * MEML * D, D, MEML, D, EpiPlain{(bf16_t*)(ws + WS_KCVC) + (size_t)BATCH * MEML * D + (size_t)bb * D * MEML, MEML, 1.f}, hs + 8 + 4 * bb);
          }
          if (b == BATCH - 1 && 2 * (int)blockIdx.x >= (int)gridDim.x) { const int tid = opaque_tid(); const int half = (gridDim.x + 1) / 2;
              const size_t gt = (size_t)(blockIdx.x - half) * 512 + tid, gn = (size_t)(gridDim.x - half) * 512;
              sp::cvt_fp8_range(PIN(26), ws + WS_PU, (size_t)PK * PK * D / 16, sp::PEER_SU, gt, gn);
              sp::cvt_fp8_range(PIN(27), ws + WS_PV, (size_t)PK * PK * D / 16, sp::PEER_SV, gt, gn); } }
        GSYNC();
        { PH_BEGIN; unsigned char* ws = PWS;
          run_gemm(lds, (const bf16_t*)(ws + WS_H) + HC_K, HP_, (const bf16_t*)(ws + WS_WO), SEQ, D, D, EpiResid{PIN(0), POUT, b * SEQ, 0}); }
        GSYNC();
        if (b + 1 < BATCH) {
            { PH_BEGIN; unsigned char* ws = PWS;
              run_gemm(lds, (const bf16_t*)(ws + WS_XB) + (size_t)(b + 1) * SEQ * D, D, (const bf16_t*)(ws + WS_WIN), SEQ, NINP, D, EpiInProj{(bf16_t*)(ws + WS_H), PIN(14)}); }
            GSYNC();
        }
    }
    { PH_BEGIN; unsigned char* ws = PWS; const int tid = opaque_tid(), lane = tid & 63, wave = __builtin_amdgcn_readfirstlane(tid >> 6), c = blockIdx.x, G = gridDim.x;
      float* out = POUT; const float* g = PIN(16); const float* bb = PIN(17); bf16_t* XB = (bf16_t*)(ws + WS_X1B);
      for (int r = c * 8 + wave; r < M; r += G * 8) sp::ln_row(out, g, bb, XB, r, lane); }
    GSYNC();
    { PH_BEGIN; unsigned char* ws = PWS;
      run_gemm(lds, (const bf16_t*)(ws + WS_X1B), D, (const bf16_t*)(ws + WS_WCQ), M, D, D, EpiPlain{(bf16_t*)(ws + WS_QC), D, CQSCALE}); }
    GSYNC();
    { PH_BEGIN; unsigned char* ws = PWS; const int c = blockIdx.x, G = gridDim.x;
      for (int u = c; u < 256; u += G) xattn::unit((XA_LAS unsigned char*)lds, (const bf16_t*)(ws + WS_QC), (const bf16_t*)(ws + WS_KCVC), (const bf16_t*)(ws + WS_KCVC) + (size_t)BATCH * MEML * D, (bf16_t*)(ws + WS_XO), u >> 2, u & 3); }
    GSYNC();
    { PH_BEGIN; unsigned char* ws = PWS; float* out = POUT;
      run_gemm(lds, (const bf16_t*)(ws + WS_XO), D, (const bf16_t*)(ws + WS_WCO), M, D, D, EpiResid{out, out, 0, 0}); }
    GSYNC();
    { PH_BEGIN; unsigned char* ws = PWS; const int tid = opaque_tid(), lane = tid & 63, wave = __builtin_amdgcn_readfirstlane(tid >> 6), c = blockIdx.x, G = gridDim.x;
      float* out = POUT; const float* g = PIN(22); const float* bb = PIN(23); bf16_t* XB = (bf16_t*)(ws + WS_X1B);
      for (int r = c * 8 + wave; r < M; r += G * 8) sp::ln_row(out, g, bb, XB, r, lane); }
    GSYNC();
    { PH_BEGIN; unsigned char* ws = PWS;
      run_gemm(lds, (const bf16_t*)(ws + WS_X1B), D, (const bf16_t*)(ws + WS_WPQ), M, 2048, D, EpiPlain{(bf16_t*)(ws + WS_QP), 2048, 1.f}); }
    GSYNC();
    { PH_BEGIN; unsigned char* ws = PWS; const int c = blockIdx.x, G = gridDim.x;
      for (int t = 64 * c; t < M; t += 64 * G) {
          for (int hp = 0; hp < 4; ++hp) psel::stage1((PS_LAS int*)lds, (const bf16_t*)(ws + WS_QP), (const bf16_t*)(ws + WS_SUBK), t, hp);
          __syncthreads();
          psel::stage2((PS_LAS int*)lds, (int*)(ws + WS_IDX), (float*)(ws + WS_GATE), t);
          __syncthreads(); } }
    GSYNC();
    { PH_BEGIN; unsigned char* ws = PWS; const int tid = opaque_tid(), lane = tid & 63, wave = __builtin_amdgcn_readfirstlane(tid >> 6);
      const peer2::Own o = peer2::ownership((unsigned*)(ws + WS_CTL), (P2_LAS unsigned*)lds, 0, wave);
      for (int jj = o.j; jj < 8; jj += o.nsl) peer2::u_wave(POUT, ws + WS_PU, (const int*)(ws + WS_IDX), (float*)(ws + WS_PART), jj, o.rank, o.nrank, lane); }
    GSYNC();
    { PH_BEGIN; unsigned char* ws = PWS; const int tid = opaque_tid(), lane = tid & 63, wave = __builtin_amdgcn_readfirstlane(tid >> 6);
      const peer2::Own o = peer2::ownership((unsigned*)(ws + WS_CTL), (P2_LAS unsigned*)lds, 1, wave);
      for (int jj = o.j; jj < 8; jj += o.nsl) peer2::v_wave(POUT, ws + WS_PV, (const int*)(ws + WS_IDX), (const float*)(ws + WS_GATE), (const float*)(ws + WS_PART), (P2_LAS float*)lds + 64 + wave * 128, jj, o.rank, o.nrank, lane); }
    GSYNC();
    { PH_BEGIN; const int tid = opaque_tid(), lane = tid & 63, wave = __builtin_amdgcn_readfirstlane(tid >> 6);
      float* out = POUT; const float* g3 = PIN(28); const float* b3 = PIN(29);
      for (int r = blockIdx.x * 8 + wave; r < M; r += gridDim.x * 8) peer2::ln_row_plain(out, g3, b3, r, lane); }
}

extern "C" void kernel_launch(void* const* d_in, const int* in_sizes, int n_in, void* d_out, int out_size, void* d_ws, size_t ws_size, hipStream_t stream) {
    static int grid_blocks = 0;
    if (grid_blocks == 0) {
        if (n_in != 30 || out_size != M * D || ws_size < WS_END) { fprintf(stderr, "kernel_launch: unexpected sizes n_in %d out %d ws %zu (need %zu)\n", n_in, out_size, ws_size, (size_t)WS_END); grid_blocks = -1; return; }
        int dev = 0, cus = 0, per_cu = 0;
        (void)hipGetDevice(&dev); (void)hipDeviceGetAttribute(&cus, hipDeviceAttributeMultiprocessorCount, dev);
        (void)hipFuncSetAttribute((const void*)hybrid_fwd, hipFuncAttributeMaxDynamicSharedMemorySize, LDS_BYTES);
        if (hipOccupancyMaxActiveBlocksPerMultiprocessor(&per_cu, (const void*)hybrid_fwd, 512, LDS_BYTES) != hipSuccess || per_cu < 1) { fprintf(stderr, "kernel_launch: occupancy query failed (%d)\n", per_cu); per_cu = 1; }
        (void)hipGetLastError();
        grid_blocks = cus * 1;
    }
    if (grid_blocks < 0) return;
    if (hipMemsetAsync(d_ws, 0, 65536, stream) != hipSuccess) { fprintf(stderr, "kernel_launch: memset of control words failed\n"); return; }
    Params p{};
    for (int i = 0; i < 30; ++i) p.in[i] = (const float*)d_in[i];
    p.out = (float*)d_out; p.ws = (unsigned char*)d_ws;
    void* args[] = {&p};
    hipError_t e = hipLaunchCooperativeKernel((const void*)hybrid_fwd, dim3(grid_blocks), dim3(512), args, LDS_BYTES, stream);
    if (e != hipSuccess) fprintf(stderr, "cooperative launch failed: %s (grid %d)\n", hipGetErrorString(e), grid_blocks);
}
```

```cpp
#include <hip/hip_runtime.h>
#include <hip/hip_cooperative_groups.h>
namespace cg = cooperative_groups;
#include <cstdio>
#include <cstdint>
#include <cmath>
#include <type_traits>

typedef unsigned short bf16_t;
typedef float f32x4 __attribute__((ext_vector_type(4)));
typedef unsigned u32x4 __attribute__((ext_vector_type(4)));
typedef unsigned u32x2 __attribute__((ext_vector_type(2)));

constexpr int D = 1024, BATCH = 2, SEQ = 8192, M = BATCH * SEQ;
constexpr int DI = 2048, NH = 32, HP = 64, NG = 4, DS = 128, DXBC = 3072;
constexpr int AH = 8, AD = 64, AV = 128;
constexpr int MEML = 256, MH = 4, MHD = 256;
constexpr int PH = 8, PK = 128, PDK = 256, PHALF = 128, PTOP = 16;
constexpr int NIN = 10272, NINP = 10240;
constexpr float ALPHA = 1.189207115002721f;
constexpr float LOG2E = 1.4426950408889634f;
constexpr float QSCALE = 0.125f * LOG2E;
constexpr float CQSCALE = 0.0625f * LOG2E;
constexpr float LAMBDA_INIT = 0.2f;
constexpr int HC_Z = 0, HC_XBC = 2048, HC_Q = 5120, HC_K = 6144, HC_V = 7168, HC_GS = 8192, HC_GA = 9216, HP_ = NINP;

constexpr size_t MiB = 1u << 20;
constexpr size_t WS_CTL = 0;
constexpr size_t WS_WIN = 1 * MiB;
constexpr size_t WS_WSSD = 21 * MiB;
constexpr size_t WS_WDIFF = 25 * MiB, WS_WO = 27 * MiB, WS_WCQ = 29 * MiB, WS_WCKV = 31 * MiB  , WS_WCO = 35 * MiB;
constexpr size_t WS_WPQ = 37 * MiB;
constexpr size_t WS_SUBK = 41 * MiB;
constexpr size_t WS_MEMB = 42 * MiB;
constexpr size_t WS_KCVC = 43 * MiB;
constexpr size_t WS_DT = 45 * MiB;
constexpr size_t WS_XB = 47 * MiB;
constexpr size_t WS_H = 79 * MiB;
constexpr size_t WS_T1 = 239 * MiB;
constexpr size_t WS_PU = 47 * MiB, WS_PV = 63 * MiB;
constexpr size_t WS_X1B = 79 * MiB;
constexpr size_t WS_QC = 143 * MiB, WS_XO = 175 * MiB;
constexpr size_t WS_QP = 207 * MiB;
constexpr size_t WS_IDX = 143 * MiB, WS_GATE = 151 * MiB;
constexpr size_t WS_PART = 207 * MiB;
constexpr size_t WS_END = 271 * MiB;
constexpr int CW_LAM = 64;

__device__ __forceinline__ int opaque_tid() { int t = threadIdx.x; asm volatile("" : "+v"(t)); return t; }
__device__ __forceinline__ unsigned f2bf(float f) { unsigned u = __builtin_bit_cast(unsigned, f); return (u + 0x7fffu + ((u >> 16) & 1u)) >> 16; }
__device__ __forceinline__ float bf2f(unsigned h) { return __builtin_bit_cast(float, h << 16); }
__device__ __forceinline__ unsigned pk2(float lo, float hi) { return f2bf(lo) | (f2bf(hi) << 16); }
__device__ __forceinline__ float bflo(unsigned w) { return __builtin_bit_cast(float, w << 16); }
__device__ __forceinline__ float bfhi(unsigned w) { return __builtin_bit_cast(float, w & 0xffff0000u); }
__device__ __forceinline__ float sigmoidf_(float v) { return __builtin_amdgcn_rcpf(1.f + __expf(-v)); }
__device__ __forceinline__ float siluf_(float v) { return v * __builtin_amdgcn_rcpf(1.f + __expf(-v)); }
__device__ __forceinline__ float wave_sum(float v) {
#pragma unroll
    for (int o = 1; o < 64; o <<= 1) v += __shfl_xor(v, o);
    return v;
}
__device__ __forceinline__ float wave_max(float v) {
#pragma unroll
    for (int o = 1; o < 64; o <<= 1) v = fmaxf(v, __shfl_xor(v, o));
    return v;
}

__device__ __forceinline__ void store_bf16x8(bf16_t* p, const float (&v)[8]) { u32x4 w; w.x = pk2(v[0], v[1]); w.y = pk2(v[2], v[3]); w.z = pk2(v[4], v[5]); w.w = pk2(v[6], v[7]); *(u32x4*)p = w; }
struct EpiPlain { bf16_t* O; int ldc; float scale;
    __device__ __forceinline__ void operator()(int row, int col0, const float (&v)[8]) const { float o[8];
#pragma unroll
        for (int j = 0; j < 8; ++j) o[j] = v[j] * scale; store_bf16x8(O + (size_t)row * ldc + col0, o); } };
struct EpiInProj { bf16_t* H; const float* gate_bias;
    __device__ __forceinline__ void operator()(int row, int col0, const float (&v)[8]) const { float o[8];
        if (col0 >= HC_GS) { const float* gb = gate_bias + (col0 - HC_GS);
#pragma unroll
            for (int j = 0; j < 8; ++j) o[j] = sigmoidf_(v[j] + gb[j]); }
        else { const float s = (col0 >= HC_Q && col0 < HC_K) ? QSCALE : 1.f;
#pragma unroll
            for (int j = 0; j < 8; ++j) o[j] = v[j] * s; }
        store_bf16x8(H + (size_t)row * HP_ + col0, o); } };
struct EpiGate1 { const bf16_t* H; float* T1;
    __device__ __forceinline__ void operator()(int row, int col0, const float (&v)[8]) const {
        const u32x4 g = *(const u32x4*)(H + (size_t)row * HP_ + HC_GS + col0); const unsigned gw[4] = {g.x, g.y, g.z, g.w};
        float* t = T1 + (size_t)row * D + col0;
#pragma unroll
        for (int j = 0; j < 4; ++j) { t[2 * j] = bflo(gw[j]) * v[2 * j]; t[2 * j + 1] = bfhi(gw[j]) * v[2 * j + 1]; } } };
struct EpiGate2 { bf16_t* H; const float* T1;
    __device__ __forceinline__ void operator()(int row, int col0, const float (&v)[8]) const {
        const u32x4 g = *(const u32x4*)(H + (size_t)row * HP_ + HC_GA + col0); const unsigned gw[4] = {g.x, g.y, g.z, g.w};
        const float* t = T1 + (size_t)row * D + col0; float o[8];
#pragma unroll
        for (int j = 0; j < 4; ++j) { o[2 * j] = t[2 * j] + bflo(gw[j]) * v[2 * j]; o[2 * j + 1] = t[2 * j + 1] + bfhi(gw[j]) * v[2 * j + 1]; }
        store_bf16x8(H + (size_t)row * HP_ + HC_K + col0, o); } };
struct EpiResid { const float* base; float* out; int row_off; int pad_;
    __device__ __forceinline__ void operator()(int row, int col0, const float (&v)[8]) const {
        const size_t o = (size_t)(row + row_off) * D + col0;
#pragma unroll
        for (int j = 0; j < 8; ++j) out[o + j] = ALPHA * base[o + j] + v[j]; } };


namespace pg8 {
#define PG8_LAS __attribute__((address_space(3)))
typedef short bf16x8 __attribute__((ext_vector_type(8)));
constexpr int BM = 256, BK = 64, HALF = 128, HTB = HALF * BK * 2, STAGE_BYTES = 8 * HTB, NXCD = 8, WGM = 8;
__host__ __device__ __forceinline__ int lds_byte(int r, int c) { const int st = (r >> 4) * 2 + (c >> 5), rr = r & 15, cc = c & 31, ob = rr * 64 + cc * 2; return st * 1024 + (ob ^ (((ob >> 9) & 1) << 5)); }
__host__ __device__ __forceinline__ void stage_rc(int b, int& R, int& C) { const int st = b / 1024, sb = b % 1024, swz = sb ^ (((sb >> 9) & 1) << 5); R = (st >> 1) * 16 + swz / 64; C = (st & 1) * 32 + (swz % 64) / 2; }
__host__ __device__ __forceinline__ int perm32(int rho) { const int n = rho >> 4, i = rho & 15; return 8 * (i >> 2) + 4 * n + (i & 3); }
struct Unit { int pm, pn; };
struct Gemm { const bf16_t* A; const bf16_t* Bt; int M, N, K, lda; };
struct StaticOrder {
    int nM, nN, nwg, G, c;
    __host__ __device__ void init(int M, int N, int G_, int c_) { nM = M / BM; nN = N / BM; nwg = nM * nN; G = G_; c = c_; }
    __host__ __device__ bool next(int i, Unit& u) const {
        const long L = (long)i * G + c; if (L >= nwg) return false;
        int wgid = (int)L; { const int q = nwg / NXCD, r = nwg % NXCD, xcd = wgid % NXCD, off = wgid / NXCD; wgid = (xcd < r ? xcd * (q + 1) : r * (q + 1) + (xcd - r) * q) + off; }
        const int nig = WGM * nN, gid = wgid / nig, fm = gid * WGM, gsz = (nM - fm) < WGM ? (nM - fm) : WGM;
        u.pm = fm + ((wgid % nig) % gsz); u.pn = (wgid % nig) / gsz; return true;
    }
};
template <class F> struct EpiAdapt {
    static constexpr bool PERM = true, AFTER_DRAIN = false; F f;
    __device__ __forceinline__ void operator()(const f32x4 (&acc)[2][2][4][2], const Unit& u, int wr, int wc, int fr, int fq) const {
#pragma unroll
        for (int ai = 0; ai < 2; ++ai)
#pragma unroll
            for (int m = 0; m < 4; ++m) { const int row = u.pm * BM + ai * HALF + wr * 64 + m * 16 + fr;
#pragma unroll
                for (int bj = 0; bj < 2; ++bj) { const int col0 = u.pn * BM + bj * HALF + wc * 32 + 8 * fq;
                    const f32x4 a = acc[ai][bj][m][0], b = acc[ai][bj][m][1]; const float v[8] = {a[0], a[1], a[2], a[3], b[0], b[1], b[2], b[3]};
                    f(row, col0, v); } }
    }
};
template <class Epi, class Sched, bool ALIGN_EPI>
__device__ __forceinline__ void gemm_phase(PG8_LAS unsigned char* lds, const Gemm g, const Sched& S, const Epi& E) {
    const int tid = opaque_tid(), wid = __builtin_amdgcn_readfirstlane(tid >> 6), lane = tid & 63, wr = wid >> 2, wc = wid & 3, fr = lane & 15, fq = lane >> 4;
    const int K = g.K, nt = K / BK, lda = g.lda;
    unsigned voffA[2], voffB[2];
#pragma unroll
    for (int i = 0; i < 2; ++i) { int R, C; stage_rc(tid * 16 + i * 8192, R, C); const int Rb = Epi::PERM ? ((R & ~31) + perm32(R & 31)) : R;
        voffA[i] = (unsigned)(R * lda + C) * 2u; voffB[i] = (unsigned)(Rb * K + C) * 2u; }
    const size_t kstep = (size_t)(BK * 2);
    const size_t hstepA = (size_t)HALF * lda * 2, hstepB = (size_t)HALF * K * 2;
    const size_t tstepA = 2 * hstepA, tstepB = 2 * hstepB;
    const unsigned ldsw = (unsigned)wid * 1024u;
    const int aoff = lds_byte(wr * 64 + fr, fq * 8), boff = lds_byte(wc * 32 + fr, fq * 8);
#define PG8_SA(b, h) (((b) * 2 + (h)) * HTB)
#define PG8_SB(b, h) ((4 + (b) * 2 + (h)) * HTB)
#define PG8_STAGE(bufoff, gbase, voff) do { _Pragma("unroll") for (int _i = 0; _i < 2; ++_i) \
        __builtin_amdgcn_global_load_lds((const unsigned*)((const char*)(gbase) + (voff)[_i]), (PG8_LAS unsigned*)(lds + (bufoff) + ldsw + _i * 8192), 16, 0, 0); } while (0)
#define PG8_LDA(dst, b, h) do { _Pragma("unroll") for (int m = 0; m < 4; ++m) _Pragma("unroll") for (int k = 0; k < 2; ++k) dst[m][k] = *(const PG8_LAS bf16x8*)(lds + PG8_SA(b, h) + aoff + m * 2048 + k * 1024); } while (0)
#define PG8_LDB(dst, b, h) do { _Pragma("unroll") for (int n = 0; n < 2; ++n) _Pragma("unroll") for (int k = 0; k < 2; ++k) dst[n][k] = *(const PG8_LAS bf16x8*)(lds + PG8_SB(b, h) + boff + n * 2048 + k * 1024); } while (0)
#define PG8_MMA(ai, bj, At, Bt) do { __builtin_amdgcn_s_setprio(1); _Pragma("unroll") for (int m = 0; m < 4; ++m) _Pragma("unroll") for (int n = 0; n < 2; ++n) _Pragma("unroll") for (int k = 0; k < 2; ++k) \
        acc[ai][bj][m][n] = __builtin_amdgcn_mfma_f32_16x16x32_bf16(Bt[n][k], At[m][k], acc[ai][bj][m][n], 0, 0, 0); __builtin_amdgcn_s_setprio(0); } while (0)
#define PG8_WAIT_V(n) asm volatile("s_waitcnt vmcnt(" #n ")" ::: "memory")
#define PG8_WAIT_L(n) asm volatile("s_waitcnt lgkmcnt(" #n ")" ::: "memory")
#define PG8_BAR __builtin_amdgcn_s_barrier()
#define PG8_SCHED __builtin_amdgcn_sched_barrier(0)
    Unit cur, nxt; int ui = 0;
    if (!S.next(0, cur)) return;
    f32x4 acc[2][2][4][2];
#pragma unroll
    for (int a = 0; a < 2; ++a)
#pragma unroll
        for (int b = 0; b < 2; ++b)
#pragma unroll
            for (int m = 0; m < 4; ++m)
#pragma unroll
                for (int n = 0; n < 2; ++n) acc[a][b][m][n] = (f32x4){0.f, 0.f, 0.f, 0.f};
    bf16x8 At[4][2], B0[2][2], B1[2][2];
    const char* cA = (const char*)g.A + (size_t)cur.pm * tstepA; const char* cB = (const char*)g.Bt + (size_t)cur.pn * tstepB;
    PG8_STAGE(PG8_SB(0, 0), cB, voffB); PG8_STAGE(PG8_SB(0, 1), cB + hstepB, voffB); PG8_STAGE(PG8_SA(0, 0), cA, voffA); PG8_STAGE(PG8_SA(0, 1), cA + hstepA, voffA);
    if (wr == 1) PG8_BAR;
    PG8_WAIT_V(2); PG8_BAR;
    PG8_STAGE(PG8_SB(1, 0), cB + kstep, voffB); PG8_STAGE(PG8_SA(1, 0), cA + kstep, voffA); PG8_STAGE(PG8_SB(1, 1), cB + hstepB + kstep, voffB);
    PG8_WAIT_V(6); PG8_BAR;
    for (;;) {
        const bool has_next = S.next(ui + 1, nxt);
        const char* nA = has_next ? (const char*)g.A + (size_t)nxt.pm * tstepA : cA; const char* nB = has_next ? (const char*)g.Bt + (size_t)nxt.pn * tstepB : cB;
        for (int t = 0; t < nt; t += 2) {
            const bool last = (t == nt - 2);
            const char* a1 = cA + (size_t)(t + 1) * kstep;
            const char* a2 = last ? nA : cA + (size_t)(t + 2) * kstep; const char* b2 = last ? nB : cB + (size_t)(t + 2) * kstep;
            const char* a3 = a2 + kstep; const char* b3 = b2 + kstep;
            PG8_LDB(B0, 0, 0); PG8_LDB(B1, 0, 1); PG8_SCHED; PG8_LDA(At, 0, 0); PG8_STAGE(PG8_SA(1, 1), a1 + hstepA, voffA);
            PG8_WAIT_V(8); PG8_WAIT_L(0); PG8_BAR; PG8_MMA(0, 0, At, B0); PG8_MMA(0, 1, At, B1); PG8_BAR; PG8_SCHED;
            PG8_LDA(At, 0, 1); PG8_STAGE(PG8_SB(0, 0), b2, voffB); PG8_STAGE(PG8_SB(0, 1), b2 + hstepB, voffB); PG8_STAGE(PG8_SA(0, 0), a2, voffA);
            PG8_WAIT_V(8); PG8_WAIT_L(0); PG8_BAR; PG8_MMA(1, 0, At, B0); PG8_MMA(1, 1, At, B1); PG8_BAR; PG8_SCHED;
            PG8_LDB(B0, 1, 0); PG8_LDB(B1, 1, 1); PG8_SCHED; PG8_LDA(At, 1, 0); PG8_STAGE(PG8_SA(0, 1), a2 + hstepA, voffA);
            PG8_WAIT_V(8); PG8_WAIT_L(0); PG8_BAR; PG8_MMA(0, 0, At, B0); PG8_MMA(0, 1, At, B1); PG8_BAR; PG8_SCHED;
            PG8_LDA(At, 1, 1); PG8_STAGE(PG8_SB(1, 0), b3, voffB); PG8_STAGE(PG8_SB(1, 1), b3 + hstepB, voffB); PG8_STAGE(PG8_SA(1, 0), a3, voffA);
            PG8_WAIT_V(8); PG8_WAIT_L(0); PG8_BAR; PG8_MMA(1, 0, At, B0); PG8_MMA(1, 1, At, B1); PG8_BAR; PG8_SCHED;
        }
        if constexpr (ALIGN_EPI) { if (wr == 0) PG8_BAR; }
        E(acc, cur, wr, wc, fr, fq);
        if (!has_next) break;
#pragma unroll
        for (int a = 0; a < 2; ++a)
#pragma unroll
            for (int b = 0; b < 2; ++b)
#pragma unroll
                for (int m = 0; m < 4; ++m)
#pragma unroll
                    for (int n = 0; n < 2; ++n) acc[a][b][m][n] = (f32x4){0.f, 0.f, 0.f, 0.f};
        cur = nxt; cA = nA; cB = nB; ++ui;
        if constexpr (ALIGN_EPI) { if (wr == 1) PG8_BAR; }
    }
    PG8_WAIT_V(0);
    if constexpr (!ALIGN_EPI) { if (wr == 0) PG8_BAR; }
    PG8_BAR;
#undef PG8_SA
#undef PG8_SB
#undef PG8_STAGE
#undef PG8_LDA
#undef PG8_LDB
#undef PG8_MMA
#undef PG8_WAIT_V
#undef PG8_WAIT_L
#undef PG8_BAR
#undef PG8_SCHED
}
}
constexpr int LDS_BYTES = 148480;
namespace dattn {
#define DA_LAS __attribute__((address_space(3)))
typedef short bf16x8 __attribute__((ext_vector_type(8)));
typedef short s16x4 __attribute__((ext_vector_type(4)));
typedef float f32x16 __attribute__((ext_vector_type(16)));
constexpr int KP = 272, VP = 320, KBUF = 64 * KP, VBUF = 64 * VP, BUF = KBUF + VBUF, XOFF = 2 * BUF, LDS_NEED = XOFF + 65536;
static_assert(LDS_NEED <= 147456, "attention LDS");
__device__ __forceinline__ unsigned cvtpk(float lo, float hi) { typedef float f2 __attribute__((ext_vector_type(2))); typedef __bf16 b2 __attribute__((ext_vector_type(2))); f2 v = {lo, hi}; b2 b = __builtin_convertvector(v, b2); return __builtin_bit_cast(unsigned, b); }
__device__ __forceinline__ s16x4 vtr(const DA_LAS unsigned char* p) { typedef short v4i16_t __attribute__((ext_vector_type(4))); return __builtin_bit_cast(s16x4, __builtin_amdgcn_ds_read_tr16_b64_v4i16((DA_LAS v4i16_t*)p)); }
template <bool STORE = true> __device__ __forceinline__ void unit(DA_LAS unsigned char* lds, bf16_t* Hb, int h, int qb, const float* __restrict__ subln_w, float lam) {
    const int tid = opaque_tid(), lane = tid & 63, w = __builtin_amdgcn_readfirstlane(tid >> 6), mp = w >> 2, rb = w & 3, c32 = lane & 31, hh = lane >> 5;
    const int qrow = 128 * qb + 32 * rb + c32;
    bf16x8 qf[4];
    { const bf16_t* qp = Hb + (size_t)qrow * HP_ + HC_Q + h * 128 + 64 * mp + 8 * hh;
#pragma unroll
      for (int s = 0; s < 4; ++s) qf[s] = *(const bf16x8*)(qp + 16 * s); }
    const int srow = tid >> 4, sch = tid & 15;
    const bf16_t* kg = Hb + HC_K + h * 128 + sch * 8; const bf16_t* vg = Hb + HC_V + h * 128 + sch * 8;
    const int nt = 2 * qb + 2;
    u32x4 kr[2], vr[2];
#define DA_LOAD(t) do { _Pragma("unroll") for (int j = 0; j < 2; ++j) { const size_t ro = (size_t)(64 * (t) + srow + 32 * j) * HP_; kr[j] = *(const u32x4*)(kg + ro); vr[j] = *(const u32x4*)(vg + ro); } } while (0)
#define DA_WRITE(buf) do { _Pragma("unroll") for (int j = 0; j < 2; ++j) { *(DA_LAS u32x4*)(lds + (buf) * BUF + (srow + 32 * j) * KP + sch * 16) = kr[j]; *(DA_LAS u32x4*)(lds + (buf) * BUF + KBUF + (srow + 32 * j) * VP + sch * 16) = vr[j]; } } while (0)
    DA_LOAD(0); DA_WRITE(0);
    __syncthreads();
    f32x16 oT[4];
#pragma unroll
    for (int i = 0; i < 4; ++i) oT[i] = (f32x16){0.f, 0.f, 0.f, 0.f, 0.f, 0.f, 0.f, 0.f, 0.f, 0.f, 0.f, 0.f, 0.f, 0.f, 0.f, 0.f};
    float lrow = 0.f;
    f32x16 negm = (f32x16){0.f, 0.f, 0.f, 0.f, 0.f, 0.f, 0.f, 0.f, 0.f, 0.f, 0.f, 0.f, 0.f, 0.f, 0.f, 0.f};
    const int koff = c32 * KP + (64 * mp + 8 * hh) * 2;
    const int voff = KBUF + (4 * hh + ((lane & 15) >> 2)) * VP + (16 * ((lane >> 4) & 1) + 4 * (lane & 3)) * 2;
    for (int t = 0; t < nt; ++t) {
        const int cur = t & 1;
        if (t + 1 < nt) DA_LOAD(t + 1);
        if (!(t == nt - 1 && rb <= 1)) {
            const DA_LAS unsigned char* kb = lds + cur * BUF + koff;
            f32x16 s0 = negm, s1 = negm;
            bf16x8 kf0[4], kf1[4];
#pragma unroll
            for (int s = 0; s < 4; ++s) { kf0[s] = *(const DA_LAS bf16x8*)(kb + s * 32); kf1[s] = *(const DA_LAS bf16x8*)(kb + 32 * KP + s * 32); }
            __builtin_amdgcn_s_setprio(1);
#pragma unroll
            for (int s = 0; s < 4; ++s) {
                s0 = __builtin_amdgcn_mfma_f32_32x32x16_bf16(kf0[s], qf[s], s0, 0, 0, 0);
                s1 = __builtin_amdgcn_mfma_f32_32x32x16_bf16(kf1[s], qf[s], s1, 0, 0, 0);
            }
            __builtin_amdgcn_s_setprio(0);
            if (t >= nt - 2) {
                const int k0 = 64 * t + 4 * hh;
#pragma unroll
                for (int r = 0; r < 16; ++r) { const int key = k0 + (r & 3) + 8 * (r >> 2); if (key > qrow) s0[r] = -INFINITY; if (key + 32 > qrow) s1[r] = -INFINITY; }
            }
            float mxa = fmaxf(fmaxf(s0[0], s0[1]), s1[0]), mxb = fmaxf(fmaxf(s0[2], s0[3]), s1[1]);
            mxa = fmaxf(fmaxf(mxa, s1[2]), s1[3]);
#pragma unroll
            for (int r = 4; r < 16; r += 4) { mxa = fmaxf(fmaxf(mxa, s0[r]), s0[r + 1]); mxb = fmaxf(fmaxf(mxb, s0[r + 2]), s0[r + 3]); mxa = fmaxf(fmaxf(mxa, s1[r]), s1[r + 1]); mxb = fmaxf(fmaxf(mxb, s1[r + 2]), s1[r + 3]); }
            float mx = fmaxf(mxa, mxb);
            mx = fmaxf(mx, __shfl_xor(mx, 32));
            if (__any(mx > 8.f)) {
                const float dl = fmaxf(mx, 0.f), alpha = __builtin_amdgcn_exp2f(-dl);
#pragma unroll
                for (int r = 0; r < 16; ++r) { s0[r] -= dl; s1[r] -= dl; negm[r] -= dl; }
                lrow *= alpha;
#pragma unroll
                for (int i = 0; i < 4; ++i)
#pragma unroll
                    for (int r = 0; r < 16; ++r) oT[i][r] *= alpha;
            }
            float ps = 0.f;
#pragma unroll
            for (int r = 0; r < 16; ++r) { s0[r] = __builtin_amdgcn_exp2f(s0[r]); s1[r] = __builtin_amdgcn_exp2f(s1[r]); ps += s0[r] + s1[r]; }
            lrow += ps;
            bf16x8 pf[2][2];
#pragma unroll
            for (int s = 0; s < 2; ++s) {
                u32x4 a, b;
                a.x = cvtpk(s0[8 * s], s0[8 * s + 1]); a.y = cvtpk(s0[8 * s + 2], s0[8 * s + 3]); a.z = cvtpk(s0[8 * s + 4], s0[8 * s + 5]); a.w = cvtpk(s0[8 * s + 6], s0[8 * s + 7]);
                b.x = cvtpk(s1[8 * s], s1[8 * s + 1]); b.y = cvtpk(s1[8 * s + 2], s1[8 * s + 3]); b.z = cvtpk(s1[8 * s + 4], s1[8 * s + 5]); b.w = cvtpk(s1[8 * s + 6], s1[8 * s + 7]);
                pf[0][s] = __builtin_bit_cast(bf16x8, a); pf[1][s] = __builtin_bit_cast(bf16x8, b);
            }
            const DA_LAS unsigned char* vb = lds + cur * BUF + voff;
#define DA_LDV(dst, db) do { _Pragma("unroll") for (int i_ = 0; i_ < 4; ++i_) { const s16x4 lo_ = vtr(vb + (16 * i_) * VP + (db) * 64), hi_ = vtr(vb + (16 * i_ + 8) * VP + (db) * 64); \
                dst[i_] = (bf16x8){lo_[0], lo_[1], lo_[2], lo_[3], hi_[0], hi_[1], hi_[2], hi_[3]}; } } while (0)
#define DA_MM(src, db) do { _Pragma("unroll") for (int i_ = 0; i_ < 4; ++i_) oT[db] = __builtin_amdgcn_mfma_f32_32x32x16_bf16(src[i_], pf[i_ >> 1][i_ & 1], oT[db], 0, 0, 0); } while (0)
            bf16x8 va[4], vq[4];
            DA_LDV(va, 0);
            DA_LDV(vq, 1); __builtin_amdgcn_s_setprio(1); DA_MM(va, 0); __builtin_amdgcn_s_setprio(0);
            DA_LDV(va, 2); __builtin_amdgcn_s_setprio(1); DA_MM(vq, 1); __builtin_amdgcn_s_setprio(0);
            DA_LDV(vq, 3); __builtin_amdgcn_s_setprio(1); DA_MM(va, 2); __builtin_amdgcn_s_setprio(0);
            __builtin_amdgcn_s_setprio(1); DA_MM(vq, 3);
#undef DA_LDV
#undef DA_MM
            __builtin_amdgcn_s_setprio(0);
        }
        if (t + 1 < nt) DA_WRITE(cur ^ 1);
        __syncthreads();
    }
#undef DA_LOAD
#undef DA_WRITE
    const float inv = 1.f / (lrow + __shfl_xor(lrow, 32));
    DA_LAS float* X = (DA_LAS float*)(lds + XOFF) + rb * 4096 + lane;
    if (mp == 1) {
#pragma unroll
        for (int i = 0; i < 4; ++i)
#pragma unroll
            for (int r = 0; r < 16; ++r) X[(i * 16 + r) * 64] = oT[i][r] * inv;
    }
    __syncthreads();
    if (mp == 0) {
        float ss = 0.f;
#pragma unroll
        for (int i = 0; i < 4; ++i)
#pragma unroll
            for (int r = 0; r < 16; ++r) { const float o = oT[i][r] * inv - lam * X[(i * 16 + r) * 64]; oT[i][r] = o; ss += o * o; }
        ss += __shfl_xor(ss, 32);
        const float rr = rsqrtf(ss * (1.f / 128.f) + 1e-5f) * (1.f - LAMBDA_INIT);
        bf16_t* op = Hb + (size_t)qrow * HP_ + HC_Q + h * 128 + 4 * hh;
#pragma unroll
        for (int i = 0; i < 4; ++i)
#pragma unroll
            for (int g = 0; g < 4; ++g) { const int d0 = 32 * i + 8 * g; const f32x4 sw = *(const f32x4*)(subln_w + d0 + 4 * hh);
                uint2 o; o.x = pk2(oT[i][4 * g] * rr * sw.x, oT[i][4 * g + 1] * rr * sw.y); o.y = pk2(oT[i][4 * g + 2] * rr * sw.z, oT[i][4 * g + 3] * rr * sw.w);
                if (STORE || o.x == 0x12345u) *(uint2*)(op + d0) = o; }
    }
    __syncthreads();
}
}
namespace ssd {
#define SS_LAS __attribute__((address_space(3)))
typedef short bf16x8 __attribute__((ext_vector_type(8)));
typedef short s16x4 __attribute__((ext_vector_type(4)));
typedef float f32x16 __attribute__((ext_vector_type(16)));
constexpr int XP = 192;
constexpr int BPT = 320;
constexpr int CP = 272;
__device__ __forceinline__ s16x4 vtr(const SS_LAS unsigned char* p) { typedef short v4i16_t __attribute__((ext_vector_type(4))); return __builtin_bit_cast(s16x4, __builtin_amdgcn_ds_read_tr16_b64_v4i16((SS_LAS v4i16_t*)p)); }
__device__ __forceinline__ unsigned cvtpk(float lo, float hi) { typedef float f2 __attribute__((ext_vector_type(2))); typedef __bf16 b2 __attribute__((ext_vector_type(2))); f2 v = {lo, hi}; b2 b = __builtin_convertvector(v, b2); return __builtin_bit_cast(unsigned, b); }
__device__ __forceinline__ void acs_tables(SS_LAS float* ACS, SS_LAS float* DTS, const float* __restrict__ DTb, const float* __restrict__ a_log, int c, int g) {
    const int tid_ = opaque_tid(); const int lane = tid_ & 63, e = __builtin_amdgcn_readfirstlane(tid_ >> 6), h = 8 * g + e;
    const float a = -expf(a_log[h]);
    const float d0 = DTb[(size_t)(128 * c + 2 * lane) * 32 + h], d1 = DTb[(size_t)(128 * c + 2 * lane + 1) * 32 + h];
    const float a0 = d0 * a, a1 = d1 * a;
    float sc = a0 + a1;
#pragma unroll
    for (int o = 1; o < 64; o <<= 1) { const float v = __shfl_up(sc, o); if (lane >= o) sc += v; }
    const float ex = sc - (a0 + a1);
    ACS[(2 * lane) * 8 + e] = ex + a0; ACS[(2 * lane + 1) * 8 + e] = ex + a0 + a1;
    DTS[(2 * lane) * 8 + e] = d0; DTS[(2 * lane + 1) * 8 + e] = d1;
}
template <int NT, class F> __device__ __forceinline__ void conv_item(const bf16_t* __restrict__ Hb, int t0, int l0, int xch0, const float* __restrict__ conv_w, const float* __restrict__ conv_b, F sink) {
    float w[4][8], bias[8];
#pragma unroll
    for (int j = 0; j < 4; ++j) { const f32x4 a = *(const f32x4*)(conv_w + j * DXBC + xch0), b = *(const f32x4*)(conv_w + j * DXBC + xch0 + 4); w[j][0] = a.x; w[j][1] = a.y; w[j][2] = a.z; w[j][3] = a.w; w[j][4] = b.x; w[j][5] = b.y; w[j][6] = b.z; w[j][7] = b.w; }
    { const f32x4 a = *(const f32x4*)(conv_b + xch0), b = *(const f32x4*)(conv_b + xch0 + 4); bias[0] = a.x; bias[1] = a.y; bias[2] = a.z; bias[3] = a.w; bias[4] = b.x; bias[5] = b.y; bias[6] = b.z; bias[7] = b.w; }
    const bf16_t* src = Hb + HC_XBC + xch0;
    u32x4 rw[NT + 3];
#pragma unroll
    for (int i = 0; i < NT + 3; ++i) { const int tt = t0 + l0 - 3 + i; rw[i] = *(const u32x4*)(src + (size_t)(tt < 0 ? 0 : tt) * HP_); }
    if (t0 + l0 < 3) {
#pragma unroll
        for (int i = 0; i < 3; ++i) if (t0 + l0 - 3 + i < 0) rw[i] = (u32x4){0u, 0u, 0u, 0u};
    }
#define SS_UNP(dst, q_) do { dst[0] = bflo(q_.x); dst[1] = bfhi(q_.x); dst[2] = bflo(q_.y); dst[3] = bfhi(q_.y); dst[4] = bflo(q_.z); dst[5] = bfhi(q_.z); dst[6] = bflo(q_.w); dst[7] = bfhi(q_.w); } while (0)
    float x0[8], x1[8], x2[8];
    SS_UNP(x0, rw[0]); SS_UNP(x1, rw[1]); SS_UNP(x2, rw[2]);
#pragma unroll
    for (int i = 0; i < NT; ++i) {
        float x3[8]; SS_UNP(x3, rw[3 + i]);
        float v[8];
#pragma unroll
        for (int k = 0; k < 8; ++k) { const float a = bias[k] + w[0][k] * x0[k] + w[1][k] * x1[k] + w[2][k] * x2[k] + w[3][k] * x3[k]; v[k] = a * __builtin_amdgcn_rcpf(1.f + __expf(-a)); x0[k] = x1[k]; x1[k] = x2[k]; x2[k] = x3[k]; }
        sink(l0 + i, v);
    }
#undef SS_UNP
}
constexpr int A_BS = 0, A_XD = 128 * BPT  , A_ACS = A_XD + 2 * 128 * XP  , A_DTS = A_ACS + 4096, A_END = A_DTS + 4096;
__device__ __forceinline__ void phaseA_unit(SS_LAS unsigned char* lds, const bf16_t* __restrict__ Hb, const float* __restrict__ DTb, const float* __restrict__ conv_w, const float* __restrict__ conv_b,
                                            const float* __restrict__ a_log, bf16_t* __restrict__ ST, float* __restrict__ CD, int c, int g) {
    const int tid = opaque_tid(), lane = tid & 63, w = __builtin_amdgcn_readfirstlane(tid >> 6), c32 = lane & 31, hh = lane >> 5;
    SS_LAS float* ACS = (SS_LAS float*)(lds + A_ACS); SS_LAS float* DTS = (SS_LAS float*)(lds + A_DTS);
    acs_tables(ACS, DTS, DTb, a_log, c, g);
    __syncthreads();
    if (tid < 8) CD[c * 32 + 8 * g + tid] = __expf(ACS[127 * 8 + tid]);
    auto stageX = [&](int e, int item, int buf) {
        const int cg = item >> 5, seg = item & 31; const float aend = ACS[127 * 8 + e];
        conv_item<4>(Hb, 128 * c, 4 * seg, g * 512 + e * 64 + cg * 8, conv_w, conv_b, [&](int l, const float (&v)[8]) {
            const float sc = DTS[l * 8 + e] * __expf(aend - ACS[l * 8 + e]);
            u32x4 o; o.x = cvtpk(v[0] * sc, v[1] * sc); o.y = cvtpk(v[2] * sc, v[3] * sc); o.z = cvtpk(v[4] * sc, v[5] * sc); o.w = cvtpk(v[6] * sc, v[7] * sc);
            *(SS_LAS u32x4*)(lds + A_XD + buf * 128 * XP + l * XP + cg * 16) = o; });
    };
    { const int cg = tid >> 5, seg = tid & 31;
        conv_item<4>(Hb, 128 * c, 4 * seg, 2048 + g * 128 + cg * 8, conv_w, conv_b, [&](int l, const float (&v)[8]) {
            u32x4 o; o.x = cvtpk(v[0], v[1]); o.y = cvtpk(v[2], v[3]); o.z = cvtpk(v[4], v[5]); o.w = cvtpk(v[6], v[7]);
            *(SS_LAS u32x4*)(lds + A_BS + l * BPT + cg * 16) = o; }); }
    if (tid < 256) stageX(0, tid, 0);
    __syncthreads();
    const int pb = w & 1, nb = w >> 1;
    const int rsel = ((lane & 15) >> 2), csel = 16 * ((lane >> 4) & 1) + 4 * (lane & 3);
    for (int e = 0; e < 8; ++e) {
        if (e + 1 < 8 && tid >= 256) stageX(e + 1, tid - 256, (e + 1) & 1);
        f32x16 acc = (f32x16){0.f, 0.f, 0.f, 0.f, 0.f, 0.f, 0.f, 0.f, 0.f, 0.f, 0.f, 0.f, 0.f, 0.f, 0.f, 0.f};
        const SS_LAS unsigned char* bp = lds + A_BS + (8 * hh + rsel) * BPT + (32 * nb + csel) * 2;
        const SS_LAS unsigned char* xp = lds + A_XD + (e & 1) * 128 * XP + (8 * hh + rsel) * XP + (32 * pb + csel) * 2;
#pragma unroll
        for (int ks = 0; ks < 8; ++ks) {
            const s16x4 b0 = vtr(bp + (16 * ks) * BPT), b1 = vtr(bp + (16 * ks + 4) * BPT), x0 = vtr(xp + (16 * ks) * XP), x1 = vtr(xp + (16 * ks + 4) * XP);
            const bf16x8 bf = (bf16x8){b0[0], b0[1], b0[2], b0[3], b1[0], b1[1], b1[2], b1[3]}, xf = (bf16x8){x0[0], x0[1], x0[2], x0[3], x1[0], x1[1], x1[2], x1[3]};
            acc = __builtin_amdgcn_mfma_f32_32x32x16_bf16(bf, xf, acc, 0, 0, 0);
        }
        bf16_t* sp = ST + ((size_t)(c * 32 + 8 * g + e) * 64 + 32 * pb + c32) * 128 + 32 * nb + 4 * hh;
#pragma unroll
        for (int q = 0; q < 4; ++q) { uint2 o; o.x = cvtpk(acc[4 * q], acc[4 * q + 1]); o.y = cvtpk(acc[4 * q + 2], acc[4 * q + 3]); *(uint2*)(sp + 8 * q) = o; }
        __syncthreads();
    }
}
__device__ __forceinline__ void scan_phase(bf16_t* __restrict__ ST, const float* __restrict__ CD, int gtid) {
    const int h = gtid >> 12;
    unsigned* p = (unsigned*)ST + gtid;
    float r0 = 0.f, r1 = 0.f;
    for (int c0 = 0; c0 < 64; c0 += 16) {
        unsigned v[16]; float d[16];
#pragma unroll
        for (int i = 0; i < 16; ++i) { v[i] = p[(size_t)(c0 + i) * 131072]; d[i] = CD[(c0 + i) * 32 + h]; }
#pragma unroll
        for (int i = 0; i < 16; ++i) { p[(size_t)(c0 + i) * 131072] = cvtpk(r0, r1); r0 = r0 * d[i] + bflo(v[i]); r1 = r1 * d[i] + bfhi(v[i]); }
    }
}
constexpr int C_CS = 0, C_BS = 128 * CP  , C_X1 = C_BS  , C_CBT = 2 * 128 * CP  , C_X0 = C_CBT + 32768  , C_ACS = C_X0 + 128 * XP  , C_DTS = C_ACS + 4096,
              C_SSQ = C_DTS + 4096, C_END = C_SSQ + 1024;
static_assert(C_END <= 147456 && 128 * XP <= 128 * CP, "ssd phase C LDS");
template <bool STORE = true> __device__ __forceinline__ void phaseC_unit(SS_LAS unsigned char* lds, bf16_t* __restrict__ Hb, const float* __restrict__ DTb, const float* __restrict__ conv_w, const float* __restrict__ conv_b,
                                            const float* __restrict__ a_log, const float* __restrict__ d_skip, const float* __restrict__ norm_w, const bf16_t* __restrict__ ST, int c, int g) {
    const int tid = opaque_tid(), lane = tid & 63, w = __builtin_amdgcn_readfirstlane(tid >> 6), c32 = lane & 31, hh = lane >> 5;
    SS_LAS float* ACS = (SS_LAS float*)(lds + C_ACS); SS_LAS float* DTS = (SS_LAS float*)(lds + C_DTS); SS_LAS float* SSQ = (SS_LAS float*)(lds + C_SSQ);
    acs_tables(ACS, DTS, DTb, a_log, c, g);
    auto stageX = [&](int e, int item, int buf) {
        const int cg = item >> 5, seg = item & 31;
        conv_item<4>(Hb, 128 * c, 4 * seg, g * 512 + e * 64 + cg * 8, conv_w, conv_b, [&](int l, const float (&v)[8]) {
            u32x4 o; o.x = cvtpk(v[0], v[1]); o.y = cvtpk(v[2], v[3]); o.z = cvtpk(v[4], v[5]); o.w = cvtpk(v[6], v[7]);
            *(SS_LAS u32x4*)(lds + (buf ? C_X1 : C_X0) + l * XP + cg * 16) = o; });
    };
    { const int isC = tid >> 8, it = tid & 255, cg = it >> 4, seg = it & 15;
        conv_item<8>(Hb, 128 * c, 8 * seg, 2048 + isC * 512 + g * 128 + cg * 8, conv_w, conv_b, [&](int l, const float (&v)[8]) {
            u32x4 o; o.x = cvtpk(v[0], v[1]); o.y = cvtpk(v[2], v[3]); o.z = cvtpk(v[4], v[5]); o.w = cvtpk(v[6], v[7]);
            *(SS_LAS u32x4*)(lds + (isC ? C_CS : C_BS) + l * CP + cg * 16) = o; }); }
    if (tid < 256) stageX(0, tid, 0);
    __syncthreads();
    for (int i = w; i < 10; i += 8) {
        const int sb = (i < 4) ? 0 : (i < 7) ? 1 : (i < 9) ? 2 : 3, lb = (i < 4) ? i : (i < 7) ? i - 3 : (i < 9) ? i - 5 : 3;
        f32x16 acc = (f32x16){0.f, 0.f, 0.f, 0.f, 0.f, 0.f, 0.f, 0.f, 0.f, 0.f, 0.f, 0.f, 0.f, 0.f, 0.f, 0.f};
        const SS_LAS unsigned char* bp = lds + C_BS + (32 * sb + c32) * CP + 16 * hh, *cp = lds + C_CS + (32 * lb + c32) * CP + 16 * hh;
#pragma unroll
        for (int ks = 0; ks < 8; ++ks) acc = __builtin_amdgcn_mfma_f32_32x32x16_bf16(*(const SS_LAS bf16x8*)(bp + 32 * ks), *(const SS_LAS bf16x8*)(cp + 32 * ks), acc, 0, 0, 0);
        SS_LAS unsigned* o = (SS_LAS unsigned*)(lds + C_CBT) + (sb * 4 + lb) * 512 + lane;
#pragma unroll
        for (int q = 0; q < 8; ++q) o[q * 64] = cvtpk(acc[2 * q], acc[2 * q + 1]);
    }
    __syncthreads();
    const int pb = w & 1, lb = w >> 1, lrow = 32 * lb + c32;
    const int rsel = ((lane & 15) >> 2), csel = 16 * ((lane >> 4) & 1) + 4 * (lane & 3);
    unsigned ypk[8][8];
    float ssq = 0.f;
    bf16x8 pcur[8]; u32x2 zcur[4];
#define SS_PREF(pdst, zdst, e_) do { const int h_ = 8 * g + (e_); const bf16_t* pp_ = ST + ((size_t)(c * 32 + h_) * 64 + 32 * pb + c32) * 128 + 8 * hh; \
        _Pragma("unroll") for (int ks_ = 0; ks_ < 8; ++ks_) pdst[ks_] = *(const bf16x8*)(pp_ + 16 * ks_); \
        const bf16_t* zp_ = Hb + (size_t)(128 * c + lrow) * HP_ + HC_Z + g * 512 + (e_) * 64 + 32 * pb + 4 * hh; \
        _Pragma("unroll") for (int q_ = 0; q_ < 4; ++q_) zdst[q_] = *(const u32x2*)(zp_ + 8 * q_); } while (0)
    SS_PREF(pcur, zcur, 0);
    for (int e = 0; e < 8; ++e) {
        const int h = 8 * g + e;
        if (e + 1 < 8 && tid < 256) stageX(e + 1, tid, (e + 1) & 1);
        bf16x8 pnext[8]; u32x2 znext[4];
        { const int en = (e + 1 < 8) ? e + 1 : 7; SS_PREF(pnext, znext, en); }
        const int xoff = (e & 1) ? C_X1 : C_X0;
        f32x16 acc = (f32x16){0.f, 0.f, 0.f, 0.f, 0.f, 0.f, 0.f, 0.f, 0.f, 0.f, 0.f, 0.f, 0.f, 0.f, 0.f, 0.f};
        {
            const SS_LAS unsigned char* cp = lds + C_CS + lrow * CP + 16 * hh;
#pragma unroll
            for (int ks = 0; ks < 8; ++ks) acc = __builtin_amdgcn_mfma_f32_32x32x16_bf16(pcur[ks], *(const SS_LAS bf16x8*)(cp + 32 * ks), acc, 0, 0, 0);
        }
        const float al = ACS[lrow * 8 + e], eal = __expf(al);
#pragma unroll
        for (int r = 0; r < 16; ++r) acc[r] *= eal;
        for (int sb = 0; sb <= lb; ++sb) {
            const SS_LAS unsigned* cbp = (const SS_LAS unsigned*)(lds + C_CBT) + (sb * 4 + lb) * 512 + lane;
            float m[16];
#pragma unroll
            for (int q = 0; q < 8; ++q) { const unsigned u = cbp[q * 64]; m[2 * q] = bflo(u); m[2 * q + 1] = bfhi(u); }
#pragma unroll
            for (int r = 0; r < 16; ++r) { const int srow = 32 * sb + (r & 3) + 8 * (r >> 2) + 4 * hh;
                const float f = __expf(al - ACS[srow * 8 + e]) * DTS[srow * 8 + e];
                m[r] = (srow <= lrow) ? m[r] * f : 0.f; }
            const SS_LAS unsigned char* xp = lds + xoff + (32 * sb + 4 * hh + rsel) * XP + (32 * pb + csel) * 2;
#pragma unroll
            for (int ks = 0; ks < 2; ++ks) {
                const s16x4 x0 = vtr(xp + (16 * ks) * XP), x1 = vtr(xp + (16 * ks + 8) * XP);
                const bf16x8 xf = (bf16x8){x0[0], x0[1], x0[2], x0[3], x1[0], x1[1], x1[2], x1[3]};
                u32x4 mm; mm.x = cvtpk(m[8 * ks], m[8 * ks + 1]); mm.y = cvtpk(m[8 * ks + 2], m[8 * ks + 3]); mm.z = cvtpk(m[8 * ks + 4], m[8 * ks + 5]); mm.w = cvtpk(m[8 * ks + 6], m[8 * ks + 7]);
                acc = __builtin_amdgcn_mfma_f32_32x32x16_bf16(xf, __builtin_bit_cast(bf16x8, mm), acc, 0, 0, 0);
            }
        }
        const float dsk = d_skip[h];
        const SS_LAS unsigned char* xr = lds + xoff + lrow * XP + (32 * pb + 4 * hh) * 2;
        unsigned yt[8];
#pragma unroll
        for (int q = 0; q < 4; ++q) {
            const u32x2 zz = zcur[q]; const u32x2 xx = *(const SS_LAS u32x2*)(xr + 16 * q);
            const float zv[4] = {bflo(zz.x), bfhi(zz.x), bflo(zz.y), bfhi(zz.y)}, xv[4] = {bflo(xx.x), bfhi(xx.x), bflo(xx.y), bfhi(xx.y)};
            float y[4];
#pragma unroll
            for (int k = 0; k < 4; ++k) { y[k] = (acc[4 * q + k] + dsk * xv[k]) * (zv[k] * __builtin_amdgcn_rcpf(1.f + __expf(-zv[k]))); ssq += y[k] * y[k]; }
            yt[2 * q] = cvtpk(y[0], y[1]); yt[2 * q + 1] = cvtpk(y[2], y[3]);
        }
#define SS_YSET(E) case E: { _Pragma("unroll") for (int q_ = 0; q_ < 8; ++q_) ypk[E][q_] = yt[q_]; } break;
        switch (e) { SS_YSET(0) SS_YSET(1) SS_YSET(2) SS_YSET(3) SS_YSET(4) SS_YSET(5) SS_YSET(6) default: { _Pragma("unroll") for (int q_ = 0; q_ < 8; ++q_) ypk[7][q_] = yt[q_]; } break; }
#undef SS_YSET
#pragma unroll
        for (int ks = 0; ks < 8; ++ks) pcur[ks] = pnext[ks];
#pragma unroll
        for (int q = 0; q < 4; ++q) zcur[q] = znext[q];
        __syncthreads();
    }
#undef SS_PREF
    ssq += __shfl_xor(ssq, 32);
    if (hh == 0) SSQ[pb * 128 + lrow] = ssq;
    __syncthreads();
    const float rstd = rsqrtf((SSQ[lrow] + SSQ[128 + lrow]) * (1.f / 512.f) + 1e-5f);
    bf16_t* op = Hb + (size_t)(128 * c + lrow) * HP_ + HC_Z + g * 512 + 32 * pb + 4 * hh;
    const float* nw = norm_w + g * 512 + 32 * pb + 4 * hh;
#pragma unroll
    for (int e = 0; e < 8; ++e)
#pragma unroll
        for (int q = 0; q < 4; ++q) { const f32x4 n4 = *(const f32x4*)(nw + e * 64 + 8 * q);
            uint2 o; o.x = cvtpk(bflo(ypk[e][2 * q]) * rstd * n4.x, bfhi(ypk[e][2 * q]) * rstd * n4.y); o.y = cvtpk(bflo(ypk[e][2 * q + 1]) * rstd * n4.z, bfhi(ypk[e][2 * q + 1]) * rstd * n4.w);
            if (STORE || o.x == 0x12345u) *(uint2*)(op + e * 64 + 8 * q) = o; }
    __syncthreads();
}
}


namespace psel {
#define PS_LAS __attribute__((address_space(3)))
typedef short bf16x8 __attribute__((ext_vector_type(8)));
typedef float f32x16 __attribute__((ext_vector_type(16)));
__device__ __forceinline__ int ord(float f) { const int b = __builtin_bit_cast(int, f); return b ^ ((b >> 31) & 0x7fffffff); }
__device__ __forceinline__ float unord(int t) { return __builtin_bit_cast(float, t ^ ((t >> 31) & 0x7fffffff)); }
#define PS_INS(top, v) do { int v_ = (v); _Pragma("unroll") for (int i_ = 0; i_ < 16; ++i_) { const int hi_ = max(top[i_], v_); v_ = min(top[i_], v_); top[i_] = hi_; } } while (0)
__device__ __forceinline__ void stage1(PS_LAS int* EXall, const bf16_t* __restrict__ QP, const bf16_t* __restrict__ SUBK, int tok0, int hp) {
    const int tid = opaque_tid(), lane = tid & 63, w1 = __builtin_amdgcn_readfirstlane(tid >> 6), c32 = lane & 31, hh = lane >> 5;
    PS_LAS int* EX = EXall + hp * 4096;
    {
        const int tile = w1 >> 2, hsel = (w1 >> 1) & 1, half = w1 & 1, h = 2 * hp + hsel;
        const bf16_t* qp = QP + (size_t)(tok0 + 32 * tile + c32) * 2048 + h * 256 + half * 128 + 8 * hh;
        const bf16_t* kp = SUBK + ((size_t)(h * 2 + half) * 128 + c32) * 128 + 8 * hh;
        bf16x8 qf[8];
#pragma unroll
        for (int ks = 0; ks < 8; ++ks) qf[ks] = *(const bf16x8*)(qp + 16 * ks);
        int top[16];
#pragma unroll
        for (int i = 0; i < 16; ++i) top[i] = (int)0x80000000;
        bf16x8 kfa[8], kfb[8];
#define PS_LDK(dst, mt_) do { _Pragma("unroll") for (int ks_ = 0; ks_ < 8; ++ks_) dst[ks_] = *(const bf16x8*)(kp + (size_t)(32 * (mt_)) * 128 + 16 * ks_); } while (0)
#define PS_TILE(src, mt_) do { f32x16 acc_ = (f32x16){0.f, 0.f, 0.f, 0.f, 0.f, 0.f, 0.f, 0.f, 0.f, 0.f, 0.f, 0.f, 0.f, 0.f, 0.f, 0.f}; \
            _Pragma("unroll") for (int ks_ = 0; ks_ < 8; ++ks_) acc_ = __builtin_amdgcn_mfma_f32_32x32x16_bf16(src[ks_], qf[ks_], acc_, 0, 0, 0); \
            _Pragma("unroll") for (int r_ = 0; r_ < 16; ++r_) { const int key_ = 32 * (mt_) + (r_ & 3) + 8 * (r_ >> 2) + 4 * hh; const int v__ = (ord(acc_[r_]) & ~127) | (127 - key_); PS_INS(top, v__); } } while (0)
        PS_LDK(kfa, 0);
        PS_LDK(kfb, 1); PS_TILE(kfa, 0);
        PS_LDK(kfa, 2); PS_TILE(kfb, 1);
        PS_LDK(kfb, 3); PS_TILE(kfa, 2);
        PS_TILE(kfb, 3);
#undef PS_LDK
#undef PS_TILE
        int oth[16];
#pragma unroll
        for (int i = 0; i < 16; ++i) oth[i] = __shfl_xor(top[i], 32);
#pragma unroll
        for (int i = 0; i < 16; ++i) PS_INS(top, oth[i]);
        if (hh == 0) {
#pragma unroll
            for (int i = 0; i < 16; ++i) EX[(w1 * 16 + i) * 32 + c32] = top[i];
        }
    }
}
__device__ __forceinline__ void stage2(PS_LAS int* EXall, int* __restrict__ IDX, float* __restrict__ GATE, int tok0) {
    const int tid = opaque_tid();
    {
        const int hp = tid >> 7, task = tid & 127, th = task >> 5, tok32 = task & 31, tile = th >> 1, hsel = th & 1, h = 2 * hp + hsel;
        PS_LAS int* EX = EXall + hp * 4096;
        const PS_LAS int* ea = EX + ((th * 2 + 0) * 16) * 32 + tok32; const PS_LAS int* eb = EX + ((th * 2 + 1) * 16) * 32 + tok32;
        float as[16], bs[16];
#pragma unroll
        for (int i = 0; i < 16; ++i) { as[i] = unord(ea[i * 32] & ~127); bs[i] = unord(eb[i * 32] & ~127); }
        int top[16];
#pragma unroll
        for (int i = 0; i < 16; ++i) top[i] = (int)0x80000000;
#pragma unroll
        for (int i = 0; i < 16; ++i)
#pragma unroll
            for (int j = 0; j < 16; ++j) if ((i + 1) * (j + 1) <= 16) { const int v = (ord(as[i] + bs[j]) & ~255) | (255 - (i * 16 + j)); PS_INS(top, v); }
        float sc[16]; int id[16];
#pragma unroll
        for (int r = 0; r < 16; ++r) { const int cn = 255 - (top[r] & 255), i = cn >> 4, j = cn & 15; const int pa = ea[i * 32], pb = eb[j * 32];
            sc[r] = unord(pa & ~127) + unord(pb & ~127); id[r] = (127 - (pa & 127)) * 128 + (127 - (pb & 127)); }
        float sum = 0.f; const float mx = sc[0];
#pragma unroll
        for (int r = 0; r < 16; ++r) { sc[r] = __expf(sc[r] - mx); sum += sc[r]; }
        const size_t o = (size_t)(tok0 + 32 * tile + tok32) * 128 + h * 16;
        const float inv = 1.f / sum;
#pragma unroll
        for (int r = 0; r < 16; r += 4) { *(f32x4*)(GATE + o + r) = (f32x4){sc[r] * inv, sc[r + 1] * inv, sc[r + 2] * inv, sc[r + 3] * inv}; *(u32x4*)(IDX + o + r) = (u32x4){(unsigned)id[r], (unsigned)id[r + 1], (unsigned)id[r + 2], (unsigned)id[r + 3]}; }
    }
}
}


namespace xattn {
#define XA_LAS __attribute__((address_space(3)))
typedef short bf16x8 __attribute__((ext_vector_type(8)));
typedef short s16x4 __attribute__((ext_vector_type(4)));
typedef float f32x16 __attribute__((ext_vector_type(16)));
constexpr int RP = 528;
__device__ __forceinline__ unsigned cvtpk(float lo, float hi) { typedef float f2 __attribute__((ext_vector_type(2))); typedef __bf16 b2 __attribute__((ext_vector_type(2))); f2 v = {lo, hi}; b2 b = __builtin_convertvector(v, b2); return __builtin_bit_cast(unsigned, b); }
__device__ __forceinline__ void stage(XA_LAS unsigned char* lds, const bf16_t* __restrict__ src, int pitch, int tid) {
#pragma unroll 4
    for (int i = 0; i < 16; ++i) { const int q = tid + 512 * i, row = q >> 5, ch = q & 31; *(XA_LAS u32x4*)(lds + row * RP + ch * 16) = *(const u32x4*)(src + (size_t)row * pitch + ch * 8); }
}
__device__ __forceinline__ void unit(XA_LAS unsigned char* lds, const bf16_t* __restrict__ QC, const bf16_t* __restrict__ KC, const bf16_t* __restrict__ VcT, bf16_t* __restrict__ XO, int tg, int h) {
    const int tid = opaque_tid(), lane = tid & 63, w = __builtin_amdgcn_readfirstlane(tid >> 6), c32 = lane & 31, hh = lane >> 5, b = tg >> 5;
    const int tok = 256 * tg + 32 * w + c32;
    stage(lds, KC + (size_t)b * MEML * D + h * 256, D, tid);
    bf16x8 pf[8][2]; float inv;
    {
        bf16x8 qf[16];
        const bf16_t* qp = QC + (size_t)tok * D + h * 256 + 8 * hh;
#pragma unroll
        for (int ks = 0; ks < 16; ++ks) qf[ks] = *(const bf16x8*)(qp + 16 * ks);
        __syncthreads();
        f32x16 acc[8];
        const XA_LAS unsigned char* kb = lds + c32 * RP + 16 * hh;
#pragma unroll
        for (int mt = 0; mt < 8; ++mt) {
            acc[mt] = (f32x16){0.f, 0.f, 0.f, 0.f, 0.f, 0.f, 0.f, 0.f, 0.f, 0.f, 0.f, 0.f, 0.f, 0.f, 0.f, 0.f};
#pragma unroll
            for (int ks = 0; ks < 16; ++ks) acc[mt] = __builtin_amdgcn_mfma_f32_32x32x16_bf16(*(const XA_LAS bf16x8*)(kb + (32 * mt) * RP + 32 * ks), qf[ks], acc[mt], 0, 0, 0);
        }
        float mx = acc[0][0];
#pragma unroll
        for (int mt = 0; mt < 8; ++mt)
#pragma unroll
            for (int r = 0; r < 16; ++r) mx = fmaxf(mx, acc[mt][r]);
        mx = fmaxf(mx, __shfl_xor(mx, 32));
        float sum = 0.f;
#pragma unroll
        for (int mt = 0; mt < 8; ++mt)
#pragma unroll
            for (int r = 0; r < 16; ++r) { acc[mt][r] = __builtin_amdgcn_exp2f(acc[mt][r] - mx); sum += acc[mt][r]; }
        sum += __shfl_xor(sum, 32); inv = 1.f / sum;
#pragma unroll
        for (int mt = 0; mt < 8; ++mt)
#pragma unroll
            for (int s2 = 0; s2 < 2; ++s2) { u32x4 a; a.x = cvtpk(acc[mt][8 * s2], acc[mt][8 * s2 + 1]); a.y = cvtpk(acc[mt][8 * s2 + 2], acc[mt][8 * s2 + 3]); a.z = cvtpk(acc[mt][8 * s2 + 4], acc[mt][8 * s2 + 5]); a.w = cvtpk(acc[mt][8 * s2 + 6], acc[mt][8 * s2 + 7]);
                pf[mt][s2] = __builtin_bit_cast(bf16x8, a); }
    }
    __syncthreads();
    stage(lds, VcT + ((size_t)b * D + h * 256) * MEML, MEML, tid);
    __syncthreads();
    const XA_LAS unsigned char* vb = lds + c32 * RP + 8 * hh;
    bf16_t* op = XO + (size_t)tok * D + h * 256 + 4 * hh;
#pragma unroll 1
    for (int dt = 0; dt < 8; ++dt) {
        f32x16 acc = (f32x16){0.f, 0.f, 0.f, 0.f, 0.f, 0.f, 0.f, 0.f, 0.f, 0.f, 0.f, 0.f, 0.f, 0.f, 0.f, 0.f};
#pragma unroll
        for (int mt = 0; mt < 8; ++mt)
#pragma unroll
            for (int s2 = 0; s2 < 2; ++s2) {
                const s16x4 lo = *(const XA_LAS s16x4*)(vb + (32 * dt) * RP + (32 * mt + 16 * s2) * 2), hi = *(const XA_LAS s16x4*)(vb + (32 * dt) * RP + (32 * mt + 16 * s2 + 8) * 2);
                const bf16x8 vf = (bf16x8){lo[0], lo[1], lo[2], lo[3], hi[0], hi[1], hi[2], hi[3]};
                acc = __builtin_amdgcn_mfma_f32_32x32x16_bf16(vf, pf[mt][s2], acc, 0, 0, 0);
            }
#pragma unroll
        for (int q = 0; q < 4; ++q) { u32x2 o; o.x = cvtpk(acc[4 * q] * inv, acc[4 * q + 1] * inv); o.y = cvtpk(acc[4 * q + 2] * inv, acc[4 * q + 3] * inv); *(u32x2*)(op + 32 * dt + 8 * q) = o; }
    }
    __syncthreads();
}
}

namespace sp {
#define SP_LAS __attribute__((address_space(3)))
#define SP_LDSWAIT() do { asm volatile("s_waitcnt lgkmcnt(0)" ::: "memory"); } while (0)
__device__ __forceinline__ void transpose_item(const float* __restrict__ W, int ldw, int col0, int K, int nblk, bf16_t* __restrict__ WT, int row_off, SP_LAS float* scr, int item, int lane) {
    const int kb = item / nblk, nb = item % nblk, k0 = 64 * kb, n0 = 32 * nb;
#pragma unroll 8
    for (int i = 0; i < 32; ++i) { const int kk = 2 * i + (lane >> 5); scr[kk * 33 + (lane & 31)] = W[(size_t)(k0 + kk) * ldw + col0 + n0 + (lane & 31)]; }
    SP_LDSWAIT();
    const int cc = lane & 7;
#pragma unroll
    for (int j = 0; j < 4; ++j) { const int n = (lane >> 3) + 8 * j; const SP_LAS float* s = scr + (8 * cc) * 33 + n;
        u32x4 o; o.x = pk2(s[0 * 33], s[1 * 33]); o.y = pk2(s[2 * 33], s[3 * 33]); o.z = pk2(s[4 * 33], s[5 * 33]); o.w = pk2(s[6 * 33], s[7 * 33]);
        *(u32x4*)(WT + (size_t)(row_off + n0 + n) * K + k0 + 8 * cc) = o; }
    SP_LDSWAIT();
}
__device__ __forceinline__ void cvt_range(const float* __restrict__ src, bf16_t* __restrict__ dst, size_t n4, size_t gtid, size_t gthreads) {
    for (size_t i = gtid; i < n4; i += gthreads) { const f32x4 v = ((const f32x4*)src)[i]; u32x2 o; o.x = pk2(v.x, v.y); o.y = pk2(v.z, v.w); ((u32x2*)dst)[i] = o; }
}

__device__ __forceinline__ void cvt_fp8_range(const float* __restrict__ src, unsigned char* __restrict__ dst, size_t n16, float scale, size_t gtid, size_t gthreads) {
    for (size_t i = gtid; i < n16; i += gthreads) {
        const f32x4* sp4 = (const f32x4*)src + 4 * i; u32x4 o; unsigned ow[4];
#pragma unroll
        for (int q = 0; q < 4; ++q) { const f32x4 v = sp4[q];
            const float a = fminf(fmaxf(v.x * scale, -448.f), 448.f), b = fminf(fmaxf(v.y * scale, -448.f), 448.f), c2 = fminf(fmaxf(v.z * scale, -448.f), 448.f), d2 = fminf(fmaxf(v.w * scale, -448.f), 448.f);
            int p = 0; p = __builtin_amdgcn_cvt_pk_fp8_f32(a, b, p, false); p = __builtin_amdgcn_cvt_pk_fp8_f32(c2, d2, p, true); ow[q] = (unsigned)p; }
        o.x = ow[0]; o.y = ow[1]; o.z = ow[2]; o.w = ow[3];
        const size_t e_ = i >> 6, cg_ = i & 63; ((u32x4*)dst)[(cg_ >> 3) * ((size_t)PK * PK * 8) + e_ * 8 + (cg_ & 7)] = o;
    }
}
__device__ __forceinline__ void dt_stage_w(SP_LAS float* Wl, const float* __restrict__ w_in) {
    const int tid = opaque_tid();
#pragma unroll 8
    for (int i = 0; i < 64; ++i) { const int idx = tid + 512 * i; Wl[idx] = w_in[(size_t)(idx >> 5) * NIN + 5120 + (idx & 31)]; }
}
__device__ __forceinline__ void dt_item(SP_LAS float* Wl, SP_LAS float* xs, SP_LAS float* part, const float* __restrict__ x, const float* __restrict__ dt_bias, float* __restrict__ DT, bf16_t* __restrict__ XBo, int item) {
    const int tid = opaque_tid(), lane = tid & 63, w = tid >> 6, m0 = item * 4;
#pragma unroll
    for (int i = 0; i < 2; ++i) { const int q = tid + 512 * i; const f32x4 v = ((const f32x4*)(x + (size_t)m0 * D))[q]; *(SP_LAS f32x4*)(xs + 4 * q) = v;
        u32x2 o; o.x = pk2(v.x, v.y); o.y = pk2(v.z, v.w); ((u32x2*)(XBo + (size_t)m0 * D))[q] = o; }
    __syncthreads();
    const int h = lane & 31, r = w >> 1, kq = (w & 1) * 2 + (lane >> 5);
    const SP_LAS float* xp = xs + r * 1024 + kq * 256; const SP_LAS float* wp = Wl + (kq * 256) * 32 + h;
    float a0 = 0.f, a1 = 0.f;
#pragma unroll 8
    for (int k = 0; k < 256; k += 2) { a0 = fmaf(xp[k], wp[k * 32], a0); a1 = fmaf(xp[k + 1], wp[(k + 1) * 32], a1); }
    float acc = a0 + a1;
    acc += __shfl_xor(acc, 32);
    if ((w & 1) && lane < 32) part[r * 32 + h] = acc;
    __syncthreads();
    if (!(w & 1) && lane < 32) { const float v = acc + part[r * 32 + h] + dt_bias[h]; DT[(size_t)(m0 + r) * 32 + h] = v > 20.f ? v : log1pf(expf(v)); }
}
__device__ __forceinline__ void ln_row(float* __restrict__ X, const float* __restrict__ g, const float* __restrict__ b, bf16_t* __restrict__ XB, int row, int lane) {
    f32x4* xr = (f32x4*)(X + (size_t)row * D) + lane;
    f32x4 v[4]; float s = 0.f;
#pragma unroll
    for (int j = 0; j < 4; ++j) { v[j] = xr[64 * j]; s += (v[j].x + v[j].y) + (v[j].z + v[j].w); }
    const float mean = wave_sum(s) * (1.f / D); float s2 = 0.f;
#pragma unroll
    for (int j = 0; j < 4; ++j) { v[j] = v[j] - mean; s2 += (v[j].x * v[j].x + v[j].y * v[j].y) + (v[j].z * v[j].z + v[j].w * v[j].w); }
    const float rstd = rsqrtf(wave_sum(s2) * (1.f / D) + 1e-5f);
#pragma unroll
    for (int j = 0; j < 4; ++j) { const int c = 4 * lane + 256 * j; const f32x4 gg = *(const f32x4*)(g + c), bb = *(const f32x4*)(b + c);
        f32x4 o = v[j] * rstd * gg + bb; xr[64 * j] = o;
        u32x2 pb; pb.x = pk2(o.x, o.y); pb.y = pk2(o.z, o.w); *(u32x2*)(XB + (size_t)row * D + c) = pb; }
}
__device__ __forceinline__ void xattn_pair(SP_LAS float* L, const bf16_t* __restrict__ QC, const bf16_t* __restrict__ KCVC, bf16_t* __restrict__ XO, int tok0) {
    const int t512 = opaque_tid(); const int half = t512 >> 8, tid = t512 & 255, lane = tid & 63, wv = tid >> 6, tok = tok0 + half, b = tok / SEQ;
    SP_LAS float* qs = L + half * 1024; SP_LAS float* ps = L + 2048 + half * 256; SP_LAS float* red = L + 2560 + half * 8;
    for (int i = tid; i < 1024; i += 256) qs[i] = bf2f(QC[(size_t)tok * D + i]);
    __syncthreads();
    const bf16_t* KV = KCVC + (size_t)b * MEML * 2048;
    for (int h = 0; h < MH; ++h) {
        const bf16_t* kp = KV + (size_t)tid * 2048 + h * 256;
        float s = 0.f;
        for (int d = 0; d < 256; d += 8) { const u32x4 w = *(const u32x4*)(kp + d); const SP_LAS float* q = qs + h * 256 + d;
            s += q[0] * bflo(w.x) + q[1] * bfhi(w.x) + q[2] * bflo(w.y) + q[3] * bfhi(w.y) + q[4] * bflo(w.z) + q[5] * bfhi(w.z) + q[6] * bflo(w.w) + q[7] * bfhi(w.w); }
        float mx = wave_max(s); if (lane == 0) red[wv] = mx; __syncthreads();
        mx = fmaxf(fmaxf(red[0], red[1]), fmaxf(red[2], red[3]));
        const float p = exp2f(s - mx);
        float sm = wave_sum(p); if (lane == 0) red[4 + wv] = sm; ps[tid] = p; __syncthreads();
        sm = (red[4] + red[5]) + (red[6] + red[7]);
        float o = 0.f;
        for (int j = 0; j < 256; ++j) o = fmaf(ps[j], bf2f(KV[(size_t)j * 2048 + 1024 + h * 256 + tid]), o);
        XO[(size_t)tok * D + h * 256 + tid] = (bf16_t)f2bf(o / sm);
        __syncthreads();
    }
}
__device__ __forceinline__ void select_pair(SP_LAS float* L, const bf16_t* __restrict__ QP, const bf16_t* __restrict__ SUBK, int* __restrict__ IDX, float* __restrict__ GATE, int tok0) {
    const int t512 = opaque_tid(); const int hf = t512 >> 8, tid = t512 & 255, tok = tok0 + hf;
    SP_LAS float* base = L + hf * 3072;
    SP_LAS float* qs = base; SP_LAS float* s = base + 2048; SP_LAS float* tops = base + 2304; SP_LAS int* topi = (SP_LAS int*)(base + 2336); SP_LAS float* cs = base + 2368; SP_LAS int* ci = (SP_LAS int*)(base + 2624);
    SP_LAS float* bs = base + 2880; SP_LAS int* bi = (SP_LAS int*)(base + 2896);
    for (int i = tid; i < 2048; i += 256) qs[i] = bf2f(QP[(size_t)tok * 2048 + i]);
    __syncthreads();
    for (int h = 0; h < PH; ++h) {
        const int half = tid >> 7, key = tid & 127;
        { const bf16_t* kp = SUBK + ((size_t)(h * 2 + half) * 128 + key) * 128; const SP_LAS float* q = qs + h * 256 + half * 128; float a = 0.f;
          for (int d = 0; d < 128; d += 8) { const u32x4 w = *(const u32x4*)(kp + d);
              a += q[d] * bflo(w.x) + q[d + 1] * bfhi(w.x) + q[d + 2] * bflo(w.y) + q[d + 3] * bfhi(w.y) + q[d + 4] * bflo(w.z) + q[d + 5] * bfhi(w.z) + q[d + 6] * bflo(w.w) + q[d + 7] * bfhi(w.w); }
          s[tid] = a; }
        __syncthreads();
        { const float me = s[tid]; int rank = 0; const SP_LAS float* spp = s + half * 128;
          for (int j = 0; j < 128; ++j) { const float o = spp[j]; rank += (o > me || (o == me && j < key)) ? 1 : 0; }
          if (rank < 16) { tops[half * 16 + rank] = me; topi[half * 16 + rank] = key; } }
        __syncthreads();
        { const int i = tid >> 4, j = tid & 15; cs[tid] = tops[i] + tops[16 + j]; ci[tid] = topi[i] * 128 + topi[16 + j]; }
        __syncthreads();
        { const float me = cs[tid]; int rank = 0;
          for (int j = 0; j < 256; ++j) { const float o = cs[j]; rank += (o > me || (o == me && j < tid)) ? 1 : 0; }
          if (rank < 16) { bs[rank] = me; bi[rank] = ci[tid]; } }
        __syncthreads();
        if (tid < 16) { const float mx = bs[0]; float sum = 0.f;
            for (int j = 0; j < 16; ++j) sum += expf(bs[j] - mx);
            GATE[(size_t)tok * 128 + h * 16 + tid] = expf(bs[tid] - mx) / sum; IDX[(size_t)tok * 128 + h * 16 + tid] = bi[tid]; }
        __syncthreads();
    }
}
__device__ __forceinline__ void gather_token(SP_LAS float* L, float* __restrict__ X, const bf16_t* __restrict__ PU, const bf16_t* __restrict__ PV, const int* __restrict__ IDX, const float* __restrict__ GATE,
                                             const float* __restrict__ g3, const float* __restrict__ b3, int tok) {
    const int tid = opaque_tid(), lane = tid & 63, wv = tid >> 6;
    SP_LAS float* ys = L; SP_LAS float* red = L + 8192;
    float xr[16], y[16];
    { const float* xp = X + (size_t)tok * D + lane * 16;
#pragma unroll
      for (int j = 0; j < 4; ++j) { const f32x4 v = *(const f32x4*)(xp + 4 * j); xr[4 * j] = v.x; xr[4 * j + 1] = v.y; xr[4 * j + 2] = v.z; xr[4 * j + 3] = v.w; }
#pragma unroll
      for (int j = 0; j < 16; ++j) y[j] = 0.f; }
    for (int e = 0; e < 16; ++e) {
        const int slot = wv * 16 + e; const int id = IDX[(size_t)tok * 128 + slot]; const float gt = GATE[(size_t)tok * 128 + slot];
        const bf16_t* up = PU + (size_t)id * D + lane * 16; const u32x4 u0 = *(const u32x4*)up, u1 = *(const u32x4*)(up + 8);
        const unsigned uw[8] = {u0.x, u0.y, u0.z, u0.w, u1.x, u1.y, u1.z, u1.w};
        float hsum = 0.f;
#pragma unroll
        for (int j = 0; j < 8; ++j) { hsum = fmaf(xr[2 * j], bflo(uw[j]), hsum); hsum = fmaf(xr[2 * j + 1], bfhi(uw[j]), hsum); }
        hsum = wave_sum(hsum);
        const float w = gt * 0.5f * hsum * (1.f + erff(hsum * 0.70710678118654752f));
        const bf16_t* vp = PV + (size_t)id * D + lane * 16; const u32x4 v0 = *(const u32x4*)vp, v1 = *(const u32x4*)(vp + 8);
        const unsigned vw[8] = {v0.x, v0.y, v0.z, v0.w, v1.x, v1.y, v1.z, v1.w};
#pragma unroll
        for (int j = 0; j < 8; ++j) { y[2 * j] = fmaf(w, bflo(vw[j]), y[2 * j]); y[2 * j + 1] = fmaf(w, bfhi(vw[j]), y[2 * j + 1]); }
    }
#pragma unroll
    for (int j = 0; j < 16; ++j) ys[wv * 1024 + lane * 16 + j] = y[j];
    __syncthreads();
    float v[2]; float s = 0.f;
#pragma unroll
    for (int j = 0; j < 2; ++j) { const int c = tid * 2 + j; float a = 0.f;
#pragma unroll
        for (int k = 0; k < 8; ++k) a += ys[k * 1024 + c];
        v[j] = ALPHA * X[(size_t)tok * D + c] + a; s += v[j]; }
    s = wave_sum(s); if (lane == 0) red[wv] = s; __syncthreads();
    float tot = 0.f;
#pragma unroll
    for (int k = 0; k < 8; ++k) tot += red[k];
    const float mean = tot * (1.f / D);
    float s2 = 0.f;
#pragma unroll
    for (int j = 0; j < 2; ++j) { v[j] -= mean; s2 += v[j] * v[j]; }
    s2 = wave_sum(s2); if (lane == 0) red[8 + wv] = s2; __syncthreads();
    float tot2 = 0.f;
#pragma unroll
    for (int k = 0; k < 8; ++k) tot2 += red[8 + k];
    const float rstd = rsqrtf(tot2 * (1.f / D) + 1e-5f);
#pragma unroll
    for (int j = 0; j < 2; ++j) { const int c = tid * 2 + j; X[(size_t)tok * D + c] = v[j] * rstd * g3[c] + b3[c]; }
    __syncthreads();
}

constexpr float PEER_SU = 2048.f, PEER_SV = 256.f;
typedef float f32x2v __attribute__((ext_vector_type(2)));
__device__ __forceinline__ void gather_wave(float* __restrict__ Xo, const float* X, const unsigned char* __restrict__ PU, const unsigned char* __restrict__ PV, const int* __restrict__ IDX, const float* __restrict__ GATE,
                                            const float* __restrict__ g3, const float* __restrict__ b3, int tok, int lane) {
    float xr[16], y[16];
    { const f32x4* xp = (const f32x4*)(X + (size_t)tok * D + 16 * lane);
#pragma unroll
      for (int q = 0; q < 4; ++q) { const f32x4 v = xp[q]; xr[4 * q] = v.x; xr[4 * q + 1] = v.y; xr[4 * q + 2] = v.z; xr[4 * q + 3] = v.w; } }
#pragma unroll
    for (int j = 0; j < 16; ++j) y[j] = 0.f;
    const int id0 = IDX[(size_t)tok * 128 + lane], id1 = IDX[(size_t)tok * 128 + 64 + lane];
    const float gt0 = GATE[(size_t)tok * 128 + lane], gt1 = GATE[(size_t)tok * 128 + 64 + lane];
    u32x4 ub[8], vb[8];
#define GW_ISSUE(buf, TBL, i) do { const int idv_ = ((i) < 8) ? id0 : id1; _Pragma("unroll") for (int k_ = 0; k_ < 8; ++k_) { \
        const int id_ = __builtin_amdgcn_readlane(idv_, (8 * (i) + k_) & 63); buf[k_] = *(const u32x4*)((TBL) + (size_t)id_ * D + 16 * lane); } } while (0)
    GW_ISSUE(ub, PU, 0); GW_ISSUE(vb, PV, 0);
    const bool h32 = (lane & 32) != 0, h16 = (lane & 16) != 0, h8 = (lane & 8) != 0;
#pragma unroll 1
    for (int i = 0; i < 16; ++i) {
        float p[8];
#pragma unroll
        for (int k = 0; k < 8; ++k) { const unsigned w[4] = {ub[k].x, ub[k].y, ub[k].z, ub[k].w}; float a = 0.f;
#pragma unroll
            for (int q = 0; q < 4; ++q) { const f32x2v lo = __builtin_amdgcn_cvt_pk_f32_fp8((int)w[q], false), hi = __builtin_amdgcn_cvt_pk_f32_fp8((int)w[q], true);
                a = fmaf(xr[4 * q], lo.x, a); a = fmaf(xr[4 * q + 1], lo.y, a); a = fmaf(xr[4 * q + 2], hi.x, a); a = fmaf(xr[4 * q + 3], hi.y, a); }
            p[k] = a; }
        { const int in_ = (i + 1 < 16) ? i + 1 : 15; GW_ISSUE(ub, PU, in_); }
        float q4[4], q2[2], q1;
#pragma unroll
        for (int k = 0; k < 4; ++k) q4[k] = (h32 ? p[k + 4] : p[k]) + __shfl_xor(h32 ? p[k] : p[k + 4], 32);
#pragma unroll
        for (int k = 0; k < 2; ++k) q2[k] = (h16 ? q4[k + 2] : q4[k]) + __shfl_xor(h16 ? q4[k] : q4[k + 2], 16);
        q1 = (h8 ? q2[1] : q2[0]) + __shfl_xor(h8 ? q2[0] : q2[1], 8);
        q1 += __shfl_xor(q1, 4); q1 += __shfl_xor(q1, 2); q1 += __shfl_xor(q1, 1);
        q1 *= (1.f / PEER_SU);
        const float gsel = __shfl((i < 8) ? gt0 : gt1, (8 * i + (lane >> 3)) & 63);
        const float wv = gsel * 0.5f * q1 * (1.f + erff(q1 * 0.70710678118654752f));
#pragma unroll
        for (int k = 0; k < 8; ++k) { const float wk = __builtin_bit_cast(float, __builtin_amdgcn_readlane(__builtin_bit_cast(int, wv), 8 * k));
            const unsigned w[4] = {vb[k].x, vb[k].y, vb[k].z, vb[k].w};
#pragma unroll
            for (int q = 0; q < 4; ++q) { const f32x2v lo = __builtin_amdgcn_cvt_pk_f32_fp8((int)w[q], false), hi = __builtin_amdgcn_cvt_pk_f32_fp8((int)w[q], true);
                y[4 * q] = fmaf(wk, lo.x, y[4 * q]); y[4 * q + 1] = fmaf(wk, lo.y, y[4 * q + 1]); y[4 * q + 2] = fmaf(wk, hi.x, y[4 * q + 2]); y[4 * q + 3] = fmaf(wk, hi.y, y[4 * q + 3]); } }
        { const int in_ = (i + 1 < 16) ? i + 1 : 15; GW_ISSUE(vb, PV, in_); }
    }
#undef GW_ISSUE
    float s = 0.f;
#pragma unroll
    for (int j = 0; j < 16; ++j) { y[j] = ALPHA * xr[j] + y[j] * (1.f / PEER_SV); s += y[j]; }
    const float mean = wave_sum(s) * (1.f / D); float s2 = 0.f;
#pragma unroll
    for (int j = 0; j < 16; ++j) { y[j] -= mean; s2 += y[j] * y[j]; }
    const float rstd = rsqrtf(wave_sum(s2) * (1.f / D) + 1e-5f);
    float* op = Xo + (size_t)tok * D + 16 * lane;
#pragma unroll
    for (int q = 0; q < 4; ++q) { const f32x4 gg = *(const f32x4*)(g3 + 16 * lane + 4 * q), bb = *(const f32x4*)(b3 + 16 * lane + 4 * q);
        f32x4 o; o.x = y[4 * q] * rstd * gg.x + bb.x; o.y = y[4 * q + 1] * rstd * gg.y + bb.y; o.z = y[4 * q + 2] * rstd * gg.z + bb.z; o.w = y[4 * q + 3] * rstd * gg.w + bb.w;
        *(f32x4*)(op + 4 * q) = o; }
}
}


#define LAS __attribute__((address_space(3)))
#define XB_TMO      128
#define XB_XCNT(j)  (256  + 64 * (j))
#define XB_XSUB(j)  (1280 + 64 * (j))
#define XB_XGEN(j)  (2304 + 64 * (j))
#define XB_TOP      3328
#define XB_TOPGEN   3392
#define XCD_BAR_WORDS 3456
#define XB_SPIN_CAP (1u << 18)
__device__ __forceinline__ unsigned xb_ld(unsigned* p)              { return __hip_atomic_load(p, __ATOMIC_RELAXED, __HIP_MEMORY_SCOPE_AGENT); }
__device__ __forceinline__ unsigned xb_add(unsigned* p, unsigned v) { return __hip_atomic_fetch_add(p, v, __ATOMIC_RELAXED, __HIP_MEMORY_SCOPE_AGENT); }
__device__ __forceinline__ unsigned xb_xcc_id() { return (unsigned)__builtin_amdgcn_s_getreg((3 << 11) | 20) & 0xFu; }
#define XB_SPIN(cond, bar) do { unsigned _sp = 0; while (cond) { __builtin_amdgcn_s_sleep(1); \
    if ((++_sp & 255u) == 0u) { if (xb_ld(&(bar)[XB_TMO])) break; if (_sp > XB_SPIN_CAP) { atomicAdd(&(bar)[XB_TMO], 1u); break; } } } } while (0)
struct XcdBarrier { unsigned* bar; unsigned x; volatile LAS unsigned* st; };
__device__ __forceinline__ XcdBarrier xcd_barrier_post(unsigned* bar, volatile LAS unsigned* st) {
    XcdBarrier b; b.bar = bar; b.x = xb_xcc_id(); b.st = st;
    if (threadIdx.x == 0) (void)xb_add(&bar[XB_XCNT(b.x)], 1u);
    return b;
}
__device__ __forceinline__ void xcd_barrier_complete(unsigned* bar, unsigned x, unsigned& nloc, unsigned& nx) {
    const unsigned G = gridDim.x * gridDim.y * gridDim.z;
    unsigned sum, cnt, mine, sp = 0u;
    for (;;) {
        sum = 0u; cnt = 0u; mine = 0u;
#pragma unroll
        for (unsigned j = 0; j < 16; ++j) { const unsigned c = xb_ld(&bar[XB_XCNT(j)]); sum += c; cnt += (c > 0u) ? 1u : 0u; mine = (j == x) ? c : mine; }
        if (sum == G) break;
        __builtin_amdgcn_s_sleep(1);
        if ((++sp & 255u) == 0u) { if (xb_ld(&bar[XB_TMO])) break; if (sp > XB_SPIN_CAP) { atomicAdd(&bar[XB_TMO], 1u); break; } }
    }
    nloc = mine > 0u ? mine : 1u; nx = cnt > 0u ? cnt : 1u;
}
__device__ __forceinline__ void xcd_barrier(const XcdBarrier& b) {
    asm volatile("s_waitcnt vmcnt(0)" ::: "memory");
    __syncthreads();
    if (threadIdx.x == 0) {
        unsigned* bar = b.bar;
        __builtin_amdgcn_s_waitcnt(0);
        unsigned nloc = b.st[0], nx = b.st[1];
        if (nloc == 0u) { xcd_barrier_complete(bar, b.x, nloc, nx); b.st[0] = nloc; b.st[1] = nx; }
        const unsigned old = xb_add(&bar[XB_XSUB(b.x)], 1u);
        const unsigned gen = old / nloc;
        if (old + 1u == (gen + 1u) * nloc) {
            __builtin_amdgcn_fence(__ATOMIC_RELEASE, "agent");
            asm volatile("s_waitcnt vmcnt(0)" ::: "memory");
            const unsigned og = xb_add(&bar[XB_TOP], 1u);
            const unsigned tg = og / nx;
            if (og + 1u == (tg + 1u) * nx) xb_add(&bar[XB_TOPGEN], 1u);
            else XB_SPIN(xb_ld(&bar[XB_TOPGEN]) == tg, bar);
            __builtin_amdgcn_fence(__ATOMIC_ACQUIRE, "agent");
            xb_add(&bar[XB_XGEN(b.x)], 1u);
            asm volatile("s_waitcnt vmcnt(0)" ::: "memory");
        } else {
            XB_SPIN(xb_ld(&bar[XB_XGEN(b.x)]) == gen, bar);
            __builtin_amdgcn_fence(__ATOMIC_ACQUIRE, "agent");
            asm volatile("s_waitcnt vmcnt(0)" ::: "memory");
        }
    }
    __syncthreads();
}
constexpr int CW_BAR = 4096;
constexpr int MISC_OFF = 147456;


namespace peer2 {
#define P2_LAS __attribute__((address_space(3)))
typedef float f32x2v __attribute__((ext_vector_type(2)));
constexpr int CW_TICK = 8192;
__device__ __forceinline__ float dpp_add_xor1(float v) { return v + __builtin_bit_cast(float, __builtin_amdgcn_update_dpp(0, __builtin_bit_cast(int, v), 0xB1, 0xf, 0xf, true)); }
__device__ __forceinline__ float dpp_add_xor2(float v) { return v + __builtin_bit_cast(float, __builtin_amdgcn_update_dpp(0, __builtin_bit_cast(int, v), 0x4E, 0xf, 0xf, true)); }
__device__ __forceinline__ float dpp_add_hmir(float v) { return v + __builtin_bit_cast(float, __builtin_amdgcn_update_dpp(0, __builtin_bit_cast(int, v), 0x141, 0xf, 0xf, true)); }
__device__ __forceinline__ float dpp_ror8(float v) { return __builtin_bit_cast(float, __builtin_amdgcn_update_dpp(0, __builtin_bit_cast(int, v), 0x128, 0xf, 0xf, true)); }
__device__ __forceinline__ float swap32_sum(float a, float b) { auto r = __builtin_amdgcn_permlane32_swap(__builtin_bit_cast(unsigned, a), __builtin_bit_cast(unsigned, b), false, false); return __builtin_bit_cast(float, r[0]) + __builtin_bit_cast(float, r[1]); }
struct Own { int j, rank, nrank, nsl; };
__device__ __forceinline__ Own ownership(unsigned* ctl, P2_LAS unsigned* scr, int phase, int wave) {
    const int G = gridDim.x;
    if (threadIdx.x == 0) {
        unsigned* bar = ctl + CW_BAR; bool uni = (G % 8) == 0;
        for (int j = 0; j < 8; ++j) uni = uni && (xb_ld(&bar[XB_XCNT(j)]) == (unsigned)(G / 8));
        const unsigned xcc = xb_xcc_id();
        if (uni && xcc < 8u) { scr[0] = xcc; scr[1] = xb_add(&ctl[CW_TICK + 64 * (8 * phase + (int)xcc)], 1u); }
        else { scr[0] = blockIdx.x & 7; scr[1] = blockIdx.x >> 3; }
    }
    __syncthreads();
    Own o;
    if (G % 8 == 0) { o.j = (int)scr[0]; o.rank = (int)scr[1] * 8 + wave; o.nrank = G; o.nsl = 8; }
    else { o.j = 0; o.rank = blockIdx.x * 8 + wave; o.nrank = G * 8; o.nsl = 1; }
    return o;
}
__device__ __forceinline__ float dot16_fp8(const float (&x)[16], const u32x4 u) {
    const unsigned w[4] = {u.x, u.y, u.z, u.w}; f32x2v a = {0.f, 0.f};
#pragma unroll
    for (int q = 0; q < 4; ++q) { const f32x2v lo = __builtin_amdgcn_cvt_pk_f32_fp8((int)w[q], false), hi = __builtin_amdgcn_cvt_pk_f32_fp8((int)w[q], true);
        a = __builtin_elementwise_fma((f32x2v){x[4 * q], x[4 * q + 1]}, lo, a); a = __builtin_elementwise_fma((f32x2v){x[4 * q + 2], x[4 * q + 3]}, hi, a); }
    return a.x + a.y;
}
__device__ __forceinline__ void u_wave(const float* __restrict__ X, const unsigned char* __restrict__ PU, const int* __restrict__ IDX, float* __restrict__ PART, int j, int rank, int nrank, int lane) {
    const int sub = lane & 7, grp = lane >> 3, col0 = 128 * j + 16 * sub;
    float* part = PART + (size_t)j * M * 128 + 16 * grp;
#define PU_LOADIDX(idv, xv, t_) do { const int tt_ = ((t_) < M) ? (t_) : (M - 1); const u32x4* ip_ = (const u32x4*)(IDX + (size_t)tt_ * 128 + 16 * grp); \
        _Pragma("unroll") for (int q_ = 0; q_ < 4; ++q_) { const u32x4 v_ = ip_[q_]; idv[4 * q_] = (int)v_.x; idv[4 * q_ + 1] = (int)v_.y; idv[4 * q_ + 2] = (int)v_.z; idv[4 * q_ + 3] = (int)v_.w; } \
        const f32x4* xp_ = (const f32x4*)(X + (size_t)tt_ * D + col0); \
        _Pragma("unroll") for (int q_ = 0; q_ < 4; ++q_) { const f32x4 v_ = xp_[q_]; xv[4 * q_] = v_.x; xv[4 * q_ + 1] = v_.y; xv[4 * q_ + 2] = v_.z; xv[4 * q_ + 3] = v_.w; } } while (0)
#define PU_GATHER(ubv, idv) do { _Pragma("unroll") for (int it_ = 0; it_ < 16; ++it_) ubv[it_] = *(const u32x4*)(PU + (size_t)j * (PK * PK * 128) + (size_t)idv[it_] * 128 + 16 * sub); } while (0)
#define PU_COMPUTE(ubv, xv, t_) do { float k0_ = 0.f, k1_ = 0.f; _Pragma("unroll") for (int it_ = 0; it_ < 16; ++it_) { float a_ = dot16_fp8(xv, ubv[it_]); a_ = dpp_add_xor1(a_); a_ = dpp_add_xor2(a_); a_ = dpp_add_hmir(a_); \
            if (it_ < 8) k0_ = ((it_ & 7) == sub) ? a_ : k0_; else k1_ = ((it_ & 7) == sub) ? a_ : k1_; } \
        if ((t_) < M) { part[(size_t)(t_) * 128 + sub] = k0_; part[(size_t)(t_) * 128 + sub + 8] = k1_; } } while (0)
    int idA[16], idB[16]; float xA[16], xB[16], xc[16]; u32x4 ubA[16], ubB[16];
    int t = rank;
    PU_LOADIDX(idA, xA, t); PU_GATHER(ubA, idA);
    PU_LOADIDX(idB, xB, t + nrank);
    for (; t < M; t += 2 * nrank) {
        PU_GATHER(ubB, idB);
#pragma unroll
        for (int q = 0; q < 16; ++q) xc[q] = xA[q];
        PU_LOADIDX(idA, xA, t + 2 * nrank);
        PU_COMPUTE(ubA, xc, t);
        PU_GATHER(ubA, idA);
#pragma unroll
        for (int q = 0; q < 16; ++q) xc[q] = xB[q];
        PU_LOADIDX(idB, xB, t + 3 * nrank);
        PU_COMPUTE(ubB, xc, t + nrank);
    }
#undef PU_LOADIDX
#undef PU_GATHER
#undef PU_COMPUTE
}
__device__ __forceinline__ void v_wave(float* __restrict__ X, const unsigned char* __restrict__ PV, const int* __restrict__ IDX, const float* __restrict__ GATE, const float* __restrict__ PART, P2_LAS float* wbuf, int j, int rank, int nrank, int lane) {
    const int sub = lane & 7, grp = lane >> 3, col0 = 128 * j + 16 * sub;
    const bool h32 = (lane & 32) != 0, h16 = (lane & 16) != 0, h8 = (lane & 8) != 0; const int cq = ((lane >> 5) & 1) * 8 + ((lane >> 4) & 1) * 4 + ((lane >> 3) & 1) * 2;
#define PV_ISSUE(vbv, hv, gv, t_) do { const int tt_ = ((t_) < M) ? (t_) : (M - 1); int id_[16]; const u32x4* ip_ = (const u32x4*)(IDX + (size_t)tt_ * 128 + 16 * grp); \
        _Pragma("unroll") for (int q_ = 0; q_ < 4; ++q_) { const u32x4 v_ = ip_[q_]; id_[4 * q_] = (int)v_.x; id_[4 * q_ + 1] = (int)v_.y; id_[4 * q_ + 2] = (int)v_.z; id_[4 * q_ + 3] = (int)v_.w; } \
        _Pragma("unroll") for (int it_ = 0; it_ < 16; ++it_) vbv[it_] = *(const u32x4*)(PV + (size_t)j * (PK * PK * 128) + (size_t)id_[it_] * 128 + 16 * sub); \
        _Pragma("unroll") for (int jj_ = 0; jj_ < 8; ++jj_) { const float* pp_ = PART + ((size_t)jj_ * M + tt_) * 128; hv[2 * jj_] = pp_[lane]; hv[2 * jj_ + 1] = pp_[64 + lane]; } \
        gv[0] = GATE[(size_t)tt_ * 128 + lane]; gv[1] = GATE[(size_t)tt_ * 128 + 64 + lane]; } while (0)
#define PV_COMPUTE(vbv, hv, gv, t_) do { float h0_ = 0.f, h1_ = 0.f; _Pragma("unroll") for (int jj_ = 0; jj_ < 8; ++jj_) { h0_ += hv[2 * jj_]; h1_ += hv[2 * jj_ + 1]; } \
        h0_ *= (1.f / sp::PEER_SU); h1_ *= (1.f / sp::PEER_SU); \
        const float w0_ = gv[0] * 0.5f * h0_ * (1.f + erff(h0_ * 0.70710678118654752f)), w1_ = gv[1] * 0.5f * h1_ * (1.f + erff(h1_ * 0.70710678118654752f)); \
        f32x2v y_[8]; _Pragma("unroll") for (int q_ = 0; q_ < 8; ++q_) y_[q_] = (f32x2v){0.f, 0.f}; \
        wbuf[lane] = w0_; wbuf[64 + lane] = w1_; asm volatile("s_waitcnt lgkmcnt(0)" ::: "memory");        \
        float wl_[16]; _Pragma("unroll") for (int q_ = 0; q_ < 4; ++q_) { const f32x4 v_ = *(const P2_LAS f32x4*)(wbuf + 16 * grp + 4 * q_); wl_[4 * q_] = v_.x; wl_[4 * q_ + 1] = v_.y; wl_[4 * q_ + 2] = v_.z; wl_[4 * q_ + 3] = v_.w; } \
        asm volatile("s_waitcnt lgkmcnt(0)" ::: "memory"); \
        _Pragma("unroll") for (int it_ = 0; it_ < 16; ++it_) { const float wq_ = wl_[it_]; \
            const unsigned ww_[4] = {vbv[it_].x, vbv[it_].y, vbv[it_].z, vbv[it_].w}; const f32x2v wv_ = {wq_, wq_}; \
            _Pragma("unroll") for (int q_ = 0; q_ < 4; ++q_) { y_[2 * q_] = __builtin_elementwise_fma(wv_, __builtin_amdgcn_cvt_pk_f32_fp8((int)ww_[q_], false), y_[2 * q_]); y_[2 * q_ + 1] = __builtin_elementwise_fma(wv_, __builtin_amdgcn_cvt_pk_f32_fp8((int)ww_[q_], true), y_[2 * q_ + 1]); } } \
        float yy_[16]; _Pragma("unroll") for (int k_ = 0; k_ < 8; ++k_) { yy_[2 * k_] = y_[k_].x; yy_[2 * k_ + 1] = y_[k_].y; } \
          \
        float y8_[8], y4_[4], y2_[2]; \
        _Pragma("unroll") for (int k_ = 0; k_ < 8; ++k_) y8_[k_] = (h32 ? yy_[k_ + 8] : yy_[k_]) + __shfl_xor(h32 ? yy_[k_] : yy_[k_ + 8], 32); \
        _Pragma("unroll") for (int k_ = 0; k_ < 4; ++k_) y4_[k_] = (h16 ? y8_[k_ + 4] : y8_[k_]) + __shfl_xor(h16 ? y8_[k_] : y8_[k_ + 4], 16); \
        _Pragma("unroll") for (int k_ = 0; k_ < 2; ++k_) y2_[k_] = (h8 ? y4_[k_ + 2] : y4_[k_]) + dpp_ror8(h8 ? y4_[k_] : y4_[k_ + 2]); \
        if ((t_) < M) { f32x2v* xp_ = (f32x2v*)(X + (size_t)(t_) * D + col0 + cq); f32x2v xv_ = *xp_; \
            xv_.x = ALPHA * xv_.x + y2_[0] * (1.f / sp::PEER_SV); xv_.y = ALPHA * xv_.y + y2_[1] * (1.f / sp::PEER_SV); *xp_ = xv_; } } while (0)
    u32x4 vbA[16], vbB[16]; float hA[16], hB[16], gA[2], gB[2];
    int t = rank;
    PV_ISSUE(vbA, hA, gA, t);
    for (; t < M; t += 2 * nrank) {
        PV_ISSUE(vbB, hB, gB, t + nrank);
        PV_COMPUTE(vbA, hA, gA, t);
        PV_ISSUE(vbA, hA, gA, t + 2 * nrank);
        PV_COMPUTE(vbB, hB, gB, t + nrank);
    }
#undef PV_ISSUE
#undef PV_COMPUTE
}
__device__ __forceinline__ void ln_row_plain(float* __restrict__ X, const float* __restrict__ g, const float* __restrict__ b, int row, int lane) {
    f32x4* xr = (f32x4*)(X + (size_t)row * D) + lane;
    f32x4 v[4]; float s = 0.f;
#pragma unroll
    for (int jq = 0; jq < 4; ++jq) { v[jq] = xr[64 * jq]; s += (v[jq].x + v[jq].y) + (v[jq].z + v[jq].w); }
    const float mean = wave_sum(s) * (1.f / D); float s2 = 0.f;
#pragma unroll
    for (int jq = 0; jq < 4; ++jq) { v[jq] = v[jq] - mean; s2 += (v[jq].x * v[jq].x + v[jq].y * v[jq].y) + (v[jq].z * v[jq].z + v[jq].w * v[jq].w); }
    const float rstd = rsqrtf(wave_sum(s2) * (1.f / D) + 1e-5f);
#pragma unroll
    for (int jq = 0; jq < 4; ++jq) { const int c = 4 * lane + 256 * jq; const f32x4 gg = *(const f32x4*)(g + c), bb = *(const f32x4*)(b + c); xr[64 * jq] = v[jq] * rstd * gg + bb; }
}
}

struct Params { const float* in[30]; float* out; unsigned char* ws; };
template <class F> __device__ __forceinline__ void run_gemm(unsigned char* lds, const bf16_t* A, int lda, const bf16_t* Bt, int Mr, int N, int K, F f, int cshift = 0) {
    pg8::Gemm g{A, Bt, Mr, N, K, lda}; pg8::StaticOrder S; S.init(Mr, N, gridDim.x, (int)((blockIdx.x + gridDim.x - (unsigned)cshift) % gridDim.x)); pg8::EpiAdapt<F> E{f};
    pg8::gemm_phase<pg8::EpiAdapt<F>, pg8::StaticOrder, true>((PG8_LAS unsigned char*)lds, g, S, E);
}
#ifndef PROBE_ATTN
#define PROBE_ATTN 0
#endif
#ifndef PROBE_SSD
#define PROBE_SSD 0
#endif
#ifndef PROBE_SYNC
#define PROBE_SYNC 0
#endif
#define KA_LAS __attribute__((address_space(4)))
#define PH_BEGIN const KA_LAS unsigned char* ka_ = (const KA_LAS unsigned char*)__builtin_amdgcn_kernarg_segment_ptr(); asm volatile("" : "+s"(ka_))
#define PIN(k) (*(const float* const KA_LAS*)(ka_ + 8 * (k)))
#define POUT (*(float* const KA_LAS*)(ka_ + 240))
#define PWS (*(unsigned char* const KA_LAS*)(ka_ + 248))
__global__ void __launch_bounds__(512, 2) hybrid_fwd(Params P) {
    extern __shared__ __attribute__((aligned(16))) unsigned char lds[];
    cg::grid_group grid = cg::this_grid();
    { PH_BEGIN; volatile LAS unsigned* misc = (volatile LAS unsigned*)((LAS unsigned char*)lds + MISC_OFF);
      if (threadIdx.x < 16) misc[threadIdx.x] = 0u;
      __syncthreads();
      (void)xcd_barrier_post((unsigned*)(PWS + WS_CTL) + CW_BAR, misc);
      if (PWS == nullptr) grid.sync(); }
#define GSYNC() do { PH_BEGIN; XcdBarrier xb_; xb_.bar = (unsigned*)(PWS + WS_CTL) + CW_BAR; xb_.x = xb_xcc_id(); xb_.st = (volatile LAS unsigned*)((LAS unsigned char*)lds + MISC_OFF); xcd_barrier(xb_); } while (0)
    {
        PH_BEGIN; unsigned char* ws = PWS;
        const int tid = opaque_tid(), lane = tid & 63, wave = __builtin_amdgcn_readfirstlane(tid >> 6), c = blockIdx.x, G = gridDim.x;
        const size_t gtid = (size_t)c * 512 + tid, gthreads = (size_t)G * 512; const int gw = c * 8 + wave, NGW = G * 8;
        const float* w_in = PIN(2);
        bf16_t* WinT = (bf16_t*)(ws + WS_WIN); bf16_t* WckvT = (bf16_t*)(ws + WS_WCKV);
        SP_LAS float* scr = (SP_LAS float*)lds + wave * (64 * 33);
        constexpr int I0 = 2560, I1 = 5120, I2 = 6144, I3 = 6656, I4 = 7168, I5 = 7680, I6 = 8192, I7 = 8704, I8 = 9216, I9 = 10240;
        for (int it = gw; it < I9; it += NGW) {
            if (it < I0) sp::transpose_item(w_in, NIN, 0, D, 160, WinT, 0, scr, it, lane);
            else if (it < I1) sp::transpose_item(w_in, NIN, 5152, D, 160, WinT, 5120, scr, it - I0, lane);
            else if (it < I2) sp::transpose_item(PIN(9), D, 0, DI, 32, (bf16_t*)(ws + WS_WSSD), 0, scr, it - I1, lane);
            else if (it < I3) sp::transpose_item(PIN(13), D, 0, D, 32, (bf16_t*)(ws + WS_WDIFF), 0, scr, it - I2, lane);
            else if (it < I4) sp::transpose_item(PIN(15), D, 0, D, 32, (bf16_t*)(ws + WS_WO), 0, scr, it - I3, lane);
            else if (it < I5) sp::transpose_item(PIN(18), D, 0, D, 32, (bf16_t*)(ws + WS_WCQ), 0, scr, it - I4, lane);
            else if (it < I6) sp::transpose_item(PIN(19), D, 0, D, 32, WckvT, 0, scr, it - I5, lane);
            else if (it < I7) sp::transpose_item(PIN(20), D, 0, D, 32, WckvT, 1024, scr, it - I6, lane);
            else if (it < I8) sp::transpose_item(PIN(21), D, 0, D, 32, (bf16_t*)(ws + WS_WCO), 0, scr, it - I7, lane);
            else sp::transpose_item(PIN(24), 2048, 0, D, 64, (bf16_t*)(ws + WS_WPQ), 0, scr, it - I8, lane);
        }
        const float* x = PIN(0);
        sp::cvt_range(PIN(1), (bf16_t*)(ws + WS_MEMB), (size_t)BATCH * MEML * D / 4, gtid, gthreads);
        sp::cvt_range(PIN(25), (bf16_t*)(ws + WS_SUBK), (size_t)PH * 2 * PK * PHALF / 4, gtid, gthreads);
        __syncthreads();
        sp::dt_stage_w((SP_LAS float*)lds, w_in);
        for (int it = c; it < M / 4; it += G) sp::dt_item((SP_LAS float*)lds, (SP_LAS float*)lds + 32768, (SP_LAS float*)lds + 36896  , x, PIN(5), (float*)(ws + WS_DT), (bf16_t*)(ws + WS_XB), it);
        __syncthreads();
        if (c == 0 && tid == 0) { const float* lam_q = PIN(10); const float* lam_k = PIN(11); float s0 = 0.f, s1 = 0.f;
            for (int i = 0; i < 64; ++i) { s0 += lam_q[i] * lam_k[i]; s1 += lam_q[64 + i] * lam_k[64 + i]; }
            ((float*)(ws + WS_CTL))[CW_LAM] = expf(s0) - expf(s1) + LAMBDA_INIT; }
    }
    GSYNC();
    { PH_BEGIN; unsigned char* ws = PWS;
      run_gemm(lds, (const bf16_t*)(ws + WS_XB), D, (const bf16_t*)(ws + WS_WIN), SEQ, NINP, D, EpiInProj{(bf16_t*)(ws + WS_H), PIN(14)}); }
    GSYNC();
#pragma unroll 1
    for (int b = 0; b < BATCH; ++b) {
        { PH_BEGIN; unsigned char* ws = PWS; const int c = blockIdx.x, G = gridDim.x;
          bf16_t* H = (bf16_t*)(ws + WS_H); const float* DTb = (const float*)(ws + WS_DT) + (size_t)b * SEQ * 32;
          for (int u = c; u < 256; u += G) ssd::phaseA_unit((SS_LAS unsigned char*)lds, H, DTb, PIN(3), PIN(4), PIN(6), (bf16_t*)(ws + WS_T1), (float*)(ws + WS_CTL) + 1024, u >> 2, u & 3);
          const float lam = ((const float*)(ws + WS_CTL))[CW_LAM]; const float* subln_w = PIN(12);
#if PROBE_ATTN
          for (int u = c; u < 256; u += G) { const int h = u >> 5, j = u & 31;
              dattn::unit<false>((DA_LAS unsigned char*)lds, H, h, 63 - j, subln_w, lam);
              dattn::unit<false>((DA_LAS unsigned char*)lds, H, h, j, subln_w, lam); }
#endif
          for (int u = c; u < 256; u += G) { const int h = u >> 5, j = u & 31;
              dattn::unit((DA_LAS unsigned char*)lds, H, h, 63 - j, subln_w, lam);
              dattn::unit((DA_LAS unsigned char*)lds, H, h, j, subln_w, lam); } }
        GSYNC();
        { PH_BEGIN; unsigned char* ws = PWS; const int tid = opaque_tid();
          for (size_t i = (size_t)blockIdx.x * 512 + tid; i < 131072; i += (size_t)gridDim.x * 512) ssd::scan_phase((bf16_t*)(ws + WS_T1), (const float*)(ws + WS_CTL) + 1024, (int)i); }
        GSYNC();
        { PH_BEGIN; unsigned char* ws = PWS; const int c = blockIdx.x, G = gridDim.x;
#if PROBE_SSD
          for (int u = c; u < 256; u += G) ssd::phaseA_unit((SS_LAS unsigned char*)lds, (bf16_t*)(ws + WS_H), (const float*)(ws + WS_DT) + (size_t)b * SEQ * 32, PIN(3), PIN(4), PIN(6), (bf16_t*)(POUT + (size_t)SEQ * D), (float*)(ws + WS_CTL) + 8192, u >> 2, u & 3);
          for (int u = c; u < 256; u += G) ssd::phaseC_unit<false>((SS_LAS unsigned char*)lds, (bf16_t*)(ws + WS_H), (const float*)(ws + WS_DT) + (size_t)b * SEQ * 32, PIN(3), PIN(4), PIN(6), PIN(7), PIN(8), (const bf16_t*)(ws + WS_T1), u >> 2, u & 3);
#endif
          for (int u = c; u < 256; u += G) ssd::phaseC_unit((SS_LAS unsigned char*)lds, (bf16_t*)(ws + WS_H), (const float*)(ws + WS_DT) + (size_t)b * SEQ * 32, PIN(3), PIN(4), PIN(6), PIN(7), PIN(8), (const bf16_t*)(ws + WS_T1), u >> 2, u & 3); }
        GSYNC();
        { PH_BEGIN; unsigned char* ws = PWS; bf16_t* H = (bf16_t*)(ws + WS_H); float* T1 = (float*)(ws + WS_T1);
          run_gemm(lds, H + HC_Z, HP_, (const bf16_t*)(ws + WS_WSSD), SEQ, D, DI, EpiGate1{H, T1});
          run_gemm(lds, H + HC_Q, HP_, (const bf16_t*)(ws + WS_WDIFF), SEQ, D, D, EpiGate2{H, T1});
          if (b == 0) {
              const int hs = (int)gridDim.x / 2;
              run_gemm(lds, (const bf16_t*)(ws + WS_MEMB), D, (const bf16_t*)(ws + WS_WCKV), BATCH * MEML, D, D, EpiPlain{(bf16_t*)(ws + WS_KCVC), D, 1.f}, hs);
              for (int bb = 0; bb < BATCH; ++bb)
                  run_gemm(lds, (const bf16_t*)(ws + WS_WCKV) + (size_t)D * D, D, (const bf16_t*)(ws + WS_MEMB) + (size_t)bb * MEML * D, D, MEML, D, EpiPlain{(bf16_t*)(ws + WS_KCVC) + (size_t)BATCH * MEML * D + (size_t)bb * D * MEML, MEML, 1.f}, hs + 8 + 4 * bb);
          }
          if (b == BATCH - 1 && 2 * (int)blockIdx.x >= (int)gridDim.x) { const int tid = opaque_tid(); const int half = (gridDim.x + 1) / 2;
              const size_t gt = (size_t)(blockIdx.x - half) * 512 + tid, gn = (size_t)(gridDim.x - half) * 512;
              sp::cvt_fp8_range(PIN(26), ws + WS_PU, (size_t)PK * PK * D / 16, sp::PEER_SU, gt, gn);
              sp::cvt_fp8_range(PIN(27), ws + WS_PV, (size_t)PK * PK * D / 16, sp::PEER_SV, gt, gn); } }
        GSYNC();
        { PH_BEGIN; unsigned char* ws = PWS;
          run_gemm(lds, (const bf16_t*)(ws + WS_H) + HC_K, HP_, (const bf16_t*)(ws + WS_WO), SEQ, D, D, EpiResid{PIN(0), POUT, b * SEQ, 0}); }
        GSYNC();
        if (b + 1 < BATCH) {
            { PH_BEGIN; unsigned char* ws = PWS;
              run_gemm(lds, (const bf16_t*)(ws + WS_XB) + (size_t)(b + 1) * SEQ * D, D, (const bf16_t*)(ws + WS_WIN), SEQ, NINP, D, EpiInProj{(bf16_t*)(ws + WS_H), PIN(14)}); }
            GSYNC();
        }
    }
    { PH_BEGIN; unsigned char* ws = PWS; const int tid = opaque_tid(), lane = tid & 63, wave = __builtin_amdgcn_readfirstlane(tid >> 6), c = blockIdx.x, G = gridDim.x;
      float* out = POUT; const float* g = PIN(16); const float* bb = PIN(17); bf16_t* XB = (bf16_t*)(ws + WS_X1B);
      for (int r = c * 8 + wave; r < M; r += G * 8) sp::ln_row(out, g, bb, XB, r, lane); }
    GSYNC();
    { PH_BEGIN; unsigned char* ws = PWS;
      run_gemm(lds, (const bf16_t*)(ws + WS_X1B), D, (const bf16_t*)(ws + WS_WCQ), M, D, D, EpiPlain{(bf16_t*)(ws + WS_QC), D, CQSCALE}); }
    GSYNC();
    { PH_BEGIN; unsigned char* ws = PWS; const int c = blockIdx.x, G = gridDim.x;
      for (int u = c; u < 256; u += G) xattn::unit((XA_LAS unsigned char*)lds, (const bf16_t*)(ws + WS_QC), (const bf16_t*)(ws + WS_KCVC), (const bf16_t*)(ws + WS_KCVC) + (size_t)BATCH * MEML * D, (bf16_t*)(ws + WS_XO), u >> 2, u & 3); }
    GSYNC();
    { PH_BEGIN; unsigned char* ws = PWS; float* out = POUT;
      run_gemm(lds, (const bf16_t*)(ws + WS_XO), D, (const bf16_t*)(ws + WS_WCO), M, D, D, EpiResid{out, out, 0, 0}); }
    GSYNC();
    { PH_BEGIN; unsigned char* ws = PWS; const int tid = opaque_tid(), lane = tid & 63, wave = __builtin_amdgcn_readfirstlane(tid >> 6), c = blockIdx.x, G = gridDim.x;
      float* out = POUT; const float* g = PIN(22); const float* bb = PIN(23); bf16_t* XB = (bf16_t*)(ws + WS_X1B);
      for (int r = c * 8 + wave; r < M; r += G * 8) sp::ln_row(out, g, bb, XB, r, lane); }
    GSYNC();
    { PH_BEGIN; unsigned char* ws = PWS;
      run_gemm(lds, (const bf16_t*)(ws + WS_X1B), D, (const bf16_t*)(ws + WS_WPQ), M, 2048, D, EpiPlain{(bf16_t*)(ws + WS_QP), 2048, 1.f}); }
    GSYNC();
    { PH_BEGIN; unsigned char* ws = PWS; const int c = blockIdx.x, G = gridDim.x;
      for (int t = 64 * c; t < M; t += 64 * G) {
          for (int hp = 0; hp < 4; ++hp) psel::stage1((PS_LAS int*)lds, (const bf16_t*)(ws + WS_QP), (const bf16_t*)(ws + WS_SUBK), t, hp);
          __syncthreads();
          psel::stage2((PS_LAS int*)lds, (int*)(ws + WS_IDX), (float*)(ws + WS_GATE), t);
          __syncthreads(); } }
    GSYNC();
    { PH_BEGIN; unsigned char* ws = PWS; const int tid = opaque_tid(), lane = tid & 63, wave = __builtin_amdgcn_readfirstlane(tid >> 6);
      const peer2::Own o = peer2::ownership((unsigned*)(ws + WS_CTL), (P2_LAS unsigned*)lds, 0, wave);
      for (int jj = o.j; jj < 8; jj += o.nsl) peer2::u_wave(POUT, ws + WS_PU, (const int*)(ws + WS_IDX), (float*)(ws + WS_PART), jj, o.rank, o.nrank, lane); }
    GSYNC();
    { PH_BEGIN; unsigned char* ws = PWS; const int tid = opaque_tid(), lane = tid & 63, wave = __builtin_amdgcn_readfirstlane(tid >> 6);
      const peer2::Own o = peer2::ownership((unsigned*)(ws + WS_CTL), (P2_LAS unsigned*)lds, 1, wave);
      for (int jj = o.j; jj < 8; jj += o.nsl) peer2::v_wave(POUT, ws + WS_PV, (const int*)(ws + WS_IDX), (const float*)(ws + WS_GATE), (const float*)(ws + WS_PART), (P2_LAS float*)lds + 64 + wave * 128, jj, o.rank, o.nrank, lane); }
    GSYNC();
    { PH_BEGIN; const int tid = opaque_tid(), lane = tid & 63, wave = __builtin_amdgcn_readfirstlane(tid >> 6);
      float* out = POUT; const float* g3 = PIN(28); const float* b3 = PIN(29);
      for (int r = blockIdx.x * 8 + wave; r < M; r += gridDim.x * 8) peer2::ln_row_plain(out, g3, b3, r, lane); }
}

extern "C" void kernel_launch(void* const* d_in, const int* in_sizes, int n_in, void* d_out, int out_size, void* d_ws, size_t ws_size, hipStream_t stream) {
    static int grid_blocks = 0;
    if (grid_blocks == 0) {
        if (n_in != 30 || out_size != M * D || ws_size < WS_END) { fprintf(stderr, "kernel_launch: unexpected sizes n_in %d out %d ws %zu (need %zu)\n", n_in, out_size, ws_size, (size_t)WS_END); grid_blocks = -1; return; }
        int dev = 0, cus = 0, per_cu = 0;
        (void)hipGetDevice(&dev); (void)hipDeviceGetAttribute(&cus, hipDeviceAttributeMultiprocessorCount, dev);
        (void)hipFuncSetAttribute((const void*)hybrid_fwd, hipFuncAttributeMaxDynamicSharedMemorySize, LDS_BYTES);
        if (hipOccupancyMaxActiveBlocksPerMultiprocessor(&per_cu, (const void*)hybrid_fwd, 512, LDS_BYTES) != hipSuccess || per_cu < 1) { fprintf(stderr, "kernel_launch: occupancy query failed (%d)\n", per_cu); per_cu = 1; }
        (void)hipGetLastError();
        grid_blocks = cus * 1;
    }
    if (grid_blocks < 0) return;
    if (hipMemsetAsync(d_ws, 0, 65536, stream) != hipSuccess) { fprintf(stderr, "kernel_launch: memset of control words failed\n"); return; }
    Params p{};
    for (int i = 0; i < 30; ++i) p.in[i] = (const float*)d_in[i];
    p.out = (float*)d_out; p.ws = (unsigned char*)d_ws;
    void* args[] = {&p};
    hipError_t e = hipLaunchCooperativeKernel((const void*)hybrid_fwd, dim3(grid_blocks), dim3(512), args, LDS_BYTES, stream);
    if (e != hipSuccess) fprintf(stderr, "cooperative launch failed: %s (grid %d)\n", hipGetErrorString(e), grid_blocks);
}
```

```cpp
#include <hip/hip_runtime.h>
#include <hip/hip_cooperative_groups.h>
namespace cg = cooperative_groups;
#include <cstdio>
#include <cstdint>
#include <cmath>
#include <type_traits>

typedef unsigned short bf16_t;
typedef float f32x4 __attribute__((ext_vector_type(4)));
typedef unsigned u32x4 __attribute__((ext_vector_type(4)));
typedef unsigned u32x2 __attribute__((ext_vector_type(2)));

constexpr int D = 1024, BATCH = 2, SEQ = 8192, M = BATCH * SEQ;
constexpr int DI = 2048, NH = 32, HP = 64, NG = 4, DS = 128, DXBC = 3072;
constexpr int AH = 8, AD = 64, AV = 128;
constexpr int MEML = 256, MH = 4, MHD = 256;
constexpr int PH = 8, PK = 128, PDK = 256, PHALF = 128, PTOP = 16;
constexpr int NIN = 10272, NINP = 10240;
constexpr float ALPHA = 1.189207115002721f;
constexpr float LOG2E = 1.4426950408889634f;
constexpr float QSCALE = 0.125f * LOG2E;
constexpr float CQSCALE = 0.0625f * LOG2E;
constexpr float LAMBDA_INIT = 0.2f;
constexpr int HC_Z = 0, HC_XBC = 2048, HC_Q = 5120, HC_K = 6144, HC_V = 7168, HC_GS = 8192, HC_GA = 9216, HP_ = NINP;

constexpr size_t MiB = 1u << 20;
constexpr size_t WS_CTL = 0;
constexpr size_t WS_WIN = 1 * MiB;
constexpr size_t WS_WSSD = 21 * MiB;
constexpr size_t WS_WDIFF = 25 * MiB, WS_WO = 27 * MiB, WS_WCQ = 29 * MiB, WS_WCKV = 31 * MiB  , WS_WCO = 35 * MiB;
constexpr size_t WS_WPQ = 37 * MiB;
constexpr size_t WS_SUBK = 41 * MiB;
constexpr size_t WS_MEMB = 42 * MiB;
constexpr size_t WS_KCVC = 43 * MiB;
constexpr size_t WS_DT = 45 * MiB;
constexpr size_t WS_XB = 47 * MiB;
constexpr size_t WS_H = 79 * MiB;
constexpr size_t WS_T1 = 239 * MiB;
constexpr size_t WS_PU = 47 * MiB, WS_PV = 63 * MiB;
constexpr size_t WS_X1B = 79 * MiB;
constexpr size_t WS_QC = 143 * MiB, WS_XO = 175 * MiB;
constexpr size_t WS_QP = 207 * MiB;
constexpr size_t WS_IDX = 143 * MiB, WS_GATE = 151 * MiB;
constexpr size_t WS_PART = 207 * MiB;
constexpr size_t WS_END = 271 * MiB;
constexpr int CW_LAM = 64;

__device__ __forceinline__ int opaque_tid() { int t = threadIdx.x; asm volatile("" : "+v"(t)); return t; }
__device__ __forceinline__ unsigned f2bf(float f) { unsigned u = __builtin_bit_cast(unsigned, f); return (u + 0x7fffu + ((u >> 16) & 1u)) >> 16; }
__device__ __forceinline__ float bf2f(unsigned h) { return __builtin_bit_cast(float, h << 16); }
__device__ __forceinline__ unsigned pk2(float lo, float hi) { return f2bf(lo) | (f2bf(hi) << 16); }
__device__ __forceinline__ float bflo(unsigned w) { return __builtin_bit_cast(float, w << 16); }
__device__ __forceinline__ float bfhi(unsigned w) { return __builtin_bit_cast(float, w & 0xffff0000u); }
__device__ __forceinline__ float sigmoidf_(float v) { return __builtin_amdgcn_rcpf(1.f + __expf(-v)); }
__device__ __forceinline__ float siluf_(float v) { return v * __builtin_amdgcn_rcpf(1.f + __expf(-v)); }
__device__ __forceinline__ float wave_sum(float v) {
#pragma unroll
    for (int o = 1; o < 64; o <<= 1) v += __shfl_xor(v, o);
    return v;
}
__device__ __forceinline__ float wave_max(float v) {
#pragma unroll
    for (int o = 1; o < 64; o <<= 1) v = fmaxf(v, __shfl_xor(v, o));
    return v;
}

__device__ __forceinline__ void store_bf16x8(bf16_t* p, const float (&v)[8]) { u32x4 w; w.x = pk2(v[0], v[1]); w.y = pk2(v[2], v[3]); w.z = pk2(v[4], v[5]); w.w = pk2(v[6], v[7]); *(u32x4*)p = w; }
struct EpiPlain { bf16_t* O; int ldc; float scale;
    __device__ __forceinline__ void operator()(int row, int col0, const float (&v)[8]) const { float o[8];
#pragma unroll
        for (int j = 0; j < 8; ++j) o[j] = v[j] * scale; store_bf16x8(O + (size_t)row * ldc + col0, o); } };
struct EpiInProj { bf16_t* H; const float* gate_bias;
    __device__ __forceinline__ void operator()(int row, int col0, const float (&v)[8]) const { float o[8];
        if (col0 >= HC_GS) { const float* gb = gate_bias + (col0 - HC_GS);
#pragma unroll
            for (int j = 0; j < 8; ++j) o[j] = sigmoidf_(v[j] + gb[j]); }
        else { const float s = (col0 >= HC_Q && col0 < HC_K) ? QSCALE : 1.f;
#pragma unroll
            for (int j = 0; j < 8; ++j) o[j] = v[j] * s; }
        store_bf16x8(H + (size_t)row * HP_ + col0, o); } };
struct EpiGate1 { const bf16_t* H; float* T1;
    __device__ __forceinline__ void operator()(int row, int col0, const float (&v)[8]) const {
        const u32x4 g = *(const u32x4*)(H + (size_t)row * HP_ + HC_GS + col0); const unsigned gw[4] = {g.x, g.y, g.z, g.w};
        float* t = T1 + (size_t)row * D + col0;
#pragma unroll
        for (int j = 0; j < 4; ++j) { t[2 * j] = bflo(gw[j]) * v[2 * j]; t[2 * j + 1] = bfhi(gw[j]) * v[2 * j + 1]; } } };
struct EpiGate2 { bf16_t* H; const float* T1;
    __device__ __forceinline__ void operator()(int row, int col0, const float (&v)[8]) const {
        const u32x4 g = *(const u32x4*)(H + (size_t)row * HP_ + HC_GA + col0); const unsigned gw[4] = {g.x, g.y, g.z, g.w};
        const float* t = T1 + (size_t)row * D + col0; float o[8];
#pragma unroll
        for (int j = 0; j < 4; ++j) { o[2 * j] = t[2 * j] + bflo(gw[j]) * v[2 * j]; o[2 * j + 1] = t[2 * j + 1] + bfhi(gw[j]) * v[2 * j + 1]; }
        store_bf16x8(H + (size_t)row * HP_ + HC_K + col0, o); } };
struct EpiResid { const float* base; float* out; int row_off; int pad_;
    __device__ __forceinline__ void operator()(int row, int col0, const float (&v)[8]) const {
        const size_t o = (size_t)(row + row_off) * D + col0;
#pragma unroll
        for (int j = 0; j < 8; ++j) out[o + j] = ALPHA * base[o + j] + v[j]; } };


namespace pg8 {
#define PG8_LAS __attribute__((address_space(3)))
typedef short bf16x8 __attribute__((ext_vector_type(8)));
constexpr int BM = 256, BK = 64, HALF = 128, HTB = HALF * BK * 2, STAGE_BYTES = 8 * HTB, NXCD = 8, WGM = 8;
__host__ __device__ __forceinline__ int lds_byte(int r, int c) { const int st = (r >> 4) * 2 + (c >> 5), rr = r & 15, cc = c & 31, ob = rr * 64 + cc * 2; return st * 1024 + (ob ^ (((ob >> 9) & 1) << 5)); }
__host__ __device__ __forceinline__ void stage_rc(int b, int& R, int& C) { const int st = b / 1024, sb = b % 1024, swz = sb ^ (((sb >> 9) & 1) << 5); R = (st >> 1) * 16 + swz / 64; C = (st & 1) * 32 + (swz % 64) / 2; }
__host__ __device__ __forceinline__ int perm32(int rho) { const int n = rho >> 4, i = rho & 15; return 8 * (i >> 2) + 4 * n + (i & 3); }
struct Unit { int pm, pn; };
struct Gemm { const bf16_t* A; const bf16_t* Bt; int M, N, K, lda; };
struct StaticOrder {
    int nM, nN, nwg, G, c;
    __host__ __device__ void init(int M, int N, int G_, int c_) { nM = M / BM; nN = N / BM; nwg = nM * nN; G = G_; c = c_; }
    __host__ __device__ bool next(int i, Unit& u) const {
        const long L = (long)i * G + c; if (L >= nwg) return false;
        int wgid = (int)L; { const int q = nwg / NXCD, r = nwg % NXCD, xcd = wgid % NXCD, off = wgid / NXCD; wgid = (xcd < r ? xcd * (q + 1) : r * (q + 1) + (xcd - r) * q) + off; }
        const int nig = WGM * nN, gid = wgid / nig, fm = gid * WGM, gsz = (nM - fm) < WGM ? (nM - fm) : WGM;
        u.pm = fm + ((wgid % nig) % gsz); u.pn = (wgid % nig) / gsz; return true;
    }
};
template <class F> struct EpiAdapt {
    static constexpr bool PERM = true, AFTER_DRAIN = false; F f;
    __device__ __forceinline__ void operator()(const f32x4 (&acc)[2][2][4][2], const Unit& u, int wr, int wc, int fr, int fq) const {
#pragma unroll
        for (int ai = 0; ai < 2; ++ai)
#pragma unroll
            for (int m = 0; m < 4; ++m) { const int row = u.pm * BM + ai * HALF + wr * 64 + m * 16 + fr;
#pragma unroll
                for (int bj = 0; bj < 2; ++bj) { const int col0 = u.pn * BM + bj * HALF + wc * 32 + 8 * fq;
                    const f32x4 a = acc[ai][bj][m][0], b = acc[ai][bj][m][1]; const float v[8] = {a[0], a[1], a[2], a[3], b[0], b[1], b[2], b[3]};
                    f(row, col0, v); } }
    }
};
template <class Epi, class Sched, bool ALIGN_EPI>
__device__ __forceinline__ void gemm_phase(PG8_LAS unsigned char* lds, const Gemm g, const Sched& S, const Epi& E) {
    const int tid = opaque_tid(), wid = __builtin_amdgcn_readfirstlane(tid >> 6), lane = tid & 63, wr = wid >> 2, wc = wid & 3, fr = lane & 15, fq = lane >> 4;
    const int K = g.K, nt = K / BK, lda = g.lda;
    unsigned voffA[2], voffB[2];
#pragma unroll
    for (int i = 0; i < 2; ++i) { int R, C; stage_rc(tid * 16 + i * 8192, R, C); const int Rb = Epi::PERM ? ((R & ~31) + perm32(R & 31)) : R;
        voffA[i] = (unsigned)(R * lda + C) * 2u; voffB[i] = (unsigned)(Rb * K + C) * 2u; }
    const size_t kstep = (size_t)(BK * 2);
    const size_t hstepA = (size_t)HALF * lda * 2, hstepB = (size_t)HALF * K * 2;
    const size_t tstepA = 2 * hstepA, tstepB = 2 * hstepB;
    const unsigned ldsw = (unsigned)wid * 1024u;
    const int aoff = lds_byte(wr * 64 + fr, fq * 8), boff = lds_byte(wc * 32 + fr, fq * 8);
#define PG8_SA(b, h) (((b) * 2 + (h)) * HTB)
#define PG8_SB(b, h) ((4 + (b) * 2 + (h)) * HTB)
#define PG8_STAGE(bufoff, gbase, voff) do { _Pragma("unroll") for (int _i = 0; _i < 2; ++_i) \
        __builtin_amdgcn_global_load_lds((const unsigned*)((const char*)(gbase) + (voff)[_i]), (PG8_LAS unsigned*)(lds + (bufoff) + ldsw + _i * 8192), 16, 0, 0); } while (0)
#define PG8_LDA(dst, b, h) do { _Pragma("unroll") for (int m = 0; m < 4; ++m) _Pragma("unroll") for (int k = 0; k < 2; ++k) dst[m][k] = *(const PG8_LAS bf16x8*)(lds + PG8_SA(b, h) + aoff + m * 2048 + k * 1024); } while (0)
#define PG8_LDB(dst, b, h) do { _Pragma("unroll") for (int n = 0; n < 2; ++n) _Pragma("unroll") for (int k = 0; k < 2; ++k) dst[n][k] = *(const PG8_LAS bf16x8*)(lds + PG8_SB(b, h) + boff + n * 2048 + k * 1024); } while (0)
#define PG8_MMA(ai, bj, At, Bt) do { __builtin_amdgcn_s_setprio(1); _Pragma("unroll") for (int m = 0; m < 4; ++m) _Pragma("unroll") for (int n = 0; n < 2; ++n) _Pragma("unroll") for (int k = 0; k < 2; ++k) \
        acc[ai][bj][m][n] = __builtin_amdgcn_mfma_f32_16x16x32_bf16(Bt[n][k], At[m][k], acc[ai][bj][m][n], 0, 0, 0); __builtin_amdgcn_s_setprio(0); } while (0)
#define PG8_WAIT_V(n) asm volatile("s_waitcnt vmcnt(" #n ")" ::: "memory")
#define PG8_WAIT_L(n) asm volatile("s_waitcnt lgkmcnt(" #n ")" ::: "memory")
#define PG8_BAR __builtin_amdgcn_s_barrier()
#define PG8_SCHED __builtin_amdgcn_sched_barrier(0)
    Unit cur, nxt; int ui = 0;
    if (!S.next(0, cur)) return;
    f32x4 acc[2][2][4][2];
#pragma unroll
    for (int a = 0; a < 2; ++a)
#pragma unroll
        for (int b = 0; b < 2; ++b)
#pragma unroll
            for (int m = 0; m < 4; ++m)
#pragma unroll
                for (int n = 0; n < 2; ++n) acc[a][b][m][n] = (f32x4){0.f, 0.f, 0.f, 0.f};
    bf16x8 At[4][2], B0[2][2], B1[2][2];
    const char* cA = (const char*)g.A + (size_t)cur.pm * tstepA; const char* cB = (const char*)g.Bt + (size_t)cur.pn * tstepB;
    PG8_STAGE(PG8_SB(0, 0), cB, voffB); PG8_STAGE(PG8_SB(0, 1), cB + hstepB, voffB); PG8_STAGE(PG8_SA(0, 0), cA, voffA); PG8_STAGE(PG8_SA(0, 1), cA + hstepA, voffA);
    if (wr == 1) PG8_BAR;
    PG8_WAIT_V(2); PG8_BAR;
    PG8_STAGE(PG8_SB(1, 0), cB + kstep, voffB); PG8_STAGE(PG8_SA(1, 0), cA + kstep, voffA); PG8_STAGE(PG8_SB(1, 1), cB + hstepB + kstep, voffB);
    PG8_WAIT_V(6); PG8_BAR;
    for (;;) {
        const bool has_next = S.next(ui + 1, nxt);
        const char* nA = has_next ? (const char*)g.A + (size_t)nxt.pm * tstepA : cA; const char* nB = has_next ? (const char*)g.Bt + (size_t)nxt.pn * tstepB : cB;
        for (int t = 0; t < nt; t += 2) {
            const bool last = (t == nt - 2);
            const char* a1 = cA + (size_t)(t + 1) * kstep;
            const char* a2 = last ? nA : cA + (size_t)(t + 2) * kstep; const char* b2 = last ? nB : cB + (size_t)(t + 2) * kstep;
            const char* a3 = a2 + kstep; const char* b3 = b2 + kstep;
            PG8_LDB(B0, 0, 0); PG8_LDB(B1, 0, 1); PG8_SCHED; PG8_LDA(At, 0, 0); PG8_STAGE(PG8_SA(1, 1), a1 + hstepA, voffA);
            PG8_WAIT_V(8); PG8_WAIT_L(0); PG8_BAR; PG8_MMA(0, 0, At, B0); PG8_MMA(0, 1, At, B1); PG8_BAR; PG8_SCHED;
            PG8_LDA(At, 0, 1); PG8_STAGE(PG8_SB(0, 0), b2, voffB); PG8_STAGE(PG8_SB(0, 1), b2 + hstepB, voffB); PG8_STAGE(PG8_SA(0, 0), a2, voffA);
            PG8_WAIT_V(8); PG8_WAIT_L(0); PG8_BAR; PG8_MMA(1, 0, At, B0); PG8_MMA(1, 1, At, B1); PG8_BAR; PG8_SCHED;
            PG8_LDB(B0, 1, 0); PG8_LDB(B1, 1, 1); PG8_SCHED; PG8_LDA(At, 1, 0); PG8_STAGE(PG8_SA(0, 1), a2 + hstepA, voffA);
            PG8_WAIT_V(8); PG8_WAIT_L(0); PG8_BAR; PG8_MMA(0, 0, At, B0); PG8_MMA(0, 1, At, B1); PG8_BAR; PG8_SCHED;
            PG8_LDA(At, 1, 1); PG8_STAGE(PG8_SB(1, 0), b3, voffB); PG8_STAGE(PG8_SB(1, 1), b3 + hstepB, voffB); PG8_STAGE(PG8_SA(1, 0), a3, voffA);
            PG8_WAIT_V(8); PG8_WAIT_L(0); PG8_BAR; PG8_MMA(1, 0, At, B0); PG8_MMA(1, 1, At, B1); PG8_BAR; PG8_SCHED;
        }
        if constexpr (ALIGN_EPI) { if (wr == 0) PG8_BAR; }
        E(acc, cur, wr, wc, fr, fq);
        if (!has_next) break;
#pragma unroll
        for (int a = 0; a < 2; ++a)
#pragma unroll
            for (int b = 0; b < 2; ++b)
#pragma unroll
                for (int m = 0; m < 4; ++m)
#pragma unroll
                    for (int n = 0; n < 2; ++n) acc[a][b][m][n] = (f32x4){0.f, 0.f, 0.f, 0.f};
        cur = nxt; cA = nA; cB = nB; ++ui;
        if constexpr (ALIGN_EPI) { if (wr == 1) PG8_BAR; }
    }
    PG8_WAIT_V(0);
    if constexpr (!ALIGN_EPI) { if (wr == 0) PG8_BAR; }
    PG8_BAR;
#undef PG8_SA
#undef PG8_SB
#undef PG8_STAGE
#undef PG8_LDA
#undef PG8_LDB
#undef PG8_MMA
#undef PG8_WAIT_V
#undef PG8_WAIT_L
#undef PG8_BAR
#undef PG8_SCHED
}
}
constexpr int LDS_BYTES = 148480;
namespace dattn {
#define DA_LAS __attribute__((address_space(3)))
typedef short bf16x8 __attribute__((ext_vector_type(8)));
typedef short s16x4 __attribute__((ext_vector_type(4)));
typedef float f32x16 __attribute__((ext_vector_type(16)));
constexpr int KP = 272, VP = 320, KBUF = 64 * KP, VBUF = 64 * VP, BUF = KBUF + VBUF, XOFF = 2 * BUF, LDS_NEED = XOFF + 65536;
static_assert(LDS_NEED <= 147456, "attention LDS");
__device__ __forceinline__ unsigned cvtpk(float lo, float hi) { typedef float f2 __attribute__((ext_vector_type(2))); typedef __bf16 b2 __attribute__((ext_vector_type(2))); f2 v = {lo, hi}; b2 b = __builtin_convertvector(v, b2); return __builtin_bit_cast(unsigned, b); }
__device__ __forceinline__ s16x4 vtr(const DA_LAS unsigned char* p) { typedef short v4i16_t __attribute__((ext_vector_type(4))); return __builtin_bit_cast(s16x4, __builtin_amdgcn_ds_read_tr16_b64_v4i16((DA_LAS v4i16_t*)p)); }
template <bool STORE = true> __device__ __forceinline__ void unit(DA_LAS unsigned char* lds, bf16_t* Hb, int h, int qb, const float* __restrict__ subln_w, float lam) {
    const int tid = opaque_tid(), lane = tid & 63, w = __builtin_amdgcn_readfirstlane(tid >> 6), mp = w >> 2, rb = w & 3, c32 = lane & 31, hh = lane >> 5;
    const int qrow = 128 * qb + 32 * rb + c32;
    bf16x8 qf[4];
    { const bf16_t* qp = Hb + (size_t)qrow * HP_ + HC_Q + h * 128 + 64 * mp + 8 * hh;
#pragma unroll
      for (int s = 0; s < 4; ++s) qf[s] = *(const bf16x8*)(qp + 16 * s); }
    const int srow = tid >> 4, sch = tid & 15;
    const bf16_t* kg = Hb + HC_K + h * 128 + sch * 8; const bf16_t* vg = Hb + HC_V + h * 128 + sch * 8;
    const int nt = 2 * qb + 2;
    u32x4 kr[2], vr[2];
#define DA_LOAD(t) do { _Pragma("unroll") for (int j = 0; j < 2; ++j) { const size_t ro = (size_t)(64 * (t) + srow + 32 * j) * HP_; kr[j] = *(const u32x4*)(kg + ro); vr[j] = *(const u32x4*)(vg + ro); } } while (0)
#define DA_WRITE(buf) do { _Pragma("unroll") for (int j = 0; j < 2; ++j) { *(DA_LAS u32x4*)(lds + (buf) * BUF + (srow + 32 * j) * KP + sch * 16) = kr[j]; *(DA_LAS u32x4*)(lds + (buf) * BUF + KBUF + (srow + 32 * j) * VP + sch * 16) = vr[j]; } } while (0)
    DA_LOAD(0); DA_WRITE(0);
    __syncthreads();
    f32x16 oT[4];
#pragma unroll
    for (int i = 0; i < 4; ++i) oT[i] = (f32x16){0.f, 0.f, 0.f, 0.f, 0.f, 0.f, 0.f, 0.f, 0.f, 0.f, 0.f, 0.f, 0.f, 0.f, 0.f, 0.f};
    float lrow = 0.f;
    f32x16 negm = (f32x16){0.f, 0.f, 0.f, 0.f, 0.f, 0.f, 0.f, 0.f, 0.f, 0.f, 0.f, 0.f, 0.f, 0.f, 0.f, 0.f};
    const int koff = c32 * KP + (64 * mp + 8 * hh) * 2;
    const int voff = KBUF + (4 * hh + ((lane & 15) >> 2)) * VP + (16 * ((lane >> 4) & 1) + 4 * (lane & 3)) * 2;
    for (int t = 0; t < nt; ++t) {
        const int cur = t & 1;
        if (t + 1 < nt) DA_LOAD(t + 1);
        if (!(t == nt - 1 && rb <= 1)) {
            const DA_LAS unsigned char* kb = lds + cur * BUF + koff;
            f32x16 s0 = negm, s1 = negm;
            bf16x8 kf0[4], kf1[4];
#pragma unroll
            for (int s = 0; s < 4; ++s) { kf0[s] = *(const DA_LAS bf16x8*)(kb + s * 32); kf1[s] = *(const DA_LAS bf16x8*)(kb + 32 * KP + s * 32); }
            __builtin_amdgcn_s_setprio(1);
#pragma unroll
            for (int s = 0; s < 4; ++s) {
                s0 = __builtin_amdgcn_mfma_f32_32x32x16_bf16(kf0[s], qf[s], s0, 0, 0, 0);
                s1 = __builtin_amdgcn_mfma_f32_32x32x16_bf16(kf1[s], qf[s], s1, 0, 0, 0);
            }
            __builtin_amdgcn_s_setprio(0);
            if (t >= nt - 2) {
                const int k0 = 64 * t + 4 * hh;
#pragma unroll
                for (int r = 0; r < 16; ++r) { const int key = k0 + (r & 3) + 8 * (r >> 2); if (key > qrow) s0[r] = -INFINITY; if (key + 32 > qrow) s1[r] = -INFINITY; }
            }
            float mxa = fmaxf(fmaxf(s0[0], s0[1]), s1[0]), mxb = fmaxf(fmaxf(s0[2], s0[3]), s1[1]);
            mxa = fmaxf(fmaxf(mxa, s1[2]), s1[3]);
#pragma unroll
            for (int r = 4; r < 16; r += 4) { mxa = fmaxf(fmaxf(mxa, s0[r]), s0[r + 1]); mxb = fmaxf(fmaxf(mxb, s0[r + 2]), s0[r + 3]); mxa = fmaxf(fmaxf(mxa, s1[r]), s1[r + 1]); mxb = fmaxf(fmaxf(mxb, s1[r + 2]), s1[r + 3]); }
            float mx = fmaxf(mxa, mxb);
            mx = fmaxf(mx, __shfl_xor(mx, 32));
            if (__any(mx > 8.f)) {
                const float dl = fmaxf(mx, 0.f), alpha = __builtin_amdgcn_exp2f(-dl);
#pragma unroll
                for (int r = 0; r < 16; ++r) { s0[r] -= dl; s1[r] -= dl; negm[r] -= dl; }
                lrow *= alpha;
#pragma unroll
                for (int i = 0; i < 4; ++i)
#pragma unroll
                    for (int r = 0; r < 16; ++r) oT[i][r] *= alpha;
            }
            float ps = 0.f;
#pragma unroll
            for (int r = 0; r < 16; ++r) { s0[r] = __builtin_amdgcn_exp2f(s0[r]); s1[r] = __builtin_amdgcn_exp2f(s1[r]); ps += s0[r] + s1[r]; }
            lrow += ps;
            bf16x8 pf[2][2];
#pragma unroll
            for (int s = 0; s < 2; ++s) {
                u32x4 a, b;
                a.x = cvtpk(s0[8 * s], s0[8 * s + 1]); a.y = cvtpk(s0[8 * s + 2], s0[8 * s + 3]); a.z = cvtpk(s0[8 * s + 4], s0[8 * s + 5]); a.w = cvtpk(s0[8 * s + 6], s0[8 * s + 7]);
                b.x = cvtpk(s1[8 * s], s1[8 * s + 1]); b.y = cvtpk(s1[8 * s + 2], s1[8 * s + 3]); b.z = cvtpk(s1[8 * s + 4], s1[8 * s + 5]); b.w = cvtpk(s1[8 * s + 6], s1[8 * s + 7]);
                pf[0][s] = __builtin_bit_cast(bf16x8, a); pf[1][s] = __builtin_bit_cast(bf16x8, b);
            }
            const DA_LAS unsigned char* vb = lds + cur * BUF + voff;
#define DA_LDV(dst, db) do { _Pragma("unroll") for (int i_ = 0; i_ < 4; ++i_) { const s16x4 lo_ = vtr(vb + (16 * i_) * VP + (db) * 64), hi_ = vtr(vb + (16 * i_ + 8) * VP + (db) * 64); \
                dst[i_] = (bf16x8){lo_[0], lo_[1], lo_[2], lo_[3], hi_[0], hi_[1], hi_[2], hi_[3]}; } } while (0)
#define DA_MM(src, db) do { _Pragma("unroll") for (int i_ = 0; i_ < 4; ++i_) oT[db] = __builtin_amdgcn_mfma_f32_32x32x16_bf16(src[i_], pf[i_ >> 1][i_ & 1], oT[db], 0, 0, 0); } while (0)
            bf16x8 va[4], vq[4];
            DA_LDV(va, 0);
            DA_LDV(vq, 1); __builtin_amdgcn_s_setprio(1); DA_MM(va, 0); __builtin_amdgcn_s_setprio(0);
            DA_LDV(va, 2); __builtin_amdgcn_s_setprio(1); DA_MM(vq, 1); __builtin_amdgcn_s_setprio(0);
            DA_LDV(vq, 3); __builtin_amdgcn_s_setprio(1); DA_MM(va, 2); __builtin_amdgcn_s_setprio(0);
            __builtin_amdgcn_s_setprio(1); DA_MM(vq, 3);
#undef DA_LDV
#undef DA_MM
            __builtin_amdgcn_s_setprio(0);
        }
        if (t + 1 < nt) DA_WRITE(cur ^ 1);
        __syncthreads();
    }
#undef DA_LOAD
#undef DA_WRITE
    const float inv = 1.f / (lrow + __shfl_xor(lrow, 32));
    DA_LAS float* X = (DA_LAS float*)(lds + XOFF) + rb * 4096 + lane;
    if (mp == 1) {
#pragma unroll
        for (int i = 0; i < 4; ++i)
#pragma unroll
            for (int r = 0; r < 16; ++r) X[(i * 16 + r) * 64] = oT[i][r] * inv;
    }
    __syncthreads();
    if (mp == 0) {
        float ss = 0.f;
#pragma unroll
        for (int i = 0; i < 4; ++i)
#pragma unroll
            for (int r = 0; r < 16; ++r) { const float o = oT[i][r] * inv - lam * X[(i * 16 + r) * 64]; oT[i][r] = o; ss += o * o; }
        ss += __shfl_xor(ss, 32);
        const float rr = rsqrtf(ss * (1.f / 128.f) + 1e-5f) * (1.f - LAMBDA_INIT);
        bf16_t* op = Hb + (size_t)qrow * HP_ + HC_Q + h * 128 + 4 * hh;
#pragma unroll
        for (int i = 0; i < 4; ++i)
#pragma unroll
            for (int g = 0; g < 4; ++g) { const int d0 = 32 * i + 8 * g; const f32x4 sw = *(const f32x4*)(subln_w + d0 + 4 * hh);
                uint2 o; o.x = pk2(oT[i][4 * g] * rr * sw.x, oT[i][4 * g + 1] * rr * sw.y); o.y = pk2(oT[i][4 * g + 2] * rr * sw.z, oT[i][4 * g + 3] * rr * sw.w);
                if (STORE || o.x == 0x12345u) *(uint2*)(op + d0) = o; }
    }
    __syncthreads();
}
}
namespace ssd {
#define SS_LAS __attribute__((address_space(3)))
typedef short bf16x8 __attribute__((ext_vector_type(8)));
typedef short s16x4 __attribute__((ext_vector_type(4)));
typedef float f32x16 __attribute__((ext_vector_type(16)));
constexpr int XP = 192;
constexpr int BPT = 320;
constexpr int CP = 272;
__device__ __forceinline__ s16x4 vtr(const SS_LAS unsigned char* p) { typedef short v4i16_t __attribute__((ext_vector_type(4))); return __builtin_bit_cast(s16x4, __builtin_amdgcn_ds_read_tr16_b64_v4i16((SS_LAS v4i16_t*)p)); }
__device__ __forceinline__ unsigned cvtpk(float lo, float hi) { typedef float f2 __attribute__((ext_vector_type(2))); typedef __bf16 b2 __attribute__((ext_vector_type(2))); f2 v = {lo, hi}; b2 b = __builtin_convertvector(v, b2); return __builtin_bit_cast(unsigned, b); }
__device__ __forceinline__ void acs_tables(SS_LAS float* ACS, SS_LAS float* DTS, const float* __restrict__ DTb, const float* __restrict__ a_log, int c, int g) {
    const int tid_ = opaque_tid(); const int lane = tid_ & 63, e = __builtin_amdgcn_readfirstlane(tid_ >> 6), h = 8 * g + e;
    const float a = -expf(a_log[h]);
    const float d0 = DTb[(size_t)(128 * c + 2 * lane) * 32 + h], d1 = DTb[(size_t)(128 * c + 2 * lane + 1) * 32 + h];
    const float a0 = d0 * a, a1 = d1 * a;
    float sc = a0 + a1;
#pragma unroll
    for (int o = 1; o < 64; o <<= 1) { const float v = __shfl_up(sc, o); if (lane >= o) sc += v; }
    const float ex = sc - (a0 + a1);
    ACS[(2 * lane) * 8 + e] = ex + a0; ACS[(2 * lane + 1) * 8 + e] = ex + a0 + a1;
    DTS[(2 * lane) * 8 + e] = d0; DTS[(2 * lane + 1) * 8 + e] = d1;
}
template <int NT, class F> __device__ __forceinline__ void conv_item(const bf16_t* __restrict__ Hb, int t0, int l0, int xch0, const float* __restrict__ conv_w, const float* __restrict__ conv_b, F sink) {
    float w[4][8], bias[8];
#pragma unroll
    for (int j = 0; j < 4; ++j) { const f32x4 a = *(const f32x4*)(conv_w + j * DXBC + xch0), b = *(const f32x4*)(conv_w + j * DXBC + xch0 + 4); w[j][0] = a.x; w[j][1] = a.y; w[j][2] = a.z; w[j][3] = a.w; w[j][4] = b.x; w[j][5] = b.y; w[j][6] = b.z; w[j][7] = b.w; }
    { const f32x4 a = *(const f32x4*)(conv_b + xch0), b = *(const f32x4*)(conv_b + xch0 + 4); bias[0] = a.x; bias[1] = a.y; bias[2] = a.z; bias[3] = a.w; bias[4] = b.x; bias[5] = b.y; bias[6] = b.z; bias[7] = b.w; }
    const bf16_t* src = Hb + HC_XBC + xch0;
    u32x4 rw[NT + 3];
#pragma unroll
    for (int i = 0; i < NT + 3; ++i) { const int tt = t0 + l0 - 3 + i; rw[i] = *(const u32x4*)(src + (size_t)(tt < 0 ? 0 : tt) * HP_); }
    if (t0 + l0 < 3) {
#pragma unroll
        for (int i = 0; i < 3; ++i) if (t0 + l0 - 3 + i < 0) rw[i] = (u32x4){0u, 0u, 0u, 0u};
    }
#define SS_UNP(dst, q_) do { dst[0] = bflo(q_.x); dst[1] = bfhi(q_.x); dst[2] = bflo(q_.y); dst[3] = bfhi(q_.y); dst[4] = bflo(q_.z); dst[5] = bfhi(q_.z); dst[6] = bflo(q_.w); dst[7] = bfhi(q_.w); } while (0)
    float x0[8], x1[8], x2[8];
    SS_UNP(x0, rw[0]); SS_UNP(x1, rw[1]); SS_UNP(x2, rw[2]);
#pragma unroll
    for (int i = 0; i < NT; ++i) {
        float x3[8]; SS_UNP(x3, rw[3 + i]);
        float v[8];
#pragma unroll
        for (int k = 0; k < 8; ++k) { const float a = bias[k] + w[0][k] * x0[k] + w[1][k] * x1[k] + w[2][k] * x2[k] + w[3][k] * x3[k]; v[k] = a * __builtin_amdgcn_rcpf(1.f + __expf(-a)); x0[k] = x1[k]; x1[k] = x2[k]; x2[k] = x3[k]; }
        sink(l0 + i, v);
    }
#undef SS_UNP
}
constexpr int A_BS = 0, A_XD = 128 * BPT  , A_ACS = A_XD + 2 * 128 * XP  , A_DTS = A_ACS + 4096, A_END = A_DTS + 4096;
__device__ __forceinline__ void phaseA_unit(SS_LAS unsigned char* lds, const bf16_t* __restrict__ Hb, const float* __restrict__ DTb, const float* __restrict__ conv_w, const float* __restrict__ conv_b,
                                            const float* __restrict__ a_log, bf16_t* __restrict__ ST, float* __restrict__ CD, int c, int g) {
    const int tid = opaque_tid(), lane = tid & 63, w = __builtin_amdgcn_readfirstlane(tid >> 6), c32 = lane & 31, hh = lane >> 5;
    SS_LAS float* ACS = (SS_LAS float*)(lds + A_ACS); SS_LAS float* DTS = (SS_LAS float*)(lds + A_DTS);
    acs_tables(ACS, DTS, DTb, a_log, c, g);
    __syncthreads();
    if (tid < 8) CD[c * 32 + 8 * g + tid] = __expf(ACS[127 * 8 + tid]);
    auto stageX = [&](int e, int item, int buf) {
        const int cg = item >> 5, seg = item & 31; const float aend = ACS[127 * 8 + e];
        conv_item<4>(Hb, 128 * c, 4 * seg, g * 512 + e * 64 + cg * 8, conv_w, conv_b, [&](int l, const float (&v)[8]) {
            const float sc = DTS[l * 8 + e] * __expf(aend - ACS[l * 8 + e]);
            u32x4 o; o.x = cvtpk(v[0] * sc, v[1] * sc); o.y = cvtpk(v[2] * sc, v[3] * sc); o.z = cvtpk(v[4] * sc, v[5] * sc); o.w = cvtpk(v[6] * sc, v[7] * sc);
            *(SS_LAS u32x4*)(lds + A_XD + buf * 128 * XP + l * XP + cg * 16) = o; });
    };
    { const int cg = tid >> 5, seg = tid & 31;
        conv_item<4>(Hb, 128 * c, 4 * seg, 2048 + g * 128 + cg * 8, conv_w, conv_b, [&](int l, const float (&v)[8]) {
            u32x4 o; o.x = cvtpk(v[0], v[1]); o.y = cvtpk(v[2], v[3]); o.z = cvtpk(v[4], v[5]); o.w = cvtpk(v[6], v[7]);
            *(SS_LAS u32x4*)(lds + A_BS + l * BPT + cg * 16) = o; }); }
    if (tid < 256) stageX(0, tid, 0);
    __syncthreads();
    const int pb = w & 1, nb = w >> 1;
    const int rsel = ((lane & 15) >> 2), csel = 16 * ((lane >> 4) & 1) + 4 * (lane & 3);
    for (int e = 0; e < 8; ++e) {
        if (e + 1 < 8 && tid >= 256) stageX(e + 1, tid - 256, (e + 1) & 1);
        f32x16 acc = (f32x16){0.f, 0.f, 0.f, 0.f, 0.f, 0.f, 0.f, 0.f, 0.f, 0.f, 0.f, 0.f, 0.f, 0.f, 0.f, 0.f};
        const SS_LAS unsigned char* bp = lds + A_BS + (8 * hh + rsel) * BPT + (32 * nb + csel) * 2;
        const SS_LAS unsigned char* xp = lds + A_XD + (e & 1) * 128 * XP + (8 * hh + rsel) * XP + (32 * pb + csel) * 2;
#pragma unroll
        for (int ks = 0; ks < 8; ++ks) {
            const s16x4 b0 = vtr(bp + (16 * ks) * BPT), b1 = vtr(bp + (16 * ks + 4) * BPT), x0 = vtr(xp + (16 * ks) * XP), x1 = vtr(xp + (16 * ks + 4) * XP);
            const bf16x8 bf = (bf16x8){b0[0], b0[1], b0[2], b0[3], b1[0], b1[1], b1[2], b1[3]}, xf = (bf16x8){x0[0], x0[1], x0[2], x0[3], x1[0], x1[1], x1[2], x1[3]};
            acc = __builtin_amdgcn_mfma_f32_32x32x16_bf16(bf, xf, acc, 0, 0, 0);
        }
        bf16_t* sp = ST + ((size_t)(c * 32 + 8 * g + e) * 64 + 32 * pb + c32) * 128 + 32 * nb + 4 * hh;
#pragma unroll
        for (int q = 0; q < 4; ++q) { uint2 o; o.x = cvtpk(acc[4 * q], acc[4 * q + 1]); o.y = cvtpk(acc[4 * q + 2], acc[4 * q + 3]); *(uint2*)(sp + 8 * q) = o; }
        __syncthreads();
    }
}
__device__ __forceinline__ void scan_phase(bf16_t* __restrict__ ST, const float* __restrict__ CD, int gtid) {
    const int h = gtid >> 12;
    unsigned* p = (unsigned*)ST + gtid;
    float r0 = 0.f, r1 = 0.f;
    for (int c0 = 0; c0 < 64; c0 += 16) {
        unsigned v[16]; float d[16];
#pragma unroll
        for (int i = 0; i < 16; ++i) { v[i] = p[(size_t)(c0 + i) * 131072]; d[i] = CD[(c0 + i) * 32 + h]; }
#pragma unroll
        for (int i = 0; i < 16; ++i) { p[(size_t)(c0 + i) * 131072] = cvtpk(r0, r1); r0 = r0 * d[i] + bflo(v[i]); r1 = r1 * d[i] + bfhi(v[i]); }
    }
}
constexpr int C_CS = 0, C_BS = 128 * CP  , C_X1 = C_BS  , C_CBT = 2 * 128 * CP  , C_X0 = C_CBT + 32768  , C_ACS = C_X0 + 128 * XP  , C_DTS = C_ACS + 4096,
              C_SSQ = C_DTS + 4096, C_END = C_SSQ + 1024;
static_assert(C_END <= 147456 && 128 * XP <= 128 * CP, "ssd phase C LDS");
template <bool STORE = true> __device__ __forceinline__ void phaseC_unit(SS_LAS unsigned char* lds, bf16_t* __restrict__ Hb, const float* __restrict__ DTb, const float* __restrict__ conv_w, const float* __restrict__ conv_b,
                                            const float* __restrict__ a_log, const float* __restrict__ d_skip, const float* __restrict__ norm_w, const bf16_t* __restrict__ ST, int c, int g) {
    const int tid = opaque_tid(), lane = tid & 63, w = __builtin_amdgcn_readfirstlane(tid >> 6), c32 = lane & 31, hh = lane >> 5;
    SS_LAS float* ACS = (SS_LAS float*)(lds + C_ACS); SS_LAS float* DTS = (SS_LAS float*)(lds + C_DTS); SS_LAS float* SSQ = (SS_LAS float*)(lds + C_SSQ);
    acs_tables(ACS, DTS, DTb, a_log, c, g);
    auto stageX = [&](int e, int item, int buf) {
        const int cg = item >> 5, seg = item & 31;
        conv_item<4>(Hb, 128 * c, 4 * seg, g * 512 + e * 64 + cg * 8, conv_w, conv_b, [&](int l, const float (&v)[8]) {
            u32x4 o; o.x = cvtpk(v[0], v[1]); o.y = cvtpk(v[2], v[3]); o.z = cvtpk(v[4], v[5]); o.w = cvtpk(v[6], v[7]);
            *(SS_LAS u32x4*)(lds + (buf ? C_X1 : C_X0) + l * XP + cg * 16) = o; });
    };
    { const int isC = tid >> 8, it = tid & 255, cg = it >> 4, seg = it & 15;
        conv_item<8>(Hb, 128 * c, 8 * seg, 2048 + isC * 512 + g * 128 + cg * 8, conv_w, conv_b, [&](int l, const float (&v)[8]) {
            u32x4 o; o.x = cvtpk(v[0], v[1]); o.y = cvtpk(v[2], v[3]); o.z = cvtpk(v[4], v[5]); o.w = cvtpk(v[6], v[7]);
            *(SS_LAS u32x4*)(lds + (isC ? C_CS : C_BS) + l * CP + cg * 16) = o; }); }
    if (tid < 256) stageX(0, tid, 0);
    __syncthreads();
    for (int i = w; i < 10; i += 8) {
        const int sb = (i < 4) ? 0 : (i < 7) ? 1 : (i < 9) ? 2 : 3, lb = (i < 4) ? i : (i < 7) ? i - 3 : (i < 9) ? i - 5 : 3;
        f32x16 acc = (f32x16){0.f, 0.f, 0.f, 0.f, 0.f, 0.f, 0.f, 0.f, 0.f, 0.f, 0.f, 0.f, 0.f, 0.f, 0.f, 0.f};
        const SS_LAS unsigned char* bp = lds + C_BS + (32 * sb + c32) * CP + 16 * hh, *cp = lds + C_CS + (32 * lb + c32) * CP + 16 * hh;
#pragma unroll
        for (int ks = 0; ks < 8; ++ks) acc = __builtin_amdgcn_mfma_f32_32x32x16_bf16(*(const SS_LAS bf16x8*)(bp + 32 * ks), *(const SS_LAS bf16x8*)(cp + 32 * ks), acc, 0, 0, 0);
        SS_LAS unsigned* o = (SS_LAS unsigned*)(lds + C_CBT) + (sb * 4 + lb) * 512 + lane;
#pragma unroll
        for (int q = 0; q < 8; ++q) o[q * 64] = cvtpk(acc[2 * q], acc[2 * q + 1]);
    }
    __syncthreads();
    const int pb = w & 1, lb = w >> 1, lrow = 32 * lb + c32;
    const int rsel = ((lane & 15) >> 2), csel = 16 * ((lane >> 4) & 1) + 4 * (lane & 3);
    unsigned ypk[8][8];
    float ssq = 0.f;
    bf16x8 pcur[8]; u32x2 zcur[4];
#define SS_PREF(pdst, zdst, e_) do { const int h_ = 8 * g + (e_); const bf16_t* pp_ = ST + ((size_t)(c * 32 + h_) * 64 + 32 * pb + c32) * 128 + 8 * hh; \
        _Pragma("unroll") for (int ks_ = 0; ks_ < 8; ++ks_) pdst[ks_] = *(const bf16x8*)(pp_ + 16 * ks_); \
        const bf16_t* zp_ = Hb + (size_t)(128 * c + lrow) * HP_ + HC_Z + g * 512 + (e_) * 64 + 32 * pb + 4 * hh; \
        _Pragma("unroll") for (int q_ = 0; q_ < 4; ++q_) zdst[q_] = *(const u32x2*)(zp_ + 8 * q_); } while (0)
    SS_PREF(pcur, zcur, 0);
    for (int e = 0; e < 8; ++e) {
        const int h = 8 * g + e;
        if (e + 1 < 8 && tid < 256) stageX(e + 1, tid, (e + 1) & 1);
        bf16x8 pnext[8]; u32x2 znext[4];
        { const int en = (e + 1 < 8) ? e + 1 : 7; SS_PREF(pnext, znext, en); }
        const int xoff = (e & 1) ? C_X1 : C_X0;
        f32x16 acc = (f32x16){0.f, 0.f, 0.f, 0.f, 0.f, 0.f, 0.f, 0.f, 0.f, 0.f, 0.f, 0.f, 0.f, 0.f, 0.f, 0.f};
        {
            const SS_LAS unsigned char* cp = lds + C_CS + lrow * CP + 16 * hh;
#pragma unroll
            for (int ks = 0; ks < 8; ++ks) acc = __builtin_amdgcn_mfma_f32_32x32x16_bf16(pcur[ks], *(const SS_LAS bf16x8*)(cp + 32 * ks), acc, 0, 0, 0);
        }
        const float al = ACS[lrow * 8 + e], eal = __expf(al);
#pragma unroll
        for (int r = 0; r < 16; ++r) acc[r] *= eal;
        for (int sb = 0; sb <= lb; ++sb) {
            const SS_LAS unsigned* cbp = (const SS_LAS unsigned*)(lds + C_CBT) + (sb * 4 + lb) * 512 + lane;
            float m[16];
#pragma unroll
            for (int q = 0; q < 8; ++q) { const unsigned u = cbp[q * 64]; m[2 * q] = bflo(u); m[2 * q + 1] = bfhi(u); }
#pragma unroll
            for (int r = 0; r < 16; ++r) { const int srow = 32 * sb + (r & 3) + 8 * (r >> 2) + 4 * hh;
                const float f = __expf(al - ACS[srow * 8 + e]) * DTS[srow * 8 + e];
                m[r] = (srow <= lrow) ? m[r] * f : 0.f; }
            const SS_LAS unsigned char* xp = lds + xoff + (32 * sb + 4 * hh + rsel) * XP + (32 * pb + csel) * 2;
#pragma unroll
            for (int ks = 0; ks < 2; ++ks) {
                const s16x4 x0 = vtr(xp + (16 * ks) * XP), x1 = vtr(xp + (16 * ks + 8) * XP);
                const bf16x8 xf = (bf16x8){x0[0], x0[1], x0[2], x0[3], x1[0], x1[1], x1[2], x1[3]};
                u32x4 mm; mm.x = cvtpk(m[8 * ks], m[8 * ks + 1]); mm.y = cvtpk(m[8 * ks + 2], m[8 * ks + 3]); mm.z = cvtpk(m[8 * ks + 4], m[8 * ks + 5]); mm.w = cvtpk(m[8 * ks + 6], m[8 * ks + 7]);
                acc = __builtin_amdgcn_mfma_f32_32x32x16_bf16(xf, __builtin_bit_cast(bf16x8, mm), acc, 0, 0, 0);
            }
        }
        const float dsk = d_skip[h];
        const SS_LAS unsigned char* xr = lds + xoff + lrow * XP + (32 * pb + 4 * hh) * 2;
        unsigned yt[8];
#pragma unroll
        for (int q = 0; q < 4; ++q) {
            const u32x2 zz = zcur[q]; const u32x2 xx = *(const SS_LAS u32x2*)(xr + 16 * q);
            const float zv[4] = {bflo(zz.x), bfhi(zz.x), bflo(zz.y), bfhi(zz.y)}, xv[4] = {bflo(xx.x), bfhi(xx.x), bflo(xx.y), bfhi(xx.y)};
            float y[4];
#pragma unroll
            for (int k = 0; k < 4; ++k) { y[k] = (acc[4 * q + k] + dsk * xv[k]) * (zv[k] * __builtin_amdgcn_rcpf(1.f + __expf(-zv[k]))); ssq += y[k] * y[k]; }
            yt[2 * q] = cvtpk(y[0], y[1]); yt[2 * q + 1] = cvtpk(y[2], y[3]);
        }
#define SS_YSET(E) case E: { _Pragma("unroll") for (int q_ = 0; q_ < 8; ++q_) ypk[E][q_] = yt[q_]; } break;
        switch (e) { SS_YSET(0) SS_YSET(1) SS_YSET(2) SS_YSET(3) SS_YSET(4) SS_YSET(5) SS_YSET(6) default: { _Pragma("unroll") for (int q_ = 0; q_ < 8; ++q_) ypk[7][q_] = yt[q_]; } break; }
#undef SS_YSET
#pragma unroll
        for (int ks = 0; ks < 8; ++ks) pcur[ks] = pnext[ks];
#pragma unroll
        for (int q = 0; q < 4; ++q) zcur[q] = znext[q];
        __syncthreads();
    }
#undef SS_PREF
    ssq += __shfl_xor(ssq, 32);
    if (hh == 0) SSQ[pb * 128 + lrow] = ssq;
    __syncthreads();
    const float rstd = rsqrtf((SSQ[lrow] + SSQ[128 + lrow]) * (1.f / 512.f) + 1e-5f);
    bf16_t* op = Hb + (size_t)(128 * c + lrow) * HP_ + HC_Z + g * 512 + 32 * pb + 4 * hh;
    const float* nw = norm_w + g * 512 + 32 * pb + 4 * hh;
#pragma unroll
    for (int e = 0; e < 8; ++e)
#pragma unroll
        for (int q = 0; q < 4; ++q) { const f32x4 n4 = *(const f32x4*)(nw + e * 64 + 8 * q);
            uint2 o; o.x = cvtpk(bflo(ypk[e][2 * q]) * rstd * n4.x, bfhi(ypk[e][2 * q]) * rstd * n4.y); o.y = cvtpk(bflo(ypk[e][2 * q + 1]) * rstd * n4.z, bfhi(ypk[e][2 * q + 1]) * rstd * n4.w);
            if (STORE || o.x == 0x12345u) *(uint2*)(op + e * 64 + 8 * q) = o; }
    __syncthreads();
}
}


namespace psel {
#define PS_LAS __attribute__((address_space(3)))
typedef short bf16x8 __attribute__((ext_vector_type(8)));
typedef float f32x16 __attribute__((ext_vector_type(16)));
__device__ __forceinline__ int ord(float f) { const int b = __builtin_bit_cast(int, f); return b ^ ((b >> 31) & 0x7fffffff); }
__device__ __forceinline__ float unord(int t) { return __builtin_bit_cast(float, t ^ ((t >> 31) & 0x7fffffff)); }
#define PS_INS(top, v) do { int v_ = (v); _Pragma("unroll") for (int i_ = 0; i_ < 16; ++i_) { const int hi_ = max(top[i_], v_); v_ = min(top[i_], v_); top[i_] = hi_; } } while (0)
__device__ __forceinline__ void stage1(PS_LAS int* EXall, const bf16_t* __restrict__ QP, const bf16_t* __restrict__ SUBK, int tok0, int hp) {
    const int tid = opaque_tid(), lane = tid & 63, w1 = __builtin_amdgcn_readfirstlane(tid >> 6), c32 = lane & 31, hh = lane >> 5;
    PS_LAS int* EX = EXall + hp * 4096;
    {
        const int tile = w1 >> 2, hsel = (w1 >> 1) & 1, half = w1 & 1, h = 2 * hp + hsel;
        const bf16_t* qp = QP + (size_t)(tok0 + 32 * tile + c32) * 2048 + h * 256 + half * 128 + 8 * hh;
        const bf16_t* kp = SUBK + ((size_t)(h * 2 + half) * 128 + c32) * 128 + 8 * hh;
        bf16x8 qf[8];
#pragma unroll
        for (int ks = 0; ks < 8; ++ks) qf[ks] = *(const bf16x8*)(qp + 16 * ks);
        int top[16];
#pragma unroll
        for (int i = 0; i < 16; ++i) top[i] = (int)0x80000000;
        bf16x8 kfa[8], kfb[8];
#define PS_LDK(dst, mt_) do { _Pragma("unroll") for (int ks_ = 0; ks_ < 8; ++ks_) dst[ks_] = *(const bf16x8*)(kp + (size_t)(32 * (mt_)) * 128 + 16 * ks_); } while (0)
#define PS_TILE(src, mt_) do { f32x16 acc_ = (f32x16){0.f, 0.f, 0.f, 0.f, 0.f, 0.f, 0.f, 0.f, 0.f, 0.f, 0.f, 0.f, 0.f, 0.f, 0.f, 0.f}; \
            _Pragma("unroll") for (int ks_ = 0; ks_ < 8; ++ks_) acc_ = __builtin_amdgcn_mfma_f32_32x32x16_bf16(src[ks_], qf[ks_], acc_, 0, 0, 0); \
            _Pragma("unroll") for (int r_ = 0; r_ < 16; ++r_) { const int key_ = 32 * (mt_) + (r_ & 3) + 8 * (r_ >> 2) + 4 * hh; const int v__ = (ord(acc_[r_]) & ~127) | (127 - key_); PS_INS(top, v__); } } while (0)
        PS_LDK(kfa, 0);
        PS_LDK(kfb, 1); PS_TILE(kfa, 0);
        PS_LDK(kfa, 2); PS_TILE(kfb, 1);
        PS_LDK(kfb, 3); PS_TILE(kfa, 2);
        PS_TILE(kfb, 3);
#undef PS_LDK
#undef PS_TILE
        int oth[16];
#pragma unroll
        for (int i = 0; i < 16; ++i) oth[i] = __shfl_xor(top[i], 32);
#pragma unroll
        for (int i = 0; i < 16; ++i) PS_INS(top, oth[i]);
        if (hh == 0) {
#pragma unroll
            for (int i = 0; i < 16; ++i) EX[(w1 * 16 + i) * 32 + c32] = top[i];
        }
    }
}
__device__ __forceinline__ void stage2(PS_LAS int* EXall, int* __restrict__ IDX, float* __restrict__ GATE, int tok0) {
    const int tid = opaque_tid();
    {
        const int hp = tid >> 7, task = tid & 127, th = task >> 5, tok32 = task & 31, tile = th >> 1, hsel = th & 1, h = 2 * hp + hsel;
        PS_LAS int* EX = EXall + hp * 4096;
        const PS_LAS int* ea = EX + ((th * 2 + 0) * 16) * 32 + tok32; const PS_LAS int* eb = EX + ((th * 2 + 1) * 16) * 32 + tok32;
        float as[16], bs[16];
#pragma unroll
        for (int i = 0; i < 16; ++i) { as[i] = unord(ea[i * 32] & ~127); bs[i] = unord(eb[i * 32] & ~127); }
        int top[16];
#pragma unroll
        for (int i = 0; i < 16; ++i) top[i] = (int)0x80000000;
#pragma unroll
        for (int i = 0; i < 16; ++i)
#pragma unroll
            for (int j = 0; j < 16; ++j) if ((i + 1) * (j + 1) <= 16) { const int v = (ord(as[i] + bs[j]) & ~255) | (255 - (i * 16 + j)); PS_INS(top, v); }
        float sc[16]; int id[16];
#pragma unroll
        for (int r = 0; r < 16; ++r) { const int cn = 255 - (top[r] & 255), i = cn >> 4, j = cn & 15; const int pa = ea[i * 32], pb = eb[j * 32];
            sc[r] = unord(pa & ~127) + unord(pb & ~127); id[r] = (127 - (pa & 127)) * 128 + (127 - (pb & 127)); }
        float sum = 0.f; const float mx = sc[0];
#pragma unroll
        for (int r = 0; r < 16; ++r) { sc[r] = __expf(sc[r] - mx); sum += sc[r]; }
        const size_t o = (size_t)(tok0 + 32 * tile + tok32) * 128 + h * 16;
        const float inv = 1.f / sum;
#pragma unroll
        for (int r = 0; r < 16; r += 4) { *(f32x4*)(GATE + o + r) = (f32x4){sc[r] * inv, sc[r + 1] * inv, sc[r + 2] * inv, sc[r + 3] * inv}; *(u32x4*)(IDX + o + r) = (u32x4){(unsigned)id[r], (unsigned)id[r + 1], (unsigned)id[r + 2], (unsigned)id[r + 3]}; }
    }
}
}


namespace xattn {
#define XA_LAS __attribute__((address_space(3)))
typedef short bf16x8 __attribute__((ext_vector_type(8)));
typedef short s16x4 __attribute__((ext_vector_type(4)));
typedef float f32x16 __attribute__((ext_vector_type(16)));
constexpr int RP = 528;
__device__ __forceinline__ unsigned cvtpk(float lo, float hi) { typedef float f2 __attribute__((ext_vector_type(2))); typedef __bf16 b2 __attribute__((ext_vector_type(2))); f2 v = {lo, hi}; b2 b = __builtin_convertvector(v, b2); return __builtin_bit_cast(unsigned, b); }
__device__ __forceinline__ void stage(XA_LAS unsigned char* lds, const bf16_t* __restrict__ src, int pitch, int tid) {
#pragma unroll 4
    for (int i = 0; i < 16; ++i) { const int q = tid + 512 * i, row = q >> 5, ch = q & 31; *(XA_LAS u32x4*)(lds + row * RP + ch * 16) = *(const u32x4*)(src + (size_t)row * pitch + ch * 8); }
}
__device__ __forceinline__ void unit(XA_LAS unsigned char* lds, const bf16_t* __restrict__ QC, const bf16_t* __restrict__ KC, const bf16_t* __restrict__ VcT, bf16_t* __restrict__ XO, int tg, int h) {
    const int tid = opaque_tid(), lane = tid & 63, w = __builtin_amdgcn_readfirstlane(tid >> 6), c32 = lane & 31, hh = lane >> 5, b = tg >> 5;
    const int tok = 256 * tg + 32 * w + c32;
    stage(lds, KC + (size_t)b * MEML * D + h * 256, D, tid);
    bf16x8 pf[8][2]; float inv;
    {
        bf16x8 qf[16];
        const bf16_t* qp = QC + (size_t)tok * D + h * 256 + 8 * hh;
#pragma unroll
        for (int ks = 0; ks < 16; ++ks) qf[ks] = *(const bf16x8*)(qp + 16 * ks);
        __syncthreads();
        f32x16 acc[8];
        const XA_LAS unsigned char* kb = lds + c32 * RP + 16 * hh;
#pragma unroll
        for (int mt = 0; mt < 8; ++mt) {
            acc[mt] = (f32x16){0.f, 0.f, 0.f, 0.f, 0.f, 0.f, 0.f, 0.f, 0.f, 0.f, 0.f, 0.f, 0.f, 0.f, 0.f, 0.f};
#pragma unroll
            for (int ks = 0; ks < 16; ++ks) acc[mt] = __builtin_amdgcn_mfma_f32_32x32x16_bf16(*(const XA_LAS bf16x8*)(kb + (32 * mt) * RP + 32 * ks), qf[ks], acc[mt], 0, 0, 0);
        }
        float mx = acc[0][0];
#pragma unroll
        for (int mt = 0; mt < 8; ++mt)
#pragma unroll
            for (int r = 0; r < 16; ++r) mx = fmaxf(mx, acc[mt][r]);
        mx = fmaxf(mx, __shfl_xor(mx, 32));
        float sum = 0.f;
#pragma unroll
        for (int mt = 0; mt < 8; ++mt)
#pragma unroll
            for (int r = 0; r < 16; ++r) { acc[mt][r] = __builtin_amdgcn_exp2f(acc[mt][r] - mx); sum += acc[mt][r]; }
        sum += __shfl_xor(sum, 32); inv = 1.f / sum;
#pragma unroll
        for (int mt = 0; mt < 8; ++mt)
#pragma unroll
            for (int s2 = 0; s2 < 2; ++s2) { u32x4 a; a.x = cvtpk(acc[mt][8 * s2], acc[mt][8 * s2 + 1]); a.y = cvtpk(acc[mt][8 * s2 + 2], acc[mt][8 * s2 + 3]); a.z = cvtpk(acc[mt][8 * s2 + 4], acc[mt][8 * s2 + 5]); a.w = cvtpk(acc[mt][8 * s2 + 6], acc[mt][8 * s2 + 7]);
                pf[mt][s2] = __builtin_bit_cast(bf16x8, a); }
    }
    __syncthreads();
    stage(lds, VcT + ((size_t)b * D + h * 256) * MEML, MEML, tid);
    __syncthreads();
    const XA_LAS unsigned char* vb = lds + c32 * RP + 8 * hh;
    bf16_t* op = XO + (size_t)tok * D + h * 256 + 4 * hh;
#pragma unroll 1
    for (int dt = 0; dt < 8; ++dt) {
        f32x16 acc = (f32x16){0.f, 0.f, 0.f, 0.f, 0.f, 0.f, 0.f, 0.f, 0.f, 0.f, 0.f, 0.f, 0.f, 0.f, 0.f, 0.f};
#pragma unroll
        for (int mt = 0; mt < 8; ++mt)
#pragma unroll
            for (int s2 = 0; s2 < 2; ++s2) {
                const s16x4 lo = *(const XA_LAS s16x4*)(vb + (32 * dt) * RP + (32 * mt + 16 * s2) * 2), hi = *(const XA_LAS s16x4*)(vb + (32 * dt) * RP + (32 * mt + 16 * s2 + 8) * 2);
                const bf16x8 vf = (bf16x8){lo[0], lo[1], lo[2], lo[3], hi[0], hi[1], hi[2], hi[3]};
                acc = __builtin_amdgcn_mfma_f32_32x32x16_bf16(vf, pf[mt][s2], acc, 0, 0, 0);
            }
#pragma unroll
        for (int q = 0; q < 4; ++q) { u32x2 o; o.x = cvtpk(acc[4 * q] * inv, acc[4 * q + 1] * inv); o.y = cvtpk(acc[4 * q + 2] * inv, acc[4 * q + 3] * inv); *(u32x2*)(op + 32 * dt + 8 * q) = o; }
    }
    __syncthreads();
}
}

namespace sp {
#define SP_LAS __attribute__((address_space(3)))
#define SP_LDSWAIT() do { asm volatile("s_waitcnt lgkmcnt(0)" ::: "memory"); } while (0)
__device__ __forceinline__ void transpose_item(const float* __restrict__ W, int ldw, int col0, int K, int nblk, bf16_t* __restrict__ WT, int row_off, SP_LAS float* scr, int item, int lane) {
    const int kb = item / nblk, nb = item % nblk, k0 = 64 * kb, n0 = 32 * nb;
#pragma unroll 8
    for (int i = 0; i < 32; ++i) { const int kk = 2 * i + (lane >> 5); scr[kk * 33 + (lane & 31)] = W[(size_t)(k0 + kk) * ldw + col0 + n0 + (lane & 31)]; }
    SP_LDSWAIT();
    const int cc = lane & 7;
#pragma unroll
    for (int j = 0; j < 4; ++j) { const int n = (lane >> 3) + 8 * j; const SP_LAS float* s = scr + (8 * cc) * 33 + n;
        u32x4 o; o.x = pk2(s[0 * 33], s[1 * 33]); o.y = pk2(s[2 * 33], s[3 * 33]); o.z = pk2(s[4 * 33], s[5 * 33]); o.w = pk2(s[6 * 33], s[7 * 33]);
        *(u32x4*)(WT + (size_t)(row_off + n0 + n) * K + k0 + 8 * cc) = o; }
    SP_LDSWAIT();
}
__device__ __forceinline__ void cvt_range(const float* __restrict__ src, bf16_t* __restrict__ dst, size_t n4, size_t gtid, size_t gthreads) {
    for (size_t i = gtid; i < n4; i += gthreads) { const f32x4 v = ((const f32x4*)src)[i]; u32x2 o; o.x = pk2(v.x, v.y); o.y = pk2(v.z, v.w); ((u32x2*)dst)[i] = o; }
}

__device__ __forceinline__ void cvt_fp8_range(const float* __restrict__ src, unsigned char* __restrict__ dst, size_t n16, float scale, size_t gtid, size_t gthreads) {
    for (size_t i = gtid; i < n16; i += gthreads) {
        const f32x4* sp4 = (const f32x4*)src + 4 * i; u32x4 o; unsigned ow[4];
#pragma unroll
        for (int q = 0; q < 4; ++q) { const f32x4 v = sp4[q];
            const float a = fminf(fmaxf(v.x * scale, -448.f), 448.f), b = fminf(fmaxf(v.y * scale, -448.f), 448.f), c2 = fminf(fmaxf(v.z * scale, -448.f), 448.f), d2 = fminf(fmaxf(v.w * scale, -448.f), 448.f);
            int p = 0; p = __builtin_amdgcn_cvt_pk_fp8_f32(a, b, p, false); p = __builtin_amdgcn_cvt_pk_fp8_f32(c2, d2, p, true); ow[q] = (unsigned)p; }
        o.x = ow[0]; o.y = ow[1]; o.z = ow[2]; o.w = ow[3];
        const size_t e_ = i >> 6, cg_ = i & 63; ((u32x4*)dst)[(cg_ >> 3) * ((size_t)PK * PK * 8) + e_ * 8 + (cg_ & 7)] = o;
    }
}
__device__ __forceinline__ void dt_stage_w(SP_LAS float* Wl, const float* __restrict__ w_in) {
    const int tid = opaque_tid();
#pragma unroll 8
    for (int i = 0; i < 64; ++i) { const int idx = tid + 512 * i; Wl[idx] = w_in[(size_t)(idx >> 5) * NIN + 5120 + (idx & 31)]; }
}
__device__ __forceinline__ void dt_items(SP_LAS float* Wl, SP_LAS float* xs, SP_LAS float* part, const float* __restrict__ x, const float* __restrict__ dt_bias, float* __restrict__ DT, bf16_t* __restrict__ XBo, int it0, int stride, int it_end) {
    const int tid = opaque_tid(), lane = tid & 63, w = tid >> 6;
    const int h = lane & 31, r = w >> 1, kq = (w & 1) * 2 + (lane >> 5);
    const SP_LAS float* xp = xs + r * 1024 + kq * 256; const SP_LAS float* wp = Wl + (kq * 256) * 32 + h;
    const float bias = dt_bias[h];
    f32x4 nx[2];
    if (it0 < it_end) {
#pragma unroll
        for (int i = 0; i < 2; ++i) nx[i] = ((const f32x4*)(x + (size_t)it0 * 4 * D))[tid + 512 * i];
    }
    for (int item = it0; item < it_end; item += stride) {
        const int m0 = item * 4;
#pragma unroll
        for (int i = 0; i < 2; ++i) { const int q = tid + 512 * i; const f32x4 v = nx[i]; *(SP_LAS f32x4*)(xs + 4 * q) = v;
            u32x2 o; o.x = pk2(v.x, v.y); o.y = pk2(v.z, v.w); ((u32x2*)(XBo + (size_t)m0 * D))[q] = o; }
        __syncthreads();
        { const int nitem = (item + stride < it_end) ? item + stride : item;
#pragma unroll
          for (int i = 0; i < 2; ++i) nx[i] = ((const f32x4*)(x + (size_t)nitem * 4 * D))[tid + 512 * i]; }
        float a0 = 0.f, a1 = 0.f;
#pragma unroll 8
        for (int k = 0; k < 256; k += 2) { a0 = fmaf(xp[k], wp[k * 32], a0); a1 = fmaf(xp[k + 1], wp[(k + 1) * 32], a1); }
        float acc = a0 + a1;
        acc += __shfl_xor(acc, 32);
        if ((w & 1) && lane < 32) part[r * 32 + h] = acc;
        __syncthreads();
        if (!(w & 1) && lane < 32) { const float v = acc + part[r * 32 + h] + bias; DT[(size_t)(m0 + r) * 32 + h] = v > 20.f ? v : log1pf(expf(v)); }
    }
}
__device__ __forceinline__ void ln_row(float* __restrict__ X, const float* __restrict__ g, const float* __restrict__ b, bf16_t* __restrict__ XB, int row, int lane) {
    f32x4* xr = (f32x4*)(X + (size_t)row * D) + lane;
    f32x4 v[4]; float s = 0.f;
#pragma unroll
    for (int j = 0; j < 4; ++j) { v[j] = xr[64 * j]; s += (v[j].x + v[j].y) + (v[j].z + v[j].w); }
    const float mean = wave_sum(s) * (1.f / D); float s2 = 0.f;
#pragma unroll
    for (int j = 0; j < 4; ++j) { v[j] = v[j] - mean; s2 += (v[j].x * v[j].x + v[j].y * v[j].y) + (v[j].z * v[j].z + v[j].w * v[j].w); }
    const float rstd = rsqrtf(wave_sum(s2) * (1.f / D) + 1e-5f);
#pragma unroll
    for (int j = 0; j < 4; ++j) { const int c = 4 * lane + 256 * j; const f32x4 gg = *(const f32x4*)(g + c), bb = *(const f32x4*)(b + c);
        f32x4 o = v[j] * rstd * gg + bb; xr[64 * j] = o;
        u32x2 pb; pb.x = pk2(o.x, o.y); pb.y = pk2(o.z, o.w); *(u32x2*)(XB + (size_t)row * D + c) = pb; }
}
__device__ __forceinline__ void xattn_pair(SP_LAS float* L, const bf16_t* __restrict__ QC, const bf16_t* __restrict__ KCVC, bf16_t* __restrict__ XO, int tok0) {
    const int t512 = opaque_tid(); const int half = t512 >> 8, tid = t512 & 255, lane = tid & 63, wv = tid >> 6, tok = tok0 + half, b = tok / SEQ;
    SP_LAS float* qs = L + half * 1024; SP_LAS float* ps = L + 2048 + half * 256; SP_LAS float* red = L + 2560 + half * 8;
    for (int i = tid; i < 1024; i += 256) qs[i] = bf2f(QC[(size_t)tok * D + i]);
    __syncthreads();
    const bf16_t* KV = KCVC + (size_t)b * MEML * 2048;
    for (int h = 0; h < MH; ++h) {
        const bf16_t* kp = KV + (size_t)tid * 2048 + h * 256;
        float s = 0.f;
        for (int d = 0; d < 256; d += 8) { const u32x4 w = *(const u32x4*)(kp + d); const SP_LAS float* q = qs + h * 256 + d;
            s += q[0] * bflo(w.x) + q[1] * bfhi(w.x) + q[2] * bflo(w.y) + q[3] * bfhi(w.y) + q[4] * bflo(w.z) + q[5] * bfhi(w.z) + q[6] * bflo(w.w) + q[7] * bfhi(w.w); }
        float mx = wave_max(s); if (lane == 0) red[wv] = mx; __syncthreads();
        mx = fmaxf(fmaxf(red[0], red[1]), fmaxf(red[2], red[3]));
        const float p = exp2f(s - mx);
        float sm = wave_sum(p); if (lane == 0) red[4 + wv] = sm; ps[tid] = p; __syncthreads();
        sm = (red[4] + red[5]) + (red[6] + red[7]);
        float o = 0.f;
        for (int j = 0; j < 256; ++j) o = fmaf(ps[j], bf2f(KV[(size_t)j * 2048 + 1024 + h * 256 + tid]), o);
        XO[(size_t)tok * D + h * 256 + tid] = (bf16_t)f2bf(o / sm);
        __syncthreads();
    }
}
__device__ __forceinline__ void select_pair(SP_LAS float* L, const bf16_t* __restrict__ QP, const bf16_t* __restrict__ SUBK, int* __restrict__ IDX, float* __restrict__ GATE, int tok0) {
    const int t512 = opaque_tid(); const int hf = t512 >> 8, tid = t512 & 255, tok = tok0 + hf;
    SP_LAS float* base = L + hf * 3072;
    SP_LAS float* qs = base; SP_LAS float* s = base + 2048; SP_LAS float* tops = base + 2304; SP_LAS int* topi = (SP_LAS int*)(base + 2336); SP_LAS float* cs = base + 2368; SP_LAS int* ci = (SP_LAS int*)(base + 2624);
    SP_LAS float* bs = base + 2880; SP_LAS int* bi = (SP_LAS int*)(base + 2896);
    for (int i = tid; i < 2048; i += 256) qs[i] = bf2f(QP[(size_t)tok * 2048 + i]);
    __syncthreads();
    for (int h = 0; h < PH; ++h) {
        const int half = tid >> 7, key = tid & 127;
        { const bf16_t* kp = SUBK + ((size_t)(h * 2 + half) * 128 + key) * 128; const SP_LAS float* q = qs + h * 256 + half * 128; float a = 0.f;
          for (int d = 0; d < 128; d += 8) { const u32x4 w = *(const u32x4*)(kp + d);
              a += q[d] * bflo(w.x) + q[d + 1] * bfhi(w.x) + q[d + 2] * bflo(w.y) + q[d + 3] * bfhi(w.y) + q[d + 4] * bflo(w.z) + q[d + 5] * bfhi(w.z) + q[d + 6] * bflo(w.w) + q[d + 7] * bfhi(w.w); }
          s[tid] = a; }
        __syncthreads();
        { const float me = s[tid]; int rank = 0; const SP_LAS float* spp = s + half * 128;
          for (int j = 0; j < 128; ++j) { const float o = spp[j]; rank += (o > me || (o == me && j < key)) ? 1 : 0; }
          if (rank < 16) { tops[half * 16 + rank] = me; topi[half * 16 + rank] = key; } }
        __syncthreads();
        { const int i = tid >> 4, j = tid & 15; cs[tid] = tops[i] + tops[16 + j]; ci[tid] = topi[i] * 128 + topi[16 + j]; }
        __syncthreads();
        { const float me = cs[tid]; int rank = 0;
          for (int j = 0; j < 256; ++j) { const float o = cs[j]; rank += (o > me || (o == me && j < tid)) ? 1 : 0; }
          if (rank < 16) { bs[rank] = me; bi[rank] = ci[tid]; } }
        __syncthreads();
        if (tid < 16) { const float mx = bs[0]; float sum = 0.f;
            for (int j = 0; j < 16; ++j) sum += expf(bs[j] - mx);
            GATE[(size_t)tok * 128 + h * 16 + tid] = expf(bs[tid] - mx) / sum; IDX[(size_t)tok * 128 + h * 16 + tid] = bi[tid]; }
        __syncthreads();
    }
}
__device__ __forceinline__ void gather_token(SP_LAS float* L, float* __restrict__ X, const bf16_t* __restrict__ PU, const bf16_t* __restrict__ PV, const int* __restrict__ IDX, const float* __restrict__ GATE,
                                             const float* __restrict__ g3, const float* __restrict__ b3, int tok) {
    const int tid = opaque_tid(), lane = tid & 63, wv = tid >> 6;
    SP_LAS float* ys = L; SP_LAS float* red = L + 8192;
    float xr[16], y[16];
    { const float* xp = X + (size_t)tok * D + lane * 16;
#pragma unroll
      for (int j = 0; j < 4; ++j) { const f32x4 v = *(const f32x4*)(xp + 4 * j); xr[4 * j] = v.x; xr[4 * j + 1] = v.y; xr[4 * j + 2] = v.z; xr[4 * j + 3] = v.w; }
#pragma unroll
      for (int j = 0; j < 16; ++j) y[j] = 0.f; }
    for (int e = 0; e < 16; ++e) {
        const int slot = wv * 16 + e; const int id = IDX[(size_t)tok * 128 + slot]; const float gt = GATE[(size_t)tok * 128 + slot];
        const bf16_t* up = PU + (size_t)id * D + lane * 16; const u32x4 u0 = *(const u32x4*)up, u1 = *(const u32x4*)(up + 8);
        const unsigned uw[8] = {u0.x, u0.y, u0.z, u0.w, u1.x, u1.y, u1.z, u1.w};
        float hsum = 0.f;
#pragma unroll
        for (int j = 0; j < 8; ++j) { hsum = fmaf(xr[2 * j], bflo(uw[j]), hsum); hsum = fmaf(xr[2 * j + 1], bfhi(uw[j]), hsum); }
        hsum = wave_sum(hsum);
        const float w = gt * 0.5f * hsum * (1.f + erff(hsum * 0.70710678118654752f));
        const bf16_t* vp = PV + (size_t)id * D + lane * 16; const u32x4 v0 = *(const u32x4*)vp, v1 = *(const u32x4*)(vp + 8);
        const unsigned vw[8] = {v0.x, v0.y, v0.z, v0.w, v1.x, v1.y, v1.z, v1.w};
#pragma unroll
        for (int j = 0; j < 8; ++j) { y[2 * j] = fmaf(w, bflo(vw[j]), y[2 * j]); y[2 * j + 1] = fmaf(w, bfhi(vw[j]), y[2 * j + 1]); }
    }
#pragma unroll
    for (int j = 0; j < 16; ++j) ys[wv * 1024 + lane * 16 + j] = y[j];
    __syncthreads();
    float v[2]; float s = 0.f;
#pragma unroll
    for (int j = 0; j < 2; ++j) { const int c = tid * 2 + j; float a = 0.f;
#pragma unroll
        for (int k = 0; k < 8; ++k) a += ys[k * 1024 + c];
        v[j] = ALPHA * X[(size_t)tok * D + c] + a; s += v[j]; }
    s = wave_sum(s); if (lane == 0) red[wv] = s; __syncthreads();
    float tot = 0.f;
#pragma unroll
    for (int k = 0; k < 8; ++k) tot += red[k];
    const float mean = tot * (1.f / D);
    float s2 = 0.f;
#pragma unroll
    for (int j = 0; j < 2; ++j) { v[j] -= mean; s2 += v[j] * v[j]; }
    s2 = wave_sum(s2); if (lane == 0) red[8 + wv] = s2; __syncthreads();
    float tot2 = 0.f;
#pragma unroll
    for (int k = 0; k < 8; ++k) tot2 += red[8 + k];
    const float rstd = rsqrtf(tot2 * (1.f / D) + 1e-5f);
#pragma unroll
    for (int j = 0; j < 2; ++j) { const int c = tid * 2 + j; X[(size_t)tok * D + c] = v[j] * rstd * g3[c] + b3[c]; }
    __syncthreads();
}

constexpr float PEER_SU = 2048.f, PEER_SV = 256.f;
typedef float f32x2v __attribute__((ext_vector_type(2)));
__device__ __forceinline__ void gather_wave(float* __restrict__ Xo, const float* X, const unsigned char* __restrict__ PU, const unsigned char* __restrict__ PV, const int* __restrict__ IDX, const float* __restrict__ GATE,
                                            const float* __restrict__ g3, const float* __restrict__ b3, int tok, int lane) {
    float xr[16], y[16];
    { const f32x4* xp = (const f32x4*)(X + (size_t)tok * D + 16 * lane);
#pragma unroll
      for (int q = 0; q < 4; ++q) { const f32x4 v = xp[q]; xr[4 * q] = v.x; xr[4 * q + 1] = v.y; xr[4 * q + 2] = v.z; xr[4 * q + 3] = v.w; } }
#pragma unroll
    for (int j = 0; j < 16; ++j) y[j] = 0.f;
    const int id0 = IDX[(size_t)tok * 128 + lane], id1 = IDX[(size_t)tok * 128 + 64 + lane];
    const float gt0 = GATE[(size_t)tok * 128 + lane], gt1 = GATE[(size_t)tok * 128 + 64 + lane];
    u32x4 ub[8], vb[8];
#define GW_ISSUE(buf, TBL, i) do { const int idv_ = ((i) < 8) ? id0 : id1; _Pragma("unroll") for (int k_ = 0; k_ < 8; ++k_) { \
        const int id_ = __builtin_amdgcn_readlane(idv_, (8 * (i) + k_) & 63); buf[k_] = *(const u32x4*)((TBL) + (size_t)id_ * D + 16 * lane); } } while (0)
    GW_ISSUE(ub, PU, 0); GW_ISSUE(vb, PV, 0);
    const bool h32 = (lane & 32) != 0, h16 = (lane & 16) != 0, h8 = (lane & 8) != 0;
#pragma unroll 1
    for (int i = 0; i < 16; ++i) {
        float p[8];
#pragma unroll
        for (int k = 0; k < 8; ++k) { const unsigned w[4] = {ub[k].x, ub[k].y, ub[k].z, ub[k].w}; float a = 0.f;
#pragma unroll
            for (int q = 0; q < 4; ++q) { const f32x2v lo = __builtin_amdgcn_cvt_pk_f32_fp8((int)w[q], false), hi = __builtin_amdgcn_cvt_pk_f32_fp8((int)w[q], true);
                a = fmaf(xr[4 * q], lo.x, a); a = fmaf(xr[4 * q + 1], lo.y, a); a = fmaf(xr[4 * q + 2], hi.x, a); a = fmaf(xr[4 * q + 3], hi.y, a); }
            p[k] = a; }
        { const int in_ = (i + 1 < 16) ? i + 1 : 15; GW_ISSUE(ub, PU, in_); }
        float q4[4], q2[2], q1;
#pragma unroll
        for (int k = 0; k < 4; ++k) q4[k] = (h32 ? p[k + 4] : p[k]) + __shfl_xor(h32 ? p[k] : p[k + 4], 32);
#pragma unroll
        for (int k = 0; k < 2; ++k) q2[k] = (h16 ? q4[k + 2] : q4[k]) + __shfl_xor(h16 ? q4[k] : q4[k + 2], 16);
        q1 = (h8 ? q2[1] : q2[0]) + __shfl_xor(h8 ? q2[0] : q2[1], 8);
        q1 += __shfl_xor(q1, 4); q1 += __shfl_xor(q1, 2); q1 += __shfl_xor(q1, 1);
        q1 *= (1.f / PEER_SU);
        const float gsel = __shfl((i < 8) ? gt0 : gt1, (8 * i + (lane >> 3)) & 63);
        const float wv = gsel * 0.5f * q1 * (1.f + erff(q1 * 0.70710678118654752f));
#pragma unroll
        for (int k = 0; k < 8; ++k) { const float wk = __builtin_bit_cast(float, __builtin_amdgcn_readlane(__builtin_bit_cast(int, wv), 8 * k));
            const unsigned w[4] = {vb[k].x, vb[k].y, vb[k].z, vb[k].w};
#pragma unroll
            for (int q = 0; q < 4; ++q) { const f32x2v lo = __builtin_amdgcn_cvt_pk_f32_fp8((int)w[q], false), hi = __builtin_amdgcn_cvt_pk_f32_fp8((int)w[q], true);
                y[4 * q] = fmaf(wk, lo.x, y[4 * q]); y[4 * q + 1] = fmaf(wk, lo.y, y[4 * q + 1]); y[4 * q + 2] = fmaf(wk, hi.x, y[4 * q + 2]); y[4 * q + 3] = fmaf(wk, hi.y, y[4 * q + 3]); } }
        { const int in_ = (i + 1 < 16) ? i + 1 : 15; GW_ISSUE(vb, PV, in_); }
    }
#undef GW_ISSUE
    float s = 0.f;
#pragma unroll
    for (int j = 0; j < 16; ++j) { y[j] = ALPHA * xr[j] + y[j] * (1.f / PEER_SV); s += y[j]; }
    const float mean = wave_sum(s) * (1.f / D); float s2 = 0.f;
#pragma unroll
    for (int j = 0; j < 16; ++j) { y[j] -= mean; s2 += y[j] * y[j]; }
    const float rstd = rsqrtf(wave_sum(s2) * (1.f / D) + 1e-5f);
    float* op = Xo + (size_t)tok * D + 16 * lane;
#pragma unroll
    for (int q = 0; q < 4; ++q) { const f32x4 gg = *(const f32x4*)(g3 + 16 * lane + 4 * q), bb = *(const f32x4*)(b3 + 16 * lane + 4 * q);
        f32x4 o; o.x = y[4 * q] * rstd * gg.x + bb.x; o.y = y[4 * q + 1] * rstd * gg.y + bb.y; o.z = y[4 * q + 2] * rstd * gg.z + bb.z; o.w = y[4 * q + 3] * rstd * gg.w + bb.w;
        *(f32x4*)(op + 4 * q) = o; }
}
}


#define LAS __attribute__((address_space(3)))
#define XB_TMO      128
#define XB_XCNT(j)  (256  + 64 * (j))
#define XB_XSUB(j)  (1280 + 64 * (j))
#define XB_XGEN(j)  (2304 + 64 * (j))
#define XB_TOP      3328
#define XB_TOPGEN   3392
#define XCD_BAR_WORDS 3456
#define XB_SPIN_CAP (1u << 18)
__device__ __forceinline__ unsigned xb_ld(unsigned* p)              { return __hip_atomic_load(p, __ATOMIC_RELAXED, __HIP_MEMORY_SCOPE_AGENT); }
__device__ __forceinline__ unsigned xb_add(unsigned* p, unsigned v) { return __hip_atomic_fetch_add(p, v, __ATOMIC_RELAXED, __HIP_MEMORY_SCOPE_AGENT); }
__device__ __forceinline__ unsigned xb_xcc_id() { return (unsigned)__builtin_amdgcn_s_getreg((3 << 11) | 20) & 0xFu; }
#define XB_SPIN(cond, bar) do { unsigned _sp = 0; while (cond) { __builtin_amdgcn_s_sleep(1); \
    if ((++_sp & 255u) == 0u) { if (xb_ld(&(bar)[XB_TMO])) break; if (_sp > XB_SPIN_CAP) { atomicAdd(&(bar)[XB_TMO], 1u); break; } } } } while (0)
struct XcdBarrier { unsigned* bar; unsigned x; volatile LAS unsigned* st; };
__device__ __forceinline__ XcdBarrier xcd_barrier_post(unsigned* bar, volatile LAS unsigned* st) {
    XcdBarrier b; b.bar = bar; b.x = xb_xcc_id(); b.st = st;
    if (threadIdx.x == 0) (void)xb_add(&bar[XB_XCNT(b.x)], 1u);
    return b;
}
__device__ __forceinline__ void xcd_barrier_complete(unsigned* bar, unsigned x, unsigned& nloc, unsigned& nx) {
    const unsigned G = gridDim.x * gridDim.y * gridDim.z;
    unsigned sum, cnt, mine, sp = 0u;
    for (;;) {
        sum = 0u; cnt = 0u; mine = 0u;
#pragma unroll
        for (unsigned j = 0; j < 16; ++j) { const unsigned c = xb_ld(&bar[XB_XCNT(j)]); sum += c; cnt += (c > 0u) ? 1u : 0u; mine = (j == x) ? c : mine; }
        if (sum == G) break;
        __builtin_amdgcn_s_sleep(1);
        if ((++sp & 255u) == 0u) { if (xb_ld(&bar[XB_TMO])) break; if (sp > XB_SPIN_CAP) { atomicAdd(&bar[XB_TMO], 1u); break; } }
    }
    nloc = mine > 0u ? mine : 1u; nx = cnt > 0u ? cnt : 1u;
}
__device__ __forceinline__ void xcd_barrier(const XcdBarrier& b) {
    asm volatile("s_waitcnt vmcnt(0)" ::: "memory");
    __syncthreads();
    if (threadIdx.x == 0) {
        unsigned* bar = b.bar;
        __builtin_amdgcn_s_waitcnt(0);
        unsigned nloc = b.st[0], nx = b.st[1];
        if (nloc == 0u) { xcd_barrier_complete(bar, b.x, nloc, nx); b.st[0] = nloc; b.st[1] = nx; }
        const unsigned old = xb_add(&bar[XB_XSUB(b.x)], 1u);
        const unsigned gen = old / nloc;
        if (old + 1u == (gen + 1u) * nloc) {
            __builtin_amdgcn_fence(__ATOMIC_RELEASE, "agent");
            asm volatile("s_waitcnt vmcnt(0)" ::: "memory");
            const unsigned og = xb_add(&bar[XB_TOP], 1u);
            const unsigned tg = og / nx;
            if (og + 1u == (tg + 1u) * nx) xb_add(&bar[XB_TOPGEN], 1u);
            else XB_SPIN(xb_ld(&bar[XB_TOPGEN]) == tg, bar);
            __builtin_amdgcn_fence(__ATOMIC_ACQUIRE, "agent");
            xb_add(&bar[XB_XGEN(b.x)], 1u);
            asm volatile("s_waitcnt vmcnt(0)" ::: "memory");
        } else {
            XB_SPIN(xb_ld(&bar[XB_XGEN(b.x)]) == gen, bar);
            __builtin_amdgcn_fence(__ATOMIC_ACQUIRE, "agent");
            asm volatile("s_waitcnt vmcnt(0)" ::: "memory");
        }
    }
    __syncthreads();
}
constexpr int CW_BAR = 4096;
constexpr int MISC_OFF = 147456;


namespace peer2 {
#define P2_LAS __attribute__((address_space(3)))
typedef float f32x2v __attribute__((ext_vector_type(2)));
constexpr int CW_TICK = 8192;
__device__ __forceinline__ float dpp_add_xor1(float v) { return v + __builtin_bit_cast(float, __builtin_amdgcn_update_dpp(0, __builtin_bit_cast(int, v), 0xB1, 0xf, 0xf, true)); }
__device__ __forceinline__ float dpp_add_xor2(float v) { return v + __builtin_bit_cast(float, __builtin_amdgcn_update_dpp(0, __builtin_bit_cast(int, v), 0x4E, 0xf, 0xf, true)); }
__device__ __forceinline__ float dpp_add_hmir(float v) { return v + __builtin_bit_cast(float, __builtin_amdgcn_update_dpp(0, __builtin_bit_cast(int, v), 0x141, 0xf, 0xf, true)); }
__device__ __forceinline__ float dpp_ror8(float v) { return __builtin_bit_cast(float, __builtin_amdgcn_update_dpp(0, __builtin_bit_cast(int, v), 0x128, 0xf, 0xf, true)); }
__device__ __forceinline__ float swap32_sum(float a, float b) { auto r = __builtin_amdgcn_permlane32_swap(__builtin_bit_cast(unsigned, a), __builtin_bit_cast(unsigned, b), false, false); return __builtin_bit_cast(float, r[0]) + __builtin_bit_cast(float, r[1]); }
struct Own { int j, rank, nrank, nsl; };
__device__ __forceinline__ Own ownership(unsigned* ctl, P2_LAS unsigned* scr, int phase, int wave) {
    const int G = gridDim.x;
    if (threadIdx.x == 0) {
        unsigned* bar = ctl + CW_BAR; bool uni = (G % 8) == 0;
        for (int j = 0; j < 8; ++j) uni = uni && (xb_ld(&bar[XB_XCNT(j)]) == (unsigned)(G / 8));
        const unsigned xcc = xb_xcc_id();
        if (uni && xcc < 8u) { scr[0] = xcc; scr[1] = xb_add(&ctl[CW_TICK + 64 * (8 * phase + (int)xcc)], 1u); }
        else { scr[0] = blockIdx.x & 7; scr[1] = blockIdx.x >> 3; }
    }
    __syncthreads();
    Own o;
    if (G % 8 == 0) { o.j = (int)scr[0]; o.rank = (int)scr[1] * 8 + wave; o.nrank = G; o.nsl = 8; }
    else { o.j = 0; o.rank = blockIdx.x * 8 + wave; o.nrank = G * 8; o.nsl = 1; }
    return o;
}
__device__ __forceinline__ float dot16_fp8(const float (&x)[16], const u32x4 u) {
    const unsigned w[4] = {u.x, u.y, u.z, u.w}; f32x2v a = {0.f, 0.f};
#pragma unroll
    for (int q = 0; q < 4; ++q) { const f32x2v lo = __builtin_amdgcn_cvt_pk_f32_fp8((int)w[q], false), hi = __builtin_amdgcn_cvt_pk_f32_fp8((int)w[q], true);
        a = __builtin_elementwise_fma((f32x2v){x[4 * q], x[4 * q + 1]}, lo, a); a = __builtin_elementwise_fma((f32x2v){x[4 * q + 2], x[4 * q + 3]}, hi, a); }
    return a.x + a.y;
}
__device__ __forceinline__ void u_wave(const float* __restrict__ X, const unsigned char* __restrict__ PU, const int* __restrict__ IDX, float* __restrict__ PART, int j, int rank, int nrank, int lane) {
    const int sub = lane & 7, grp = lane >> 3, col0 = 128 * j + 16 * sub;
    float* part = PART + (size_t)j * M * 128 + 16 * grp;
#define PU_LOADIDX(idv, xv, t_) do { const int tt_ = ((t_) < M) ? (t_) : (M - 1); const u32x4* ip_ = (const u32x4*)(IDX + (size_t)tt_ * 128 + 16 * grp); \
        _Pragma("unroll") for (int q_ = 0; q_ < 4; ++q_) { const u32x4 v_ = ip_[q_]; idv[4 * q_] = (int)v_.x; idv[4 * q_ + 1] = (int)v_.y; idv[4 * q_ + 2] = (int)v_.z; idv[4 * q_ + 3] = (int)v_.w; } \
        const f32x4* xp_ = (const f32x4*)(X + (size_t)tt_ * D + col0); \
        _Pragma("unroll") for (int q_ = 0; q_ < 4; ++q_) { const f32x4 v_ = xp_[q_]; xv[4 * q_] = v_.x; xv[4 * q_ + 1] = v_.y; xv[4 * q_ + 2] = v_.z; xv[4 * q_ + 3] = v_.w; } } while (0)
#define PU_GATHER(ubv, idv) do { _Pragma("unroll") for (int it_ = 0; it_ < 16; ++it_) ubv[it_] = *(const u32x4*)(PU + (size_t)j * (PK * PK * 128) + (size_t)idv[it_] * 128 + 16 * sub); } while (0)
#define PU_COMPUTE(ubv, xv, t_) do { float k0_ = 0.f, k1_ = 0.f; _Pragma("unroll") for (int it_ = 0; it_ < 16; ++it_) { float a_ = dot16_fp8(xv, ubv[it_]); a_ = dpp_add_xor1(a_); a_ = dpp_add_xor2(a_); a_ = dpp_add_hmir(a_); \
            if (it_ < 8) k0_ = ((it_ & 7) == sub) ? a_ : k0_; else k1_ = ((it_ & 7) == sub) ? a_ : k1_; } \
        if ((t_) < M) { part[(size_t)(t_) * 128 + sub] = k0_; part[(size_t)(t_) * 128 + sub + 8] = k1_; } } while (0)
    int idA[16], idB[16]; float xA[16], xB[16], xc[16]; u32x4 ubA[16], ubB[16];
    int t = rank;
    PU_LOADIDX(idA, xA, t); PU_GATHER(ubA, idA);
    PU_LOADIDX(idB, xB, t + nrank);
    for (; t < M; t += 2 * nrank) {
        PU_GATHER(ubB, idB);
#pragma unroll
        for (int q = 0; q < 16; ++q) xc[q] = xA[q];
        PU_LOADIDX(idA, xA, t + 2 * nrank);
        PU_COMPUTE(ubA, xc, t);
        PU_GATHER(ubA, idA);
#pragma unroll
        for (int q = 0; q < 16; ++q) xc[q] = xB[q];
        PU_LOADIDX(idB, xB, t + 3 * nrank);
        PU_COMPUTE(ubB, xc, t + nrank);
    }
#undef PU_LOADIDX
#undef PU_GATHER
#undef PU_COMPUTE
}
__device__ __forceinline__ void v_wave(float* __restrict__ X, const unsigned char* __restrict__ PV, const int* __restrict__ IDX, const float* __restrict__ GATE, const float* __restrict__ PART, P2_LAS float* wbuf, int j, int rank, int nrank, int lane) {
    const int sub = lane & 7, grp = lane >> 3, col0 = 128 * j + 16 * sub;
    const bool h32 = (lane & 32) != 0, h16 = (lane & 16) != 0, h8 = (lane & 8) != 0; const int cq = ((lane >> 5) & 1) * 8 + ((lane >> 4) & 1) * 4 + ((lane >> 3) & 1) * 2;
#define PV_ISSUE(vbv, hv, gv, t_) do { const int tt_ = ((t_) < M) ? (t_) : (M - 1); int id_[16]; const u32x4* ip_ = (const u32x4*)(IDX + (size_t)tt_ * 128 + 16 * grp); \
        _Pragma("unroll") for (int q_ = 0; q_ < 4; ++q_) { const u32x4 v_ = ip_[q_]; id_[4 * q_] = (int)v_.x; id_[4 * q_ + 1] = (int)v_.y; id_[4 * q_ + 2] = (int)v_.z; id_[4 * q_ + 3] = (int)v_.w; } \
        _Pragma("unroll") for (int it_ = 0; it_ < 16; ++it_) vbv[it_] = *(const u32x4*)(PV + (size_t)j * (PK * PK * 128) + (size_t)id_[it_] * 128 + 16 * sub); \
        _Pragma("unroll") for (int jj_ = 0; jj_ < 8; ++jj_) { const float* pp_ = PART + ((size_t)jj_ * M + tt_) * 128; hv[2 * jj_] = pp_[lane]; hv[2 * jj_ + 1] = pp_[64 + lane]; } \
        gv[0] = GATE[(size_t)tt_ * 128 + lane]; gv[1] = GATE[(size_t)tt_ * 128 + 64 + lane]; } while (0)
#define PV_COMPUTE(vbv, hv, gv, t_) do { float h0_ = 0.f, h1_ = 0.f; _Pragma("unroll") for (int jj_ = 0; jj_ < 8; ++jj_) { h0_ += hv[2 * jj_]; h1_ += hv[2 * jj_ + 1]; } \
        h0_ *= (1.f / sp::PEER_SU); h1_ *= (1.f / sp::PEER_SU); \
        const float w0_ = gv[0] * 0.5f * h0_ * (1.f + erff(h0_ * 0.70710678118654752f)), w1_ = gv[1] * 0.5f * h1_ * (1.f + erff(h1_ * 0.70710678118654752f)); \
        f32x2v y_[8]; _Pragma("unroll") for (int q_ = 0; q_ < 8; ++q_) y_[q_] = (f32x2v){0.f, 0.f}; \
        wbuf[lane] = w0_; wbuf[64 + lane] = w1_; asm volatile("s_waitcnt lgkmcnt(0)" ::: "memory");        \
        float wl_[16]; _Pragma("unroll") for (int q_ = 0; q_ < 4; ++q_) { const f32x4 v_ = *(const P2_LAS f32x4*)(wbuf + 16 * grp + 4 * q_); wl_[4 * q_] = v_.x; wl_[4 * q_ + 1] = v_.y; wl_[4 * q_ + 2] = v_.z; wl_[4 * q_ + 3] = v_.w; } \
        asm volatile("s_waitcnt lgkmcnt(0)" ::: "memory"); \
        _Pragma("unroll") for (int it_ = 0; it_ < 16; ++it_) { const float wq_ = wl_[it_]; \
            const unsigned ww_[4] = {vbv[it_].x, vbv[it_].y, vbv[it_].z, vbv[it_].w}; const f32x2v wv_ = {wq_, wq_}; \
            _Pragma("unroll") for (int q_ = 0; q_ < 4; ++q_) { y_[2 * q_] = __builtin_elementwise_fma(wv_, __builtin_amdgcn_cvt_pk_f32_fp8((int)ww_[q_], false), y_[2 * q_]); y_[2 * q_ + 1] = __builtin_elementwise_fma(wv_, __builtin_amdgcn_cvt_pk_f32_fp8((int)ww_[q_], true), y_[2 * q_ + 1]); } } \
        float yy_[16]; _Pragma("unroll") for (int k_ = 0; k_ < 8; ++k_) { yy_[2 * k_] = y_[k_].x; yy_[2 * k_ + 1] = y_[k_].y; } \
          \
        float y8_[8], y4_[4], y2_[2]; \
        _Pragma("unroll") for (int k_ = 0; k_ < 8; ++k_) y8_[k_] = (h32 ? yy_[k_ + 8] : yy_[k_]) + __shfl_xor(h32 ? yy_[k_] : yy_[k_ + 8], 32); \
        _Pragma("unroll") for (int k_ = 0; k_ < 4; ++k_) y4_[k_] = (h16 ? y8_[k_ + 4] : y8_[k_]) + __shfl_xor(h16 ? y8_[k_] : y8_[k_ + 4], 16); \
        _Pragma("unroll") for (int k_ = 0; k_ < 2; ++k_) y2_[k_] = (h8 ? y4_[k_ + 2] : y4_[k_]) + dpp_ror8(h8 ? y4_[k_] : y4_[k_ + 2]); \
        if ((t_) < M) { f32x2v* xp_ = (f32x2v*)(X + (size_t)(t_) * D + col0 + cq); f32x2v xv_ = *xp_; \
            xv_.x = ALPHA * xv_.x + y2_[0] * (1.f / sp::PEER_SV); xv_.y = ALPHA * xv_.y + y2_[1] * (1.f / sp::PEER_SV); *xp_ = xv_; } } while (0)
    u32x4 vbA[16], vbB[16]; float hA[16], hB[16], gA[2], gB[2];
    int t = rank;
    PV_ISSUE(vbA, hA, gA, t);
    for (; t < M; t += 2 * nrank) {
        PV_ISSUE(vbB, hB, gB, t + nrank);
        PV_COMPUTE(vbA, hA, gA, t);
        PV_ISSUE(vbA, hA, gA, t + 2 * nrank);
        PV_COMPUTE(vbB, hB, gB, t + nrank);
    }
#undef PV_ISSUE
#undef PV_COMPUTE
}
__device__ __forceinline__ void ln_row_plain(float* __restrict__ X, const float* __restrict__ g, const float* __restrict__ b, int row, int lane) {
    f32x4* xr = (f32x4*)(X + (size_t)row * D) + lane;
    f32x4 v[4]; float s = 0.f;
#pragma unroll
    for (int jq = 0; jq < 4; ++jq) { v[jq] = xr[64 * jq]; s += (v[jq].x + v[jq].y) + (v[jq].z + v[jq].w); }
    const float mean = wave_sum(s) * (1.f / D); float s2 = 0.f;
#pragma unroll
    for (int jq = 0; jq < 4; ++jq) { v[jq] = v[jq] - mean; s2 += (v[jq].x * v[jq].x + v[jq].y * v[jq].y) + (v[jq].z * v[jq].z + v[jq].w * v[jq].w); }
    const float rstd = rsqrtf(wave_sum(s2) * (1.f / D) + 1e-5f);
#pragma unroll
    for (int jq = 0; jq < 4; ++jq) { const int c = 4 * lane + 256 * jq; const f32x4 gg = *(const f32x4*)(g + c), bb = *(const f32x4*)(b + c); xr[64 * jq] = v[jq] * rstd * gg + bb; }
}
}

struct Params { const float* in[30]; float* out; unsigned char* ws; };
template <class F> __device__ __forceinline__ void run_gemm(unsigned char* lds, const bf16_t* A, int lda, const bf16_t* Bt, int Mr, int N, int K, F f, int cshift = 0) {
    pg8::Gemm g{A, Bt, Mr, N, K, lda}; pg8::StaticOrder S; S.init(Mr, N, gridDim.x, (int)((blockIdx.x + gridDim.x - (unsigned)cshift) % gridDim.x)); pg8::EpiAdapt<F> E{f};
    pg8::gemm_phase<pg8::EpiAdapt<F>, pg8::StaticOrder, true>((PG8_LAS unsigned char*)lds, g, S, E);
}
#ifndef PROBE_ATTN
#define PROBE_ATTN 0
#endif
#ifndef PROBE_SSD
#define PROBE_SSD 0
#endif
#ifndef PROBE_SYNC
#define PROBE_SYNC 0
#endif
#define KA_LAS __attribute__((address_space(4)))
#define PH_BEGIN const KA_LAS unsigned char* ka_ = (const KA_LAS unsigned char*)__builtin_amdgcn_kernarg_segment_ptr(); asm volatile("" : "+s"(ka_))
#define PIN(k) (*(const float* const KA_LAS*)(ka_ + 8 * (k)))
#define POUT (*(float* const KA_LAS*)(ka_ + 240))
#define PWS (*(unsigned char* const KA_LAS*)(ka_ + 248))
__global__ void __launch_bounds__(512, 2) hybrid_fwd(Params P) {
    extern __shared__ __attribute__((aligned(16))) unsigned char lds[];
    cg::grid_group grid = cg::this_grid();
    { PH_BEGIN; volatile LAS unsigned* misc = (volatile LAS unsigned*)((LAS unsigned char*)lds + MISC_OFF);
      if (threadIdx.x < 16) misc[threadIdx.x] = 0u;
      __syncthreads();
      (void)xcd_barrier_post((unsigned*)(PWS + WS_CTL) + CW_BAR, misc);
      if (PWS == nullptr) grid.sync(); }
#define GSYNC() do { PH_BEGIN; XcdBarrier xb_; xb_.bar = (unsigned*)(PWS + WS_CTL) + CW_BAR; xb_.x = xb_xcc_id(); xb_.st = (volatile LAS unsigned*)((LAS unsigned char*)lds + MISC_OFF); xcd_barrier(xb_); } while (0)
    {
        PH_BEGIN; unsigned char* ws = PWS;
        const int tid = opaque_tid(), lane = tid & 63, wave = __builtin_amdgcn_readfirstlane(tid >> 6), c = blockIdx.x, G = gridDim.x;
        const size_t gtid = (size_t)c * 512 + tid, gthreads = (size_t)G * 512; const int gw = c * 8 + wave, NGW = G * 8;
        const float* w_in = PIN(2);
        bf16_t* WinT = (bf16_t*)(ws + WS_WIN); bf16_t* WckvT = (bf16_t*)(ws + WS_WCKV);
        SP_LAS float* scr = (SP_LAS float*)lds + wave * (64 * 33);
        constexpr int I0 = 2560, I1 = 5120, I2 = 6144, I3 = 6656, I4 = 7168, I5 = 7680, I6 = 8192, I7 = 8704, I8 = 9216, I9 = 10240;
        for (int it = gw; it < I9; it += NGW) {
            if (it < I0) sp::transpose_item(w_in, NIN, 0, D, 160, WinT, 0, scr, it, lane);
            else if (it < I1) sp::transpose_item(w_in, NIN, 5152, D, 160, WinT, 5120, scr, it - I0, lane);
            else if (it < I2) sp::transpose_item(PIN(9), D, 0, DI, 32, (bf16_t*)(ws + WS_WSSD), 0, scr, it - I1, lane);
            else if (it < I3) sp::transpose_item(PIN(13), D, 0, D, 32, (bf16_t*)(ws + WS_WDIFF), 0, scr, it - I2, lane);
            else if (it < I4) sp::transpose_item(PIN(15), D, 0, D, 32, (bf16_t*)(ws + WS_WO), 0, scr, it - I3, lane);
            else if (it < I5) sp::transpose_item(PIN(18), D, 0, D, 32, (bf16_t*)(ws + WS_WCQ), 0, scr, it - I4, lane);
            else if (it < I6) sp::transpose_item(PIN(19), D, 0, D, 32, WckvT, 0, scr, it - I5, lane);
            else if (it < I7) sp::transpose_item(PIN(20), D, 0, D, 32, WckvT, 1024, scr, it - I6, lane);
            else if (it < I8) sp::transpose_item(PIN(21), D, 0, D, 32, (bf16_t*)(ws + WS_WCO), 0, scr, it - I7, lane);
            else sp::transpose_item(PIN(24), 2048, 0, D, 64, (bf16_t*)(ws + WS_WPQ), 0, scr, it - I8, lane);
        }
        const float* x = PIN(0);
        sp::cvt_range(PIN(1), (bf16_t*)(ws + WS_MEMB), (size_t)BATCH * MEML * D / 4, gtid, gthreads);
        sp::cvt_range(PIN(25), (bf16_t*)(ws + WS_SUBK), (size_t)PH * 2 * PK * PHALF / 4, gtid, gthreads);
        __syncthreads();
        sp::dt_stage_w((SP_LAS float*)lds, w_in);
        sp::dt_items((SP_LAS float*)lds, (SP_LAS float*)lds + 32768, (SP_LAS float*)lds + 36896  , x, PIN(5), (float*)(ws + WS_DT), (bf16_t*)(ws + WS_XB), c, G, M / 4);
        __syncthreads();
        if (c == 0 && tid == 0) { const float* lam_q = PIN(10); const float* lam_k = PIN(11); float s0 = 0.f, s1 = 0.f;
            for (int i = 0; i < 64; ++i) { s0 += lam_q[i] * lam_k[i]; s1 += lam_q[64 + i] * lam_k[64 + i]; }
            ((float*)(ws + WS_CTL))[CW_LAM] = expf(s0) - expf(s1) + LAMBDA_INIT; }
    }
    GSYNC();
    { PH_BEGIN; unsigned char* ws = PWS;
      run_gemm(lds, (const bf16_t*)(ws + WS_XB), D, (const bf16_t*)(ws + WS_WIN), SEQ, NINP, D, EpiInProj{(bf16_t*)(ws + WS_H), PIN(14)}); }
    GSYNC();
#pragma unroll 1
    for (int b = 0; b < BATCH; ++b) {
        { PH_BEGIN; unsigned char* ws = PWS; const int c = blockIdx.x, G = gridDim.x;
          bf16_t* H = (bf16_t*)(ws + WS_H); const float* DTb = (const float*)(ws + WS_DT) + (size_t)b * SEQ * 32;
          for (int u = c; u < 256; u += G) ssd::phaseA_unit((SS_LAS unsigned char*)lds, H, DTb, PIN(3), PIN(4), PIN(6), (bf16_t*)(ws + WS_T1), (float*)(ws + WS_CTL) + 1024, u >> 2, u & 3);
          const float lam = ((const float*)(ws + WS_CTL))[CW_LAM]; const float* subln_w = PIN(12);
#if PROBE_ATTN
          for (int u = c; u < 256; u += G) { const int h = u >> 5, j = u & 31;
              dattn::unit<false>((DA_LAS unsigned char*)lds, H, h, 63 - j, subln_w, lam);
              dattn::unit<false>((DA_LAS unsigned char*)lds, H, h, j, subln_w, lam); }
#endif
          for (int u = c; u < 256; u += G) { const int h = u >> 5, j = u & 31;
              dattn::unit((DA_LAS unsigned char*)lds, H, h, 63 - j, subln_w, lam);
              dattn::unit((DA_LAS unsigned char*)lds, H, h, j, subln_w, lam); } }
        GSYNC();
        { PH_BEGIN; unsigned char* ws = PWS; const int tid = opaque_tid();
          for (size_t i = (size_t)blockIdx.x * 512 + tid; i < 131072; i += (size_t)gridDim.x * 512) ssd::scan_phase((bf16_t*)(ws + WS_T1), (const float*)(ws + WS_CTL) + 1024, (int)i); }
        GSYNC();
        { PH_BEGIN; unsigned char* ws = PWS; const int c = blockIdx.x, G = gridDim.x;
#if PROBE_SSD
          for (int u = c; u < 256; u += G) ssd::phaseA_unit((SS_LAS unsigned char*)lds, (bf16_t*)(ws + WS_H), (const float*)(ws + WS_DT) + (size_t)b * SEQ * 32, PIN(3), PIN(4), PIN(6), (bf16_t*)(POUT + (size_t)SEQ * D), (float*)(ws + WS_CTL) + 8192, u >> 2, u & 3);
          for (int u = c; u < 256; u += G) ssd::phaseC_unit<false>((SS_LAS unsigned char*)lds, (bf16_t*)(ws + WS_H), (const float*)(ws + WS_DT) + (size_t)b * SEQ * 32, PIN(3), PIN(4), PIN(6), PIN(7), PIN(8), (const bf16_t*)(ws + WS_T1), u >> 2, u & 3);
#endif
          for (int u = c; u < 256; u += G) ssd::phaseC_unit((SS_LAS unsigned char*)lds, (bf16_t*)(ws + WS_H), (const float*)(ws + WS_DT) + (size_t)b * SEQ * 32, PIN(3), PIN(4), PIN(6), PIN(7), PIN(8), (const bf16_t*)(ws + WS_T1), u >> 2, u & 3); }
        GSYNC();
        { PH_BEGIN; unsigned char* ws = PWS; bf16_t* H = (bf16_t*)(ws + WS_H); float* T1 = (float*)(ws + WS_T1);
          run_gemm(lds, H + HC_Z, HP_, (const bf16_t*)(ws + WS_WSSD), SEQ, D, DI, EpiGate1{H, T1});
          run_gemm(lds, H + HC_Q, HP_, (const bf16_t*)(ws + WS_WDIFF), SEQ, D, D, EpiGate2{H, T1});
          if (b == 0) {
              const int hs = (int)gridDim.x / 2;
              run_gemm(lds, (const bf16_t*)(ws + WS_MEMB), D, (const bf16_t*)(ws + WS_WCKV), BATCH * MEML, D, D, EpiPlain{(bf16_t*)(ws + WS_KCVC), D, 1.f}, hs);
              for (int bb = 0; bb < BATCH; ++bb)
                  run_gemm(lds, (const bf16_t*)(ws + WS_WCKV) + (size_t)D * D, D, (const bf16_t*)(ws + WS_MEMB) + (size_t)bb * MEML * D, D, MEML, D, EpiPlain{(bf16_t*)(ws + WS_KCVC) + (size_t)BATCH * MEML * D + (size_t)bb * D * MEML, MEML, 1.f}, hs + 8 + 4 * bb);
          }
          if (b == BATCH - 1 && 2 * (int)blockIdx.x >= (int)gridDim.x) { const int tid = opaque_tid(); const int half = (gridDim.x + 1) / 2;
              const size_t gt = (size_t)(blockIdx.x - half) * 512 + tid, gn = (size_t)(gridDim.x - half) * 512;
              sp::cvt_fp8_range(PIN(26), ws + WS_PU, (size_t)PK * PK * D / 16, sp::PEER_SU, gt, gn);
              sp::cvt_fp8_range(PIN(27), ws + WS_PV, (size_t)PK * PK * D / 16, sp::PEER_SV, gt, gn); } }
        GSYNC();
        { PH_BEGIN; unsigned char* ws = PWS;
          run_gemm(lds, (const bf16_t*)(ws + WS_H) + HC_K, HP_, (const bf16_t*)(ws + WS_WO), SEQ, D, D, EpiResid{PIN(0), POUT, b * SEQ, 0}); }
        GSYNC();
        if (b + 1 < BATCH) {
            { PH_BEGIN; unsigned char* ws = PWS;
              run_gemm(lds, (const bf16_t*)(ws + WS_XB) + (size_t)(b + 1) * SEQ * D, D, (const bf16_t*)(ws + WS_WIN), SEQ, NINP, D, EpiInProj{(bf16_t*)(ws + WS_H), PIN(14)}); }
            GSYNC();
        }
    }
    { PH_BEGIN; unsigned char* ws = PWS; const int tid = opaque_tid(), lane = tid & 63, wave = __builtin_amdgcn_readfirstlane(tid >> 6), c = blockIdx.x, G = gridDim.x;
      float* out = POUT; const float* g = PIN(16); const float* bb = PIN(17); bf16_t* XB = (bf16_t*)(ws + WS_X1B);
      for (int r = c * 8 + wave; r < M; r += G * 8) sp::ln_row(out, g, bb, XB, r, lane); }
    GSYNC();
    { PH_BEGIN; unsigned char* ws = PWS;
      run_gemm(lds, (const bf16_t*)(ws + WS_X1B), D, (const bf16_t*)(ws + WS_WCQ), M, D, D, EpiPlain{(bf16_t*)(ws + WS_QC), D, CQSCALE}); }
    GSYNC();
    { PH_BEGIN; unsigned char* ws = PWS; const int c = blockIdx.x, G = gridDim.x;
      for (int u = c; u < 256; u += G) xattn::unit((XA_LAS unsigned char*)lds, (const bf16_t*)(ws + WS_QC), (const bf16_t*)(ws + WS_KCVC), (const bf16_t*)(ws + WS_KCVC) + (size_t)BATCH * MEML * D, (bf16_t*)(ws + WS_XO), u >> 2, u & 3); }
    GSYNC();
    { PH_BEGIN; unsigned char* ws = PWS; float* out = POUT;
      run_gemm(lds, (const bf16_t*)(ws + WS_XO), D, (const bf16_t*)(ws + WS_WCO), M, D, D, EpiResid{out, out, 0, 0}); }
    GSYNC();
    { PH_BEGIN; unsigned char* ws = PWS; const int tid = opaque_tid(), lane = tid & 63, wave = __builtin_amdgcn_readfirstlane(tid >> 6), c = blockIdx.x, G = gridDim.x;
      float* out = POUT; const float* g = PIN(22); const float* bb = PIN(23); bf16_t* XB = (bf16_t*)(ws + WS_X1B);
      for (int r = c * 8 + wave; r < M; r += G * 8) sp::ln_row(out, g, bb, XB, r, lane); }
    GSYNC();
    { PH_BEGIN; unsigned char* ws = PWS;
      run_gemm(lds, (const bf16_t*)(ws + WS_X1B), D, (const bf16_t*)(ws + WS_WPQ), M, 2048, D, EpiPlain{(bf16_t*)(ws + WS_QP), 2048, 1.f}); }
    GSYNC();
    { PH_BEGIN; unsigned char* ws = PWS; const int c = blockIdx.x, G = gridDim.x;
      for (int t = 64 * c; t < M; t += 64 * G) {
          for (int hp = 0; hp < 4; ++hp) psel::stage1((PS_LAS int*)lds, (const bf16_t*)(ws + WS_QP), (const bf16_t*)(ws + WS_SUBK), t, hp);
          __syncthreads();
          psel::stage2((PS_LAS int*)lds, (int*)(ws + WS_IDX), (float*)(ws + WS_GATE), t);
          __syncthreads(); } }
    GSYNC();
    { PH_BEGIN; unsigned char* ws = PWS; const int tid = opaque_tid(), lane = tid & 63, wave = __builtin_amdgcn_readfirstlane(tid >> 6);
      const peer2::Own o = peer2::ownership((unsigned*)(ws + WS_CTL), (P2_LAS unsigned*)lds, 0, wave);
      for (int jj = o.j; jj < 8; jj += o.nsl) peer2::u_wave(POUT, ws + WS_PU, (const int*)(ws + WS_IDX), (float*)(ws + WS_PART), jj, o.rank, o.nrank, lane); }
    GSYNC();
    { PH_BEGIN; unsigned char* ws = PWS; const int tid = opaque_tid(), lane = tid & 63, wave = __builtin_amdgcn_readfirstlane(tid >> 6);
      const peer2::Own o = peer2::ownership((unsigned*)(ws + WS_CTL), (P2_LAS unsigned*)lds, 1, wave);
      for (int jj = o.j; jj < 8; jj += o.nsl) peer2::v_wave(POUT, ws + WS_PV, (const int*)(ws + WS_IDX), (const float*)(ws + WS_GATE), (const float*)(ws + WS_PART), (P2_LAS float*)lds + 64 + wave * 128, jj, o.rank, o.nrank, lane); }
    GSYNC();
    { PH_BEGIN; const int tid = opaque_tid(), lane = tid & 63, wave = __builtin_amdgcn_readfirstlane(tid >> 6);
      float* out = POUT; const float* g3 = PIN(28); const float* b3 = PIN(29);
      for (int r = blockIdx.x * 8 + wave; r < M; r += gridDim.x * 8) peer2::ln_row_plain(out, g3, b3, r, lane); }
}

extern "C" void kernel_launch(void* const* d_in, const int* in_sizes, int n_in, void* d_out, int out_size, void* d_ws, size_t ws_size, hipStream_t stream) {
    static int grid_blocks = 0;
    if (grid_blocks == 0) {
        if (n_in != 30 || out_size != M * D || ws_size < WS_END) { fprintf(stderr, "kernel_launch: unexpected sizes n_in %d out %d ws %zu (need %zu)\n", n_in, out_size, ws_size, (size_t)WS_END); grid_blocks = -1; return; }
        int dev = 0, cus = 0, per_cu = 0;
        (void)hipGetDevice(&dev); (void)hipDeviceGetAttribute(&cus, hipDeviceAttributeMultiprocessorCount, dev);
        (void)hipFuncSetAttribute((const void*)hybrid_fwd, hipFuncAttributeMaxDynamicSharedMemorySize, LDS_BYTES);
        if (hipOccupancyMaxActiveBlocksPerMultiprocessor(&per_cu, (const void*)hybrid_fwd, 512, LDS_BYTES) != hipSuccess || per_cu < 1) { fprintf(stderr, "kernel_launch: occupancy query failed (%d)\n", per_cu); per_cu = 1; }
        (void)hipGetLastError();
        grid_blocks = cus * 1;
    }
    if (grid_blocks < 0) return;
    if (hipMemsetAsync(d_ws, 0, 65536, stream) != hipSuccess) { fprintf(stderr, "kernel_launch: memset of control words failed\n"); return; }
    Params p{};
    for (int i = 0; i < 30; ++i) p.in[i] = (const float*)d_in[i];
    p.out = (float*)d_out; p.ws = (unsigned char*)d_ws;
    void* args[] = {&p};
    hipError_t e = hipLaunchCooperativeKernel((const void*)hybrid_fwd, dim3(grid_blocks), dim3(512), args, LDS_BYTES, stream);
    if (e != hipSuccess) fprintf(stderr, "cooperative launch failed: %s (grid %d)\n", hipGetErrorString(e), grid_blocks);
}
```

```cpp
#include <hip/hip_runtime.h>
#include <hip/hip_cooperative_groups.h>
namespace cg = cooperative_groups;
#include <cstdio>
#include <cstdint>
#include <cmath>
#include <type_traits>

typedef unsigned short bf16_t;
typedef float f32x4 __attribute__((ext_vector_type(4)));
typedef unsigned u32x4 __attribute__((ext_vector_type(4)));
typedef unsigned u32x2 __attribute__((ext_vector_type(2)));

constexpr int D = 1024, BATCH = 2, SEQ = 8192, M = BATCH * SEQ;
constexpr int DI = 2048, NH = 32, HP = 64, NG = 4, DS = 128, DXBC = 3072;
constexpr int AH = 8, AD = 64, AV = 128;
constexpr int MEML = 256, MH = 4, MHD = 256;
constexpr int PH = 8, PK = 128, PDK = 256, PHALF = 128, PTOP = 16;
constexpr int NIN = 10272, NINP = 10240;
constexpr float ALPHA = 1.189207115002721f;
constexpr float LOG2E = 1.4426950408889634f;
constexpr float QSCALE = 0.125f * LOG2E;
constexpr float CQSCALE = 0.0625f * LOG2E;
constexpr float LAMBDA_INIT = 0.2f;
constexpr int HC_Z = 0, HC_XBC = 2048, HC_Q = 5120, HC_K = 6144, HC_V = 7168, HC_GS = 8192, HC_GA = 9216, HP_ = NINP;

constexpr size_t MiB = 1u << 20;
constexpr size_t WS_CTL = 0;
constexpr size_t WS_WIN = 1 * MiB;
constexpr size_t WS_WSSD = 21 * MiB;
constexpr size_t WS_WDIFF = 25 * MiB, WS_WO = 27 * MiB, WS_WCQ = 29 * MiB, WS_WCKV = 31 * MiB  , WS_WCO = 35 * MiB;
constexpr size_t WS_WPQ = 37 * MiB;
constexpr size_t WS_SUBK = 41 * MiB;
constexpr size_t WS_MEMB = 42 * MiB;
constexpr size_t WS_KCVC = 43 * MiB;
constexpr size_t WS_DT = 45 * MiB;
constexpr size_t WS_XB = 47 * MiB;
constexpr size_t WS_H = 79 * MiB;
constexpr size_t WS_T1 = 239 * MiB;
constexpr size_t WS_PU = 47 * MiB, WS_PV = 63 * MiB;
constexpr size_t WS_X1B = 79 * MiB;
constexpr size_t WS_QC = 143 * MiB, WS_XO = 175 * MiB;
constexpr size_t WS_QP = 207 * MiB;
constexpr size_t WS_IDX = 143 * MiB, WS_GATE = 151 * MiB;
constexpr size_t WS_PART = 207 * MiB;
constexpr size_t WS_END = 271 * MiB;
constexpr int CW_LAM = 64;

__device__ __forceinline__ int opaque_tid() { int t = threadIdx.x; asm volatile("" : "+v"(t)); return t; }
__device__ __forceinline__ unsigned f2bf(float f) { unsigned u = __builtin_bit_cast(unsigned, f); return (u + 0x7fffu + ((u >> 16) & 1u)) >> 16; }
__device__ __forceinline__ float bf2f(unsigned h) { return __builtin_bit_cast(float, h << 16); }
__device__ __forceinline__ unsigned pk2(float lo, float hi) { return f2bf(lo) | (f2bf(hi) << 16); }
__device__ __forceinline__ float bflo(unsigned w) { return __builtin_bit_cast(float, w << 16); }
__device__ __forceinline__ float bfhi(unsigned w) { return __builtin_bit_cast(float, w & 0xffff0000u); }
__device__ __forceinline__ float sigmoidf_(float v) { return __builtin_amdgcn_rcpf(1.f + __expf(-v)); }
__device__ __forceinline__ float siluf_(float v) { return v * __builtin_amdgcn_rcpf(1.f + __expf(-v)); }
__device__ __forceinline__ float wave_sum(float v) {
#pragma unroll
    for (int o = 1; o < 64; o <<= 1) v += __shfl_xor(v, o);
    return v;
}
__device__ __forceinline__ float wave_max(float v) {
#pragma unroll
    for (int o = 1; o < 64; o <<= 1) v = fmaxf(v, __shfl_xor(v, o));
    return v;
}

__device__ __forceinline__ void store_bf16x8(bf16_t* p, const float (&v)[8]) { u32x4 w; w.x = pk2(v[0], v[1]); w.y = pk2(v[2], v[3]); w.z = pk2(v[4], v[5]); w.w = pk2(v[6], v[7]); *(u32x4*)p = w; }
struct EpiPlain { bf16_t* O; int ldc; float scale;
    __device__ __forceinline__ void operator()(int row, int col0, const float (&v)[8]) const { float o[8];
#pragma unroll
        for (int j = 0; j < 8; ++j) o[j] = v[j] * scale; store_bf16x8(O + (size_t)row * ldc + col0, o); } };
struct EpiInProj { bf16_t* H; const float* gate_bias;
    __device__ __forceinline__ void operator()(int row, int col0, const float (&v)[8]) const { float o[8];
        if (col0 >= HC_GS) { const float* gb = gate_bias + (col0 - HC_GS);
#pragma unroll
            for (int j = 0; j < 8; ++j) o[j] = sigmoidf_(v[j] + gb[j]); }
        else { const float s = (col0 >= HC_Q && col0 < HC_K) ? QSCALE : 1.f;
#pragma unroll
            for (int j = 0; j < 8; ++j) o[j] = v[j] * s; }
        store_bf16x8(H + (size_t)row * HP_ + col0, o); } };
struct EpiGate1 { const bf16_t* H; float* T1;
    __device__ __forceinline__ void operator()(int row, int col0, const float (&v)[8]) const {
        const u32x4 g = *(const u32x4*)(H + (size_t)row * HP_ + HC_GS + col0); const unsigned gw[4] = {g.x, g.y, g.z, g.w};
        float* t = T1 + (size_t)row * D + col0;
#pragma unroll
        for (int j = 0; j < 4; ++j) { t[2 * j] = bflo(gw[j]) * v[2 * j]; t[2 * j + 1] = bfhi(gw[j]) * v[2 * j + 1]; } } };
struct EpiGate2 { bf16_t* H; const float* T1;
    __device__ __forceinline__ void operator()(int row, int col0, const float (&v)[8]) const {
        const u32x4 g = *(const u32x4*)(H + (size_t)row * HP_ + HC_GA + col0); const unsigned gw[4] = {g.x, g.y, g.z, g.w};
        const float* t = T1 + (size_t)row * D + col0; float o[8];
#pragma unroll
        for (int j = 0; j < 4; ++j) { o[2 * j] = t[2 * j] + bflo(gw[j]) * v[2 * j]; o[2 * j + 1] = t[2 * j + 1] + bfhi(gw[j]) * v[2 * j + 1]; }
        store_bf16x8(H + (size_t)row * HP_ + HC_K + col0, o); } };
struct EpiResid { const float* base; float* out; int row_off; int pad_;
    __device__ __forceinline__ void operator()(int row, int col0, const float (&v)[8]) const {
        const size_t o = (size_t)(row + row_off) * D + col0;
#pragma unroll
        for (int j = 0; j < 8; ++j) out[o + j] = ALPHA * base[o + j] + v[j]; } };


namespace pg8 {
#define PG8_LAS __attribute__((address_space(3)))
typedef short bf16x8 __attribute__((ext_vector_type(8)));
constexpr int BM = 256, BK = 64, HALF = 128, HTB = HALF * BK * 2, STAGE_BYTES = 8 * HTB, NXCD = 8, WGM = 8;
__host__ __device__ __forceinline__ int lds_byte(int r, int c) { const int st = (r >> 4) * 2 + (c >> 5), rr = r & 15, cc = c & 31, ob = rr * 64 + cc * 2; return st * 1024 + (ob ^ (((ob >> 9) & 1) << 5)); }
__host__ __device__ __forceinline__ void stage_rc(int b, int& R, int& C) { const int st = b / 1024, sb = b % 1024, swz = sb ^ (((sb >> 9) & 1) << 5); R = (st >> 1) * 16 + swz / 64; C = (st & 1) * 32 + (swz % 64) / 2; }
__host__ __device__ __forceinline__ int perm32(int rho) { const int n = rho >> 4, i = rho & 15; return 8 * (i >> 2) + 4 * n + (i & 3); }
struct Unit { int pm, pn; };
struct Gemm { const bf16_t* A; const bf16_t* Bt; int M, N, K, lda; };
struct StaticOrder {
    int nM, nN, nwg, G, c;
    __host__ __device__ void init(int M, int N, int G_, int c_) { nM = M / BM; nN = N / BM; nwg = nM * nN; G = G_; c = c_; }
    __host__ __device__ bool next(int i, Unit& u) const {
        const long L = (long)i * G + c; if (L >= nwg) return false;
        int wgid = (int)L; { const int q = nwg / NXCD, r = nwg % NXCD, xcd = wgid % NXCD, off = wgid / NXCD; wgid = (xcd < r ? xcd * (q + 1) : r * (q + 1) + (xcd - r) * q) + off; }
        const int nig = WGM * nN, gid = wgid / nig, fm = gid * WGM, gsz = (nM - fm) < WGM ? (nM - fm) : WGM;
        u.pm = fm + ((wgid % nig) % gsz); u.pn = (wgid % nig) / gsz; return true;
    }
};
template <class F> struct EpiAdapt {
    static constexpr bool PERM = true, AFTER_DRAIN = false; F f;
    __device__ __forceinline__ void operator()(const f32x4 (&acc)[2][2][4][2], const Unit& u, int wr, int wc, int fr, int fq) const {
#pragma unroll
        for (int ai = 0; ai < 2; ++ai)
#pragma unroll
            for (int m = 0; m < 4; ++m) { const int row = u.pm * BM + ai * HALF + wr * 64 + m * 16 + fr;
#pragma unroll
                for (int bj = 0; bj < 2; ++bj) { const int col0 = u.pn * BM + bj * HALF + wc * 32 + 8 * fq;
                    const f32x4 a = acc[ai][bj][m][0], b = acc[ai][bj][m][1]; const float v[8] = {a[0], a[1], a[2], a[3], b[0], b[1], b[2], b[3]};
                    f(row, col0, v); } }
    }
};
template <class Epi, class Sched, bool ALIGN_EPI>
__device__ __forceinline__ void gemm_phase(PG8_LAS unsigned char* lds, const Gemm g, const Sched& S, const Epi& E) {
    const int tid = opaque_tid(), wid = __builtin_amdgcn_readfirstlane(tid >> 6), lane = tid & 63, wr = wid >> 2, wc = wid & 3, fr = lane & 15, fq = lane >> 4;
    const int K = g.K, nt = K / BK, lda = g.lda;
    unsigned voffA[2], voffB[2];
#pragma unroll
    for (int i = 0; i < 2; ++i) { int R, C; stage_rc(tid * 16 + i * 8192, R, C); const int Rb = Epi::PERM ? ((R & ~31) + perm32(R & 31)) : R;
        voffA[i] = (unsigned)(R * lda + C) * 2u; voffB[i] = (unsigned)(Rb * K + C) * 2u; }
    const size_t kstep = (size_t)(BK * 2);
    const size_t hstepA = (size_t)HALF * lda * 2, hstepB = (size_t)HALF * K * 2;
    const size_t tstepA = 2 * hstepA, tstepB = 2 * hstepB;
    const unsigned ldsw = (unsigned)wid * 1024u;
    const int aoff = lds_byte(wr * 64 + fr, fq * 8), boff = lds_byte(wc * 32 + fr, fq * 8);
#define PG8_SA(b, h) (((b) * 2 + (h)) * HTB)
#define PG8_SB(b, h) ((4 + (b) * 2 + (h)) * HTB)
#define PG8_STAGE(bufoff, gbase, voff) do { _Pragma("unroll") for (int _i = 0; _i < 2; ++_i) \
        __builtin_amdgcn_global_load_lds((const unsigned*)((const char*)(gbase) + (voff)[_i]), (PG8_LAS unsigned*)(lds + (bufoff) + ldsw + _i * 8192), 16, 0, 0); } while (0)
#define PG8_LDA(dst, b, h) do { _Pragma("unroll") for (int m = 0; m < 4; ++m) _Pragma("unroll") for (int k = 0; k < 2; ++k) dst[m][k] = *(const PG8_LAS bf16x8*)(lds + PG8_SA(b, h) + aoff + m * 2048 + k * 1024); } while (0)
#define PG8_LDB(dst, b, h) do { _Pragma("unroll") for (int n = 0; n < 2; ++n) _Pragma("unroll") for (int k = 0; k < 2; ++k) dst[n][k] = *(const PG8_LAS bf16x8*)(lds + PG8_SB(b, h) + boff + n * 2048 + k * 1024); } while (0)
#define PG8_MMA(ai, bj, At, Bt) do { __builtin_amdgcn_s_setprio(1); _Pragma("unroll") for (int m = 0; m < 4; ++m) _Pragma("unroll") for (int n = 0; n < 2; ++n) _Pragma("unroll") for (int k = 0; k < 2; ++k) \
        acc[ai][bj][m][n] = __builtin_amdgcn_mfma_f32_16x16x32_bf16(Bt[n][k], At[m][k], acc[ai][bj][m][n], 0, 0, 0); __builtin_amdgcn_s_setprio(0); } while (0)
#define PG8_WAIT_V(n) asm volatile("s_waitcnt vmcnt(" #n ")" ::: "memory")
#define PG8_WAIT_L(n) asm volatile("s_waitcnt lgkmcnt(" #n ")" ::: "memory")
#define PG8_BAR __builtin_amdgcn_s_barrier()
#define PG8_SCHED __builtin_amdgcn_sched_barrier(0)
    Unit cur, nxt; int ui = 0;
    if (!S.next(0, cur)) return;
    f32x4 acc[2][2][4][2];
#pragma unroll
    for (int a = 0; a < 2; ++a)
#pragma unroll
        for (int b = 0; b < 2; ++b)
#pragma unroll
            for (int m = 0; m < 4; ++m)
#pragma unroll
                for (int n = 0; n < 2; ++n) acc[a][b][m][n] = (f32x4){0.f, 0.f, 0.f, 0.f};
    bf16x8 At[4][2], B0[2][2], B1[2][2];
    const char* cA = (const char*)g.A + (size_t)cur.pm * tstepA; const char* cB = (const char*)g.Bt + (size_t)cur.pn * tstepB;
    PG8_STAGE(PG8_SB(0, 0), cB, voffB); PG8_STAGE(PG8_SB(0, 1), cB + hstepB, voffB); PG8_STAGE(PG8_SA(0, 0), cA, voffA); PG8_STAGE(PG8_SA(0, 1), cA + hstepA, voffA);
    if (wr == 1) PG8_BAR;
    PG8_WAIT_V(2); PG8_BAR;
    PG8_STAGE(PG8_SB(1, 0), cB + kstep, voffB); PG8_STAGE(PG8_SA(1, 0), cA + kstep, voffA); PG8_STAGE(PG8_SB(1, 1), cB + hstepB + kstep, voffB);
    PG8_WAIT_V(6); PG8_BAR;
    for (;;) {
        const bool has_next = S.next(ui + 1, nxt);
        const char* nA = has_next ? (const char*)g.A + (size_t)nxt.pm * tstepA : cA; const char* nB = has_next ? (const char*)g.Bt + (size_t)nxt.pn * tstepB : cB;
        for (int t = 0; t < nt; t += 2) {
            const bool last = (t == nt - 2);
            const char* a1 = cA + (size_t)(t + 1) * kstep;
            const char* a2 = last ? nA : cA + (size_t)(t + 2) * kstep; const char* b2 = last ? nB : cB + (size_t)(t + 2) * kstep;
            const char* a3 = a2 + kstep; const char* b3 = b2 + kstep;
            PG8_LDB(B0, 0, 0); PG8_LDB(B1, 0, 1); PG8_SCHED; PG8_LDA(At, 0, 0); PG8_STAGE(PG8_SA(1, 1), a1 + hstepA, voffA);
            PG8_WAIT_V(8); PG8_WAIT_L(0); PG8_BAR; PG8_MMA(0, 0, At, B0); PG8_MMA(0, 1, At, B1); PG8_BAR; PG8_SCHED;
            PG8_LDA(At, 0, 1); PG8_STAGE(PG8_SB(0, 0), b2, voffB); PG8_STAGE(PG8_SB(0, 1), b2 + hstepB, voffB); PG8_STAGE(PG8_SA(0, 0), a2, voffA);
            PG8_WAIT_V(8); PG8_WAIT_L(0); PG8_BAR; PG8_MMA(1, 0, At, B0); PG8_MMA(1, 1, At, B1); PG8_BAR; PG8_SCHED;
            PG8_LDB(B0, 1, 0); PG8_LDB(B1, 1, 1); PG8_SCHED; PG8_LDA(At, 1, 0); PG8_STAGE(PG8_SA(0, 1), a2 + hstepA, voffA);
            PG8_WAIT_V(8); PG8_WAIT_L(0); PG8_BAR; PG8_MMA(0, 0, At, B0); PG8_MMA(0, 1, At, B1); PG8_BAR; PG8_SCHED;
            PG8_LDA(At, 1, 1); PG8_STAGE(PG8_SB(1, 0), b3, voffB); PG8_STAGE(PG8_SB(1, 1), b3 + hstepB, voffB); PG8_STAGE(PG8_SA(1, 0), a3, voffA);
            PG8_WAIT_V(8); PG8_WAIT_L(0); PG8_BAR; PG8_MMA(1, 0, At, B0); PG8_MMA(1, 1, At, B1); PG8_BAR; PG8_SCHED;
        }
        if constexpr (ALIGN_EPI) { if (wr == 0) PG8_BAR; }
        E(acc, cur, wr, wc, fr, fq);
        if (!has_next) break;
#pragma unroll
        for (int a = 0; a < 2; ++a)
#pragma unroll
            for (int b = 0; b < 2; ++b)
#pragma unroll
                for (int m = 0; m < 4; ++m)
#pragma unroll
                    for (int n = 0; n < 2; ++n) acc[a][b][m][n] = (f32x4){0.f, 0.f, 0.f, 0.f};
        cur = nxt; cA = nA; cB = nB; ++ui;
        if constexpr (ALIGN_EPI) { if (wr == 1) PG8_BAR; }
    }
    PG8_WAIT_V(0);
    if constexpr (!ALIGN_EPI) { if (wr == 0) PG8_BAR; }
    PG8_BAR;
#undef PG8_SA
#undef PG8_SB
#undef PG8_STAGE
#undef PG8_LDA
#undef PG8_LDB
#undef PG8_MMA
#undef PG8_WAIT_V
#undef PG8_WAIT_L
#undef PG8_BAR
#undef PG8_SCHED
}
}
constexpr int LDS_BYTES = 148480;
namespace dattn {
#define DA_LAS __attribute__((address_space(3)))
typedef short bf16x8 __attribute__((ext_vector_type(8)));
typedef short s16x4 __attribute__((ext_vector_type(4)));
typedef float f32x16 __attribute__((ext_vector_type(16)));
constexpr int KP = 272, VP = 320, KBUF = 64 * KP, VBUF = 64 * VP, BUF = KBUF + VBUF, XOFF = 2 * BUF, LDS_NEED = XOFF + 65536;
static_assert(LDS_NEED <= 147456, "attention LDS");
__device__ __forceinline__ unsigned cvtpk(float lo, float hi) { typedef float f2 __attribute__((ext_vector_type(2))); typedef __bf16 b2 __attribute__((ext_vector_type(2))); f2 v = {lo, hi}; b2 b = __builtin_convertvector(v, b2); return __builtin_bit_cast(unsigned, b); }
__device__ __forceinline__ s16x4 vtr(const DA_LAS unsigned char* p) { typedef short v4i16_t __attribute__((ext_vector_type(4))); return __builtin_bit_cast(s16x4, __builtin_amdgcn_ds_read_tr16_b64_v4i16((DA_LAS v4i16_t*)p)); }
template <bool STORE = true> __device__ __forceinline__ void unit(DA_LAS unsigned char* lds, bf16_t* Hb, int h, int qb, const float* __restrict__ subln_w, float lam) {
    const int tid = opaque_tid(), lane = tid & 63, w = __builtin_amdgcn_readfirstlane(tid >> 6), mp = w >> 2, rb = w & 3, c32 = lane & 31, hh = lane >> 5;
    const int qrow = 128 * qb + 32 * rb + c32;
    bf16x8 qf[4];
    { const bf16_t* qp = Hb + (size_t)qrow * HP_ + HC_Q + h * 128 + 64 * mp + 8 * hh;
#pragma unroll
      for (int s = 0; s < 4; ++s) qf[s] = *(const bf16x8*)(qp + 16 * s); }
    const int srow = tid >> 4, sch = tid & 15;
    const bf16_t* kg = Hb + HC_K + h * 128 + sch * 8; const bf16_t* vg = Hb + HC_V + h * 128 + sch * 8;
    const int nt = 2 * qb + 2;
    u32x4 kr[2], vr[2];
#define DA_LOAD(t) do { _Pragma("unroll") for (int j = 0; j < 2; ++j) { const size_t ro = (size_t)(64 * (t) + srow + 32 * j) * HP_; kr[j] = *(const u32x4*)(kg + ro); vr[j] = *(const u32x4*)(vg + ro); } } while (0)
#define DA_WRITE(buf) do { _Pragma("unroll") for (int j = 0; j < 2; ++j) { *(DA_LAS u32x4*)(lds + (buf) * BUF + (srow + 32 * j) * KP + sch * 16) = kr[j]; *(DA_LAS u32x4*)(lds + (buf) * BUF + KBUF + (srow + 32 * j) * VP + sch * 16) = vr[j]; } } while (0)
    DA_LOAD(0); DA_WRITE(0);
    __syncthreads();
    f32x16 oT[4];
#pragma unroll
    for (int i = 0; i < 4; ++i) oT[i] = (f32x16){0.f, 0.f, 0.f, 0.f, 0.f, 0.f, 0.f, 0.f, 0.f, 0.f, 0.f, 0.f, 0.f, 0.f, 0.f, 0.f};
    float lrow = 0.f;
    f32x16 negm = (f32x16){0.f, 0.f, 0.f, 0.f, 0.f, 0.f, 0.f, 0.f, 0.f, 0.f, 0.f, 0.f, 0.f, 0.f, 0.f, 0.f};
    const int koff = c32 * KP + (64 * mp + 8 * hh) * 2;
    const int voff = KBUF + (4 * hh + ((lane & 15) >> 2)) * VP + (16 * ((lane >> 4) & 1) + 4 * (lane & 3)) * 2;
    for (int t = 0; t < nt; ++t) {
        const int cur = t & 1;
        if (t + 1 < nt) DA_LOAD(t + 1);
        if (!(t == nt - 1 && rb <= 1)) {
            const DA_LAS unsigned char* kb = lds + cur * BUF + koff;
            f32x16 s0 = negm, s1 = negm;
            bf16x8 kf0[4], kf1[4];
#pragma unroll
            for (int s = 0; s < 4; ++s) { kf0[s] = *(const DA_LAS bf16x8*)(kb + s * 32); kf1[s] = *(const DA_LAS bf16x8*)(kb + 32 * KP + s * 32); }
            __builtin_amdgcn_s_setprio(1);
#pragma unroll
            for (int s = 0; s < 4; ++s) {
                s0 = __builtin_amdgcn_mfma_f32_32x32x16_bf16(kf0[s], qf[s], s0, 0, 0, 0);
                s1 = __builtin_amdgcn_mfma_f32_32x32x16_bf16(kf1[s], qf[s], s1, 0, 0, 0);
            }
            __builtin_amdgcn_s_setprio(0);
            if (t >= nt - 2) {
                const int k0 = 64 * t + 4 * hh;
#pragma unroll
                for (int r = 0; r < 16; ++r) { const int key = k0 + (r & 3) + 8 * (r >> 2); if (key > qrow) s0[r] = -INFINITY; if (key + 32 > qrow) s1[r] = -INFINITY; }
            }
            float mxa = fmaxf(fmaxf(s0[0], s0[1]), s1[0]), mxb = fmaxf(fmaxf(s0[2], s0[3]), s1[1]);
            mxa = fmaxf(fmaxf(mxa, s1[2]), s1[3]);
#pragma unroll
            for (int r = 4; r < 16; r += 4) { mxa = fmaxf(fmaxf(mxa, s0[r]), s0[r + 1]); mxb = fmaxf(fmaxf(mxb, s0[r + 2]), s0[r + 3]); mxa = fmaxf(fmaxf(mxa, s1[r]), s1[r + 1]); mxb = fmaxf(fmaxf(mxb, s1[r + 2]), s1[r + 3]); }
            float mx = fmaxf(mxa, mxb);
            mx = fmaxf(mx, __shfl_xor(mx, 32));
            if (__any(mx > 8.f)) {
                const float dl = fmaxf(mx, 0.f), alpha = __builtin_amdgcn_exp2f(-dl);
#pragma unroll
                for (int r = 0; r < 16; ++r) { s0[r] -= dl; s1[r] -= dl; negm[r] -= dl; }
                lrow *= alpha;
#pragma unroll
                for (int i = 0; i < 4; ++i)
#pragma unroll
                    for (int r = 0; r < 16; ++r) oT[i][r] *= alpha;
            }
            float ps = 0.f;
#pragma unroll
            for (int r = 0; r < 16; ++r) { s0[r] = __builtin_amdgcn_exp2f(s0[r]); s1[r] = __builtin_amdgcn_exp2f(s1[r]); ps += s0[r] + s1[r]; }
            lrow += ps;
            bf16x8 pf[2][2];
#pragma unroll
            for (int s = 0; s < 2; ++s) {
                u32x4 a, b;
                a.x = cvtpk(s0[8 * s], s0[8 * s + 1]); a.y = cvtpk(s0[8 * s + 2], s0[8 * s + 3]); a.z = cvtpk(s0[8 * s + 4], s0[8 * s + 5]); a.w = cvtpk(s0[8 * s + 6], s0[8 * s + 7]);
                b.x = cvtpk(s1[8 * s], s1[8 * s + 1]); b.y = cvtpk(s1[8 * s + 2], s1[8 * s + 3]); b.z = cvtpk(s1[8 * s + 4], s1[8 * s + 5]); b.w = cvtpk(s1[8 * s + 6], s1[8 * s + 7]);
                pf[0][s] = __builtin_bit_cast(bf16x8, a); pf[1][s] = __builtin_bit_cast(bf16x8, b);
            }
            const DA_LAS unsigned char* vb = lds + cur * BUF + voff;
#define DA_LDV(dst, db) do { _Pragma("unroll") for (int i_ = 0; i_ < 4; ++i_) { const s16x4 lo_ = vtr(vb + (16 * i_) * VP + (db) * 64), hi_ = vtr(vb + (16 * i_ + 8) * VP + (db) * 64); \
                dst[i_] = (bf16x8){lo_[0], lo_[1], lo_[2], lo_[3], hi_[0], hi_[1], hi_[2], hi_[3]}; } } while (0)
#define DA_MM(src, db) do { _Pragma("unroll") for (int i_ = 0; i_ < 4; ++i_) oT[db] = __builtin_amdgcn_mfma_f32_32x32x16_bf16(src[i_], pf[i_ >> 1][i_ & 1], oT[db], 0, 0, 0); } while (0)
            bf16x8 va[4], vq[4];
            DA_LDV(va, 0);
            DA_LDV(vq, 1); __builtin_amdgcn_s_setprio(1); DA_MM(va, 0); __builtin_amdgcn_s_setprio(0);
            DA_LDV(va, 2); __builtin_amdgcn_s_setprio(1); DA_MM(vq, 1); __builtin_amdgcn_s_setprio(0);
            DA_LDV(vq, 3); __builtin_amdgcn_s_setprio(1); DA_MM(va, 2); __builtin_amdgcn_s_setprio(0);
            __builtin_amdgcn_s_setprio(1); DA_MM(vq, 3);
#undef DA_LDV
#undef DA_MM
            __builtin_amdgcn_s_setprio(0);
        }
        if (t + 1 < nt) DA_WRITE(cur ^ 1);
        __syncthreads();
    }
#undef DA_LOAD
#undef DA_WRITE
    const float inv = 1.f / (lrow + __shfl_xor(lrow, 32));
    DA_LAS float* X = (DA_LAS float*)(lds + XOFF) + rb * 4096 + lane;
    if (mp == 1) {
#pragma unroll
        for (int i = 0; i < 4; ++i)
#pragma unroll
            for (int r = 0; r < 16; ++r) X[(i * 16 + r) * 64] = oT[i][r] * inv;
    }
    __syncthreads();
    if (mp == 0) {
        float ss = 0.f;
#pragma unroll
        for (int i = 0; i < 4; ++i)
#pragma unroll
            for (int r = 0; r < 16; ++r) { const float o = oT[i][r] * inv - lam * X[(i * 16 + r) * 64]; oT[i][r] = o; ss += o * o; }
        ss += __shfl_xor(ss, 32);
        const float rr = rsqrtf(ss * (1.f / 128.f) + 1e-5f) * (1.f - LAMBDA_INIT);
        bf16_t* op = Hb + (size_t)qrow * HP_ + HC_Q + h * 128 + 4 * hh;
#pragma unroll
        for (int i = 0; i < 4; ++i)
#pragma unroll
            for (int g = 0; g < 4; ++g) { const int d0 = 32 * i + 8 * g; const f32x4 sw = *(const f32x4*)(subln_w + d0 + 4 * hh);
                uint2 o; o.x = pk2(oT[i][4 * g] * rr * sw.x, oT[i][4 * g + 1] * rr * sw.y); o.y = pk2(oT[i][4 * g + 2] * rr * sw.z, oT[i][4 * g + 3] * rr * sw.w);
                if (STORE || o.x == 0x12345u) *(uint2*)(op + d0) = o; }
    }
    __syncthreads();
}
}
namespace ssd {
#define SS_LAS __attribute__((address_space(3)))
typedef short bf16x8 __attribute__((ext_vector_type(8)));
typedef short s16x4 __attribute__((ext_vector_type(4)));
typedef float f32x16 __attribute__((ext_vector_type(16)));
constexpr int XP = 192;
constexpr int BPT = 320;
constexpr int CP = 272;
__device__ __forceinline__ s16x4 vtr(const SS_LAS unsigned char* p) { typedef short v4i16_t __attribute__((ext_vector_type(4))); return __builtin_bit_cast(s16x4, __builtin_amdgcn_ds_read_tr16_b64_v4i16((SS_LAS v4i16_t*)p)); }
__device__ __forceinline__ unsigned cvtpk(float lo, float hi) { typedef float f2 __attribute__((ext_vector_type(2))); typedef __bf16 b2 __attribute__((ext_vector_type(2))); f2 v = {lo, hi}; b2 b = __builtin_convertvector(v, b2); return __builtin_bit_cast(unsigned, b); }
__device__ __forceinline__ void acs_tables(SS_LAS float* ACS, SS_LAS float* DTS, const float* __restrict__ DTb, const float* __restrict__ a_log, int c, int g) {
    const int tid_ = opaque_tid(); const int lane = tid_ & 63, e = __builtin_amdgcn_readfirstlane(tid_ >> 6), h = 8 * g + e;
    const float a = -expf(a_log[h]);
    const float d0 = DTb[(size_t)(128 * c + 2 * lane) * 32 + h], d1 = DTb[(size_t)(128 * c + 2 * lane + 1) * 32 + h];
    const float a0 = d0 * a, a1 = d1 * a;
    float sc = a0 + a1;
#pragma unroll
    for (int o = 1; o < 64; o <<= 1) { const float v = __shfl_up(sc, o); if (lane >= o) sc += v; }
    const float ex = sc - (a0 + a1);
    ACS[(2 * lane) * 8 + e] = ex + a0; ACS[(2 * lane + 1) * 8 + e] = ex + a0 + a1;
    DTS[(2 * lane) * 8 + e] = d0; DTS[(2 * lane + 1) * 8 + e] = d1;
}
template <int NT, class F> __device__ __forceinline__ void conv_item(const bf16_t* __restrict__ Hb, int t0, int l0, int xch0, const float* __restrict__ conv_w, const float* __restrict__ conv_b, F sink) {
    float w[4][8], bias[8];
#pragma unroll
    for (int j = 0; j < 4; ++j) { const f32x4 a = *(const f32x4*)(conv_w + j * DXBC + xch0), b = *(const f32x4*)(conv_w + j * DXBC + xch0 + 4); w[j][0] = a.x; w[j][1] = a.y; w[j][2] = a.z; w[j][3] = a.w; w[j][4] = b.x; w[j][5] = b.y; w[j][6] = b.z; w[j][7] = b.w; }
    { const f32x4 a = *(const f32x4*)(conv_b + xch0), b = *(const f32x4*)(conv_b + xch0 + 4); bias[0] = a.x; bias[1] = a.y; bias[2] = a.z; bias[3] = a.w; bias[4] = b.x; bias[5] = b.y; bias[6] = b.z; bias[7] = b.w; }
    const bf16_t* src = Hb + HC_XBC + xch0;
    u32x4 rw[NT + 3];
#pragma unroll
    for (int i = 0; i < NT + 3; ++i) { const int tt = t0 + l0 - 3 + i; rw[i] = *(const u32x4*)(src + (size_t)(tt < 0 ? 0 : tt) * HP_); }
    if (t0 + l0 < 3) {
#pragma unroll
        for (int i = 0; i < 3; ++i) if (t0 + l0 - 3 + i < 0) rw[i] = (u32x4){0u, 0u, 0u, 0u};
    }
#define SS_UNP(dst, q_) do { dst[0] = bflo(q_.x); dst[1] = bfhi(q_.x); dst[2] = bflo(q_.y); dst[3] = bfhi(q_.y); dst[4] = bflo(q_.z); dst[5] = bfhi(q_.z); dst[6] = bflo(q_.w); dst[7] = bfhi(q_.w); } while (0)
    float x0[8], x1[8], x2[8];
    SS_UNP(x0, rw[0]); SS_UNP(x1, rw[1]); SS_UNP(x2, rw[2]);
#pragma unroll
    for (int i = 0; i < NT; ++i) {
        float x3[8]; SS_UNP(x3, rw[3 + i]);
        float v[8];
#pragma unroll
        for (int k = 0; k < 8; ++k) { const float a = bias[k] + w[0][k] * x0[k] + w[1][k] * x1[k] + w[2][k] * x2[k] + w[3][k] * x3[k]; v[k] = a * __builtin_amdgcn_rcpf(1.f + __expf(-a)); x0[k] = x1[k]; x1[k] = x2[k]; x2[k] = x3[k]; }
        sink(l0 + i, v);
    }
#undef SS_UNP
}
constexpr int A_BS = 0, A_XD = 128 * BPT  , A_ACS = A_XD + 2 * 128 * XP  , A_DTS = A_ACS + 4096, A_END = A_DTS + 4096;
__device__ __forceinline__ void phaseA_unit(SS_LAS unsigned char* lds, const bf16_t* __restrict__ Hb, const float* __restrict__ DTb, const float* __restrict__ conv_w, const float* __restrict__ conv_b,
                                            const float* __restrict__ a_log, bf16_t* __restrict__ ST, float* __restrict__ CD, int c, int g) {
    const int tid = opaque_tid(), lane = tid & 63, w = __builtin_amdgcn_readfirstlane(tid >> 6), c32 = lane & 31, hh = lane >> 5;
    SS_LAS float* ACS = (SS_LAS float*)(lds + A_ACS); SS_LAS float* DTS = (SS_LAS float*)(lds + A_DTS);
    acs_tables(ACS, DTS, DTb, a_log, c, g);
    __syncthreads();
    if (tid < 8) CD[c * 32 + 8 * g + tid] = __expf(ACS[127 * 8 + tid]);
    auto stageX = [&](int e, int item, int buf) {
        const int cg = item >> 5, seg = item & 31; const float aend = ACS[127 * 8 + e];
        conv_item<4>(Hb, 128 * c, 4 * seg, g * 512 + e * 64 + cg * 8, conv_w, conv_b, [&](int l, const float (&v)[8]) {
            const float sc = DTS[l * 8 + e] * __expf(aend - ACS[l * 8 + e]);
            u32x4 o; o.x = cvtpk(v[0] * sc, v[1] * sc); o.y = cvtpk(v[2] * sc, v[3] * sc); o.z = cvtpk(v[4] * sc, v[5] * sc); o.w = cvtpk(v[6] * sc, v[7] * sc);
            *(SS_LAS u32x4*)(lds + A_XD + buf * 128 * XP + l * XP + cg * 16) = o; });
    };
    { const int cg = tid >> 5, seg = tid & 31;
        conv_item<4>(Hb, 128 * c, 4 * seg, 2048 + g * 128 + cg * 8, conv_w, conv_b, [&](int l, const float (&v)[8]) {
            u32x4 o; o.x = cvtpk(v[0], v[1]); o.y = cvtpk(v[2], v[3]); o.z = cvtpk(v[4], v[5]); o.w = cvtpk(v[6], v[7]);
            *(SS_LAS u32x4*)(lds + A_BS + l * BPT + cg * 16) = o; }); }
    if (tid < 256) stageX(0, tid, 0);
    __syncthreads();
    const int pb = w & 1, nb = w >> 1;
    const int rsel = ((lane & 15) >> 2), csel = 16 * ((lane >> 4) & 1) + 4 * (lane & 3);
    for (int e = 0; e < 8; ++e) {
        if (e + 1 < 8 && tid >= 256) stageX(e + 1, tid - 256, (e + 1) & 1);
        f32x16 acc = (f32x16){0.f, 0.f, 0.f, 0.f, 0.f, 0.f, 0.f, 0.f, 0.f, 0.f, 0.f, 0.f, 0.f, 0.f, 0.f, 0.f};
        const SS_LAS unsigned char* bp = lds + A_BS + (8 * hh + rsel) * BPT + (32 * nb + csel) * 2;
        const SS_LAS unsigned char* xp = lds + A_XD + (e & 1) * 128 * XP + (8 * hh + rsel) * XP + (32 * pb + csel) * 2;
#pragma unroll
        for (int ks = 0; ks < 8; ++ks) {
            const s16x4 b0 = vtr(bp + (16 * ks) * BPT), b1 = vtr(bp + (16 * ks + 4) * BPT), x0 = vtr(xp + (16 * ks) * XP), x1 = vtr(xp + (16 * ks + 4) * XP);
            const bf16x8 bf = (bf16x8){b0[0], b0[1], b0[2], b0[3], b1[0], b1[1], b1[2], b1[3]}, xf = (bf16x8){x0[0], x0[1], x0[2], x0[3], x1[0], x1[1], x1[2], x1[3]};
            acc = __builtin_amdgcn_mfma_f32_32x32x16_bf16(bf, xf, acc, 0, 0, 0);
        }
        bf16_t* sp = ST + ((size_t)(c * 32 + 8 * g + e) * 64 + 32 * pb + c32) * 128 + 32 * nb + 4 * hh;
#pragma unroll
        for (int q = 0; q < 4; ++q) { uint2 o; o.x = cvtpk(acc[4 * q], acc[4 * q + 1]); o.y = cvtpk(acc[4 * q + 2], acc[4 * q + 3]); *(uint2*)(sp + 8 * q) = o; }
        __syncthreads();
    }
}
__device__ __forceinline__ void scan_phase(bf16_t* __restrict__ ST, const float* __restrict__ CD, int gtid) {
    const int h = gtid >> 12;
    unsigned* p = (unsigned*)ST + gtid;
    float r0 = 0.f, r1 = 0.f;
    for (int c0 = 0; c0 < 64; c0 += 16) {
        unsigned v[16]; float d[16];
#pragma unroll
        for (int i = 0; i < 16; ++i) { v[i] = p[(size_t)(c0 + i) * 131072]; d[i] = CD[(c0 + i) * 32 + h]; }
#pragma unroll
        for (int i = 0; i < 16; ++i) { p[(size_t)(c0 + i) * 131072] = cvtpk(r0, r1); r0 = r0 * d[i] + bflo(v[i]); r1 = r1 * d[i] + bfhi(v[i]); }
    }
}
constexpr int C_CS = 0, C_BS = 128 * CP  , C_X1 = C_BS  , C_CBT = 2 * 128 * CP  , C_X0 = C_CBT + 32768  , C_ACS = C_X0 + 128 * XP  , C_DTS = C_ACS + 4096,
              C_SSQ = C_DTS + 4096, C_END = C_SSQ + 1024;
static_assert(C_END <= 147456 && 128 * XP <= 128 * CP, "ssd phase C LDS");
template <bool STORE = true> __device__ __forceinline__ void phaseC_unit(SS_LAS unsigned char* lds, bf16_t* __restrict__ Hb, const float* __restrict__ DTb, const float* __restrict__ conv_w, const float* __restrict__ conv_b,
                                            const float* __restrict__ a_log, const float* __restrict__ d_skip, const float* __restrict__ norm_w, const bf16_t* __restrict__ ST, int c, int g) {
    const int tid = opaque_tid(), lane = tid & 63, w = __builtin_amdgcn_readfirstlane(tid >> 6), c32 = lane & 31, hh = lane >> 5;
    SS_LAS float* ACS = (SS_LAS float*)(lds + C_ACS); SS_LAS float* DTS = (SS_LAS float*)(lds + C_DTS); SS_LAS float* SSQ = (SS_LAS float*)(lds + C_SSQ);
    acs_tables(ACS, DTS, DTb, a_log, c, g);
    auto stageX = [&](int e, int item, int buf) {
        const int cg = item >> 5, seg = item & 31;
        conv_item<4>(Hb, 128 * c, 4 * seg, g * 512 + e * 64 + cg * 8, conv_w, conv_b, [&](int l, const float (&v)[8]) {
            u32x4 o; o.x = cvtpk(v[0], v[1]); o.y = cvtpk(v[2], v[3]); o.z = cvtpk(v[4], v[5]); o.w = cvtpk(v[6], v[7]);
            *(SS_LAS u32x4*)(lds + (buf ? C_X1 : C_X0) + l * XP + cg * 16) = o; });
    };
    { const int isC = tid >> 8, it = tid & 255, cg = it >> 4, seg = it & 15;
        conv_item<8>(Hb, 128 * c, 8 * seg, 2048 + isC * 512 + g * 128 + cg * 8, conv_w, conv_b, [&](int l, const float (&v)[8]) {
            u32x4 o; o.x = cvtpk(v[0], v[1]); o.y = cvtpk(v[2], v[3]); o.z = cvtpk(v[4], v[5]); o.w = cvtpk(v[6], v[7]);
            *(SS_LAS u32x4*)(lds + (isC ? C_CS : C_BS) + l * CP + cg * 16) = o; }); }
    if (tid < 256) stageX(0, tid, 0);
    __syncthreads();
    for (int i = w; i < 10; i += 8) {
        const int sb = (i < 4) ? 0 : (i < 7) ? 1 : (i < 9) ? 2 : 3, lb = (i < 4) ? i : (i < 7) ? i - 3 : (i < 9) ? i - 5 : 3;
        f32x16 acc = (f32x16){0.f, 0.f, 0.f, 0.f, 0.f, 0.f, 0.f, 0.f, 0.f, 0.f, 0.f, 0.f, 0.f, 0.f, 0.f, 0.f};
        const SS_LAS unsigned char* bp = lds + C_BS + (32 * sb + c32) * CP + 16 * hh, *cp = lds + C_CS + (32 * lb + c32) * CP + 16 * hh;
#pragma unroll
        for (int ks = 0; ks < 8; ++ks) acc = __builtin_amdgcn_mfma_f32_32x32x16_bf16(*(const SS_LAS bf16x8*)(bp + 32 * ks), *(const SS_LAS bf16x8*)(cp + 32 * ks), acc, 0, 0, 0);
        SS_LAS unsigned* o = (SS_LAS unsigned*)(lds + C_CBT) + (sb * 4 + lb) * 512 + lane;
#pragma unroll
        for (int q = 0; q < 8; ++q) o[q * 64] = cvtpk(acc[2 * q], acc[2 * q + 1]);
    }
    __syncthreads();
    const int pb = w & 1, lb = w >> 1, lrow = 32 * lb + c32;
    const int rsel = ((lane & 15) >> 2), csel = 16 * ((lane >> 4) & 1) + 4 * (lane & 3);
    unsigned ypk[8][8];
    float ssq = 0.f;
    bf16x8 pcur[8]; u32x2 zcur[4];
#define SS_PREF(pdst, zdst, e_) do { const int h_ = 8 * g + (e_); const bf16_t* pp_ = ST + ((size_t)(c * 32 + h_) * 64 + 32 * pb + c32) * 128 + 8 * hh; \
        _Pragma("unroll") for (int ks_ = 0; ks_ < 8; ++ks_) pdst[ks_] = *(const bf16x8*)(pp_ + 16 * ks_); \
        const bf16_t* zp_ = Hb + (size_t)(128 * c + lrow) * HP_ + HC_Z + g * 512 + (e_) * 64 + 32 * pb + 4 * hh; \
        _Pragma("unroll") for (int q_ = 0; q_ < 4; ++q_) zdst[q_] = *(const u32x2*)(zp_ + 8 * q_); } while (0)
    SS_PREF(pcur, zcur, 0);
    for (int e = 0; e < 8; ++e) {
        const int h = 8 * g + e;
        if (e + 1 < 8 && tid < 256) stageX(e + 1, tid, (e + 1) & 1);
        bf16x8 pnext[8]; u32x2 znext[4];
        { const int en = (e + 1 < 8) ? e + 1 : 7; SS_PREF(pnext, znext, en); }
        const int xoff = (e & 1) ? C_X1 : C_X0;
        f32x16 acc = (f32x16){0.f, 0.f, 0.f, 0.f, 0.f, 0.f, 0.f, 0.f, 0.f, 0.f, 0.f, 0.f, 0.f, 0.f, 0.f, 0.f};
        {
            const SS_LAS unsigned char* cp = lds + C_CS + lrow * CP + 16 * hh;
#pragma unroll
            for (int ks = 0; ks < 8; ++ks) acc = __builtin_amdgcn_mfma_f32_32x32x16_bf16(pcur[ks], *(const SS_LAS bf16x8*)(cp + 32 * ks), acc, 0, 0, 0);
        }
        const float al = ACS[lrow * 8 + e], eal = __expf(al);
#pragma unroll
        for (int r = 0; r < 16; ++r) acc[r] *= eal;
        for (int sb = 0; sb <= lb; ++sb) {
            const SS_LAS unsigned* cbp = (const SS_LAS unsigned*)(lds + C_CBT) + (sb * 4 + lb) * 512 + lane;
            float m[16];
#pragma unroll
            for (int q = 0; q < 8; ++q) { const unsigned u = cbp[q * 64]; m[2 * q] = bflo(u); m[2 * q + 1] = bfhi(u); }
#pragma unroll
            for (int r = 0; r < 16; ++r) { const int srow = 32 * sb + (r & 3) + 8 * (r >> 2) + 4 * hh;
                const float f = __expf(al - ACS[srow * 8 + e]) * DTS[srow * 8 + e];
                m[r] = (srow <= lrow) ? m[r] * f : 0.f; }
            const SS_LAS unsigned char* xp = lds + xoff + (32 * sb + 4 * hh + rsel) * XP + (32 * pb + csel) * 2;
#pragma unroll
            for (int ks = 0; ks < 2; ++ks) {
                const s16x4 x0 = vtr(xp + (16 * ks) * XP), x1 = vtr(xp + (16 * ks + 8) * XP);
                const bf16x8 xf = (bf16x8){x0[0], x0[1], x0[2], x0[3], x1[0], x1[1], x1[2], x1[3]};
                u32x4 mm; mm.x = cvtpk(m[8 * ks], m[8 * ks + 1]); mm.y = cvtpk(m[8 * ks + 2], m[8 * ks + 3]); mm.z = cvtpk(m[8 * ks + 4], m[8 * ks + 5]); mm.w = cvtpk(m[8 * ks + 6], m[8 * ks + 7]);
                acc = __builtin_amdgcn_mfma_f32_32x32x16_bf16(xf, __builtin_bit_cast(bf16x8, mm), acc, 0, 0, 0);
            }
        }
        const float dsk = d_skip[h];
        const SS_LAS unsigned char* xr = lds + xoff + lrow * XP + (32 * pb + 4 * hh) * 2;
        unsigned yt[8];
#pragma unroll
        for (int q = 0; q < 4; ++q) {
            const u32x2 zz = zcur[q]; const u32x2 xx = *(const SS_LAS u32x2*)(xr + 16 * q);
            const float zv[4] = {bflo(zz.x), bfhi(zz.x), bflo(zz.y), bfhi(zz.y)}, xv[4] = {bflo(xx.x), bfhi(xx.x), bflo(xx.y), bfhi(xx.y)};
            float y[4];
#pragma unroll
            for (int k = 0; k < 4; ++k) { y[k] = (acc[4 * q + k] + dsk * xv[k]) * (zv[k] * __builtin_amdgcn_rcpf(1.f + __expf(-zv[k]))); ssq += y[k] * y[k]; }
            yt[2 * q] = cvtpk(y[0], y[1]); yt[2 * q + 1] = cvtpk(y[2], y[3]);
        }
#define SS_YSET(E) case E: { _Pragma("unroll") for (int q_ = 0; q_ < 8; ++q_) ypk[E][q_] = yt[q_]; } break;
        switch (e) { SS_YSET(0) SS_YSET(1) SS_YSET(2) SS_YSET(3) SS_YSET(4) SS_YSET(5) SS_YSET(6) default: { _Pragma("unroll") for (int q_ = 0; q_ < 8; ++q_) ypk[7][q_] = yt[q_]; } break; }
#undef SS_YSET
#pragma unroll
        for (int ks = 0; ks < 8; ++ks) pcur[ks] = pnext[ks];
#pragma unroll
        for (int q = 0; q < 4; ++q) zcur[q] = znext[q];
        __syncthreads();
    }
#undef SS_PREF
    ssq += __shfl_xor(ssq, 32);
    if (hh == 0) SSQ[pb * 128 + lrow] = ssq;
    __syncthreads();
    const float rstd = rsqrtf((SSQ[lrow] + SSQ[128 + lrow]) * (1.f / 512.f) + 1e-5f);
    bf16_t* op = Hb + (size_t)(128 * c + lrow) * HP_ + HC_Z + g * 512 + 32 * pb + 4 * hh;
    const float* nw = norm_w + g * 512 + 32 * pb + 4 * hh;
#pragma unroll
    for (int e = 0; e < 8; ++e)
#pragma unroll
        for (int q = 0; q < 4; ++q) { const f32x4 n4 = *(const f32x4*)(nw + e * 64 + 8 * q);
            uint2 o; o.x = cvtpk(bflo(ypk[e][2 * q]) * rstd * n4.x, bfhi(ypk[e][2 * q]) * rstd * n4.y); o.y = cvtpk(bflo(ypk[e][2 * q + 1]) * rstd * n4.z, bfhi(ypk[e][2 * q + 1]) * rstd * n4.w);
            if (STORE || o.x == 0x12345u) *(uint2*)(op + e * 64 + 8 * q) = o; }
    __syncthreads();
}
}


namespace psel {
#define PS_LAS __attribute__((address_space(3)))
typedef short bf16x8 __attribute__((ext_vector_type(8)));
typedef float f32x16 __attribute__((ext_vector_type(16)));
__device__ __forceinline__ int ord(float f) { const int b = __builtin_bit_cast(int, f); return b ^ ((b >> 31) & 0x7fffffff); }
__device__ __forceinline__ float unord(int t) { return __builtin_bit_cast(float, t ^ ((t >> 31) & 0x7fffffff)); }
#define PS_INS(top, v) do { int v_ = (v); _Pragma("unroll") for (int i_ = 0; i_ < 16; ++i_) { const int hi_ = max(top[i_], v_); v_ = min(top[i_], v_); top[i_] = hi_; } } while (0)
__device__ __forceinline__ void stage1(PS_LAS int* EXall, const bf16_t* __restrict__ QP, const bf16_t* __restrict__ SUBK, int tok0, int hp) {
    const int tid = opaque_tid(), lane = tid & 63, w1 = __builtin_amdgcn_readfirstlane(tid >> 6), c32 = lane & 31, hh = lane >> 5;
    PS_LAS int* EX = EXall + hp * 4096;
    {
        const int tile = w1 >> 2, hsel = (w1 >> 1) & 1, half = w1 & 1, h = 2 * hp + hsel;
        const bf16_t* qp = QP + (size_t)(tok0 + 32 * tile + c32) * 2048 + h * 256 + half * 128 + 8 * hh;
        const bf16_t* kp = SUBK + ((size_t)(h * 2 + half) * 128 + c32) * 128 + 8 * hh;
        bf16x8 qf[8];
#pragma unroll
        for (int ks = 0; ks < 8; ++ks) qf[ks] = *(const bf16x8*)(qp + 16 * ks);
        int top[16];
#pragma unroll
        for (int i = 0; i < 16; ++i) top[i] = (int)0x80000000;
        bf16x8 kfa[8], kfb[8];
#define PS_LDK(dst, mt_) do { _Pragma("unroll") for (int ks_ = 0; ks_ < 8; ++ks_) dst[ks_] = *(const bf16x8*)(kp + (size_t)(32 * (mt_)) * 128 + 16 * ks_); } while (0)
#define PS_TILE(src, mt_) do { f32x16 acc_ = (f32x16){0.f, 0.f, 0.f, 0.f, 0.f, 0.f, 0.f, 0.f, 0.f, 0.f, 0.f, 0.f, 0.f, 0.f, 0.f, 0.f}; \
            _Pragma("unroll") for (int ks_ = 0; ks_ < 8; ++ks_) acc_ = __builtin_amdgcn_mfma_f32_32x32x16_bf16(src[ks_], qf[ks_], acc_, 0, 0, 0); \
            _Pragma("unroll") for (int r_ = 0; r_ < 16; ++r_) { const int key_ = 32 * (mt_) + (r_ & 3) + 8 * (r_ >> 2) + 4 * hh; const int v__ = (ord(acc_[r_]) & ~127) | (127 - key_); PS_INS(top, v__); } } while (0)
        PS_LDK(kfa, 0);
        PS_LDK(kfb, 1); PS_TILE(kfa, 0);
        PS_LDK(kfa, 2); PS_TILE(kfb, 1);
        PS_LDK(kfb, 3); PS_TILE(kfa, 2);
        PS_TILE(kfb, 3);
#undef PS_LDK
#undef PS_TILE
        int oth[16];
#pragma unroll
        for (int i = 0; i < 16; ++i) oth[i] = __shfl_xor(top[i], 32);
#pragma unroll
        for (int i = 0; i < 16; ++i) PS_INS(top, oth[i]);
        if (hh == 0) {
#pragma unroll
            for (int i = 0; i < 16; ++i) EX[(w1 * 16 + i) * 32 + c32] = top[i];
        }
    }
}
__device__ __forceinline__ void stage2(PS_LAS int* EXall, int* __restrict__ IDX, float* __restrict__ GATE, int tok0) {
    const int tid = opaque_tid();
    {
        const int hp = tid >> 7, task = tid & 127, th = task >> 5, tok32 = task & 31, tile = th >> 1, hsel = th & 1, h = 2 * hp + hsel;
        PS_LAS int* EX = EXall + hp * 4096;
        const PS_LAS int* ea = EX + ((th * 2 + 0) * 16) * 32 + tok32; const PS_LAS int* eb = EX + ((th * 2 + 1) * 16) * 32 + tok32;
        float as[16], bs[16];
#pragma unroll
        for (int i = 0; i < 16; ++i) { as[i] = unord(ea[i * 32] & ~127); bs[i] = unord(eb[i * 32] & ~127); }
        int top[16];
#pragma unroll
        for (int i = 0; i < 16; ++i) top[i] = (int)0x80000000;
#pragma unroll
        for (int i = 0; i < 16; ++i)
#pragma unroll
            for (int j = 0; j < 16; ++j) if ((i + 1) * (j + 1) <= 16) { const int v = (ord(as[i] + bs[j]) & ~255) | (255 - (i * 16 + j)); PS_INS(top, v); }
        float sc[16]; int id[16];
#pragma unroll
        for (int r = 0; r < 16; ++r) { const int cn = 255 - (top[r] & 255), i = cn >> 4, j = cn & 15; const int pa = ea[i * 32], pb = eb[j * 32];
            sc[r] = unord(pa & ~127) + unord(pb & ~127); id[r] = (127 - (pa & 127)) * 128 + (127 - (pb & 127)); }
        float sum = 0.f; const float mx = sc[0];
#pragma unroll
        for (int r = 0; r < 16; ++r) { sc[r] = __expf(sc[r] - mx); sum += sc[r]; }
        const size_t o = (size_t)(tok0 + 32 * tile + tok32) * 128 + h * 16;
        const float inv = 1.f / sum;
#pragma unroll
        for (int r = 0; r < 16; r += 4) { *(f32x4*)(GATE + o + r) = (f32x4){sc[r] * inv, sc[r + 1] * inv, sc[r + 2] * inv, sc[r + 3] * inv}; *(u32x4*)(IDX + o + r) = (u32x4){(unsigned)id[r], (unsigned)id[r + 1], (unsigned)id[r + 2], (unsigned)id[r + 3]}; }
    }
}
}


namespace xattn {
#define XA_LAS __attribute__((address_space(3)))
typedef short bf16x8 __attribute__((ext_vector_type(8)));
typedef short s16x4 __attribute__((ext_vector_type(4)));
typedef float f32x16 __attribute__((ext_vector_type(16)));
constexpr int RP = 528;
__device__ __forceinline__ unsigned cvtpk(float lo, float hi) { typedef float f2 __attribute__((ext_vector_type(2))); typedef __bf16 b2 __attribute__((ext_vector_type(2))); f2 v = {lo, hi}; b2 b = __builtin_convertvector(v, b2); return __builtin_bit_cast(unsigned, b); }
__device__ __forceinline__ void stage(XA_LAS unsigned char* lds, const bf16_t* __restrict__ src, int pitch, int tid) {
#pragma unroll 4
    for (int i = 0; i < 16; ++i) { const int q = tid + 512 * i, row = q >> 5, ch = q & 31; *(XA_LAS u32x4*)(lds + row * RP + ch * 16) = *(const u32x4*)(src + (size_t)row * pitch + ch * 8); }
}
__device__ __forceinline__ void unit(XA_LAS unsigned char* lds, const bf16_t* __restrict__ QC, const bf16_t* __restrict__ KC, const bf16_t* __restrict__ VcT, bf16_t* __restrict__ XO, int tg, int h) {
    const int tid = opaque_tid(), lane = tid & 63, w = __builtin_amdgcn_readfirstlane(tid >> 6), c32 = lane & 31, hh = lane >> 5, b = tg >> 5;
    const int tok = 256 * tg + 32 * w + c32;
    stage(lds, KC + (size_t)b * MEML * D + h * 256, D, tid);
    bf16x8 pf[8][2]; float inv;
    {
        bf16x8 qf[16];
        const bf16_t* qp = QC + (size_t)tok * D + h * 256 + 8 * hh;
#pragma unroll
        for (int ks = 0; ks < 16; ++ks) qf[ks] = *(const bf16x8*)(qp + 16 * ks);
        __syncthreads();
        f32x16 acc[8];
        const XA_LAS unsigned char* kb = lds + c32 * RP + 16 * hh;
#pragma unroll
        for (int mt = 0; mt < 8; ++mt) {
            acc[mt] = (f32x16){0.f, 0.f, 0.f, 0.f, 0.f, 0.f, 0.f, 0.f, 0.f, 0.f, 0.f, 0.f, 0.f, 0.f, 0.f, 0.f};
#pragma unroll
            for (int ks = 0; ks < 16; ++ks) acc[mt] = __builtin_amdgcn_mfma_f32_32x32x16_bf16(*(const XA_LAS bf16x8*)(kb + (32 * mt) * RP + 32 * ks), qf[ks], acc[mt], 0, 0, 0);
        }
        float mx = acc[0][0];
#pragma unroll
        for (int mt = 0; mt < 8; ++mt)
#pragma unroll
            for (int r = 0; r < 16; ++r) mx = fmaxf(mx, acc[mt][r]);
        mx = fmaxf(mx, __shfl_xor(mx, 32));
        float sum = 0.f;
#pragma unroll
        for (int mt = 0; mt < 8; ++mt)
#pragma unroll
            for (int r = 0; r < 16; ++r) { acc[mt][r] = __builtin_amdgcn_exp2f(acc[mt][r] - mx); sum += acc[mt][r]; }
        sum += __shfl_xor(sum, 32); inv = 1.f / sum;
#pragma unroll
        for (int mt = 0; mt < 8; ++mt)
#pragma unroll
            for (int s2 = 0; s2 < 2; ++s2) { u32x4 a; a.x = cvtpk(acc[mt][8 * s2], acc[mt][8 * s2 + 1]); a.y = cvtpk(acc[mt][8 * s2 + 2], acc[mt][8 * s2 + 3]); a.z = cvtpk(acc[mt][8 * s2 + 4], acc[mt][8 * s2 + 5]); a.w = cvtpk(acc[mt][8 * s2 + 6], acc[mt][8 * s2 + 7]);
                pf[mt][s2] = __builtin_bit_cast(bf16x8, a); }
    }
    __syncthreads();
    stage(lds, VcT + ((size_t)b * D + h * 256) * MEML, MEML, tid);
    __syncthreads();
    const XA_LAS unsigned char* vb = lds + c32 * RP + 8 * hh;
    bf16_t* op = XO + (size_t)tok * D + h * 256 + 4 * hh;
#pragma unroll 1
    for (int dt = 0; dt < 8; ++dt) {
        f32x16 acc = (f32x16){0.f, 0.f, 0.f, 0.f, 0.f, 0.f, 0.f, 0.f, 0.f, 0.f, 0.f, 0.f, 0.f, 0.f, 0.f, 0.f};
#pragma unroll
        for (int mt = 0; mt < 8; ++mt)
#pragma unroll
            for (int s2 = 0; s2 < 2; ++s2) {
                const s16x4 lo = *(const XA_LAS s16x4*)(vb + (32 * dt) * RP + (32 * mt + 16 * s2) * 2), hi = *(const XA_LAS s16x4*)(vb + (32 * dt) * RP + (32 * mt + 16 * s2 + 8) * 2);
                const bf16x8 vf = (bf16x8){lo[0], lo[1], lo[2], lo[3], hi[0], hi[1], hi[2], hi[3]};
                acc = __builtin_amdgcn_mfma_f32_32x32x16_bf16(vf, pf[mt][s2], acc, 0, 0, 0);
            }
#pragma unroll
        for (int q = 0; q < 4; ++q) { u32x2 o; o.x = cvtpk(acc[4 * q] * inv, acc[4 * q + 1] * inv); o.y = cvtpk(acc[4 * q + 2] * inv, acc[4 * q + 3] * inv); *(u32x2*)(op + 32 * dt + 8 * q) = o; }
    }
    __syncthreads();
}
}

namespace sp {
#define SP_LAS __attribute__((address_space(3)))
#define SP_LDSWAIT() do { asm volatile("s_waitcnt lgkmcnt(0)" ::: "memory"); } while (0)
__device__ __forceinline__ void transpose_item(const float* __restrict__ W, int ldw, int col0, int K, int nblk, bf16_t* __restrict__ WT, int row_off, SP_LAS float* scr, int item, int lane) {
    const int kb = item / nblk, nb = item % nblk, k0 = 64 * kb, n0 = 32 * nb;
#pragma unroll 8
    for (int i = 0; i < 32; ++i) { const int kk = 2 * i + (lane >> 5); scr[kk * 33 + (lane & 31)] = W[(size_t)(k0 + kk) * ldw + col0 + n0 + (lane & 31)]; }
    SP_LDSWAIT();
    const int cc = lane & 7;
#pragma unroll
    for (int j = 0; j < 4; ++j) { const int n = (lane >> 3) + 8 * j; const SP_LAS float* s = scr + (8 * cc) * 33 + n;
        u32x4 o; o.x = pk2(s[0 * 33], s[1 * 33]); o.y = pk2(s[2 * 33], s[3 * 33]); o.z = pk2(s[4 * 33], s[5 * 33]); o.w = pk2(s[6 * 33], s[7 * 33]);
        *(u32x4*)(WT + (size_t)(row_off + n0 + n) * K + k0 + 8 * cc) = o; }
    SP_LDSWAIT();
}
__device__ __forceinline__ void cvt_range(const float* __restrict__ src, bf16_t* __restrict__ dst, size_t n4, size_t gtid, size_t gthreads) {
    for (size_t i = gtid; i < n4; i += gthreads) { const f32x4 v = ((const f32x4*)src)[i]; u32x2 o; o.x = pk2(v.x, v.y); o.y = pk2(v.z, v.w); ((u32x2*)dst)[i] = o; }
}

__device__ __forceinline__ void cvt_fp8_range(const float* __restrict__ src, unsigned char* __restrict__ dst, size_t n16, float scale, size_t gtid, size_t gthreads) {
    for (size_t i0 = gtid; i0 < n16; i0 += 2 * gthreads) {
        const size_t i1 = (i0 + gthreads < n16) ? i0 + gthreads : i0;
        f32x4 v[2][4];
#pragma unroll
        for (int q = 0; q < 4; ++q) { v[0][q] = ((const f32x4*)src + 4 * i0)[q]; v[1][q] = ((const f32x4*)src + 4 * i1)[q]; }
#pragma unroll
        for (int u = 0; u < 2; ++u) { const size_t i = u ? i1 : i0; unsigned ow[4];
#pragma unroll
            for (int q = 0; q < 4; ++q) { const f32x4 t = v[u][q];
                const float a = fminf(fmaxf(t.x * scale, -448.f), 448.f), b = fminf(fmaxf(t.y * scale, -448.f), 448.f), c2 = fminf(fmaxf(t.z * scale, -448.f), 448.f), d2 = fminf(fmaxf(t.w * scale, -448.f), 448.f);
                int p = 0; p = __builtin_amdgcn_cvt_pk_fp8_f32(a, b, p, false); p = __builtin_amdgcn_cvt_pk_fp8_f32(c2, d2, p, true); ow[q] = (unsigned)p; }
            u32x4 o; o.x = ow[0]; o.y = ow[1]; o.z = ow[2]; o.w = ow[3];
            const size_t e_ = i >> 6, cg_ = i & 63; ((u32x4*)dst)[(cg_ >> 3) * ((size_t)PK * PK * 8) + e_ * 8 + (cg_ & 7)] = o; }
    }
}
__device__ __forceinline__ void dt_stage_w(SP_LAS float* Wl, const float* __restrict__ w_in) {
    const int tid = opaque_tid();
#pragma unroll 8
    for (int i = 0; i < 64; ++i) { const int idx = tid + 512 * i; Wl[idx] = w_in[(size_t)(idx >> 5) * NIN + 5120 + (idx & 31)]; }
}
__device__ __forceinline__ void dt_items(SP_LAS float* Wl, SP_LAS float* xs, SP_LAS float* part, const float* __restrict__ x, const float* __restrict__ dt_bias, float* __restrict__ DT, bf16_t* __restrict__ XBo, int it0, int stride, int it_end) {
    const int tid = opaque_tid(), lane = tid & 63, w = tid >> 6;
    const int h = lane & 31, r = w >> 1, kq = (w & 1) * 2 + (lane >> 5);
    const SP_LAS float* xp = xs + r * 1024 + kq * 256; const SP_LAS float* wp = Wl + (kq * 256) * 32 + h;
    const float bias = dt_bias[h];
    f32x4 nx[2];
    if (it0 < it_end) {
#pragma unroll
        for (int i = 0; i < 2; ++i) nx[i] = ((const f32x4*)(x + (size_t)it0 * 4 * D))[tid + 512 * i];
    }
    for (int item = it0; item < it_end; item += stride) {
        const int m0 = item * 4;
#pragma unroll
        for (int i = 0; i < 2; ++i) { const int q = tid + 512 * i; const f32x4 v = nx[i]; *(SP_LAS f32x4*)(xs + 4 * q) = v;
            u32x2 o; o.x = pk2(v.x, v.y); o.y = pk2(v.z, v.w); ((u32x2*)(XBo + (size_t)m0 * D))[q] = o; }
        __syncthreads();
        { const int nitem = (item + stride < it_end) ? item + stride : item;
#pragma unroll
          for (int i = 0; i < 2; ++i) nx[i] = ((const f32x4*)(x + (size_t)nitem * 4 * D))[tid + 512 * i]; }
        float a0 = 0.f, a1 = 0.f;
#pragma unroll 8
        for (int k = 0; k < 256; k += 2) { a0 = fmaf(xp[k], wp[k * 32], a0); a1 = fmaf(xp[k + 1], wp[(k + 1) * 32], a1); }
        float acc = a0 + a1;
        acc += __shfl_xor(acc, 32);
        if ((w & 1) && lane < 32) part[r * 32 + h] = acc;
        __syncthreads();
        if (!(w & 1) && lane < 32) { const float v = acc + part[r * 32 + h] + bias; DT[(size_t)(m0 + r) * 32 + h] = v > 20.f ? v : log1pf(expf(v)); }
    }
}
__device__ __forceinline__ void ln_row(float* __restrict__ X, const float* __restrict__ g, const float* __restrict__ b, bf16_t* __restrict__ XB, int row, int lane) {
    f32x4* xr = (f32x4*)(X + (size_t)row * D) + lane;
    f32x4 v[4]; float s = 0.f;
#pragma unroll
    for (int j = 0; j < 4; ++j) { v[j] = xr[64 * j]; s += (v[j].x + v[j].y) + (v[j].z + v[j].w); }
    const float mean = wave_sum(s) * (1.f / D); float s2 = 0.f;
#pragma unroll
    for (int j = 0; j < 4; ++j) { v[j] = v[j] - mean; s2 += (v[j].x * v[j].x + v[j].y * v[j].y) + (v[j].z * v[j].z + v[j].w * v[j].w); }
    const float rstd = rsqrtf(wave_sum(s2) * (1.f / D) + 1e-5f);
#pragma unroll
    for (int j = 0; j < 4; ++j) { const int c = 4 * lane + 256 * j; const f32x4 gg = *(const f32x4*)(g + c), bb = *(const f32x4*)(b + c);
        f32x4 o = v[j] * rstd * gg + bb; xr[64 * j] = o;
        u32x2 pb; pb.x = pk2(o.x, o.y); pb.y = pk2(o.z, o.w); *(u32x2*)(XB + (size_t)row * D + c) = pb; }
}
__device__ __forceinline__ void xattn_pair(SP_LAS float* L, const bf16_t* __restrict__ QC, const bf16_t* __restrict__ KCVC, bf16_t* __restrict__ XO, int tok0) {
    const int t512 = opaque_tid(); const int half = t512 >> 8, tid = t512 & 255, lane = tid & 63, wv = tid >> 6, tok = tok0 + half, b = tok / SEQ;
    SP_LAS float* qs = L + half * 1024; SP_LAS float* ps = L + 2048 + half * 256; SP_LAS float* red = L + 2560 + half * 8;
    for (int i = tid; i < 1024; i += 256) qs[i] = bf2f(QC[(size_t)tok * D + i]);
    __syncthreads();
    const bf16_t* KV = KCVC + (size_t)b * MEML * 2048;
    for (int h = 0; h < MH; ++h) {
        const bf16_t* kp = KV + (size_t)tid * 2048 + h * 256;
        float s = 0.f;
        for (int d = 0; d < 256; d += 8) { const u32x4 w = *(const u32x4*)(kp + d); const SP_LAS float* q = qs + h * 256 + d;
            s += q[0] * bflo(w.x) + q[1] * bfhi(w.x) + q[2] * bflo(w.y) + q[3] * bfhi(w.y) + q[4] * bflo(w.z) + q[5] * bfhi(w.z) + q[6] * bflo(w.w) + q[7] * bfhi(w.w); }
        float mx = wave_max(s); if (lane == 0) red[wv] = mx; __syncthreads();
        mx = fmaxf(fmaxf(red[0], red[1]), fmaxf(red[2], red[3]));
        const float p = exp2f(s - mx);
        float sm = wave_sum(p); if (lane == 0) red[4 + wv] = sm; ps[tid] = p; __syncthreads();
        sm = (red[4] + red[5]) + (red[6] + red[7]);
        float o = 0.f;
        for (int j = 0; j < 256; ++j) o = fmaf(ps[j], bf2f(KV[(size_t)j * 2048 + 1024 + h * 256 + tid]), o);
        XO[(size_t)tok * D + h * 256 + tid] = (bf16_t)f2bf(o / sm);
        __syncthreads();
    }
}
__device__ __forceinline__ void select_pair(SP_LAS float* L, const bf16_t* __restrict__ QP, const bf16_t* __restrict__ SUBK, int* __restrict__ IDX, float* __restrict__ GATE, int tok0) {
    const int t512 = opaque_tid(); const int hf = t512 >> 8, tid = t512 & 255, tok = tok0 + hf;
    SP_LAS float* base = L + hf * 3072;
    SP_LAS float* qs = base; SP_LAS float* s = base + 2048; SP_LAS float* tops = base + 2304; SP_LAS int* topi = (SP_LAS int*)(base + 2336); SP_LAS float* cs = base + 2368; SP_LAS int* ci = (SP_LAS int*)(base + 2624);
    SP_LAS float* bs = base + 2880; SP_LAS int* bi = (SP_LAS int*)(base + 2896);
    for (int i = tid; i < 2048; i += 256) qs[i] = bf2f(QP[(size_t)tok * 2048 + i]);
    __syncthreads();
    for (int h = 0; h < PH; ++h) {
        const int half = tid >> 7, key = tid & 127;
        { const bf16_t* kp = SUBK + ((size_t)(h * 2 + half) * 128 + key) * 128; const SP_LAS float* q = qs + h * 256 + half * 128; float a = 0.f;
          for (int d = 0; d < 128; d += 8) { const u32x4 w = *(const u32x4*)(kp + d);
              a += q[d] * bflo(w.x) + q[d + 1] * bfhi(w.x) + q[d + 2] * bflo(w.y) + q[d + 3] * bfhi(w.y) + q[d + 4] * bflo(w.z) + q[d + 5] * bfhi(w.z) + q[d + 6] * bflo(w.w) + q[d + 7] * bfhi(w.w); }
          s[tid] = a; }
        __syncthreads();
        { const float me = s[tid]; int rank = 0; const SP_LAS float* spp = s + half * 128;
          for (int j = 0; j < 128; ++j) { const float o = spp[j]; rank += (o > me || (o == me && j < key)) ? 1 : 0; }
          if (rank < 16) { tops[half * 16 + rank] = me; topi[half * 16 + rank] = key; } }
        __syncthreads();
        { const int i = tid >> 4, j = tid & 15; cs[tid] = tops[i] + tops[16 + j]; ci[tid] = topi[i] * 128 + topi[16 + j]; }
        __syncthreads();
        { const float me = cs[tid]; int rank = 0;
          for (int j = 0; j < 256; ++j) { const float o = cs[j]; rank += (o > me || (o == me && j < tid)) ? 1 : 0; }
          if (rank < 16) { bs[rank] = me; bi[rank] = ci[tid]; } }
        __syncthreads();
        if (tid < 16) { const float mx = bs[0]; float sum = 0.f;
            for (int j = 0; j < 16; ++j) sum += expf(bs[j] - mx);
            GATE[(size_t)tok * 128 + h * 16 + tid] = expf(bs[tid] - mx) / sum; IDX[(size_t)tok * 128 + h * 16 + tid] = bi[tid]; }
        __syncthreads();
    }
}
__device__ __forceinline__ void gather_token(SP_LAS float* L, float* __restrict__ X, const bf16_t* __restrict__ PU, const bf16_t* __restrict__ PV, const int* __restrict__ IDX, const float* __restrict__ GATE,
                                             const float* __restrict__ g3, const float* __restrict__ b3, int tok) {
    const int tid = opaque_tid(), lane = tid & 63, wv = tid >> 6;
    SP_LAS float* ys = L; SP_LAS float* red = L + 8192;
    float xr[16], y[16];
    { const float* xp = X + (size_t)tok * D + lane * 16;
#pragma unroll
      for (int j = 0; j < 4; ++j) { const f32x4 v = *(const f32x4*)(xp + 4 * j); xr[4 * j] = v.x; xr[4 * j + 1] = v.y; xr[4 * j + 2] = v.z; xr[4 * j + 3] = v.w; }
#pragma unroll
      for (int j = 0; j < 16; ++j) y[j] = 0.f; }
    for (int e = 0; e < 16; ++e) {
        const int slot = wv * 16 + e; const int id = IDX[(size_t)tok * 128 + slot]; const float gt = GATE[(size_t)tok * 128 + slot];
        const bf16_t* up = PU + (size_t)id * D + lane * 16; const u32x4 u0 = *(const u32x4*)up, u1 = *(const u32x4*)(up + 8);
        const unsigned uw[8] = {u0.x, u0.y, u0.z, u0.w, u1.x, u1.y, u1.z, u1.w};
        float hsum = 0.f;
#pragma unroll
        for (int j = 0; j < 8; ++j) { hsum = fmaf(xr[2 * j], bflo(uw[j]), hsum); hsum = fmaf(xr[2 * j + 1], bfhi(uw[j]), hsum); }
        hsum = wave_sum(hsum);
        const float w = gt * 0.5f * hsum * (1.f + erff(hsum * 0.70710678118654752f));
        const bf16_t* vp = PV + (size_t)id * D + lane * 16; const u32x4 v0 = *(const u32x4*)vp, v1 = *(const u32x4*)(vp + 8);
        const unsigned vw[8] = {v0.x, v0.y, v0.z, v0.w, v1.x, v1.y, v1.z, v1.w};
#pragma unroll
        for (int j = 0; j < 8; ++j) { y[2 * j] = fmaf(w, bflo(vw[j]), y[2 * j]); y[2 * j + 1] = fmaf(w, bfhi(vw[j]), y[2 * j + 1]); }
    }
#pragma unroll
    for (int j = 0; j < 16; ++j) ys[wv * 1024 + lane * 16 + j] = y[j];
    __syncthreads();
    float v[2]; float s = 0.f;
#pragma unroll
    for (int j = 0; j < 2; ++j) { const int c = tid * 2 + j; float a = 0.f;
#pragma unroll
        for (int k = 0; k < 8; ++k) a += ys[k * 1024 + c];
        v[j] = ALPHA * X[(size_t)tok * D + c] + a; s += v[j]; }
    s = wave_sum(s); if (lane == 0) red[wv] = s; __syncthreads();
    float tot = 0.f;
#pragma unroll
    for (int k = 0; k < 8; ++k) tot += red[k];
    const float mean = tot * (1.f / D);
    float s2 = 0.f;
#pragma unroll
    for (int j = 0; j < 2; ++j) { v[j] -= mean; s2 += v[j] * v[j]; }
    s2 = wave_sum(s2); if (lane == 0) red[8 + wv] = s2; __syncthreads();
    float tot2 = 0.f;
#pragma unroll
    for (int k = 0; k < 8; ++k) tot2 += red[8 + k];
    const float rstd = rsqrtf(tot2 * (1.f / D) + 1e-5f);
#pragma unroll
    for (int j = 0; j < 2; ++j) { const int c = tid * 2 + j; X[(size_t)tok * D + c] = v[j] * rstd * g3[c] + b3[c]; }
    __syncthreads();
}

constexpr float PEER_SU = 2048.f, PEER_SV = 256.f;
typedef float f32x2v __attribute__((ext_vector_type(2)));
__device__ __forceinline__ void gather_wave(float* __restrict__ Xo, const float* X, const unsigned char* __restrict__ PU, const unsigned char* __restrict__ PV, const int* __restrict__ IDX, const float* __restrict__ GATE,
                                            const float* __restrict__ g3, const float* __restrict__ b3, int tok, int lane) {
    float xr[16], y[16];
    { const f32x4* xp = (const f32x4*)(X + (size_t)tok * D + 16 * lane);
#pragma unroll
      for (int q = 0; q < 4; ++q) { const f32x4 v = xp[q]; xr[4 * q] = v.x; xr[4 * q + 1] = v.y; xr[4 * q + 2] = v.z; xr[4 * q + 3] = v.w; } }
#pragma unroll
    for (int j = 0; j < 16; ++j) y[j] = 0.f;
    const int id0 = IDX[(size_t)tok * 128 + lane], id1 = IDX[(size_t)tok * 128 + 64 + lane];
    const float gt0 = GATE[(size_t)tok * 128 + lane], gt1 = GATE[(size_t)tok * 128 + 64 + lane];
    u32x4 ub[8], vb[8];
#define GW_ISSUE(buf, TBL, i) do { const int idv_ = ((i) < 8) ? id0 : id1; _Pragma("unroll") for (int k_ = 0; k_ < 8; ++k_) { \
        const int id_ = __builtin_amdgcn_readlane(idv_, (8 * (i) + k_) & 63); buf[k_] = *(const u32x4*)((TBL) + (size_t)id_ * D + 16 * lane); } } while (0)
    GW_ISSUE(ub, PU, 0); GW_ISSUE(vb, PV, 0);
    const bool h32 = (lane & 32) != 0, h16 = (lane & 16) != 0, h8 = (lane & 8) != 0;
#pragma unroll 1
    for (int i = 0; i < 16; ++i) {
        float p[8];
#pragma unroll
        for (int k = 0; k < 8; ++k) { const unsigned w[4] = {ub[k].x, ub[k].y, ub[k].z, ub[k].w}; float a = 0.f;
#pragma unroll
            for (int q = 0; q < 4; ++q) { const f32x2v lo = __builtin_amdgcn_cvt_pk_f32_fp8((int)w[q], false), hi = __builtin_amdgcn_cvt_pk_f32_fp8((int)w[q], true);
                a = fmaf(xr[4 * q], lo.x, a); a = fmaf(xr[4 * q + 1], lo.y, a); a = fmaf(xr[4 * q + 2], hi.x, a); a = fmaf(xr[4 * q + 3], hi.y, a); }
            p[k] = a; }
        { const int in_ = (i + 1 < 16) ? i + 1 : 15; GW_ISSUE(ub, PU, in_); }
        float q4[4], q2[2], q1;
#pragma unroll
        for (int k = 0; k < 4; ++k) q4[k] = (h32 ? p[k + 4] : p[k]) + __shfl_xor(h32 ? p[k] : p[k + 4], 32);
#pragma unroll
        for (int k = 0; k < 2; ++k) q2[k] = (h16 ? q4[k + 2] : q4[k]) + __shfl_xor(h16 ? q4[k] : q4[k + 2], 16);
        q1 = (h8 ? q2[1] : q2[0]) + __shfl_xor(h8 ? q2[0] : q2[1], 8);
        q1 += __shfl_xor(q1, 4); q1 += __shfl_xor(q1, 2); q1 += __shfl_xor(q1, 1);
        q1 *= (1.f / PEER_SU);
        const float gsel = __shfl((i < 8) ? gt0 : gt1, (8 * i + (lane >> 3)) & 63);
        const float wv = gsel * 0.5f * q1 * (1.f + erff(q1 * 0.70710678118654752f));
#pragma unroll
        for (int k = 0; k < 8; ++k) { const float wk = __builtin_bit_cast(float, __builtin_amdgcn_readlane(__builtin_bit_cast(int, wv), 8 * k));
            const unsigned w[4] = {vb[k].x, vb[k].y, vb[k].z, vb[k].w};
#pragma unroll
            for (int q = 0; q < 4; ++q) { const f32x2v lo = __builtin_amdgcn_cvt_pk_f32_fp8((int)w[q], false), hi = __builtin_amdgcn_cvt_pk_f32_fp8((int)w[q], true);
                y[4 * q] = fmaf(wk, lo.x, y[4 * q]); y[4 * q + 1] = fmaf(wk, lo.y, y[4 * q + 1]); y[4 * q + 2] = fmaf(wk, hi.x, y[4 * q + 2]); y[4 * q + 3] = fmaf(wk, hi.y, y[4 * q + 3]); } }
        { const int in_ = (i + 1 < 16) ? i + 1 : 15; GW_ISSUE(vb, PV, in_); }
    }
#undef GW_ISSUE
    float s = 0.f;
#pragma unroll
    for (int j = 0; j < 16; ++j) { y[j] = ALPHA * xr[j] + y[j] * (1.f / PEER_SV); s += y[j]; }
    const float mean = wave_sum(s) * (1.f / D); float s2 = 0.f;
#pragma unroll
    for (int j = 0; j < 16; ++j) { y[j] -= mean; s2 += y[j] * y[j]; }
    const float rstd = rsqrtf(wave_sum(s2) * (1.f / D) + 1e-5f);
    float* op = Xo + (size_t)tok * D + 16 * lane;
#pragma unroll
    for (int q = 0; q < 4; ++q) { const f32x4 gg = *(const f32x4*)(g3 + 16 * lane + 4 * q), bb = *(const f32x4*)(b3 + 16 * lane + 4 * q);
        f32x4 o; o.x = y[4 * q] * rstd * gg.x + bb.x; o.y = y[4 * q + 1] * rstd * gg.y + bb.y; o.z = y[4 * q + 2] * rstd * gg.z + bb.z; o.w = y[4 * q + 3] * rstd * gg.w + bb.w;
        *(f32x4*)(op + 4 * q) = o; }
}
}


#define LAS __attribute__((address_space(3)))
#define XB_TMO      128
#define XB_XCNT(j)  (256  + 64 * (j))
#define XB_XSUB(j)  (1280 + 64 * (j))
#define XB_XGEN(j)  (2304 + 64 * (j))
#define XB_TOP      3328
#define XB_TOPGEN   3392
#define XCD_BAR_WORDS 3456
#define XB_SPIN_CAP (1u << 18)
__device__ __forceinline__ unsigned xb_ld(unsigned* p)              { return __hip_atomic_load(p, __ATOMIC_RELAXED, __HIP_MEMORY_SCOPE_AGENT); }
__device__ __forceinline__ unsigned xb_add(unsigned* p, unsigned v) { return __hip_atomic_fetch_add(p, v, __ATOMIC_RELAXED, __HIP_MEMORY_SCOPE_AGENT); }
__device__ __forceinline__ unsigned xb_xcc_id() { return (unsigned)__builtin_amdgcn_s_getreg((3 << 11) | 20) & 0xFu; }
#define XB_SPIN(cond, bar) do { unsigned _sp = 0; while (cond) { __builtin_amdgcn_s_sleep(1); \
    if ((++_sp & 255u) == 0u) { if (xb_ld(&(bar)[XB_TMO])) break; if (_sp > XB_SPIN_CAP) { atomicAdd(&(bar)[XB_TMO], 1u); break; } } } } while (0)
struct XcdBarrier { unsigned* bar; unsigned x; volatile LAS unsigned* st; };
__device__ __forceinline__ XcdBarrier xcd_barrier_post(unsigned* bar, volatile LAS unsigned* st) {
    XcdBarrier b; b.bar = bar; b.x = xb_xcc_id(); b.st = st;
    if (threadIdx.x == 0) (void)xb_add(&bar[XB_XCNT(b.x)], 1u);
    return b;
}
__device__ __forceinline__ void xcd_barrier_complete(unsigned* bar, unsigned x, unsigned& nloc, unsigned& nx) {
    const unsigned G = gridDim.x * gridDim.y * gridDim.z;
    unsigned sum, cnt, mine, sp = 0u;
    for (;;) {
        sum = 0u; cnt = 0u; mine = 0u;
#pragma unroll
        for (unsigned j = 0; j < 16; ++j) { const unsigned c = xb_ld(&bar[XB_XCNT(j)]); sum += c; cnt += (c > 0u) ? 1u : 0u; mine = (j == x) ? c : mine; }
        if (sum == G) break;
        __builtin_amdgcn_s_sleep(1);
        if ((++sp & 255u) == 0u) { if (xb_ld(&bar[XB_TMO])) break; if (sp > XB_SPIN_CAP) { atomicAdd(&bar[XB_TMO], 1u); break; } }
    }
    nloc = mine > 0u ? mine : 1u; nx = cnt > 0u ? cnt : 1u;
}
__device__ __forceinline__ void xcd_barrier(const XcdBarrier& b) {
    asm volatile("s_waitcnt vmcnt(0)" ::: "memory");
    __syncthreads();
    if (threadIdx.x == 0) {
        unsigned* bar = b.bar;
        __builtin_amdgcn_s_waitcnt(0);
        unsigned nloc = b.st[0], nx = b.st[1];
        if (nloc == 0u) { xcd_barrier_complete(bar, b.x, nloc, nx); b.st[0] = nloc; b.st[1] = nx; }
        const unsigned old = xb_add(&bar[XB_XSUB(b.x)], 1u);
        const unsigned gen = old / nloc;
        if (old + 1u == (gen + 1u) * nloc) {
            __builtin_amdgcn_fence(__ATOMIC_RELEASE, "agent");
            asm volatile("s_waitcnt vmcnt(0)" ::: "memory");
            const unsigned og = xb_add(&bar[XB_TOP], 1u);
            const unsigned tg = og / nx;
            if (og + 1u == (tg + 1u) * nx) xb_add(&bar[XB_TOPGEN], 1u);
            else XB_SPIN(xb_ld(&bar[XB_TOPGEN]) == tg, bar);
            __builtin_amdgcn_fence(__ATOMIC_ACQUIRE, "agent");
            xb_add(&bar[XB_XGEN(b.x)], 1u);
            asm volatile("s_waitcnt vmcnt(0)" ::: "memory");
        } else {
            XB_SPIN(xb_ld(&bar[XB_XGEN(b.x)]) == gen, bar);
            __builtin_amdgcn_fence(__ATOMIC_ACQUIRE, "agent");
            asm volatile("s_waitcnt vmcnt(0)" ::: "memory");
        }
    }
    __syncthreads();
}
constexpr int CW_BAR = 4096;
constexpr int MISC_OFF = 147456;


namespace peer2 {
#define P2_LAS __attribute__((address_space(3)))
typedef float f32x2v __attribute__((ext_vector_type(2)));
constexpr int CW_TICK = 8192;
__device__ __forceinline__ float dpp_add_xor1(float v) { return v + __builtin_bit_cast(float, __builtin_amdgcn_update_dpp(0, __builtin_bit_cast(int, v), 0xB1, 0xf, 0xf, true)); }
__device__ __forceinline__ float dpp_add_xor2(float v) { return v + __builtin_bit_cast(float, __builtin_amdgcn_update_dpp(0, __builtin_bit_cast(int, v), 0x4E, 0xf, 0xf, true)); }
__device__ __forceinline__ float dpp_add_hmir(float v) { return v + __builtin_bit_cast(float, __builtin_amdgcn_update_dpp(0, __builtin_bit_cast(int, v), 0x141, 0xf, 0xf, true)); }
__device__ __forceinline__ float dpp_ror8(float v) { return __builtin_bit_cast(float, __builtin_amdgcn_update_dpp(0, __builtin_bit_cast(int, v), 0x128, 0xf, 0xf, true)); }
__device__ __forceinline__ float swap32_sum(float a, float b) { auto r = __builtin_amdgcn_permlane32_swap(__builtin_bit_cast(unsigned, a), __builtin_bit_cast(unsigned, b), false, false); return __builtin_bit_cast(float, r[0]) + __builtin_bit_cast(float, r[1]); }
struct Own { int j, rank, nrank, nsl; };
__device__ __forceinline__ Own ownership(unsigned* ctl, P2_LAS unsigned* scr, int phase, int wave) {
    const int G = gridDim.x;
    if (threadIdx.x == 0) {
        unsigned* bar = ctl + CW_BAR; bool uni = (G % 8) == 0;
        for (int j = 0; j < 8; ++j) uni = uni && (xb_ld(&bar[XB_XCNT(j)]) == (unsigned)(G / 8));
        const unsigned xcc = xb_xcc_id();
        if (uni && xcc < 8u) { scr[0] = xcc; scr[1] = xb_add(&ctl[CW_TICK + 64 * (8 * phase + (int)xcc)], 1u); }
        else { scr[0] = blockIdx.x & 7; scr[1] = blockIdx.x >> 3; }
    }
    __syncthreads();
    Own o;
    if (G % 8 == 0) { o.j = (int)scr[0]; o.rank = (int)scr[1] * 8 + wave; o.nrank = G; o.nsl = 8; }
    else { o.j = 0; o.rank = blockIdx.x * 8 + wave; o.nrank = G * 8; o.nsl = 1; }
    return o;
}
__device__ __forceinline__ float dot16_fp8(const float (&x)[16], const u32x4 u) {
    const unsigned w[4] = {u.x, u.y, u.z, u.w}; f32x2v a = {0.f, 0.f};
#pragma unroll
    for (int q = 0; q < 4; ++q) { const f32x2v lo = __builtin_amdgcn_cvt_pk_f32_fp8((int)w[q], false), hi = __builtin_amdgcn_cvt_pk_f32_fp8((int)w[q], true);
        a = __builtin_elementwise_fma((f32x2v){x[4 * q], x[4 * q + 1]}, lo, a); a = __builtin_elementwise_fma((f32x2v){x[4 * q + 2], x[4 * q + 3]}, hi, a); }
    return a.x + a.y;
}
__device__ __forceinline__ void u_wave(const float* __restrict__ X, const unsigned char* __restrict__ PU, const int* __restrict__ IDX, float* __restrict__ PART, int j, int rank, int nrank, int lane) {
    const int sub = lane & 7, grp = lane >> 3, col0 = 128 * j + 16 * sub;
    float* part = PART + (size_t)j * M * 128 + 16 * grp;
#define PU_LOADIDX(idv, xv, t_) do { const int tt_ = ((t_) < M) ? (t_) : (M - 1); const u32x4* ip_ = (const u32x4*)(IDX + (size_t)tt_ * 128 + 16 * grp); \
        _Pragma("unroll") for (int q_ = 0; q_ < 4; ++q_) { const u32x4 v_ = ip_[q_]; idv[4 * q_] = (int)v_.x; idv[4 * q_ + 1] = (int)v_.y; idv[4 * q_ + 2] = (int)v_.z; idv[4 * q_ + 3] = (int)v_.w; } \
        const f32x4* xp_ = (const f32x4*)(X + (size_t)tt_ * D + col0); \
        _Pragma("unroll") for (int q_ = 0; q_ < 4; ++q_) { const f32x4 v_ = xp_[q_]; xv[4 * q_] = v_.x; xv[4 * q_ + 1] = v_.y; xv[4 * q_ + 2] = v_.z; xv[4 * q_ + 3] = v_.w; } } while (0)
#define PU_GATHER(ubv, idv) do { _Pragma("unroll") for (int it_ = 0; it_ < 16; ++it_) ubv[it_] = *(const u32x4*)(PU + (size_t)j * (PK * PK * 128) + (size_t)idv[it_] * 128 + 16 * sub); } while (0)
#define PU_COMPUTE(ubv, xv, t_) do { float k0_ = 0.f, k1_ = 0.f; _Pragma("unroll") for (int it_ = 0; it_ < 16; ++it_) { float a_ = dot16_fp8(xv, ubv[it_]); a_ = dpp_add_xor1(a_); a_ = dpp_add_xor2(a_); a_ = dpp_add_hmir(a_); \
            if (it_ < 8) k0_ = ((it_ & 7) == sub) ? a_ : k0_; else k1_ = ((it_ & 7) == sub) ? a_ : k1_; } \
        if ((t_) < M) { part[(size_t)(t_) * 128 + sub] = k0_; part[(size_t)(t_) * 128 + sub + 8] = k1_; } } while (0)
    int idA[16], idB[16]; float xA[16], xB[16], xc[16]; u32x4 ubA[16], ubB[16];
    int t = rank;
    PU_LOADIDX(idA, xA, t); PU_GATHER(ubA, idA);
    PU_LOADIDX(idB, xB, t + nrank);
    for (; t < M; t += 2 * nrank) {
        PU_GATHER(ubB, idB);
#pragma unroll
        for (int q = 0; q < 16; ++q) xc[q] = xA[q];
        PU_LOADIDX(idA, xA, t + 2 * nrank);
        PU_COMPUTE(ubA, xc, t);
        PU_GATHER(ubA, idA);
#pragma unroll
        for (int q = 0; q < 16; ++q) xc[q] = xB[q];
        PU_LOADIDX(idB, xB, t + 3 * nrank);
        PU_COMPUTE(ubB, xc, t + nrank);
    }
#undef PU_LOADIDX
#undef PU_GATHER
#undef PU_COMPUTE
}
__device__ __forceinline__ void v_wave(float* __restrict__ X, const unsigned char* __restrict__ PV, const int* __restrict__ IDX, const float* __restrict__ GATE, const float* __restrict__ PART, P2_LAS float* wbuf, int j, int rank, int nrank, int lane) {
    const int sub = lane & 7, grp = lane >> 3, col0 = 128 * j + 16 * sub;
    const bool h32 = (lane & 32) != 0, h16 = (lane & 16) != 0, h8 = (lane & 8) != 0; const int cq = ((lane >> 5) & 1) * 8 + ((lane >> 4) & 1) * 4 + ((lane >> 3) & 1) * 2;
#define PV_ISSUE(vbv, hv, gv, t_) do { const int tt_ = ((t_) < M) ? (t_) : (M - 1); int id_[16]; const u32x4* ip_ = (const u32x4*)(IDX + (size_t)tt_ * 128 + 16 * grp); \
        _Pragma("unroll") for (int q_ = 0; q_ < 4; ++q_) { const u32x4 v_ = ip_[q_]; id_[4 * q_] = (int)v_.x; id_[4 * q_ + 1] = (int)v_.y; id_[4 * q_ + 2] = (int)v_.z; id_[4 * q_ + 3] = (int)v_.w; } \
        _Pragma("unroll") for (int it_ = 0; it_ < 16; ++it_) vbv[it_] = *(const u32x4*)(PV + (size_t)j * (PK * PK * 128) + (size_t)id_[it_] * 128 + 16 * sub); \
        _Pragma("unroll") for (int jj_ = 0; jj_ < 8; ++jj_) { const float* pp_ = PART + ((size_t)jj_ * M + tt_) * 128; hv[2 * jj_] = pp_[lane]; hv[2 * jj_ + 1] = pp_[64 + lane]; } \
        gv[0] = GATE[(size_t)tt_ * 128 + lane]; gv[1] = GATE[(size_t)tt_ * 128 + 64 + lane]; } while (0)
#define PV_COMPUTE(vbv, hv, gv, t_) do { float h0_ = 0.f, h1_ = 0.f; _Pragma("unroll") for (int jj_ = 0; jj_ < 8; ++jj_) { h0_ += hv[2 * jj_]; h1_ += hv[2 * jj_ + 1]; } \
        h0_ *= (1.f / sp::PEER_SU); h1_ *= (1.f / sp::PEER_SU); \
        const float w0_ = gv[0] * 0.5f * h0_ * (1.f + erff(h0_ * 0.70710678118654752f)), w1_ = gv[1] * 0.5f * h1_ * (1.f + erff(h1_ * 0.70710678118654752f)); \
        f32x2v y_[8]; _Pragma("unroll") for (int q_ = 0; q_ < 8; ++q_) y_[q_] = (f32x2v){0.f, 0.f}; \
        wbuf[lane] = w0_; wbuf[64 + lane] = w1_; asm volatile("s_waitcnt lgkmcnt(0)" ::: "memory");        \
        float wl_[16]; _Pragma("unroll") for (int q_ = 0; q_ < 4; ++q_) { const f32x4 v_ = *(const P2_LAS f32x4*)(wbuf + 16 * grp + 4 * q_); wl_[4 * q_] = v_.x; wl_[4 * q_ + 1] = v_.y; wl_[4 * q_ + 2] = v_.z; wl_[4 * q_ + 3] = v_.w; } \
        asm volatile("s_waitcnt lgkmcnt(0)" ::: "memory"); \
        _Pragma("unroll") for (int it_ = 0; it_ < 16; ++it_) { const float wq_ = wl_[it_]; \
            const unsigned ww_[4] = {vbv[it_].x, vbv[it_].y, vbv[it_].z, vbv[it_].w}; const f32x2v wv_ = {wq_, wq_}; \
            _Pragma("unroll") for (int q_ = 0; q_ < 4; ++q_) { y_[2 * q_] = __builtin_elementwise_fma(wv_, __builtin_amdgcn_cvt_pk_f32_fp8((int)ww_[q_], false), y_[2 * q_]); y_[2 * q_ + 1] = __builtin_elementwise_fma(wv_, __builtin_amdgcn_cvt_pk_f32_fp8((int)ww_[q_], true), y_[2 * q_ + 1]); } } \
        float yy_[16]; _Pragma("unroll") for (int k_ = 0; k_ < 8; ++k_) { yy_[2 * k_] = y_[k_].x; yy_[2 * k_ + 1] = y_[k_].y; } \
          \
        float y8_[8], y4_[4], y2_[2]; \
        _Pragma("unroll") for (int k_ = 0; k_ < 8; ++k_) y8_[k_] = (h32 ? yy_[k_ + 8] : yy_[k_]) + __shfl_xor(h32 ? yy_[k_] : yy_[k_ + 8], 32); \
        _Pragma("unroll") for (int k_ = 0; k_ < 4; ++k_) y4_[k_] = (h16 ? y8_[k_ + 4] : y8_[k_]) + __shfl_xor(h16 ? y8_[k_] : y8_[k_ + 4], 16); \
        _Pragma("unroll") for (int k_ = 0; k_ < 2; ++k_) y2_[k_] = (h8 ? y4_[k_ + 2] : y4_[k_]) + dpp_ror8(h8 ? y4_[k_] : y4_[k_ + 2]); \
        if ((t_) < M) { f32x2v* xp_ = (f32x2v*)(X + (size_t)(t_) * D + col0 + cq); f32x2v xv_ = *xp_; \
            xv_.x = ALPHA * xv_.x + y2_[0] * (1.f / sp::PEER_SV); xv_.y = ALPHA * xv_.y + y2_[1] * (1.f / sp::PEER_SV); *xp_ = xv_; } } while (0)
    u32x4 vbA[16], vbB[16]; float hA[16], hB[16], gA[2], gB[2];
    int t = rank;
    PV_ISSUE(vbA, hA, gA, t);
    for (; t < M; t += 2 * nrank) {
        PV_ISSUE(vbB, hB, gB, t + nrank);
        PV_COMPUTE(vbA, hA, gA, t);
        PV_ISSUE(vbA, hA, gA, t + 2 * nrank);
        PV_COMPUTE(vbB, hB, gB, t + nrank);
    }
#undef PV_ISSUE
#undef PV_COMPUTE
}
__device__ __forceinline__ void ln_row_plain(float* __restrict__ X, const float* __restrict__ g, const float* __restrict__ b, int row, int lane) {
    f32x4* xr = (f32x4*)(X + (size_t)row * D) + lane;
    f32x4 v[4]; float s = 0.f;
#pragma unroll
    for (int jq = 0; jq < 4; ++jq) { v[jq] = xr[64 * jq]; s += (v[jq].x + v[jq].y) + (v[jq].z + v[jq].w); }
    const float mean = wave_sum(s) * (1.f / D); float s2 = 0.f;
#pragma unroll
    for (int jq = 0; jq < 4; ++jq) { v[jq] = v[jq] - mean; s2 += (v[jq].x * v[jq].x + v[jq].y * v[jq].y) + (v[jq].z * v[jq].z + v[jq].w * v[jq].w); }
    const float rstd = rsqrtf(wave_sum(s2) * (1.f / D) + 1e-5f);
#pragma unroll
    for (int jq = 0; jq < 4; ++jq) { const int c = 4 * lane + 256 * jq; const f32x4 gg = *(const f32x4*)(g + c), bb = *(const f32x4*)(b + c); xr[64 * jq] = v[jq] * rstd * gg + bb; }
}
}

struct Params { const float* in[30]; float* out; unsigned char* ws; };
template <class F> __device__ __forceinline__ void run_gemm(unsigned char* lds, const bf16_t* A, int lda, const bf16_t* Bt, int Mr, int N, int K, F f, int cshift = 0) {
    pg8::Gemm g{A, Bt, Mr, N, K, lda}; pg8::StaticOrder S; S.init(Mr, N, gridDim.x, (int)((blockIdx.x + gridDim.x - (unsigned)cshift) % gridDim.x)); pg8::EpiAdapt<F> E{f};
    pg8::gemm_phase<pg8::EpiAdapt<F>, pg8::StaticOrder, true>((PG8_LAS unsigned char*)lds, g, S, E);
}
#ifndef PROBE_ATTN
#define PROBE_ATTN 0
#endif
#ifndef PROBE_SSD
#define PROBE_SSD 0
#endif
#ifndef PROBE_SYNC
#define PROBE_SYNC 0
#endif
#define KA_LAS __attribute__((address_space(4)))
#define PH_BEGIN const KA_LAS unsigned char* ka_ = (const KA_LAS unsigned char*)__builtin_amdgcn_kernarg_segment_ptr(); asm volatile("" : "+s"(ka_))
#define PIN(k) (*(const float* const KA_LAS*)(ka_ + 8 * (k)))
#define POUT (*(float* const KA_LAS*)(ka_ + 240))
#define PWS (*(unsigned char* const KA_LAS*)(ka_ + 248))
__global__ void __launch_bounds__(512, 2) hybrid_fwd(Params P) {
    extern __shared__ __attribute__((aligned(16))) unsigned char lds[];
    cg::grid_group grid = cg::this_grid();
    { PH_BEGIN; volatile LAS unsigned* misc = (volatile LAS unsigned*)((LAS unsigned char*)lds + MISC_OFF);
      if (threadIdx.x < 16) misc[threadIdx.x] = 0u;
      __syncthreads();
      (void)xcd_barrier_post((unsigned*)(PWS + WS_CTL) + CW_BAR, misc);
      if (PWS == nullptr) grid.sync(); }
#define GSYNC() do { PH_BEGIN; XcdBarrier xb_; xb_.bar = (unsigned*)(PWS + WS_CTL) + CW_BAR; xb_.x = xb_xcc_id(); xb_.st = (volatile LAS unsigned*)((LAS unsigned char*)lds + MISC_OFF); xcd_barrier(xb_); } while (0)
    {
        PH_BEGIN; unsigned char* ws = PWS;
        const int tid = opaque_tid(), lane = tid & 63, wave = __builtin_amdgcn_readfirstlane(tid >> 6), c = blockIdx.x, G = gridDim.x;
        const size_t gtid = (size_t)c * 512 + tid, gthreads = (size_t)G * 512; const int gw = c * 8 + wave, NGW = G * 8;
        const float* w_in = PIN(2);
        bf16_t* WinT = (bf16_t*)(ws + WS_WIN); bf16_t* WckvT = (bf16_t*)(ws + WS_WCKV);
        SP_LAS float* scr = (SP_LAS float*)lds + wave * (64 * 33);
        constexpr int I0 = 2560, I1 = 5120, I2 = 6144, I3 = 6656, I4 = 7168, I5 = 7680, I6 = 8192, I7 = 8704, I8 = 9216, I9 = 10240;
        for (int it = gw; it < I9; it += NGW) {
            if (it < I0) sp::transpose_item(w_in, NIN, 0, D, 160, WinT, 0, scr, it, lane);
            else if (it < I1) sp::transpose_item(w_in, NIN, 5152, D, 160, WinT, 5120, scr, it - I0, lane);
            else if (it < I2) sp::transpose_item(PIN(9), D, 0, DI, 32, (bf16_t*)(ws + WS_WSSD), 0, scr, it - I1, lane);
            else if (it < I3) sp::transpose_item(PIN(13), D, 0, D, 32, (bf16_t*)(ws + WS_WDIFF), 0, scr, it - I2, lane);
            else if (it < I4) sp::transpose_item(PIN(15), D, 0, D, 32, (bf16_t*)(ws + WS_WO), 0, scr, it - I3, lane);
            else if (it < I5) sp::transpose_item(PIN(18), D, 0, D, 32, (bf16_t*)(ws + WS_WCQ), 0, scr, it - I4, lane);
            else if (it < I6) sp::transpose_item(PIN(19), D, 0, D, 32, WckvT, 0, scr, it - I5, lane);
            else if (it < I7) sp::transpose_item(PIN(20), D, 0, D, 32, WckvT, 1024, scr, it - I6, lane);
            else if (it < I8) sp::transpose_item(PIN(21), D, 0, D, 32, (bf16_t*)(ws + WS_WCO), 0, scr, it - I7, lane);
            else sp::transpose_item(PIN(24), 2048, 0, D, 64, (bf16_t*)(ws + WS_WPQ), 0, scr, it - I8, lane);
        }
        const float* x = PIN(0);
        sp::cvt_range(PIN(1), (bf16_t*)(ws + WS_MEMB), (size_t)BATCH * MEML * D / 4, gtid, gthreads);
        sp::cvt_range(PIN(25), (bf16_t*)(ws + WS_SUBK), (size_t)PH * 2 * PK * PHALF / 4, gtid, gthreads);
        __syncthreads();
        sp::dt_stage_w((SP_LAS float*)lds, w_in);
        sp::dt_items((SP_LAS float*)lds, (SP_LAS float*)lds + 32768, (SP_LAS float*)lds + 36896  , x, PIN(5), (float*)(ws + WS_DT), (bf16_t*)(ws + WS_XB), c, G, M / 4);
        __syncthreads();
        if (c == 0 && tid == 0) { const float* lam_q = PIN(10); const float* lam_k = PIN(11); float s0 = 0.f, s1 = 0.f;
            for (int i = 0; i < 64; ++i) { s0 += lam_q[i] * lam_k[i]; s1 += lam_q[64 + i] * lam_k[64 + i]; }
            ((float*)(ws + WS_CTL))[CW_LAM] = expf(s0) - expf(s1) + LAMBDA_INIT; }
    }
    GSYNC();
    { PH_BEGIN; unsigned char* ws = PWS;
      run_gemm(lds, (const bf16_t*)(ws + WS_XB), D, (const bf16_t*)(ws + WS_WIN), SEQ, NINP, D, EpiInProj{(bf16_t*)(ws + WS_H), PIN(14)}); }
    GSYNC();
#pragma unroll 1
    for (int b = 0; b < BATCH; ++b) {
        { PH_BEGIN; unsigned char* ws = PWS; const int c = blockIdx.x, G = gridDim.x;
          bf16_t* H = (bf16_t*)(ws + WS_H); const float* DTb = (const float*)(ws + WS_DT) + (size_t)b * SEQ * 32;
          for (int u = c; u < 256; u += G) ssd::phaseA_unit((SS_LAS unsigned char*)lds, H, DTb, PIN(3), PIN(4), PIN(6), (bf16_t*)(ws + WS_T1), (float*)(ws + WS_CTL) + 1024, u >> 2, u & 3);
          const float lam = ((const float*)(ws + WS_CTL))[CW_LAM]; const float* subln_w = PIN(12);
#if PROBE_ATTN
          for (int u = c; u < 256; u += G) { const int h = u >> 5, j = u & 31;
              dattn::unit<false>((DA_LAS unsigned char*)lds, H, h, 63 - j, subln_w, lam);
              dattn::unit<false>((DA_LAS unsigned char*)lds, H, h, j, subln_w, lam); }
#endif
          for (int u = c; u < 256; u += G) { const int h = u >> 5, j = u & 31;
              dattn::unit((DA_LAS unsigned char*)lds, H, h, 63 - j, subln_w, lam);
              dattn::unit((DA_LAS unsigned char*)lds, H, h, j, subln_w, lam); } }
        GSYNC();
        { PH_BEGIN; unsigned char* ws = PWS; const int tid = opaque_tid();
          for (size_t i = (size_t)blockIdx.x * 512 + tid; i < 131072; i += (size_t)gridDim.x * 512) ssd::scan_phase((bf16_t*)(ws + WS_T1), (const float*)(ws + WS_CTL) + 1024, (int)i); }
        GSYNC();
        { PH_BEGIN; unsigned char* ws = PWS; const int c = blockIdx.x, G = gridDim.x;
#if PROBE_SSD
          for (int u = c; u < 256; u += G) ssd::phaseA_unit((SS_LAS unsigned char*)lds, (bf16_t*)(ws + WS_H), (const float*)(ws + WS_DT) + (size_t)b * SEQ * 32, PIN(3), PIN(4), PIN(6), (bf16_t*)(POUT + (size_t)SEQ * D), (float*)(ws + WS_CTL) + 8192, u >> 2, u & 3);
          for (int u = c; u < 256; u += G) ssd::phaseC_unit<false>((SS_LAS unsigned char*)lds, (bf16_t*)(ws + WS_H), (const float*)(ws + WS_DT) + (size_t)b * SEQ * 32, PIN(3), PIN(4), PIN(6), PIN(7), PIN(8), (const bf16_t*)(ws + WS_T1), u >> 2, u & 3);
#endif
          for (int u = c; u < 256; u += G) ssd::phaseC_unit((SS_LAS unsigned char*)lds, (bf16_t*)(ws + WS_H), (const float*)(ws + WS_DT) + (size_t)b * SEQ * 32, PIN(3), PIN(4), PIN(6), PIN(7), PIN(8), (const bf16_t*)(ws + WS_T1), u >> 2, u & 3); }
        GSYNC();
        { PH_BEGIN; unsigned char* ws = PWS; bf16_t* H = (bf16_t*)(ws + WS_H); float* T1 = (float*)(ws + WS_T1);
          run_gemm(lds, H + HC_Z, HP_, (const bf16_t*)(ws + WS_WSSD), SEQ, D, DI, EpiGate1{H, T1});
          run_gemm(lds, H + HC_Q, HP_, (const bf16_t*)(ws + WS_WDIFF), SEQ, D, D, EpiGate2{H, T1});
          if (b == 0) {
              const int hs = (int)gridDim.x / 2;
              run_gemm(lds, (const bf16_t*)(ws + WS_MEMB), D, (const bf16_t*)(ws + WS_WCKV), BATCH * MEML, D, D, EpiPlain{(bf16_t*)(ws + WS_KCVC), D, 1.f}, hs);
              for (int bb = 0; bb < BATCH; ++bb)
                  run_gemm(lds, (const bf16_t*)(ws + WS_WCKV) + (size_t)D * D, D, (const bf16_t*)(ws + WS_MEMB) + (size_t)bb * MEML * D, D, MEML, D, EpiPlain{(bf16_t*)(ws + WS_KCVC) + (size_t)BATCH * MEML * D + (size_t)bb * D * MEML, MEML, 1.f}, hs + 8 + 4 * bb);
          }
          if (b == BATCH - 1 && 2 * (int)blockIdx.x >= (int)gridDim.x) { const int tid = opaque_tid(); const int half = (gridDim.x + 1) / 2;
              const size_t gt = (size_t)(blockIdx.x - half) * 512 + tid, gn = (size_t)(gridDim.x - half) * 512;
              sp::cvt_fp8_range(PIN(26), ws + WS_PU, (size_t)PK * PK * D / 16, sp::PEER_SU, gt, gn);
              sp::cvt_fp8_range(PIN(27), ws + WS_PV, (size_t)PK * PK * D / 16, sp::PEER_SV, gt, gn); } }
        GSYNC();
        { PH_BEGIN; unsigned char* ws = PWS;
          run_gemm(lds, (const bf16_t*)(ws + WS_H) + HC_K, HP_, (const bf16_t*)(ws + WS_WO), SEQ, D, D, EpiResid{PIN(0), POUT, b * SEQ, 0}); }
        GSYNC();
        if (b + 1 < BATCH) {
            { PH_BEGIN; unsigned char* ws = PWS;
              run_gemm(lds, (const bf16_t*)(ws + WS_XB) + (size_t)(b + 1) * SEQ * D, D, (const bf16_t*)(ws + WS_WIN), SEQ, NINP, D, EpiInProj{(bf16_t*)(ws + WS_H), PIN(14)}); }
            GSYNC();
        }
    }
    { PH_BEGIN; unsigned char* ws = PWS; const int tid = opaque_tid(), lane = tid & 63, wave = __builtin_amdgcn_readfirstlane(tid >> 6), c = blockIdx.x, G = gridDim.x;
      float* out = POUT; const float* g = PIN(16); const float* bb = PIN(17); bf16_t* XB = (bf16_t*)(ws + WS_X1B);
      for (int r = c * 8 + wave; r < M; r += G * 8) sp::ln_row(out, g, bb, XB, r, lane); }
    GSYNC();
    { PH_BEGIN; unsigned char* ws = PWS;
      run_gemm(lds, (const bf16_t*)(ws + WS_X1B), D, (const bf16_t*)(ws + WS_WCQ), M, D, D, EpiPlain{(bf16_t*)(ws + WS_QC), D, CQSCALE}); }
    GSYNC();
    { PH_BEGIN; unsigned char* ws = PWS; const int c = blockIdx.x, G = gridDim.x;
      for (int u = c; u < 256; u += G) xattn::unit((XA_LAS unsigned char*)lds, (const bf16_t*)(ws + WS_QC), (const bf16_t*)(ws + WS_KCVC), (const bf16_t*)(ws + WS_KCVC) + (size_t)BATCH * MEML * D, (bf16_t*)(ws + WS_XO), u >> 2, u & 3); }
    GSYNC();
    { PH_BEGIN; unsigned char* ws = PWS; float* out = POUT;
      run_gemm(lds, (const bf16_t*)(ws + WS_XO), D, (const bf16_t*)(ws + WS_WCO), M, D, D, EpiResid{out, out, 0, 0}); }
    GSYNC();
    { PH_BEGIN; unsigned char* ws = PWS; const int tid = opaque_tid(), lane = tid & 63, wave = __builtin_amdgcn_readfirstlane(tid >> 6), c = blockIdx.x, G = gridDim.x;
      float* out = POUT; const float* g = PIN(22); const float* bb = PIN(23); bf16_t* XB = (bf16_t*)(ws + WS_X1B);
      for (int r = c * 8 + wave; r < M; r += G * 8) sp::ln_row(out, g, bb, XB, r, lane); }
    GSYNC();
    { PH_BEGIN; unsigned char* ws = PWS;
      run_gemm(lds, (const bf16_t*)(ws + WS_X1B), D, (const bf16_t*)(ws + WS_WPQ), M, 2048, D, EpiPlain{(bf16_t*)(ws + WS_QP), 2048, 1.f}); }
    GSYNC();
    { PH_BEGIN; unsigned char* ws = PWS; const int c = blockIdx.x, G = gridDim.x;
      for (int t = 64 * c; t < M; t += 64 * G) {
          for (int hp = 0; hp < 4; ++hp) psel::stage1((PS_LAS int*)lds, (const bf16_t*)(ws + WS_QP), (const bf16_t*)(ws + WS_SUBK), t, hp);
          __syncthreads();
          psel::stage2((PS_LAS int*)lds, (int*)(ws + WS_IDX), (float*)(ws + WS_GATE), t);
          __syncthreads(); } }
    GSYNC();
    { PH_BEGIN; unsigned char* ws = PWS; const int tid = opaque_tid(), lane = tid & 63, wave = __builtin_amdgcn_readfirstlane(tid >> 6);
      const peer2::Own o = peer2::ownership((unsigned*)(ws + WS_CTL), (P2_LAS unsigned*)lds, 0, wave);
      for (int jj = o.j; jj < 8; jj += o.nsl) peer2::u_wave(POUT, ws + WS_PU, (const int*)(ws + WS_IDX), (float*)(ws + WS_PART), jj, o.rank, o.nrank, lane); }
    GSYNC();
    { PH_BEGIN; unsigned char* ws = PWS; const int tid = opaque_tid(), lane = tid & 63, wave = __builtin_amdgcn_readfirstlane(tid >> 6);
      const peer2::Own o = peer2::ownership((unsigned*)(ws + WS_CTL), (P2_LAS unsigned*)lds, 1, wave);
      for (int jj = o.j; jj < 8; jj += o.nsl) peer2::v_wave(POUT, ws + WS_PV, (const int*)(ws + WS_IDX), (const float*)(ws + WS_GATE), (const float*)(ws + WS_PART), (P2_LAS float*)lds + 64 + wave * 128, jj, o.rank, o.nrank, lane); }
    GSYNC();
    { PH_BEGIN; const int tid = opaque_tid(), lane = tid & 63, wave = __builtin_amdgcn_readfirstlane(tid >> 6);
      float* out = POUT; const float* g3 = PIN(28); const float* b3 = PIN(29);
      for (int r = blockIdx.x * 8 + wave; r < M; r += gridDim.x * 8) peer2::ln_row_plain(out, g3, b3, r, lane); }
}

extern "C" void kernel_launch(void* const* d_in, const int* in_sizes, int n_in, void* d_out, int out_size, void* d_ws, size_t ws_size, hipStream_t stream) {
    static int grid_blocks = 0;
    if (grid_blocks == 0) {
        if (n_in != 30 || out_size != M * D || ws_size < WS_END) { fprintf(stderr, "kernel_launch: unexpected sizes n_in %d out %d ws %zu (need %zu)\n", n_in, out_size, ws_size, (size_t)WS_END); grid_blocks = -1; return; }
        int dev = 0, cus = 0, per_cu = 0;
        (void)hipGetDevice(&dev); (void)hipDeviceGetAttribute(&cus, hipDeviceAttributeMultiprocessorCount, dev);
        (void)hipFuncSetAttribute((const void*)hybrid_fwd, hipFuncAttributeMaxDynamicSharedMemorySize, LDS_BYTES);
        if (hipOccupancyMaxActiveBlocksPerMultiprocessor(&per_cu, (const void*)hybrid_fwd, 512, LDS_BYTES) != hipSuccess || per_cu < 1) { fprintf(stderr, "kernel_launch: occupancy query failed (%d)\n", per_cu); per_cu = 1; }
        (void)hipGetLastError();
        grid_blocks = cus * 1;
    }
    if (grid_blocks < 0) return;
    if (hipMemsetAsync(d_ws, 0, 65536, stream) != hipSuccess) { fprintf(stderr, "kernel_launch: memset of control words failed\n"); return; }
    Params p{};
    for (int i = 0; i < 30; ++i) p.in[i] = (const float*)d_in[i];
    p.out = (float*)d_out; p.ws = (unsigned char*)d_ws;
    void* args[] = {&p};
    hipError_t e = hipLaunchCooperativeKernel((const void*)hybrid_fwd, dim3(grid_blocks), dim3(512), args, LDS_BYTES, stream);
    if (e != hipSuccess) fprintf(stderr, "cooperative launch failed: %s (grid %d)\n", hipGetErrorString(e), grid_blocks);
}
```

```cpp
#include <hip/hip_runtime.h>
#include <hip/hip_cooperative_groups.h>
namespace cg = cooperative_groups;
#include <cstdio>
#include <cstdint>
#include <cmath>
#include <type_traits>

typedef unsigned short bf16_t;
typedef float f32x4 __attribute__((ext_vector_type(4)));
typedef unsigned u32x4 __attribute__((ext_vector_type(4)));
typedef unsigned u32x2 __attribute__((ext_vector_type(2)));

constexpr int D = 1024, BATCH = 2, SEQ = 8192, M = BATCH * SEQ;
constexpr int DI = 2048, NH = 32, HP = 64, NG = 4, DS = 128, DXBC = 3072;
constexpr int AH = 8, AD = 64, AV = 128;
constexpr int MEML = 256, MH = 4, MHD = 256;
constexpr int PH = 8, PK = 128, PDK = 256, PHALF = 128, PTOP = 16;
constexpr int NIN = 10272, NINP = 10240;
constexpr float ALPHA = 1.189207115002721f;
constexpr float LOG2E = 1.4426950408889634f;
constexpr float QSCALE = 0.125f * LOG2E;
constexpr float CQSCALE = 0.0625f * LOG2E;
constexpr float LAMBDA_INIT = 0.2f;
constexpr int HC_Z = 0, HC_XBC = 2048, HC_Q = 5120, HC_K = 6144, HC_V = 7168, HC_GS = 8192, HC_GA = 9216, HP_ = NINP;

constexpr size_t MiB = 1u << 20;
constexpr size_t WS_CTL = 0;
constexpr size_t WS_WIN = 1 * MiB;
constexpr size_t WS_WSSD = 21 * MiB;
constexpr size_t WS_WDIFF = 25 * MiB, WS_WO = 27 * MiB, WS_WCQ = 29 * MiB, WS_WCKV = 31 * MiB  , WS_WCO = 35 * MiB;
constexpr size_t WS_WPQ = 37 * MiB;
constexpr size_t WS_SUBK = 41 * MiB;
constexpr size_t WS_MEMB = 42 * MiB;
constexpr size_t WS_KCVC = 43 * MiB;
constexpr size_t WS_DT = 45 * MiB;
constexpr size_t WS_XB = 47 * MiB;
constexpr size_t WS_H = 79 * MiB;
constexpr size_t WS_T1 = 239 * MiB;
constexpr size_t WS_PU = 47 * MiB, WS_PV = 63 * MiB;
constexpr size_t WS_X1B = 79 * MiB;
constexpr size_t WS_QC = 143 * MiB, WS_XO = 175 * MiB;
constexpr size_t WS_QP = 207 * MiB;
constexpr size_t WS_IDX = 143 * MiB, WS_GATE = 151 * MiB;
constexpr size_t WS_PART = 207 * MiB;
constexpr size_t WS_END = 271 * MiB;
constexpr int CW_LAM = 64;

__device__ __forceinline__ int opaque_tid() { int t = threadIdx.x; asm volatile("" : "+v"(t)); return t; }
__device__ __forceinline__ unsigned f2bf(float f) { unsigned u = __builtin_bit_cast(unsigned, f); return (u + 0x7fffu + ((u >> 16) & 1u)) >> 16; }
__device__ __forceinline__ float bf2f(unsigned h) { return __builtin_bit_cast(float, h << 16); }
__device__ __forceinline__ unsigned pk2(float lo, float hi) { return f2bf(lo) | (f2bf(hi) << 16); }
__device__ __forceinline__ float bflo(unsigned w) { return __builtin_bit_cast(float, w << 16); }
__device__ __forceinline__ float bfhi(unsigned w) { return __builtin_bit_cast(float, w & 0xffff0000u); }
__device__ __forceinline__ float sigmoidf_(float v) { return __builtin_amdgcn_rcpf(1.f + __expf(-v)); }
__device__ __forceinline__ float siluf_(float v) { return v * __builtin_amdgcn_rcpf(1.f + __expf(-v)); }
__device__ __forceinline__ float wave_sum(float v) {
#pragma unroll
    for (int o = 1; o < 64; o <<= 1) v += __shfl_xor(v, o);
    return v;
}
__device__ __forceinline__ float wave_max(float v) {
#pragma unroll
    for (int o = 1; o < 64; o <<= 1) v = fmaxf(v, __shfl_xor(v, o));
    return v;
}

__device__ __forceinline__ void store_bf16x8(bf16_t* p, const float (&v)[8]) { u32x4 w; w.x = pk2(v[0], v[1]); w.y = pk2(v[2], v[3]); w.z = pk2(v[4], v[5]); w.w = pk2(v[6], v[7]); *(u32x4*)p = w; }
struct EpiPlain { bf16_t* O; int ldc; float scale;
    __device__ __forceinline__ void operator()(int row, int col0, const float (&v)[8]) const { float o[8];
#pragma unroll
        for (int j = 0; j < 8; ++j) o[j] = v[j] * scale; store_bf16x8(O + (size_t)row * ldc + col0, o); } };
struct EpiInProj { bf16_t* H; const float* gate_bias; bf16_t* GSO;
    __device__ __forceinline__ void operator()(int row, int col0, const float (&v)[8]) const { float o[8];
        if (col0 >= HC_GS) { const float* gb = gate_bias + (col0 - HC_GS);
#pragma unroll
            for (int j = 0; j < 8; ++j) o[j] = sigmoidf_(v[j] + gb[j]); }
        else { const float s = (col0 >= HC_Q && col0 < HC_K) ? QSCALE : 1.f;
#pragma unroll
            for (int j = 0; j < 8; ++j) o[j] = v[j] * s; }
        if (GSO != nullptr && col0 >= HC_GS && col0 < HC_GA) store_bf16x8(GSO + (size_t)row * D + (col0 - HC_GS), o);
        else store_bf16x8(H + (size_t)row * HP_ + col0, o); } };
struct EpiGate1 { const bf16_t* H; float* T1;
    __device__ __forceinline__ void operator()(int row, int col0, const float (&v)[8]) const {
        const u32x4 g = *(const u32x4*)(H + (size_t)row * HP_ + HC_GS + col0); const unsigned gw[4] = {g.x, g.y, g.z, g.w};
        float* t = T1 + (size_t)row * D + col0;
#pragma unroll
        for (int j = 0; j < 4; ++j) { t[2 * j] = bflo(gw[j]) * v[2 * j]; t[2 * j + 1] = bfhi(gw[j]) * v[2 * j + 1]; } } };
struct EpiGate2 { bf16_t* H; const float* T1;
    __device__ __forceinline__ void operator()(int row, int col0, const float (&v)[8]) const {
        const u32x4 g = *(const u32x4*)(H + (size_t)row * HP_ + HC_GA + col0); const unsigned gw[4] = {g.x, g.y, g.z, g.w};
        const float* t = T1 + (size_t)row * D + col0; float o[8];
#pragma unroll
        for (int j = 0; j < 4; ++j) { o[2 * j] = t[2 * j] + bflo(gw[j]) * v[2 * j]; o[2 * j + 1] = t[2 * j + 1] + bfhi(gw[j]) * v[2 * j + 1]; }
        store_bf16x8(H + (size_t)row * HP_ + HC_K + col0, o); } };
struct EpiGate1g { const bf16_t* GS; bf16_t* T; int ldg; int pad_;
    __device__ __forceinline__ void operator()(int row, int col0, const float (&v)[8]) const {
        const u32x4 g = *(const u32x4*)(GS + (size_t)row * ldg + col0); const unsigned gw[4] = {g.x, g.y, g.z, g.w}; float o[8];
#pragma unroll
        for (int j = 0; j < 4; ++j) { o[2 * j] = bflo(gw[j]) * v[2 * j]; o[2 * j + 1] = bfhi(gw[j]) * v[2 * j + 1]; }
        store_bf16x8(T + (size_t)row * D + col0, o); } };
struct EpiGate2g { const bf16_t* GA; const bf16_t* T; bf16_t* MIX; int ldg; int ldm;
    __device__ __forceinline__ void operator()(int row, int col0, const float (&v)[8]) const {
        const u32x4 g = *(const u32x4*)(GA + (size_t)row * ldg + col0), t = *(const u32x4*)(T + (size_t)row * D + col0); const unsigned gw[4] = {g.x, g.y, g.z, g.w}, tw[4] = {t.x, t.y, t.z, t.w}; float o[8];
#pragma unroll
        for (int j = 0; j < 4; ++j) { o[2 * j] = bflo(tw[j]) + bflo(gw[j]) * v[2 * j]; o[2 * j + 1] = bfhi(tw[j]) + bfhi(gw[j]) * v[2 * j + 1]; }
        store_bf16x8(MIX + (size_t)row * ldm + col0, o); } };
struct EpiResid { const float* base; float* out; int row_off; int pad_;
    __device__ __forceinline__ void operator()(int row, int col0, const float (&v)[8]) const {
        const size_t o = (size_t)(row + row_off) * D + col0;
#pragma unroll
        for (int j = 0; j < 8; ++j) out[o + j] = ALPHA * base[o + j] + v[j]; } };


namespace pg8 {
#define PG8_LAS __attribute__((address_space(3)))
typedef short bf16x8 __attribute__((ext_vector_type(8)));
constexpr int BM = 256, BK = 64, HALF = 128, HTB = HALF * BK * 2, STAGE_BYTES = 8 * HTB, NXCD = 8, WGM = 8;
__host__ __device__ __forceinline__ int lds_byte(int r, int c) { const int st = (r >> 4) * 2 + (c >> 5), rr = r & 15, cc = c & 31, ob = rr * 64 + cc * 2; return st * 1024 + (ob ^ (((ob >> 9) & 1) << 5)); }
__host__ __device__ __forceinline__ void stage_rc(int b, int& R, int& C) { const int st = b / 1024, sb = b % 1024, swz = sb ^ (((sb >> 9) & 1) << 5); R = (st >> 1) * 16 + swz / 64; C = (st & 1) * 32 + (swz % 64) / 2; }
__host__ __device__ __forceinline__ int perm32(int rho) { const int n = rho >> 4, i = rho & 15; return 8 * (i >> 2) + 4 * n + (i & 3); }
struct Unit { int pm, pn; };
struct Gemm { const bf16_t* A; const bf16_t* Bt; int M, N, K, lda; };
struct StaticOrder {
    int nM, nN, nwg, G, c;
    __host__ __device__ void init(int M, int N, int G_, int c_) { nM = M / BM; nN = N / BM; nwg = nM * nN; G = G_; c = c_; }
    __host__ __device__ bool next(int i, Unit& u) const {
        const long L = (long)i * G + c; if (L >= nwg) return false;
        int wgid = (int)L; { const int q = nwg / NXCD, r = nwg % NXCD, xcd = wgid % NXCD, off = wgid / NXCD; wgid = (xcd < r ? xcd * (q + 1) : r * (q + 1) + (xcd - r) * q) + off; }
        const int nig = WGM * nN, gid = wgid / nig, fm = gid * WGM, gsz = (nM - fm) < WGM ? (nM - fm) : WGM;
        u.pm = fm + ((wgid % nig) % gsz); u.pn = (wgid % nig) / gsz; return true;
    }
};
template <class F> struct EpiAdapt {
    static constexpr bool PERM = true, AFTER_DRAIN = false; F f;
    __device__ __forceinline__ void operator()(const f32x4 (&acc)[2][2][4][2], const Unit& u, int wr, int wc, int fr, int fq) const {
#pragma unroll
        for (int ai = 0; ai < 2; ++ai)
#pragma unroll
            for (int m = 0; m < 4; ++m) { const int row = u.pm * BM + ai * HALF + wr * 64 + m * 16 + fr;
#pragma unroll
                for (int bj = 0; bj < 2; ++bj) { const int col0 = u.pn * BM + bj * HALF + wc * 32 + 8 * fq;
                    const f32x4 a = acc[ai][bj][m][0], b = acc[ai][bj][m][1]; const float v[8] = {a[0], a[1], a[2], a[3], b[0], b[1], b[2], b[3]};
                    f(row, col0, v); } }
    }
};
template <class Epi, class Sched, bool ALIGN_EPI>
__device__ __forceinline__ void gemm_phase(PG8_LAS unsigned char* lds, const Gemm g, const Sched& S, const Epi& E) {
    const int tid = opaque_tid(), wid = __builtin_amdgcn_readfirstlane(tid >> 6), lane = tid & 63, wr = wid >> 2, wc = wid & 3, fr = lane & 15, fq = lane >> 4;
    const int K = g.K, nt = K / BK, lda = g.lda;
    unsigned voffA[2], voffB[2];
#pragma unroll
    for (int i = 0; i < 2; ++i) { int R, C; stage_rc(tid * 16 + i * 8192, R, C); const int Rb = Epi::PERM ? ((R & ~31) + perm32(R & 31)) : R;
        voffA[i] = (unsigned)(R * lda + C) * 2u; voffB[i] = (unsigned)(Rb * K + C) * 2u; }
    const size_t kstep = (size_t)(BK * 2);
    const size_t hstepA = (size_t)HALF * lda * 2, hstepB = (size_t)HALF * K * 2;
    const size_t tstepA = 2 * hstepA, tstepB = 2 * hstepB;
    const unsigned ldsw = (unsigned)wid * 1024u;
    const int aoff = lds_byte(wr * 64 + fr, fq * 8), boff = lds_byte(wc * 32 + fr, fq * 8);
#define PG8_SA(b, h) (((b) * 2 + (h)) * HTB)
#define PG8_SB(b, h) ((4 + (b) * 2 + (h)) * HTB)
#define PG8_STAGE(bufoff, gbase, voff) do { _Pragma("unroll") for (int _i = 0; _i < 2; ++_i) \
        __builtin_amdgcn_global_load_lds((const unsigned*)((const char*)(gbase) + (voff)[_i]), (PG8_LAS unsigned*)(lds + (bufoff) + ldsw + _i * 8192), 16, 0, 0); } while (0)
#define PG8_LDA(dst, b, h) do { _Pragma("unroll") for (int m = 0; m < 4; ++m) _Pragma("unroll") for (int k = 0; k < 2; ++k) dst[m][k] = *(const PG8_LAS bf16x8*)(lds + PG8_SA(b, h) + aoff + m * 2048 + k * 1024); } while (0)
#define PG8_LDB(dst, b, h) do { _Pragma("unroll") for (int n = 0; n < 2; ++n) _Pragma("unroll") for (int k = 0; k < 2; ++k) dst[n][k] = *(const PG8_LAS bf16x8*)(lds + PG8_SB(b, h) + boff + n * 2048 + k * 1024); } while (0)
#define PG8_MMA(ai, bj, At, Bt) do { __builtin_amdgcn_s_setprio(1); _Pragma("unroll") for (int m = 0; m < 4; ++m) _Pragma("unroll") for (int n = 0; n < 2; ++n) _Pragma("unroll") for (int k = 0; k < 2; ++k) \
        acc[ai][bj][m][n] = __builtin_amdgcn_mfma_f32_16x16x32_bf16(Bt[n][k], At[m][k], acc[ai][bj][m][n], 0, 0, 0); __builtin_amdgcn_s_setprio(0); } while (0)
#define PG8_WAIT_V(n) asm volatile("s_waitcnt vmcnt(" #n ")" ::: "memory")
#define PG8_WAIT_L(n) asm volatile("s_waitcnt lgkmcnt(" #n ")" ::: "memory")
#define PG8_BAR __builtin_amdgcn_s_barrier()
#define PG8_SCHED __builtin_amdgcn_sched_barrier(0)
    Unit cur, nxt; int ui = 0;
    if (!S.next(0, cur)) return;
    f32x4 acc[2][2][4][2];
#pragma unroll
    for (int a = 0; a < 2; ++a)
#pragma unroll
        for (int b = 0; b < 2; ++b)
#pragma unroll
            for (int m = 0; m < 4; ++m)
#pragma unroll
                for (int n = 0; n < 2; ++n) acc[a][b][m][n] = (f32x4){0.f, 0.f, 0.f, 0.f};
    bf16x8 At[4][2], B0[2][2], B1[2][2];
    const char* cA = (const char*)g.A + (size_t)cur.pm * tstepA; const char* cB = (const char*)g.Bt + (size_t)cur.pn * tstepB;
    PG8_STAGE(PG8_SB(0, 0), cB, voffB); PG8_STAGE(PG8_SB(0, 1), cB + hstepB, voffB); PG8_STAGE(PG8_SA(0, 0), cA, voffA); PG8_STAGE(PG8_SA(0, 1), cA + hstepA, voffA);
    if (wr == 1) PG8_BAR;
    PG8_WAIT_V(2); PG8_BAR;
    PG8_STAGE(PG8_SB(1, 0), cB + kstep, voffB); PG8_STAGE(PG8_SA(1, 0), cA + kstep, voffA); PG8_STAGE(PG8_SB(1, 1), cB + hstepB + kstep, voffB);
    PG8_WAIT_V(6); PG8_BAR;
    for (;;) {
        const bool has_next = S.next(ui + 1, nxt);
        const char* nA = has_next ? (const char*)g.A + (size_t)nxt.pm * tstepA : cA; const char* nB = has_next ? (const char*)g.Bt + (size_t)nxt.pn * tstepB : cB;
        for (int t = 0; t < nt; t += 2) {
            const bool last = (t == nt - 2);
            const char* a1 = cA + (size_t)(t + 1) * kstep;
            const char* a2 = last ? nA : cA + (size_t)(t + 2) * kstep; const char* b2 = last ? nB : cB + (size_t)(t + 2) * kstep;
            const char* a3 = a2 + kstep; const char* b3 = b2 + kstep;
            PG8_LDB(B0, 0, 0); PG8_LDB(B1, 0, 1); PG8_SCHED; PG8_LDA(At, 0, 0); PG8_STAGE(PG8_SA(1, 1), a1 + hstepA, voffA);
            PG8_WAIT_V(8); PG8_WAIT_L(0); PG8_BAR; PG8_MMA(0, 0, At, B0); PG8_MMA(0, 1, At, B1); PG8_BAR; PG8_SCHED;
            PG8_LDA(At, 0, 1); PG8_STAGE(PG8_SB(0, 0), b2, voffB); PG8_STAGE(PG8_SB(0, 1), b2 + hstepB, voffB); PG8_STAGE(PG8_SA(0, 0), a2, voffA);
            PG8_WAIT_V(8); PG8_WAIT_L(0); PG8_BAR; PG8_MMA(1, 0, At, B0); PG8_MMA(1, 1, At, B1); PG8_BAR; PG8_SCHED;
            PG8_LDB(B0, 1, 0); PG8_LDB(B1, 1, 1); PG8_SCHED; PG8_LDA(At, 1, 0); PG8_STAGE(PG8_SA(0, 1), a2 + hstepA, voffA);
            PG8_WAIT_V(8); PG8_WAIT_L(0); PG8_BAR; PG8_MMA(0, 0, At, B0); PG8_MMA(0, 1, At, B1); PG8_BAR; PG8_SCHED;
            PG8_LDA(At, 1, 1); PG8_STAGE(PG8_SB(1, 0), b3, voffB); PG8_STAGE(PG8_SB(1, 1), b3 + hstepB, voffB); PG8_STAGE(PG8_SA(1, 0), a3, voffA);
            PG8_WAIT_V(8); PG8_WAIT_L(0); PG8_BAR; PG8_MMA(1, 0, At, B0); PG8_MMA(1, 1, At, B1); PG8_BAR; PG8_SCHED;
        }
        if constexpr (ALIGN_EPI) { if (wr == 0) PG8_BAR; }
        E(acc, cur, wr, wc, fr, fq);
        if (!has_next) break;
#pragma unroll
        for (int a = 0; a < 2; ++a)
#pragma unroll
            for (int b = 0; b < 2; ++b)
#pragma unroll
                for (int m = 0; m < 4; ++m)
#pragma unroll
                    for (int n = 0; n < 2; ++n) acc[a][b][m][n] = (f32x4){0.f, 0.f, 0.f, 0.f};
        cur = nxt; cA = nA; cB = nB; ++ui;
        if constexpr (ALIGN_EPI) { if (wr == 1) PG8_BAR; }
    }
    PG8_WAIT_V(0);
    if constexpr (!ALIGN_EPI) { if (wr == 0) PG8_BAR; }
    PG8_BAR;
#undef PG8_SA
#undef PG8_SB
#undef PG8_STAGE
#undef PG8_LDA
#undef PG8_LDB
#undef PG8_MMA
#undef PG8_WAIT_V
#undef PG8_WAIT_L
#undef PG8_BAR
#undef PG8_SCHED
}
}
constexpr int LDS_BYTES = 148480;
namespace dattn {
#define DA_LAS __attribute__((address_space(3)))
typedef short bf16x8 __attribute__((ext_vector_type(8)));
typedef short s16x4 __attribute__((ext_vector_type(4)));
typedef float f32x16 __attribute__((ext_vector_type(16)));
constexpr int KP = 272, VP = 320, KBUF = 64 * KP, VBUF = 64 * VP, BUF = KBUF + VBUF, XOFF = 2 * BUF, LDS_NEED = XOFF + 65536;
static_assert(LDS_NEED <= 147456, "attention LDS");
__device__ __forceinline__ unsigned cvtpk(float lo, float hi) { typedef float f2 __attribute__((ext_vector_type(2))); typedef __bf16 b2 __attribute__((ext_vector_type(2))); f2 v = {lo, hi}; b2 b = __builtin_convertvector(v, b2); return __builtin_bit_cast(unsigned, b); }
__device__ __forceinline__ s16x4 vtr(const DA_LAS unsigned char* p) { typedef short v4i16_t __attribute__((ext_vector_type(4))); return __builtin_bit_cast(s16x4, __builtin_amdgcn_ds_read_tr16_b64_v4i16((DA_LAS v4i16_t*)p)); }
template <bool STORE = true> __device__ __forceinline__ void unit(DA_LAS unsigned char* lds, bf16_t* Hb, int h, int qb, const float* __restrict__ subln_w, float lam, bf16_t* Ob, int ldo) {
    const int tid = opaque_tid(), lane = tid & 63, w = __builtin_amdgcn_readfirstlane(tid >> 6), mp = w >> 2, rb = w & 3, c32 = lane & 31, hh = lane >> 5;
    const int qrow = 128 * qb + 32 * rb + c32;
    bf16x8 qf[4];
    { const bf16_t* qp = Hb + (size_t)qrow * HP_ + HC_Q + h * 128 + 64 * mp + 8 * hh;
#pragma unroll
      for (int s = 0; s < 4; ++s) qf[s] = *(const bf16x8*)(qp + 16 * s); }
    const int srow = tid >> 4, sch = tid & 15;
    const bf16_t* kg = Hb + HC_K + h * 128 + sch * 8; const bf16_t* vg = Hb + HC_V + h * 128 + sch * 8;
    const int nt = 2 * qb + 2;
    u32x4 kr[2], vr[2];
#define DA_LOAD(t) do { _Pragma("unroll") for (int j = 0; j < 2; ++j) { const size_t ro = (size_t)(64 * (t) + srow + 32 * j) * HP_; kr[j] = *(const u32x4*)(kg + ro); vr[j] = *(const u32x4*)(vg + ro); } } while (0)
#define DA_WRITE(buf) do { _Pragma("unroll") for (int j = 0; j < 2; ++j) { *(DA_LAS u32x4*)(lds + (buf) * BUF + (srow + 32 * j) * KP + sch * 16) = kr[j]; *(DA_LAS u32x4*)(lds + (buf) * BUF + KBUF + (srow + 32 * j) * VP + sch * 16) = vr[j]; } } while (0)
    DA_LOAD(0); DA_WRITE(0);
    __syncthreads();
    f32x16 oT[4];
#pragma unroll
    for (int i = 0; i < 4; ++i) oT[i] = (f32x16){0.f, 0.f, 0.f, 0.f, 0.f, 0.f, 0.f, 0.f, 0.f, 0.f, 0.f, 0.f, 0.f, 0.f, 0.f, 0.f};
    float lrow = 0.f;
    f32x16 negm = (f32x16){0.f, 0.f, 0.f, 0.f, 0.f, 0.f, 0.f, 0.f, 0.f, 0.f, 0.f, 0.f, 0.f, 0.f, 0.f, 0.f};
    const int koff = c32 * KP + (64 * mp + 8 * hh) * 2;
    const int voff = KBUF + (4 * hh + ((lane & 15) >> 2)) * VP + (16 * ((lane >> 4) & 1) + 4 * (lane & 3)) * 2;
    for (int t = 0; t < nt; ++t) {
        const int cur = t & 1;
        if (t + 1 < nt) DA_LOAD(t + 1);
        if (!(t == nt - 1 && rb <= 1)) {
            const DA_LAS unsigned char* kb = lds + cur * BUF + koff;
            f32x16 s0 = negm, s1 = negm;
            bf16x8 kf0[4], kf1[4];
#pragma unroll
            for (int s = 0; s < 4; ++s) { kf0[s] = *(const DA_LAS bf16x8*)(kb + s * 32); kf1[s] = *(const DA_LAS bf16x8*)(kb + 32 * KP + s * 32); }
            __builtin_amdgcn_s_setprio(1);
#pragma unroll
            for (int s = 0; s < 4; ++s) {
                s0 = __builtin_amdgcn_mfma_f32_32x32x16_bf16(kf0[s], qf[s], s0, 0, 0, 0);
                s1 = __builtin_amdgcn_mfma_f32_32x32x16_bf16(kf1[s], qf[s], s1, 0, 0, 0);
            }
            __builtin_amdgcn_s_setprio(0);
            if (t >= nt - 2) {
                const int k0 = 64 * t + 4 * hh;
#pragma unroll
                for (int r = 0; r < 16; ++r) { const int key = k0 + (r & 3) + 8 * (r >> 2); if (key > qrow) s0[r] = -INFINITY; if (key + 32 > qrow) s1[r] = -INFINITY; }
            }
            float mxa = fmaxf(fmaxf(s0[0], s0[1]), s1[0]), mxb = fmaxf(fmaxf(s0[2], s0[3]), s1[1]);
            mxa = fmaxf(fmaxf(mxa, s1[2]), s1[3]);
#pragma unroll
            for (int r = 4; r < 16; r += 4) { mxa = fmaxf(fmaxf(mxa, s0[r]), s0[r + 1]); mxb = fmaxf(fmaxf(mxb, s0[r + 2]), s0[r + 3]); mxa = fmaxf(fmaxf(mxa, s1[r]), s1[r + 1]); mxb = fmaxf(fmaxf(mxb, s1[r + 2]), s1[r + 3]); }
            float mx = fmaxf(mxa, mxb);
            mx = fmaxf(mx, __shfl_xor(mx, 32));
            if (__any(mx > 8.f)) {
                const float dl = fmaxf(mx, 0.f), alpha = __builtin_amdgcn_exp2f(-dl);
#pragma unroll
                for (int r = 0; r < 16; ++r) { s0[r] -= dl; s1[r] -= dl; negm[r] -= dl; }
                lrow *= alpha;
#pragma unroll
                for (int i = 0; i < 4; ++i)
#pragma unroll
                    for (int r = 0; r < 16; ++r) oT[i][r] *= alpha;
            }
            float ps = 0.f;
#pragma unroll
            for (int r = 0; r < 16; ++r) { s0[r] = __builtin_amdgcn_exp2f(s0[r]); s1[r] = __builtin_amdgcn_exp2f(s1[r]); ps += s0[r] + s1[r]; }
            lrow += ps;
            bf16x8 pf[2][2];
#pragma unroll
            for (int s = 0; s < 2; ++s) {
                u32x4 a, b;
                a.x = cvtpk(s0[8 * s], s0[8 * s + 1]); a.y = cvtpk(s0[8 * s + 2], s0[8 * s + 3]); a.z = cvtpk(s0[8 * s + 4], s0[8 * s + 5]); a.w = cvtpk(s0[8 * s + 6], s0[8 * s + 7]);
                b.x = cvtpk(s1[8 * s], s1[8 * s + 1]); b.y = cvtpk(s1[8 * s + 2], s1[8 * s + 3]); b.z = cvtpk(s1[8 * s + 4], s1[8 * s + 5]); b.w = cvtpk(s1[8 * s + 6], s1[8 * s + 7]);
                pf[0][s] = __builtin_bit_cast(bf16x8, a); pf[1][s] = __builtin_bit_cast(bf16x8, b);
            }
            const DA_LAS unsigned char* vb = lds + cur * BUF + voff;
#define DA_LDV(dst, db) do { _Pragma("unroll") for (int i_ = 0; i_ < 4; ++i_) { const s16x4 lo_ = vtr(vb + (16 * i_) * VP + (db) * 64), hi_ = vtr(vb + (16 * i_ + 8) * VP + (db) * 64); \
                dst[i_] = (bf16x8){lo_[0], lo_[1], lo_[2], lo_[3], hi_[0], hi_[1], hi_[2], hi_[3]}; } } while (0)
#define DA_MM(src, db) do { _Pragma("unroll") for (int i_ = 0; i_ < 4; ++i_) oT[db] = __builtin_amdgcn_mfma_f32_32x32x16_bf16(src[i_], pf[i_ >> 1][i_ & 1], oT[db], 0, 0, 0); } while (0)
            bf16x8 va[4], vq[4];
            DA_LDV(va, 0);
            DA_LDV(vq, 1); __builtin_amdgcn_s_setprio(1); DA_MM(va, 0); __builtin_amdgcn_s_setprio(0);
            DA_LDV(va, 2); __builtin_amdgcn_s_setprio(1); DA_MM(vq, 1); __builtin_amdgcn_s_setprio(0);
            DA_LDV(vq, 3); __builtin_amdgcn_s_setprio(1); DA_MM(va, 2); __builtin_amdgcn_s_setprio(0);
            __builtin_amdgcn_s_setprio(1); DA_MM(vq, 3);
#undef DA_LDV
#undef DA_MM
            __builtin_amdgcn_s_setprio(0);
        }
        if (t + 1 < nt) DA_WRITE(cur ^ 1);
        __syncthreads();
    }
#undef DA_LOAD
#undef DA_WRITE
    const float inv = 1.f / (lrow + __shfl_xor(lrow, 32));
    DA_LAS float* X = (DA_LAS float*)(lds + XOFF) + rb * 4096 + lane;
    if (mp == 1) {
#pragma unroll
        for (int i = 0; i < 4; ++i)
#pragma unroll
            for (int r = 0; r < 16; ++r) X[(i * 16 + r) * 64] = oT[i][r] * inv;
    }
    __syncthreads();
    if (mp == 0) {
        float ss = 0.f;
#pragma unroll
        for (int i = 0; i < 4; ++i)
#pragma unroll
            for (int r = 0; r < 16; ++r) { const float o = oT[i][r] * inv - lam * X[(i * 16 + r) * 64]; oT[i][r] = o; ss += o * o; }
        ss += __shfl_xor(ss, 32);
        const float rr = rsqrtf(ss * (1.f / 128.f) + 1e-5f) * (1.f - LAMBDA_INIT);
        bf16_t* op = Ob + (size_t)qrow * ldo + h * 128 + 4 * hh;
#pragma unroll
        for (int i = 0; i < 4; ++i)
#pragma unroll
            for (int g = 0; g < 4; ++g) { const int d0 = 32 * i + 8 * g; const f32x4 sw = *(const f32x4*)(subln_w + d0 + 4 * hh);
                uint2 o; o.x = pk2(oT[i][4 * g] * rr * sw.x, oT[i][4 * g + 1] * rr * sw.y); o.y = pk2(oT[i][4 * g + 2] * rr * sw.z, oT[i][4 * g + 3] * rr * sw.w);
                if (STORE || o.x == 0x12345u) *(uint2*)(op + d0) = o; }
    }
    __syncthreads();
}
}
namespace ssd {
#define SS_LAS __attribute__((address_space(3)))
typedef short bf16x8 __attribute__((ext_vector_type(8)));
typedef short s16x4 __attribute__((ext_vector_type(4)));
typedef float f32x16 __attribute__((ext_vector_type(16)));
constexpr int XP = 192;
constexpr int BPT = 320;
constexpr int CP = 272;
__device__ __forceinline__ s16x4 vtr(const SS_LAS unsigned char* p) { typedef short v4i16_t __attribute__((ext_vector_type(4))); return __builtin_bit_cast(s16x4, __builtin_amdgcn_ds_read_tr16_b64_v4i16((SS_LAS v4i16_t*)p)); }
__device__ __forceinline__ unsigned cvtpk(float lo, float hi) { typedef float f2 __attribute__((ext_vector_type(2))); typedef __bf16 b2 __attribute__((ext_vector_type(2))); f2 v = {lo, hi}; b2 b = __builtin_convertvector(v, b2); return __builtin_bit_cast(unsigned, b); }
__device__ __forceinline__ void acs_tables(SS_LAS float* ACS, SS_LAS float* DTS, const float* __restrict__ DTb, const float* __restrict__ a_log, int c, int g) {
    const int tid_ = opaque_tid(); const int lane = tid_ & 63, e = __builtin_amdgcn_readfirstlane(tid_ >> 6), h = 8 * g + e;
    const float a = -expf(a_log[h]);
    const float d0 = DTb[(size_t)(128 * c + 2 * lane) * 32 + h], d1 = DTb[(size_t)(128 * c + 2 * lane + 1) * 32 + h];
    const float a0 = d0 * a, a1 = d1 * a;
    float sc = a0 + a1;
#pragma unroll
    for (int o = 1; o < 64; o <<= 1) { const float v = __shfl_up(sc, o); if (lane >= o) sc += v; }
    const float ex = sc - (a0 + a1);
    ACS[(2 * lane) * 8 + e] = ex + a0; ACS[(2 * lane + 1) * 8 + e] = ex + a0 + a1;
    DTS[(2 * lane) * 8 + e] = d0; DTS[(2 * lane + 1) * 8 + e] = d1;
}
template <int NT, class F> __device__ __forceinline__ void conv_item(const bf16_t* __restrict__ Hb, int t0, int l0, int xch0, const float* __restrict__ conv_w, const float* __restrict__ conv_b, F sink) {
    float w[4][8], bias[8];
#pragma unroll
    for (int j = 0; j < 4; ++j) { const f32x4 a = *(const f32x4*)(conv_w + j * DXBC + xch0), b = *(const f32x4*)(conv_w + j * DXBC + xch0 + 4); w[j][0] = a.x; w[j][1] = a.y; w[j][2] = a.z; w[j][3] = a.w; w[j][4] = b.x; w[j][5] = b.y; w[j][6] = b.z; w[j][7] = b.w; }
    { const f32x4 a = *(const f32x4*)(conv_b + xch0), b = *(const f32x4*)(conv_b + xch0 + 4); bias[0] = a.x; bias[1] = a.y; bias[2] = a.z; bias[3] = a.w; bias[4] = b.x; bias[5] = b.y; bias[6] = b.z; bias[7] = b.w; }
    const bf16_t* src = Hb + HC_XBC + xch0;
    u32x4 rw[NT + 3];
#pragma unroll
    for (int i = 0; i < NT + 3; ++i) { const int tt = t0 + l0 - 3 + i; rw[i] = *(const u32x4*)(src + (size_t)(tt < 0 ? 0 : tt) * HP_); }
    if (t0 + l0 < 3) {
#pragma unroll
        for (int i = 0; i < 3; ++i) if (t0 + l0 - 3 + i < 0) rw[i] = (u32x4){0u, 0u, 0u, 0u};
    }
#define SS_UNP(dst, q_) do { dst[0] = bflo(q_.x); dst[1] = bfhi(q_.x); dst[2] = bflo(q_.y); dst[3] = bfhi(q_.y); dst[4] = bflo(q_.z); dst[5] = bfhi(q_.z); dst[6] = bflo(q_.w); dst[7] = bfhi(q_.w); } while (0)
    float x0[8], x1[8], x2[8];
    SS_UNP(x0, rw[0]); SS_UNP(x1, rw[1]); SS_UNP(x2, rw[2]);
#pragma unroll
    for (int i = 0; i < NT; ++i) {
        float x3[8]; SS_UNP(x3, rw[3 + i]);
        float v[8];
#pragma unroll
        for (int k = 0; k < 8; ++k) { const float a = bias[k] + w[0][k] * x0[k] + w[1][k] * x1[k] + w[2][k] * x2[k] + w[3][k] * x3[k]; v[k] = a * __builtin_amdgcn_rcpf(1.f + __expf(-a)); x0[k] = x1[k]; x1[k] = x2[k]; x2[k] = x3[k]; }
        sink(l0 + i, v);
    }
#undef SS_UNP
}
constexpr int A_BS = 0, A_XD = 128 * BPT  , A_ACS = A_XD + 2 * 128 * XP  , A_DTS = A_ACS + 4096, A_END = A_DTS + 4096;
__device__ __forceinline__ void phaseA_unit(SS_LAS unsigned char* lds, const bf16_t* __restrict__ Hb, const float* __restrict__ DTb, const float* __restrict__ conv_w, const float* __restrict__ conv_b,
                                            const float* __restrict__ a_log, bf16_t* __restrict__ ST, float* __restrict__ CD, int c, int g) {
    const int tid = opaque_tid(), lane = tid & 63, w = __builtin_amdgcn_readfirstlane(tid >> 6), c32 = lane & 31, hh = lane >> 5;
    SS_LAS float* ACS = (SS_LAS float*)(lds + A_ACS); SS_LAS float* DTS = (SS_LAS float*)(lds + A_DTS);
    acs_tables(ACS, DTS, DTb, a_log, c, g);
    __syncthreads();
    if (tid < 8) CD[c * 32 + 8 * g + tid] = __expf(ACS[127 * 8 + tid]);
    auto stageX = [&](int e, int item, int buf) {
        const int cg = item >> 5, seg = item & 31; const float aend = ACS[127 * 8 + e];
        conv_item<4>(Hb, 128 * c, 4 * seg, g * 512 + e * 64 + cg * 8, conv_w, conv_b, [&](int l, const float (&v)[8]) {
            const float sc = DTS[l * 8 + e] * __expf(aend - ACS[l * 8 + e]);
            u32x4 o; o.x = cvtpk(v[0] * sc, v[1] * sc); o.y = cvtpk(v[2] * sc, v[3] * sc); o.z = cvtpk(v[4] * sc, v[5] * sc); o.w = cvtpk(v[6] * sc, v[7] * sc);
            *(SS_LAS u32x4*)(lds + A_XD + buf * 128 * XP + l * XP + cg * 16) = o; });
    };
    { const int cg = tid >> 5, seg = tid & 31;
        conv_item<4>(Hb, 128 * c, 4 * seg, 2048 + g * 128 + cg * 8, conv_w, conv_b, [&](int l, const float (&v)[8]) {
            u32x4 o; o.x = cvtpk(v[0], v[1]); o.y = cvtpk(v[2], v[3]); o.z = cvtpk(v[4], v[5]); o.w = cvtpk(v[6], v[7]);
            *(SS_LAS u32x4*)(lds + A_BS + l * BPT + cg * 16) = o; }); }
    if (tid < 256) stageX(0, tid, 0);
    __syncthreads();
    const int pb = w & 1, nb = w >> 1;
    const int rsel = ((lane & 15) >> 2), csel = 16 * ((lane >> 4) & 1) + 4 * (lane & 3);
    for (int e = 0; e < 8; ++e) {
        if (e + 1 < 8 && tid >= 256) stageX(e + 1, tid - 256, (e + 1) & 1);
        f32x16 acc = (f32x16){0.f, 0.f, 0.f, 0.f, 0.f, 0.f, 0.f, 0.f, 0.f, 0.f, 0.f, 0.f, 0.f, 0.f, 0.f, 0.f};
        const SS_LAS unsigned char* bp = lds + A_BS + (8 * hh + rsel) * BPT + (32 * nb + csel) * 2;
        const SS_LAS unsigned char* xp = lds + A_XD + (e & 1) * 128 * XP + (8 * hh + rsel) * XP + (32 * pb + csel) * 2;
#pragma unroll
        for (int ks = 0; ks < 8; ++ks) {
            const s16x4 b0 = vtr(bp + (16 * ks) * BPT), b1 = vtr(bp + (16 * ks + 4) * BPT), x0 = vtr(xp + (16 * ks) * XP), x1 = vtr(xp + (16 * ks + 4) * XP);
            const bf16x8 bf = (bf16x8){b0[0], b0[1], b0[2], b0[3], b1[0], b1[1], b1[2], b1[3]}, xf = (bf16x8){x0[0], x0[1], x0[2], x0[3], x1[0], x1[1], x1[2], x1[3]};
            acc = __builtin_amdgcn_mfma_f32_32x32x16_bf16(bf, xf, acc, 0, 0, 0);
        }
        bf16_t* sp = ST + ((size_t)(c * 32 + 8 * g + e) * 64 + 32 * pb + c32) * 128 + 32 * nb + 4 * hh;
#pragma unroll
        for (int q = 0; q < 4; ++q) { uint2 o; o.x = cvtpk(acc[4 * q], acc[4 * q + 1]); o.y = cvtpk(acc[4 * q + 2], acc[4 * q + 3]); *(uint2*)(sp + 8 * q) = o; }
        __syncthreads();
    }
}
__device__ __forceinline__ void scan_phase(bf16_t* __restrict__ ST, const float* __restrict__ CD, int gtid) {
    const int h = gtid >> 12;
    unsigned* p = (unsigned*)ST + gtid;
    float r0 = 0.f, r1 = 0.f;
    for (int c0 = 0; c0 < 64; c0 += 16) {
        unsigned v[16]; float d[16];
#pragma unroll
        for (int i = 0; i < 16; ++i) { v[i] = p[(size_t)(c0 + i) * 131072]; d[i] = CD[(c0 + i) * 32 + h]; }
#pragma unroll
        for (int i = 0; i < 16; ++i) { p[(size_t)(c0 + i) * 131072] = cvtpk(r0, r1); r0 = r0 * d[i] + bflo(v[i]); r1 = r1 * d[i] + bfhi(v[i]); }
    }
}
constexpr int C_CS = 0, C_BS = 128 * CP  , C_X1 = C_BS  , C_CBT = 2 * 128 * CP  , C_X0 = C_CBT + 32768  , C_ACS = C_X0 + 128 * XP  , C_DTS = C_ACS + 4096,
              C_SSQ = C_DTS + 4096, C_END = C_SSQ + 1024;
static_assert(C_END <= 147456 && 128 * XP <= 128 * CP, "ssd phase C LDS");
template <bool STORE = true> __device__ __forceinline__ void phaseC_unit(SS_LAS unsigned char* lds, bf16_t* __restrict__ Hb, const float* __restrict__ DTb, const float* __restrict__ conv_w, const float* __restrict__ conv_b,
                                            const float* __restrict__ a_log, const float* __restrict__ d_skip, const float* __restrict__ norm_w, const bf16_t* __restrict__ ST, int c, int g, bf16_t* Yb, int ldy) {
    const int tid = opaque_tid(), lane = tid & 63, w = __builtin_amdgcn_readfirstlane(tid >> 6), c32 = lane & 31, hh = lane >> 5;
    SS_LAS float* ACS = (SS_LAS float*)(lds + C_ACS); SS_LAS float* DTS = (SS_LAS float*)(lds + C_DTS); SS_LAS float* SSQ = (SS_LAS float*)(lds + C_SSQ);
    acs_tables(ACS, DTS, DTb, a_log, c, g);
    auto stageX = [&](int e, int item, int buf) {
        const int cg = item >> 5, seg = item & 31;
        conv_item<4>(Hb, 128 * c, 4 * seg, g * 512 + e * 64 + cg * 8, conv_w, conv_b, [&](int l, const float (&v)[8]) {
            u32x4 o; o.x = cvtpk(v[0], v[1]); o.y = cvtpk(v[2], v[3]); o.z = cvtpk(v[4], v[5]); o.w = cvtpk(v[6], v[7]);
            *(SS_LAS u32x4*)(lds + (buf ? C_X1 : C_X0) + l * XP + cg * 16) = o; });
    };
    { const int isC = tid >> 8, it = tid & 255, cg = it >> 4, seg = it & 15;
        conv_item<8>(Hb, 128 * c, 8 * seg, 2048 + isC * 512 + g * 128 + cg * 8, conv_w, conv_b, [&](int l, const float (&v)[8]) {
            u32x4 o; o.x = cvtpk(v[0], v[1]); o.y = cvtpk(v[2], v[3]); o.z = cvtpk(v[4], v[5]); o.w = cvtpk(v[6], v[7]);
            *(SS_LAS u32x4*)(lds + (isC ? C_CS : C_BS) + l * CP + cg * 16) = o; }); }
    if (tid < 256) stageX(0, tid, 0);
    __syncthreads();
    for (int i = w; i < 10; i += 8) {
        const int sb = (i < 4) ? 0 : (i < 7) ? 1 : (i < 9) ? 2 : 3, lb = (i < 4) ? i : (i < 7) ? i - 3 : (i < 9) ? i - 5 : 3;
        f32x16 acc = (f32x16){0.f, 0.f, 0.f, 0.f, 0.f, 0.f, 0.f, 0.f, 0.f, 0.f, 0.f, 0.f, 0.f, 0.f, 0.f, 0.f};
        const SS_LAS unsigned char* bp = lds + C_BS + (32 * sb + c32) * CP + 16 * hh, *cp = lds + C_CS + (32 * lb + c32) * CP + 16 * hh;
#pragma unroll
        for (int ks = 0; ks < 8; ++ks) acc = __builtin_amdgcn_mfma_f32_32x32x16_bf16(*(const SS_LAS bf16x8*)(bp + 32 * ks), *(const SS_LAS bf16x8*)(cp + 32 * ks), acc, 0, 0, 0);
        SS_LAS unsigned* o = (SS_LAS unsigned*)(lds + C_CBT) + (sb * 4 + lb) * 512 + lane;
#pragma unroll
        for (int q = 0; q < 8; ++q) o[q * 64] = cvtpk(acc[2 * q], acc[2 * q + 1]);
    }
    __syncthreads();
    const int pb = w & 1, lb = w >> 1, lrow = 32 * lb + c32;
    const int rsel = ((lane & 15) >> 2), csel = 16 * ((lane >> 4) & 1) + 4 * (lane & 3);
    unsigned ypk[8][8];
    float ssq = 0.f;
    bf16x8 pcur[8]; u32x2 zcur[4];
#define SS_PREF(pdst, zdst, e_) do { const int h_ = 8 * g + (e_); const bf16_t* pp_ = ST + ((size_t)(c * 32 + h_) * 64 + 32 * pb + c32) * 128 + 8 * hh; \
        _Pragma("unroll") for (int ks_ = 0; ks_ < 8; ++ks_) pdst[ks_] = *(const bf16x8*)(pp_ + 16 * ks_); \
        const bf16_t* zp_ = Hb + (size_t)(128 * c + lrow) * HP_ + HC_Z + g * 512 + (e_) * 64 + 32 * pb + 4 * hh; \
        _Pragma("unroll") for (int q_ = 0; q_ < 4; ++q_) zdst[q_] = *(const u32x2*)(zp_ + 8 * q_); } while (0)
    SS_PREF(pcur, zcur, 0);
    for (int e = 0; e < 8; ++e) {
        const int h = 8 * g + e;
        if (e + 1 < 8 && tid < 256) stageX(e + 1, tid, (e + 1) & 1);
        bf16x8 pnext[8]; u32x2 znext[4];
        { const int en = (e + 1 < 8) ? e + 1 : 7; SS_PREF(pnext, znext, en); }
        const int xoff = (e & 1) ? C_X1 : C_X0;
        f32x16 acc = (f32x16){0.f, 0.f, 0.f, 0.f, 0.f, 0.f, 0.f, 0.f, 0.f, 0.f, 0.f, 0.f, 0.f, 0.f, 0.f, 0.f};
        {
            const SS_LAS unsigned char* cp = lds + C_CS + lrow * CP + 16 * hh;
#pragma unroll
            for (int ks = 0; ks < 8; ++ks) acc = __builtin_amdgcn_mfma_f32_32x32x16_bf16(pcur[ks], *(const SS_LAS bf16x8*)(cp + 32 * ks), acc, 0, 0, 0);
        }
        const float al = ACS[lrow * 8 + e], eal = __expf(al);
#pragma unroll
        for (int r = 0; r < 16; ++r) acc[r] *= eal;
        for (int sb = 0; sb <= lb; ++sb) {
            const SS_LAS unsigned* cbp = (const SS_LAS unsigned*)(lds + C_CBT) + (sb * 4 + lb) * 512 + lane;
            float m[16];
#pragma unroll
            for (int q = 0; q < 8; ++q) { const unsigned u = cbp[q * 64]; m[2 * q] = bflo(u); m[2 * q + 1] = bfhi(u); }
#pragma unroll
            for (int r = 0; r < 16; ++r) { const int srow = 32 * sb + (r & 3) + 8 * (r >> 2) + 4 * hh;
                const float f = __expf(al - ACS[srow * 8 + e]) * DTS[srow * 8 + e];
                m[r] = (srow <= lrow) ? m[r] * f : 0.f; }
            const SS_LAS unsigned char* xp = lds + xoff + (32 * sb + 4 * hh + rsel) * XP + (32 * pb + csel) * 2;
#pragma unroll
            for (int ks = 0; ks < 2; ++ks) {
                const s16x4 x0 = vtr(xp + (16 * ks) * XP), x1 = vtr(xp + (16 * ks + 8) * XP);
                const bf16x8 xf = (bf16x8){x0[0], x0[1], x0[2], x0[3], x1[0], x1[1], x1[2], x1[3]};
                u32x4 mm; mm.x = cvtpk(m[8 * ks], m[8 * ks + 1]); mm.y = cvtpk(m[8 * ks + 2], m[8 * ks + 3]); mm.z = cvtpk(m[8 * ks + 4], m[8 * ks + 5]); mm.w = cvtpk(m[8 * ks + 6], m[8 * ks + 7]);
                acc = __builtin_amdgcn_mfma_f32_32x32x16_bf16(xf, __builtin_bit_cast(bf16x8, mm), acc, 0, 0, 0);
            }
        }
        const float dsk = d_skip[h];
        const SS_LAS unsigned char* xr = lds + xoff + lrow * XP + (32 * pb + 4 * hh) * 2;
        unsigned yt[8];
#pragma unroll
        for (int q = 0; q < 4; ++q) {
            const u32x2 zz = zcur[q]; const u32x2 xx = *(const SS_LAS u32x2*)(xr + 16 * q);
            const float zv[4] = {bflo(zz.x), bfhi(zz.x), bflo(zz.y), bfhi(zz.y)}, xv[4] = {bflo(xx.x), bfhi(xx.x), bflo(xx.y), bfhi(xx.y)};
            float y[4];
#pragma unroll
            for (int k = 0; k < 4; ++k) { y[k] = (acc[4 * q + k] + dsk * xv[k]) * (zv[k] * __builtin_amdgcn_rcpf(1.f + __expf(-zv[k]))); ssq += y[k] * y[k]; }
            yt[2 * q] = cvtpk(y[0], y[1]); yt[2 * q + 1] = cvtpk(y[2], y[3]);
        }
#define SS_YSET(E) case E: { _Pragma("unroll") for (int q_ = 0; q_ < 8; ++q_) ypk[E][q_] = yt[q_]; } break;
        switch (e) { SS_YSET(0) SS_YSET(1) SS_YSET(2) SS_YSET(3) SS_YSET(4) SS_YSET(5) SS_YSET(6) default: { _Pragma("unroll") for (int q_ = 0; q_ < 8; ++q_) ypk[7][q_] = yt[q_]; } break; }
#undef SS_YSET
#pragma unroll
        for (int ks = 0; ks < 8; ++ks) pcur[ks] = pnext[ks];
#pragma unroll
        for (int q = 0; q < 4; ++q) zcur[q] = znext[q];
        __syncthreads();
    }
#undef SS_PREF
    ssq += __shfl_xor(ssq, 32);
    if (hh == 0) SSQ[pb * 128 + lrow] = ssq;
    __syncthreads();
    const float rstd = rsqrtf((SSQ[lrow] + SSQ[128 + lrow]) * (1.f / 512.f) + 1e-5f);
    bf16_t* op = Yb + (size_t)(128 * c + lrow) * ldy + g * 512 + 32 * pb + 4 * hh;
    const float* nw = norm_w + g * 512 + 32 * pb + 4 * hh;
#pragma unroll
    for (int e = 0; e < 8; ++e)
#pragma unroll
        for (int q = 0; q < 4; ++q) { const f32x4 n4 = *(const f32x4*)(nw + e * 64 + 8 * q);
            uint2 o; o.x = cvtpk(bflo(ypk[e][2 * q]) * rstd * n4.x, bfhi(ypk[e][2 * q]) * rstd * n4.y); o.y = cvtpk(bflo(ypk[e][2 * q + 1]) * rstd * n4.z, bfhi(ypk[e][2 * q + 1]) * rstd * n4.w);
            if (STORE || o.x == 0x12345u) *(uint2*)(op + e * 64 + 8 * q) = o; }
    __syncthreads();
}
}


namespace psel {
#define PS_LAS __attribute__((address_space(3)))
typedef short bf16x8 __attribute__((ext_vector_type(8)));
typedef float f32x16 __attribute__((ext_vector_type(16)));
__device__ __forceinline__ int ord(float f) { const int b = __builtin_bit_cast(int, f); return b ^ ((b >> 31) & 0x7fffffff); }
__device__ __forceinline__ float unord(int t) { return __builtin_bit_cast(float, t ^ ((t >> 31) & 0x7fffffff)); }
#define PS_INS(top, v) do { int v_ = (v); _Pragma("unroll") for (int i_ = 0; i_ < 16; ++i_) { const int hi_ = max(top[i_], v_); v_ = min(top[i_], v_); top[i_] = hi_; } } while (0)
__device__ __forceinline__ void stage1(PS_LAS int* EXall, const bf16_t* __restrict__ QP, const bf16_t* __restrict__ SUBK, int tok0, int hp) {
    const int tid = opaque_tid(), lane = tid & 63, w1 = __builtin_amdgcn_readfirstlane(tid >> 6), c32 = lane & 31, hh = lane >> 5;
    PS_LAS int* EX = EXall + hp * 4096;
    {
        const int tile = w1 >> 2, hsel = (w1 >> 1) & 1, half = w1 & 1, h = 2 * hp + hsel;
        const bf16_t* qp = QP + (size_t)(tok0 + 32 * tile + c32) * 2048 + h * 256 + half * 128 + 8 * hh;
        const bf16_t* kp = SUBK + ((size_t)(h * 2 + half) * 128 + c32) * 128 + 8 * hh;
        bf16x8 qf[8];
#pragma unroll
        for (int ks = 0; ks < 8; ++ks) qf[ks] = *(const bf16x8*)(qp + 16 * ks);
        int top[16];
#pragma unroll
        for (int i = 0; i < 16; ++i) top[i] = (int)0x80000000;
        bf16x8 kfa[8], kfb[8];
#define PS_LDK(dst, mt_) do { _Pragma("unroll") for (int ks_ = 0; ks_ < 8; ++ks_) dst[ks_] = *(const bf16x8*)(kp + (size_t)(32 * (mt_)) * 128 + 16 * ks_); } while (0)
#define PS_TILE(src, mt_) do { f32x16 acc_ = (f32x16){0.f, 0.f, 0.f, 0.f, 0.f, 0.f, 0.f, 0.f, 0.f, 0.f, 0.f, 0.f, 0.f, 0.f, 0.f, 0.f}; \
            _Pragma("unroll") for (int ks_ = 0; ks_ < 8; ++ks_) acc_ = __builtin_amdgcn_mfma_f32_32x32x16_bf16(src[ks_], qf[ks_], acc_, 0, 0, 0); \
            _Pragma("unroll") for (int r_ = 0; r_ < 16; ++r_) { const int key_ = 32 * (mt_) + (r_ & 3) + 8 * (r_ >> 2) + 4 * hh; const int v__ = (ord(acc_[r_]) & ~127) | (127 - key_); PS_INS(top, v__); } } while (0)
        PS_LDK(kfa, 0);
        PS_LDK(kfb, 1); PS_TILE(kfa, 0);
        PS_LDK(kfa, 2); PS_TILE(kfb, 1);
        PS_LDK(kfb, 3); PS_TILE(kfa, 2);
        PS_TILE(kfb, 3);
#undef PS_LDK
#undef PS_TILE
        int oth[16];
#pragma unroll
        for (int i = 0; i < 16; ++i) oth[i] = __shfl_xor(top[i], 32);
#pragma unroll
        for (int i = 0; i < 16; ++i) PS_INS(top, oth[i]);
        if (hh == 0) {
#pragma unroll
            for (int i = 0; i < 16; ++i) EX[(w1 * 16 + i) * 32 + c32] = top[i];
        }
    }
}
__device__ __forceinline__ void stage2(PS_LAS int* EXall, int* __restrict__ IDX, float* __restrict__ GATE, int tok0) {
    const int tid = opaque_tid();
    {
        const int hp = tid >> 7, task = tid & 127, th = task >> 5, tok32 = task & 31, tile = th >> 1, hsel = th & 1, h = 2 * hp + hsel;
        PS_LAS int* EX = EXall + hp * 4096;
        const PS_LAS int* ea = EX + ((th * 2 + 0) * 16) * 32 + tok32; const PS_LAS int* eb = EX + ((th * 2 + 1) * 16) * 32 + tok32;
        float as[16], bs[16];
#pragma unroll
        for (int i = 0; i < 16; ++i) { as[i] = unord(ea[i * 32] & ~127); bs[i] = unord(eb[i * 32] & ~127); }
        int top[16];
#pragma unroll
        for (int i = 0; i < 16; ++i) top[i] = (int)0x80000000;
#pragma unroll
        for (int i = 0; i < 16; ++i)
#pragma unroll
            for (int j = 0; j < 16; ++j) if ((i + 1) * (j + 1) <= 16) { const int v = (ord(as[i] + bs[j]) & ~255) | (255 - (i * 16 + j)); PS_INS(top, v); }
        float sc[16]; int id[16];
#pragma unroll
        for (int r = 0; r < 16; ++r) { const int cn = 255 - (top[r] & 255), i = cn >> 4, j = cn & 15; const int pa = ea[i * 32], pb = eb[j * 32];
            sc[r] = unord(pa & ~127) + unord(pb & ~127); id[r] = (127 - (pa & 127)) * 128 + (127 - (pb & 127)); }
        float sum = 0.f; const float mx = sc[0];
#pragma unroll
        for (int r = 0; r < 16; ++r) { sc[r] = __expf(sc[r] - mx); sum += sc[r]; }
        const size_t o = (size_t)(tok0 + 32 * tile + tok32) * 128 + h * 16;
        const float inv = 1.f / sum;
#pragma unroll
        for (int r = 0; r < 16; r += 4) { *(f32x4*)(GATE + o + r) = (f32x4){sc[r] * inv, sc[r + 1] * inv, sc[r + 2] * inv, sc[r + 3] * inv}; *(u32x4*)(IDX + o + r) = (u32x4){(unsigned)id[r], (unsigned)id[r + 1], (unsigned)id[r + 2], (unsigned)id[r + 3]}; }
    }
}
}


namespace xattn {
#define XA_LAS __attribute__((address_space(3)))
typedef short bf16x8 __attribute__((ext_vector_type(8)));
typedef short s16x4 __attribute__((ext_vector_type(4)));
typedef float f32x16 __attribute__((ext_vector_type(16)));
constexpr int RP = 528;
__device__ __forceinline__ unsigned cvtpk(float lo, float hi) { typedef float f2 __attribute__((ext_vector_type(2))); typedef __bf16 b2 __attribute__((ext_vector_type(2))); f2 v = {lo, hi}; b2 b = __builtin_convertvector(v, b2); return __builtin_bit_cast(unsigned, b); }
__device__ __forceinline__ void stage(XA_LAS unsigned char* lds, const bf16_t* __restrict__ src, int pitch, int tid) {
#pragma unroll 4
    for (int i = 0; i < 16; ++i) { const int q = tid + 512 * i, row = q >> 5, ch = q & 31; *(XA_LAS u32x4*)(lds + row * RP + ch * 16) = *(const u32x4*)(src + (size_t)row * pitch + ch * 8); }
}
__device__ __forceinline__ void unit(XA_LAS unsigned char* lds, const bf16_t* __restrict__ QC, const bf16_t* __restrict__ KC, const bf16_t* __restrict__ VcT, bf16_t* __restrict__ XO, int tg, int h) {
    const int tid = opaque_tid(), lane = tid & 63, w = __builtin_amdgcn_readfirstlane(tid >> 6), c32 = lane & 31, hh = lane >> 5, b = tg >> 5;
    const int tok = 256 * tg + 32 * w + c32;
    stage(lds, KC + (size_t)b * MEML * D + h * 256, D, tid);
    bf16x8 pf[8][2]; float inv;
    {
        bf16x8 qf[16];
        const bf16_t* qp = QC + (size_t)tok * D + h * 256 + 8 * hh;
#pragma unroll
        for (int ks = 0; ks < 16; ++ks) qf[ks] = *(const bf16x8*)(qp + 16 * ks);
        __syncthreads();
        f32x16 acc[8];
        const XA_LAS unsigned char* kb = lds + c32 * RP + 16 * hh;
#pragma unroll
        for (int mt = 0; mt < 8; ++mt) {
            acc[mt] = (f32x16){0.f, 0.f, 0.f, 0.f, 0.f, 0.f, 0.f, 0.f, 0.f, 0.f, 0.f, 0.f, 0.f, 0.f, 0.f, 0.f};
#pragma unroll
            for (int ks = 0; ks < 16; ++ks) acc[mt] = __builtin_amdgcn_mfma_f32_32x32x16_bf16(*(const XA_LAS bf16x8*)(kb + (32 * mt) * RP + 32 * ks), qf[ks], acc[mt], 0, 0, 0);
        }
        float mx = acc[0][0];
#pragma unroll
        for (int mt = 0; mt < 8; ++mt)
#pragma unroll
            for (int r = 0; r < 16; ++r) mx = fmaxf(mx, acc[mt][r]);
        mx = fmaxf(mx, __shfl_xor(mx, 32));
        float sum = 0.f;
#pragma unroll
        for (int mt = 0; mt < 8; ++mt)
#pragma unroll
            for (int r = 0; r < 16; ++r) { acc[mt][r] = __builtin_amdgcn_exp2f(acc[mt][r] - mx); sum += acc[mt][r]; }
        sum += __shfl_xor(sum, 32); inv = 1.f / sum;
#pragma unroll
        for (int mt = 0; mt < 8; ++mt)
#pragma unroll
            for (int s2 = 0; s2 < 2; ++s2) { u32x4 a; a.x = cvtpk(acc[mt][8 * s2], acc[mt][8 * s2 + 1]); a.y = cvtpk(acc[mt][8 * s2 + 2], acc[mt][8 * s2 + 3]); a.z = cvtpk(acc[mt][8 * s2 + 4], acc[mt][8 * s2 + 5]); a.w = cvtpk(acc[mt][8 * s2 + 6], acc[mt][8 * s2 + 7]);
                pf[mt][s2] = __builtin_bit_cast(bf16x8, a); }
    }
    __syncthreads();
    stage(lds, VcT + ((size_t)b * D + h * 256) * MEML, MEML, tid);
    __syncthreads();
    const XA_LAS unsigned char* vb = lds + c32 * RP + 8 * hh;
    bf16_t* op = XO + (size_t)tok * D + h * 256 + 4 * hh;
#pragma unroll 1
    for (int dt = 0; dt < 8; ++dt) {
        f32x16 acc = (f32x16){0.f, 0.f, 0.f, 0.f, 0.f, 0.f, 0.f, 0.f, 0.f, 0.f, 0.f, 0.f, 0.f, 0.f, 0.f, 0.f};
#pragma unroll
        for (int mt = 0; mt < 8; ++mt)
#pragma unroll
            for (int s2 = 0; s2 < 2; ++s2) {
                const s16x4 lo = *(const XA_LAS s16x4*)(vb + (32 * dt) * RP + (32 * mt + 16 * s2) * 2), hi = *(const XA_LAS s16x4*)(vb + (32 * dt) * RP + (32 * mt + 16 * s2 + 8) * 2);
                const bf16x8 vf = (bf16x8){lo[0], lo[1], lo[2], lo[3], hi[0], hi[1], hi[2], hi[3]};
                acc = __builtin_amdgcn_mfma_f32_32x32x16_bf16(vf, pf[mt][s2], acc, 0, 0, 0);
            }
#pragma unroll
        for (int q = 0; q < 4; ++q) { u32x2 o; o.x = cvtpk(acc[4 * q] * inv, acc[4 * q + 1] * inv); o.y = cvtpk(acc[4 * q + 2] * inv, acc[4 * q + 3] * inv); *(u32x2*)(op + 32 * dt + 8 * q) = o; }
    }
    __syncthreads();
}
}

namespace sp {
#define SP_LAS __attribute__((address_space(3)))
#define SP_LDSWAIT() do { asm volatile("s_waitcnt lgkmcnt(0)" ::: "memory"); } while (0)
__device__ __forceinline__ void transpose_item(const float* __restrict__ W, int ldw, int col0, int K, int nblk, bf16_t* __restrict__ WT, int row_off, SP_LAS float* scr, int item, int lane) {
    const int kb = item / nblk, nb = item % nblk, k0 = 64 * kb, n0 = 32 * nb;
#pragma unroll 8
    for (int i = 0; i < 32; ++i) { const int kk = 2 * i + (lane >> 5); scr[kk * 33 + (lane & 31)] = W[(size_t)(k0 + kk) * ldw + col0 + n0 + (lane & 31)]; }
    SP_LDSWAIT();
    const int cc = lane & 7;
#pragma unroll
    for (int j = 0; j < 4; ++j) { const int n = (lane >> 3) + 8 * j; const SP_LAS float* s = scr + (8 * cc) * 33 + n;
        u32x4 o; o.x = pk2(s[0 * 33], s[1 * 33]); o.y = pk2(s[2 * 33], s[3 * 33]); o.z = pk2(s[4 * 33], s[5 * 33]); o.w = pk2(s[6 * 33], s[7 * 33]);
        *(u32x4*)(WT + (size_t)(row_off + n0 + n) * K + k0 + 8 * cc) = o; }
    SP_LDSWAIT();
}
__device__ __forceinline__ void cvt_range(const float* __restrict__ src, bf16_t* __restrict__ dst, size_t n4, size_t gtid, size_t gthreads) {
    for (size_t i = gtid; i < n4; i += gthreads) { const f32x4 v = ((const f32x4*)src)[i]; u32x2 o; o.x = pk2(v.x, v.y); o.y = pk2(v.z, v.w); ((u32x2*)dst)[i] = o; }
}

__device__ __forceinline__ void cvt_fp8_range(const float* __restrict__ src, unsigned char* __restrict__ dst, size_t n16, float scale, size_t gtid, size_t gthreads) {
    for (size_t i0 = gtid; i0 < n16; i0 += 2 * gthreads) {
        const size_t i1 = (i0 + gthreads < n16) ? i0 + gthreads : i0;
        f32x4 v[2][4];
#pragma unroll
        for (int q = 0; q < 4; ++q) { v[0][q] = ((const f32x4*)src + 4 * i0)[q]; v[1][q] = ((const f32x4*)src + 4 * i1)[q]; }
#pragma unroll
        for (int u = 0; u < 2; ++u) { const size_t i = u ? i1 : i0; unsigned ow[4];
#pragma unroll
            for (int q = 0; q < 4; ++q) { const f32x4 t = v[u][q];
                const float a = fminf(fmaxf(t.x * scale, -448.f), 448.f), b = fminf(fmaxf(t.y * scale, -448.f), 448.f), c2 = fminf(fmaxf(t.z * scale, -448.f), 448.f), d2 = fminf(fmaxf(t.w * scale, -448.f), 448.f);
                int p = 0; p = __builtin_amdgcn_cvt_pk_fp8_f32(a, b, p, false); p = __builtin_amdgcn_cvt_pk_fp8_f32(c2, d2, p, true); ow[q] = (unsigned)p; }
            u32x4 o; o.x = ow[0]; o.y = ow[1]; o.z = ow[2]; o.w = ow[3];
            const size_t e_ = i >> 6, cg_ = i & 63; ((u32x4*)dst)[(cg_ >> 3) * ((size_t)PK * PK * 8) + e_ * 8 + (cg_ & 7)] = o; }
    }
}
__device__ __forceinline__ void dt_stage_w(SP_LAS float* Wl, const float* __restrict__ w_in) {
    const int tid = opaque_tid();
#pragma unroll 8
    for (int i = 0; i < 64; ++i) { const int idx = tid + 512 * i; Wl[idx] = w_in[(size_t)(idx >> 5) * NIN + 5120 + (idx & 31)]; }
}
__device__ __forceinline__ void dt_items(SP_LAS float* Wl, SP_LAS float* xs, SP_LAS float* part, const float* __restrict__ x, const float* __restrict__ dt_bias, float* __restrict__ DT, bf16_t* __restrict__ XBo, int it0, int stride, int it_end) {
    const int tid = opaque_tid(), lane = tid & 63, w = tid >> 6;
    const int h = lane & 31, r = w >> 1, kq = (w & 1) * 2 + (lane >> 5);
    const SP_LAS float* xp = xs + r * 1024 + kq * 256; const SP_LAS float* wp = Wl + (kq * 256) * 32 + h;
    const float bias = dt_bias[h];
    f32x4 nx[2];
    if (it0 < it_end) {
#pragma unroll
        for (int i = 0; i < 2; ++i) nx[i] = ((const f32x4*)(x + (size_t)it0 * 4 * D))[tid + 512 * i];
    }
    for (int item = it0; item < it_end; item += stride) {
        const int m0 = item * 4;
#pragma unroll
        for (int i = 0; i < 2; ++i) { const int q = tid + 512 * i; const f32x4 v = nx[i]; *(SP_LAS f32x4*)(xs + 4 * q) = v;
            u32x2 o; o.x = pk2(v.x, v.y); o.y = pk2(v.z, v.w); ((u32x2*)(XBo + (size_t)m0 * D))[q] = o; }
        __syncthreads();
        { const int nitem = (item + stride < it_end) ? item + stride : item;
#pragma unroll
          for (int i = 0; i < 2; ++i) nx[i] = ((const f32x4*)(x + (size_t)nitem * 4 * D))[tid + 512 * i]; }
        float a0 = 0.f, a1 = 0.f;
#pragma unroll 8
        for (int k = 0; k < 256; k += 2) { a0 = fmaf(xp[k], wp[k * 32], a0); a1 = fmaf(xp[k + 1], wp[(k + 1) * 32], a1); }
        float acc = a0 + a1;
        acc += __shfl_xor(acc, 32);
        if ((w & 1) && lane < 32) part[r * 32 + h] = acc;
        __syncthreads();
        if (!(w & 1) && lane < 32) { const float v = acc + part[r * 32 + h] + bias; DT[(size_t)(m0 + r) * 32 + h] = v > 20.f ? v : log1pf(expf(v)); }
    }
}
__device__ __forceinline__ void ln_row(float* __restrict__ X, const float* __restrict__ g, const float* __restrict__ b, bf16_t* __restrict__ XB, int row, int lane) {
    f32x4* xr = (f32x4*)(X + (size_t)row * D) + lane;
    f32x4 v[4]; float s = 0.f;
#pragma unroll
    for (int j = 0; j < 4; ++j) { v[j] = xr[64 * j]; s += (v[j].x + v[j].y) + (v[j].z + v[j].w); }
    const float mean = wave_sum(s) * (1.f / D); float s2 = 0.f;
#pragma unroll
    for (int j = 0; j < 4; ++j) { v[j] = v[j] - mean; s2 += (v[j].x * v[j].x + v[j].y * v[j].y) + (v[j].z * v[j].z + v[j].w * v[j].w); }
    const float rstd = rsqrtf(wave_sum(s2) * (1.f / D) + 1e-5f);
#pragma unroll
    for (int j = 0; j < 4; ++j) { const int c = 4 * lane + 256 * j; const f32x4 gg = *(const f32x4*)(g + c), bb = *(const f32x4*)(b + c);
        f32x4 o = v[j] * rstd * gg + bb; xr[64 * j] = o;
        u32x2 pb; pb.x = pk2(o.x, o.y); pb.y = pk2(o.z, o.w); *(u32x2*)(XB + (size_t)row * D + c) = pb; }
}
__device__ __forceinline__ void xattn_pair(SP_LAS float* L, const bf16_t* __restrict__ QC, const bf16_t* __restrict__ KCVC, bf16_t* __restrict__ XO, int tok0) {
    const int t512 = opaque_tid(); const int half = t512 >> 8, tid = t512 & 255, lane = tid & 63, wv = tid >> 6, tok = tok0 + half, b = tok / SEQ;
    SP_LAS float* qs = L + half * 1024; SP_LAS float* ps = L + 2048 + half * 256; SP_LAS float* red = L + 2560 + half * 8;
    for (int i = tid; i < 1024; i += 256) qs[i] = bf2f(QC[(size_t)tok * D + i]);
    __syncthreads();
    const bf16_t* KV = KCVC + (size_t)b * MEML * 2048;
    for (int h = 0; h < MH; ++h) {
        const bf16_t* kp = KV + (size_t)tid * 2048 + h * 256;
        float s = 0.f;
        for (int d = 0; d < 256; d += 8) { const u32x4 w = *(const u32x4*)(kp + d); const SP_LAS float* q = qs + h * 256 + d;
            s += q[0] * bflo(w.x) + q[1] * bfhi(w.x) + q[2] * bflo(w.y) + q[3] * bfhi(w.y) + q[4] * bflo(w.z) + q[5] * bfhi(w.z) + q[6] * bflo(w.w) + q[7] * bfhi(w.w); }
        float mx = wave_max(s); if (lane == 0) red[wv] = mx; __syncthreads();
        mx = fmaxf(fmaxf(red[0], red[1]), fmaxf(red[2], red[3]));
        const float p = exp2f(s - mx);
        float sm = wave_sum(p); if (lane == 0) red[4 + wv] = sm; ps[tid] = p; __syncthreads();
        sm = (red[4] + red[5]) + (red[6] + red[7]);
        float o = 0.f;
        for (int j = 0; j < 256; ++j) o = fmaf(ps[j], bf2f(KV[(size_t)j * 2048 + 1024 + h * 256 + tid]), o);
        XO[(size_t)tok * D + h * 256 + tid] = (bf16_t)f2bf(o / sm);
        __syncthreads();
    }
}
__device__ __forceinline__ void select_pair(SP_LAS float* L, const bf16_t* __restrict__ QP, const bf16_t* __restrict__ SUBK, int* __restrict__ IDX, float* __restrict__ GATE, int tok0) {
    const int t512 = opaque_tid(); const int hf = t512 >> 8, tid = t512 & 255, tok = tok0 + hf;
    SP_LAS float* base = L + hf * 3072;
    SP_LAS float* qs = base; SP_LAS float* s = base + 2048; SP_LAS float* tops = base + 2304; SP_LAS int* topi = (SP_LAS int*)(base + 2336); SP_LAS float* cs = base + 2368; SP_LAS int* ci = (SP_LAS int*)(base + 2624);
    SP_LAS float* bs = base + 2880; SP_LAS int* bi = (SP_LAS int*)(base + 2896);
    for (int i = tid; i < 2048; i += 256) qs[i] = bf2f(QP[(size_t)tok * 2048 + i]);
    __syncthreads();
    for (int h = 0; h < PH; ++h) {
        const int half = tid >> 7, key = tid & 127;
        { const bf16_t* kp = SUBK + ((size_t)(h * 2 + half) * 128 + key) * 128; const SP_LAS float* q = qs + h * 256 + half * 128; float a = 0.f;
          for (int d = 0; d < 128; d += 8) { const u32x4 w = *(const u32x4*)(kp + d);
              a += q[d] * bflo(w.x) + q[d + 1] * bfhi(w.x) + q[d + 2] * bflo(w.y) + q[d + 3] * bfhi(w.y) + q[d + 4] * bflo(w.z) + q[d + 5] * bfhi(w.z) + q[d + 6] * bflo(w.w) + q[d + 7] * bfhi(w.w); }
          s[tid] = a; }
        __syncthreads();
        { const float me = s[tid]; int rank = 0; const SP_LAS float* spp = s + half * 128;
          for (int j = 0; j < 128; ++j) { const float o = spp[j]; rank += (o > me || (o == me && j < key)) ? 1 : 0; }
          if (rank < 16) { tops[half * 16 + rank] = me; topi[half * 16 + rank] = key; } }
        __syncthreads();
        { const int i = tid >> 4, j = tid & 15; cs[tid] = tops[i] + tops[16 + j]; ci[tid] = topi[i] * 128 + topi[16 + j]; }
        __syncthreads();
        { const float me = cs[tid]; int rank = 0;
          for (int j = 0; j < 256; ++j) { const float o = cs[j]; rank += (o > me || (o == me && j < tid)) ? 1 : 0; }
          if (rank < 16) { bs[rank] = me; bi[rank] = ci[tid]; } }
        __syncthreads();
        if (tid < 16) { const float mx = bs[0]; float sum = 0.f;
            for (int j = 0; j < 16; ++j) sum += expf(bs[j] - mx);
            GATE[(size_t)tok * 128 + h * 16 + tid] = expf(bs[tid] - mx) / sum; IDX[(size_t)tok * 128 + h * 16 + tid] = bi[tid]; }
        __syncthreads();
    }
}
__device__ __forceinline__ void gather_token(SP_LAS float* L, float* __restrict__ X, const bf16_t* __restrict__ PU, const bf16_t* __restrict__ PV, const int* __restrict__ IDX, const float* __restrict__ GATE,
                                             const float* __restrict__ g3, const float* __restrict__ b3, int tok) {
    const int tid = opaque_tid(), lane = tid & 63, wv = tid >> 6;
    SP_LAS float* ys = L; SP_LAS float* red = L + 8192;
    float xr[16], y[16];
    { const float* xp = X + (size_t)tok * D + lane * 16;
#pragma unroll
      for (int j = 0; j < 4; ++j) { const f32x4 v = *(const f32x4*)(xp + 4 * j); xr[4 * j] = v.x; xr[4 * j + 1] = v.y; xr[4 * j + 2] = v.z; xr[4 * j + 3] = v.w; }
#pragma unroll
      for (int j = 0; j < 16; ++j) y[j] = 0.f; }
    for (int e = 0; e < 16; ++e) {
        const int slot = wv * 16 + e; const int id = IDX[(size_t)tok * 128 + slot]; const float gt = GATE[(size_t)tok * 128 + slot];
        const bf16_t* up = PU + (size_t)id * D + lane * 16; const u32x4 u0 = *(const u32x4*)up, u1 = *(const u32x4*)(up + 8);
        const unsigned uw[8] = {u0.x, u0.y, u0.z, u0.w, u1.x, u1.y, u1.z, u1.w};
        float hsum = 0.f;
#pragma unroll
        for (int j = 0; j < 8; ++j) { hsum = fmaf(xr[2 * j], bflo(uw[j]), hsum); hsum = fmaf(xr[2 * j + 1], bfhi(uw[j]), hsum); }
        hsum = wave_sum(hsum);
        const float w = gt * 0.5f * hsum * (1.f + erff(hsum * 0.70710678118654752f));
        const bf16_t* vp = PV + (size_t)id * D + lane * 16; const u32x4 v0 = *(const u32x4*)vp, v1 = *(const u32x4*)(vp + 8);
        const unsigned vw[8] = {v0.x, v0.y, v0.z, v0.w, v1.x, v1.y, v1.z, v1.w};
#pragma unroll
        for (int j = 0; j < 8; ++j) { y[2 * j] = fmaf(w, bflo(vw[j]), y[2 * j]); y[2 * j + 1] = fmaf(w, bfhi(vw[j]), y[2 * j + 1]); }
    }
#pragma unroll
    for (int j = 0; j < 16; ++j) ys[wv * 1024 + lane * 16 + j] = y[j];
    __syncthreads();
    float v[2]; float s = 0.f;
#pragma unroll
    for (int j = 0; j < 2; ++j) { const int c = tid * 2 + j; float a = 0.f;
#pragma unroll
        for (int k = 0; k < 8; ++k) a += ys[k * 1024 + c];
        v[j] = ALPHA * X[(size_t)tok * D + c] + a; s += v[j]; }
    s = wave_sum(s); if (lane == 0) red[wv] = s; __syncthreads();
    float tot = 0.f;
#pragma unroll
    for (int k = 0; k < 8; ++k) tot += red[k];
    const float mean = tot * (1.f / D);
    float s2 = 0.f;
#pragma unroll
    for (int j = 0; j < 2; ++j) { v[j] -= mean; s2 += v[j] * v[j]; }
    s2 = wave_sum(s2); if (lane == 0) red[8 + wv] = s2; __syncthreads();
    float tot2 = 0.f;
#pragma unroll
    for (int k = 0; k < 8; ++k) tot2 += red[8 + k];
    const float rstd = rsqrtf(tot2 * (1.f / D) + 1e-5f);
#pragma unroll
    for (int j = 0; j < 2; ++j) { const int c = tid * 2 + j; X[(size_t)tok * D + c] = v[j] * rstd * g3[c] + b3[c]; }
    __syncthreads();
}

constexpr float PEER_SU = 2048.f, PEER_SV = 256.f;
typedef float f32x2v __attribute__((ext_vector_type(2)));
__device__ __forceinline__ void gather_wave(float* __restrict__ Xo, const float* X, const unsigned char* __restrict__ PU, const unsigned char* __restrict__ PV, const int* __restrict__ IDX, const float* __restrict__ GATE,
                                            const float* __restrict__ g3, const float* __restrict__ b3, int tok, int lane) {
    float xr[16], y[16];
    { const f32x4* xp = (const f32x4*)(X + (size_t)tok * D + 16 * lane);
#pragma unroll
      for (int q = 0; q < 4; ++q) { const f32x4 v = xp[q]; xr[4 * q] = v.x; xr[4 * q + 1] = v.y; xr[4 * q + 2] = v.z; xr[4 * q + 3] = v.w; } }
#pragma unroll
    for (int j = 0; j < 16; ++j) y[j] = 0.f;
    const int id0 = IDX[(size_t)tok * 128 + lane], id1 = IDX[(size_t)tok * 128 + 64 + lane];
    const float gt0 = GATE[(size_t)tok * 128 + lane], gt1 = GATE[(size_t)tok * 128 + 64 + lane];
    u32x4 ub[8], vb[8];
#define GW_ISSUE(buf, TBL, i) do { const int idv_ = ((i) < 8) ? id0 : id1; _Pragma("unroll") for (int k_ = 0; k_ < 8; ++k_) { \
        const int id_ = __builtin_amdgcn_readlane(idv_, (8 * (i) + k_) & 63); buf[k_] = *(const u32x4*)((TBL) + (size_t)id_ * D + 16 * lane); } } while (0)
    GW_ISSUE(ub, PU, 0); GW_ISSUE(vb, PV, 0);
    const bool h32 = (lane & 32) != 0, h16 = (lane & 16) != 0, h8 = (lane & 8) != 0;
#pragma unroll 1
    for (int i = 0; i < 16; ++i) {
        float p[8];
#pragma unroll
        for (int k = 0; k < 8; ++k) { const unsigned w[4] = {ub[k].x, ub[k].y, ub[k].z, ub[k].w}; float a = 0.f;
#pragma unroll
            for (int q = 0; q < 4; ++q) { const f32x2v lo = __builtin_amdgcn_cvt_pk_f32_fp8((int)w[q], false), hi = __builtin_amdgcn_cvt_pk_f32_fp8((int)w[q], true);
                a = fmaf(xr[4 * q], lo.x, a); a = fmaf(xr[4 * q + 1], lo.y, a); a = fmaf(xr[4 * q + 2], hi.x, a); a = fmaf(xr[4 * q + 3], hi.y, a); }
            p[k] = a; }
        { const int in_ = (i + 1 < 16) ? i + 1 : 15; GW_ISSUE(ub, PU, in_); }
        float q4[4], q2[2], q1;
#pragma unroll
        for (int k = 0; k < 4; ++k) q4[k] = (h32 ? p[k + 4] : p[k]) + __shfl_xor(h32 ? p[k] : p[k + 4], 32);
#pragma unroll
        for (int k = 0; k < 2; ++k) q2[k] = (h16 ? q4[k + 2] : q4[k]) + __shfl_xor(h16 ? q4[k] : q4[k + 2], 16);
        q1 = (h8 ? q2[1] : q2[0]) + __shfl_xor(h8 ? q2[0] : q2[1], 8);
        q1 += __shfl_xor(q1, 4); q1 += __shfl_xor(q1, 2); q1 += __shfl_xor(q1, 1);
        q1 *= (1.f / PEER_SU);
        const float gsel = __shfl((i < 8) ? gt0 : gt1, (8 * i + (lane >> 3)) & 63);
        const float wv = gsel * 0.5f * q1 * (1.f + erff(q1 * 0.70710678118654752f));
#pragma unroll
        for (int k = 0; k < 8; ++k) { const float wk = __builtin_bit_cast(float, __builtin_amdgcn_readlane(__builtin_bit_cast(int, wv), 8 * k));
            const unsigned w[4] = {vb[k].x, vb[k].y, vb[k].z, vb[k].w};
#pragma unroll
            for (int q = 0; q < 4; ++q) { const f32x2v lo = __builtin_amdgcn_cvt_pk_f32_fp8((int)w[q], false), hi = __builtin_amdgcn_cvt_pk_f32_fp8((int)w[q], true);
                y[4 * q] = fmaf(wk, lo.x, y[4 * q]); y[4 * q + 1] = fmaf(wk, lo.y, y[4 * q + 1]); y[4 * q + 2] = fmaf(wk, hi.x, y[4 * q + 2]); y[4 * q + 3] = fmaf(wk, hi.y, y[4 * q + 3]); } }
        { const int in_ = (i + 1 < 16) ? i + 1 : 15; GW_ISSUE(vb, PV, in_); }
    }
#undef GW_ISSUE
    float s = 0.f;
#pragma unroll
    for (int j = 0; j < 16; ++j) { y[j] = ALPHA * xr[j] + y[j] * (1.f / PEER_SV); s += y[j]; }
    const float mean = wave_sum(s) * (1.f / D); float s2 = 0.f;
#pragma unroll
    for (int j = 0; j < 16; ++j) { y[j] -= mean; s2 += y[j] * y[j]; }
    const float rstd = rsqrtf(wave_sum(s2) * (1.f / D) + 1e-5f);
    float* op = Xo + (size_t)tok * D + 16 * lane;
#pragma unroll
    for (int q = 0; q < 4; ++q) { const f32x4 gg = *(const f32x4*)(g3 + 16 * lane + 4 * q), bb = *(const f32x4*)(b3 + 16 * lane + 4 * q);
        f32x4 o; o.x = y[4 * q] * rstd * gg.x + bb.x; o.y = y[4 * q + 1] * rstd * gg.y + bb.y; o.z = y[4 * q + 2] * rstd * gg.z + bb.z; o.w = y[4 * q + 3] * rstd * gg.w + bb.w;
        *(f32x4*)(op + 4 * q) = o; }
}
}


#define LAS __attribute__((address_space(3)))
#define XB_TMO      128
#define XB_XCNT(j)  (256  + 64 * (j))
#define XB_XSUB(j)  (1280 + 64 * (j))
#define XB_XGEN(j)  (2304 + 64 * (j))
#define XB_TOP      3328
#define XB_TOPGEN   3392
#define XCD_BAR_WORDS 3456
#define XB_SPIN_CAP (1u << 18)
__device__ __forceinline__ unsigned xb_ld(unsigned* p)              { return __hip_atomic_load(p, __ATOMIC_RELAXED, __HIP_MEMORY_SCOPE_AGENT); }
__device__ __forceinline__ unsigned xb_add(unsigned* p, unsigned v) { return __hip_atomic_fetch_add(p, v, __ATOMIC_RELAXED, __HIP_MEMORY_SCOPE_AGENT); }
__device__ __forceinline__ unsigned xb_xcc_id() { return (unsigned)__builtin_amdgcn_s_getreg((3 << 11) | 20) & 0xFu; }
#define XB_SPIN(cond, bar) do { unsigned _sp = 0; while (cond) { __builtin_amdgcn_s_sleep(1); \
    if ((++_sp & 255u) == 0u) { if (xb_ld(&(bar)[XB_TMO])) break; if (_sp > XB_SPIN_CAP) { atomicAdd(&(bar)[XB_TMO], 1u); break; } } } } while (0)
struct XcdBarrier { unsigned* bar; unsigned x; volatile LAS unsigned* st; };
__device__ __forceinline__ XcdBarrier xcd_barrier_post(unsigned* bar, volatile LAS unsigned* st) {
    XcdBarrier b; b.bar = bar; b.x = xb_xcc_id(); b.st = st;
    if (threadIdx.x == 0) (void)xb_add(&bar[XB_XCNT(b.x)], 1u);
    return b;
}
__device__ __forceinline__ void xcd_barrier_complete(unsigned* bar, unsigned x, unsigned& nloc, unsigned& nx) {
    const unsigned G = gridDim.x * gridDim.y * gridDim.z;
    unsigned sum, cnt, mine, sp = 0u;
    for (;;) {
        sum = 0u; cnt = 0u; mine = 0u;
#pragma unroll
        for (unsigned j = 0; j < 16; ++j) { const unsigned c = xb_ld(&bar[XB_XCNT(j)]); sum += c; cnt += (c > 0u) ? 1u : 0u; mine = (j == x) ? c : mine; }
        if (sum == G) break;
        __builtin_amdgcn_s_sleep(1);
        if ((++sp & 255u) == 0u) { if (xb_ld(&bar[XB_TMO])) break; if (sp > XB_SPIN_CAP) { atomicAdd(&bar[XB_TMO], 1u); break; } }
    }
    nloc = mine > 0u ? mine : 1u; nx = cnt > 0u ? cnt : 1u;
}
__device__ __forceinline__ void xcd_barrier(const XcdBarrier& b) {
    asm volatile("s_waitcnt vmcnt(0)" ::: "memory");
    __syncthreads();
    if (threadIdx.x == 0) {
        unsigned* bar = b.bar;
        __builtin_amdgcn_s_waitcnt(0);
        unsigned nloc = b.st[0], nx = b.st[1];
        if (nloc == 0u) { xcd_barrier_complete(bar, b.x, nloc, nx); b.st[0] = nloc; b.st[1] = nx; }
        const unsigned old = xb_add(&bar[XB_XSUB(b.x)], 1u);
        const unsigned gen = old / nloc;
        if (old + 1u == (gen + 1u) * nloc) {
            __builtin_amdgcn_fence(__ATOMIC_RELEASE, "agent");
            asm volatile("s_waitcnt vmcnt(0)" ::: "memory");
            const unsigned og = xb_add(&bar[XB_TOP], 1u);
            const unsigned tg = og / nx;
            if (og + 1u == (tg + 1u) * nx) xb_add(&bar[XB_TOPGEN], 1u);
            else XB_SPIN(xb_ld(&bar[XB_TOPGEN]) == tg, bar);
            __builtin_amdgcn_fence(__ATOMIC_ACQUIRE, "agent");
            xb_add(&bar[XB_XGEN(b.x)], 1u);
            asm volatile("s_waitcnt vmcnt(0)" ::: "memory");
        } else {
            XB_SPIN(xb_ld(&bar[XB_XGEN(b.x)]) == gen, bar);
            __builtin_amdgcn_fence(__ATOMIC_ACQUIRE, "agent");
            asm volatile("s_waitcnt vmcnt(0)" ::: "memory");
        }
    }
    __syncthreads();
}
constexpr int CW_BAR = 4096;
constexpr int MISC_OFF = 147456;


namespace peer2 {
#define P2_LAS __attribute__((address_space(3)))
typedef float f32x2v __attribute__((ext_vector_type(2)));
constexpr int CW_TICK = 8192;
__device__ __forceinline__ float dpp_add_xor1(float v) { return v + __builtin_bit_cast(float, __builtin_amdgcn_update_dpp(0, __builtin_bit_cast(int, v), 0xB1, 0xf, 0xf, true)); }
__device__ __forceinline__ float dpp_add_xor2(float v) { return v + __builtin_bit_cast(float, __builtin_amdgcn_update_dpp(0, __builtin_bit_cast(int, v), 0x4E, 0xf, 0xf, true)); }
__device__ __forceinline__ float dpp_add_hmir(float v) { return v + __builtin_bit_cast(float, __builtin_amdgcn_update_dpp(0, __builtin_bit_cast(int, v), 0x141, 0xf, 0xf, true)); }
__device__ __forceinline__ float dpp_ror8(float v) { return __builtin_bit_cast(float, __builtin_amdgcn_update_dpp(0, __builtin_bit_cast(int, v), 0x128, 0xf, 0xf, true)); }
__device__ __forceinline__ float swap32_sum(float a, float b) { auto r = __builtin_amdgcn_permlane32_swap(__builtin_bit_cast(unsigned, a), __builtin_bit_cast(unsigned, b), false, false); return __builtin_bit_cast(float, r[0]) + __builtin_bit_cast(float, r[1]); }
struct Own { int j, rank, nrank, nsl; };
__device__ __forceinline__ Own ownership(unsigned* ctl, P2_LAS unsigned* scr, int phase, int wave) {
    const int G = gridDim.x;
    if (threadIdx.x == 0) {
        unsigned* bar = ctl + CW_BAR; bool uni = (G % 8) == 0;
        for (int j = 0; j < 8; ++j) uni = uni && (xb_ld(&bar[XB_XCNT(j)]) == (unsigned)(G / 8));
        const unsigned xcc = xb_xcc_id();
        if (uni && xcc < 8u) { scr[0] = xcc; scr[1] = xb_add(&ctl[CW_TICK + 64 * (8 * phase + (int)xcc)], 1u); }
        else { scr[0] = blockIdx.x & 7; scr[1] = blockIdx.x >> 3; }
    }
    __syncthreads();
    Own o;
    if (G % 8 == 0) { o.j = (int)scr[0]; o.rank = (int)scr[1] * 8 + wave; o.nrank = G; o.nsl = 8; }
    else { o.j = 0; o.rank = blockIdx.x * 8 + wave; o.nrank = G * 8; o.nsl = 1; }
    return o;
}
__device__ __forceinline__ float dot16_fp8(const float (&x)[16], const u32x4 u) {
    const unsigned w[4] = {u.x, u.y, u.z, u.w}; f32x2v a = {0.f, 0.f};
#pragma unroll
    for (int q = 0; q < 4; ++q) { const f32x2v lo = __builtin_amdgcn_cvt_pk_f32_fp8((int)w[q], false), hi = __builtin_amdgcn_cvt_pk_f32_fp8((int)w[q], true);
        a = __builtin_elementwise_fma((f32x2v){x[4 * q], x[4 * q + 1]}, lo, a); a = __builtin_elementwise_fma((f32x2v){x[4 * q + 2], x[4 * q + 3]}, hi, a); }
    return a.x + a.y;
}
__device__ __forceinline__ void u_wave(const float* __restrict__ X, const unsigned char* __restrict__ PU, const int* __restrict__ IDX, float* __restrict__ PART, int j, int rank, int nrank, int lane) {
    const int sub = lane & 7, grp = lane >> 3, col0 = 128 * j + 16 * sub;
    float* part = PART + (size_t)j * M * 128 + 16 * grp;
#define PU_LOADIDX(idv, xv, t_) do { const int tt_ = ((t_) < M) ? (t_) : (M - 1); const u32x4* ip_ = (const u32x4*)(IDX + (size_t)tt_ * 128 + 16 * grp); \
        _Pragma("unroll") for (int q_ = 0; q_ < 4; ++q_) { const u32x4 v_ = ip_[q_]; idv[4 * q_] = (int)v_.x; idv[4 * q_ + 1] = (int)v_.y; idv[4 * q_ + 2] = (int)v_.z; idv[4 * q_ + 3] = (int)v_.w; } \
        const f32x4* xp_ = (const f32x4*)(X + (size_t)tt_ * D + col0); \
        _Pragma("unroll") for (int q_ = 0; q_ < 4; ++q_) { const f32x4 v_ = xp_[q_]; xv[4 * q_] = v_.x; xv[4 * q_ + 1] = v_.y; xv[4 * q_ + 2] = v_.z; xv[4 * q_ + 3] = v_.w; } } while (0)
#define PU_GATHER(ubv, idv) do { _Pragma("unroll") for (int it_ = 0; it_ < 16; ++it_) ubv[it_] = *(const u32x4*)(PU + (size_t)j * (PK * PK * 128) + (size_t)idv[it_] * 128 + 16 * sub); } while (0)
#define PU_COMPUTE(ubv, xv, t_) do { float k0_ = 0.f, k1_ = 0.f; _Pragma("unroll") for (int it_ = 0; it_ < 16; ++it_) { float a_ = dot16_fp8(xv, ubv[it_]); a_ = dpp_add_xor1(a_); a_ = dpp_add_xor2(a_); a_ = dpp_add_hmir(a_); \
            if (it_ < 8) k0_ = ((it_ & 7) == sub) ? a_ : k0_; else k1_ = ((it_ & 7) == sub) ? a_ : k1_; } \
        if ((t_) < M) { part[(size_t)(t_) * 128 + sub] = k0_; part[(size_t)(t_) * 128 + sub + 8] = k1_; } } while (0)
    int idA[16], idB[16]; float xA[16], xB[16], xc[16]; u32x4 ubA[16], ubB[16];
    int t = rank;
    PU_LOADIDX(idA, xA, t); PU_GATHER(ubA, idA);
    PU_LOADIDX(idB, xB, t + nrank);
    for (; t < M; t += 2 * nrank) {
        PU_GATHER(ubB, idB);
#pragma unroll
        for (int q = 0; q < 16; ++q) xc[q] = xA[q];
        PU_LOADIDX(idA, xA, t + 2 * nrank);
        PU_COMPUTE(ubA, xc, t);
        PU_GATHER(ubA, idA);
#pragma unroll
        for (int q = 0; q < 16; ++q) xc[q] = xB[q];
        PU_LOADIDX(idB, xB, t + 3 * nrank);
        PU_COMPUTE(ubB, xc, t + nrank);
    }
#undef PU_LOADIDX
#undef PU_GATHER
#undef PU_COMPUTE
}
__device__ __forceinline__ void v_wave(float* __restrict__ X, const unsigned char* __restrict__ PV, const int* __restrict__ IDX, const float* __restrict__ GATE, const float* __restrict__ PART, P2_LAS float* wbuf, int j, int rank, int nrank, int lane) {
    const int sub = lane & 7, grp = lane >> 3, col0 = 128 * j + 16 * sub;
    const bool h32 = (lane & 32) != 0, h16 = (lane & 16) != 0, h8 = (lane & 8) != 0; const int cq = ((lane >> 5) & 1) * 8 + ((lane >> 4) & 1) * 4 + ((lane >> 3) & 1) * 2;
#define PV_ISSUE(vbv, hv, gv, t_) do { const int tt_ = ((t_) < M) ? (t_) : (M - 1); int id_[16]; const u32x4* ip_ = (const u32x4*)(IDX + (size_t)tt_ * 128 + 16 * grp); \
        _Pragma("unroll") for (int q_ = 0; q_ < 4; ++q_) { const u32x4 v_ = ip_[q_]; id_[4 * q_] = (int)v_.x; id_[4 * q_ + 1] = (int)v_.y; id_[4 * q_ + 2] = (int)v_.z; id_[4 * q_ + 3] = (int)v_.w; } \
        _Pragma("unroll") for (int it_ = 0; it_ < 16; ++it_) vbv[it_] = *(const u32x4*)(PV + (size_t)j * (PK * PK * 128) + (size_t)id_[it_] * 128 + 16 * sub); \
        _Pragma("unroll") for (int jj_ = 0; jj_ < 8; ++jj_) { const float* pp_ = PART + ((size_t)jj_ * M + tt_) * 128; hv[2 * jj_] = pp_[lane]; hv[2 * jj_ + 1] = pp_[64 + lane]; } \
        gv[0] = GATE[(size_t)tt_ * 128 + lane]; gv[1] = GATE[(size_t)tt_ * 128 + 64 + lane]; } while (0)
#define PV_COMPUTE(vbv, hv, gv, t_) do { float h0_ = 0.f, h1_ = 0.f; _Pragma("unroll") for (int jj_ = 0; jj_ < 8; ++jj_) { h0_ += hv[2 * jj_]; h1_ += hv[2 * jj_ + 1]; } \
        h0_ *= (1.f / sp::PEER_SU); h1_ *= (1.f / sp::PEER_SU); \
        const float w0_ = gv[0] * 0.5f * h0_ * (1.f + erff(h0_ * 0.70710678118654752f)), w1_ = gv[1] * 0.5f * h1_ * (1.f + erff(h1_ * 0.70710678118654752f)); \
        f32x2v y_[8]; _Pragma("unroll") for (int q_ = 0; q_ < 8; ++q_) y_[q_] = (f32x2v){0.f, 0.f}; \
        wbuf[lane] = w0_; wbuf[64 + lane] = w1_; asm volatile("s_waitcnt lgkmcnt(0)" ::: "memory");        \
        float wl_[16]; _Pragma("unroll") for (int q_ = 0; q_ < 4; ++q_) { const f32x4 v_ = *(const P2_LAS f32x4*)(wbuf + 16 * grp + 4 * q_); wl_[4 * q_] = v_.x; wl_[4 * q_ + 1] = v_.y; wl_[4 * q_ + 2] = v_.z; wl_[4 * q_ + 3] = v_.w; } \
        asm volatile("s_waitcnt lgkmcnt(0)" ::: "memory"); \
        _Pragma("unroll") for (int it_ = 0; it_ < 16; ++it_) { const float wq_ = wl_[it_]; \
            const unsigned ww_[4] = {vbv[it_].x, vbv[it_].y, vbv[it_].z, vbv[it_].w}; const f32x2v wv_ = {wq_, wq_}; \
            _Pragma("unroll") for (int q_ = 0; q_ < 4; ++q_) { y_[2 * q_] = __builtin_elementwise_fma(wv_, __builtin_amdgcn_cvt_pk_f32_fp8((int)ww_[q_], false), y_[2 * q_]); y_[2 * q_ + 1] = __builtin_elementwise_fma(wv_, __builtin_amdgcn_cvt_pk_f32_fp8((int)ww_[q_], true), y_[2 * q_ + 1]); } } \
        float yy_[16]; _Pragma("unroll") for (int k_ = 0; k_ < 8; ++k_) { yy_[2 * k_] = y_[k_].x; yy_[2 * k_ + 1] = y_[k_].y; } \
          \
        float y8_[8], y4_[4], y2_[2]; \
        _Pragma("unroll") for (int k_ = 0; k_ < 8; ++k_) y8_[k_] = (h32 ? yy_[k_ + 8] : yy_[k_]) + __shfl_xor(h32 ? yy_[k_] : yy_[k_ + 8], 32); \
        _Pragma("unroll") for (int k_ = 0; k_ < 4; ++k_) y4_[k_] = (h16 ? y8_[k_ + 4] : y8_[k_]) + __shfl_xor(h16 ? y8_[k_] : y8_[k_ + 4], 16); \
        _Pragma("unroll") for (int k_ = 0; k_ < 2; ++k_) y2_[k_] = (h8 ? y4_[k_ + 2] : y4_[k_]) + dpp_ror8(h8 ? y4_[k_] : y4_[k_ + 2]); \
        if ((t_) < M) { f32x2v* xp_ = (f32x2v*)(X + (size_t)(t_) * D + col0 + cq); f32x2v xv_ = *xp_; \
            xv_.x = ALPHA * xv_.x + y2_[0] * (1.f / sp::PEER_SV); xv_.y = ALPHA * xv_.y + y2_[1] * (1.f / sp::PEER_SV); *xp_ = xv_; } } while (0)
    u32x4 vbA[16], vbB[16]; float hA[16], hB[16], gA[2], gB[2];
    int t = rank;
    PV_ISSUE(vbA, hA, gA, t);
    for (; t < M; t += 2 * nrank) {
        PV_ISSUE(vbB, hB, gB, t + nrank);
        PV_COMPUTE(vbA, hA, gA, t);
        PV_ISSUE(vbA, hA, gA, t + 2 * nrank);
        PV_COMPUTE(vbB, hB, gB, t + nrank);
    }
#undef PV_ISSUE
#undef PV_COMPUTE
}
__device__ __forceinline__ void ln_row_plain(float* __restrict__ X, const float* __restrict__ g, const float* __restrict__ b, int row, int lane) {
    f32x4* xr = (f32x4*)(X + (size_t)row * D) + lane;
    f32x4 v[4]; float s = 0.f;
#pragma unroll
    for (int jq = 0; jq < 4; ++jq) { v[jq] = xr[64 * jq]; s += (v[jq].x + v[jq].y) + (v[jq].z + v[jq].w); }
    const float mean = wave_sum(s) * (1.f / D); float s2 = 0.f;
#pragma unroll
    for (int jq = 0; jq < 4; ++jq) { v[jq] = v[jq] - mean; s2 += (v[jq].x * v[jq].x + v[jq].y * v[jq].y) + (v[jq].z * v[jq].z + v[jq].w * v[jq].w); }
    const float rstd = rsqrtf(wave_sum(s2) * (1.f / D) + 1e-5f);
#pragma unroll
    for (int jq = 0; jq < 4; ++jq) { const int c = 4 * lane + 256 * jq; const f32x4 gg = *(const f32x4*)(g + c), bb = *(const f32x4*)(b + c); xr[64 * jq] = v[jq] * rstd * gg + bb; }
}
}

struct Params { const float* in[30]; float* out; unsigned char* ws; };
template <class F> __device__ __forceinline__ void run_gemm(unsigned char* lds, const bf16_t* A, int lda, const bf16_t* Bt, int Mr, int N, int K, F f, int cshift = 0) {
    pg8::Gemm g{A, Bt, Mr, N, K, lda}; pg8::StaticOrder S; S.init(Mr, N, gridDim.x, (int)((blockIdx.x + gridDim.x - (unsigned)cshift) % gridDim.x)); pg8::EpiAdapt<F> E{f};
    pg8::gemm_phase<pg8::EpiAdapt<F>, pg8::StaticOrder, true>((PG8_LAS unsigned char*)lds, g, S, E);
}
#ifndef PROBE_ATTN
#define PROBE_ATTN 0
#endif
#ifndef PROBE_SSD
#define PROBE_SSD 0
#endif
#ifndef PROBE_SYNC
#define PROBE_SYNC 0
#endif
#define KA_LAS __attribute__((address_space(4)))
#define PH_BEGIN const KA_LAS unsigned char* ka_ = (const KA_LAS unsigned char*)__builtin_amdgcn_kernarg_segment_ptr(); asm volatile("" : "+s"(ka_))
#define PIN(k) (*(const float* const KA_LAS*)(ka_ + 8 * (k)))
#define POUT (*(float* const KA_LAS*)(ka_ + 240))
#define PWS (*(unsigned char* const KA_LAS*)(ka_ + 248))
__global__ void __launch_bounds__(512, 2) hybrid_fwd(Params P) {
    extern __shared__ __attribute__((aligned(16))) unsigned char lds[];
    cg::grid_group grid = cg::this_grid();
    { PH_BEGIN; volatile LAS unsigned* misc = (volatile LAS unsigned*)((LAS unsigned char*)lds + MISC_OFF);
      if (threadIdx.x < 16) misc[threadIdx.x] = 0u;
      __syncthreads();
      (void)xcd_barrier_post((unsigned*)(PWS + WS_CTL) + CW_BAR, misc);
      if (PWS == nullptr) grid.sync(); }
#define GSYNC() do { PH_BEGIN; XcdBarrier xb_; xb_.bar = (unsigned*)(PWS + WS_CTL) + CW_BAR; xb_.x = xb_xcc_id(); xb_.st = (volatile LAS unsigned*)((LAS unsigned char*)lds + MISC_OFF); xcd_barrier(xb_); } while (0)
    {
        PH_BEGIN; unsigned char* ws = PWS;
        const int tid = opaque_tid(), lane = tid & 63, wave = __builtin_amdgcn_readfirstlane(tid >> 6), c = blockIdx.x, G = gridDim.x;
        const size_t gtid = (size_t)c * 512 + tid, gthreads = (size_t)G * 512; const int gw = c * 8 + wave, NGW = G * 8;
        const float* w_in = PIN(2);
        bf16_t* WinT = (bf16_t*)(ws + WS_WIN); bf16_t* WckvT = (bf16_t*)(ws + WS_WCKV);
        SP_LAS float* scr = (SP_LAS float*)lds + wave * (64 * 33);
        constexpr int I0 = 2560, I1 = 5120, I2 = 6144, I3 = 6656, I4 = 7168, I5 = 7680, I6 = 8192, I7 = 8704, I8 = 9216, I9 = 10240;
        for (int it = gw; it < I9; it += NGW) {
            if (it < I0) sp::transpose_item(w_in, NIN, 0, D, 160, WinT, 0, scr, it, lane);
            else if (it < I1) sp::transpose_item(w_in, NIN, 5152, D, 160, WinT, 5120, scr, it - I0, lane);
            else if (it < I2) sp::transpose_item(PIN(9), D, 0, DI, 32, (bf16_t*)(ws + WS_WSSD), 0, scr, it - I1, lane);
            else if (it < I3) sp::transpose_item(PIN(13), D, 0, D, 32, (bf16_t*)(ws + WS_WDIFF), 0, scr, it - I2, lane);
            else if (it < I4) sp::transpose_item(PIN(15), D, 0, D, 32, (bf16_t*)(ws + WS_WO), 0, scr, it - I3, lane);
            else if (it < I5) sp::transpose_item(PIN(18), D, 0, D, 32, (bf16_t*)(ws + WS_WCQ), 0, scr, it - I4, lane);
            else if (it < I6) sp::transpose_item(PIN(19), D, 0, D, 32, WckvT, 0, scr, it - I5, lane);
            else if (it < I7) sp::transpose_item(PIN(20), D, 0, D, 32, WckvT, 1024, scr, it - I6, lane);
            else if (it < I8) sp::transpose_item(PIN(21), D, 0, D, 32, (bf16_t*)(ws + WS_WCO), 0, scr, it - I7, lane);
            else sp::transpose_item(PIN(24), 2048, 0, D, 64, (bf16_t*)(ws + WS_WPQ), 0, scr, it - I8, lane);
        }
        const float* x = PIN(0);
        sp::cvt_range(PIN(1), (bf16_t*)(ws + WS_MEMB), (size_t)BATCH * MEML * D / 4, gtid, gthreads);
        sp::cvt_range(PIN(25), (bf16_t*)(ws + WS_SUBK), (size_t)PH * 2 * PK * PHALF / 4, gtid, gthreads);
        __syncthreads();
        sp::dt_stage_w((SP_LAS float*)lds, w_in);
        sp::dt_items((SP_LAS float*)lds, (SP_LAS float*)lds + 32768, (SP_LAS float*)lds + 36896  , x, PIN(5), (float*)(ws + WS_DT), (bf16_t*)(ws + WS_XB), c, G, M / 4);
        __syncthreads();
        if (c == 0 && tid == 0) { const float* lam_q = PIN(10); const float* lam_k = PIN(11); float s0 = 0.f, s1 = 0.f;
            for (int i = 0; i < 64; ++i) { s0 += lam_q[i] * lam_k[i]; s1 += lam_q[64 + i] * lam_k[64 + i]; }
            ((float*)(ws + WS_CTL))[CW_LAM] = expf(s0) - expf(s1) + LAMBDA_INIT; }
    }
    GSYNC();
#define YS0_  ((bf16_t*)POUT)
#define AO0_  ((bf16_t*)((unsigned char*)POUT + 32 * MiB))
#define GS0_  ((bf16_t*)((unsigned char*)POUT + 48 * MiB))
#define GA0_  ((bf16_t*)(ws + WS_XB))
#define MIX0_ ((bf16_t*)(ws + WS_XB) + (size_t)SEQ * D)
    { PH_BEGIN; unsigned char* ws = PWS;
      run_gemm(lds, (const bf16_t*)(ws + WS_XB), D, (const bf16_t*)(ws + WS_WIN), SEQ, NINP, D, EpiInProj{(bf16_t*)(ws + WS_H), PIN(14), GS0_}); }
    GSYNC();
#pragma unroll 1
    for (int b = 0; b < BATCH; ++b) {
        { PH_BEGIN; unsigned char* ws = PWS; const int c = blockIdx.x, G = gridDim.x;
          bf16_t* H = (bf16_t*)(ws + WS_H); const float* DTb = (const float*)(ws + WS_DT) + (size_t)b * SEQ * 32;
          for (int u = c; u < 256; u += G) ssd::phaseA_unit((SS_LAS unsigned char*)lds, H, DTb, PIN(3), PIN(4), PIN(6), (bf16_t*)(ws + WS_T1), (float*)(ws + WS_CTL) + 1024, u >> 2, u & 3);
          const float lam = ((const float*)(ws + WS_CTL))[CW_LAM]; const float* subln_w = PIN(12);
          bf16_t* Ob = (b == 0) ? AO0_ : (H + HC_Q); const int ldo = (b == 0) ? D : HP_;
          for (int u = c; u < 256; u += G) { const int h = u >> 5, j = u & 31;
              dattn::unit((DA_LAS unsigned char*)lds, H, h, 63 - j, subln_w, lam, Ob, ldo);
              dattn::unit((DA_LAS unsigned char*)lds, H, h, j, subln_w, lam, Ob, ldo); } }
        GSYNC();
        { PH_BEGIN; unsigned char* ws = PWS; const int tid = opaque_tid();
          for (size_t i = (size_t)blockIdx.x * 512 + tid; i < 131072; i += (size_t)gridDim.x * 512) ssd::scan_phase((bf16_t*)(ws + WS_T1), (const float*)(ws + WS_CTL) + 1024, (int)i); }
        GSYNC();
        { PH_BEGIN; unsigned char* ws = PWS; const int c = blockIdx.x, G = gridDim.x; bf16_t* H = (bf16_t*)(ws + WS_H);
          bf16_t* Yb = (b == 0) ? YS0_ : (H + HC_Z); const int ldy = (b == 0) ? DI : HP_;
          for (int u = c; u < 256; u += G) ssd::phaseC_unit((SS_LAS unsigned char*)lds, H, (const float*)(ws + WS_DT) + (size_t)b * SEQ * 32, PIN(3), PIN(4), PIN(6), PIN(7), PIN(8), (const bf16_t*)(ws + WS_T1), u >> 2, u & 3, Yb, ldy);
          if (b == 0) { const int tid = opaque_tid(); bf16_t* ga = GA0_;
              for (int r0 = 32 * c; r0 < SEQ; r0 += 32 * G) { const int row = r0 + (tid >> 4);
#pragma unroll
                  for (int i = 0; i < 8; ++i) { const int ch = (tid & 15) + 16 * i; *(u32x4*)(ga + (size_t)row * D + ch * 8) = *(const u32x4*)(H + (size_t)row * HP_ + HC_GA + ch * 8); } } } }
        GSYNC();
        if (b + 1 < BATCH) {
            { PH_BEGIN; unsigned char* ws = PWS;
              run_gemm(lds, (const bf16_t*)(ws + WS_XB) + (size_t)(b + 1) * SEQ * D, D, (const bf16_t*)(ws + WS_WIN), SEQ, NINP, D, EpiInProj{(bf16_t*)(ws + WS_H), PIN(14), nullptr}); }
            GSYNC();
        }
    }
    { PH_BEGIN; unsigned char* ws = PWS; bf16_t* H = (bf16_t*)(ws + WS_H); bf16_t* T1a = (bf16_t*)(ws + WS_T1); bf16_t* T1b = T1a + (size_t)SEQ * D; const int hs = (int)gridDim.x / 2;
      run_gemm(lds, H + HC_Z, HP_, (const bf16_t*)(ws + WS_WSSD), SEQ, D, DI, EpiGate1g{H + HC_GS, T1b, HP_, 0}, 0);
      run_gemm(lds, YS0_, DI, (const bf16_t*)(ws + WS_WSSD), SEQ, D, DI, EpiGate1g{GS0_, T1a, D, 0}, hs);
      run_gemm(lds, H + HC_Q, HP_, (const bf16_t*)(ws + WS_WDIFF), SEQ, D, D, EpiGate2g{H + HC_GA, T1b, H + HC_K, HP_, HP_}, 0);
      run_gemm(lds, AO0_, D, (const bf16_t*)(ws + WS_WDIFF), SEQ, D, D, EpiGate2g{GA0_, T1a, MIX0_, D, D}, hs); }
    GSYNC();
    { PH_BEGIN; unsigned char* ws = PWS; const int hs = (int)gridDim.x / 2;
      run_gemm(lds, (const bf16_t*)(ws + WS_H) + HC_K, HP_, (const bf16_t*)(ws + WS_WO), SEQ, D, D, EpiResid{PIN(0), POUT, SEQ, 0}, 0);
      run_gemm(lds, MIX0_, D, (const bf16_t*)(ws + WS_WO), SEQ, D, D, EpiResid{PIN(0), POUT, 0, 0}, hs); }
    GSYNC();
    { PH_BEGIN; unsigned char* ws = PWS; const int tid = opaque_tid(), lane = tid & 63, wave = __builtin_amdgcn_readfirstlane(tid >> 6), c = blockIdx.x, G = gridDim.x;
      const int nk = (G > 32) ? 16 : 0;
      if (c < nk || nk == 0) {
          run_gemm(lds, (const bf16_t*)(ws + WS_MEMB), D, (const bf16_t*)(ws + WS_WCKV), BATCH * MEML, D, D, EpiPlain{(bf16_t*)(ws + WS_KCVC), D, 1.f}, 0);
          for (int bb = 0; bb < BATCH; ++bb)
              run_gemm(lds, (const bf16_t*)(ws + WS_WCKV) + (size_t)D * D, D, (const bf16_t*)(ws + WS_MEMB) + (size_t)bb * MEML * D, D, MEML, D, EpiPlain{(bf16_t*)(ws + WS_KCVC) + (size_t)BATCH * MEML * D + (size_t)bb * D * MEML, MEML, 1.f}, (nk ? 8 + 4 * bb : 0));
      }
      if (c >= nk) {
          const int cr = c - nk, Gr = G - nk; const size_t gtid = (size_t)cr * 512 + tid, gthreads = (size_t)Gr * 512;
          float* out = POUT; const float* g = PIN(16); const float* bb = PIN(17); bf16_t* XB = (bf16_t*)(ws + WS_X1B);
          for (int r = cr * 8 + wave; r < M; r += Gr * 8) sp::ln_row(out, g, bb, XB, r, lane);
          sp::cvt_fp8_range(PIN(26), ws + WS_PU, (size_t)PK * PK * D / 16, sp::PEER_SU, gtid, gthreads);
          sp::cvt_fp8_range(PIN(27), ws + WS_PV, (size_t)PK * PK * D / 16, sp::PEER_SV, gtid, gthreads);
      } }
    GSYNC();
    { PH_BEGIN; unsigned char* ws = PWS;
      run_gemm(lds, (const bf16_t*)(ws + WS_X1B), D, (const bf16_t*)(ws + WS_WCQ), M, D, D, EpiPlain{(bf16_t*)(ws + WS_QC), D, CQSCALE}); }
    GSYNC();
    { PH_BEGIN; unsigned char* ws = PWS; const int c = blockIdx.x, G = gridDim.x;
      for (int u = c; u < 256; u += G) xattn::unit((XA_LAS unsigned char*)lds, (const bf16_t*)(ws + WS_QC), (const bf16_t*)(ws + WS_KCVC), (const bf16_t*)(ws + WS_KCVC) + (size_t)BATCH * MEML * D, (bf16_t*)(ws + WS_XO), u >> 2, u & 3); }
    GSYNC();
    { PH_BEGIN; unsigned char* ws = PWS; float* out = POUT;
      run_gemm(lds, (const bf16_t*)(ws + WS_XO), D, (const bf16_t*)(ws + WS_WCO), M, D, D, EpiResid{out, out, 0, 0}); }
    GSYNC();
    { PH_BEGIN; unsigned char* ws = PWS; const int tid = opaque_tid(), lane = tid & 63, wave = __builtin_amdgcn_readfirstlane(tid >> 6), c = blockIdx.x, G = gridDim.x;
      float* out = POUT; const float* g = PIN(22); const float* bb = PIN(23); bf16_t* XB = (bf16_t*)(ws + WS_X1B);
      for (int r = c * 8 + wave; r < M; r += G * 8) sp::ln_row(out, g, bb, XB, r, lane); }
    GSYNC();
    { PH_BEGIN; unsigned char* ws = PWS;
      run_gemm(lds, (const bf16_t*)(ws + WS_X1B), D, (const bf16_t*)(ws + WS_WPQ), M, 2048, D, EpiPlain{(bf16_t*)(ws + WS_QP), 2048, 1.f}); }
    GSYNC();
    { PH_BEGIN; unsigned char* ws = PWS; const int c = blockIdx.x, G = gridDim.x;
      for (int t = 64 * c; t < M; t += 64 * G) {
          for (int hp = 0; hp < 4; ++hp) psel::stage1((PS_LAS int*)lds, (const bf16_t*)(ws + WS_QP), (const bf16_t*)(ws + WS_SUBK), t, hp);
          __syncthreads();
          psel::stage2((PS_LAS int*)lds, (int*)(ws + WS_IDX), (float*)(ws + WS_GATE), t);
          __syncthreads(); } }
    GSYNC();
    { PH_BEGIN; unsigned char* ws = PWS; const int tid = opaque_tid(), lane = tid & 63, wave = __builtin_amdgcn_readfirstlane(tid >> 6);
      const peer2::Own o = peer2::ownership((unsigned*)(ws + WS_CTL), (P2_LAS unsigned*)lds, 0, wave);
      for (int jj = o.j; jj < 8; jj += o.nsl) peer2::u_wave(POUT, ws + WS_PU, (const int*)(ws + WS_IDX), (float*)(ws + WS_PART), jj, o.rank, o.nrank, lane); }
    GSYNC();
    { PH_BEGIN; unsigned char* ws = PWS; const int tid = opaque_tid(), lane = tid & 63, wave = __builtin_amdgcn_readfirstlane(tid >> 6);
      const peer2::Own o = peer2::ownership((unsigned*)(ws + WS_CTL), (P2_LAS unsigned*)lds, 1, wave);
      for (int jj = o.j; jj < 8; jj += o.nsl) peer2::v_wave(POUT, ws + WS_PV, (const int*)(ws + WS_IDX), (const float*)(ws + WS_GATE), (const float*)(ws + WS_PART), (P2_LAS float*)lds + 64 + wave * 128, jj, o.rank, o.nrank, lane); }
    GSYNC();
    { PH_BEGIN; const int tid = opaque_tid(), lane = tid & 63, wave = __builtin_amdgcn_readfirstlane(tid >> 6);
      float* out = POUT; const float* g3 = PIN(28); const float* b3 = PIN(29);
      for (int r = blockIdx.x * 8 + wave; r < M; r += gridDim.x * 8) peer2::ln_row_plain(out, g3, b3, r, lane); }
}

extern "C" void kernel_launch(void* const* d_in, const int* in_sizes, int n_in, void* d_out, int out_size, void* d_ws, size_t ws_size, hipStream_t stream) {
    static int grid_blocks = 0;
    if (grid_blocks == 0) {
        if (n_in != 30 || out_size != M * D || ws_size < WS_END) { fprintf(stderr, "kernel_launch: unexpected sizes n_in %d out %d ws %zu (need %zu)\n", n_in, out_size, ws_size, (size_t)WS_END); grid_blocks = -1; return; }
        int dev = 0, cus = 0, per_cu = 0;
        (void)hipGetDevice(&dev); (void)hipDeviceGetAttribute(&cus, hipDeviceAttributeMultiprocessorCount, dev);
        (void)hipFuncSetAttribute((const void*)hybrid_fwd, hipFuncAttributeMaxDynamicSharedMemorySize, LDS_BYTES);
        if (hipOccupancyMaxActiveBlocksPerMultiprocessor(&per_cu, (const void*)hybrid_fwd, 512, LDS_BYTES) != hipSuccess || per_cu < 1) { fprintf(stderr, "kernel_launch: occupancy query failed (%d)\n", per_cu); per_cu = 1; }
        (void)hipGetLastError();
        grid_blocks = cus * 1;
    }
    if (grid_blocks < 0) return;
    if (hipMemsetAsync(d_ws, 0, 65536, stream) != hipSuccess) { fprintf(stderr, "kernel_launch: memset of control words failed\n"); return; }
    Params p{};
    for (int i = 0; i < 30; ++i) p.in[i] = (const float*)d_in[i];
    p.out = (float*)d_out; p.ws = (unsigned char*)d_ws;
    void* args[] = {&p};
    hipError_t e = hipLaunchCooperativeKernel((const void*)hybrid_fwd, dim3(grid_blocks), dim3(512), args, LDS_BYTES, stream);
    if (e != hipSuccess) fprintf(stderr, "cooperative launch failed: %s (grid %d)\n", hipGetErrorString(e), grid_blocks);
}
```
